# Optimizing an MI355X kernel written in HIP

```python
import math
import jax, jax.numpy as jnp
from jax import lax
import numpy as np


D_MODEL = 1024
BATCH = 4
SEQ = 8192
DEPTH = 2

GLA_HEADS = 4
GLA_DK = 64
GLA_DV = 128
GLA_RANK = 16
GLA_TAU = 16.0
GLA_CHUNK = 64
DIFF_HEADS = 4
DIFF_DH = 64
DIFF_DV = 2 * DIFF_DH
Q_BLOCK = 128
REL_BUCKETS = 32
REL_MAX_DIST = 128
N_GROUPS = 4
EXPERTS_PER_GROUP = 8
N_EXPERTS = N_GROUPS * EXPERTS_PER_GROUP
TOP_K = 2
D_EXPERT = D_MODEL // 2
RMS_EPS = 1e-6

GLA_QK_W = GLA_HEADS * GLA_DK
GLA_V_W = GLA_HEADS * GLA_DV
DIFF_QK_W = DIFF_HEADS * 2 * DIFF_DH
DIFF_V_W = DIFF_HEADS * DIFF_DV
IN_SPLITS = (GLA_QK_W, GLA_QK_W, GLA_V_W, GLA_V_W, GLA_RANK, GLA_RANK,
             DIFF_QK_W, DIFF_QK_W, DIFF_V_W, D_MODEL, D_MODEL)
D_IN = GLA_QK_W * 2 + GLA_V_W * 2 + GLA_RANK * 2 + DIFF_QK_W * 2 + DIFF_V_W + D_MODEL * 2

kernel_name = 'hybrid_gla_diffattn_hmoe_encoder'


def rms_norm(x, g):
    xf = x.astype(jnp.float32)
    y = xf * lax.rsqrt(jnp.mean(xf * xf, axis=-1, keepdims=True) + RMS_EPS)
    return (y * g.astype(jnp.float32)).astype(x.dtype)


def modulate(h, shift, scale):
    return h * (1.0 + scale[:, None, :]) + shift[:, None, :]


def split_heads(t, n):
    b, s, _ = t.shape
    return t.reshape(b, s, n, -1).transpose(0, 2, 1, 3)


def merge_heads(t):
    b, h, s, d = t.shape
    return t.transpose(0, 2, 1, 3).reshape(b, s, h * d)


def t5_bucket(rel):
    nb = REL_BUCKETS // 2
    max_exact = nb // 2
    ret = jnp.where(rel > 0, nb, 0)
    n = jnp.abs(rel)
    nf = jnp.maximum(n, 1).astype(jnp.float32)
    large = max_exact + (jnp.log(nf / max_exact) / math.log(REL_MAX_DIST / max_exact)
                         * (nb - max_exact)).astype(jnp.int32)
    large = jnp.minimum(large, nb - 1)
    return ret + jnp.where(n < max_exact, n, large)


def gla_chunked(q, k, v, lg, inclusive):
    out_dtype = v.dtype
    b_, h_, s_, dk = q.shape
    dv = v.shape[-1]
    n = s_ // GLA_CHUNK
    f32 = jnp.float32
    q = q.astype(f32).reshape(b_, h_, n, GLA_CHUNK, dk)
    k = k.astype(f32).reshape(b_, h_, n, GLA_CHUNK, dk)
    v = v.astype(f32).reshape(b_, h_, n, GLA_CHUNK, dv)
    cum = jnp.cumsum(lg.astype(f32).reshape(b_, h_, n, GLA_CHUNK, dk), axis=-2)
    cum_last = cum[..., -1:, :]
    q_dec = q * jnp.exp(cum)
    k_inv = k * jnp.exp(-cum)
    k_end = k * jnp.exp(cum_last - cum)
    mask = jnp.tril(jnp.ones((GLA_CHUNK, GLA_CHUNK), bool), 0 if inclusive else -1)
    a = jnp.where(mask, jnp.einsum('bhnid,bhnjd->bhnij', q_dec, k_inv), 0.0)
    o_intra = jnp.einsum('bhnij,bhnjv->bhniv', a, v)
    kv = jnp.einsum('bhncd,bhncv->bhndv', k_end, v)
    chunk_decay = jnp.exp(cum_last[..., 0, :])

    def step(state, inp):
        kv_n, dec_n = inp
        return dec_n[..., None] * state + kv_n, state

    _, states = lax.scan(step, jnp.zeros((b_, h_, dk, dv), f32),
                         (jnp.moveaxis(kv, 2, 0), jnp.moveaxis(chunk_decay, 2, 0)))
    states = jnp.moveaxis(states, 0, 2)
    o_inter = jnp.einsum('bhncd,bhndv->bhncv', q_dec, states)
    return (o_intra + o_inter).reshape(b_, h_, s_, dv).astype(out_dtype)


def diff_attention(q, k, v, lam, rel_bias):
    b_, h_, _, s_, dh = q.shape
    nb = s_ // Q_BLOCK
    qb = q.reshape(b_, h_, 2, nb, Q_BLOCK, dh).transpose(3, 0, 1, 2, 4, 5)
    kpos = jnp.arange(s_, dtype=jnp.int32)
    scale = dh ** -0.5

    def block(args):
        q_blk, start = args
        qpos = start + jnp.arange(Q_BLOCK, dtype=jnp.int32)
        bucket = t5_bucket(kpos[None, :] - qpos[:, None])
        bias = jnp.moveaxis(rel_bias[bucket], -1, 0).astype(jnp.float32)
        logits = (jnp.einsum('bhcqd,bhckd->bhcqk', q_blk, k).astype(jnp.float32) * scale
                  + bias[None, :, None])
        p = jax.nn.softmax(logits, axis=-1)
        w = p[:, :, 0] - lam.astype(jnp.float32) * p[:, :, 1]
        return jnp.einsum('bhqk,bhkv->bhqv', w.astype(v.dtype), v)

    starts = jnp.arange(nb, dtype=jnp.int32) * Q_BLOCK
    out = lax.map(block, (qb, starts))
    return out.transpose(1, 2, 0, 3, 4).reshape(b_, h_, s_, v.shape[-1])


def token_mixer(h, w_in, gla_w_up, gla_b_up, gla_norm_g, qn_g, kn_g, lam_vecs,
                subn_g, rel_bias, w_a, w_b, w_o, lam_init):
    b_, s_, _ = h.shape
    proj = h @ w_in
    idx = np.cumsum(IN_SPLITS)[:-1].tolist()
    (g_q, g_k, g_v, g_g, lr_f, lr_b, d_q, d_k, d_v, gate_a, gate_b) = jnp.split(proj, idx, axis=-1)

    q = split_heads(g_q, GLA_HEADS) * (GLA_DK ** -0.5)
    k = split_heads(g_k, GLA_HEADS)
    v = split_heads(g_v, GLA_HEADS)
    lg_f = split_heads(jax.nn.log_sigmoid((lr_f @ gla_w_up[0] + gla_b_up[0]).astype(jnp.float32)) / GLA_TAU, GLA_HEADS)
    lg_b = split_heads(jax.nn.log_sigmoid((lr_b @ gla_w_up[1] + gla_b_up[1]).astype(jnp.float32)) / GLA_TAU, GLA_HEADS)
    flip = lambda t: jnp.flip(t, axis=2)
    o_f = gla_chunked(q, k, v, lg_f, True)
    o_b = flip(gla_chunked(flip(q), flip(k), flip(v), flip(lg_b), False))
    o_a = merge_heads(rms_norm(o_f + o_b, gla_norm_g)) * jax.nn.silu(g_g)
    y_a = o_a @ w_a

    dq = rms_norm(d_q.reshape(b_, s_, DIFF_HEADS, 2, DIFF_DH).transpose(0, 2, 3, 1, 4), qn_g)
    dk = rms_norm(d_k.reshape(b_, s_, DIFF_HEADS, 2, DIFF_DH).transpose(0, 2, 3, 1, 4), kn_g)
    dv = split_heads(d_v, DIFF_HEADS)
    lam = (jnp.exp(jnp.sum(lam_vecs[0] * lam_vecs[1]).astype(jnp.float32))
           - jnp.exp(jnp.sum(lam_vecs[2] * lam_vecs[3]).astype(jnp.float32)) + lam_init)
    o_b2 = diff_attention(dq, dk, dv, lam, rel_bias)
    o_b2 = merge_heads(rms_norm(o_b2, subn_g) * (1.0 - lam_init))
    y_b = o_b2 @ w_b

    merged = jax.nn.sigmoid(gate_a) * y_a + jax.nn.sigmoid(gate_b) * y_b
    return merged @ w_o


def hier_moe(h, w_rg, b_rg, w_re, b_re, w1, w2):
    b_, s_, d_ = h.shape
    t = h.reshape(-1, d_)
    n_tok = t.shape[0]
    g_logits = (t @ w_rg).astype(jnp.float32) + b_rg.astype(jnp.float32)
    g_prob = jax.nn.softmax(g_logits, axis=-1)
    grp = jnp.argmax(g_logits, axis=-1)
    p_grp = jnp.take_along_axis(g_prob, grp[:, None], axis=-1)
    e_logits = ((t @ w_re).astype(jnp.float32) + b_re.astype(jnp.float32)).reshape(n_tok, N_GROUPS, EXPERTS_PER_GROUP)
    e_logits = jnp.take_along_axis(e_logits, grp[:, None, None], axis=1)[:, 0]
    e_prob = jax.nn.softmax(e_logits, axis=-1)
    top_p, top_e = lax.top_k(e_prob, TOP_K)
    gate = p_grp * (top_p / jnp.sum(top_p, axis=-1, keepdims=True))
    expert = grp[:, None] * EXPERTS_PER_GROUP + top_e
    flat_e = expert.reshape(-1)
    flat_tok = jnp.repeat(jnp.arange(n_tok, dtype=jnp.int32), TOP_K)
    flat_gate = gate.reshape(-1)
    order = jnp.argsort(flat_e)
    tok_s = flat_tok[order]
    xs = t[tok_s]
    sizes = jnp.bincount(flat_e, length=N_EXPERTS).astype(jnp.int32)
    hu = lax.ragged_dot(xs, w1, sizes)
    h_gate, h_up = jnp.split(hu, 2, axis=-1)
    ys = lax.ragged_dot(jax.nn.silu(h_gate) * h_up, w2, sizes)
    ys = ys * flat_gate[order][:, None].astype(ys.dtype)
    out = jnp.zeros_like(t).at[tok_s].add(ys)
    return out.reshape(b_, s_, d_)


def setup_inputs(seed: int = 0) -> dict:
    key = jax.random.key(seed)
    ks = jax.random.split(key, 26)
    nrm = lambda k, shape, s: jax.random.normal(k, shape, jnp.float32) * s
    gain = lambda k, shape: 1.0 + 0.05 * jax.random.normal(k, shape, jnp.float32)
    D = D_MODEL
    return {
        'x': nrm(ks[0], (BATCH, SEQ, D), 1.0),
        'c': nrm(ks[1], (BATCH, D), 1.0),
        'w_ada': nrm(ks[2], (DEPTH, D, 6 * D), 0.5 * D ** -0.5),
        'b_ada': nrm(ks[3], (DEPTH, 6 * D), 0.01),
        'norm1_g': gain(ks[4], (DEPTH, D)),
        'norm2_g': gain(ks[5], (DEPTH, D)),
        'w_in': nrm(ks[6], (DEPTH, D, D_IN), D ** -0.5),
        'gla_w_up': nrm(ks[7], (DEPTH, 2, GLA_RANK, GLA_QK_W), GLA_RANK ** -0.5),
        'gla_b_up': nrm(ks[8], (DEPTH, 2, GLA_QK_W), 0.1),
        'gla_norm_g': gain(ks[9], (DEPTH, GLA_DV)),
        'diff_qnorm_g': gain(ks[10], (DEPTH, DIFF_DH)),
        'diff_knorm_g': gain(ks[11], (DEPTH, DIFF_DH)),
        'diff_lambda': nrm(ks[12], (DEPTH, 4, DIFF_DH), 0.1),
        'diff_subnorm_g': gain(ks[13], (DEPTH, DIFF_DV)),
        'rel_bias': nrm(ks[14], (REL_BUCKETS, DIFF_HEADS), 0.5),
        'w_branch_a': nrm(ks[15], (DEPTH, GLA_V_W, D), GLA_V_W ** -0.5),
        'w_branch_b': nrm(ks[16], (DEPTH, DIFF_V_W, D), DIFF_V_W ** -0.5),
        'w_out': nrm(ks[17], (DEPTH, D, D), D ** -0.5),
        'w_router_group': nrm(ks[18], (DEPTH, D, N_GROUPS), D ** -0.5),
        'b_router_group': nrm(ks[19], (DEPTH, N_GROUPS), 0.01),
        'w_router_expert': nrm(ks[20], (DEPTH, D, N_EXPERTS), D ** -0.5),
        'b_router_expert': nrm(ks[21], (DEPTH, N_EXPERTS), 0.01),
        'w_expert_in': nrm(ks[22], (DEPTH, N_EXPERTS, D, 2 * D_EXPERT), D ** -0.5),
        'w_expert_out': nrm(ks[23], (DEPTH, N_EXPERTS, D_EXPERT, D), D_EXPERT ** -0.5),
    }


def reference(x, c, w_ada, b_ada, norm1_g, norm2_g, w_in, gla_w_up, gla_b_up, gla_norm_g,
              diff_qnorm_g, diff_knorm_g, diff_lambda, diff_subnorm_g, rel_bias,
              w_branch_a, w_branch_b, w_out, w_router_group, b_router_group,
              w_router_expert, b_router_expert, w_expert_in, w_expert_out):
    c_act = jax.nn.silu(c)
    for l in range(DEPTH):
        lam_init = 0.8 - 0.6 * math.exp(-0.3 * l)
        mod = c_act @ w_ada[l] + b_ada[l]
        sh1, sc1, g1, sh2, sc2, g2 = jnp.split(mod, 6, axis=-1)
        h = modulate(rms_norm(x, norm1_g[l]), sh1, sc1)
        y = token_mixer(h, w_in[l], gla_w_up[l], gla_b_up[l], gla_norm_g[l],
                        diff_qnorm_g[l], diff_knorm_g[l], diff_lambda[l], diff_subnorm_g[l],
                        rel_bias, w_branch_a[l], w_branch_b[l], w_out[l], lam_init)
        x = x + g1[:, None, :] * y
        h = modulate(rms_norm(x, norm2_g[l]), sh2, sc2)
        y = hier_moe(h, w_router_group[l], b_router_group[l], w_router_expert[l],
                     b_router_expert[l], w_expert_in[l], w_expert_out[l])
        x = x + g2[:, None, :] * y
    return x
```

```cpp
#include <hip/hip_runtime.h>
#include <cstdio>
#include <cstdint>
#include <cmath>
namespace nv {
constexpr int D = 1024, B = 4, S = 8192, DIN = 5152, NE = 32, DE = 512;
constexpr int O_GQ = 0, O_GK = 256, O_GV = 512, O_GG = 1024, O_LRF = 1536, O_LRB = 1552, O_DQ = 1568, O_DK = 2080, O_DV = 2592, O_GA = 3104, O_GB = 4128;

__device__ __forceinline__ float sigmoidf_(float x) { return 1.f / (1.f + expf(-x)); }
__device__ __forceinline__ float siluf_(float x) { return x / (1.f + expf(-x)); }

__global__ void k_mod(const float* c, const float* w_ada, const float* b_ada, float* mod) {
    int j = blockIdx.x * blockDim.x + threadIdx.x;
    int b = blockIdx.y, l = blockIdx.z;
    if (j >= 6 * D) return;
    const float* w = w_ada + (size_t)l * D * 6 * D;
    float acc = 0.f;
    for (int k = 0; k < D; ++k) acc += siluf_(c[b * D + k]) * w[(size_t)k * 6 * D + j];
    mod[((size_t)l * B + b) * 6 * D + j] = acc + b_ada[l * 6 * D + j];
}

__global__ void k_norm_mod(const float* x, const float* g, const float* sh, const float* sc, float* h) {
    int t = blockIdx.x; const float* xr = x + (size_t)t * D;
    __shared__ float red[4];
    float v[4]; float ss = 0.f;
    for (int i = 0; i < 4; ++i) { v[i] = xr[threadIdx.x + i * 256]; ss += v[i] * v[i]; }
    for (int o = 32; o >= 1; o >>= 1) ss += __shfl_xor(ss, o);
    if ((threadIdx.x & 63) == 0) red[threadIdx.x >> 6] = ss;
    __syncthreads();
    float tot = red[0] + red[1] + red[2] + red[3];
    float r = rsqrtf(tot / D + 1e-6f);
    for (int i = 0; i < 4; ++i) { int cidx = threadIdx.x + i * 256; h[(size_t)t * D + cidx] = v[i] * r * g[cidx] * (1.f + sc[cidx]) + sh[cidx]; }
}

__global__ void __launch_bounds__(256) k_sgemm(const float* __restrict__ A, int lda, const int* __restrict__ arows, const float* __restrict__ Bm, int ldb, size_t strideB,
                                                float* __restrict__ C, int ldc, int M, const int* __restrict__ seg_off, int N, int K) {
    __shared__ float At[16][68];
    __shared__ float Bs[16][64];
    int z = blockIdx.z; int off = 0, m = M;
    if (seg_off) { off = seg_off[z]; m = seg_off[z + 1] - off; }
    int m0 = blockIdx.y * 64; if (m0 >= m) return;
    int n0 = blockIdx.x * 64;
    const float* Bz = Bm + (size_t)z * strideB;
    int tid = threadIdx.x, tx = tid & 15, ty = tid >> 4;
    float acc[4][4] = {};
    int ar = tid >> 2, ak = (tid & 3) * 4;
    int grow = m0 + ar; bool aval = grow < m;
    long arow = aval ? (arows ? (long)arows[off + grow] : (long)(off + grow)) : 0;
    int bk = tid >> 4, bn = (tid & 15) * 4;
    for (int k0 = 0; k0 < K; k0 += 16) {
        float4 av = aval ? *(const float4*)(A + arow * lda + k0 + ak) : make_float4(0, 0, 0, 0);
        At[ak + 0][ar] = av.x; At[ak + 1][ar] = av.y; At[ak + 2][ar] = av.z; At[ak + 3][ar] = av.w;
        float4 bv = make_float4(0, 0, 0, 0);
        if (n0 + bn < N) bv = *(const float4*)(Bz + (size_t)(k0 + bk) * ldb + n0 + bn);
        *(float4*)&Bs[bk][bn] = bv;
        __syncthreads();
#pragma unroll
        for (int k = 0; k < 16; ++k) {
            float4 a = *(const float4*)&At[k][ty * 4]; float4 b = *(const float4*)&Bs[k][tx * 4];
            float aa[4] = {a.x, a.y, a.z, a.w}, bb[4] = {b.x, b.y, b.z, b.w};
#pragma unroll
            for (int i = 0; i < 4; ++i)
#pragma unroll
                for (int j = 0; j < 4; ++j) acc[i][j] += aa[i] * bb[j];
        }
        __syncthreads();
    }
    for (int i = 0; i < 4; ++i) { int r = m0 + ty * 4 + i; if (r >= m) continue; int cn = n0 + tx * 4; if (cn >= N) continue;
        *(float4*)(C + (size_t)(off + r) * ldc + cn) = make_float4(acc[i][0], acc[i][1], acc[i][2], acc[i][3]); }
}

__global__ void k_gla_gate(const float* proj, const float* w_up, const float* b_up, float* a) {
    int t = blockIdx.x, dir = blockIdx.y, j = threadIdx.x;
    const float* lr = proj + (size_t)t * DIN + (dir ? O_LRB : O_LRF);
    float z = b_up[dir * 256 + j];
    for (int r = 0; r < 16; ++r) z += lr[r] * w_up[(dir * 16 + r) * 256 + j];
    float ls = fminf(z, 0.f) - log1pf(expf(-fabsf(z)));
    a[((size_t)dir * S + t) * 256 + j] = expf(ls * (1.f / 16.f));
}

__global__ void k_gla(const float* proj, const float* a, float* o  ) {
    int lane = threadIdx.x & 63, w = threadIdx.x >> 6; int dv = blockIdx.x * 4 + w, h = blockIdx.y, dir = blockIdx.z;
    float st = 0.f;
    for (int i0 = 0; i0 < S; i0 += 8) {
        float qv[8], kv[8], vv[8], avv[8];
#pragma unroll
        for (int u = 0; u < 8; ++u) {
            int t = dir ? (S - 1 - (i0 + u)) : (i0 + u);
            const float* pr = proj + (size_t)t * DIN;
            qv[u] = pr[O_GQ + h * 64 + lane] * 0.125f; kv[u] = pr[O_GK + h * 64 + lane]; vv[u] = pr[O_GV + h * 128 + dv];
            avv[u] = a[((size_t)dir * S + t) * 256 + h * 64 + lane];
        }
#pragma unroll
        for (int u = 0; u < 8; ++u) {
            int t = dir ? (S - 1 - (i0 + u)) : (i0 + u);
            float contrib;
            if (dir == 0) { st = avv[u] * st + kv[u] * vv[u]; contrib = qv[u] * st; }
            else { st = avv[u] * st; contrib = qv[u] * st; st += kv[u] * vv[u]; }
            for (int off = 32; off >= 1; off >>= 1) contrib += __shfl_xor(contrib, off);
            if (lane == 0) o[((size_t)dir * S + t) * 512 + h * 128 + dv] = contrib;
        }
    }
}

__global__ void k_gla_post(const float* o, const float* proj, const float* g, float* oa) {
    int t = blockIdx.x, h = blockIdx.y, dv = threadIdx.x;
    float v = o[(size_t)t * 512 + h * 128 + dv] + o[((size_t)S + t) * 512 + h * 128 + dv];
    __shared__ float red[2];
    float ss = v * v; for (int off = 32; off >= 1; off >>= 1) ss += __shfl_xor(ss, off);
    if ((dv & 63) == 0) red[dv >> 6] = ss; __syncthreads();
    float r = rsqrtf((red[0] + red[1]) / 128.f + 1e-6f);
    float gg = proj[(size_t)t * DIN + O_GG + h * 128 + dv];
    oa[(size_t)t * 512 + h * 128 + dv] = v * r * g[dv] * siluf_(gg);
}

__global__ void k_qknorm(const float* proj, const float* qg, const float* kg, float* qn, float* kn) {
    int t = blockIdx.x; int grp = threadIdx.x >> 6, lane = threadIdx.x & 63;
    for (int which = 0; which < 2; ++which) {
        const float* src = proj + (size_t)t * DIN + (which ? O_DK : O_DQ) + grp * 64;
        float v = src[lane]; float ss = v * v; for (int off = 32; off >= 1; off >>= 1) ss += __shfl_xor(ss, off);
        float r = rsqrtf(ss / 64.f + 1e-6f);
        (which ? kn : qn)[(size_t)t * 512 + grp * 64 + lane] = v * r * (which ? kg : qg)[lane];
    }
}

__device__ __forceinline__ int t5_bucket(int rel) {
    int ret = rel > 0 ? 16 : 0; int n = rel < 0 ? -rel : rel;
    if (n < 8) return ret + n;
    int lg = 8 + (n >= 12) + (n >= 16) + (n >= 23) + (n >= 32) + (n >= 46) + (n >= 64) + (n >= 91);
    return ret + lg;
}
__global__ void k_bias_tab(const float* rel_bias, float* tab) {
    int i = blockIdx.x * blockDim.x + threadIdx.x; int h = blockIdx.y; if (i >= 16384) return;
    int rel = i - 8192; tab[h * 16384 + i] = rel_bias[t5_bucket(rel) * 4 + h];
}

__global__ void __launch_bounds__(256) k_attn(const float* qn, const float* kn, const float* proj, const float* tab, const float* lamv, const float* subg, float lam_init, float* ob) {
    extern __shared__ float sm[];
    float* Qt = sm;
    float* Kt = Qt + 2 * 64 * 68;
    float* Vs = Kt + 2 * 64 * 68;
    float* Wt = Vs + 64 * 128;
    __shared__ float lam_s;
    int tid = threadIdx.x, tx = tid & 15, ty = tid >> 4; int q0 = blockIdx.x * 64, h = blockIdx.y;
    if (tid == 0) { float s1 = 0.f, s2 = 0.f; for (int i = 0; i < 64; ++i) { s1 += lamv[i] * lamv[64 + i]; s2 += lamv[128 + i] * lamv[192 + i]; } lam_s = expf(s1) - expf(s2) + lam_init; }
    for (int i = tid; i < 2 * 64 * 64; i += 256) { int c = i >> 12, r = (i >> 6) & 63, d = i & 63; Qt[(c * 64 + d) * 68 + r] = qn[(size_t)(q0 + r) * 512 + h * 128 + c * 64 + d]; }
    __syncthreads();
    const float lam = lam_s;
    const float* tb = tab + h * 16384 + 8192;
    float m_[2][4], l_[2][4];
    for (int c = 0; c < 2; ++c) for (int i = 0; i < 4; ++i) { m_[c][i] = -1e30f; l_[c][i] = 0.f; }
    float oacc[4][8] = {};
    for (int pass = 0; pass < 2; ++pass) {
        for (int k0 = 0; k0 < S; k0 += 64) {
            __syncthreads();
            for (int i = tid; i < 2 * 64 * 64; i += 256) { int c = i >> 12, r = (i >> 6) & 63, d = i & 63; Kt[(c * 64 + d) * 68 + r] = kn[(size_t)(k0 + r) * 512 + h * 128 + c * 64 + d]; }
            if (pass == 1) for (int i = tid; i < 64 * 128; i += 256) { int r = i >> 7, d = i & 127; Vs[r * 128 + d] = proj[(size_t)(k0 + r) * DIN + O_DV + h * 128 + d]; }
            __syncthreads();
            float s[2][4][4];
            for (int c = 0; c < 2; ++c) {
                for (int i = 0; i < 4; ++i) for (int j = 0; j < 4; ++j) s[c][i][j] = 0.f;
                for (int d = 0; d < 64; ++d) {
                    float4 a = *(const float4*)&Qt[(c * 64 + d) * 68 + ty * 4]; float4 b = *(const float4*)&Kt[(c * 64 + d) * 68 + tx * 4];
                    float aa[4] = {a.x, a.y, a.z, a.w}, bb[4] = {b.x, b.y, b.z, b.w};
                    for (int i = 0; i < 4; ++i) for (int j = 0; j < 4; ++j) s[c][i][j] += aa[i] * bb[j];
                }
                for (int i = 0; i < 4; ++i) for (int j = 0; j < 4; ++j) { int qq = q0 + ty * 4 + i, kk = k0 + tx * 4 + j; s[c][i][j] = s[c][i][j] * 0.125f + tb[kk - qq]; }
            }
            if (pass == 0) {
                for (int c = 0; c < 2; ++c) for (int i = 0; i < 4; ++i) {
                    float mx = fmaxf(fmaxf(s[c][i][0], s[c][i][1]), fmaxf(s[c][i][2], s[c][i][3]));
                    for (int off = 1; off < 16; off <<= 1) mx = fmaxf(mx, __shfl_xor(mx, off));
                    float mn = fmaxf(m_[c][i], mx);
                    float sum = expf(s[c][i][0] - mn) + expf(s[c][i][1] - mn) + expf(s[c][i][2] - mn) + expf(s[c][i][3] - mn);
                    for (int off = 1; off < 16; off <<= 1) sum += __shfl_xor(sum, off);
                    l_[c][i] = l_[c][i] * expf(m_[c][i] - mn) + sum; m_[c][i] = mn;
                }
            } else {
                for (int i = 0; i < 4; ++i) for (int j = 0; j < 4; ++j) {
                    float w = expf(s[0][i][j] - m_[0][i]) / l_[0][i] - lam * expf(s[1][i][j] - m_[1][i]) / l_[1][i];
                    Wt[(tx * 4 + j) * 68 + ty * 4 + i] = w;
                }
                __syncthreads();
                for (int k = 0; k < 64; ++k) {
                    float4 w4 = *(const float4*)&Wt[k * 68 + ty * 4]; float ww[4] = {w4.x, w4.y, w4.z, w4.w};
                    float4 v0 = *(const float4*)&Vs[k * 128 + tx * 8], v1 = *(const float4*)&Vs[k * 128 + tx * 8 + 4];
                    float vv[8] = {v0.x, v0.y, v0.z, v0.w, v1.x, v1.y, v1.z, v1.w};
                    for (int i = 0; i < 4; ++i) for (int j = 0; j < 8; ++j) oacc[i][j] += ww[i] * vv[j];
                }
            }
        }
    }
    for (int i = 0; i < 4; ++i) {
        float ss = 0.f; for (int j = 0; j < 8; ++j) ss += oacc[i][j] * oacc[i][j];
        for (int off = 1; off < 16; off <<= 1) ss += __shfl_xor(ss, off);
        float r = rsqrtf(ss / 128.f + 1e-6f) * (1.f - lam_init);
        for (int j = 0; j < 8; ++j) ob[(size_t)(q0 + ty * 4 + i) * 512 + h * 128 + tx * 8 + j] = oacc[i][j] * r * subg[tx * 8 + j];
    }
}

__global__ void k_merge(const float* proj, float* ya, const float* yb) {
    size_t i = (size_t)blockIdx.x * blockDim.x + threadIdx.x; if (i >= (size_t)S * D) return;
    size_t t = i / D; int cidx = (int)(i % D);
    float ga = proj[t * DIN + O_GA + cidx], gb = proj[t * DIN + O_GB + cidx];
    ya[i] = sigmoidf_(ga) * ya[i] + sigmoidf_(gb) * yb[i];
}
__global__ void k_resid(float* x, const float* y, const float* g) {
    size_t i = (size_t)blockIdx.x * blockDim.x + threadIdx.x; if (i >= (size_t)S * D) return;
    x[i] += g[i % D] * y[i];
}

__global__ void k_router(const float* h, const float* w_rg, const float* b_rg, const float* w_re, const float* b_re, int* eid, float* gate) {
    int t = blockIdx.x * 4 + (threadIdx.x >> 6); int lane = threadIdx.x & 63;
    const float* hr = h + (size_t)t * D;
    float acc[36];
    for (int j = 0; j < 36; ++j) acc[j] = 0.f;
    for (int k = lane; k < D; k += 64) { float hv = hr[k];
        for (int j = 0; j < 4; ++j) acc[j] += hv * w_rg[k * 4 + j];
        for (int j = 0; j < 32; ++j) acc[4 + j] += hv * w_re[k * 32 + j]; }
    float mine = 0.f;
#pragma unroll
    for (int j = 0; j < 36; ++j) { float a = acc[j]; for (int off = 32; off >= 1; off >>= 1) a += __shfl_xor(a, off); mine = (lane == j) ? a : mine; }
    if (lane < 4) mine += b_rg[lane]; else if (lane < 36) mine += b_re[lane - 4];
    float g0 = __shfl(mine, 0), g1 = __shfl(mine, 1), g2 = __shfl(mine, 2), g3 = __shfl(mine, 3);
    int grp = 0; float mx = g0;
    if (g1 > mx) { mx = g1; grp = 1; } if (g2 > mx) { mx = g2; grp = 2; } if (g3 > mx) { mx = g3; grp = 3; }
    float den = expf(g0 - mx) + expf(g1 - mx) + expf(g2 - mx) + expf(g3 - mx);
    float p_grp = 1.f / den;
    float b0v = -1e30f, b1v = -1e30f; int i0 = 0, i1 = 0;
#pragma unroll
    for (int j = 0; j < 8; ++j) { float e = __shfl(mine, 4 + grp * 8 + j);
        if (e > b0v) { b1v = b0v; i1 = i0; b0v = e; i0 = j; } else if (e > b1v) { b1v = e; i1 = j; } }
    float p0 = 1.f, p1 = expf(b1v - b0v); float s2 = p0 + p1;
    if (lane == 0) {
        eid[t * 2] = grp * 8 + i0; eid[t * 2 + 1] = grp * 8 + i1;
        gate[t * 2] = p_grp * p0 / s2; gate[t * 2 + 1] = p_grp * p1 / s2;
    }
}
__global__ void k_moe_sort(const int* eid, int* seg_off, int* sorted_tok, int* slot_pos) {
    int e = threadIdx.x;
    int cnt = 0;
    if (e < 32) for (int i = 0; i < 2 * S; ++i) cnt += (eid[i] == e);
    int incl = cnt; for (int off = 1; off < 32; off <<= 1) { int v = __shfl_up(incl, off); if ((e & 63) >= off) incl += v; }
    int base = incl - cnt;
    if (e < 32) { seg_off[e] = base; if (e == 31) seg_off[32] = incl;
        int p = base; for (int i = 0; i < 2 * S; ++i) if (eid[i] == e) { sorted_tok[p] = i >> 1; slot_pos[i] = p; ++p; } }
}
__global__ void k_moe_act(const float* hu, float* act) {
    size_t i = (size_t)blockIdx.x * blockDim.x + threadIdx.x; if (i >= (size_t)2 * S * DE) return;
    size_t r = i / DE; int j = (int)(i % DE);
    act[i] = siluf_(hu[r * 1024 + j]) * hu[r * 1024 + 512 + j];
}
__global__ void k_moe_combine(float* x, const float* ys, const int* slot_pos, const float* gate, const float* g2) {
    size_t i = (size_t)blockIdx.x * blockDim.x + threadIdx.x; if (i >= (size_t)S * D) return;
    size_t t = i / D; int cidx = (int)(i % D);
    float y = gate[t * 2] * ys[(size_t)slot_pos[t * 2] * D + cidx] + gate[t * 2 + 1] * ys[(size_t)slot_pos[t * 2 + 1] * D + cidx];
    x[i] += g2[cidx] * y;
}

struct Bufs {
    float *mod, *tab, *h, *proj, *agate, *ogla, *oa, *qn, *kn, *ob, *ya, *yb, *mix, *hu, *act, *ys, *gate; int *eid, *seg, *stok, *spos;
};
inline size_t carve(char* base, Bufs& b) {
    size_t o = 0; auto take = [&](size_t bytes) { void* p = base ? base + o : nullptr; o += (bytes + 255) & ~(size_t)255; return p; };
    b.mod = (float*)take((size_t)2 * B * 6 * D * 4); b.tab = (float*)take(4 * 16384 * 4);
    b.h = (float*)take((size_t)S * D * 4); b.proj = (float*)take((size_t)S * DIN * 4); b.agate = (float*)take((size_t)2 * S * 256 * 4);
    b.ogla = (float*)take((size_t)2 * S * 512 * 4); b.oa = (float*)take((size_t)S * 512 * 4); b.qn = (float*)take((size_t)S * 512 * 4); b.kn = (float*)take((size_t)S * 512 * 4);
    b.ob = (float*)take((size_t)S * 512 * 4); b.ya = (float*)take((size_t)S * D * 4); b.yb = (float*)take((size_t)S * D * 4); b.mix = (float*)take((size_t)S * D * 4);
    b.hu = (float*)take((size_t)2 * S * 1024 * 4); b.act = (float*)take((size_t)2 * S * DE * 4); b.ys = (float*)take((size_t)2 * S * D * 4); b.gate = (float*)take((size_t)2 * S * 4);
    b.eid = (int*)take((size_t)2 * S * 4); b.seg = (int*)take(64 * 4); b.stok = (int*)take((size_t)2 * S * 4); b.spos = (int*)take((size_t)2 * S * 4);
    return o;
}
constexpr int ATTN_LDS = (2 * 64 * 68 * 2 + 64 * 128 + 64 * 68) * 4;

inline void run_batch_layers(void* const* d_in, const Bufs& w, float* xb, int b, int l0, int l1, hipStream_t st) {
    const float* norm1_g = (const float*)d_in[4]; const float* norm2_g = (const float*)d_in[5]; const float* w_in = (const float*)d_in[6];
    const float* gla_w_up = (const float*)d_in[7]; const float* gla_b_up = (const float*)d_in[8]; const float* gla_norm_g = (const float*)d_in[9];
    const float* qg = (const float*)d_in[10]; const float* kg = (const float*)d_in[11]; const float* lamv = (const float*)d_in[12]; const float* subg = (const float*)d_in[13];
    const float* w_a = (const float*)d_in[15]; const float* w_b = (const float*)d_in[16]; const float* w_o = (const float*)d_in[17];
    const float* w_rg = (const float*)d_in[18]; const float* b_rg = (const float*)d_in[19]; const float* w_re = (const float*)d_in[20]; const float* b_re = (const float*)d_in[21];
    const float* w1 = (const float*)d_in[22]; const float* w2 = (const float*)d_in[23];
    for (int l = l0; l < l1; ++l) {
        const float* md = w.mod + ((size_t)l * B + b) * 6 * D;
        const float lam_init = 0.8f - 0.6f * expf(-0.3f * (float)l);
        k_norm_mod<<<S, 256, 0, st>>>(xb, norm1_g + l * D, md + 0 * D, md + 1 * D, w.h);
        k_sgemm<<<dim3((DIN + 63) / 64, S / 64, 1), 256, 0, st>>>(w.h, D, nullptr, w_in + (size_t)l * D * DIN, DIN, 0, w.proj, DIN, S, nullptr, DIN, D);
        k_gla_gate<<<dim3(S, 2), 256, 0, st>>>(w.proj, gla_w_up + (size_t)l * 2 * 16 * 256, gla_b_up + l * 2 * 256, w.agate);
        k_gla<<<dim3(32, 4, 2), 256, 0, st>>>(w.proj, w.agate, w.ogla);
        k_gla_post<<<dim3(S, 4), 128, 0, st>>>(w.ogla, w.proj, gla_norm_g + l * 128, w.oa);
        k_qknorm<<<S, 512, 0, st>>>(w.proj, qg + l * 64, kg + l * 64, w.qn, w.kn);
        k_attn<<<dim3(S / 64, 4), 256, ATTN_LDS, st>>>(w.qn, w.kn, w.proj, w.tab, lamv + l * 256, subg + l * 128, lam_init, w.ob);
        k_sgemm<<<dim3(D / 64, S / 64, 1), 256, 0, st>>>(w.oa, 512, nullptr, w_a + (size_t)l * 512 * D, D, 0, w.ya, D, S, nullptr, D, 512);
        k_sgemm<<<dim3(D / 64, S / 64, 1), 256, 0, st>>>(w.ob, 512, nullptr, w_b + (size_t)l * 512 * D, D, 0, w.yb, D, S, nullptr, D, 512);
        k_merge<<<(S * D + 255) / 256, 256, 0, st>>>(w.proj, w.ya, w.yb);
        k_sgemm<<<dim3(D / 64, S / 64, 1), 256, 0, st>>>(w.ya, D, nullptr, w_o + (size_t)l * D * D, D, 0, w.mix, D, S, nullptr, D, D);
        k_resid<<<(S * D + 255) / 256, 256, 0, st>>>(xb, w.mix, md + 2 * D);
        k_norm_mod<<<S, 256, 0, st>>>(xb, norm2_g + l * D, md + 3 * D, md + 4 * D, w.h);
        k_router<<<S / 4, 256, 0, st>>>(w.h, w_rg + (size_t)l * D * 4, b_rg + l * 4, w_re + (size_t)l * D * 32, b_re + l * 32, w.eid, w.gate);
        k_moe_sort<<<1, 64, 0, st>>>(w.eid, w.seg, w.stok, w.spos);
        k_sgemm<<<dim3(1024 / 64, (2 * S) / 64, 32), 256, 0, st>>>(w.h, D, w.stok, w1 + (size_t)l * NE * D * 1024, 1024, (size_t)D * 1024, w.hu, 1024, 0, w.seg, 1024, D);
        k_moe_act<<<(2 * S * DE + 255) / 256, 256, 0, st>>>(w.hu, w.act);
        k_sgemm<<<dim3(D / 64, (2 * S) / 64, 32), 256, 0, st>>>(w.act, DE, nullptr, w2 + (size_t)l * NE * DE * D, D, (size_t)DE * D, w.ys, D, 0, w.seg, D, DE);
        k_moe_combine<<<(S * D + 255) / 256, 256, 0, st>>>(xb, w.ys, w.spos, w.gate, md + 5 * D);
    }
}
inline void prep(void* const* d_in, const Bufs& w, hipStream_t st) {
    static bool attr = false; if (!attr) { (void)hipFuncSetAttribute((const void*)k_attn, hipFuncAttributeMaxDynamicSharedMemorySize, ATTN_LDS); attr = true; }
    k_mod<<<dim3(6 * D / 256, B, 2), 256, 0, st>>>((const float*)d_in[1], (const float*)d_in[2], (const float*)d_in[3], w.mod);
    k_bias_tab<<<dim3(64, 4), 256, 0, st>>>((const float*)d_in[14], w.tab);
}
}
extern "C" void kernel_launch(void* const* d_in, const int* in_sizes, int n_in, void* d_out, int out_size, void* d_ws, size_t ws_size, hipStream_t stream) {
    (void)in_sizes; (void)n_in; (void)out_size; (void)ws_size;
    nv::Bufs w; nv::carve((char*)d_ws, w);
    float* out = (float*)d_out;
    hipMemcpyAsync(out, d_in[0], (size_t)nv::B * nv::S * nv::D * 4, hipMemcpyDeviceToDevice, stream);
    nv::prep(d_in, w, stream);
    for (int b = 0; b < nv::B; ++b) nv::run_batch_layers(d_in, w, out + (size_t)b * nv::S * nv::D, b, 0, 2, stream);
}
```

```cpp
#include <hip/hip_runtime.h>
#include <cstdio>
#include <cstdint>
#include <cmath>
namespace pg8 {
#define PG8_LAS __attribute__((address_space(3)))
typedef unsigned short bf16_t;
typedef short bf16x8 __attribute__((ext_vector_type(8)));
typedef float f32x4 __attribute__((ext_vector_type(4)));
typedef unsigned u32x4 __attribute__((ext_vector_type(4)));
constexpr int BM = 256, BK = 64, HALF = 128, HTB = HALF * BK * 2  , STAGE_BYTES = 8 * HTB, NXCD = 8, WGM = 8;

__host__ __device__ __forceinline__ int lds_byte(int r, int c) { const int st = (r >> 4) * 2 + (c >> 5), rr = r & 15, cc = c & 31, ob = rr * 64 + cc * 2; return st * 1024 + (ob ^ (((ob >> 9) & 1) << 5)); }
__host__ __device__ __forceinline__ void stage_rc(int b, int& R, int& C) { const int st = b / 1024, sb = b % 1024, swz = sb ^ (((sb >> 9) & 1) << 5); R = (st >> 1) * 16 + swz / 64; C = (st & 1) * 32 + (swz % 64) / 2; }
__host__ __device__ __forceinline__ int perm32(int rho) { const int n = rho >> 4, i = rho & 15; return 8 * (i >> 2) + 4 * n + (i & 3); }

struct Unit { int pm, pn; };
struct Gemm { const bf16_t* A; const bf16_t* Bt; int M, N, K; };

struct StaticOrder {
    int nM, nN, nwg, G, c;
    __host__ __device__ void init(int M, int N, int G_, int c_) { nM = M / BM; nN = N / BM; nwg = nM * nN; G = G_; c = c_; }
    __host__ __device__ bool next(int i, Unit& u) const {
        const long L = (long)i * G + c; if (L >= nwg) return false;
        int wgid = (int)L; { const int q = nwg / NXCD, r = nwg % NXCD, xcd = wgid % NXCD, off = wgid / NXCD; wgid = (xcd < r ? xcd * (q + 1) : r * (q + 1) + (xcd - r) * q) + off; }
        const int nig = WGM * nN, gid = wgid / nig, fm = gid * WGM, gsz = (nM - fm) < WGM ? (nM - fm) : WGM;
        u.pm = fm + ((wgid % nig) % gsz); u.pn = (wgid % nig) / gsz; return true;
    }
    __device__ __forceinline__ void a_ready(const Unit&) const {}
    __device__ __forceinline__ void done(const Unit&) const {}
};
__device__ __forceinline__ unsigned cvt_pk_bf16(float lo, float hi) { unsigned r; asm volatile("v_cvt_pk_bf16_f32 %0, %1, %2" : "=v"(r) : "v"(lo), "v"(hi)); return r; }
template <class Epi, class Sched, bool ALIGN_EPI = false, bool SP2 = false>
__device__ __forceinline__ void gemm_phase(PG8_LAS unsigned char* lds, const Gemm g, const Sched& S, const Epi& E) {
    int tid_ = threadIdx.x; asm volatile("" : "+v"(tid_));
    const int tid = tid_, wid = __builtin_amdgcn_readfirstlane(tid >> 6), lane = tid & 63, wr = wid >> 2, wc = wid & 3, fr = lane & 15, fq = lane >> 4;
    const int K = g.K, nt = K / BK;
    unsigned voffA[2], voffB[2];
#pragma unroll
    for (int i = 0; i < 2; ++i) { int R, C; stage_rc(tid * 16 + i * 8192, R, C); const int Rb = Epi::PERM ? ((R & ~31) + perm32(R & 31)) : R;
        voffA[i] = (unsigned)(R * K + C) * 2u; voffB[i] = (unsigned)(Rb * K + C) * 2u; }
    const size_t kstep = (size_t)(BK * 2);
    const size_t hstep = (size_t)HALF * K * 2;
    const size_t tstep = 2 * hstep;
    const unsigned ldsw = (unsigned)wid * 1024u;
    const int aoff = lds_byte(wr * 64 + fr, fq * 8), boff = lds_byte(wc * 32 + fr, fq * 8);
#define PG8_SA(b, h) (((b) * 2 + (h)) * HTB)
#define PG8_SB(b, h) ((4 + (b) * 2 + (h)) * HTB)
#define PG8_STAGE(bufoff, gbase, voff) do { _Pragma("unroll") for (int _i = 0; _i < 2; ++_i) \
        __builtin_amdgcn_global_load_lds((const unsigned*)((const char*)(gbase) + (voff)[_i]), (PG8_LAS unsigned*)(lds + (bufoff) + ldsw + _i * 8192), 16, 0, 0); } while (0)
#define PG8_LDA(dst, b, h) do { _Pragma("unroll") for (int m = 0; m < 4; ++m) _Pragma("unroll") for (int k = 0; k < 2; ++k) dst[m][k] = *(const PG8_LAS bf16x8*)(lds + PG8_SA(b, h) + aoff + m * 2048 + k * 1024); } while (0)
#define PG8_LDB(dst, b, h) do { _Pragma("unroll") for (int n = 0; n < 2; ++n) _Pragma("unroll") for (int k = 0; k < 2; ++k) dst[n][k] = *(const PG8_LAS bf16x8*)(lds + PG8_SB(b, h) + boff + n * 2048 + k * 1024); } while (0)
#define PG8_MMA(ai, bj, At, Bt) do { __builtin_amdgcn_s_setprio(1); _Pragma("unroll") for (int m = 0; m < 4; ++m) _Pragma("unroll") for (int n = 0; n < 2; ++n) _Pragma("unroll") for (int k = 0; k < 2; ++k) \
        acc[ai][bj][m][n] = __builtin_amdgcn_mfma_f32_16x16x32_bf16(Bt[n][k], At[m][k], acc[ai][bj][m][n], 0, 0, 0); __builtin_amdgcn_s_setprio(0); } while (0)
#define PG8_WAIT_V(n) asm volatile("s_waitcnt vmcnt(" #n ")" ::: "memory")
#define PG8_WAIT_L(n) asm volatile("s_waitcnt lgkmcnt(" #n ")" ::: "memory")
#define PG8_BAR __builtin_amdgcn_s_barrier()
#define PG8_SCHED __builtin_amdgcn_sched_barrier(0)
    Unit cur, nxt; int ui = 0;
    if (!S.next(0, cur)) return;
    f32x4 acc[2][2][4][2];
#pragma unroll
    for (int a = 0; a < 2; ++a)
#pragma unroll
        for (int b = 0; b < 2; ++b)
#pragma unroll
            for (int m = 0; m < 4; ++m)
#pragma unroll
                for (int n = 0; n < 2; ++n) acc[a][b][m][n] = (f32x4){0.f, 0.f, 0.f, 0.f};
    bf16x8 At[4][2], B0[2][2], B1[2][2];
    const char* cA = (const char*)g.A + (size_t)cur.pm * tstep; const char* cB = (const char*)g.Bt + (size_t)cur.pn * tstep;
    S.a_ready(cur);
    if constexpr (SP2) {
        PG8_STAGE(PG8_SB(0, 0), cB, voffB); PG8_STAGE(PG8_SB(0, 1), cB + hstep, voffB); PG8_STAGE(PG8_SA(0, 0), cA, voffA); PG8_STAGE(PG8_SA(0, 1), cA + hstep, voffA);
        if (wr == 1) PG8_BAR;
        PG8_WAIT_V(2); PG8_BAR;
        PG8_STAGE(PG8_SB(1, 0), cB + kstep, voffB); PG8_STAGE(PG8_SA(1, 0), cA + kstep, voffA); PG8_STAGE(PG8_SB(1, 1), cB + hstep + kstep, voffB);
        PG8_WAIT_V(6); PG8_BAR;
    } else {
        PG8_STAGE(PG8_SB(0, 0), cB, voffB); PG8_STAGE(PG8_SA(0, 0), cA, voffA); PG8_STAGE(PG8_SB(0, 1), cB + hstep, voffB); PG8_STAGE(PG8_SA(0, 1), cA + hstep, voffA);
        if (wr == 1) PG8_BAR;
        PG8_WAIT_V(4); PG8_BAR;
        PG8_STAGE(PG8_SB(1, 0), cB + kstep, voffB); PG8_STAGE(PG8_SA(1, 0), cA + kstep, voffA); PG8_STAGE(PG8_SB(1, 1), cB + hstep + kstep, voffB);
        PG8_WAIT_V(6); PG8_BAR;
    }
    for (;;) {
        const bool has_next = S.next(ui + 1, nxt);
        const char* nA = has_next ? (const char*)g.A + (size_t)nxt.pm * tstep : cA; const char* nB = has_next ? (const char*)g.Bt + (size_t)nxt.pn * tstep : cB;
        for (int t = 0; t < nt; t += 2) {
            const bool last = (t == nt - 2);
            const char* a1 = cA + (size_t)(t + 1) * kstep;
            const char* a2 = last ? nA : cA + (size_t)(t + 2) * kstep; const char* b2 = last ? nB : cB + (size_t)(t + 2) * kstep;
            const char* a3 = a2 + kstep; const char* b3 = b2 + kstep;
            if (last && has_next) S.a_ready(nxt);
            if constexpr (Epi::MIDK) { if (t == nt / 2) E.mid(acc, cur, wr, wc, fr, fq); }
            if constexpr (SP2) {
            PG8_LDB(B0, 0, 0); PG8_LDB(B1, 0, 1); PG8_SCHED; PG8_LDA(At, 0, 0); PG8_STAGE(PG8_SA(1, 1), a1 + hstep, voffA);
            PG8_WAIT_V(8); PG8_WAIT_L(0); PG8_BAR; PG8_MMA(0, 0, At, B0); PG8_MMA(0, 1, At, B1); PG8_BAR; PG8_SCHED;
            PG8_LDA(At, 0, 1); PG8_STAGE(PG8_SB(0, 0), b2, voffB); PG8_STAGE(PG8_SB(0, 1), b2 + hstep, voffB); PG8_STAGE(PG8_SA(0, 0), a2, voffA);
            PG8_WAIT_V(8); PG8_WAIT_L(0); PG8_BAR; PG8_MMA(1, 0, At, B0); PG8_MMA(1, 1, At, B1); PG8_BAR; PG8_SCHED;
            PG8_LDB(B0, 1, 0); PG8_LDB(B1, 1, 1); PG8_SCHED; PG8_LDA(At, 1, 0); PG8_STAGE(PG8_SA(0, 1), a2 + hstep, voffA);
            PG8_WAIT_V(8); PG8_WAIT_L(0); PG8_BAR; PG8_MMA(0, 0, At, B0); PG8_MMA(0, 1, At, B1); PG8_BAR; PG8_SCHED;
            PG8_LDA(At, 1, 1); PG8_STAGE(PG8_SB(1, 0), b3, voffB); PG8_STAGE(PG8_SB(1, 1), b3 + hstep, voffB); PG8_STAGE(PG8_SA(1, 0), a3, voffA);
            PG8_WAIT_V(8); PG8_WAIT_L(0); PG8_BAR; PG8_MMA(1, 0, At, B0); PG8_MMA(1, 1, At, B1); PG8_BAR; PG8_SCHED;
            } else {
            PG8_LDB(B0, 0, 0); PG8_SCHED; PG8_LDA(At, 0, 0); PG8_STAGE(PG8_SA(1, 1), a1 + hstep, voffA);
            PG8_WAIT_L(8); PG8_BAR; PG8_WAIT_L(0); PG8_MMA(0, 0, At, B0); PG8_BAR; PG8_SCHED;
            PG8_LDB(B1, 0, 1); PG8_STAGE(PG8_SB(0, 0), b2, voffB);
            PG8_BAR; PG8_WAIT_L(0); PG8_MMA(0, 1, At, B1); PG8_BAR;
            PG8_LDA(At, 0, 1); PG8_STAGE(PG8_SA(0, 0), a2, voffA);
            PG8_BAR; PG8_WAIT_L(0); PG8_MMA(1, 0, At, B0); PG8_BAR; PG8_SCHED;
            PG8_STAGE(PG8_SB(0, 1), b2 + hstep, voffB);
            PG8_WAIT_V(6); PG8_BAR; PG8_MMA(1, 1, At, B1); PG8_BAR;
            PG8_LDB(B0, 1, 0); PG8_SCHED; PG8_LDA(At, 1, 0); PG8_STAGE(PG8_SA(0, 1), a2 + hstep, voffA);
            PG8_WAIT_L(8); PG8_BAR; PG8_WAIT_L(0); PG8_MMA(0, 0, At, B0); PG8_BAR; PG8_SCHED;
            PG8_LDB(B1, 1, 1); PG8_STAGE(PG8_SB(1, 0), b3, voffB);
            PG8_BAR; PG8_WAIT_L(0); PG8_MMA(0, 1, At, B1); PG8_BAR;
            PG8_LDA(At, 1, 1); PG8_STAGE(PG8_SA(1, 0), a3, voffA);
            PG8_BAR; PG8_WAIT_L(0); PG8_MMA(1, 0, At, B0); PG8_BAR; PG8_SCHED;
            PG8_STAGE(PG8_SB(1, 1), b3 + hstep, voffB);
            PG8_WAIT_V(6); PG8_BAR; PG8_MMA(1, 1, At, B1); PG8_BAR;
            }
        }
        if constexpr (ALIGN_EPI) { if (wr == 0) PG8_BAR; }
        if constexpr (!Epi::AFTER_DRAIN) { E(acc, cur, wr, wc, fr, fq); S.done(cur); }
        if (!has_next) break;
#pragma unroll
        for (int a = 0; a < 2; ++a)
#pragma unroll
            for (int b = 0; b < 2; ++b)
#pragma unroll
                for (int m = 0; m < 4; ++m)
#pragma unroll
                    for (int n = 0; n < 2; ++n) acc[a][b][m][n] = (f32x4){0.f, 0.f, 0.f, 0.f};
        cur = nxt; cA = nA; cB = nB; ++ui;
        if constexpr (ALIGN_EPI) { if (wr == 1) PG8_BAR; }
    }
    PG8_WAIT_V(0);
    if constexpr (!ALIGN_EPI) { if (wr == 0) PG8_BAR; }
    PG8_BAR;
    if constexpr (Epi::AFTER_DRAIN) { E.fused(acc, cur, wr, wc, fr, fq, lds, wid, lane); S.done(cur); }
#undef PG8_SA
#undef PG8_SB
#undef PG8_STAGE
#undef PG8_LDA
#undef PG8_LDB
#undef PG8_MMA
#undef PG8_WAIT_V
#undef PG8_WAIT_L
#undef PG8_BAR
#undef PG8_SCHED
}
}
namespace mk {
constexpr int D = 1024, SEQ = 8192, NBMAX = 4, NH = 4, DIN = 5152, NE = 32, DE = 512, DEPTH = 2;
constexpr int NT_IN = 22, NIN = NT_IN * 256;
constexpr int NWAVES = 8, NTHR = 512;
constexpr float LOG2E = 1.4426950408889634f, QSCALE = 0.125f * LOG2E, RMS_EPS = 1e-6f;
constexpr int O_GQ = 0, O_GK = 256, O_GV = 512, O_GG = 1024, O_LRF = 1536, O_LRB = 1552, O_DQ = 1568, O_DK = 2080, O_DV = 2592, O_GA = 3104, O_GB = 4128;
typedef unsigned short bf16;
typedef unsigned u32x4 __attribute__((ext_vector_type(4)));
typedef unsigned u32x2 __attribute__((ext_vector_type(2)));
typedef float f32x4 __attribute__((ext_vector_type(4)));
typedef float f32x16 __attribute__((ext_vector_type(16)));
typedef short bf16x8 __attribute__((ext_vector_type(8)));
typedef short s16x4 __attribute__((ext_vector_type(4)));
#define LAS __attribute__((address_space(3)))
#define GAS __attribute__((address_space(1)))
#define LDS_WAIT() asm volatile("s_waitcnt lgkmcnt(0)" ::: "memory")
#define VM_WAIT() asm volatile("s_waitcnt vmcnt(0)" ::: "memory")

constexpr size_t MiB = 1u << 20;
constexpr size_t CTL_BYTES = 256 * 1024;
constexpr int CW_BAR = 4096;
constexpr int CW_CNT = 32768;
constexpr size_t OFF_MOD = 256 * 1024, OFF_TAB = 512 * 1024;
constexpr size_t OFF_WIN = 1 * MiB, SZ_WIN = (size_t)DEPTH * NIN * D * 2;
constexpr size_t OFF_WAB = OFF_WIN + SZ_WIN, SZ_WAB = (size_t)DEPTH * D * D * 2;
constexpr size_t OFF_WO = OFF_WAB + SZ_WAB, SZ_WO = SZ_WAB;
constexpr size_t OFF_WR = OFF_WO + SZ_WO, SZ_WR = (size_t)DEPTH * 256 * D * 2;
constexpr size_t OFF_W1 = OFF_WR + SZ_WR, SZ_W1 = (size_t)DEPTH * NE * 1024 * D * 2;
constexpr size_t OFF_W2 = OFF_W1 + SZ_W1, SZ_W2 = (size_t)DEPTH * NE * D * DE * 2;
constexpr size_t OFF_ACT = 225 * MiB;
static_assert(OFF_W2 + SZ_W2 <= OFF_ACT, "weights fit");
struct WS {
    unsigned* ctl; float* mod; float* tab;
    bf16 *win, *wab, *wo, *wr, *w1, *w2;
    bf16 *H, *OAB; int* eid; float* gate; int* rank; int* pos; int* tilee; int* segp;
    bf16 *GQ, *GK, *GV, *SG; float *LGF, *LGB; bf16 *DQ, *DK, *DV, *SGA, *SGB; float* KVT; float* DEC; bf16* MERGED;
    bf16 *XS, *ACT, *YS; float* LOGITS; float* gsort;
    size_t end;
};
__host__ __device__ inline WS ws_map(unsigned char* b, int nb) {
    WS w; const size_t T = (size_t)nb * SEQ;
    w.ctl = (unsigned*)b; w.mod = (float*)(b + OFF_MOD); w.tab = (float*)(b + OFF_TAB);
    w.win = (bf16*)(b + OFF_WIN); w.wab = (bf16*)(b + OFF_WAB); w.wo = (bf16*)(b + OFF_WO); w.wr = (bf16*)(b + OFF_WR); w.w1 = (bf16*)(b + OFF_W1); w.w2 = (bf16*)(b + OFF_W2);
    size_t o = OFF_ACT;
    auto take = [&](size_t bytes) { unsigned char* p = b + o; o += (bytes + 255) & ~(size_t)255; return p; };
    w.H = (bf16*)take(T * 2048); w.OAB = (bf16*)take(T * 2048);
    w.eid = (int*)take(T * 8); w.gate = (float*)take(T * 8); w.rank = (int*)take(T * 8); w.pos = (int*)take(T * 8); w.tilee = (int*)take(4096); w.segp = (int*)take(1024);
    const size_t u0 = o;
    w.GQ = (bf16*)take(T * 512); w.GK = (bf16*)take(T * 512); w.GV = (bf16*)take(T * 1024); w.SG = (bf16*)take(T * 1024);
    w.LGF = (float*)take(T * 1024); w.LGB = (float*)take(T * 1024);
    w.DQ = (bf16*)take(T * 1024); w.DK = (bf16*)take(T * 1024); w.DV = (bf16*)take(T * 1024); w.SGA = (bf16*)take(T * 2048); w.SGB = (bf16*)take(T * 2048);
    w.KVT = (float*)take(T * 4096); w.MERGED = (bf16*)w.KVT; w.DEC = (float*)take(T * 32);
    const size_t e1 = o; o = u0;
    const size_t R = 2 * T + 32 * 256;
    w.XS = (bf16*)take(R * 2048); w.ACT = (bf16*)take(R * 1024); w.YS = (bf16*)take(R * 2048); w.LOGITS = (float*)take(T * 256); w.gsort = (float*)take(R * 4);
    w.end = o > e1 ? o : e1;
    return w;
}

__device__ __forceinline__ unsigned cvt_pk(float lo, float hi) { unsigned r; asm volatile("v_cvt_pk_bf16_f32 %0, %1, %2" : "=v"(r) : "v"(lo), "v"(hi)); return r; }
__device__ __forceinline__ float bf2f(unsigned short b) { return __uint_as_float(((unsigned)b) << 16); }
__device__ __forceinline__ float bflo(unsigned w) { return __uint_as_float(w << 16); }
__device__ __forceinline__ float bfhi(unsigned w) { return __uint_as_float(w & 0xffff0000u); }
__device__ __forceinline__ float fsigmoid(float x) { return __builtin_amdgcn_rcpf(1.f + __expf(-x)); }
__device__ __forceinline__ float fsilu(float x) { return x * fsigmoid(x); }
__device__ __forceinline__ float wave_sum(float v) {
#pragma unroll
    for (int o = 1; o < 64; o <<= 1) v += __shfl_xor(v, o);
    return v;
}
__device__ __forceinline__ int t5_bucket(int rel) {
    int ret = rel > 0 ? 16 : 0; int n = rel < 0 ? -rel : rel;
    if (n < 8) return ret + n;
    return ret + 8 + (n >= 12) + (n >= 16) + (n >= 23) + (n >= 32) + (n >= 46) + (n >= 64) + (n >= 91);
}

#define XB_TMO      128
#define XB_XCNT(j)  (256  + 64 * (j))
#define XB_XSUB(j)  (1280 + 64 * (j))
#define XB_XGEN(j)  (2304 + 64 * (j))
#define XB_TOP      3328
#define XB_TOPGEN   3392
#define XCD_BAR_WORDS 3456
#define XB_SPIN_CAP (1u << 18)
__device__ __forceinline__ unsigned xb_ld(unsigned* p)              { return __hip_atomic_load(p, __ATOMIC_RELAXED, __HIP_MEMORY_SCOPE_AGENT); }
__device__ __forceinline__ unsigned xb_add(unsigned* p, unsigned v) { return __hip_atomic_fetch_add(p, v, __ATOMIC_RELAXED, __HIP_MEMORY_SCOPE_AGENT); }
__device__ __forceinline__ unsigned xb_xcc_id() { return (unsigned)__builtin_amdgcn_s_getreg((3 << 11) | 20) & 0xFu; }
#define XB_SPIN(cond, bar) do { unsigned _sp = 0; while (cond) { __builtin_amdgcn_s_sleep(1); \
    if ((++_sp & 255u) == 0u) { if (xb_ld(&(bar)[XB_TMO])) break; if (_sp > XB_SPIN_CAP) { atomicAdd(&(bar)[XB_TMO], 1u); break; } } } } while (0)
struct XcdBarrier { unsigned* bar; unsigned x; volatile LAS unsigned* st; };
__device__ __forceinline__ XcdBarrier xcd_barrier_post(unsigned* bar, volatile LAS unsigned* st) {
    XcdBarrier b; b.bar = bar; b.x = xb_xcc_id(); b.st = st;
    if (threadIdx.x == 0) (void)xb_add(&bar[XB_XCNT(b.x)], 1u);
    return b;
}
__device__ __forceinline__ void xcd_barrier_complete(unsigned* bar, unsigned x, unsigned& nloc, unsigned& nx) {
    const unsigned G = gridDim.x * gridDim.y * gridDim.z;
    unsigned sum, cnt, mine, sp = 0u;
    for (;;) {
        sum = 0u; cnt = 0u; mine = 0u;
#pragma unroll
        for (unsigned j = 0; j < 16; ++j) { const unsigned c = xb_ld(&bar[XB_XCNT(j)]); sum += c; cnt += (c > 0u) ? 1u : 0u; mine = (j == x) ? c : mine; }
        if (sum == G) break;
        __builtin_amdgcn_s_sleep(1);
        if ((++sp & 255u) == 0u) { if (xb_ld(&bar[XB_TMO])) break; if (sp > XB_SPIN_CAP) { atomicAdd(&bar[XB_TMO], 1u); break; } }
    }
    nloc = mine > 0u ? mine : 1u; nx = cnt > 0u ? cnt : 1u;
}
__device__ __forceinline__ void xcd_barrier(const XcdBarrier& b) {
    asm volatile("s_waitcnt vmcnt(0)" ::: "memory");
    __syncthreads();
    if (threadIdx.x == 0) {
        unsigned* bar = b.bar;
        __builtin_amdgcn_s_waitcnt(0);
        unsigned nloc = b.st[0], nx = b.st[1];
        if (nloc == 0u) { xcd_barrier_complete(bar, b.x, nloc, nx); b.st[0] = nloc; b.st[1] = nx; }
        const unsigned old = xb_add(&bar[XB_XSUB(b.x)], 1u);
        const unsigned gen = old / nloc;
        if (old + 1u == (gen + 1u) * nloc) {
            __builtin_amdgcn_fence(__ATOMIC_RELEASE, "agent");
            asm volatile("s_waitcnt vmcnt(0)" ::: "memory");
            const unsigned og = xb_add(&bar[XB_TOP], 1u);
            const unsigned tg = og / nx;
            if (og + 1u == (tg + 1u) * nx) xb_add(&bar[XB_TOPGEN], 1u);
            else XB_SPIN(xb_ld(&bar[XB_TOPGEN]) == tg, bar);
            __builtin_amdgcn_fence(__ATOMIC_ACQUIRE, "agent");
            xb_add(&bar[XB_XGEN(b.x)], 1u);
            asm volatile("s_waitcnt vmcnt(0)" ::: "memory");
        } else {
            XB_SPIN(xb_ld(&bar[XB_XGEN(b.x)]) == gen, bar);
            __builtin_amdgcn_fence(__ATOMIC_ACQUIRE, "agent");
            asm volatile("s_waitcnt vmcnt(0)" ::: "memory");
        }
    }
    __syncthreads();
}

struct Args { const float* in[24]; float* out; unsigned char* ws; int nb, ph_lo, ph_hi, li; };
struct Frame {
    LAS unsigned char* lds; int tid, lane, wave, G, bid, nb, T; unsigned char* ws; const Args* a; float* xbuf;
};
__device__ __forceinline__ void refresh(Frame& F) { int t = threadIdx.x; asm volatile("" : "+v"(t)); F.tid = t; F.lane = t & 63; F.wave = __builtin_amdgcn_readfirstlane(t >> 6); }
constexpr int LDS_BYTES = 160 * 1024 - 64 * 0;
constexpr int LDS_MISC = 160 * 1024 - 256;

__device__ __forceinline__ void tr_item(const float* src, int lds_, int ks0, int c0, bf16* dst, int ldd, int r0, int kd0, LAS float* scr, int lane) {
#pragma unroll 8
    for (int i = 0; i < 32; ++i) { const int kk = 2 * i + (lane >> 5); scr[kk * 33 + (lane & 31)] = src[(size_t)(ks0 + kk) * lds_ + c0 + (lane & 31)]; }
    LDS_WAIT(); asm volatile("" ::: "memory");
    const int c = lane & 7;
#pragma unroll
    for (int j = 0; j < 4; ++j) { const int n = (lane >> 3) + 8 * j; const LAS float* s = scr + (8 * c) * 33 + n;
        u32x4 o; o.x = cvt_pk(s[0 * 33], s[1 * 33]); o.y = cvt_pk(s[2 * 33], s[3 * 33]); o.z = cvt_pk(s[4 * 33], s[5 * 33]); o.w = cvt_pk(s[6 * 33], s[7 * 33]);
        *(u32x4*)(dst + (size_t)(r0 + n) * ldd + kd0 + 8 * c) = o; }
    LDS_WAIT(); asm volatile("" ::: "memory");
}
__device__ __forceinline__ int win_src_col(int tile, int p0) {
    const int bj = p0 >> 7, wc = (p0 >> 5) & 3; const int L = 64 * wc + 32 * bj;
    switch (tile) {
        case 0: return O_GQ + p0; case 1: return O_GK + p0;
        case 2: case 3: return O_GV + (tile - 2) * 256 + p0;
        case 4: case 5: return O_GG + (tile - 4) * 256 + p0;
        case 8: case 9: return O_DQ + (tile - 8) * 256 + L;
        case 10: case 11: return O_DK + (tile - 10) * 256 + L;
        case 12: case 13: return O_DV + (tile - 12) * 256 + p0;
        case 14: case 15: case 16: case 17: return O_GA + (tile - 14) * 256 + p0;
        default: return O_GB + (tile - 18) * 256 + p0;
    }
}
__device__ __forceinline__ void p0_prologue(Frame& F) {
    refresh(F);
    const WS W = ws_map(F.ws, F.nb); const float* const* IN_ = F.a->in;
    const float* c_in = IN_[1]; const float* w_ada = IN_[2]; const float* b_ada = IN_[3];
    {
        LAS float* red = (LAS float*)F.lds;
        for (int it = F.bid; it < DEPTH * 96; it += F.G) {
            const int l = it / 96, j = (it % 96) * 64 + F.lane;
            const float* w = w_ada + (size_t)l * D * 6 * D + j;
            float a0 = 0.f, a1 = 0.f, a2 = 0.f, a3 = 0.f;
            const int kbeg = F.wave * 128;
#pragma unroll 16
            for (int k = kbeg; k < kbeg + 128; ++k) { const float wv = w[(size_t)k * 6 * D];
                const float c0 = c_in[k], c1 = c_in[D + k], c2 = c_in[2 * D + k], c3 = c_in[3 * D + k];
                a0 += fsilu(c0) * wv; a1 += fsilu(c1) * wv; a2 += fsilu(c2) * wv; a3 += fsilu(c3) * wv; }
            red[(F.wave * 4 + 0) * 64 + F.lane] = a0; red[(F.wave * 4 + 1) * 64 + F.lane] = a1; red[(F.wave * 4 + 2) * 64 + F.lane] = a2; red[(F.wave * 4 + 3) * 64 + F.lane] = a3;
            __syncthreads();
            if (F.tid < 256) { const int b = F.tid >> 6, jj = F.tid & 63; float s = 0.f;
#pragma unroll
                for (int wv = 0; wv < 8; ++wv) s += red[(wv * 4 + b) * 64 + jj];
                const int jc = (it % 96) * 64 + jj;
                W.mod[((size_t)l * NBMAX + b) * 6 * D + jc] = s + b_ada[l * 6 * D + jc]; }
            __syncthreads();
        }
    }
    if (F.bid == 0) {
        const float* rb = IN_[14];
        for (int i = F.tid; i < 1024; i += NTHR) { const int h = i >> 8, rel = (i & 255) - 128; W.tab[i] = (rb[t5_bucket(rel) * 4 + h] - rb[31 * 4 + h]) * LOG2E; }
        if (F.tid < 4) W.tab[1024 + F.tid] = __expf(rb[15 * 4 + F.tid] - rb[31 * 4 + F.tid]);
        if (F.tid >= 64 && F.tid < 64 + DEPTH) { const int l = F.tid - 64; const float* lv = IN_[12] + l * 256; float s1 = 0.f, s2 = 0.f;
            for (int i = 0; i < 64; ++i) { s1 += lv[i] * lv[64 + i]; s2 += lv[128 + i] * lv[192 + i]; }
            W.tab[1032 + l] = expf(s1) - expf(s2) + (0.8f - 0.6f * expf(-0.3f * (float)l)); }
    }
    __syncthreads();
    LAS float* scr = (LAS float*)(F.lds + F.wave * 16384);
    const int gw = F.bid * NWAVES + F.wave, NGW = F.G * NWAVES;
    constexpr int I_IN = (NIN / 32) * 16, I_AB = 32 * 16, I_O = 32 * 16, I_1 = NE * 32 * 16, I_2 = NE * 32 * 8;
    constexpr int PER_L = I_IN + I_AB + I_O + I_1 + I_2;
    for (int it = gw; it < DEPTH * PER_L; it += NGW) {
        const int l = it / PER_L; int r = it % PER_L;
        if (r < I_IN) { const int rb = r / 16, kb = r % 16, R = rb * 32, tile = R >> 8, p0 = R & 255;
            if (tile == 6 || tile == 7) continue;
            tr_item(IN_[6] + (size_t)l * D * DIN, DIN, kb * 64, win_src_col(tile, p0), W.win + (size_t)l * NIN * D, D, R, kb * 64, scr, F.lane); continue; }
        r -= I_IN;
        if (r < I_AB) { const int rb = r / 16, kb = r % 16;
            if (kb < 8) tr_item(IN_[15] + (size_t)l * 512 * D, D, kb * 64, rb * 32, W.wab + (size_t)l * D * D, 512, rb * 32, kb * 64, scr, F.lane);
            else tr_item(IN_[16] + (size_t)l * 512 * D, D, (kb - 8) * 64, rb * 32, W.wab + (size_t)l * D * D + (size_t)1024 * 512, 512, rb * 32, (kb - 8) * 64, scr, F.lane);
            continue; }
        r -= I_AB;
        if (r < I_O) { const int rb = r / 16, kb = r % 16; tr_item(IN_[17] + (size_t)l * D * D, D, kb * 64, rb * 32, W.wo + (size_t)l * D * D, D, rb * 32, kb * 64, scr, F.lane); continue; }
        r -= I_O;
        if (r < I_1) { const int e = r / 512, q = r % 512, rb = q / 16, kb = q % 16, R = rb * 32, pn = R >> 8, p = R & 255;
            const int col = (p < 128) ? (128 * pn + p) : (512 + 128 * pn + p - 128);
            tr_item(IN_[22] + ((size_t)l * NE + e) * D * 1024, 1024, kb * 64, col, W.w1 + ((size_t)l * NE + e) * 1024 * D, D, R, kb * 64, scr, F.lane); continue; }
        r -= I_1;
        { const int e = r / 256, q = r % 256, rb = q / 8, kb = q % 8;
          tr_item(IN_[23] + ((size_t)l * NE + e) * DE * D, D, kb * 64, rb * 32, W.w2 + ((size_t)l * NE + e) * D * DE, DE, rb * 32, kb * 64, scr, F.lane); }
    }
    for (int it = gw; it < DEPTH * 2 * 8 * 16; it += NGW) {
        const int l = it >> 8, dir = (it >> 7) & 1, nbk = (it >> 4) & 7, kb = it & 15; const int k = kb * 64 + F.lane;
        const float* wi = IN_[6] + (size_t)l * D * DIN + (size_t)k * DIN + (dir ? O_LRB : O_LRF);
        float wv[16];
#pragma unroll
        for (int r = 0; r < 16; ++r) wv[r] = wi[r];
        const float* wu = IN_[7] + ((size_t)l * 2 + dir) * 16 * 256;
        bf16* dst = W.win + (size_t)l * NIN * D + (size_t)((6 + dir) * 256) * D;
        for (int n = nbk * 32; n < nbk * 32 + 32; ++n) { float s = 0.f;
#pragma unroll
            for (int r = 0; r < 16; ++r) s += wv[r] * wu[r * 256 + n];
            dst[(size_t)n * D + k] = (bf16)(cvt_pk(s, 0.f) & 0xffffu); }
    }
    for (int it = gw * 64 + F.lane; it < DEPTH * 256 * 128; it += NGW * 64) {
        const int l = it / (256 * 128), q = it % (256 * 128), row = q >> 7, k0 = (q & 127) * 8;
        float v[8];
#pragma unroll
        for (int i = 0; i < 8; ++i) { float x = 0.f;
            if (row < 4) x = IN_[18][((size_t)l * D + k0 + i) * 4 + row]; else if (row < 36) x = IN_[20][((size_t)l * D + k0 + i) * 32 + row - 4];
            v[i] = x; }
        u32x4 o; o.x = cvt_pk(v[0], v[1]); o.y = cvt_pk(v[2], v[3]); o.z = cvt_pk(v[4], v[5]); o.w = cvt_pk(v[6], v[7]);
        *(u32x4*)(W.wr + ((size_t)l * 256 + row) * D + k0) = o;
    }
}

__device__ __forceinline__ void phase_norm(Frame& F, int l, int mode) {
    refresh(F);
    const WS W = ws_map(F.ws, F.nb); const float* const* IN_ = F.a->in;
    const int gw = F.bid * NWAVES + F.wave, NGW = F.G * NWAVES;
    const bool combine = (mode == 2) || (mode == 0 && l > 0);
    const int lp = (mode == 2) ? DEPTH - 1 : l - 1;
    const float* xsrc = (mode == 0 && l == 0) ? IN_[0] : F.xbuf;
    const float* ng = (mode == 1 ? IN_[5] : IN_[4]) + (size_t)(mode == 2 ? 0 : l) * D;
    for (int t = gw; t < F.T; t += NGW) {
        const int b = t / SEQ;
        const GAS f32x4* xr = (const GAS f32x4*)(xsrc + (size_t)t * D) + F.lane;
        f32x4 v[4];
#pragma unroll
        for (int j = 0; j < 4; ++j) v[j] = xr[64 * j];
        if (combine) {
            const float* g2 = W.mod + ((size_t)lp * NBMAX + b) * 6 * D + 5 * D;
            const int p0 = W.pos[t * 2], p1 = W.pos[t * 2 + 1];
            const GAS u32x2* y0 = (const GAS u32x2*)(W.YS + (size_t)p0 * D) + F.lane; const GAS u32x2* y1 = (const GAS u32x2*)(W.YS + (size_t)p1 * D) + F.lane;
#pragma unroll
            for (int j = 0; j < 4; ++j) { const u32x2 a = y0[64 * j], c = y1[64 * j]; const f32x4 g = *((const GAS f32x4*)g2 + F.lane + 64 * j);
                v[j].x += g.x * (bflo(a.x) + bflo(c.x)); v[j].y += g.y * (bfhi(a.x) + bfhi(c.x)); v[j].z += g.z * (bflo(a.y) + bflo(c.y)); v[j].w += g.w * (bfhi(a.y) + bfhi(c.y)); }
            GAS f32x4* xo = (GAS f32x4*)(F.xbuf + (size_t)t * D) + F.lane;
#pragma unroll
            for (int j = 0; j < 4; ++j) xo[64 * j] = v[j];
        }
        if (mode == 2) continue;
        float ss = 0.f;
#pragma unroll
        for (int j = 0; j < 4; ++j) ss += (v[j].x * v[j].x + v[j].y * v[j].y) + (v[j].z * v[j].z + v[j].w * v[j].w);
        const float rstd = rsqrtf(wave_sum(ss) * (1.f / D) + RMS_EPS);
        const float* md = W.mod + ((size_t)l * NBMAX + b) * 6 * D + (mode == 1 ? 3 * D : 0);
        GAS u32x2* ho = (GAS u32x2*)(W.H + (size_t)t * D) + F.lane;
#pragma unroll
        for (int j = 0; j < 4; ++j) { const f32x4 g = *((const GAS f32x4*)ng + F.lane + 64 * j), sh = *((const GAS f32x4*)md + F.lane + 64 * j), sc = *((const GAS f32x4*)(md + D) + F.lane + 64 * j);
            const float h0 = v[j].x * rstd * g.x * (1.f + sc.x) + sh.x, h1 = v[j].y * rstd * g.y * (1.f + sc.y) + sh.y, h2 = v[j].z * rstd * g.z * (1.f + sc.z) + sh.z, h3 = v[j].w * rstd * g.w * (1.f + sc.w) + sh.w;
            u32x2 o; o.x = cvt_pk(h0, h1); o.y = cvt_pk(h2, h3); ho[64 * j] = o; }
    }
}
typedef pg8::Unit Unit;
__device__ __forceinline__ u32x4 pack8(const f32x4& a, const f32x4& b) { u32x4 w; w.x = cvt_pk(a[0], a[1]); w.y = cvt_pk(a[2], a[3]); w.z = cvt_pk(b[0], b[1]); w.w = cvt_pk(b[2], b[3]); return w; }

struct EpiIn {
    static constexpr bool PERM = true, AFTER_DRAIN = false, MIDK = false;
    bf16 *GQ, *GK, *GV, *SG; float *LGF, *LGB; bf16 *DQ, *DK, *DV, *SGA, *SGB; const float* b_up; const float* qg; const float* kg;
    __device__ __forceinline__ void operator()(const f32x4 (&acc)[2][2][4][2], const Unit& u, int wr, int wc, int fr, int fq) const {
        const int pn = u.pn; const int row0 = u.pm * 256 + wr * 64 + fr;
        if (pn >= 8 && pn <= 11) {
            const bool isk = pn >= 10; const int head = 2 * ((pn - 8) & 1) + (wc >> 1), c = wc & 1;
            const float* gv = isk ? kg : qg; const float sc = isk ? 1.f : QSCALE;
            f32x4 g[2][2];
#pragma unroll
            for (int bj = 0; bj < 2; ++bj)
#pragma unroll
                for (int n = 0; n < 2; ++n) g[bj][n] = *(const f32x4*)(gv + 32 * bj + 8 * fq + 4 * n);
#pragma unroll
            for (int ai = 0; ai < 2; ++ai)
#pragma unroll
                for (int m = 0; m < 4; ++m) {
                    const int r = row0 + ai * 128 + m * 16, b = r / SEQ, s = r % SEQ;
                    float ss = 0.f;
#pragma unroll
                    for (int bj = 0; bj < 2; ++bj)
#pragma unroll
                        for (int n = 0; n < 2; ++n) { const f32x4 x = acc[ai][bj][m][n]; ss += (x[0] * x[0] + x[1] * x[1]) + (x[2] * x[2] + x[3] * x[3]); }
                    ss += __shfl_xor(ss, 16); ss += __shfl_xor(ss, 32);
                    const float rs = rsqrtf(ss * (1.f / 64.f) + RMS_EPS) * sc;
                    bf16* dst = (isk ? DK : DQ) + ((((size_t)b * NH + head) * 2 + c) * SEQ + s) * 64;
#pragma unroll
                    for (int bj = 0; bj < 2; ++bj) {
                        const f32x4 v0 = acc[ai][bj][m][0] * rs * g[bj][0], v1 = acc[ai][bj][m][1] * rs * g[bj][1];
                        int chunk = 4 * bj + fq; if (isk) chunk ^= ((s >> 1) & 7);
                        *(u32x4*)(dst + chunk * 8) = pack8(v0, v1);
                    }
                }
            return;
        }
#pragma unroll
        for (int ai = 0; ai < 2; ++ai)
#pragma unroll
            for (int m = 0; m < 4; ++m) {
                const int r = row0 + ai * 128 + m * 16;
#pragma unroll
                for (int bj = 0; bj < 2; ++bj) {
                    const int c0 = 128 * bj + 32 * wc + 8 * fq;
                    f32x4 v0 = acc[ai][bj][m][0], v1 = acc[ai][bj][m][1];
                    if (pn == 0) { *(u32x4*)(GQ + (size_t)r * 256 + c0) = pack8(v0 * 0.125f, v1 * 0.125f); }
                    else if (pn == 1) { *(u32x4*)(GK + (size_t)r * 256 + c0) = pack8(v0, v1); }
                    else if (pn <= 3) { *(u32x4*)(GV + (size_t)r * 512 + (pn - 2) * 256 + c0) = pack8(v0, v1); }
                    else if (pn <= 5) {
#pragma unroll
                        for (int i = 0; i < 4; ++i) { v0[i] = fsilu(v0[i]); v1[i] = fsilu(v1[i]); }
                        *(u32x4*)(SG + (size_t)r * 512 + (pn - 4) * 256 + c0) = pack8(v0, v1); }
                    else if (pn <= 7) {
                        const float* bu = b_up + (pn - 6) * 256 + c0; const f32x4 b0 = *(const f32x4*)bu, b1 = *(const f32x4*)(bu + 4);
#pragma unroll
                        for (int i = 0; i < 4; ++i) { float z = v0[i] + b0[i]; v0[i] = (fminf(z, 0.f) - __logf(1.f + __expf(-fabsf(z)))) * (1.f / 16.f);
                                                      z = v1[i] + b1[i]; v1[i] = (fminf(z, 0.f) - __logf(1.f + __expf(-fabsf(z)))) * (1.f / 16.f); }
                        float* o = (pn == 6 ? LGF : LGB) + (size_t)r * 256 + c0; *(f32x4*)o = v0; *(f32x4*)(o + 4) = v1; }
                    else if (pn <= 13) {
                        const int b = r / SEQ, s = r % SEQ, head = 2 * (pn - 12) + bj;
                        bf16* dst = DV + ((((size_t)b * NH + head) * (SEQ / 8) + (s >> 3)) * 4 + wc) * 256 + (s & 7) * 32 + 8 * fq;
                        *(u32x4*)dst = pack8(v0, v1); }
                    else {
#pragma unroll
                        for (int i = 0; i < 4; ++i) { v0[i] = fsigmoid(v0[i]); v1[i] = fsigmoid(v1[i]); }
                        bf16* base = (pn <= 17) ? SGA + (pn - 14) * 256 : SGB + (pn - 18) * 256;
                        *(u32x4*)(base + (size_t)r * D + c0) = pack8(v0, v1); }
                }
            }
    }
};

struct EpiMerge {
    static constexpr bool PERM = true, AFTER_DRAIN = false, MIDK = false;
    const bf16* SGA; const bf16* SGB; bf16* O; int nM;
    __device__ __forceinline__ void operator()(const f32x4 (&acc)[2][2][4][2], const Unit& u, int wr, int wc, int fr, int fq) const {
        const int sel = u.pn >> 2; const int row0 = (u.pm - sel * nM) * 256 + wr * 64 + fr, col0 = (u.pn & 3) * 256 + wc * 32 + 8 * fq;
        const bf16* G = sel ? SGB : SGA;
#pragma unroll
        for (int ai = 0; ai < 2; ++ai)
#pragma unroll
            for (int m = 0; m < 4; ++m) { const size_t off = (size_t)(row0 + ai * 128 + m * 16) * D + col0;
#pragma unroll
                for (int bj = 0; bj < 2; ++bj) { const u32x4 b = *(const u32x4*)(G + off + bj * 128);
                    f32x4 v0 = acc[ai][bj][m][0], v1 = acc[ai][bj][m][1];
                    v0[0] *= bflo(b.x); v0[1] *= bfhi(b.x); v0[2] *= bflo(b.y); v0[3] *= bfhi(b.y); v1[0] *= bflo(b.z); v1[1] *= bfhi(b.z); v1[2] *= bflo(b.w); v1[3] *= bfhi(b.w);
                    if (sel) { const u32x4 t = *(const u32x4*)(O + off + bj * 128);
                        v0[0] += bflo(t.x); v0[1] += bfhi(t.x); v0[2] += bflo(t.y); v0[3] += bfhi(t.y); v1[0] += bflo(t.z); v1[1] += bfhi(t.z); v1[2] += bflo(t.w); v1[3] += bfhi(t.w); }
                    *(u32x4*)(O + off + bj * 128) = pack8(v0, v1); }
                asm volatile("" ::: "memory"); }
    }
};
struct MergeOrder {
    pg8::StaticOrder so; int nM;
    __device__ __forceinline__ bool next(int i, Unit& u) const { Unit t; if (!so.next(i >> 1, t)) return false; const int sel = i & 1; u.pm = t.pm + sel * nM; u.pn = t.pn + sel * 4; return true; }
    __device__ __forceinline__ void a_ready(const Unit&) const {}
    __device__ __forceinline__ void done(const Unit&) const {}
};

struct EpiResid {
    static constexpr bool PERM = false, AFTER_DRAIN = false, MIDK = false;
    const float* xin; float* xout; const float* g1;
    __device__ __forceinline__ void operator()(const f32x4 (&acc)[2][2][4][2], const Unit& u, int wr, int wc, int fr, int fq) const {
        const int row0 = u.pm * 256 + wr * 64 + fr, col0 = u.pn * 256 + wc * 32 + 4 * fq;
        const int b = (u.pm * 256) / SEQ; const float* g = g1 + (size_t)b * 6 * D + col0;
        f32x4 gv[2][2];
#pragma unroll
        for (int bj = 0; bj < 2; ++bj)
#pragma unroll
            for (int n = 0; n < 2; ++n) gv[bj][n] = *(const f32x4*)(g + bj * 128 + n * 16);
#pragma unroll
        for (int ai = 0; ai < 2; ++ai)
#pragma unroll
            for (int m = 0; m < 4; ++m) { const size_t off = (size_t)(row0 + ai * 128 + m * 16) * D + col0;
#pragma unroll
                for (int bj = 0; bj < 2; ++bj)
#pragma unroll
                    for (int n = 0; n < 2; ++n) { const f32x4 xv = *(const f32x4*)(xin + off + bj * 128 + n * 16); *(f32x4*)(xout + off + bj * 128 + n * 16) = xv + gv[bj][n] * acc[ai][bj][m][n]; } }
    }
};

struct EpiLogits {
    static constexpr bool PERM = false, AFTER_DRAIN = false, MIDK = false;
    float* L;
    __device__ __forceinline__ void operator()(const f32x4 (&acc)[2][2][4][2], const Unit& u, int wr, int wc, int fr, int fq) const {
        if (wc >= 2) return;
        const int row0 = u.pm * 256 + wr * 64 + fr, col0 = wc * 32 + 4 * fq;
#pragma unroll
        for (int ai = 0; ai < 2; ++ai)
#pragma unroll
            for (int m = 0; m < 4; ++m)
#pragma unroll
                for (int n = 0; n < 2; ++n) *(f32x4*)(L + (size_t)(row0 + ai * 128 + m * 16) * 64 + col0 + n * 16) = acc[ai][0][m][n];
    }
};

struct EpiAct {
    static constexpr bool PERM = true, AFTER_DRAIN = false, MIDK = false;
    bf16* ACT;
    __device__ __forceinline__ void operator()(const f32x4 (&acc)[2][2][4][2], const Unit& u, int wr, int wc, int fr, int fq) const {
        const int row0 = u.pm * 256 + wr * 64 + fr, col0 = (u.pn & 3) * 128 + wc * 32 + 8 * fq;
#pragma unroll
        for (int ai = 0; ai < 2; ++ai)
#pragma unroll
            for (int m = 0; m < 4; ++m) { f32x4 v0, v1;
#pragma unroll
                for (int i = 0; i < 4; ++i) { v0[i] = fsilu(acc[ai][0][m][0][i]) * acc[ai][1][m][0][i]; v1[i] = fsilu(acc[ai][0][m][1][i]) * acc[ai][1][m][1][i]; }
                *(u32x4*)(ACT + (size_t)(row0 + ai * 128 + m * 16) * DE + col0) = pack8(v0, v1); }
    }
};
struct EpiYs {
    static constexpr bool PERM = true, AFTER_DRAIN = false, MIDK = false;
    bf16* YS; const float* gs;
    __device__ __forceinline__ void operator()(const f32x4 (&acc)[2][2][4][2], const Unit& u, int wr, int wc, int fr, int fq) const {
        const int row0 = u.pm * 256 + wr * 64 + fr, col0 = (u.pn & 3) * 256 + wc * 32 + 8 * fq;
#pragma unroll
        for (int ai = 0; ai < 2; ++ai)
#pragma unroll
            for (int m = 0; m < 4; ++m) { const int r = row0 + ai * 128 + m * 16; const float gt = gs[r];
#pragma unroll
                for (int bj = 0; bj < 2; ++bj) *(u32x4*)(YS + (size_t)r * D + col0 + bj * 128) = pack8(acc[ai][bj][m][0] * gt, acc[ai][bj][m][1] * gt); }
    }
};
struct GroupedOrder {
    const int* tilee; int U, G, c;
    __device__ __forceinline__ bool next(int i, Unit& u) const {
        int id;
        if ((G & 7) == 0) { const int gx = G >> 3, per = (U + 7) >> 3, n = i * gx + (c >> 3); if (n >= per) return false; id = (c & 7) * per + n; if (id >= U) return false; }
        else { id = i * G + c; if (id >= U) return false; }
        const int t = id >> 2; u.pm = t; u.pn = tilee[t] * 4 + (id & 3); return true;
    }
    __device__ __forceinline__ void a_ready(const Unit&) const {}
    __device__ __forceinline__ void done(const Unit&) const {}
};
constexpr int AT_KR = 0, AT_VR = 49152, AT_TAB = 98304, AT_SLOT = 16384;
__device__ __forceinline__ int crow(int r, int hi) { return (r & 3) + 8 * (r >> 2) + 4 * hi; }
__device__ __forceinline__ s16x4 vtr(const LAS unsigned char* p) {
    typedef short v4i16_t __attribute__((ext_vector_type(4)));
    return __builtin_bit_cast(s16x4, __builtin_amdgcn_ds_read_tr16_b64_v4i16((LAS v4i16_t*)p));
}
__device__ __forceinline__ bf16x8 pk8(const f32x16& s, int o) {
    u32x4 w; w.x = cvt_pk(s[o + 0], s[o + 1]); w.y = cvt_pk(s[o + 2], s[o + 3]); w.z = cvt_pk(s[o + 4], s[o + 5]); w.w = cvt_pk(s[o + 6], s[o + 7]);
    return __builtin_bit_cast(bf16x8, w);
}
struct AttnState { f32x16 o[4]; float lsum; };

template <int SLOT>
__device__ __forceinline__ void attn_step(const LAS unsigned char* lds, AttnState& st, const bf16x8 (&qf)[4], const int (&koff)[4], int vb, int c, int mode  , int relbase, const LAS float* tabh) {
    const LAS unsigned char* kb = lds + AT_KR + SLOT * AT_SLOT + c * 8192;
    f32x16 s0 = {}, s1 = {};
#pragma unroll
    for (int s = 0; s < 4; ++s) {
        const bf16x8 k0 = *(const LAS bf16x8*)(kb + koff[s]);
        const bf16x8 k1 = *(const LAS bf16x8*)(kb + 4096 + koff[s]);
        s0 = __builtin_amdgcn_mfma_f32_32x32x16_bf16(k0, qf[s], s0, 0, 0, 0);
        s1 = __builtin_amdgcn_mfma_f32_32x32x16_bf16(k1, qf[s], s1, 0, 0, 0);
    }
    if (mode == 1) {
#pragma unroll
        for (int r = 0; r < 16; ++r) {
            int i0 = relbase + (r & 3) + 8 * (r >> 2); int i1 = i0 + 32;
            i0 = i0 < 0 ? 0 : (i0 > 255 ? 255 : i0); i1 = i1 < 0 ? 0 : (i1 > 255 ? 255 : i1);
            s0[r] += tabh[i0]; s1[r] += tabh[i1];
        }
    }
    float ls = 0.f;
#pragma unroll
    for (int r = 0; r < 16; ++r) { s0[r] = __builtin_amdgcn_exp2f(s0[r]); s1[r] = __builtin_amdgcn_exp2f(s1[r]); ls += s0[r] + s1[r]; }
    st.lsum += ls;
    bf16x8 p[4]; p[0] = pk8(s0, 0); p[1] = pk8(s0, 8); p[2] = pk8(s1, 0); p[3] = pk8(s1, 8);
    const LAS unsigned char* vbase = lds + AT_VR + SLOT * AT_SLOT + vb;
#pragma unroll
    for (int dt = 0; dt < 4; ++dt)
#pragma unroll
        for (int ks = 0; ks < 4; ++ks) {
            const s16x4 lo = vtr(vbase + (2 * ks) * 2048 + dt * 512), hi = vtr(vbase + (2 * ks + 1) * 2048 + dt * 512);
            const bf16x8 vf = (bf16x8){lo[0], lo[1], lo[2], lo[3], hi[0], hi[1], hi[2], hi[3]};
            st.o[dt] = __builtin_amdgcn_mfma_f32_32x32x16_bf16(vf, p[ks], st.o[dt], 0, 0, 0);
        }
}

__device__ __forceinline__ void attn_dma(LAS unsigned char* lds, const unsigned char* kg0, const unsigned char* vg0, int t, int slot, int wid, int lane) {
#pragma unroll
    for (int j = 0; j < 4; ++j) { const int piece = wid * 4 + j;
        const unsigned char* src; unsigned dst;
        if (piece < 8) { src = kg0 + (size_t)t * 8192 + piece * 1024; dst = AT_KR + slot * AT_SLOT + piece * 1024; }
        else if (piece < 16) { src = kg0 + (size_t)SEQ * 128 + (size_t)t * 8192 + (piece - 8) * 1024; dst = AT_KR + slot * AT_SLOT + 8192 + (piece - 8) * 1024; }
        else { src = vg0 + (size_t)t * 16384 + (piece - 16) * 1024; dst = AT_VR + slot * AT_SLOT + (piece - 16) * 1024; }
        __builtin_amdgcn_global_load_lds((const unsigned*)(src + lane * 16), (LAS unsigned*)(lds + dst), 16, 0, 0); }
}

__device__ __forceinline__ void phase_attn(Frame& F, int l) {
    refresh(F);
    const WS W = ws_map(F.ws, F.nb); const float* const* IN_ = F.a->in; (void)IN_; (void)W;
    const int lane = F.lane, wid = F.wave, r32 = lane & 31, hh = lane >> 5, qg = wid >> 1, c = wid & 1;
    LAS unsigned char* lds = F.lds;
    LAS float* tab = (LAS float*)(lds + AT_TAB);
    for (int i = F.tid; i < 1028; i += NTHR) tab[i] = W.tab[i];
    const float lam = W.tab[1032 + l]; const float lam_init = 0.8f - 0.6f * __expf(-0.3f * (float)l);
    const float* subg = IN_[13] + l * 128;
    const int U = F.nb * NH * 64;
    const int gx = F.G >> 3, per = U >> 3;
    int koff[4]; { const int sw = (r32 >> 1) & 7;
#pragma unroll
        for (int s = 0; s < 4; ++s) koff[s] = r32 * 128 + (((2 * s + hh) ^ sw) << 4); }
    const int vb = (4 * hh + ((lane & 15) >> 2)) * 64 + (((lane >> 4) & 1) * 16 + 4 * (lane & 3)) * 2;
    __syncthreads();
    for (int i = 0;; ++i) {
        int id;
        if ((F.G & 7) == 0) { const int n = i * gx + (F.bid >> 3); if (n >= per) break; id = (F.bid & 7) * per + n; }
        else { id = i * F.G + F.bid; if (id >= U) break; }
        const int bh = id >> 6, qb = id & 63, b = bh >> 2, h = bh & 3;
        const int qw0 = qb * 128 + 32 * qg;
        const unsigned char* kg0 = (const unsigned char*)(W.DK + ((size_t)bh * 2) * SEQ * 64);
        const unsigned char* vg0 = (const unsigned char*)(W.DV + (size_t)bh * SEQ * 128);
        attn_dma(lds, kg0, vg0, 0, 0, wid, lane); attn_dma(lds, kg0, vg0, 1, 1, wid, lane);
        bf16x8 qf[4]; { const bf16* qp = W.DQ + (((size_t)bh * 2 + c) * SEQ + qw0 + r32) * 64 + 8 * hh;
#pragma unroll
            for (int s = 0; s < 4; ++s) qf[s] = *(const bf16x8*)(qp + 16 * s); }
        AttnState st;
#pragma unroll
        for (int dt = 0; dt < 4; ++dt) st.o[dt] = f32x16{};
        st.lsum = 0.f;
        const int tL = (qw0 >= 154) ? ((qw0 - 154) >> 6) + 1 : 0, tR = (qw0 + 185) >> 6;
        const float shl = tab[1024 + h];
        const LAS float* tabh = tab + h * 256;
#define AT_STEP(SL, t) do { \
            asm volatile("s_waitcnt vmcnt(4)" ::: "memory"); __builtin_amdgcn_s_barrier(); asm volatile("" ::: "memory"); \
            { const int tn = (t) + 2 < 128 ? (t) + 2 : 127; attn_dma(lds, kg0, vg0, tn, (SL + 2) % 3, wid, lane); } \
            if ((t) == tL) { _Pragma("unroll") for (int dt = 0; dt < 4; ++dt) st.o[dt] *= shl; st.lsum *= shl; } \
            const int mode = ((t) >= tL && (t) < tR) ? 1 : 0; \
            attn_step<SL>(lds, st, qf, koff, vb, c, mode, 64 * (t) - qw0 - r32 + 4 * hh + 128, tabh); } while (0)
        for (int t0 = 0; t0 < 126; t0 += 3) { AT_STEP(0, t0); AT_STEP(1, t0 + 1); AT_STEP(2, t0 + 2); }
        AT_STEP(0, 126); AT_STEP(1, 127);
#undef AT_STEP
        asm volatile("s_waitcnt vmcnt(0)" ::: "memory"); __builtin_amdgcn_s_barrier(); asm volatile("" ::: "memory");
        const float lt = st.lsum + __shfl_xor(st.lsum, 32);
        LAS float* xch = (LAS float*)(lds + qg * 16384);
        if (c == 1) { const float f = lam / lt;
#pragma unroll
            for (int dt = 0; dt < 4; ++dt)
#pragma unroll
                for (int r = 0; r < 16; ++r) xch[(dt * 16 + r) * 64 + lane] = st.o[dt][r] * f; }
        LDS_WAIT(); __builtin_amdgcn_s_barrier(); asm volatile("" ::: "memory");
        if (c == 0) { const float f = 1.f / lt; float ss = 0.f;
#pragma unroll
            for (int dt = 0; dt < 4; ++dt)
#pragma unroll
                for (int r = 0; r < 16; ++r) { const float v = st.o[dt][r] * f - xch[(dt * 16 + r) * 64 + lane]; st.o[dt][r] = v; ss += v * v; }
            ss += __shfl_xor(ss, 32);
            const float rn = rsqrtf(ss * (1.f / 128.f) + RMS_EPS) * (1.f - lam_init);
            bf16* orow = W.OAB + (size_t)F.T * 512 + ((size_t)b * SEQ + qw0 + r32) * 512 + h * 128;
#pragma unroll
            for (int dt = 0; dt < 4; ++dt)
#pragma unroll
                for (int g = 0; g < 4; ++g) { const int dv = 32 * dt + 8 * g + 4 * hh; const f32x4 sg = *(const f32x4*)(subg + dv);
                    u32x2 o; o.x = cvt_pk(st.o[dt][4 * g] * rn * sg[0], st.o[dt][4 * g + 1] * rn * sg[1]); o.y = cvt_pk(st.o[dt][4 * g + 2] * rn * sg[2], st.o[dt][4 * g + 3] * rn * sg[3]);
                    *(u32x2*)(orow + dv) = o; }
        }
        LDS_WAIT(); __builtin_amdgcn_s_barrier(); asm volatile("" ::: "memory");
    }
}
constexpr int GL_CUM = 0;
constexpr int GL_S64 = 144, GL_S192 = 400;
constexpr int G1_KEF = 32768, G1_KEB = G1_KEF + 64 * GL_S64, G1_VT = G1_KEB + 64 * GL_S64;
constexpr int G3_AOP = 32768, G3_KIF = G3_AOP + 64 * GL_S192, G3_KIB = G3_KIF + 64 * GL_S64, G3_BOP = G3_KIB + 64 * GL_S64;
static_assert(G3_BOP + 128 * GL_S192 <= 150 * 1024, "GLA LDS");

__device__ __forceinline__ bf16x8 lds_frag(const LAS unsigned char* base, int row, int stride, int kbyte) { return *(const LAS bf16x8*)(base + row * stride + kbyte); }

__device__ __forceinline__ void gla_cum(Frame& F, size_t trow0, int h) {
    const WS W = ws_map(F.ws, F.nb); const float* const* IN_ = F.a->in; (void)IN_; (void)W;
    LAS float* cum = (LAS float*)(F.lds + GL_CUM);
#pragma unroll
    for (int it = 0; it < 4; ++it) { const int idx = F.tid + it * NTHR; const int dir = idx >> 10, t = (idx >> 4) & 63, d4 = (idx & 15) * 4;
        const f32x4 v = *(const f32x4*)((dir ? W.LGB : W.LGF) + (trow0 + t) * 256 + h * 64 + d4);
        *(LAS f32x4*)(cum + (dir * 64 + t) * 64 + d4) = v; }
    __syncthreads();
    if (F.tid < 128) { const int dir = F.tid >> 6, d = F.tid & 63; LAS float* cc = cum + dir * 4096 + d; float run = 0.f;
        if (dir == 0) { for (int t = 0; t < 64; ++t) { run += cc[t * 64]; cc[t * 64] = run; } }
        else { for (int t = 63; t >= 0; --t) { run += cc[t * 64]; cc[t * 64] = run; } } }
    __syncthreads();
}

__device__ __forceinline__ void phase_gla1(Frame& F) {
    refresh(F);
    const WS W = ws_map(F.ws, F.nb); const float* const* IN_ = F.a->in; (void)IN_; (void)W;
    LAS unsigned char* lds = F.lds; LAS float* cum = (LAS float*)(lds + GL_CUM);
    const int lane = F.lane, wid = F.wave, r32 = lane & 31, hh = lane >> 5;
    const int U = F.nb * NH * 128;
    for (int u = F.bid; u < U; u += F.G) {
        const int n = u & 127, bh = u >> 7, b = bh >> 2, h = bh & 3; const size_t trow0 = (size_t)b * SEQ + n * 64;
        gla_cum(F, trow0, h);
        {
            const int t = F.tid >> 3, d0 = (F.tid & 7) * 8;
            const u32x4 kv = *(const u32x4*)(W.GK + (trow0 + t) * 256 + h * 64 + d0);
            const unsigned kw[4] = {kv.x, kv.y, kv.z, kv.w};
#pragma unroll
            for (int j = 0; j < 8; ++j) { const int d = d0 + j; const float k = (j & 1) ? bfhi(kw[j >> 1]) : bflo(kw[j >> 1]);
                const float ef = __expf(cum[63 * 64 + d] - cum[t * 64 + d]), eb = __expf(cum[4096 + d] - cum[4096 + t * 64 + d]);
                *(LAS bf16*)(lds + G1_KEF + d * GL_S64 + t * 2) = (bf16)(cvt_pk(k * ef, 0.f) & 0xffffu);
                *(LAS bf16*)(lds + G1_KEB + d * GL_S64 + t * 2) = (bf16)(cvt_pk(k * eb, 0.f) & 0xffffu); }
            const int v0 = (F.tid & 7) * 16;
            const u32x4 va = *(const u32x4*)(W.GV + (trow0 + t) * 512 + h * 128 + v0), vb = *(const u32x4*)(W.GV + (trow0 + t) * 512 + h * 128 + v0 + 8);
            const unsigned vw[8] = {va.x, va.y, va.z, va.w, vb.x, vb.y, vb.z, vb.w};
#pragma unroll
            for (int j = 0; j < 16; ++j) *(LAS bf16*)(lds + G1_VT + (v0 + j) * GL_S64 + t * 2) = (bf16)((j & 1) ? (vw[j >> 1] >> 16) : (vw[j >> 1] & 0xffffu));
            if (F.tid < 128) { const int dir = F.tid >> 6, d = F.tid & 63; W.DEC[((size_t)u * 2 + dir) * 64 + d] = __expf(dir ? cum[4096 + d] : cum[63 * 64 + d]); }
        }
        __syncthreads();
        {
            const int dt = wid & 3, dd = wid >> 2;
            f32x16 cf = {}, cb = {};
#pragma unroll
            for (int s = 0; s < 4; ++s) { const int kb = (16 * s + 8 * hh) * 2;
                const bf16x8 a = lds_frag(lds + G1_VT, 32 * dt + r32, GL_S64, kb);
                cf = __builtin_amdgcn_mfma_f32_32x32x16_bf16(a, lds_frag(lds + G1_KEF, 32 * dd + r32, GL_S64, kb), cf, 0, 0, 0);
                cb = __builtin_amdgcn_mfma_f32_32x32x16_bf16(a, lds_frag(lds + G1_KEB, 32 * dd + r32, GL_S64, kb), cb, 0, 0, 0); }
            float* of = W.KVT + ((size_t)u * 2) * 8192; float* ob = of + 8192;
#pragma unroll
            for (int r = 0; r < 16; ++r) { const int dv = 32 * dt + crow(r, hh), d = 32 * dd + r32; of[dv * 64 + d] = cf[r]; ob[dv * 64 + d] = cb[r]; }
        }
        __syncthreads();
    }
}

__device__ __forceinline__ void phase_gla2(Frame& F) {
    refresh(F);
    const WS W = ws_map(F.ws, F.nb); const float* const* IN_ = F.a->in; (void)IN_; (void)W;
    const size_t total = (size_t)F.nb * NH * 2 * 8192;
    for (size_t wk = (size_t)F.bid * NTHR + F.tid; wk < total; wk += (size_t)F.G * NTHR) {
        const int e = (int)(wk & 8191), dir = (int)((wk >> 13) & 1), bh = (int)(wk >> 14), d = e & 63;
        float* base = W.KVT + ((size_t)bh * 128 * 2 + dir) * 8192 + e; const float* dec = W.DEC + ((size_t)bh * 128 * 2 + dir) * 64 + d;
        float S = 0.f;
        for (int n0 = 0; n0 < 128; n0 += 8) {
            float kv[8], dc[8];
#pragma unroll
            for (int j = 0; j < 8; ++j) { const int n = dir ? 127 - (n0 + j) : n0 + j; kv[j] = base[(size_t)n * 16384]; dc[j] = dec[(size_t)n * 128]; }
#pragma unroll
            for (int j = 0; j < 8; ++j) { const int n = dir ? 127 - (n0 + j) : n0 + j; base[(size_t)n * 16384] = S; S = dc[j] * S + kv[j]; }
        }
    }
}

__device__ __forceinline__ void phase_gla3(Frame& F, int l) {
    refresh(F);
    const WS W = ws_map(F.ws, F.nb); const float* const* IN_ = F.a->in; (void)IN_; (void)W;
    LAS unsigned char* lds = F.lds; LAS float* cum = (LAS float*)(lds + GL_CUM);
    const int lane = F.lane, wid = F.wave, r32 = lane & 31, hh = lane >> 5;
    const float* gng = IN_[9] + l * 128;
    const int U = F.nb * NH * 128;
    for (int u = F.bid; u < U; u += F.G) {
        const int n = u & 127, bh = u >> 7, b = bh >> 2, h = bh & 3; const size_t trow0 = (size_t)b * SEQ + n * 64;
        gla_cum(F, trow0, h);
        {
            const int t = F.tid >> 3, d0 = (F.tid & 7) * 8;
            const u32x4 qv = *(const u32x4*)(W.GQ + (trow0 + t) * 256 + h * 64 + d0), kv = *(const u32x4*)(W.GK + (trow0 + t) * 256 + h * 64 + d0);
            const unsigned qw[4] = {qv.x, qv.y, qv.z, qv.w}, kw[4] = {kv.x, kv.y, kv.z, kv.w};
            float qf[8], qb[8], kf[8], kb[8];
#pragma unroll
            for (int j = 0; j < 8; ++j) { const int d = d0 + j; const float q = (j & 1) ? bfhi(qw[j >> 1]) : bflo(qw[j >> 1]), k = (j & 1) ? bfhi(kw[j >> 1]) : bflo(kw[j >> 1]);
                const float cf = cum[t * 64 + d], cb = cum[4096 + t * 64 + d];
                qf[j] = q * __expf(cf); qb[j] = q * __expf(cb); kf[j] = k * __expf(-cf); kb[j] = k * __expf(-cb); }
            u32x4 o;
            o.x = cvt_pk(qf[0], qf[1]); o.y = cvt_pk(qf[2], qf[3]); o.z = cvt_pk(qf[4], qf[5]); o.w = cvt_pk(qf[6], qf[7]); *(LAS u32x4*)(lds + G3_AOP + t * GL_S192 + (64 + d0) * 2) = o;
            o.x = cvt_pk(qb[0], qb[1]); o.y = cvt_pk(qb[2], qb[3]); o.z = cvt_pk(qb[4], qb[5]); o.w = cvt_pk(qb[6], qb[7]); *(LAS u32x4*)(lds + G3_AOP + t * GL_S192 + (128 + d0) * 2) = o;
            o.x = cvt_pk(kf[0], kf[1]); o.y = cvt_pk(kf[2], kf[3]); o.z = cvt_pk(kf[4], kf[5]); o.w = cvt_pk(kf[6], kf[7]); *(LAS u32x4*)(lds + G3_KIF + t * GL_S64 + d0 * 2) = o;
            o.x = cvt_pk(kb[0], kb[1]); o.y = cvt_pk(kb[2], kb[3]); o.z = cvt_pk(kb[4], kb[5]); o.w = cvt_pk(kb[6], kb[7]); *(LAS u32x4*)(lds + G3_KIB + t * GL_S64 + d0 * 2) = o;
            const int v0 = (F.tid & 7) * 16;
            const u32x4 va = *(const u32x4*)(W.GV + (trow0 + t) * 512 + h * 128 + v0), vb = *(const u32x4*)(W.GV + (trow0 + t) * 512 + h * 128 + v0 + 8);
            const unsigned vw[8] = {va.x, va.y, va.z, va.w, vb.x, vb.y, vb.z, vb.w};
#pragma unroll
            for (int j = 0; j < 16; ++j) *(LAS bf16*)(lds + G3_BOP + (v0 + j) * GL_S192 + t * 2) = (bf16)((j & 1) ? (vw[j >> 1] >> 16) : (vw[j >> 1] & 0xffffu));
            const int dv = F.tid >> 2, dd0 = (F.tid & 3) * 16;
#pragma unroll
            for (int dir = 0; dir < 2; ++dir) { const float* sp = W.KVT + ((size_t)u * 2 + dir) * 8192 + dv * 64 + dd0;
                const f32x4 a = *(const f32x4*)sp, bq = *(const f32x4*)(sp + 4), cq = *(const f32x4*)(sp + 8), dq = *(const f32x4*)(sp + 12);
                u32x4 o0, o1; o0.x = cvt_pk(a[0], a[1]); o0.y = cvt_pk(a[2], a[3]); o0.z = cvt_pk(bq[0], bq[1]); o0.w = cvt_pk(bq[2], bq[3]);
                o1.x = cvt_pk(cq[0], cq[1]); o1.y = cvt_pk(cq[2], cq[3]); o1.z = cvt_pk(dq[0], dq[1]); o1.w = cvt_pk(dq[2], dq[3]);
                *(LAS u32x4*)(lds + G3_BOP + dv * GL_S192 + (64 + 64 * dir + dd0) * 2) = o0; *(LAS u32x4*)(lds + G3_BOP + dv * GL_S192 + (64 + 64 * dir + dd0 + 8) * 2) = o1; }
        }
        __syncthreads();
        if (wid < 4) {
            const int it = wid >> 1, jt = wid & 1;
            f32x16 af = {}, ab = {};
#pragma unroll
            for (int s = 0; s < 4; ++s) { const int kb = (16 * s + 8 * hh) * 2;
                if (jt <= it) af = __builtin_amdgcn_mfma_f32_32x32x16_bf16(lds_frag(lds + G3_AOP, 32 * it + r32, GL_S192, 128 + kb), lds_frag(lds + G3_KIF, 32 * jt + r32, GL_S64, kb), af, 0, 0, 0);
                if (jt >= it) ab = __builtin_amdgcn_mfma_f32_32x32x16_bf16(lds_frag(lds + G3_AOP, 32 * it + r32, GL_S192, 256 + kb), lds_frag(lds + G3_KIB, 32 * jt + r32, GL_S64, kb), ab, 0, 0, 0); }
#pragma unroll
            for (int r = 0; r < 16; ++r) { const int i = 32 * it + crow(r, hh), j = 32 * jt + r32; const float v = (j <= i) ? af[r] : ab[r];
                *(LAS bf16*)(lds + G3_AOP + i * GL_S192 + j * 2) = (bf16)(cvt_pk(v, 0.f) & 0xffffu); }
        }
        __syncthreads();
        {
            const int it = wid >> 2, dt = wid & 3; f32x16 o = {};
#pragma unroll
            for (int s = 0; s < 12; ++s) { const int kb = (16 * s + 8 * hh) * 2;
                o = __builtin_amdgcn_mfma_f32_32x32x16_bf16(lds_frag(lds + G3_AOP, 32 * it + r32, GL_S192, kb), lds_frag(lds + G3_BOP, 32 * dt + r32, GL_S192, kb), o, 0, 0, 0); }
            LAS float* out = (LAS float*)(lds + GL_CUM);
#pragma unroll
            for (int r = 0; r < 16; ++r) out[(32 * it + crow(r, hh)) * 128 + 32 * dt + r32] = o[r];
        }
        __syncthreads();
        {
            const int t = F.tid >> 3, v0 = (F.tid & 7) * 16; const LAS float* orow = (const LAS float*)(lds + GL_CUM) + t * 128 + v0;
            float x[16]; float ss = 0.f;
#pragma unroll
            for (int j = 0; j < 16; ++j) { x[j] = orow[j]; ss += x[j] * x[j]; }
            ss += __shfl_xor(ss, 1); ss += __shfl_xor(ss, 2); ss += __shfl_xor(ss, 4);
            const float rs = rsqrtf(ss * (1.f / 128.f) + RMS_EPS);
            const u32x4 ga = *(const u32x4*)(W.SG + (trow0 + t) * 512 + h * 128 + v0), gb = *(const u32x4*)(W.SG + (trow0 + t) * 512 + h * 128 + v0 + 8);
            const unsigned gw[8] = {ga.x, ga.y, ga.z, ga.w, gb.x, gb.y, gb.z, gb.w};
            float y[16];
#pragma unroll
            for (int j = 0; j < 16; ++j) y[j] = x[j] * rs * gng[v0 + j] * ((j & 1) ? bfhi(gw[j >> 1]) : bflo(gw[j >> 1]));
            u32x4 o0, o1; o0.x = cvt_pk(y[0], y[1]); o0.y = cvt_pk(y[2], y[3]); o0.z = cvt_pk(y[4], y[5]); o0.w = cvt_pk(y[6], y[7]);
            o1.x = cvt_pk(y[8], y[9]); o1.y = cvt_pk(y[10], y[11]); o1.z = cvt_pk(y[12], y[13]); o1.w = cvt_pk(y[14], y[15]);
            bf16* dst = W.OAB + (trow0 + t) * 512 + h * 128 + v0; *(u32x4*)dst = o0; *(u32x4*)(dst + 8) = o1;
        }
        __syncthreads();
    }
}
__device__ __forceinline__ void phase_select(Frame& F, int l) {
    refresh(F);
    const WS W = ws_map(F.ws, F.nb); const float* const* IN_ = F.a->in; (void)IN_; (void)W;
    LAS int* lcnt = (LAS int*)F.lds; LAS int* lbase = lcnt + 32;
    const float* b_rg = IN_[19] + l * 4; const float* b_re = IN_[21] + l * 32;
    unsigned* gcnt = W.ctl + CW_CNT + l * 64;
    for (int t0 = F.bid * NTHR; t0 < F.T; t0 += F.G * NTHR) {
        if (F.tid < 32) lcnt[F.tid] = 0;
        __syncthreads();
        const int t = t0 + F.tid; int e0 = 0, e1 = 0, r0 = 0, r1 = 0; float g0 = 0.f, g1 = 0.f;
        if (t < F.T) {
            const float* lg = W.LOGITS + (size_t)t * 64;
            float gl[4]; { const f32x4 v = *(const f32x4*)lg; gl[0] = v[0] + b_rg[0]; gl[1] = v[1] + b_rg[1]; gl[2] = v[2] + b_rg[2]; gl[3] = v[3] + b_rg[3]; }
            int grp = 0; float mx = gl[0];
            if (gl[1] > mx) { mx = gl[1]; grp = 1; } if (gl[2] > mx) { mx = gl[2]; grp = 2; } if (gl[3] > mx) { mx = gl[3]; grp = 3; }
            const float p_grp = 1.f / (__expf(gl[0] - mx) + __expf(gl[1] - mx) + __expf(gl[2] - mx) + __expf(gl[3] - mx));
            const f32x4 ea = *(const f32x4*)(lg + 4 + grp * 8), eb = *(const f32x4*)(lg + 8 + grp * 8);
            const f32x4 ba = *(const f32x4*)(b_re + grp * 8), bb = *(const f32x4*)(b_re + grp * 8 + 4);
            float b0v = -1e30f, b1v = -1e30f; int i0 = 0, i1 = 0;
#pragma unroll
            for (int j = 0; j < 8; ++j) { const float e = (j < 4) ? ea[j] + ba[j] : eb[j - 4] + bb[j - 4];
                if (e > b0v) { b1v = b0v; i1 = i0; b0v = e; i0 = j; } else if (e > b1v) { b1v = e; i1 = j; } }
            const float p1 = __expf(b1v - b0v), s2 = 1.f + p1;
            e0 = grp * 8 + i0; e1 = grp * 8 + i1; g0 = p_grp / s2; g1 = p_grp * p1 / s2;
            r0 = __hip_atomic_fetch_add(lcnt + e0, 1, __ATOMIC_RELAXED, __HIP_MEMORY_SCOPE_WORKGROUP);
            r1 = __hip_atomic_fetch_add(lcnt + e1, 1, __ATOMIC_RELAXED, __HIP_MEMORY_SCOPE_WORKGROUP);
        }
        __syncthreads();
        if (F.tid < 32) lbase[F.tid] = (int)__hip_atomic_fetch_add(gcnt + F.tid, (unsigned)lcnt[F.tid], __ATOMIC_RELAXED, __HIP_MEMORY_SCOPE_AGENT);
        __syncthreads();
        if (t < F.T) { W.eid[t * 2] = e0; W.eid[t * 2 + 1] = e1; W.gate[t * 2] = g0; W.gate[t * 2 + 1] = g1; W.rank[t * 2] = lbase[e0] + r0; W.rank[t * 2 + 1] = lbase[e1] + r1; }
        __syncthreads();
    }
}
__device__ __forceinline__ void phase_gather(Frame& F, int l) {
    refresh(F);
    const WS W = ws_map(F.ws, F.nb); const float* const* IN_ = F.a->in; (void)IN_; (void)W;
    LAS int* seg = (LAS int*)F.lds;
    const unsigned* gcnt = W.ctl + CW_CNT + l * 64;
    if (F.tid == 0) { int o = 0; for (int e = 0; e < 32; ++e) { seg[e] = o; o += ((int)__hip_atomic_load(gcnt + e, __ATOMIC_RELAXED, __HIP_MEMORY_SCOPE_AGENT) + 255) & ~255; } seg[32] = o; }
    __syncthreads();
    if (F.bid == 0) {
        const int ntile = seg[32] >> 8;
        for (int i = F.tid; i < ntile; i += NTHR) { int e = 0; while (e < 31 && (i << 8) >= seg[e + 1]) ++e; W.tilee[i] = e; }
        if (F.tid == 0) W.segp[0] = ntile;
    }
    const int gw = F.bid * NWAVES + F.wave, NGW = F.G * NWAVES;
    for (int it = gw; it < F.T * 2; it += NGW) {
        const int t = it >> 1; const int e = W.eid[it], p = seg[e] + W.rank[it];
        const GAS u32x4* src = (const GAS u32x4*)(W.H + (size_t)t * D) + F.lane; GAS u32x4* dst = (GAS u32x4*)(W.XS + (size_t)p * D) + F.lane;
        const u32x4 a = src[0], b = src[64]; dst[0] = a; dst[64] = b;
        if (F.lane == 0) { W.pos[it] = p; W.gsort[p] = W.gate[it]; }
    }
}

#ifndef MK_MASK
#define MK_MASK 0xffffffffu
#endif
#define EN(b) (((MK_MASK) >> (b)) & 1u)
constexpr int NPL = 14, NPH = 2 + DEPTH * NPL;
__global__ void __launch_bounds__(NTHR, 2) mk_fwd(Args args) {
    extern __shared__ __attribute__((aligned(16))) unsigned char lds_raw[];
    Frame F;
    F.lds = (LAS unsigned char*)lds_raw; F.tid = threadIdx.x; F.lane = F.tid & 63; F.wave = __builtin_amdgcn_readfirstlane(F.tid >> 6);
    F.G = gridDim.x; F.bid = blockIdx.x; F.nb = args.nb; F.T = args.nb * SEQ; F.ws = args.ws; F.a = &args; F.xbuf = args.out;
    const float* const* IN_ = args.in;
    volatile LAS unsigned* misc = (volatile LAS unsigned*)(F.lds + LDS_MISC);
    if (F.tid < 64) misc[F.tid] = 0u;
    __syncthreads();
    XcdBarrier bar = xcd_barrier_post((unsigned*)args.ws + CW_BAR + args.li * XCD_BAR_WORDS, misc);
    const int lo = args.ph_lo, hi = args.ph_hi;
#define IN(k) (lo <= (k) && (k) < hi)
#define SEAM(k) do { if (IN(k) && IN((k) + 1)) xcd_barrier(bar); } while (0)
    LAS unsigned char* gl = F.lds;
    if (EN(0) && IN(0)) { p0_prologue(F); SEAM(0); }
    for (int l = 0; l < DEPTH; ++l) {
        const int pb = 1 + l * NPL;
        if (EN(1) && IN(pb + 0)) { phase_norm(F, l, 0); SEAM(pb + 0); }
        if (EN(2) && IN(pb + 1)) { const WS W = ws_map(F.ws, F.nb);
            pg8::Gemm g{W.H, W.win + (size_t)l * NIN * D, F.T, NIN, D}; pg8::StaticOrder S; S.init(F.T, NIN, F.G, F.bid);
            EpiIn E{W.GQ, W.GK, W.GV, W.SG, W.LGF, W.LGB, W.DQ, W.DK, W.DV, W.SGA, W.SGB, IN_[8] + l * 512, IN_[10] + l * 64, IN_[11] + l * 64};
            pg8::gemm_phase<EpiIn, pg8::StaticOrder, true, true>(gl, g, S, E);
            SEAM(pb + 1);
        }
        if (EN(3) && IN(pb + 2)) { phase_gla1(F); SEAM(pb + 2); }
        if (EN(4) && IN(pb + 3)) { phase_gla2(F); SEAM(pb + 3); }
        if (EN(5) && IN(pb + 4)) { phase_gla3(F, l); __syncthreads(); }
        if (EN(6) && IN(pb + 5)) { phase_attn(F, l); SEAM(pb + 5); }
        if (EN(7) && IN(pb + 6)) { const WS W = ws_map(F.ws, F.nb);
            pg8::Gemm g{W.OAB, W.wab + (size_t)l * D * D, 0, 0, 512}; MergeOrder S; S.so.init(F.T, D, F.G, F.bid); S.nM = F.T / 256;
            EpiMerge E{W.SGA, W.SGB, W.MERGED, F.T / 256};
            pg8::gemm_phase<EpiMerge, MergeOrder, true, true>(gl, g, S, E);
            SEAM(pb + 6);
        }
        if (EN(8) && IN(pb + 7)) { const WS W = ws_map(F.ws, F.nb); const float* modl = W.mod + (size_t)l * NBMAX * 6 * D;
            pg8::Gemm g{W.MERGED, W.wo + (size_t)l * D * D, F.T, D, D}; pg8::StaticOrder S; S.init(F.T, D, F.G, F.bid);
            EpiResid E{l == 0 ? IN_[0] : F.xbuf, F.xbuf, modl + 2 * D};
            pg8::gemm_phase<EpiResid, pg8::StaticOrder, true, true>(gl, g, S, E);
            SEAM(pb + 7);
        }
        if (EN(1) && IN(pb + 8)) { phase_norm(F, l, 1); SEAM(pb + 8); }
        if (EN(9) && IN(pb + 9)) { const WS W = ws_map(F.ws, F.nb);
            pg8::Gemm g{W.H, W.wr + (size_t)l * 256 * D, F.T, 256, D}; pg8::StaticOrder S; S.init(F.T, 256, F.G, F.bid);
            EpiLogits E{W.LOGITS};
            pg8::gemm_phase<EpiLogits, pg8::StaticOrder, true, true>(gl, g, S, E);
            SEAM(pb + 9);
        }
        if (EN(10) && IN(pb + 10)) { phase_select(F, l); SEAM(pb + 10); }
        if (EN(11) && IN(pb + 11)) { phase_gather(F, l); SEAM(pb + 11); }
        if (EN(12) && IN(pb + 12)) { const WS W = ws_map(F.ws, F.nb);
            const int ntile = W.segp[0];
            pg8::Gemm g{W.XS, W.w1 + (size_t)l * NE * 1024 * D, 0, 0, D}; GroupedOrder S{W.tilee, ntile * 4, F.G, F.bid};
            EpiAct E{W.ACT};
            pg8::gemm_phase<EpiAct, GroupedOrder, true, true>(gl, g, S, E);
            SEAM(pb + 12);
        }
        if (EN(13) && IN(pb + 13)) { const WS W = ws_map(F.ws, F.nb);
            const int ntile = W.segp[0];
            pg8::Gemm g{W.ACT, W.w2 + (size_t)l * NE * D * DE, 0, 0, DE}; GroupedOrder S{W.tilee, ntile * 4, F.G, F.bid};
            EpiYs E{W.YS, W.gsort};
            pg8::gemm_phase<EpiYs, GroupedOrder, true, true>(gl, g, S, E);
            SEAM(pb + 13);
        }
    }
    if (EN(1) && IN(NPH - 1)) phase_norm(F, 0, 2);
#undef IN
#undef SEAM
}

struct LaunchCfg { int grid; bool ok; };
inline LaunchCfg& launch_cfg() {
    static LaunchCfg c{0, false}; static bool init = false;
    if (!init) { init = true;
        int dev = 0, cus = 0, per_cu = 0;
        if (hipGetDevice(&dev) != hipSuccess || hipDeviceGetAttribute(&cus, hipDeviceAttributeMultiprocessorCount, dev) != hipSuccess) { fprintf(stderr, "mk: device query failed\n"); return c; }
        if (hipFuncSetAttribute((const void*)mk_fwd, hipFuncAttributeMaxDynamicSharedMemorySize, LDS_BYTES) != hipSuccess) { fprintf(stderr, "mk: hipFuncSetAttribute failed\n"); return c; }
        if (hipOccupancyMaxActiveBlocksPerMultiprocessor(&per_cu, (const void*)mk_fwd, NTHR, LDS_BYTES) != hipSuccess || per_cu < 1) { fprintf(stderr, "mk: occupancy query says %d blocks/CU\n", per_cu); (void)hipGetLastError(); return c; }
        c.grid = cus; c.ok = true;
    }
    return c;
}
inline void launch_range(void* const* d_in, float* xbuf, void* d_ws, int nb, int lo, int hi, int li, hipStream_t stream) {
    LaunchCfg& c = launch_cfg(); if (!c.ok) return;
    Args a{}; for (int i = 0; i < 24; ++i) a.in[i] = (const float*)d_in[i];
    a.out = xbuf; a.ws = (unsigned char*)d_ws; a.nb = nb; a.ph_lo = lo; a.ph_hi = hi; a.li = li;
    hipLaunchKernelGGL(mk_fwd, dim3(c.grid), dim3(NTHR), LDS_BYTES, stream, a);
    const hipError_t le = hipPeekAtLastError(); if (le != hipSuccess) fprintf(stderr, "mk: launch [%d,%d) failed: %s\n", lo, hi, hipGetErrorName(le));
}
}
extern "C" void kernel_launch(void* const* d_in, const int* in_sizes, int n_in, void* d_out, int out_size, void* d_ws, size_t ws_size, hipStream_t stream) {
    (void)in_sizes; (void)n_in; (void)out_size;
    static int checked = 0;
    if (!checked) { checked = 1; const mk::WS w = mk::ws_map((unsigned char*)d_ws, 4); if (w.end > ws_size) { fprintf(stderr, "mk: workspace too small: need %zu, have %zu\n", w.end, ws_size); checked = -1; } }
    if (checked < 0) return;
    if (hipMemsetAsync(d_ws, 0, mk::CTL_BYTES, stream) != hipSuccess) return;
    mk::launch_range(d_in, (float*)d_out, d_ws, 4, 0, mk::NPH, 0, stream);
}
```

```cpp
#include <hip/hip_runtime.h>
#include <cstdio>
#include <cstdint>
#include <cmath>
namespace pg8 {
#define PG8_LAS __attribute__((address_space(3)))
typedef unsigned short bf16_t;
typedef short bf16x8 __attribute__((ext_vector_type(8)));
typedef float f32x4 __attribute__((ext_vector_type(4)));
typedef unsigned u32x4 __attribute__((ext_vector_type(4)));
constexpr int BM = 256, BK = 64, HALF = 128, HTB = HALF * BK * 2  , STAGE_BYTES = 8 * HTB, NXCD = 8, WGM = 8;

__host__ __device__ __forceinline__ int lds_byte(int r, int c) { const int st = (r >> 4) * 2 + (c >> 5), rr = r & 15, cc = c & 31, ob = rr * 64 + cc * 2; return st * 1024 + (ob ^ (((ob >> 9) & 1) << 5)); }
__host__ __device__ __forceinline__ void stage_rc(int b, int& R, int& C) { const int st = b / 1024, sb = b % 1024, swz = sb ^ (((sb >> 9) & 1) << 5); R = (st >> 1) * 16 + swz / 64; C = (st & 1) * 32 + (swz % 64) / 2; }
__host__ __device__ __forceinline__ int perm32(int rho) { const int n = rho >> 4, i = rho & 15; return 8 * (i >> 2) + 4 * n + (i & 3); }

struct Unit { int pm, pn; };
struct Gemm { const bf16_t* A; const bf16_t* Bt; int M, N, K; };

struct StaticOrder {
    int nM, nN, nwg, G, c;
    __host__ __device__ void init(int M, int N, int G_, int c_) { nM = M / BM; nN = N / BM; nwg = nM * nN; G = G_; c = c_; }
    __host__ __device__ bool next(int i, Unit& u) const {
        const long L = (long)i * G + c; if (L >= nwg) return false;
        int wgid = (int)L; { const int q = nwg / NXCD, r = nwg % NXCD, xcd = wgid % NXCD, off = wgid / NXCD; wgid = (xcd < r ? xcd * (q + 1) : r * (q + 1) + (xcd - r) * q) + off; }
        const int nig = WGM * nN, gid = wgid / nig, fm = gid * WGM, gsz = (nM - fm) < WGM ? (nM - fm) : WGM;
        u.pm = fm + ((wgid % nig) % gsz); u.pn = (wgid % nig) / gsz; return true;
    }
    __device__ __forceinline__ void a_ready(const Unit&) const {}
    __device__ __forceinline__ void done(const Unit&) const {}
};
__device__ __forceinline__ unsigned cvt_pk_bf16(float lo, float hi) { unsigned r; asm volatile("v_cvt_pk_bf16_f32 %0, %1, %2" : "=v"(r) : "v"(lo), "v"(hi)); return r; }
template <class Epi, class Sched, bool ALIGN_EPI = false, bool SP2 = false>
__device__ __forceinline__ void gemm_phase(PG8_LAS unsigned char* lds, const Gemm g, const Sched& S, const Epi& E) {
    int tid_ = threadIdx.x; asm volatile("" : "+v"(tid_));
    const int tid = tid_, wid = __builtin_amdgcn_readfirstlane(tid >> 6), lane = tid & 63, wr = wid >> 2, wc = wid & 3, fr = lane & 15, fq = lane >> 4;
    const int K = g.K, nt = K / BK;
    unsigned voffA[2], voffB[2];
#pragma unroll
    for (int i = 0; i < 2; ++i) { int R, C; stage_rc(tid * 16 + i * 8192, R, C); const int Rb = Epi::PERM ? ((R & ~31) + perm32(R & 31)) : R;
        voffA[i] = (unsigned)(R * K + C) * 2u; voffB[i] = (unsigned)(Rb * K + C) * 2u; }
    const size_t kstep = (size_t)(BK * 2);
    const size_t hstep = (size_t)HALF * K * 2;
    const size_t tstep = 2 * hstep;
    const unsigned ldsw = (unsigned)wid * 1024u;
    const int aoff = lds_byte(wr * 64 + fr, fq * 8), boff = lds_byte(wc * 32 + fr, fq * 8);
#define PG8_SA(b, h) (((b) * 2 + (h)) * HTB)
#define PG8_SB(b, h) ((4 + (b) * 2 + (h)) * HTB)
#define PG8_STAGE(bufoff, gbase, voff) do { _Pragma("unroll") for (int _i = 0; _i < 2; ++_i) \
        __builtin_amdgcn_global_load_lds((const unsigned*)((const char*)(gbase) + (voff)[_i]), (PG8_LAS unsigned*)(lds + (bufoff) + ldsw + _i * 8192), 16, 0, 0); } while (0)
#define PG8_LDA(dst, b, h) do { _Pragma("unroll") for (int m = 0; m < 4; ++m) _Pragma("unroll") for (int k = 0; k < 2; ++k) dst[m][k] = *(const PG8_LAS bf16x8*)(lds + PG8_SA(b, h) + aoff + m * 2048 + k * 1024); } while (0)
#define PG8_LDB(dst, b, h) do { _Pragma("unroll") for (int n = 0; n < 2; ++n) _Pragma("unroll") for (int k = 0; k < 2; ++k) dst[n][k] = *(const PG8_LAS bf16x8*)(lds + PG8_SB(b, h) + boff + n * 2048 + k * 1024); } while (0)
#define PG8_MMA(ai, bj, At, Bt) do { __builtin_amdgcn_s_setprio(1); _Pragma("unroll") for (int m = 0; m < 4; ++m) _Pragma("unroll") for (int n = 0; n < 2; ++n) _Pragma("unroll") for (int k = 0; k < 2; ++k) \
        acc[ai][bj][m][n] = __builtin_amdgcn_mfma_f32_16x16x32_bf16(Bt[n][k], At[m][k], acc[ai][bj][m][n], 0, 0, 0); __builtin_amdgcn_s_setprio(0); } while (0)
#define PG8_WAIT_V(n) asm volatile("s_waitcnt vmcnt(" #n ")" ::: "memory")
#define PG8_WAIT_L(n) asm volatile("s_waitcnt lgkmcnt(" #n ")" ::: "memory")
#define PG8_BAR __builtin_amdgcn_s_barrier()
#define PG8_SCHED __builtin_amdgcn_sched_barrier(0)
    Unit cur, nxt; int ui = 0;
    if (!S.next(0, cur)) return;
    f32x4 acc[2][2][4][2];
#pragma unroll
    for (int a = 0; a < 2; ++a)
#pragma unroll
        for (int b = 0; b < 2; ++b)
#pragma unroll
            for (int m = 0; m < 4; ++m)
#pragma unroll
                for (int n = 0; n < 2; ++n) acc[a][b][m][n] = (f32x4){0.f, 0.f, 0.f, 0.f};
    bf16x8 At[4][2], B0[2][2], B1[2][2];
    const char* cA = (const char*)g.A + (size_t)cur.pm * tstep; const char* cB = (const char*)g.Bt + (size_t)cur.pn * tstep;
    S.a_ready(cur);
    if constexpr (SP2) {
        PG8_STAGE(PG8_SB(0, 0), cB, voffB); PG8_STAGE(PG8_SB(0, 1), cB + hstep, voffB); PG8_STAGE(PG8_SA(0, 0), cA, voffA); PG8_STAGE(PG8_SA(0, 1), cA + hstep, voffA);
        if (wr == 1) PG8_BAR;
        PG8_WAIT_V(2); PG8_BAR;
        PG8_STAGE(PG8_SB(1, 0), cB + kstep, voffB); PG8_STAGE(PG8_SA(1, 0), cA + kstep, voffA); PG8_STAGE(PG8_SB(1, 1), cB + hstep + kstep, voffB);
        PG8_WAIT_V(6); PG8_BAR;
    } else {
        PG8_STAGE(PG8_SB(0, 0), cB, voffB); PG8_STAGE(PG8_SA(0, 0), cA, voffA); PG8_STAGE(PG8_SB(0, 1), cB + hstep, voffB); PG8_STAGE(PG8_SA(0, 1), cA + hstep, voffA);
        if (wr == 1) PG8_BAR;
        PG8_WAIT_V(4); PG8_BAR;
        PG8_STAGE(PG8_SB(1, 0), cB + kstep, voffB); PG8_STAGE(PG8_SA(1, 0), cA + kstep, voffA); PG8_STAGE(PG8_SB(1, 1), cB + hstep + kstep, voffB);
        PG8_WAIT_V(6); PG8_BAR;
    }
    for (;;) {
        const bool has_next = S.next(ui + 1, nxt);
        const char* nA = has_next ? (const char*)g.A + (size_t)nxt.pm * tstep : cA; const char* nB = has_next ? (const char*)g.Bt + (size_t)nxt.pn * tstep : cB;
        for (int t = 0; t < nt; t += 2) {
            const bool last = (t == nt - 2);
            const char* a1 = cA + (size_t)(t + 1) * kstep;
            const char* a2 = last ? nA : cA + (size_t)(t + 2) * kstep; const char* b2 = last ? nB : cB + (size_t)(t + 2) * kstep;
            const char* a3 = a2 + kstep; const char* b3 = b2 + kstep;
            if (last && has_next) S.a_ready(nxt);
            if constexpr (Epi::MIDK) { if (t == nt / 2) E.mid(acc, cur, wr, wc, fr, fq); }
            if constexpr (SP2) {
            PG8_LDB(B0, 0, 0); PG8_LDB(B1, 0, 1); PG8_SCHED; PG8_LDA(At, 0, 0); PG8_STAGE(PG8_SA(1, 1), a1 + hstep, voffA);
            PG8_WAIT_V(8); PG8_WAIT_L(0); PG8_BAR; PG8_MMA(0, 0, At, B0); PG8_MMA(0, 1, At, B1); PG8_BAR; PG8_SCHED;
            PG8_LDA(At, 0, 1); PG8_STAGE(PG8_SB(0, 0), b2, voffB); PG8_STAGE(PG8_SB(0, 1), b2 + hstep, voffB); PG8_STAGE(PG8_SA(0, 0), a2, voffA);
            PG8_WAIT_V(8); PG8_WAIT_L(0); PG8_BAR; PG8_MMA(1, 0, At, B0); PG8_MMA(1, 1, At, B1); PG8_BAR; PG8_SCHED;
            PG8_LDB(B0, 1, 0); PG8_LDB(B1, 1, 1); PG8_SCHED; PG8_LDA(At, 1, 0); PG8_STAGE(PG8_SA(0, 1), a2 + hstep, voffA);
            PG8_WAIT_V(8); PG8_WAIT_L(0); PG8_BAR; PG8_MMA(0, 0, At, B0); PG8_MMA(0, 1, At, B1); PG8_BAR; PG8_SCHED;
            PG8_LDA(At, 1, 1); PG8_STAGE(PG8_SB(1, 0), b3, voffB); PG8_STAGE(PG8_SB(1, 1), b3 + hstep, voffB); PG8_STAGE(PG8_SA(1, 0), a3, voffA);
            PG8_WAIT_V(8); PG8_WAIT_L(0); PG8_BAR; PG8_MMA(1, 0, At, B0); PG8_MMA(1, 1, At, B1); PG8_BAR; PG8_SCHED;
            } else {
            PG8_LDB(B0, 0, 0); PG8_SCHED; PG8_LDA(At, 0, 0); PG8_STAGE(PG8_SA(1, 1), a1 + hstep, voffA);
            PG8_WAIT_L(8); PG8_BAR; PG8_WAIT_L(0); PG8_MMA(0, 0, At, B0); PG8_BAR; PG8_SCHED;
            PG8_LDB(B1, 0, 1); PG8_STAGE(PG8_SB(0, 0), b2, voffB);
            PG8_BAR; PG8_WAIT_L(0); PG8_MMA(0, 1, At, B1); PG8_BAR;
            PG8_LDA(At, 0, 1); PG8_STAGE(PG8_SA(0, 0), a2, voffA);
            PG8_BAR; PG8_WAIT_L(0); PG8_MMA(1, 0, At, B0); PG8_BAR; PG8_SCHED;
            PG8_STAGE(PG8_SB(0, 1), b2 + hstep, voffB);
            PG8_WAIT_V(6); PG8_BAR; PG8_MMA(1, 1, At, B1); PG8_BAR;
            PG8_LDB(B0, 1, 0); PG8_SCHED; PG8_LDA(At, 1, 0); PG8_STAGE(PG8_SA(0, 1), a2 + hstep, voffA);
            PG8_WAIT_L(8); PG8_BAR; PG8_WAIT_L(0); PG8_MMA(0, 0, At, B0); PG8_BAR; PG8_SCHED;
            PG8_LDB(B1, 1, 1); PG8_STAGE(PG8_SB(1, 0), b3, voffB);
            PG8_BAR; PG8_WAIT_L(0); PG8_MMA(0, 1, At, B1); PG8_BAR;
            PG8_LDA(At, 1, 1); PG8_STAGE(PG8_SA(1, 0), a3, voffA);
            PG8_BAR; PG8_WAIT_L(0); PG8_MMA(1, 0, At, B0); PG8_BAR; PG8_SCHED;
            PG8_STAGE(PG8_SB(1, 1), b3 + hstep, voffB);
            PG8_WAIT_V(6); PG8_BAR; PG8_MMA(1, 1, At, B1); PG8_BAR;
            }
        }
        if constexpr (ALIGN_EPI) { if (wr == 0) PG8_BAR; }
        if constexpr (!Epi::AFTER_DRAIN) { E(acc, cur, wr, wc, fr, fq); S.done(cur); }
        if (!has_next) break;
#pragma unroll
        for (int a = 0; a < 2; ++a)
#pragma unroll
            for (int b = 0; b < 2; ++b)
#pragma unroll
                for (int m = 0; m < 4; ++m)
#pragma unroll
                    for (int n = 0; n < 2; ++n) acc[a][b][m][n] = (f32x4){0.f, 0.f, 0.f, 0.f};
        cur = nxt; cA = nA; cB = nB; ++ui;
        if constexpr (ALIGN_EPI) { if (wr == 1) PG8_BAR; }
    }
    PG8_WAIT_V(0);
    if constexpr (!ALIGN_EPI) { if (wr == 0) PG8_BAR; }
    PG8_BAR;
    if constexpr (Epi::AFTER_DRAIN) { E.fused(acc, cur, wr, wc, fr, fq, lds, wid, lane); S.done(cur); }
#undef PG8_SA
#undef PG8_SB
#undef PG8_STAGE
#undef PG8_LDA
#undef PG8_LDB
#undef PG8_MMA
#undef PG8_WAIT_V
#undef PG8_WAIT_L
#undef PG8_BAR
#undef PG8_SCHED
}
}
namespace mk {
constexpr int D = 1024, SEQ = 8192, NBMAX = 4, NH = 4, DIN = 5152, NE = 32, DE = 512, DEPTH = 2;
constexpr int NT_IN = 22, NIN = NT_IN * 256;
constexpr int NWAVES = 8, NTHR = 512;
constexpr float LOG2E = 1.4426950408889634f, QSCALE = 0.125f * LOG2E, RMS_EPS = 1e-6f;
constexpr int O_GQ = 0, O_GK = 256, O_GV = 512, O_GG = 1024, O_LRF = 1536, O_LRB = 1552, O_DQ = 1568, O_DK = 2080, O_DV = 2592, O_GA = 3104, O_GB = 4128;
typedef unsigned short bf16;
typedef unsigned u32x4 __attribute__((ext_vector_type(4)));
typedef unsigned u32x2 __attribute__((ext_vector_type(2)));
typedef float f32x4 __attribute__((ext_vector_type(4)));
typedef float f32x16 __attribute__((ext_vector_type(16)));
typedef short bf16x8 __attribute__((ext_vector_type(8)));
typedef short s16x4 __attribute__((ext_vector_type(4)));
#define LAS __attribute__((address_space(3)))
#define GAS __attribute__((address_space(1)))
#define LDS_WAIT() asm volatile("s_waitcnt lgkmcnt(0)" ::: "memory")
#define VM_WAIT() asm volatile("s_waitcnt vmcnt(0)" ::: "memory")

constexpr size_t MiB = 1u << 20;
constexpr size_t CTL_BYTES = 256 * 1024;
constexpr int CW_BAR = 4096;
constexpr int CW_CNT = 32768;
constexpr size_t OFF_MOD = 256 * 1024, OFF_TAB = 512 * 1024;
constexpr size_t OFF_WIN = 1 * MiB, SZ_WIN = (size_t)DEPTH * NIN * D * 2;
constexpr size_t OFF_WAB = OFF_WIN + SZ_WIN, SZ_WAB = (size_t)DEPTH * D * D * 2;
constexpr size_t OFF_WO = OFF_WAB + SZ_WAB, SZ_WO = SZ_WAB;
constexpr size_t OFF_WR = OFF_WO + SZ_WO, SZ_WR = (size_t)DEPTH * 256 * D * 2;
constexpr size_t OFF_W1 = OFF_WR + SZ_WR, SZ_W1 = (size_t)DEPTH * NE * 1024 * D * 2;
constexpr size_t OFF_W2 = OFF_W1 + SZ_W1, SZ_W2 = (size_t)DEPTH * NE * D * DE * 2;
constexpr size_t OFF_ACT = 225 * MiB;
static_assert(OFF_W2 + SZ_W2 <= OFF_ACT, "weights fit");
struct WS {
    unsigned* ctl; float* mod; float* tab;
    bf16 *win, *wab, *wo, *wr, *w1, *w2;
    bf16 *H, *OAB; int* eid; float* gate; int* rank; int* pos; int* tilee; int* segp;
    bf16 *GQ, *GK, *GV, *SG; float *LGF, *LGB; bf16 *DQ, *DK, *DV, *SGA, *SGB; float* KVT; float* DEC; bf16* MERGED;
    bf16 *XS, *ACT, *YS; float* LOGITS; float* gsort;
    size_t end;
};
__host__ __device__ inline WS ws_map(unsigned char* b, int nb) {
    WS w; const size_t T = (size_t)nb * SEQ;
    w.ctl = (unsigned*)b; w.mod = (float*)(b + OFF_MOD); w.tab = (float*)(b + OFF_TAB);
    w.win = (bf16*)(b + OFF_WIN); w.wab = (bf16*)(b + OFF_WAB); w.wo = (bf16*)(b + OFF_WO); w.wr = (bf16*)(b + OFF_WR); w.w1 = (bf16*)(b + OFF_W1); w.w2 = (bf16*)(b + OFF_W2);
    size_t o = OFF_ACT;
    auto take = [&](size_t bytes) { unsigned char* p = b + o; o += (bytes + 255) & ~(size_t)255; return p; };
    w.H = (bf16*)take(T * 2048); w.OAB = (bf16*)take(T * 2048);
    w.eid = (int*)take(T * 8); w.gate = (float*)take(T * 8); w.rank = (int*)take(T * 8); w.pos = (int*)take(T * 8); w.tilee = (int*)take(4096); w.segp = (int*)take(1024);
    const size_t u0 = o;
    w.GQ = (bf16*)take(T * 512); w.GK = (bf16*)take(T * 512); w.GV = (bf16*)take(T * 1024); w.SG = (bf16*)take(T * 1024);
    w.LGF = (float*)take(T * 1024); w.LGB = (float*)take(T * 1024);
    w.DQ = (bf16*)take(T * 1024); w.DK = (bf16*)take(T * 1024); w.DV = (bf16*)take(T * 1024); w.SGA = (bf16*)take(T * 2048); w.SGB = (bf16*)take(T * 2048);
    w.KVT = (float*)take(T * 4096); w.MERGED = (bf16*)w.KVT; w.DEC = (float*)take(T * 32);
    const size_t e1 = o; o = u0;
    const size_t R = 2 * T + 32 * 256;
    w.XS = (bf16*)take(R * 2048); w.ACT = (bf16*)take(R * 1024); w.YS = (bf16*)take(R * 2048); w.LOGITS = (float*)take(T * 256); w.gsort = (float*)take(R * 4);
    w.end = o > e1 ? o : e1;
    return w;
}

__device__ __forceinline__ unsigned cvt_pk(float lo, float hi) { unsigned r; asm volatile("v_cvt_pk_bf16_f32 %0, %1, %2" : "=v"(r) : "v"(lo), "v"(hi)); return r; }
__device__ __forceinline__ float bf2f(unsigned short b) { return __uint_as_float(((unsigned)b) << 16); }
__device__ __forceinline__ float bflo(unsigned w) { return __uint_as_float(w << 16); }
__device__ __forceinline__ float bfhi(unsigned w) { return __uint_as_float(w & 0xffff0000u); }
__device__ __forceinline__ float fsigmoid(float x) { return __builtin_amdgcn_rcpf(1.f + __expf(-x)); }
__device__ __forceinline__ float fsilu(float x) { return x * fsigmoid(x); }
__device__ __forceinline__ float wave_sum(float v) {
#pragma unroll
    for (int o = 1; o < 64; o <<= 1) v += __shfl_xor(v, o);
    return v;
}
__device__ __forceinline__ int t5_bucket(int rel) {
    int ret = rel > 0 ? 16 : 0; int n = rel < 0 ? -rel : rel;
    if (n < 8) return ret + n;
    return ret + 8 + (n >= 12) + (n >= 16) + (n >= 23) + (n >= 32) + (n >= 46) + (n >= 64) + (n >= 91);
}

#define XB_TMO      128
#define XB_XCNT(j)  (256  + 64 * (j))
#define XB_XSUB(j)  (1280 + 64 * (j))
#define XB_XGEN(j)  (2304 + 64 * (j))
#define XB_TOP      3328
#define XB_TOPGEN   3392
#define XCD_BAR_WORDS 3456
#define XB_SPIN_CAP (1u << 18)
__device__ __forceinline__ unsigned xb_ld(unsigned* p)              { return __hip_atomic_load(p, __ATOMIC_RELAXED, __HIP_MEMORY_SCOPE_AGENT); }
__device__ __forceinline__ unsigned xb_add(unsigned* p, unsigned v) { return __hip_atomic_fetch_add(p, v, __ATOMIC_RELAXED, __HIP_MEMORY_SCOPE_AGENT); }
__device__ __forceinline__ unsigned xb_xcc_id() { return (unsigned)__builtin_amdgcn_s_getreg((3 << 11) | 20) & 0xFu; }
#define XB_SPIN(cond, bar) do { unsigned _sp = 0; while (cond) { __builtin_amdgcn_s_sleep(1); \
    if ((++_sp & 255u) == 0u) { if (xb_ld(&(bar)[XB_TMO])) break; if (_sp > XB_SPIN_CAP) { atomicAdd(&(bar)[XB_TMO], 1u); break; } } } } while (0)
struct XcdBarrier { unsigned* bar; unsigned x; volatile LAS unsigned* st; };
__device__ __forceinline__ XcdBarrier xcd_barrier_post(unsigned* bar, volatile LAS unsigned* st) {
    XcdBarrier b; b.bar = bar; b.x = xb_xcc_id(); b.st = st;
    if (threadIdx.x == 0) (void)xb_add(&bar[XB_XCNT(b.x)], 1u);
    return b;
}
__device__ __forceinline__ void xcd_barrier_complete(unsigned* bar, unsigned x, unsigned& nloc, unsigned& nx) {
    const unsigned G = gridDim.x * gridDim.y * gridDim.z;
    unsigned sum, cnt, mine, sp = 0u;
    for (;;) {
        sum = 0u; cnt = 0u; mine = 0u;
#pragma unroll
        for (unsigned j = 0; j < 16; ++j) { const unsigned c = xb_ld(&bar[XB_XCNT(j)]); sum += c; cnt += (c > 0u) ? 1u : 0u; mine = (j == x) ? c : mine; }
        if (sum == G) break;
        __builtin_amdgcn_s_sleep(1);
        if ((++sp & 255u) == 0u) { if (xb_ld(&bar[XB_TMO])) break; if (sp > XB_SPIN_CAP) { atomicAdd(&bar[XB_TMO], 1u); break; } }
    }
    nloc = mine > 0u ? mine : 1u; nx = cnt > 0u ? cnt : 1u;
}
__device__ __forceinline__ void xcd_barrier(const XcdBarrier& b) {
    asm volatile("s_waitcnt vmcnt(0)" ::: "memory");
    __syncthreads();
    if (threadIdx.x == 0) {
        unsigned* bar = b.bar;
        __builtin_amdgcn_s_waitcnt(0);
        unsigned nloc = b.st[0], nx = b.st[1];
        if (nloc == 0u) { xcd_barrier_complete(bar, b.x, nloc, nx); b.st[0] = nloc; b.st[1] = nx; }
        const unsigned old = xb_add(&bar[XB_XSUB(b.x)], 1u);
        const unsigned gen = old / nloc;
        if (old + 1u == (gen + 1u) * nloc) {
            __builtin_amdgcn_fence(__ATOMIC_RELEASE, "agent");
            asm volatile("s_waitcnt vmcnt(0)" ::: "memory");
            const unsigned og = xb_add(&bar[XB_TOP], 1u);
            const unsigned tg = og / nx;
            if (og + 1u == (tg + 1u) * nx) xb_add(&bar[XB_TOPGEN], 1u);
            else XB_SPIN(xb_ld(&bar[XB_TOPGEN]) == tg, bar);
            __builtin_amdgcn_fence(__ATOMIC_ACQUIRE, "agent");
            xb_add(&bar[XB_XGEN(b.x)], 1u);
            asm volatile("s_waitcnt vmcnt(0)" ::: "memory");
        } else {
            XB_SPIN(xb_ld(&bar[XB_XGEN(b.x)]) == gen, bar);
            __builtin_amdgcn_fence(__ATOMIC_ACQUIRE, "agent");
            asm volatile("s_waitcnt vmcnt(0)" ::: "memory");
        }
    }
    __syncthreads();
}

struct Args { const float* in[24]; float* out; unsigned char* ws; int nb, ph_lo, ph_hi, li; };
struct Frame {
    LAS unsigned char* lds; int tid, lane, wave, G, bid, nb, T; unsigned char* ws; const Args* a; float* xbuf;
};
__device__ __forceinline__ void refresh(Frame& F) { int t = threadIdx.x; asm volatile("" : "+v"(t)); F.tid = t; F.lane = t & 63; F.wave = __builtin_amdgcn_readfirstlane(t >> 6); }
constexpr int LDS_BYTES = 160 * 1024 - 64 * 0;
constexpr int LDS_MISC = 160 * 1024 - 256;

__device__ __forceinline__ void tr_item(const float* src, int lds_, int ks0, int c0, bf16* dst, int ldd, int r0, int kd0, LAS float* scr, int lane) {
#pragma unroll 8
    for (int i = 0; i < 32; ++i) { const int kk = 2 * i + (lane >> 5); scr[kk * 33 + (lane & 31)] = src[(size_t)(ks0 + kk) * lds_ + c0 + (lane & 31)]; }
    LDS_WAIT(); asm volatile("" ::: "memory");
    const int c = lane & 7;
#pragma unroll
    for (int j = 0; j < 4; ++j) { const int n = (lane >> 3) + 8 * j; const LAS float* s = scr + (8 * c) * 33 + n;
        u32x4 o; o.x = cvt_pk(s[0 * 33], s[1 * 33]); o.y = cvt_pk(s[2 * 33], s[3 * 33]); o.z = cvt_pk(s[4 * 33], s[5 * 33]); o.w = cvt_pk(s[6 * 33], s[7 * 33]);
        *(u32x4*)(dst + (size_t)(r0 + n) * ldd + kd0 + 8 * c) = o; }
    LDS_WAIT(); asm volatile("" ::: "memory");
}
__device__ __forceinline__ int win_src_col(int tile, int p0) {
    const int bj = p0 >> 7, wc = (p0 >> 5) & 3; const int L = 64 * wc + 32 * bj;
    switch (tile) {
        case 0: return O_GQ + p0; case 1: return O_GK + p0;
        case 2: case 3: return O_GV + (tile - 2) * 256 + p0;
        case 4: case 5: return O_GG + (tile - 4) * 256 + p0;
        case 8: case 9: return O_DQ + (tile - 8) * 256 + L;
        case 10: case 11: return O_DK + (tile - 10) * 256 + L;
        case 12: case 13: return O_DV + (tile - 12) * 256 + p0;
        case 14: case 15: case 16: case 17: return O_GA + (tile - 14) * 256 + p0;
        default: return O_GB + (tile - 18) * 256 + p0;
    }
}
__device__ __forceinline__ void p0_prologue(Frame& F) {
    refresh(F);
    const WS W = ws_map(F.ws, F.nb); const float* const* IN_ = F.a->in;
    const float* c_in = IN_[1]; const float* w_ada = IN_[2]; const float* b_ada = IN_[3];
    {
        LAS float* red = (LAS float*)F.lds;
        for (int it = F.bid; it < DEPTH * 96; it += F.G) {
            const int l = it / 96, j = (it % 96) * 64 + F.lane;
            const float* w = w_ada + (size_t)l * D * 6 * D + j;
            float a0 = 0.f, a1 = 0.f, a2 = 0.f, a3 = 0.f;
            const int kbeg = F.wave * 128;
#pragma unroll 16
            for (int k = kbeg; k < kbeg + 128; ++k) { const float wv = w[(size_t)k * 6 * D];
                const float c0 = c_in[k], c1 = c_in[D + k], c2 = c_in[2 * D + k], c3 = c_in[3 * D + k];
                a0 += fsilu(c0) * wv; a1 += fsilu(c1) * wv; a2 += fsilu(c2) * wv; a3 += fsilu(c3) * wv; }
            red[(F.wave * 4 + 0) * 64 + F.lane] = a0; red[(F.wave * 4 + 1) * 64 + F.lane] = a1; red[(F.wave * 4 + 2) * 64 + F.lane] = a2; red[(F.wave * 4 + 3) * 64 + F.lane] = a3;
            __syncthreads();
            if (F.tid < 256) { const int b = F.tid >> 6, jj = F.tid & 63; float s = 0.f;
#pragma unroll
                for (int wv = 0; wv < 8; ++wv) s += red[(wv * 4 + b) * 64 + jj];
                const int jc = (it % 96) * 64 + jj;
                W.mod[((size_t)l * NBMAX + b) * 6 * D + jc] = s + b_ada[l * 6 * D + jc]; }
            __syncthreads();
        }
    }
    if (F.bid == 0) {
        const float* rb = IN_[14];
        for (int i = F.tid; i < 1024; i += NTHR) { const int h = i >> 8, rel = (i & 255) - 128; W.tab[i] = (rb[t5_bucket(rel) * 4 + h] - rb[31 * 4 + h]) * LOG2E; }
        if (F.tid < 4) W.tab[1024 + F.tid] = __expf(rb[15 * 4 + F.tid] - rb[31 * 4 + F.tid]);
        if (F.tid >= 64 && F.tid < 64 + DEPTH) { const int l = F.tid - 64; const float* lv = IN_[12] + l * 256; float s1 = 0.f, s2 = 0.f;
            for (int i = 0; i < 64; ++i) { s1 += lv[i] * lv[64 + i]; s2 += lv[128 + i] * lv[192 + i]; }
            W.tab[1032 + l] = expf(s1) - expf(s2) + (0.8f - 0.6f * expf(-0.3f * (float)l)); }
    }
    __syncthreads();
    LAS float* scr = (LAS float*)(F.lds + F.wave * 16384);
    const int gw = F.bid * NWAVES + F.wave, NGW = F.G * NWAVES;
    constexpr int I_IN = (NIN / 32) * 16, I_AB = 32 * 16, I_O = 32 * 16, I_1 = NE * 32 * 16, I_2 = NE * 32 * 8;
    constexpr int PER_L = I_IN + I_AB + I_O + I_1 + I_2;
    for (int it = gw; it < DEPTH * PER_L; it += NGW) {
        const int l = it / PER_L; int r = it % PER_L;
        if (r < I_IN) { const int rb = r / 16, kb = r % 16, R = rb * 32, tile = R >> 8, p0 = R & 255;
            if (tile == 6 || tile == 7) continue;
            tr_item(IN_[6] + (size_t)l * D * DIN, DIN, kb * 64, win_src_col(tile, p0), W.win + (size_t)l * NIN * D, D, R, kb * 64, scr, F.lane); continue; }
        r -= I_IN;
        if (r < I_AB) { const int rb = r / 16, kb = r % 16;
            if (kb < 8) tr_item(IN_[15] + (size_t)l * 512 * D, D, kb * 64, rb * 32, W.wab + (size_t)l * D * D, 512, rb * 32, kb * 64, scr, F.lane);
            else tr_item(IN_[16] + (size_t)l * 512 * D, D, (kb - 8) * 64, rb * 32, W.wab + (size_t)l * D * D + (size_t)1024 * 512, 512, rb * 32, (kb - 8) * 64, scr, F.lane);
            continue; }
        r -= I_AB;
        if (r < I_O) { const int rb = r / 16, kb = r % 16; tr_item(IN_[17] + (size_t)l * D * D, D, kb * 64, rb * 32, W.wo + (size_t)l * D * D, D, rb * 32, kb * 64, scr, F.lane); continue; }
        r -= I_O;
        if (r < I_1) { const int e = r / 512, q = r % 512, rb = q / 16, kb = q % 16, R = rb * 32, pn = R >> 8, p = R & 255;
            const int col = (p < 128) ? (128 * pn + p) : (512 + 128 * pn + p - 128);
            tr_item(IN_[22] + ((size_t)l * NE + e) * D * 1024, 1024, kb * 64, col, W.w1 + ((size_t)l * NE + e) * 1024 * D, D, R, kb * 64, scr, F.lane); continue; }
        r -= I_1;
        { const int e = r / 256, q = r % 256, rb = q / 8, kb = q % 8;
          tr_item(IN_[23] + ((size_t)l * NE + e) * DE * D, D, kb * 64, rb * 32, W.w2 + ((size_t)l * NE + e) * D * DE, DE, rb * 32, kb * 64, scr, F.lane); }
    }
    for (int it = gw; it < DEPTH * 2 * 8 * 16; it += NGW) {
        const int l = it >> 8, dir = (it >> 7) & 1, nbk = (it >> 4) & 7, kb = it & 15; const int k = kb * 64 + F.lane;
        const float* wi = IN_[6] + (size_t)l * D * DIN + (size_t)k * DIN + (dir ? O_LRB : O_LRF);
        float wv[16];
#pragma unroll
        for (int r = 0; r < 16; ++r) wv[r] = wi[r];
        const float* wu = IN_[7] + ((size_t)l * 2 + dir) * 16 * 256;
        bf16* dst = W.win + (size_t)l * NIN * D + (size_t)((6 + dir) * 256) * D;
        for (int n = nbk * 32; n < nbk * 32 + 32; ++n) { float s = 0.f;
#pragma unroll
            for (int r = 0; r < 16; ++r) s += wv[r] * wu[r * 256 + n];
            dst[(size_t)n * D + k] = (bf16)(cvt_pk(s, 0.f) & 0xffffu); }
    }
    for (int it = gw * 64 + F.lane; it < DEPTH * 256 * 128; it += NGW * 64) {
        const int l = it / (256 * 128), q = it % (256 * 128), row = q >> 7, k0 = (q & 127) * 8;
        float v[8];
#pragma unroll
        for (int i = 0; i < 8; ++i) { float x = 0.f;
            if (row < 4) x = IN_[18][((size_t)l * D + k0 + i) * 4 + row]; else if (row < 36) x = IN_[20][((size_t)l * D + k0 + i) * 32 + row - 4];
            v[i] = x; }
        u32x4 o; o.x = cvt_pk(v[0], v[1]); o.y = cvt_pk(v[2], v[3]); o.z = cvt_pk(v[4], v[5]); o.w = cvt_pk(v[6], v[7]);
        *(u32x4*)(W.wr + ((size_t)l * 256 + row) * D + k0) = o;
    }
}

__device__ __forceinline__ void phase_norm(Frame& F, int l, int mode) {
    refresh(F);
    const WS W = ws_map(F.ws, F.nb); const float* const* IN_ = F.a->in;
    const int gw = F.bid * NWAVES + F.wave, NGW = F.G * NWAVES;
    const bool combine = (mode == 2) || (mode == 0 && l > 0);
    const int lp = (mode == 2) ? DEPTH - 1 : l - 1;
    const float* xsrc = (mode == 0 && l == 0) ? IN_[0] : F.xbuf;
    const float* ng = (mode == 1 ? IN_[5] : IN_[4]) + (size_t)(mode == 2 ? 0 : l) * D;
    for (int t = gw; t < F.T; t += NGW) {
        const int b = t / SEQ;
        const GAS f32x4* xr = (const GAS f32x4*)(xsrc + (size_t)t * D) + F.lane;
        f32x4 v[4];
#pragma unroll
        for (int j = 0; j < 4; ++j) v[j] = xr[64 * j];
        if (combine) {
            const float* g2 = W.mod + ((size_t)lp * NBMAX + b) * 6 * D + 5 * D;
            const int p0 = W.pos[t * 2], p1 = W.pos[t * 2 + 1];
            const GAS u32x2* y0 = (const GAS u32x2*)(W.YS + (size_t)p0 * D) + F.lane; const GAS u32x2* y1 = (const GAS u32x2*)(W.YS + (size_t)p1 * D) + F.lane;
#pragma unroll
            for (int j = 0; j < 4; ++j) { const u32x2 a = y0[64 * j], c = y1[64 * j]; const f32x4 g = *((const GAS f32x4*)g2 + F.lane + 64 * j);
                v[j].x += g.x * (bflo(a.x) + bflo(c.x)); v[j].y += g.y * (bfhi(a.x) + bfhi(c.x)); v[j].z += g.z * (bflo(a.y) + bflo(c.y)); v[j].w += g.w * (bfhi(a.y) + bfhi(c.y)); }
            GAS f32x4* xo = (GAS f32x4*)(F.xbuf + (size_t)t * D) + F.lane;
#pragma unroll
            for (int j = 0; j < 4; ++j) xo[64 * j] = v[j];
        }
        if (mode == 2) continue;
        float ss = 0.f;
#pragma unroll
        for (int j = 0; j < 4; ++j) ss += (v[j].x * v[j].x + v[j].y * v[j].y) + (v[j].z * v[j].z + v[j].w * v[j].w);
        const float rstd = rsqrtf(wave_sum(ss) * (1.f / D) + RMS_EPS);
        const float* md = W.mod + ((size_t)l * NBMAX + b) * 6 * D + (mode == 1 ? 3 * D : 0);
        GAS u32x2* ho = (GAS u32x2*)(W.H + (size_t)t * D) + F.lane;
#pragma unroll
        for (int j = 0; j < 4; ++j) { const f32x4 g = *((const GAS f32x4*)ng + F.lane + 64 * j), sh = *((const GAS f32x4*)md + F.lane + 64 * j), sc = *((const GAS f32x4*)(md + D) + F.lane + 64 * j);
            const float h0 = v[j].x * rstd * g.x * (1.f + sc.x) + sh.x, h1 = v[j].y * rstd * g.y * (1.f + sc.y) + sh.y, h2 = v[j].z * rstd * g.z * (1.f + sc.z) + sh.z, h3 = v[j].w * rstd * g.w * (1.f + sc.w) + sh.w;
            u32x2 o; o.x = cvt_pk(h0, h1); o.y = cvt_pk(h2, h3); ho[64 * j] = o; }
    }
}
typedef pg8::Unit Unit;
__device__ __forceinline__ u32x4 pack8(const f32x4& a, const f32x4& b) { u32x4 w; w.x = cvt_pk(a[0], a[1]); w.y = cvt_pk(a[2], a[3]); w.z = cvt_pk(b[0], b[1]); w.w = cvt_pk(b[2], b[3]); return w; }

struct EpiIn {
    static constexpr bool PERM = true, AFTER_DRAIN = false, MIDK = false;
    bf16 *GQ, *GK, *GV, *SG; float *LGF, *LGB; bf16 *DQ, *DK, *DV, *SGA, *SGB; const float* b_up; const float* qg; const float* kg;
    __device__ __forceinline__ void operator()(const f32x4 (&acc)[2][2][4][2], const Unit& u, int wr, int wc, int fr, int fq) const {
        const int pn = u.pn; const int row0 = u.pm * 256 + wr * 64 + fr;
        if (pn >= 8 && pn <= 11) {
            const bool isk = pn >= 10; const int head = 2 * ((pn - 8) & 1) + (wc >> 1), c = wc & 1;
            const float* gv = isk ? kg : qg; const float sc = isk ? 1.f : QSCALE;
            f32x4 g[2][2];
#pragma unroll
            for (int bj = 0; bj < 2; ++bj)
#pragma unroll
                for (int n = 0; n < 2; ++n) g[bj][n] = *(const f32x4*)(gv + 32 * bj + 8 * fq + 4 * n);
#pragma unroll
            for (int ai = 0; ai < 2; ++ai)
#pragma unroll
                for (int m = 0; m < 4; ++m) {
                    const int r = row0 + ai * 128 + m * 16, b = r / SEQ, s = r % SEQ;
                    float ss = 0.f;
#pragma unroll
                    for (int bj = 0; bj < 2; ++bj)
#pragma unroll
                        for (int n = 0; n < 2; ++n) { const f32x4 x = acc[ai][bj][m][n]; ss += (x[0] * x[0] + x[1] * x[1]) + (x[2] * x[2] + x[3] * x[3]); }
                    ss += __shfl_xor(ss, 16); ss += __shfl_xor(ss, 32);
                    const float rs = rsqrtf(ss * (1.f / 64.f) + RMS_EPS) * sc;
                    bf16* dst = (isk ? DK : DQ) + ((((size_t)b * NH + head) * 2 + c) * SEQ + s) * 64;
#pragma unroll
                    for (int bj = 0; bj < 2; ++bj) {
                        const f32x4 v0 = acc[ai][bj][m][0] * rs * g[bj][0], v1 = acc[ai][bj][m][1] * rs * g[bj][1];
                        int chunk = 4 * bj + fq; if (isk) chunk ^= ((s >> 1) & 7);
                        *(u32x4*)(dst + chunk * 8) = pack8(v0, v1);
                    }
                }
            return;
        }
#pragma unroll
        for (int ai = 0; ai < 2; ++ai)
#pragma unroll
            for (int m = 0; m < 4; ++m) {
                const int r = row0 + ai * 128 + m * 16;
#pragma unroll
                for (int bj = 0; bj < 2; ++bj) {
                    const int c0 = 128 * bj + 32 * wc + 8 * fq;
                    f32x4 v0 = acc[ai][bj][m][0], v1 = acc[ai][bj][m][1];
                    if (pn == 0) { *(u32x4*)(GQ + (size_t)r * 256 + c0) = pack8(v0 * 0.125f, v1 * 0.125f); }
                    else if (pn == 1) { *(u32x4*)(GK + (size_t)r * 256 + c0) = pack8(v0, v1); }
                    else if (pn <= 3) { *(u32x4*)(GV + (size_t)r * 512 + (pn - 2) * 256 + c0) = pack8(v0, v1); }
                    else if (pn <= 5) {
#pragma unroll
                        for (int i = 0; i < 4; ++i) { v0[i] = fsilu(v0[i]); v1[i] = fsilu(v1[i]); }
                        *(u32x4*)(SG + (size_t)r * 512 + (pn - 4) * 256 + c0) = pack8(v0, v1); }
                    else if (pn <= 7) {
                        const float* bu = b_up + (pn - 6) * 256 + c0; const f32x4 b0 = *(const f32x4*)bu, b1 = *(const f32x4*)(bu + 4);
#pragma unroll
                        for (int i = 0; i < 4; ++i) { float z = v0[i] + b0[i]; v0[i] = (fminf(z, 0.f) - __logf(1.f + __expf(-fabsf(z)))) * (1.f / 16.f);
                                                      z = v1[i] + b1[i]; v1[i] = (fminf(z, 0.f) - __logf(1.f + __expf(-fabsf(z)))) * (1.f / 16.f); }
                        float* o = (pn == 6 ? LGF : LGB) + (size_t)r * 256 + c0; *(f32x4*)o = v0; *(f32x4*)(o + 4) = v1; }
                    else if (pn <= 13) {
                        const int b = r / SEQ, s = r % SEQ, head = 2 * (pn - 12) + bj;
                        bf16* dst = DV + ((((size_t)b * NH + head) * (SEQ / 8) + (s >> 3)) * 4 + wc) * 256 + (s & 7) * 32 + 8 * fq;
                        *(u32x4*)dst = pack8(v0, v1); }
                    else {
#pragma unroll
                        for (int i = 0; i < 4; ++i) { v0[i] = fsigmoid(v0[i]); v1[i] = fsigmoid(v1[i]); }
                        bf16* base = (pn <= 17) ? SGA + (pn - 14) * 256 : SGB + (pn - 18) * 256;
                        *(u32x4*)(base + (size_t)r * D + c0) = pack8(v0, v1); }
                }
            }
    }
};

struct EpiMerge {
    static constexpr bool PERM = true, AFTER_DRAIN = false, MIDK = false;
    const bf16* SGA; const bf16* SGB; bf16* O; int nM;
    __device__ __forceinline__ void operator()(const f32x4 (&acc)[2][2][4][2], const Unit& u, int wr, int wc, int fr, int fq) const {
        const int sel = u.pn >> 2; const int row0 = (u.pm - sel * nM) * 256 + wr * 64 + fr, col0 = (u.pn & 3) * 256 + wc * 32 + 8 * fq;
        const bf16* G = sel ? SGB : SGA;
#pragma unroll
        for (int ai = 0; ai < 2; ++ai)
#pragma unroll
            for (int m = 0; m < 4; ++m) { const size_t off = (size_t)(row0 + ai * 128 + m * 16) * D + col0;
#pragma unroll
                for (int bj = 0; bj < 2; ++bj) { const u32x4 b = *(const u32x4*)(G + off + bj * 128);
                    f32x4 v0 = acc[ai][bj][m][0], v1 = acc[ai][bj][m][1];
                    v0[0] *= bflo(b.x); v0[1] *= bfhi(b.x); v0[2] *= bflo(b.y); v0[3] *= bfhi(b.y); v1[0] *= bflo(b.z); v1[1] *= bfhi(b.z); v1[2] *= bflo(b.w); v1[3] *= bfhi(b.w);
                    if (sel) { const u32x4 t = *(const u32x4*)(O + off + bj * 128);
                        v0[0] += bflo(t.x); v0[1] += bfhi(t.x); v0[2] += bflo(t.y); v0[3] += bfhi(t.y); v1[0] += bflo(t.z); v1[1] += bfhi(t.z); v1[2] += bflo(t.w); v1[3] += bfhi(t.w); }
                    *(u32x4*)(O + off + bj * 128) = pack8(v0, v1); }
                asm volatile("" ::: "memory"); }
    }
};
struct MergeOrder {
    pg8::StaticOrder so; int nM;
    __device__ __forceinline__ bool next(int i, Unit& u) const { Unit t; if (!so.next(i >> 1, t)) return false; const int sel = i & 1; u.pm = t.pm + sel * nM; u.pn = t.pn + sel * 4; return true; }
    __device__ __forceinline__ void a_ready(const Unit&) const {}
    __device__ __forceinline__ void done(const Unit&) const {}
};

struct EpiResid {
    static constexpr bool PERM = false, AFTER_DRAIN = false, MIDK = false;
    const float* xin; float* xout; const float* g1;
    __device__ __forceinline__ void operator()(const f32x4 (&acc)[2][2][4][2], const Unit& u, int wr, int wc, int fr, int fq) const {
        const int row0 = u.pm * 256 + wr * 64 + fr, col0 = u.pn * 256 + wc * 32 + 4 * fq;
        const int b = (u.pm * 256) / SEQ; const float* g = g1 + (size_t)b * 6 * D + col0;
        f32x4 gv[2][2];
#pragma unroll
        for (int bj = 0; bj < 2; ++bj)
#pragma unroll
            for (int n = 0; n < 2; ++n) gv[bj][n] = *(const f32x4*)(g + bj * 128 + n * 16);
#pragma unroll
        for (int ai = 0; ai < 2; ++ai)
#pragma unroll
            for (int m = 0; m < 4; ++m) { const size_t off = (size_t)(row0 + ai * 128 + m * 16) * D + col0;
#pragma unroll
                for (int bj = 0; bj < 2; ++bj)
#pragma unroll
                    for (int n = 0; n < 2; ++n) { const f32x4 xv = *(const f32x4*)(xin + off + bj * 128 + n * 16); *(f32x4*)(xout + off + bj * 128 + n * 16) = xv + gv[bj][n] * acc[ai][bj][m][n]; } }
    }
};

struct EpiLogits {
    static constexpr bool PERM = false, AFTER_DRAIN = false, MIDK = false;
    float* L;
    __device__ __forceinline__ void operator()(const f32x4 (&acc)[2][2][4][2], const Unit& u, int wr, int wc, int fr, int fq) const {
        if (wc >= 2) return;
        const int row0 = u.pm * 256 + wr * 64 + fr, col0 = wc * 32 + 4 * fq;
#pragma unroll
        for (int ai = 0; ai < 2; ++ai)
#pragma unroll
            for (int m = 0; m < 4; ++m)
#pragma unroll
                for (int n = 0; n < 2; ++n) *(f32x4*)(L + (size_t)(row0 + ai * 128 + m * 16) * 64 + col0 + n * 16) = acc[ai][0][m][n];
    }
};

struct EpiAct {
    static constexpr bool PERM = true, AFTER_DRAIN = false, MIDK = false;
    bf16* ACT;
    __device__ __forceinline__ void operator()(const f32x4 (&acc)[2][2][4][2], const Unit& u, int wr, int wc, int fr, int fq) const {
        const int row0 = u.pm * 256 + wr * 64 + fr, col0 = (u.pn & 3) * 128 + wc * 32 + 8 * fq;
#pragma unroll
        for (int ai = 0; ai < 2; ++ai)
#pragma unroll
            for (int m = 0; m < 4; ++m) { f32x4 v0, v1;
#pragma unroll
                for (int i = 0; i < 4; ++i) { v0[i] = fsilu(acc[ai][0][m][0][i]) * acc[ai][1][m][0][i]; v1[i] = fsilu(acc[ai][0][m][1][i]) * acc[ai][1][m][1][i]; }
                *(u32x4*)(ACT + (size_t)(row0 + ai * 128 + m * 16) * DE + col0) = pack8(v0, v1); }
    }
};
struct EpiYs {
    static constexpr bool PERM = true, AFTER_DRAIN = false, MIDK = false;
    bf16* YS; const float* gs;
    __device__ __forceinline__ void operator()(const f32x4 (&acc)[2][2][4][2], const Unit& u, int wr, int wc, int fr, int fq) const {
        const int row0 = u.pm * 256 + wr * 64 + fr, col0 = (u.pn & 3) * 256 + wc * 32 + 8 * fq;
#pragma unroll
        for (int ai = 0; ai < 2; ++ai)
#pragma unroll
            for (int m = 0; m < 4; ++m) { const int r = row0 + ai * 128 + m * 16; const float gt = gs[r];
#pragma unroll
                for (int bj = 0; bj < 2; ++bj) *(u32x4*)(YS + (size_t)r * D + col0 + bj * 128) = pack8(acc[ai][bj][m][0] * gt, acc[ai][bj][m][1] * gt); }
    }
};
struct GroupedOrder {
    const int* tilee; int U, G, c;
    __device__ __forceinline__ bool next(int i, Unit& u) const {
        int id;
        if ((G & 7) == 0) { const int gx = G >> 3, per = (U + 7) >> 3, n = i * gx + (c >> 3); if (n >= per) return false; id = (c & 7) * per + n; if (id >= U) return false; }
        else { id = i * G + c; if (id >= U) return false; }
        const int t = id >> 2; u.pm = t; u.pn = tilee[t] * 4 + (id & 3); return true;
    }
    __device__ __forceinline__ void a_ready(const Unit&) const {}
    __device__ __forceinline__ void done(const Unit&) const {}
};
constexpr int AT_KR = 0, AT_VR = 65536, AT_TAB = 131072, AT_SLOT = 16384;
__device__ __forceinline__ int crow(int r, int hi) { return (r & 3) + 8 * (r >> 2) + 4 * hi; }
__device__ __forceinline__ s16x4 vtr(const LAS unsigned char* p) {
    typedef short v4i16_t __attribute__((ext_vector_type(4)));
    return __builtin_bit_cast(s16x4, __builtin_amdgcn_ds_read_tr16_b64_v4i16((LAS v4i16_t*)p));
}
__device__ __forceinline__ bf16x8 pk8(const f32x16& s, int o) {
    u32x4 w; w.x = cvt_pk(s[o + 0], s[o + 1]); w.y = cvt_pk(s[o + 2], s[o + 3]); w.z = cvt_pk(s[o + 4], s[o + 5]); w.w = cvt_pk(s[o + 6], s[o + 7]);
    return __builtin_bit_cast(bf16x8, w);
}
struct AttnState { f32x16 o[4]; float lsum; };

template <int SLOT>
__device__ __forceinline__ void attn_kread(bf16x8 (&kf)[8], const unsigned (&kaddr)[4]) {
#pragma unroll
    for (int s = 0; s < 4; ++s) {
        asm volatile("ds_read_b128 %0, %1 offset:%c2" : "=&v"(kf[2 * s]) : "v"(kaddr[s]), "i"(SLOT * AT_SLOT) : "memory");
        asm volatile("ds_read_b128 %0, %1 offset:%c2" : "=&v"(kf[2 * s + 1]) : "v"(kaddr[s]), "i"(SLOT * AT_SLOT + 4096) : "memory");
    }
}
__device__ __forceinline__ void attn_qk(f32x16& s0, f32x16& s1, const bf16x8 (&kf)[8], const bf16x8 (&qf)[4]) {
    s0 = f32x16{}; s1 = f32x16{};
#pragma unroll
    for (int s = 0; s < 4; ++s) {
        s0 = __builtin_amdgcn_mfma_f32_32x32x16_bf16(kf[2 * s], qf[s], s0, 0, 0, 0);
        s1 = __builtin_amdgcn_mfma_f32_32x32x16_bf16(kf[2 * s + 1], qf[s], s1, 0, 0, 0);
    }
}
__device__ __forceinline__ void attn_bias(f32x16& s0, f32x16& s1, int relbase, const LAS float* tabh) {
#pragma unroll
    for (int r = 0; r < 16; ++r) {
        int i0 = relbase + (r & 3) + 8 * (r >> 2); int i1 = i0 + 32;
        i0 = i0 < 0 ? 0 : (i0 > 255 ? 255 : i0); i1 = i1 < 0 ? 0 : (i1 > 255 ? 255 : i1);
        s0[r] += tabh[i0]; s1[r] += tabh[i1];
    }
}
template <bool NOEXP, int J>
__device__ __forceinline__ void attn_exp_chunk(f32x16& s0, f32x16& s1, float& lsum) {
    float ls = 0.f;
#pragma unroll
    for (int r = 4 * J; r < 4 * J + 4; ++r) { if (!NOEXP) { s0[r] = __builtin_amdgcn_exp2f(s0[r]); s1[r] = __builtin_amdgcn_exp2f(s1[r]); } ls += s0[r] + s1[r]; }
    lsum += ls;
}
#define AT_VREAD(buf, dt) do { _Pragma("unroll") for (int ks = 0; ks < 4; ++ks) { \
        asm volatile("ds_read_b64_tr_b16 %0, %1 offset:%c2" : "=&v"(lo[buf][ks]) : "v"(va), "i"((2 * ks) * 2048 + (dt) * 512) : "memory"); \
        asm volatile("ds_read_b64_tr_b16 %0, %1 offset:%c2" : "=&v"(hi[buf][ks]) : "v"(va), "i"((2 * ks + 1) * 2048 + (dt) * 512) : "memory"); } } while (0)
#define AT_VMMA(buf, dt) do { _Pragma("unroll") for (int ks = 0; ks < 4; ++ks) { \
        const bf16x8 vf = (bf16x8){lo[buf][ks][0], lo[buf][ks][1], lo[buf][ks][2], lo[buf][ks][3], hi[buf][ks][0], hi[buf][ks][1], hi[buf][ks][2], hi[buf][ks][3]}; \
        o[dt] = __builtin_amdgcn_mfma_f32_32x32x16_bf16(vf, p[ks], o[dt], 0, 0, 0); } } while (0)
template <int SLOT>
__device__ __forceinline__ void attn_pv(unsigned vaddr, f32x16 (&o)[4], const bf16x8 (&p)[4]) {
    const unsigned va = vaddr + SLOT * AT_SLOT;
    s16x4 lo[2][4], hi[2][4];
    AT_VREAD(0, 0);
    AT_VREAD(1, 1);
    asm volatile("s_waitcnt lgkmcnt(8)" ::: "memory"); __builtin_amdgcn_sched_barrier(0);
    AT_VMMA(0, 0);
    __builtin_amdgcn_sched_barrier(0);
    AT_VREAD(0, 2);
    asm volatile("s_waitcnt lgkmcnt(8)" ::: "memory"); __builtin_amdgcn_sched_barrier(0);
    AT_VMMA(1, 1);
    __builtin_amdgcn_sched_barrier(0);
    AT_VREAD(1, 3);
    asm volatile("s_waitcnt lgkmcnt(8)" ::: "memory"); __builtin_amdgcn_sched_barrier(0);
    AT_VMMA(0, 2);
    asm volatile("s_waitcnt lgkmcnt(0)" ::: "memory"); __builtin_amdgcn_sched_barrier(0);
    AT_VMMA(1, 3);
}
__device__ __forceinline__ void glds16(const void* gsrc, unsigned lds_dst) { unsigned keep;
    asm volatile("s_mov_b32 %0, m0\n\ts_mov_b32 m0, %2\n\ts_nop 0\n\tglobal_load_lds_dwordx4 %1, off\n\ts_mov_b32 m0, %0" : "=&s"(keep) : "v"(gsrc), "s"(lds_dst) : "memory"); }
__device__ __forceinline__ void attn_dma_k(unsigned lds0, const unsigned char* kg0, int t, int slot, int wid, int lane) {
#pragma unroll
    for (int j = 0; j < 2; ++j) { const int piece = wid * 2 + j, half = piece >> 3, pp = piece & 7;
        glds16(kg0 + (size_t)half * SEQ * 128 + (size_t)t * 8192 + pp * 1024 + lane * 16, (unsigned)__builtin_amdgcn_readfirstlane((int)(lds0 + AT_KR + slot * AT_SLOT + half * 8192 + pp * 1024))); }
}
__device__ __forceinline__ void attn_dma_v(unsigned lds0, const unsigned char* vg0, int t, int slot, int wid, int lane) {
#pragma unroll
    for (int j = 0; j < 2; ++j) { const int piece = wid * 2 + j;
        glds16(vg0 + (size_t)t * 16384 + piece * 1024 + lane * 16, (unsigned)__builtin_amdgcn_readfirstlane((int)(lds0 + AT_VR + slot * AT_SLOT + piece * 1024))); }
}

template <int VAR>
__device__ __forceinline__ void phase_attn(Frame& F, int l) {
    refresh(F);
    const WS W = ws_map(F.ws, F.nb); const float* const* IN_ = F.a->in; (void)IN_; (void)W;
    const int lane = F.lane, wid = F.wave, r32 = lane & 31, hh = lane >> 5, qg = wid & 3, c = wid >> 2;
    LAS unsigned char* lds = F.lds; const unsigned lds0 = (unsigned)(unsigned long)lds;
    LAS float* tab = (LAS float*)(lds + AT_TAB);
    for (int i = F.tid; i < 1028; i += NTHR) tab[i] = W.tab[i];
    const float lam = W.tab[1032 + l]; const float lam_init = 0.8f - 0.6f * __expf(-0.3f * (float)l);
    const float* subg = IN_[13] + l * 128;
    const int U = F.nb * NH * 64;
    const int gx = F.G >> 3, per = U >> 3;
    int koff[4]; { const int sw = (r32 >> 1) & 7;
#pragma unroll
        for (int s = 0; s < 4; ++s) koff[s] = r32 * 128 + (((2 * s + hh) ^ sw) << 4); }
    const int vb = (4 * hh + ((lane & 15) >> 2)) * 64 + (((lane >> 4) & 1) * 16 + 4 * (lane & 3)) * 2;
    const bool lag = wid >= 4;
    unsigned kaddr[4];
#pragma unroll
    for (int s = 0; s < 4; ++s) kaddr[s] = lds0 + AT_KR + c * 8192 + koff[s];
    const unsigned vaddr = lds0 + AT_VR + vb;
    __syncthreads();
    for (int i = 0;; ++i) {
        int id;
        if ((F.G & 7) == 0) { const int n = i * gx + (F.bid >> 3); if (n >= per) break; id = (F.bid & 7) * per + n; }
        else { id = i * F.G + F.bid; if (id >= U) break; }
        const int bh = id >> 6, qb = id & 63, b = bh >> 2, h = bh & 3;
        const int qw0 = qb * 128 + 32 * qg;
        const unsigned char* kg0 = (const unsigned char*)(W.DK + ((size_t)bh * 2) * SEQ * 64);
        const unsigned char* vg0 = (const unsigned char*)(W.DV + (size_t)bh * SEQ * 128);
        bf16x8 qf[4]; { const bf16* qp = W.DQ + (((size_t)bh * 2 + c) * SEQ + qw0 + r32) * 64 + 8 * hh;
#pragma unroll
            for (int s = 0; s < 4; ++s) qf[s] = *(const bf16x8*)(qp + 16 * s); }
        asm volatile("s_waitcnt vmcnt(0)" ::: "memory");
        attn_dma_k(lds0, kg0, 0, 0, wid, lane); attn_dma_k(lds0, kg0, 1, 1, wid, lane); attn_dma_v(lds0, vg0, 0, 0, wid, lane); attn_dma_k(lds0, kg0, 2, 2, wid, lane);
        attn_dma_v(lds0, vg0, 1, 1, wid, lane); attn_dma_k(lds0, kg0, 3, 3, wid, lane); attn_dma_v(lds0, vg0, 2, 2, wid, lane);
        f32x16 o[4];
#pragma unroll
        for (int dt = 0; dt < 4; ++dt) o[dt] = f32x16{};
        float lsum = 0.f;
        const int tL = (qw0 >= 154) ? ((qw0 - 154) >> 6) + 1 : 0, tR = (qw0 + 185) >> 6;
        const float shl = tab[1024 + h];
        const LAS float* tabh = tab + h * 256;
        const int rel0 = -qw0 - r32 + 4 * hh + 128;
        asm volatile("s_waitcnt vmcnt(8)" ::: "memory"); __builtin_amdgcn_s_barrier(); asm volatile("" ::: "memory");
        f32x16 sc0, sc1, sn0, sn1; bf16x8 p[4]; bf16x8 kf[8];
        attn_kread<0>(kf, kaddr);
        asm volatile("s_waitcnt lgkmcnt(0)" ::: "memory"); __builtin_amdgcn_sched_barrier(0);
        attn_qk(sc0, sc1, kf, qf);
        __builtin_amdgcn_s_barrier(); asm volatile("" ::: "memory");
        if (lag) { __builtin_amdgcn_s_barrier(); asm volatile("" ::: "memory"); }
#define AT_STEP(SL, t) do { \
            if (VAR != 4) { const int tk = (t) + 4 < 128 ? (t) + 4 : 127; attn_dma_k(lds0, kg0, tk, SL, wid, lane); } \
            asm volatile("s_waitcnt vmcnt(8)" ::: "memory");                                                       \
            if (VAR != 3) attn_kread<(SL + 1) & 3>(kf, kaddr);                                                    \
            if ((t) >= tL && (t) < tR) attn_bias(sc0, sc1, 64 * (t) + rel0, tabh);                                \
            attn_exp_chunk<VAR == 1, 0>(sc0, sc1, lsum); attn_exp_chunk<VAR == 1, 1>(sc0, sc1, lsum);             \
            p[0] = pk8(sc0, 0); p[2] = pk8(sc1, 0); \
            asm volatile("s_waitcnt lgkmcnt(0)" ::: "memory"); __builtin_amdgcn_sched_barrier(0); \
            if (VAR != 3) { sn0 = __builtin_amdgcn_mfma_f32_32x32x16_bf16(kf[0], qf[0], f32x16{}, 0, 0, 0); sn1 = __builtin_amdgcn_mfma_f32_32x32x16_bf16(kf[1], qf[0], f32x16{}, 0, 0, 0); \
                            sn0 = __builtin_amdgcn_mfma_f32_32x32x16_bf16(kf[2], qf[1], sn0, 0, 0, 0); sn1 = __builtin_amdgcn_mfma_f32_32x32x16_bf16(kf[3], qf[1], sn1, 0, 0, 0); } \
            __builtin_amdgcn_sched_barrier(0); \
            attn_exp_chunk<VAR == 1, 2>(sc0, sc1, lsum); \
            __builtin_amdgcn_sched_barrier(0); \
            if (VAR != 3) { sn0 = __builtin_amdgcn_mfma_f32_32x32x16_bf16(kf[4], qf[2], sn0, 0, 0, 0); sn1 = __builtin_amdgcn_mfma_f32_32x32x16_bf16(kf[5], qf[2], sn1, 0, 0, 0); } \
            __builtin_amdgcn_sched_barrier(0); \
            attn_exp_chunk<VAR == 1, 3>(sc0, sc1, lsum); \
            __builtin_amdgcn_sched_barrier(0); \
            if (VAR != 3) { sn0 = __builtin_amdgcn_mfma_f32_32x32x16_bf16(kf[6], qf[3], sn0, 0, 0, 0); sn1 = __builtin_amdgcn_mfma_f32_32x32x16_bf16(kf[7], qf[3], sn1, 0, 0, 0); } else { sn0 = sc0; sn1 = sc1; } \
            p[1] = pk8(sc0, 8); p[3] = pk8(sc1, 8); \
            __builtin_amdgcn_s_barrier(); asm volatile("" ::: "memory"); \
            if (VAR != 4) { const int tv = (t) + 3 < 128 ? (t) + 3 : 127; attn_dma_v(lds0, vg0, tv, (SL + 3) & 3, wid, lane); } \
            asm volatile("s_waitcnt vmcnt(8)" ::: "memory");                                                       \
            if ((t) == tL) { _Pragma("unroll") for (int dt = 0; dt < 4; ++dt) o[dt] *= shl; lsum *= shl; } \
            if (VAR != 2) attn_pv<SL>(vaddr, o, p); else { _Pragma("unroll") for (int ks = 0; ks < 4; ++ks) asm volatile("" :: "v"(p[ks])); } \
            sc0 = sn0; sc1 = sn1; \
            __builtin_amdgcn_s_barrier(); asm volatile("" ::: "memory"); } while (0)
        for (int t0 = 0; t0 < 128; t0 += 4) { AT_STEP(0, t0); AT_STEP(1, t0 + 1); AT_STEP(2, t0 + 2); AT_STEP(3, t0 + 3); }
#undef AT_STEP
        if (!lag) { __builtin_amdgcn_s_barrier(); asm volatile("" ::: "memory"); }
        asm volatile("s_waitcnt vmcnt(0)" ::: "memory"); __builtin_amdgcn_s_barrier(); asm volatile("" ::: "memory");
        const float lt = lsum + __shfl_xor(lsum, 32);
        LAS float* xch = (LAS float*)(lds + qg * 16384);
        if (c == 1) { const float f = lam / lt;
#pragma unroll
            for (int dt = 0; dt < 4; ++dt)
#pragma unroll
                for (int r = 0; r < 16; ++r) xch[(dt * 16 + r) * 64 + lane] = o[dt][r] * f; }
        LDS_WAIT(); __builtin_amdgcn_s_barrier(); asm volatile("" ::: "memory");
        if (c == 0) { const float f = 1.f / lt; float ss = 0.f;
#pragma unroll
            for (int dt = 0; dt < 4; ++dt)
#pragma unroll
                for (int r = 0; r < 16; ++r) { const float v = o[dt][r] * f - xch[(dt * 16 + r) * 64 + lane]; o[dt][r] = v; ss += v * v; }
            ss += __shfl_xor(ss, 32);
            const float rn = rsqrtf(ss * (1.f / 128.f) + RMS_EPS) * (1.f - lam_init);
            bf16* orow = W.OAB + (size_t)F.T * 512 + ((size_t)b * SEQ + qw0 + r32) * 512 + h * 128;
#pragma unroll
            for (int dt = 0; dt < 4; ++dt)
#pragma unroll
                for (int g = 0; g < 4; ++g) { const int dv = 32 * dt + 8 * g + 4 * hh; const f32x4 sg = *(const f32x4*)(subg + dv);
                    u32x2 ov; ov.x = cvt_pk(o[dt][4 * g] * rn * sg[0], o[dt][4 * g + 1] * rn * sg[1]); ov.y = cvt_pk(o[dt][4 * g + 2] * rn * sg[2], o[dt][4 * g + 3] * rn * sg[3]);
                    *(u32x2*)(orow + dv) = ov; }
        }
        LDS_WAIT(); __builtin_amdgcn_s_barrier(); asm volatile("" ::: "memory");
    }
}
constexpr int GL_CUM = 0;
constexpr int GL_S64 = 144, GL_S192 = 400;
constexpr int G1_KEF = 32768, G1_KEB = G1_KEF + 64 * GL_S64, G1_VT = G1_KEB + 64 * GL_S64;
constexpr int G3_AOP = 32768, G3_KIF = G3_AOP + 64 * GL_S192, G3_KIB = G3_KIF + 64 * GL_S64, G3_BOP = G3_KIB + 64 * GL_S64;
static_assert(G3_BOP + 128 * GL_S192 <= 150 * 1024, "GLA LDS");

__device__ __forceinline__ bf16x8 lds_frag(const LAS unsigned char* base, int row, int stride, int kbyte) { return *(const LAS bf16x8*)(base + row * stride + kbyte); }

__device__ __forceinline__ void gla_cum(Frame& F, size_t trow0, int h) {
    const WS W = ws_map(F.ws, F.nb); const float* const* IN_ = F.a->in; (void)IN_; (void)W;
    LAS float* cum = (LAS float*)(F.lds + GL_CUM);
#pragma unroll
    for (int it = 0; it < 4; ++it) { const int idx = F.tid + it * NTHR; const int dir = idx >> 10, t = (idx >> 4) & 63, d4 = (idx & 15) * 4;
        const f32x4 v = *(const f32x4*)((dir ? W.LGB : W.LGF) + (trow0 + t) * 256 + h * 64 + d4);
        *(LAS f32x4*)(cum + (dir * 64 + t) * 64 + d4) = v; }
    __syncthreads();
    if (F.tid < 128) { const int dir = F.tid >> 6, d = F.tid & 63; LAS float* cc = cum + dir * 4096 + d; float run = 0.f;
        if (dir == 0) { for (int t = 0; t < 64; ++t) { run += cc[t * 64]; cc[t * 64] = run; } }
        else { for (int t = 63; t >= 0; --t) { run += cc[t * 64]; cc[t * 64] = run; } } }
    __syncthreads();
}

__device__ __forceinline__ void phase_gla1(Frame& F) {
    refresh(F);
    const WS W = ws_map(F.ws, F.nb); const float* const* IN_ = F.a->in; (void)IN_; (void)W;
    LAS unsigned char* lds = F.lds; LAS float* cum = (LAS float*)(lds + GL_CUM);
    const int lane = F.lane, wid = F.wave, r32 = lane & 31, hh = lane >> 5;
    const int U = F.nb * NH * 128;
    for (int u = F.bid; u < U; u += F.G) {
        const int n = u & 127, bh = u >> 7, b = bh >> 2, h = bh & 3; const size_t trow0 = (size_t)b * SEQ + n * 64;
        gla_cum(F, trow0, h);
        {
            const int t = F.tid >> 3, d0 = (F.tid & 7) * 8;
            const u32x4 kv = *(const u32x4*)(W.GK + (trow0 + t) * 256 + h * 64 + d0);
            const unsigned kw[4] = {kv.x, kv.y, kv.z, kv.w};
#pragma unroll
            for (int j = 0; j < 8; ++j) { const int d = d0 + j; const float k = (j & 1) ? bfhi(kw[j >> 1]) : bflo(kw[j >> 1]);
                const float ef = __expf(cum[63 * 64 + d] - cum[t * 64 + d]), eb = __expf(cum[4096 + d] - cum[4096 + t * 64 + d]);
                *(LAS bf16*)(lds + G1_KEF + d * GL_S64 + t * 2) = (bf16)(cvt_pk(k * ef, 0.f) & 0xffffu);
                *(LAS bf16*)(lds + G1_KEB + d * GL_S64 + t * 2) = (bf16)(cvt_pk(k * eb, 0.f) & 0xffffu); }
            const int v0 = (F.tid & 7) * 16;
            const u32x4 va = *(const u32x4*)(W.GV + (trow0 + t) * 512 + h * 128 + v0), vb = *(const u32x4*)(W.GV + (trow0 + t) * 512 + h * 128 + v0 + 8);
            const unsigned vw[8] = {va.x, va.y, va.z, va.w, vb.x, vb.y, vb.z, vb.w};
#pragma unroll
            for (int j = 0; j < 16; ++j) *(LAS bf16*)(lds + G1_VT + (v0 + j) * GL_S64 + t * 2) = (bf16)((j & 1) ? (vw[j >> 1] >> 16) : (vw[j >> 1] & 0xffffu));
            if (F.tid < 128) { const int dir = F.tid >> 6, d = F.tid & 63; W.DEC[((size_t)u * 2 + dir) * 64 + d] = __expf(dir ? cum[4096 + d] : cum[63 * 64 + d]); }
        }
        __syncthreads();
        {
            const int dt = wid & 3, dd = wid >> 2;
            f32x16 cf = {}, cb = {};
#pragma unroll
            for (int s = 0; s < 4; ++s) { const int kb = (16 * s + 8 * hh) * 2;
                const bf16x8 a = lds_frag(lds + G1_VT, 32 * dt + r32, GL_S64, kb);
                cf = __builtin_amdgcn_mfma_f32_32x32x16_bf16(a, lds_frag(lds + G1_KEF, 32 * dd + r32, GL_S64, kb), cf, 0, 0, 0);
                cb = __builtin_amdgcn_mfma_f32_32x32x16_bf16(a, lds_frag(lds + G1_KEB, 32 * dd + r32, GL_S64, kb), cb, 0, 0, 0); }
            float* of = W.KVT + ((size_t)u * 2) * 8192; float* ob = of + 8192;
#pragma unroll
            for (int r = 0; r < 16; ++r) { const int dv = 32 * dt + crow(r, hh), d = 32 * dd + r32; of[dv * 64 + d] = cf[r]; ob[dv * 64 + d] = cb[r]; }
        }
        __syncthreads();
    }
}

__device__ __forceinline__ void phase_gla2(Frame& F) {
    refresh(F);
    const WS W = ws_map(F.ws, F.nb); const float* const* IN_ = F.a->in; (void)IN_; (void)W;
    const size_t total = (size_t)F.nb * NH * 2 * 8192;
    for (size_t wk = (size_t)F.bid * NTHR + F.tid; wk < total; wk += (size_t)F.G * NTHR) {
        const int e = (int)(wk & 8191), dir = (int)((wk >> 13) & 1), bh = (int)(wk >> 14), d = e & 63;
        float* base = W.KVT + ((size_t)bh * 128 * 2 + dir) * 8192 + e; const float* dec = W.DEC + ((size_t)bh * 128 * 2 + dir) * 64 + d;
        float S = 0.f;
        for (int n0 = 0; n0 < 128; n0 += 8) {
            float kv[8], dc[8];
#pragma unroll
            for (int j = 0; j < 8; ++j) { const int n = dir ? 127 - (n0 + j) : n0 + j; kv[j] = base[(size_t)n * 16384]; dc[j] = dec[(size_t)n * 128]; }
#pragma unroll
            for (int j = 0; j < 8; ++j) { const int n = dir ? 127 - (n0 + j) : n0 + j; base[(size_t)n * 16384] = S; S = dc[j] * S + kv[j]; }
        }
    }
}

__device__ __forceinline__ void phase_gla3(Frame& F, int l) {
    refresh(F);
    const WS W = ws_map(F.ws, F.nb); const float* const* IN_ = F.a->in; (void)IN_; (void)W;
    LAS unsigned char* lds = F.lds; LAS float* cum = (LAS float*)(lds + GL_CUM);
    const int lane = F.lane, wid = F.wave, r32 = lane & 31, hh = lane >> 5;
    const float* gng = IN_[9] + l * 128;
    const int U = F.nb * NH * 128;
    for (int u = F.bid; u < U; u += F.G) {
        const int n = u & 127, bh = u >> 7, b = bh >> 2, h = bh & 3; const size_t trow0 = (size_t)b * SEQ + n * 64;
        gla_cum(F, trow0, h);
        {
            const int t = F.tid >> 3, d0 = (F.tid & 7) * 8;
            const u32x4 qv = *(const u32x4*)(W.GQ + (trow0 + t) * 256 + h * 64 + d0), kv = *(const u32x4*)(W.GK + (trow0 + t) * 256 + h * 64 + d0);
            const unsigned qw[4] = {qv.x, qv.y, qv.z, qv.w}, kw[4] = {kv.x, kv.y, kv.z, kv.w};
            float qf[8], qb[8], kf[8], kb[8];
#pragma unroll
            for (int j = 0; j < 8; ++j) { const int d = d0 + j; const float q = (j & 1) ? bfhi(qw[j >> 1]) : bflo(qw[j >> 1]), k = (j & 1) ? bfhi(kw[j >> 1]) : bflo(kw[j >> 1]);
                const float cf = cum[t * 64 + d], cb = cum[4096 + t * 64 + d];
                qf[j] = q * __expf(cf); qb[j] = q * __expf(cb); kf[j] = k * __expf(-cf); kb[j] = k * __expf(-cb); }
            u32x4 o;
            o.x = cvt_pk(qf[0], qf[1]); o.y = cvt_pk(qf[2], qf[3]); o.z = cvt_pk(qf[4], qf[5]); o.w = cvt_pk(qf[6], qf[7]); *(LAS u32x4*)(lds + G3_AOP + t * GL_S192 + (64 + d0) * 2) = o;
            o.x = cvt_pk(qb[0], qb[1]); o.y = cvt_pk(qb[2], qb[3]); o.z = cvt_pk(qb[4], qb[5]); o.w = cvt_pk(qb[6], qb[7]); *(LAS u32x4*)(lds + G3_AOP + t * GL_S192 + (128 + d0) * 2) = o;
            o.x = cvt_pk(kf[0], kf[1]); o.y = cvt_pk(kf[2], kf[3]); o.z = cvt_pk(kf[4], kf[5]); o.w = cvt_pk(kf[6], kf[7]); *(LAS u32x4*)(lds + G3_KIF + t * GL_S64 + d0 * 2) = o;
            o.x = cvt_pk(kb[0], kb[1]); o.y = cvt_pk(kb[2], kb[3]); o.z = cvt_pk(kb[4], kb[5]); o.w = cvt_pk(kb[6], kb[7]); *(LAS u32x4*)(lds + G3_KIB + t * GL_S64 + d0 * 2) = o;
            const int v0 = (F.tid & 7) * 16;
            const u32x4 va = *(const u32x4*)(W.GV + (trow0 + t) * 512 + h * 128 + v0), vb = *(const u32x4*)(W.GV + (trow0 + t) * 512 + h * 128 + v0 + 8);
            const unsigned vw[8] = {va.x, va.y, va.z, va.w, vb.x, vb.y, vb.z, vb.w};
#pragma unroll
            for (int j = 0; j < 16; ++j) *(LAS bf16*)(lds + G3_BOP + (v0 + j) * GL_S192 + t * 2) = (bf16)((j & 1) ? (vw[j >> 1] >> 16) : (vw[j >> 1] & 0xffffu));
            const int dv = F.tid >> 2, dd0 = (F.tid & 3) * 16;
#pragma unroll
            for (int dir = 0; dir < 2; ++dir) { const float* sp = W.KVT + ((size_t)u * 2 + dir) * 8192 + dv * 64 + dd0;
                const f32x4 a = *(const f32x4*)sp, bq = *(const f32x4*)(sp + 4), cq = *(const f32x4*)(sp + 8), dq = *(const f32x4*)(sp + 12);
                u32x4 o0, o1; o0.x = cvt_pk(a[0], a[1]); o0.y = cvt_pk(a[2], a[3]); o0.z = cvt_pk(bq[0], bq[1]); o0.w = cvt_pk(bq[2], bq[3]);
                o1.x = cvt_pk(cq[0], cq[1]); o1.y = cvt_pk(cq[2], cq[3]); o1.z = cvt_pk(dq[0], dq[1]); o1.w = cvt_pk(dq[2], dq[3]);
                *(LAS u32x4*)(lds + G3_BOP + dv * GL_S192 + (64 + 64 * dir + dd0) * 2) = o0; *(LAS u32x4*)(lds + G3_BOP + dv * GL_S192 + (64 + 64 * dir + dd0 + 8) * 2) = o1; }
        }
        __syncthreads();
        if (wid < 4) {
            const int it = wid >> 1, jt = wid & 1;
            f32x16 af = {}, ab = {};
#pragma unroll
            for (int s = 0; s < 4; ++s) { const int kb = (16 * s + 8 * hh) * 2;
                if (jt <= it) af = __builtin_amdgcn_mfma_f32_32x32x16_bf16(lds_frag(lds + G3_AOP, 32 * it + r32, GL_S192, 128 + kb), lds_frag(lds + G3_KIF, 32 * jt + r32, GL_S64, kb), af, 0, 0, 0);
                if (jt >= it) ab = __builtin_amdgcn_mfma_f32_32x32x16_bf16(lds_frag(lds + G3_AOP, 32 * it + r32, GL_S192, 256 + kb), lds_frag(lds + G3_KIB, 32 * jt + r32, GL_S64, kb), ab, 0, 0, 0); }
#pragma unroll
            for (int r = 0; r < 16; ++r) { const int i = 32 * it + crow(r, hh), j = 32 * jt + r32; const float v = (j <= i) ? af[r] : ab[r];
                *(LAS bf16*)(lds + G3_AOP + i * GL_S192 + j * 2) = (bf16)(cvt_pk(v, 0.f) & 0xffffu); }
        }
        __syncthreads();
        {
            const int it = wid >> 2, dt = wid & 3; f32x16 o = {};
#pragma unroll
            for (int s = 0; s < 12; ++s) { const int kb = (16 * s + 8 * hh) * 2;
                o = __builtin_amdgcn_mfma_f32_32x32x16_bf16(lds_frag(lds + G3_AOP, 32 * it + r32, GL_S192, kb), lds_frag(lds + G3_BOP, 32 * dt + r32, GL_S192, kb), o, 0, 0, 0); }
            LAS float* out = (LAS float*)(lds + GL_CUM);
#pragma unroll
            for (int r = 0; r < 16; ++r) out[(32 * it + crow(r, hh)) * 128 + 32 * dt + r32] = o[r];
        }
        __syncthreads();
        {
            const int t = F.tid >> 3, v0 = (F.tid & 7) * 16; const LAS float* orow = (const LAS float*)(lds + GL_CUM) + t * 128 + v0;
            float x[16]; float ss = 0.f;
#pragma unroll
            for (int j = 0; j < 16; ++j) { x[j] = orow[j]; ss += x[j] * x[j]; }
            ss += __shfl_xor(ss, 1); ss += __shfl_xor(ss, 2); ss += __shfl_xor(ss, 4);
            const float rs = rsqrtf(ss * (1.f / 128.f) + RMS_EPS);
            const u32x4 ga = *(const u32x4*)(W.SG + (trow0 + t) * 512 + h * 128 + v0), gb = *(const u32x4*)(W.SG + (trow0 + t) * 512 + h * 128 + v0 + 8);
            const unsigned gw[8] = {ga.x, ga.y, ga.z, ga.w, gb.x, gb.y, gb.z, gb.w};
            float y[16];
#pragma unroll
            for (int j = 0; j < 16; ++j) y[j] = x[j] * rs * gng[v0 + j] * ((j & 1) ? bfhi(gw[j >> 1]) : bflo(gw[j >> 1]));
            u32x4 o0, o1; o0.x = cvt_pk(y[0], y[1]); o0.y = cvt_pk(y[2], y[3]); o0.z = cvt_pk(y[4], y[5]); o0.w = cvt_pk(y[6], y[7]);
            o1.x = cvt_pk(y[8], y[9]); o1.y = cvt_pk(y[10], y[11]); o1.z = cvt_pk(y[12], y[13]); o1.w = cvt_pk(y[14], y[15]);
            bf16* dst = W.OAB + (trow0 + t) * 512 + h * 128 + v0; *(u32x4*)dst = o0; *(u32x4*)(dst + 8) = o1;
        }
        __syncthreads();
    }
}
__device__ __forceinline__ void phase_select(Frame& F, int l) {
    refresh(F);
    const WS W = ws_map(F.ws, F.nb); const float* const* IN_ = F.a->in; (void)IN_; (void)W;
    LAS int* lcnt = (LAS int*)F.lds; LAS int* lbase = lcnt + 32;
    const float* b_rg = IN_[19] + l * 4; const float* b_re = IN_[21] + l * 32;
    unsigned* gcnt = W.ctl + CW_CNT + l * 64;
    for (int t0 = F.bid * NTHR; t0 < F.T; t0 += F.G * NTHR) {
        if (F.tid < 32) lcnt[F.tid] = 0;
        __syncthreads();
        const int t = t0 + F.tid; int e0 = 0, e1 = 0, r0 = 0, r1 = 0; float g0 = 0.f, g1 = 0.f;
        if (t < F.T) {
            const float* lg = W.LOGITS + (size_t)t * 64;
            float gl[4]; { const f32x4 v = *(const f32x4*)lg; gl[0] = v[0] + b_rg[0]; gl[1] = v[1] + b_rg[1]; gl[2] = v[2] + b_rg[2]; gl[3] = v[3] + b_rg[3]; }
            int grp = 0; float mx = gl[0];
            if (gl[1] > mx) { mx = gl[1]; grp = 1; } if (gl[2] > mx) { mx = gl[2]; grp = 2; } if (gl[3] > mx) { mx = gl[3]; grp = 3; }
            const float p_grp = 1.f / (__expf(gl[0] - mx) + __expf(gl[1] - mx) + __expf(gl[2] - mx) + __expf(gl[3] - mx));
            const f32x4 ea = *(const f32x4*)(lg + 4 + grp * 8), eb = *(const f32x4*)(lg + 8 + grp * 8);
            const f32x4 ba = *(const f32x4*)(b_re + grp * 8), bb = *(const f32x4*)(b_re + grp * 8 + 4);
            float b0v = -1e30f, b1v = -1e30f; int i0 = 0, i1 = 0;
#pragma unroll
            for (int j = 0; j < 8; ++j) { const float e = (j < 4) ? ea[j] + ba[j] : eb[j - 4] + bb[j - 4];
                if (e > b0v) { b1v = b0v; i1 = i0; b0v = e; i0 = j; } else if (e > b1v) { b1v = e; i1 = j; } }
            const float p1 = __expf(b1v - b0v), s2 = 1.f + p1;
            e0 = grp * 8 + i0; e1 = grp * 8 + i1; g0 = p_grp / s2; g1 = p_grp * p1 / s2;
            r0 = __hip_atomic_fetch_add(lcnt + e0, 1, __ATOMIC_RELAXED, __HIP_MEMORY_SCOPE_WORKGROUP);
            r1 = __hip_atomic_fetch_add(lcnt + e1, 1, __ATOMIC_RELAXED, __HIP_MEMORY_SCOPE_WORKGROUP);
        }
        __syncthreads();
        if (F.tid < 32) lbase[F.tid] = (int)__hip_atomic_fetch_add(gcnt + F.tid, (unsigned)lcnt[F.tid], __ATOMIC_RELAXED, __HIP_MEMORY_SCOPE_AGENT);
        __syncthreads();
        if (t < F.T) { W.eid[t * 2] = e0; W.eid[t * 2 + 1] = e1; W.gate[t * 2] = g0; W.gate[t * 2 + 1] = g1; W.rank[t * 2] = lbase[e0] + r0; W.rank[t * 2 + 1] = lbase[e1] + r1; }
        __syncthreads();
    }
}
__device__ __forceinline__ void phase_gather(Frame& F, int l) {
    refresh(F);
    const WS W = ws_map(F.ws, F.nb); const float* const* IN_ = F.a->in; (void)IN_; (void)W;
    LAS int* seg = (LAS int*)F.lds;
    const unsigned* gcnt = W.ctl + CW_CNT + l * 64;
    if (F.tid == 0) { int o = 0; for (int e = 0; e < 32; ++e) { seg[e] = o; o += ((int)__hip_atomic_load(gcnt + e, __ATOMIC_RELAXED, __HIP_MEMORY_SCOPE_AGENT) + 255) & ~255; } seg[32] = o; }
    __syncthreads();
    if (F.bid == 0) {
        const int ntile = seg[32] >> 8;
        for (int i = F.tid; i < ntile; i += NTHR) { int e = 0; while (e < 31 && (i << 8) >= seg[e + 1]) ++e; W.tilee[i] = e; }
        if (F.tid == 0) W.segp[0] = ntile;
    }
    const int gw = F.bid * NWAVES + F.wave, NGW = F.G * NWAVES;
    for (int it = gw; it < F.T * 2; it += NGW) {
        const int t = it >> 1; const int e = W.eid[it], p = seg[e] + W.rank[it];
        const GAS u32x4* src = (const GAS u32x4*)(W.H + (size_t)t * D) + F.lane; GAS u32x4* dst = (GAS u32x4*)(W.XS + (size_t)p * D) + F.lane;
        const u32x4 a = src[0], b = src[64]; dst[0] = a; dst[64] = b;
        if (F.lane == 0) { W.pos[it] = p; W.gsort[p] = W.gate[it]; }
    }
}

#ifndef MK_MASK
#define MK_MASK 0xffffffffu
#endif
#define EN(b) (((MK_MASK) >> (b)) & 1u)
#ifndef MK_DUP
#define MK_DUP 0u
#endif
#define REPS(b) ((((MK_DUP) >> (b)) & 1u) ? 2 : 1)
constexpr int NPL = 14, NPH = 2 + DEPTH * NPL;
__global__ void __launch_bounds__(NTHR, 2) mk_fwd(Args args) {
    extern __shared__ __attribute__((aligned(16))) unsigned char lds_raw[];
    Frame F;
    F.lds = (LAS unsigned char*)lds_raw; F.tid = threadIdx.x; F.lane = F.tid & 63; F.wave = __builtin_amdgcn_readfirstlane(F.tid >> 6);
    F.G = gridDim.x; F.bid = blockIdx.x; F.nb = args.nb; F.T = args.nb * SEQ; F.ws = args.ws; F.a = &args; F.xbuf = args.out;
    const float* const* IN_ = args.in;
    volatile LAS unsigned* misc = (volatile LAS unsigned*)(F.lds + LDS_MISC);
    if (F.tid < 64) misc[F.tid] = 0u;
    __syncthreads();
    XcdBarrier bar = xcd_barrier_post((unsigned*)args.ws + CW_BAR + args.li * XCD_BAR_WORDS, misc);
    const int lo = args.ph_lo, hi = args.ph_hi;
#define IN(k) (lo <= (k) && (k) < hi)
#define SEAM(k) do { if (IN(k) && IN((k) + 1)) xcd_barrier(bar); } while (0)
    LAS unsigned char* gl = F.lds;
    if (EN(0) && IN(0)) { for (int rp = 0; rp < REPS(0); ++rp) { p0_prologue(F); __syncthreads(); } SEAM(0); }
    for (int l = 0; l < DEPTH; ++l) {
        const int pb = 1 + l * NPL;
        if (EN(1) && IN(pb + 0)) { phase_norm(F, l, 0); SEAM(pb + 0); }
        if (EN(2) && IN(pb + 1)) { const WS W = ws_map(F.ws, F.nb);
            pg8::Gemm g{W.H, W.win + (size_t)l * NIN * D, F.T, NIN, D}; pg8::StaticOrder S; S.init(F.T, NIN, F.G, F.bid);
            EpiIn E{W.GQ, W.GK, W.GV, W.SG, W.LGF, W.LGB, W.DQ, W.DK, W.DV, W.SGA, W.SGB, IN_[8] + l * 512, IN_[10] + l * 64, IN_[11] + l * 64};
            for (int rp = 0; rp < REPS(2); ++rp) pg8::gemm_phase<EpiIn, pg8::StaticOrder, true, true>(gl, g, S, E);
            SEAM(pb + 1);
        }
        if (EN(3) && IN(pb + 2)) { for (int rp = 0; rp < REPS(3); ++rp) phase_gla1(F); SEAM(pb + 2); }
        if (EN(4) && IN(pb + 3)) { phase_gla2(F); SEAM(pb + 3); }
        if (EN(5) && IN(pb + 4)) { for (int rp = 0; rp < REPS(5); ++rp) phase_gla3(F, l); __syncthreads(); }
        if (EN(6) && IN(pb + 5)) {
#ifdef MK_ATT_PROBE
            phase_attn<MK_ATT_PROBE>(F, l);
#endif
            phase_attn<0>(F, l); SEAM(pb + 5); }
        if (EN(7) && IN(pb + 6)) { const WS W = ws_map(F.ws, F.nb);
            pg8::Gemm g{W.OAB, W.wab + (size_t)l * D * D, 0, 0, 512}; MergeOrder S; S.so.init(F.T, D, F.G, F.bid); S.nM = F.T / 256;
            EpiMerge E{W.SGA, W.SGB, W.MERGED, F.T / 256};
            for (int rp = 0; rp < REPS(7); ++rp) pg8::gemm_phase<EpiMerge, MergeOrder, true, true>(gl, g, S, E);
            SEAM(pb + 6);
        }
        if (EN(8) && IN(pb + 7)) { const WS W = ws_map(F.ws, F.nb); const float* modl = W.mod + (size_t)l * NBMAX * 6 * D;
            pg8::Gemm g{W.MERGED, W.wo + (size_t)l * D * D, F.T, D, D}; pg8::StaticOrder S; S.init(F.T, D, F.G, F.bid);
            EpiResid E{l == 0 ? IN_[0] : F.xbuf, F.xbuf, modl + 2 * D};
            pg8::gemm_phase<EpiResid, pg8::StaticOrder, true, true>(gl, g, S, E);
            SEAM(pb + 7);
        }
        if (EN(1) && IN(pb + 8)) { for (int rp = 0; rp < REPS(1); ++rp) phase_norm(F, l, 1); SEAM(pb + 8); }
        if (EN(9) && IN(pb + 9)) { const WS W = ws_map(F.ws, F.nb);
            pg8::Gemm g{W.H, W.wr + (size_t)l * 256 * D, F.T, 256, D}; pg8::StaticOrder S; S.init(F.T, 256, F.G, F.bid);
            EpiLogits E{W.LOGITS};
            for (int rp = 0; rp < REPS(9); ++rp) pg8::gemm_phase<EpiLogits, pg8::StaticOrder, true, true>(gl, g, S, E);
            SEAM(pb + 9);
        }
        if (EN(10) && IN(pb + 10)) { phase_select(F, l); SEAM(pb + 10); }
        if (EN(11) && IN(pb + 11)) { for (int rp = 0; rp < REPS(11); ++rp) { phase_gather(F, l); __syncthreads(); } SEAM(pb + 11); }
        if (EN(12) && IN(pb + 12)) { const WS W = ws_map(F.ws, F.nb);
            const int ntile = W.segp[0];
            pg8::Gemm g{W.XS, W.w1 + (size_t)l * NE * 1024 * D, 0, 0, D}; GroupedOrder S{W.tilee, ntile * 4, F.G, F.bid};
            EpiAct E{W.ACT};
            for (int rp = 0; rp < REPS(12); ++rp) pg8::gemm_phase<EpiAct, GroupedOrder, true, true>(gl, g, S, E);
            SEAM(pb + 12);
        }
        if (EN(13) && IN(pb + 13)) { const WS W = ws_map(F.ws, F.nb);
            const int ntile = W.segp[0];
            pg8::Gemm g{W.ACT, W.w2 + (size_t)l * NE * D * DE, 0, 0, DE}; GroupedOrder S{W.tilee, ntile * 4, F.G, F.bid};
            EpiYs E{W.YS, W.gsort};
            for (int rp = 0; rp < REPS(13); ++rp) pg8::gemm_phase<EpiYs, GroupedOrder, true, true>(gl, g, S, E);
            SEAM(pb + 13);
        }
    }
    if (EN(1) && IN(NPH - 1)) phase_norm(F, 0, 2);
#undef IN
#undef SEAM
}

struct LaunchCfg { int grid; bool ok; };
inline LaunchCfg& launch_cfg() {
    static LaunchCfg c{0, false}; static bool init = false;
    if (!init) { init = true;
        int dev = 0, cus = 0, per_cu = 0;
        if (hipGetDevice(&dev) != hipSuccess || hipDeviceGetAttribute(&cus, hipDeviceAttributeMultiprocessorCount, dev) != hipSuccess) { fprintf(stderr, "mk: device query failed\n"); return c; }
        if (hipFuncSetAttribute((const void*)mk_fwd, hipFuncAttributeMaxDynamicSharedMemorySize, LDS_BYTES) != hipSuccess) { fprintf(stderr, "mk: hipFuncSetAttribute failed\n"); return c; }
        if (hipOccupancyMaxActiveBlocksPerMultiprocessor(&per_cu, (const void*)mk_fwd, NTHR, LDS_BYTES) != hipSuccess || per_cu < 1) { fprintf(stderr, "mk: occupancy query says %d blocks/CU\n", per_cu); (void)hipGetLastError(); return c; }
        c.grid = cus; c.ok = true;
    }
    return c;
}
inline void launch_range(void* const* d_in, float* xbuf, void* d_ws, int nb, int lo, int hi, int li, hipStream_t stream) {
    LaunchCfg& c = launch_cfg(); if (!c.ok) return;
    Args a{}; for (int i = 0; i < 24; ++i) a.in[i] = (const float*)d_in[i];
    a.out = xbuf; a.ws = (unsigned char*)d_ws; a.nb = nb; a.ph_lo = lo; a.ph_hi = hi; a.li = li;
    hipLaunchKernelGGL(mk_fwd, dim3(c.grid), dim3(NTHR), LDS_BYTES, stream, a);
    const hipError_t le = hipPeekAtLastError(); if (le != hipSuccess) fprintf(stderr, "mk: launch [%d,%d) failed: %s\n", lo, hi, hipGetErrorName(le));
}
}
extern "C" void kernel_launch(void* const* d_in, const int* in_sizes, int n_in, void* d_out, int out_size, void* d_ws, size_t ws_size, hipStream_t stream) {
    (void)in_sizes; (void)n_in; (void)out_size;
    static int checked = 0;
    if (!checked) { checked = 1; const mk::WS w = mk::ws_map((unsigned char*)d_ws, 4); if (w.end > ws_size) { fprintf(stderr, "mk: workspace too small: need %zu, have %zu\n", w.end, ws_size); checked = -1; } }
    if (checked < 0) return;
    if (hipMemsetAsync(d_ws, 0, mk::CTL_BYTES, stream) != hipSuccess) return;
    mk::launch_range(d_in, (float*)d_out, d_ws, 4, 0, mk::NPH, 0, stream);
}
```

```cpp
#include <hip/hip_runtime.h>
#include <cstdio>
#include <cstdint>
#include <cmath>
#define MK_ATT_FP8 1
namespace pg8 {
#define PG8_LAS __attribute__((address_space(3)))
typedef unsigned short bf16_t;
typedef short bf16x8 __attribute__((ext_vector_type(8)));
typedef float f32x4 __attribute__((ext_vector_type(4)));
typedef unsigned u32x4 __attribute__((ext_vector_type(4)));
constexpr int BM = 256, BK = 64, HALF = 128, HTB = HALF * BK * 2  , STAGE_BYTES = 8 * HTB, NXCD = 8, WGM = 8;

__host__ __device__ __forceinline__ int lds_byte(int r, int c) { const int st = (r >> 4) * 2 + (c >> 5), rr = r & 15, cc = c & 31, ob = rr * 64 + cc * 2; return st * 1024 + (ob ^ (((ob >> 9) & 1) << 5)); }
__host__ __device__ __forceinline__ void stage_rc(int b, int& R, int& C) { const int st = b / 1024, sb = b % 1024, swz = sb ^ (((sb >> 9) & 1) << 5); R = (st >> 1) * 16 + swz / 64; C = (st & 1) * 32 + (swz % 64) / 2; }
__host__ __device__ __forceinline__ int perm32(int rho) { const int n = rho >> 4, i = rho & 15; return 8 * (i >> 2) + 4 * n + (i & 3); }

struct Unit { int pm, pn; };
struct Gemm { const bf16_t* A; const bf16_t* Bt; int M, N, K; };

struct StaticOrder {
    int nM, nN, nwg, G, c;
    __host__ __device__ void init(int M, int N, int G_, int c_) { nM = M / BM; nN = N / BM; nwg = nM * nN; G = G_; c = c_; }
    __host__ __device__ bool next(int i, Unit& u) const {
        const long L = (long)i * G + c; if (L >= nwg) return false;
        int wgid = (int)L; { const int q = nwg / NXCD, r = nwg % NXCD, xcd = wgid % NXCD, off = wgid / NXCD; wgid = (xcd < r ? xcd * (q + 1) : r * (q + 1) + (xcd - r) * q) + off; }
        const int nig = WGM * nN, gid = wgid / nig, fm = gid * WGM, gsz = (nM - fm) < WGM ? (nM - fm) : WGM;
        u.pm = fm + ((wgid % nig) % gsz); u.pn = (wgid % nig) / gsz; return true;
    }
    __device__ __forceinline__ void a_ready(const Unit&) const {}
    __device__ __forceinline__ void done(const Unit&) const {}
};
__device__ __forceinline__ unsigned cvt_pk_bf16(float lo, float hi) { unsigned r; asm volatile("v_cvt_pk_bf16_f32 %0, %1, %2" : "=v"(r) : "v"(lo), "v"(hi)); return r; }
template <class Epi, class Sched, bool ALIGN_EPI = false, bool SP2 = false>
__device__ __forceinline__ void gemm_phase(PG8_LAS unsigned char* lds, const Gemm g, const Sched& S, const Epi& E) {
    int tid_ = threadIdx.x; asm volatile("" : "+v"(tid_));
    const int tid = tid_, wid = __builtin_amdgcn_readfirstlane(tid >> 6), lane = tid & 63, wr = wid >> 2, wc = wid & 3, fr = lane & 15, fq = lane >> 4;
    const int K = g.K, nt = K / BK;
    unsigned voffA[2], voffB[2];
#pragma unroll
    for (int i = 0; i < 2; ++i) { int R, C; stage_rc(tid * 16 + i * 8192, R, C); const int Rb = Epi::PERM ? ((R & ~31) + perm32(R & 31)) : R;
        voffA[i] = (unsigned)(R * K + C) * 2u; voffB[i] = (unsigned)(Rb * K + C) * 2u; }
    const size_t kstep = (size_t)(BK * 2);
    const size_t hstep = (size_t)HALF * K * 2;
    const size_t tstep = 2 * hstep;
    const unsigned ldsw = (unsigned)wid * 1024u;
    const int aoff = lds_byte(wr * 64 + fr, fq * 8), boff = lds_byte(wc * 32 + fr, fq * 8);
#define PG8_SA(b, h) (((b) * 2 + (h)) * HTB)
#define PG8_SB(b, h) ((4 + (b) * 2 + (h)) * HTB)
#define PG8_STAGE(bufoff, gbase, voff) do { _Pragma("unroll") for (int _i = 0; _i < 2; ++_i) \
        __builtin_amdgcn_global_load_lds((const unsigned*)((const char*)(gbase) + (voff)[_i]), (PG8_LAS unsigned*)(lds + (bufoff) + ldsw + _i * 8192), 16, 0, 0); } while (0)
#define PG8_LDA(dst, b, h) do { _Pragma("unroll") for (int m = 0; m < 4; ++m) _Pragma("unroll") for (int k = 0; k < 2; ++k) dst[m][k] = *(const PG8_LAS bf16x8*)(lds + PG8_SA(b, h) + aoff + m * 2048 + k * 1024); } while (0)
#define PG8_LDB(dst, b, h) do { _Pragma("unroll") for (int n = 0; n < 2; ++n) _Pragma("unroll") for (int k = 0; k < 2; ++k) dst[n][k] = *(const PG8_LAS bf16x8*)(lds + PG8_SB(b, h) + boff + n * 2048 + k * 1024); } while (0)
#define PG8_MMA(ai, bj, At, Bt) do { __builtin_amdgcn_s_setprio(1); _Pragma("unroll") for (int m = 0; m < 4; ++m) _Pragma("unroll") for (int n = 0; n < 2; ++n) _Pragma("unroll") for (int k = 0; k < 2; ++k) \
        acc[ai][bj][m][n] = __builtin_amdgcn_mfma_f32_16x16x32_bf16(Bt[n][k], At[m][k], acc[ai][bj][m][n], 0, 0, 0); __builtin_amdgcn_s_setprio(0); } while (0)
#define PG8_WAIT_V(n) asm volatile("s_waitcnt vmcnt(" #n ")" ::: "memory")
#define PG8_WAIT_L(n) asm volatile("s_waitcnt lgkmcnt(" #n ")" ::: "memory")
#define PG8_BAR __builtin_amdgcn_s_barrier()
#define PG8_SCHED __builtin_amdgcn_sched_barrier(0)
    Unit cur, nxt; int ui = 0;
    if (!S.next(0, cur)) return;
    f32x4 acc[2][2][4][2];
#pragma unroll
    for (int a = 0; a < 2; ++a)
#pragma unroll
        for (int b = 0; b < 2; ++b)
#pragma unroll
            for (int m = 0; m < 4; ++m)
#pragma unroll
                for (int n = 0; n < 2; ++n) acc[a][b][m][n] = (f32x4){0.f, 0.f, 0.f, 0.f};
    bf16x8 At[4][2], B0[2][2], B1[2][2];
    const char* cA = (const char*)g.A + (size_t)cur.pm * tstep; const char* cB = (const char*)g.Bt + (size_t)cur.pn * tstep;
    S.a_ready(cur);
    if constexpr (SP2) {
        PG8_STAGE(PG8_SB(0, 0), cB, voffB); PG8_STAGE(PG8_SB(0, 1), cB + hstep, voffB); PG8_STAGE(PG8_SA(0, 0), cA, voffA); PG8_STAGE(PG8_SA(0, 1), cA + hstep, voffA);
        if (wr == 1) PG8_BAR;
        PG8_WAIT_V(2); PG8_BAR;
        PG8_STAGE(PG8_SB(1, 0), cB + kstep, voffB); PG8_STAGE(PG8_SA(1, 0), cA + kstep, voffA); PG8_STAGE(PG8_SB(1, 1), cB + hstep + kstep, voffB);
        PG8_WAIT_V(6); PG8_BAR;
    } else {
        PG8_STAGE(PG8_SB(0, 0), cB, voffB); PG8_STAGE(PG8_SA(0, 0), cA, voffA); PG8_STAGE(PG8_SB(0, 1), cB + hstep, voffB); PG8_STAGE(PG8_SA(0, 1), cA + hstep, voffA);
        if (wr == 1) PG8_BAR;
        PG8_WAIT_V(4); PG8_BAR;
        PG8_STAGE(PG8_SB(1, 0), cB + kstep, voffB); PG8_STAGE(PG8_SA(1, 0), cA + kstep, voffA); PG8_STAGE(PG8_SB(1, 1), cB + hstep + kstep, voffB);
        PG8_WAIT_V(6); PG8_BAR;
    }
    for (;;) {
        const bool has_next = S.next(ui + 1, nxt);
        const char* nA = has_next ? (const char*)g.A + (size_t)nxt.pm * tstep : cA; const char* nB = has_next ? (const char*)g.Bt + (size_t)nxt.pn * tstep : cB;
        for (int t = 0; t < nt; t += 2) {
            const bool last = (t == nt - 2);
            const char* a1 = cA + (size_t)(t + 1) * kstep;
            const char* a2 = last ? nA : cA + (size_t)(t + 2) * kstep; const char* b2 = last ? nB : cB + (size_t)(t + 2) * kstep;
            const char* a3 = a2 + kstep; const char* b3 = b2 + kstep;
            if (last && has_next) S.a_ready(nxt);
            if constexpr (Epi::MIDK) { if (t == nt / 2) E.mid(acc, cur, wr, wc, fr, fq); }
            if constexpr (SP2) {
            PG8_LDB(B0, 0, 0); PG8_LDB(B1, 0, 1); PG8_SCHED; PG8_LDA(At, 0, 0); PG8_STAGE(PG8_SA(1, 1), a1 + hstep, voffA);
            PG8_WAIT_V(8); PG8_WAIT_L(0); PG8_BAR; PG8_MMA(0, 0, At, B0); PG8_MMA(0, 1, At, B1); PG8_BAR; PG8_SCHED;
            PG8_LDA(At, 0, 1); PG8_STAGE(PG8_SB(0, 0), b2, voffB); PG8_STAGE(PG8_SB(0, 1), b2 + hstep, voffB); PG8_STAGE(PG8_SA(0, 0), a2, voffA);
            PG8_WAIT_V(8); PG8_WAIT_L(0); PG8_BAR; PG8_MMA(1, 0, At, B0); PG8_MMA(1, 1, At, B1); PG8_BAR; PG8_SCHED;
            PG8_LDB(B0, 1, 0); PG8_LDB(B1, 1, 1); PG8_SCHED; PG8_LDA(At, 1, 0); PG8_STAGE(PG8_SA(0, 1), a2 + hstep, voffA);
            PG8_WAIT_V(8); PG8_WAIT_L(0); PG8_BAR; PG8_MMA(0, 0, At, B0); PG8_MMA(0, 1, At, B1); PG8_BAR; PG8_SCHED;
            PG8_LDA(At, 1, 1); PG8_STAGE(PG8_SB(1, 0), b3, voffB); PG8_STAGE(PG8_SB(1, 1), b3 + hstep, voffB); PG8_STAGE(PG8_SA(1, 0), a3, voffA);
            PG8_WAIT_V(8); PG8_WAIT_L(0); PG8_BAR; PG8_MMA(1, 0, At, B0); PG8_MMA(1, 1, At, B1); PG8_BAR; PG8_SCHED;
            } else {
            PG8_LDB(B0, 0, 0); PG8_SCHED; PG8_LDA(At, 0, 0); PG8_STAGE(PG8_SA(1, 1), a1 + hstep, voffA);
            PG8_WAIT_L(8); PG8_BAR; PG8_WAIT_L(0); PG8_MMA(0, 0, At, B0); PG8_BAR; PG8_SCHED;
            PG8_LDB(B1, 0, 1); PG8_STAGE(PG8_SB(0, 0), b2, voffB);
            PG8_BAR; PG8_WAIT_L(0); PG8_MMA(0, 1, At, B1); PG8_BAR;
            PG8_LDA(At, 0, 1); PG8_STAGE(PG8_SA(0, 0), a2, voffA);
            PG8_BAR; PG8_WAIT_L(0); PG8_MMA(1, 0, At, B0); PG8_BAR; PG8_SCHED;
            PG8_STAGE(PG8_SB(0, 1), b2 + hstep, voffB);
            PG8_WAIT_V(6); PG8_BAR; PG8_MMA(1, 1, At, B1); PG8_BAR;
            PG8_LDB(B0, 1, 0); PG8_SCHED; PG8_LDA(At, 1, 0); PG8_STAGE(PG8_SA(0, 1), a2 + hstep, voffA);
            PG8_WAIT_L(8); PG8_BAR; PG8_WAIT_L(0); PG8_MMA(0, 0, At, B0); PG8_BAR; PG8_SCHED;
            PG8_LDB(B1, 1, 1); PG8_STAGE(PG8_SB(1, 0), b3, voffB);
            PG8_BAR; PG8_WAIT_L(0); PG8_MMA(0, 1, At, B1); PG8_BAR;
            PG8_LDA(At, 1, 1); PG8_STAGE(PG8_SA(1, 0), a3, voffA);
            PG8_BAR; PG8_WAIT_L(0); PG8_MMA(1, 0, At, B0); PG8_BAR; PG8_SCHED;
            PG8_STAGE(PG8_SB(1, 1), b3 + hstep, voffB);
            PG8_WAIT_V(6); PG8_BAR; PG8_MMA(1, 1, At, B1); PG8_BAR;
            }
        }
        if constexpr (ALIGN_EPI) { if (wr == 0) PG8_BAR; }
        if constexpr (!Epi::AFTER_DRAIN) { E(acc, cur, wr, wc, fr, fq); S.done(cur); }
        if (!has_next) break;
#pragma unroll
        for (int a = 0; a < 2; ++a)
#pragma unroll
            for (int b = 0; b < 2; ++b)
#pragma unroll
                for (int m = 0; m < 4; ++m)
#pragma unroll
                    for (int n = 0; n < 2; ++n) acc[a][b][m][n] = (f32x4){0.f, 0.f, 0.f, 0.f};
        cur = nxt; cA = nA; cB = nB; ++ui;
        if constexpr (ALIGN_EPI) { if (wr == 1) PG8_BAR; }
    }
    PG8_WAIT_V(0);
    if constexpr (!ALIGN_EPI) { if (wr == 0) PG8_BAR; }
    PG8_BAR;
    if constexpr (Epi::AFTER_DRAIN) { E.fused(acc, cur, wr, wc, fr, fq, lds, wid, lane); S.done(cur); }
#undef PG8_SA
#undef PG8_SB
#undef PG8_STAGE
#undef PG8_LDA
#undef PG8_LDB
#undef PG8_MMA
#undef PG8_WAIT_V
#undef PG8_WAIT_L
#undef PG8_BAR
#undef PG8_SCHED
}
}
namespace mk {
constexpr int D = 1024, SEQ = 8192, NBMAX = 4, NH = 4, DIN = 5152, NE = 32, DE = 512, DEPTH = 2;
constexpr int NT_IN = 22, NIN = NT_IN * 256;
constexpr int NWAVES = 8, NTHR = 512;
constexpr float LOG2E = 1.4426950408889634f, QSCALE = 0.125f * LOG2E, RMS_EPS = 1e-6f;
constexpr int O_GQ = 0, O_GK = 256, O_GV = 512, O_GG = 1024, O_LRF = 1536, O_LRB = 1552, O_DQ = 1568, O_DK = 2080, O_DV = 2592, O_GA = 3104, O_GB = 4128;
typedef unsigned short bf16;
typedef unsigned u32x4 __attribute__((ext_vector_type(4)));
typedef unsigned u32x2 __attribute__((ext_vector_type(2)));
typedef float f32x4 __attribute__((ext_vector_type(4)));
typedef float f32x16 __attribute__((ext_vector_type(16)));
typedef short bf16x8 __attribute__((ext_vector_type(8)));
typedef short s16x4 __attribute__((ext_vector_type(4)));
#define LAS __attribute__((address_space(3)))
#define GAS __attribute__((address_space(1)))
#define LDS_WAIT() asm volatile("s_waitcnt lgkmcnt(0)" ::: "memory")
#define VM_WAIT() asm volatile("s_waitcnt vmcnt(0)" ::: "memory")

constexpr size_t MiB = 1u << 20;
constexpr size_t CTL_BYTES = 256 * 1024;
constexpr int CW_BAR = 4096;
constexpr int CW_CNT = 32768;
constexpr size_t OFF_MOD = 256 * 1024, OFF_TAB = 512 * 1024;
constexpr size_t OFF_WIN = 1 * MiB, SZ_WIN = (size_t)DEPTH * NIN * D * 2;
constexpr size_t OFF_WAB = OFF_WIN + SZ_WIN, SZ_WAB = (size_t)DEPTH * D * D * 2;
constexpr size_t OFF_WO = OFF_WAB + SZ_WAB, SZ_WO = SZ_WAB;
constexpr size_t OFF_WR = OFF_WO + SZ_WO, SZ_WR = (size_t)DEPTH * 256 * D * 2;
constexpr size_t OFF_W1 = OFF_WR + SZ_WR, SZ_W1 = (size_t)DEPTH * NE * 1024 * D * 2;
constexpr size_t OFF_W2 = OFF_W1 + SZ_W1, SZ_W2 = (size_t)DEPTH * NE * D * DE * 2;
constexpr size_t OFF_ACT = 225 * MiB;
static_assert(OFF_W2 + SZ_W2 <= OFF_ACT, "weights fit");
struct WS {
    unsigned* ctl; float* mod; float* tab;
    bf16 *win, *wab, *wo, *wr, *w1, *w2;
    bf16 *H, *OAB; int* eid; float* gate; int* rank; int* pos; int* tilee; int* segp;
    bf16 *GQ, *GK, *GV, *SG; float *LGF, *LGB; bf16 *DQ, *DK, *DV, *SGA, *SGB; float* KVT; float* DEC; bf16* MERGED;
    bf16 *XS, *ACT, *YS; float* LOGITS; float* gsort;
    size_t end;
};
__host__ __device__ inline WS ws_map(unsigned char* b, int nb) {
    WS w; const size_t T = (size_t)nb * SEQ;
    w.ctl = (unsigned*)b; w.mod = (float*)(b + OFF_MOD); w.tab = (float*)(b + OFF_TAB);
    w.win = (bf16*)(b + OFF_WIN); w.wab = (bf16*)(b + OFF_WAB); w.wo = (bf16*)(b + OFF_WO); w.wr = (bf16*)(b + OFF_WR); w.w1 = (bf16*)(b + OFF_W1); w.w2 = (bf16*)(b + OFF_W2);
    size_t o = OFF_ACT;
    auto take = [&](size_t bytes) { unsigned char* p = b + o; o += (bytes + 255) & ~(size_t)255; return p; };
    w.H = (bf16*)take(T * 2048); w.OAB = (bf16*)take(T * 2048);
    w.eid = (int*)take(T * 8); w.gate = (float*)take(T * 8); w.rank = (int*)take(T * 8); w.pos = (int*)take(T * 8); w.tilee = (int*)take(4096); w.segp = (int*)take(1024);
    const size_t u0 = o;
    w.GQ = (bf16*)take(T * 512); w.GK = (bf16*)take(T * 512); w.GV = (bf16*)take(T * 1024); w.SG = (bf16*)take(T * 1024);
    w.LGF = (float*)take(T * 1024); w.LGB = (float*)take(T * 1024);
    w.DQ = (bf16*)take(T * 1024); w.DK = (bf16*)take(T * 1024); w.DV = (bf16*)take(T * 1024); w.SGA = (bf16*)take(T * 2048); w.SGB = (bf16*)take(T * 2048);
    w.KVT = (float*)take(T * 4096); w.MERGED = (bf16*)w.KVT; w.DEC = (float*)take(T * 32);
    const size_t e1 = o; o = u0;
    const size_t R = 2 * T + 32 * 256;
    w.XS = (bf16*)take(R * 2048); w.ACT = (bf16*)take(R * 1024); w.YS = (bf16*)take(R * 2048); w.LOGITS = (float*)take(T * 256); w.gsort = (float*)take(R * 4);
    w.end = o > e1 ? o : e1;
    return w;
}

__device__ __forceinline__ unsigned cvt_pk(float lo, float hi) { unsigned r; asm volatile("v_cvt_pk_bf16_f32 %0, %1, %2" : "=v"(r) : "v"(lo), "v"(hi)); return r; }
__device__ __forceinline__ float bf2f(unsigned short b) { return __uint_as_float(((unsigned)b) << 16); }
__device__ __forceinline__ float bflo(unsigned w) { return __uint_as_float(w << 16); }
__device__ __forceinline__ float bfhi(unsigned w) { return __uint_as_float(w & 0xffff0000u); }
__device__ __forceinline__ float fsigmoid(float x) { return __builtin_amdgcn_rcpf(1.f + __expf(-x)); }
__device__ __forceinline__ float fsilu(float x) { return x * fsigmoid(x); }
__device__ __forceinline__ float wave_sum(float v) {
#pragma unroll
    for (int o = 1; o < 64; o <<= 1) v += __shfl_xor(v, o);
    return v;
}
__device__ __forceinline__ int t5_bucket(int rel) {
    int ret = rel > 0 ? 16 : 0; int n = rel < 0 ? -rel : rel;
    if (n < 8) return ret + n;
    return ret + 8 + (n >= 12) + (n >= 16) + (n >= 23) + (n >= 32) + (n >= 46) + (n >= 64) + (n >= 91);
}

#define XB_TMO      128
#define XB_XCNT(j)  (256  + 64 * (j))
#define XB_XSUB(j)  (1280 + 64 * (j))
#define XB_XGEN(j)  (2304 + 64 * (j))
#define XB_TOP      3328
#define XB_TOPGEN   3392
#define XCD_BAR_WORDS 3456
#define XB_SPIN_CAP (1u << 18)
__device__ __forceinline__ unsigned xb_ld(unsigned* p)              { return __hip_atomic_load(p, __ATOMIC_RELAXED, __HIP_MEMORY_SCOPE_AGENT); }
__device__ __forceinline__ unsigned xb_add(unsigned* p, unsigned v) { return __hip_atomic_fetch_add(p, v, __ATOMIC_RELAXED, __HIP_MEMORY_SCOPE_AGENT); }
__device__ __forceinline__ unsigned xb_xcc_id() { return (unsigned)__builtin_amdgcn_s_getreg((3 << 11) | 20) & 0xFu; }
#define XB_SPIN(cond, bar) do { unsigned _sp = 0; while (cond) { __builtin_amdgcn_s_sleep(1); \
    if ((++_sp & 255u) == 0u) { if (xb_ld(&(bar)[XB_TMO])) break; if (_sp > XB_SPIN_CAP) { atomicAdd(&(bar)[XB_TMO], 1u); break; } } } } while (0)
struct XcdBarrier { unsigned* bar; unsigned x; volatile LAS unsigned* st; };
__device__ __forceinline__ XcdBarrier xcd_barrier_post(unsigned* bar, volatile LAS unsigned* st) {
    XcdBarrier b; b.bar = bar; b.x = xb_xcc_id(); b.st = st;
    if (threadIdx.x == 0) (void)xb_add(&bar[XB_XCNT(b.x)], 1u);
    return b;
}
__device__ __forceinline__ void xcd_barrier_complete(unsigned* bar, unsigned x, unsigned& nloc, unsigned& nx) {
    const unsigned G = gridDim.x * gridDim.y * gridDim.z;
    unsigned sum, cnt, mine, sp = 0u;
    for (;;) {
        sum = 0u; cnt = 0u; mine = 0u;
#pragma unroll
        for (unsigned j = 0; j < 16; ++j) { const unsigned c = xb_ld(&bar[XB_XCNT(j)]); sum += c; cnt += (c > 0u) ? 1u : 0u; mine = (j == x) ? c : mine; }
        if (sum == G) break;
        __builtin_amdgcn_s_sleep(1);
        if ((++sp & 255u) == 0u) { if (xb_ld(&bar[XB_TMO])) break; if (sp > XB_SPIN_CAP) { atomicAdd(&bar[XB_TMO], 1u); break; } }
    }
    nloc = mine > 0u ? mine : 1u; nx = cnt > 0u ? cnt : 1u;
}
__device__ __forceinline__ void xcd_barrier(const XcdBarrier& b) {
    asm volatile("s_waitcnt vmcnt(0)" ::: "memory");
    __syncthreads();
    if (threadIdx.x == 0) {
        unsigned* bar = b.bar;
        __builtin_amdgcn_s_waitcnt(0);
        unsigned nloc = b.st[0], nx = b.st[1];
        if (nloc == 0u) { xcd_barrier_complete(bar, b.x, nloc, nx); b.st[0] = nloc; b.st[1] = nx; }
        const unsigned old = xb_add(&bar[XB_XSUB(b.x)], 1u);
        const unsigned gen = old / nloc;
        if (old + 1u == (gen + 1u) * nloc) {
            __builtin_amdgcn_fence(__ATOMIC_RELEASE, "agent");
            asm volatile("s_waitcnt vmcnt(0)" ::: "memory");
            const unsigned og = xb_add(&bar[XB_TOP], 1u);
            const unsigned tg = og / nx;
            if (og + 1u == (tg + 1u) * nx) xb_add(&bar[XB_TOPGEN], 1u);
            else XB_SPIN(xb_ld(&bar[XB_TOPGEN]) == tg, bar);
            __builtin_amdgcn_fence(__ATOMIC_ACQUIRE, "agent");
            xb_add(&bar[XB_XGEN(b.x)], 1u);
            asm volatile("s_waitcnt vmcnt(0)" ::: "memory");
        } else {
            XB_SPIN(xb_ld(&bar[XB_XGEN(b.x)]) == gen, bar);
            __builtin_amdgcn_fence(__ATOMIC_ACQUIRE, "agent");
            asm volatile("s_waitcnt vmcnt(0)" ::: "memory");
        }
    }
    __syncthreads();
}

struct Args { const float* in[24]; float* out; unsigned char* ws; int nb, ph_lo, ph_hi, li; };
struct Frame {
    LAS unsigned char* lds; int tid, lane, wave, G, bid, nb, T; unsigned char* ws; const Args* a; float* xbuf;
};
__device__ __forceinline__ void refresh(Frame& F) { int t = threadIdx.x; asm volatile("" : "+v"(t)); F.tid = t; F.lane = t & 63; F.wave = __builtin_amdgcn_readfirstlane(t >> 6); }
constexpr int LDS_BYTES = 160 * 1024 - 64 * 0;
constexpr int LDS_MISC = 160 * 1024 - 256;

__device__ __forceinline__ void tr_item(const float* src, int lds_, int ks0, int c0, bf16* dst, int ldd, int r0, int kd0, LAS float* scr, int lane) {
#pragma unroll 8
    for (int i = 0; i < 32; ++i) { const int kk = 2 * i + (lane >> 5); scr[kk * 33 + (lane & 31)] = src[(size_t)(ks0 + kk) * lds_ + c0 + (lane & 31)]; }
    LDS_WAIT(); asm volatile("" ::: "memory");
    const int c = lane & 7;
#pragma unroll
    for (int j = 0; j < 4; ++j) { const int n = (lane >> 3) + 8 * j; const LAS float* s = scr + (8 * c) * 33 + n;
        u32x4 o; o.x = cvt_pk(s[0 * 33], s[1 * 33]); o.y = cvt_pk(s[2 * 33], s[3 * 33]); o.z = cvt_pk(s[4 * 33], s[5 * 33]); o.w = cvt_pk(s[6 * 33], s[7 * 33]);
        *(u32x4*)(dst + (size_t)(r0 + n) * ldd + kd0 + 8 * c) = o; }
    LDS_WAIT(); asm volatile("" ::: "memory");
}
__device__ __forceinline__ int win_src_col(int tile, int p0) {
    const int bj = p0 >> 7, wc = (p0 >> 5) & 3; const int L = 64 * wc + 32 * bj;
    switch (tile) {
        case 0: return O_GQ + p0; case 1: return O_GK + p0;
        case 2: case 3: return O_GV + (tile - 2) * 256 + p0;
        case 4: case 5: return O_GG + (tile - 4) * 256 + p0;
        case 8: case 9: return O_DQ + (tile - 8) * 256 + L;
        case 10: case 11: return O_DK + (tile - 10) * 256 + L;
        case 12: case 13: return O_DV + (tile - 12) * 256 + p0;
        case 14: case 15: case 16: case 17: return O_GA + (tile - 14) * 256 + p0;
        default: return O_GB + (tile - 18) * 256 + p0;
    }
}
__device__ __forceinline__ void p0_prologue(Frame& F) {
    refresh(F);
    const WS W = ws_map(F.ws, F.nb); const float* const* IN_ = F.a->in;
    const float* c_in = IN_[1]; const float* w_ada = IN_[2]; const float* b_ada = IN_[3];
    {
        LAS float* red = (LAS float*)F.lds;
        for (int it = F.bid; it < DEPTH * 96; it += F.G) {
            const int l = it / 96, j = (it % 96) * 64 + F.lane;
            const float* w = w_ada + (size_t)l * D * 6 * D + j;
            float a0 = 0.f, a1 = 0.f, a2 = 0.f, a3 = 0.f;
            const int kbeg = F.wave * 128;
#pragma unroll 16
            for (int k = kbeg; k < kbeg + 128; ++k) { const float wv = w[(size_t)k * 6 * D];
                const float c0 = c_in[k], c1 = c_in[D + k], c2 = c_in[2 * D + k], c3 = c_in[3 * D + k];
                a0 += fsilu(c0) * wv; a1 += fsilu(c1) * wv; a2 += fsilu(c2) * wv; a3 += fsilu(c3) * wv; }
            red[(F.wave * 4 + 0) * 64 + F.lane] = a0; red[(F.wave * 4 + 1) * 64 + F.lane] = a1; red[(F.wave * 4 + 2) * 64 + F.lane] = a2; red[(F.wave * 4 + 3) * 64 + F.lane] = a3;
            __syncthreads();
            if (F.tid < 256) { const int b = F.tid >> 6, jj = F.tid & 63; float s = 0.f;
#pragma unroll
                for (int wv = 0; wv < 8; ++wv) s += red[(wv * 4 + b) * 64 + jj];
                const int jc = (it % 96) * 64 + jj;
                W.mod[((size_t)l * NBMAX + b) * 6 * D + jc] = s + b_ada[l * 6 * D + jc]; }
            __syncthreads();
        }
    }
    if (F.bid == 0) {
        const float* rb = IN_[14];
        for (int i = F.tid; i < 1024; i += NTHR) { const int h = i >> 8, rel = (i & 255) - 128; W.tab[i] = (rb[t5_bucket(rel) * 4 + h] - rb[31 * 4 + h]) * LOG2E; }
        if (F.tid < 4) W.tab[1024 + F.tid] = __expf(rb[15 * 4 + F.tid] - rb[31 * 4 + F.tid]);
        if (F.tid >= 64 && F.tid < 64 + DEPTH) { const int l = F.tid - 64; const float* lv = IN_[12] + l * 256; float s1 = 0.f, s2 = 0.f;
            for (int i = 0; i < 64; ++i) { s1 += lv[i] * lv[64 + i]; s2 += lv[128 + i] * lv[192 + i]; }
            W.tab[1032 + l] = expf(s1) - expf(s2) + (0.8f - 0.6f * expf(-0.3f * (float)l)); }
    }
    __syncthreads();
    LAS float* scr = (LAS float*)(F.lds + F.wave * 16384);
    const int gw = F.bid * NWAVES + F.wave, NGW = F.G * NWAVES;
    constexpr int I_IN = (NIN / 32) * 16, I_AB = 32 * 16, I_O = 32 * 16, I_1 = NE * 32 * 16, I_2 = NE * 32 * 8;
    constexpr int PER_L = I_IN + I_AB + I_O + I_1 + I_2;
    for (int it = gw; it < DEPTH * PER_L; it += NGW) {
        const int l = it / PER_L; int r = it % PER_L;
        if (r < I_IN) { const int rb = r / 16, kb = r % 16, R = rb * 32, tile = R >> 8, p0 = R & 255;
            if (tile == 6 || tile == 7) continue;
            tr_item(IN_[6] + (size_t)l * D * DIN, DIN, kb * 64, win_src_col(tile, p0), W.win + (size_t)l * NIN * D, D, R, kb * 64, scr, F.lane); continue; }
        r -= I_IN;
        if (r < I_AB) { const int rb = r / 16, kb = r % 16;
            if (kb < 8) tr_item(IN_[15] + (size_t)l * 512 * D, D, kb * 64, rb * 32, W.wab + (size_t)l * D * D, 512, rb * 32, kb * 64, scr, F.lane);
            else tr_item(IN_[16] + (size_t)l * 512 * D, D, (kb - 8) * 64, rb * 32, W.wab + (size_t)l * D * D + (size_t)1024 * 512, 512, rb * 32, (kb - 8) * 64, scr, F.lane);
            continue; }
        r -= I_AB;
        if (r < I_O) { const int rb = r / 16, kb = r % 16; tr_item(IN_[17] + (size_t)l * D * D, D, kb * 64, rb * 32, W.wo + (size_t)l * D * D, D, rb * 32, kb * 64, scr, F.lane); continue; }
        r -= I_O;
        if (r < I_1) { const int e = r / 512, q = r % 512, rb = q / 16, kb = q % 16, R = rb * 32, pn = R >> 8, p = R & 255;
            const int col = (p < 128) ? (128 * pn + p) : (512 + 128 * pn + p - 128);
            tr_item(IN_[22] + ((size_t)l * NE + e) * D * 1024, 1024, kb * 64, col, W.w1 + ((size_t)l * NE + e) * 1024 * D, D, R, kb * 64, scr, F.lane); continue; }
        r -= I_1;
        { const int e = r / 256, q = r % 256, rb = q / 8, kb = q % 8;
          tr_item(IN_[23] + ((size_t)l * NE + e) * DE * D, D, kb * 64, rb * 32, W.w2 + ((size_t)l * NE + e) * D * DE, DE, rb * 32, kb * 64, scr, F.lane); }
    }
    for (int it = gw; it < DEPTH * 2 * 8 * 16; it += NGW) {
        const int l = it >> 8, dir = (it >> 7) & 1, nbk = (it >> 4) & 7, kb = it & 15; const int k = kb * 64 + F.lane;
        const float* wi = IN_[6] + (size_t)l * D * DIN + (size_t)k * DIN + (dir ? O_LRB : O_LRF);
        float wv[16];
#pragma unroll
        for (int r = 0; r < 16; ++r) wv[r] = wi[r];
        const float* wu = IN_[7] + ((size_t)l * 2 + dir) * 16 * 256;
        bf16* dst = W.win + (size_t)l * NIN * D + (size_t)((6 + dir) * 256) * D;
        for (int n = nbk * 32; n < nbk * 32 + 32; ++n) { float s = 0.f;
#pragma unroll
            for (int r = 0; r < 16; ++r) s += wv[r] * wu[r * 256 + n];
            dst[(size_t)n * D + k] = (bf16)(cvt_pk(s, 0.f) & 0xffffu); }
    }
    for (int it = gw * 64 + F.lane; it < DEPTH * 256 * 128; it += NGW * 64) {
        const int l = it / (256 * 128), q = it % (256 * 128), row = q >> 7, k0 = (q & 127) * 8;
        float v[8];
#pragma unroll
        for (int i = 0; i < 8; ++i) { float x = 0.f;
            if (row < 4) x = IN_[18][((size_t)l * D + k0 + i) * 4 + row]; else if (row < 36) x = IN_[20][((size_t)l * D + k0 + i) * 32 + row - 4];
            v[i] = x; }
        u32x4 o; o.x = cvt_pk(v[0], v[1]); o.y = cvt_pk(v[2], v[3]); o.z = cvt_pk(v[4], v[5]); o.w = cvt_pk(v[6], v[7]);
        *(u32x4*)(W.wr + ((size_t)l * 256 + row) * D + k0) = o;
    }
}

__device__ __forceinline__ void phase_norm(Frame& F, int l, int mode) {
    refresh(F);
    const WS W = ws_map(F.ws, F.nb); const float* const* IN_ = F.a->in;
    const int gw = F.bid * NWAVES + F.wave, NGW = F.G * NWAVES;
    const bool combine = (mode == 2) || (mode == 0 && l > 0);
    const int lp = (mode == 2) ? DEPTH - 1 : l - 1;
    const float* xsrc = (mode == 0 && l == 0) ? IN_[0] : F.xbuf;
    const float* ng = (mode == 1 ? IN_[5] : IN_[4]) + (size_t)(mode == 2 ? 0 : l) * D;
    for (int t = gw; t < F.T; t += NGW) {
        const int b = t / SEQ;
        const GAS f32x4* xr = (const GAS f32x4*)(xsrc + (size_t)t * D) + F.lane;
        f32x4 v[4];
#pragma unroll
        for (int j = 0; j < 4; ++j) v[j] = xr[64 * j];
        if (combine) {
            const float* g2 = W.mod + ((size_t)lp * NBMAX + b) * 6 * D + 5 * D;
            const int p0 = W.pos[t * 2], p1 = W.pos[t * 2 + 1];
            const GAS u32x2* y0 = (const GAS u32x2*)(W.YS + (size_t)p0 * D) + F.lane; const GAS u32x2* y1 = (const GAS u32x2*)(W.YS + (size_t)p1 * D) + F.lane;
#pragma unroll
            for (int j = 0; j < 4; ++j) { const u32x2 a = y0[64 * j], c = y1[64 * j]; const f32x4 g = *((const GAS f32x4*)g2 + F.lane + 64 * j);
                v[j].x += g.x * (bflo(a.x) + bflo(c.x)); v[j].y += g.y * (bfhi(a.x) + bfhi(c.x)); v[j].z += g.z * (bflo(a.y) + bflo(c.y)); v[j].w += g.w * (bfhi(a.y) + bfhi(c.y)); }
            GAS f32x4* xo = (GAS f32x4*)(F.xbuf + (size_t)t * D) + F.lane;
#pragma unroll
            for (int j = 0; j < 4; ++j) xo[64 * j] = v[j];
        }
        if (mode == 2) continue;
        float ss = 0.f;
#pragma unroll
        for (int j = 0; j < 4; ++j) ss += (v[j].x * v[j].x + v[j].y * v[j].y) + (v[j].z * v[j].z + v[j].w * v[j].w);
        const float rstd = rsqrtf(wave_sum(ss) * (1.f / D) + RMS_EPS);
        const float* md = W.mod + ((size_t)l * NBMAX + b) * 6 * D + (mode == 1 ? 3 * D : 0);
        GAS u32x2* ho = (GAS u32x2*)(W.H + (size_t)t * D) + F.lane;
#pragma unroll
        for (int j = 0; j < 4; ++j) { const f32x4 g = *((const GAS f32x4*)ng + F.lane + 64 * j), sh = *((const GAS f32x4*)md + F.lane + 64 * j), sc = *((const GAS f32x4*)(md + D) + F.lane + 64 * j);
            const float h0 = v[j].x * rstd * g.x * (1.f + sc.x) + sh.x, h1 = v[j].y * rstd * g.y * (1.f + sc.y) + sh.y, h2 = v[j].z * rstd * g.z * (1.f + sc.z) + sh.z, h3 = v[j].w * rstd * g.w * (1.f + sc.w) + sh.w;
            u32x2 o; o.x = cvt_pk(h0, h1); o.y = cvt_pk(h2, h3); ho[64 * j] = o; }
    }
}
typedef pg8::Unit Unit;
__device__ __forceinline__ u32x4 pack8(const f32x4& a, const f32x4& b) { u32x4 w; w.x = cvt_pk(a[0], a[1]); w.y = cvt_pk(a[2], a[3]); w.z = cvt_pk(b[0], b[1]); w.w = cvt_pk(b[2], b[3]); return w; }

#ifndef MK_ATT_FP8
#define MK_ATT_FP8 1
#endif
__device__ __forceinline__ u32x2 pack8_fp8(const f32x4& a, const f32x4& b) { int w0 = 0, w1 = 0;
    w0 = __builtin_amdgcn_cvt_pk_fp8_f32(a[0], a[1], w0, false); w0 = __builtin_amdgcn_cvt_pk_fp8_f32(a[2], a[3], w0, true);
    w1 = __builtin_amdgcn_cvt_pk_fp8_f32(b[0], b[1], w1, false); w1 = __builtin_amdgcn_cvt_pk_fp8_f32(b[2], b[3], w1, true);
    u32x2 r; r.x = (unsigned)w0; r.y = (unsigned)w1; return r; }
struct EpiIn {
    static constexpr bool PERM = true, AFTER_DRAIN = false, MIDK = false;
    bf16 *GQ, *GK, *GV, *SG; float *LGF, *LGB; bf16 *DQ, *DK, *DV, *SGA, *SGB; const float* b_up; const float* qg; const float* kg;
    __device__ __forceinline__ void operator()(const f32x4 (&acc)[2][2][4][2], const Unit& u, int wr, int wc, int fr, int fq) const {
        const int pn = u.pn; const int row0 = u.pm * 256 + wr * 64 + fr;
        if (pn >= 8 && pn <= 11) {
            const bool isk = pn >= 10; const int head = 2 * ((pn - 8) & 1) + (wc >> 1), c = wc & 1;
            const float* gv = isk ? kg : qg; const float sc = isk ? 1.f : QSCALE;
            f32x4 g[2][2];
#pragma unroll
            for (int bj = 0; bj < 2; ++bj)
#pragma unroll
                for (int n = 0; n < 2; ++n) g[bj][n] = *(const f32x4*)(gv + 32 * bj + 8 * fq + 4 * n);
#pragma unroll
            for (int ai = 0; ai < 2; ++ai)
#pragma unroll
                for (int m = 0; m < 4; ++m) {
                    const int r = row0 + ai * 128 + m * 16, b = r / SEQ, s = r % SEQ;
                    float ss = 0.f;
#pragma unroll
                    for (int bj = 0; bj < 2; ++bj)
#pragma unroll
                        for (int n = 0; n < 2; ++n) { const f32x4 x = acc[ai][bj][m][n]; ss += (x[0] * x[0] + x[1] * x[1]) + (x[2] * x[2] + x[3] * x[3]); }
                    ss += __shfl_xor(ss, 16); ss += __shfl_xor(ss, 32);
                    const float rs = rsqrtf(ss * (1.f / 64.f) + RMS_EPS) * sc;
#if MK_ATT_FP8
                    unsigned char* dst8 = (unsigned char*)(isk ? DK : DQ) + ((((size_t)b * NH + head) * 2 + c) * SEQ + s) * 64;
#pragma unroll
                    for (int bj = 0; bj < 2; ++bj) {
                        const f32x4 v0 = acc[ai][bj][m][0] * rs * g[bj][0], v1 = acc[ai][bj][m][1] * rs * g[bj][1];
                        int chunk = 2 * bj + (fq >> 1); if (isk) chunk ^= ((s >> 2) & 3);
                        *(u32x2*)(dst8 + chunk * 16 + 8 * (fq & 1)) = pack8_fp8(v0, v1);
                    }
#else
                    bf16* dst = (isk ? DK : DQ) + ((((size_t)b * NH + head) * 2 + c) * SEQ + s) * 64;
#pragma unroll
                    for (int bj = 0; bj < 2; ++bj) {
                        const f32x4 v0 = acc[ai][bj][m][0] * rs * g[bj][0], v1 = acc[ai][bj][m][1] * rs * g[bj][1];
                        int chunk = 4 * bj + fq; if (isk) chunk ^= ((s >> 1) & 7);
                        *(u32x4*)(dst + chunk * 8) = pack8(v0, v1);
                    }
#endif
                }
            return;
        }
#pragma unroll
        for (int ai = 0; ai < 2; ++ai)
#pragma unroll
            for (int m = 0; m < 4; ++m) {
                const int r = row0 + ai * 128 + m * 16;
#pragma unroll
                for (int bj = 0; bj < 2; ++bj) {
                    const int c0 = 128 * bj + 32 * wc + 8 * fq;
                    f32x4 v0 = acc[ai][bj][m][0], v1 = acc[ai][bj][m][1];
                    if (pn == 0) { *(u32x4*)(GQ + (size_t)r * 256 + c0) = pack8(v0 * 0.125f, v1 * 0.125f); }
                    else if (pn == 1) { *(u32x4*)(GK + (size_t)r * 256 + c0) = pack8(v0, v1); }
                    else if (pn <= 3) { *(u32x4*)(GV + (size_t)r * 512 + (pn - 2) * 256 + c0) = pack8(v0, v1); }
                    else if (pn <= 5) {
#pragma unroll
                        for (int i = 0; i < 4; ++i) { v0[i] = fsilu(v0[i]); v1[i] = fsilu(v1[i]); }
                        *(u32x4*)(SG + (size_t)r * 512 + (pn - 4) * 256 + c0) = pack8(v0, v1); }
                    else if (pn <= 7) {
                        const float* bu = b_up + (pn - 6) * 256 + c0; const f32x4 b0 = *(const f32x4*)bu, b1 = *(const f32x4*)(bu + 4);
#pragma unroll
                        for (int i = 0; i < 4; ++i) { float z = v0[i] + b0[i]; v0[i] = (fminf(z, 0.f) - __logf(1.f + __expf(-fabsf(z)))) * (1.f / 16.f);
                                                      z = v1[i] + b1[i]; v1[i] = (fminf(z, 0.f) - __logf(1.f + __expf(-fabsf(z)))) * (1.f / 16.f); }
                        float* o = (pn == 6 ? LGF : LGB) + (size_t)r * 256 + c0; *(f32x4*)o = v0; *(f32x4*)(o + 4) = v1; }
#if MK_ATT_FP8
                    else if (pn <= 13) {
                        const int b = r / SEQ, s = r % SEQ, head = 2 * (pn - 12) + bj;
                        const int kk = s & 63, wkey = kk & 31, hh_ = (wkey >> 2) & 1, reg_ = (wkey & 3) + 4 * (wkey >> 3), pos = hh_ * 32 + 16 * (kk >> 5) + reg_;
                        unsigned char* tb = (unsigned char*)DV + (((size_t)b * NH + head) * (SEQ / 64) + (s >> 6)) * 8192;
                        const u32x2 pk = pack8_fp8(v0, v1); const int dv0 = 32 * wc + 8 * fq;
#pragma unroll
                        for (int i = 0; i < 8; ++i) { const int dv = dv0 + i; const unsigned byte = ((i < 4 ? pk.x : pk.y) >> (8 * (i & 3))) & 0xffu;
                            tb[dv * 64 + ((((pos >> 4) ^ ((dv >> 2) & 3)) << 4) | (pos & 15))] = (unsigned char)byte; } }
#else
                    else if (pn <= 13) {
                        const int b = r / SEQ, s = r % SEQ, head = 2 * (pn - 12) + bj;
                        bf16* dst = DV + ((((size_t)b * NH + head) * (SEQ / 8) + (s >> 3)) * 4 + wc) * 256 + (s & 7) * 32 + 8 * fq;
                        *(u32x4*)dst = pack8(v0, v1); }
#endif
                    else {
#pragma unroll
                        for (int i = 0; i < 4; ++i) { v0[i] = fsigmoid(v0[i]); v1[i] = fsigmoid(v1[i]); }
                        bf16* base = (pn <= 17) ? SGA + (pn - 14) * 256 : SGB + (pn - 18) * 256;
                        *(u32x4*)(base + (size_t)r * D + c0) = pack8(v0, v1); }
                }
            }
    }
};

struct EpiMerge {
    static constexpr bool PERM = true, AFTER_DRAIN = false, MIDK = false;
    const bf16* SGA; const bf16* SGB; bf16* O; int nM;
    __device__ __forceinline__ void operator()(const f32x4 (&acc)[2][2][4][2], const Unit& u, int wr, int wc, int fr, int fq) const {
        const int sel = u.pn >> 2; const int row0 = (u.pm - sel * nM) * 256 + wr * 64 + fr, col0 = (u.pn & 3) * 256 + wc * 32 + 8 * fq;
        const bf16* G = sel ? SGB : SGA;
#pragma unroll
        for (int ai = 0; ai < 2; ++ai)
#pragma unroll
            for (int m = 0; m < 4; ++m) { const size_t off = (size_t)(row0 + ai * 128 + m * 16) * D + col0;
#pragma unroll
                for (int bj = 0; bj < 2; ++bj) { const u32x4 b = *(const u32x4*)(G + off + bj * 128);
                    f32x4 v0 = acc[ai][bj][m][0], v1 = acc[ai][bj][m][1];
                    v0[0] *= bflo(b.x); v0[1] *= bfhi(b.x); v0[2] *= bflo(b.y); v0[3] *= bfhi(b.y); v1[0] *= bflo(b.z); v1[1] *= bfhi(b.z); v1[2] *= bflo(b.w); v1[3] *= bfhi(b.w);
                    if (sel) { const u32x4 t = *(const u32x4*)(O + off + bj * 128);
                        v0[0] += bflo(t.x); v0[1] += bfhi(t.x); v0[2] += bflo(t.y); v0[3] += bfhi(t.y); v1[0] += bflo(t.z); v1[1] += bfhi(t.z); v1[2] += bflo(t.w); v1[3] += bfhi(t.w); }
                    *(u32x4*)(O + off + bj * 128) = pack8(v0, v1); }
                asm volatile("" ::: "memory"); }
    }
};
struct MergeOrder {
    pg8::StaticOrder so; int nM;
    __device__ __forceinline__ bool next(int i, Unit& u) const { Unit t; if (!so.next(i >> 1, t)) return false; const int sel = i & 1; u.pm = t.pm + sel * nM; u.pn = t.pn + sel * 4; return true; }
    __device__ __forceinline__ void a_ready(const Unit&) const {}
    __device__ __forceinline__ void done(const Unit&) const {}
};

struct EpiResid {
    static constexpr bool PERM = false, AFTER_DRAIN = false, MIDK = false;
    const float* xin; float* xout; const float* g1;
    __device__ __forceinline__ void operator()(const f32x4 (&acc)[2][2][4][2], const Unit& u, int wr, int wc, int fr, int fq) const {
        const int row0 = u.pm * 256 + wr * 64 + fr, col0 = u.pn * 256 + wc * 32 + 4 * fq;
        const int b = (u.pm * 256) / SEQ; const float* g = g1 + (size_t)b * 6 * D + col0;
        f32x4 gv[2][2];
#pragma unroll
        for (int bj = 0; bj < 2; ++bj)
#pragma unroll
            for (int n = 0; n < 2; ++n) gv[bj][n] = *(const f32x4*)(g + bj * 128 + n * 16);
#pragma unroll
        for (int ai = 0; ai < 2; ++ai)
#pragma unroll
            for (int m = 0; m < 4; ++m) { const size_t off = (size_t)(row0 + ai * 128 + m * 16) * D + col0;
#pragma unroll
                for (int bj = 0; bj < 2; ++bj)
#pragma unroll
                    for (int n = 0; n < 2; ++n) { const f32x4 xv = *(const f32x4*)(xin + off + bj * 128 + n * 16); *(f32x4*)(xout + off + bj * 128 + n * 16) = xv + gv[bj][n] * acc[ai][bj][m][n]; } }
    }
};

struct EpiLogits {
    static constexpr bool PERM = false, AFTER_DRAIN = false, MIDK = false;
    float* L;
    __device__ __forceinline__ void operator()(const f32x4 (&acc)[2][2][4][2], const Unit& u, int wr, int wc, int fr, int fq) const {
        if (wc >= 2) return;
        const int row0 = u.pm * 256 + wr * 64 + fr, col0 = wc * 32 + 4 * fq;
#pragma unroll
        for (int ai = 0; ai < 2; ++ai)
#pragma unroll
            for (int m = 0; m < 4; ++m)
#pragma unroll
                for (int n = 0; n < 2; ++n) *(f32x4*)(L + (size_t)(row0 + ai * 128 + m * 16) * 64 + col0 + n * 16) = acc[ai][0][m][n];
    }
};

struct EpiAct {
    static constexpr bool PERM = true, AFTER_DRAIN = false, MIDK = false;
    bf16* ACT;
    __device__ __forceinline__ void operator()(const f32x4 (&acc)[2][2][4][2], const Unit& u, int wr, int wc, int fr, int fq) const {
        const int row0 = u.pm * 256 + wr * 64 + fr, col0 = (u.pn & 3) * 128 + wc * 32 + 8 * fq;
#pragma unroll
        for (int ai = 0; ai < 2; ++ai)
#pragma unroll
            for (int m = 0; m < 4; ++m) { f32x4 v0, v1;
#pragma unroll
                for (int i = 0; i < 4; ++i) { v0[i] = fsilu(acc[ai][0][m][0][i]) * acc[ai][1][m][0][i]; v1[i] = fsilu(acc[ai][0][m][1][i]) * acc[ai][1][m][1][i]; }
                *(u32x4*)(ACT + (size_t)(row0 + ai * 128 + m * 16) * DE + col0) = pack8(v0, v1); }
    }
};
struct EpiYs {
    static constexpr bool PERM = true, AFTER_DRAIN = false, MIDK = false;
    bf16* YS; const float* gs;
    __device__ __forceinline__ void operator()(const f32x4 (&acc)[2][2][4][2], const Unit& u, int wr, int wc, int fr, int fq) const {
        const int row0 = u.pm * 256 + wr * 64 + fr, col0 = (u.pn & 3) * 256 + wc * 32 + 8 * fq;
#pragma unroll
        for (int ai = 0; ai < 2; ++ai)
#pragma unroll
            for (int m = 0; m < 4; ++m) { const int r = row0 + ai * 128 + m * 16; const float gt = gs[r];
#pragma unroll
                for (int bj = 0; bj < 2; ++bj) *(u32x4*)(YS + (size_t)r * D + col0 + bj * 128) = pack8(acc[ai][bj][m][0] * gt, acc[ai][bj][m][1] * gt); }
    }
};
struct GroupedOrder {
    const int* tilee; int U, G, c;
    __device__ __forceinline__ bool next(int i, Unit& u) const {
        int id;
        if ((G & 7) == 0) { const int gx = G >> 3, per = (U + 7) >> 3, n = i * gx + (c >> 3); if (n >= per) return false; id = (c & 7) * per + n; if (id >= U) return false; }
        else { id = i * G + c; if (id >= U) return false; }
        const int t = id >> 2; u.pm = t; u.pn = tilee[t] * 4 + (id & 3); return true;
    }
    __device__ __forceinline__ void a_ready(const Unit&) const {}
    __device__ __forceinline__ void done(const Unit&) const {}
};
constexpr int AT_KR = 0, AT_VR = 32768, AT_TAB = 65536, AT_SLOT = 8192;
typedef int v8i __attribute__((ext_vector_type(8)));
typedef int v4i __attribute__((ext_vector_type(4)));
__device__ __forceinline__ int crow(int r, int hi) { return (r & 3) + 8 * (r >> 2) + 4 * hi; }

__device__ __forceinline__ void attn_bias(f32x16& s0, f32x16& s1, int relbase, const LAS float* tabh) {
#pragma unroll
    for (int r = 0; r < 16; ++r) {
        int i0 = relbase + (r & 3) + 8 * (r >> 2); int i1 = i0 + 32;
        i0 = i0 < 0 ? 0 : (i0 > 255 ? 255 : i0); i1 = i1 < 0 ? 0 : (i1 > 255 ? 255 : i1);
        s0[r] += tabh[i0]; s1[r] += tabh[i1];
    }
}
template <int J>
__device__ __forceinline__ void attn_exp_chunk(f32x16& s0, f32x16& s1, float& lsum) {
    float ls = 0.f;
#pragma unroll
    for (int r = 4 * J; r < 4 * J + 4; ++r) { s0[r] = __builtin_amdgcn_exp2f(s0[r]); s1[r] = __builtin_amdgcn_exp2f(s1[r]); ls += s0[r] + s1[r]; }
    lsum += ls;
}
__device__ __forceinline__ int pk4_bf8(float a, float b, float c, float d) { int w = 0; w = __builtin_amdgcn_cvt_pk_bf8_f32(a, b, w, false); w = __builtin_amdgcn_cvt_pk_bf8_f32(c, d, w, true); return w; }
__device__ __forceinline__ void glds16(const void* gsrc, unsigned lds_dst) { unsigned keep;
    asm volatile("s_mov_b32 %0, m0\n\ts_mov_b32 m0, %2\n\ts_nop 0\n\tglobal_load_lds_dwordx4 %1, off\n\ts_mov_b32 m0, %0" : "=&s"(keep) : "v"(gsrc), "s"(lds_dst) : "memory"); }
__device__ __forceinline__ void attn_dma_k(unsigned lds0, const unsigned char* kg0, int t, int slot, int wid, int lane) {
    glds16(kg0 + (size_t)(wid >> 2) * SEQ * 64 + (size_t)t * 4096 + (wid & 3) * 1024 + lane * 16, (unsigned)__builtin_amdgcn_readfirstlane((int)(lds0 + AT_KR + slot * AT_SLOT + wid * 1024)));
}
__device__ __forceinline__ void attn_dma_v(unsigned lds0, const unsigned char* vg0, int t, int slot, int wid, int lane) {
    glds16(vg0 + (size_t)t * 8192 + wid * 1024 + lane * 16, (unsigned)__builtin_amdgcn_readfirstlane((int)(lds0 + AT_VR + slot * AT_SLOT + wid * 1024)));
}
#define AT_RD128(dst, addr, off) asm volatile("ds_read_b128 %0, %1 offset:%c2" : "=&v"(dst) : "v"(addr), "i"(off) : "memory")
#define AT_MFMA8(a, b, c) __builtin_amdgcn_mfma_scale_f32_32x32x64_f8f6f4(a, b, c, 0, 0, 0, 0, 0, 0)
#define AT_MFMA8B(a, b, c) __builtin_amdgcn_mfma_scale_f32_32x32x64_f8f6f4(a, b, c, 0, 1, 0, 0, 0, 0)

template <int VAR>
__device__ __forceinline__ void phase_attn(Frame& F, int l) {
    refresh(F);
    const WS W = ws_map(F.ws, F.nb); const float* const* IN_ = F.a->in; (void)IN_; (void)W;
    const int lane = F.lane, wid = F.wave, r32 = lane & 31, hh = lane >> 5, qg = wid & 3, c = wid >> 2;
    LAS unsigned char* lds = F.lds; const unsigned lds0 = (unsigned)(unsigned long)lds;
    LAS float* tab = (LAS float*)(lds + AT_TAB);
    for (int i = F.tid; i < 1028; i += NTHR) tab[i] = W.tab[i];
    const float lam = W.tab[1032 + l]; const float lam_init = 0.8f - 0.6f * __expf(-0.3f * (float)l);
    const float* subg = IN_[13] + l * 128;
    const int U = F.nb * NH * 64;
    const int gx = F.G >> 3, per = U >> 3;
    const int sw = (r32 >> 2) & 3;
    const unsigned ka0 = lds0 + AT_KR + c * 4096 + r32 * 64 + (((2 * hh) ^ sw) << 4), ka1 = lds0 + AT_KR + c * 4096 + r32 * 64 + (((2 * hh + 1) ^ sw) << 4);
    const unsigned va0 = lds0 + AT_VR + r32 * 64 + (((2 * hh) ^ sw) << 4), va1 = lds0 + AT_VR + r32 * 64 + (((2 * hh + 1) ^ sw) << 4);
    const bool lag = wid >= 4;
    __syncthreads();
    for (int i = 0;; ++i) {
        int id;
        if ((F.G & 7) == 0) { const int n = i * gx + (F.bid >> 3); if (n >= per) break; id = (F.bid & 7) * per + n; }
        else { id = i * F.G + F.bid; if (id >= U) break; }
        const int bh = id >> 6, qb = id & 63, b = bh >> 2, h = bh & 3;
        const int qw0 = qb * 128 + 32 * qg;
        const unsigned char* kg0 = (const unsigned char*)W.DK + ((size_t)bh * 2) * SEQ * 64;
        const unsigned char* vg0 = (const unsigned char*)W.DV + (size_t)bh * SEQ * 128;
        v8i qf; { const unsigned char* qp = (const unsigned char*)W.DQ + (((size_t)bh * 2 + c) * SEQ + qw0 + r32) * 64 + 32 * hh;
            const v4i q0 = *(const v4i*)qp, q1 = *(const v4i*)(qp + 16); qf = (v8i){q0[0], q0[1], q0[2], q0[3], q1[0], q1[1], q1[2], q1[3]}; }
        asm volatile("s_waitcnt vmcnt(0)" ::: "memory");
        attn_dma_k(lds0, kg0, 0, 0, wid, lane); attn_dma_k(lds0, kg0, 1, 1, wid, lane); attn_dma_v(lds0, vg0, 0, 0, wid, lane); attn_dma_k(lds0, kg0, 2, 2, wid, lane);
        attn_dma_v(lds0, vg0, 1, 1, wid, lane); attn_dma_k(lds0, kg0, 3, 3, wid, lane); attn_dma_v(lds0, vg0, 2, 2, wid, lane);
        f32x16 o[4];
#pragma unroll
        for (int dt = 0; dt < 4; ++dt) o[dt] = f32x16{};
        float lsum = 0.f;
        const int tL = (qw0 >= 154) ? ((qw0 - 154) >> 6) + 1 : 0, tR = (qw0 + 185) >> 6;
        const float shl = tab[1024 + h];
        const LAS float* tabh = tab + h * 256;
        const int rel0 = -qw0 - r32 + 4 * hh + 128;
        const f32x16 cshift = {-2.f, -2.f, -2.f, -2.f, -2.f, -2.f, -2.f, -2.f, -2.f, -2.f, -2.f, -2.f, -2.f, -2.f, -2.f, -2.f};
        asm volatile("s_waitcnt vmcnt(4)" ::: "memory"); __builtin_amdgcn_s_barrier(); asm volatile("" ::: "memory");
        f32x16 sc0, sc1, sn0, sn1; v8i p; v4i kx[4];
        AT_RD128(kx[0], ka0, 0); AT_RD128(kx[1], ka1, 0); AT_RD128(kx[2], ka0, 2048); AT_RD128(kx[3], ka1, 2048);
        asm volatile("s_waitcnt lgkmcnt(0)" ::: "memory"); __builtin_amdgcn_sched_barrier(0);
        sc0 = AT_MFMA8(((v8i){kx[0][0], kx[0][1], kx[0][2], kx[0][3], kx[1][0], kx[1][1], kx[1][2], kx[1][3]}), qf, cshift);
        sc1 = AT_MFMA8(((v8i){kx[2][0], kx[2][1], kx[2][2], kx[2][3], kx[3][0], kx[3][1], kx[3][2], kx[3][3]}), qf, cshift);
        __builtin_amdgcn_s_barrier(); asm volatile("" ::: "memory");
        if (lag) { __builtin_amdgcn_s_barrier(); asm volatile("" ::: "memory"); }
#define AT_STEP(SL, t) do { \
            { const int tk = (t) + 4 < 128 ? (t) + 4 : 127; attn_dma_k(lds0, kg0, tk, SL, wid, lane); } \
            asm volatile("s_waitcnt vmcnt(4)" ::: "memory");                                                       \
            AT_RD128(kx[0], ka0, ((SL + 1) & 3) * AT_SLOT); AT_RD128(kx[1], ka1, ((SL + 1) & 3) * AT_SLOT);        \
            AT_RD128(kx[2], ka0, ((SL + 1) & 3) * AT_SLOT + 2048); AT_RD128(kx[3], ka1, ((SL + 1) & 3) * AT_SLOT + 2048); \
            if ((t) >= tL && (t) < tR) attn_bias(sc0, sc1, 64 * (t) + rel0, tabh);                                \
            attn_exp_chunk<0>(sc0, sc1, lsum); attn_exp_chunk<1>(sc0, sc1, lsum);                                 \
            asm volatile("s_waitcnt lgkmcnt(0)" ::: "memory"); __builtin_amdgcn_sched_barrier(0); \
            sn0 = AT_MFMA8(((v8i){kx[0][0], kx[0][1], kx[0][2], kx[0][3], kx[1][0], kx[1][1], kx[1][2], kx[1][3]}), qf, cshift); \
            __builtin_amdgcn_sched_barrier(0); \
            attn_exp_chunk<2>(sc0, sc1, lsum); \
            __builtin_amdgcn_sched_barrier(0); \
            sn1 = AT_MFMA8(((v8i){kx[2][0], kx[2][1], kx[2][2], kx[2][3], kx[3][0], kx[3][1], kx[3][2], kx[3][3]}), qf, cshift); \
            __builtin_amdgcn_sched_barrier(0); \
            attn_exp_chunk<3>(sc0, sc1, lsum); \
            p[0] = pk4_bf8(sc0[0], sc0[1], sc0[2], sc0[3]); p[1] = pk4_bf8(sc0[4], sc0[5], sc0[6], sc0[7]); p[2] = pk4_bf8(sc0[8], sc0[9], sc0[10], sc0[11]); p[3] = pk4_bf8(sc0[12], sc0[13], sc0[14], sc0[15]); \
            p[4] = pk4_bf8(sc1[0], sc1[1], sc1[2], sc1[3]); p[5] = pk4_bf8(sc1[4], sc1[5], sc1[6], sc1[7]); p[6] = pk4_bf8(sc1[8], sc1[9], sc1[10], sc1[11]); p[7] = pk4_bf8(sc1[12], sc1[13], sc1[14], sc1[15]); \
            __builtin_amdgcn_s_barrier(); asm volatile("" ::: "memory"); \
            { const int tv = (t) + 3 < 128 ? (t) + 3 : 127; attn_dma_v(lds0, vg0, tv, (SL + 3) & 3, wid, lane); } \
            asm volatile("s_waitcnt vmcnt(4)" ::: "memory");                                                       \
            { v4i vx[8]; \
              AT_RD128(vx[0], va0, SL * AT_SLOT); AT_RD128(vx[1], va1, SL * AT_SLOT); AT_RD128(vx[2], va0, SL * AT_SLOT + 2048); AT_RD128(vx[3], va1, SL * AT_SLOT + 2048); \
              AT_RD128(vx[4], va0, SL * AT_SLOT + 4096); AT_RD128(vx[5], va1, SL * AT_SLOT + 4096); AT_RD128(vx[6], va0, SL * AT_SLOT + 6144); AT_RD128(vx[7], va1, SL * AT_SLOT + 6144); \
              if ((t) == tL) { _Pragma("unroll") for (int dt = 0; dt < 4; ++dt) o[dt] *= shl; lsum *= shl; } \
              asm volatile("s_waitcnt lgkmcnt(4)" ::: "memory"); __builtin_amdgcn_sched_barrier(0); \
              o[0] = AT_MFMA8B(((v8i){vx[0][0], vx[0][1], vx[0][2], vx[0][3], vx[1][0], vx[1][1], vx[1][2], vx[1][3]}), p, o[0]); \
              o[1] = AT_MFMA8B(((v8i){vx[2][0], vx[2][1], vx[2][2], vx[2][3], vx[3][0], vx[3][1], vx[3][2], vx[3][3]}), p, o[1]); \
              asm volatile("s_waitcnt lgkmcnt(0)" ::: "memory"); __builtin_amdgcn_sched_barrier(0); \
              o[2] = AT_MFMA8B(((v8i){vx[4][0], vx[4][1], vx[4][2], vx[4][3], vx[5][0], vx[5][1], vx[5][2], vx[5][3]}), p, o[2]); \
              o[3] = AT_MFMA8B(((v8i){vx[6][0], vx[6][1], vx[6][2], vx[6][3], vx[7][0], vx[7][1], vx[7][2], vx[7][3]}), p, o[3]); } \
            sc0 = sn0; sc1 = sn1; \
            __builtin_amdgcn_s_barrier(); asm volatile("" ::: "memory"); } while (0)
        for (int t0 = 0; t0 < 128; t0 += 4) { AT_STEP(0, t0); AT_STEP(1, t0 + 1); AT_STEP(2, t0 + 2); AT_STEP(3, t0 + 3); }
#undef AT_STEP
        if (!lag) { __builtin_amdgcn_s_barrier(); asm volatile("" ::: "memory"); }
        asm volatile("s_waitcnt vmcnt(0)" ::: "memory"); __builtin_amdgcn_s_barrier(); asm volatile("" ::: "memory");
        const float lt = lsum + __shfl_xor(lsum, 32);
        LAS float* xch = (LAS float*)(lds + qg * 16384);
        if (c == 1) { const float f = lam / lt;
#pragma unroll
            for (int dt = 0; dt < 4; ++dt)
#pragma unroll
                for (int r = 0; r < 16; ++r) xch[(dt * 16 + r) * 64 + lane] = o[dt][r] * f; }
        LDS_WAIT(); __builtin_amdgcn_s_barrier(); asm volatile("" ::: "memory");
        if (c == 0) { const float f = 1.f / lt; float ss = 0.f;
#pragma unroll
            for (int dt = 0; dt < 4; ++dt)
#pragma unroll
                for (int r = 0; r < 16; ++r) { const float v = o[dt][r] * f - xch[(dt * 16 + r) * 64 + lane]; o[dt][r] = v; ss += v * v; }
            ss += __shfl_xor(ss, 32);
            const float rn = rsqrtf(ss * (1.f / 128.f) + RMS_EPS) * (1.f - lam_init);
            bf16* orow = W.OAB + (size_t)F.T * 512 + ((size_t)b * SEQ + qw0 + r32) * 512 + h * 128;
#pragma unroll
            for (int dt = 0; dt < 4; ++dt)
#pragma unroll
                for (int g = 0; g < 4; ++g) { const int dv = 32 * dt + 8 * g + 4 * hh; const f32x4 sg = *(const f32x4*)(subg + dv);
                    u32x2 ov; ov.x = cvt_pk(o[dt][4 * g] * rn * sg[0], o[dt][4 * g + 1] * rn * sg[1]); ov.y = cvt_pk(o[dt][4 * g + 2] * rn * sg[2], o[dt][4 * g + 3] * rn * sg[3]);
                    *(u32x2*)(orow + dv) = ov; }
        }
        LDS_WAIT(); __builtin_amdgcn_s_barrier(); asm volatile("" ::: "memory");
    }
}
constexpr int GL_CUM = 0;
constexpr int GL_S64 = 144, GL_S192 = 400;
constexpr int G1_KEF = 32768, G1_KEB = G1_KEF + 64 * GL_S64, G1_VT = G1_KEB + 64 * GL_S64;
constexpr int G3_AOP = 32768, G3_KIF = G3_AOP + 64 * GL_S192, G3_KIB = G3_KIF + 64 * GL_S64, G3_BOP = G3_KIB + 64 * GL_S64;
static_assert(G3_BOP + 128 * GL_S192 <= 150 * 1024, "GLA LDS");

__device__ __forceinline__ bf16x8 lds_frag(const LAS unsigned char* base, int row, int stride, int kbyte) { return *(const LAS bf16x8*)(base + row * stride + kbyte); }

__device__ __forceinline__ void gla_cum(Frame& F, size_t trow0, int h) {
    const WS W = ws_map(F.ws, F.nb); const float* const* IN_ = F.a->in; (void)IN_; (void)W;
    LAS float* cum = (LAS float*)(F.lds + GL_CUM);
#pragma unroll
    for (int it = 0; it < 4; ++it) { const int idx = F.tid + it * NTHR; const int dir = idx >> 10, t = (idx >> 4) & 63, d4 = (idx & 15) * 4;
        const f32x4 v = *(const f32x4*)((dir ? W.LGB : W.LGF) + (trow0 + t) * 256 + h * 64 + d4);
        *(LAS f32x4*)(cum + (dir * 64 + t) * 64 + d4) = v; }
    __syncthreads();
    if (F.tid < 128) { const int dir = F.tid >> 6, d = F.tid & 63; LAS float* cc = cum + dir * 4096 + d; float run = 0.f;
        if (dir == 0) { for (int t = 0; t < 64; ++t) { run += cc[t * 64]; cc[t * 64] = run; } }
        else { for (int t = 63; t >= 0; --t) { run += cc[t * 64]; cc[t * 64] = run; } } }
    __syncthreads();
}

__device__ __forceinline__ void phase_gla1(Frame& F) {
    refresh(F);
    const WS W = ws_map(F.ws, F.nb); const float* const* IN_ = F.a->in; (void)IN_; (void)W;
    LAS unsigned char* lds = F.lds; LAS float* cum = (LAS float*)(lds + GL_CUM);
    const int lane = F.lane, wid = F.wave, r32 = lane & 31, hh = lane >> 5;
    const int U = F.nb * NH * 128;
    for (int u = F.bid; u < U; u += F.G) {
        const int n = u & 127, bh = u >> 7, b = bh >> 2, h = bh & 3; const size_t trow0 = (size_t)b * SEQ + n * 64;
        gla_cum(F, trow0, h);
        {
            const int t = F.tid >> 3, d0 = (F.tid & 7) * 8;
            const u32x4 kv = *(const u32x4*)(W.GK + (trow0 + t) * 256 + h * 64 + d0);
            const unsigned kw[4] = {kv.x, kv.y, kv.z, kv.w};
#pragma unroll
            for (int j = 0; j < 8; ++j) { const int d = d0 + j; const float k = (j & 1) ? bfhi(kw[j >> 1]) : bflo(kw[j >> 1]);
                const float ef = __expf(cum[63 * 64 + d] - cum[t * 64 + d]), eb = __expf(cum[4096 + d] - cum[4096 + t * 64 + d]);
                *(LAS bf16*)(lds + G1_KEF + d * GL_S64 + t * 2) = (bf16)(cvt_pk(k * ef, 0.f) & 0xffffu);
                *(LAS bf16*)(lds + G1_KEB + d * GL_S64 + t * 2) = (bf16)(cvt_pk(k * eb, 0.f) & 0xffffu); }
            const int v0 = (F.tid & 7) * 16;
            const u32x4 va = *(const u32x4*)(W.GV + (trow0 + t) * 512 + h * 128 + v0), vb = *(const u32x4*)(W.GV + (trow0 + t) * 512 + h * 128 + v0 + 8);
            const unsigned vw[8] = {va.x, va.y, va.z, va.w, vb.x, vb.y, vb.z, vb.w};
#pragma unroll
            for (int j = 0; j < 16; ++j) *(LAS bf16*)(lds + G1_VT + (v0 + j) * GL_S64 + t * 2) = (bf16)((j & 1) ? (vw[j >> 1] >> 16) : (vw[j >> 1] & 0xffffu));
            if (F.tid < 128) { const int dir = F.tid >> 6, d = F.tid & 63; W.DEC[((size_t)u * 2 + dir) * 64 + d] = __expf(dir ? cum[4096 + d] : cum[63 * 64 + d]); }
        }
        __syncthreads();
        {
            const int dt = wid & 3, dd = wid >> 2;
            f32x16 cf = {}, cb = {};
#pragma unroll
            for (int s = 0; s < 4; ++s) { const int kb = (16 * s + 8 * hh) * 2;
                const bf16x8 a = lds_frag(lds + G1_VT, 32 * dt + r32, GL_S64, kb);
                cf = __builtin_amdgcn_mfma_f32_32x32x16_bf16(a, lds_frag(lds + G1_KEF, 32 * dd + r32, GL_S64, kb), cf, 0, 0, 0);
                cb = __builtin_amdgcn_mfma_f32_32x32x16_bf16(a, lds_frag(lds + G1_KEB, 32 * dd + r32, GL_S64, kb), cb, 0, 0, 0); }
            float* of = W.KVT + ((size_t)u * 2) * 8192; float* ob = of + 8192;
#pragma unroll
            for (int r = 0; r < 16; ++r) { const int dv = 32 * dt + crow(r, hh), d = 32 * dd + r32; of[dv * 64 + d] = cf[r]; ob[dv * 64 + d] = cb[r]; }
        }
        __syncthreads();
    }
}

__device__ __forceinline__ void phase_gla2(Frame& F) {
    refresh(F);
    const WS W = ws_map(F.ws, F.nb); const float* const* IN_ = F.a->in; (void)IN_; (void)W;
    const size_t total = (size_t)F.nb * NH * 2 * 8192;
    for (size_t wk = (size_t)F.bid * NTHR + F.tid; wk < total; wk += (size_t)F.G * NTHR) {
        const int e = (int)(wk & 8191), dir = (int)((wk >> 13) & 1), bh = (int)(wk >> 14), d = e & 63;
        float* base = W.KVT + ((size_t)bh * 128 * 2 + dir) * 8192 + e; const float* dec = W.DEC + ((size_t)bh * 128 * 2 + dir) * 64 + d;
        float S = 0.f;
        for (int n0 = 0; n0 < 128; n0 += 8) {
            float kv[8], dc[8];
#pragma unroll
            for (int j = 0; j < 8; ++j) { const int n = dir ? 127 - (n0 + j) : n0 + j; kv[j] = base[(size_t)n * 16384]; dc[j] = dec[(size_t)n * 128]; }
#pragma unroll
            for (int j = 0; j < 8; ++j) { const int n = dir ? 127 - (n0 + j) : n0 + j; base[(size_t)n * 16384] = S; S = dc[j] * S + kv[j]; }
        }
    }
}

__device__ __forceinline__ void phase_gla3(Frame& F, int l) {
    refresh(F);
    const WS W = ws_map(F.ws, F.nb); const float* const* IN_ = F.a->in; (void)IN_; (void)W;
    LAS unsigned char* lds = F.lds; LAS float* cum = (LAS float*)(lds + GL_CUM);
    const int lane = F.lane, wid = F.wave, r32 = lane & 31, hh = lane >> 5;
    const float* gng = IN_[9] + l * 128;
    const int U = F.nb * NH * 128;
    for (int u = F.bid; u < U; u += F.G) {
        const int n = u & 127, bh = u >> 7, b = bh >> 2, h = bh & 3; const size_t trow0 = (size_t)b * SEQ + n * 64;
        gla_cum(F, trow0, h);
        {
            const int t = F.tid >> 3, d0 = (F.tid & 7) * 8;
            const u32x4 qv = *(const u32x4*)(W.GQ + (trow0 + t) * 256 + h * 64 + d0), kv = *(const u32x4*)(W.GK + (trow0 + t) * 256 + h * 64 + d0);
            const unsigned qw[4] = {qv.x, qv.y, qv.z, qv.w}, kw[4] = {kv.x, kv.y, kv.z, kv.w};
            float qf[8], qb[8], kf[8], kb[8];
#pragma unroll
            for (int j = 0; j < 8; ++j) { const int d = d0 + j; const float q = (j & 1) ? bfhi(qw[j >> 1]) : bflo(qw[j >> 1]), k = (j & 1) ? bfhi(kw[j >> 1]) : bflo(kw[j >> 1]);
                const float cf = cum[t * 64 + d], cb = cum[4096 + t * 64 + d];
                qf[j] = q * __expf(cf); qb[j] = q * __expf(cb); kf[j] = k * __expf(-cf); kb[j] = k * __expf(-cb); }
            u32x4 o;
            o.x = cvt_pk(qf[0], qf[1]); o.y = cvt_pk(qf[2], qf[3]); o.z = cvt_pk(qf[4], qf[5]); o.w = cvt_pk(qf[6], qf[7]); *(LAS u32x4*)(lds + G3_AOP + t * GL_S192 + (64 + d0) * 2) = o;
            o.x = cvt_pk(qb[0], qb[1]); o.y = cvt_pk(qb[2], qb[3]); o.z = cvt_pk(qb[4], qb[5]); o.w = cvt_pk(qb[6], qb[7]); *(LAS u32x4*)(lds + G3_AOP + t * GL_S192 + (128 + d0) * 2) = o;
            o.x = cvt_pk(kf[0], kf[1]); o.y = cvt_pk(kf[2], kf[3]); o.z = cvt_pk(kf[4], kf[5]); o.w = cvt_pk(kf[6], kf[7]); *(LAS u32x4*)(lds + G3_KIF + t * GL_S64 + d0 * 2) = o;
            o.x = cvt_pk(kb[0], kb[1]); o.y = cvt_pk(kb[2], kb[3]); o.z = cvt_pk(kb[4], kb[5]); o.w = cvt_pk(kb[6], kb[7]); *(LAS u32x4*)(lds + G3_KIB + t * GL_S64 + d0 * 2) = o;
            const int v0 = (F.tid & 7) * 16;
            const u32x4 va = *(const u32x4*)(W.GV + (trow0 + t) * 512 + h * 128 + v0), vb = *(const u32x4*)(W.GV + (trow0 + t) * 512 + h * 128 + v0 + 8);
            const unsigned vw[8] = {va.x, va.y, va.z, va.w, vb.x, vb.y, vb.z, vb.w};
#pragma unroll
            for (int j = 0; j < 16; ++j) *(LAS bf16*)(lds + G3_BOP + (v0 + j) * GL_S192 + t * 2) = (bf16)((j & 1) ? (vw[j >> 1] >> 16) : (vw[j >> 1] & 0xffffu));
            const int dv = F.tid >> 2, dd0 = (F.tid & 3) * 16;
#pragma unroll
            for (int dir = 0; dir < 2; ++dir) { const float* sp = W.KVT + ((size_t)u * 2 + dir) * 8192 + dv * 64 + dd0;
                const f32x4 a = *(const f32x4*)sp, bq = *(const f32x4*)(sp + 4), cq = *(const f32x4*)(sp + 8), dq = *(const f32x4*)(sp + 12);
                u32x4 o0, o1; o0.x = cvt_pk(a[0], a[1]); o0.y = cvt_pk(a[2], a[3]); o0.z = cvt_pk(bq[0], bq[1]); o0.w = cvt_pk(bq[2], bq[3]);
                o1.x = cvt_pk(cq[0], cq[1]); o1.y = cvt_pk(cq[2], cq[3]); o1.z = cvt_pk(dq[0], dq[1]); o1.w = cvt_pk(dq[2], dq[3]);
                *(LAS u32x4*)(lds + G3_BOP + dv * GL_S192 + (64 + 64 * dir + dd0) * 2) = o0; *(LAS u32x4*)(lds + G3_BOP + dv * GL_S192 + (64 + 64 * dir + dd0 + 8) * 2) = o1; }
        }
        __syncthreads();
        if (wid < 4) {
            const int it = wid >> 1, jt = wid & 1;
            f32x16 af = {}, ab = {};
#pragma unroll
            for (int s = 0; s < 4; ++s) { const int kb = (16 * s + 8 * hh) * 2;
                if (jt <= it) af = __builtin_amdgcn_mfma_f32_32x32x16_bf16(lds_frag(lds + G3_AOP, 32 * it + r32, GL_S192, 128 + kb), lds_frag(lds + G3_KIF, 32 * jt + r32, GL_S64, kb), af, 0, 0, 0);
                if (jt >= it) ab = __builtin_amdgcn_mfma_f32_32x32x16_bf16(lds_frag(lds + G3_AOP, 32 * it + r32, GL_S192, 256 + kb), lds_frag(lds + G3_KIB, 32 * jt + r32, GL_S64, kb), ab, 0, 0, 0); }
#pragma unroll
            for (int r = 0; r < 16; ++r) { const int i = 32 * it + crow(r, hh), j = 32 * jt + r32; const float v = (j <= i) ? af[r] : ab[r];
                *(LAS bf16*)(lds + G3_AOP + i * GL_S192 + j * 2) = (bf16)(cvt_pk(v, 0.f) & 0xffffu); }
        }
        __syncthreads();
        {
            const int it = wid >> 2, dt = wid & 3; f32x16 o = {};
#pragma unroll
            for (int s = 0; s < 12; ++s) { const int kb = (16 * s + 8 * hh) * 2;
                o = __builtin_amdgcn_mfma_f32_32x32x16_bf16(lds_frag(lds + G3_AOP, 32 * it + r32, GL_S192, kb), lds_frag(lds + G3_BOP, 32 * dt + r32, GL_S192, kb), o, 0, 0, 0); }
            LAS float* out = (LAS float*)(lds + GL_CUM);
#pragma unroll
            for (int r = 0; r < 16; ++r) out[(32 * it + crow(r, hh)) * 128 + 32 * dt + r32] = o[r];
        }
        __syncthreads();
        {
            const int t = F.tid >> 3, v0 = (F.tid & 7) * 16; const LAS float* orow = (const LAS float*)(lds + GL_CUM) + t * 128 + v0;
            float x[16]; float ss = 0.f;
#pragma unroll
            for (int j = 0; j < 16; ++j) { x[j] = orow[j]; ss += x[j] * x[j]; }
            ss += __shfl_xor(ss, 1); ss += __shfl_xor(ss, 2); ss += __shfl_xor(ss, 4);
            const float rs = rsqrtf(ss * (1.f / 128.f) + RMS_EPS);
            const u32x4 ga = *(const u32x4*)(W.SG + (trow0 + t) * 512 + h * 128 + v0), gb = *(const u32x4*)(W.SG + (trow0 + t) * 512 + h * 128 + v0 + 8);
            const unsigned gw[8] = {ga.x, ga.y, ga.z, ga.w, gb.x, gb.y, gb.z, gb.w};
            float y[16];
#pragma unroll
            for (int j = 0; j < 16; ++j) y[j] = x[j] * rs * gng[v0 + j] * ((j & 1) ? bfhi(gw[j >> 1]) : bflo(gw[j >> 1]));
            u32x4 o0, o1; o0.x = cvt_pk(y[0], y[1]); o0.y = cvt_pk(y[2], y[3]); o0.z = cvt_pk(y[4], y[5]); o0.w = cvt_pk(y[6], y[7]);
            o1.x = cvt_pk(y[8], y[9]); o1.y = cvt_pk(y[10], y[11]); o1.z = cvt_pk(y[12], y[13]); o1.w = cvt_pk(y[14], y[15]);
            bf16* dst = W.OAB + (trow0 + t) * 512 + h * 128 + v0; *(u32x4*)dst = o0; *(u32x4*)(dst + 8) = o1;
        }
        __syncthreads();
    }
}
__device__ __forceinline__ void phase_select(Frame& F, int l) {
    refresh(F);
    const WS W = ws_map(F.ws, F.nb); const float* const* IN_ = F.a->in; (void)IN_; (void)W;
    LAS int* lcnt = (LAS int*)F.lds; LAS int* lbase = lcnt + 32;
    const float* b_rg = IN_[19] + l * 4; const float* b_re = IN_[21] + l * 32;
    unsigned* gcnt = W.ctl + CW_CNT + l * 64;
    for (int t0 = F.bid * NTHR; t0 < F.T; t0 += F.G * NTHR) {
        if (F.tid < 32) lcnt[F.tid] = 0;
        __syncthreads();
        const int t = t0 + F.tid; int e0 = 0, e1 = 0, r0 = 0, r1 = 0; float g0 = 0.f, g1 = 0.f;
        if (t < F.T) {
            const float* lg = W.LOGITS + (size_t)t * 64;
            float gl[4]; { const f32x4 v = *(const f32x4*)lg; gl[0] = v[0] + b_rg[0]; gl[1] = v[1] + b_rg[1]; gl[2] = v[2] + b_rg[2]; gl[3] = v[3] + b_rg[3]; }
            int grp = 0; float mx = gl[0];
            if (gl[1] > mx) { mx = gl[1]; grp = 1; } if (gl[2] > mx) { mx = gl[2]; grp = 2; } if (gl[3] > mx) { mx = gl[3]; grp = 3; }
            const float p_grp = 1.f / (__expf(gl[0] - mx) + __expf(gl[1] - mx) + __expf(gl[2] - mx) + __expf(gl[3] - mx));
            const f32x4 ea = *(const f32x4*)(lg + 4 + grp * 8), eb = *(const f32x4*)(lg + 8 + grp * 8);
            const f32x4 ba = *(const f32x4*)(b_re + grp * 8), bb = *(const f32x4*)(b_re + grp * 8 + 4);
            float b0v = -1e30f, b1v = -1e30f; int i0 = 0, i1 = 0;
#pragma unroll
            for (int j = 0; j < 8; ++j) { const float e = (j < 4) ? ea[j] + ba[j] : eb[j - 4] + bb[j - 4];
                if (e > b0v) { b1v = b0v; i1 = i0; b0v = e; i0 = j; } else if (e > b1v) { b1v = e; i1 = j; } }
            const float p1 = __expf(b1v - b0v), s2 = 1.f + p1;
            e0 = grp * 8 + i0; e1 = grp * 8 + i1; g0 = p_grp / s2; g1 = p_grp * p1 / s2;
            r0 = __hip_atomic_fetch_add(lcnt + e0, 1, __ATOMIC_RELAXED, __HIP_MEMORY_SCOPE_WORKGROUP);
            r1 = __hip_atomic_fetch_add(lcnt + e1, 1, __ATOMIC_RELAXED, __HIP_MEMORY_SCOPE_WORKGROUP);
        }
        __syncthreads();
        if (F.tid < 32) lbase[F.tid] = (int)__hip_atomic_fetch_add(gcnt + F.tid, (unsigned)lcnt[F.tid], __ATOMIC_RELAXED, __HIP_MEMORY_SCOPE_AGENT);
        __syncthreads();
        if (t < F.T) { W.eid[t * 2] = e0; W.eid[t * 2 + 1] = e1; W.gate[t * 2] = g0; W.gate[t * 2 + 1] = g1; W.rank[t * 2] = lbase[e0] + r0; W.rank[t * 2 + 1] = lbase[e1] + r1; }
        __syncthreads();
    }
}
__device__ __forceinline__ void phase_gather(Frame& F, int l) {
    refresh(F);
    const WS W = ws_map(F.ws, F.nb); const float* const* IN_ = F.a->in; (void)IN_; (void)W;
    LAS int* seg = (LAS int*)F.lds;
    const unsigned* gcnt = W.ctl + CW_CNT + l * 64;
    if (F.tid == 0) { int o = 0; for (int e = 0; e < 32; ++e) { seg[e] = o; o += ((int)__hip_atomic_load(gcnt + e, __ATOMIC_RELAXED, __HIP_MEMORY_SCOPE_AGENT) + 255) & ~255; } seg[32] = o; }
    __syncthreads();
    if (F.bid == 0) {
        const int ntile = seg[32] >> 8;
        for (int i = F.tid; i < ntile; i += NTHR) { int e = 0; while (e < 31 && (i << 8) >= seg[e + 1]) ++e; W.tilee[i] = e; }
        if (F.tid == 0) W.segp[0] = ntile;
    }
    const int gw = F.bid * NWAVES + F.wave, NGW = F.G * NWAVES;
    for (int it = gw; it < F.T * 2; it += NGW) {
        const int t = it >> 1; const int e = W.eid[it], p = seg[e] + W.rank[it];
        const GAS u32x4* src = (const GAS u32x4*)(W.H + (size_t)t * D) + F.lane; GAS u32x4* dst = (GAS u32x4*)(W.XS + (size_t)p * D) + F.lane;
        const u32x4 a = src[0], b = src[64]; dst[0] = a; dst[64] = b;
        if (F.lane == 0) { W.pos[it] = p; W.gsort[p] = W.gate[it]; }
    }
}

#ifndef MK_MASK
#define MK_MASK 0xffffffffu
#endif
#define EN(b) (((MK_MASK) >> (b)) & 1u)
#ifndef MK_DUP
#define MK_DUP 0u
#endif
#define REPS(b) ((((MK_DUP) >> (b)) & 1u) ? 2 : 1)
constexpr int NPL = 14, NPH = 2 + DEPTH * NPL;
__global__ void __launch_bounds__(NTHR, 2) mk_fwd(Args args) {
    extern __shared__ __attribute__((aligned(16))) unsigned char lds_raw[];
    Frame F;
    F.lds = (LAS unsigned char*)lds_raw; F.tid = threadIdx.x; F.lane = F.tid & 63; F.wave = __builtin_amdgcn_readfirstlane(F.tid >> 6);
    F.G = gridDim.x; F.bid = blockIdx.x; F.nb = args.nb; F.T = args.nb * SEQ; F.ws = args.ws; F.a = &args; F.xbuf = args.out;
    const float* const* IN_ = args.in;
    volatile LAS unsigned* misc = (volatile LAS unsigned*)(F.lds + LDS_MISC);
    if (F.tid < 64) misc[F.tid] = 0u;
    __syncthreads();
    XcdBarrier bar = xcd_barrier_post((unsigned*)args.ws + CW_BAR + args.li * XCD_BAR_WORDS, misc);
    const int lo = args.ph_lo, hi = args.ph_hi;
#define IN(k) (lo <= (k) && (k) < hi)
#define SEAM(k) do { if (IN(k) && IN((k) + 1)) xcd_barrier(bar); } while (0)
    LAS unsigned char* gl = F.lds;
    if (EN(0) && IN(0)) { for (int rp = 0; rp < REPS(0); ++rp) { p0_prologue(F); __syncthreads(); } SEAM(0); }
    for (int l = 0; l < DEPTH; ++l) {
        const int pb = 1 + l * NPL;
        if (EN(1) && IN(pb + 0)) { phase_norm(F, l, 0); SEAM(pb + 0); }
        if (EN(2) && IN(pb + 1)) { const WS W = ws_map(F.ws, F.nb);
            pg8::Gemm g{W.H, W.win + (size_t)l * NIN * D, F.T, NIN, D}; pg8::StaticOrder S; S.init(F.T, NIN, F.G, F.bid);
            EpiIn E{W.GQ, W.GK, W.GV, W.SG, W.LGF, W.LGB, W.DQ, W.DK, W.DV, W.SGA, W.SGB, IN_[8] + l * 512, IN_[10] + l * 64, IN_[11] + l * 64};
            for (int rp = 0; rp < REPS(2); ++rp) pg8::gemm_phase<EpiIn, pg8::StaticOrder, true, true>(gl, g, S, E);
            SEAM(pb + 1);
        }
        if (EN(3) && IN(pb + 2)) { for (int rp = 0; rp < REPS(3); ++rp) phase_gla1(F); SEAM(pb + 2); }
        if (EN(4) && IN(pb + 3)) { phase_gla2(F); SEAM(pb + 3); }
        if (EN(5) && IN(pb + 4)) { for (int rp = 0; rp < REPS(5); ++rp) phase_gla3(F, l); __syncthreads(); }
        if (EN(6) && IN(pb + 5)) {
#ifdef MK_ATT_PROBE
            phase_attn<MK_ATT_PROBE>(F, l);
#endif
            phase_attn<0>(F, l); SEAM(pb + 5); }
        if (EN(7) && IN(pb + 6)) { const WS W = ws_map(F.ws, F.nb);
            pg8::Gemm g{W.OAB, W.wab + (size_t)l * D * D, 0, 0, 512}; MergeOrder S; S.so.init(F.T, D, F.G, F.bid); S.nM = F.T / 256;
            EpiMerge E{W.SGA, W.SGB, W.MERGED, F.T / 256};
            for (int rp = 0; rp < REPS(7); ++rp) pg8::gemm_phase<EpiMerge, MergeOrder, true, true>(gl, g, S, E);
            SEAM(pb + 6);
        }
        if (EN(8) && IN(pb + 7)) { const WS W = ws_map(F.ws, F.nb); const float* modl = W.mod + (size_t)l * NBMAX * 6 * D;
            pg8::Gemm g{W.MERGED, W.wo + (size_t)l * D * D, F.T, D, D}; pg8::StaticOrder S; S.init(F.T, D, F.G, F.bid);
            EpiResid E{l == 0 ? IN_[0] : F.xbuf, F.xbuf, modl + 2 * D};
            pg8::gemm_phase<EpiResid, pg8::StaticOrder, true, true>(gl, g, S, E);
            SEAM(pb + 7);
        }
        if (EN(1) && IN(pb + 8)) { for (int rp = 0; rp < REPS(1); ++rp) phase_norm(F, l, 1); SEAM(pb + 8); }
        if (EN(9) && IN(pb + 9)) { const WS W = ws_map(F.ws, F.nb);
            pg8::Gemm g{W.H, W.wr + (size_t)l * 256 * D, F.T, 256, D}; pg8::StaticOrder S; S.init(F.T, 256, F.G, F.bid);
            EpiLogits E{W.LOGITS};
            for (int rp = 0; rp < REPS(9); ++rp) pg8::gemm_phase<EpiLogits, pg8::StaticOrder, true, true>(gl, g, S, E);
            SEAM(pb + 9);
        }
        if (EN(10) && IN(pb + 10)) { phase_select(F, l); SEAM(pb + 10); }
        if (EN(11) && IN(pb + 11)) { for (int rp = 0; rp < REPS(11); ++rp) { phase_gather(F, l); __syncthreads(); } SEAM(pb + 11); }
        if (EN(12) && IN(pb + 12)) { const WS W = ws_map(F.ws, F.nb);
            const int ntile = W.segp[0];
            pg8::Gemm g{W.XS, W.w1 + (size_t)l * NE * 1024 * D, 0, 0, D}; GroupedOrder S{W.tilee, ntile * 4, F.G, F.bid};
            EpiAct E{W.ACT};
            for (int rp = 0; rp < REPS(12); ++rp) pg8::gemm_phase<EpiAct, GroupedOrder, true, true>(gl, g, S, E);
            SEAM(pb + 12);
        }
        if (EN(13) && IN(pb + 13)) { const WS W = ws_map(F.ws, F.nb);
            const int ntile = W.segp[0];
            pg8::Gemm g{W.ACT, W.w2 + (size_t)l * NE * D * DE, 0, 0, DE}; GroupedOrder S{W.tilee, ntile * 4, F.G, F.bid};
            EpiYs E{W.YS, W.gsort};
            for (int rp = 0; rp < REPS(13); ++rp) pg8::gemm_phase<EpiYs, GroupedOrder, true, true>(gl, g, S, E);
            SEAM(pb + 13);
        }
    }
    if (EN(1) && IN(NPH - 1)) phase_norm(F, 0, 2);
#undef IN
#undef SEAM
}

struct LaunchCfg { int grid; bool ok; };
inline LaunchCfg& launch_cfg() {
    static LaunchCfg c{0, false}; static bool init = false;
    if (!init) { init = true;
        int dev = 0, cus = 0, per_cu = 0;
        if (hipGetDevice(&dev) != hipSuccess || hipDeviceGetAttribute(&cus, hipDeviceAttributeMultiprocessorCount, dev) != hipSuccess) { fprintf(stderr, "mk: device query failed\n"); return c; }
        if (hipFuncSetAttribute((const void*)mk_fwd, hipFuncAttributeMaxDynamicSharedMemorySize, LDS_BYTES) != hipSuccess) { fprintf(stderr, "mk: hipFuncSetAttribute failed\n"); return c; }
        if (hipOccupancyMaxActiveBlocksPerMultiprocessor(&per_cu, (const void*)mk_fwd, NTHR, LDS_BYTES) != hipSuccess || per_cu < 1) { fprintf(stderr, "mk: occupancy query says %d blocks/CU\n", per_cu); (void)hipGetLastError(); return c; }
        c.grid = cus; c.ok = true;
    }
    return c;
}
inline void launch_range(void* const* d_in, float* xbuf, void* d_ws, int nb, int lo, int hi, int li, hipStream_t stream) {
    LaunchCfg& c = launch_cfg(); if (!c.ok) return;
    Args a{}; for (int i = 0; i < 24; ++i) a.in[i] = (const float*)d_in[i];
    a.out = xbuf; a.ws = (unsigned char*)d_ws; a.nb = nb; a.ph_lo = lo; a.ph_hi = hi; a.li = li;
    hipLaunchKernelGGL(mk_fwd, dim3(c.grid), dim3(NTHR), LDS_BYTES, stream, a);
    const hipError_t le = hipPeekAtLastError(); if (le != hipSuccess) fprintf(stderr, "mk: launch [%d,%d) failed: %s\n", lo, hi, hipGetErrorName(le));
}
}
extern "C" void kernel_launch(void* const* d_in, const int* in_sizes, int n_in, void* d_out, int out_size, void* d_ws, size_t ws_size, hipStream_t stream) {
    (void)in_sizes; (void)n_in; (void)out_size;
    static int checked = 0;
    if (!checked) { checked = 1; const mk::WS w = mk::ws_map((unsigned char*)d_ws, 4); if (w.end > ws_size) { fprintf(stderr, "mk: workspace too small: need %zu, have %zu\n", w.end, ws_size); checked = -1; } }
    if (checked < 0) return;
    if (hipMemsetAsync(d_ws, 0, mk::CTL_BYTES, stream) != hipSuccess) return;
    mk::launch_range(d_in, (float*)d_out, d_ws, 4, 0, mk::NPH, 0, stream);
}
```

```cpp
#include <hip/hip_runtime.h>
#include <cstdio>
#include <cstdint>
#include <cmath>
#define MK_ATT_FP8 1
namespace pg8 {
#define PG8_LAS __attribute__((address_space(3)))
typedef unsigned short bf16_t;
typedef short bf16x8 __attribute__((ext_vector_type(8)));
typedef float f32x4 __attribute__((ext_vector_type(4)));
typedef unsigned u32x4 __attribute__((ext_vector_type(4)));
constexpr int BM = 256, BK = 64, HALF = 128, HTB = HALF * BK * 2  , STAGE_BYTES = 8 * HTB, NXCD = 8, WGM = 8;

__host__ __device__ __forceinline__ int lds_byte(int r, int c) { const int st = (r >> 4) * 2 + (c >> 5), rr = r & 15, cc = c & 31, ob = rr * 64 + cc * 2; return st * 1024 + (ob ^ (((ob >> 9) & 1) << 5)); }
__host__ __device__ __forceinline__ void stage_rc(int b, int& R, int& C) { const int st = b / 1024, sb = b % 1024, swz = sb ^ (((sb >> 9) & 1) << 5); R = (st >> 1) * 16 + swz / 64; C = (st & 1) * 32 + (swz % 64) / 2; }
__host__ __device__ __forceinline__ int perm32(int rho) { const int n = rho >> 4, i = rho & 15; return 8 * (i >> 2) + 4 * n + (i & 3); }

struct Unit { int pm, pn; };
struct Gemm { const bf16_t* A; const bf16_t* Bt; int M, N, K; };

struct StaticOrder {
    int nM, nN, nwg, G, c;
    __host__ __device__ void init(int M, int N, int G_, int c_) { nM = M / BM; nN = N / BM; nwg = nM * nN; G = G_; c = c_; }
    __host__ __device__ bool next(int i, Unit& u) const {
        const long L = (long)i * G + c; if (L >= nwg) return false;
        int wgid = (int)L; { const int q = nwg / NXCD, r = nwg % NXCD, xcd = wgid % NXCD, off = wgid / NXCD; wgid = (xcd < r ? xcd * (q + 1) : r * (q + 1) + (xcd - r) * q) + off; }
        const int nig = WGM * nN, gid = wgid / nig, fm = gid * WGM, gsz = (nM - fm) < WGM ? (nM - fm) : WGM;
        u.pm = fm + ((wgid % nig) % gsz); u.pn = (wgid % nig) / gsz; return true;
    }
    __device__ __forceinline__ void a_ready(const Unit&) const {}
    __device__ __forceinline__ void done(const Unit&) const {}
};
__device__ __forceinline__ unsigned cvt_pk_bf16(float lo, float hi) { unsigned r; asm volatile("v_cvt_pk_bf16_f32 %0, %1, %2" : "=v"(r) : "v"(lo), "v"(hi)); return r; }
__device__ __forceinline__ const void* pg8_uniform(const void* p) { const unsigned long long v = (unsigned long long)p;
    const unsigned lo = (unsigned)__builtin_amdgcn_readfirstlane((int)(unsigned)v), hi = (unsigned)__builtin_amdgcn_readfirstlane((int)(unsigned)(v >> 32)); return (const void*)(((unsigned long long)hi << 32) | lo); }
__device__ __forceinline__ void pg8_glds(const void* sbase, unsigned voff, unsigned ldsdst) { unsigned keep;
    asm volatile("s_nop 4\n\ts_mov_b32 %0, m0\n\ts_mov_b32 m0, %3\n\ts_nop 0\n\tglobal_load_lds_dwordx4 %1, %2\n\ts_mov_b32 m0, %0" : "=&s"(keep) : "v"(voff), "s"(sbase), "s"(ldsdst) : "memory"); }
typedef int pg8_v8i __attribute__((ext_vector_type(8)));
typedef int pg8_v4i __attribute__((ext_vector_type(4)));
template <class Epi, class Sched, bool ALIGN_EPI = false, bool SP2 = false, bool GATHER = false>
__device__ __forceinline__ void gemm_phase(PG8_LAS unsigned char* lds, const Gemm g, const Sched& S, const Epi& E) {
    int tid_ = threadIdx.x; asm volatile("" : "+v"(tid_));
    const int tid = tid_, wid = __builtin_amdgcn_readfirstlane(tid >> 6), lane = tid & 63, wr = wid >> 2, wc = wid & 3, fr = lane & 15, fq = lane >> 4;
    const int K = g.K, nt = K / BK;
    unsigned voffA[2], voffB[2]; unsigned vc[2][2] = {}, vn[2][2] = {}, vs[2][2] = {}; (void)vc; (void)vn; (void)vs;
#pragma unroll
    for (int i = 0; i < 2; ++i) { int R, C; stage_rc(tid * 16 + i * 8192, R, C); const int Rb = Epi::PERM ? ((R & ~31) + perm32(R & 31)) : R;
        voffA[i] = (unsigned)(R * K + C) * 2u; voffB[i] = (unsigned)(Rb * K + C) * 2u; }
    const size_t kstep = (size_t)(BK * 2);
    const size_t hstep = (size_t)HALF * K * 2;
    const size_t tstep = 2 * hstep;
    const unsigned ldsw = (unsigned)wid * 1024u; const unsigned lds0 = (unsigned)(unsigned long)lds; (void)lds0;
    const int aoff = lds_byte(wr * 64 + fr, fq * 8), boff = lds_byte(wc * 32 + fr, fq * 8);
#define PG8_SA(b, h) (((b) * 2 + (h)) * HTB)
#define PG8_SB(b, h) ((4 + (b) * 2 + (h)) * HTB)
#if defined(PG8_ASM_STAGE) && PG8_ASM_STAGE
#define PG8_STAGE(bufoff, gbase, voff) do { const void* _gb = pg8_uniform(gbase); _Pragma("unroll") for (int _i = 0; _i < 2; ++_i) \
        pg8_glds(_gb, (voff)[_i], (unsigned)__builtin_amdgcn_readfirstlane((int)(lds0 + (unsigned)(bufoff) + ldsw + _i * 8192))); } while (0)
#else
#define PG8_STAGE(bufoff, gbase, voff) do { _Pragma("unroll") for (int _i = 0; _i < 2; ++_i) \
        __builtin_amdgcn_global_load_lds((const unsigned*)((const char*)(gbase) + (voff)[_i]), (PG8_LAS unsigned*)(lds + (bufoff) + ldsw + _i * 8192), 16, 0, 0); } while (0)
#endif
#define PG8_STAGE_A(b, h, X, VS) do { if constexpr (GATHER) { PG8_STAGE(PG8_SA(b, h), X, VS[h]); } else { PG8_STAGE(PG8_SA(b, h), (X) + (h) * hstep, voffA); } } while (0)
#define PG8_LOADROWS(u, v) do { _Pragma("unroll") for (int i_ = 0; i_ < 2; ++i_) { int R_, C_; stage_rc(tid * 16 + i_ * 8192, R_, C_); _Pragma("unroll") for (int h_ = 0; h_ < 2; ++h_) \
        v[h_][i_] = (unsigned)S.rowidx[(u).pm * 256 + h_ * 128 + R_] * (unsigned)(K * 2) + (unsigned)C_ * 2u; } } while (0)
#define PG8_LDA(dst, b, h) do { _Pragma("unroll") for (int m = 0; m < 4; ++m) _Pragma("unroll") for (int k = 0; k < 2; ++k) dst[m][k] = *(const PG8_LAS bf16x8*)(lds + PG8_SA(b, h) + aoff + m * 2048 + k * 1024); } while (0)
#define PG8_LDB(dst, b, h) do { _Pragma("unroll") for (int n = 0; n < 2; ++n) _Pragma("unroll") for (int k = 0; k < 2; ++k) dst[n][k] = *(const PG8_LAS bf16x8*)(lds + PG8_SB(b, h) + boff + n * 2048 + k * 1024); } while (0)
#define PG8_MMA(ai, bj, At, Bt) do { __builtin_amdgcn_s_setprio(1); _Pragma("unroll") for (int m = 0; m < 4; ++m) _Pragma("unroll") for (int n = 0; n < 2; ++n) _Pragma("unroll") for (int k = 0; k < 2; ++k) \
        acc[ai][bj][m][n] = __builtin_amdgcn_mfma_f32_16x16x32_bf16(Bt[n][k], At[m][k], acc[ai][bj][m][n], 0, 0, 0); __builtin_amdgcn_s_setprio(0); } while (0)
#define PG8_WAIT_V(n) asm volatile("s_waitcnt vmcnt(" #n ")" ::: "memory")
#define PG8_WAIT_L(n) asm volatile("s_waitcnt lgkmcnt(" #n ")" ::: "memory")
#define PG8_BAR __builtin_amdgcn_s_barrier()
#define PG8_SCHED __builtin_amdgcn_sched_barrier(0)
    Unit cur, nxt; int ui = 0;
    if (!S.next(0, cur)) return;
    f32x4 acc[2][2][4][2];
#pragma unroll
    for (int a = 0; a < 2; ++a)
#pragma unroll
        for (int b = 0; b < 2; ++b)
#pragma unroll
            for (int m = 0; m < 4; ++m)
#pragma unroll
                for (int n = 0; n < 2; ++n) acc[a][b][m][n] = (f32x4){0.f, 0.f, 0.f, 0.f};
    bf16x8 At[4][2], B0[2][2], B1[2][2];
    const char* cA = (const char*)g.A + (GATHER ? (size_t)0 : (size_t)cur.pm * tstep); const char* cB = (const char*)g.Bt + (size_t)cur.pn * tstep;
    S.a_ready(cur);
    if constexpr (GATHER) { PG8_LOADROWS(cur, vc); }
    if constexpr (SP2) {
        PG8_STAGE(PG8_SB(0, 0), cB, voffB); PG8_STAGE(PG8_SB(0, 1), cB + hstep, voffB); PG8_STAGE_A(0, 0, cA, vc); PG8_STAGE_A(0, 1, cA, vc);
        if (wr == 1) PG8_BAR;
        PG8_WAIT_V(2); PG8_BAR;
        PG8_STAGE(PG8_SB(1, 0), cB + kstep, voffB); PG8_STAGE_A(1, 0, cA + kstep, vc); PG8_STAGE(PG8_SB(1, 1), cB + hstep + kstep, voffB);
        PG8_WAIT_V(6); PG8_BAR;
    } else {
        PG8_STAGE(PG8_SB(0, 0), cB, voffB); PG8_STAGE_A(0, 0, cA, vc); PG8_STAGE(PG8_SB(0, 1), cB + hstep, voffB); PG8_STAGE_A(0, 1, cA, vc);
        if (wr == 1) PG8_BAR;
        PG8_WAIT_V(4); PG8_BAR;
        PG8_STAGE(PG8_SB(1, 0), cB + kstep, voffB); PG8_STAGE_A(1, 0, cA + kstep, vc); PG8_STAGE(PG8_SB(1, 1), cB + hstep + kstep, voffB);
        PG8_WAIT_V(6); PG8_BAR;
    }
    for (;;) {
        const bool has_next = S.next(ui + 1, nxt);
        const char* nA = (has_next && !GATHER) ? (const char*)g.A + (size_t)nxt.pm * tstep : cA; const char* nB = has_next ? (const char*)g.Bt + (size_t)nxt.pn * tstep : cB;
        for (int t = 0; t < nt; t += 2) {
            const bool last = (t == nt - 2);
            const char* a1 = cA + (size_t)(t + 1) * kstep;
            const char* a2 = last ? nA : cA + (size_t)(t + 2) * kstep; const char* b2 = last ? nB : cB + (size_t)(t + 2) * kstep;
            const char* a3 = a2 + kstep; const char* b3 = b2 + kstep;
            if (last && has_next) S.a_ready(nxt);
            if constexpr (GATHER) { if (last && has_next) { PG8_LOADROWS(nxt, vn); }
                _Pragma("unroll") for (int h_ = 0; h_ < 2; ++h_) _Pragma("unroll") for (int i_ = 0; i_ < 2; ++i_) vs[h_][i_] = (last && has_next) ? vn[h_][i_] : vc[h_][i_]; }
            if constexpr (Epi::MIDK) { if (t == nt / 2) E.mid(acc, cur, wr, wc, fr, fq); }
            if constexpr (SP2) {
            PG8_LDB(B0, 0, 0); PG8_LDB(B1, 0, 1); PG8_SCHED; PG8_LDA(At, 0, 0); PG8_STAGE_A(1, 1, a1, vc);
            PG8_WAIT_V(8); PG8_WAIT_L(0); PG8_BAR; PG8_MMA(0, 0, At, B0); PG8_MMA(0, 1, At, B1); PG8_BAR; PG8_SCHED;
            PG8_LDA(At, 0, 1); PG8_STAGE(PG8_SB(0, 0), b2, voffB); PG8_STAGE(PG8_SB(0, 1), b2 + hstep, voffB); PG8_STAGE_A(0, 0, a2, vs);
            PG8_WAIT_V(8); PG8_WAIT_L(0); PG8_BAR; PG8_MMA(1, 0, At, B0); PG8_MMA(1, 1, At, B1); PG8_BAR; PG8_SCHED;
            PG8_LDB(B0, 1, 0); PG8_LDB(B1, 1, 1); PG8_SCHED; PG8_LDA(At, 1, 0); PG8_STAGE_A(0, 1, a2, vs);
            PG8_WAIT_V(8); PG8_WAIT_L(0); PG8_BAR; PG8_MMA(0, 0, At, B0); PG8_MMA(0, 1, At, B1); PG8_BAR; PG8_SCHED;
            PG8_LDA(At, 1, 1); PG8_STAGE(PG8_SB(1, 0), b3, voffB); PG8_STAGE(PG8_SB(1, 1), b3 + hstep, voffB); PG8_STAGE_A(1, 0, a3, vs);
            PG8_WAIT_V(8); PG8_WAIT_L(0); PG8_BAR; PG8_MMA(1, 0, At, B0); PG8_MMA(1, 1, At, B1); PG8_BAR; PG8_SCHED;
            } else {
            PG8_LDB(B0, 0, 0); PG8_SCHED; PG8_LDA(At, 0, 0); PG8_STAGE_A(1, 1, a1, vc);
            PG8_WAIT_L(8); PG8_BAR; PG8_WAIT_L(0); PG8_MMA(0, 0, At, B0); PG8_BAR; PG8_SCHED;
            PG8_LDB(B1, 0, 1); PG8_STAGE(PG8_SB(0, 0), b2, voffB);
            PG8_BAR; PG8_WAIT_L(0); PG8_MMA(0, 1, At, B1); PG8_BAR;
            PG8_LDA(At, 0, 1); PG8_STAGE_A(0, 0, a2, vs);
            PG8_BAR; PG8_WAIT_L(0); PG8_MMA(1, 0, At, B0); PG8_BAR; PG8_SCHED;
            PG8_STAGE(PG8_SB(0, 1), b2 + hstep, voffB);
            PG8_WAIT_V(6); PG8_BAR; PG8_MMA(1, 1, At, B1); PG8_BAR;
            PG8_LDB(B0, 1, 0); PG8_SCHED; PG8_LDA(At, 1, 0); PG8_STAGE_A(0, 1, a2, vs);
            PG8_WAIT_L(8); PG8_BAR; PG8_WAIT_L(0); PG8_MMA(0, 0, At, B0); PG8_BAR; PG8_SCHED;
            PG8_LDB(B1, 1, 1); PG8_STAGE(PG8_SB(1, 0), b3, voffB);
            PG8_BAR; PG8_WAIT_L(0); PG8_MMA(0, 1, At, B1); PG8_BAR;
            PG8_LDA(At, 1, 1); PG8_STAGE_A(1, 0, a3, vs);
            PG8_BAR; PG8_WAIT_L(0); PG8_MMA(1, 0, At, B0); PG8_BAR; PG8_SCHED;
            PG8_STAGE(PG8_SB(1, 1), b3 + hstep, voffB);
            PG8_WAIT_V(6); PG8_BAR; PG8_MMA(1, 1, At, B1); PG8_BAR;
            }
        }
        if constexpr (ALIGN_EPI) { if (wr == 0) PG8_BAR; }
        if constexpr (!Epi::AFTER_DRAIN) { E(acc, cur, wr, wc, fr, fq); S.done(cur); }
        if (!has_next) break;
#pragma unroll
        for (int a = 0; a < 2; ++a)
#pragma unroll
            for (int b = 0; b < 2; ++b)
#pragma unroll
                for (int m = 0; m < 4; ++m)
#pragma unroll
                    for (int n = 0; n < 2; ++n) acc[a][b][m][n] = (f32x4){0.f, 0.f, 0.f, 0.f};
        cur = nxt; cA = nA; cB = nB; ++ui;
        if constexpr (GATHER) { _Pragma("unroll") for (int h_ = 0; h_ < 2; ++h_) _Pragma("unroll") for (int i_ = 0; i_ < 2; ++i_) vc[h_][i_] = vn[h_][i_]; }
        if constexpr (ALIGN_EPI) { if (wr == 1) PG8_BAR; }
    }
    PG8_WAIT_V(0);
    if constexpr (!ALIGN_EPI) { if (wr == 0) PG8_BAR; }
    PG8_BAR;
    if constexpr (Epi::AFTER_DRAIN) { E.fused(acc, cur, wr, wc, fr, fq, lds, wid, lane); S.done(cur); }
#undef PG8_SA
#undef PG8_SB
#undef PG8_STAGE
#undef PG8_STAGE_A
#undef PG8_LOADROWS
#undef PG8_LDA
#undef PG8_LDB
#undef PG8_MMA
#undef PG8_WAIT_V
#undef PG8_WAIT_L
#undef PG8_BAR
#undef PG8_SCHED
}
}
namespace mk {
constexpr int D = 1024, SEQ = 8192, NBMAX = 4, NH = 4, DIN = 5152, NE = 32, DE = 512, DEPTH = 2;
constexpr int NT_IN = 22, NIN = NT_IN * 256;
constexpr int NWAVES = 8, NTHR = 512;
#ifndef MK_MOE_FP8
#define MK_MOE_FP8 0
#endif
constexpr float WSCALE = 16.f, ASCALE = 4.f;
constexpr float LOG2E = 1.4426950408889634f, QSCALE = 0.125f * LOG2E, RMS_EPS = 1e-6f;
constexpr int O_GQ = 0, O_GK = 256, O_GV = 512, O_GG = 1024, O_LRF = 1536, O_LRB = 1552, O_DQ = 1568, O_DK = 2080, O_DV = 2592, O_GA = 3104, O_GB = 4128;
typedef unsigned short bf16;
typedef unsigned u32x4 __attribute__((ext_vector_type(4)));
typedef unsigned u32x2 __attribute__((ext_vector_type(2)));
typedef float f32x4 __attribute__((ext_vector_type(4)));
typedef float f32x16 __attribute__((ext_vector_type(16)));
typedef short bf16x8 __attribute__((ext_vector_type(8)));
typedef short s16x4 __attribute__((ext_vector_type(4)));
#define LAS __attribute__((address_space(3)))
#define GAS __attribute__((address_space(1)))
#define LDS_WAIT() asm volatile("s_waitcnt lgkmcnt(0)" ::: "memory")
#define VM_WAIT() asm volatile("s_waitcnt vmcnt(0)" ::: "memory")

constexpr size_t MiB = 1u << 20;
constexpr size_t CTL_BYTES = 256 * 1024;
constexpr int CW_BAR = 4096;
constexpr int CW_CNT = 32768;
constexpr size_t OFF_MOD = 256 * 1024, OFF_TAB = 512 * 1024;
constexpr size_t OFF_WIN = 1 * MiB, SZ_WIN = (size_t)DEPTH * NIN * D * 2;
constexpr size_t OFF_WAB = OFF_WIN + SZ_WIN, SZ_WAB = (size_t)DEPTH * D * D * 2;
constexpr size_t OFF_WO = OFF_WAB + SZ_WAB, SZ_WO = SZ_WAB;
constexpr size_t OFF_WR = OFF_WO + SZ_WO, SZ_WR = (size_t)DEPTH * 256 * D * 2;
constexpr size_t OFF_W1 = OFF_WR + SZ_WR, SZ_W1 = (size_t)DEPTH * NE * 1024 * D * 2;
constexpr size_t OFF_W2 = OFF_W1 + SZ_W1, SZ_W2 = (size_t)DEPTH * NE * D * DE * 2;
constexpr size_t OFF_ACT = 225 * MiB;
static_assert(OFF_W2 + SZ_W2 <= OFF_ACT, "weights fit");
struct WS {
    unsigned* ctl; float* mod; float* tab;
    bf16 *win, *wab, *wo, *wr, *w1, *w2;
    bf16 *H, *OAB; int* eid; float* gate; int* rank; int* pos; int* tilee; int* segp;
    bf16 *GQ, *GK, *GV, *SG; float *LGF, *LGB; bf16 *DQ, *DK, *DV, *SGA, *SGB; float* KVT; float* DEC; bf16* MERGED;
    bf16 *XS, *ACT, *YS; float* LOGITS; float* gsort; int* stok;
    size_t end;
};
__host__ __device__ inline WS ws_map(unsigned char* b, int nb) {
    WS w; const size_t T = (size_t)nb * SEQ;
    w.ctl = (unsigned*)b; w.mod = (float*)(b + OFF_MOD); w.tab = (float*)(b + OFF_TAB);
    w.win = (bf16*)(b + OFF_WIN); w.wab = (bf16*)(b + OFF_WAB); w.wo = (bf16*)(b + OFF_WO); w.wr = (bf16*)(b + OFF_WR); w.w1 = (bf16*)(b + OFF_W1); w.w2 = (bf16*)(b + OFF_W2);
    size_t o = OFF_ACT;
    auto take = [&](size_t bytes) { unsigned char* p = b + o; o += (bytes + 255) & ~(size_t)255; return p; };
    w.H = (bf16*)take(T * 2048); w.OAB = (bf16*)take(T * 2048);
    w.eid = (int*)take(T * 8); w.gate = (float*)take(T * 8); w.rank = (int*)take(T * 8); w.pos = (int*)take(T * 8); w.tilee = (int*)take(4096); w.segp = (int*)take(1024);
    const size_t u0 = o;
    w.GQ = (bf16*)take(T * 512); w.GK = (bf16*)take(T * 512); w.GV = (bf16*)take(T * 1024); w.SG = (bf16*)take(T * 1024);
    w.LGF = (float*)take(T * 1024); w.LGB = (float*)take(T * 1024);
    w.DQ = (bf16*)take(T * 1024); w.DK = (bf16*)take(T * 1024); w.DV = (bf16*)take(T * 1024); w.SGA = (bf16*)take(T * 2048); w.SGB = (bf16*)take(T * 2048);
    w.KVT = (float*)take(T * 4096); w.MERGED = (bf16*)w.KVT; w.DEC = (float*)take(T * 32);
    const size_t e1 = o; o = u0;
    const size_t R = 2 * T + 32 * 256;
    w.XS = (bf16*)take(R * 2048); w.ACT = (bf16*)take(R * 1024); w.YS = (bf16*)take(R * 2048); w.LOGITS = (float*)take(T * 256); w.gsort = (float*)take(R * 4); w.stok = (int*)take(R * 4);
    w.end = o > e1 ? o : e1;
    return w;
}

__device__ __forceinline__ unsigned cvt_pk(float lo, float hi) { unsigned r; asm volatile("v_cvt_pk_bf16_f32 %0, %1, %2" : "=v"(r) : "v"(lo), "v"(hi)); return r; }
__device__ __forceinline__ float bf2f(unsigned short b) { return __uint_as_float(((unsigned)b) << 16); }
__device__ __forceinline__ float bflo(unsigned w) { return __uint_as_float(w << 16); }
__device__ __forceinline__ float bfhi(unsigned w) { return __uint_as_float(w & 0xffff0000u); }
__device__ __forceinline__ float fsigmoid(float x) { return __builtin_amdgcn_rcpf(1.f + __expf(-x)); }
__device__ __forceinline__ float fsilu(float x) { return x * fsigmoid(x); }
__device__ __forceinline__ float wave_sum(float v) {
#pragma unroll
    for (int o = 1; o < 64; o <<= 1) v += __shfl_xor(v, o);
    return v;
}
__device__ __forceinline__ int t5_bucket(int rel) {
    int ret = rel > 0 ? 16 : 0; int n = rel < 0 ? -rel : rel;
    if (n < 8) return ret + n;
    return ret + 8 + (n >= 12) + (n >= 16) + (n >= 23) + (n >= 32) + (n >= 46) + (n >= 64) + (n >= 91);
}

#define XB_TMO      128
#define XB_XCNT(j)  (256  + 64 * (j))
#define XB_XSUB(j)  (1280 + 64 * (j))
#define XB_XGEN(j)  (2304 + 64 * (j))
#define XB_TOP      3328
#define XB_TOPGEN   3392
#define XCD_BAR_WORDS 3456
#define XB_SPIN_CAP (1u << 18)
__device__ __forceinline__ unsigned xb_ld(unsigned* p)              { return __hip_atomic_load(p, __ATOMIC_RELAXED, __HIP_MEMORY_SCOPE_AGENT); }
__device__ __forceinline__ unsigned xb_add(unsigned* p, unsigned v) { return __hip_atomic_fetch_add(p, v, __ATOMIC_RELAXED, __HIP_MEMORY_SCOPE_AGENT); }
__device__ __forceinline__ unsigned xb_xcc_id() { return (unsigned)__builtin_amdgcn_s_getreg((3 << 11) | 20) & 0xFu; }
#define XB_SPIN(cond, bar) do { unsigned _sp = 0; while (cond) { __builtin_amdgcn_s_sleep(1); \
    if ((++_sp & 255u) == 0u) { if (xb_ld(&(bar)[XB_TMO])) break; if (_sp > XB_SPIN_CAP) { atomicAdd(&(bar)[XB_TMO], 1u); break; } } } } while (0)
struct XcdBarrier { unsigned* bar; unsigned x; volatile LAS unsigned* st; };
__device__ __forceinline__ XcdBarrier xcd_barrier_post(unsigned* bar, volatile LAS unsigned* st) {
    XcdBarrier b; b.bar = bar; b.x = xb_xcc_id(); b.st = st;
    if (threadIdx.x == 0) (void)xb_add(&bar[XB_XCNT(b.x)], 1u);
    return b;
}
__device__ __forceinline__ void xcd_barrier_complete(unsigned* bar, unsigned x, unsigned& nloc, unsigned& nx) {
    const unsigned G = gridDim.x * gridDim.y * gridDim.z;
    unsigned sum, cnt, mine, sp = 0u;
    for (;;) {
        sum = 0u; cnt = 0u; mine = 0u;
#pragma unroll
        for (unsigned j = 0; j < 16; ++j) { const unsigned c = xb_ld(&bar[XB_XCNT(j)]); sum += c; cnt += (c > 0u) ? 1u : 0u; mine = (j == x) ? c : mine; }
        if (sum == G) break;
        __builtin_amdgcn_s_sleep(1);
        if ((++sp & 255u) == 0u) { if (xb_ld(&bar[XB_TMO])) break; if (sp > XB_SPIN_CAP) { atomicAdd(&bar[XB_TMO], 1u); break; } }
    }
    nloc = mine > 0u ? mine : 1u; nx = cnt > 0u ? cnt : 1u;
}
__device__ __forceinline__ void xcd_barrier(const XcdBarrier& b) {
    asm volatile("s_waitcnt vmcnt(0)" ::: "memory");
    __syncthreads();
    if (threadIdx.x == 0) {
        unsigned* bar = b.bar;
        __builtin_amdgcn_s_waitcnt(0);
        unsigned nloc = b.st[0], nx = b.st[1];
        if (nloc == 0u) { xcd_barrier_complete(bar, b.x, nloc, nx); b.st[0] = nloc; b.st[1] = nx; }
        const unsigned old = xb_add(&bar[XB_XSUB(b.x)], 1u);
        const unsigned gen = old / nloc;
        if (old + 1u == (gen + 1u) * nloc) {
            __builtin_amdgcn_fence(__ATOMIC_RELEASE, "agent");
            asm volatile("s_waitcnt vmcnt(0)" ::: "memory");
            const unsigned og = xb_add(&bar[XB_TOP], 1u);
            const unsigned tg = og / nx;
            if (og + 1u == (tg + 1u) * nx) xb_add(&bar[XB_TOPGEN], 1u);
            else XB_SPIN(xb_ld(&bar[XB_TOPGEN]) == tg, bar);
            __builtin_amdgcn_fence(__ATOMIC_ACQUIRE, "agent");
            xb_add(&bar[XB_XGEN(b.x)], 1u);
            asm volatile("s_waitcnt vmcnt(0)" ::: "memory");
        } else {
            XB_SPIN(xb_ld(&bar[XB_XGEN(b.x)]) == gen, bar);
            __builtin_amdgcn_fence(__ATOMIC_ACQUIRE, "agent");
            asm volatile("s_waitcnt vmcnt(0)" ::: "memory");
        }
    }
    __syncthreads();
}

struct Args { const float* in[24]; float* out; unsigned char* ws; int nb, ph_lo, ph_hi, li; };
struct Frame {
    LAS unsigned char* lds; int tid, lane, wave, G, bid, nb, T; unsigned char* ws; const Args* a; float* xbuf;
};
__device__ __forceinline__ void refresh(Frame& F) { int t = threadIdx.x; asm volatile("" : "+v"(t)); F.tid = t; F.lane = t & 63; F.wave = __builtin_amdgcn_readfirstlane(t >> 6); }
constexpr int LDS_BYTES = 160 * 1024 - 64 * 0;
constexpr int LDS_MISC = 160 * 1024 - 256;

__device__ __forceinline__ void tr_item(const float* src, int lds_, int ks0, int c0, bf16* dst, int ldd, int r0, int kd0, LAS float* scr, int lane) {
#pragma unroll 8
    for (int i = 0; i < 32; ++i) { const int kk = 2 * i + (lane >> 5); scr[kk * 33 + (lane & 31)] = src[(size_t)(ks0 + kk) * lds_ + c0 + (lane & 31)]; }
    LDS_WAIT(); asm volatile("" ::: "memory");
    const int c = lane & 7;
#pragma unroll
    for (int j = 0; j < 4; ++j) { const int n = (lane >> 3) + 8 * j; const LAS float* s = scr + (8 * c) * 33 + n;
        u32x4 o; o.x = cvt_pk(s[0 * 33], s[1 * 33]); o.y = cvt_pk(s[2 * 33], s[3 * 33]); o.z = cvt_pk(s[4 * 33], s[5 * 33]); o.w = cvt_pk(s[6 * 33], s[7 * 33]);
        *(u32x4*)(dst + (size_t)(r0 + n) * ldd + kd0 + 8 * c) = o; }
    LDS_WAIT(); asm volatile("" ::: "memory");
}
__device__ __forceinline__ void tr_item8(const float* src, int lds_, int ks0, int c0, unsigned char* dst, int ldd, int r0, int kd0, float scale, LAS float* scr, int lane) {
#pragma unroll 8
    for (int i = 0; i < 32; ++i) { const int kk = 2 * i + (lane >> 5); scr[kk * 33 + (lane & 31)] = src[(size_t)(ks0 + kk) * lds_ + c0 + (lane & 31)] * scale; }
    LDS_WAIT(); asm volatile("" ::: "memory");
    const int c = lane & 7;
#pragma unroll
    for (int j = 0; j < 4; ++j) { const int n = (lane >> 3) + 8 * j; const LAS float* s = scr + (8 * c) * 33 + n;
        int w0 = 0, w1 = 0;
        w0 = __builtin_amdgcn_cvt_pk_fp8_f32(s[0 * 33], s[1 * 33], w0, false); w0 = __builtin_amdgcn_cvt_pk_fp8_f32(s[2 * 33], s[3 * 33], w0, true);
        w1 = __builtin_amdgcn_cvt_pk_fp8_f32(s[4 * 33], s[5 * 33], w1, false); w1 = __builtin_amdgcn_cvt_pk_fp8_f32(s[6 * 33], s[7 * 33], w1, true);
        u32x2 o; o.x = (unsigned)w0; o.y = (unsigned)w1;
        *(u32x2*)(dst + (size_t)(r0 + n) * ldd + kd0 + 8 * c) = o; }
    LDS_WAIT(); asm volatile("" ::: "memory");
}
__device__ __forceinline__ int win_src_col(int tile, int p0) {
    const int bj = p0 >> 7, wc = (p0 >> 5) & 3; const int L = 64 * wc + 32 * bj;
    switch (tile) {
        case 0: return O_GQ + p0; case 1: return O_GK + p0;
        case 2: case 3: return O_GV + (tile - 2) * 256 + p0;
        case 4: case 5: return O_GG + (tile - 4) * 256 + p0;
        case 8: case 9: return O_DQ + (tile - 8) * 256 + L;
        case 10: case 11: return O_DK + (tile - 10) * 256 + L;
        case 12: case 13: return O_DV + (tile - 12) * 256 + p0;
        case 14: case 15: case 16: case 17: return O_GA + (tile - 14) * 256 + p0;
        default: return O_GB + (tile - 18) * 256 + p0;
    }
}
__device__ __forceinline__ void p0_prologue(Frame& F) {
    refresh(F);
    const WS W = ws_map(F.ws, F.nb); const float* const* IN_ = F.a->in;
    const float* c_in = IN_[1]; const float* w_ada = IN_[2]; const float* b_ada = IN_[3];
    {
        LAS float* red = (LAS float*)F.lds;
        for (int it = F.bid; it < DEPTH * 96; it += F.G) {
            const int l = it / 96, j = (it % 96) * 64 + F.lane;
            const float* w = w_ada + (size_t)l * D * 6 * D + j;
            float a0 = 0.f, a1 = 0.f, a2 = 0.f, a3 = 0.f;
            const int kbeg = F.wave * 128;
#pragma unroll 16
            for (int k = kbeg; k < kbeg + 128; ++k) { const float wv = w[(size_t)k * 6 * D];
                const float c0 = c_in[k], c1 = c_in[D + k], c2 = c_in[2 * D + k], c3 = c_in[3 * D + k];
                a0 += fsilu(c0) * wv; a1 += fsilu(c1) * wv; a2 += fsilu(c2) * wv; a3 += fsilu(c3) * wv; }
            red[(F.wave * 4 + 0) * 64 + F.lane] = a0; red[(F.wave * 4 + 1) * 64 + F.lane] = a1; red[(F.wave * 4 + 2) * 64 + F.lane] = a2; red[(F.wave * 4 + 3) * 64 + F.lane] = a3;
            __syncthreads();
            if (F.tid < 256) { const int b = F.tid >> 6, jj = F.tid & 63; float s = 0.f;
#pragma unroll
                for (int wv = 0; wv < 8; ++wv) s += red[(wv * 4 + b) * 64 + jj];
                const int jc = (it % 96) * 64 + jj;
                W.mod[((size_t)l * NBMAX + b) * 6 * D + jc] = s + b_ada[l * 6 * D + jc]; }
            __syncthreads();
        }
    }
    if (F.bid == 0) {
        const float* rb = IN_[14];
        for (int i = F.tid; i < 1024; i += NTHR) { const int h = i >> 8, rel = (i & 255) - 128; W.tab[i] = (rb[t5_bucket(rel) * 4 + h] - rb[31 * 4 + h]) * LOG2E; }
        if (F.tid < 4) W.tab[1024 + F.tid] = __expf(rb[15 * 4 + F.tid] - rb[31 * 4 + F.tid]);
        if (F.tid >= 64 && F.tid < 64 + DEPTH) { const int l = F.tid - 64; const float* lv = IN_[12] + l * 256; float s1 = 0.f, s2 = 0.f;
            for (int i = 0; i < 64; ++i) { s1 += lv[i] * lv[64 + i]; s2 += lv[128 + i] * lv[192 + i]; }
            W.tab[1032 + l] = expf(s1) - expf(s2) + (0.8f - 0.6f * expf(-0.3f * (float)l)); }
    }
    __syncthreads();
    LAS float* scr = (LAS float*)(F.lds + F.wave * 16384);
    const int gw = F.bid * NWAVES + F.wave, NGW = F.G * NWAVES;
    constexpr int I_IN = (NIN / 32) * 16, I_AB = 32 * 16, I_O = 32 * 16, I_1 = NE * 32 * 16, I_2 = NE * 32 * 8;
    constexpr int PER_L = I_IN + I_AB + I_O + I_1 + I_2;
    for (int it = gw; it < DEPTH * PER_L; it += NGW) {
        const int l = it / PER_L; int r = it % PER_L;
        if (r < I_IN) { const int rb = r / 16, kb = r % 16, R = rb * 32, tile = R >> 8, p0 = R & 255;
            if (tile == 6 || tile == 7) continue;
            tr_item(IN_[6] + (size_t)l * D * DIN, DIN, kb * 64, win_src_col(tile, p0), W.win + (size_t)l * NIN * D, D, R, kb * 64, scr, F.lane); continue; }
        r -= I_IN;
        if (r < I_AB) { const int rb = r / 16, kb = r % 16;
            if (kb < 8) tr_item(IN_[15] + (size_t)l * 512 * D, D, kb * 64, rb * 32, W.wab + (size_t)l * D * D, 512, rb * 32, kb * 64, scr, F.lane);
            else tr_item(IN_[16] + (size_t)l * 512 * D, D, (kb - 8) * 64, rb * 32, W.wab + (size_t)l * D * D + (size_t)1024 * 512, 512, rb * 32, (kb - 8) * 64, scr, F.lane);
            continue; }
        r -= I_AB;
        if (r < I_O) { const int rb = r / 16, kb = r % 16; tr_item(IN_[17] + (size_t)l * D * D, D, kb * 64, rb * 32, W.wo + (size_t)l * D * D, D, rb * 32, kb * 64, scr, F.lane); continue; }
        r -= I_O;
        if (r < I_1) { const int e = r / 512, q = r % 512, rb = q / 16, kb = q % 16, R = rb * 32, pn = R >> 8, p = R & 255;
            const int col = (p < 128) ? (128 * pn + p) : (512 + 128 * pn + p - 128);
#if MK_MOE_FP8
            tr_item8(IN_[22] + ((size_t)l * NE + e) * D * 1024, 1024, kb * 64, col, (unsigned char*)W.w1 + ((size_t)l * NE + e) * 1024 * D, D, R, kb * 64, WSCALE, scr, F.lane); continue; }
#else
            tr_item(IN_[22] + ((size_t)l * NE + e) * D * 1024, 1024, kb * 64, col, W.w1 + ((size_t)l * NE + e) * 1024 * D, D, R, kb * 64, scr, F.lane); continue; }
#endif
        r -= I_1;
        { const int e = r / 256, q = r % 256, rb = q / 8, kb = q % 8;
#if MK_MOE_FP8
          tr_item8(IN_[23] + ((size_t)l * NE + e) * DE * D, D, kb * 64, rb * 32, (unsigned char*)W.w2 + ((size_t)l * NE + e) * D * DE, DE, rb * 32, kb * 64, WSCALE, scr, F.lane); }
#else
          tr_item(IN_[23] + ((size_t)l * NE + e) * DE * D, D, kb * 64, rb * 32, W.w2 + ((size_t)l * NE + e) * D * DE, DE, rb * 32, kb * 64, scr, F.lane); }
#endif
    }
    for (int it = gw; it < DEPTH * 2 * 8 * 16; it += NGW) {
        const int l = it >> 8, dir = (it >> 7) & 1, nbk = (it >> 4) & 7, kb = it & 15; const int k = kb * 64 + F.lane;
        const float* wi = IN_[6] + (size_t)l * D * DIN + (size_t)k * DIN + (dir ? O_LRB : O_LRF);
        float wv[16];
#pragma unroll
        for (int r = 0; r < 16; ++r) wv[r] = wi[r];
        const float* wu = IN_[7] + ((size_t)l * 2 + dir) * 16 * 256;
        bf16* dst = W.win + (size_t)l * NIN * D + (size_t)((6 + dir) * 256) * D;
        for (int n = nbk * 32; n < nbk * 32 + 32; ++n) { float s = 0.f;
#pragma unroll
            for (int r = 0; r < 16; ++r) s += wv[r] * wu[r * 256 + n];
            dst[(size_t)n * D + k] = (bf16)(cvt_pk(s, 0.f) & 0xffffu); }
    }
    for (int it = gw * 64 + F.lane; it < DEPTH * 256 * 128; it += NGW * 64) {
        const int l = it / (256 * 128), q = it % (256 * 128), row = q >> 7, k0 = (q & 127) * 8;
        float v[8];
#pragma unroll
        for (int i = 0; i < 8; ++i) { float x = 0.f;
            if (row < 4) x = IN_[18][((size_t)l * D + k0 + i) * 4 + row]; else if (row < 36) x = IN_[20][((size_t)l * D + k0 + i) * 32 + row - 4];
            v[i] = x; }
        u32x4 o; o.x = cvt_pk(v[0], v[1]); o.y = cvt_pk(v[2], v[3]); o.z = cvt_pk(v[4], v[5]); o.w = cvt_pk(v[6], v[7]);
        *(u32x4*)(W.wr + ((size_t)l * 256 + row) * D + k0) = o;
    }
}

__device__ __forceinline__ void phase_norm(Frame& F, int l, int mode) {
    refresh(F);
    const WS W = ws_map(F.ws, F.nb); const float* const* IN_ = F.a->in;
    const int gw = F.bid * NWAVES + F.wave, NGW = F.G * NWAVES;
    const bool combine = (mode == 2) || (mode == 0 && l > 0);
    const int lp = (mode == 2) ? DEPTH - 1 : l - 1;
    const float* xsrc = (mode == 0 && l == 0) ? IN_[0] : F.xbuf;
    const float* ng = (mode == 1 ? IN_[5] : IN_[4]) + (size_t)(mode == 2 ? 0 : l) * D;
    for (int t = gw; t < F.T; t += NGW) {
        const int b = t / SEQ;
        const GAS f32x4* xr = (const GAS f32x4*)(xsrc + (size_t)t * D) + F.lane;
        f32x4 v[4];
#pragma unroll
        for (int j = 0; j < 4; ++j) v[j] = xr[64 * j];
        if (combine) {
            const float* g2 = W.mod + ((size_t)lp * NBMAX + b) * 6 * D + 5 * D;
            const int p0 = W.pos[t * 2], p1 = W.pos[t * 2 + 1];
            const GAS u32x2* y0 = (const GAS u32x2*)(W.YS + (size_t)p0 * D) + F.lane; const GAS u32x2* y1 = (const GAS u32x2*)(W.YS + (size_t)p1 * D) + F.lane;
#pragma unroll
            for (int j = 0; j < 4; ++j) { const u32x2 a = y0[64 * j], c = y1[64 * j]; const f32x4 g = *((const GAS f32x4*)g2 + F.lane + 64 * j);
                v[j].x += g.x * (bflo(a.x) + bflo(c.x)); v[j].y += g.y * (bfhi(a.x) + bfhi(c.x)); v[j].z += g.z * (bflo(a.y) + bflo(c.y)); v[j].w += g.w * (bfhi(a.y) + bfhi(c.y)); }
            GAS f32x4* xo = (GAS f32x4*)(F.xbuf + (size_t)t * D) + F.lane;
#pragma unroll
            for (int j = 0; j < 4; ++j) xo[64 * j] = v[j];
        }
        if (mode == 2) continue;
        float ss = 0.f;
#pragma unroll
        for (int j = 0; j < 4; ++j) ss += (v[j].x * v[j].x + v[j].y * v[j].y) + (v[j].z * v[j].z + v[j].w * v[j].w);
        const float rstd = rsqrtf(wave_sum(ss) * (1.f / D) + RMS_EPS);
        const float* md = W.mod + ((size_t)l * NBMAX + b) * 6 * D + (mode == 1 ? 3 * D : 0);
        GAS u32x2* ho = (GAS u32x2*)(W.H + (size_t)t * D) + F.lane;
#pragma unroll
        for (int j = 0; j < 4; ++j) { const f32x4 g = *((const GAS f32x4*)ng + F.lane + 64 * j), sh = *((const GAS f32x4*)md + F.lane + 64 * j), sc = *((const GAS f32x4*)(md + D) + F.lane + 64 * j);
            const float h0 = v[j].x * rstd * g.x * (1.f + sc.x) + sh.x, h1 = v[j].y * rstd * g.y * (1.f + sc.y) + sh.y, h2 = v[j].z * rstd * g.z * (1.f + sc.z) + sh.z, h3 = v[j].w * rstd * g.w * (1.f + sc.w) + sh.w;
            u32x2 o; o.x = cvt_pk(h0, h1); o.y = cvt_pk(h2, h3); ho[64 * j] = o; }
    }
}
typedef pg8::Unit Unit;
__device__ __forceinline__ u32x4 pack8(const f32x4& a, const f32x4& b) { u32x4 w; w.x = cvt_pk(a[0], a[1]); w.y = cvt_pk(a[2], a[3]); w.z = cvt_pk(b[0], b[1]); w.w = cvt_pk(b[2], b[3]); return w; }

#ifndef MK_ATT_FP8
#define MK_ATT_FP8 1
#endif
__device__ __forceinline__ u32x2 pack8_fp8(const f32x4& a, const f32x4& b) { int w0 = 0, w1 = 0;
    w0 = __builtin_amdgcn_cvt_pk_fp8_f32(a[0], a[1], w0, false); w0 = __builtin_amdgcn_cvt_pk_fp8_f32(a[2], a[3], w0, true);
    w1 = __builtin_amdgcn_cvt_pk_fp8_f32(b[0], b[1], w1, false); w1 = __builtin_amdgcn_cvt_pk_fp8_f32(b[2], b[3], w1, true);
    u32x2 r; r.x = (unsigned)w0; r.y = (unsigned)w1; return r; }
struct EpiNull {
    static constexpr bool PERM = true, AFTER_DRAIN = false, MIDK = false;
    __device__ __forceinline__ void operator()(const f32x4 (&acc)[2][2][4][2], const Unit&, int, int, int, int) const {
#pragma unroll
        for (int a = 0; a < 2; ++a)
#pragma unroll
            for (int b = 0; b < 2; ++b)
#pragma unroll
                for (int m = 0; m < 4; ++m) { asm volatile("" :: "v"(acc[a][b][m][0]), "v"(acc[a][b][m][1])); } }
};
struct EpiIn {
    static constexpr bool PERM = true, AFTER_DRAIN = false, MIDK = false;
    bf16 *GQ, *GK, *GV, *SG; float *LGF, *LGB; bf16 *DQ, *DK, *DV, *SGA, *SGB; const float* b_up; const float* qg; const float* kg;
    __device__ __forceinline__ void operator()(const f32x4 (&acc)[2][2][4][2], const Unit& u, int wr, int wc, int fr, int fq) const {
        const int pn = u.pn; const int row0 = u.pm * 256 + wr * 64 + fr;
        if (pn >= 8 && pn <= 11) {
            const bool isk = pn >= 10; const int head = 2 * ((pn - 8) & 1) + (wc >> 1), c = wc & 1;
            const float* gv = isk ? kg : qg; const float sc = isk ? 1.f : QSCALE;
            f32x4 g[2][2];
#pragma unroll
            for (int bj = 0; bj < 2; ++bj)
#pragma unroll
                for (int n = 0; n < 2; ++n) g[bj][n] = *(const f32x4*)(gv + 32 * bj + 8 * fq + 4 * n);
#pragma unroll
            for (int ai = 0; ai < 2; ++ai)
#pragma unroll
                for (int m = 0; m < 4; ++m) {
                    const int r = row0 + ai * 128 + m * 16, b = r / SEQ, s = r % SEQ;
                    float ss = 0.f;
#pragma unroll
                    for (int bj = 0; bj < 2; ++bj)
#pragma unroll
                        for (int n = 0; n < 2; ++n) { const f32x4 x = acc[ai][bj][m][n]; ss += (x[0] * x[0] + x[1] * x[1]) + (x[2] * x[2] + x[3] * x[3]); }
                    ss += __shfl_xor(ss, 16); ss += __shfl_xor(ss, 32);
                    const float rs = rsqrtf(ss * (1.f / 64.f) + RMS_EPS) * sc;
#if MK_ATT_FP8
                    unsigned char* dst8 = (unsigned char*)(isk ? DK : DQ) + ((((size_t)b * NH + head) * 2 + c) * SEQ + s) * 64;
#pragma unroll
                    for (int bj = 0; bj < 2; ++bj) {
                        const f32x4 v0 = acc[ai][bj][m][0] * rs * g[bj][0], v1 = acc[ai][bj][m][1] * rs * g[bj][1];
                        int chunk = 2 * bj + (fq >> 1); if (isk) chunk ^= ((s >> 2) & 3);
                        *(u32x2*)(dst8 + chunk * 16 + 8 * (fq & 1)) = pack8_fp8(v0, v1);
                    }
#else
                    bf16* dst = (isk ? DK : DQ) + ((((size_t)b * NH + head) * 2 + c) * SEQ + s) * 64;
#pragma unroll
                    for (int bj = 0; bj < 2; ++bj) {
                        const f32x4 v0 = acc[ai][bj][m][0] * rs * g[bj][0], v1 = acc[ai][bj][m][1] * rs * g[bj][1];
                        int chunk = 4 * bj + fq; if (isk) chunk ^= ((s >> 1) & 7);
                        *(u32x4*)(dst + chunk * 8) = pack8(v0, v1);
                    }
#endif
                }
            return;
        }
#pragma unroll
        for (int ai = 0; ai < 2; ++ai)
#pragma unroll
            for (int m = 0; m < 4; ++m) {
                const int r = row0 + ai * 128 + m * 16;
#pragma unroll
                for (int bj = 0; bj < 2; ++bj) {
                    const int c0 = 128 * bj + 32 * wc + 8 * fq;
                    f32x4 v0 = acc[ai][bj][m][0], v1 = acc[ai][bj][m][1];
                    if (pn == 0) { *(u32x4*)(GQ + (size_t)r * 256 + c0) = pack8(v0 * 0.125f, v1 * 0.125f); }
                    else if (pn == 1) { *(u32x4*)(GK + (size_t)r * 256 + c0) = pack8(v0, v1); }
                    else if (pn <= 3) { *(u32x4*)(GV + (size_t)r * 512 + (pn - 2) * 256 + c0) = pack8(v0, v1); }
                    else if (pn <= 5) {
#pragma unroll
                        for (int i = 0; i < 4; ++i) { v0[i] = fsilu(v0[i]); v1[i] = fsilu(v1[i]); }
                        *(u32x4*)(SG + (size_t)r * 512 + (pn - 4) * 256 + c0) = pack8(v0, v1); }
                    else if (pn <= 7) {
                        const float* bu = b_up + (pn - 6) * 256 + c0; const f32x4 b0 = *(const f32x4*)bu, b1 = *(const f32x4*)(bu + 4);
#pragma unroll
                        for (int i = 0; i < 4; ++i) { float z = v0[i] + b0[i]; v0[i] = (fminf(z, 0.f) - __logf(1.f + __expf(-fabsf(z)))) * (1.f / 16.f);
                                                      z = v1[i] + b1[i]; v1[i] = (fminf(z, 0.f) - __logf(1.f + __expf(-fabsf(z)))) * (1.f / 16.f); }
                        float* o = (pn == 6 ? LGF : LGB) + (size_t)r * 256 + c0; *(f32x4*)o = v0; *(f32x4*)(o + 4) = v1; }
#if MK_ATT_FP8
                    else if (pn <= 13) {
                        const int b = r / SEQ, s = r % SEQ, head = 2 * (pn - 12) + bj;
                        const int kk = s & 63, wkey = kk & 31, hh_ = (wkey >> 2) & 1, reg_ = (wkey & 3) + 4 * (wkey >> 3), pos = hh_ * 32 + 16 * (kk >> 5) + reg_;
                        unsigned char* tb = (unsigned char*)DV + (((size_t)b * NH + head) * (SEQ / 64) + (s >> 6)) * 8192;
                        const u32x2 pk = pack8_fp8(v0, v1); const int dv0 = 32 * wc + 8 * fq;
#pragma unroll
                        for (int i = 0; i < 8; ++i) { const int dv = dv0 + i; const unsigned byte = ((i < 4 ? pk.x : pk.y) >> (8 * (i & 3))) & 0xffu;
                            tb[dv * 64 + ((((pos >> 4) ^ ((dv >> 2) & 3)) << 4) | (pos & 15))] = (unsigned char)byte; } }
#else
                    else if (pn <= 13) {
                        const int b = r / SEQ, s = r % SEQ, head = 2 * (pn - 12) + bj;
                        bf16* dst = DV + ((((size_t)b * NH + head) * (SEQ / 8) + (s >> 3)) * 4 + wc) * 256 + (s & 7) * 32 + 8 * fq;
                        *(u32x4*)dst = pack8(v0, v1); }
#endif
                    else {
#pragma unroll
                        for (int i = 0; i < 4; ++i) { v0[i] = fsigmoid(v0[i]); v1[i] = fsigmoid(v1[i]); }
                        bf16* base = (pn <= 17) ? SGA + (pn - 14) * 256 : SGB + (pn - 18) * 256;
                        *(u32x4*)(base + (size_t)r * D + c0) = pack8(v0, v1); }
                }
            }
    }
};

struct EpiMerge {
    static constexpr bool PERM = true, AFTER_DRAIN = false, MIDK = false;
    const bf16* SGA; const bf16* SGB; bf16* O; int nM;
    __device__ __forceinline__ void operator()(const f32x4 (&acc)[2][2][4][2], const Unit& u, int wr, int wc, int fr, int fq) const {
        const int sel = u.pn >> 2; const int row0 = (u.pm - sel * nM) * 256 + wr * 64 + fr, col0 = (u.pn & 3) * 256 + wc * 32 + 8 * fq;
        const bf16* G = sel ? SGB : SGA;
#pragma unroll
        for (int ai = 0; ai < 2; ++ai)
#pragma unroll
            for (int m = 0; m < 4; ++m) { const size_t off = (size_t)(row0 + ai * 128 + m * 16) * D + col0;
#pragma unroll
                for (int bj = 0; bj < 2; ++bj) { const u32x4 b = *(const u32x4*)(G + off + bj * 128);
                    f32x4 v0 = acc[ai][bj][m][0], v1 = acc[ai][bj][m][1];
                    v0[0] *= bflo(b.x); v0[1] *= bfhi(b.x); v0[2] *= bflo(b.y); v0[3] *= bfhi(b.y); v1[0] *= bflo(b.z); v1[1] *= bfhi(b.z); v1[2] *= bflo(b.w); v1[3] *= bfhi(b.w);
                    if (sel) { const u32x4 t = *(const u32x4*)(O + off + bj * 128);
                        v0[0] += bflo(t.x); v0[1] += bfhi(t.x); v0[2] += bflo(t.y); v0[3] += bfhi(t.y); v1[0] += bflo(t.z); v1[1] += bfhi(t.z); v1[2] += bflo(t.w); v1[3] += bfhi(t.w); }
                    *(u32x4*)(O + off + bj * 128) = pack8(v0, v1); }
                asm volatile("" ::: "memory"); }
    }
};
struct MergeOrder {
    pg8::StaticOrder so; int nM;
    __device__ __forceinline__ bool next(int i, Unit& u) const { Unit t; if (!so.next(i >> 1, t)) return false; const int sel = i & 1; u.pm = t.pm + sel * nM; u.pn = t.pn + sel * 4; return true; }
    __device__ __forceinline__ void a_ready(const Unit&) const {}
    __device__ __forceinline__ void done(const Unit&) const {}
};

struct EpiResid {
    static constexpr bool PERM = false, AFTER_DRAIN = false, MIDK = false;
    const float* xin; float* xout; const float* g1;
    __device__ __forceinline__ void operator()(const f32x4 (&acc)[2][2][4][2], const Unit& u, int wr, int wc, int fr, int fq) const {
        const int row0 = u.pm * 256 + wr * 64 + fr, col0 = u.pn * 256 + wc * 32 + 4 * fq;
        const int b = (u.pm * 256) / SEQ; const float* g = g1 + (size_t)b * 6 * D + col0;
        f32x4 gv[2][2];
#pragma unroll
        for (int bj = 0; bj < 2; ++bj)
#pragma unroll
            for (int n = 0; n < 2; ++n) gv[bj][n] = *(const f32x4*)(g + bj * 128 + n * 16);
#pragma unroll
        for (int ai = 0; ai < 2; ++ai)
#pragma unroll
            for (int m = 0; m < 4; ++m) { const size_t off = (size_t)(row0 + ai * 128 + m * 16) * D + col0;
#pragma unroll
                for (int bj = 0; bj < 2; ++bj)
#pragma unroll
                    for (int n = 0; n < 2; ++n) { const f32x4 xv = *(const f32x4*)(xin + off + bj * 128 + n * 16); *(f32x4*)(xout + off + bj * 128 + n * 16) = xv + gv[bj][n] * acc[ai][bj][m][n]; } }
    }
};

struct EpiLogits {
    static constexpr bool PERM = false, AFTER_DRAIN = false, MIDK = false;
    float* L;
    __device__ __forceinline__ void operator()(const f32x4 (&acc)[2][2][4][2], const Unit& u, int wr, int wc, int fr, int fq) const {
        if (wc >= 2) return;
        const int row0 = u.pm * 256 + wr * 64 + fr, col0 = wc * 32 + 4 * fq;
#pragma unroll
        for (int ai = 0; ai < 2; ++ai)
#pragma unroll
            for (int m = 0; m < 4; ++m)
#pragma unroll
                for (int n = 0; n < 2; ++n) *(f32x4*)(L + (size_t)(row0 + ai * 128 + m * 16) * 64 + col0 + n * 16) = acc[ai][0][m][n];
    }
};

#ifndef MK_MOE_FP8
#define MK_MOE_FP8 0
#endif
#if MK_MOE_FP8
struct EpiAct {
    static constexpr bool PERM = true, AFTER_DRAIN = false, MIDK = false;
    unsigned char* ACT;
    __device__ __forceinline__ void operator()(const f32x4 (&acc)[2][2][4][2], const Unit& u, int wr, int wc, int fr, int fq) const {
        const int row0 = u.pm * 256 + wr * 64 + fr, col0 = (u.pn & 3) * 128 + wc * 32 + 8 * fq;
        constexpr float inv = 1.f / WSCALE;
#pragma unroll
        for (int ai = 0; ai < 2; ++ai)
#pragma unroll
            for (int m = 0; m < 4; ++m) { f32x4 v0, v1;
#pragma unroll
                for (int i = 0; i < 4; ++i) { v0[i] = fsilu(acc[ai][0][m][0][i] * inv) * acc[ai][1][m][0][i] * (inv * ASCALE); v1[i] = fsilu(acc[ai][0][m][1][i] * inv) * acc[ai][1][m][1][i] * (inv * ASCALE); }
                *(u32x2*)(ACT + (size_t)(row0 + ai * 128 + m * 16) * DE + col0) = pack8_fp8(v0, v1); }
    }
};
struct EpiYs {
    static constexpr bool PERM = true, AFTER_DRAIN = false, MIDK = false;
    bf16* YS; const float* gs;
    __device__ __forceinline__ void operator()(const f32x4 (&acc)[2][2][4][2], const Unit& u, int wr, int wc, int fr, int fq) const {
        const int row0 = u.pm * 256 + wr * 64 + fr, col0 = (u.pn & 3) * 256 + wc * 32 + 8 * fq;
#pragma unroll
        for (int ai = 0; ai < 2; ++ai)
#pragma unroll
            for (int m = 0; m < 4; ++m) { const int r = row0 + ai * 128 + m * 16; const float gt = gs[r] * (1.f / (WSCALE * ASCALE));
#pragma unroll
                for (int bj = 0; bj < 2; ++bj) *(u32x4*)(YS + (size_t)r * D + col0 + bj * 128) = pack8(acc[ai][bj][m][0] * gt, acc[ai][bj][m][1] * gt); }
    }
};
#else
struct EpiAct {
    static constexpr bool PERM = true, AFTER_DRAIN = false, MIDK = false;
    bf16* ACT;
    __device__ __forceinline__ void operator()(const f32x4 (&acc)[2][2][4][2], const Unit& u, int wr, int wc, int fr, int fq) const {
        const int row0 = u.pm * 256 + wr * 64 + fr, col0 = (u.pn & 3) * 128 + wc * 32 + 8 * fq;
#pragma unroll
        for (int ai = 0; ai < 2; ++ai)
#pragma unroll
            for (int m = 0; m < 4; ++m) { f32x4 v0, v1;
#pragma unroll
                for (int i = 0; i < 4; ++i) { v0[i] = fsilu(acc[ai][0][m][0][i]) * acc[ai][1][m][0][i]; v1[i] = fsilu(acc[ai][0][m][1][i]) * acc[ai][1][m][1][i]; }
                *(u32x4*)(ACT + (size_t)(row0 + ai * 128 + m * 16) * DE + col0) = pack8(v0, v1); }
    }
};
struct EpiYs {
    static constexpr bool PERM = true, AFTER_DRAIN = false, MIDK = false;
    bf16* YS; const float* gs;
    __device__ __forceinline__ void operator()(const f32x4 (&acc)[2][2][4][2], const Unit& u, int wr, int wc, int fr, int fq) const {
        const int row0 = u.pm * 256 + wr * 64 + fr, col0 = (u.pn & 3) * 256 + wc * 32 + 8 * fq;
#pragma unroll
        for (int ai = 0; ai < 2; ++ai)
#pragma unroll
            for (int m = 0; m < 4; ++m) { const int r = row0 + ai * 128 + m * 16; const float gt = gs[r];
#pragma unroll
                for (int bj = 0; bj < 2; ++bj) *(u32x4*)(YS + (size_t)r * D + col0 + bj * 128) = pack8(acc[ai][bj][m][0] * gt, acc[ai][bj][m][1] * gt); }
    }
};
#endif
struct GroupedOrder {
    const int* tilee; int U, G, c; const int* rowidx;
    __device__ __forceinline__ bool next(int i, Unit& u) const {
        int id;
        if ((G & 7) == 0) { const int gx = G >> 3, per = (U + 7) >> 3, n = i * gx + (c >> 3); if (n >= per) return false; id = (c & 7) * per + n; if (id >= U) return false; }
        else { id = i * G + c; if (id >= U) return false; }
        const int t = id >> 2; u.pm = t; u.pn = tilee[t] * 4 + (id & 3); return true;
    }
    __device__ __forceinline__ void a_ready(const Unit&) const {}
    __device__ __forceinline__ void done(const Unit&) const {}
};
constexpr int AT_KR = 0, AT_VR = 32768, AT_TAB = 65536, AT_SLOT = 8192;
typedef int v8i __attribute__((ext_vector_type(8)));
typedef int v4i __attribute__((ext_vector_type(4)));
__device__ __forceinline__ int crow(int r, int hi) { return (r & 3) + 8 * (r >> 2) + 4 * hi; }

__device__ __forceinline__ void attn_bias(f32x16& s0, f32x16& s1, int relbase, const LAS float* tabh) {
#pragma unroll
    for (int r = 0; r < 16; ++r) {
        int i0 = relbase + (r & 3) + 8 * (r >> 2); int i1 = i0 + 32;
        i0 = i0 < 0 ? 0 : (i0 > 255 ? 255 : i0); i1 = i1 < 0 ? 0 : (i1 > 255 ? 255 : i1);
        s0[r] += tabh[i0]; s1[r] += tabh[i1];
    }
}
template <int J>
__device__ __forceinline__ void attn_exp_chunk(f32x16& s0, f32x16& s1, float& lsum) {
    float ls = 0.f;
#pragma unroll
    for (int r = 4 * J; r < 4 * J + 4; ++r) { s0[r] = __builtin_amdgcn_exp2f(s0[r]); s1[r] = __builtin_amdgcn_exp2f(s1[r]); }
    (void)ls; (void)lsum;
}
__device__ __forceinline__ int pk4_bf8(float a, float b, float c, float d) { int w = 0; w = __builtin_amdgcn_cvt_pk_bf8_f32(a, b, w, false); w = __builtin_amdgcn_cvt_pk_bf8_f32(c, d, w, true); return w; }
__device__ __forceinline__ void glds16(const void* gsrc, unsigned lds_dst) { unsigned keep;
    asm volatile("s_mov_b32 %0, m0\n\ts_mov_b32 m0, %2\n\ts_nop 0\n\tglobal_load_lds_dwordx4 %1, off\n\ts_mov_b32 m0, %0" : "=&s"(keep) : "v"(gsrc), "s"(lds_dst) : "memory"); }
__device__ __forceinline__ void attn_dma_k(unsigned lds0, const unsigned char* kg0, int t, int slot, int wid, int lane) {
    glds16(kg0 + (size_t)(wid >> 2) * SEQ * 64 + (size_t)t * 4096 + (wid & 3) * 1024 + lane * 16, (unsigned)__builtin_amdgcn_readfirstlane((int)(lds0 + AT_KR + slot * AT_SLOT + wid * 1024)));
}
__device__ __forceinline__ void attn_dma_v(unsigned lds0, const unsigned char* vg0, int t, int slot, int wid, int lane) {
    glds16(vg0 + (size_t)t * 8192 + wid * 1024 + lane * 16, (unsigned)__builtin_amdgcn_readfirstlane((int)(lds0 + AT_VR + slot * AT_SLOT + wid * 1024)));
}
#define AT_RD128(dst, addr, off) asm volatile("ds_read_b128 %0, %1 offset:%c2" : "=&v"(dst) : "v"(addr), "i"(off) : "memory")
#define AT_MFMA8(a, b, c) __builtin_amdgcn_mfma_scale_f32_32x32x64_f8f6f4(a, b, c, 0, 0, 0, 0, 0, 0)
#define AT_MFMA8B(a, b, c) __builtin_amdgcn_mfma_scale_f32_32x32x64_f8f6f4(a, b, c, 0, 1, 0, 0, 0, 0)

template <int VAR>
__device__ __forceinline__ void phase_attn(Frame& F, int l) {
    refresh(F);
    const WS W = ws_map(F.ws, F.nb); const float* const* IN_ = F.a->in; (void)IN_; (void)W;
    const int lane = F.lane, wid = F.wave, r32 = lane & 31, hh = lane >> 5, qg = wid & 3, c = wid >> 2;
    LAS unsigned char* lds = F.lds; const unsigned lds0 = (unsigned)(unsigned long)lds;
    LAS float* tab = (LAS float*)(lds + AT_TAB);
    for (int i = F.tid; i < 1028; i += NTHR) tab[i] = W.tab[i];
    const float lam = W.tab[1032 + l]; const float lam_init = 0.8f - 0.6f * __expf(-0.3f * (float)l);
    const float* subg = IN_[13] + l * 128;
    const int U = F.nb * NH * 64;
    const int gx = F.G >> 3, per = U >> 3;
    const int sw = (r32 >> 2) & 3;
    const unsigned ka0 = lds0 + AT_KR + c * 4096 + r32 * 64 + (((2 * hh) ^ sw) << 4), ka1 = lds0 + AT_KR + c * 4096 + r32 * 64 + (((2 * hh + 1) ^ sw) << 4);
    const unsigned va0 = lds0 + AT_VR + r32 * 64 + (((2 * hh) ^ sw) << 4), va1 = lds0 + AT_VR + r32 * 64 + (((2 * hh + 1) ^ sw) << 4);
    const bool lag = wid >= 4;
    __syncthreads();
    for (int i = 0;; ++i) {
        int id;
        if ((F.G & 7) == 0) { const int n = i * gx + (F.bid >> 3); if (n >= per) break; id = (F.bid & 7) * per + n; }
        else { id = i * F.G + F.bid; if (id >= U) break; }
        const int bh = id >> 6, qb = id & 63, b = bh >> 2, h = bh & 3;
        const int qw0 = qb * 128 + 32 * qg;
        const unsigned char* kg0 = (const unsigned char*)W.DK + ((size_t)bh * 2) * SEQ * 64;
        const unsigned char* vg0 = (const unsigned char*)W.DV + (size_t)bh * SEQ * 128;
        v8i qf; { const unsigned char* qp = (const unsigned char*)W.DQ + (((size_t)bh * 2 + c) * SEQ + qw0 + r32) * 64 + 32 * hh;
            const v4i q0 = *(const v4i*)qp, q1 = *(const v4i*)(qp + 16); qf = (v8i){q0[0], q0[1], q0[2], q0[3], q1[0], q1[1], q1[2], q1[3]}; }
        asm volatile("s_waitcnt vmcnt(0)" ::: "memory");
        attn_dma_k(lds0, kg0, 0, 0, wid, lane); attn_dma_k(lds0, kg0, 1, 1, wid, lane); attn_dma_v(lds0, vg0, 0, 0, wid, lane); attn_dma_k(lds0, kg0, 2, 2, wid, lane);
        attn_dma_v(lds0, vg0, 1, 1, wid, lane); attn_dma_k(lds0, kg0, 3, 3, wid, lane); attn_dma_v(lds0, vg0, 2, 2, wid, lane);
        f32x16 o[4]; f32x16 osum = f32x16{};
#pragma unroll
        for (int dt = 0; dt < 4; ++dt) o[dt] = f32x16{};
        float lsum = 0.f;
        const v8i ones8 = {0x38383838, 0x38383838, 0x38383838, 0x38383838, 0x38383838, 0x38383838, 0x38383838, 0x38383838};
        const int tL = (qw0 >= 154) ? ((qw0 - 154) >> 6) + 1 : 0, tR = (qw0 + 185) >> 6;
        const float shl = tab[1024 + h];
        const LAS float* tabh = tab + h * 256;
        const int rel0 = -qw0 - r32 + 4 * hh + 128;
        const f32x16 cshift = {-2.f, -2.f, -2.f, -2.f, -2.f, -2.f, -2.f, -2.f, -2.f, -2.f, -2.f, -2.f, -2.f, -2.f, -2.f, -2.f};
        asm volatile("s_waitcnt vmcnt(4)" ::: "memory"); __builtin_amdgcn_s_barrier(); asm volatile("" ::: "memory");
        f32x16 sc0, sc1, sn0, sn1; v8i p; v4i kx[4];
        AT_RD128(kx[0], ka0, 0); AT_RD128(kx[1], ka1, 0); AT_RD128(kx[2], ka0, 2048); AT_RD128(kx[3], ka1, 2048);
        asm volatile("s_waitcnt lgkmcnt(0)" ::: "memory"); __builtin_amdgcn_sched_barrier(0);
        sc0 = AT_MFMA8(((v8i){kx[0][0], kx[0][1], kx[0][2], kx[0][3], kx[1][0], kx[1][1], kx[1][2], kx[1][3]}), qf, cshift);
        sc1 = AT_MFMA8(((v8i){kx[2][0], kx[2][1], kx[2][2], kx[2][3], kx[3][0], kx[3][1], kx[3][2], kx[3][3]}), qf, cshift);
        __builtin_amdgcn_s_barrier(); asm volatile("" ::: "memory");
        if (lag) { __builtin_amdgcn_s_barrier(); asm volatile("" ::: "memory"); }
#define AT_STEP(SL, t) do { \
            { const int tk = (t) + 4 < 128 ? (t) + 4 : 127; attn_dma_k(lds0, kg0, tk, SL, wid, lane); } \
            asm volatile("s_waitcnt vmcnt(4)" ::: "memory");                                                       \
            AT_RD128(kx[0], ka0, ((SL + 1) & 3) * AT_SLOT); AT_RD128(kx[1], ka1, ((SL + 1) & 3) * AT_SLOT);        \
            AT_RD128(kx[2], ka0, ((SL + 1) & 3) * AT_SLOT + 2048); AT_RD128(kx[3], ka1, ((SL + 1) & 3) * AT_SLOT + 2048); \
            if ((t) >= tL && (t) < tR) attn_bias(sc0, sc1, 64 * (t) + rel0, tabh);                                \
            attn_exp_chunk<0>(sc0, sc1, lsum); attn_exp_chunk<1>(sc0, sc1, lsum);                                 \
            asm volatile("s_waitcnt lgkmcnt(0)" ::: "memory"); __builtin_amdgcn_sched_barrier(0); \
            sn0 = AT_MFMA8(((v8i){kx[0][0], kx[0][1], kx[0][2], kx[0][3], kx[1][0], kx[1][1], kx[1][2], kx[1][3]}), qf, cshift); \
            __builtin_amdgcn_sched_barrier(0); \
            attn_exp_chunk<2>(sc0, sc1, lsum); \
            __builtin_amdgcn_sched_barrier(0); \
            sn1 = AT_MFMA8(((v8i){kx[2][0], kx[2][1], kx[2][2], kx[2][3], kx[3][0], kx[3][1], kx[3][2], kx[3][3]}), qf, cshift); \
            __builtin_amdgcn_sched_barrier(0); \
            attn_exp_chunk<3>(sc0, sc1, lsum); \
            p[0] = pk4_bf8(sc0[0], sc0[1], sc0[2], sc0[3]); p[1] = pk4_bf8(sc0[4], sc0[5], sc0[6], sc0[7]); p[2] = pk4_bf8(sc0[8], sc0[9], sc0[10], sc0[11]); p[3] = pk4_bf8(sc0[12], sc0[13], sc0[14], sc0[15]); \
            p[4] = pk4_bf8(sc1[0], sc1[1], sc1[2], sc1[3]); p[5] = pk4_bf8(sc1[4], sc1[5], sc1[6], sc1[7]); p[6] = pk4_bf8(sc1[8], sc1[9], sc1[10], sc1[11]); p[7] = pk4_bf8(sc1[12], sc1[13], sc1[14], sc1[15]); \
            __builtin_amdgcn_s_barrier(); asm volatile("" ::: "memory"); \
            { const int tv = (t) + 3 < 128 ? (t) + 3 : 127; attn_dma_v(lds0, vg0, tv, (SL + 3) & 3, wid, lane); } \
            asm volatile("s_waitcnt vmcnt(4)" ::: "memory");                                                       \
            { v4i vx[8]; \
              AT_RD128(vx[0], va0, SL * AT_SLOT); AT_RD128(vx[1], va1, SL * AT_SLOT); AT_RD128(vx[2], va0, SL * AT_SLOT + 2048); AT_RD128(vx[3], va1, SL * AT_SLOT + 2048); \
              AT_RD128(vx[4], va0, SL * AT_SLOT + 4096); AT_RD128(vx[5], va1, SL * AT_SLOT + 4096); AT_RD128(vx[6], va0, SL * AT_SLOT + 6144); AT_RD128(vx[7], va1, SL * AT_SLOT + 6144); \
              if ((t) == tL) { _Pragma("unroll") for (int dt = 0; dt < 4; ++dt) o[dt] *= shl; osum *= shl; } \
              osum = AT_MFMA8B(ones8, p, osum); \
              asm volatile("s_waitcnt lgkmcnt(4)" ::: "memory"); __builtin_amdgcn_sched_barrier(0); \
              o[0] = AT_MFMA8B(((v8i){vx[0][0], vx[0][1], vx[0][2], vx[0][3], vx[1][0], vx[1][1], vx[1][2], vx[1][3]}), p, o[0]); \
              o[1] = AT_MFMA8B(((v8i){vx[2][0], vx[2][1], vx[2][2], vx[2][3], vx[3][0], vx[3][1], vx[3][2], vx[3][3]}), p, o[1]); \
              asm volatile("s_waitcnt lgkmcnt(0)" ::: "memory"); __builtin_amdgcn_sched_barrier(0); \
              o[2] = AT_MFMA8B(((v8i){vx[4][0], vx[4][1], vx[4][2], vx[4][3], vx[5][0], vx[5][1], vx[5][2], vx[5][3]}), p, o[2]); \
              o[3] = AT_MFMA8B(((v8i){vx[6][0], vx[6][1], vx[6][2], vx[6][3], vx[7][0], vx[7][1], vx[7][2], vx[7][3]}), p, o[3]); } \
            sc0 = sn0; sc1 = sn1; \
            __builtin_amdgcn_s_barrier(); asm volatile("" ::: "memory"); } while (0)
        for (int t0 = 0; t0 < 128; t0 += 4) { AT_STEP(0, t0); AT_STEP(1, t0 + 1); AT_STEP(2, t0 + 2); AT_STEP(3, t0 + 3); }
#undef AT_STEP
        if (!lag) { __builtin_amdgcn_s_barrier(); asm volatile("" ::: "memory"); }
        asm volatile("s_waitcnt vmcnt(0)" ::: "memory"); __builtin_amdgcn_s_barrier(); asm volatile("" ::: "memory");
        const float lt = osum[0];
        LAS float* xch = (LAS float*)(lds + qg * 16384);
        if (c == 1) { const float f = lam / lt;
#pragma unroll
            for (int dt = 0; dt < 4; ++dt)
#pragma unroll
                for (int r = 0; r < 16; ++r) xch[(dt * 16 + r) * 64 + lane] = o[dt][r] * f; }
        LDS_WAIT(); __builtin_amdgcn_s_barrier(); asm volatile("" ::: "memory");
        if (c == 0) { const float f = 1.f / lt; float ss = 0.f;
#pragma unroll
            for (int dt = 0; dt < 4; ++dt)
#pragma unroll
                for (int r = 0; r < 16; ++r) { const float v = o[dt][r] * f - xch[(dt * 16 + r) * 64 + lane]; o[dt][r] = v; ss += v * v; }
            ss += __shfl_xor(ss, 32);
            const float rn = rsqrtf(ss * (1.f / 128.f) + RMS_EPS) * (1.f - lam_init);
            bf16* orow = W.OAB + (size_t)F.T * 512 + ((size_t)b * SEQ + qw0 + r32) * 512 + h * 128;
#pragma unroll
            for (int dt = 0; dt < 4; ++dt)
#pragma unroll
                for (int g = 0; g < 4; ++g) { const int dv = 32 * dt + 8 * g + 4 * hh; const f32x4 sg = *(const f32x4*)(subg + dv);
                    u32x2 ov; ov.x = cvt_pk(o[dt][4 * g] * rn * sg[0], o[dt][4 * g + 1] * rn * sg[1]); ov.y = cvt_pk(o[dt][4 * g + 2] * rn * sg[2], o[dt][4 * g + 3] * rn * sg[3]);
                    *(u32x2*)(orow + dv) = ov; }
        }
        LDS_WAIT(); __builtin_amdgcn_s_barrier(); asm volatile("" ::: "memory");
    }
}
constexpr int GL_CUM = 0;
constexpr int GL_S64 = 144, GL_S192 = 400;
constexpr int G1_KEF = 34816, G1_KEB = G1_KEF + 64 * GL_S64, G1_VT = G1_KEB + 64 * GL_S64;
constexpr int G3_AOP = 34816, G3_KIF = G3_AOP + 64 * GL_S192, G3_KIB = G3_KIF + 64 * GL_S64, G3_BOP = G3_KIB + 64 * GL_S64;
static_assert(G3_BOP + 128 * GL_S192 <= 150 * 1024, "GLA LDS");

__device__ __forceinline__ bf16x8 lds_frag(const LAS unsigned char* base, int row, int stride, int kbyte) { return *(const LAS bf16x8*)(base + row * stride + kbyte); }

__device__ __forceinline__ void gla_cum(Frame& F, size_t trow0, int h) {
    const WS W = ws_map(F.ws, F.nb); const float* const* IN_ = F.a->in; (void)IN_; (void)W;
    LAS float* cum = (LAS float*)(F.lds + GL_CUM);
#pragma unroll
    for (int it = 0; it < 4; ++it) { const int idx = F.tid + it * NTHR; const int dir = idx >> 10, t = (idx >> 4) & 63, d4 = (idx & 15) * 4;
        const f32x4 v = *(const f32x4*)((dir ? W.LGB : W.LGF) + (trow0 + t) * 256 + h * 64 + d4);
        *(LAS f32x4*)(cum + (dir * 64 + t) * 64 + d4) = v; }
    __syncthreads();
    {
        const int dir = F.tid >> 8, seg = (F.tid >> 6) & 3, d = F.tid & 63; LAS float* cc = cum + dir * 4096 + d; LAS float* tot = cum + 8192 + (dir * 4 + seg) * 64 + d;
        float v[16]; float run = 0.f;
        if (dir == 0) {
#pragma unroll
            for (int i = 0; i < 16; ++i) { run += cc[(16 * seg + i) * 64]; v[i] = run; }
        } else {
#pragma unroll
            for (int i = 15; i >= 0; --i) { run += cc[(16 * seg + i) * 64]; v[i] = run; }
        }
        *tot = run;
        __syncthreads();
        float off = 0.f; const LAS float* tb = cum + 8192 + dir * 256 + d;
        if (dir == 0) { if (seg > 0) off += tb[0]; if (seg > 1) off += tb[64]; if (seg > 2) off += tb[128]; }
        else { if (seg < 3) off += tb[192]; if (seg < 2) off += tb[128]; if (seg < 1) off += tb[64]; }
#pragma unroll
        for (int i = 0; i < 16; ++i) cc[(16 * seg + i) * 64] = v[i] + off;
    }
    __syncthreads();
}

__device__ __forceinline__ void phase_gla1(Frame& F) {
    refresh(F);
    const WS W = ws_map(F.ws, F.nb); const float* const* IN_ = F.a->in; (void)IN_; (void)W;
    LAS unsigned char* lds = F.lds; LAS float* cum = (LAS float*)(lds + GL_CUM);
    const int lane = F.lane, wid = F.wave, r32 = lane & 31, hh = lane >> 5;
    const int U = F.nb * NH * 128;
    for (int u = F.bid; u < U; u += F.G) {
        const int n = u & 127, bh = u >> 7, b = bh >> 2, h = bh & 3; const size_t trow0 = (size_t)b * SEQ + n * 64;
        gla_cum(F, trow0, h);
        {
            const int t = F.tid >> 3, d0 = (F.tid & 7) * 8;
            const u32x4 kv = *(const u32x4*)(W.GK + (trow0 + t) * 256 + h * 64 + d0);
            const unsigned kw[4] = {kv.x, kv.y, kv.z, kv.w};
#pragma unroll
            for (int j = 0; j < 8; ++j) { const int d = d0 + j; const float k = (j & 1) ? bfhi(kw[j >> 1]) : bflo(kw[j >> 1]);
                const float ef = __expf(cum[63 * 64 + d] - cum[t * 64 + d]), eb = __expf(cum[4096 + d] - cum[4096 + t * 64 + d]);
                *(LAS bf16*)(lds + G1_KEF + d * GL_S64 + t * 2) = (bf16)(cvt_pk(k * ef, 0.f) & 0xffffu);
                *(LAS bf16*)(lds + G1_KEB + d * GL_S64 + t * 2) = (bf16)(cvt_pk(k * eb, 0.f) & 0xffffu); }
            const int v0 = (F.tid & 7) * 16;
            const u32x4 va = *(const u32x4*)(W.GV + (trow0 + t) * 512 + h * 128 + v0), vb = *(const u32x4*)(W.GV + (trow0 + t) * 512 + h * 128 + v0 + 8);
            const unsigned vw[8] = {va.x, va.y, va.z, va.w, vb.x, vb.y, vb.z, vb.w};
#pragma unroll
            for (int j = 0; j < 16; ++j) *(LAS bf16*)(lds + G1_VT + (v0 + j) * GL_S64 + t * 2) = (bf16)((j & 1) ? (vw[j >> 1] >> 16) : (vw[j >> 1] & 0xffffu));
            if (F.tid < 128) { const int dir = F.tid >> 6, d = F.tid & 63; W.DEC[((size_t)u * 2 + dir) * 64 + d] = __expf(dir ? cum[4096 + d] : cum[63 * 64 + d]); }
        }
        __syncthreads();
        {
            const int dt = wid & 3, dd = wid >> 2;
            f32x16 cf = {}, cb = {};
#pragma unroll
            for (int s = 0; s < 4; ++s) { const int kb = (16 * s + 8 * hh) * 2;
                const bf16x8 a = lds_frag(lds + G1_VT, 32 * dt + r32, GL_S64, kb);
                cf = __builtin_amdgcn_mfma_f32_32x32x16_bf16(a, lds_frag(lds + G1_KEF, 32 * dd + r32, GL_S64, kb), cf, 0, 0, 0);
                cb = __builtin_amdgcn_mfma_f32_32x32x16_bf16(a, lds_frag(lds + G1_KEB, 32 * dd + r32, GL_S64, kb), cb, 0, 0, 0); }
            float* of = W.KVT + ((size_t)u * 2) * 8192; float* ob = of + 8192;
#pragma unroll
            for (int r = 0; r < 16; ++r) { const int dv = 32 * dt + crow(r, hh), d = 32 * dd + r32; of[dv * 64 + d] = cf[r]; ob[dv * 64 + d] = cb[r]; }
        }
        __syncthreads();
    }
}

__device__ __forceinline__ void phase_gla2(Frame& F) {
    refresh(F);
    const WS W = ws_map(F.ws, F.nb); const float* const* IN_ = F.a->in; (void)IN_; (void)W;
    const size_t total = (size_t)F.nb * NH * 2 * 8192;
    for (size_t wk = (size_t)F.bid * NTHR + F.tid; wk < total; wk += (size_t)F.G * NTHR) {
        const int e = (int)(wk & 8191), dir = (int)((wk >> 13) & 1), bh = (int)(wk >> 14), d = e & 63;
        float* base = W.KVT + ((size_t)bh * 128 * 2 + dir) * 8192 + e; const float* dec = W.DEC + ((size_t)bh * 128 * 2 + dir) * 64 + d;
        float S = 0.f;
        for (int n0 = 0; n0 < 128; n0 += 8) {
            float kv[8], dc[8];
#pragma unroll
            for (int j = 0; j < 8; ++j) { const int n = dir ? 127 - (n0 + j) : n0 + j; kv[j] = base[(size_t)n * 16384]; dc[j] = dec[(size_t)n * 128]; }
#pragma unroll
            for (int j = 0; j < 8; ++j) { const int n = dir ? 127 - (n0 + j) : n0 + j; base[(size_t)n * 16384] = S; S = dc[j] * S + kv[j]; }
        }
    }
}

__device__ __forceinline__ void phase_gla3(Frame& F, int l) {
    refresh(F);
    const WS W = ws_map(F.ws, F.nb); const float* const* IN_ = F.a->in; (void)IN_; (void)W;
    LAS unsigned char* lds = F.lds; LAS float* cum = (LAS float*)(lds + GL_CUM);
    const int lane = F.lane, wid = F.wave, r32 = lane & 31, hh = lane >> 5;
    const float* gng = IN_[9] + l * 128;
    const int U = F.nb * NH * 128;
    for (int u = F.bid; u < U; u += F.G) {
        const int n = u & 127, bh = u >> 7, b = bh >> 2, h = bh & 3; const size_t trow0 = (size_t)b * SEQ + n * 64;
        gla_cum(F, trow0, h);
        {
            const int t = F.tid >> 3, d0 = (F.tid & 7) * 8;
            const u32x4 qv = *(const u32x4*)(W.GQ + (trow0 + t) * 256 + h * 64 + d0), kv = *(const u32x4*)(W.GK + (trow0 + t) * 256 + h * 64 + d0);
            const unsigned qw[4] = {qv.x, qv.y, qv.z, qv.w}, kw[4] = {kv.x, kv.y, kv.z, kv.w};
            float qf[8], qb[8], kf[8], kb[8];
#pragma unroll
            for (int j = 0; j < 8; ++j) { const int d = d0 + j; const float q = (j & 1) ? bfhi(qw[j >> 1]) : bflo(qw[j >> 1]), k = (j & 1) ? bfhi(kw[j >> 1]) : bflo(kw[j >> 1]);
                const float cf = cum[t * 64 + d], cb = cum[4096 + t * 64 + d];
                qf[j] = q * __expf(cf); qb[j] = q * __expf(cb); kf[j] = k * __expf(-cf); kb[j] = k * __expf(-cb); }
            u32x4 o;
            o.x = cvt_pk(qf[0], qf[1]); o.y = cvt_pk(qf[2], qf[3]); o.z = cvt_pk(qf[4], qf[5]); o.w = cvt_pk(qf[6], qf[7]); *(LAS u32x4*)(lds + G3_AOP + t * GL_S192 + (64 + d0) * 2) = o;
            o.x = cvt_pk(qb[0], qb[1]); o.y = cvt_pk(qb[2], qb[3]); o.z = cvt_pk(qb[4], qb[5]); o.w = cvt_pk(qb[6], qb[7]); *(LAS u32x4*)(lds + G3_AOP + t * GL_S192 + (128 + d0) * 2) = o;
            o.x = cvt_pk(kf[0], kf[1]); o.y = cvt_pk(kf[2], kf[3]); o.z = cvt_pk(kf[4], kf[5]); o.w = cvt_pk(kf[6], kf[7]); *(LAS u32x4*)(lds + G3_KIF + t * GL_S64 + d0 * 2) = o;
            o.x = cvt_pk(kb[0], kb[1]); o.y = cvt_pk(kb[2], kb[3]); o.z = cvt_pk(kb[4], kb[5]); o.w = cvt_pk(kb[6], kb[7]); *(LAS u32x4*)(lds + G3_KIB + t * GL_S64 + d0 * 2) = o;
            const int v0 = (F.tid & 7) * 16;
            const u32x4 va = *(const u32x4*)(W.GV + (trow0 + t) * 512 + h * 128 + v0), vb = *(const u32x4*)(W.GV + (trow0 + t) * 512 + h * 128 + v0 + 8);
            const unsigned vw[8] = {va.x, va.y, va.z, va.w, vb.x, vb.y, vb.z, vb.w};
#pragma unroll
            for (int j = 0; j < 16; ++j) *(LAS bf16*)(lds + G3_BOP + (v0 + j) * GL_S192 + t * 2) = (bf16)((j & 1) ? (vw[j >> 1] >> 16) : (vw[j >> 1] & 0xffffu));
            const int dv = F.tid >> 2, dd0 = (F.tid & 3) * 16;
#pragma unroll
            for (int dir = 0; dir < 2; ++dir) { const float* sp = W.KVT + ((size_t)u * 2 + dir) * 8192 + dv * 64 + dd0;
                const f32x4 a = *(const f32x4*)sp, bq = *(const f32x4*)(sp + 4), cq = *(const f32x4*)(sp + 8), dq = *(const f32x4*)(sp + 12);
                u32x4 o0, o1; o0.x = cvt_pk(a[0], a[1]); o0.y = cvt_pk(a[2], a[3]); o0.z = cvt_pk(bq[0], bq[1]); o0.w = cvt_pk(bq[2], bq[3]);
                o1.x = cvt_pk(cq[0], cq[1]); o1.y = cvt_pk(cq[2], cq[3]); o1.z = cvt_pk(dq[0], dq[1]); o1.w = cvt_pk(dq[2], dq[3]);
                *(LAS u32x4*)(lds + G3_BOP + dv * GL_S192 + (64 + 64 * dir + dd0) * 2) = o0; *(LAS u32x4*)(lds + G3_BOP + dv * GL_S192 + (64 + 64 * dir + dd0 + 8) * 2) = o1; }
        }
        __syncthreads();
        if (wid < 4) {
            const int it = wid >> 1, jt = wid & 1;
            f32x16 af = {}, ab = {};
#pragma unroll
            for (int s = 0; s < 4; ++s) { const int kb = (16 * s + 8 * hh) * 2;
                if (jt <= it) af = __builtin_amdgcn_mfma_f32_32x32x16_bf16(lds_frag(lds + G3_AOP, 32 * it + r32, GL_S192, 128 + kb), lds_frag(lds + G3_KIF, 32 * jt + r32, GL_S64, kb), af, 0, 0, 0);
                if (jt >= it) ab = __builtin_amdgcn_mfma_f32_32x32x16_bf16(lds_frag(lds + G3_AOP, 32 * it + r32, GL_S192, 256 + kb), lds_frag(lds + G3_KIB, 32 * jt + r32, GL_S64, kb), ab, 0, 0, 0); }
#pragma unroll
            for (int r = 0; r < 16; ++r) { const int i = 32 * it + crow(r, hh), j = 32 * jt + r32; const float v = (j <= i) ? af[r] : ab[r];
                *(LAS bf16*)(lds + G3_AOP + i * GL_S192 + j * 2) = (bf16)(cvt_pk(v, 0.f) & 0xffffu); }
        }
        __syncthreads();
        {
            const int it = wid >> 2, dt = wid & 3; f32x16 o = {};
#pragma unroll
            for (int s = 0; s < 12; ++s) { const int kb = (16 * s + 8 * hh) * 2;
                o = __builtin_amdgcn_mfma_f32_32x32x16_bf16(lds_frag(lds + G3_AOP, 32 * it + r32, GL_S192, kb), lds_frag(lds + G3_BOP, 32 * dt + r32, GL_S192, kb), o, 0, 0, 0); }
            LAS float* out = (LAS float*)(lds + GL_CUM);
#pragma unroll
            for (int r = 0; r < 16; ++r) out[(32 * it + crow(r, hh)) * 128 + 32 * dt + r32] = o[r];
        }
        __syncthreads();
        {
            const int t = F.tid >> 3, v0 = (F.tid & 7) * 16; const LAS float* orow = (const LAS float*)(lds + GL_CUM) + t * 128 + v0;
            float x[16]; float ss = 0.f;
#pragma unroll
            for (int j = 0; j < 16; ++j) { x[j] = orow[j]; ss += x[j] * x[j]; }
            ss += __shfl_xor(ss, 1); ss += __shfl_xor(ss, 2); ss += __shfl_xor(ss, 4);
            const float rs = rsqrtf(ss * (1.f / 128.f) + RMS_EPS);
            const u32x4 ga = *(const u32x4*)(W.SG + (trow0 + t) * 512 + h * 128 + v0), gb = *(const u32x4*)(W.SG + (trow0 + t) * 512 + h * 128 + v0 + 8);
            const unsigned gw[8] = {ga.x, ga.y, ga.z, ga.w, gb.x, gb.y, gb.z, gb.w};
            float y[16];
#pragma unroll
            for (int j = 0; j < 16; ++j) y[j] = x[j] * rs * gng[v0 + j] * ((j & 1) ? bfhi(gw[j >> 1]) : bflo(gw[j >> 1]));
            u32x4 o0, o1; o0.x = cvt_pk(y[0], y[1]); o0.y = cvt_pk(y[2], y[3]); o0.z = cvt_pk(y[4], y[5]); o0.w = cvt_pk(y[6], y[7]);
            o1.x = cvt_pk(y[8], y[9]); o1.y = cvt_pk(y[10], y[11]); o1.z = cvt_pk(y[12], y[13]); o1.w = cvt_pk(y[14], y[15]);
            bf16* dst = W.OAB + (trow0 + t) * 512 + h * 128 + v0; *(u32x4*)dst = o0; *(u32x4*)(dst + 8) = o1;
        }
        __syncthreads();
    }
}
__device__ __forceinline__ void phase_select(Frame& F, int l) {
    refresh(F);
    const WS W = ws_map(F.ws, F.nb); const float* const* IN_ = F.a->in; (void)IN_; (void)W;
    LAS int* lcnt = (LAS int*)F.lds; LAS int* lbase = lcnt + 32;
    const float* b_rg = IN_[19] + l * 4; const float* b_re = IN_[21] + l * 32;
    unsigned* gcnt = W.ctl + CW_CNT + l * 64;
    for (int t0 = F.bid * NTHR; t0 < F.T; t0 += F.G * NTHR) {
        if (F.tid < 32) lcnt[F.tid] = 0;
        __syncthreads();
        const int t = t0 + F.tid; int e0 = 0, e1 = 0, r0 = 0, r1 = 0; float g0 = 0.f, g1 = 0.f;
        if (t < F.T) {
            const float* lg = W.LOGITS + (size_t)t * 64;
            float gl[4]; { const f32x4 v = *(const f32x4*)lg; gl[0] = v[0] + b_rg[0]; gl[1] = v[1] + b_rg[1]; gl[2] = v[2] + b_rg[2]; gl[3] = v[3] + b_rg[3]; }
            int grp = 0; float mx = gl[0];
            if (gl[1] > mx) { mx = gl[1]; grp = 1; } if (gl[2] > mx) { mx = gl[2]; grp = 2; } if (gl[3] > mx) { mx = gl[3]; grp = 3; }
            const float p_grp = 1.f / (__expf(gl[0] - mx) + __expf(gl[1] - mx) + __expf(gl[2] - mx) + __expf(gl[3] - mx));
            const f32x4 ea = *(const f32x4*)(lg + 4 + grp * 8), eb = *(const f32x4*)(lg + 8 + grp * 8);
            const f32x4 ba = *(const f32x4*)(b_re + grp * 8), bb = *(const f32x4*)(b_re + grp * 8 + 4);
            float b0v = -1e30f, b1v = -1e30f; int i0 = 0, i1 = 0;
#pragma unroll
            for (int j = 0; j < 8; ++j) { const float e = (j < 4) ? ea[j] + ba[j] : eb[j - 4] + bb[j - 4];
                if (e > b0v) { b1v = b0v; i1 = i0; b0v = e; i0 = j; } else if (e > b1v) { b1v = e; i1 = j; } }
            const float p1 = __expf(b1v - b0v), s2 = 1.f + p1;
            e0 = grp * 8 + i0; e1 = grp * 8 + i1; g0 = p_grp / s2; g1 = p_grp * p1 / s2;
            r0 = __hip_atomic_fetch_add(lcnt + e0, 1, __ATOMIC_RELAXED, __HIP_MEMORY_SCOPE_WORKGROUP);
            r1 = __hip_atomic_fetch_add(lcnt + e1, 1, __ATOMIC_RELAXED, __HIP_MEMORY_SCOPE_WORKGROUP);
        }
        __syncthreads();
        if (F.tid < 32) lbase[F.tid] = (int)__hip_atomic_fetch_add(gcnt + F.tid, (unsigned)lcnt[F.tid], __ATOMIC_RELAXED, __HIP_MEMORY_SCOPE_AGENT);
        __syncthreads();
        if (t < F.T) { W.eid[t * 2] = e0; W.eid[t * 2 + 1] = e1; W.gate[t * 2] = g0; W.gate[t * 2 + 1] = g1; W.rank[t * 2] = lbase[e0] + r0; W.rank[t * 2 + 1] = lbase[e1] + r1; }
        __syncthreads();
    }
}
__device__ __forceinline__ void phase_gather(Frame& F, int l) {
    refresh(F);
    const WS W = ws_map(F.ws, F.nb); const float* const* IN_ = F.a->in; (void)IN_; (void)W;
    LAS int* seg = (LAS int*)F.lds; LAS int* cnt = seg + 40;
    const unsigned* gcnt = W.ctl + CW_CNT + l * 64;
    if (F.tid == 0) { int o = 0; for (int e = 0; e < 32; ++e) { const int c = (int)__hip_atomic_load(gcnt + e, __ATOMIC_RELAXED, __HIP_MEMORY_SCOPE_AGENT); seg[e] = o; cnt[e] = c; o += (c + 255) & ~255; } seg[32] = o; }
    __syncthreads();
    const int ntile = seg[32] >> 8;
    if (F.bid == 0) {
        for (int i = F.tid; i < ntile; i += NTHR) { int e = 0; while (e < 31 && (i << 8) >= seg[e + 1]) ++e; W.tilee[i] = e; }
        if (F.tid == 0) W.segp[0] = ntile;
    }
    for (int p = F.bid * NTHR + F.tid; p < (ntile << 8); p += F.G * NTHR) { int e = 0; while (e < 31 && p >= seg[e + 1]) ++e; if (p - seg[e] >= cnt[e]) W.stok[p] = 0; }
    for (int it = F.bid * NTHR + F.tid; it < F.T * 2; it += F.G * NTHR) {
        const int e = W.eid[it], p = seg[e] + W.rank[it];
        W.stok[p] = it >> 1; W.pos[it] = p; W.gsort[p] = W.gate[it];
    }
}

#ifndef MK_MASK
#define MK_MASK 0xffffffffu
#endif
#define EN(b) (((MK_MASK) >> (b)) & 1u)
#ifndef MK_DUP
#define MK_DUP 0u
#endif
#define REPS(b) ((((MK_DUP) >> (b)) & 1u) ? 2 : 1)
constexpr int NPL = 14, NPH = 2 + DEPTH * NPL;
__global__ void __launch_bounds__(NTHR, 2) mk_fwd(Args args) {
    extern __shared__ __attribute__((aligned(16))) unsigned char lds_raw[];
    Frame F;
    F.lds = (LAS unsigned char*)lds_raw; F.tid = threadIdx.x; F.lane = F.tid & 63; F.wave = __builtin_amdgcn_readfirstlane(F.tid >> 6);
    F.G = gridDim.x; F.bid = blockIdx.x; F.nb = args.nb; F.T = args.nb * SEQ; F.ws = args.ws; F.a = &args; F.xbuf = args.out;
    const float* const* IN_ = args.in;
    volatile LAS unsigned* misc = (volatile LAS unsigned*)(F.lds + LDS_MISC);
    if (F.tid < 64) misc[F.tid] = 0u;
    __syncthreads();
    XcdBarrier bar = xcd_barrier_post((unsigned*)args.ws + CW_BAR + args.li * XCD_BAR_WORDS, misc);
    const int lo = args.ph_lo, hi = args.ph_hi;
#define IN(k) (lo <= (k) && (k) < hi)
#ifdef MK_BAR2
#define SEAM(k) do { if (IN(k) && IN((k) + 1)) { xcd_barrier(bar); xcd_barrier(bar); } } while (0)
#else
#define SEAM(k) do { if (IN(k) && IN((k) + 1)) xcd_barrier(bar); } while (0)
#endif
    LAS unsigned char* gl = F.lds;
    if (EN(0) && IN(0)) { for (int rp = 0; rp < REPS(0); ++rp) { p0_prologue(F); __syncthreads(); } SEAM(0); }
    for (int l = 0; l < DEPTH; ++l) {
        const int pb = 1 + l * NPL;
        if (EN(1) && IN(pb + 0)) { for (int rp = 0; rp < ((l == 0) ? REPS(14) : 1); ++rp) phase_norm(F, l, 0); SEAM(pb + 0); }
        if (EN(2) && IN(pb + 1)) { const WS W = ws_map(F.ws, F.nb);
            pg8::Gemm g{W.H, W.win + (size_t)l * NIN * D, F.T, NIN, D}; pg8::StaticOrder S; S.init(F.T, NIN, F.G, F.bid);
            EpiIn E{W.GQ, W.GK, W.GV, W.SG, W.LGF, W.LGB, W.DQ, W.DK, W.DV, W.SGA, W.SGB, IN_[8] + l * 512, IN_[10] + l * 64, IN_[11] + l * 64};
#ifdef MK_INPROJ_NULL
            { EpiNull EN_; pg8::gemm_phase<EpiNull, pg8::StaticOrder, true, true>(gl, g, S, EN_); }
#endif
            for (int rp = 0; rp < REPS(2); ++rp) pg8::gemm_phase<EpiIn, pg8::StaticOrder, true, true>(gl, g, S, E);
            SEAM(pb + 1);
        }
        if (EN(3) && IN(pb + 2)) { for (int rp = 0; rp < REPS(3); ++rp) phase_gla1(F); SEAM(pb + 2); }
        if (EN(4) && IN(pb + 3)) { phase_gla2(F); SEAM(pb + 3); }
        if (EN(5) && IN(pb + 4)) { for (int rp = 0; rp < REPS(5); ++rp) phase_gla3(F, l); __syncthreads(); }
        if (EN(6) && IN(pb + 5)) {
#ifdef MK_ATT_PROBE
            phase_attn<MK_ATT_PROBE>(F, l);
#endif
            phase_attn<0>(F, l); SEAM(pb + 5); }
        if (EN(7) && IN(pb + 6)) { const WS W = ws_map(F.ws, F.nb);
            pg8::Gemm g{W.OAB, W.wab + (size_t)l * D * D, 0, 0, 512}; MergeOrder S; S.so.init(F.T, D, F.G, F.bid); S.nM = F.T / 256;
            EpiMerge E{W.SGA, W.SGB, W.MERGED, F.T / 256};
            for (int rp = 0; rp < REPS(7); ++rp) pg8::gemm_phase<EpiMerge, MergeOrder, true, true>(gl, g, S, E);
            SEAM(pb + 6);
        }
        if (EN(8) && IN(pb + 7)) { const WS W = ws_map(F.ws, F.nb); const float* modl = W.mod + (size_t)l * NBMAX * 6 * D;
            pg8::Gemm g{W.MERGED, W.wo + (size_t)l * D * D, F.T, D, D}; pg8::StaticOrder S; S.init(F.T, D, F.G, F.bid);
            EpiResid E{l == 0 ? IN_[0] : F.xbuf, F.xbuf, modl + 2 * D};
            for (int rp = 0; rp < ((l == 0) ? REPS(8) : 1); ++rp) pg8::gemm_phase<EpiResid, pg8::StaticOrder, true, true>(gl, g, S, E);
            SEAM(pb + 7);
        }
        if (EN(1) && IN(pb + 8)) { for (int rp = 0; rp < REPS(1); ++rp) phase_norm(F, l, 1); SEAM(pb + 8); }
        if (EN(9) && IN(pb + 9)) { const WS W = ws_map(F.ws, F.nb);
            pg8::Gemm g{W.H, W.wr + (size_t)l * 256 * D, F.T, 256, D}; pg8::StaticOrder S; S.init(F.T, 256, F.G, F.bid);
            EpiLogits E{W.LOGITS};
            for (int rp = 0; rp < REPS(9); ++rp) pg8::gemm_phase<EpiLogits, pg8::StaticOrder, true, true>(gl, g, S, E);
            SEAM(pb + 9);
        }
        if (EN(10) && IN(pb + 10)) { phase_select(F, l); SEAM(pb + 10); }
        if (EN(11) && IN(pb + 11)) { for (int rp = 0; rp < REPS(11); ++rp) { phase_gather(F, l); __syncthreads(); } SEAM(pb + 11); }
        if (EN(12) && IN(pb + 12)) { const WS W = ws_map(F.ws, F.nb);
            const int ntile = W.segp[0];
#if MK_MOE_FP8
            pg8::Gemm g{W.XS, (const bf16*)((const unsigned char*)W.w1 + (size_t)l * NE * 1024 * D), 0, 0, D / 2}; GroupedOrder S{W.tilee, ntile * 4, F.G, F.bid};
            EpiAct E{(unsigned char*)W.ACT};
#else
            pg8::Gemm g{W.H, W.w1 + (size_t)l * NE * 1024 * D, 0, 0, D}; GroupedOrder S{W.tilee, ntile * 4, F.G, F.bid, W.stok};
            EpiAct E{W.ACT};
#endif
            for (int rp = 0; rp < REPS(12); ++rp) pg8::gemm_phase<EpiAct, GroupedOrder, true, true, true>(gl, g, S, E);
            SEAM(pb + 12);
        }
        if (EN(13) && IN(pb + 13)) { const WS W = ws_map(F.ws, F.nb);
            const int ntile = W.segp[0];
#if MK_MOE_FP8
            pg8::Gemm g{W.ACT, (const bf16*)((const unsigned char*)W.w2 + (size_t)l * NE * D * DE), 0, 0, DE / 2}; GroupedOrder S{W.tilee, ntile * 4, F.G, F.bid};
#else
            pg8::Gemm g{W.ACT, W.w2 + (size_t)l * NE * D * DE, 0, 0, DE}; GroupedOrder S{W.tilee, ntile * 4, F.G, F.bid, nullptr};
#endif
            EpiYs E{W.YS, W.gsort};
            for (int rp = 0; rp < REPS(13); ++rp) pg8::gemm_phase<EpiYs, GroupedOrder, true, true>(gl, g, S, E);
            SEAM(pb + 13);
        }
    }
    if (EN(1) && IN(NPH - 1)) phase_norm(F, 0, 2);
#undef IN
#undef SEAM
}

struct LaunchCfg { int grid; bool ok; };
inline LaunchCfg& launch_cfg() {
    static LaunchCfg c{0, false}; static bool init = false;
    if (!init) { init = true;
        int dev = 0, cus = 0, per_cu = 0;
        if (hipGetDevice(&dev) != hipSuccess || hipDeviceGetAttribute(&cus, hipDeviceAttributeMultiprocessorCount, dev) != hipSuccess) { fprintf(stderr, "mk: device query failed\n"); return c; }
        if (hipFuncSetAttribute((const void*)mk_fwd, hipFuncAttributeMaxDynamicSharedMemorySize, LDS_BYTES) != hipSuccess) { fprintf(stderr, "mk: hipFuncSetAttribute failed\n"); return c; }
        if (hipOccupancyMaxActiveBlocksPerMultiprocessor(&per_cu, (const void*)mk_fwd, NTHR, LDS_BYTES) != hipSuccess || per_cu < 1) { fprintf(stderr, "mk: occupancy query says %d blocks/CU\n", per_cu); (void)hipGetLastError(); return c; }
        c.grid = cus; c.ok = true;
    }
    return c;
}
inline void launch_range(void* const* d_in, float* xbuf, void* d_ws, int nb, int lo, int hi, int li, hipStream_t stream) {
    LaunchCfg& c = launch_cfg(); if (!c.ok) return;
    Args a{}; for (int i = 0; i < 24; ++i) a.in[i] = (const float*)d_in[i];
    a.out = xbuf; a.ws = (unsigned char*)d_ws; a.nb = nb; a.ph_lo = lo; a.ph_hi = hi; a.li = li;
    hipLaunchKernelGGL(mk_fwd, dim3(c.grid), dim3(NTHR), LDS_BYTES, stream, a);
    const hipError_t le = hipPeekAtLastError(); if (le != hipSuccess) fprintf(stderr, "mk: launch [%d,%d) failed: %s\n", lo, hi, hipGetErrorName(le));
}
}
extern "C" void kernel_launch(void* const* d_in, const int* in_sizes, int n_in, void* d_out, int out_size, void* d_ws, size_t ws_size, hipStream_t stream) {
    (void)in_sizes; (void)n_in; (void)out_size;
    static int checked = 0;
    if (!checked) { checked = 1; const mk::WS w = mk::ws_map((unsigned char*)d_ws, 4); if (w.end > ws_size) { fprintf(stderr, "mk: workspace too small: need %zu, have %zu\n", w.end, ws_size); checked = -1; } }
    if (checked < 0) return;
    if (hipMemsetAsync(d_ws, 0, mk::CTL_BYTES, stream) != hipSuccess) return;
    mk::launch_range(d_in, (float*)d_out, d_ws, 4, 0, mk::NPH, 0, stream);
}
```

```cpp
#include <hip/hip_runtime.h>
#include <cstdio>
#include <cstdint>
#include <cmath>
#define MK_ATT_FP8 1
namespace pg8 {
#define PG8_LAS __attribute__((address_space(3)))
typedef unsigned short bf16_t;
typedef short bf16x8 __attribute__((ext_vector_type(8)));
typedef float f32x4 __attribute__((ext_vector_type(4)));
typedef unsigned u32x4 __attribute__((ext_vector_type(4)));
constexpr int BM = 256, BK = 64, HALF = 128, HTB = HALF * BK * 2  , STAGE_BYTES = 8 * HTB, NXCD = 8, WGM = 8;

__host__ __device__ __forceinline__ int lds_byte(int r, int c) { const int st = (r >> 4) * 2 + (c >> 5), rr = r & 15, cc = c & 31, ob = rr * 64 + cc * 2; return st * 1024 + (ob ^ (((ob >> 9) & 1) << 5)); }
__host__ __device__ __forceinline__ void stage_rc(int b, int& R, int& C) { const int st = b / 1024, sb = b % 1024, swz = sb ^ (((sb >> 9) & 1) << 5); R = (st >> 1) * 16 + swz / 64; C = (st & 1) * 32 + (swz % 64) / 2; }
__host__ __device__ __forceinline__ int perm32(int rho) { const int n = rho >> 4, i = rho & 15; return 8 * (i >> 2) + 4 * n + (i & 3); }

struct Unit { int pm, pn; };
struct Gemm { const bf16_t* A; const bf16_t* Bt; int M, N, K; };

struct StaticOrder {
    int nM, nN, nwg, G, c;
    __host__ __device__ void init(int M, int N, int G_, int c_) { nM = M / BM; nN = N / BM; nwg = nM * nN; G = G_; c = c_; }
    __host__ __device__ bool next(int i, Unit& u) const {
        const long L = (long)i * G + c; if (L >= nwg) return false;
        int wgid = (int)L; { const int q = nwg / NXCD, r = nwg % NXCD, xcd = wgid % NXCD, off = wgid / NXCD; wgid = (xcd < r ? xcd * (q + 1) : r * (q + 1) + (xcd - r) * q) + off; }
        const int nig = WGM * nN, gid = wgid / nig, fm = gid * WGM, gsz = (nM - fm) < WGM ? (nM - fm) : WGM;
        u.pm = fm + ((wgid % nig) % gsz); u.pn = (wgid % nig) / gsz; return true;
    }
    __device__ __forceinline__ void a_ready(const Unit&) const {}
    __device__ __forceinline__ void done(const Unit&) const {}
};
__device__ __forceinline__ unsigned cvt_pk_bf16(float lo, float hi) { unsigned r; asm volatile("v_cvt_pk_bf16_f32 %0, %1, %2" : "=v"(r) : "v"(lo), "v"(hi)); return r; }
__device__ __forceinline__ const void* pg8_uniform(const void* p) { const unsigned long long v = (unsigned long long)p;
    const unsigned lo = (unsigned)__builtin_amdgcn_readfirstlane((int)(unsigned)v), hi = (unsigned)__builtin_amdgcn_readfirstlane((int)(unsigned)(v >> 32)); return (const void*)(((unsigned long long)hi << 32) | lo); }
__device__ __forceinline__ void pg8_glds(const void* sbase, unsigned voff, unsigned ldsdst) { unsigned keep;
    asm volatile("s_nop 4\n\ts_mov_b32 %0, m0\n\ts_mov_b32 m0, %3\n\ts_nop 0\n\tglobal_load_lds_dwordx4 %1, %2\n\ts_mov_b32 m0, %0" : "=&s"(keep) : "v"(voff), "s"(sbase), "s"(ldsdst) : "memory"); }
typedef int pg8_v8i __attribute__((ext_vector_type(8)));
typedef int pg8_v4i __attribute__((ext_vector_type(4)));
template <class Epi, class Sched, bool ALIGN_EPI = false, bool SP2 = false, bool GATHER = false>
__device__ __forceinline__ void gemm_phase(PG8_LAS unsigned char* lds, const Gemm g, const Sched& S, const Epi& E) {
    int tid_ = threadIdx.x; asm volatile("" : "+v"(tid_));
    const int tid = tid_, wid = __builtin_amdgcn_readfirstlane(tid >> 6), lane = tid & 63, wr = wid >> 2, wc = wid & 3, fr = lane & 15, fq = lane >> 4;
    const int K = g.K, nt = K / BK;
    unsigned voffA[2], voffB[2]; unsigned vc[2][2] = {}, vn[2][2] = {}, vs[2][2] = {}; (void)vc; (void)vn; (void)vs;
#pragma unroll
    for (int i = 0; i < 2; ++i) { int R, C; stage_rc(tid * 16 + i * 8192, R, C); const int Rb = Epi::PERM ? ((R & ~31) + perm32(R & 31)) : R;
        voffA[i] = (unsigned)(R * K + C) * 2u; voffB[i] = (unsigned)(Rb * K + C) * 2u; }
    const size_t kstep = (size_t)(BK * 2);
    const size_t hstep = (size_t)HALF * K * 2;
    const size_t tstep = 2 * hstep;
    const unsigned ldsw = (unsigned)wid * 1024u; const unsigned lds0 = (unsigned)(unsigned long)lds; (void)lds0;
    const int aoff = lds_byte(wr * 64 + fr, fq * 8), boff = lds_byte(wc * 32 + fr, fq * 8);
#define PG8_SA(b, h) (((b) * 2 + (h)) * HTB)
#define PG8_SB(b, h) ((4 + (b) * 2 + (h)) * HTB)
#if defined(PG8_ASM_STAGE) && PG8_ASM_STAGE
#define PG8_STAGE(bufoff, gbase, voff) do { const void* _gb = pg8_uniform(gbase); _Pragma("unroll") for (int _i = 0; _i < 2; ++_i) \
        pg8_glds(_gb, (voff)[_i], (unsigned)__builtin_amdgcn_readfirstlane((int)(lds0 + (unsigned)(bufoff) + ldsw + _i * 8192))); } while (0)
#else
#define PG8_STAGE(bufoff, gbase, voff) do { _Pragma("unroll") for (int _i = 0; _i < 2; ++_i) \
        __builtin_amdgcn_global_load_lds((const unsigned*)((const char*)(gbase) + (voff)[_i]), (PG8_LAS unsigned*)(lds + (bufoff) + ldsw + _i * 8192), 16, 0, 0); } while (0)
#endif
#define PG8_STAGE_A(b, h, X, VS) do { if constexpr (GATHER) { PG8_STAGE(PG8_SA(b, h), X, VS[h]); } else { PG8_STAGE(PG8_SA(b, h), (X) + (h) * hstep, voffA); } } while (0)
#define PG8_LOADROWS(u, v) do { _Pragma("unroll") for (int i_ = 0; i_ < 2; ++i_) { int R_, C_; stage_rc(tid * 16 + i_ * 8192, R_, C_); _Pragma("unroll") for (int h_ = 0; h_ < 2; ++h_) \
        v[h_][i_] = (unsigned)S.rowidx[(u).pm * 256 + h_ * 128 + R_] * (unsigned)(K * 2) + (unsigned)C_ * 2u; } } while (0)
#define PG8_LDA(dst, b, h) do { _Pragma("unroll") for (int m = 0; m < 4; ++m) _Pragma("unroll") for (int k = 0; k < 2; ++k) dst[m][k] = *(const PG8_LAS bf16x8*)(lds + PG8_SA(b, h) + aoff + m * 2048 + k * 1024); } while (0)
#define PG8_LDB(dst, b, h) do { _Pragma("unroll") for (int n = 0; n < 2; ++n) _Pragma("unroll") for (int k = 0; k < 2; ++k) dst[n][k] = *(const PG8_LAS bf16x8*)(lds + PG8_SB(b, h) + boff + n * 2048 + k * 1024); } while (0)
#define PG8_MMA(ai, bj, At, Bt) do { __builtin_amdgcn_s_setprio(1); _Pragma("unroll") for (int m = 0; m < 4; ++m) _Pragma("unroll") for (int n = 0; n < 2; ++n) _Pragma("unroll") for (int k = 0; k < 2; ++k) \
        acc[ai][bj][m][n] = __builtin_amdgcn_mfma_f32_16x16x32_bf16(Bt[n][k], At[m][k], acc[ai][bj][m][n], 0, 0, 0); __builtin_amdgcn_s_setprio(0); } while (0)
#define PG8_WAIT_V(n) asm volatile("s_waitcnt vmcnt(" #n ")" ::: "memory")
#define PG8_WAIT_L(n) asm volatile("s_waitcnt lgkmcnt(" #n ")" ::: "memory")
#define PG8_BAR __builtin_amdgcn_s_barrier()
#define PG8_SCHED __builtin_amdgcn_sched_barrier(0)
    Unit cur, nxt; int ui = 0;
    if (!S.next(0, cur)) return;
    f32x4 acc[2][2][4][2];
#pragma unroll
    for (int a = 0; a < 2; ++a)
#pragma unroll
        for (int b = 0; b < 2; ++b)
#pragma unroll
            for (int m = 0; m < 4; ++m)
#pragma unroll
                for (int n = 0; n < 2; ++n) acc[a][b][m][n] = (f32x4){0.f, 0.f, 0.f, 0.f};
    bf16x8 At[4][2], B0[2][2], B1[2][2];
    const char* cA = (const char*)g.A + (GATHER ? (size_t)0 : (size_t)cur.pm * tstep); const char* cB = (const char*)g.Bt + (size_t)cur.pn * tstep;
    S.a_ready(cur);
    if constexpr (GATHER) { PG8_LOADROWS(cur, vc); }
    if constexpr (SP2) {
        PG8_STAGE(PG8_SB(0, 0), cB, voffB); PG8_STAGE(PG8_SB(0, 1), cB + hstep, voffB); PG8_STAGE_A(0, 0, cA, vc); PG8_STAGE_A(0, 1, cA, vc);
        if (wr == 1) PG8_BAR;
        PG8_WAIT_V(2); PG8_BAR;
        PG8_STAGE(PG8_SB(1, 0), cB + kstep, voffB); PG8_STAGE_A(1, 0, cA + kstep, vc); PG8_STAGE(PG8_SB(1, 1), cB + hstep + kstep, voffB);
        PG8_WAIT_V(6); PG8_BAR;
    } else {
        PG8_STAGE(PG8_SB(0, 0), cB, voffB); PG8_STAGE_A(0, 0, cA, vc); PG8_STAGE(PG8_SB(0, 1), cB + hstep, voffB); PG8_STAGE_A(0, 1, cA, vc);
        if (wr == 1) PG8_BAR;
        PG8_WAIT_V(4); PG8_BAR;
        PG8_STAGE(PG8_SB(1, 0), cB + kstep, voffB); PG8_STAGE_A(1, 0, cA + kstep, vc); PG8_STAGE(PG8_SB(1, 1), cB + hstep + kstep, voffB);
        PG8_WAIT_V(6); PG8_BAR;
    }
    for (;;) {
        const bool has_next = S.next(ui + 1, nxt);
        const char* nA = (has_next && !GATHER) ? (const char*)g.A + (size_t)nxt.pm * tstep : cA; const char* nB = has_next ? (const char*)g.Bt + (size_t)nxt.pn * tstep : cB;
        for (int t = 0; t < nt; t += 2) {
            const bool last = (t == nt - 2);
            const char* a1 = cA + (size_t)(t + 1) * kstep;
            const char* a2 = last ? nA : cA + (size_t)(t + 2) * kstep; const char* b2 = last ? nB : cB + (size_t)(t + 2) * kstep;
            const char* a3 = a2 + kstep; const char* b3 = b2 + kstep;
            if (last && has_next) S.a_ready(nxt);
            if constexpr (GATHER) { if (last && has_next) { PG8_LOADROWS(nxt, vn); }
                _Pragma("unroll") for (int h_ = 0; h_ < 2; ++h_) _Pragma("unroll") for (int i_ = 0; i_ < 2; ++i_) vs[h_][i_] = (last && has_next) ? vn[h_][i_] : vc[h_][i_]; }
            if constexpr (Epi::MIDK) { if (t == nt / 2) E.mid(acc, cur, wr, wc, fr, fq); }
            if constexpr (SP2) {
            PG8_LDB(B0, 0, 0); PG8_LDB(B1, 0, 1); PG8_SCHED; PG8_LDA(At, 0, 0); PG8_STAGE_A(1, 1, a1, vc);
            PG8_WAIT_V(8); PG8_WAIT_L(0); PG8_BAR; PG8_MMA(0, 0, At, B0); PG8_MMA(0, 1, At, B1); PG8_BAR; PG8_SCHED;
            PG8_LDA(At, 0, 1); PG8_STAGE(PG8_SB(0, 0), b2, voffB); PG8_STAGE(PG8_SB(0, 1), b2 + hstep, voffB); PG8_STAGE_A(0, 0, a2, vs);
            PG8_WAIT_V(8); PG8_WAIT_L(0); PG8_BAR; PG8_MMA(1, 0, At, B0); PG8_MMA(1, 1, At, B1); PG8_BAR; PG8_SCHED;
            PG8_LDB(B0, 1, 0); PG8_LDB(B1, 1, 1); PG8_SCHED; PG8_LDA(At, 1, 0); PG8_STAGE_A(0, 1, a2, vs);
            PG8_WAIT_V(8); PG8_WAIT_L(0); PG8_BAR; PG8_MMA(0, 0, At, B0); PG8_MMA(0, 1, At, B1); PG8_BAR; PG8_SCHED;
            PG8_LDA(At, 1, 1); PG8_STAGE(PG8_SB(1, 0), b3, voffB); PG8_STAGE(PG8_SB(1, 1), b3 + hstep, voffB); PG8_STAGE_A(1, 0, a3, vs);
            PG8_WAIT_V(8); PG8_WAIT_L(0); PG8_BAR; PG8_MMA(1, 0, At, B0); PG8_MMA(1, 1, At, B1); PG8_BAR; PG8_SCHED;
            } else {
            PG8_LDB(B0, 0, 0); PG8_SCHED; PG8_LDA(At, 0, 0); PG8_STAGE_A(1, 1, a1, vc);
            PG8_WAIT_L(8); PG8_BAR; PG8_WAIT_L(0); PG8_MMA(0, 0, At, B0); PG8_BAR; PG8_SCHED;
            PG8_LDB(B1, 0, 1); PG8_STAGE(PG8_SB(0, 0), b2, voffB);
            PG8_BAR; PG8_WAIT_L(0); PG8_MMA(0, 1, At, B1); PG8_BAR;
            PG8_LDA(At, 0, 1); PG8_STAGE_A(0, 0, a2, vs);
            PG8_BAR; PG8_WAIT_L(0); PG8_MMA(1, 0, At, B0); PG8_BAR; PG8_SCHED;
            PG8_STAGE(PG8_SB(0, 1), b2 + hstep, voffB);
            PG8_WAIT_V(6); PG8_BAR; PG8_MMA(1, 1, At, B1); PG8_BAR;
            PG8_LDB(B0, 1, 0); PG8_SCHED; PG8_LDA(At, 1, 0); PG8_STAGE_A(0, 1, a2, vs);
            PG8_WAIT_L(8); PG8_BAR; PG8_WAIT_L(0); PG8_MMA(0, 0, At, B0); PG8_BAR; PG8_SCHED;
            PG8_LDB(B1, 1, 1); PG8_STAGE(PG8_SB(1, 0), b3, voffB);
            PG8_BAR; PG8_WAIT_L(0); PG8_MMA(0, 1, At, B1); PG8_BAR;
            PG8_LDA(At, 1, 1); PG8_STAGE_A(1, 0, a3, vs);
            PG8_BAR; PG8_WAIT_L(0); PG8_MMA(1, 0, At, B0); PG8_BAR; PG8_SCHED;
            PG8_STAGE(PG8_SB(1, 1), b3 + hstep, voffB);
            PG8_WAIT_V(6); PG8_BAR; PG8_MMA(1, 1, At, B1); PG8_BAR;
            }
        }
        if constexpr (ALIGN_EPI) { if (wr == 0) PG8_BAR; }
        if constexpr (!Epi::AFTER_DRAIN) { E(acc, cur, wr, wc, fr, fq); S.done(cur); }
        if (!has_next) break;
#pragma unroll
        for (int a = 0; a < 2; ++a)
#pragma unroll
            for (int b = 0; b < 2; ++b)
#pragma unroll
                for (int m = 0; m < 4; ++m)
#pragma unroll
                    for (int n = 0; n < 2; ++n) acc[a][b][m][n] = (f32x4){0.f, 0.f, 0.f, 0.f};
        cur = nxt; cA = nA; cB = nB; ++ui;
        if constexpr (GATHER) { _Pragma("unroll") for (int h_ = 0; h_ < 2; ++h_) _Pragma("unroll") for (int i_ = 0; i_ < 2; ++i_) vc[h_][i_] = vn[h_][i_]; }
        if constexpr (ALIGN_EPI) { if (wr == 1) PG8_BAR; }
    }
    PG8_WAIT_V(0);
    if constexpr (!ALIGN_EPI) { if (wr == 0) PG8_BAR; }
    PG8_BAR;
    if constexpr (Epi::AFTER_DRAIN) { E.fused(acc, cur, wr, wc, fr, fq, lds, wid, lane); S.done(cur); }
#undef PG8_SA
#undef PG8_SB
#undef PG8_STAGE
#undef PG8_STAGE_A
#undef PG8_LOADROWS
#undef PG8_LDA
#undef PG8_LDB
#undef PG8_MMA
#undef PG8_WAIT_V
#undef PG8_WAIT_L
#undef PG8_BAR
#undef PG8_SCHED
}
}
namespace mk {
constexpr int D = 1024, SEQ = 8192, NBMAX = 4, NH = 4, DIN = 5152, NE = 32, DE = 512, DEPTH = 2;
constexpr int NT_IN = 22, NIN = NT_IN * 256;
constexpr int NWAVES = 8, NTHR = 512;
#ifndef MK_MOE_FP8
#define MK_MOE_FP8 0
#endif
constexpr float WSCALE = 16.f, ASCALE = 4.f;
constexpr float LOG2E = 1.4426950408889634f, QSCALE = 0.125f * LOG2E, RMS_EPS = 1e-6f;
constexpr int O_GQ = 0, O_GK = 256, O_GV = 512, O_GG = 1024, O_LRF = 1536, O_LRB = 1552, O_DQ = 1568, O_DK = 2080, O_DV = 2592, O_GA = 3104, O_GB = 4128;
typedef unsigned short bf16;
typedef unsigned u32x4 __attribute__((ext_vector_type(4)));
typedef unsigned u32x2 __attribute__((ext_vector_type(2)));
typedef float f32x4 __attribute__((ext_vector_type(4)));
typedef float f32x16 __attribute__((ext_vector_type(16)));
typedef short bf16x8 __attribute__((ext_vector_type(8)));
typedef short s16x4 __attribute__((ext_vector_type(4)));
#define LAS __attribute__((address_space(3)))
#define GAS __attribute__((address_space(1)))
#define LDS_WAIT() asm volatile("s_waitcnt lgkmcnt(0)" ::: "memory")
#define VM_WAIT() asm volatile("s_waitcnt vmcnt(0)" ::: "memory")

constexpr size_t MiB = 1u << 20;
constexpr size_t CTL_BYTES = 256 * 1024;
constexpr int CW_BAR = 4096;
constexpr int CW_CNT = 32768;
constexpr size_t OFF_MOD = 256 * 1024, OFF_TAB = 512 * 1024;
constexpr size_t OFF_WIN = 1 * MiB, SZ_WIN = (size_t)DEPTH * NIN * D * 2;
constexpr size_t OFF_WAB = OFF_WIN + SZ_WIN, SZ_WAB = (size_t)DEPTH * D * D * 2;
constexpr size_t OFF_WO = OFF_WAB + SZ_WAB, SZ_WO = SZ_WAB;
constexpr size_t OFF_WR = OFF_WO + SZ_WO, SZ_WR = (size_t)DEPTH * 256 * D * 2;
constexpr size_t OFF_W1 = OFF_WR + SZ_WR, SZ_W1 = (size_t)DEPTH * NE * 1024 * D * 2;
constexpr size_t OFF_W2 = OFF_W1 + SZ_W1, SZ_W2 = (size_t)DEPTH * NE * D * DE * 2;
constexpr size_t OFF_ACT = 225 * MiB;
static_assert(OFF_W2 + SZ_W2 <= OFF_ACT, "weights fit");
struct WS {
    unsigned* ctl; float* mod; float* tab;
    bf16 *win, *wab, *wo, *wr, *w1, *w2;
    bf16 *H, *OAB; int* eid; float* gate; int* rank; int* pos; int* tilee; int* segp;
    bf16 *GQ, *GK, *GV, *SG; float *LGF, *LGB; bf16 *DQ, *DK, *DV, *SGA, *SGB; float* KVT; float* DEC; bf16* MERGED;
    bf16 *XS, *ACT, *YS; float* LOGITS; float* gsort; int* stok;
    size_t end;
};
__host__ __device__ inline WS ws_map(unsigned char* b, int nb) {
    WS w; const size_t T = (size_t)nb * SEQ;
    w.ctl = (unsigned*)b; w.mod = (float*)(b + OFF_MOD); w.tab = (float*)(b + OFF_TAB);
    w.win = (bf16*)(b + OFF_WIN); w.wab = (bf16*)(b + OFF_WAB); w.wo = (bf16*)(b + OFF_WO); w.wr = (bf16*)(b + OFF_WR); w.w1 = (bf16*)(b + OFF_W1); w.w2 = (bf16*)(b + OFF_W2);
    size_t o = OFF_ACT;
    auto take = [&](size_t bytes) { unsigned char* p = b + o; o += (bytes + 255) & ~(size_t)255; return p; };
    w.H = (bf16*)take(T * 2048); w.OAB = (bf16*)take(T * 2048);
    w.eid = (int*)take(T * 8); w.gate = (float*)take(T * 8); w.rank = (int*)take(T * 8); w.pos = (int*)take(T * 8); w.tilee = (int*)take(4096); w.segp = (int*)take(1024);
    const size_t u0 = o;
    w.GQ = (bf16*)take(T * 512); w.GK = (bf16*)take(T * 512); w.GV = (bf16*)take(T * 1024); w.SG = (bf16*)take(T * 1024);
    w.LGF = (float*)take(T * 1024); w.LGB = (float*)take(T * 1024);
    w.DQ = (bf16*)take(T * 1024); w.DK = (bf16*)take(T * 1024); w.DV = (bf16*)take(T * 1024); w.SGA = (bf16*)take(T * 2048); w.SGB = (bf16*)take(T * 2048);
    w.KVT = (float*)take(T * 4096); w.MERGED = (bf16*)w.KVT; w.DEC = (float*)take(T * 32);
    const size_t e1 = o; o = u0;
    const size_t R = 2 * T + 32 * 256;
    w.XS = (bf16*)take(R * 2048); w.ACT = (bf16*)take(R * 1024); w.YS = (bf16*)take(R * 2048); w.LOGITS = (float*)take(T * 256); w.gsort = (float*)take(R * 4); w.stok = (int*)take(R * 4);
    w.end = o > e1 ? o : e1;
    return w;
}

__device__ __forceinline__ unsigned cvt_pk(float lo, float hi) { unsigned r; asm volatile("v_cvt_pk_bf16_f32 %0, %1, %2" : "=v"(r) : "v"(lo), "v"(hi)); return r; }
__device__ __forceinline__ float bf2f(unsigned short b) { return __uint_as_float(((unsigned)b) << 16); }
__device__ __forceinline__ float bflo(unsigned w) { return __uint_as_float(w << 16); }
__device__ __forceinline__ float bfhi(unsigned w) { return __uint_as_float(w & 0xffff0000u); }
__device__ __forceinline__ float fsigmoid(float x) { return __builtin_amdgcn_rcpf(1.f + __expf(-x)); }
__device__ __forceinline__ float fsilu(float x) { return x * fsigmoid(x); }
__device__ __forceinline__ float wave_sum(float v) {
#pragma unroll
    for (int o = 1; o < 64; o <<= 1) v += __shfl_xor(v, o);
    return v;
}
__device__ __forceinline__ int t5_bucket(int rel) {
    int ret = rel > 0 ? 16 : 0; int n = rel < 0 ? -rel : rel;
    if (n < 8) return ret + n;
    return ret + 8 + (n >= 12) + (n >= 16) + (n >= 23) + (n >= 32) + (n >= 46) + (n >= 64) + (n >= 91);
}

#define XB_TMO      128
#define XB_XCNT(j)  (256  + 64 * (j))
#define XB_XSUB(j)  (1280 + 64 * (j))
#define XB_XGEN(j)  (2304 + 64 * (j))
#define XB_TOP      3328
#define XB_TOPGEN   3392
#define XCD_BAR_WORDS 3456
#define XB_SPIN_CAP (1u << 18)
__device__ __forceinline__ unsigned xb_ld(unsigned* p)              { return __hip_atomic_load(p, __ATOMIC_RELAXED, __HIP_MEMORY_SCOPE_AGENT); }
__device__ __forceinline__ unsigned xb_add(unsigned* p, unsigned v) { return __hip_atomic_fetch_add(p, v, __ATOMIC_RELAXED, __HIP_MEMORY_SCOPE_AGENT); }
__device__ __forceinline__ unsigned xb_xcc_id() { return (unsigned)__builtin_amdgcn_s_getreg((3 << 11) | 20) & 0xFu; }
#define XB_SPIN(cond, bar) do { unsigned _sp = 0; while (cond) { __builtin_amdgcn_s_sleep(1); \
    if ((++_sp & 255u) == 0u) { if (xb_ld(&(bar)[XB_TMO])) break; if (_sp > XB_SPIN_CAP) { atomicAdd(&(bar)[XB_TMO], 1u); break; } } } } while (0)
struct XcdBarrier { unsigned* bar; unsigned x; volatile LAS unsigned* st; };
__device__ __forceinline__ XcdBarrier xcd_barrier_post(unsigned* bar, volatile LAS unsigned* st) {
    XcdBarrier b; b.bar = bar; b.x = xb_xcc_id(); b.st = st;
    if (threadIdx.x == 0) (void)xb_add(&bar[XB_XCNT(b.x)], 1u);
    return b;
}
__device__ __forceinline__ void xcd_barrier_complete(unsigned* bar, unsigned x, unsigned& nloc, unsigned& nx) {
    const unsigned G = gridDim.x * gridDim.y * gridDim.z;
    unsigned sum, cnt, mine, sp = 0u;
    for (;;) {
        sum = 0u; cnt = 0u; mine = 0u;
#pragma unroll
        for (unsigned j = 0; j < 16; ++j) { const unsigned c = xb_ld(&bar[XB_XCNT(j)]); sum += c; cnt += (c > 0u) ? 1u : 0u; mine = (j == x) ? c : mine; }
        if (sum == G) break;
        __builtin_amdgcn_s_sleep(1);
        if ((++sp & 255u) == 0u) { if (xb_ld(&bar[XB_TMO])) break; if (sp > XB_SPIN_CAP) { atomicAdd(&bar[XB_TMO], 1u); break; } }
    }
    nloc = mine > 0u ? mine : 1u; nx = cnt > 0u ? cnt : 1u;
}
__device__ __forceinline__ void xcd_barrier(const XcdBarrier& b) {
    asm volatile("s_waitcnt vmcnt(0)" ::: "memory");
    __syncthreads();
    if (threadIdx.x == 0) {
        unsigned* bar = b.bar;
        __builtin_amdgcn_s_waitcnt(0);
        unsigned nloc = b.st[0], nx = b.st[1];
        if (nloc == 0u) { xcd_barrier_complete(bar, b.x, nloc, nx); b.st[0] = nloc; b.st[1] = nx; }
        const unsigned old = xb_add(&bar[XB_XSUB(b.x)], 1u);
        const unsigned gen = old / nloc;
        if (old + 1u == (gen + 1u) * nloc) {
            __builtin_amdgcn_fence(__ATOMIC_RELEASE, "agent");
            asm volatile("s_waitcnt vmcnt(0)" ::: "memory");
            const unsigned og = xb_add(&bar[XB_TOP], 1u);
            const unsigned tg = og / nx;
            if (og + 1u == (tg + 1u) * nx) xb_add(&bar[XB_TOPGEN], 1u);
            else XB_SPIN(xb_ld(&bar[XB_TOPGEN]) == tg, bar);
            __builtin_amdgcn_fence(__ATOMIC_ACQUIRE, "agent");
            xb_add(&bar[XB_XGEN(b.x)], 1u);
            asm volatile("s_waitcnt vmcnt(0)" ::: "memory");
        } else {
            XB_SPIN(xb_ld(&bar[XB_XGEN(b.x)]) == gen, bar);
            __builtin_amdgcn_fence(__ATOMIC_ACQUIRE, "agent");
            asm volatile("s_waitcnt vmcnt(0)" ::: "memory");
        }
    }
    __syncthreads();
}

struct Args { const float* in[24]; float* out; unsigned char* ws; int nb, ph_lo, ph_hi, li; };
struct Frame {
    LAS unsigned char* lds; int tid, lane, wave, G, bid, nb, T; unsigned char* ws; const Args* a; float* xbuf;
};
__device__ __forceinline__ void refresh(Frame& F) { int t = threadIdx.x; asm volatile("" : "+v"(t)); F.tid = t; F.lane = t & 63; F.wave = __builtin_amdgcn_readfirstlane(t >> 6); }
constexpr int LDS_BYTES = 160 * 1024 - 64 * 0;
constexpr int LDS_MISC = 160 * 1024 - 256;

__device__ __forceinline__ void tr_item(const float* src, int lds_, int ks0, int c0, bf16* dst, int ldd, int r0, int kd0, LAS float* scr, int lane) {
#pragma unroll 8
    for (int i = 0; i < 32; ++i) { const int kk = 2 * i + (lane >> 5); scr[kk * 33 + (lane & 31)] = src[(size_t)(ks0 + kk) * lds_ + c0 + (lane & 31)]; }
    LDS_WAIT(); asm volatile("" ::: "memory");
    const int c = lane & 7;
#pragma unroll
    for (int j = 0; j < 4; ++j) { const int n = (lane >> 3) + 8 * j; const LAS float* s = scr + (8 * c) * 33 + n;
        u32x4 o; o.x = cvt_pk(s[0 * 33], s[1 * 33]); o.y = cvt_pk(s[2 * 33], s[3 * 33]); o.z = cvt_pk(s[4 * 33], s[5 * 33]); o.w = cvt_pk(s[6 * 33], s[7 * 33]);
        *(u32x4*)(dst + (size_t)(r0 + n) * ldd + kd0 + 8 * c) = o; }
    LDS_WAIT(); asm volatile("" ::: "memory");
}
__device__ __forceinline__ void tr_item8(const float* src, int lds_, int ks0, int c0, unsigned char* dst, int ldd, int r0, int kd0, float scale, LAS float* scr, int lane) {
#pragma unroll 8
    for (int i = 0; i < 32; ++i) { const int kk = 2 * i + (lane >> 5); scr[kk * 33 + (lane & 31)] = src[(size_t)(ks0 + kk) * lds_ + c0 + (lane & 31)] * scale; }
    LDS_WAIT(); asm volatile("" ::: "memory");
    const int c = lane & 7;
#pragma unroll
    for (int j = 0; j < 4; ++j) { const int n = (lane >> 3) + 8 * j; const LAS float* s = scr + (8 * c) * 33 + n;
        int w0 = 0, w1 = 0;
        w0 = __builtin_amdgcn_cvt_pk_fp8_f32(s[0 * 33], s[1 * 33], w0, false); w0 = __builtin_amdgcn_cvt_pk_fp8_f32(s[2 * 33], s[3 * 33], w0, true);
        w1 = __builtin_amdgcn_cvt_pk_fp8_f32(s[4 * 33], s[5 * 33], w1, false); w1 = __builtin_amdgcn_cvt_pk_fp8_f32(s[6 * 33], s[7 * 33], w1, true);
        u32x2 o; o.x = (unsigned)w0; o.y = (unsigned)w1;
        *(u32x2*)(dst + (size_t)(r0 + n) * ldd + kd0 + 8 * c) = o; }
    LDS_WAIT(); asm volatile("" ::: "memory");
}
__device__ __forceinline__ int win_src_col(int tile, int p0) {
    const int bj = p0 >> 7, wc = (p0 >> 5) & 3; const int L = 64 * wc + 32 * bj;
    switch (tile) {
        case 0: return O_GQ + p0; case 1: return O_GK + p0;
        case 2: case 3: return O_GV + (tile - 2) * 256 + p0;
        case 4: case 5: return O_GG + (tile - 4) * 256 + p0;
        case 8: case 9: return O_DQ + (tile - 8) * 256 + L;
        case 10: case 11: return O_DK + (tile - 10) * 256 + L;
        case 12: case 13: return O_DV + (tile - 12) * 256 + p0;
        case 14: case 15: case 16: case 17: return O_GA + (tile - 14) * 256 + p0;
        default: return O_GB + (tile - 18) * 256 + p0;
    }
}
__device__ __forceinline__ void p0_prologue(Frame& F) {
    refresh(F);
    const WS W = ws_map(F.ws, F.nb); const float* const* IN_ = F.a->in;
    const float* c_in = IN_[1]; const float* w_ada = IN_[2]; const float* b_ada = IN_[3];
    {
        LAS float* red = (LAS float*)F.lds;
        for (int it = F.bid; it < DEPTH * 96; it += F.G) {
            const int l = it / 96, j = (it % 96) * 64 + F.lane;
            const float* w = w_ada + (size_t)l * D * 6 * D + j;
            float a0 = 0.f, a1 = 0.f, a2 = 0.f, a3 = 0.f;
            const int kbeg = F.wave * 128;
#pragma unroll 16
            for (int k = kbeg; k < kbeg + 128; ++k) { const float wv = w[(size_t)k * 6 * D];
                const float c0 = c_in[k], c1 = c_in[D + k], c2 = c_in[2 * D + k], c3 = c_in[3 * D + k];
                a0 += fsilu(c0) * wv; a1 += fsilu(c1) * wv; a2 += fsilu(c2) * wv; a3 += fsilu(c3) * wv; }
            red[(F.wave * 4 + 0) * 64 + F.lane] = a0; red[(F.wave * 4 + 1) * 64 + F.lane] = a1; red[(F.wave * 4 + 2) * 64 + F.lane] = a2; red[(F.wave * 4 + 3) * 64 + F.lane] = a3;
            __syncthreads();
            if (F.tid < 256) { const int b = F.tid >> 6, jj = F.tid & 63; float s = 0.f;
#pragma unroll
                for (int wv = 0; wv < 8; ++wv) s += red[(wv * 4 + b) * 64 + jj];
                const int jc = (it % 96) * 64 + jj;
                W.mod[((size_t)l * NBMAX + b) * 6 * D + jc] = s + b_ada[l * 6 * D + jc]; }
            __syncthreads();
        }
    }
    if (F.bid == 0) {
        const float* rb = IN_[14];
        for (int i = F.tid; i < 1024; i += NTHR) { const int h = i >> 8, rel = (i & 255) - 128; W.tab[i] = (rb[t5_bucket(rel) * 4 + h] - rb[31 * 4 + h]) * LOG2E; }
        if (F.tid < 4) W.tab[1024 + F.tid] = __expf(rb[15 * 4 + F.tid] - rb[31 * 4 + F.tid]);
        if (F.tid >= 64 && F.tid < 64 + DEPTH) { const int l = F.tid - 64; const float* lv = IN_[12] + l * 256; float s1 = 0.f, s2 = 0.f;
            for (int i = 0; i < 64; ++i) { s1 += lv[i] * lv[64 + i]; s2 += lv[128 + i] * lv[192 + i]; }
            W.tab[1032 + l] = expf(s1) - expf(s2) + (0.8f - 0.6f * expf(-0.3f * (float)l)); }
    }
    __syncthreads();
    LAS float* scr = (LAS float*)(F.lds + F.wave * 16384);
    const int gw = F.bid * NWAVES + F.wave, NGW = F.G * NWAVES;
    constexpr int I_IN = (NIN / 32) * 16, I_AB = 32 * 16, I_O = 32 * 16, I_1 = NE * 32 * 16, I_2 = NE * 32 * 8;
    constexpr int PER_L = I_IN + I_AB + I_O + I_1 + I_2;
    for (int it = gw; it < DEPTH * PER_L; it += NGW) {
        const int l = it / PER_L; int r = it % PER_L;
        if (r < I_IN) { const int rb = r / 16, kb = r % 16, R = rb * 32, tile = R >> 8, p0 = R & 255;
            if (tile == 6 || tile == 7) continue;
            tr_item(IN_[6] + (size_t)l * D * DIN, DIN, kb * 64, win_src_col(tile, p0), W.win + (size_t)l * NIN * D, D, R, kb * 64, scr, F.lane); continue; }
        r -= I_IN;
        if (r < I_AB) { const int rb = r / 16, kb = r % 16;
            if (kb < 8) tr_item(IN_[15] + (size_t)l * 512 * D, D, kb * 64, rb * 32, W.wab + (size_t)l * D * D, 512, rb * 32, kb * 64, scr, F.lane);
            else tr_item(IN_[16] + (size_t)l * 512 * D, D, (kb - 8) * 64, rb * 32, W.wab + (size_t)l * D * D + (size_t)1024 * 512, 512, rb * 32, (kb - 8) * 64, scr, F.lane);
            continue; }
        r -= I_AB;
        if (r < I_O) { const int rb = r / 16, kb = r % 16; tr_item(IN_[17] + (size_t)l * D * D, D, kb * 64, rb * 32, W.wo + (size_t)l * D * D, D, rb * 32, kb * 64, scr, F.lane); continue; }
        r -= I_O;
        if (r < I_1) { const int e = r / 512, q = r % 512, rb = q / 16, kb = q % 16, R = rb * 32, pn = R >> 8, p = R & 255;
            const int col = (p < 128) ? (128 * pn + p) : (512 + 128 * pn + p - 128);
#if MK_MOE_FP8
            tr_item8(IN_[22] + ((size_t)l * NE + e) * D * 1024, 1024, kb * 64, col, (unsigned char*)W.w1 + ((size_t)l * NE + e) * 1024 * D, D, R, kb * 64, WSCALE, scr, F.lane); continue; }
#else
            tr_item(IN_[22] + ((size_t)l * NE + e) * D * 1024, 1024, kb * 64, col, W.w1 + ((size_t)l * NE + e) * 1024 * D, D, R, kb * 64, scr, F.lane); continue; }
#endif
        r -= I_1;
        { const int e = r / 256, q = r % 256, rb = q / 8, kb = q % 8;
#if MK_MOE_FP8
          tr_item8(IN_[23] + ((size_t)l * NE + e) * DE * D, D, kb * 64, rb * 32, (unsigned char*)W.w2 + ((size_t)l * NE + e) * D * DE, DE, rb * 32, kb * 64, WSCALE, scr, F.lane); }
#else
          tr_item(IN_[23] + ((size_t)l * NE + e) * DE * D, D, kb * 64, rb * 32, W.w2 + ((size_t)l * NE + e) * D * DE, DE, rb * 32, kb * 64, scr, F.lane); }
#endif
    }
    for (int it = gw; it < DEPTH * 2 * 8 * 16; it += NGW) {
        const int l = it >> 8, dir = (it >> 7) & 1, nbk = (it >> 4) & 7, kb = it & 15; const int k = kb * 64 + F.lane;
        const float* wi = IN_[6] + (size_t)l * D * DIN + (size_t)k * DIN + (dir ? O_LRB : O_LRF);
        float wv[16];
#pragma unroll
        for (int r = 0; r < 16; ++r) wv[r] = wi[r];
        const float* wu = IN_[7] + ((size_t)l * 2 + dir) * 16 * 256;
        bf16* dst = W.win + (size_t)l * NIN * D + (size_t)((6 + dir) * 256) * D;
        for (int n = nbk * 32; n < nbk * 32 + 32; ++n) { float s = 0.f;
#pragma unroll
            for (int r = 0; r < 16; ++r) s += wv[r] * wu[r * 256 + n];
            dst[(size_t)n * D + k] = (bf16)(cvt_pk(s, 0.f) & 0xffffu); }
    }
    for (int it = gw * 64 + F.lane; it < DEPTH * 256 * 128; it += NGW * 64) {
        const int l = it / (256 * 128), q = it % (256 * 128), row = q >> 7, k0 = (q & 127) * 8;
        float v[8];
#pragma unroll
        for (int i = 0; i < 8; ++i) { float x = 0.f;
            if (row < 4) x = IN_[18][((size_t)l * D + k0 + i) * 4 + row]; else if (row < 36) x = IN_[20][((size_t)l * D + k0 + i) * 32 + row - 4];
            v[i] = x; }
        u32x4 o; o.x = cvt_pk(v[0], v[1]); o.y = cvt_pk(v[2], v[3]); o.z = cvt_pk(v[4], v[5]); o.w = cvt_pk(v[6], v[7]);
        *(u32x4*)(W.wr + ((size_t)l * 256 + row) * D + k0) = o;
    }
}

__device__ __forceinline__ void phase_norm(Frame& F, int l, int mode) {
    refresh(F);
    const WS W = ws_map(F.ws, F.nb); const float* const* IN_ = F.a->in;
    const int gw = F.bid * NWAVES + F.wave, NGW = F.G * NWAVES;
    const bool combine = (mode == 2) || (mode == 0 && l > 0);
    const int lp = (mode == 2) ? DEPTH - 1 : l - 1;
    const float* xsrc = (mode == 0 && l == 0) ? IN_[0] : F.xbuf;
    const float* ng = (mode == 1 ? IN_[5] : IN_[4]) + (size_t)(mode == 2 ? 0 : l) * D;
    for (int t = gw; t < F.T; t += NGW) {
        const int b = t / SEQ;
        const GAS f32x4* xr = (const GAS f32x4*)(xsrc + (size_t)t * D) + F.lane;
        f32x4 v[4];
#pragma unroll
        for (int j = 0; j < 4; ++j) v[j] = xr[64 * j];
        if (combine) {
            const float* g2 = W.mod + ((size_t)lp * NBMAX + b) * 6 * D + 5 * D;
            const int p0 = W.pos[t * 2], p1 = W.pos[t * 2 + 1];
            const GAS u32x2* y0 = (const GAS u32x2*)(W.YS + (size_t)p0 * D) + F.lane; const GAS u32x2* y1 = (const GAS u32x2*)(W.YS + (size_t)p1 * D) + F.lane;
#pragma unroll
            for (int j = 0; j < 4; ++j) { const u32x2 a = y0[64 * j], c = y1[64 * j]; const f32x4 g = *((const GAS f32x4*)g2 + F.lane + 64 * j);
                v[j].x += g.x * (bflo(a.x) + bflo(c.x)); v[j].y += g.y * (bfhi(a.x) + bfhi(c.x)); v[j].z += g.z * (bflo(a.y) + bflo(c.y)); v[j].w += g.w * (bfhi(a.y) + bfhi(c.y)); }
            GAS f32x4* xo = (GAS f32x4*)(F.xbuf + (size_t)t * D) + F.lane;
#pragma unroll
            for (int j = 0; j < 4; ++j) xo[64 * j] = v[j];
        }
        if (mode == 2) continue;
        float ss = 0.f;
#pragma unroll
        for (int j = 0; j < 4; ++j) ss += (v[j].x * v[j].x + v[j].y * v[j].y) + (v[j].z * v[j].z + v[j].w * v[j].w);
        const float rstd = rsqrtf(wave_sum(ss) * (1.f / D) + RMS_EPS);
        const float* md = W.mod + ((size_t)l * NBMAX + b) * 6 * D + (mode == 1 ? 3 * D : 0);
        GAS u32x2* ho = (GAS u32x2*)(W.H + (size_t)t * D) + F.lane;
#pragma unroll
        for (int j = 0; j < 4; ++j) { const f32x4 g = *((const GAS f32x4*)ng + F.lane + 64 * j), sh = *((const GAS f32x4*)md + F.lane + 64 * j), sc = *((const GAS f32x4*)(md + D) + F.lane + 64 * j);
            const float h0 = v[j].x * rstd * g.x * (1.f + sc.x) + sh.x, h1 = v[j].y * rstd * g.y * (1.f + sc.y) + sh.y, h2 = v[j].z * rstd * g.z * (1.f + sc.z) + sh.z, h3 = v[j].w * rstd * g.w * (1.f + sc.w) + sh.w;
            u32x2 o; o.x = cvt_pk(h0, h1); o.y = cvt_pk(h2, h3); ho[64 * j] = o; }
    }
}
typedef pg8::Unit Unit;
__device__ __forceinline__ u32x4 pack8(const f32x4& a, const f32x4& b) { u32x4 w; w.x = cvt_pk(a[0], a[1]); w.y = cvt_pk(a[2], a[3]); w.z = cvt_pk(b[0], b[1]); w.w = cvt_pk(b[2], b[3]); return w; }

#ifndef MK_ATT_FP8
#define MK_ATT_FP8 1
#endif
__device__ __forceinline__ u32x2 pack8_fp8(const f32x4& a, const f32x4& b) { int w0 = 0, w1 = 0;
    w0 = __builtin_amdgcn_cvt_pk_fp8_f32(a[0], a[1], w0, false); w0 = __builtin_amdgcn_cvt_pk_fp8_f32(a[2], a[3], w0, true);
    w1 = __builtin_amdgcn_cvt_pk_fp8_f32(b[0], b[1], w1, false); w1 = __builtin_amdgcn_cvt_pk_fp8_f32(b[2], b[3], w1, true);
    u32x2 r; r.x = (unsigned)w0; r.y = (unsigned)w1; return r; }
struct EpiNull {
    static constexpr bool PERM = true, AFTER_DRAIN = false, MIDK = false;
    __device__ __forceinline__ void operator()(const f32x4 (&acc)[2][2][4][2], const Unit&, int, int, int, int) const {
#pragma unroll
        for (int a = 0; a < 2; ++a)
#pragma unroll
            for (int b = 0; b < 2; ++b)
#pragma unroll
                for (int m = 0; m < 4; ++m) { asm volatile("" :: "v"(acc[a][b][m][0]), "v"(acc[a][b][m][1])); } }
};
struct EpiIn {
    static constexpr bool PERM = true, AFTER_DRAIN = false, MIDK = false;
    bf16 *GQ, *GK, *GV, *SG; float *LGF, *LGB; bf16 *DQ, *DK, *DV, *SGA, *SGB; const float* b_up; const float* qg; const float* kg;
    __device__ __forceinline__ void operator()(const f32x4 (&acc)[2][2][4][2], const Unit& u, int wr, int wc, int fr, int fq) const {
        const int pn = u.pn; const int row0 = u.pm * 256 + wr * 64 + fr;
        if (pn >= 8 && pn <= 11) {
            const bool isk = pn >= 10; const int head = 2 * ((pn - 8) & 1) + (wc >> 1), c = wc & 1;
            const float* gv = isk ? kg : qg; const float sc = isk ? 1.f : QSCALE;
            f32x4 g[2][2];
#pragma unroll
            for (int bj = 0; bj < 2; ++bj)
#pragma unroll
                for (int n = 0; n < 2; ++n) g[bj][n] = *(const f32x4*)(gv + 32 * bj + 8 * fq + 4 * n);
#pragma unroll
            for (int ai = 0; ai < 2; ++ai)
#pragma unroll
                for (int m = 0; m < 4; ++m) {
                    const int r = row0 + ai * 128 + m * 16, b = r / SEQ, s = r % SEQ;
                    float ss = 0.f;
#pragma unroll
                    for (int bj = 0; bj < 2; ++bj)
#pragma unroll
                        for (int n = 0; n < 2; ++n) { const f32x4 x = acc[ai][bj][m][n]; ss += (x[0] * x[0] + x[1] * x[1]) + (x[2] * x[2] + x[3] * x[3]); }
                    ss += __shfl_xor(ss, 16); ss += __shfl_xor(ss, 32);
                    const float rs = rsqrtf(ss * (1.f / 64.f) + RMS_EPS) * sc;
#if MK_ATT_FP8
                    unsigned char* dst8 = (unsigned char*)(isk ? DK : DQ) + ((((size_t)b * NH + head) * 2 + c) * SEQ + s) * 64;
#pragma unroll
                    for (int bj = 0; bj < 2; ++bj) {
                        const f32x4 v0 = acc[ai][bj][m][0] * rs * g[bj][0], v1 = acc[ai][bj][m][1] * rs * g[bj][1];
                        int chunk = 2 * bj + (fq >> 1); if (isk) chunk ^= ((s >> 2) & 3);
                        *(u32x2*)(dst8 + chunk * 16 + 8 * (fq & 1)) = pack8_fp8(v0, v1);
                    }
#else
                    bf16* dst = (isk ? DK : DQ) + ((((size_t)b * NH + head) * 2 + c) * SEQ + s) * 64;
#pragma unroll
                    for (int bj = 0; bj < 2; ++bj) {
                        const f32x4 v0 = acc[ai][bj][m][0] * rs * g[bj][0], v1 = acc[ai][bj][m][1] * rs * g[bj][1];
                        int chunk = 4 * bj + fq; if (isk) chunk ^= ((s >> 1) & 7);
                        *(u32x4*)(dst + chunk * 8) = pack8(v0, v1);
                    }
#endif
                }
            return;
        }
#pragma unroll
        for (int ai = 0; ai < 2; ++ai)
#pragma unroll
            for (int m = 0; m < 4; ++m) {
                const int r = row0 + ai * 128 + m * 16;
#pragma unroll
                for (int bj = 0; bj < 2; ++bj) {
                    const int c0 = 128 * bj + 32 * wc + 8 * fq;
                    f32x4 v0 = acc[ai][bj][m][0], v1 = acc[ai][bj][m][1];
                    if (pn == 0) { *(u32x4*)(GQ + (size_t)r * 256 + c0) = pack8(v0 * 0.125f, v1 * 0.125f); }
                    else if (pn == 1) { *(u32x4*)(GK + (size_t)r * 256 + c0) = pack8(v0, v1); }
                    else if (pn <= 3) { *(u32x4*)(GV + (size_t)r * 512 + (pn - 2) * 256 + c0) = pack8(v0, v1); }
                    else if (pn <= 5) {
#pragma unroll
                        for (int i = 0; i < 4; ++i) { v0[i] = fsilu(v0[i]); v1[i] = fsilu(v1[i]); }
                        *(u32x4*)(SG + (size_t)r * 512 + (pn - 4) * 256 + c0) = pack8(v0, v1); }
                    else if (pn <= 7) {
                        const float* bu = b_up + (pn - 6) * 256 + c0; const f32x4 b0 = *(const f32x4*)bu, b1 = *(const f32x4*)(bu + 4);
#pragma unroll
                        for (int i = 0; i < 4; ++i) { float z = v0[i] + b0[i]; v0[i] = (fminf(z, 0.f) - __logf(1.f + __expf(-fabsf(z)))) * (1.f / 16.f);
                                                      z = v1[i] + b1[i]; v1[i] = (fminf(z, 0.f) - __logf(1.f + __expf(-fabsf(z)))) * (1.f / 16.f); }
                        float* o = (pn == 6 ? LGF : LGB) + (size_t)r * 256 + c0; *(f32x4*)o = v0; *(f32x4*)(o + 4) = v1; }
#if MK_ATT_FP8
                    else if (pn <= 13) {
                        const int b = r / SEQ, s = r % SEQ, head = 2 * (pn - 12) + bj;
                        const int kk = s & 63, wkey = kk & 31, hh_ = (wkey >> 2) & 1, reg_ = (wkey & 3) + 4 * (wkey >> 3), pos = hh_ * 32 + 16 * (kk >> 5) + reg_;
                        unsigned char* tb = (unsigned char*)DV + (((size_t)b * NH + head) * (SEQ / 64) + (s >> 6)) * 8192;
                        const u32x2 pk = pack8_fp8(v0, v1); const int dv0 = 32 * wc + 8 * fq;
#pragma unroll
                        for (int i = 0; i < 8; ++i) { const int dv = dv0 + i; const unsigned byte = ((i < 4 ? pk.x : pk.y) >> (8 * (i & 3))) & 0xffu;
                            tb[dv * 64 + ((((pos >> 4) ^ ((dv >> 2) & 3)) << 4) | (pos & 15))] = (unsigned char)byte; } }
#else
                    else if (pn <= 13) {
                        const int b = r / SEQ, s = r % SEQ, head = 2 * (pn - 12) + bj;
                        bf16* dst = DV + ((((size_t)b * NH + head) * (SEQ / 8) + (s >> 3)) * 4 + wc) * 256 + (s & 7) * 32 + 8 * fq;
                        *(u32x4*)dst = pack8(v0, v1); }
#endif
                    else {
#pragma unroll
                        for (int i = 0; i < 4; ++i) { v0[i] = fsigmoid(v0[i]); v1[i] = fsigmoid(v1[i]); }
                        bf16* base = (pn <= 17) ? SGA + (pn - 14) * 256 : SGB + (pn - 18) * 256;
                        *(u32x4*)(base + (size_t)r * D + c0) = pack8(v0, v1); }
                }
            }
    }
};

struct EpiMerge {
    static constexpr bool PERM = true, AFTER_DRAIN = false, MIDK = false;
    const bf16* SGA; const bf16* SGB; bf16* O; int nM;
    __device__ __forceinline__ void operator()(const f32x4 (&acc)[2][2][4][2], const Unit& u, int wr, int wc, int fr, int fq) const {
        const int sel = u.pn >> 2; const int row0 = (u.pm - sel * nM) * 256 + wr * 64 + fr, col0 = (u.pn & 3) * 256 + wc * 32 + 8 * fq;
        const bf16* G = sel ? SGB : SGA;
#pragma unroll
        for (int ai = 0; ai < 2; ++ai)
#pragma unroll
            for (int m = 0; m < 4; ++m) { const size_t off = (size_t)(row0 + ai * 128 + m * 16) * D + col0;
#pragma unroll
                for (int bj = 0; bj < 2; ++bj) { const u32x4 b = *(const u32x4*)(G + off + bj * 128);
                    f32x4 v0 = acc[ai][bj][m][0], v1 = acc[ai][bj][m][1];
                    v0[0] *= bflo(b.x); v0[1] *= bfhi(b.x); v0[2] *= bflo(b.y); v0[3] *= bfhi(b.y); v1[0] *= bflo(b.z); v1[1] *= bfhi(b.z); v1[2] *= bflo(b.w); v1[3] *= bfhi(b.w);
                    if (sel) { const u32x4 t = *(const u32x4*)(O + off + bj * 128);
                        v0[0] += bflo(t.x); v0[1] += bfhi(t.x); v0[2] += bflo(t.y); v0[3] += bfhi(t.y); v1[0] += bflo(t.z); v1[1] += bfhi(t.z); v1[2] += bflo(t.w); v1[3] += bfhi(t.w); }
                    *(u32x4*)(O + off + bj * 128) = pack8(v0, v1); }
                asm volatile("" ::: "memory"); }
    }
};
struct MergeOrder {
    pg8::StaticOrder so; int nM;
    __device__ __forceinline__ bool next(int i, Unit& u) const { Unit t; if (!so.next(i >> 1, t)) return false; const int sel = i & 1; u.pm = t.pm + sel * nM; u.pn = t.pn + sel * 4; return true; }
    __device__ __forceinline__ void a_ready(const Unit&) const {}
    __device__ __forceinline__ void done(const Unit&) const {}
};

struct EpiResid {
    static constexpr bool PERM = false, AFTER_DRAIN = false, MIDK = false;
    const float* xin; float* xout; const float* g1;
    __device__ __forceinline__ void operator()(const f32x4 (&acc)[2][2][4][2], const Unit& u, int wr, int wc, int fr, int fq) const {
        const int row0 = u.pm * 256 + wr * 64 + fr, col0 = u.pn * 256 + wc * 32 + 4 * fq;
        const int b = (u.pm * 256) / SEQ; const float* g = g1 + (size_t)b * 6 * D + col0;
        f32x4 gv[2][2];
#pragma unroll
        for (int bj = 0; bj < 2; ++bj)
#pragma unroll
            for (int n = 0; n < 2; ++n) gv[bj][n] = *(const f32x4*)(g + bj * 128 + n * 16);
#pragma unroll
        for (int ai = 0; ai < 2; ++ai)
#pragma unroll
            for (int m = 0; m < 4; ++m) { const size_t off = (size_t)(row0 + ai * 128 + m * 16) * D + col0;
#pragma unroll
                for (int bj = 0; bj < 2; ++bj)
#pragma unroll
                    for (int n = 0; n < 2; ++n) { const f32x4 xv = *(const f32x4*)(xin + off + bj * 128 + n * 16); *(f32x4*)(xout + off + bj * 128 + n * 16) = xv + gv[bj][n] * acc[ai][bj][m][n]; } }
    }
};

struct EpiLogits {
    static constexpr bool PERM = false, AFTER_DRAIN = false, MIDK = false;
    float* L;
    __device__ __forceinline__ void operator()(const f32x4 (&acc)[2][2][4][2], const Unit& u, int wr, int wc, int fr, int fq) const {
        if (wc >= 2) return;
        const int row0 = u.pm * 256 + wr * 64 + fr, col0 = wc * 32 + 4 * fq;
#pragma unroll
        for (int ai = 0; ai < 2; ++ai)
#pragma unroll
            for (int m = 0; m < 4; ++m)
#pragma unroll
                for (int n = 0; n < 2; ++n) *(f32x4*)(L + (size_t)(row0 + ai * 128 + m * 16) * 64 + col0 + n * 16) = acc[ai][0][m][n];
    }
};

#ifndef MK_MOE_FP8
#define MK_MOE_FP8 0
#endif
#if MK_MOE_FP8
struct EpiAct {
    static constexpr bool PERM = true, AFTER_DRAIN = false, MIDK = false;
    unsigned char* ACT;
    __device__ __forceinline__ void operator()(const f32x4 (&acc)[2][2][4][2], const Unit& u, int wr, int wc, int fr, int fq) const {
        const int row0 = u.pm * 256 + wr * 64 + fr, col0 = (u.pn & 3) * 128 + wc * 32 + 8 * fq;
        constexpr float inv = 1.f / WSCALE;
#pragma unroll
        for (int ai = 0; ai < 2; ++ai)
#pragma unroll
            for (int m = 0; m < 4; ++m) { f32x4 v0, v1;
#pragma unroll
                for (int i = 0; i < 4; ++i) { v0[i] = fsilu(acc[ai][0][m][0][i] * inv) * acc[ai][1][m][0][i] * (inv * ASCALE); v1[i] = fsilu(acc[ai][0][m][1][i] * inv) * acc[ai][1][m][1][i] * (inv * ASCALE); }
                *(u32x2*)(ACT + (size_t)(row0 + ai * 128 + m * 16) * DE + col0) = pack8_fp8(v0, v1); }
    }
};
struct EpiYs {
    static constexpr bool PERM = true, AFTER_DRAIN = false, MIDK = false;
    bf16* YS; const float* gs;
    __device__ __forceinline__ void operator()(const f32x4 (&acc)[2][2][4][2], const Unit& u, int wr, int wc, int fr, int fq) const {
        const int row0 = u.pm * 256 + wr * 64 + fr, col0 = (u.pn & 3) * 256 + wc * 32 + 8 * fq;
#pragma unroll
        for (int ai = 0; ai < 2; ++ai)
#pragma unroll
            for (int m = 0; m < 4; ++m) { const int r = row0 + ai * 128 + m * 16; const float gt = gs[r] * (1.f / (WSCALE * ASCALE));
#pragma unroll
                for (int bj = 0; bj < 2; ++bj) *(u32x4*)(YS + (size_t)r * D + col0 + bj * 128) = pack8(acc[ai][bj][m][0] * gt, acc[ai][bj][m][1] * gt); }
    }
};
#else
struct EpiAct {
    static constexpr bool PERM = true, AFTER_DRAIN = false, MIDK = false;
    bf16* ACT;
    __device__ __forceinline__ void operator()(const f32x4 (&acc)[2][2][4][2], const Unit& u, int wr, int wc, int fr, int fq) const {
        const int row0 = u.pm * 256 + wr * 64 + fr, col0 = (u.pn & 3) * 128 + wc * 32 + 8 * fq;
#pragma unroll
        for (int ai = 0; ai < 2; ++ai)
#pragma unroll
            for (int m = 0; m < 4; ++m) { f32x4 v0, v1;
#pragma unroll
                for (int i = 0; i < 4; ++i) { v0[i] = fsilu(acc[ai][0][m][0][i]) * acc[ai][1][m][0][i]; v1[i] = fsilu(acc[ai][0][m][1][i]) * acc[ai][1][m][1][i]; }
                *(u32x4*)(ACT + (size_t)(row0 + ai * 128 + m * 16) * DE + col0) = pack8(v0, v1); }
    }
};
struct EpiYs {
    static constexpr bool PERM = true, AFTER_DRAIN = false, MIDK = false;
    bf16* YS; const float* gs;
    __device__ __forceinline__ void operator()(const f32x4 (&acc)[2][2][4][2], const Unit& u, int wr, int wc, int fr, int fq) const {
        const int row0 = u.pm * 256 + wr * 64 + fr, col0 = (u.pn & 3) * 256 + wc * 32 + 8 * fq;
#pragma unroll
        for (int ai = 0; ai < 2; ++ai)
#pragma unroll
            for (int m = 0; m < 4; ++m) { const int r = row0 + ai * 128 + m * 16; const float gt = gs[r];
#pragma unroll
                for (int bj = 0; bj < 2; ++bj) *(u32x4*)(YS + (size_t)r * D + col0 + bj * 128) = pack8(acc[ai][bj][m][0] * gt, acc[ai][bj][m][1] * gt); }
    }
};
#endif
struct GroupedOrder {
    const int* tilee; int U, G, c; const int* rowidx;
    __device__ __forceinline__ bool next(int i, Unit& u) const {
        int id;
        if ((G & 7) == 0) { const int gx = G >> 3, per = (U + 7) >> 3, n = i * gx + (c >> 3); if (n >= per) return false; id = (c & 7) * per + n; if (id >= U) return false; }
        else { id = i * G + c; if (id >= U) return false; }
        const int t = id >> 2; u.pm = t; u.pn = tilee[t] * 4 + (id & 3); return true;
    }
    __device__ __forceinline__ void a_ready(const Unit&) const {}
    __device__ __forceinline__ void done(const Unit&) const {}
};
constexpr int AT_KR = 0, AT_VR = 32768, AT_TAB = 65536, AT_SLOT = 8192;
typedef int v8i __attribute__((ext_vector_type(8)));
typedef int v4i __attribute__((ext_vector_type(4)));
__device__ __forceinline__ int crow(int r, int hi) { return (r & 3) + 8 * (r >> 2) + 4 * hi; }

__device__ __forceinline__ void attn_bias(f32x16& s0, f32x16& s1, int relbase, const LAS float* tabh) {
#pragma unroll
    for (int r = 0; r < 16; ++r) {
        int i0 = relbase + (r & 3) + 8 * (r >> 2); int i1 = i0 + 32;
        i0 = i0 < 0 ? 0 : (i0 > 255 ? 255 : i0); i1 = i1 < 0 ? 0 : (i1 > 255 ? 255 : i1);
        s0[r] += tabh[i0]; s1[r] += tabh[i1];
    }
}
template <int J>
__device__ __forceinline__ void attn_exp_chunk(f32x16& s0, f32x16& s1, float& lsum) {
    float ls = 0.f;
#pragma unroll
    for (int r = 4 * J; r < 4 * J + 4; ++r) { s0[r] = __builtin_amdgcn_exp2f(s0[r]); s1[r] = __builtin_amdgcn_exp2f(s1[r]); }
    (void)ls; (void)lsum;
}
__device__ __forceinline__ int pk4_bf8(float a, float b, float c, float d) { int w = 0; w = __builtin_amdgcn_cvt_pk_bf8_f32(a, b, w, false); w = __builtin_amdgcn_cvt_pk_bf8_f32(c, d, w, true); return w; }
__device__ __forceinline__ void glds16(const void* gsrc, unsigned lds_dst) { unsigned keep;
    asm volatile("s_mov_b32 %0, m0\n\ts_mov_b32 m0, %2\n\ts_nop 0\n\tglobal_load_lds_dwordx4 %1, off\n\ts_mov_b32 m0, %0" : "=&s"(keep) : "v"(gsrc), "s"(lds_dst) : "memory"); }
__device__ __forceinline__ void attn_dma_k(unsigned lds0, const unsigned char* kg0, int t, int slot, int wid, int lane) {
    glds16(kg0 + (size_t)(wid >> 2) * SEQ * 64 + (size_t)t * 4096 + (wid & 3) * 1024 + lane * 16, (unsigned)__builtin_amdgcn_readfirstlane((int)(lds0 + AT_KR + slot * AT_SLOT + wid * 1024)));
}
__device__ __forceinline__ void attn_dma_v(unsigned lds0, const unsigned char* vg0, int t, int slot, int wid, int lane) {
    glds16(vg0 + (size_t)t * 8192 + wid * 1024 + lane * 16, (unsigned)__builtin_amdgcn_readfirstlane((int)(lds0 + AT_VR + slot * AT_SLOT + wid * 1024)));
}
#define AT_RD128(dst, addr, off) asm volatile("ds_read_b128 %0, %1 offset:%c2" : "=&v"(dst) : "v"(addr), "i"(off) : "memory")
#define AT_MFMA8(a, b, c) __builtin_amdgcn_mfma_scale_f32_32x32x64_f8f6f4(a, b, c, 0, 0, 0, 0, 0, 0)
#define AT_MFMA8B(a, b, c) __builtin_amdgcn_mfma_scale_f32_32x32x64_f8f6f4(a, b, c, 0, 1, 0, 0, 0, 0)

template <int VAR>
__device__ __forceinline__ void phase_attn(Frame& F, int l) {
    refresh(F);
    const WS W = ws_map(F.ws, F.nb); const float* const* IN_ = F.a->in; (void)IN_; (void)W;
    const int lane = F.lane, wid = F.wave, r32 = lane & 31, hh = lane >> 5, qg = wid & 3, c = wid >> 2;
    LAS unsigned char* lds = F.lds; const unsigned lds0 = (unsigned)(unsigned long)lds;
    LAS float* tab = (LAS float*)(lds + AT_TAB);
    for (int i = F.tid; i < 1028; i += NTHR) tab[i] = W.tab[i];
    const float lam = W.tab[1032 + l]; const float lam_init = 0.8f - 0.6f * __expf(-0.3f * (float)l);
    const float* subg = IN_[13] + l * 128;
    const int U = F.nb * NH * 64;
    const int gx = F.G >> 3, per = U >> 3;
    const int sw = (r32 >> 2) & 3;
    const unsigned ka0 = lds0 + AT_KR + c * 4096 + r32 * 64 + (((2 * hh) ^ sw) << 4), ka1 = lds0 + AT_KR + c * 4096 + r32 * 64 + (((2 * hh + 1) ^ sw) << 4);
    const unsigned va0 = lds0 + AT_VR + r32 * 64 + (((2 * hh) ^ sw) << 4), va1 = lds0 + AT_VR + r32 * 64 + (((2 * hh + 1) ^ sw) << 4);
    const bool lag = wid >= 4;
    __syncthreads();
    for (int i = 0;; ++i) {
        int id;
        if ((F.G & 7) == 0) { const int n = i * gx + (F.bid >> 3); if (n >= per) break; id = (F.bid & 7) * per + n; }
        else { id = i * F.G + F.bid; if (id >= U) break; }
        const int bh = id >> 6, qb = id & 63, b = bh >> 2, h = bh & 3;
        const int qw0 = qb * 128 + 32 * qg;
        const unsigned char* kg0 = (const unsigned char*)W.DK + ((size_t)bh * 2) * SEQ * 64;
        const unsigned char* vg0 = (const unsigned char*)W.DV + (size_t)bh * SEQ * 128;
        v8i qf; { const unsigned char* qp = (const unsigned char*)W.DQ + (((size_t)bh * 2 + c) * SEQ + qw0 + r32) * 64 + 32 * hh;
            const v4i q0 = *(const v4i*)qp, q1 = *(const v4i*)(qp + 16); qf = (v8i){q0[0], q0[1], q0[2], q0[3], q1[0], q1[1], q1[2], q1[3]}; }
        asm volatile("s_waitcnt vmcnt(0)" ::: "memory");
        attn_dma_k(lds0, kg0, 0, 0, wid, lane); attn_dma_k(lds0, kg0, 1, 1, wid, lane); attn_dma_v(lds0, vg0, 0, 0, wid, lane); attn_dma_k(lds0, kg0, 2, 2, wid, lane);
        attn_dma_v(lds0, vg0, 1, 1, wid, lane); attn_dma_k(lds0, kg0, 3, 3, wid, lane); attn_dma_v(lds0, vg0, 2, 2, wid, lane);
        f32x16 o[4]; f32x16 osum = f32x16{};
#pragma unroll
        for (int dt = 0; dt < 4; ++dt) o[dt] = f32x16{};
        float lsum = 0.f;
        const v8i ones8 = {0x38383838, 0x38383838, 0x38383838, 0x38383838, 0x38383838, 0x38383838, 0x38383838, 0x38383838};
        const int tL = (qw0 >= 154) ? ((qw0 - 154) >> 6) + 1 : 0, tR = (qw0 + 185) >> 6;
        const float shl = tab[1024 + h];
        const LAS float* tabh = tab + h * 256;
        const int rel0 = -qw0 - r32 + 4 * hh + 128;
        const f32x16 cshift = {-2.f, -2.f, -2.f, -2.f, -2.f, -2.f, -2.f, -2.f, -2.f, -2.f, -2.f, -2.f, -2.f, -2.f, -2.f, -2.f};
        asm volatile("s_waitcnt vmcnt(4)" ::: "memory"); __builtin_amdgcn_s_barrier(); asm volatile("" ::: "memory");
        f32x16 sc0, sc1, sn0, sn1; v8i p; v4i kx[4];
        AT_RD128(kx[0], ka0, 0); AT_RD128(kx[1], ka1, 0); AT_RD128(kx[2], ka0, 2048); AT_RD128(kx[3], ka1, 2048);
        asm volatile("s_waitcnt lgkmcnt(0)" ::: "memory"); __builtin_amdgcn_sched_barrier(0);
        sc0 = AT_MFMA8(((v8i){kx[0][0], kx[0][1], kx[0][2], kx[0][3], kx[1][0], kx[1][1], kx[1][2], kx[1][3]}), qf, cshift);
        sc1 = AT_MFMA8(((v8i){kx[2][0], kx[2][1], kx[2][2], kx[2][3], kx[3][0], kx[3][1], kx[3][2], kx[3][3]}), qf, cshift);
        __builtin_amdgcn_s_barrier(); asm volatile("" ::: "memory");
        if (lag) { __builtin_amdgcn_s_barrier(); asm volatile("" ::: "memory"); }
#define AT_STEP(SL, t) do { \
            { const int tk = (t) + 4 < 128 ? (t) + 4 : 127; attn_dma_k(lds0, kg0, tk, SL, wid, lane); } \
            asm volatile("s_waitcnt vmcnt(4)" ::: "memory");                                                       \
            AT_RD128(kx[0], ka0, ((SL + 1) & 3) * AT_SLOT); AT_RD128(kx[1], ka1, ((SL + 1) & 3) * AT_SLOT);        \
            AT_RD128(kx[2], ka0, ((SL + 1) & 3) * AT_SLOT + 2048); AT_RD128(kx[3], ka1, ((SL + 1) & 3) * AT_SLOT + 2048); \
            if ((t) >= tL && (t) < tR) attn_bias(sc0, sc1, 64 * (t) + rel0, tabh);                                \
            attn_exp_chunk<0>(sc0, sc1, lsum); attn_exp_chunk<1>(sc0, sc1, lsum);                                 \
            asm volatile("s_waitcnt lgkmcnt(0)" ::: "memory"); __builtin_amdgcn_sched_barrier(0); \
            sn0 = AT_MFMA8(((v8i){kx[0][0], kx[0][1], kx[0][2], kx[0][3], kx[1][0], kx[1][1], kx[1][2], kx[1][3]}), qf, cshift); \
            __builtin_amdgcn_sched_barrier(0); \
            attn_exp_chunk<2>(sc0, sc1, lsum); \
            __builtin_amdgcn_sched_barrier(0); \
            sn1 = AT_MFMA8(((v8i){kx[2][0], kx[2][1], kx[2][2], kx[2][3], kx[3][0], kx[3][1], kx[3][2], kx[3][3]}), qf, cshift); \
            __builtin_amdgcn_sched_barrier(0); \
            attn_exp_chunk<3>(sc0, sc1, lsum); \
            p[0] = pk4_bf8(sc0[0], sc0[1], sc0[2], sc0[3]); p[1] = pk4_bf8(sc0[4], sc0[5], sc0[6], sc0[7]); p[2] = pk4_bf8(sc0[8], sc0[9], sc0[10], sc0[11]); p[3] = pk4_bf8(sc0[12], sc0[13], sc0[14], sc0[15]); \
            p[4] = pk4_bf8(sc1[0], sc1[1], sc1[2], sc1[3]); p[5] = pk4_bf8(sc1[4], sc1[5], sc1[6], sc1[7]); p[6] = pk4_bf8(sc1[8], sc1[9], sc1[10], sc1[11]); p[7] = pk4_bf8(sc1[12], sc1[13], sc1[14], sc1[15]); \
            __builtin_amdgcn_s_barrier(); asm volatile("" ::: "memory"); \
            { const int tv = (t) + 3 < 128 ? (t) + 3 : 127; attn_dma_v(lds0, vg0, tv, (SL + 3) & 3, wid, lane); } \
            asm volatile("s_waitcnt vmcnt(4)" ::: "memory");                                                       \
            { v4i vx[8]; \
              AT_RD128(vx[0], va0, SL * AT_SLOT); AT_RD128(vx[1], va1, SL * AT_SLOT); AT_RD128(vx[2], va0, SL * AT_SLOT + 2048); AT_RD128(vx[3], va1, SL * AT_SLOT + 2048); \
              AT_RD128(vx[4], va0, SL * AT_SLOT + 4096); AT_RD128(vx[5], va1, SL * AT_SLOT + 4096); AT_RD128(vx[6], va0, SL * AT_SLOT + 6144); AT_RD128(vx[7], va1, SL * AT_SLOT + 6144); \
              if ((t) == tL) { _Pragma("unroll") for (int dt = 0; dt < 4; ++dt) o[dt] *= shl; osum *= shl; } \
              osum = AT_MFMA8B(ones8, p, osum); \
              asm volatile("s_waitcnt lgkmcnt(4)" ::: "memory"); __builtin_amdgcn_sched_barrier(0); \
              o[0] = AT_MFMA8B(((v8i){vx[0][0], vx[0][1], vx[0][2], vx[0][3], vx[1][0], vx[1][1], vx[1][2], vx[1][3]}), p, o[0]); \
              o[1] = AT_MFMA8B(((v8i){vx[2][0], vx[2][1], vx[2][2], vx[2][3], vx[3][0], vx[3][1], vx[3][2], vx[3][3]}), p, o[1]); \
              asm volatile("s_waitcnt lgkmcnt(0)" ::: "memory"); __builtin_amdgcn_sched_barrier(0); \
              o[2] = AT_MFMA8B(((v8i){vx[4][0], vx[4][1], vx[4][2], vx[4][3], vx[5][0], vx[5][1], vx[5][2], vx[5][3]}), p, o[2]); \
              o[3] = AT_MFMA8B(((v8i){vx[6][0], vx[6][1], vx[6][2], vx[6][3], vx[7][0], vx[7][1], vx[7][2], vx[7][3]}), p, o[3]); } \
            sc0 = sn0; sc1 = sn1; \
            __builtin_amdgcn_s_barrier(); asm volatile("" ::: "memory"); } while (0)
        for (int t0 = 0; t0 < 128; t0 += 4) { AT_STEP(0, t0); AT_STEP(1, t0 + 1); AT_STEP(2, t0 + 2); AT_STEP(3, t0 + 3); }
#undef AT_STEP
        if (!lag) { __builtin_amdgcn_s_barrier(); asm volatile("" ::: "memory"); }
        asm volatile("s_waitcnt vmcnt(0)" ::: "memory"); __builtin_amdgcn_s_barrier(); asm volatile("" ::: "memory");
        const float lt = osum[0];
        LAS float* xch = (LAS float*)(lds + qg * 16384);
        if (c == 1) { const float f = lam / lt;
#pragma unroll
            for (int dt = 0; dt < 4; ++dt)
#pragma unroll
                for (int r = 0; r < 16; ++r) xch[(dt * 16 + r) * 64 + lane] = o[dt][r] * f; }
        LDS_WAIT(); __builtin_amdgcn_s_barrier(); asm volatile("" ::: "memory");
        if (c == 0) { const float f = 1.f / lt; float ss = 0.f;
#pragma unroll
            for (int dt = 0; dt < 4; ++dt)
#pragma unroll
                for (int r = 0; r < 16; ++r) { const float v = o[dt][r] * f - xch[(dt * 16 + r) * 64 + lane]; o[dt][r] = v; ss += v * v; }
            ss += __shfl_xor(ss, 32);
            const float rn = rsqrtf(ss * (1.f / 128.f) + RMS_EPS) * (1.f - lam_init);
            bf16* orow = W.OAB + (size_t)F.T * 512 + ((size_t)b * SEQ + qw0 + r32) * 512 + h * 128;
#pragma unroll
            for (int dt = 0; dt < 4; ++dt)
#pragma unroll
                for (int g = 0; g < 4; ++g) { const int dv = 32 * dt + 8 * g + 4 * hh; const f32x4 sg = *(const f32x4*)(subg + dv);
                    u32x2 ov; ov.x = cvt_pk(o[dt][4 * g] * rn * sg[0], o[dt][4 * g + 1] * rn * sg[1]); ov.y = cvt_pk(o[dt][4 * g + 2] * rn * sg[2], o[dt][4 * g + 3] * rn * sg[3]);
                    *(u32x2*)(orow + dv) = ov; }
        }
        LDS_WAIT(); __builtin_amdgcn_s_barrier(); asm volatile("" ::: "memory");
    }
}
constexpr int GL_CUM = 0;
constexpr int GL_S64 = 144, GL_S192 = 400;
constexpr int G1_KEF = 34816, G1_KEB = G1_KEF + 64 * GL_S64, G1_VT = G1_KEB + 64 * GL_S64;
constexpr int G3_AOP = 34816, G3_KIF = G3_AOP + 64 * GL_S192, G3_KIB = G3_KIF + 64 * GL_S64, G3_BOP = G3_KIB + 64 * GL_S64;
static_assert(G3_BOP + 128 * GL_S192 <= 150 * 1024, "GLA LDS");

__device__ __forceinline__ bf16x8 lds_frag(const LAS unsigned char* base, int row, int stride, int kbyte) { return *(const LAS bf16x8*)(base + row * stride + kbyte); }

__device__ __forceinline__ void gla_cum(Frame& F, size_t trow0, int h) {
    const WS W = ws_map(F.ws, F.nb); const float* const* IN_ = F.a->in; (void)IN_; (void)W;
    LAS float* cum = (LAS float*)(F.lds + GL_CUM);
#pragma unroll
    for (int it = 0; it < 4; ++it) { const int idx = F.tid + it * NTHR; const int dir = idx >> 10, t = (idx >> 4) & 63, d4 = (idx & 15) * 4;
        const f32x4 v = *(const f32x4*)((dir ? W.LGB : W.LGF) + (trow0 + t) * 256 + h * 64 + d4);
        *(LAS f32x4*)(cum + (dir * 64 + t) * 64 + d4) = v; }
    __syncthreads();
    {
        const int dir = F.tid >> 8, seg = (F.tid >> 6) & 3, d = F.tid & 63; LAS float* cc = cum + dir * 4096 + d; LAS float* tot = cum + 8192 + (dir * 4 + seg) * 64 + d;
        float v[16]; float run = 0.f;
        if (dir == 0) {
#pragma unroll
            for (int i = 0; i < 16; ++i) { run += cc[(16 * seg + i) * 64]; v[i] = run; }
        } else {
#pragma unroll
            for (int i = 15; i >= 0; --i) { run += cc[(16 * seg + i) * 64]; v[i] = run; }
        }
        *tot = run;
        __syncthreads();
        float off = 0.f; const LAS float* tb = cum + 8192 + dir * 256 + d;
        if (dir == 0) { if (seg > 0) off += tb[0]; if (seg > 1) off += tb[64]; if (seg > 2) off += tb[128]; }
        else { if (seg < 3) off += tb[192]; if (seg < 2) off += tb[128]; if (seg < 1) off += tb[64]; }
#pragma unroll
        for (int i = 0; i < 16; ++i) cc[(16 * seg + i) * 64] = v[i] + off;
    }
    __syncthreads();
}

__device__ __forceinline__ void phase_gla1(Frame& F) {
    refresh(F);
    const WS W = ws_map(F.ws, F.nb); const float* const* IN_ = F.a->in; (void)IN_; (void)W;
    LAS unsigned char* lds = F.lds; LAS float* cum = (LAS float*)(lds + GL_CUM);
    const int lane = F.lane, wid = F.wave, r32 = lane & 31, hh = lane >> 5;
    const int U = F.nb * NH * 128;
    for (int u = F.bid; u < U; u += F.G) {
        const int n = u & 127, bh = u >> 7, b = bh >> 2, h = bh & 3; const size_t trow0 = (size_t)b * SEQ + n * 64;
        gla_cum(F, trow0, h);
        {
            const int t = F.tid >> 3, d0 = (F.tid & 7) * 8;
            const u32x4 kv = *(const u32x4*)(W.GK + (trow0 + t) * 256 + h * 64 + d0);
            const unsigned kw[4] = {kv.x, kv.y, kv.z, kv.w};
#pragma unroll
            for (int j = 0; j < 8; ++j) { const int d = d0 + j; const float k = (j & 1) ? bfhi(kw[j >> 1]) : bflo(kw[j >> 1]);
                const float ef = __expf(cum[63 * 64 + d] - cum[t * 64 + d]), eb = __expf(cum[4096 + d] - cum[4096 + t * 64 + d]);
                *(LAS bf16*)(lds + G1_KEF + d * GL_S64 + t * 2) = (bf16)(cvt_pk(k * ef, 0.f) & 0xffffu);
                *(LAS bf16*)(lds + G1_KEB + d * GL_S64 + t * 2) = (bf16)(cvt_pk(k * eb, 0.f) & 0xffffu); }
            const int v0 = (F.tid & 7) * 16;
            const u32x4 va = *(const u32x4*)(W.GV + (trow0 + t) * 512 + h * 128 + v0), vb = *(const u32x4*)(W.GV + (trow0 + t) * 512 + h * 128 + v0 + 8);
            const unsigned vw[8] = {va.x, va.y, va.z, va.w, vb.x, vb.y, vb.z, vb.w};
#pragma unroll
            for (int j = 0; j < 16; ++j) *(LAS bf16*)(lds + G1_VT + (v0 + j) * GL_S64 + t * 2) = (bf16)((j & 1) ? (vw[j >> 1] >> 16) : (vw[j >> 1] & 0xffffu));
            if (F.tid < 128) { const int dir = F.tid >> 6, d = F.tid & 63; W.DEC[((size_t)u * 2 + dir) * 64 + d] = __expf(dir ? cum[4096 + d] : cum[63 * 64 + d]); }
        }
        __syncthreads();
        {
            const int dt = wid & 3, dd = wid >> 2;
            f32x16 cf = {}, cb = {};
#pragma unroll
            for (int s = 0; s < 4; ++s) { const int kb = (16 * s + 8 * hh) * 2;
                const bf16x8 a = lds_frag(lds + G1_VT, 32 * dt + r32, GL_S64, kb);
                cf = __builtin_amdgcn_mfma_f32_32x32x16_bf16(a, lds_frag(lds + G1_KEF, 32 * dd + r32, GL_S64, kb), cf, 0, 0, 0);
                cb = __builtin_amdgcn_mfma_f32_32x32x16_bf16(a, lds_frag(lds + G1_KEB, 32 * dd + r32, GL_S64, kb), cb, 0, 0, 0); }
            bf16* of = (bf16*)W.KVT + ((size_t)u * 2) * 8192; bf16* ob = of + 8192;
#pragma unroll
            for (int r = 0; r < 16; ++r) { const int dv = 32 * dt + crow(r, hh), d = 32 * dd + r32;
                const float pf = __shfl_xor(cf[r], 1), pb = __shfl_xor(cb[r], 1);
                if (!(lane & 1)) { *(unsigned*)(of + dv * 64 + d) = cvt_pk(cf[r], pf); *(unsigned*)(ob + dv * 64 + d) = cvt_pk(cb[r], pb); } }
        }
        __syncthreads();
    }
}

__device__ __forceinline__ void phase_gla2(Frame& F) {
    refresh(F);
    const WS W = ws_map(F.ws, F.nb); const float* const* IN_ = F.a->in; (void)IN_; (void)W;
    const size_t total = (size_t)F.nb * NH * 2 * 4096;
    for (size_t wk = (size_t)F.bid * NTHR + F.tid; wk < total; wk += (size_t)F.G * NTHR) {
        const int e2 = (int)(wk & 4095), dir = (int)((wk >> 12) & 1), bh = (int)(wk >> 13), d = (e2 * 2) & 63;
        unsigned* base = (unsigned*)((bf16*)W.KVT + ((size_t)bh * 128 * 2 + dir) * 8192) + e2; const float* dec = W.DEC + ((size_t)bh * 128 * 2 + dir) * 64 + d;
        float S0 = 0.f, S1 = 0.f;
        for (int n0 = 0; n0 < 128; n0 += 8) {
            unsigned kv[8]; float dc0[8], dc1[8];
#pragma unroll
            for (int j = 0; j < 8; ++j) { const int n = dir ? 127 - (n0 + j) : n0 + j; kv[j] = base[(size_t)n * 8192]; dc0[j] = dec[(size_t)n * 128]; dc1[j] = dec[(size_t)n * 128 + 1]; }
#pragma unroll
            for (int j = 0; j < 8; ++j) { const int n = dir ? 127 - (n0 + j) : n0 + j; base[(size_t)n * 8192] = cvt_pk(S0, S1); S0 = dc0[j] * S0 + bflo(kv[j]); S1 = dc1[j] * S1 + bfhi(kv[j]); }
        }
    }
}

__device__ __forceinline__ void phase_gla3(Frame& F, int l) {
    refresh(F);
    const WS W = ws_map(F.ws, F.nb); const float* const* IN_ = F.a->in; (void)IN_; (void)W;
    LAS unsigned char* lds = F.lds; LAS float* cum = (LAS float*)(lds + GL_CUM);
    const int lane = F.lane, wid = F.wave, r32 = lane & 31, hh = lane >> 5;
    const float* gng = IN_[9] + l * 128;
    const int U = F.nb * NH * 128;
    for (int u = F.bid; u < U; u += F.G) {
        const int n = u & 127, bh = u >> 7, b = bh >> 2, h = bh & 3; const size_t trow0 = (size_t)b * SEQ + n * 64;
        gla_cum(F, trow0, h);
        {
            const int t = F.tid >> 3, d0 = (F.tid & 7) * 8;
            const u32x4 qv = *(const u32x4*)(W.GQ + (trow0 + t) * 256 + h * 64 + d0), kv = *(const u32x4*)(W.GK + (trow0 + t) * 256 + h * 64 + d0);
            const unsigned qw[4] = {qv.x, qv.y, qv.z, qv.w}, kw[4] = {kv.x, kv.y, kv.z, kv.w};
            float qf[8], qb[8], kf[8], kb[8];
#pragma unroll
            for (int j = 0; j < 8; ++j) { const int d = d0 + j; const float q = (j & 1) ? bfhi(qw[j >> 1]) : bflo(qw[j >> 1]), k = (j & 1) ? bfhi(kw[j >> 1]) : bflo(kw[j >> 1]);
                const float cf = cum[t * 64 + d], cb = cum[4096 + t * 64 + d];
                qf[j] = q * __expf(cf); qb[j] = q * __expf(cb); kf[j] = k * __expf(-cf); kb[j] = k * __expf(-cb); }
            u32x4 o;
            o.x = cvt_pk(qf[0], qf[1]); o.y = cvt_pk(qf[2], qf[3]); o.z = cvt_pk(qf[4], qf[5]); o.w = cvt_pk(qf[6], qf[7]); *(LAS u32x4*)(lds + G3_AOP + t * GL_S192 + (64 + d0) * 2) = o;
            o.x = cvt_pk(qb[0], qb[1]); o.y = cvt_pk(qb[2], qb[3]); o.z = cvt_pk(qb[4], qb[5]); o.w = cvt_pk(qb[6], qb[7]); *(LAS u32x4*)(lds + G3_AOP + t * GL_S192 + (128 + d0) * 2) = o;
            o.x = cvt_pk(kf[0], kf[1]); o.y = cvt_pk(kf[2], kf[3]); o.z = cvt_pk(kf[4], kf[5]); o.w = cvt_pk(kf[6], kf[7]); *(LAS u32x4*)(lds + G3_KIF + t * GL_S64 + d0 * 2) = o;
            o.x = cvt_pk(kb[0], kb[1]); o.y = cvt_pk(kb[2], kb[3]); o.z = cvt_pk(kb[4], kb[5]); o.w = cvt_pk(kb[6], kb[7]); *(LAS u32x4*)(lds + G3_KIB + t * GL_S64 + d0 * 2) = o;
            const int v0 = (F.tid & 7) * 16;
            const u32x4 va = *(const u32x4*)(W.GV + (trow0 + t) * 512 + h * 128 + v0), vb = *(const u32x4*)(W.GV + (trow0 + t) * 512 + h * 128 + v0 + 8);
            const unsigned vw[8] = {va.x, va.y, va.z, va.w, vb.x, vb.y, vb.z, vb.w};
#pragma unroll
            for (int j = 0; j < 16; ++j) *(LAS bf16*)(lds + G3_BOP + (v0 + j) * GL_S192 + t * 2) = (bf16)((j & 1) ? (vw[j >> 1] >> 16) : (vw[j >> 1] & 0xffffu));
            const int dv = F.tid >> 2, dd0 = (F.tid & 3) * 16;
#pragma unroll
            for (int dir = 0; dir < 2; ++dir) { const bf16* sp = (const bf16*)W.KVT + ((size_t)u * 2 + dir) * 8192 + dv * 64 + dd0;
                const u32x4 o0 = *(const u32x4*)sp, o1 = *(const u32x4*)(sp + 8);
                *(LAS u32x4*)(lds + G3_BOP + dv * GL_S192 + (64 + 64 * dir + dd0) * 2) = o0; *(LAS u32x4*)(lds + G3_BOP + dv * GL_S192 + (64 + 64 * dir + dd0 + 8) * 2) = o1; }
        }
        __syncthreads();
        if (wid < 4) {
            const int it = wid >> 1, jt = wid & 1;
            f32x16 af = {}, ab = {};
#pragma unroll
            for (int s = 0; s < 4; ++s) { const int kb = (16 * s + 8 * hh) * 2;
                if (jt <= it) af = __builtin_amdgcn_mfma_f32_32x32x16_bf16(lds_frag(lds + G3_AOP, 32 * it + r32, GL_S192, 128 + kb), lds_frag(lds + G3_KIF, 32 * jt + r32, GL_S64, kb), af, 0, 0, 0);
                if (jt >= it) ab = __builtin_amdgcn_mfma_f32_32x32x16_bf16(lds_frag(lds + G3_AOP, 32 * it + r32, GL_S192, 256 + kb), lds_frag(lds + G3_KIB, 32 * jt + r32, GL_S64, kb), ab, 0, 0, 0); }
#pragma unroll
            for (int r = 0; r < 16; ++r) { const int i = 32 * it + crow(r, hh), j = 32 * jt + r32; const float v = (j <= i) ? af[r] : ab[r];
                *(LAS bf16*)(lds + G3_AOP + i * GL_S192 + j * 2) = (bf16)(cvt_pk(v, 0.f) & 0xffffu); }
        }
        __syncthreads();
        {
            const int it = wid >> 2, dt = wid & 3; f32x16 o = {};
#pragma unroll
            for (int s = 0; s < 12; ++s) { const int kb = (16 * s + 8 * hh) * 2;
                o = __builtin_amdgcn_mfma_f32_32x32x16_bf16(lds_frag(lds + G3_AOP, 32 * it + r32, GL_S192, kb), lds_frag(lds + G3_BOP, 32 * dt + r32, GL_S192, kb), o, 0, 0, 0); }
            LAS float* out = (LAS float*)(lds + GL_CUM);
#pragma unroll
            for (int r = 0; r < 16; ++r) out[(32 * it + crow(r, hh)) * 128 + 32 * dt + r32] = o[r];
        }
        __syncthreads();
        {
            const int t = F.tid >> 3, v0 = (F.tid & 7) * 16; const LAS float* orow = (const LAS float*)(lds + GL_CUM) + t * 128 + v0;
            float x[16]; float ss = 0.f;
#pragma unroll
            for (int j = 0; j < 16; ++j) { x[j] = orow[j]; ss += x[j] * x[j]; }
            ss += __shfl_xor(ss, 1); ss += __shfl_xor(ss, 2); ss += __shfl_xor(ss, 4);
            const float rs = rsqrtf(ss * (1.f / 128.f) + RMS_EPS);
            const u32x4 ga = *(const u32x4*)(W.SG + (trow0 + t) * 512 + h * 128 + v0), gb = *(const u32x4*)(W.SG + (trow0 + t) * 512 + h * 128 + v0 + 8);
            const unsigned gw[8] = {ga.x, ga.y, ga.z, ga.w, gb.x, gb.y, gb.z, gb.w};
            float y[16];
#pragma unroll
            for (int j = 0; j < 16; ++j) y[j] = x[j] * rs * gng[v0 + j] * ((j & 1) ? bfhi(gw[j >> 1]) : bflo(gw[j >> 1]));
            u32x4 o0, o1; o0.x = cvt_pk(y[0], y[1]); o0.y = cvt_pk(y[2], y[3]); o0.z = cvt_pk(y[4], y[5]); o0.w = cvt_pk(y[6], y[7]);
            o1.x = cvt_pk(y[8], y[9]); o1.y = cvt_pk(y[10], y[11]); o1.z = cvt_pk(y[12], y[13]); o1.w = cvt_pk(y[14], y[15]);
            bf16* dst = W.OAB + (trow0 + t) * 512 + h * 128 + v0; *(u32x4*)dst = o0; *(u32x4*)(dst + 8) = o1;
        }
        __syncthreads();
    }
}
__device__ __forceinline__ void phase_select(Frame& F, int l) {
    refresh(F);
    const WS W = ws_map(F.ws, F.nb); const float* const* IN_ = F.a->in; (void)IN_; (void)W;
    LAS int* lcnt = (LAS int*)F.lds; LAS int* lbase = lcnt + 32;
    const float* b_rg = IN_[19] + l * 4; const float* b_re = IN_[21] + l * 32;
    unsigned* gcnt = W.ctl + CW_CNT + l * 64;
    for (int t0 = F.bid * NTHR; t0 < F.T; t0 += F.G * NTHR) {
        if (F.tid < 32) lcnt[F.tid] = 0;
        __syncthreads();
        const int t = t0 + F.tid; int e0 = 0, e1 = 0, r0 = 0, r1 = 0; float g0 = 0.f, g1 = 0.f;
        if (t < F.T) {
            const float* lg = W.LOGITS + (size_t)t * 64;
            float gl[4]; { const f32x4 v = *(const f32x4*)lg; gl[0] = v[0] + b_rg[0]; gl[1] = v[1] + b_rg[1]; gl[2] = v[2] + b_rg[2]; gl[3] = v[3] + b_rg[3]; }
            int grp = 0; float mx = gl[0];
            if (gl[1] > mx) { mx = gl[1]; grp = 1; } if (gl[2] > mx) { mx = gl[2]; grp = 2; } if (gl[3] > mx) { mx = gl[3]; grp = 3; }
            const float p_grp = 1.f / (__expf(gl[0] - mx) + __expf(gl[1] - mx) + __expf(gl[2] - mx) + __expf(gl[3] - mx));
            const f32x4 ea = *(const f32x4*)(lg + 4 + grp * 8), eb = *(const f32x4*)(lg + 8 + grp * 8);
            const f32x4 ba = *(const f32x4*)(b_re + grp * 8), bb = *(const f32x4*)(b_re + grp * 8 + 4);
            float b0v = -1e30f, b1v = -1e30f; int i0 = 0, i1 = 0;
#pragma unroll
            for (int j = 0; j < 8; ++j) { const float e = (j < 4) ? ea[j] + ba[j] : eb[j - 4] + bb[j - 4];
                if (e > b0v) { b1v = b0v; i1 = i0; b0v = e; i0 = j; } else if (e > b1v) { b1v = e; i1 = j; } }
            const float p1 = __expf(b1v - b0v), s2 = 1.f + p1;
            e0 = grp * 8 + i0; e1 = grp * 8 + i1; g0 = p_grp / s2; g1 = p_grp * p1 / s2;
            r0 = __hip_atomic_fetch_add(lcnt + e0, 1, __ATOMIC_RELAXED, __HIP_MEMORY_SCOPE_WORKGROUP);
            r1 = __hip_atomic_fetch_add(lcnt + e1, 1, __ATOMIC_RELAXED, __HIP_MEMORY_SCOPE_WORKGROUP);
        }
        __syncthreads();
        if (F.tid < 32) lbase[F.tid] = (int)__hip_atomic_fetch_add(gcnt + F.tid, (unsigned)lcnt[F.tid], __ATOMIC_RELAXED, __HIP_MEMORY_SCOPE_AGENT);
        __syncthreads();
        if (t < F.T) { W.eid[t * 2] = e0; W.eid[t * 2 + 1] = e1; W.gate[t * 2] = g0; W.gate[t * 2 + 1] = g1; W.rank[t * 2] = lbase[e0] + r0; W.rank[t * 2 + 1] = lbase[e1] + r1; }
        __syncthreads();
    }
}
__device__ __forceinline__ void phase_gather(Frame& F, int l) {
    refresh(F);
    const WS W = ws_map(F.ws, F.nb); const float* const* IN_ = F.a->in; (void)IN_; (void)W;
    LAS int* seg = (LAS int*)F.lds; LAS int* cnt = seg + 40;
    const unsigned* gcnt = W.ctl + CW_CNT + l * 64;
    if (F.tid == 0) { int o = 0; for (int e = 0; e < 32; ++e) { const int c = (int)__hip_atomic_load(gcnt + e, __ATOMIC_RELAXED, __HIP_MEMORY_SCOPE_AGENT); seg[e] = o; cnt[e] = c; o += (c + 255) & ~255; } seg[32] = o; }
    __syncthreads();
    const int ntile = seg[32] >> 8;
    if (F.bid == 0) {
        for (int i = F.tid; i < ntile; i += NTHR) { int e = 0; while (e < 31 && (i << 8) >= seg[e + 1]) ++e; W.tilee[i] = e; }
        if (F.tid == 0) W.segp[0] = ntile;
    }
    for (int p = F.bid * NTHR + F.tid; p < (ntile << 8); p += F.G * NTHR) { int e = 0; while (e < 31 && p >= seg[e + 1]) ++e; if (p - seg[e] >= cnt[e]) W.stok[p] = 0; }
    for (int it = F.bid * NTHR + F.tid; it < F.T * 2; it += F.G * NTHR) {
        const int e = W.eid[it], p = seg[e] + W.rank[it];
        W.stok[p] = it >> 1; W.pos[it] = p; W.gsort[p] = W.gate[it];
    }
}

#ifndef MK_MASK
#define MK_MASK 0xffffffffu
#endif
#define EN(b) (((MK_MASK) >> (b)) & 1u)
#ifndef MK_DUP
#define MK_DUP 0u
#endif
#define REPS(b) ((((MK_DUP) >> (b)) & 1u) ? 2 : 1)
constexpr int NPL = 14, NPH = 2 + DEPTH * NPL;
__global__ void __launch_bounds__(NTHR, 2) mk_fwd(Args args) {
    extern __shared__ __attribute__((aligned(16))) unsigned char lds_raw[];
    Frame F;
    F.lds = (LAS unsigned char*)lds_raw; F.tid = threadIdx.x; F.lane = F.tid & 63; F.wave = __builtin_amdgcn_readfirstlane(F.tid >> 6);
    F.G = gridDim.x; F.bid = blockIdx.x; F.nb = args.nb; F.T = args.nb * SEQ; F.ws = args.ws; F.a = &args; F.xbuf = args.out;
    const float* const* IN_ = args.in;
    volatile LAS unsigned* misc = (volatile LAS unsigned*)(F.lds + LDS_MISC);
    if (F.tid < 64) misc[F.tid] = 0u;
    __syncthreads();
    XcdBarrier bar = xcd_barrier_post((unsigned*)args.ws + CW_BAR + args.li * XCD_BAR_WORDS, misc);
    const int lo = args.ph_lo, hi = args.ph_hi;
#define IN(k) (lo <= (k) && (k) < hi)
#ifdef MK_BAR2
#define SEAM(k) do { if (IN(k) && IN((k) + 1)) { xcd_barrier(bar); xcd_barrier(bar); } } while (0)
#else
#define SEAM(k) do { if (IN(k) && IN((k) + 1)) xcd_barrier(bar); } while (0)
#endif
    LAS unsigned char* gl = F.lds;
    if (EN(0) && IN(0)) { for (int rp = 0; rp < REPS(0); ++rp) { p0_prologue(F); __syncthreads(); } SEAM(0); }
    for (int l = 0; l < DEPTH; ++l) {
        const int pb = 1 + l * NPL;
        if (EN(1) && IN(pb + 0)) { for (int rp = 0; rp < ((l == 0) ? REPS(14) : 1); ++rp) phase_norm(F, l, 0); SEAM(pb + 0); }
        if (EN(2) && IN(pb + 1)) { const WS W = ws_map(F.ws, F.nb);
            pg8::Gemm g{W.H, W.win + (size_t)l * NIN * D, F.T, NIN, D}; pg8::StaticOrder S; S.init(F.T, NIN, F.G, F.bid);
            EpiIn E{W.GQ, W.GK, W.GV, W.SG, W.LGF, W.LGB, W.DQ, W.DK, W.DV, W.SGA, W.SGB, IN_[8] + l * 512, IN_[10] + l * 64, IN_[11] + l * 64};
#ifdef MK_INPROJ_NULL
            { EpiNull EN_; pg8::gemm_phase<EpiNull, pg8::StaticOrder, true, true>(gl, g, S, EN_); }
#endif
            for (int rp = 0; rp < REPS(2); ++rp) pg8::gemm_phase<EpiIn, pg8::StaticOrder, true, true>(gl, g, S, E);
            SEAM(pb + 1);
        }
        if (EN(3) && IN(pb + 2)) { for (int rp = 0; rp < REPS(3); ++rp) phase_gla1(F); SEAM(pb + 2); }
        if (EN(4) && IN(pb + 3)) { phase_gla2(F); SEAM(pb + 3); }
        if (EN(5) && IN(pb + 4)) { for (int rp = 0; rp < REPS(5); ++rp) phase_gla3(F, l); __syncthreads(); }
        if (EN(6) && IN(pb + 5)) {
#ifdef MK_ATT_PROBE
            phase_attn<MK_ATT_PROBE>(F, l);
#endif
            phase_attn<0>(F, l); SEAM(pb + 5); }
        if (EN(7) && IN(pb + 6)) { const WS W = ws_map(F.ws, F.nb);
            pg8::Gemm g{W.OAB, W.wab + (size_t)l * D * D, 0, 0, 512}; MergeOrder S; S.so.init(F.T, D, F.G, F.bid); S.nM = F.T / 256;
            EpiMerge E{W.SGA, W.SGB, W.MERGED, F.T / 256};
            for (int rp = 0; rp < REPS(7); ++rp) pg8::gemm_phase<EpiMerge, MergeOrder, true, true>(gl, g, S, E);
            SEAM(pb + 6);
        }
        if (EN(8) && IN(pb + 7)) { const WS W = ws_map(F.ws, F.nb); const float* modl = W.mod + (size_t)l * NBMAX * 6 * D;
            pg8::Gemm g{W.MERGED, W.wo + (size_t)l * D * D, F.T, D, D}; pg8::StaticOrder S; S.init(F.T, D, F.G, F.bid);
            EpiResid E{l == 0 ? IN_[0] : F.xbuf, F.xbuf, modl + 2 * D};
            for (int rp = 0; rp < ((l == 0) ? REPS(8) : 1); ++rp) pg8::gemm_phase<EpiResid, pg8::StaticOrder, true, true>(gl, g, S, E);
            SEAM(pb + 7);
        }
        if (EN(1) && IN(pb + 8)) { for (int rp = 0; rp < REPS(1); ++rp) phase_norm(F, l, 1); SEAM(pb + 8); }
        if (EN(9) && IN(pb + 9)) { const WS W = ws_map(F.ws, F.nb);
            pg8::Gemm g{W.H, W.wr + (size_t)l * 256 * D, F.T, 256, D}; pg8::StaticOrder S; S.init(F.T, 256, F.G, F.bid);
            EpiLogits E{W.LOGITS};
            for (int rp = 0; rp < REPS(9); ++rp) pg8::gemm_phase<EpiLogits, pg8::StaticOrder, true, true>(gl, g, S, E);
            SEAM(pb + 9);
        }
        if (EN(10) && IN(pb + 10)) { phase_select(F, l); SEAM(pb + 10); }
        if (EN(11) && IN(pb + 11)) { for (int rp = 0; rp < REPS(11); ++rp) { phase_gather(F, l); __syncthreads(); } SEAM(pb + 11); }
        if (EN(12) && IN(pb + 12)) { const WS W = ws_map(F.ws, F.nb);
            const int ntile = W.segp[0];
#if MK_MOE_FP8
            pg8::Gemm g{W.XS, (const bf16*)((const unsigned char*)W.w1 + (size_t)l * NE * 1024 * D), 0, 0, D / 2}; GroupedOrder S{W.tilee, ntile * 4, F.G, F.bid};
            EpiAct E{(unsigned char*)W.ACT};
#else
            pg8::Gemm g{W.H, W.w1 + (size_t)l * NE * 1024 * D, 0, 0, D}; GroupedOrder S{W.tilee, ntile * 4, F.G, F.bid, W.stok};
            EpiAct E{W.ACT};
#endif
            for (int rp = 0; rp < REPS(12); ++rp) pg8::gemm_phase<EpiAct, GroupedOrder, true, true, true>(gl, g, S, E);
            SEAM(pb + 12);
        }
        if (EN(13) && IN(pb + 13)) { const WS W = ws_map(F.ws, F.nb);
            const int ntile = W.segp[0];
#if MK_MOE_FP8
            pg8::Gemm g{W.ACT, (const bf16*)((const unsigned char*)W.w2 + (size_t)l * NE * D * DE), 0, 0, DE / 2}; GroupedOrder S{W.tilee, ntile * 4, F.G, F.bid};
#else
            pg8::Gemm g{W.ACT, W.w2 + (size_t)l * NE * D * DE, 0, 0, DE}; GroupedOrder S{W.tilee, ntile * 4, F.G, F.bid, nullptr};
#endif
            EpiYs E{W.YS, W.gsort};
            for (int rp = 0; rp < REPS(13); ++rp) pg8::gemm_phase<EpiYs, GroupedOrder, true, true>(gl, g, S, E);
            SEAM(pb + 13);
        }
    }
    if (EN(1) && IN(NPH - 1)) phase_norm(F, 0, 2);
#undef IN
#undef SEAM
}

struct LaunchCfg { int grid; bool ok; };
inline LaunchCfg& launch_cfg() {
    static LaunchCfg c{0, false}; static bool init = false;
    if (!init) { init = true;
        int dev = 0, cus = 0, per_cu = 0;
        if (hipGetDevice(&dev) != hipSuccess || hipDeviceGetAttribute(&cus, hipDeviceAttributeMultiprocessorCount, dev) != hipSuccess) { fprintf(stderr, "mk: device query failed\n"); return c; }
        if (hipFuncSetAttribute((const void*)mk_fwd, hipFuncAttributeMaxDynamicSharedMemorySize, LDS_BYTES) != hipSuccess) { fprintf(stderr, "mk: hipFuncSetAttribute failed\n"); return c; }
        if (hipOccupancyMaxActiveBlocksPerMultiprocessor(&per_cu, (const void*)mk_fwd, NTHR, LDS_BYTES) != hipSuccess || per_cu < 1) { fprintf(stderr, "mk: occupancy query says %d blocks/CU\n", per_cu); (void)hipGetLastError(); return c; }
        c.grid = cus; c.ok = true;
    }
    return c;
}
inline void launch_range(void* const* d_in, float* xbuf, void* d_ws, int nb, int lo, int hi, int li, hipStream_t stream) {
    LaunchCfg& c = launch_cfg(); if (!c.ok) return;
    Args a{}; for (int i = 0; i < 24; ++i) a.in[i] = (const float*)d_in[i];
    a.out = xbuf; a.ws = (unsigned char*)d_ws; a.nb = nb; a.ph_lo = lo; a.ph_hi = hi; a.li = li;
    hipLaunchKernelGGL(mk_fwd, dim3(c.grid), dim3(NTHR), LDS_BYTES, stream, a);
    const hipError_t le = hipPeekAtLastError(); if (le != hipSuccess) fprintf(stderr, "mk: launch [%d,%d) failed: %s\n", lo, hi, hipGetErrorName(le));
}
}
extern "C" void kernel_launch(void* const* d_in, const int* in_sizes, int n_in, void* d_out, int out_size, void* d_ws, size_t ws_size, hipStream_t stream) {
    (void)in_sizes; (void)n_in; (void)out_size;
    static int checked = 0;
    if (!checked) { checked = 1; const mk::WS w = mk::ws_map((unsigned char*)d_ws, 4); if (w.end > ws_size) { fprintf(stderr, "mk: workspace too small: need %zu, have %zu\n", w.end, ws_size); checked = -1; } }
    if (checked < 0) return;
    if (hipMemsetAsync(d_ws, 0, mk::CTL_BYTES, stream) != hipSuccess) return;
    mk::launch_range(d_in, (float*)d_out, d_ws, 4, 0, mk::NPH, 0, stream);
}
```

```cpp
#include <hip/hip_runtime.h>
#include <cstdio>
#include <cstdint>
#include <cmath>
#define MK_ATT_FP8 1
namespace pg8 {
#define PG8_LAS __attribute__((address_space(3)))
typedef unsigned short bf16_t;
typedef short bf16x8 __attribute__((ext_vector_type(8)));
typedef float f32x4 __attribute__((ext_vector_type(4)));
typedef unsigned u32x4 __attribute__((ext_vector_type(4)));
constexpr int BM = 256, BK = 64, HALF = 128, HTB = HALF * BK * 2  , STAGE_BYTES = 8 * HTB, NXCD = 8, WGM = 8;

__host__ __device__ __forceinline__ int lds_byte(int r, int c) { const int st = (r >> 4) * 2 + (c >> 5), rr = r & 15, cc = c & 31, ob = rr * 64 + cc * 2; return st * 1024 + (ob ^ (((ob >> 9) & 1) << 5)); }
__host__ __device__ __forceinline__ void stage_rc(int b, int& R, int& C) { const int st = b / 1024, sb = b % 1024, swz = sb ^ (((sb >> 9) & 1) << 5); R = (st >> 1) * 16 + swz / 64; C = (st & 1) * 32 + (swz % 64) / 2; }
__host__ __device__ __forceinline__ int perm32(int rho) { const int n = rho >> 4, i = rho & 15; return 8 * (i >> 2) + 4 * n + (i & 3); }

struct Unit { int pm, pn; };
struct Gemm { const bf16_t* A; const bf16_t* Bt; int M, N, K; };

struct StaticOrder {
    int nM, nN, nwg, G, c;
    __host__ __device__ void init(int M, int N, int G_, int c_) { nM = M / BM; nN = N / BM; nwg = nM * nN; G = G_; c = c_; }
    __host__ __device__ bool next(int i, Unit& u) const {
        const long L = (long)i * G + c; if (L >= nwg) return false;
        int wgid = (int)L; { const int q = nwg / NXCD, r = nwg % NXCD, xcd = wgid % NXCD, off = wgid / NXCD; wgid = (xcd < r ? xcd * (q + 1) : r * (q + 1) + (xcd - r) * q) + off; }
        const int nig = WGM * nN, gid = wgid / nig, fm = gid * WGM, gsz = (nM - fm) < WGM ? (nM - fm) : WGM;
        u.pm = fm + ((wgid % nig) % gsz); u.pn = (wgid % nig) / gsz; return true;
    }
    __device__ __forceinline__ void a_ready(const Unit&) const {}
    __device__ __forceinline__ void done(const Unit&) const {}
};
__device__ __forceinline__ unsigned cvt_pk_bf16(float lo, float hi) { unsigned r; asm volatile("v_cvt_pk_bf16_f32 %0, %1, %2" : "=v"(r) : "v"(lo), "v"(hi)); return r; }
__device__ __forceinline__ const void* pg8_uniform(const void* p) { const unsigned long long v = (unsigned long long)p;
    const unsigned lo = (unsigned)__builtin_amdgcn_readfirstlane((int)(unsigned)v), hi = (unsigned)__builtin_amdgcn_readfirstlane((int)(unsigned)(v >> 32)); return (const void*)(((unsigned long long)hi << 32) | lo); }
__device__ __forceinline__ void pg8_glds(const void* sbase, unsigned voff, unsigned ldsdst) { unsigned keep;
    asm volatile("s_nop 4\n\ts_mov_b32 %0, m0\n\ts_mov_b32 m0, %3\n\ts_nop 0\n\tglobal_load_lds_dwordx4 %1, %2\n\ts_mov_b32 m0, %0" : "=&s"(keep) : "v"(voff), "s"(sbase), "s"(ldsdst) : "memory"); }
typedef int pg8_v8i __attribute__((ext_vector_type(8)));
typedef int pg8_v4i __attribute__((ext_vector_type(4)));
template <class Epi, class Sched, bool ALIGN_EPI = false, bool SP2 = false, bool GATHER = false>
__device__ __forceinline__ void gemm_phase(PG8_LAS unsigned char* lds, const Gemm g, const Sched& S, const Epi& E) {
    int tid_ = threadIdx.x; asm volatile("" : "+v"(tid_));
    const int tid = tid_, wid = __builtin_amdgcn_readfirstlane(tid >> 6), lane = tid & 63, wr = wid >> 2, wc = wid & 3, fr = lane & 15, fq = lane >> 4;
    const int K = g.K, nt = K / BK;
    unsigned voffA[2], voffB[2]; unsigned vc[2][2] = {}, vn[2][2] = {}, vs[2][2] = {}; (void)vc; (void)vn; (void)vs;
#pragma unroll
    for (int i = 0; i < 2; ++i) { int R, C; stage_rc(tid * 16 + i * 8192, R, C); const int Rb = Epi::PERM ? ((R & ~31) + perm32(R & 31)) : R;
        voffA[i] = (unsigned)(R * K + C) * 2u; voffB[i] = (unsigned)(Rb * K + C) * 2u; }
    const size_t kstep = (size_t)(BK * 2);
    const size_t hstep = (size_t)HALF * K * 2;
    const size_t tstep = 2 * hstep;
    const unsigned ldsw = (unsigned)wid * 1024u; const unsigned lds0 = (unsigned)(unsigned long)lds; (void)lds0;
    const int aoff = lds_byte(wr * 64 + fr, fq * 8), boff = lds_byte(wc * 32 + fr, fq * 8);
#define PG8_SA(b, h) (((b) * 2 + (h)) * HTB)
#define PG8_SB(b, h) ((4 + (b) * 2 + (h)) * HTB)
#if defined(PG8_ASM_STAGE) && PG8_ASM_STAGE
#define PG8_STAGE(bufoff, gbase, voff) do { const void* _gb = pg8_uniform(gbase); _Pragma("unroll") for (int _i = 0; _i < 2; ++_i) \
        pg8_glds(_gb, (voff)[_i], (unsigned)__builtin_amdgcn_readfirstlane((int)(lds0 + (unsigned)(bufoff) + ldsw + _i * 8192))); } while (0)
#else
#define PG8_STAGE(bufoff, gbase, voff) do { _Pragma("unroll") for (int _i = 0; _i < 2; ++_i) \
        __builtin_amdgcn_global_load_lds((const unsigned*)((const char*)(gbase) + (voff)[_i]), (PG8_LAS unsigned*)(lds + (bufoff) + ldsw + _i * 8192), 16, 0, 0); } while (0)
#endif
#define PG8_STAGE_A(b, h, X, VS) do { if constexpr (GATHER) { PG8_STAGE(PG8_SA(b, h), X, VS[h]); } else { PG8_STAGE(PG8_SA(b, h), (X) + (h) * hstep, voffA); } } while (0)
#define PG8_LOADROWS(u, v) do { _Pragma("unroll") for (int i_ = 0; i_ < 2; ++i_) { int R_, C_; stage_rc(tid * 16 + i_ * 8192, R_, C_); _Pragma("unroll") for (int h_ = 0; h_ < 2; ++h_) \
        v[h_][i_] = (unsigned)S.rowidx[(u).pm * 256 + h_ * 128 + R_] * (unsigned)(K * 2) + (unsigned)C_ * 2u; } } while (0)
#define PG8_LDA(dst, b, h) do { _Pragma("unroll") for (int m = 0; m < 4; ++m) _Pragma("unroll") for (int k = 0; k < 2; ++k) dst[m][k] = *(const PG8_LAS bf16x8*)(lds + PG8_SA(b, h) + aoff + m * 2048 + k * 1024); } while (0)
#define PG8_LDB(dst, b, h) do { _Pragma("unroll") for (int n = 0; n < 2; ++n) _Pragma("unroll") for (int k = 0; k < 2; ++k) dst[n][k] = *(const PG8_LAS bf16x8*)(lds + PG8_SB(b, h) + boff + n * 2048 + k * 1024); } while (0)
#define PG8_MMA(ai, bj, At, Bt) do { __builtin_amdgcn_s_setprio(1); _Pragma("unroll") for (int m = 0; m < 4; ++m) _Pragma("unroll") for (int n = 0; n < 2; ++n) _Pragma("unroll") for (int k = 0; k < 2; ++k) \
        acc[ai][bj][m][n] = __builtin_amdgcn_mfma_f32_16x16x32_bf16(Bt[n][k], At[m][k], acc[ai][bj][m][n], 0, 0, 0); __builtin_amdgcn_s_setprio(0); } while (0)
#define PG8_WAIT_V(n) asm volatile("s_waitcnt vmcnt(" #n ")" ::: "memory")
#define PG8_WAIT_L(n) asm volatile("s_waitcnt lgkmcnt(" #n ")" ::: "memory")
#define PG8_BAR __builtin_amdgcn_s_barrier()
#define PG8_SCHED __builtin_amdgcn_sched_barrier(0)
    Unit cur, nxt; int ui = 0;
    if (!S.next(0, cur)) return;
    f32x4 acc[2][2][4][2];
#pragma unroll
    for (int a = 0; a < 2; ++a)
#pragma unroll
        for (int b = 0; b < 2; ++b)
#pragma unroll
            for (int m = 0; m < 4; ++m)
#pragma unroll
                for (int n = 0; n < 2; ++n) acc[a][b][m][n] = (f32x4){0.f, 0.f, 0.f, 0.f};
    bf16x8 At[4][2], B0[2][2], B1[2][2];
    const char* cA = (const char*)g.A + (GATHER ? (size_t)0 : (size_t)cur.pm * tstep); const char* cB = (const char*)g.Bt + (size_t)cur.pn * tstep;
    S.a_ready(cur);
    if constexpr (GATHER) { PG8_LOADROWS(cur, vc); }
    if constexpr (SP2) {
        PG8_STAGE(PG8_SB(0, 0), cB, voffB); PG8_STAGE(PG8_SB(0, 1), cB + hstep, voffB); PG8_STAGE_A(0, 0, cA, vc); PG8_STAGE_A(0, 1, cA, vc);
        if (wr == 1) PG8_BAR;
        PG8_WAIT_V(2); PG8_BAR;
        PG8_STAGE(PG8_SB(1, 0), cB + kstep, voffB); PG8_STAGE_A(1, 0, cA + kstep, vc); PG8_STAGE(PG8_SB(1, 1), cB + hstep + kstep, voffB);
        PG8_WAIT_V(6); PG8_BAR;
    } else {
        PG8_STAGE(PG8_SB(0, 0), cB, voffB); PG8_STAGE_A(0, 0, cA, vc); PG8_STAGE(PG8_SB(0, 1), cB + hstep, voffB); PG8_STAGE_A(0, 1, cA, vc);
        if (wr == 1) PG8_BAR;
        PG8_WAIT_V(4); PG8_BAR;
        PG8_STAGE(PG8_SB(1, 0), cB + kstep, voffB); PG8_STAGE_A(1, 0, cA + kstep, vc); PG8_STAGE(PG8_SB(1, 1), cB + hstep + kstep, voffB);
        PG8_WAIT_V(6); PG8_BAR;
    }
    for (;;) {
        const bool has_next = S.next(ui + 1, nxt);
        const char* nA = (has_next && !GATHER) ? (const char*)g.A + (size_t)nxt.pm * tstep : cA; const char* nB = has_next ? (const char*)g.Bt + (size_t)nxt.pn * tstep : cB;
        for (int t = 0; t < nt; t += 2) {
            const bool last = (t == nt - 2);
            const char* a1 = cA + (size_t)(t + 1) * kstep;
            const char* a2 = last ? nA : cA + (size_t)(t + 2) * kstep; const char* b2 = last ? nB : cB + (size_t)(t + 2) * kstep;
            const char* a3 = a2 + kstep; const char* b3 = b2 + kstep;
            if (last && has_next) S.a_ready(nxt);
            if constexpr (GATHER) { if (last && has_next) { PG8_LOADROWS(nxt, vn); }
                _Pragma("unroll") for (int h_ = 0; h_ < 2; ++h_) _Pragma("unroll") for (int i_ = 0; i_ < 2; ++i_) vs[h_][i_] = (last && has_next) ? vn[h_][i_] : vc[h_][i_]; }
            if constexpr (Epi::MIDK) { if (t == nt / 2) E.mid(acc, cur, wr, wc, fr, fq); }
            if constexpr (SP2) {
            PG8_LDB(B0, 0, 0); PG8_LDB(B1, 0, 1); PG8_SCHED; PG8_LDA(At, 0, 0); PG8_STAGE_A(1, 1, a1, vc);
            PG8_WAIT_V(8); PG8_WAIT_L(0); PG8_BAR; PG8_MMA(0, 0, At, B0); PG8_MMA(0, 1, At, B1); PG8_BAR; PG8_SCHED;
            PG8_LDA(At, 0, 1); PG8_STAGE(PG8_SB(0, 0), b2, voffB); PG8_STAGE(PG8_SB(0, 1), b2 + hstep, voffB); PG8_STAGE_A(0, 0, a2, vs);
            PG8_WAIT_V(8); PG8_WAIT_L(0); PG8_BAR; PG8_MMA(1, 0, At, B0); PG8_MMA(1, 1, At, B1); PG8_BAR; PG8_SCHED;
            PG8_LDB(B0, 1, 0); PG8_LDB(B1, 1, 1); PG8_SCHED; PG8_LDA(At, 1, 0); PG8_STAGE_A(0, 1, a2, vs);
            PG8_WAIT_V(8); PG8_WAIT_L(0); PG8_BAR; PG8_MMA(0, 0, At, B0); PG8_MMA(0, 1, At, B1); PG8_BAR; PG8_SCHED;
            PG8_LDA(At, 1, 1); PG8_STAGE(PG8_SB(1, 0), b3, voffB); PG8_STAGE(PG8_SB(1, 1), b3 + hstep, voffB); PG8_STAGE_A(1, 0, a3, vs);
            PG8_WAIT_V(8); PG8_WAIT_L(0); PG8_BAR; PG8_MMA(1, 0, At, B0); PG8_MMA(1, 1, At, B1); PG8_BAR; PG8_SCHED;
            } else {
            PG8_LDB(B0, 0, 0); PG8_SCHED; PG8_LDA(At, 0, 0); PG8_STAGE_A(1, 1, a1, vc);
            PG8_WAIT_L(8); PG8_BAR; PG8_WAIT_L(0); PG8_MMA(0, 0, At, B0); PG8_BAR; PG8_SCHED;
            PG8_LDB(B1, 0, 1); PG8_STAGE(PG8_SB(0, 0), b2, voffB);
            PG8_BAR; PG8_WAIT_L(0); PG8_MMA(0, 1, At, B1); PG8_BAR;
            PG8_LDA(At, 0, 1); PG8_STAGE_A(0, 0, a2, vs);
            PG8_BAR; PG8_WAIT_L(0); PG8_MMA(1, 0, At, B0); PG8_BAR; PG8_SCHED;
            PG8_STAGE(PG8_SB(0, 1), b2 + hstep, voffB);
            PG8_WAIT_V(6); PG8_BAR; PG8_MMA(1, 1, At, B1); PG8_BAR;
            PG8_LDB(B0, 1, 0); PG8_SCHED; PG8_LDA(At, 1, 0); PG8_STAGE_A(0, 1, a2, vs);
            PG8_WAIT_L(8); PG8_BAR; PG8_WAIT_L(0); PG8_MMA(0, 0, At, B0); PG8_BAR; PG8_SCHED;
            PG8_LDB(B1, 1, 1); PG8_STAGE(PG8_SB(1, 0), b3, voffB);
            PG8_BAR; PG8_WAIT_L(0); PG8_MMA(0, 1, At, B1); PG8_BAR;
            PG8_LDA(At, 1, 1); PG8_STAGE_A(1, 0, a3, vs);
            PG8_BAR; PG8_WAIT_L(0); PG8_MMA(1, 0, At, B0); PG8_BAR; PG8_SCHED;
            PG8_STAGE(PG8_SB(1, 1), b3 + hstep, voffB);
            PG8_WAIT_V(6); PG8_BAR; PG8_MMA(1, 1, At, B1); PG8_BAR;
            }
        }
        if constexpr (ALIGN_EPI) { if (wr == 0) PG8_BAR; }
        if constexpr (!Epi::AFTER_DRAIN) { E(acc, cur, wr, wc, fr, fq); S.done(cur); }
        if (!has_next) break;
#pragma unroll
        for (int a = 0; a < 2; ++a)
#pragma unroll
            for (int b = 0; b < 2; ++b)
#pragma unroll
                for (int m = 0; m < 4; ++m)
#pragma unroll
                    for (int n = 0; n < 2; ++n) acc[a][b][m][n] = (f32x4){0.f, 0.f, 0.f, 0.f};
        cur = nxt; cA = nA; cB = nB; ++ui;
        if constexpr (GATHER) { _Pragma("unroll") for (int h_ = 0; h_ < 2; ++h_) _Pragma("unroll") for (int i_ = 0; i_ < 2; ++i_) vc[h_][i_] = vn[h_][i_]; }
        if constexpr (ALIGN_EPI) { if (wr == 1) PG8_BAR; }
    }
    PG8_WAIT_V(0);
    if constexpr (!ALIGN_EPI) { if (wr == 0) PG8_BAR; }
    PG8_BAR;
    if constexpr (Epi::AFTER_DRAIN) { E.fused(acc, cur, wr, wc, fr, fq, lds, wid, lane); S.done(cur); }
#undef PG8_SA
#undef PG8_SB
#undef PG8_STAGE
#undef PG8_STAGE_A
#undef PG8_LOADROWS
#undef PG8_LDA
#undef PG8_LDB
#undef PG8_MMA
#undef PG8_WAIT_V
#undef PG8_WAIT_L
#undef PG8_BAR
#undef PG8_SCHED
}
}
namespace mk {
constexpr int D = 1024, SEQ = 8192, NBMAX = 4, NH = 4, DIN = 5152, NE = 32, DE = 512, DEPTH = 2;
constexpr int NT_IN = 22, NIN = NT_IN * 256;
constexpr int NWAVES = 8, NTHR = 512;
#ifndef MK_MOE_FP8
#define MK_MOE_FP8 0
#endif
constexpr float WSCALE = 16.f, ASCALE = 4.f;
constexpr float LOG2E = 1.4426950408889634f, QSCALE = 0.125f * LOG2E, RMS_EPS = 1e-6f;
constexpr int O_GQ = 0, O_GK = 256, O_GV = 512, O_GG = 1024, O_LRF = 1536, O_LRB = 1552, O_DQ = 1568, O_DK = 2080, O_DV = 2592, O_GA = 3104, O_GB = 4128;
typedef unsigned short bf16;
typedef unsigned u32x4 __attribute__((ext_vector_type(4)));
typedef unsigned u32x2 __attribute__((ext_vector_type(2)));
typedef float f32x4 __attribute__((ext_vector_type(4)));
typedef float f32x16 __attribute__((ext_vector_type(16)));
typedef short bf16x8 __attribute__((ext_vector_type(8)));
typedef short s16x4 __attribute__((ext_vector_type(4)));
#define LAS __attribute__((address_space(3)))
#define GAS __attribute__((address_space(1)))
#define LDS_WAIT() asm volatile("s_waitcnt lgkmcnt(0)" ::: "memory")
#define VM_WAIT() asm volatile("s_waitcnt vmcnt(0)" ::: "memory")

constexpr size_t MiB = 1u << 20;
constexpr size_t CTL_BYTES = 256 * 1024;
constexpr int CW_BAR = 4096;
constexpr int CW_CNT = 32768;
constexpr size_t OFF_MOD = 256 * 1024, OFF_TAB = 512 * 1024;
constexpr size_t OFF_WIN = 1 * MiB, SZ_WIN = (size_t)DEPTH * NIN * D * 2;
constexpr size_t OFF_WAB = OFF_WIN + SZ_WIN, SZ_WAB = (size_t)DEPTH * D * D * 2;
constexpr size_t OFF_WO = OFF_WAB + SZ_WAB, SZ_WO = SZ_WAB;
constexpr size_t OFF_WR = OFF_WO + SZ_WO, SZ_WR = (size_t)DEPTH * 256 * D * 2;
constexpr size_t OFF_W1 = OFF_WR + SZ_WR, SZ_W1 = (size_t)DEPTH * NE * 1024 * D * 2;
constexpr size_t OFF_W2 = OFF_W1 + SZ_W1, SZ_W2 = (size_t)DEPTH * NE * D * DE * 2;
constexpr size_t OFF_ACT = 225 * MiB;
static_assert(OFF_W2 + SZ_W2 <= OFF_ACT, "weights fit");
struct WS {
    unsigned* ctl; float* mod; float* tab;
    bf16 *win, *wab, *wo, *wr, *w1, *w2;
    bf16 *H, *OAB, *XB; int* eid; float* gate; int* rank; int* pos; int* tilee; int* segp;
    bf16 *GQ, *GK, *GV, *SG; bf16 *LGF, *LGB; bf16 *DQ, *DK, *DV, *SGA, *SGB; float* KVT; float* DEC; bf16* MERGED;
    bf16 *XS, *ACT, *YS; float* LOGITS; float* gsort; int* stok;
    size_t end;
};
__host__ __device__ inline WS ws_map(unsigned char* b, int nb) {
    WS w; const size_t T = (size_t)nb * SEQ;
    w.ctl = (unsigned*)b; w.mod = (float*)(b + OFF_MOD); w.tab = (float*)(b + OFF_TAB);
    w.win = (bf16*)(b + OFF_WIN); w.wab = (bf16*)(b + OFF_WAB); w.wo = (bf16*)(b + OFF_WO); w.wr = (bf16*)(b + OFF_WR); w.w1 = (bf16*)(b + OFF_W1); w.w2 = (bf16*)(b + OFF_W2);
    size_t o = OFF_ACT;
    auto take = [&](size_t bytes) { unsigned char* p = b + o; o += (bytes + 255) & ~(size_t)255; return p; };
    w.H = (bf16*)take(T * 2048); w.OAB = (bf16*)take(T * 2048); w.XB = (bf16*)take(T * 2048);
    w.eid = (int*)take(T * 8); w.gate = (float*)take(T * 8); w.rank = (int*)take(T * 8); w.pos = (int*)take(T * 8); w.tilee = (int*)take(4096); w.segp = (int*)take(1024);
    const size_t u0 = o;
    w.GQ = (bf16*)take(T * 512); w.GK = (bf16*)take(T * 512); w.GV = (bf16*)take(T * 1024); w.SG = (bf16*)take(T * 1024);
    w.LGF = (bf16*)take(T * 512); w.LGB = (bf16*)take(T * 512);
    w.DQ = (bf16*)take(T * 1024); w.DK = (bf16*)take(T * 1024); w.DV = (bf16*)take(T * 1024); w.SGA = (bf16*)take(T * 2048); w.SGB = (bf16*)take(T * 2048);
    w.KVT = (float*)take(T * 4096); w.MERGED = (bf16*)w.KVT; w.DEC = (float*)take(T * 32);
    const size_t e1 = o; o = u0;
    const size_t R = 2 * T + 32 * 256;
    w.XS = (bf16*)take(R * 2048); w.ACT = (bf16*)take(R * 1024); w.YS = (bf16*)take(R * 2048); w.LOGITS = (float*)take(T * 256); w.gsort = (float*)take(R * 4); w.stok = (int*)take(R * 4);
    w.end = o > e1 ? o : e1;
    return w;
}

__device__ __forceinline__ unsigned cvt_pk(float lo, float hi) { unsigned r; asm volatile("v_cvt_pk_bf16_f32 %0, %1, %2" : "=v"(r) : "v"(lo), "v"(hi)); return r; }
__device__ __forceinline__ float bf2f(unsigned short b) { return __uint_as_float(((unsigned)b) << 16); }
__device__ __forceinline__ float bflo(unsigned w) { return __uint_as_float(w << 16); }
__device__ __forceinline__ float bfhi(unsigned w) { return __uint_as_float(w & 0xffff0000u); }
__device__ __forceinline__ float fsigmoid(float x) { return __builtin_amdgcn_rcpf(1.f + __expf(-x)); }
__device__ __forceinline__ float fsilu(float x) { return x * fsigmoid(x); }
__device__ __forceinline__ float wave_sum(float v) {
#pragma unroll
    for (int o = 1; o < 64; o <<= 1) v += __shfl_xor(v, o);
    return v;
}
__device__ __forceinline__ int t5_bucket(int rel) {
    int ret = rel > 0 ? 16 : 0; int n = rel < 0 ? -rel : rel;
    if (n < 8) return ret + n;
    return ret + 8 + (n >= 12) + (n >= 16) + (n >= 23) + (n >= 32) + (n >= 46) + (n >= 64) + (n >= 91);
}

#define XB_TMO      128
#define XB_XCNT(j)  (256  + 64 * (j))
#define XB_XSUB(j)  (1280 + 64 * (j))
#define XB_XGEN(j)  (2304 + 64 * (j))
#define XB_TOP      3328
#define XB_TOPGEN   3392
#define XCD_BAR_WORDS 3456
#define XB_SPIN_CAP (1u << 18)
__device__ __forceinline__ unsigned xb_ld(unsigned* p)              { return __hip_atomic_load(p, __ATOMIC_RELAXED, __HIP_MEMORY_SCOPE_AGENT); }
__device__ __forceinline__ unsigned xb_add(unsigned* p, unsigned v) { return __hip_atomic_fetch_add(p, v, __ATOMIC_RELAXED, __HIP_MEMORY_SCOPE_AGENT); }
__device__ __forceinline__ unsigned xb_xcc_id() { return (unsigned)__builtin_amdgcn_s_getreg((3 << 11) | 20) & 0xFu; }
#define XB_SPIN(cond, bar) do { unsigned _sp = 0; while (cond) { __builtin_amdgcn_s_sleep(1); \
    if ((++_sp & 255u) == 0u) { if (xb_ld(&(bar)[XB_TMO])) break; if (_sp > XB_SPIN_CAP) { atomicAdd(&(bar)[XB_TMO], 1u); break; } } } } while (0)
struct XcdBarrier { unsigned* bar; unsigned x; volatile LAS unsigned* st; };
__device__ __forceinline__ XcdBarrier xcd_barrier_post(unsigned* bar, volatile LAS unsigned* st) {
    XcdBarrier b; b.bar = bar; b.x = xb_xcc_id(); b.st = st;
    if (threadIdx.x == 0) (void)xb_add(&bar[XB_XCNT(b.x)], 1u);
    return b;
}
__device__ __forceinline__ void xcd_barrier_complete(unsigned* bar, unsigned x, unsigned& nloc, unsigned& nx) {
    const unsigned G = gridDim.x * gridDim.y * gridDim.z;
    unsigned sum, cnt, mine, sp = 0u;
    for (;;) {
        sum = 0u; cnt = 0u; mine = 0u;
#pragma unroll
        for (unsigned j = 0; j < 16; ++j) { const unsigned c = xb_ld(&bar[XB_XCNT(j)]); sum += c; cnt += (c > 0u) ? 1u : 0u; mine = (j == x) ? c : mine; }
        if (sum == G) break;
        __builtin_amdgcn_s_sleep(1);
        if ((++sp & 255u) == 0u) { if (xb_ld(&bar[XB_TMO])) break; if (sp > XB_SPIN_CAP) { atomicAdd(&bar[XB_TMO], 1u); break; } }
    }
    nloc = mine > 0u ? mine : 1u; nx = cnt > 0u ? cnt : 1u;
}
__device__ __forceinline__ void xcd_barrier(const XcdBarrier& b) {
    asm volatile("s_waitcnt vmcnt(0)" ::: "memory");
    __syncthreads();
    if (threadIdx.x == 0) {
        unsigned* bar = b.bar;
        __builtin_amdgcn_s_waitcnt(0);
        unsigned nloc = b.st[0], nx = b.st[1];
        if (nloc == 0u) { xcd_barrier_complete(bar, b.x, nloc, nx); b.st[0] = nloc; b.st[1] = nx; }
        const unsigned old = xb_add(&bar[XB_XSUB(b.x)], 1u);
        const unsigned gen = old / nloc;
        if (old + 1u == (gen + 1u) * nloc) {
            __builtin_amdgcn_fence(__ATOMIC_RELEASE, "agent");
            asm volatile("s_waitcnt vmcnt(0)" ::: "memory");
            const unsigned og = xb_add(&bar[XB_TOP], 1u);
            const unsigned tg = og / nx;
            if (og + 1u == (tg + 1u) * nx) xb_add(&bar[XB_TOPGEN], 1u);
            else XB_SPIN(xb_ld(&bar[XB_TOPGEN]) == tg, bar);
            __builtin_amdgcn_fence(__ATOMIC_ACQUIRE, "agent");
            xb_add(&bar[XB_XGEN(b.x)], 1u);
            asm volatile("s_waitcnt vmcnt(0)" ::: "memory");
        } else {
            XB_SPIN(xb_ld(&bar[XB_XGEN(b.x)]) == gen, bar);
            __builtin_amdgcn_fence(__ATOMIC_ACQUIRE, "agent");
            asm volatile("s_waitcnt vmcnt(0)" ::: "memory");
        }
    }
    __syncthreads();
}

struct Args { const float* in[24]; float* out; unsigned char* ws; int nb, ph_lo, ph_hi, li; };
struct Frame {
    LAS unsigned char* lds; int tid, lane, wave, G, bid, nb, T; unsigned char* ws; const Args* a; float* xbuf;
};
__device__ __forceinline__ void refresh(Frame& F) { int t = threadIdx.x; asm volatile("" : "+v"(t)); F.tid = t; F.lane = t & 63; F.wave = __builtin_amdgcn_readfirstlane(t >> 6); }
constexpr int LDS_BYTES = 160 * 1024 - 64 * 0;
constexpr int LDS_MISC = 160 * 1024 - 256;

__device__ __forceinline__ void tr_item(const float* src, int lds_, int ks0, int c0, bf16* dst, int ldd, int r0, int kd0, LAS float* scr, int lane) {
#pragma unroll 8
    for (int i = 0; i < 32; ++i) { const int kk = 2 * i + (lane >> 5); scr[kk * 33 + (lane & 31)] = src[(size_t)(ks0 + kk) * lds_ + c0 + (lane & 31)]; }
    LDS_WAIT(); asm volatile("" ::: "memory");
    const int c = lane & 7;
#pragma unroll
    for (int j = 0; j < 4; ++j) { const int n = (lane >> 3) + 8 * j; const LAS float* s = scr + (8 * c) * 33 + n;
        u32x4 o; o.x = cvt_pk(s[0 * 33], s[1 * 33]); o.y = cvt_pk(s[2 * 33], s[3 * 33]); o.z = cvt_pk(s[4 * 33], s[5 * 33]); o.w = cvt_pk(s[6 * 33], s[7 * 33]);
        *(u32x4*)(dst + (size_t)(r0 + n) * ldd + kd0 + 8 * c) = o; }
    LDS_WAIT(); asm volatile("" ::: "memory");
}
__device__ __forceinline__ void tr_item8(const float* src, int lds_, int ks0, int c0, unsigned char* dst, int ldd, int r0, int kd0, float scale, LAS float* scr, int lane) {
#pragma unroll 8
    for (int i = 0; i < 32; ++i) { const int kk = 2 * i + (lane >> 5); scr[kk * 33 + (lane & 31)] = src[(size_t)(ks0 + kk) * lds_ + c0 + (lane & 31)] * scale; }
    LDS_WAIT(); asm volatile("" ::: "memory");
    const int c = lane & 7;
#pragma unroll
    for (int j = 0; j < 4; ++j) { const int n = (lane >> 3) + 8 * j; const LAS float* s = scr + (8 * c) * 33 + n;
        int w0 = 0, w1 = 0;
        w0 = __builtin_amdgcn_cvt_pk_fp8_f32(s[0 * 33], s[1 * 33], w0, false); w0 = __builtin_amdgcn_cvt_pk_fp8_f32(s[2 * 33], s[3 * 33], w0, true);
        w1 = __builtin_amdgcn_cvt_pk_fp8_f32(s[4 * 33], s[5 * 33], w1, false); w1 = __builtin_amdgcn_cvt_pk_fp8_f32(s[6 * 33], s[7 * 33], w1, true);
        u32x2 o; o.x = (unsigned)w0; o.y = (unsigned)w1;
        *(u32x2*)(dst + (size_t)(r0 + n) * ldd + kd0 + 8 * c) = o; }
    LDS_WAIT(); asm volatile("" ::: "memory");
}
__device__ __forceinline__ int win_src_col(int tile, int p0) {
    const int bj = p0 >> 7, wc = (p0 >> 5) & 3; const int L = 64 * wc + 32 * bj;
    switch (tile) {
        case 0: return O_GQ + p0; case 1: return O_GK + p0;
        case 2: case 3: return O_GV + (tile - 2) * 256 + p0;
        case 4: case 5: return O_GG + (tile - 4) * 256 + p0;
        case 8: case 9: return O_DQ + (tile - 8) * 256 + L;
        case 10: case 11: return O_DK + (tile - 10) * 256 + L;
        case 12: case 13: return O_DV + (tile - 12) * 256 + p0;
        case 14: case 15: case 16: case 17: return O_GA + (tile - 14) * 256 + p0;
        default: return O_GB + (tile - 18) * 256 + p0;
    }
}
__device__ __forceinline__ void p0_prologue(Frame& F) {
    refresh(F);
    const WS W = ws_map(F.ws, F.nb); const float* const* IN_ = F.a->in;
    const float* c_in = IN_[1]; const float* w_ada = IN_[2]; const float* b_ada = IN_[3];
    {
        LAS float* red = (LAS float*)F.lds;
        for (int it = F.bid; it < DEPTH * 96; it += F.G) {
            const int l = it / 96, j = (it % 96) * 64 + F.lane;
            const float* w = w_ada + (size_t)l * D * 6 * D + j;
            float a0 = 0.f, a1 = 0.f, a2 = 0.f, a3 = 0.f;
            const int kbeg = F.wave * 128;
#pragma unroll 16
            for (int k = kbeg; k < kbeg + 128; ++k) { const float wv = w[(size_t)k * 6 * D];
                const float c0 = c_in[k], c1 = c_in[D + k], c2 = c_in[2 * D + k], c3 = c_in[3 * D + k];
                a0 += fsilu(c0) * wv; a1 += fsilu(c1) * wv; a2 += fsilu(c2) * wv; a3 += fsilu(c3) * wv; }
            red[(F.wave * 4 + 0) * 64 + F.lane] = a0; red[(F.wave * 4 + 1) * 64 + F.lane] = a1; red[(F.wave * 4 + 2) * 64 + F.lane] = a2; red[(F.wave * 4 + 3) * 64 + F.lane] = a3;
            __syncthreads();
            if (F.tid < 256) { const int b = F.tid >> 6, jj = F.tid & 63; float s = 0.f;
#pragma unroll
                for (int wv = 0; wv < 8; ++wv) s += red[(wv * 4 + b) * 64 + jj];
                const int jc = (it % 96) * 64 + jj;
                W.mod[((size_t)l * NBMAX + b) * 6 * D + jc] = s + b_ada[l * 6 * D + jc]; }
            __syncthreads();
        }
    }
    if (F.bid == 0) {
        const float* rb = IN_[14];
        for (int i = F.tid; i < 1024; i += NTHR) { const int h = i >> 8, rel = (i & 255) - 128; W.tab[i] = (rb[t5_bucket(rel) * 4 + h] - rb[31 * 4 + h]) * LOG2E; }
        if (F.tid < 4) W.tab[1024 + F.tid] = __expf(rb[15 * 4 + F.tid] - rb[31 * 4 + F.tid]);
        if (F.tid >= 64 && F.tid < 64 + DEPTH) { const int l = F.tid - 64; const float* lv = IN_[12] + l * 256; float s1 = 0.f, s2 = 0.f;
            for (int i = 0; i < 64; ++i) { s1 += lv[i] * lv[64 + i]; s2 += lv[128 + i] * lv[192 + i]; }
            W.tab[1032 + l] = expf(s1) - expf(s2) + (0.8f - 0.6f * expf(-0.3f * (float)l)); }
    }
    __syncthreads();
    LAS float* scr = (LAS float*)(F.lds + F.wave * 16384);
    const int gw = F.bid * NWAVES + F.wave, NGW = F.G * NWAVES;
    constexpr int I_IN = (NIN / 32) * 16, I_AB = 32 * 16, I_O = 32 * 16, I_1 = NE * 32 * 16, I_2 = NE * 32 * 8;
    constexpr int PER_L = I_IN + I_AB + I_O + I_1 + I_2;
    for (int it = gw; it < DEPTH * PER_L; it += NGW) {
        const int l = it / PER_L; int r = it % PER_L;
        if (r < I_IN) { const int rb = r / 16, kb = r % 16, R = rb * 32, tile = R >> 8, p0 = R & 255;
            if (tile == 6 || tile == 7) continue;
            tr_item(IN_[6] + (size_t)l * D * DIN, DIN, kb * 64, win_src_col(tile, p0), W.win + (size_t)l * NIN * D, D, R, kb * 64, scr, F.lane); continue; }
        r -= I_IN;
        if (r < I_AB) { const int rb = r / 16, kb = r % 16;
            if (kb < 8) tr_item(IN_[15] + (size_t)l * 512 * D, D, kb * 64, rb * 32, W.wab + (size_t)l * D * D, 512, rb * 32, kb * 64, scr, F.lane);
            else tr_item(IN_[16] + (size_t)l * 512 * D, D, (kb - 8) * 64, rb * 32, W.wab + (size_t)l * D * D + (size_t)1024 * 512, 512, rb * 32, (kb - 8) * 64, scr, F.lane);
            continue; }
        r -= I_AB;
        if (r < I_O) { const int rb = r / 16, kb = r % 16; tr_item(IN_[17] + (size_t)l * D * D, D, kb * 64, rb * 32, W.wo + (size_t)l * D * D, D, rb * 32, kb * 64, scr, F.lane); continue; }
        r -= I_O;
        if (r < I_1) { const int e = r / 512, q = r % 512, rb = q / 16, kb = q % 16, R = rb * 32, pn = R >> 8, p = R & 255;
            const int col = (p < 128) ? (128 * pn + p) : (512 + 128 * pn + p - 128);
#if MK_MOE_FP8
            tr_item8(IN_[22] + ((size_t)l * NE + e) * D * 1024, 1024, kb * 64, col, (unsigned char*)W.w1 + ((size_t)l * NE + e) * 1024 * D, D, R, kb * 64, WSCALE, scr, F.lane); continue; }
#else
            tr_item(IN_[22] + ((size_t)l * NE + e) * D * 1024, 1024, kb * 64, col, W.w1 + ((size_t)l * NE + e) * 1024 * D, D, R, kb * 64, scr, F.lane); continue; }
#endif
        r -= I_1;
        { const int e = r / 256, q = r % 256, rb = q / 8, kb = q % 8;
#if MK_MOE_FP8
          tr_item8(IN_[23] + ((size_t)l * NE + e) * DE * D, D, kb * 64, rb * 32, (unsigned char*)W.w2 + ((size_t)l * NE + e) * D * DE, DE, rb * 32, kb * 64, WSCALE, scr, F.lane); }
#else
          tr_item(IN_[23] + ((size_t)l * NE + e) * DE * D, D, kb * 64, rb * 32, W.w2 + ((size_t)l * NE + e) * D * DE, DE, rb * 32, kb * 64, scr, F.lane); }
#endif
    }
    for (int it = gw; it < DEPTH * 2 * 8 * 16; it += NGW) {
        const int l = it >> 8, dir = (it >> 7) & 1, nbk = (it >> 4) & 7, kb = it & 15; const int k = kb * 64 + F.lane;
        const float* wi = IN_[6] + (size_t)l * D * DIN + (size_t)k * DIN + (dir ? O_LRB : O_LRF);
        float wv[16];
#pragma unroll
        for (int r = 0; r < 16; ++r) wv[r] = wi[r];
        const float* wu = IN_[7] + ((size_t)l * 2 + dir) * 16 * 256;
        bf16* dst = W.win + (size_t)l * NIN * D + (size_t)((6 + dir) * 256) * D;
        for (int n = nbk * 32; n < nbk * 32 + 32; ++n) { float s = 0.f;
#pragma unroll
            for (int r = 0; r < 16; ++r) s += wv[r] * wu[r * 256 + n];
            dst[(size_t)n * D + k] = (bf16)(cvt_pk(s, 0.f) & 0xffffu); }
    }
    for (int it = gw * 64 + F.lane; it < DEPTH * 256 * 128; it += NGW * 64) {
        const int l = it / (256 * 128), q = it % (256 * 128), row = q >> 7, k0 = (q & 127) * 8;
        float v[8];
#pragma unroll
        for (int i = 0; i < 8; ++i) { float x = 0.f;
            if (row < 4) x = IN_[18][((size_t)l * D + k0 + i) * 4 + row]; else if (row < 36) x = IN_[20][((size_t)l * D + k0 + i) * 32 + row - 4];
            v[i] = x; }
        u32x4 o; o.x = cvt_pk(v[0], v[1]); o.y = cvt_pk(v[2], v[3]); o.z = cvt_pk(v[4], v[5]); o.w = cvt_pk(v[6], v[7]);
        *(u32x4*)(W.wr + ((size_t)l * 256 + row) * D + k0) = o;
    }
}

__device__ __forceinline__ void phase_norm(Frame& F, int l, int mode) {
    refresh(F);
    const WS W = ws_map(F.ws, F.nb); const float* const* IN_ = F.a->in;
    const int gw = F.bid * NWAVES + F.wave, NGW = F.G * NWAVES;
    const bool combine = (mode == 2) || (mode == 0 && l > 0);
    const bool from_in = (mode == 0 && l == 0);
    const int lp = (mode == 2) ? DEPTH - 1 : l - 1;
    const float* ng = (mode == 1 ? IN_[5] : IN_[4]) + (size_t)(mode == 2 ? 0 : l) * D;
    for (int t = gw; t < F.T; t += NGW) {
        const int b = t / SEQ;
        f32x4 v[4];
        if (from_in) { const GAS f32x4* xr = (const GAS f32x4*)(IN_[0] + (size_t)t * D) + F.lane;
#pragma unroll
            for (int j = 0; j < 4; ++j) v[j] = xr[64 * j]; }
        else { const GAS u32x2* xr = (const GAS u32x2*)(W.XB + (size_t)t * D) + F.lane;
#pragma unroll
            for (int j = 0; j < 4; ++j) { const u32x2 a = xr[64 * j]; v[j] = (f32x4){bflo(a.x), bfhi(a.x), bflo(a.y), bfhi(a.y)}; } }
        if (combine) {
            const float* g2 = W.mod + ((size_t)lp * NBMAX + b) * 6 * D + 5 * D;
            const int p0 = W.pos[t * 2], p1 = W.pos[t * 2 + 1];
            const GAS u32x2* y0 = (const GAS u32x2*)(W.YS + (size_t)p0 * D) + F.lane; const GAS u32x2* y1 = (const GAS u32x2*)(W.YS + (size_t)p1 * D) + F.lane;
#pragma unroll
            for (int j = 0; j < 4; ++j) { const u32x2 a = y0[64 * j], c = y1[64 * j]; const f32x4 g = *((const GAS f32x4*)g2 + F.lane + 64 * j);
                v[j].x += g.x * (bflo(a.x) + bflo(c.x)); v[j].y += g.y * (bfhi(a.x) + bfhi(c.x)); v[j].z += g.z * (bflo(a.y) + bflo(c.y)); v[j].w += g.w * (bfhi(a.y) + bfhi(c.y)); }
            if (mode == 2) { GAS f32x4* xo = (GAS f32x4*)(F.xbuf + (size_t)t * D) + F.lane;
#pragma unroll
                for (int j = 0; j < 4; ++j) xo[64 * j] = v[j]; }
            else { GAS u32x2* xo = (GAS u32x2*)(W.XB + (size_t)t * D) + F.lane;
#pragma unroll
                for (int j = 0; j < 4; ++j) { u32x2 o; o.x = cvt_pk(v[j].x, v[j].y); o.y = cvt_pk(v[j].z, v[j].w); xo[64 * j] = o; } }
        }
        if (mode == 2) continue;
        float ss = 0.f;
#pragma unroll
        for (int j = 0; j < 4; ++j) ss += (v[j].x * v[j].x + v[j].y * v[j].y) + (v[j].z * v[j].z + v[j].w * v[j].w);
        const float rstd = rsqrtf(wave_sum(ss) * (1.f / D) + RMS_EPS);
        const float* md = W.mod + ((size_t)l * NBMAX + b) * 6 * D + (mode == 1 ? 3 * D : 0);
        GAS u32x2* ho = (GAS u32x2*)(W.H + (size_t)t * D) + F.lane;
#pragma unroll
        for (int j = 0; j < 4; ++j) { const f32x4 g = *((const GAS f32x4*)ng + F.lane + 64 * j), sh = *((const GAS f32x4*)md + F.lane + 64 * j), sc = *((const GAS f32x4*)(md + D) + F.lane + 64 * j);
            const float h0 = v[j].x * rstd * g.x * (1.f + sc.x) + sh.x, h1 = v[j].y * rstd * g.y * (1.f + sc.y) + sh.y, h2 = v[j].z * rstd * g.z * (1.f + sc.z) + sh.z, h3 = v[j].w * rstd * g.w * (1.f + sc.w) + sh.w;
            u32x2 o; o.x = cvt_pk(h0, h1); o.y = cvt_pk(h2, h3); ho[64 * j] = o; }
    }
}
typedef pg8::Unit Unit;
__device__ __forceinline__ u32x4 pack8(const f32x4& a, const f32x4& b) { u32x4 w; w.x = cvt_pk(a[0], a[1]); w.y = cvt_pk(a[2], a[3]); w.z = cvt_pk(b[0], b[1]); w.w = cvt_pk(b[2], b[3]); return w; }

#ifndef MK_ATT_FP8
#define MK_ATT_FP8 1
#endif
__device__ __forceinline__ u32x2 pack8_fp8(const f32x4& a, const f32x4& b) { int w0 = 0, w1 = 0;
    w0 = __builtin_amdgcn_cvt_pk_fp8_f32(a[0], a[1], w0, false); w0 = __builtin_amdgcn_cvt_pk_fp8_f32(a[2], a[3], w0, true);
    w1 = __builtin_amdgcn_cvt_pk_fp8_f32(b[0], b[1], w1, false); w1 = __builtin_amdgcn_cvt_pk_fp8_f32(b[2], b[3], w1, true);
    u32x2 r; r.x = (unsigned)w0; r.y = (unsigned)w1; return r; }
struct EpiNull {
    static constexpr bool PERM = true, AFTER_DRAIN = false, MIDK = false;
    __device__ __forceinline__ void operator()(const f32x4 (&acc)[2][2][4][2], const Unit&, int, int, int, int) const {
#pragma unroll
        for (int a = 0; a < 2; ++a)
#pragma unroll
            for (int b = 0; b < 2; ++b)
#pragma unroll
                for (int m = 0; m < 4; ++m) { asm volatile("" :: "v"(acc[a][b][m][0]), "v"(acc[a][b][m][1])); } }
};
struct EpiIn {
    static constexpr bool PERM = true, AFTER_DRAIN = false, MIDK = false;
    bf16 *GQ, *GK, *GV, *SG, *LGF, *LGB, *DQ, *DK, *DV, *SGA, *SGB; const float* b_up; const float* qg; const float* kg;
    __device__ __forceinline__ void operator()(const f32x4 (&acc)[2][2][4][2], const Unit& u, int wr, int wc, int fr, int fq) const {
        const int pn = u.pn; const int row0 = u.pm * 256 + wr * 64 + fr;
        if (pn >= 8 && pn <= 11) {
            const bool isk = pn >= 10; const int head = 2 * ((pn - 8) & 1) + (wc >> 1), c = wc & 1;
            const float* gv = isk ? kg : qg; const float sc = isk ? 1.f : QSCALE;
            f32x4 g[2][2];
#pragma unroll
            for (int bj = 0; bj < 2; ++bj)
#pragma unroll
                for (int n = 0; n < 2; ++n) g[bj][n] = *(const f32x4*)(gv + 32 * bj + 8 * fq + 4 * n);
#pragma unroll
            for (int ai = 0; ai < 2; ++ai)
#pragma unroll
                for (int m = 0; m < 4; ++m) {
                    const int r = row0 + ai * 128 + m * 16, b = r / SEQ, s = r % SEQ;
                    float ss = 0.f;
#pragma unroll
                    for (int bj = 0; bj < 2; ++bj)
#pragma unroll
                        for (int n = 0; n < 2; ++n) { const f32x4 x = acc[ai][bj][m][n]; ss += (x[0] * x[0] + x[1] * x[1]) + (x[2] * x[2] + x[3] * x[3]); }
                    ss += __shfl_xor(ss, 16); ss += __shfl_xor(ss, 32);
                    const float rs = rsqrtf(ss * (1.f / 64.f) + RMS_EPS) * sc;
#if MK_ATT_FP8
                    unsigned char* dst8 = (unsigned char*)(isk ? DK : DQ) + ((((size_t)b * NH + head) * 2 + c) * SEQ + s) * 64;
#pragma unroll
                    for (int bj = 0; bj < 2; ++bj) {
                        const f32x4 v0 = acc[ai][bj][m][0] * rs * g[bj][0], v1 = acc[ai][bj][m][1] * rs * g[bj][1];
                        int chunk = 2 * bj + (fq >> 1); if (isk) chunk ^= ((s >> 2) & 3);
                        *(u32x2*)(dst8 + chunk * 16 + 8 * (fq & 1)) = pack8_fp8(v0, v1);
                    }
#else
                    bf16* dst = (isk ? DK : DQ) + ((((size_t)b * NH + head) * 2 + c) * SEQ + s) * 64;
#pragma unroll
                    for (int bj = 0; bj < 2; ++bj) {
                        const f32x4 v0 = acc[ai][bj][m][0] * rs * g[bj][0], v1 = acc[ai][bj][m][1] * rs * g[bj][1];
                        int chunk = 4 * bj + fq; if (isk) chunk ^= ((s >> 1) & 7);
                        *(u32x4*)(dst + chunk * 8) = pack8(v0, v1);
                    }
#endif
                }
            return;
        }
#pragma unroll
        for (int ai = 0; ai < 2; ++ai)
#pragma unroll
            for (int m = 0; m < 4; ++m) {
                const int r = row0 + ai * 128 + m * 16;
#pragma unroll
                for (int bj = 0; bj < 2; ++bj) {
                    const int c0 = 128 * bj + 32 * wc + 8 * fq;
                    f32x4 v0 = acc[ai][bj][m][0], v1 = acc[ai][bj][m][1];
                    if (pn == 0) { *(u32x4*)(GQ + (size_t)r * 256 + c0) = pack8(v0 * 0.125f, v1 * 0.125f); }
                    else if (pn == 1) { *(u32x4*)(GK + (size_t)r * 256 + c0) = pack8(v0, v1); }
                    else if (pn <= 3) { *(u32x4*)(GV + (size_t)r * 512 + (pn - 2) * 256 + c0) = pack8(v0, v1); }
                    else if (pn <= 5) {
#pragma unroll
                        for (int i = 0; i < 4; ++i) { v0[i] = fsilu(v0[i]); v1[i] = fsilu(v1[i]); }
                        *(u32x4*)(SG + (size_t)r * 512 + (pn - 4) * 256 + c0) = pack8(v0, v1); }
                    else if (pn <= 7) {
                        const float* bu = b_up + (pn - 6) * 256 + c0; const f32x4 b0 = *(const f32x4*)bu, b1 = *(const f32x4*)(bu + 4);
#pragma unroll
                        for (int i = 0; i < 4; ++i) { float z = v0[i] + b0[i]; v0[i] = (fminf(z, 0.f) - __logf(1.f + __expf(-fabsf(z)))) * (1.f / 16.f);
                                                      z = v1[i] + b1[i]; v1[i] = (fminf(z, 0.f) - __logf(1.f + __expf(-fabsf(z)))) * (1.f / 16.f); }
                        *(u32x4*)((pn == 6 ? LGF : LGB) + (size_t)r * 256 + c0) = pack8(v0, v1); }
#if MK_ATT_FP8
                    else if (pn <= 13) {
                        const int b = r / SEQ, s = r % SEQ, head = 2 * (pn - 12) + bj;
                        const int kk = s & 63, wkey = kk & 31, hh_ = (wkey >> 2) & 1, reg_ = (wkey & 3) + 4 * (wkey >> 3), pos = hh_ * 32 + 16 * (kk >> 5) + reg_;
                        unsigned char* tb = (unsigned char*)DV + (((size_t)b * NH + head) * (SEQ / 64) + (s >> 6)) * 8192;
                        const u32x2 pk = pack8_fp8(v0, v1); const int dv0 = 32 * wc + 8 * fq;
#pragma unroll
                        for (int i = 0; i < 8; ++i) { const int dv = dv0 + i; const unsigned byte = ((i < 4 ? pk.x : pk.y) >> (8 * (i & 3))) & 0xffu;
                            tb[dv * 64 + ((((pos >> 4) ^ ((dv >> 2) & 3)) << 4) | (pos & 15))] = (unsigned char)byte; } }
#else
                    else if (pn <= 13) {
                        const int b = r / SEQ, s = r % SEQ, head = 2 * (pn - 12) + bj;
                        bf16* dst = DV + ((((size_t)b * NH + head) * (SEQ / 8) + (s >> 3)) * 4 + wc) * 256 + (s & 7) * 32 + 8 * fq;
                        *(u32x4*)dst = pack8(v0, v1); }
#endif
                    else {
#pragma unroll
                        for (int i = 0; i < 4; ++i) { v0[i] = fsigmoid(v0[i]); v1[i] = fsigmoid(v1[i]); }
                        bf16* base = (pn <= 17) ? SGA + (pn - 14) * 256 : SGB + (pn - 18) * 256;
                        *(u32x4*)(base + (size_t)r * D + c0) = pack8(v0, v1); }
                }
            }
    }
};

struct EpiMerge {
    static constexpr bool PERM = true, AFTER_DRAIN = false, MIDK = false;
    const bf16* SGA; const bf16* SGB; bf16* O; int nM;
    __device__ __forceinline__ void operator()(const f32x4 (&acc)[2][2][4][2], const Unit& u, int wr, int wc, int fr, int fq) const {
        const int sel = u.pn >> 2; const int row0 = (u.pm - sel * nM) * 256 + wr * 64 + fr, col0 = (u.pn & 3) * 256 + wc * 32 + 8 * fq;
        const bf16* G = sel ? SGB : SGA;
#pragma unroll
        for (int ai = 0; ai < 2; ++ai)
#pragma unroll
            for (int m = 0; m < 4; ++m) { const size_t off = (size_t)(row0 + ai * 128 + m * 16) * D + col0;
#pragma unroll
                for (int bj = 0; bj < 2; ++bj) { const u32x4 b = *(const u32x4*)(G + off + bj * 128);
                    f32x4 v0 = acc[ai][bj][m][0], v1 = acc[ai][bj][m][1];
                    v0[0] *= bflo(b.x); v0[1] *= bfhi(b.x); v0[2] *= bflo(b.y); v0[3] *= bfhi(b.y); v1[0] *= bflo(b.z); v1[1] *= bfhi(b.z); v1[2] *= bflo(b.w); v1[3] *= bfhi(b.w);
                    if (sel) { const u32x4 t = *(const u32x4*)(O + off + bj * 128);
                        v0[0] += bflo(t.x); v0[1] += bfhi(t.x); v0[2] += bflo(t.y); v0[3] += bfhi(t.y); v1[0] += bflo(t.z); v1[1] += bfhi(t.z); v1[2] += bflo(t.w); v1[3] += bfhi(t.w); }
                    *(u32x4*)(O + off + bj * 128) = pack8(v0, v1); }
                asm volatile("" ::: "memory"); }
    }
};
struct MergeOrder {
    pg8::StaticOrder so; int nM;
    __device__ __forceinline__ bool next(int i, Unit& u) const { Unit t; if (!so.next(i >> 1, t)) return false; const int sel = i & 1; u.pm = t.pm + sel * nM; u.pn = t.pn + sel * 4; return true; }
    __device__ __forceinline__ void a_ready(const Unit&) const {}
    __device__ __forceinline__ void done(const Unit&) const {}
};

struct EpiResid {
    static constexpr bool PERM = true, AFTER_DRAIN = false, MIDK = false;
    const float* xin32; bf16* xb; const float* g1;
    __device__ __forceinline__ void operator()(const f32x4 (&acc)[2][2][4][2], const Unit& u, int wr, int wc, int fr, int fq) const {
        const int row0 = u.pm * 256 + wr * 64 + fr, col0 = u.pn * 256 + wc * 32 + 8 * fq;
        const int b = (u.pm * 256) / SEQ; const float* g = g1 + (size_t)b * 6 * D + col0;
        f32x4 gv[2][2];
#pragma unroll
        for (int bj = 0; bj < 2; ++bj)
#pragma unroll
            for (int n = 0; n < 2; ++n) gv[bj][n] = *(const f32x4*)(g + bj * 128 + n * 4);
#pragma unroll
        for (int ai = 0; ai < 2; ++ai)
#pragma unroll
            for (int m = 0; m < 4; ++m) { const size_t off = (size_t)(row0 + ai * 128 + m * 16) * D + col0;
#pragma unroll
                for (int bj = 0; bj < 2; ++bj) { f32x4 x0, x1;
                    if (xin32) { x0 = *(const f32x4*)(xin32 + off + bj * 128); x1 = *(const f32x4*)(xin32 + off + bj * 128 + 4); }
                    else { const u32x4 a = *(const u32x4*)(xb + off + bj * 128); x0 = (f32x4){bflo(a.x), bfhi(a.x), bflo(a.y), bfhi(a.y)}; x1 = (f32x4){bflo(a.z), bfhi(a.z), bflo(a.w), bfhi(a.w)}; }
                    *(u32x4*)(xb + off + bj * 128) = pack8(x0 + gv[bj][0] * acc[ai][bj][m][0], x1 + gv[bj][1] * acc[ai][bj][m][1]); }
                asm volatile("" ::: "memory"); }
    }
};

struct EpiLogits {
    static constexpr bool PERM = false, AFTER_DRAIN = false, MIDK = false;
    float* L;
    __device__ __forceinline__ void operator()(const f32x4 (&acc)[2][2][4][2], const Unit& u, int wr, int wc, int fr, int fq) const {
        if (wc >= 2) return;
        const int row0 = u.pm * 256 + wr * 64 + fr, col0 = wc * 32 + 4 * fq;
#pragma unroll
        for (int ai = 0; ai < 2; ++ai)
#pragma unroll
            for (int m = 0; m < 4; ++m)
#pragma unroll
                for (int n = 0; n < 2; ++n) *(f32x4*)(L + (size_t)(row0 + ai * 128 + m * 16) * 64 + col0 + n * 16) = acc[ai][0][m][n];
    }
};

#ifndef MK_MOE_FP8
#define MK_MOE_FP8 0
#endif
#if MK_MOE_FP8
struct EpiAct {
    static constexpr bool PERM = true, AFTER_DRAIN = false, MIDK = false;
    unsigned char* ACT;
    __device__ __forceinline__ void operator()(const f32x4 (&acc)[2][2][4][2], const Unit& u, int wr, int wc, int fr, int fq) const {
        const int row0 = u.pm * 256 + wr * 64 + fr, col0 = (u.pn & 3) * 128 + wc * 32 + 8 * fq;
        constexpr float inv = 1.f / WSCALE;
#pragma unroll
        for (int ai = 0; ai < 2; ++ai)
#pragma unroll
            for (int m = 0; m < 4; ++m) { f32x4 v0, v1;
#pragma unroll
                for (int i = 0; i < 4; ++i) { v0[i] = fsilu(acc[ai][0][m][0][i] * inv) * acc[ai][1][m][0][i] * (inv * ASCALE); v1[i] = fsilu(acc[ai][0][m][1][i] * inv) * acc[ai][1][m][1][i] * (inv * ASCALE); }
                *(u32x2*)(ACT + (size_t)(row0 + ai * 128 + m * 16) * DE + col0) = pack8_fp8(v0, v1); }
    }
};
struct EpiYs {
    static constexpr bool PERM = true, AFTER_DRAIN = false, MIDK = false;
    bf16* YS; const float* gs;
    __device__ __forceinline__ void operator()(const f32x4 (&acc)[2][2][4][2], const Unit& u, int wr, int wc, int fr, int fq) const {
        const int row0 = u.pm * 256 + wr * 64 + fr, col0 = (u.pn & 3) * 256 + wc * 32 + 8 * fq;
#pragma unroll
        for (int ai = 0; ai < 2; ++ai)
#pragma unroll
            for (int m = 0; m < 4; ++m) { const int r = row0 + ai * 128 + m * 16; const float gt = gs[r] * (1.f / (WSCALE * ASCALE));
#pragma unroll
                for (int bj = 0; bj < 2; ++bj) *(u32x4*)(YS + (size_t)r * D + col0 + bj * 128) = pack8(acc[ai][bj][m][0] * gt, acc[ai][bj][m][1] * gt); }
    }
};
#else
struct EpiAct {
    static constexpr bool PERM = true, AFTER_DRAIN = false, MIDK = false;
    bf16* ACT;
    __device__ __forceinline__ void operator()(const f32x4 (&acc)[2][2][4][2], const Unit& u, int wr, int wc, int fr, int fq) const {
        const int row0 = u.pm * 256 + wr * 64 + fr, col0 = (u.pn & 3) * 128 + wc * 32 + 8 * fq;
#pragma unroll
        for (int ai = 0; ai < 2; ++ai)
#pragma unroll
            for (int m = 0; m < 4; ++m) { f32x4 v0, v1;
#pragma unroll
                for (int i = 0; i < 4; ++i) { v0[i] = fsilu(acc[ai][0][m][0][i]) * acc[ai][1][m][0][i]; v1[i] = fsilu(acc[ai][0][m][1][i]) * acc[ai][1][m][1][i]; }
                *(u32x4*)(ACT + (size_t)(row0 + ai * 128 + m * 16) * DE + col0) = pack8(v0, v1); }
    }
};
struct EpiYs {
    static constexpr bool PERM = true, AFTER_DRAIN = false, MIDK = false;
    bf16* YS; const float* gs;
    __device__ __forceinline__ void operator()(const f32x4 (&acc)[2][2][4][2], const Unit& u, int wr, int wc, int fr, int fq) const {
        const int row0 = u.pm * 256 + wr * 64 + fr, col0 = (u.pn & 3) * 256 + wc * 32 + 8 * fq;
#pragma unroll
        for (int ai = 0; ai < 2; ++ai)
#pragma unroll
            for (int m = 0; m < 4; ++m) { const int r = row0 + ai * 128 + m * 16; const float gt = gs[r];
#pragma unroll
                for (int bj = 0; bj < 2; ++bj) *(u32x4*)(YS + (size_t)r * D + col0 + bj * 128) = pack8(acc[ai][bj][m][0] * gt, acc[ai][bj][m][1] * gt); }
    }
};
#endif
struct GroupedOrder {
    const int* tilee; int U, G, c; const int* rowidx;
    __device__ __forceinline__ bool next(int i, Unit& u) const {
        int id;
        if ((G & 7) == 0) { const int gx = G >> 3, per = (U + 7) >> 3, n = i * gx + (c >> 3); if (n >= per) return false; id = (c & 7) * per + n; if (id >= U) return false; }
        else { id = i * G + c; if (id >= U) return false; }
        const int t = id >> 2; u.pm = t; u.pn = tilee[t] * 4 + (id & 3); return true;
    }
    __device__ __forceinline__ void a_ready(const Unit&) const {}
    __device__ __forceinline__ void done(const Unit&) const {}
};
constexpr int AT_KR = 0, AT_VR = 32768, AT_TAB = 65536, AT_SLOT = 8192;
typedef int v8i __attribute__((ext_vector_type(8)));
typedef int v4i __attribute__((ext_vector_type(4)));
__device__ __forceinline__ int crow(int r, int hi) { return (r & 3) + 8 * (r >> 2) + 4 * hi; }

__device__ __forceinline__ void attn_bias(f32x16& s0, f32x16& s1, int relbase, const LAS float* tabh) {
#pragma unroll
    for (int r = 0; r < 16; ++r) {
        int i0 = relbase + (r & 3) + 8 * (r >> 2); int i1 = i0 + 32;
        i0 = i0 < 0 ? 0 : (i0 > 255 ? 255 : i0); i1 = i1 < 0 ? 0 : (i1 > 255 ? 255 : i1);
        s0[r] += tabh[i0]; s1[r] += tabh[i1];
    }
}
template <int J>
__device__ __forceinline__ void attn_exp_chunk(f32x16& s0, f32x16& s1, float& lsum) {
    float ls = 0.f;
#pragma unroll
    for (int r = 4 * J; r < 4 * J + 4; ++r) { s0[r] = __builtin_amdgcn_exp2f(s0[r]); s1[r] = __builtin_amdgcn_exp2f(s1[r]); }
    (void)ls; (void)lsum;
}
__device__ __forceinline__ int pk4_bf8(float a, float b, float c, float d) { int w = 0; w = __builtin_amdgcn_cvt_pk_bf8_f32(a, b, w, false); w = __builtin_amdgcn_cvt_pk_bf8_f32(c, d, w, true); return w; }
__device__ __forceinline__ void glds16(const void* gsrc, unsigned lds_dst) { unsigned keep;
    asm volatile("s_mov_b32 %0, m0\n\ts_mov_b32 m0, %2\n\ts_nop 0\n\tglobal_load_lds_dwordx4 %1, off\n\ts_mov_b32 m0, %0" : "=&s"(keep) : "v"(gsrc), "s"(lds_dst) : "memory"); }
__device__ __forceinline__ void attn_dma_k(unsigned lds0, const unsigned char* kg0, int t, int slot, int wid, int lane) {
    glds16(kg0 + (size_t)(wid >> 2) * SEQ * 64 + (size_t)t * 4096 + (wid & 3) * 1024 + lane * 16, (unsigned)__builtin_amdgcn_readfirstlane((int)(lds0 + AT_KR + slot * AT_SLOT + wid * 1024)));
}
__device__ __forceinline__ void attn_dma_v(unsigned lds0, const unsigned char* vg0, int t, int slot, int wid, int lane) {
    glds16(vg0 + (size_t)t * 8192 + wid * 1024 + lane * 16, (unsigned)__builtin_amdgcn_readfirstlane((int)(lds0 + AT_VR + slot * AT_SLOT + wid * 1024)));
}
#define AT_RD128(dst, addr, off) asm volatile("ds_read_b128 %0, %1 offset:%c2" : "=&v"(dst) : "v"(addr), "i"(off) : "memory")
#define AT_MFMA8(a, b, c) __builtin_amdgcn_mfma_scale_f32_32x32x64_f8f6f4(a, b, c, 0, 0, 0, 0, 0, 0)
#define AT_MFMA8B(a, b, c) __builtin_amdgcn_mfma_scale_f32_32x32x64_f8f6f4(a, b, c, 0, 1, 0, 0, 0, 0)

template <int VAR>
__device__ __forceinline__ void phase_attn(Frame& F, int l) {
    refresh(F);
    const WS W = ws_map(F.ws, F.nb); const float* const* IN_ = F.a->in; (void)IN_; (void)W;
    const int lane = F.lane, wid = F.wave, r32 = lane & 31, hh = lane >> 5, qg = wid & 3, c = wid >> 2;
    LAS unsigned char* lds = F.lds; const unsigned lds0 = (unsigned)(unsigned long)lds;
    LAS float* tab = (LAS float*)(lds + AT_TAB);
    for (int i = F.tid; i < 1028; i += NTHR) tab[i] = W.tab[i];
    const float lam = W.tab[1032 + l]; const float lam_init = 0.8f - 0.6f * __expf(-0.3f * (float)l);
    const float* subg = IN_[13] + l * 128;
    const int U = F.nb * NH * 64;
    const int gx = F.G >> 3, per = U >> 3;
    const int sw = (r32 >> 2) & 3;
    const unsigned ka0 = lds0 + AT_KR + c * 4096 + r32 * 64 + (((2 * hh) ^ sw) << 4), ka1 = lds0 + AT_KR + c * 4096 + r32 * 64 + (((2 * hh + 1) ^ sw) << 4);
    const unsigned va0 = lds0 + AT_VR + r32 * 64 + (((2 * hh) ^ sw) << 4), va1 = lds0 + AT_VR + r32 * 64 + (((2 * hh + 1) ^ sw) << 4);
    const bool lag = wid >= 4;
    __syncthreads();
    for (int i = 0;; ++i) {
        int id;
        if ((F.G & 7) == 0) { const int n = i * gx + (F.bid >> 3); if (n >= per) break; id = (F.bid & 7) * per + n; }
        else { id = i * F.G + F.bid; if (id >= U) break; }
        const int bh = id >> 6, qb = id & 63, b = bh >> 2, h = bh & 3;
        const int qw0 = qb * 128 + 32 * qg;
        const unsigned char* kg0 = (const unsigned char*)W.DK + ((size_t)bh * 2) * SEQ * 64;
        const unsigned char* vg0 = (const unsigned char*)W.DV + (size_t)bh * SEQ * 128;
        v8i qf; { const unsigned char* qp = (const unsigned char*)W.DQ + (((size_t)bh * 2 + c) * SEQ + qw0 + r32) * 64 + 32 * hh;
            const v4i q0 = *(const v4i*)qp, q1 = *(const v4i*)(qp + 16); qf = (v8i){q0[0], q0[1], q0[2], q0[3], q1[0], q1[1], q1[2], q1[3]}; }
        asm volatile("s_waitcnt vmcnt(0)" ::: "memory");
        attn_dma_k(lds0, kg0, 0, 0, wid, lane); attn_dma_k(lds0, kg0, 1, 1, wid, lane); attn_dma_v(lds0, vg0, 0, 0, wid, lane); attn_dma_k(lds0, kg0, 2, 2, wid, lane);
        attn_dma_v(lds0, vg0, 1, 1, wid, lane); attn_dma_k(lds0, kg0, 3, 3, wid, lane); attn_dma_v(lds0, vg0, 2, 2, wid, lane);
        f32x16 o[4]; f32x16 osum = f32x16{};
#pragma unroll
        for (int dt = 0; dt < 4; ++dt) o[dt] = f32x16{};
        float lsum = 0.f;
        const v8i ones8 = {0x38383838, 0x38383838, 0x38383838, 0x38383838, 0x38383838, 0x38383838, 0x38383838, 0x38383838};
        const int tL = (qw0 >= 154) ? ((qw0 - 154) >> 6) + 1 : 0, tR = (qw0 + 185) >> 6;
        const float shl = tab[1024 + h];
        const LAS float* tabh = tab + h * 256;
        const int rel0 = -qw0 - r32 + 4 * hh + 128;
        const f32x16 cshift = {-2.f, -2.f, -2.f, -2.f, -2.f, -2.f, -2.f, -2.f, -2.f, -2.f, -2.f, -2.f, -2.f, -2.f, -2.f, -2.f};
        asm volatile("s_waitcnt vmcnt(4)" ::: "memory"); __builtin_amdgcn_s_barrier(); asm volatile("" ::: "memory");
        f32x16 sc0, sc1, sn0, sn1; v8i p; v4i kx[4];
        AT_RD128(kx[0], ka0, 0); AT_RD128(kx[1], ka1, 0); AT_RD128(kx[2], ka0, 2048); AT_RD128(kx[3], ka1, 2048);
        asm volatile("s_waitcnt lgkmcnt(0)" ::: "memory"); __builtin_amdgcn_sched_barrier(0);
        sc0 = AT_MFMA8(((v8i){kx[0][0], kx[0][1], kx[0][2], kx[0][3], kx[1][0], kx[1][1], kx[1][2], kx[1][3]}), qf, cshift);
        sc1 = AT_MFMA8(((v8i){kx[2][0], kx[2][1], kx[2][2], kx[2][3], kx[3][0], kx[3][1], kx[3][2], kx[3][3]}), qf, cshift);
        __builtin_amdgcn_s_barrier(); asm volatile("" ::: "memory");
        if (lag) { __builtin_amdgcn_s_barrier(); asm volatile("" ::: "memory"); }
#define AT_STEP(SL, t) do { \
            { const int tk = (t) + 4 < 128 ? (t) + 4 : 127; attn_dma_k(lds0, kg0, tk, SL, wid, lane); } \
            asm volatile("s_waitcnt vmcnt(4)" ::: "memory");                                                       \
            AT_RD128(kx[0], ka0, ((SL + 1) & 3) * AT_SLOT); AT_RD128(kx[1], ka1, ((SL + 1) & 3) * AT_SLOT);        \
            AT_RD128(kx[2], ka0, ((SL + 1) & 3) * AT_SLOT + 2048); AT_RD128(kx[3], ka1, ((SL + 1) & 3) * AT_SLOT + 2048); \
            if ((t) >= tL && (t) < tR) attn_bias(sc0, sc1, 64 * (t) + rel0, tabh);                                \
            attn_exp_chunk<0>(sc0, sc1, lsum); attn_exp_chunk<1>(sc0, sc1, lsum);                                 \
            asm volatile("s_waitcnt lgkmcnt(0)" ::: "memory"); __builtin_amdgcn_sched_barrier(0); \
            sn0 = AT_MFMA8(((v8i){kx[0][0], kx[0][1], kx[0][2], kx[0][3], kx[1][0], kx[1][1], kx[1][2], kx[1][3]}), qf, cshift); \
            __builtin_amdgcn_sched_barrier(0); \
            attn_exp_chunk<2>(sc0, sc1, lsum); \
            __builtin_amdgcn_sched_barrier(0); \
            sn1 = AT_MFMA8(((v8i){kx[2][0], kx[2][1], kx[2][2], kx[2][3], kx[3][0], kx[3][1], kx[3][2], kx[3][3]}), qf, cshift); \
            __builtin_amdgcn_sched_barrier(0); \
            attn_exp_chunk<3>(sc0, sc1, lsum); \
            p[0] = pk4_bf8(sc0[0], sc0[1], sc0[2], sc0[3]); p[1] = pk4_bf8(sc0[4], sc0[5], sc0[6], sc0[7]); p[2] = pk4_bf8(sc0[8], sc0[9], sc0[10], sc0[11]); p[3] = pk4_bf8(sc0[12], sc0[13], sc0[14], sc0[15]); \
            p[4] = pk4_bf8(sc1[0], sc1[1], sc1[2], sc1[3]); p[5] = pk4_bf8(sc1[4], sc1[5], sc1[6], sc1[7]); p[6] = pk4_bf8(sc1[8], sc1[9], sc1[10], sc1[11]); p[7] = pk4_bf8(sc1[12], sc1[13], sc1[14], sc1[15]); \
            __builtin_amdgcn_s_barrier(); asm volatile("" ::: "memory"); \
            { const int tv = (t) + 3 < 128 ? (t) + 3 : 127; attn_dma_v(lds0, vg0, tv, (SL + 3) & 3, wid, lane); } \
            asm volatile("s_waitcnt vmcnt(4)" ::: "memory");                                                       \
            { v4i vx[8]; \
              AT_RD128(vx[0], va0, SL * AT_SLOT); AT_RD128(vx[1], va1, SL * AT_SLOT); AT_RD128(vx[2], va0, SL * AT_SLOT + 2048); AT_RD128(vx[3], va1, SL * AT_SLOT + 2048); \
              AT_RD128(vx[4], va0, SL * AT_SLOT + 4096); AT_RD128(vx[5], va1, SL * AT_SLOT + 4096); AT_RD128(vx[6], va0, SL * AT_SLOT + 6144); AT_RD128(vx[7], va1, SL * AT_SLOT + 6144); \
              if ((t) == tL) { _Pragma("unroll") for (int dt = 0; dt < 4; ++dt) o[dt] *= shl; osum *= shl; } \
              osum = AT_MFMA8B(ones8, p, osum); \
              asm volatile("s_waitcnt lgkmcnt(4)" ::: "memory"); __builtin_amdgcn_sched_barrier(0); \
              o[0] = AT_MFMA8B(((v8i){vx[0][0], vx[0][1], vx[0][2], vx[0][3], vx[1][0], vx[1][1], vx[1][2], vx[1][3]}), p, o[0]); \
              o[1] = AT_MFMA8B(((v8i){vx[2][0], vx[2][1], vx[2][2], vx[2][3], vx[3][0], vx[3][1], vx[3][2], vx[3][3]}), p, o[1]); \
              asm volatile("s_waitcnt lgkmcnt(0)" ::: "memory"); __builtin_amdgcn_sched_barrier(0); \
              o[2] = AT_MFMA8B(((v8i){vx[4][0], vx[4][1], vx[4][2], vx[4][3], vx[5][0], vx[5][1], vx[5][2], vx[5][3]}), p, o[2]); \
              o[3] = AT_MFMA8B(((v8i){vx[6][0], vx[6][1], vx[6][2], vx[6][3], vx[7][0], vx[7][1], vx[7][2], vx[7][3]}), p, o[3]); } \
            sc0 = sn0; sc1 = sn1; \
            __builtin_amdgcn_s_barrier(); asm volatile("" ::: "memory"); } while (0)
        for (int t0 = 0; t0 < 128; t0 += 4) { AT_STEP(0, t0); AT_STEP(1, t0 + 1); AT_STEP(2, t0 + 2); AT_STEP(3, t0 + 3); }
#undef AT_STEP
        if (!lag) { __builtin_amdgcn_s_barrier(); asm volatile("" ::: "memory"); }
        asm volatile("s_waitcnt vmcnt(0)" ::: "memory"); __builtin_amdgcn_s_barrier(); asm volatile("" ::: "memory");
        const float lt = osum[0];
        LAS float* xch = (LAS float*)(lds + qg * 16384);
        if (c == 1) { const float f = lam / lt;
#pragma unroll
            for (int dt = 0; dt < 4; ++dt)
#pragma unroll
                for (int r = 0; r < 16; ++r) xch[(dt * 16 + r) * 64 + lane] = o[dt][r] * f; }
        LDS_WAIT(); __builtin_amdgcn_s_barrier(); asm volatile("" ::: "memory");
        if (c == 0) { const float f = 1.f / lt; float ss = 0.f;
#pragma unroll
            for (int dt = 0; dt < 4; ++dt)
#pragma unroll
                for (int r = 0; r < 16; ++r) { const float v = o[dt][r] * f - xch[(dt * 16 + r) * 64 + lane]; o[dt][r] = v; ss += v * v; }
            ss += __shfl_xor(ss, 32);
            const float rn = rsqrtf(ss * (1.f / 128.f) + RMS_EPS) * (1.f - lam_init);
            bf16* orow = W.OAB + (size_t)F.T * 512 + ((size_t)b * SEQ + qw0 + r32) * 512 + h * 128;
#pragma unroll
            for (int dt = 0; dt < 4; ++dt)
#pragma unroll
                for (int g = 0; g < 4; ++g) { const int dv = 32 * dt + 8 * g + 4 * hh; const f32x4 sg = *(const f32x4*)(subg + dv);
                    u32x2 ov; ov.x = cvt_pk(o[dt][4 * g] * rn * sg[0], o[dt][4 * g + 1] * rn * sg[1]); ov.y = cvt_pk(o[dt][4 * g + 2] * rn * sg[2], o[dt][4 * g + 3] * rn * sg[3]);
                    *(u32x2*)(orow + dv) = ov; }
        }
        LDS_WAIT(); __builtin_amdgcn_s_barrier(); asm volatile("" ::: "memory");
    }
}
constexpr int GL_CUM = 0;
constexpr int GL_S64 = 144, GL_S192 = 400;
constexpr int G1_KEF = 34816, G1_KEB = G1_KEF + 64 * GL_S64, G1_VT = G1_KEB + 64 * GL_S64;
constexpr int G3_AOP = 34816, G3_KIF = G3_AOP + 64 * GL_S192, G3_KIB = G3_KIF + 64 * GL_S64, G3_BOP = G3_KIB + 64 * GL_S64;
static_assert(G3_BOP + 128 * GL_S192 <= 150 * 1024, "GLA LDS");

__device__ __forceinline__ bf16x8 lds_frag(const LAS unsigned char* base, int row, int stride, int kbyte) { return *(const LAS bf16x8*)(base + row * stride + kbyte); }

__device__ __forceinline__ void gla_cum(Frame& F, size_t trow0, int h) {
    const WS W = ws_map(F.ws, F.nb); const float* const* IN_ = F.a->in; (void)IN_; (void)W;
    LAS float* cum = (LAS float*)(F.lds + GL_CUM);
#pragma unroll
    for (int it = 0; it < 4; ++it) { const int idx = F.tid + it * NTHR; const int dir = idx >> 10, t = (idx >> 4) & 63, d4 = (idx & 15) * 4;
        const u32x2 a = *(const u32x2*)((dir ? W.LGB : W.LGF) + (trow0 + t) * 256 + h * 64 + d4);
        *(LAS f32x4*)(cum + (dir * 64 + t) * 64 + d4) = (f32x4){bflo(a.x), bfhi(a.x), bflo(a.y), bfhi(a.y)}; }
    __syncthreads();
    {
        const int dir = F.tid >> 8, seg = (F.tid >> 6) & 3, d = F.tid & 63; LAS float* cc = cum + dir * 4096 + d; LAS float* tot = cum + 8192 + (dir * 4 + seg) * 64 + d;
        float v[16]; float run = 0.f;
        if (dir == 0) {
#pragma unroll
            for (int i = 0; i < 16; ++i) { run += cc[(16 * seg + i) * 64]; v[i] = run; }
        } else {
#pragma unroll
            for (int i = 15; i >= 0; --i) { run += cc[(16 * seg + i) * 64]; v[i] = run; }
        }
        *tot = run;
        __syncthreads();
        float off = 0.f; const LAS float* tb = cum + 8192 + dir * 256 + d;
        if (dir == 0) { if (seg > 0) off += tb[0]; if (seg > 1) off += tb[64]; if (seg > 2) off += tb[128]; }
        else { if (seg < 3) off += tb[192]; if (seg < 2) off += tb[128]; if (seg < 1) off += tb[64]; }
#pragma unroll
        for (int i = 0; i < 16; ++i) cc[(16 * seg + i) * 64] = v[i] + off;
    }
    __syncthreads();
}

__device__ __forceinline__ void phase_gla1(Frame& F) {
    refresh(F);
    const WS W = ws_map(F.ws, F.nb); const float* const* IN_ = F.a->in; (void)IN_; (void)W;
    LAS unsigned char* lds = F.lds; LAS float* cum = (LAS float*)(lds + GL_CUM);
    const int lane = F.lane, wid = F.wave, r32 = lane & 31, hh = lane >> 5;
    const int U = F.nb * NH * 128;
    for (int u = F.bid; u < U; u += F.G) {
        const int n = u & 127, bh = u >> 7, b = bh >> 2, h = bh & 3; const size_t trow0 = (size_t)b * SEQ + n * 64;
        gla_cum(F, trow0, h);
        {
            const int t = F.tid >> 3, d0 = (F.tid & 7) * 8;
            const u32x4 kv = *(const u32x4*)(W.GK + (trow0 + t) * 256 + h * 64 + d0);
            const unsigned kw[4] = {kv.x, kv.y, kv.z, kv.w};
#pragma unroll
            for (int j = 0; j < 8; ++j) { const int d = d0 + j; const float k = (j & 1) ? bfhi(kw[j >> 1]) : bflo(kw[j >> 1]);
                const float ef = __expf(cum[63 * 64 + d] - cum[t * 64 + d]), eb = __expf(cum[4096 + d] - cum[4096 + t * 64 + d]);
                *(LAS bf16*)(lds + G1_KEF + d * GL_S64 + t * 2) = (bf16)(cvt_pk(k * ef, 0.f) & 0xffffu);
                *(LAS bf16*)(lds + G1_KEB + d * GL_S64 + t * 2) = (bf16)(cvt_pk(k * eb, 0.f) & 0xffffu); }
            const int v0 = (F.tid & 7) * 16;
            const u32x4 va = *(const u32x4*)(W.GV + (trow0 + t) * 512 + h * 128 + v0), vb = *(const u32x4*)(W.GV + (trow0 + t) * 512 + h * 128 + v0 + 8);
            const unsigned vw[8] = {va.x, va.y, va.z, va.w, vb.x, vb.y, vb.z, vb.w};
#pragma unroll
            for (int j = 0; j < 16; ++j) *(LAS bf16*)(lds + G1_VT + (v0 + j) * GL_S64 + t * 2) = (bf16)((j & 1) ? (vw[j >> 1] >> 16) : (vw[j >> 1] & 0xffffu));
            if (F.tid < 128) { const int dir = F.tid >> 6, d = F.tid & 63; W.DEC[((size_t)u * 2 + dir) * 64 + d] = __expf(dir ? cum[4096 + d] : cum[63 * 64 + d]); }
        }
        __syncthreads();
        {
            const int dt = wid & 3, dd = wid >> 2;
            f32x16 cf = {}, cb = {};
#pragma unroll
            for (int s = 0; s < 4; ++s) { const int kb = (16 * s + 8 * hh) * 2;
                const bf16x8 a = lds_frag(lds + G1_VT, 32 * dt + r32, GL_S64, kb);
                cf = __builtin_amdgcn_mfma_f32_32x32x16_bf16(a, lds_frag(lds + G1_KEF, 32 * dd + r32, GL_S64, kb), cf, 0, 0, 0);
                cb = __builtin_amdgcn_mfma_f32_32x32x16_bf16(a, lds_frag(lds + G1_KEB, 32 * dd + r32, GL_S64, kb), cb, 0, 0, 0); }
            bf16* of = (bf16*)W.KVT + ((size_t)u * 2) * 8192; bf16* ob = of + 8192;
#pragma unroll
            for (int r = 0; r < 16; ++r) { const int dv = 32 * dt + crow(r, hh), d = 32 * dd + r32;
                const float pf = __shfl_xor(cf[r], 1), pb = __shfl_xor(cb[r], 1);
                if (!(lane & 1)) { *(unsigned*)(of + dv * 64 + d) = cvt_pk(cf[r], pf); *(unsigned*)(ob + dv * 64 + d) = cvt_pk(cb[r], pb); } }
        }
        __syncthreads();
    }
}

__device__ __forceinline__ void phase_gla2(Frame& F) {
    refresh(F);
    const WS W = ws_map(F.ws, F.nb); const float* const* IN_ = F.a->in; (void)IN_; (void)W;
    const size_t total = (size_t)F.nb * NH * 2 * 4096;
    for (size_t wk = (size_t)F.bid * NTHR + F.tid; wk < total; wk += (size_t)F.G * NTHR) {
        const int e2 = (int)(wk & 4095), dir = (int)((wk >> 12) & 1), bh = (int)(wk >> 13), d = (e2 * 2) & 63;
        unsigned* base = (unsigned*)((bf16*)W.KVT + ((size_t)bh * 128 * 2 + dir) * 8192) + e2; const float* dec = W.DEC + ((size_t)bh * 128 * 2 + dir) * 64 + d;
        float S0 = 0.f, S1 = 0.f;
        for (int n0 = 0; n0 < 128; n0 += 8) {
            unsigned kv[8]; float dc0[8], dc1[8];
#pragma unroll
            for (int j = 0; j < 8; ++j) { const int n = dir ? 127 - (n0 + j) : n0 + j; kv[j] = base[(size_t)n * 8192]; dc0[j] = dec[(size_t)n * 128]; dc1[j] = dec[(size_t)n * 128 + 1]; }
#pragma unroll
            for (int j = 0; j < 8; ++j) { const int n = dir ? 127 - (n0 + j) : n0 + j; base[(size_t)n * 8192] = cvt_pk(S0, S1); S0 = dc0[j] * S0 + bflo(kv[j]); S1 = dc1[j] * S1 + bfhi(kv[j]); }
        }
    }
}

__device__ __forceinline__ void phase_gla3(Frame& F, int l) {
    refresh(F);
    const WS W = ws_map(F.ws, F.nb); const float* const* IN_ = F.a->in; (void)IN_; (void)W;
    LAS unsigned char* lds = F.lds; LAS float* cum = (LAS float*)(lds + GL_CUM);
    const int lane = F.lane, wid = F.wave, r32 = lane & 31, hh = lane >> 5;
    const float* gng = IN_[9] + l * 128;
    const int U = F.nb * NH * 128;
    for (int u = F.bid; u < U; u += F.G) {
        const int n = u & 127, bh = u >> 7, b = bh >> 2, h = bh & 3; const size_t trow0 = (size_t)b * SEQ + n * 64;
        gla_cum(F, trow0, h);
        {
            const int t = F.tid >> 3, d0 = (F.tid & 7) * 8;
            const u32x4 qv = *(const u32x4*)(W.GQ + (trow0 + t) * 256 + h * 64 + d0), kv = *(const u32x4*)(W.GK + (trow0 + t) * 256 + h * 64 + d0);
            const unsigned qw[4] = {qv.x, qv.y, qv.z, qv.w}, kw[4] = {kv.x, kv.y, kv.z, kv.w};
            float qf[8], qb[8], kf[8], kb[8];
#pragma unroll
            for (int j = 0; j < 8; ++j) { const int d = d0 + j; const float q = (j & 1) ? bfhi(qw[j >> 1]) : bflo(qw[j >> 1]), k = (j & 1) ? bfhi(kw[j >> 1]) : bflo(kw[j >> 1]);
                const float cf = cum[t * 64 + d], cb = cum[4096 + t * 64 + d];
                qf[j] = q * __expf(cf); qb[j] = q * __expf(cb); kf[j] = k * __expf(-cf); kb[j] = k * __expf(-cb); }
            u32x4 o;
            o.x = cvt_pk(qf[0], qf[1]); o.y = cvt_pk(qf[2], qf[3]); o.z = cvt_pk(qf[4], qf[5]); o.w = cvt_pk(qf[6], qf[7]); *(LAS u32x4*)(lds + G3_AOP + t * GL_S192 + (64 + d0) * 2) = o;
            o.x = cvt_pk(qb[0], qb[1]); o.y = cvt_pk(qb[2], qb[3]); o.z = cvt_pk(qb[4], qb[5]); o.w = cvt_pk(qb[6], qb[7]); *(LAS u32x4*)(lds + G3_AOP + t * GL_S192 + (128 + d0) * 2) = o;
            o.x = cvt_pk(kf[0], kf[1]); o.y = cvt_pk(kf[2], kf[3]); o.z = cvt_pk(kf[4], kf[5]); o.w = cvt_pk(kf[6], kf[7]); *(LAS u32x4*)(lds + G3_KIF + t * GL_S64 + d0 * 2) = o;
            o.x = cvt_pk(kb[0], kb[1]); o.y = cvt_pk(kb[2], kb[3]); o.z = cvt_pk(kb[4], kb[5]); o.w = cvt_pk(kb[6], kb[7]); *(LAS u32x4*)(lds + G3_KIB + t * GL_S64 + d0 * 2) = o;
            const int v0 = (F.tid & 7) * 16;
            const u32x4 va = *(const u32x4*)(W.GV + (trow0 + t) * 512 + h * 128 + v0), vb = *(const u32x4*)(W.GV + (trow0 + t) * 512 + h * 128 + v0 + 8);
            const unsigned vw[8] = {va.x, va.y, va.z, va.w, vb.x, vb.y, vb.z, vb.w};
#pragma unroll
            for (int j = 0; j < 16; ++j) *(LAS bf16*)(lds + G3_BOP + (v0 + j) * GL_S192 + t * 2) = (bf16)((j & 1) ? (vw[j >> 1] >> 16) : (vw[j >> 1] & 0xffffu));
            const int dv = F.tid >> 2, dd0 = (F.tid & 3) * 16;
#pragma unroll
            for (int dir = 0; dir < 2; ++dir) { const bf16* sp = (const bf16*)W.KVT + ((size_t)u * 2 + dir) * 8192 + dv * 64 + dd0;
                const u32x4 o0 = *(const u32x4*)sp, o1 = *(const u32x4*)(sp + 8);
                *(LAS u32x4*)(lds + G3_BOP + dv * GL_S192 + (64 + 64 * dir + dd0) * 2) = o0; *(LAS u32x4*)(lds + G3_BOP + dv * GL_S192 + (64 + 64 * dir + dd0 + 8) * 2) = o1; }
        }
        __syncthreads();
        if (wid < 4) {
            const int it = wid >> 1, jt = wid & 1;
            f32x16 af = {}, ab = {};
#pragma unroll
            for (int s = 0; s < 4; ++s) { const int kb = (16 * s + 8 * hh) * 2;
                if (jt <= it) af = __builtin_amdgcn_mfma_f32_32x32x16_bf16(lds_frag(lds + G3_AOP, 32 * it + r32, GL_S192, 128 + kb), lds_frag(lds + G3_KIF, 32 * jt + r32, GL_S64, kb), af, 0, 0, 0);
                if (jt >= it) ab = __builtin_amdgcn_mfma_f32_32x32x16_bf16(lds_frag(lds + G3_AOP, 32 * it + r32, GL_S192, 256 + kb), lds_frag(lds + G3_KIB, 32 * jt + r32, GL_S64, kb), ab, 0, 0, 0); }
#pragma unroll
            for (int r = 0; r < 16; ++r) { const int i = 32 * it + crow(r, hh), j = 32 * jt + r32; const float v = (j <= i) ? af[r] : ab[r];
                *(LAS bf16*)(lds + G3_AOP + i * GL_S192 + j * 2) = (bf16)(cvt_pk(v, 0.f) & 0xffffu); }
        }
        __syncthreads();
        {
            const int it = wid >> 2, dt = wid & 3; f32x16 o = {};
#pragma unroll
            for (int s = 0; s < 12; ++s) { const int kb = (16 * s + 8 * hh) * 2;
                o = __builtin_amdgcn_mfma_f32_32x32x16_bf16(lds_frag(lds + G3_AOP, 32 * it + r32, GL_S192, kb), lds_frag(lds + G3_BOP, 32 * dt + r32, GL_S192, kb), o, 0, 0, 0); }
            LAS float* out = (LAS float*)(lds + GL_CUM);
#pragma unroll
            for (int r = 0; r < 16; ++r) out[(32 * it + crow(r, hh)) * 128 + 32 * dt + r32] = o[r];
        }
        __syncthreads();
        {
            const int t = F.tid >> 3, v0 = (F.tid & 7) * 16; const LAS float* orow = (const LAS float*)(lds + GL_CUM) + t * 128 + v0;
            float x[16]; float ss = 0.f;
#pragma unroll
            for (int j = 0; j < 16; ++j) { x[j] = orow[j]; ss += x[j] * x[j]; }
            ss += __shfl_xor(ss, 1); ss += __shfl_xor(ss, 2); ss += __shfl_xor(ss, 4);
            const float rs = rsqrtf(ss * (1.f / 128.f) + RMS_EPS);
            const u32x4 ga = *(const u32x4*)(W.SG + (trow0 + t) * 512 + h * 128 + v0), gb = *(const u32x4*)(W.SG + (trow0 + t) * 512 + h * 128 + v0 + 8);
            const unsigned gw[8] = {ga.x, ga.y, ga.z, ga.w, gb.x, gb.y, gb.z, gb.w};
            float y[16];
#pragma unroll
            for (int j = 0; j < 16; ++j) y[j] = x[j] * rs * gng[v0 + j] * ((j & 1) ? bfhi(gw[j >> 1]) : bflo(gw[j >> 1]));
            u32x4 o0, o1; o0.x = cvt_pk(y[0], y[1]); o0.y = cvt_pk(y[2], y[3]); o0.z = cvt_pk(y[4], y[5]); o0.w = cvt_pk(y[6], y[7]);
            o1.x = cvt_pk(y[8], y[9]); o1.y = cvt_pk(y[10], y[11]); o1.z = cvt_pk(y[12], y[13]); o1.w = cvt_pk(y[14], y[15]);
            bf16* dst = W.OAB + (trow0 + t) * 512 + h * 128 + v0; *(u32x4*)dst = o0; *(u32x4*)(dst + 8) = o1;
        }
        __syncthreads();
    }
}
__device__ __forceinline__ void phase_select(Frame& F, int l) {
    refresh(F);
    const WS W = ws_map(F.ws, F.nb); const float* const* IN_ = F.a->in; (void)IN_; (void)W;
    LAS int* lcnt = (LAS int*)F.lds; LAS int* lbase = lcnt + 32;
    const float* b_rg = IN_[19] + l * 4; const float* b_re = IN_[21] + l * 32;
    unsigned* gcnt = W.ctl + CW_CNT + l * 64;
    for (int t0 = F.bid * NTHR; t0 < F.T; t0 += F.G * NTHR) {
        if (F.tid < 32) lcnt[F.tid] = 0;
        __syncthreads();
        const int t = t0 + F.tid; int e0 = 0, e1 = 0, r0 = 0, r1 = 0; float g0 = 0.f, g1 = 0.f;
        if (t < F.T) {
            const float* lg = W.LOGITS + (size_t)t * 64;
            float gl[4]; { const f32x4 v = *(const f32x4*)lg; gl[0] = v[0] + b_rg[0]; gl[1] = v[1] + b_rg[1]; gl[2] = v[2] + b_rg[2]; gl[3] = v[3] + b_rg[3]; }
            int grp = 0; float mx = gl[0];
            if (gl[1] > mx) { mx = gl[1]; grp = 1; } if (gl[2] > mx) { mx = gl[2]; grp = 2; } if (gl[3] > mx) { mx = gl[3]; grp = 3; }
            const float p_grp = 1.f / (__expf(gl[0] - mx) + __expf(gl[1] - mx) + __expf(gl[2] - mx) + __expf(gl[3] - mx));
            const f32x4 ea = *(const f32x4*)(lg + 4 + grp * 8), eb = *(const f32x4*)(lg + 8 + grp * 8);
            const f32x4 ba = *(const f32x4*)(b_re + grp * 8), bb = *(const f32x4*)(b_re + grp * 8 + 4);
            float b0v = -1e30f, b1v = -1e30f; int i0 = 0, i1 = 0;
#pragma unroll
            for (int j = 0; j < 8; ++j) { const float e = (j < 4) ? ea[j] + ba[j] : eb[j - 4] + bb[j - 4];
                if (e > b0v) { b1v = b0v; i1 = i0; b0v = e; i0 = j; } else if (e > b1v) { b1v = e; i1 = j; } }
            const float p1 = __expf(b1v - b0v), s2 = 1.f + p1;
            e0 = grp * 8 + i0; e1 = grp * 8 + i1; g0 = p_grp / s2; g1 = p_grp * p1 / s2;
            r0 = __hip_atomic_fetch_add(lcnt + e0, 1, __ATOMIC_RELAXED, __HIP_MEMORY_SCOPE_WORKGROUP);
            r1 = __hip_atomic_fetch_add(lcnt + e1, 1, __ATOMIC_RELAXED, __HIP_MEMORY_SCOPE_WORKGROUP);
        }
        __syncthreads();
        if (F.tid < 32) lbase[F.tid] = (int)__hip_atomic_fetch_add(gcnt + F.tid, (unsigned)lcnt[F.tid], __ATOMIC_RELAXED, __HIP_MEMORY_SCOPE_AGENT);
        __syncthreads();
        if (t < F.T) { W.eid[t * 2] = e0; W.eid[t * 2 + 1] = e1; W.gate[t * 2] = g0; W.gate[t * 2 + 1] = g1; W.rank[t * 2] = lbase[e0] + r0; W.rank[t * 2 + 1] = lbase[e1] + r1; }
        __syncthreads();
    }
}
__device__ __forceinline__ void phase_gather(Frame& F, int l) {
    refresh(F);
    const WS W = ws_map(F.ws, F.nb); const float* const* IN_ = F.a->in; (void)IN_; (void)W;
    LAS int* seg = (LAS int*)F.lds; LAS int* cnt = seg + 40;
    const unsigned* gcnt = W.ctl + CW_CNT + l * 64;
    if (F.tid == 0) { int o = 0; for (int e = 0; e < 32; ++e) { const int c = (int)__hip_atomic_load(gcnt + e, __ATOMIC_RELAXED, __HIP_MEMORY_SCOPE_AGENT); seg[e] = o; cnt[e] = c; o += (c + 255) & ~255; } seg[32] = o; }
    __syncthreads();
    const int ntile = seg[32] >> 8;
    if (F.bid == 0) {
        for (int i = F.tid; i < ntile; i += NTHR) { int e = 0; while (e < 31 && (i << 8) >= seg[e + 1]) ++e; W.tilee[i] = e; }
        if (F.tid == 0) W.segp[0] = ntile;
    }
    for (int p = F.bid * NTHR + F.tid; p < (ntile << 8); p += F.G * NTHR) { int e = 0; while (e < 31 && p >= seg[e + 1]) ++e; if (p - seg[e] >= cnt[e]) W.stok[p] = 0; }
    for (int it = F.bid * NTHR + F.tid; it < F.T * 2; it += F.G * NTHR) {
        const int e = W.eid[it], p = seg[e] + W.rank[it];
        W.stok[p] = it >> 1; W.pos[it] = p; W.gsort[p] = W.gate[it];
    }
}

#ifndef MK_MASK
#define MK_MASK 0xffffffffu
#endif
#define EN(b) (((MK_MASK) >> (b)) & 1u)
#ifndef MK_DUP
#define MK_DUP 0u
#endif
#define REPS(b) ((((MK_DUP) >> (b)) & 1u) ? 2 : 1)
constexpr int NPL = 14, NPH = 2 + DEPTH * NPL;
__global__ void __launch_bounds__(NTHR, 2) mk_fwd(Args args) {
    extern __shared__ __attribute__((aligned(16))) unsigned char lds_raw[];
    Frame F;
    F.lds = (LAS unsigned char*)lds_raw; F.tid = threadIdx.x; F.lane = F.tid & 63; F.wave = __builtin_amdgcn_readfirstlane(F.tid >> 6);
    F.G = gridDim.x; F.bid = blockIdx.x; F.nb = args.nb; F.T = args.nb * SEQ; F.ws = args.ws; F.a = &args; F.xbuf = args.out;
    const float* const* IN_ = args.in;
    volatile LAS unsigned* misc = (volatile LAS unsigned*)(F.lds + LDS_MISC);
    if (F.tid < 64) misc[F.tid] = 0u;
    __syncthreads();
    XcdBarrier bar = xcd_barrier_post((unsigned*)args.ws + CW_BAR + args.li * XCD_BAR_WORDS, misc);
    const int lo = args.ph_lo, hi = args.ph_hi;
#define IN(k) (lo <= (k) && (k) < hi)
#ifdef MK_BAR2
#define SEAM(k) do { if (IN(k) && IN((k) + 1)) { xcd_barrier(bar); xcd_barrier(bar); } } while (0)
#else
#define SEAM(k) do { if (IN(k) && IN((k) + 1)) xcd_barrier(bar); } while (0)
#endif
    LAS unsigned char* gl = F.lds;
    if (EN(0) && IN(0)) { for (int rp = 0; rp < REPS(0); ++rp) { p0_prologue(F); __syncthreads(); } SEAM(0); }
    for (int l = 0; l < DEPTH; ++l) {
        const int pb = 1 + l * NPL;
        if (EN(1) && IN(pb + 0)) { for (int rp = 0; rp < ((l == 0) ? REPS(14) : 1); ++rp) phase_norm(F, l, 0); SEAM(pb + 0); }
        if (EN(2) && IN(pb + 1)) { const WS W = ws_map(F.ws, F.nb);
            pg8::Gemm g{W.H, W.win + (size_t)l * NIN * D, F.T, NIN, D}; pg8::StaticOrder S; S.init(F.T, NIN, F.G, F.bid);
            EpiIn E{W.GQ, W.GK, W.GV, W.SG, W.LGF, W.LGB, W.DQ, W.DK, W.DV, W.SGA, W.SGB, IN_[8] + l * 512, IN_[10] + l * 64, IN_[11] + l * 64};
#ifdef MK_DEPHASE
            { const int g_ = (F.bid >> 3) & 7; for (int k_ = 0; k_ < g_ * MK_DEPHASE; ++k_) __builtin_amdgcn_s_sleep(127); }
#endif
#ifdef MK_INPROJ_NULL
            { EpiNull EN_; pg8::gemm_phase<EpiNull, pg8::StaticOrder, true, true>(gl, g, S, EN_); }
#endif
            for (int rp = 0; rp < REPS(2); ++rp) pg8::gemm_phase<EpiIn, pg8::StaticOrder, true, true>(gl, g, S, E);
            SEAM(pb + 1);
        }
        if (EN(3) && IN(pb + 2)) { for (int rp = 0; rp < REPS(3); ++rp) phase_gla1(F); SEAM(pb + 2); }
        if (EN(4) && IN(pb + 3)) { phase_gla2(F); SEAM(pb + 3); }
        if (EN(5) && IN(pb + 4)) { for (int rp = 0; rp < REPS(5); ++rp) phase_gla3(F, l); __syncthreads(); }
        if (EN(6) && IN(pb + 5)) {
#ifdef MK_ATT_PROBE
            phase_attn<MK_ATT_PROBE>(F, l);
#endif
            phase_attn<0>(F, l); SEAM(pb + 5); }
        if (EN(7) && IN(pb + 6)) { const WS W = ws_map(F.ws, F.nb);
            pg8::Gemm g{W.OAB, W.wab + (size_t)l * D * D, 0, 0, 512}; MergeOrder S; S.so.init(F.T, D, F.G, F.bid); S.nM = F.T / 256;
            EpiMerge E{W.SGA, W.SGB, W.MERGED, F.T / 256};
            for (int rp = 0; rp < REPS(7); ++rp) pg8::gemm_phase<EpiMerge, MergeOrder, true, true>(gl, g, S, E);
            SEAM(pb + 6);
        }
        if (EN(8) && IN(pb + 7)) { const WS W = ws_map(F.ws, F.nb); const float* modl = W.mod + (size_t)l * NBMAX * 6 * D;
            pg8::Gemm g{W.MERGED, W.wo + (size_t)l * D * D, F.T, D, D}; pg8::StaticOrder S; S.init(F.T, D, F.G, F.bid);
            EpiResid E{l == 0 ? IN_[0] : nullptr, W.XB, modl + 2 * D};
            for (int rp = 0; rp < ((l == 0) ? REPS(8) : 1); ++rp) pg8::gemm_phase<EpiResid, pg8::StaticOrder, true, true>(gl, g, S, E);
            SEAM(pb + 7);
        }
        if (EN(1) && IN(pb + 8)) { for (int rp = 0; rp < REPS(1); ++rp) phase_norm(F, l, 1); SEAM(pb + 8); }
        if (EN(9) && IN(pb + 9)) { const WS W = ws_map(F.ws, F.nb);
            pg8::Gemm g{W.H, W.wr + (size_t)l * 256 * D, F.T, 256, D}; pg8::StaticOrder S; S.init(F.T, 256, F.G, F.bid);
            EpiLogits E{W.LOGITS};
            for (int rp = 0; rp < REPS(9); ++rp) pg8::gemm_phase<EpiLogits, pg8::StaticOrder, true, true>(gl, g, S, E);
            SEAM(pb + 9);
        }
        if (EN(10) && IN(pb + 10)) { phase_select(F, l); SEAM(pb + 10); }
        if (EN(11) && IN(pb + 11)) { for (int rp = 0; rp < REPS(11); ++rp) { phase_gather(F, l); __syncthreads(); } SEAM(pb + 11); }
        if (EN(12) && IN(pb + 12)) { const WS W = ws_map(F.ws, F.nb);
            const int ntile = W.segp[0];
#if MK_MOE_FP8
            pg8::Gemm g{W.XS, (const bf16*)((const unsigned char*)W.w1 + (size_t)l * NE * 1024 * D), 0, 0, D / 2}; GroupedOrder S{W.tilee, ntile * 4, F.G, F.bid};
            EpiAct E{(unsigned char*)W.ACT};
#else
            pg8::Gemm g{W.H, W.w1 + (size_t)l * NE * 1024 * D, 0, 0, D}; GroupedOrder S{W.tilee, ntile * 4, F.G, F.bid, W.stok};
            EpiAct E{W.ACT};
#endif
            for (int rp = 0; rp < REPS(12); ++rp) pg8::gemm_phase<EpiAct, GroupedOrder, true, true, true>(gl, g, S, E);
            SEAM(pb + 12);
        }
        if (EN(13) && IN(pb + 13)) { const WS W = ws_map(F.ws, F.nb);
            const int ntile = W.segp[0];
#if MK_MOE_FP8
            pg8::Gemm g{W.ACT, (const bf16*)((const unsigned char*)W.w2 + (size_t)l * NE * D * DE), 0, 0, DE / 2}; GroupedOrder S{W.tilee, ntile * 4, F.G, F.bid};
#else
            pg8::Gemm g{W.ACT, W.w2 + (size_t)l * NE * D * DE, 0, 0, DE}; GroupedOrder S{W.tilee, ntile * 4, F.G, F.bid, nullptr};
#endif
            EpiYs E{W.YS, W.gsort};
            for (int rp = 0; rp < REPS(13); ++rp) pg8::gemm_phase<EpiYs, GroupedOrder, true, true>(gl, g, S, E);
            SEAM(pb + 13);
        }
    }
    if (EN(1) && IN(NPH - 1)) phase_norm(F, 0, 2);
#undef IN
#undef SEAM
}

struct LaunchCfg { int grid; bool ok; };
inline LaunchCfg& launch_cfg() {
    static LaunchCfg c{0, false}; static bool init = false;
    if (!init) { init = true;
        int dev = 0, cus = 0, per_cu = 0;
        if (hipGetDevice(&dev) != hipSuccess || hipDeviceGetAttribute(&cus, hipDeviceAttributeMultiprocessorCount, dev) != hipSuccess) { fprintf(stderr, "mk: device query failed\n"); return c; }
        if (hipFuncSetAttribute((const void*)mk_fwd, hipFuncAttributeMaxDynamicSharedMemorySize, LDS_BYTES) != hipSuccess) { fprintf(stderr, "mk: hipFuncSetAttribute failed\n"); return c; }
        if (hipOccupancyMaxActiveBlocksPerMultiprocessor(&per_cu, (const void*)mk_fwd, NTHR, LDS_BYTES) != hipSuccess || per_cu < 1) { fprintf(stderr, "mk: occupancy query says %d blocks/CU\n", per_cu); (void)hipGetLastError(); return c; }
        c.grid = cus; c.ok = true;
    }
    return c;
}
inline void launch_range(void* const* d_in, float* xbuf, void* d_ws, int nb, int lo, int hi, int li, hipStream_t stream) {
    LaunchCfg& c = launch_cfg(); if (!c.ok) return;
    Args a{}; for (int i = 0; i < 24; ++i) a.in[i] = (const float*)d_in[i];
    a.out = xbuf; a.ws = (unsigned char*)d_ws; a.nb = nb; a.ph_lo = lo; a.ph_hi = hi; a.li = li;
    hipLaunchKernelGGL(mk_fwd, dim3(c.grid), dim3(NTHR), LDS_BYTES, stream, a);
    const hipError_t le = hipPeekAtLastError(); if (le != hipSuccess) fprintf(stderr, "mk: launch [%d,%d) failed: %s\n", lo, hi, hipGetErrorName(le));
}
}
extern "C" void kernel_launch(void* const* d_in, const int* in_sizes, int n_in, void* d_out, int out_size, void* d_ws, size_t ws_size, hipStream_t stream) {
    (void)in_sizes; (void)n_in; (void)out_size;
    static int checked = 0;
    if (!checked) { checked = 1; const mk::WS w = mk::ws_map((unsigned char*)d_ws, 4); if (w.end > ws_size) { fprintf(stderr, "mk: workspace too small: need %zu, have %zu\n", w.end, ws_size); checked = -1; } }
    if (checked < 0) return;
    if (hipMemsetAsync(d_ws, 0, mk::CTL_BYTES, stream) != hipSuccess) return;
    mk::launch_range(d_in, (float*)d_out, d_ws, 4, 0, mk::NPH, 0, stream);
}
```

```cpp
#include <hip/hip_runtime.h>
#include <cstdio>
#include <cstdint>
#include <cmath>
#define MK_ATT_FP8 1
namespace pg8 {
#define PG8_LAS __attribute__((address_space(3)))
typedef unsigned short bf16_t;
typedef short bf16x8 __attribute__((ext_vector_type(8)));
typedef float f32x4 __attribute__((ext_vector_type(4)));
typedef unsigned u32x4 __attribute__((ext_vector_type(4)));
constexpr int BM = 256, BK = 64, HALF = 128, HTB = HALF * BK * 2  , STAGE_BYTES = 8 * HTB, NXCD = 8, WGM = 8;

__host__ __device__ __forceinline__ int lds_byte(int r, int c) { const int st = (r >> 4) * 2 + (c >> 5), rr = r & 15, cc = c & 31, ob = rr * 64 + cc * 2; return st * 1024 + (ob ^ (((ob >> 9) & 1) << 5)); }
__host__ __device__ __forceinline__ void stage_rc(int b, int& R, int& C) { const int st = b / 1024, sb = b % 1024, swz = sb ^ (((sb >> 9) & 1) << 5); R = (st >> 1) * 16 + swz / 64; C = (st & 1) * 32 + (swz % 64) / 2; }
__host__ __device__ __forceinline__ int perm32(int rho) { const int n = rho >> 4, i = rho & 15; return 8 * (i >> 2) + 4 * n + (i & 3); }

struct Unit { int pm, pn; };
struct Gemm { const bf16_t* A; const bf16_t* Bt; int M, N, K; };

struct StaticOrder {
    int nM, nN, nwg, G, c;
    __host__ __device__ void init(int M, int N, int G_, int c_) { nM = M / BM; nN = N / BM; nwg = nM * nN; G = G_; c = c_; }
    __host__ __device__ bool next(int i, Unit& u) const {
        const long L = (long)i * G + c; if (L >= nwg) return false;
        int wgid = (int)L; { const int q = nwg / NXCD, r = nwg % NXCD, xcd = wgid % NXCD, off = wgid / NXCD; wgid = (xcd < r ? xcd * (q + 1) : r * (q + 1) + (xcd - r) * q) + off; }
        const int nig = WGM * nN, gid = wgid / nig, fm = gid * WGM, gsz = (nM - fm) < WGM ? (nM - fm) : WGM;
        u.pm = fm + ((wgid % nig) % gsz); u.pn = (wgid % nig) / gsz; return true;
    }
    __device__ __forceinline__ void a_ready(const Unit&) const {}
    __device__ __forceinline__ void done(const Unit&) const {}
};
__device__ __forceinline__ unsigned cvt_pk_bf16(float lo, float hi) { unsigned r; asm volatile("v_cvt_pk_bf16_f32 %0, %1, %2" : "=v"(r) : "v"(lo), "v"(hi)); return r; }
__device__ __forceinline__ const void* pg8_uniform(const void* p) { const unsigned long long v = (unsigned long long)p;
    const unsigned lo = (unsigned)__builtin_amdgcn_readfirstlane((int)(unsigned)v), hi = (unsigned)__builtin_amdgcn_readfirstlane((int)(unsigned)(v >> 32)); return (const void*)(((unsigned long long)hi << 32) | lo); }
__device__ __forceinline__ void pg8_glds(const void* sbase, unsigned voff, unsigned ldsdst) { unsigned keep;
    asm volatile("s_nop 4\n\ts_mov_b32 %0, m0\n\ts_mov_b32 m0, %3\n\ts_nop 0\n\tglobal_load_lds_dwordx4 %1, %2\n\ts_mov_b32 m0, %0" : "=&s"(keep) : "v"(voff), "s"(sbase), "s"(ldsdst) : "memory"); }
typedef int pg8_v8i __attribute__((ext_vector_type(8)));
typedef int pg8_v4i __attribute__((ext_vector_type(4)));
template <class Epi, class Sched, bool ALIGN_EPI = false, bool SP2 = false, bool GATHER = false>
__device__ __forceinline__ void gemm_phase(PG8_LAS unsigned char* lds, const Gemm g, const Sched& S, const Epi& E) {
    int tid_ = threadIdx.x; asm volatile("" : "+v"(tid_));
    const int tid = tid_, wid = __builtin_amdgcn_readfirstlane(tid >> 6), lane = tid & 63, wr = wid >> 2, wc = wid & 3, fr = lane & 15, fq = lane >> 4;
    const int K = g.K, nt = K / BK;
    unsigned voffA[2], voffB[2]; unsigned vc[2][2] = {}, vn[2][2] = {}, vs[2][2] = {}; (void)vc; (void)vn; (void)vs;
#pragma unroll
    for (int i = 0; i < 2; ++i) { int R, C; stage_rc(tid * 16 + i * 8192, R, C); const int Rb = Epi::PERM ? ((R & ~31) + perm32(R & 31)) : R;
        voffA[i] = (unsigned)(R * K + C) * 2u; voffB[i] = (unsigned)(Rb * K + C) * 2u; }
    const size_t kstep = (size_t)(BK * 2);
    const size_t hstep = (size_t)HALF * K * 2;
    const size_t tstep = 2 * hstep;
    const unsigned ldsw = (unsigned)wid * 1024u; const unsigned lds0 = (unsigned)(unsigned long)lds; (void)lds0;
    const int aoff = lds_byte(wr * 64 + fr, fq * 8), boff = lds_byte(wc * 32 + fr, fq * 8);
#define PG8_SA(b, h) (((b) * 2 + (h)) * HTB)
#define PG8_SB(b, h) ((4 + (b) * 2 + (h)) * HTB)
#if defined(PG8_ASM_STAGE) && PG8_ASM_STAGE
#define PG8_STAGE(bufoff, gbase, voff) do { const void* _gb = pg8_uniform(gbase); _Pragma("unroll") for (int _i = 0; _i < 2; ++_i) \
        pg8_glds(_gb, (voff)[_i], (unsigned)__builtin_amdgcn_readfirstlane((int)(lds0 + (unsigned)(bufoff) + ldsw + _i * 8192))); } while (0)
#else
#define PG8_STAGE(bufoff, gbase, voff) do { _Pragma("unroll") for (int _i = 0; _i < 2; ++_i) \
        __builtin_amdgcn_global_load_lds((const unsigned*)((const char*)(gbase) + (voff)[_i]), (PG8_LAS unsigned*)(lds + (bufoff) + ldsw + _i * 8192), 16, 0, 0); } while (0)
#endif
#define PG8_STAGE_A(b, h, X, VS) do { if constexpr (GATHER) { PG8_STAGE(PG8_SA(b, h), X, VS[h]); } else { PG8_STAGE(PG8_SA(b, h), (X) + (h) * hstep, voffA); } } while (0)
#define PG8_LOADROWS(u, v) do { _Pragma("unroll") for (int i_ = 0; i_ < 2; ++i_) { int R_, C_; stage_rc(tid * 16 + i_ * 8192, R_, C_); _Pragma("unroll") for (int h_ = 0; h_ < 2; ++h_) \
        v[h_][i_] = (unsigned)S.rowidx[(u).pm * 256 + h_ * 128 + R_] * (unsigned)(K * 2) + (unsigned)C_ * 2u; } } while (0)
#define PG8_LDA(dst, b, h) do { _Pragma("unroll") for (int m = 0; m < 4; ++m) _Pragma("unroll") for (int k = 0; k < 2; ++k) dst[m][k] = *(const PG8_LAS bf16x8*)(lds + PG8_SA(b, h) + aoff + m * 2048 + k * 1024); } while (0)
#define PG8_LDB(dst, b, h) do { _Pragma("unroll") for (int n = 0; n < 2; ++n) _Pragma("unroll") for (int k = 0; k < 2; ++k) dst[n][k] = *(const PG8_LAS bf16x8*)(lds + PG8_SB(b, h) + boff + n * 2048 + k * 1024); } while (0)
#define PG8_MMA(ai, bj, At, Bt) do { __builtin_amdgcn_s_setprio(1); _Pragma("unroll") for (int m = 0; m < 4; ++m) _Pragma("unroll") for (int n = 0; n < 2; ++n) _Pragma("unroll") for (int k = 0; k < 2; ++k) \
        acc[ai][bj][m][n] = __builtin_amdgcn_mfma_f32_16x16x32_bf16(Bt[n][k], At[m][k], acc[ai][bj][m][n], 0, 0, 0); __builtin_amdgcn_s_setprio(0); } while (0)
#define PG8_WAIT_V(n) asm volatile("s_waitcnt vmcnt(" #n ")" ::: "memory")
#define PG8_WAIT_L(n) asm volatile("s_waitcnt lgkmcnt(" #n ")" ::: "memory")
#define PG8_BAR __builtin_amdgcn_s_barrier()
#define PG8_SCHED __builtin_amdgcn_sched_barrier(0)
    Unit cur, nxt; int ui = 0;
    if (!S.next(0, cur)) return;
    f32x4 acc[2][2][4][2];
#pragma unroll
    for (int a = 0; a < 2; ++a)
#pragma unroll
        for (int b = 0; b < 2; ++b)
#pragma unroll
            for (int m = 0; m < 4; ++m)
#pragma unroll
                for (int n = 0; n < 2; ++n) acc[a][b][m][n] = (f32x4){0.f, 0.f, 0.f, 0.f};
    bf16x8 At[4][2], B0[2][2], B1[2][2];
    const char* cA = (const char*)g.A + (GATHER ? (size_t)0 : (size_t)cur.pm * tstep); const char* cB = (const char*)g.Bt + (size_t)cur.pn * tstep;
    S.a_ready(cur);
    if constexpr (GATHER) { PG8_LOADROWS(cur, vc); }
    if constexpr (SP2) {
        PG8_STAGE(PG8_SB(0, 0), cB, voffB); PG8_STAGE(PG8_SB(0, 1), cB + hstep, voffB); PG8_STAGE_A(0, 0, cA, vc); PG8_STAGE_A(0, 1, cA, vc);
        if (wr == 1) PG8_BAR;
        PG8_WAIT_V(2); PG8_BAR;
        PG8_STAGE(PG8_SB(1, 0), cB + kstep, voffB); PG8_STAGE_A(1, 0, cA + kstep, vc); PG8_STAGE(PG8_SB(1, 1), cB + hstep + kstep, voffB);
        PG8_WAIT_V(6); PG8_BAR;
    } else {
        PG8_STAGE(PG8_SB(0, 0), cB, voffB); PG8_STAGE_A(0, 0, cA, vc); PG8_STAGE(PG8_SB(0, 1), cB + hstep, voffB); PG8_STAGE_A(0, 1, cA, vc);
        if (wr == 1) PG8_BAR;
        PG8_WAIT_V(4); PG8_BAR;
        PG8_STAGE(PG8_SB(1, 0), cB + kstep, voffB); PG8_STAGE_A(1, 0, cA + kstep, vc); PG8_STAGE(PG8_SB(1, 1), cB + hstep + kstep, voffB);
        PG8_WAIT_V(6); PG8_BAR;
    }
    for (;;) {
        const bool has_next = S.next(ui + 1, nxt);
        const char* nA = (has_next && !GATHER) ? (const char*)g.A + (size_t)nxt.pm * tstep : cA; const char* nB = has_next ? (const char*)g.Bt + (size_t)nxt.pn * tstep : cB;
        for (int t = 0; t < nt; t += 2) {
            const bool last = (t == nt - 2);
            const char* a1 = cA + (size_t)(t + 1) * kstep;
            const char* a2 = last ? nA : cA + (size_t)(t + 2) * kstep; const char* b2 = last ? nB : cB + (size_t)(t + 2) * kstep;
            const char* a3 = a2 + kstep; const char* b3 = b2 + kstep;
            if (last && has_next) S.a_ready(nxt);
            if constexpr (GATHER) { if (last && has_next) { PG8_LOADROWS(nxt, vn); }
                _Pragma("unroll") for (int h_ = 0; h_ < 2; ++h_) _Pragma("unroll") for (int i_ = 0; i_ < 2; ++i_) vs[h_][i_] = (last && has_next) ? vn[h_][i_] : vc[h_][i_]; }
            if constexpr (Epi::MIDK) { if (t == nt / 2) E.mid(acc, cur, wr, wc, fr, fq); }
            if constexpr (SP2) {
            PG8_LDB(B0, 0, 0); PG8_LDB(B1, 0, 1); PG8_SCHED; PG8_LDA(At, 0, 0); PG8_STAGE_A(1, 1, a1, vc);
            PG8_WAIT_V(8); PG8_WAIT_L(0); PG8_BAR; PG8_MMA(0, 0, At, B0); PG8_MMA(0, 1, At, B1); PG8_BAR; PG8_SCHED;
            PG8_LDA(At, 0, 1); PG8_STAGE(PG8_SB(0, 0), b2, voffB); PG8_STAGE(PG8_SB(0, 1), b2 + hstep, voffB); PG8_STAGE_A(0, 0, a2, vs);
            PG8_WAIT_V(8); PG8_WAIT_L(0); PG8_BAR; PG8_MMA(1, 0, At, B0); PG8_MMA(1, 1, At, B1); PG8_BAR; PG8_SCHED;
            PG8_LDB(B0, 1, 0); PG8_LDB(B1, 1, 1); PG8_SCHED; PG8_LDA(At, 1, 0); PG8_STAGE_A(0, 1, a2, vs);
            PG8_WAIT_V(8); PG8_WAIT_L(0); PG8_BAR; PG8_MMA(0, 0, At, B0); PG8_MMA(0, 1, At, B1); PG8_BAR; PG8_SCHED;
            PG8_LDA(At, 1, 1); PG8_STAGE(PG8_SB(1, 0), b3, voffB); PG8_STAGE(PG8_SB(1, 1), b3 + hstep, voffB); PG8_STAGE_A(1, 0, a3, vs);
            PG8_WAIT_V(8); PG8_WAIT_L(0); PG8_BAR; PG8_MMA(1, 0, At, B0); PG8_MMA(1, 1, At, B1); PG8_BAR; PG8_SCHED;
            } else {
            PG8_LDB(B0, 0, 0); PG8_SCHED; PG8_LDA(At, 0, 0); PG8_STAGE_A(1, 1, a1, vc);
            PG8_WAIT_L(8); PG8_BAR; PG8_WAIT_L(0); PG8_MMA(0, 0, At, B0); PG8_BAR; PG8_SCHED;
            PG8_LDB(B1, 0, 1); PG8_STAGE(PG8_SB(0, 0), b2, voffB);
            PG8_BAR; PG8_WAIT_L(0); PG8_MMA(0, 1, At, B1); PG8_BAR;
            PG8_LDA(At, 0, 1); PG8_STAGE_A(0, 0, a2, vs);
            PG8_BAR; PG8_WAIT_L(0); PG8_MMA(1, 0, At, B0); PG8_BAR; PG8_SCHED;
            PG8_STAGE(PG8_SB(0, 1), b2 + hstep, voffB);
            PG8_WAIT_V(6); PG8_BAR; PG8_MMA(1, 1, At, B1); PG8_BAR;
            PG8_LDB(B0, 1, 0); PG8_SCHED; PG8_LDA(At, 1, 0); PG8_STAGE_A(0, 1, a2, vs);
            PG8_WAIT_L(8); PG8_BAR; PG8_WAIT_L(0); PG8_MMA(0, 0, At, B0); PG8_BAR; PG8_SCHED;
            PG8_LDB(B1, 1, 1); PG8_STAGE(PG8_SB(1, 0), b3, voffB);
            PG8_BAR; PG8_WAIT_L(0); PG8_MMA(0, 1, At, B1); PG8_BAR;
            PG8_LDA(At, 1, 1); PG8_STAGE_A(1, 0, a3, vs);
            PG8_BAR; PG8_WAIT_L(0); PG8_MMA(1, 0, At, B0); PG8_BAR; PG8_SCHED;
            PG8_STAGE(PG8_SB(1, 1), b3 + hstep, voffB);
            PG8_WAIT_V(6); PG8_BAR; PG8_MMA(1, 1, At, B1); PG8_BAR;
            }
        }
        if constexpr (ALIGN_EPI) { if (wr == 0) PG8_BAR; }
        if constexpr (!Epi::AFTER_DRAIN) { E(acc, cur, wr, wc, fr, fq); S.done(cur); }
        if (!has_next) break;
#pragma unroll
        for (int a = 0; a < 2; ++a)
#pragma unroll
            for (int b = 0; b < 2; ++b)
#pragma unroll
                for (int m = 0; m < 4; ++m)
#pragma unroll
                    for (int n = 0; n < 2; ++n) acc[a][b][m][n] = (f32x4){0.f, 0.f, 0.f, 0.f};
        cur = nxt; cA = nA; cB = nB; ++ui;
        if constexpr (GATHER) { _Pragma("unroll") for (int h_ = 0; h_ < 2; ++h_) _Pragma("unroll") for (int i_ = 0; i_ < 2; ++i_) vc[h_][i_] = vn[h_][i_]; }
        if constexpr (ALIGN_EPI) { if (wr == 1) PG8_BAR; }
    }
    PG8_WAIT_V(0);
    if constexpr (!ALIGN_EPI) { if (wr == 0) PG8_BAR; }
    PG8_BAR;
    if constexpr (Epi::AFTER_DRAIN) { E.fused(acc, cur, wr, wc, fr, fq, lds, wid, lane); S.done(cur); }
#undef PG8_SA
#undef PG8_SB
#undef PG8_STAGE
#undef PG8_STAGE_A
#undef PG8_LOADROWS
#undef PG8_LDA
#undef PG8_LDB
#undef PG8_MMA
#undef PG8_WAIT_V
#undef PG8_WAIT_L
#undef PG8_BAR
#undef PG8_SCHED
}
}
namespace mk {
constexpr int D = 1024, SEQ = 8192, NBMAX = 4, NH = 4, DIN = 5152, NE = 32, DE = 512, DEPTH = 2;
constexpr int NT_IN = 22, NIN = NT_IN * 256;
constexpr int NWAVES = 8, NTHR = 512;
#ifndef MK_MOE_FP8
#define MK_MOE_FP8 0
#endif
constexpr float WSCALE = 16.f, ASCALE = 4.f, YSCALE = 32.f;
constexpr float LOG2E = 1.4426950408889634f, QSCALE = 0.125f * LOG2E, RMS_EPS = 1e-6f;
constexpr int O_GQ = 0, O_GK = 256, O_GV = 512, O_GG = 1024, O_LRF = 1536, O_LRB = 1552, O_DQ = 1568, O_DK = 2080, O_DV = 2592, O_GA = 3104, O_GB = 4128;
typedef unsigned short bf16;
typedef unsigned u32x4 __attribute__((ext_vector_type(4)));
typedef unsigned u32x2 __attribute__((ext_vector_type(2)));
typedef float f32x4 __attribute__((ext_vector_type(4)));
typedef float f32x16 __attribute__((ext_vector_type(16)));
typedef short bf16x8 __attribute__((ext_vector_type(8)));
typedef short s16x4 __attribute__((ext_vector_type(4)));
#define LAS __attribute__((address_space(3)))
#define GAS __attribute__((address_space(1)))
#define LDS_WAIT() asm volatile("s_waitcnt lgkmcnt(0)" ::: "memory")
#define VM_WAIT() asm volatile("s_waitcnt vmcnt(0)" ::: "memory")

constexpr size_t MiB = 1u << 20;
constexpr size_t CTL_BYTES = 256 * 1024;
constexpr int CW_BAR = 4096;
constexpr int CW_CNT = 32768;
constexpr size_t OFF_MOD = 256 * 1024, OFF_TAB = 512 * 1024;
constexpr size_t OFF_WIN = 1 * MiB, SZ_WIN = (size_t)DEPTH * NIN * D * 2;
constexpr size_t OFF_WAB = OFF_WIN + SZ_WIN, SZ_WAB = (size_t)DEPTH * D * D * 2;
constexpr size_t OFF_WO = OFF_WAB + SZ_WAB, SZ_WO = SZ_WAB;
constexpr size_t OFF_WR = OFF_WO + SZ_WO, SZ_WR = (size_t)DEPTH * 256 * D * 2;
constexpr size_t OFF_W1 = OFF_WR + SZ_WR, SZ_W1 = (size_t)DEPTH * NE * 1024 * D * 2;
constexpr size_t OFF_W2 = OFF_W1 + SZ_W1, SZ_W2 = (size_t)DEPTH * NE * D * DE * 2;
constexpr size_t OFF_ACT = 225 * MiB;
static_assert(OFF_W2 + SZ_W2 <= OFF_ACT, "weights fit");
struct WS {
    unsigned* ctl; float* mod; float* tab;
    bf16 *win, *wab, *wo, *wr, *w1, *w2;
    bf16 *H, *OAB, *XB; int* eid; float* gate; int* rank; int* pos; int* tilee; int* segp;
    bf16 *GQ, *GK, *GV, *SG; bf16 *LGF, *LGB; bf16 *DQ, *DK, *DV, *SGA, *SGB; float* KVT; float* DEC; bf16* MERGED;
    bf16 *XS, *ACT, *YS; float* LOGITS; float* gsort; int* stok;
    size_t end;
};
__host__ __device__ inline WS ws_map(unsigned char* b, int nb) {
    WS w; const size_t T = (size_t)nb * SEQ;
    w.ctl = (unsigned*)b; w.mod = (float*)(b + OFF_MOD); w.tab = (float*)(b + OFF_TAB);
    w.win = (bf16*)(b + OFF_WIN); w.wab = (bf16*)(b + OFF_WAB); w.wo = (bf16*)(b + OFF_WO); w.wr = (bf16*)(b + OFF_WR); w.w1 = (bf16*)(b + OFF_W1); w.w2 = (bf16*)(b + OFF_W2);
    size_t o = OFF_ACT;
    auto take = [&](size_t bytes) { unsigned char* p = b + o; o += (bytes + 255) & ~(size_t)255; return p; };
    w.H = (bf16*)take(T * 2048); w.OAB = (bf16*)take(T * 2048); w.XB = (bf16*)take(T * 2048);
    w.eid = (int*)take(T * 8); w.gate = (float*)take(T * 8); w.rank = (int*)take(T * 8); w.pos = (int*)take(T * 8); w.tilee = (int*)take(4096); w.segp = (int*)take(1024);
    const size_t u0 = o;
    w.GQ = (bf16*)take(T * 512); w.GK = (bf16*)take(T * 512); w.GV = (bf16*)take(T * 1024); w.SG = (bf16*)take(T * 1024);
    w.LGF = (bf16*)take(T * 512); w.LGB = (bf16*)take(T * 512);
    w.DQ = (bf16*)take(T * 1024); w.DK = (bf16*)take(T * 1024); w.DV = (bf16*)take(T * 1024); w.SGA = (bf16*)take(T * 2048); w.SGB = (bf16*)take(T * 2048);
    w.KVT = (float*)take(T * 4096); w.MERGED = (bf16*)w.KVT; w.DEC = (float*)take(T * 32);
    const size_t e1 = o; o = u0;
    const size_t R = 2 * T + 32 * 256;
    w.XS = (bf16*)take(R * 2048); w.ACT = (bf16*)take(R * 1024); w.YS = (bf16*)take(R * 2048); w.LOGITS = (float*)take(T * 256); w.gsort = (float*)take(R * 4); w.stok = (int*)take(R * 4);
    w.end = o > e1 ? o : e1;
    return w;
}

__device__ __forceinline__ unsigned cvt_pk(float lo, float hi) { unsigned r; asm volatile("v_cvt_pk_bf16_f32 %0, %1, %2" : "=v"(r) : "v"(lo), "v"(hi)); return r; }
__device__ __forceinline__ float bf2f(unsigned short b) { return __uint_as_float(((unsigned)b) << 16); }
__device__ __forceinline__ float bflo(unsigned w) { return __uint_as_float(w << 16); }
__device__ __forceinline__ float bfhi(unsigned w) { return __uint_as_float(w & 0xffff0000u); }
__device__ __forceinline__ float fsigmoid(float x) { return __builtin_amdgcn_rcpf(1.f + __expf(-x)); }
__device__ __forceinline__ float fsilu(float x) { return x * fsigmoid(x); }
__device__ __forceinline__ float wave_sum(float v) {
#pragma unroll
    for (int o = 1; o < 64; o <<= 1) v += __shfl_xor(v, o);
    return v;
}
__device__ __forceinline__ int t5_bucket(int rel) {
    int ret = rel > 0 ? 16 : 0; int n = rel < 0 ? -rel : rel;
    if (n < 8) return ret + n;
    return ret + 8 + (n >= 12) + (n >= 16) + (n >= 23) + (n >= 32) + (n >= 46) + (n >= 64) + (n >= 91);
}

#define XB_TMO      128
#define XB_XCNT(j)  (256  + 64 * (j))
#define XB_XSUB(j)  (1280 + 64 * (j))
#define XB_XGEN(j)  (2304 + 64 * (j))
#define XB_TOP      3328
#define XB_TOPGEN   3392
#define XCD_BAR_WORDS 3456
#define XB_SPIN_CAP (1u << 18)
__device__ __forceinline__ unsigned xb_ld(unsigned* p)              { return __hip_atomic_load(p, __ATOMIC_RELAXED, __HIP_MEMORY_SCOPE_AGENT); }
__device__ __forceinline__ unsigned xb_add(unsigned* p, unsigned v) { return __hip_atomic_fetch_add(p, v, __ATOMIC_RELAXED, __HIP_MEMORY_SCOPE_AGENT); }
__device__ __forceinline__ unsigned xb_xcc_id() { return (unsigned)__builtin_amdgcn_s_getreg((3 << 11) | 20) & 0xFu; }
#define XB_SPIN(cond, bar) do { unsigned _sp = 0; while (cond) { __builtin_amdgcn_s_sleep(1); \
    if ((++_sp & 255u) == 0u) { if (xb_ld(&(bar)[XB_TMO])) break; if (_sp > XB_SPIN_CAP) { atomicAdd(&(bar)[XB_TMO], 1u); break; } } } } while (0)
struct XcdBarrier { unsigned* bar; unsigned x; volatile LAS unsigned* st; };
__device__ __forceinline__ XcdBarrier xcd_barrier_post(unsigned* bar, volatile LAS unsigned* st) {
    XcdBarrier b; b.bar = bar; b.x = xb_xcc_id(); b.st = st;
    if (threadIdx.x == 0) (void)xb_add(&bar[XB_XCNT(b.x)], 1u);
    return b;
}
__device__ __forceinline__ void xcd_barrier_complete(unsigned* bar, unsigned x, unsigned& nloc, unsigned& nx) {
    const unsigned G = gridDim.x * gridDim.y * gridDim.z;
    unsigned sum, cnt, mine, sp = 0u;
    for (;;) {
        sum = 0u; cnt = 0u; mine = 0u;
#pragma unroll
        for (unsigned j = 0; j < 16; ++j) { const unsigned c = xb_ld(&bar[XB_XCNT(j)]); sum += c; cnt += (c > 0u) ? 1u : 0u; mine = (j == x) ? c : mine; }
        if (sum == G) break;
        __builtin_amdgcn_s_sleep(1);
        if ((++sp & 255u) == 0u) { if (xb_ld(&bar[XB_TMO])) break; if (sp > XB_SPIN_CAP) { atomicAdd(&bar[XB_TMO], 1u); break; } }
    }
    nloc = mine > 0u ? mine : 1u; nx = cnt > 0u ? cnt : 1u;
}
__device__ __forceinline__ void xcd_barrier(const XcdBarrier& b) {
    asm volatile("s_waitcnt vmcnt(0)" ::: "memory");
    __syncthreads();
    if (threadIdx.x == 0) {
        unsigned* bar = b.bar;
        __builtin_amdgcn_s_waitcnt(0);
        unsigned nloc = b.st[0], nx = b.st[1];
        if (nloc == 0u) { xcd_barrier_complete(bar, b.x, nloc, nx); b.st[0] = nloc; b.st[1] = nx; }
        const unsigned old = xb_add(&bar[XB_XSUB(b.x)], 1u);
        const unsigned gen = old / nloc;
        if (old + 1u == (gen + 1u) * nloc) {
            __builtin_amdgcn_fence(__ATOMIC_RELEASE, "agent");
            asm volatile("s_waitcnt vmcnt(0)" ::: "memory");
            const unsigned og = xb_add(&bar[XB_TOP], 1u);
            const unsigned tg = og / nx;
            if (og + 1u == (tg + 1u) * nx) xb_add(&bar[XB_TOPGEN], 1u);
            else XB_SPIN(xb_ld(&bar[XB_TOPGEN]) == tg, bar);
            __builtin_amdgcn_fence(__ATOMIC_ACQUIRE, "agent");
            xb_add(&bar[XB_XGEN(b.x)], 1u);
            asm volatile("s_waitcnt vmcnt(0)" ::: "memory");
        } else {
            XB_SPIN(xb_ld(&bar[XB_XGEN(b.x)]) == gen, bar);
            __builtin_amdgcn_fence(__ATOMIC_ACQUIRE, "agent");
            asm volatile("s_waitcnt vmcnt(0)" ::: "memory");
        }
    }
    __syncthreads();
}

struct Args { const float* in[24]; float* out; unsigned char* ws; int nb, ph_lo, ph_hi, li; };
struct Frame {
    LAS unsigned char* lds; int tid, lane, wave, G, bid, nb, T; unsigned char* ws; const Args* a; float* xbuf;
};
__device__ __forceinline__ void refresh(Frame& F) { int t = threadIdx.x; asm volatile("" : "+v"(t)); F.tid = t; F.lane = t & 63; F.wave = __builtin_amdgcn_readfirstlane(t >> 6); }
constexpr int LDS_BYTES = 160 * 1024 - 64 * 0;
constexpr int LDS_MISC = 160 * 1024 - 256;

__device__ __forceinline__ void tr_item(const float* src, int lds_, int ks0, int c0, bf16* dst, int ldd, int r0, int kd0, LAS float* scr, int lane) {
#pragma unroll 8
    for (int i = 0; i < 32; ++i) { const int kk = 2 * i + (lane >> 5); scr[kk * 33 + (lane & 31)] = src[(size_t)(ks0 + kk) * lds_ + c0 + (lane & 31)]; }
    LDS_WAIT(); asm volatile("" ::: "memory");
    const int c = lane & 7;
#pragma unroll
    for (int j = 0; j < 4; ++j) { const int n = (lane >> 3) + 8 * j; const LAS float* s = scr + (8 * c) * 33 + n;
        u32x4 o; o.x = cvt_pk(s[0 * 33], s[1 * 33]); o.y = cvt_pk(s[2 * 33], s[3 * 33]); o.z = cvt_pk(s[4 * 33], s[5 * 33]); o.w = cvt_pk(s[6 * 33], s[7 * 33]);
        *(u32x4*)(dst + (size_t)(r0 + n) * ldd + kd0 + 8 * c) = o; }
    LDS_WAIT(); asm volatile("" ::: "memory");
}
__device__ __forceinline__ void tr_item8(const float* src, int lds_, int ks0, int c0, unsigned char* dst, int ldd, int r0, int kd0, float scale, LAS float* scr, int lane) {
#pragma unroll 8
    for (int i = 0; i < 32; ++i) { const int kk = 2 * i + (lane >> 5); scr[kk * 33 + (lane & 31)] = src[(size_t)(ks0 + kk) * lds_ + c0 + (lane & 31)] * scale; }
    LDS_WAIT(); asm volatile("" ::: "memory");
    const int c = lane & 7;
#pragma unroll
    for (int j = 0; j < 4; ++j) { const int n = (lane >> 3) + 8 * j; const LAS float* s = scr + (8 * c) * 33 + n;
        int w0 = 0, w1 = 0;
        w0 = __builtin_amdgcn_cvt_pk_fp8_f32(s[0 * 33], s[1 * 33], w0, false); w0 = __builtin_amdgcn_cvt_pk_fp8_f32(s[2 * 33], s[3 * 33], w0, true);
        w1 = __builtin_amdgcn_cvt_pk_fp8_f32(s[4 * 33], s[5 * 33], w1, false); w1 = __builtin_amdgcn_cvt_pk_fp8_f32(s[6 * 33], s[7 * 33], w1, true);
        u32x2 o; o.x = (unsigned)w0; o.y = (unsigned)w1;
        *(u32x2*)(dst + (size_t)(r0 + n) * ldd + kd0 + 8 * c) = o; }
    LDS_WAIT(); asm volatile("" ::: "memory");
}
__device__ __forceinline__ int win_src_col(int tile, int p0) {
    const int bj = p0 >> 7, wc = (p0 >> 5) & 3; const int L = 64 * wc + 32 * bj;
    switch (tile) {
        case 0: return O_GQ + p0; case 1: return O_GK + p0;
        case 2: case 3: return O_GV + (tile - 2) * 256 + p0;
        case 4: case 5: return O_GG + (tile - 4) * 256 + p0;
        case 8: case 9: return O_DQ + (tile - 8) * 256 + L;
        case 10: case 11: return O_DK + (tile - 10) * 256 + L;
        case 12: case 13: return O_DV + (tile - 12) * 256 + p0;
        case 14: case 15: case 16: case 17: return O_GA + (tile - 14) * 256 + p0;
        default: return O_GB + (tile - 18) * 256 + p0;
    }
}
__device__ __forceinline__ void p0_prologue(Frame& F) {
    refresh(F);
    const WS W = ws_map(F.ws, F.nb); const float* const* IN_ = F.a->in;
    const float* c_in = IN_[1]; const float* w_ada = IN_[2]; const float* b_ada = IN_[3];
    {
        LAS float* red = (LAS float*)F.lds;
        for (int it = F.bid; it < DEPTH * 96; it += F.G) {
            const int l = it / 96, j = (it % 96) * 64 + F.lane;
            const float* w = w_ada + (size_t)l * D * 6 * D + j;
            float a0 = 0.f, a1 = 0.f, a2 = 0.f, a3 = 0.f;
            const int kbeg = F.wave * 128;
#pragma unroll 16
            for (int k = kbeg; k < kbeg + 128; ++k) { const float wv = w[(size_t)k * 6 * D];
                const float c0 = c_in[k], c1 = c_in[D + k], c2 = c_in[2 * D + k], c3 = c_in[3 * D + k];
                a0 += fsilu(c0) * wv; a1 += fsilu(c1) * wv; a2 += fsilu(c2) * wv; a3 += fsilu(c3) * wv; }
            red[(F.wave * 4 + 0) * 64 + F.lane] = a0; red[(F.wave * 4 + 1) * 64 + F.lane] = a1; red[(F.wave * 4 + 2) * 64 + F.lane] = a2; red[(F.wave * 4 + 3) * 64 + F.lane] = a3;
            __syncthreads();
            if (F.tid < 256) { const int b = F.tid >> 6, jj = F.tid & 63; float s = 0.f;
#pragma unroll
                for (int wv = 0; wv < 8; ++wv) s += red[(wv * 4 + b) * 64 + jj];
                const int jc = (it % 96) * 64 + jj;
                W.mod[((size_t)l * NBMAX + b) * 6 * D + jc] = s + b_ada[l * 6 * D + jc]; }
            __syncthreads();
        }
    }
    if (F.bid == 0) {
        const float* rb = IN_[14];
        for (int i = F.tid; i < 1024; i += NTHR) { const int h = i >> 8, rel = (i & 255) - 128; W.tab[i] = (rb[t5_bucket(rel) * 4 + h] - rb[31 * 4 + h]) * LOG2E; }
        if (F.tid < 4) W.tab[1024 + F.tid] = __expf(rb[15 * 4 + F.tid] - rb[31 * 4 + F.tid]);
        if (F.tid >= 64 && F.tid < 64 + DEPTH) { const int l = F.tid - 64; const float* lv = IN_[12] + l * 256; float s1 = 0.f, s2 = 0.f;
            for (int i = 0; i < 64; ++i) { s1 += lv[i] * lv[64 + i]; s2 += lv[128 + i] * lv[192 + i]; }
            W.tab[1032 + l] = expf(s1) - expf(s2) + (0.8f - 0.6f * expf(-0.3f * (float)l)); }
    }
    __syncthreads();
    LAS float* scr = (LAS float*)(F.lds + F.wave * 16384);
    const int gw = F.bid * NWAVES + F.wave, NGW = F.G * NWAVES;
    constexpr int I_IN = (NIN / 32) * 16, I_AB = 32 * 16, I_O = 32 * 16, I_1 = NE * 32 * 16, I_2 = NE * 32 * 8;
    constexpr int PER_L = I_IN + I_AB + I_O + I_1 + I_2;
    for (int it = gw; it < DEPTH * PER_L; it += NGW) {
        const int l = it / PER_L; int r = it % PER_L;
        if (r < I_IN) { const int rb = r / 16, kb = r % 16, R = rb * 32, tile = R >> 8, p0 = R & 255;
            if (tile == 6 || tile == 7) continue;
            tr_item(IN_[6] + (size_t)l * D * DIN, DIN, kb * 64, win_src_col(tile, p0), W.win + (size_t)l * NIN * D, D, R, kb * 64, scr, F.lane); continue; }
        r -= I_IN;
        if (r < I_AB) { const int rb = r / 16, kb = r % 16;
            if (kb < 8) tr_item(IN_[15] + (size_t)l * 512 * D, D, kb * 64, rb * 32, W.wab + (size_t)l * D * D, 512, rb * 32, kb * 64, scr, F.lane);
            else tr_item(IN_[16] + (size_t)l * 512 * D, D, (kb - 8) * 64, rb * 32, W.wab + (size_t)l * D * D + (size_t)1024 * 512, 512, rb * 32, (kb - 8) * 64, scr, F.lane);
            continue; }
        r -= I_AB;
        if (r < I_O) { const int rb = r / 16, kb = r % 16; tr_item(IN_[17] + (size_t)l * D * D, D, kb * 64, rb * 32, W.wo + (size_t)l * D * D, D, rb * 32, kb * 64, scr, F.lane); continue; }
        r -= I_O;
        if (r < I_1) { const int e = r / 512, q = r % 512, rb = q / 16, kb = q % 16, R = rb * 32, pn = R >> 8, p = R & 255;
            const int col = (p < 128) ? (128 * pn + p) : (512 + 128 * pn + p - 128);
#if MK_MOE_FP8
            tr_item8(IN_[22] + ((size_t)l * NE + e) * D * 1024, 1024, kb * 64, col, (unsigned char*)W.w1 + ((size_t)l * NE + e) * 1024 * D, D, R, kb * 64, WSCALE, scr, F.lane); continue; }
#else
            tr_item(IN_[22] + ((size_t)l * NE + e) * D * 1024, 1024, kb * 64, col, W.w1 + ((size_t)l * NE + e) * 1024 * D, D, R, kb * 64, scr, F.lane); continue; }
#endif
        r -= I_1;
        { const int e = r / 256, q = r % 256, rb = q / 8, kb = q % 8;
#if MK_MOE_FP8
          tr_item8(IN_[23] + ((size_t)l * NE + e) * DE * D, D, kb * 64, rb * 32, (unsigned char*)W.w2 + ((size_t)l * NE + e) * D * DE, DE, rb * 32, kb * 64, WSCALE, scr, F.lane); }
#else
          tr_item(IN_[23] + ((size_t)l * NE + e) * DE * D, D, kb * 64, rb * 32, W.w2 + ((size_t)l * NE + e) * D * DE, DE, rb * 32, kb * 64, scr, F.lane); }
#endif
    }
    for (int it = gw; it < DEPTH * 2 * 8 * 16; it += NGW) {
        const int l = it >> 8, dir = (it >> 7) & 1, nbk = (it >> 4) & 7, kb = it & 15; const int k = kb * 64 + F.lane;
        const float* wi = IN_[6] + (size_t)l * D * DIN + (size_t)k * DIN + (dir ? O_LRB : O_LRF);
        float wv[16];
#pragma unroll
        for (int r = 0; r < 16; ++r) wv[r] = wi[r];
        const float* wu = IN_[7] + ((size_t)l * 2 + dir) * 16 * 256;
        bf16* dst = W.win + (size_t)l * NIN * D + (size_t)((6 + dir) * 256) * D;
        for (int n = nbk * 32; n < nbk * 32 + 32; ++n) { float s = 0.f;
#pragma unroll
            for (int r = 0; r < 16; ++r) s += wv[r] * wu[r * 256 + n];
            dst[(size_t)n * D + k] = (bf16)(cvt_pk(s, 0.f) & 0xffffu); }
    }
    for (int it = gw * 64 + F.lane; it < DEPTH * 256 * 128; it += NGW * 64) {
        const int l = it / (256 * 128), q = it % (256 * 128), row = q >> 7, k0 = (q & 127) * 8;
        float v[8];
#pragma unroll
        for (int i = 0; i < 8; ++i) { float x = 0.f;
            if (row < 4) x = IN_[18][((size_t)l * D + k0 + i) * 4 + row]; else if (row < 36) x = IN_[20][((size_t)l * D + k0 + i) * 32 + row - 4];
            v[i] = x; }
        u32x4 o; o.x = cvt_pk(v[0], v[1]); o.y = cvt_pk(v[2], v[3]); o.z = cvt_pk(v[4], v[5]); o.w = cvt_pk(v[6], v[7]);
        *(u32x4*)(W.wr + ((size_t)l * 256 + row) * D + k0) = o;
    }
}

__device__ __forceinline__ void phase_norm(Frame& F, int l, int mode) {
    refresh(F);
    const WS W = ws_map(F.ws, F.nb); const float* const* IN_ = F.a->in;
    const int gw = F.bid * NWAVES + F.wave, NGW = F.G * NWAVES;
    const bool combine = (mode == 2) || (mode == 0 && l > 0);
    const bool from_in = (mode == 0 && l == 0);
    const int lp = (mode == 2) ? DEPTH - 1 : l - 1;
    const float* ng = (mode == 1 ? IN_[5] : IN_[4]) + (size_t)(mode == 2 ? 0 : l) * D;
    for (int t = gw; t < F.T; t += NGW) {
        const int b = t / SEQ;
        f32x4 v[4];
        if (from_in) { const GAS f32x4* xr = (const GAS f32x4*)(IN_[0] + (size_t)t * D) + F.lane;
#pragma unroll
            for (int j = 0; j < 4; ++j) v[j] = xr[64 * j]; }
        else { const GAS u32x2* xr = (const GAS u32x2*)(W.XB + (size_t)t * D) + F.lane;
#pragma unroll
            for (int j = 0; j < 4; ++j) { const u32x2 a = xr[64 * j]; v[j] = (f32x4){bflo(a.x), bfhi(a.x), bflo(a.y), bfhi(a.y)}; } }
        if (combine) {
            const float* g2 = W.mod + ((size_t)lp * NBMAX + b) * 6 * D + 5 * D;
            const int p0 = W.pos[t * 2], p1 = W.pos[t * 2 + 1];
            const GAS unsigned* y0 = (const GAS unsigned*)((const unsigned char*)W.YS + (size_t)p0 * D) + F.lane; const GAS unsigned* y1 = (const GAS unsigned*)((const unsigned char*)W.YS + (size_t)p1 * D) + F.lane;
#pragma unroll
            for (int j = 0; j < 4; ++j) { const unsigned a = y0[64 * j], c = y1[64 * j]; const f32x4 g = *((const GAS f32x4*)g2 + F.lane + 64 * j) * (1.f / YSCALE);
                v[j].x += g.x * (__builtin_amdgcn_cvt_f32_fp8((int)a, 0) + __builtin_amdgcn_cvt_f32_fp8((int)c, 0)); v[j].y += g.y * (__builtin_amdgcn_cvt_f32_fp8((int)a, 1) + __builtin_amdgcn_cvt_f32_fp8((int)c, 1));
                v[j].z += g.z * (__builtin_amdgcn_cvt_f32_fp8((int)a, 2) + __builtin_amdgcn_cvt_f32_fp8((int)c, 2)); v[j].w += g.w * (__builtin_amdgcn_cvt_f32_fp8((int)a, 3) + __builtin_amdgcn_cvt_f32_fp8((int)c, 3)); }
            if (mode == 2) { GAS f32x4* xo = (GAS f32x4*)(F.xbuf + (size_t)t * D) + F.lane;
#pragma unroll
                for (int j = 0; j < 4; ++j) xo[64 * j] = v[j]; }
            else { GAS u32x2* xo = (GAS u32x2*)(W.XB + (size_t)t * D) + F.lane;
#pragma unroll
                for (int j = 0; j < 4; ++j) { u32x2 o; o.x = cvt_pk(v[j].x, v[j].y); o.y = cvt_pk(v[j].z, v[j].w); xo[64 * j] = o; } }
        }
        if (mode == 2) continue;
        float ss = 0.f;
#pragma unroll
        for (int j = 0; j < 4; ++j) ss += (v[j].x * v[j].x + v[j].y * v[j].y) + (v[j].z * v[j].z + v[j].w * v[j].w);
        const float rstd = rsqrtf(wave_sum(ss) * (1.f / D) + RMS_EPS);
        const float* md = W.mod + ((size_t)l * NBMAX + b) * 6 * D + (mode == 1 ? 3 * D : 0);
        GAS u32x2* ho = (GAS u32x2*)(W.H + (size_t)t * D) + F.lane;
#pragma unroll
        for (int j = 0; j < 4; ++j) { const f32x4 g = *((const GAS f32x4*)ng + F.lane + 64 * j), sh = *((const GAS f32x4*)md + F.lane + 64 * j), sc = *((const GAS f32x4*)(md + D) + F.lane + 64 * j);
            const float h0 = v[j].x * rstd * g.x * (1.f + sc.x) + sh.x, h1 = v[j].y * rstd * g.y * (1.f + sc.y) + sh.y, h2 = v[j].z * rstd * g.z * (1.f + sc.z) + sh.z, h3 = v[j].w * rstd * g.w * (1.f + sc.w) + sh.w;
            u32x2 o; o.x = cvt_pk(h0, h1); o.y = cvt_pk(h2, h3); ho[64 * j] = o; }
    }
}
typedef pg8::Unit Unit;
__device__ __forceinline__ u32x4 pack8(const f32x4& a, const f32x4& b) { u32x4 w; w.x = cvt_pk(a[0], a[1]); w.y = cvt_pk(a[2], a[3]); w.z = cvt_pk(b[0], b[1]); w.w = cvt_pk(b[2], b[3]); return w; }

#ifndef MK_ATT_FP8
#define MK_ATT_FP8 1
#endif
__device__ __forceinline__ u32x2 pack8_fp8(const f32x4& a, const f32x4& b) { int w0 = 0, w1 = 0;
    w0 = __builtin_amdgcn_cvt_pk_fp8_f32(a[0], a[1], w0, false); w0 = __builtin_amdgcn_cvt_pk_fp8_f32(a[2], a[3], w0, true);
    w1 = __builtin_amdgcn_cvt_pk_fp8_f32(b[0], b[1], w1, false); w1 = __builtin_amdgcn_cvt_pk_fp8_f32(b[2], b[3], w1, true);
    u32x2 r; r.x = (unsigned)w0; r.y = (unsigned)w1; return r; }
struct EpiNull {
    static constexpr bool PERM = true, AFTER_DRAIN = false, MIDK = false;
    __device__ __forceinline__ void operator()(const f32x4 (&acc)[2][2][4][2], const Unit&, int, int, int, int) const {
#pragma unroll
        for (int a = 0; a < 2; ++a)
#pragma unroll
            for (int b = 0; b < 2; ++b)
#pragma unroll
                for (int m = 0; m < 4; ++m) { asm volatile("" :: "v"(acc[a][b][m][0]), "v"(acc[a][b][m][1])); } }
};
struct EpiIn {
    static constexpr bool PERM = true, AFTER_DRAIN = false, MIDK = false;
    bf16 *GQ, *GK, *GV, *SG, *LGF, *LGB, *DQ, *DK, *DV, *SGA, *SGB; const float* b_up; const float* qg; const float* kg;
    __device__ __forceinline__ void operator()(const f32x4 (&acc)[2][2][4][2], const Unit& u, int wr, int wc, int fr, int fq) const {
        const int pn = u.pn; const int row0 = u.pm * 256 + wr * 64 + fr;
        if (pn >= 8 && pn <= 11) {
            const bool isk = pn >= 10; const int head = 2 * ((pn - 8) & 1) + (wc >> 1), c = wc & 1;
            const float* gv = isk ? kg : qg; const float sc = isk ? 1.f : QSCALE;
            f32x4 g[2][2];
#pragma unroll
            for (int bj = 0; bj < 2; ++bj)
#pragma unroll
                for (int n = 0; n < 2; ++n) g[bj][n] = *(const f32x4*)(gv + 32 * bj + 8 * fq + 4 * n);
#pragma unroll
            for (int ai = 0; ai < 2; ++ai)
#pragma unroll
                for (int m = 0; m < 4; ++m) {
                    const int r = row0 + ai * 128 + m * 16, b = r / SEQ, s = r % SEQ;
                    float ss = 0.f;
#pragma unroll
                    for (int bj = 0; bj < 2; ++bj)
#pragma unroll
                        for (int n = 0; n < 2; ++n) { const f32x4 x = acc[ai][bj][m][n]; ss += (x[0] * x[0] + x[1] * x[1]) + (x[2] * x[2] + x[3] * x[3]); }
                    ss += __shfl_xor(ss, 16); ss += __shfl_xor(ss, 32);
                    const float rs = rsqrtf(ss * (1.f / 64.f) + RMS_EPS) * sc;
#if MK_ATT_FP8
                    unsigned char* dst8 = (unsigned char*)(isk ? DK : DQ) + ((((size_t)b * NH + head) * 2 + c) * SEQ + s) * 64;
#pragma unroll
                    for (int bj = 0; bj < 2; ++bj) {
                        const f32x4 v0 = acc[ai][bj][m][0] * rs * g[bj][0], v1 = acc[ai][bj][m][1] * rs * g[bj][1];
                        int chunk = 2 * bj + (fq >> 1); if (isk) chunk ^= ((s >> 2) & 3);
                        *(u32x2*)(dst8 + chunk * 16 + 8 * (fq & 1)) = pack8_fp8(v0, v1);
                    }
#else
                    bf16* dst = (isk ? DK : DQ) + ((((size_t)b * NH + head) * 2 + c) * SEQ + s) * 64;
#pragma unroll
                    for (int bj = 0; bj < 2; ++bj) {
                        const f32x4 v0 = acc[ai][bj][m][0] * rs * g[bj][0], v1 = acc[ai][bj][m][1] * rs * g[bj][1];
                        int chunk = 4 * bj + fq; if (isk) chunk ^= ((s >> 1) & 7);
                        *(u32x4*)(dst + chunk * 8) = pack8(v0, v1);
                    }
#endif
                }
            return;
        }
#pragma unroll
        for (int ai = 0; ai < 2; ++ai)
#pragma unroll
            for (int m = 0; m < 4; ++m) {
                const int r = row0 + ai * 128 + m * 16;
#pragma unroll
                for (int bj = 0; bj < 2; ++bj) {
                    const int c0 = 128 * bj + 32 * wc + 8 * fq;
                    f32x4 v0 = acc[ai][bj][m][0], v1 = acc[ai][bj][m][1];
                    if (pn == 0) { *(u32x4*)(GQ + (size_t)r * 256 + c0) = pack8(v0 * 0.125f, v1 * 0.125f); }
                    else if (pn == 1) { *(u32x4*)(GK + (size_t)r * 256 + c0) = pack8(v0, v1); }
                    else if (pn <= 3) { *(u32x4*)(GV + (size_t)r * 512 + (pn - 2) * 256 + c0) = pack8(v0, v1); }
                    else if (pn <= 5) {
#pragma unroll
                        for (int i = 0; i < 4; ++i) { v0[i] = fsilu(v0[i]); v1[i] = fsilu(v1[i]); }
                        *(u32x4*)(SG + (size_t)r * 512 + (pn - 4) * 256 + c0) = pack8(v0, v1); }
                    else if (pn <= 7) {
                        const float* bu = b_up + (pn - 6) * 256 + c0; const f32x4 b0 = *(const f32x4*)bu, b1 = *(const f32x4*)(bu + 4);
#pragma unroll
                        for (int i = 0; i < 4; ++i) { float z = v0[i] + b0[i]; v0[i] = (fminf(z, 0.f) - __logf(1.f + __expf(-fabsf(z)))) * (1.f / 16.f);
                                                      z = v1[i] + b1[i]; v1[i] = (fminf(z, 0.f) - __logf(1.f + __expf(-fabsf(z)))) * (1.f / 16.f); }
                        *(u32x4*)((pn == 6 ? LGF : LGB) + (size_t)r * 256 + c0) = pack8(v0, v1); }
#if MK_ATT_FP8
                    else if (pn <= 13) {
                        const int b = r / SEQ, s = r % SEQ, head = 2 * (pn - 12) + bj;
                        const int kk = s & 63, wkey = kk & 31, hh_ = (wkey >> 2) & 1, reg_ = (wkey & 3) + 4 * (wkey >> 3), pos = hh_ * 32 + 16 * (kk >> 5) + reg_;
                        unsigned char* tb = (unsigned char*)DV + (((size_t)b * NH + head) * (SEQ / 64) + (s >> 6)) * 8192;
                        const u32x2 pk = pack8_fp8(v0, v1); const int dv0 = 32 * wc + 8 * fq;
#pragma unroll
                        for (int i = 0; i < 8; ++i) { const int dv = dv0 + i; const unsigned byte = ((i < 4 ? pk.x : pk.y) >> (8 * (i & 3))) & 0xffu;
                            tb[dv * 64 + ((((pos >> 4) ^ ((dv >> 2) & 3)) << 4) | (pos & 15))] = (unsigned char)byte; } }
#else
                    else if (pn <= 13) {
                        const int b = r / SEQ, s = r % SEQ, head = 2 * (pn - 12) + bj;
                        bf16* dst = DV + ((((size_t)b * NH + head) * (SEQ / 8) + (s >> 3)) * 4 + wc) * 256 + (s & 7) * 32 + 8 * fq;
                        *(u32x4*)dst = pack8(v0, v1); }
#endif
                    else {
#pragma unroll
                        for (int i = 0; i < 4; ++i) { v0[i] = fsigmoid(v0[i]); v1[i] = fsigmoid(v1[i]); }
                        bf16* base = (pn <= 17) ? SGA + (pn - 14) * 256 : SGB + (pn - 18) * 256;
                        *(u32x4*)(base + (size_t)r * D + c0) = pack8(v0, v1); }
                }
            }
    }
};

struct EpiMerge {
    static constexpr bool PERM = true, AFTER_DRAIN = false, MIDK = false;
    const bf16* SGA; const bf16* SGB; bf16* O; int nM;
    __device__ __forceinline__ void operator()(const f32x4 (&acc)[2][2][4][2], const Unit& u, int wr, int wc, int fr, int fq) const {
        const int sel = u.pn >> 2; const int row0 = (u.pm - sel * nM) * 256 + wr * 64 + fr, col0 = (u.pn & 3) * 256 + wc * 32 + 8 * fq;
        const bf16* G = sel ? SGB : SGA;
#pragma unroll
        for (int ai = 0; ai < 2; ++ai)
#pragma unroll
            for (int m = 0; m < 4; ++m) { const size_t off = (size_t)(row0 + ai * 128 + m * 16) * D + col0;
#pragma unroll
                for (int bj = 0; bj < 2; ++bj) { const u32x4 b = *(const u32x4*)(G + off + bj * 128);
                    f32x4 v0 = acc[ai][bj][m][0], v1 = acc[ai][bj][m][1];
                    v0[0] *= bflo(b.x); v0[1] *= bfhi(b.x); v0[2] *= bflo(b.y); v0[3] *= bfhi(b.y); v1[0] *= bflo(b.z); v1[1] *= bfhi(b.z); v1[2] *= bflo(b.w); v1[3] *= bfhi(b.w);
                    if (sel) { const u32x4 t = *(const u32x4*)(O + off + bj * 128);
                        v0[0] += bflo(t.x); v0[1] += bfhi(t.x); v0[2] += bflo(t.y); v0[3] += bfhi(t.y); v1[0] += bflo(t.z); v1[1] += bfhi(t.z); v1[2] += bflo(t.w); v1[3] += bfhi(t.w); }
                    *(u32x4*)(O + off + bj * 128) = pack8(v0, v1); }
                asm volatile("" ::: "memory"); }
    }
};
struct MergeOrder {
    pg8::StaticOrder so; int nM;
    __device__ __forceinline__ bool next(int i, Unit& u) const { Unit t; if (!so.next(i >> 1, t)) return false; const int sel = i & 1; u.pm = t.pm + sel * nM; u.pn = t.pn + sel * 4; return true; }
    __device__ __forceinline__ void a_ready(const Unit&) const {}
    __device__ __forceinline__ void done(const Unit&) const {}
};

struct EpiResid {
    static constexpr bool PERM = true, AFTER_DRAIN = false, MIDK = false;
    const float* xin32; bf16* xb; const float* g1;
    __device__ __forceinline__ void operator()(const f32x4 (&acc)[2][2][4][2], const Unit& u, int wr, int wc, int fr, int fq) const {
        const int row0 = u.pm * 256 + wr * 64 + fr, col0 = u.pn * 256 + wc * 32 + 8 * fq;
        const int b = (u.pm * 256) / SEQ; const float* g = g1 + (size_t)b * 6 * D + col0;
        f32x4 gv[2][2];
#pragma unroll
        for (int bj = 0; bj < 2; ++bj)
#pragma unroll
            for (int n = 0; n < 2; ++n) gv[bj][n] = *(const f32x4*)(g + bj * 128 + n * 4);
#pragma unroll
        for (int ai = 0; ai < 2; ++ai)
#pragma unroll
            for (int m = 0; m < 4; ++m) { const size_t off = (size_t)(row0 + ai * 128 + m * 16) * D + col0;
#pragma unroll
                for (int bj = 0; bj < 2; ++bj) { f32x4 x0, x1;
                    if (xin32) { x0 = *(const f32x4*)(xin32 + off + bj * 128); x1 = *(const f32x4*)(xin32 + off + bj * 128 + 4); }
                    else { const u32x4 a = *(const u32x4*)(xb + off + bj * 128); x0 = (f32x4){bflo(a.x), bfhi(a.x), bflo(a.y), bfhi(a.y)}; x1 = (f32x4){bflo(a.z), bfhi(a.z), bflo(a.w), bfhi(a.w)}; }
                    *(u32x4*)(xb + off + bj * 128) = pack8(x0 + gv[bj][0] * acc[ai][bj][m][0], x1 + gv[bj][1] * acc[ai][bj][m][1]); }
                asm volatile("" ::: "memory"); }
    }
};

struct EpiLogits {
    static constexpr bool PERM = false, AFTER_DRAIN = false, MIDK = false;
    float* L;
    __device__ __forceinline__ void operator()(const f32x4 (&acc)[2][2][4][2], const Unit& u, int wr, int wc, int fr, int fq) const {
        if (wc >= 2) return;
        const int row0 = u.pm * 256 + wr * 64 + fr, col0 = wc * 32 + 4 * fq;
#pragma unroll
        for (int ai = 0; ai < 2; ++ai)
#pragma unroll
            for (int m = 0; m < 4; ++m)
#pragma unroll
                for (int n = 0; n < 2; ++n) *(f32x4*)(L + (size_t)(row0 + ai * 128 + m * 16) * 64 + col0 + n * 16) = acc[ai][0][m][n];
    }
};

#ifndef MK_MOE_FP8
#define MK_MOE_FP8 0
#endif
#if MK_MOE_FP8
struct EpiAct {
    static constexpr bool PERM = true, AFTER_DRAIN = false, MIDK = false;
    unsigned char* ACT;
    __device__ __forceinline__ void operator()(const f32x4 (&acc)[2][2][4][2], const Unit& u, int wr, int wc, int fr, int fq) const {
        const int row0 = u.pm * 256 + wr * 64 + fr, col0 = (u.pn & 3) * 128 + wc * 32 + 8 * fq;
        constexpr float inv = 1.f / WSCALE;
#pragma unroll
        for (int ai = 0; ai < 2; ++ai)
#pragma unroll
            for (int m = 0; m < 4; ++m) { f32x4 v0, v1;
#pragma unroll
                for (int i = 0; i < 4; ++i) { v0[i] = fsilu(acc[ai][0][m][0][i] * inv) * acc[ai][1][m][0][i] * (inv * ASCALE); v1[i] = fsilu(acc[ai][0][m][1][i] * inv) * acc[ai][1][m][1][i] * (inv * ASCALE); }
                *(u32x2*)(ACT + (size_t)(row0 + ai * 128 + m * 16) * DE + col0) = pack8_fp8(v0, v1); }
    }
};
struct EpiYs {
    static constexpr bool PERM = true, AFTER_DRAIN = false, MIDK = false;
    bf16* YS; const float* gs;
    __device__ __forceinline__ void operator()(const f32x4 (&acc)[2][2][4][2], const Unit& u, int wr, int wc, int fr, int fq) const {
        const int row0 = u.pm * 256 + wr * 64 + fr, col0 = (u.pn & 3) * 256 + wc * 32 + 8 * fq;
#pragma unroll
        for (int ai = 0; ai < 2; ++ai)
#pragma unroll
            for (int m = 0; m < 4; ++m) { const int r = row0 + ai * 128 + m * 16; const float gt = gs[r] * (1.f / (WSCALE * ASCALE));
#pragma unroll
                for (int bj = 0; bj < 2; ++bj) *(u32x4*)(YS + (size_t)r * D + col0 + bj * 128) = pack8(acc[ai][bj][m][0] * gt, acc[ai][bj][m][1] * gt); }
    }
};
#else
struct EpiAct {
    static constexpr bool PERM = true, AFTER_DRAIN = false, MIDK = false;
    bf16* ACT;
    __device__ __forceinline__ void operator()(const f32x4 (&acc)[2][2][4][2], const Unit& u, int wr, int wc, int fr, int fq) const {
        const int row0 = u.pm * 256 + wr * 64 + fr, col0 = (u.pn & 3) * 128 + wc * 32 + 8 * fq;
#pragma unroll
        for (int ai = 0; ai < 2; ++ai)
#pragma unroll
            for (int m = 0; m < 4; ++m) { f32x4 v0, v1;
#pragma unroll
                for (int i = 0; i < 4; ++i) { v0[i] = fsilu(acc[ai][0][m][0][i]) * acc[ai][1][m][0][i]; v1[i] = fsilu(acc[ai][0][m][1][i]) * acc[ai][1][m][1][i]; }
                *(u32x4*)(ACT + (size_t)(row0 + ai * 128 + m * 16) * DE + col0) = pack8(v0, v1); }
    }
};
struct EpiYs {
    static constexpr bool PERM = true, AFTER_DRAIN = false, MIDK = false;
    unsigned char* YS; const float* gs;
    __device__ __forceinline__ void operator()(const f32x4 (&acc)[2][2][4][2], const Unit& u, int wr, int wc, int fr, int fq) const {
        const int row0 = u.pm * 256 + wr * 64 + fr, col0 = (u.pn & 3) * 256 + wc * 32 + 8 * fq;
#pragma unroll
        for (int ai = 0; ai < 2; ++ai)
#pragma unroll
            for (int m = 0; m < 4; ++m) { const int r = row0 + ai * 128 + m * 16; const float gt = gs[r] * YSCALE;
#pragma unroll
                for (int bj = 0; bj < 2; ++bj) *(u32x2*)(YS + (size_t)r * D + col0 + bj * 128) = pack8_fp8(acc[ai][bj][m][0] * gt, acc[ai][bj][m][1] * gt); }
    }
};
#endif
struct GroupedOrder {
    const int* tilee; int U, G, c; const int* rowidx;
    __device__ __forceinline__ bool next(int i, Unit& u) const {
        int id;
        if ((G & 7) == 0) { const int gx = G >> 3, per = (U + 7) >> 3, n = i * gx + (c >> 3); if (n >= per) return false; id = (c & 7) * per + n; if (id >= U) return false; }
        else { id = i * G + c; if (id >= U) return false; }
        const int t = id >> 2; u.pm = t; u.pn = tilee[t] * 4 + (id & 3); return true;
    }
    __device__ __forceinline__ void a_ready(const Unit&) const {}
    __device__ __forceinline__ void done(const Unit&) const {}
};
constexpr int AT_KR = 0, AT_VR = 32768, AT_TAB = 65536, AT_SLOT = 8192;
typedef int v8i __attribute__((ext_vector_type(8)));
typedef int v4i __attribute__((ext_vector_type(4)));
__device__ __forceinline__ int crow(int r, int hi) { return (r & 3) + 8 * (r >> 2) + 4 * hi; }

__device__ __forceinline__ void attn_bias(f32x16& s0, f32x16& s1, int relbase, const LAS float* tabh) {
#pragma unroll
    for (int r = 0; r < 16; ++r) {
        int i0 = relbase + (r & 3) + 8 * (r >> 2); int i1 = i0 + 32;
        i0 = i0 < 0 ? 0 : (i0 > 255 ? 255 : i0); i1 = i1 < 0 ? 0 : (i1 > 255 ? 255 : i1);
        s0[r] += tabh[i0]; s1[r] += tabh[i1];
    }
}
template <int J>
__device__ __forceinline__ void attn_exp_chunk(f32x16& s0, f32x16& s1, float& lsum) {
    float ls = 0.f;
#pragma unroll
    for (int r = 4 * J; r < 4 * J + 4; ++r) { s0[r] = __builtin_amdgcn_exp2f(s0[r]); s1[r] = __builtin_amdgcn_exp2f(s1[r]); }
    (void)ls; (void)lsum;
}
__device__ __forceinline__ int pk4_bf8(float a, float b, float c, float d) { int w = 0; w = __builtin_amdgcn_cvt_pk_bf8_f32(a, b, w, false); w = __builtin_amdgcn_cvt_pk_bf8_f32(c, d, w, true); return w; }
__device__ __forceinline__ void glds16(const void* gsrc, unsigned lds_dst) { unsigned keep;
    asm volatile("s_mov_b32 %0, m0\n\ts_mov_b32 m0, %2\n\ts_nop 0\n\tglobal_load_lds_dwordx4 %1, off\n\ts_mov_b32 m0, %0" : "=&s"(keep) : "v"(gsrc), "s"(lds_dst) : "memory"); }
__device__ __forceinline__ void attn_dma_k(unsigned lds0, const unsigned char* kg0, int t, int slot, int wid, int lane) {
    glds16(kg0 + (size_t)(wid >> 2) * SEQ * 64 + (size_t)t * 4096 + (wid & 3) * 1024 + lane * 16, (unsigned)__builtin_amdgcn_readfirstlane((int)(lds0 + AT_KR + slot * AT_SLOT + wid * 1024)));
}
__device__ __forceinline__ void attn_dma_v(unsigned lds0, const unsigned char* vg0, int t, int slot, int wid, int lane) {
    glds16(vg0 + (size_t)t * 8192 + wid * 1024 + lane * 16, (unsigned)__builtin_amdgcn_readfirstlane((int)(lds0 + AT_VR + slot * AT_SLOT + wid * 1024)));
}
#define AT_RD128(dst, addr, off) asm volatile("ds_read_b128 %0, %1 offset:%c2" : "=&v"(dst) : "v"(addr), "i"(off) : "memory")
#define AT_MFMA8(a, b, c) __builtin_amdgcn_mfma_scale_f32_32x32x64_f8f6f4(a, b, c, 0, 0, 0, 0, 0, 0)
#define AT_MFMA8B(a, b, c) __builtin_amdgcn_mfma_scale_f32_32x32x64_f8f6f4(a, b, c, 0, 1, 0, 0, 0, 0)

template <int VAR>
__device__ __forceinline__ void phase_attn(Frame& F, int l) {
    refresh(F);
    const WS W = ws_map(F.ws, F.nb); const float* const* IN_ = F.a->in; (void)IN_; (void)W;
    const int lane = F.lane, wid = F.wave, r32 = lane & 31, hh = lane >> 5, qg = wid & 3, c = wid >> 2;
    LAS unsigned char* lds = F.lds; const unsigned lds0 = (unsigned)(unsigned long)lds;
    LAS float* tab = (LAS float*)(lds + AT_TAB);
    for (int i = F.tid; i < 1028; i += NTHR) tab[i] = W.tab[i];
    const float lam = W.tab[1032 + l]; const float lam_init = 0.8f - 0.6f * __expf(-0.3f * (float)l);
    const float* subg = IN_[13] + l * 128;
    const int U = F.nb * NH * 64;
    const int gx = F.G >> 3, per = U >> 3;
    const int sw = (r32 >> 2) & 3;
    const unsigned ka0 = lds0 + AT_KR + c * 4096 + r32 * 64 + (((2 * hh) ^ sw) << 4), ka1 = lds0 + AT_KR + c * 4096 + r32 * 64 + (((2 * hh + 1) ^ sw) << 4);
    const unsigned va0 = lds0 + AT_VR + r32 * 64 + (((2 * hh) ^ sw) << 4), va1 = lds0 + AT_VR + r32 * 64 + (((2 * hh + 1) ^ sw) << 4);
    const bool lag = wid >= 4;
    __syncthreads();
    for (int i = 0;; ++i) {
        int id;
        if ((F.G & 7) == 0) { const int n = i * gx + (F.bid >> 3); if (n >= per) break; id = (F.bid & 7) * per + n; }
        else { id = i * F.G + F.bid; if (id >= U) break; }
        const int bh = id >> 6, qb = id & 63, b = bh >> 2, h = bh & 3;
        const int qw0 = qb * 128 + 32 * qg;
        const unsigned char* kg0 = (const unsigned char*)W.DK + ((size_t)bh * 2) * SEQ * 64;
        const unsigned char* vg0 = (const unsigned char*)W.DV + (size_t)bh * SEQ * 128;
        v8i qf; { const unsigned char* qp = (const unsigned char*)W.DQ + (((size_t)bh * 2 + c) * SEQ + qw0 + r32) * 64 + 32 * hh;
            const v4i q0 = *(const v4i*)qp, q1 = *(const v4i*)(qp + 16); qf = (v8i){q0[0], q0[1], q0[2], q0[3], q1[0], q1[1], q1[2], q1[3]}; }
        asm volatile("s_waitcnt vmcnt(0)" ::: "memory");
        attn_dma_k(lds0, kg0, 0, 0, wid, lane); attn_dma_k(lds0, kg0, 1, 1, wid, lane); attn_dma_v(lds0, vg0, 0, 0, wid, lane); attn_dma_k(lds0, kg0, 2, 2, wid, lane);
        attn_dma_v(lds0, vg0, 1, 1, wid, lane); attn_dma_k(lds0, kg0, 3, 3, wid, lane); attn_dma_v(lds0, vg0, 2, 2, wid, lane);
        f32x16 o[4]; f32x16 osum = f32x16{};
#pragma unroll
        for (int dt = 0; dt < 4; ++dt) o[dt] = f32x16{};
        float lsum = 0.f;
        const v8i ones8 = {0x38383838, 0x38383838, 0x38383838, 0x38383838, 0x38383838, 0x38383838, 0x38383838, 0x38383838};
        const int tL = (qw0 >= 154) ? ((qw0 - 154) >> 6) + 1 : 0, tR = (qw0 + 185) >> 6;
        const float shl = tab[1024 + h];
        const LAS float* tabh = tab + h * 256;
        const int rel0 = -qw0 - r32 + 4 * hh + 128;
        const f32x16 cshift = {-2.f, -2.f, -2.f, -2.f, -2.f, -2.f, -2.f, -2.f, -2.f, -2.f, -2.f, -2.f, -2.f, -2.f, -2.f, -2.f};
        asm volatile("s_waitcnt vmcnt(4)" ::: "memory"); __builtin_amdgcn_s_barrier(); asm volatile("" ::: "memory");
        f32x16 sc0, sc1, sn0, sn1; v8i p; v4i kx[4];
        AT_RD128(kx[0], ka0, 0); AT_RD128(kx[1], ka1, 0); AT_RD128(kx[2], ka0, 2048); AT_RD128(kx[3], ka1, 2048);
        asm volatile("s_waitcnt lgkmcnt(0)" ::: "memory"); __builtin_amdgcn_sched_barrier(0);
        sc0 = AT_MFMA8(((v8i){kx[0][0], kx[0][1], kx[0][2], kx[0][3], kx[1][0], kx[1][1], kx[1][2], kx[1][3]}), qf, cshift);
        sc1 = AT_MFMA8(((v8i){kx[2][0], kx[2][1], kx[2][2], kx[2][3], kx[3][0], kx[3][1], kx[3][2], kx[3][3]}), qf, cshift);
        __builtin_amdgcn_s_barrier(); asm volatile("" ::: "memory");
        if (lag) { __builtin_amdgcn_s_barrier(); asm volatile("" ::: "memory"); }
#define AT_STEP(SL, t) do { \
            { const int tk = (t) + 4 < 128 ? (t) + 4 : 127; attn_dma_k(lds0, kg0, tk, SL, wid, lane); } \
            asm volatile("s_waitcnt vmcnt(4)" ::: "memory");                                                       \
            AT_RD128(kx[0], ka0, ((SL + 1) & 3) * AT_SLOT); AT_RD128(kx[1], ka1, ((SL + 1) & 3) * AT_SLOT);        \
            AT_RD128(kx[2], ka0, ((SL + 1) & 3) * AT_SLOT + 2048); AT_RD128(kx[3], ka1, ((SL + 1) & 3) * AT_SLOT + 2048); \
            if ((t) >= tL && (t) < tR) attn_bias(sc0, sc1, 64 * (t) + rel0, tabh);                                \
            attn_exp_chunk<0>(sc0, sc1, lsum); attn_exp_chunk<1>(sc0, sc1, lsum);                                 \
            asm volatile("s_waitcnt lgkmcnt(0)" ::: "memory"); __builtin_amdgcn_sched_barrier(0); \
            sn0 = AT_MFMA8(((v8i){kx[0][0], kx[0][1], kx[0][2], kx[0][3], kx[1][0], kx[1][1], kx[1][2], kx[1][3]}), qf, cshift); \
            __builtin_amdgcn_sched_barrier(0); \
            attn_exp_chunk<2>(sc0, sc1, lsum); \
            __builtin_amdgcn_sched_barrier(0); \
            sn1 = AT_MFMA8(((v8i){kx[2][0], kx[2][1], kx[2][2], kx[2][3], kx[3][0], kx[3][1], kx[3][2], kx[3][3]}), qf, cshift); \
            __builtin_amdgcn_sched_barrier(0); \
            attn_exp_chunk<3>(sc0, sc1, lsum); \
            p[0] = pk4_bf8(sc0[0], sc0[1], sc0[2], sc0[3]); p[1] = pk4_bf8(sc0[4], sc0[5], sc0[6], sc0[7]); p[2] = pk4_bf8(sc0[8], sc0[9], sc0[10], sc0[11]); p[3] = pk4_bf8(sc0[12], sc0[13], sc0[14], sc0[15]); \
            p[4] = pk4_bf8(sc1[0], sc1[1], sc1[2], sc1[3]); p[5] = pk4_bf8(sc1[4], sc1[5], sc1[6], sc1[7]); p[6] = pk4_bf8(sc1[8], sc1[9], sc1[10], sc1[11]); p[7] = pk4_bf8(sc1[12], sc1[13], sc1[14], sc1[15]); \
            __builtin_amdgcn_s_barrier(); asm volatile("" ::: "memory"); \
            { const int tv = (t) + 3 < 128 ? (t) + 3 : 127; attn_dma_v(lds0, vg0, tv, (SL + 3) & 3, wid, lane); } \
            asm volatile("s_waitcnt vmcnt(4)" ::: "memory");                                                       \
            { v4i vx[8]; \
              AT_RD128(vx[0], va0, SL * AT_SLOT); AT_RD128(vx[1], va1, SL * AT_SLOT); AT_RD128(vx[2], va0, SL * AT_SLOT + 2048); AT_RD128(vx[3], va1, SL * AT_SLOT + 2048); \
              AT_RD128(vx[4], va0, SL * AT_SLOT + 4096); AT_RD128(vx[5], va1, SL * AT_SLOT + 4096); AT_RD128(vx[6], va0, SL * AT_SLOT + 6144); AT_RD128(vx[7], va1, SL * AT_SLOT + 6144); \
              if ((t) == tL) { _Pragma("unroll") for (int dt = 0; dt < 4; ++dt) o[dt] *= shl; osum *= shl; } \
              osum = AT_MFMA8B(ones8, p, osum); \
              asm volatile("s_waitcnt lgkmcnt(4)" ::: "memory"); __builtin_amdgcn_sched_barrier(0); \
              o[0] = AT_MFMA8B(((v8i){vx[0][0], vx[0][1], vx[0][2], vx[0][3], vx[1][0], vx[1][1], vx[1][2], vx[1][3]}), p, o[0]); \
              o[1] = AT_MFMA8B(((v8i){vx[2][0], vx[2][1], vx[2][2], vx[2][3], vx[3][0], vx[3][1], vx[3][2], vx[3][3]}), p, o[1]); \
              asm volatile("s_waitcnt lgkmcnt(0)" ::: "memory"); __builtin_amdgcn_sched_barrier(0); \
              o[2] = AT_MFMA8B(((v8i){vx[4][0], vx[4][1], vx[4][2], vx[4][3], vx[5][0], vx[5][1], vx[5][2], vx[5][3]}), p, o[2]); \
              o[3] = AT_MFMA8B(((v8i){vx[6][0], vx[6][1], vx[6][2], vx[6][3], vx[7][0], vx[7][1], vx[7][2], vx[7][3]}), p, o[3]); } \
            sc0 = sn0; sc1 = sn1; \
            __builtin_amdgcn_s_barrier(); asm volatile("" ::: "memory"); } while (0)
        for (int t0 = 0; t0 < 128; t0 += 4) { AT_STEP(0, t0); AT_STEP(1, t0 + 1); AT_STEP(2, t0 + 2); AT_STEP(3, t0 + 3); }
#undef AT_STEP
        if (!lag) { __builtin_amdgcn_s_barrier(); asm volatile("" ::: "memory"); }
        asm volatile("s_waitcnt vmcnt(0)" ::: "memory"); __builtin_amdgcn_s_barrier(); asm volatile("" ::: "memory");
        const float lt = osum[0];
        LAS float* xch = (LAS float*)(lds + qg * 16384);
        if (c == 1) { const float f = lam / lt;
#pragma unroll
            for (int dt = 0; dt < 4; ++dt)
#pragma unroll
                for (int r = 0; r < 16; ++r) xch[(dt * 16 + r) * 64 + lane] = o[dt][r] * f; }
        LDS_WAIT(); __builtin_amdgcn_s_barrier(); asm volatile("" ::: "memory");
        if (c == 0) { const float f = 1.f / lt; float ss = 0.f;
#pragma unroll
            for (int dt = 0; dt < 4; ++dt)
#pragma unroll
                for (int r = 0; r < 16; ++r) { const float v = o[dt][r] * f - xch[(dt * 16 + r) * 64 + lane]; o[dt][r] = v; ss += v * v; }
            ss += __shfl_xor(ss, 32);
            const float rn = rsqrtf(ss * (1.f / 128.f) + RMS_EPS) * (1.f - lam_init);
            bf16* orow = W.OAB + (size_t)F.T * 512 + ((size_t)b * SEQ + qw0 + r32) * 512 + h * 128;
#pragma unroll
            for (int dt = 0; dt < 4; ++dt)
#pragma unroll
                for (int g = 0; g < 4; ++g) { const int dv = 32 * dt + 8 * g + 4 * hh; const f32x4 sg = *(const f32x4*)(subg + dv);
                    u32x2 ov; ov.x = cvt_pk(o[dt][4 * g] * rn * sg[0], o[dt][4 * g + 1] * rn * sg[1]); ov.y = cvt_pk(o[dt][4 * g + 2] * rn * sg[2], o[dt][4 * g + 3] * rn * sg[3]);
                    *(u32x2*)(orow + dv) = ov; }
        }
        LDS_WAIT(); __builtin_amdgcn_s_barrier(); asm volatile("" ::: "memory");
    }
}
constexpr int GL_CUM = 0;
constexpr int GL_S64 = 144, GL_S192 = 400;
constexpr int G1_KEF = 34816, G1_KEB = G1_KEF + 64 * GL_S64, G1_VT = G1_KEB + 64 * GL_S64;
constexpr int G3_AOP = 34816, G3_KIF = G3_AOP + 64 * GL_S192, G3_KIB = G3_KIF + 64 * GL_S64, G3_BOP = G3_KIB + 64 * GL_S64;
static_assert(G3_BOP + 128 * GL_S192 <= 150 * 1024, "GLA LDS");

__device__ __forceinline__ bf16x8 lds_frag(const LAS unsigned char* base, int row, int stride, int kbyte) { return *(const LAS bf16x8*)(base + row * stride + kbyte); }

__device__ __forceinline__ void gla_cum(Frame& F, size_t trow0, int h) {
    const WS W = ws_map(F.ws, F.nb); const float* const* IN_ = F.a->in; (void)IN_; (void)W;
    LAS float* cum = (LAS float*)(F.lds + GL_CUM);
#pragma unroll
    for (int it = 0; it < 4; ++it) { const int idx = F.tid + it * NTHR; const int dir = idx >> 10, t = (idx >> 4) & 63, d4 = (idx & 15) * 4;
        const u32x2 a = *(const u32x2*)((dir ? W.LGB : W.LGF) + (trow0 + t) * 256 + h * 64 + d4);
        *(LAS f32x4*)(cum + (dir * 64 + t) * 64 + d4) = (f32x4){bflo(a.x), bfhi(a.x), bflo(a.y), bfhi(a.y)}; }
    __syncthreads();
    {
        const int dir = F.tid >> 8, seg = (F.tid >> 6) & 3, d = F.tid & 63; LAS float* cc = cum + dir * 4096 + d; LAS float* tot = cum + 8192 + (dir * 4 + seg) * 64 + d;
        float v[16]; float run = 0.f;
        if (dir == 0) {
#pragma unroll
            for (int i = 0; i < 16; ++i) { run += cc[(16 * seg + i) * 64]; v[i] = run; }
        } else {
#pragma unroll
            for (int i = 15; i >= 0; --i) { run += cc[(16 * seg + i) * 64]; v[i] = run; }
        }
        *tot = run;
        __syncthreads();
        float off = 0.f; const LAS float* tb = cum + 8192 + dir * 256 + d;
        if (dir == 0) { if (seg > 0) off += tb[0]; if (seg > 1) off += tb[64]; if (seg > 2) off += tb[128]; }
        else { if (seg < 3) off += tb[192]; if (seg < 2) off += tb[128]; if (seg < 1) off += tb[64]; }
#pragma unroll
        for (int i = 0; i < 16; ++i) cc[(16 * seg + i) * 64] = v[i] + off;
    }
    __syncthreads();
}

__device__ __forceinline__ void phase_gla1(Frame& F) {
    refresh(F);
    const WS W = ws_map(F.ws, F.nb); const float* const* IN_ = F.a->in; (void)IN_; (void)W;
    LAS unsigned char* lds = F.lds; LAS float* cum = (LAS float*)(lds + GL_CUM);
    const int lane = F.lane, wid = F.wave, r32 = lane & 31, hh = lane >> 5;
    const int U = F.nb * NH * 128;
    for (int u = F.bid; u < U; u += F.G) {
        const int n = u & 127, bh = u >> 7, b = bh >> 2, h = bh & 3; const size_t trow0 = (size_t)b * SEQ + n * 64;
        gla_cum(F, trow0, h);
        {
            const int t = F.tid >> 3, d0 = (F.tid & 7) * 8;
            const u32x4 kv = *(const u32x4*)(W.GK + (trow0 + t) * 256 + h * 64 + d0);
            const unsigned kw[4] = {kv.x, kv.y, kv.z, kv.w};
#pragma unroll
            for (int j = 0; j < 8; ++j) { const int d = d0 + j; const float k = (j & 1) ? bfhi(kw[j >> 1]) : bflo(kw[j >> 1]);
                const float ef = __expf(cum[63 * 64 + d] - cum[t * 64 + d]), eb = __expf(cum[4096 + d] - cum[4096 + t * 64 + d]);
                *(LAS bf16*)(lds + G1_KEF + d * GL_S64 + t * 2) = (bf16)(cvt_pk(k * ef, 0.f) & 0xffffu);
                *(LAS bf16*)(lds + G1_KEB + d * GL_S64 + t * 2) = (bf16)(cvt_pk(k * eb, 0.f) & 0xffffu); }
            const int v0 = (F.tid & 7) * 16;
            const u32x4 va = *(const u32x4*)(W.GV + (trow0 + t) * 512 + h * 128 + v0), vb = *(const u32x4*)(W.GV + (trow0 + t) * 512 + h * 128 + v0 + 8);
            const unsigned vw[8] = {va.x, va.y, va.z, va.w, vb.x, vb.y, vb.z, vb.w};
#pragma unroll
            for (int j = 0; j < 16; ++j) *(LAS bf16*)(lds + G1_VT + (v0 + j) * GL_S64 + t * 2) = (bf16)((j & 1) ? (vw[j >> 1] >> 16) : (vw[j >> 1] & 0xffffu));
            if (F.tid < 128) { const int dir = F.tid >> 6, d = F.tid & 63; W.DEC[((size_t)u * 2 + dir) * 64 + d] = __expf(dir ? cum[4096 + d] : cum[63 * 64 + d]); }
        }
        __syncthreads();
        {
            const int dt = wid & 3, dd = wid >> 2;
            f32x16 cf = {}, cb = {};
#pragma unroll
            for (int s = 0; s < 4; ++s) { const int kb = (16 * s + 8 * hh) * 2;
                const bf16x8 a = lds_frag(lds + G1_VT, 32 * dt + r32, GL_S64, kb);
                cf = __builtin_amdgcn_mfma_f32_32x32x16_bf16(a, lds_frag(lds + G1_KEF, 32 * dd + r32, GL_S64, kb), cf, 0, 0, 0);
                cb = __builtin_amdgcn_mfma_f32_32x32x16_bf16(a, lds_frag(lds + G1_KEB, 32 * dd + r32, GL_S64, kb), cb, 0, 0, 0); }
            bf16* of = (bf16*)W.KVT + ((size_t)u * 2) * 8192; bf16* ob = of + 8192;
#pragma unroll
            for (int r = 0; r < 16; ++r) { const int dv = 32 * dt + crow(r, hh), d = 32 * dd + r32;
                const float pf = __shfl_xor(cf[r], 1), pb = __shfl_xor(cb[r], 1);
                if (!(lane & 1)) { *(unsigned*)(of + dv * 64 + d) = cvt_pk(cf[r], pf); *(unsigned*)(ob + dv * 64 + d) = cvt_pk(cb[r], pb); } }
        }
        __syncthreads();
    }
}

__device__ __forceinline__ void phase_gla2(Frame& F) {
    refresh(F);
    const WS W = ws_map(F.ws, F.nb); const float* const* IN_ = F.a->in; (void)IN_; (void)W;
    const size_t total = (size_t)F.nb * NH * 2 * 4096;
    for (size_t wk = (size_t)F.bid * NTHR + F.tid; wk < total; wk += (size_t)F.G * NTHR) {
        const int e2 = (int)(wk & 4095), dir = (int)((wk >> 12) & 1), bh = (int)(wk >> 13), d = (e2 * 2) & 63;
        unsigned* base = (unsigned*)((bf16*)W.KVT + ((size_t)bh * 128 * 2 + dir) * 8192) + e2; const float* dec = W.DEC + ((size_t)bh * 128 * 2 + dir) * 64 + d;
        float S0 = 0.f, S1 = 0.f;
        for (int n0 = 0; n0 < 128; n0 += 8) {
            unsigned kv[8]; float dc0[8], dc1[8];
#pragma unroll
            for (int j = 0; j < 8; ++j) { const int n = dir ? 127 - (n0 + j) : n0 + j; kv[j] = base[(size_t)n * 8192]; dc0[j] = dec[(size_t)n * 128]; dc1[j] = dec[(size_t)n * 128 + 1]; }
#pragma unroll
            for (int j = 0; j < 8; ++j) { const int n = dir ? 127 - (n0 + j) : n0 + j; base[(size_t)n * 8192] = cvt_pk(S0, S1); S0 = dc0[j] * S0 + bflo(kv[j]); S1 = dc1[j] * S1 + bfhi(kv[j]); }
        }
    }
}

__device__ __forceinline__ void phase_gla3(Frame& F, int l) {
    refresh(F);
    const WS W = ws_map(F.ws, F.nb); const float* const* IN_ = F.a->in; (void)IN_; (void)W;
    LAS unsigned char* lds = F.lds; LAS float* cum = (LAS float*)(lds + GL_CUM);
    const int lane = F.lane, wid = F.wave, r32 = lane & 31, hh = lane >> 5;
    const float* gng = IN_[9] + l * 128;
    const int U = F.nb * NH * 128;
    for (int u = F.bid; u < U; u += F.G) {
        const int n = u & 127, bh = u >> 7, b = bh >> 2, h = bh & 3; const size_t trow0 = (size_t)b * SEQ + n * 64;
        gla_cum(F, trow0, h);
        {
            const int t = F.tid >> 3, d0 = (F.tid & 7) * 8;
            const u32x4 qv = *(const u32x4*)(W.GQ + (trow0 + t) * 256 + h * 64 + d0), kv = *(const u32x4*)(W.GK + (trow0 + t) * 256 + h * 64 + d0);
            const unsigned qw[4] = {qv.x, qv.y, qv.z, qv.w}, kw[4] = {kv.x, kv.y, kv.z, kv.w};
            float qf[8], qb[8], kf[8], kb[8];
#pragma unroll
            for (int j = 0; j < 8; ++j) { const int d = d0 + j; const float q = (j & 1) ? bfhi(qw[j >> 1]) : bflo(qw[j >> 1]), k = (j & 1) ? bfhi(kw[j >> 1]) : bflo(kw[j >> 1]);
                const float cf = cum[t * 64 + d], cb = cum[4096 + t * 64 + d];
                qf[j] = q * __expf(cf); qb[j] = q * __expf(cb); kf[j] = k * __expf(-cf); kb[j] = k * __expf(-cb); }
            u32x4 o;
            o.x = cvt_pk(qf[0], qf[1]); o.y = cvt_pk(qf[2], qf[3]); o.z = cvt_pk(qf[4], qf[5]); o.w = cvt_pk(qf[6], qf[7]); *(LAS u32x4*)(lds + G3_AOP + t * GL_S192 + (64 + d0) * 2) = o;
            o.x = cvt_pk(qb[0], qb[1]); o.y = cvt_pk(qb[2], qb[3]); o.z = cvt_pk(qb[4], qb[5]); o.w = cvt_pk(qb[6], qb[7]); *(LAS u32x4*)(lds + G3_AOP + t * GL_S192 + (128 + d0) * 2) = o;
            o.x = cvt_pk(kf[0], kf[1]); o.y = cvt_pk(kf[2], kf[3]); o.z = cvt_pk(kf[4], kf[5]); o.w = cvt_pk(kf[6], kf[7]); *(LAS u32x4*)(lds + G3_KIF + t * GL_S64 + d0 * 2) = o;
            o.x = cvt_pk(kb[0], kb[1]); o.y = cvt_pk(kb[2], kb[3]); o.z = cvt_pk(kb[4], kb[5]); o.w = cvt_pk(kb[6], kb[7]); *(LAS u32x4*)(lds + G3_KIB + t * GL_S64 + d0 * 2) = o;
            const int v0 = (F.tid & 7) * 16;
            const u32x4 va = *(const u32x4*)(W.GV + (trow0 + t) * 512 + h * 128 + v0), vb = *(const u32x4*)(W.GV + (trow0 + t) * 512 + h * 128 + v0 + 8);
            const unsigned vw[8] = {va.x, va.y, va.z, va.w, vb.x, vb.y, vb.z, vb.w};
#pragma unroll
            for (int j = 0; j < 16; ++j) *(LAS bf16*)(lds + G3_BOP + (v0 + j) * GL_S192 + t * 2) = (bf16)((j & 1) ? (vw[j >> 1] >> 16) : (vw[j >> 1] & 0xffffu));
            const int dv = F.tid >> 2, dd0 = (F.tid & 3) * 16;
#pragma unroll
            for (int dir = 0; dir < 2; ++dir) { const bf16* sp = (const bf16*)W.KVT + ((size_t)u * 2 + dir) * 8192 + dv * 64 + dd0;
                const u32x4 o0 = *(const u32x4*)sp, o1 = *(const u32x4*)(sp + 8);
                *(LAS u32x4*)(lds + G3_BOP + dv * GL_S192 + (64 + 64 * dir + dd0) * 2) = o0; *(LAS u32x4*)(lds + G3_BOP + dv * GL_S192 + (64 + 64 * dir + dd0 + 8) * 2) = o1; }
        }
        __syncthreads();
        if (wid < 4) {
            const int it = wid >> 1, jt = wid & 1;
            f32x16 af = {}, ab = {};
#pragma unroll
            for (int s = 0; s < 4; ++s) { const int kb = (16 * s + 8 * hh) * 2;
                if (jt <= it) af = __builtin_amdgcn_mfma_f32_32x32x16_bf16(lds_frag(lds + G3_AOP, 32 * it + r32, GL_S192, 128 + kb), lds_frag(lds + G3_KIF, 32 * jt + r32, GL_S64, kb), af, 0, 0, 0);
                if (jt >= it) ab = __builtin_amdgcn_mfma_f32_32x32x16_bf16(lds_frag(lds + G3_AOP, 32 * it + r32, GL_S192, 256 + kb), lds_frag(lds + G3_KIB, 32 * jt + r32, GL_S64, kb), ab, 0, 0, 0); }
#pragma unroll
            for (int r = 0; r < 16; ++r) { const int i = 32 * it + crow(r, hh), j = 32 * jt + r32; const float v = (j <= i) ? af[r] : ab[r];
                *(LAS bf16*)(lds + G3_AOP + i * GL_S192 + j * 2) = (bf16)(cvt_pk(v, 0.f) & 0xffffu); }
        }
        __syncthreads();
        {
            const int it = wid >> 2, dt = wid & 3; f32x16 o = {};
#pragma unroll
            for (int s = 0; s < 12; ++s) { const int kb = (16 * s + 8 * hh) * 2;
                o = __builtin_amdgcn_mfma_f32_32x32x16_bf16(lds_frag(lds + G3_AOP, 32 * it + r32, GL_S192, kb), lds_frag(lds + G3_BOP, 32 * dt + r32, GL_S192, kb), o, 0, 0, 0); }
            LAS float* out = (LAS float*)(lds + GL_CUM);
#pragma unroll
            for (int r = 0; r < 16; ++r) out[(32 * it + crow(r, hh)) * 128 + 32 * dt + r32] = o[r];
        }
        __syncthreads();
        {
            const int t = F.tid >> 3, v0 = (F.tid & 7) * 16; const LAS float* orow = (const LAS float*)(lds + GL_CUM) + t * 128 + v0;
            float x[16]; float ss = 0.f;
#pragma unroll
            for (int j = 0; j < 16; ++j) { x[j] = orow[j]; ss += x[j] * x[j]; }
            ss += __shfl_xor(ss, 1); ss += __shfl_xor(ss, 2); ss += __shfl_xor(ss, 4);
            const float rs = rsqrtf(ss * (1.f / 128.f) + RMS_EPS);
            const u32x4 ga = *(const u32x4*)(W.SG + (trow0 + t) * 512 + h * 128 + v0), gb = *(const u32x4*)(W.SG + (trow0 + t) * 512 + h * 128 + v0 + 8);
            const unsigned gw[8] = {ga.x, ga.y, ga.z, ga.w, gb.x, gb.y, gb.z, gb.w};
            float y[16];
#pragma unroll
            for (int j = 0; j < 16; ++j) y[j] = x[j] * rs * gng[v0 + j] * ((j & 1) ? bfhi(gw[j >> 1]) : bflo(gw[j >> 1]));
            u32x4 o0, o1; o0.x = cvt_pk(y[0], y[1]); o0.y = cvt_pk(y[2], y[3]); o0.z = cvt_pk(y[4], y[5]); o0.w = cvt_pk(y[6], y[7]);
            o1.x = cvt_pk(y[8], y[9]); o1.y = cvt_pk(y[10], y[11]); o1.z = cvt_pk(y[12], y[13]); o1.w = cvt_pk(y[14], y[15]);
            bf16* dst = W.OAB + (trow0 + t) * 512 + h * 128 + v0; *(u32x4*)dst = o0; *(u32x4*)(dst + 8) = o1;
        }
        __syncthreads();
    }
}
__device__ __forceinline__ void phase_select(Frame& F, int l) {
    refresh(F);
    const WS W = ws_map(F.ws, F.nb); const float* const* IN_ = F.a->in; (void)IN_; (void)W;
    LAS int* lcnt = (LAS int*)F.lds; LAS int* lbase = lcnt + 32;
    const float* b_rg = IN_[19] + l * 4; const float* b_re = IN_[21] + l * 32;
    unsigned* gcnt = W.ctl + CW_CNT + l * 64;
    for (int t0 = F.bid * NTHR; t0 < F.T; t0 += F.G * NTHR) {
        if (F.tid < 32) lcnt[F.tid] = 0;
        __syncthreads();
        const int t = t0 + F.tid; int e0 = 0, e1 = 0, r0 = 0, r1 = 0; float g0 = 0.f, g1 = 0.f;
        if (t < F.T) {
            const float* lg = W.LOGITS + (size_t)t * 64;
            float gl[4]; { const f32x4 v = *(const f32x4*)lg; gl[0] = v[0] + b_rg[0]; gl[1] = v[1] + b_rg[1]; gl[2] = v[2] + b_rg[2]; gl[3] = v[3] + b_rg[3]; }
            int grp = 0; float mx = gl[0];
            if (gl[1] > mx) { mx = gl[1]; grp = 1; } if (gl[2] > mx) { mx = gl[2]; grp = 2; } if (gl[3] > mx) { mx = gl[3]; grp = 3; }
            const float p_grp = 1.f / (__expf(gl[0] - mx) + __expf(gl[1] - mx) + __expf(gl[2] - mx) + __expf(gl[3] - mx));
            const f32x4 ea = *(const f32x4*)(lg + 4 + grp * 8), eb = *(const f32x4*)(lg + 8 + grp * 8);
            const f32x4 ba = *(const f32x4*)(b_re + grp * 8), bb = *(const f32x4*)(b_re + grp * 8 + 4);
            float b0v = -1e30f, b1v = -1e30f; int i0 = 0, i1 = 0;
#pragma unroll
            for (int j = 0; j < 8; ++j) { const float e = (j < 4) ? ea[j] + ba[j] : eb[j - 4] + bb[j - 4];
                if (e > b0v) { b1v = b0v; i1 = i0; b0v = e; i0 = j; } else if (e > b1v) { b1v = e; i1 = j; } }
            const float p1 = __expf(b1v - b0v), s2 = 1.f + p1;
            e0 = grp * 8 + i0; e1 = grp * 8 + i1; g0 = p_grp / s2; g1 = p_grp * p1 / s2;
            r0 = __hip_atomic_fetch_add(lcnt + e0, 1, __ATOMIC_RELAXED, __HIP_MEMORY_SCOPE_WORKGROUP);
            r1 = __hip_atomic_fetch_add(lcnt + e1, 1, __ATOMIC_RELAXED, __HIP_MEMORY_SCOPE_WORKGROUP);
        }
        __syncthreads();
        if (F.tid < 32) lbase[F.tid] = (int)__hip_atomic_fetch_add(gcnt + F.tid, (unsigned)lcnt[F.tid], __ATOMIC_RELAXED, __HIP_MEMORY_SCOPE_AGENT);
        __syncthreads();
        if (t < F.T) { W.eid[t * 2] = e0; W.eid[t * 2 + 1] = e1; W.gate[t * 2] = g0; W.gate[t * 2 + 1] = g1; W.rank[t * 2] = lbase[e0] + r0; W.rank[t * 2 + 1] = lbase[e1] + r1; }
        __syncthreads();
    }
}
__device__ __forceinline__ void phase_gather(Frame& F, int l) {
    refresh(F);
    const WS W = ws_map(F.ws, F.nb); const float* const* IN_ = F.a->in; (void)IN_; (void)W;
    LAS int* seg = (LAS int*)F.lds; LAS int* cnt = seg + 40;
    const unsigned* gcnt = W.ctl + CW_CNT + l * 64;
    if (F.tid == 0) { int o = 0; for (int e = 0; e < 32; ++e) { const int c = (int)__hip_atomic_load(gcnt + e, __ATOMIC_RELAXED, __HIP_MEMORY_SCOPE_AGENT); seg[e] = o; cnt[e] = c; o += (c + 255) & ~255; } seg[32] = o; }
    __syncthreads();
    const int ntile = seg[32] >> 8;
    if (F.bid == 0) {
        for (int i = F.tid; i < ntile; i += NTHR) { int e = 0; while (e < 31 && (i << 8) >= seg[e + 1]) ++e; W.tilee[i] = e; }
        if (F.tid == 0) W.segp[0] = ntile;
    }
    for (int p = F.bid * NTHR + F.tid; p < (ntile << 8); p += F.G * NTHR) { int e = 0; while (e < 31 && p >= seg[e + 1]) ++e; if (p - seg[e] >= cnt[e]) W.stok[p] = 0; }
    for (int it = F.bid * NTHR + F.tid; it < F.T * 2; it += F.G * NTHR) {
        const int e = W.eid[it], p = seg[e] + W.rank[it];
        W.stok[p] = it >> 1; W.pos[it] = p; W.gsort[p] = W.gate[it];
    }
}

#ifndef MK_MASK
#define MK_MASK 0xffffffffu
#endif
#define EN(b) (((MK_MASK) >> (b)) & 1u)
#ifndef MK_DUP
#define MK_DUP 0u
#endif
#define REPS(b) ((((MK_DUP) >> (b)) & 1u) ? 2 : 1)
constexpr int NPL = 14, NPH = 2 + DEPTH * NPL;
__global__ void __launch_bounds__(NTHR, 2) mk_fwd(Args args) {
    extern __shared__ __attribute__((aligned(16))) unsigned char lds_raw[];
    Frame F;
    F.lds = (LAS unsigned char*)lds_raw; F.tid = threadIdx.x; F.lane = F.tid & 63; F.wave = __builtin_amdgcn_readfirstlane(F.tid >> 6);
    F.G = gridDim.x; F.bid = blockIdx.x; F.nb = args.nb; F.T = args.nb * SEQ; F.ws = args.ws; F.a = &args; F.xbuf = args.out;
    const float* const* IN_ = args.in;
    volatile LAS unsigned* misc = (volatile LAS unsigned*)(F.lds + LDS_MISC);
    if (F.tid < 64) misc[F.tid] = 0u;
    __syncthreads();
    XcdBarrier bar = xcd_barrier_post((unsigned*)args.ws + CW_BAR + args.li * XCD_BAR_WORDS, misc);
    const int lo = args.ph_lo, hi = args.ph_hi;
#define IN(k) (lo <= (k) && (k) < hi)
#ifdef MK_BAR2
#define SEAM(k) do { if (IN(k) && IN((k) + 1)) { xcd_barrier(bar); xcd_barrier(bar); } } while (0)
#else
#define SEAM(k) do { if (IN(k) && IN((k) + 1)) xcd_barrier(bar); } while (0)
#endif
    LAS unsigned char* gl = F.lds;
    if (EN(0) && IN(0)) { for (int rp = 0; rp < REPS(0); ++rp) { p0_prologue(F); __syncthreads(); } SEAM(0); }
    for (int l = 0; l < DEPTH; ++l) {
        const int pb = 1 + l * NPL;
        if (EN(1) && IN(pb + 0)) { for (int rp = 0; rp < ((l == 0) ? REPS(14) : 1); ++rp) phase_norm(F, l, 0); SEAM(pb + 0); }
        if (EN(2) && IN(pb + 1)) { const WS W = ws_map(F.ws, F.nb);
            pg8::Gemm g{W.H, W.win + (size_t)l * NIN * D, F.T, NIN, D}; pg8::StaticOrder S; S.init(F.T, NIN, F.G, F.bid);
            EpiIn E{W.GQ, W.GK, W.GV, W.SG, W.LGF, W.LGB, W.DQ, W.DK, W.DV, W.SGA, W.SGB, IN_[8] + l * 512, IN_[10] + l * 64, IN_[11] + l * 64};
#ifdef MK_DEPHASE
            { const int g_ = (F.bid >> 3) & 7; for (int k_ = 0; k_ < g_ * MK_DEPHASE; ++k_) __builtin_amdgcn_s_sleep(127); }
#endif
#ifdef MK_INPROJ_NULL
            { EpiNull EN_; pg8::gemm_phase<EpiNull, pg8::StaticOrder, true, true>(gl, g, S, EN_); }
#endif
            for (int rp = 0; rp < REPS(2); ++rp) pg8::gemm_phase<EpiIn, pg8::StaticOrder, true, true>(gl, g, S, E);
            SEAM(pb + 1);
        }
        if (EN(3) && IN(pb + 2)) { for (int rp = 0; rp < REPS(3); ++rp) phase_gla1(F); SEAM(pb + 2); }
        if (EN(4) && IN(pb + 3)) { phase_gla2(F); SEAM(pb + 3); }
        if (EN(5) && IN(pb + 4)) { for (int rp = 0; rp < REPS(5); ++rp) phase_gla3(F, l); __syncthreads(); }
        if (EN(6) && IN(pb + 5)) {
#ifdef MK_ATT_PROBE
            phase_attn<MK_ATT_PROBE>(F, l);
#endif
            phase_attn<0>(F, l); SEAM(pb + 5); }
        if (EN(7) && IN(pb + 6)) { const WS W = ws_map(F.ws, F.nb);
            pg8::Gemm g{W.OAB, W.wab + (size_t)l * D * D, 0, 0, 512}; MergeOrder S; S.so.init(F.T, D, F.G, F.bid); S.nM = F.T / 256;
            EpiMerge E{W.SGA, W.SGB, W.MERGED, F.T / 256};
            for (int rp = 0; rp < REPS(7); ++rp) pg8::gemm_phase<EpiMerge, MergeOrder, true, true>(gl, g, S, E);
            SEAM(pb + 6);
        }
        if (EN(8) && IN(pb + 7)) { const WS W = ws_map(F.ws, F.nb); const float* modl = W.mod + (size_t)l * NBMAX * 6 * D;
            pg8::Gemm g{W.MERGED, W.wo + (size_t)l * D * D, F.T, D, D}; pg8::StaticOrder S; S.init(F.T, D, F.G, F.bid);
            EpiResid E{l == 0 ? IN_[0] : nullptr, W.XB, modl + 2 * D};
            for (int rp = 0; rp < ((l == 0) ? REPS(8) : 1); ++rp) pg8::gemm_phase<EpiResid, pg8::StaticOrder, true, true>(gl, g, S, E);
            SEAM(pb + 7);
        }
        if (EN(1) && IN(pb + 8)) { for (int rp = 0; rp < REPS(1); ++rp) phase_norm(F, l, 1); SEAM(pb + 8); }
        if (EN(9) && IN(pb + 9)) { const WS W = ws_map(F.ws, F.nb);
            pg8::Gemm g{W.H, W.wr + (size_t)l * 256 * D, F.T, 256, D}; pg8::StaticOrder S; S.init(F.T, 256, F.G, F.bid);
            EpiLogits E{W.LOGITS};
            for (int rp = 0; rp < REPS(9); ++rp) pg8::gemm_phase<EpiLogits, pg8::StaticOrder, true, true>(gl, g, S, E);
            SEAM(pb + 9);
        }
        if (EN(10) && IN(pb + 10)) { phase_select(F, l); SEAM(pb + 10); }
        if (EN(11) && IN(pb + 11)) { for (int rp = 0; rp < REPS(11); ++rp) { phase_gather(F, l); __syncthreads(); } SEAM(pb + 11); }
        if (EN(12) && IN(pb + 12)) { const WS W = ws_map(F.ws, F.nb);
            const int ntile = W.segp[0];
#if MK_MOE_FP8
            pg8::Gemm g{W.XS, (const bf16*)((const unsigned char*)W.w1 + (size_t)l * NE * 1024 * D), 0, 0, D / 2}; GroupedOrder S{W.tilee, ntile * 4, F.G, F.bid};
            EpiAct E{(unsigned char*)W.ACT};
#else
            pg8::Gemm g{W.H, W.w1 + (size_t)l * NE * 1024 * D, 0, 0, D}; GroupedOrder S{W.tilee, ntile * 4, F.G, F.bid, W.stok};
            EpiAct E{W.ACT};
#endif
            for (int rp = 0; rp < REPS(12); ++rp) pg8::gemm_phase<EpiAct, GroupedOrder, true, true, true>(gl, g, S, E);
            SEAM(pb + 12);
        }
        if (EN(13) && IN(pb + 13)) { const WS W = ws_map(F.ws, F.nb);
            const int ntile = W.segp[0];
#if MK_MOE_FP8
            pg8::Gemm g{W.ACT, (const bf16*)((const unsigned char*)W.w2 + (size_t)l * NE * D * DE), 0, 0, DE / 2}; GroupedOrder S{W.tilee, ntile * 4, F.G, F.bid};
#else
            pg8::Gemm g{W.ACT, W.w2 + (size_t)l * NE * D * DE, 0, 0, DE}; GroupedOrder S{W.tilee, ntile * 4, F.G, F.bid, nullptr};
#endif
            EpiYs E{(unsigned char*)W.YS, W.gsort};
            for (int rp = 0; rp < REPS(13); ++rp) pg8::gemm_phase<EpiYs, GroupedOrder, true, true>(gl, g, S, E);
            SEAM(pb + 13);
        }
    }
    if (EN(1) && IN(NPH - 1)) phase_norm(F, 0, 2);
#undef IN
#undef SEAM
}

struct LaunchCfg { int grid; bool ok; };
inline LaunchCfg& launch_cfg() {
    static LaunchCfg c{0, false}; static bool init = false;
    if (!init) { init = true;
        int dev = 0, cus = 0, per_cu = 0;
        if (hipGetDevice(&dev) != hipSuccess || hipDeviceGetAttribute(&cus, hipDeviceAttributeMultiprocessorCount, dev) != hipSuccess) { fprintf(stderr, "mk: device query failed\n"); return c; }
        if (hipFuncSetAttribute((const void*)mk_fwd, hipFuncAttributeMaxDynamicSharedMemorySize, LDS_BYTES) != hipSuccess) { fprintf(stderr, "mk: hipFuncSetAttribute failed\n"); return c; }
        if (hipOccupancyMaxActiveBlocksPerMultiprocessor(&per_cu, (const void*)mk_fwd, NTHR, LDS_BYTES) != hipSuccess || per_cu < 1) { fprintf(stderr, "mk: occupancy query says %d blocks/CU\n", per_cu); (void)hipGetLastError(); return c; }
        c.grid = cus; c.ok = true;
    }
    return c;
}
inline void launch_range(void* const* d_in, float* xbuf, void* d_ws, int nb, int lo, int hi, int li, hipStream_t stream) {
    LaunchCfg& c = launch_cfg(); if (!c.ok) return;
    Args a{}; for (int i = 0; i < 24; ++i) a.in[i] = (const float*)d_in[i];
    a.out = xbuf; a.ws = (unsigned char*)d_ws; a.nb = nb; a.ph_lo = lo; a.ph_hi = hi; a.li = li;
    hipLaunchKernelGGL(mk_fwd, dim3(c.grid), dim3(NTHR), LDS_BYTES, stream, a);
    const hipError_t le = hipPeekAtLastError(); if (le != hipSuccess) fprintf(stderr, "mk: launch [%d,%d) failed: %s\n", lo, hi, hipGetErrorName(le));
}
}
extern "C" void kernel_launch(void* const* d_in, const int* in_sizes, int n_in, void* d_out, int out_size, void* d_ws, size_t ws_size, hipStream_t stream) {
    (void)in_sizes; (void)n_in; (void)out_size;
    static int checked = 0;
    if (!checked) { checked = 1; const mk::WS w = mk::ws_map((unsigned char*)d_ws, 4); if (w.end > ws_size) { fprintf(stderr, "mk: workspace too small: need %zu, have %zu\n", w.end, ws_size); checked = -1; } }
    if (checked < 0) return;
    if (hipMemsetAsync(d_ws, 0, mk::CTL_BYTES, stream) != hipSuccess) return;
    mk::launch_range(d_in, (float*)d_out, d_ws, 4, 0, mk::NPH, 0, stream);
}
```

```cpp
#include <hip/hip_runtime.h>
#include <cstdio>
#include <cstdint>
#include <cmath>
#define MK_ATT_FP8 1
namespace pg8 {
#define PG8_LAS __attribute__((address_space(3)))
typedef unsigned short bf16_t;
typedef short bf16x8 __attribute__((ext_vector_type(8)));
typedef float f32x4 __attribute__((ext_vector_type(4)));
typedef unsigned u32x4 __attribute__((ext_vector_type(4)));
constexpr int BM = 256, BK = 64, HALF = 128, HTB = HALF * BK * 2  , STAGE_BYTES = 8 * HTB, NXCD = 8, WGM = 8;

__host__ __device__ __forceinline__ int lds_byte(int r, int c) { const int st = (r >> 4) * 2 + (c >> 5), rr = r & 15, cc = c & 31, ob = rr * 64 + cc * 2; return st * 1024 + (ob ^ (((ob >> 9) & 1) << 5)); }
__host__ __device__ __forceinline__ void stage_rc(int b, int& R, int& C) { const int st = b / 1024, sb = b % 1024, swz = sb ^ (((sb >> 9) & 1) << 5); R = (st >> 1) * 16 + swz / 64; C = (st & 1) * 32 + (swz % 64) / 2; }
__host__ __device__ __forceinline__ int perm32(int rho) { const int n = rho >> 4, i = rho & 15; return 8 * (i >> 2) + 4 * n + (i & 3); }

struct Unit { int pm, pn; };
struct Gemm { const bf16_t* A; const bf16_t* Bt; int M, N, K; };

struct StaticOrder {
    int nM, nN, nwg, G, c;
    __host__ __device__ void init(int M, int N, int G_, int c_) { nM = M / BM; nN = N / BM; nwg = nM * nN; G = G_; c = c_; }
    __host__ __device__ bool next(int i, Unit& u) const {
        const long L = (long)i * G + c; if (L >= nwg) return false;
        int wgid = (int)L; { const int q = nwg / NXCD, r = nwg % NXCD, xcd = wgid % NXCD, off = wgid / NXCD; wgid = (xcd < r ? xcd * (q + 1) : r * (q + 1) + (xcd - r) * q) + off; }
        const int nig = WGM * nN, gid = wgid / nig, fm = gid * WGM, gsz = (nM - fm) < WGM ? (nM - fm) : WGM;
        u.pm = fm + ((wgid % nig) % gsz); u.pn = (wgid % nig) / gsz; return true;
    }
    __device__ __forceinline__ void a_ready(const Unit&) const {}
    __device__ __forceinline__ void done(const Unit&) const {}
};
__device__ __forceinline__ unsigned cvt_pk_bf16(float lo, float hi) { unsigned r; asm volatile("v_cvt_pk_bf16_f32 %0, %1, %2" : "=v"(r) : "v"(lo), "v"(hi)); return r; }
__device__ __forceinline__ const void* pg8_uniform(const void* p) { const unsigned long long v = (unsigned long long)p;
    const unsigned lo = (unsigned)__builtin_amdgcn_readfirstlane((int)(unsigned)v), hi = (unsigned)__builtin_amdgcn_readfirstlane((int)(unsigned)(v >> 32)); return (const void*)(((unsigned long long)hi << 32) | lo); }
__device__ __forceinline__ void pg8_glds(const void* sbase, unsigned voff, unsigned ldsdst) { unsigned keep;
    asm volatile("s_nop 4\n\ts_mov_b32 %0, m0\n\ts_mov_b32 m0, %3\n\ts_nop 0\n\tglobal_load_lds_dwordx4 %1, %2\n\ts_mov_b32 m0, %0" : "=&s"(keep) : "v"(voff), "s"(sbase), "s"(ldsdst) : "memory"); }
typedef int pg8_v8i __attribute__((ext_vector_type(8)));
typedef int pg8_v4i __attribute__((ext_vector_type(4)));
template <class Epi, class Sched, bool ALIGN_EPI = false, bool SP2 = false, bool GATHER = false>
__device__ __forceinline__ void gemm_phase(PG8_LAS unsigned char* lds, const Gemm g, const Sched& S, const Epi& E) {
    int tid_ = threadIdx.x; asm volatile("" : "+v"(tid_));
    const int tid = tid_, wid = __builtin_amdgcn_readfirstlane(tid >> 6), lane = tid & 63, wr = wid >> 2, wc = wid & 3, fr = lane & 15, fq = lane >> 4;
    const int K = g.K, nt = K / BK;
    unsigned voffA[2], voffB[2]; unsigned vc[2][2] = {}, vn[2][2] = {}, vs[2][2] = {}; (void)vc; (void)vn; (void)vs;
#pragma unroll
    for (int i = 0; i < 2; ++i) { int R, C; stage_rc(tid * 16 + i * 8192, R, C); const int Rb = Epi::PERM ? ((R & ~31) + perm32(R & 31)) : R;
        voffA[i] = (unsigned)(R * K + C) * 2u; voffB[i] = (unsigned)(Rb * K + C) * 2u; }
    const size_t kstep = (size_t)(BK * 2);
    const size_t hstep = (size_t)HALF * K * 2;
    const size_t tstep = 2 * hstep;
    const unsigned ldsw = (unsigned)wid * 1024u; const unsigned lds0 = (unsigned)(unsigned long)lds; (void)lds0;
    const int aoff = lds_byte(wr * 64 + fr, fq * 8), boff = lds_byte(wc * 32 + fr, fq * 8);
#define PG8_SA(b, h) (((b) * 2 + (h)) * HTB)
#define PG8_SB(b, h) ((4 + (b) * 2 + (h)) * HTB)
#if defined(PG8_ASM_STAGE) && PG8_ASM_STAGE
#define PG8_STAGE(bufoff, gbase, voff) do { const void* _gb = pg8_uniform(gbase); _Pragma("unroll") for (int _i = 0; _i < 2; ++_i) \
        pg8_glds(_gb, (voff)[_i], (unsigned)__builtin_amdgcn_readfirstlane((int)(lds0 + (unsigned)(bufoff) + ldsw + _i * 8192))); } while (0)
#else
#define PG8_STAGE(bufoff, gbase, voff) do { _Pragma("unroll") for (int _i = 0; _i < 2; ++_i) \
        __builtin_amdgcn_global_load_lds((const unsigned*)((const char*)(gbase) + (voff)[_i]), (PG8_LAS unsigned*)(lds + (bufoff) + ldsw + _i * 8192), 16, 0, 0); } while (0)
#endif
#define PG8_STAGE_A(b, h, X, VS) do { if constexpr (GATHER) { PG8_STAGE(PG8_SA(b, h), X, VS[h]); } else { PG8_STAGE(PG8_SA(b, h), (X) + (h) * hstep, voffA); } } while (0)
#define PG8_LOADROWS(u, v) do { _Pragma("unroll") for (int i_ = 0; i_ < 2; ++i_) { int R_, C_; stage_rc(tid * 16 + i_ * 8192, R_, C_); _Pragma("unroll") for (int h_ = 0; h_ < 2; ++h_) \
        v[h_][i_] = (unsigned)S.rowidx[(u).pm * 256 + h_ * 128 + R_] * (unsigned)(K * 2) + (unsigned)C_ * 2u; } } while (0)
#define PG8_LDA(dst, b, h) do { _Pragma("unroll") for (int m = 0; m < 4; ++m) _Pragma("unroll") for (int k = 0; k < 2; ++k) dst[m][k] = *(const PG8_LAS bf16x8*)(lds + PG8_SA(b, h) + aoff + m * 2048 + k * 1024); } while (0)
#define PG8_LDB(dst, b, h) do { _Pragma("unroll") for (int n = 0; n < 2; ++n) _Pragma("unroll") for (int k = 0; k < 2; ++k) dst[n][k] = *(const PG8_LAS bf16x8*)(lds + PG8_SB(b, h) + boff + n * 2048 + k * 1024); } while (0)
#define PG8_MMA(ai, bj, At, Bt) do { __builtin_amdgcn_s_setprio(1); _Pragma("unroll") for (int m = 0; m < 4; ++m) _Pragma("unroll") for (int n = 0; n < 2; ++n) _Pragma("unroll") for (int k = 0; k < 2; ++k) \
        acc[ai][bj][m][n] = __builtin_amdgcn_mfma_f32_16x16x32_bf16(Bt[n][k], At[m][k], acc[ai][bj][m][n], 0, 0, 0); __builtin_amdgcn_s_setprio(0); } while (0)
#define PG8_WAIT_V(n) asm volatile("s_waitcnt vmcnt(" #n ")" ::: "memory")
#define PG8_WAIT_L(n) asm volatile("s_waitcnt lgkmcnt(" #n ")" ::: "memory")
#define PG8_BAR __builtin_amdgcn_s_barrier()
#define PG8_SCHED __builtin_amdgcn_sched_barrier(0)
    Unit cur, nxt; int ui = 0;
    if (!S.next(0, cur)) return;
    f32x4 acc[2][2][4][2];
#pragma unroll
    for (int a = 0; a < 2; ++a)
#pragma unroll
        for (int b = 0; b < 2; ++b)
#pragma unroll
            for (int m = 0; m < 4; ++m)
#pragma unroll
                for (int n = 0; n < 2; ++n) acc[a][b][m][n] = (f32x4){0.f, 0.f, 0.f, 0.f};
    bf16x8 At[4][2], B0[2][2], B1[2][2];
    const char* cA = (const char*)g.A + (GATHER ? (size_t)0 : (size_t)cur.pm * tstep); const char* cB = (const char*)g.Bt + (size_t)cur.pn * tstep;
    S.a_ready(cur);
    if constexpr (GATHER) { PG8_LOADROWS(cur, vc); }
    if constexpr (SP2) {
        PG8_STAGE(PG8_SB(0, 0), cB, voffB); PG8_STAGE(PG8_SB(0, 1), cB + hstep, voffB); PG8_STAGE_A(0, 0, cA, vc); PG8_STAGE_A(0, 1, cA, vc);
        if (wr == 1) PG8_BAR;
        PG8_WAIT_V(2); PG8_BAR;
        PG8_STAGE(PG8_SB(1, 0), cB + kstep, voffB); PG8_STAGE_A(1, 0, cA + kstep, vc); PG8_STAGE(PG8_SB(1, 1), cB + hstep + kstep, voffB);
        PG8_WAIT_V(6); PG8_BAR;
    } else {
        PG8_STAGE(PG8_SB(0, 0), cB, voffB); PG8_STAGE_A(0, 0, cA, vc); PG8_STAGE(PG8_SB(0, 1), cB + hstep, voffB); PG8_STAGE_A(0, 1, cA, vc);
        if (wr == 1) PG8_BAR;
        PG8_WAIT_V(4); PG8_BAR;
        PG8_STAGE(PG8_SB(1, 0), cB + kstep, voffB); PG8_STAGE_A(1, 0, cA + kstep, vc); PG8_STAGE(PG8_SB(1, 1), cB + hstep + kstep, voffB);
        PG8_WAIT_V(6); PG8_BAR;
    }
    for (;;) {
        const bool has_next = S.next(ui + 1, nxt);
        const char* nA = (has_next && !GATHER) ? (const char*)g.A + (size_t)nxt.pm * tstep : cA; const char* nB = has_next ? (const char*)g.Bt + (size_t)nxt.pn * tstep : cB;
        for (int t = 0; t < nt; t += 2) {
            const bool last = (t == nt - 2);
            const char* a1 = cA + (size_t)(t + 1) * kstep;
            const char* a2 = last ? nA : cA + (size_t)(t + 2) * kstep; const char* b2 = last ? nB : cB + (size_t)(t + 2) * kstep;
            const char* a3 = a2 + kstep; const char* b3 = b2 + kstep;
            if (last && has_next) S.a_ready(nxt);
            if constexpr (GATHER) { if (last && has_next) { PG8_LOADROWS(nxt, vn); }
                _Pragma("unroll") for (int h_ = 0; h_ < 2; ++h_) _Pragma("unroll") for (int i_ = 0; i_ < 2; ++i_) vs[h_][i_] = (last && has_next) ? vn[h_][i_] : vc[h_][i_]; }
            if constexpr (Epi::MIDK) { if (t == nt / 2) E.mid(acc, cur, wr, wc, fr, fq); }
            if constexpr (SP2) {
            PG8_LDB(B0, 0, 0); PG8_LDB(B1, 0, 1); PG8_SCHED; PG8_LDA(At, 0, 0); PG8_STAGE_A(1, 1, a1, vc);
            PG8_WAIT_V(8); PG8_WAIT_L(0); PG8_BAR; PG8_MMA(0, 0, At, B0); PG8_MMA(0, 1, At, B1); PG8_BAR; PG8_SCHED;
            PG8_LDA(At, 0, 1); PG8_STAGE(PG8_SB(0, 0), b2, voffB); PG8_STAGE(PG8_SB(0, 1), b2 + hstep, voffB); PG8_STAGE_A(0, 0, a2, vs);
            PG8_WAIT_V(8); PG8_WAIT_L(0); PG8_BAR; PG8_MMA(1, 0, At, B0); PG8_MMA(1, 1, At, B1); PG8_BAR; PG8_SCHED;
            PG8_LDB(B0, 1, 0); PG8_LDB(B1, 1, 1); PG8_SCHED; PG8_LDA(At, 1, 0); PG8_STAGE_A(0, 1, a2, vs);
            PG8_WAIT_V(8); PG8_WAIT_L(0); PG8_BAR; PG8_MMA(0, 0, At, B0); PG8_MMA(0, 1, At, B1); PG8_BAR; PG8_SCHED;
            PG8_LDA(At, 1, 1); PG8_STAGE(PG8_SB(1, 0), b3, voffB); PG8_STAGE(PG8_SB(1, 1), b3 + hstep, voffB); PG8_STAGE_A(1, 0, a3, vs);
            PG8_WAIT_V(8); PG8_WAIT_L(0); PG8_BAR; PG8_MMA(1, 0, At, B0); PG8_MMA(1, 1, At, B1); PG8_BAR; PG8_SCHED;
            } else {
            PG8_LDB(B0, 0, 0); PG8_SCHED; PG8_LDA(At, 0, 0); PG8_STAGE_A(1, 1, a1, vc);
            PG8_WAIT_L(8); PG8_BAR; PG8_WAIT_L(0); PG8_MMA(0, 0, At, B0); PG8_BAR; PG8_SCHED;
            PG8_LDB(B1, 0, 1); PG8_STAGE(PG8_SB(0, 0), b2, voffB);
            PG8_BAR; PG8_WAIT_L(0); PG8_MMA(0, 1, At, B1); PG8_BAR;
            PG8_LDA(At, 0, 1); PG8_STAGE_A(0, 0, a2, vs);
            PG8_BAR; PG8_WAIT_L(0); PG8_MMA(1, 0, At, B0); PG8_BAR; PG8_SCHED;
            PG8_STAGE(PG8_SB(0, 1), b2 + hstep, voffB);
            PG8_WAIT_V(6); PG8_BAR; PG8_MMA(1, 1, At, B1); PG8_BAR;
            PG8_LDB(B0, 1, 0); PG8_SCHED; PG8_LDA(At, 1, 0); PG8_STAGE_A(0, 1, a2, vs);
            PG8_WAIT_L(8); PG8_BAR; PG8_WAIT_L(0); PG8_MMA(0, 0, At, B0); PG8_BAR; PG8_SCHED;
            PG8_LDB(B1, 1, 1); PG8_STAGE(PG8_SB(1, 0), b3, voffB);
            PG8_BAR; PG8_WAIT_L(0); PG8_MMA(0, 1, At, B1); PG8_BAR;
            PG8_LDA(At, 1, 1); PG8_STAGE_A(1, 0, a3, vs);
            PG8_BAR; PG8_WAIT_L(0); PG8_MMA(1, 0, At, B0); PG8_BAR; PG8_SCHED;
            PG8_STAGE(PG8_SB(1, 1), b3 + hstep, voffB);
            PG8_WAIT_V(6); PG8_BAR; PG8_MMA(1, 1, At, B1); PG8_BAR;
            }
        }
        if constexpr (ALIGN_EPI) { if (wr == 0) PG8_BAR; }
        if constexpr (!Epi::AFTER_DRAIN) { E(acc, cur, wr, wc, fr, fq); S.done(cur); }
        if (!has_next) break;
#pragma unroll
        for (int a = 0; a < 2; ++a)
#pragma unroll
            for (int b = 0; b < 2; ++b)
#pragma unroll
                for (int m = 0; m < 4; ++m)
#pragma unroll
                    for (int n = 0; n < 2; ++n) acc[a][b][m][n] = (f32x4){0.f, 0.f, 0.f, 0.f};
        cur = nxt; cA = nA; cB = nB; ++ui;
        if constexpr (GATHER) { _Pragma("unroll") for (int h_ = 0; h_ < 2; ++h_) _Pragma("unroll") for (int i_ = 0; i_ < 2; ++i_) vc[h_][i_] = vn[h_][i_]; }
        if constexpr (ALIGN_EPI) { if (wr == 1) PG8_BAR; }
    }
    PG8_WAIT_V(0);
    if constexpr (!ALIGN_EPI) { if (wr == 0) PG8_BAR; }
    PG8_BAR;
    if constexpr (Epi::AFTER_DRAIN) { E.fused(acc, cur, wr, wc, fr, fq, lds, wid, lane); S.done(cur); }
#undef PG8_SA
#undef PG8_SB
#undef PG8_STAGE
#undef PG8_STAGE_A
#undef PG8_LOADROWS
#undef PG8_LDA
#undef PG8_LDB
#undef PG8_MMA
#undef PG8_WAIT_V
#undef PG8_WAIT_L
#undef PG8_BAR
#undef PG8_SCHED
}
}
namespace mk {
constexpr int D = 1024, SEQ = 8192, NBMAX = 4, NH = 4, DIN = 5152, NE = 32, DE = 512, DEPTH = 2;
constexpr int NT_IN = 22, NIN = NT_IN * 256;
constexpr int NWAVES = 8, NTHR = 512;
#ifndef MK_MOE_FP8
#define MK_MOE_FP8 0
#endif
constexpr float WSCALE = 16.f, ASCALE = 4.f, YSCALE = 32.f;
constexpr float LOG2E = 1.4426950408889634f, QSCALE = 0.125f * LOG2E, RMS_EPS = 1e-6f;
constexpr int O_GQ = 0, O_GK = 256, O_GV = 512, O_GG = 1024, O_LRF = 1536, O_LRB = 1552, O_DQ = 1568, O_DK = 2080, O_DV = 2592, O_GA = 3104, O_GB = 4128;
typedef unsigned short bf16;
typedef unsigned u32x4 __attribute__((ext_vector_type(4)));
typedef unsigned u32x2 __attribute__((ext_vector_type(2)));
typedef float f32x4 __attribute__((ext_vector_type(4)));
typedef float f32x16 __attribute__((ext_vector_type(16)));
typedef short bf16x8 __attribute__((ext_vector_type(8)));
typedef short s16x4 __attribute__((ext_vector_type(4)));
#define LAS __attribute__((address_space(3)))
#define GAS __attribute__((address_space(1)))
#define LDS_WAIT() asm volatile("s_waitcnt lgkmcnt(0)" ::: "memory")
#define VM_WAIT() asm volatile("s_waitcnt vmcnt(0)" ::: "memory")

constexpr size_t MiB = 1u << 20;
constexpr size_t CTL_BYTES = 256 * 1024;
constexpr int CW_BAR = 4096;
constexpr int CW_CNT = 32768;
constexpr size_t OFF_MOD = 256 * 1024, OFF_TAB = 512 * 1024;
constexpr size_t OFF_WIN = 1 * MiB, SZ_WIN = (size_t)DEPTH * NIN * D * 2;
constexpr size_t OFF_WAB = OFF_WIN + SZ_WIN, SZ_WAB = (size_t)DEPTH * D * D * 2;
constexpr size_t OFF_WO = OFF_WAB + SZ_WAB, SZ_WO = SZ_WAB;
constexpr size_t OFF_WR = OFF_WO + SZ_WO, SZ_WR = (size_t)DEPTH * 256 * D * 2;
constexpr size_t OFF_W1 = OFF_WR + SZ_WR, SZ_W1 = (size_t)DEPTH * NE * 1024 * D * 2;
constexpr size_t OFF_W2 = OFF_W1 + SZ_W1, SZ_W2 = (size_t)DEPTH * NE * D * DE * 2;
constexpr size_t OFF_ACT = 225 * MiB;
static_assert(OFF_W2 + SZ_W2 <= OFF_ACT, "weights fit");
struct WS {
    unsigned* ctl; float* mod; float* tab;
    bf16 *win, *wab, *wo, *wr, *w1, *w2;
    bf16 *H, *OAB, *XB; int* eid; float* gate; int* rank; int* pos; int* tilee; int* segp;
    bf16 *GQ, *GK, *GV, *SG; bf16 *LGF, *LGB; bf16 *DQ, *DK, *DV, *SGA, *SGB; float* KVT; float* DEC; bf16* MERGED;
    bf16 *XS, *ACT, *YS; float* LOGITS; float* gsort; int* stok;
    size_t end;
};
__host__ __device__ inline WS ws_map(unsigned char* b, int nb) {
    WS w; const size_t T = (size_t)nb * SEQ;
    w.ctl = (unsigned*)b; w.mod = (float*)(b + OFF_MOD); w.tab = (float*)(b + OFF_TAB);
    w.win = (bf16*)(b + OFF_WIN); w.wab = (bf16*)(b + OFF_WAB); w.wo = (bf16*)(b + OFF_WO); w.wr = (bf16*)(b + OFF_WR); w.w1 = (bf16*)(b + OFF_W1); w.w2 = (bf16*)(b + OFF_W2);
    size_t o = OFF_ACT;
    auto take = [&](size_t bytes) { unsigned char* p = b + o; o += (bytes + 255) & ~(size_t)255; return p; };
    w.H = (bf16*)take(T * 2048); w.OAB = (bf16*)take(T * 2048); w.XB = (bf16*)take(T * 2048);
    w.eid = (int*)take(T * 8); w.gate = (float*)take(T * 8); w.rank = (int*)take(T * 8); w.pos = (int*)take(T * 8); w.tilee = (int*)take(4096); w.segp = (int*)take(1024);
    const size_t u0 = o;
    w.GQ = (bf16*)take(T * 512); w.GK = (bf16*)take(T * 512); w.GV = (bf16*)take(T * 1024); w.SG = (bf16*)take(T * 1024);
    w.LGF = (bf16*)take(T * 512); w.LGB = (bf16*)take(T * 512);
    w.DQ = (bf16*)take(T * 1024); w.DK = (bf16*)take(T * 1024); w.DV = (bf16*)take(T * 1024); w.SGA = (bf16*)take(T * 2048); w.SGB = (bf16*)take(T * 2048);
    w.KVT = (float*)take(T * 4096); w.MERGED = (bf16*)w.KVT; w.DEC = (float*)take(T * 32);
    const size_t e1 = o; o = u0;
    const size_t R = 2 * T + 32 * 256;
    w.XS = (bf16*)take(R * 2048); w.ACT = (bf16*)take(R * 1024); w.YS = (bf16*)take(R * 2048); w.LOGITS = (float*)take(T * 256); w.gsort = (float*)take(R * 4); w.stok = (int*)take(R * 4);
    w.end = o > e1 ? o : e1;
    return w;
}

__device__ __forceinline__ unsigned cvt_pk(float lo, float hi) { unsigned r; asm volatile("v_cvt_pk_bf16_f32 %0, %1, %2" : "=v"(r) : "v"(lo), "v"(hi)); return r; }
__device__ __forceinline__ float bf2f(unsigned short b) { return __uint_as_float(((unsigned)b) << 16); }
__device__ __forceinline__ float bflo(unsigned w) { return __uint_as_float(w << 16); }
__device__ __forceinline__ float bfhi(unsigned w) { return __uint_as_float(w & 0xffff0000u); }
__device__ __forceinline__ float fsigmoid(float x) { return __builtin_amdgcn_rcpf(1.f + __expf(-x)); }
__device__ __forceinline__ float fsilu(float x) { return x * fsigmoid(x); }
__device__ __forceinline__ float wave_sum(float v) {
#pragma unroll
    for (int o = 1; o < 64; o <<= 1) v += __shfl_xor(v, o);
    return v;
}
__device__ __forceinline__ int t5_bucket(int rel) {
    int ret = rel > 0 ? 16 : 0; int n = rel < 0 ? -rel : rel;
    if (n < 8) return ret + n;
    return ret + 8 + (n >= 12) + (n >= 16) + (n >= 23) + (n >= 32) + (n >= 46) + (n >= 64) + (n >= 91);
}

#define XB_TMO      128
#define XB_XCNT(j)  (256  + 64 * (j))
#define XB_XSUB(j)  (1280 + 64 * (j))
#define XB_XGEN(j)  (2304 + 64 * (j))
#define XB_TOP      3328
#define XB_TOPGEN   3392
#define XCD_BAR_WORDS 3456
#define XB_SPIN_CAP (1u << 18)
__device__ __forceinline__ unsigned xb_ld(unsigned* p)              { return __hip_atomic_load(p, __ATOMIC_RELAXED, __HIP_MEMORY_SCOPE_AGENT); }
__device__ __forceinline__ unsigned xb_add(unsigned* p, unsigned v) { return __hip_atomic_fetch_add(p, v, __ATOMIC_RELAXED, __HIP_MEMORY_SCOPE_AGENT); }
__device__ __forceinline__ unsigned xb_xcc_id() { return (unsigned)__builtin_amdgcn_s_getreg((3 << 11) | 20) & 0xFu; }
#define XB_SPIN(cond, bar) do { unsigned _sp = 0; while (cond) { __builtin_amdgcn_s_sleep(1); \
    if ((++_sp & 255u) == 0u) { if (xb_ld(&(bar)[XB_TMO])) break; if (_sp > XB_SPIN_CAP) { atomicAdd(&(bar)[XB_TMO], 1u); break; } } } } while (0)
struct XcdBarrier { unsigned* bar; unsigned x; volatile LAS unsigned* st; };
__device__ __forceinline__ XcdBarrier xcd_barrier_post(unsigned* bar, volatile LAS unsigned* st) {
    XcdBarrier b; b.bar = bar; b.x = xb_xcc_id(); b.st = st;
    if (threadIdx.x == 0) (void)xb_add(&bar[XB_XCNT(b.x)], 1u);
    return b;
}
__device__ __forceinline__ void xcd_barrier_complete(unsigned* bar, unsigned x, unsigned& nloc, unsigned& nx) {
    const unsigned G = gridDim.x * gridDim.y * gridDim.z;
    unsigned sum, cnt, mine, sp = 0u;
    for (;;) {
        sum = 0u; cnt = 0u; mine = 0u;
#pragma unroll
        for (unsigned j = 0; j < 16; ++j) { const unsigned c = xb_ld(&bar[XB_XCNT(j)]); sum += c; cnt += (c > 0u) ? 1u : 0u; mine = (j == x) ? c : mine; }
        if (sum == G) break;
        __builtin_amdgcn_s_sleep(1);
        if ((++sp & 255u) == 0u) { if (xb_ld(&bar[XB_TMO])) break; if (sp > XB_SPIN_CAP) { atomicAdd(&bar[XB_TMO], 1u); break; } }
    }
    nloc = mine > 0u ? mine : 1u; nx = cnt > 0u ? cnt : 1u;
}
__device__ __forceinline__ void xcd_barrier(const XcdBarrier& b) {
    asm volatile("s_waitcnt vmcnt(0)" ::: "memory");
    __syncthreads();
    if (threadIdx.x == 0) {
        unsigned* bar = b.bar;
        __builtin_amdgcn_s_waitcnt(0);
        unsigned nloc = b.st[0], nx = b.st[1];
        if (nloc == 0u) { xcd_barrier_complete(bar, b.x, nloc, nx); b.st[0] = nloc; b.st[1] = nx; }
        const unsigned old = xb_add(&bar[XB_XSUB(b.x)], 1u);
        const unsigned gen = old / nloc;
        if (old + 1u == (gen + 1u) * nloc) {
            __builtin_amdgcn_fence(__ATOMIC_RELEASE, "agent");
            asm volatile("s_waitcnt vmcnt(0)" ::: "memory");
            const unsigned og = xb_add(&bar[XB_TOP], 1u);
            const unsigned tg = og / nx;
            if (og + 1u == (tg + 1u) * nx) xb_add(&bar[XB_TOPGEN], 1u);
            else XB_SPIN(xb_ld(&bar[XB_TOPGEN]) == tg, bar);
            __builtin_amdgcn_fence(__ATOMIC_ACQUIRE, "agent");
            xb_add(&bar[XB_XGEN(b.x)], 1u);
            asm volatile("s_waitcnt vmcnt(0)" ::: "memory");
        } else {
            XB_SPIN(xb_ld(&bar[XB_XGEN(b.x)]) == gen, bar);
            __builtin_amdgcn_fence(__ATOMIC_ACQUIRE, "agent");
            asm volatile("s_waitcnt vmcnt(0)" ::: "memory");
        }
    }
    __syncthreads();
}

struct Args { const float* in[24]; float* out; unsigned char* ws; int nb, ph_lo, ph_hi, li; };
struct Frame {
    LAS unsigned char* lds; int tid, lane, wave, G, bid, nb, T; unsigned char* ws; const Args* a; float* xbuf;
};
__device__ __forceinline__ void refresh(Frame& F) { int t = threadIdx.x; asm volatile("" : "+v"(t)); F.tid = t; F.lane = t & 63; F.wave = __builtin_amdgcn_readfirstlane(t >> 6); }
constexpr int LDS_BYTES = 160 * 1024 - 64 * 0;
constexpr int LDS_MISC = 160 * 1024 - 256;

__device__ __forceinline__ void tr_item(const float* src, int lds_, int ks0, int c0, bf16* dst, int ldd, int r0, int kd0, LAS float* scr, int lane) {
#pragma unroll 8
    for (int i = 0; i < 32; ++i) { const int kk = 2 * i + (lane >> 5); scr[kk * 33 + (lane & 31)] = src[(size_t)(ks0 + kk) * lds_ + c0 + (lane & 31)]; }
    LDS_WAIT(); asm volatile("" ::: "memory");
    const int c = lane & 7;
#pragma unroll
    for (int j = 0; j < 4; ++j) { const int n = (lane >> 3) + 8 * j; const LAS float* s = scr + (8 * c) * 33 + n;
        u32x4 o; o.x = cvt_pk(s[0 * 33], s[1 * 33]); o.y = cvt_pk(s[2 * 33], s[3 * 33]); o.z = cvt_pk(s[4 * 33], s[5 * 33]); o.w = cvt_pk(s[6 * 33], s[7 * 33]);
        *(u32x4*)(dst + (size_t)(r0 + n) * ldd + kd0 + 8 * c) = o; }
    LDS_WAIT(); asm volatile("" ::: "memory");
}
__device__ __forceinline__ void tr_item8(const float* src, int lds_, int ks0, int c0, unsigned char* dst, int ldd, int r0, int kd0, float scale, LAS float* scr, int lane) {
#pragma unroll 8
    for (int i = 0; i < 32; ++i) { const int kk = 2 * i + (lane >> 5); scr[kk * 33 + (lane & 31)] = src[(size_t)(ks0 + kk) * lds_ + c0 + (lane & 31)] * scale; }
    LDS_WAIT(); asm volatile("" ::: "memory");
    const int c = lane & 7;
#pragma unroll
    for (int j = 0; j < 4; ++j) { const int n = (lane >> 3) + 8 * j; const LAS float* s = scr + (8 * c) * 33 + n;
        int w0 = 0, w1 = 0;
        w0 = __builtin_amdgcn_cvt_pk_fp8_f32(s[0 * 33], s[1 * 33], w0, false); w0 = __builtin_amdgcn_cvt_pk_fp8_f32(s[2 * 33], s[3 * 33], w0, true);
        w1 = __builtin_amdgcn_cvt_pk_fp8_f32(s[4 * 33], s[5 * 33], w1, false); w1 = __builtin_amdgcn_cvt_pk_fp8_f32(s[6 * 33], s[7 * 33], w1, true);
        u32x2 o; o.x = (unsigned)w0; o.y = (unsigned)w1;
        *(u32x2*)(dst + (size_t)(r0 + n) * ldd + kd0 + 8 * c) = o; }
    LDS_WAIT(); asm volatile("" ::: "memory");
}
__device__ __forceinline__ int win_src_col(int tile, int p0) {
    const int bj = p0 >> 7, wc = (p0 >> 5) & 3; const int L = 64 * wc + 32 * bj;
    switch (tile) {
        case 0: return O_GQ + p0; case 1: return O_GK + p0;
        case 2: case 3: return O_GV + (tile - 2) * 256 + p0;
        case 4: case 5: return O_GG + (tile - 4) * 256 + p0;
        case 8: case 9: return O_DQ + (tile - 8) * 256 + L;
        case 10: case 11: return O_DK + (tile - 10) * 256 + L;
        case 12: case 13: return O_DV + (tile - 12) * 256 + p0;
        case 14: case 15: case 16: case 17: return O_GA + (tile - 14) * 256 + p0;
        default: return O_GB + (tile - 18) * 256 + p0;
    }
}
__device__ __forceinline__ void p0_prologue(Frame& F) {
    refresh(F);
    const WS W = ws_map(F.ws, F.nb); const float* const* IN_ = F.a->in;
    const float* c_in = IN_[1]; const float* w_ada = IN_[2]; const float* b_ada = IN_[3];
    {
        LAS float* red = (LAS float*)F.lds;
        for (int it = F.bid; it < DEPTH * 96; it += F.G) {
            const int l = it / 96, j = (it % 96) * 64 + F.lane;
            const float* w = w_ada + (size_t)l * D * 6 * D + j;
            float a0 = 0.f, a1 = 0.f, a2 = 0.f, a3 = 0.f;
            const int kbeg = F.wave * 128;
#pragma unroll 16
            for (int k = kbeg; k < kbeg + 128; ++k) { const float wv = w[(size_t)k * 6 * D];
                const float c0 = c_in[k], c1 = c_in[D + k], c2 = c_in[2 * D + k], c3 = c_in[3 * D + k];
                a0 += fsilu(c0) * wv; a1 += fsilu(c1) * wv; a2 += fsilu(c2) * wv; a3 += fsilu(c3) * wv; }
            red[(F.wave * 4 + 0) * 64 + F.lane] = a0; red[(F.wave * 4 + 1) * 64 + F.lane] = a1; red[(F.wave * 4 + 2) * 64 + F.lane] = a2; red[(F.wave * 4 + 3) * 64 + F.lane] = a3;
            __syncthreads();
            if (F.tid < 256) { const int b = F.tid >> 6, jj = F.tid & 63; float s = 0.f;
#pragma unroll
                for (int wv = 0; wv < 8; ++wv) s += red[(wv * 4 + b) * 64 + jj];
                const int jc = (it % 96) * 64 + jj;
                W.mod[((size_t)l * NBMAX + b) * 6 * D + jc] = s + b_ada[l * 6 * D + jc]; }
            __syncthreads();
        }
    }
    if (F.bid == 0) {
        const float* rb = IN_[14];
        for (int i = F.tid; i < 1024; i += NTHR) { const int h = i >> 8, rel = (i & 255) - 128; W.tab[i] = (rb[t5_bucket(rel) * 4 + h] - rb[31 * 4 + h]) * LOG2E; }
        if (F.tid < 4) W.tab[1024 + F.tid] = __expf(rb[15 * 4 + F.tid] - rb[31 * 4 + F.tid]);
        if (F.tid >= 64 && F.tid < 64 + DEPTH) { const int l = F.tid - 64; const float* lv = IN_[12] + l * 256; float s1 = 0.f, s2 = 0.f;
            for (int i = 0; i < 64; ++i) { s1 += lv[i] * lv[64 + i]; s2 += lv[128 + i] * lv[192 + i]; }
            W.tab[1032 + l] = expf(s1) - expf(s2) + (0.8f - 0.6f * expf(-0.3f * (float)l)); }
    }
    __syncthreads();
    LAS float* scr = (LAS float*)(F.lds + F.wave * 16384);
    const int gw = F.bid * NWAVES + F.wave, NGW = F.G * NWAVES;
    constexpr int I_IN = (NIN / 32) * 16, I_AB = 32 * 16, I_O = 32 * 16, I_1 = NE * 32 * 16, I_2 = NE * 32 * 8;
    constexpr int PER_L = I_IN + I_AB + I_O + I_1 + I_2;
    for (int it = gw; it < DEPTH * PER_L; it += NGW) {
        const int l = it / PER_L; int r = it % PER_L;
        if (r < I_IN) { const int rb = r / 16, kb = r % 16, R = rb * 32, tile = R >> 8, p0 = R & 255;
            if (tile == 6 || tile == 7) continue;
            tr_item(IN_[6] + (size_t)l * D * DIN, DIN, kb * 64, win_src_col(tile, p0), W.win + (size_t)l * NIN * D, D, R, kb * 64, scr, F.lane); continue; }
        r -= I_IN;
        if (r < I_AB) { const int rb = r / 16, kb = r % 16;
            if (kb < 8) tr_item(IN_[15] + (size_t)l * 512 * D, D, kb * 64, rb * 32, W.wab + (size_t)l * D * D, 512, rb * 32, kb * 64, scr, F.lane);
            else tr_item(IN_[16] + (size_t)l * 512 * D, D, (kb - 8) * 64, rb * 32, W.wab + (size_t)l * D * D + (size_t)1024 * 512, 512, rb * 32, (kb - 8) * 64, scr, F.lane);
            continue; }
        r -= I_AB;
        if (r < I_O) { const int rb = r / 16, kb = r % 16; tr_item(IN_[17] + (size_t)l * D * D, D, kb * 64, rb * 32, W.wo + (size_t)l * D * D, D, rb * 32, kb * 64, scr, F.lane); continue; }
        r -= I_O;
        if (r < I_1) { const int e = r / 512, q = r % 512, rb = q / 16, kb = q % 16, R = rb * 32, pn = R >> 8, p = R & 255;
            const int col = (p < 128) ? (128 * pn + p) : (512 + 128 * pn + p - 128);
#if MK_MOE_FP8
            tr_item8(IN_[22] + ((size_t)l * NE + e) * D * 1024, 1024, kb * 64, col, (unsigned char*)W.w1 + ((size_t)l * NE + e) * 1024 * D, D, R, kb * 64, WSCALE, scr, F.lane); continue; }
#else
            tr_item(IN_[22] + ((size_t)l * NE + e) * D * 1024, 1024, kb * 64, col, W.w1 + ((size_t)l * NE + e) * 1024 * D, D, R, kb * 64, scr, F.lane); continue; }
#endif
        r -= I_1;
        { const int e = r / 256, q = r % 256, rb = q / 8, kb = q % 8;
#if MK_MOE_FP8
          tr_item8(IN_[23] + ((size_t)l * NE + e) * DE * D, D, kb * 64, rb * 32, (unsigned char*)W.w2 + ((size_t)l * NE + e) * D * DE, DE, rb * 32, kb * 64, WSCALE, scr, F.lane); }
#else
          tr_item(IN_[23] + ((size_t)l * NE + e) * DE * D, D, kb * 64, rb * 32, W.w2 + ((size_t)l * NE + e) * D * DE, DE, rb * 32, kb * 64, scr, F.lane); }
#endif
    }
    for (int it = gw; it < DEPTH * 2 * 8 * 16; it += NGW) {
        const int l = it >> 8, dir = (it >> 7) & 1, nbk = (it >> 4) & 7, kb = it & 15; const int k = kb * 64 + F.lane;
        const float* wi = IN_[6] + (size_t)l * D * DIN + (size_t)k * DIN + (dir ? O_LRB : O_LRF);
        float wv[16];
#pragma unroll
        for (int r = 0; r < 16; ++r) wv[r] = wi[r];
        const float* wu = IN_[7] + ((size_t)l * 2 + dir) * 16 * 256;
        bf16* dst = W.win + (size_t)l * NIN * D + (size_t)((6 + dir) * 256) * D;
        for (int n = nbk * 32; n < nbk * 32 + 32; ++n) { float s = 0.f;
#pragma unroll
            for (int r = 0; r < 16; ++r) s += wv[r] * wu[r * 256 + n];
            dst[(size_t)n * D + k] = (bf16)(cvt_pk(s, 0.f) & 0xffffu); }
    }
    for (int it = gw * 64 + F.lane; it < DEPTH * 256 * 128; it += NGW * 64) {
        const int l = it / (256 * 128), q = it % (256 * 128), row = q >> 7, k0 = (q & 127) * 8;
        float v[8];
#pragma unroll
        for (int i = 0; i < 8; ++i) { float x = 0.f;
            if (row < 4) x = IN_[18][((size_t)l * D + k0 + i) * 4 + row]; else if (row < 36) x = IN_[20][((size_t)l * D + k0 + i) * 32 + row - 4];
            v[i] = x; }
        u32x4 o; o.x = cvt_pk(v[0], v[1]); o.y = cvt_pk(v[2], v[3]); o.z = cvt_pk(v[4], v[5]); o.w = cvt_pk(v[6], v[7]);
        *(u32x4*)(W.wr + ((size_t)l * 256 + row) * D + k0) = o;
    }
}

__device__ __forceinline__ void phase_norm(Frame& F, int l, int mode) {
    refresh(F);
    const WS W = ws_map(F.ws, F.nb); const float* const* IN_ = F.a->in;
    const int gw = F.bid * NWAVES + F.wave, NGW = F.G * NWAVES;
    const bool combine = (mode == 2) || (mode == 0 && l > 0);
    const bool from_in = (mode == 0 && l == 0);
    const int lp = (mode == 2) ? DEPTH - 1 : l - 1;
    const float* ng = (mode == 1 ? IN_[5] : IN_[4]) + (size_t)(mode == 2 ? 0 : l) * D;
    for (int t = gw; t < F.T; t += NGW) {
        const int b = t / SEQ;
        f32x4 v[4];
        if (from_in) { const GAS f32x4* xr = (const GAS f32x4*)(IN_[0] + (size_t)t * D) + F.lane;
#pragma unroll
            for (int j = 0; j < 4; ++j) v[j] = xr[64 * j]; }
        else { const GAS u32x2* xr = (const GAS u32x2*)(W.XB + (size_t)t * D) + F.lane;
#pragma unroll
            for (int j = 0; j < 4; ++j) { const u32x2 a = xr[64 * j]; v[j] = (f32x4){bflo(a.x), bfhi(a.x), bflo(a.y), bfhi(a.y)}; } }
        if (combine) {
            const float* g2 = W.mod + ((size_t)lp * NBMAX + b) * 6 * D + 5 * D;
            const int p0 = W.pos[t * 2], p1 = W.pos[t * 2 + 1];
            const GAS unsigned* y0 = (const GAS unsigned*)((const unsigned char*)W.YS + (size_t)p0 * D) + F.lane; const GAS unsigned* y1 = (const GAS unsigned*)((const unsigned char*)W.YS + (size_t)p1 * D) + F.lane;
#pragma unroll
            for (int j = 0; j < 4; ++j) { const unsigned a = y0[64 * j], c = y1[64 * j]; const f32x4 g = *((const GAS f32x4*)g2 + F.lane + 64 * j) * (1.f / YSCALE);
                v[j].x += g.x * (__builtin_amdgcn_cvt_f32_fp8((int)a, 0) + __builtin_amdgcn_cvt_f32_fp8((int)c, 0)); v[j].y += g.y * (__builtin_amdgcn_cvt_f32_fp8((int)a, 1) + __builtin_amdgcn_cvt_f32_fp8((int)c, 1));
                v[j].z += g.z * (__builtin_amdgcn_cvt_f32_fp8((int)a, 2) + __builtin_amdgcn_cvt_f32_fp8((int)c, 2)); v[j].w += g.w * (__builtin_amdgcn_cvt_f32_fp8((int)a, 3) + __builtin_amdgcn_cvt_f32_fp8((int)c, 3)); }
            if (mode == 2) { GAS f32x4* xo = (GAS f32x4*)(F.xbuf + (size_t)t * D) + F.lane;
#pragma unroll
                for (int j = 0; j < 4; ++j) xo[64 * j] = v[j]; }
            else { GAS u32x2* xo = (GAS u32x2*)(W.XB + (size_t)t * D) + F.lane;
#pragma unroll
                for (int j = 0; j < 4; ++j) { u32x2 o; o.x = cvt_pk(v[j].x, v[j].y); o.y = cvt_pk(v[j].z, v[j].w); xo[64 * j] = o; } }
        }
        if (mode == 2) continue;
        float ss = 0.f;
#pragma unroll
        for (int j = 0; j < 4; ++j) ss += (v[j].x * v[j].x + v[j].y * v[j].y) + (v[j].z * v[j].z + v[j].w * v[j].w);
        const float rstd = rsqrtf(wave_sum(ss) * (1.f / D) + RMS_EPS);
        const float* md = W.mod + ((size_t)l * NBMAX + b) * 6 * D + (mode == 1 ? 3 * D : 0);
        GAS u32x2* ho = (GAS u32x2*)(W.H + (size_t)t * D) + F.lane;
#pragma unroll
        for (int j = 0; j < 4; ++j) { const f32x4 g = *((const GAS f32x4*)ng + F.lane + 64 * j), sh = *((const GAS f32x4*)md + F.lane + 64 * j), sc = *((const GAS f32x4*)(md + D) + F.lane + 64 * j);
            const float h0 = v[j].x * rstd * g.x * (1.f + sc.x) + sh.x, h1 = v[j].y * rstd * g.y * (1.f + sc.y) + sh.y, h2 = v[j].z * rstd * g.z * (1.f + sc.z) + sh.z, h3 = v[j].w * rstd * g.w * (1.f + sc.w) + sh.w;
            u32x2 o; o.x = cvt_pk(h0, h1); o.y = cvt_pk(h2, h3); ho[64 * j] = o; }
    }
}
typedef pg8::Unit Unit;
__device__ __forceinline__ u32x4 pack8(const f32x4& a, const f32x4& b) { u32x4 w; w.x = cvt_pk(a[0], a[1]); w.y = cvt_pk(a[2], a[3]); w.z = cvt_pk(b[0], b[1]); w.w = cvt_pk(b[2], b[3]); return w; }

#ifndef MK_ATT_FP8
#define MK_ATT_FP8 1
#endif
__device__ __forceinline__ u32x2 pack8_fp8(const f32x4& a, const f32x4& b) { int w0 = 0, w1 = 0;
    w0 = __builtin_amdgcn_cvt_pk_fp8_f32(a[0], a[1], w0, false); w0 = __builtin_amdgcn_cvt_pk_fp8_f32(a[2], a[3], w0, true);
    w1 = __builtin_amdgcn_cvt_pk_fp8_f32(b[0], b[1], w1, false); w1 = __builtin_amdgcn_cvt_pk_fp8_f32(b[2], b[3], w1, true);
    u32x2 r; r.x = (unsigned)w0; r.y = (unsigned)w1; return r; }
struct EpiNull {
    static constexpr bool PERM = true, AFTER_DRAIN = false, MIDK = false;
    __device__ __forceinline__ void operator()(const f32x4 (&acc)[2][2][4][2], const Unit&, int, int, int, int) const {
#pragma unroll
        for (int a = 0; a < 2; ++a)
#pragma unroll
            for (int b = 0; b < 2; ++b)
#pragma unroll
                for (int m = 0; m < 4; ++m) { asm volatile("" :: "v"(acc[a][b][m][0]), "v"(acc[a][b][m][1])); } }
};
struct EpiIn {
    static constexpr bool PERM = true, AFTER_DRAIN = false, MIDK = false;
    bf16 *GQ, *GK, *GV, *SG, *LGF, *LGB, *DQ, *DK, *DV, *SGA, *SGB; const float* b_up; const float* qg; const float* kg;
    __device__ __forceinline__ void operator()(const f32x4 (&acc)[2][2][4][2], const Unit& u, int wr, int wc, int fr, int fq) const {
        const int pn = u.pn; const int row0 = u.pm * 256 + wr * 64 + fr;
        if (pn >= 8 && pn <= 11) {
            const bool isk = pn >= 10; const int head = 2 * ((pn - 8) & 1) + (wc >> 1), c = wc & 1;
            const float* gv = isk ? kg : qg; const float sc = isk ? 1.f : QSCALE;
            f32x4 g[2][2];
#pragma unroll
            for (int bj = 0; bj < 2; ++bj)
#pragma unroll
                for (int n = 0; n < 2; ++n) g[bj][n] = *(const f32x4*)(gv + 32 * bj + 8 * fq + 4 * n);
#pragma unroll
            for (int ai = 0; ai < 2; ++ai)
#pragma unroll
                for (int m = 0; m < 4; ++m) {
                    const int r = row0 + ai * 128 + m * 16, b = r / SEQ, s = r % SEQ;
                    float ss = 0.f;
#pragma unroll
                    for (int bj = 0; bj < 2; ++bj)
#pragma unroll
                        for (int n = 0; n < 2; ++n) { const f32x4 x = acc[ai][bj][m][n]; ss += (x[0] * x[0] + x[1] * x[1]) + (x[2] * x[2] + x[3] * x[3]); }
                    ss += __shfl_xor(ss, 16); ss += __shfl_xor(ss, 32);
                    const float rs = rsqrtf(ss * (1.f / 64.f) + RMS_EPS) * sc;
#if MK_ATT_FP8
                    unsigned char* dst8 = (unsigned char*)(isk ? DK : DQ) + ((((size_t)b * NH + head) * 2 + c) * SEQ + s) * 64;
#pragma unroll
                    for (int bj = 0; bj < 2; ++bj) {
                        const f32x4 v0 = acc[ai][bj][m][0] * rs * g[bj][0], v1 = acc[ai][bj][m][1] * rs * g[bj][1];
                        int chunk = 2 * bj + (fq >> 1); if (isk) chunk ^= ((s >> 2) & 3);
                        *(u32x2*)(dst8 + chunk * 16 + 8 * (fq & 1)) = pack8_fp8(v0, v1);
                    }
#else
                    bf16* dst = (isk ? DK : DQ) + ((((size_t)b * NH + head) * 2 + c) * SEQ + s) * 64;
#pragma unroll
                    for (int bj = 0; bj < 2; ++bj) {
                        const f32x4 v0 = acc[ai][bj][m][0] * rs * g[bj][0], v1 = acc[ai][bj][m][1] * rs * g[bj][1];
                        int chunk = 4 * bj + fq; if (isk) chunk ^= ((s >> 1) & 7);
                        *(u32x4*)(dst + chunk * 8) = pack8(v0, v1);
                    }
#endif
                }
            return;
        }
#pragma unroll
        for (int ai = 0; ai < 2; ++ai)
#pragma unroll
            for (int m = 0; m < 4; ++m) {
                const int r = row0 + ai * 128 + m * 16;
#pragma unroll
                for (int bj = 0; bj < 2; ++bj) {
                    const int c0 = 128 * bj + 32 * wc + 8 * fq;
                    f32x4 v0 = acc[ai][bj][m][0], v1 = acc[ai][bj][m][1];
                    if (pn == 0) { *(u32x4*)(GQ + (size_t)r * 256 + c0) = pack8(v0 * 0.125f, v1 * 0.125f); }
                    else if (pn == 1) { *(u32x4*)(GK + (size_t)r * 256 + c0) = pack8(v0, v1); }
                    else if (pn <= 3) { *(u32x4*)(GV + (size_t)r * 512 + (pn - 2) * 256 + c0) = pack8(v0, v1); }
                    else if (pn <= 5) {
#pragma unroll
                        for (int i = 0; i < 4; ++i) { v0[i] = fsilu(v0[i]); v1[i] = fsilu(v1[i]); }
                        *(u32x4*)(SG + (size_t)r * 512 + (pn - 4) * 256 + c0) = pack8(v0, v1); }
                    else if (pn <= 7) {
                        const float* bu = b_up + (pn - 6) * 256 + c0; const f32x4 b0 = *(const f32x4*)bu, b1 = *(const f32x4*)(bu + 4);
#pragma unroll
                        for (int i = 0; i < 4; ++i) { float z = v0[i] + b0[i]; v0[i] = (fminf(z, 0.f) - __logf(1.f + __expf(-fabsf(z)))) * (1.f / 16.f);
                                                      z = v1[i] + b1[i]; v1[i] = (fminf(z, 0.f) - __logf(1.f + __expf(-fabsf(z)))) * (1.f / 16.f); }
                        *(u32x4*)((pn == 6 ? LGF : LGB) + (size_t)r * 256 + c0) = pack8(v0, v1); }
#if MK_ATT_FP8
                    else if (pn <= 13) {
                        const int b = r / SEQ, s = r % SEQ, head = 2 * (pn - 12) + bj;
                        const int kk = s & 63, wkey = kk & 31, hh_ = (wkey >> 2) & 1, reg_ = (wkey & 3) + 4 * (wkey >> 3), pos = hh_ * 32 + 16 * (kk >> 5) + reg_;
                        unsigned char* tb = (unsigned char*)DV + (((size_t)b * NH + head) * (SEQ / 64) + (s >> 6)) * 8192;
                        const u32x2 pk = pack8_fp8(v0, v1); const int dv0 = 32 * wc + 8 * fq;
#pragma unroll
                        for (int i = 0; i < 8; ++i) { const int dv = dv0 + i; const unsigned byte = ((i < 4 ? pk.x : pk.y) >> (8 * (i & 3))) & 0xffu;
                            tb[dv * 64 + ((((pos >> 4) ^ ((dv >> 2) & 3)) << 4) | (pos & 15))] = (unsigned char)byte; } }
#else
                    else if (pn <= 13) {
                        const int b = r / SEQ, s = r % SEQ, head = 2 * (pn - 12) + bj;
                        bf16* dst = DV + ((((size_t)b * NH + head) * (SEQ / 8) + (s >> 3)) * 4 + wc) * 256 + (s & 7) * 32 + 8 * fq;
                        *(u32x4*)dst = pack8(v0, v1); }
#endif
                    else {
#pragma unroll
                        for (int i = 0; i < 4; ++i) { v0[i] = fsigmoid(v0[i]); v1[i] = fsigmoid(v1[i]); }
                        bf16* base = (pn <= 17) ? SGA + (pn - 14) * 256 : SGB + (pn - 18) * 256;
                        *(u32x4*)(base + (size_t)r * D + c0) = pack8(v0, v1); }
                }
            }
    }
};

struct EpiMerge {
    static constexpr bool PERM = true, AFTER_DRAIN = false, MIDK = false;
    const bf16* SGA; const bf16* SGB; bf16* O; int nM;
    __device__ __forceinline__ void operator()(const f32x4 (&acc)[2][2][4][2], const Unit& u, int wr, int wc, int fr, int fq) const {
        const int sel = u.pn >> 2; const int row0 = (u.pm - sel * nM) * 256 + wr * 64 + fr, col0 = (u.pn & 3) * 256 + wc * 32 + 8 * fq;
        const bf16* G = sel ? SGB : SGA;
#pragma unroll
        for (int ai = 0; ai < 2; ++ai)
#pragma unroll
            for (int m = 0; m < 4; ++m) { const size_t off = (size_t)(row0 + ai * 128 + m * 16) * D + col0;
#pragma unroll
                for (int bj = 0; bj < 2; ++bj) { const u32x4 b = *(const u32x4*)(G + off + bj * 128);
                    f32x4 v0 = acc[ai][bj][m][0], v1 = acc[ai][bj][m][1];
                    v0[0] *= bflo(b.x); v0[1] *= bfhi(b.x); v0[2] *= bflo(b.y); v0[3] *= bfhi(b.y); v1[0] *= bflo(b.z); v1[1] *= bfhi(b.z); v1[2] *= bflo(b.w); v1[3] *= bfhi(b.w);
                    if (sel) { const u32x4 t = *(const u32x4*)(O + off + bj * 128);
                        v0[0] += bflo(t.x); v0[1] += bfhi(t.x); v0[2] += bflo(t.y); v0[3] += bfhi(t.y); v1[0] += bflo(t.z); v1[1] += bfhi(t.z); v1[2] += bflo(t.w); v1[3] += bfhi(t.w); }
                    *(u32x4*)(O + off + bj * 128) = pack8(v0, v1); }
                asm volatile("" ::: "memory"); }
    }
};
struct MergeOrder {
    pg8::StaticOrder so; int nM;
    __device__ __forceinline__ bool next(int i, Unit& u) const { Unit t; if (!so.next(i >> 1, t)) return false; const int sel = i & 1; u.pm = t.pm + sel * nM; u.pn = t.pn + sel * 4; return true; }
    __device__ __forceinline__ void a_ready(const Unit&) const {}
    __device__ __forceinline__ void done(const Unit&) const {}
};

struct EpiResid {
    static constexpr bool PERM = true, AFTER_DRAIN = false, MIDK = false;
    const float* xin32; bf16* xb; const float* g1;
    __device__ __forceinline__ void operator()(const f32x4 (&acc)[2][2][4][2], const Unit& u, int wr, int wc, int fr, int fq) const {
        const int row0 = u.pm * 256 + wr * 64 + fr, col0 = u.pn * 256 + wc * 32 + 8 * fq;
        const int b = (u.pm * 256) / SEQ; const float* g = g1 + (size_t)b * 6 * D + col0;
        f32x4 gv[2][2];
#pragma unroll
        for (int bj = 0; bj < 2; ++bj)
#pragma unroll
            for (int n = 0; n < 2; ++n) gv[bj][n] = *(const f32x4*)(g + bj * 128 + n * 4);
#pragma unroll
        for (int ai = 0; ai < 2; ++ai)
#pragma unroll
            for (int m = 0; m < 4; ++m) { const size_t off = (size_t)(row0 + ai * 128 + m * 16) * D + col0;
#pragma unroll
                for (int bj = 0; bj < 2; ++bj) { f32x4 x0, x1;
                    if (xin32) { x0 = *(const f32x4*)(xin32 + off + bj * 128); x1 = *(const f32x4*)(xin32 + off + bj * 128 + 4); }
                    else { const u32x4 a = *(const u32x4*)(xb + off + bj * 128); x0 = (f32x4){bflo(a.x), bfhi(a.x), bflo(a.y), bfhi(a.y)}; x1 = (f32x4){bflo(a.z), bfhi(a.z), bflo(a.w), bfhi(a.w)}; }
                    *(u32x4*)(xb + off + bj * 128) = pack8(x0 + gv[bj][0] * acc[ai][bj][m][0], x1 + gv[bj][1] * acc[ai][bj][m][1]); }
                asm volatile("" ::: "memory"); }
    }
};

struct EpiLogits {
    static constexpr bool PERM = false, AFTER_DRAIN = false, MIDK = false;
    float* L;
    __device__ __forceinline__ void operator()(const f32x4 (&acc)[2][2][4][2], const Unit& u, int wr, int wc, int fr, int fq) const {
        if (wc >= 2) return;
        const int row0 = u.pm * 256 + wr * 64 + fr, col0 = wc * 32 + 4 * fq;
#pragma unroll
        for (int ai = 0; ai < 2; ++ai)
#pragma unroll
            for (int m = 0; m < 4; ++m)
#pragma unroll
                for (int n = 0; n < 2; ++n) *(f32x4*)(L + (size_t)(row0 + ai * 128 + m * 16) * 64 + col0 + n * 16) = acc[ai][0][m][n];
    }
};

#ifndef MK_MOE_FP8
#define MK_MOE_FP8 0
#endif
#if MK_MOE_FP8
struct EpiAct {
    static constexpr bool PERM = true, AFTER_DRAIN = false, MIDK = false;
    unsigned char* ACT;
    __device__ __forceinline__ void operator()(const f32x4 (&acc)[2][2][4][2], const Unit& u, int wr, int wc, int fr, int fq) const {
        const int row0 = u.pm * 256 + wr * 64 + fr, col0 = (u.pn & 3) * 128 + wc * 32 + 8 * fq;
        constexpr float inv = 1.f / WSCALE;
#pragma unroll
        for (int ai = 0; ai < 2; ++ai)
#pragma unroll
            for (int m = 0; m < 4; ++m) { f32x4 v0, v1;
#pragma unroll
                for (int i = 0; i < 4; ++i) { v0[i] = fsilu(acc[ai][0][m][0][i] * inv) * acc[ai][1][m][0][i] * (inv * ASCALE); v1[i] = fsilu(acc[ai][0][m][1][i] * inv) * acc[ai][1][m][1][i] * (inv * ASCALE); }
                *(u32x2*)(ACT + (size_t)(row0 + ai * 128 + m * 16) * DE + col0) = pack8_fp8(v0, v1); }
    }
};
struct EpiYs {
    static constexpr bool PERM = true, AFTER_DRAIN = false, MIDK = false;
    bf16* YS; const float* gs;
    __device__ __forceinline__ void operator()(const f32x4 (&acc)[2][2][4][2], const Unit& u, int wr, int wc, int fr, int fq) const {
        const int row0 = u.pm * 256 + wr * 64 + fr, col0 = (u.pn & 3) * 256 + wc * 32 + 8 * fq;
#pragma unroll
        for (int ai = 0; ai < 2; ++ai)
#pragma unroll
            for (int m = 0; m < 4; ++m) { const int r = row0 + ai * 128 + m * 16; const float gt = gs[r] * (1.f / (WSCALE * ASCALE));
#pragma unroll
                for (int bj = 0; bj < 2; ++bj) *(u32x4*)(YS + (size_t)r * D + col0 + bj * 128) = pack8(acc[ai][bj][m][0] * gt, acc[ai][bj][m][1] * gt); }
    }
};
#else
struct EpiAct {
    static constexpr bool PERM = true, AFTER_DRAIN = false, MIDK = false;
    bf16* ACT;
    __device__ __forceinline__ void operator()(const f32x4 (&acc)[2][2][4][2], const Unit& u, int wr, int wc, int fr, int fq) const {
        const int row0 = u.pm * 256 + wr * 64 + fr, col0 = (u.pn & 3) * 128 + wc * 32 + 8 * fq;
#pragma unroll
        for (int ai = 0; ai < 2; ++ai)
#pragma unroll
            for (int m = 0; m < 4; ++m) { f32x4 v0, v1;
#pragma unroll
                for (int i = 0; i < 4; ++i) { v0[i] = fsilu(acc[ai][0][m][0][i]) * acc[ai][1][m][0][i]; v1[i] = fsilu(acc[ai][0][m][1][i]) * acc[ai][1][m][1][i]; }
                *(u32x4*)(ACT + (size_t)(row0 + ai * 128 + m * 16) * DE + col0) = pack8(v0, v1); }
    }
};
struct EpiYs {
    static constexpr bool PERM = true, AFTER_DRAIN = false, MIDK = false;
    unsigned char* YS; const float* gs;
    __device__ __forceinline__ void operator()(const f32x4 (&acc)[2][2][4][2], const Unit& u, int wr, int wc, int fr, int fq) const {
        const int row0 = u.pm * 256 + wr * 64 + fr, col0 = (u.pn & 3) * 256 + wc * 32 + 8 * fq;
#pragma unroll
        for (int ai = 0; ai < 2; ++ai)
#pragma unroll
            for (int m = 0; m < 4; ++m) { const int r = row0 + ai * 128 + m * 16; const float gt = gs[r] * YSCALE;
#pragma unroll
                for (int bj = 0; bj < 2; ++bj) *(u32x2*)(YS + (size_t)r * D + col0 + bj * 128) = pack8_fp8(acc[ai][bj][m][0] * gt, acc[ai][bj][m][1] * gt); }
    }
};
#endif
struct GroupedOrder {
    const int* tilee; int U, G, c; const int* rowidx;
    __device__ __forceinline__ bool next(int i, Unit& u) const {
        int id;
        if ((G & 7) == 0) { const int gx = G >> 3, per = (U + 7) >> 3, n = i * gx + (c >> 3); if (n >= per) return false; id = (c & 7) * per + n; if (id >= U) return false; }
        else { id = i * G + c; if (id >= U) return false; }
        const int t = id >> 2; u.pm = t; u.pn = tilee[t] * 4 + (id & 3); return true;
    }
    __device__ __forceinline__ void a_ready(const Unit&) const {}
    __device__ __forceinline__ void done(const Unit&) const {}
};
constexpr int AT_KR = 0, AT_VR = 32768, AT_TAB = 65536, AT_SLOT = 8192;
typedef int v8i __attribute__((ext_vector_type(8)));
typedef int v4i __attribute__((ext_vector_type(4)));
__device__ __forceinline__ int crow(int r, int hi) { return (r & 3) + 8 * (r >> 2) + 4 * hi; }

__device__ __forceinline__ void attn_bias(f32x16& s0, f32x16& s1, int relbase, const LAS float* tabh) {
#pragma unroll
    for (int r = 0; r < 16; ++r) {
        int i0 = relbase + (r & 3) + 8 * (r >> 2); int i1 = i0 + 32;
        i0 = i0 < 0 ? 0 : (i0 > 255 ? 255 : i0); i1 = i1 < 0 ? 0 : (i1 > 255 ? 255 : i1);
        s0[r] += tabh[i0]; s1[r] += tabh[i1];
    }
}
template <int J>
__device__ __forceinline__ void attn_exp_chunk(f32x16& s0, f32x16& s1, float& lsum) {
    float ls = 0.f;
#pragma unroll
    for (int r = 4 * J; r < 4 * J + 4; ++r) { s0[r] = __builtin_amdgcn_exp2f(s0[r]); s1[r] = __builtin_amdgcn_exp2f(s1[r]); }
    (void)ls; (void)lsum;
}
__device__ __forceinline__ int pk4_bf8(float a, float b, float c, float d) { int w = 0; w = __builtin_amdgcn_cvt_pk_bf8_f32(a, b, w, false); w = __builtin_amdgcn_cvt_pk_bf8_f32(c, d, w, true); return w; }
__device__ __forceinline__ void glds16(const void* gsrc, unsigned lds_dst) { unsigned keep;
    asm volatile("s_mov_b32 %0, m0\n\ts_mov_b32 m0, %2\n\ts_nop 0\n\tglobal_load_lds_dwordx4 %1, off\n\ts_mov_b32 m0, %0" : "=&s"(keep) : "v"(gsrc), "s"(lds_dst) : "memory"); }
__device__ __forceinline__ void attn_dma_k(unsigned lds0, const unsigned char* kg0, int t, int slot, int wid, int lane) {
    glds16(kg0 + (size_t)(wid >> 2) * SEQ * 64 + (size_t)t * 4096 + (wid & 3) * 1024 + lane * 16, (unsigned)__builtin_amdgcn_readfirstlane((int)(lds0 + AT_KR + slot * AT_SLOT + wid * 1024)));
}
__device__ __forceinline__ void attn_dma_v(unsigned lds0, const unsigned char* vg0, int t, int slot, int wid, int lane) {
    glds16(vg0 + (size_t)t * 8192 + wid * 1024 + lane * 16, (unsigned)__builtin_amdgcn_readfirstlane((int)(lds0 + AT_VR + slot * AT_SLOT + wid * 1024)));
}
#define AT_RD128(dst, addr, off) asm volatile("ds_read_b128 %0, %1 offset:%c2" : "=&v"(dst) : "v"(addr), "i"(off) : "memory")
#define AT_MFMA8(a, b, c) __builtin_amdgcn_mfma_scale_f32_32x32x64_f8f6f4(a, b, c, 0, 0, 0, 0, 0, 0)
#define AT_MFMA8B(a, b, c) __builtin_amdgcn_mfma_scale_f32_32x32x64_f8f6f4(a, b, c, 0, 1, 0, 0, 0, 0)

template <int VAR>
__device__ __forceinline__ void phase_attn(Frame& F, int l) {
    refresh(F);
    const WS W = ws_map(F.ws, F.nb); const float* const* IN_ = F.a->in; (void)IN_; (void)W;
    const int lane = F.lane, wid = F.wave, r32 = lane & 31, hh = lane >> 5, qg = wid & 3, c = wid >> 2;
    LAS unsigned char* lds = F.lds; const unsigned lds0 = (unsigned)(unsigned long)lds;
    LAS float* tab = (LAS float*)(lds + AT_TAB);
    for (int i = F.tid; i < 1028; i += NTHR) tab[i] = W.tab[i];
    const float lam = W.tab[1032 + l]; const float lam_init = 0.8f - 0.6f * __expf(-0.3f * (float)l);
    const float* subg = IN_[13] + l * 128;
    const int U = F.nb * NH * 64;
    const int gx = F.G >> 3, per = U >> 3;
    const int sw = (r32 >> 2) & 3;
    const unsigned ka0 = lds0 + AT_KR + c * 4096 + r32 * 64 + (((2 * hh) ^ sw) << 4), ka1 = lds0 + AT_KR + c * 4096 + r32 * 64 + (((2 * hh + 1) ^ sw) << 4);
    const unsigned va0 = lds0 + AT_VR + r32 * 64 + (((2 * hh) ^ sw) << 4), va1 = lds0 + AT_VR + r32 * 64 + (((2 * hh + 1) ^ sw) << 4);
#ifndef MK_ATT_1BAR
#define MK_ATT_1BAR 1
#endif
    const bool lag = (MK_ATT_1BAR == 0) && wid >= 4;
    __syncthreads();
    for (int i = 0;; ++i) {
        int id;
        if ((F.G & 7) == 0) { const int n = i * gx + (F.bid >> 3); if (n >= per) break; id = (F.bid & 7) * per + n; }
        else { id = i * F.G + F.bid; if (id >= U) break; }
        const int bh = id >> 6, qb = id & 63, b = bh >> 2, h = bh & 3;
        const int qw0 = qb * 128 + 32 * qg;
        const unsigned char* kg0 = (const unsigned char*)W.DK + ((size_t)bh * 2) * SEQ * 64;
        const unsigned char* vg0 = (const unsigned char*)W.DV + (size_t)bh * SEQ * 128;
        v8i qf; { const unsigned char* qp = (const unsigned char*)W.DQ + (((size_t)bh * 2 + c) * SEQ + qw0 + r32) * 64 + 32 * hh;
            const v4i q0 = *(const v4i*)qp, q1 = *(const v4i*)(qp + 16); qf = (v8i){q0[0], q0[1], q0[2], q0[3], q1[0], q1[1], q1[2], q1[3]}; }
        asm volatile("s_waitcnt vmcnt(0)" ::: "memory");
        attn_dma_k(lds0, kg0, 0, 0, wid, lane); attn_dma_k(lds0, kg0, 1, 1, wid, lane); attn_dma_v(lds0, vg0, 0, 0, wid, lane); attn_dma_k(lds0, kg0, 2, 2, wid, lane);
        attn_dma_v(lds0, vg0, 1, 1, wid, lane); attn_dma_k(lds0, kg0, 3, 3, wid, lane); attn_dma_v(lds0, vg0, 2, 2, wid, lane);
        f32x16 o[4]; f32x16 osum = f32x16{};
#pragma unroll
        for (int dt = 0; dt < 4; ++dt) o[dt] = f32x16{};
        float lsum = 0.f;
        const v8i ones8 = {0x38383838, 0x38383838, 0x38383838, 0x38383838, 0x38383838, 0x38383838, 0x38383838, 0x38383838};
        const int tL = (qw0 >= 154) ? ((qw0 - 154) >> 6) + 1 : 0, tR = (qw0 + 185) >> 6;
        const float shl = tab[1024 + h];
        const LAS float* tabh = tab + h * 256;
        const int rel0 = -qw0 - r32 + 4 * hh + 128;
        const f32x16 cshift = {-2.f, -2.f, -2.f, -2.f, -2.f, -2.f, -2.f, -2.f, -2.f, -2.f, -2.f, -2.f, -2.f, -2.f, -2.f, -2.f};
        asm volatile("s_waitcnt vmcnt(4)" ::: "memory"); __builtin_amdgcn_s_barrier(); asm volatile("" ::: "memory");
        f32x16 sc0, sc1, sn0, sn1; v8i p; v4i kx[4];
        AT_RD128(kx[0], ka0, 0); AT_RD128(kx[1], ka1, 0); AT_RD128(kx[2], ka0, 2048); AT_RD128(kx[3], ka1, 2048);
        asm volatile("s_waitcnt lgkmcnt(0)" ::: "memory"); __builtin_amdgcn_sched_barrier(0);
        sc0 = AT_MFMA8(((v8i){kx[0][0], kx[0][1], kx[0][2], kx[0][3], kx[1][0], kx[1][1], kx[1][2], kx[1][3]}), qf, cshift);
        sc1 = AT_MFMA8(((v8i){kx[2][0], kx[2][1], kx[2][2], kx[2][3], kx[3][0], kx[3][1], kx[3][2], kx[3][3]}), qf, cshift);
        __builtin_amdgcn_s_barrier(); asm volatile("" ::: "memory");
        if (lag) { __builtin_amdgcn_s_barrier(); asm volatile("" ::: "memory"); }
#define AT_STEP(SL, t) do { \
            { const int tk = (t) + 4 < 128 ? (t) + 4 : 127; attn_dma_k(lds0, kg0, tk, SL, wid, lane); } \
            asm volatile("s_waitcnt vmcnt(4)" ::: "memory");                                                       \
            AT_RD128(kx[0], ka0, ((SL + 1) & 3) * AT_SLOT); AT_RD128(kx[1], ka1, ((SL + 1) & 3) * AT_SLOT);        \
            AT_RD128(kx[2], ka0, ((SL + 1) & 3) * AT_SLOT + 2048); AT_RD128(kx[3], ka1, ((SL + 1) & 3) * AT_SLOT + 2048); \
            if ((t) >= tL && (t) < tR) attn_bias(sc0, sc1, 64 * (t) + rel0, tabh);                                \
            attn_exp_chunk<0>(sc0, sc1, lsum); attn_exp_chunk<1>(sc0, sc1, lsum);                                 \
            asm volatile("s_waitcnt lgkmcnt(0)" ::: "memory"); __builtin_amdgcn_sched_barrier(0); \
            sn0 = AT_MFMA8(((v8i){kx[0][0], kx[0][1], kx[0][2], kx[0][3], kx[1][0], kx[1][1], kx[1][2], kx[1][3]}), qf, cshift); \
            __builtin_amdgcn_sched_barrier(0); \
            attn_exp_chunk<2>(sc0, sc1, lsum); \
            __builtin_amdgcn_sched_barrier(0); \
            sn1 = AT_MFMA8(((v8i){kx[2][0], kx[2][1], kx[2][2], kx[2][3], kx[3][0], kx[3][1], kx[3][2], kx[3][3]}), qf, cshift); \
            __builtin_amdgcn_sched_barrier(0); \
            attn_exp_chunk<3>(sc0, sc1, lsum); \
            p[0] = pk4_bf8(sc0[0], sc0[1], sc0[2], sc0[3]); p[1] = pk4_bf8(sc0[4], sc0[5], sc0[6], sc0[7]); p[2] = pk4_bf8(sc0[8], sc0[9], sc0[10], sc0[11]); p[3] = pk4_bf8(sc0[12], sc0[13], sc0[14], sc0[15]); \
            p[4] = pk4_bf8(sc1[0], sc1[1], sc1[2], sc1[3]); p[5] = pk4_bf8(sc1[4], sc1[5], sc1[6], sc1[7]); p[6] = pk4_bf8(sc1[8], sc1[9], sc1[10], sc1[11]); p[7] = pk4_bf8(sc1[12], sc1[13], sc1[14], sc1[15]); \
            if (!MK_ATT_1BAR) { __builtin_amdgcn_s_barrier(); asm volatile("" ::: "memory"); } \
            { const int tv = (t) + 3 < 128 ? (t) + 3 : 127; attn_dma_v(lds0, vg0, tv, (SL + 3) & 3, wid, lane); } \
            asm volatile("s_waitcnt vmcnt(4)" ::: "memory");                                                       \
            { v4i vx[8]; \
              AT_RD128(vx[0], va0, SL * AT_SLOT); AT_RD128(vx[1], va1, SL * AT_SLOT); AT_RD128(vx[2], va0, SL * AT_SLOT + 2048); AT_RD128(vx[3], va1, SL * AT_SLOT + 2048); \
              AT_RD128(vx[4], va0, SL * AT_SLOT + 4096); AT_RD128(vx[5], va1, SL * AT_SLOT + 4096); AT_RD128(vx[6], va0, SL * AT_SLOT + 6144); AT_RD128(vx[7], va1, SL * AT_SLOT + 6144); \
              if ((t) == tL) { _Pragma("unroll") for (int dt = 0; dt < 4; ++dt) o[dt] *= shl; osum *= shl; } \
              osum = AT_MFMA8B(ones8, p, osum); \
              asm volatile("s_waitcnt lgkmcnt(4)" ::: "memory"); __builtin_amdgcn_sched_barrier(0); \
              o[0] = AT_MFMA8B(((v8i){vx[0][0], vx[0][1], vx[0][2], vx[0][3], vx[1][0], vx[1][1], vx[1][2], vx[1][3]}), p, o[0]); \
              o[1] = AT_MFMA8B(((v8i){vx[2][0], vx[2][1], vx[2][2], vx[2][3], vx[3][0], vx[3][1], vx[3][2], vx[3][3]}), p, o[1]); \
              asm volatile("s_waitcnt lgkmcnt(0)" ::: "memory"); __builtin_amdgcn_sched_barrier(0); \
              o[2] = AT_MFMA8B(((v8i){vx[4][0], vx[4][1], vx[4][2], vx[4][3], vx[5][0], vx[5][1], vx[5][2], vx[5][3]}), p, o[2]); \
              o[3] = AT_MFMA8B(((v8i){vx[6][0], vx[6][1], vx[6][2], vx[6][3], vx[7][0], vx[7][1], vx[7][2], vx[7][3]}), p, o[3]); } \
            sc0 = sn0; sc1 = sn1; \
            __builtin_amdgcn_s_barrier(); asm volatile("" ::: "memory"); } while (0)
        for (int t0 = 0; t0 < 128; t0 += 4) { AT_STEP(0, t0); AT_STEP(1, t0 + 1); AT_STEP(2, t0 + 2); AT_STEP(3, t0 + 3); }
#undef AT_STEP
        if (!lag && !MK_ATT_1BAR) { __builtin_amdgcn_s_barrier(); asm volatile("" ::: "memory"); }
        asm volatile("s_waitcnt vmcnt(0)" ::: "memory"); __builtin_amdgcn_s_barrier(); asm volatile("" ::: "memory");
        const float lt = osum[0];
        LAS float* xch = (LAS float*)(lds + qg * 16384);
        if (c == 1) { const float f = lam / lt;
#pragma unroll
            for (int dt = 0; dt < 4; ++dt)
#pragma unroll
                for (int r = 0; r < 16; ++r) xch[(dt * 16 + r) * 64 + lane] = o[dt][r] * f; }
        LDS_WAIT(); __builtin_amdgcn_s_barrier(); asm volatile("" ::: "memory");
        if (c == 0) { const float f = 1.f / lt; float ss = 0.f;
#pragma unroll
            for (int dt = 0; dt < 4; ++dt)
#pragma unroll
                for (int r = 0; r < 16; ++r) { const float v = o[dt][r] * f - xch[(dt * 16 + r) * 64 + lane]; o[dt][r] = v; ss += v * v; }
            ss += __shfl_xor(ss, 32);
            const float rn = rsqrtf(ss * (1.f / 128.f) + RMS_EPS) * (1.f - lam_init);
            bf16* orow = W.OAB + (size_t)F.T * 512 + ((size_t)b * SEQ + qw0 + r32) * 512 + h * 128;
#pragma unroll
            for (int dt = 0; dt < 4; ++dt)
#pragma unroll
                for (int g = 0; g < 4; ++g) { const int dv = 32 * dt + 8 * g + 4 * hh; const f32x4 sg = *(const f32x4*)(subg + dv);
                    u32x2 ov; ov.x = cvt_pk(o[dt][4 * g] * rn * sg[0], o[dt][4 * g + 1] * rn * sg[1]); ov.y = cvt_pk(o[dt][4 * g + 2] * rn * sg[2], o[dt][4 * g + 3] * rn * sg[3]);
                    *(u32x2*)(orow + dv) = ov; }
        }
        LDS_WAIT(); __builtin_amdgcn_s_barrier(); asm volatile("" ::: "memory");
    }
}
constexpr int GL_CUM = 0;
constexpr int GL_S64 = 144, GL_S192 = 400;
constexpr int G1_KEF = 34816, G1_KEB = G1_KEF + 64 * GL_S64, G1_VT = G1_KEB + 64 * GL_S64;
constexpr int G3_AOP = 34816, G3_KIF = G3_AOP + 64 * GL_S192, G3_KIB = G3_KIF + 64 * GL_S64, G3_BOP = G3_KIB + 64 * GL_S64;
static_assert(G3_BOP + 128 * GL_S192 <= 150 * 1024, "GLA LDS");

__device__ __forceinline__ bf16x8 lds_frag(const LAS unsigned char* base, int row, int stride, int kbyte) { return *(const LAS bf16x8*)(base + row * stride + kbyte); }

__device__ __forceinline__ void gla_cum(Frame& F, size_t trow0, int h) {
    const WS W = ws_map(F.ws, F.nb); const float* const* IN_ = F.a->in; (void)IN_; (void)W;
    LAS float* cum = (LAS float*)(F.lds + GL_CUM);
#pragma unroll
    for (int it = 0; it < 4; ++it) { const int idx = F.tid + it * NTHR; const int dir = idx >> 10, t = (idx >> 4) & 63, d4 = (idx & 15) * 4;
        const u32x2 a = *(const u32x2*)((dir ? W.LGB : W.LGF) + (trow0 + t) * 256 + h * 64 + d4);
        *(LAS f32x4*)(cum + (dir * 64 + t) * 64 + d4) = (f32x4){bflo(a.x), bfhi(a.x), bflo(a.y), bfhi(a.y)}; }
    __syncthreads();
    {
        const int dir = F.tid >> 8, seg = (F.tid >> 6) & 3, d = F.tid & 63; LAS float* cc = cum + dir * 4096 + d; LAS float* tot = cum + 8192 + (dir * 4 + seg) * 64 + d;
        float v[16]; float run = 0.f;
        if (dir == 0) {
#pragma unroll
            for (int i = 0; i < 16; ++i) { run += cc[(16 * seg + i) * 64]; v[i] = run; }
        } else {
#pragma unroll
            for (int i = 15; i >= 0; --i) { run += cc[(16 * seg + i) * 64]; v[i] = run; }
        }
        *tot = run;
        __syncthreads();
        float off = 0.f; const LAS float* tb = cum + 8192 + dir * 256 + d;
        if (dir == 0) { if (seg > 0) off += tb[0]; if (seg > 1) off += tb[64]; if (seg > 2) off += tb[128]; }
        else { if (seg < 3) off += tb[192]; if (seg < 2) off += tb[128]; if (seg < 1) off += tb[64]; }
#pragma unroll
        for (int i = 0; i < 16; ++i) cc[(16 * seg + i) * 64] = v[i] + off;
    }
    __syncthreads();
}

__device__ __forceinline__ void phase_gla1(Frame& F) {
    refresh(F);
    const WS W = ws_map(F.ws, F.nb); const float* const* IN_ = F.a->in; (void)IN_; (void)W;
    LAS unsigned char* lds = F.lds; LAS float* cum = (LAS float*)(lds + GL_CUM);
    const int lane = F.lane, wid = F.wave, r32 = lane & 31, hh = lane >> 5;
    const int U = F.nb * NH * 128;
    for (int u = F.bid; u < U; u += F.G) {
        const int n = u & 127, bh = u >> 7, b = bh >> 2, h = bh & 3; const size_t trow0 = (size_t)b * SEQ + n * 64;
        gla_cum(F, trow0, h);
        {
            const int t = F.tid >> 3, d0 = (F.tid & 7) * 8;
            const u32x4 kv = *(const u32x4*)(W.GK + (trow0 + t) * 256 + h * 64 + d0);
            const unsigned kw[4] = {kv.x, kv.y, kv.z, kv.w};
#pragma unroll
            for (int j = 0; j < 8; ++j) { const int d = d0 + j; const float k = (j & 1) ? bfhi(kw[j >> 1]) : bflo(kw[j >> 1]);
                const float ef = __expf(cum[63 * 64 + d] - cum[t * 64 + d]), eb = __expf(cum[4096 + d] - cum[4096 + t * 64 + d]);
                *(LAS bf16*)(lds + G1_KEF + d * GL_S64 + t * 2) = (bf16)(cvt_pk(k * ef, 0.f) & 0xffffu);
                *(LAS bf16*)(lds + G1_KEB + d * GL_S64 + t * 2) = (bf16)(cvt_pk(k * eb, 0.f) & 0xffffu); }
            const int v0 = (F.tid & 7) * 16;
            const u32x4 va = *(const u32x4*)(W.GV + (trow0 + t) * 512 + h * 128 + v0), vb = *(const u32x4*)(W.GV + (trow0 + t) * 512 + h * 128 + v0 + 8);
            const unsigned vw[8] = {va.x, va.y, va.z, va.w, vb.x, vb.y, vb.z, vb.w};
#pragma unroll
            for (int j = 0; j < 16; ++j) *(LAS bf16*)(lds + G1_VT + (v0 + j) * GL_S64 + t * 2) = (bf16)((j & 1) ? (vw[j >> 1] >> 16) : (vw[j >> 1] & 0xffffu));
            if (F.tid < 128) { const int dir = F.tid >> 6, d = F.tid & 63; W.DEC[((size_t)u * 2 + dir) * 64 + d] = __expf(dir ? cum[4096 + d] : cum[63 * 64 + d]); }
        }
        __syncthreads();
        {
            const int dt = wid & 3, dd = wid >> 2;
            f32x16 cf = {}, cb = {};
#pragma unroll
            for (int s = 0; s < 4; ++s) { const int kb = (16 * s + 8 * hh) * 2;
                const bf16x8 a = lds_frag(lds + G1_VT, 32 * dt + r32, GL_S64, kb);
                cf = __builtin_amdgcn_mfma_f32_32x32x16_bf16(a, lds_frag(lds + G1_KEF, 32 * dd + r32, GL_S64, kb), cf, 0, 0, 0);
                cb = __builtin_amdgcn_mfma_f32_32x32x16_bf16(a, lds_frag(lds + G1_KEB, 32 * dd + r32, GL_S64, kb), cb, 0, 0, 0); }
            bf16* of = (bf16*)W.KVT + ((size_t)u * 2) * 8192; bf16* ob = of + 8192;
#pragma unroll
            for (int r = 0; r < 16; ++r) { const int dv = 32 * dt + crow(r, hh), d = 32 * dd + r32;
                const float pf = __shfl_xor(cf[r], 1), pb = __shfl_xor(cb[r], 1);
                if (!(lane & 1)) { *(unsigned*)(of + dv * 64 + d) = cvt_pk(cf[r], pf); *(unsigned*)(ob + dv * 64 + d) = cvt_pk(cb[r], pb); } }
        }
        __syncthreads();
    }
}

__device__ __forceinline__ void phase_gla2(Frame& F) {
    refresh(F);
    const WS W = ws_map(F.ws, F.nb); const float* const* IN_ = F.a->in; (void)IN_; (void)W;
    const size_t total = (size_t)F.nb * NH * 2 * 4096;
    for (size_t wk = (size_t)F.bid * NTHR + F.tid; wk < total; wk += (size_t)F.G * NTHR) {
        const int e2 = (int)(wk & 4095), dir = (int)((wk >> 12) & 1), bh = (int)(wk >> 13), d = (e2 * 2) & 63;
        unsigned* base = (unsigned*)((bf16*)W.KVT + ((size_t)bh * 128 * 2 + dir) * 8192) + e2; const float* dec = W.DEC + ((size_t)bh * 128 * 2 + dir) * 64 + d;
        float S0 = 0.f, S1 = 0.f;
        for (int n0 = 0; n0 < 128; n0 += 8) {
            unsigned kv[8]; float dc0[8], dc1[8];
#pragma unroll
            for (int j = 0; j < 8; ++j) { const int n = dir ? 127 - (n0 + j) : n0 + j; kv[j] = base[(size_t)n * 8192]; dc0[j] = dec[(size_t)n * 128]; dc1[j] = dec[(size_t)n * 128 + 1]; }
#pragma unroll
            for (int j = 0; j < 8; ++j) { const int n = dir ? 127 - (n0 + j) : n0 + j; base[(size_t)n * 8192] = cvt_pk(S0, S1); S0 = dc0[j] * S0 + bflo(kv[j]); S1 = dc1[j] * S1 + bfhi(kv[j]); }
        }
    }
}

__device__ __forceinline__ void phase_gla3(Frame& F, int l) {
    refresh(F);
    const WS W = ws_map(F.ws, F.nb); const float* const* IN_ = F.a->in; (void)IN_; (void)W;
    LAS unsigned char* lds = F.lds; LAS float* cum = (LAS float*)(lds + GL_CUM);
    const int lane = F.lane, wid = F.wave, r32 = lane & 31, hh = lane >> 5;
    const float* gng = IN_[9] + l * 128;
    const int U = F.nb * NH * 128;
    for (int u = F.bid; u < U; u += F.G) {
        const int n = u & 127, bh = u >> 7, b = bh >> 2, h = bh & 3; const size_t trow0 = (size_t)b * SEQ + n * 64;
        gla_cum(F, trow0, h);
        {
            const int t = F.tid >> 3, d0 = (F.tid & 7) * 8;
            const u32x4 qv = *(const u32x4*)(W.GQ + (trow0 + t) * 256 + h * 64 + d0), kv = *(const u32x4*)(W.GK + (trow0 + t) * 256 + h * 64 + d0);
            const unsigned qw[4] = {qv.x, qv.y, qv.z, qv.w}, kw[4] = {kv.x, kv.y, kv.z, kv.w};
            float qf[8], qb[8], kf[8], kb[8];
#pragma unroll
            for (int j = 0; j < 8; ++j) { const int d = d0 + j; const float q = (j & 1) ? bfhi(qw[j >> 1]) : bflo(qw[j >> 1]), k = (j & 1) ? bfhi(kw[j >> 1]) : bflo(kw[j >> 1]);
                const float cf = cum[t * 64 + d], cb = cum[4096 + t * 64 + d];
                qf[j] = q * __expf(cf); qb[j] = q * __expf(cb); kf[j] = k * __expf(-cf); kb[j] = k * __expf(-cb); }
            u32x4 o;
            o.x = cvt_pk(qf[0], qf[1]); o.y = cvt_pk(qf[2], qf[3]); o.z = cvt_pk(qf[4], qf[5]); o.w = cvt_pk(qf[6], qf[7]); *(LAS u32x4*)(lds + G3_AOP + t * GL_S192 + (64 + d0) * 2) = o;
            o.x = cvt_pk(qb[0], qb[1]); o.y = cvt_pk(qb[2], qb[3]); o.z = cvt_pk(qb[4], qb[5]); o.w = cvt_pk(qb[6], qb[7]); *(LAS u32x4*)(lds + G3_AOP + t * GL_S192 + (128 + d0) * 2) = o;
            o.x = cvt_pk(kf[0], kf[1]); o.y = cvt_pk(kf[2], kf[3]); o.z = cvt_pk(kf[4], kf[5]); o.w = cvt_pk(kf[6], kf[7]); *(LAS u32x4*)(lds + G3_KIF + t * GL_S64 + d0 * 2) = o;
            o.x = cvt_pk(kb[0], kb[1]); o.y = cvt_pk(kb[2], kb[3]); o.z = cvt_pk(kb[4], kb[5]); o.w = cvt_pk(kb[6], kb[7]); *(LAS u32x4*)(lds + G3_KIB + t * GL_S64 + d0 * 2) = o;
            const int v0 = (F.tid & 7) * 16;
            const u32x4 va = *(const u32x4*)(W.GV + (trow0 + t) * 512 + h * 128 + v0), vb = *(const u32x4*)(W.GV + (trow0 + t) * 512 + h * 128 + v0 + 8);
            const unsigned vw[8] = {va.x, va.y, va.z, va.w, vb.x, vb.y, vb.z, vb.w};
#pragma unroll
            for (int j = 0; j < 16; ++j) *(LAS bf16*)(lds + G3_BOP + (v0 + j) * GL_S192 + t * 2) = (bf16)((j & 1) ? (vw[j >> 1] >> 16) : (vw[j >> 1] & 0xffffu));
            const int dv = F.tid >> 2, dd0 = (F.tid & 3) * 16;
#pragma unroll
            for (int dir = 0; dir < 2; ++dir) { const bf16* sp = (const bf16*)W.KVT + ((size_t)u * 2 + dir) * 8192 + dv * 64 + dd0;
                const u32x4 o0 = *(const u32x4*)sp, o1 = *(const u32x4*)(sp + 8);
                *(LAS u32x4*)(lds + G3_BOP + dv * GL_S192 + (64 + 64 * dir + dd0) * 2) = o0; *(LAS u32x4*)(lds + G3_BOP + dv * GL_S192 + (64 + 64 * dir + dd0 + 8) * 2) = o1; }
        }
        __syncthreads();
        if (wid < 4) {
            const int it = wid >> 1, jt = wid & 1;
            f32x16 af = {}, ab = {};
#pragma unroll
            for (int s = 0; s < 4; ++s) { const int kb = (16 * s + 8 * hh) * 2;
                if (jt <= it) af = __builtin_amdgcn_mfma_f32_32x32x16_bf16(lds_frag(lds + G3_AOP, 32 * it + r32, GL_S192, 128 + kb), lds_frag(lds + G3_KIF, 32 * jt + r32, GL_S64, kb), af, 0, 0, 0);
                if (jt >= it) ab = __builtin_amdgcn_mfma_f32_32x32x16_bf16(lds_frag(lds + G3_AOP, 32 * it + r32, GL_S192, 256 + kb), lds_frag(lds + G3_KIB, 32 * jt + r32, GL_S64, kb), ab, 0, 0, 0); }
#pragma unroll
            for (int r = 0; r < 16; ++r) { const int i = 32 * it + crow(r, hh), j = 32 * jt + r32; const float v = (j <= i) ? af[r] : ab[r];
                *(LAS bf16*)(lds + G3_AOP + i * GL_S192 + j * 2) = (bf16)(cvt_pk(v, 0.f) & 0xffffu); }
        }
        __syncthreads();
        {
            const int it = wid >> 2, dt = wid & 3; f32x16 o = {};
#pragma unroll
            for (int s = 0; s < 12; ++s) { const int kb = (16 * s + 8 * hh) * 2;
                o = __builtin_amdgcn_mfma_f32_32x32x16_bf16(lds_frag(lds + G3_AOP, 32 * it + r32, GL_S192, kb), lds_frag(lds + G3_BOP, 32 * dt + r32, GL_S192, kb), o, 0, 0, 0); }
            LAS float* out = (LAS float*)(lds + GL_CUM);
#pragma unroll
            for (int r = 0; r < 16; ++r) out[(32 * it + crow(r, hh)) * 128 + 32 * dt + r32] = o[r];
        }
        __syncthreads();
        {
            const int t = F.tid >> 3, v0 = (F.tid & 7) * 16; const LAS float* orow = (const LAS float*)(lds + GL_CUM) + t * 128 + v0;
            float x[16]; float ss = 0.f;
#pragma unroll
            for (int j = 0; j < 16; ++j) { x[j] = orow[j]; ss += x[j] * x[j]; }
            ss += __shfl_xor(ss, 1); ss += __shfl_xor(ss, 2); ss += __shfl_xor(ss, 4);
            const float rs = rsqrtf(ss * (1.f / 128.f) + RMS_EPS);
            const u32x4 ga = *(const u32x4*)(W.SG + (trow0 + t) * 512 + h * 128 + v0), gb = *(const u32x4*)(W.SG + (trow0 + t) * 512 + h * 128 + v0 + 8);
            const unsigned gw[8] = {ga.x, ga.y, ga.z, ga.w, gb.x, gb.y, gb.z, gb.w};
            float y[16];
#pragma unroll
            for (int j = 0; j < 16; ++j) y[j] = x[j] * rs * gng[v0 + j] * ((j & 1) ? bfhi(gw[j >> 1]) : bflo(gw[j >> 1]));
            u32x4 o0, o1; o0.x = cvt_pk(y[0], y[1]); o0.y = cvt_pk(y[2], y[3]); o0.z = cvt_pk(y[4], y[5]); o0.w = cvt_pk(y[6], y[7]);
            o1.x = cvt_pk(y[8], y[9]); o1.y = cvt_pk(y[10], y[11]); o1.z = cvt_pk(y[12], y[13]); o1.w = cvt_pk(y[14], y[15]);
            bf16* dst = W.OAB + (trow0 + t) * 512 + h * 128 + v0; *(u32x4*)dst = o0; *(u32x4*)(dst + 8) = o1;
        }
        __syncthreads();
    }
}
__device__ __forceinline__ void phase_select(Frame& F, int l) {
    refresh(F);
    const WS W = ws_map(F.ws, F.nb); const float* const* IN_ = F.a->in; (void)IN_; (void)W;
    LAS int* lcnt = (LAS int*)F.lds; LAS int* lbase = lcnt + 32;
    const float* b_rg = IN_[19] + l * 4; const float* b_re = IN_[21] + l * 32;
    unsigned* gcnt = W.ctl + CW_CNT + l * 64;
    for (int t0 = F.bid * NTHR; t0 < F.T; t0 += F.G * NTHR) {
        if (F.tid < 32) lcnt[F.tid] = 0;
        __syncthreads();
        const int t = t0 + F.tid; int e0 = 0, e1 = 0, r0 = 0, r1 = 0; float g0 = 0.f, g1 = 0.f;
        if (t < F.T) {
            const float* lg = W.LOGITS + (size_t)t * 64;
            float gl[4]; { const f32x4 v = *(const f32x4*)lg; gl[0] = v[0] + b_rg[0]; gl[1] = v[1] + b_rg[1]; gl[2] = v[2] + b_rg[2]; gl[3] = v[3] + b_rg[3]; }
            int grp = 0; float mx = gl[0];
            if (gl[1] > mx) { mx = gl[1]; grp = 1; } if (gl[2] > mx) { mx = gl[2]; grp = 2; } if (gl[3] > mx) { mx = gl[3]; grp = 3; }
            const float p_grp = 1.f / (__expf(gl[0] - mx) + __expf(gl[1] - mx) + __expf(gl[2] - mx) + __expf(gl[3] - mx));
            const f32x4 ea = *(const f32x4*)(lg + 4 + grp * 8), eb = *(const f32x4*)(lg + 8 + grp * 8);
            const f32x4 ba = *(const f32x4*)(b_re + grp * 8), bb = *(const f32x4*)(b_re + grp * 8 + 4);
            float b0v = -1e30f, b1v = -1e30f; int i0 = 0, i1 = 0;
#pragma unroll
            for (int j = 0; j < 8; ++j) { const float e = (j < 4) ? ea[j] + ba[j] : eb[j - 4] + bb[j - 4];
                if (e > b0v) { b1v = b0v; i1 = i0; b0v = e; i0 = j; } else if (e > b1v) { b1v = e; i1 = j; } }
            const float p1 = __expf(b1v - b0v), s2 = 1.f + p1;
            e0 = grp * 8 + i0; e1 = grp * 8 + i1; g0 = p_grp / s2; g1 = p_grp * p1 / s2;
            r0 = __hip_atomic_fetch_add(lcnt + e0, 1, __ATOMIC_RELAXED, __HIP_MEMORY_SCOPE_WORKGROUP);
            r1 = __hip_atomic_fetch_add(lcnt + e1, 1, __ATOMIC_RELAXED, __HIP_MEMORY_SCOPE_WORKGROUP);
        }
        __syncthreads();
        if (F.tid < 32) lbase[F.tid] = (int)__hip_atomic_fetch_add(gcnt + F.tid, (unsigned)lcnt[F.tid], __ATOMIC_RELAXED, __HIP_MEMORY_SCOPE_AGENT);
        __syncthreads();
        if (t < F.T) { W.eid[t * 2] = e0; W.eid[t * 2 + 1] = e1; W.gate[t * 2] = g0; W.gate[t * 2 + 1] = g1; W.rank[t * 2] = lbase[e0] + r0; W.rank[t * 2 + 1] = lbase[e1] + r1; }
        __syncthreads();
    }
}
__device__ __forceinline__ void phase_gather(Frame& F, int l) {
    refresh(F);
    const WS W = ws_map(F.ws, F.nb); const float* const* IN_ = F.a->in; (void)IN_; (void)W;
    LAS int* seg = (LAS int*)F.lds; LAS int* cnt = seg + 40;
    const unsigned* gcnt = W.ctl + CW_CNT + l * 64;
    if (F.tid == 0) { int o = 0; for (int e = 0; e < 32; ++e) { const int c = (int)__hip_atomic_load(gcnt + e, __ATOMIC_RELAXED, __HIP_MEMORY_SCOPE_AGENT); seg[e] = o; cnt[e] = c; o += (c + 255) & ~255; } seg[32] = o; }
    __syncthreads();
    const int ntile = seg[32] >> 8;
    if (F.bid == 0) {
        for (int i = F.tid; i < ntile; i += NTHR) { int e = 0; while (e < 31 && (i << 8) >= seg[e + 1]) ++e; W.tilee[i] = e; }
        if (F.tid == 0) W.segp[0] = ntile;
    }
    for (int p = F.bid * NTHR + F.tid; p < (ntile << 8); p += F.G * NTHR) { int e = 0; while (e < 31 && p >= seg[e + 1]) ++e; if (p - seg[e] >= cnt[e]) W.stok[p] = 0; }
    for (int it = F.bid * NTHR + F.tid; it < F.T * 2; it += F.G * NTHR) {
        const int e = W.eid[it], p = seg[e] + W.rank[it];
        W.stok[p] = it >> 1; W.pos[it] = p; W.gsort[p] = W.gate[it];
    }
}

#ifndef MK_MASK
#define MK_MASK 0xffffffffu
#endif
#define EN(b) (((MK_MASK) >> (b)) & 1u)
#ifndef MK_ALIGN
#define MK_ALIGN true
#endif
#ifndef MK_SP2
#define MK_SP2 true
#endif
#ifndef MK_DUP
#define MK_DUP 0u
#endif
#define REPS(b) ((((MK_DUP) >> (b)) & 1u) ? 2 : 1)
constexpr int NPL = 14, NPH = 2 + DEPTH * NPL;
__global__ void __launch_bounds__(NTHR, 2) mk_fwd(Args args) {
    extern __shared__ __attribute__((aligned(16))) unsigned char lds_raw[];
    Frame F;
    F.lds = (LAS unsigned char*)lds_raw; F.tid = threadIdx.x; F.lane = F.tid & 63; F.wave = __builtin_amdgcn_readfirstlane(F.tid >> 6);
    F.G = gridDim.x; F.bid = blockIdx.x; F.nb = args.nb; F.T = args.nb * SEQ; F.ws = args.ws; F.a = &args; F.xbuf = args.out;
    const float* const* IN_ = args.in;
    volatile LAS unsigned* misc = (volatile LAS unsigned*)(F.lds + LDS_MISC);
    if (F.tid < 64) misc[F.tid] = 0u;
    __syncthreads();
    XcdBarrier bar = xcd_barrier_post((unsigned*)args.ws + CW_BAR + args.li * XCD_BAR_WORDS, misc);
    const int lo = args.ph_lo, hi = args.ph_hi;
#define IN(k) (lo <= (k) && (k) < hi)
#ifdef MK_BAR2
#define SEAM(k) do { if (IN(k) && IN((k) + 1)) { xcd_barrier(bar); xcd_barrier(bar); } } while (0)
#else
#define SEAM(k) do { if (IN(k) && IN((k) + 1)) xcd_barrier(bar); } while (0)
#endif
    LAS unsigned char* gl = F.lds;
    if (EN(0) && IN(0)) { for (int rp = 0; rp < REPS(0); ++rp) { p0_prologue(F); __syncthreads(); } SEAM(0); }
    for (int l = 0; l < DEPTH; ++l) {
        const int pb = 1 + l * NPL;
        if (EN(1) && IN(pb + 0)) { for (int rp = 0; rp < ((l == 0) ? REPS(14) : 1); ++rp) phase_norm(F, l, 0); SEAM(pb + 0); }
        if (EN(2) && IN(pb + 1)) { const WS W = ws_map(F.ws, F.nb);
            pg8::Gemm g{W.H, W.win + (size_t)l * NIN * D, F.T, NIN, D}; pg8::StaticOrder S; S.init(F.T, NIN, F.G, F.bid);
            EpiIn E{W.GQ, W.GK, W.GV, W.SG, W.LGF, W.LGB, W.DQ, W.DK, W.DV, W.SGA, W.SGB, IN_[8] + l * 512, IN_[10] + l * 64, IN_[11] + l * 64};
#ifdef MK_DEPHASE
            { const int g_ = (F.bid >> 3) & 7; for (int k_ = 0; k_ < g_ * MK_DEPHASE; ++k_) __builtin_amdgcn_s_sleep(127); }
#endif
#ifdef MK_INPROJ_NULL
            { EpiNull EN_; pg8::gemm_phase<EpiNull, pg8::StaticOrder, MK_ALIGN, MK_SP2>(gl, g, S, EN_); }
#endif
            for (int rp = 0; rp < REPS(2); ++rp) pg8::gemm_phase<EpiIn, pg8::StaticOrder, MK_ALIGN, MK_SP2>(gl, g, S, E);
            SEAM(pb + 1);
        }
        if (EN(3) && IN(pb + 2)) { for (int rp = 0; rp < REPS(3); ++rp) phase_gla1(F); SEAM(pb + 2); }
        if (EN(4) && IN(pb + 3)) { phase_gla2(F); SEAM(pb + 3); }
        if (EN(5) && IN(pb + 4)) { for (int rp = 0; rp < REPS(5); ++rp) phase_gla3(F, l); __syncthreads(); }
        if (EN(6) && IN(pb + 5)) {
#ifdef MK_ATT_PROBE
            phase_attn<MK_ATT_PROBE>(F, l);
#endif
            phase_attn<0>(F, l); SEAM(pb + 5); }
        if (EN(7) && IN(pb + 6)) { const WS W = ws_map(F.ws, F.nb);
            pg8::Gemm g{W.OAB, W.wab + (size_t)l * D * D, 0, 0, 512}; MergeOrder S; S.so.init(F.T, D, F.G, F.bid); S.nM = F.T / 256;
            EpiMerge E{W.SGA, W.SGB, W.MERGED, F.T / 256};
            for (int rp = 0; rp < REPS(7); ++rp) pg8::gemm_phase<EpiMerge, MergeOrder, MK_ALIGN, MK_SP2>(gl, g, S, E);
            SEAM(pb + 6);
        }
        if (EN(8) && IN(pb + 7)) { const WS W = ws_map(F.ws, F.nb); const float* modl = W.mod + (size_t)l * NBMAX * 6 * D;
            pg8::Gemm g{W.MERGED, W.wo + (size_t)l * D * D, F.T, D, D}; pg8::StaticOrder S; S.init(F.T, D, F.G, F.bid);
            EpiResid E{l == 0 ? IN_[0] : nullptr, W.XB, modl + 2 * D};
            for (int rp = 0; rp < ((l == 0) ? REPS(8) : 1); ++rp) pg8::gemm_phase<EpiResid, pg8::StaticOrder, MK_ALIGN, MK_SP2>(gl, g, S, E);
            SEAM(pb + 7);
        }
        if (EN(1) && IN(pb + 8)) { for (int rp = 0; rp < REPS(1); ++rp) phase_norm(F, l, 1); SEAM(pb + 8); }
        if (EN(9) && IN(pb + 9)) { const WS W = ws_map(F.ws, F.nb);
            pg8::Gemm g{W.H, W.wr + (size_t)l * 256 * D, F.T, 256, D}; pg8::StaticOrder S; S.init(F.T, 256, F.G, F.bid);
            EpiLogits E{W.LOGITS};
            for (int rp = 0; rp < REPS(9); ++rp) pg8::gemm_phase<EpiLogits, pg8::StaticOrder, MK_ALIGN, MK_SP2>(gl, g, S, E);
            SEAM(pb + 9);
        }
        if (EN(10) && IN(pb + 10)) { phase_select(F, l); SEAM(pb + 10); }
        if (EN(11) && IN(pb + 11)) { for (int rp = 0; rp < REPS(11); ++rp) { phase_gather(F, l); __syncthreads(); } SEAM(pb + 11); }
        if (EN(12) && IN(pb + 12)) { const WS W = ws_map(F.ws, F.nb);
            const int ntile = W.segp[0];
#if MK_MOE_FP8
            pg8::Gemm g{W.XS, (const bf16*)((const unsigned char*)W.w1 + (size_t)l * NE * 1024 * D), 0, 0, D / 2}; GroupedOrder S{W.tilee, ntile * 4, F.G, F.bid};
            EpiAct E{(unsigned char*)W.ACT};
#else
            pg8::Gemm g{W.H, W.w1 + (size_t)l * NE * 1024 * D, 0, 0, D}; GroupedOrder S{W.tilee, ntile * 4, F.G, F.bid, W.stok};
            EpiAct E{W.ACT};
#endif
            for (int rp = 0; rp < REPS(12); ++rp) pg8::gemm_phase<EpiAct, GroupedOrder, MK_ALIGN, MK_SP2, true>(gl, g, S, E);
            SEAM(pb + 12);
        }
        if (EN(13) && IN(pb + 13)) { const WS W = ws_map(F.ws, F.nb);
            const int ntile = W.segp[0];
#if MK_MOE_FP8
            pg8::Gemm g{W.ACT, (const bf16*)((const unsigned char*)W.w2 + (size_t)l * NE * D * DE), 0, 0, DE / 2}; GroupedOrder S{W.tilee, ntile * 4, F.G, F.bid};
#else
            pg8::Gemm g{W.ACT, W.w2 + (size_t)l * NE * D * DE, 0, 0, DE}; GroupedOrder S{W.tilee, ntile * 4, F.G, F.bid, nullptr};
#endif
            EpiYs E{(unsigned char*)W.YS, W.gsort};
            for (int rp = 0; rp < REPS(13); ++rp) pg8::gemm_phase<EpiYs, GroupedOrder, MK_ALIGN, MK_SP2>(gl, g, S, E);
            SEAM(pb + 13);
        }
    }
    if (EN(1) && IN(NPH - 1)) phase_norm(F, 0, 2);
#undef IN
#undef SEAM
}

struct LaunchCfg { int grid; bool ok; };
inline LaunchCfg& launch_cfg() {
    static LaunchCfg c{0, false}; static bool init = false;
    if (!init) { init = true;
        int dev = 0, cus = 0, per_cu = 0;
        if (hipGetDevice(&dev) != hipSuccess || hipDeviceGetAttribute(&cus, hipDeviceAttributeMultiprocessorCount, dev) != hipSuccess) { fprintf(stderr, "mk: device query failed\n"); return c; }
        if (hipFuncSetAttribute((const void*)mk_fwd, hipFuncAttributeMaxDynamicSharedMemorySize, LDS_BYTES) != hipSuccess) { fprintf(stderr, "mk: hipFuncSetAttribute failed\n"); return c; }
        if (hipOccupancyMaxActiveBlocksPerMultiprocessor(&per_cu, (const void*)mk_fwd, NTHR, LDS_BYTES) != hipSuccess || per_cu < 1) { fprintf(stderr, "mk: occupancy query says %d blocks/CU\n", per_cu); (void)hipGetLastError(); return c; }
        c.grid = cus; c.ok = true;
    }
    return c;
}
inline void launch_range(void* const* d_in, float* xbuf, void* d_ws, int nb, int lo, int hi, int li, hipStream_t stream) {
    LaunchCfg& c = launch_cfg(); if (!c.ok) return;
    Args a{}; for (int i = 0; i < 24; ++i) a.in[i] = (const float*)d_in[i];
    a.out = xbuf; a.ws = (unsigned char*)d_ws; a.nb = nb; a.ph_lo = lo; a.ph_hi = hi; a.li = li;
    hipLaunchKernelGGL(mk_fwd, dim3(c.grid), dim3(NTHR), LDS_BYTES, stream, a);
    const hipError_t le = hipPeekAtLastError(); if (le != hipSuccess) fprintf(stderr, "mk: launch [%d,%d) failed: %s\n", lo, hi, hipGetErrorName(le));
}
}
extern "C" void kernel_launch(void* const* d_in, const int* in_sizes, int n_in, void* d_out, int out_size, void* d_ws, size_t ws_size, hipStream_t stream) {
    (void)in_sizes; (void)n_in; (void)out_size;
    static int checked = 0;
    if (!checked) { checked = 1; const mk::WS w = mk::ws_map((unsigned char*)d_ws, 4); if (w.end > ws_size) { fprintf(stderr, "mk: workspace too small: need %zu, have %zu\n", w.end, ws_size); checked = -1; } }
    if (checked < 0) return;
    if (hipMemsetAsync(d_ws, 0, mk::CTL_BYTES, stream) != hipSuccess) return;
    mk::launch_range(d_in, (float*)d_out, d_ws, 4, 0, mk::NPH, 0, stream);
}
```

```cpp
#include <hip/hip_runtime.h>
#include <cstdio>
#include <cstdint>
#include <cmath>
#define MK_ATT_FP8 1
namespace pg8 {
#define PG8_LAS __attribute__((address_space(3)))
typedef unsigned short bf16_t;
typedef short bf16x8 __attribute__((ext_vector_type(8)));
typedef float f32x4 __attribute__((ext_vector_type(4)));
typedef unsigned u32x4 __attribute__((ext_vector_type(4)));
constexpr int BM = 256, BK = 64, HALF = 128, HTB = HALF * BK * 2  , STAGE_BYTES = 8 * HTB, NXCD = 8, WGM = 8;

__host__ __device__ __forceinline__ int lds_byte(int r, int c) { const int st = (r >> 4) * 2 + (c >> 5), rr = r & 15, cc = c & 31, ob = rr * 64 + cc * 2; return st * 1024 + (ob ^ (((ob >> 9) & 1) << 5)); }
__host__ __device__ __forceinline__ void stage_rc(int b, int& R, int& C) { const int st = b / 1024, sb = b % 1024, swz = sb ^ (((sb >> 9) & 1) << 5); R = (st >> 1) * 16 + swz / 64; C = (st & 1) * 32 + (swz % 64) / 2; }
__host__ __device__ __forceinline__ int perm32(int rho) { const int n = rho >> 4, i = rho & 15; return 8 * (i >> 2) + 4 * n + (i & 3); }

struct Unit { int pm, pn; };
struct Gemm { const bf16_t* A; const bf16_t* Bt; int M, N, K; };

struct StaticOrder {
    int nM, nN, nwg, G, c;
    __host__ __device__ void init(int M, int N, int G_, int c_) { nM = M / BM; nN = N / BM; nwg = nM * nN; G = G_; c = c_; }
    __host__ __device__ bool next(int i, Unit& u) const {
        const long L = (long)i * G + c; if (L >= nwg) return false;
        int wgid = (int)L; { const int q = nwg / NXCD, r = nwg % NXCD, xcd = wgid % NXCD, off = wgid / NXCD; wgid = (xcd < r ? xcd * (q + 1) : r * (q + 1) + (xcd - r) * q) + off; }
        const int nig = WGM * nN, gid = wgid / nig, fm = gid * WGM, gsz = (nM - fm) < WGM ? (nM - fm) : WGM;
        u.pm = fm + ((wgid % nig) % gsz); u.pn = (wgid % nig) / gsz; return true;
    }
    __device__ __forceinline__ void a_ready(const Unit&) const {}
    __device__ __forceinline__ void done(const Unit&) const {}
};
__device__ __forceinline__ unsigned cvt_pk_bf16(float lo, float hi) { unsigned r; asm volatile("v_cvt_pk_bf16_f32 %0, %1, %2" : "=v"(r) : "v"(lo), "v"(hi)); return r; }
__device__ __forceinline__ const void* pg8_uniform(const void* p) { const unsigned long long v = (unsigned long long)p;
    const unsigned lo = (unsigned)__builtin_amdgcn_readfirstlane((int)(unsigned)v), hi = (unsigned)__builtin_amdgcn_readfirstlane((int)(unsigned)(v >> 32)); return (const void*)(((unsigned long long)hi << 32) | lo); }
__device__ __forceinline__ void pg8_glds(const void* sbase, unsigned voff, unsigned ldsdst) { unsigned keep;
    asm volatile("s_nop 4\n\ts_mov_b32 %0, m0\n\ts_mov_b32 m0, %3\n\ts_nop 0\n\tglobal_load_lds_dwordx4 %1, %2\n\ts_mov_b32 m0, %0" : "=&s"(keep) : "v"(voff), "s"(sbase), "s"(ldsdst) : "memory"); }
typedef int pg8_v8i __attribute__((ext_vector_type(8)));
typedef int pg8_v4i __attribute__((ext_vector_type(4)));
template <class Epi, class Sched, bool ALIGN_EPI = false, bool SP2 = false, bool GATHER = false>
__device__ __forceinline__ void gemm_phase(PG8_LAS unsigned char* lds, const Gemm g, const Sched& S, const Epi& E) {
    int tid_ = threadIdx.x; asm volatile("" : "+v"(tid_));
    const int tid = tid_, wid = __builtin_amdgcn_readfirstlane(tid >> 6), lane = tid & 63, wr = wid >> 2, wc = wid & 3, fr = lane & 15, fq = lane >> 4;
    const int K = g.K, nt = K / BK;
    unsigned voffA[2], voffB[2]; unsigned vc[2][2] = {}, vn[2][2] = {}, vs[2][2] = {}; (void)vc; (void)vn; (void)vs;
#pragma unroll
    for (int i = 0; i < 2; ++i) { int R, C; stage_rc(tid * 16 + i * 8192, R, C); const int Rb = Epi::PERM ? ((R & ~31) + perm32(R & 31)) : R;
        voffA[i] = (unsigned)(R * K + C) * 2u; voffB[i] = (unsigned)(Rb * K + C) * 2u; }
    const size_t kstep = (size_t)(BK * 2);
    const size_t hstep = (size_t)HALF * K * 2;
    const size_t tstep = 2 * hstep;
    const unsigned ldsw = (unsigned)wid * 1024u; const unsigned lds0 = (unsigned)(unsigned long)lds; (void)lds0;
    const int aoff = lds_byte(wr * 64 + fr, fq * 8), boff = lds_byte(wc * 32 + fr, fq * 8);
#define PG8_SA(b, h) (((b) * 2 + (h)) * HTB)
#define PG8_SB(b, h) ((4 + (b) * 2 + (h)) * HTB)
#if defined(PG8_ASM_STAGE) && PG8_ASM_STAGE
#define PG8_STAGE(bufoff, gbase, voff) do { const void* _gb = pg8_uniform(gbase); _Pragma("unroll") for (int _i = 0; _i < 2; ++_i) \
        pg8_glds(_gb, (voff)[_i], (unsigned)__builtin_amdgcn_readfirstlane((int)(lds0 + (unsigned)(bufoff) + ldsw + _i * 8192))); } while (0)
#else
#define PG8_STAGE(bufoff, gbase, voff) do { _Pragma("unroll") for (int _i = 0; _i < 2; ++_i) \
        __builtin_amdgcn_global_load_lds((const unsigned*)((const char*)(gbase) + (voff)[_i]), (PG8_LAS unsigned*)(lds + (bufoff) + ldsw + _i * 8192), 16, 0, 0); } while (0)
#endif
#define PG8_STAGE_A(b, h, X, VS) do { if constexpr (GATHER) { PG8_STAGE(PG8_SA(b, h), X, VS[h]); } else { PG8_STAGE(PG8_SA(b, h), (X) + (h) * hstep, voffA); } } while (0)
#define PG8_LOADROWS(u, v) do { _Pragma("unroll") for (int i_ = 0; i_ < 2; ++i_) { int R_, C_; stage_rc(tid * 16 + i_ * 8192, R_, C_); _Pragma("unroll") for (int h_ = 0; h_ < 2; ++h_) \
        v[h_][i_] = (unsigned)S.rowidx[(u).pm * 256 + h_ * 128 + R_] * (unsigned)(K * 2) + (unsigned)C_ * 2u; } } while (0)
#define PG8_LDA(dst, b, h) do { _Pragma("unroll") for (int m = 0; m < 4; ++m) _Pragma("unroll") for (int k = 0; k < 2; ++k) dst[m][k] = *(const PG8_LAS bf16x8*)(lds + PG8_SA(b, h) + aoff + m * 2048 + k * 1024); } while (0)
#define PG8_LDB(dst, b, h) do { _Pragma("unroll") for (int n = 0; n < 2; ++n) _Pragma("unroll") for (int k = 0; k < 2; ++k) dst[n][k] = *(const PG8_LAS bf16x8*)(lds + PG8_SB(b, h) + boff + n * 2048 + k * 1024); } while (0)
#define PG8_MMA(ai, bj, At, Bt) do { __builtin_amdgcn_s_setprio(1); _Pragma("unroll") for (int m = 0; m < 4; ++m) _Pragma("unroll") for (int n = 0; n < 2; ++n) _Pragma("unroll") for (int k = 0; k < 2; ++k) \
        acc[ai][bj][m][n] = __builtin_amdgcn_mfma_f32_16x16x32_bf16(Bt[n][k], At[m][k], acc[ai][bj][m][n], 0, 0, 0); __builtin_amdgcn_s_setprio(0); } while (0)
#define PG8_WAIT_V(n) asm volatile("s_waitcnt vmcnt(" #n ")" ::: "memory")
#define PG8_WAIT_L(n) asm volatile("s_waitcnt lgkmcnt(" #n ")" ::: "memory")
#define PG8_BAR __builtin_amdgcn_s_barrier()
#define PG8_SCHED __builtin_amdgcn_sched_barrier(0)
    Unit cur, nxt; int ui = 0;
    if (!S.next(0, cur)) return;
    f32x4 acc[2][2][4][2];
#pragma unroll
    for (int a = 0; a < 2; ++a)
#pragma unroll
        for (int b = 0; b < 2; ++b)
#pragma unroll
            for (int m = 0; m < 4; ++m)
#pragma unroll
                for (int n = 0; n < 2; ++n) acc[a][b][m][n] = (f32x4){0.f, 0.f, 0.f, 0.f};
    bf16x8 At[4][2], B0[2][2], B1[2][2];
    const char* cA = (const char*)g.A + (GATHER ? (size_t)0 : (size_t)cur.pm * tstep); const char* cB = (const char*)g.Bt + (size_t)cur.pn * tstep;
    S.a_ready(cur);
    if constexpr (GATHER) { PG8_LOADROWS(cur, vc); }
    if constexpr (SP2) {
        PG8_STAGE(PG8_SB(0, 0), cB, voffB); PG8_STAGE(PG8_SB(0, 1), cB + hstep, voffB); PG8_STAGE_A(0, 0, cA, vc); PG8_STAGE_A(0, 1, cA, vc);
        if (wr == 1) PG8_BAR;
        PG8_WAIT_V(2); PG8_BAR;
        PG8_STAGE(PG8_SB(1, 0), cB + kstep, voffB); PG8_STAGE_A(1, 0, cA + kstep, vc); PG8_STAGE(PG8_SB(1, 1), cB + hstep + kstep, voffB);
        PG8_WAIT_V(6); PG8_BAR;
    } else {
        PG8_STAGE(PG8_SB(0, 0), cB, voffB); PG8_STAGE_A(0, 0, cA, vc); PG8_STAGE(PG8_SB(0, 1), cB + hstep, voffB); PG8_STAGE_A(0, 1, cA, vc);
        if (wr == 1) PG8_BAR;
        PG8_WAIT_V(4); PG8_BAR;
        PG8_STAGE(PG8_SB(1, 0), cB + kstep, voffB); PG8_STAGE_A(1, 0, cA + kstep, vc); PG8_STAGE(PG8_SB(1, 1), cB + hstep + kstep, voffB);
        PG8_WAIT_V(6); PG8_BAR;
    }
    for (;;) {
        const bool has_next = S.next(ui + 1, nxt);
        const char* nA = (has_next && !GATHER) ? (const char*)g.A + (size_t)nxt.pm * tstep : cA; const char* nB = has_next ? (const char*)g.Bt + (size_t)nxt.pn * tstep : cB;
        for (int t = 0; t < nt; t += 2) {
            const bool last = (t == nt - 2);
            const char* a1 = cA + (size_t)(t + 1) * kstep;
            const char* a2 = last ? nA : cA + (size_t)(t + 2) * kstep; const char* b2 = last ? nB : cB + (size_t)(t + 2) * kstep;
            const char* a3 = a2 + kstep; const char* b3 = b2 + kstep;
            if (last && has_next) S.a_ready(nxt);
            if constexpr (GATHER) { if (last && has_next) { PG8_LOADROWS(nxt, vn); }
                _Pragma("unroll") for (int h_ = 0; h_ < 2; ++h_) _Pragma("unroll") for (int i_ = 0; i_ < 2; ++i_) vs[h_][i_] = (last && has_next) ? vn[h_][i_] : vc[h_][i_]; }
            if constexpr (Epi::MIDK) { if (t == nt / 2) E.mid(acc, cur, wr, wc, fr, fq); }
            if constexpr (SP2) {
            PG8_LDB(B0, 0, 0); PG8_LDB(B1, 0, 1); PG8_SCHED; PG8_LDA(At, 0, 0); PG8_STAGE_A(1, 1, a1, vc);
            PG8_WAIT_V(8); PG8_WAIT_L(0); PG8_BAR; PG8_MMA(0, 0, At, B0); PG8_MMA(0, 1, At, B1); PG8_BAR; PG8_SCHED;
            PG8_LDA(At, 0, 1); PG8_STAGE(PG8_SB(0, 0), b2, voffB); PG8_STAGE(PG8_SB(0, 1), b2 + hstep, voffB); PG8_STAGE_A(0, 0, a2, vs);
            PG8_WAIT_V(8); PG8_WAIT_L(0); PG8_BAR; PG8_MMA(1, 0, At, B0); PG8_MMA(1, 1, At, B1); PG8_BAR; PG8_SCHED;
            PG8_LDB(B0, 1, 0); PG8_LDB(B1, 1, 1); PG8_SCHED; PG8_LDA(At, 1, 0); PG8_STAGE_A(0, 1, a2, vs);
            PG8_WAIT_V(8); PG8_WAIT_L(0); PG8_BAR; PG8_MMA(0, 0, At, B0); PG8_MMA(0, 1, At, B1); PG8_BAR; PG8_SCHED;
            PG8_LDA(At, 1, 1); PG8_STAGE(PG8_SB(1, 0), b3, voffB); PG8_STAGE(PG8_SB(1, 1), b3 + hstep, voffB); PG8_STAGE_A(1, 0, a3, vs);
            PG8_WAIT_V(8); PG8_WAIT_L(0); PG8_BAR; PG8_MMA(1, 0, At, B0); PG8_MMA(1, 1, At, B1); PG8_BAR; PG8_SCHED;
            } else {
            PG8_LDB(B0, 0, 0); PG8_SCHED; PG8_LDA(At, 0, 0); PG8_STAGE_A(1, 1, a1, vc);
            PG8_WAIT_L(8); PG8_BAR; PG8_WAIT_L(0); PG8_MMA(0, 0, At, B0); PG8_BAR; PG8_SCHED;
            PG8_LDB(B1, 0, 1); PG8_STAGE(PG8_SB(0, 0), b2, voffB);
            PG8_BAR; PG8_WAIT_L(0); PG8_MMA(0, 1, At, B1); PG8_BAR;
            PG8_LDA(At, 0, 1); PG8_STAGE_A(0, 0, a2, vs);
            PG8_BAR; PG8_WAIT_L(0); PG8_MMA(1, 0, At, B0); PG8_BAR; PG8_SCHED;
            PG8_STAGE(PG8_SB(0, 1), b2 + hstep, voffB);
            PG8_WAIT_V(6); PG8_BAR; PG8_MMA(1, 1, At, B1); PG8_BAR;
            PG8_LDB(B0, 1, 0); PG8_SCHED; PG8_LDA(At, 1, 0); PG8_STAGE_A(0, 1, a2, vs);
            PG8_WAIT_L(8); PG8_BAR; PG8_WAIT_L(0); PG8_MMA(0, 0, At, B0); PG8_BAR; PG8_SCHED;
            PG8_LDB(B1, 1, 1); PG8_STAGE(PG8_SB(1, 0), b3, voffB);
            PG8_BAR; PG8_WAIT_L(0); PG8_MMA(0, 1, At, B1); PG8_BAR;
            PG8_LDA(At, 1, 1); PG8_STAGE_A(1, 0, a3, vs);
            PG8_BAR; PG8_WAIT_L(0); PG8_MMA(1, 0, At, B0); PG8_BAR; PG8_SCHED;
            PG8_STAGE(PG8_SB(1, 1), b3 + hstep, voffB);
            PG8_WAIT_V(6); PG8_BAR; PG8_MMA(1, 1, At, B1); PG8_BAR;
            }
        }
        if constexpr (ALIGN_EPI) { if (wr == 0) PG8_BAR; }
        if constexpr (!Epi::AFTER_DRAIN) { E(acc, cur, wr, wc, fr, fq); S.done(cur); }
        if (!has_next) break;
#pragma unroll
        for (int a = 0; a < 2; ++a)
#pragma unroll
            for (int b = 0; b < 2; ++b)
#pragma unroll
                for (int m = 0; m < 4; ++m)
#pragma unroll
                    for (int n = 0; n < 2; ++n) acc[a][b][m][n] = (f32x4){0.f, 0.f, 0.f, 0.f};
        cur = nxt; cA = nA; cB = nB; ++ui;
        if constexpr (GATHER) { _Pragma("unroll") for (int h_ = 0; h_ < 2; ++h_) _Pragma("unroll") for (int i_ = 0; i_ < 2; ++i_) vc[h_][i_] = vn[h_][i_]; }
        if constexpr (ALIGN_EPI) { if (wr == 1) PG8_BAR; }
    }
    PG8_WAIT_V(0);
    if constexpr (!ALIGN_EPI) { if (wr == 0) PG8_BAR; }
    PG8_BAR;
    if constexpr (Epi::AFTER_DRAIN) { E.fused(acc, cur, wr, wc, fr, fq, lds, wid, lane); S.done(cur); }
#undef PG8_SA
#undef PG8_SB
#undef PG8_STAGE
#undef PG8_STAGE_A
#undef PG8_LOADROWS
#undef PG8_LDA
#undef PG8_LDB
#undef PG8_MMA
#undef PG8_WAIT_V
#undef PG8_WAIT_L
#undef PG8_BAR
#undef PG8_SCHED
}
}
namespace mk {
constexpr int D = 1024, SEQ = 8192, NBMAX = 4, NH = 4, DIN = 5152, NE = 32, DE = 512, DEPTH = 2;
constexpr int NT_IN = 22, NIN = NT_IN * 256;
constexpr int NWAVES = 8, NTHR = 512;
#ifndef MK_MOE_FP8
#define MK_MOE_FP8 0
#endif
constexpr float WSCALE = 16.f, ASCALE = 4.f, YSCALE = 32.f;
constexpr float LOG2E = 1.4426950408889634f, QSCALE = 0.125f * LOG2E, RMS_EPS = 1e-6f;
constexpr int O_GQ = 0, O_GK = 256, O_GV = 512, O_GG = 1024, O_LRF = 1536, O_LRB = 1552, O_DQ = 1568, O_DK = 2080, O_DV = 2592, O_GA = 3104, O_GB = 4128;
typedef unsigned short bf16;
typedef unsigned u32x4 __attribute__((ext_vector_type(4)));
typedef unsigned u32x2 __attribute__((ext_vector_type(2)));
typedef float f32x4 __attribute__((ext_vector_type(4)));
typedef float f32x16 __attribute__((ext_vector_type(16)));
typedef short bf16x8 __attribute__((ext_vector_type(8)));
typedef short s16x4 __attribute__((ext_vector_type(4)));
#define LAS __attribute__((address_space(3)))
#define GAS __attribute__((address_space(1)))
#define LDS_WAIT() asm volatile("s_waitcnt lgkmcnt(0)" ::: "memory")
#define VM_WAIT() asm volatile("s_waitcnt vmcnt(0)" ::: "memory")

constexpr size_t MiB = 1u << 20;
constexpr size_t CTL_BYTES = 256 * 1024;
constexpr int CW_BAR = 4096;
constexpr int CW_CNT = 32768;
constexpr size_t OFF_MOD = 256 * 1024, OFF_TAB = 512 * 1024;
constexpr size_t OFF_WIN = 1 * MiB, SZ_WIN = (size_t)DEPTH * NIN * D * 2;
constexpr size_t OFF_WAB = OFF_WIN + SZ_WIN, SZ_WAB = (size_t)DEPTH * D * D * 2;
constexpr size_t OFF_WO = OFF_WAB + SZ_WAB, SZ_WO = SZ_WAB;
constexpr size_t OFF_WR = OFF_WO + SZ_WO, SZ_WR = (size_t)DEPTH * 256 * D * 2;
constexpr size_t OFF_W1 = OFF_WR + SZ_WR, SZ_W1 = (size_t)DEPTH * NE * 1024 * D * 2;
constexpr size_t OFF_W2 = OFF_W1 + SZ_W1, SZ_W2 = (size_t)DEPTH * NE * D * DE * 2;
constexpr size_t OFF_ACT = 225 * MiB;
static_assert(OFF_W2 + SZ_W2 <= OFF_ACT, "weights fit");
struct WS {
    unsigned* ctl; float* mod; float* tab;
    bf16 *win, *wab, *wo, *wr, *w1, *w2;
    bf16 *H, *OAB, *XB; int* eid; float* gate; int* rank; int* pos; int* tilee; int* segp;
    bf16 *GQ, *GK, *GV, *SG; bf16 *LGF, *LGB; bf16 *DQ, *DK, *DV, *SGA, *SGB; float* KVT; float* DEC; bf16* MERGED;
    bf16 *XS, *ACT, *YS; float* LOGITS; float* gsort; int* stok;
    size_t end;
};
__host__ __device__ inline WS ws_map(unsigned char* b, int nb) {
    WS w; const size_t T = (size_t)nb * SEQ;
    w.ctl = (unsigned*)b; w.mod = (float*)(b + OFF_MOD); w.tab = (float*)(b + OFF_TAB);
    w.win = (bf16*)(b + OFF_WIN); w.wab = (bf16*)(b + OFF_WAB); w.wo = (bf16*)(b + OFF_WO); w.wr = (bf16*)(b + OFF_WR); w.w1 = (bf16*)(b + OFF_W1); w.w2 = (bf16*)(b + OFF_W2);
    size_t o = OFF_ACT;
    auto take = [&](size_t bytes) { unsigned char* p = b + o; o += (bytes + 255) & ~(size_t)255; return p; };
    w.H = (bf16*)take(T * 2048); w.OAB = (bf16*)take(T * 2048); w.XB = (bf16*)take(T * 2048);
    w.eid = (int*)take(T * 8); w.gate = (float*)take(T * 8); w.rank = (int*)take(T * 8); w.pos = (int*)take(T * 8); w.tilee = (int*)take(4096); w.segp = (int*)take(1024);
    const size_t u0 = o;
    w.GQ = (bf16*)take(T * 512); w.GK = (bf16*)take(T * 512); w.GV = (bf16*)take(T * 1024); w.SG = (bf16*)take(T * 1024);
    w.LGF = (bf16*)take(T * 512); w.LGB = (bf16*)take(T * 512);
    w.DQ = (bf16*)take(T * 1024); w.DK = (bf16*)take(T * 1024); w.DV = (bf16*)take(T * 1024); w.SGA = (bf16*)take(T * 2048); w.SGB = (bf16*)take(T * 2048);
    w.KVT = (float*)take(T * 4096); w.MERGED = (bf16*)w.KVT; w.DEC = (float*)take(T * 32);
    const size_t e1 = o; o = u0;
    const size_t R = 2 * T + 32 * 256;
    w.XS = (bf16*)take(R * 2048); w.ACT = (bf16*)take(R * 1024); w.YS = (bf16*)take(R * 2048); w.LOGITS = (float*)take(T * 256); w.gsort = (float*)take(R * 4); w.stok = (int*)take(R * 4);
    w.end = o > e1 ? o : e1;
    return w;
}

typedef float f32x2_t __attribute__((ext_vector_type(2))); typedef __bf16 bf16x2_t __attribute__((ext_vector_type(2)));
__device__ __forceinline__ unsigned cvt_pk(float lo, float hi) { const f32x2_t v = {lo, hi}; const bf16x2_t b = __builtin_convertvector(v, bf16x2_t); return __builtin_bit_cast(unsigned, b); }
__device__ __forceinline__ float bf2f(unsigned short b) { return __uint_as_float(((unsigned)b) << 16); }
__device__ __forceinline__ float bflo(unsigned w) { return __uint_as_float(w << 16); }
__device__ __forceinline__ float bfhi(unsigned w) { return __uint_as_float(w & 0xffff0000u); }
__device__ __forceinline__ float fsigmoid(float x) { return __builtin_amdgcn_rcpf(1.f + __expf(-x)); }
__device__ __forceinline__ float fsilu(float x) { return x * fsigmoid(x); }
__device__ __forceinline__ float wave_sum(float v) {
#pragma unroll
    for (int o = 1; o < 64; o <<= 1) v += __shfl_xor(v, o);
    return v;
}
__device__ __forceinline__ int t5_bucket(int rel) {
    int ret = rel > 0 ? 16 : 0; int n = rel < 0 ? -rel : rel;
    if (n < 8) return ret + n;
    return ret + 8 + (n >= 12) + (n >= 16) + (n >= 23) + (n >= 32) + (n >= 46) + (n >= 64) + (n >= 91);
}

#define XB_TMO      128
#define XB_XCNT(j)  (256  + 64 * (j))
#define XB_XSUB(j)  (1280 + 64 * (j))
#define XB_XGEN(j)  (2304 + 64 * (j))
#define XB_TOP      3328
#define XB_TOPGEN   3392
#define XCD_BAR_WORDS 3456
#define XB_SPIN_CAP (1u << 18)
__device__ __forceinline__ unsigned xb_ld(unsigned* p)              { return __hip_atomic_load(p, __ATOMIC_RELAXED, __HIP_MEMORY_SCOPE_AGENT); }
__device__ __forceinline__ unsigned xb_add(unsigned* p, unsigned v) { return __hip_atomic_fetch_add(p, v, __ATOMIC_RELAXED, __HIP_MEMORY_SCOPE_AGENT); }
__device__ __forceinline__ unsigned xb_xcc_id() { return (unsigned)__builtin_amdgcn_s_getreg((3 << 11) | 20) & 0xFu; }
#define XB_SPIN(cond, bar) do { unsigned _sp = 0; while (cond) { __builtin_amdgcn_s_sleep(1); \
    if ((++_sp & 255u) == 0u) { if (xb_ld(&(bar)[XB_TMO])) break; if (_sp > XB_SPIN_CAP) { atomicAdd(&(bar)[XB_TMO], 1u); break; } } } } while (0)
struct XcdBarrier { unsigned* bar; unsigned x; volatile LAS unsigned* st; };
__device__ __forceinline__ XcdBarrier xcd_barrier_post(unsigned* bar, volatile LAS unsigned* st) {
    XcdBarrier b; b.bar = bar; b.x = xb_xcc_id(); b.st = st;
    if (threadIdx.x == 0) (void)xb_add(&bar[XB_XCNT(b.x)], 1u);
    return b;
}
__device__ __forceinline__ void xcd_barrier_complete(unsigned* bar, unsigned x, unsigned& nloc, unsigned& nx) {
    const unsigned G = gridDim.x * gridDim.y * gridDim.z;
    unsigned sum, cnt, mine, sp = 0u;
    for (;;) {
        sum = 0u; cnt = 0u; mine = 0u;
#pragma unroll
        for (unsigned j = 0; j < 16; ++j) { const unsigned c = xb_ld(&bar[XB_XCNT(j)]); sum += c; cnt += (c > 0u) ? 1u : 0u; mine = (j == x) ? c : mine; }
        if (sum == G) break;
        __builtin_amdgcn_s_sleep(1);
        if ((++sp & 255u) == 0u) { if (xb_ld(&bar[XB_TMO])) break; if (sp > XB_SPIN_CAP) { atomicAdd(&bar[XB_TMO], 1u); break; } }
    }
    nloc = mine > 0u ? mine : 1u; nx = cnt > 0u ? cnt : 1u;
}
__device__ __forceinline__ void xcd_barrier(const XcdBarrier& b) {
    asm volatile("s_waitcnt vmcnt(0)" ::: "memory");
    __syncthreads();
    if (threadIdx.x == 0) {
        unsigned* bar = b.bar;
        __builtin_amdgcn_s_waitcnt(0);
        unsigned nloc = b.st[0], nx = b.st[1];
        if (nloc == 0u) { xcd_barrier_complete(bar, b.x, nloc, nx); b.st[0] = nloc; b.st[1] = nx; }
        const unsigned old = xb_add(&bar[XB_XSUB(b.x)], 1u);
        const unsigned gen = old / nloc;
        if (old + 1u == (gen + 1u) * nloc) {
            __builtin_amdgcn_fence(__ATOMIC_RELEASE, "agent");
            asm volatile("s_waitcnt vmcnt(0)" ::: "memory");
            const unsigned og = xb_add(&bar[XB_TOP], 1u);
            const unsigned tg = og / nx;
            if (og + 1u == (tg + 1u) * nx) xb_add(&bar[XB_TOPGEN], 1u);
            else XB_SPIN(xb_ld(&bar[XB_TOPGEN]) == tg, bar);
            __builtin_amdgcn_fence(__ATOMIC_ACQUIRE, "agent");
            xb_add(&bar[XB_XGEN(b.x)], 1u);
            asm volatile("s_waitcnt vmcnt(0)" ::: "memory");
        } else {
            XB_SPIN(xb_ld(&bar[XB_XGEN(b.x)]) == gen, bar);
            __builtin_amdgcn_fence(__ATOMIC_ACQUIRE, "agent");
            asm volatile("s_waitcnt vmcnt(0)" ::: "memory");
        }
    }
    __syncthreads();
}

struct Args { const float* in[24]; float* out; unsigned char* ws; int nb, ph_lo, ph_hi, li; };
struct Frame {
    LAS unsigned char* lds; int tid, lane, wave, G, bid, nb, T; unsigned char* ws; const Args* a; float* xbuf;
};
__device__ __forceinline__ void refresh(Frame& F) { int t = threadIdx.x; asm volatile("" : "+v"(t)); F.tid = t; F.lane = t & 63; F.wave = __builtin_amdgcn_readfirstlane(t >> 6); }
constexpr int LDS_BYTES = 160 * 1024 - 64 * 0;
constexpr int LDS_MISC = 160 * 1024 - 256;

__device__ __forceinline__ void tr_item(const float* src, int lds_, int ks0, int c0, bf16* dst, int ldd, int r0, int kd0, LAS float* scr, int lane) {
#pragma unroll 8
    for (int i = 0; i < 32; ++i) { const int kk = 2 * i + (lane >> 5); scr[kk * 33 + (lane & 31)] = src[(size_t)(ks0 + kk) * lds_ + c0 + (lane & 31)]; }
    LDS_WAIT(); asm volatile("" ::: "memory");
    const int c = lane & 7;
#pragma unroll
    for (int j = 0; j < 4; ++j) { const int n = (lane >> 3) + 8 * j; const LAS float* s = scr + (8 * c) * 33 + n;
        u32x4 o; o.x = cvt_pk(s[0 * 33], s[1 * 33]); o.y = cvt_pk(s[2 * 33], s[3 * 33]); o.z = cvt_pk(s[4 * 33], s[5 * 33]); o.w = cvt_pk(s[6 * 33], s[7 * 33]);
        *(u32x4*)(dst + (size_t)(r0 + n) * ldd + kd0 + 8 * c) = o; }
    LDS_WAIT(); asm volatile("" ::: "memory");
}
__device__ __forceinline__ void tr_item8(const float* src, int lds_, int ks0, int c0, unsigned char* dst, int ldd, int r0, int kd0, float scale, LAS float* scr, int lane) {
#pragma unroll 8
    for (int i = 0; i < 32; ++i) { const int kk = 2 * i + (lane >> 5); scr[kk * 33 + (lane & 31)] = src[(size_t)(ks0 + kk) * lds_ + c0 + (lane & 31)] * scale; }
    LDS_WAIT(); asm volatile("" ::: "memory");
    const int c = lane & 7;
#pragma unroll
    for (int j = 0; j < 4; ++j) { const int n = (lane >> 3) + 8 * j; const LAS float* s = scr + (8 * c) * 33 + n;
        int w0 = 0, w1 = 0;
        w0 = __builtin_amdgcn_cvt_pk_fp8_f32(s[0 * 33], s[1 * 33], w0, false); w0 = __builtin_amdgcn_cvt_pk_fp8_f32(s[2 * 33], s[3 * 33], w0, true);
        w1 = __builtin_amdgcn_cvt_pk_fp8_f32(s[4 * 33], s[5 * 33], w1, false); w1 = __builtin_amdgcn_cvt_pk_fp8_f32(s[6 * 33], s[7 * 33], w1, true);
        u32x2 o; o.x = (unsigned)w0; o.y = (unsigned)w1;
        *(u32x2*)(dst + (size_t)(r0 + n) * ldd + kd0 + 8 * c) = o; }
    LDS_WAIT(); asm volatile("" ::: "memory");
}
__device__ __forceinline__ int win_src_col(int tile, int p0) {
    const int bj = p0 >> 7, wc = (p0 >> 5) & 3; const int L = 64 * wc + 32 * bj;
    switch (tile) {
        case 0: return O_GQ + p0; case 1: return O_GK + p0;
        case 2: case 3: return O_GV + (tile - 2) * 256 + p0;
        case 4: case 5: return O_GG + (tile - 4) * 256 + p0;
        case 8: case 9: return O_DQ + (tile - 8) * 256 + L;
        case 10: case 11: return O_DK + (tile - 10) * 256 + L;
        case 12: case 13: return O_DV + (tile - 12) * 256 + p0;
        case 14: case 15: case 16: case 17: return O_GA + (tile - 14) * 256 + p0;
        default: return O_GB + (tile - 18) * 256 + p0;
    }
}
__device__ __forceinline__ void p0_prologue(Frame& F) {
    refresh(F);
    const WS W = ws_map(F.ws, F.nb); const float* const* IN_ = F.a->in;
    const float* c_in = IN_[1]; const float* w_ada = IN_[2]; const float* b_ada = IN_[3];
    {
        LAS float* red = (LAS float*)F.lds;
        for (int it = F.bid; it < DEPTH * 96; it += F.G) {
            const int l = it / 96, j = (it % 96) * 64 + F.lane;
            const float* w = w_ada + (size_t)l * D * 6 * D + j;
            float a0 = 0.f, a1 = 0.f, a2 = 0.f, a3 = 0.f;
            const int kbeg = F.wave * 128;
#pragma unroll 16
            for (int k = kbeg; k < kbeg + 128; ++k) { const float wv = w[(size_t)k * 6 * D];
                const float c0 = c_in[k], c1 = c_in[D + k], c2 = c_in[2 * D + k], c3 = c_in[3 * D + k];
                a0 += fsilu(c0) * wv; a1 += fsilu(c1) * wv; a2 += fsilu(c2) * wv; a3 += fsilu(c3) * wv; }
            red[(F.wave * 4 + 0) * 64 + F.lane] = a0; red[(F.wave * 4 + 1) * 64 + F.lane] = a1; red[(F.wave * 4 + 2) * 64 + F.lane] = a2; red[(F.wave * 4 + 3) * 64 + F.lane] = a3;
            __syncthreads();
            if (F.tid < 256) { const int b = F.tid >> 6, jj = F.tid & 63; float s = 0.f;
#pragma unroll
                for (int wv = 0; wv < 8; ++wv) s += red[(wv * 4 + b) * 64 + jj];
                const int jc = (it % 96) * 64 + jj;
                W.mod[((size_t)l * NBMAX + b) * 6 * D + jc] = s + b_ada[l * 6 * D + jc]; }
            __syncthreads();
        }
    }
    if (F.bid == 0) {
        const float* rb = IN_[14];
        for (int i = F.tid; i < 1024; i += NTHR) { const int h = i >> 8, rel = (i & 255) - 128; W.tab[i] = (rb[t5_bucket(rel) * 4 + h] - rb[31 * 4 + h]) * LOG2E; }
        if (F.tid < 4) W.tab[1024 + F.tid] = __expf(rb[15 * 4 + F.tid] - rb[31 * 4 + F.tid]);
        if (F.tid >= 64 && F.tid < 64 + DEPTH) { const int l = F.tid - 64; const float* lv = IN_[12] + l * 256; float s1 = 0.f, s2 = 0.f;
            for (int i = 0; i < 64; ++i) { s1 += lv[i] * lv[64 + i]; s2 += lv[128 + i] * lv[192 + i]; }
            W.tab[1032 + l] = expf(s1) - expf(s2) + (0.8f - 0.6f * expf(-0.3f * (float)l)); }
    }
    __syncthreads();
    LAS float* scr = (LAS float*)(F.lds + F.wave * 16384);
    const int gw = F.bid * NWAVES + F.wave, NGW = F.G * NWAVES;
    constexpr int I_IN = (NIN / 32) * 16, I_AB = 32 * 16, I_O = 32 * 16, I_1 = NE * 32 * 16, I_2 = NE * 32 * 8;
    constexpr int PER_L = I_IN + I_AB + I_O + I_1 + I_2;
    for (int it = gw; it < DEPTH * PER_L; it += NGW) {
        const int l = it / PER_L; int r = it % PER_L;
        if (r < I_IN) { const int rb = r / 16, kb = r % 16, R = rb * 32, tile = R >> 8, p0 = R & 255;
            if (tile == 6 || tile == 7) continue;
            tr_item(IN_[6] + (size_t)l * D * DIN, DIN, kb * 64, win_src_col(tile, p0), W.win + (size_t)l * NIN * D, D, R, kb * 64, scr, F.lane); continue; }
        r -= I_IN;
        if (r < I_AB) { const int rb = r / 16, kb = r % 16;
            if (kb < 8) tr_item(IN_[15] + (size_t)l * 512 * D, D, kb * 64, rb * 32, W.wab + (size_t)l * D * D, 512, rb * 32, kb * 64, scr, F.lane);
            else tr_item(IN_[16] + (size_t)l * 512 * D, D, (kb - 8) * 64, rb * 32, W.wab + (size_t)l * D * D + (size_t)1024 * 512, 512, rb * 32, (kb - 8) * 64, scr, F.lane);
            continue; }
        r -= I_AB;
        if (r < I_O) { const int rb = r / 16, kb = r % 16; tr_item(IN_[17] + (size_t)l * D * D, D, kb * 64, rb * 32, W.wo + (size_t)l * D * D, D, rb * 32, kb * 64, scr, F.lane); continue; }
        r -= I_O;
        if (r < I_1) { const int e = r / 512, q = r % 512, rb = q / 16, kb = q % 16, R = rb * 32, pn = R >> 8, p = R & 255;
            const int col = (p < 128) ? (128 * pn + p) : (512 + 128 * pn + p - 128);
#if MK_MOE_FP8
            tr_item8(IN_[22] + ((size_t)l * NE + e) * D * 1024, 1024, kb * 64, col, (unsigned char*)W.w1 + ((size_t)l * NE + e) * 1024 * D, D, R, kb * 64, WSCALE, scr, F.lane); continue; }
#else
            tr_item(IN_[22] + ((size_t)l * NE + e) * D * 1024, 1024, kb * 64, col, W.w1 + ((size_t)l * NE + e) * 1024 * D, D, R, kb * 64, scr, F.lane); continue; }
#endif
        r -= I_1;
        { const int e = r / 256, q = r % 256, rb = q / 8, kb = q % 8;
#if MK_MOE_FP8
          tr_item8(IN_[23] + ((size_t)l * NE + e) * DE * D, D, kb * 64, rb * 32, (unsigned char*)W.w2 + ((size_t)l * NE + e) * D * DE, DE, rb * 32, kb * 64, WSCALE, scr, F.lane); }
#else
          tr_item(IN_[23] + ((size_t)l * NE + e) * DE * D, D, kb * 64, rb * 32, W.w2 + ((size_t)l * NE + e) * D * DE, DE, rb * 32, kb * 64, scr, F.lane); }
#endif
    }
    for (int it = gw; it < DEPTH * 2 * 8 * 16; it += NGW) {
        const int l = it >> 8, dir = (it >> 7) & 1, nbk = (it >> 4) & 7, kb = it & 15; const int k = kb * 64 + F.lane;
        const float* wi = IN_[6] + (size_t)l * D * DIN + (size_t)k * DIN + (dir ? O_LRB : O_LRF);
        float wv[16];
#pragma unroll
        for (int r = 0; r < 16; ++r) wv[r] = wi[r];
        const float* wu = IN_[7] + ((size_t)l * 2 + dir) * 16 * 256;
        bf16* dst = W.win + (size_t)l * NIN * D + (size_t)((6 + dir) * 256) * D;
        for (int n = nbk * 32; n < nbk * 32 + 32; ++n) { float s = 0.f;
#pragma unroll
            for (int r = 0; r < 16; ++r) s += wv[r] * wu[r * 256 + n];
            dst[(size_t)n * D + k] = (bf16)(cvt_pk(s, 0.f) & 0xffffu); }
    }
    for (int it = gw * 64 + F.lane; it < DEPTH * 256 * 128; it += NGW * 64) {
        const int l = it / (256 * 128), q = it % (256 * 128), row = q >> 7, k0 = (q & 127) * 8;
        float v[8];
#pragma unroll
        for (int i = 0; i < 8; ++i) { float x = 0.f;
            if (row < 4) x = IN_[18][((size_t)l * D + k0 + i) * 4 + row]; else if (row < 36) x = IN_[20][((size_t)l * D + k0 + i) * 32 + row - 4];
            v[i] = x; }
        u32x4 o; o.x = cvt_pk(v[0], v[1]); o.y = cvt_pk(v[2], v[3]); o.z = cvt_pk(v[4], v[5]); o.w = cvt_pk(v[6], v[7]);
        *(u32x4*)(W.wr + ((size_t)l * 256 + row) * D + k0) = o;
    }
}

__device__ __forceinline__ void phase_norm(Frame& F, int l, int mode) {
    refresh(F);
    const WS W = ws_map(F.ws, F.nb); const float* const* IN_ = F.a->in;
    const int gw = F.bid * NWAVES + F.wave, NGW = F.G * NWAVES;
    const bool combine = (mode == 2) || (mode == 0 && l > 0);
    const bool from_in = (mode == 0 && l == 0);
    const int lp = (mode == 2) ? DEPTH - 1 : l - 1;
    const float* ng = (mode == 1 ? IN_[5] : IN_[4]) + (size_t)(mode == 2 ? 0 : l) * D;
    for (int t = gw; t < F.T; t += NGW) {
        const int b = t / SEQ;
        f32x4 v[4];
        if (from_in) { const GAS f32x4* xr = (const GAS f32x4*)(IN_[0] + (size_t)t * D) + F.lane;
#pragma unroll
            for (int j = 0; j < 4; ++j) v[j] = xr[64 * j]; }
        else { const GAS u32x2* xr = (const GAS u32x2*)(W.XB + (size_t)t * D) + F.lane;
#pragma unroll
            for (int j = 0; j < 4; ++j) { const u32x2 a = xr[64 * j]; v[j] = (f32x4){bflo(a.x), bfhi(a.x), bflo(a.y), bfhi(a.y)}; } }
        if (combine) {
            const float* g2 = W.mod + ((size_t)lp * NBMAX + b) * 6 * D + 5 * D;
            const int p0 = W.pos[t * 2], p1 = W.pos[t * 2 + 1];
            const GAS unsigned* y0 = (const GAS unsigned*)((const unsigned char*)W.YS + (size_t)p0 * D) + F.lane; const GAS unsigned* y1 = (const GAS unsigned*)((const unsigned char*)W.YS + (size_t)p1 * D) + F.lane;
#pragma unroll
            for (int j = 0; j < 4; ++j) { const unsigned a = y0[64 * j], c = y1[64 * j]; const f32x4 g = *((const GAS f32x4*)g2 + F.lane + 64 * j) * (1.f / YSCALE);
                v[j].x += g.x * (__builtin_amdgcn_cvt_f32_fp8((int)a, 0) + __builtin_amdgcn_cvt_f32_fp8((int)c, 0)); v[j].y += g.y * (__builtin_amdgcn_cvt_f32_fp8((int)a, 1) + __builtin_amdgcn_cvt_f32_fp8((int)c, 1));
                v[j].z += g.z * (__builtin_amdgcn_cvt_f32_fp8((int)a, 2) + __builtin_amdgcn_cvt_f32_fp8((int)c, 2)); v[j].w += g.w * (__builtin_amdgcn_cvt_f32_fp8((int)a, 3) + __builtin_amdgcn_cvt_f32_fp8((int)c, 3)); }
            if (mode == 2) { GAS f32x4* xo = (GAS f32x4*)(F.xbuf + (size_t)t * D) + F.lane;
#pragma unroll
                for (int j = 0; j < 4; ++j) xo[64 * j] = v[j]; }
            else { GAS u32x2* xo = (GAS u32x2*)(W.XB + (size_t)t * D) + F.lane;
#pragma unroll
                for (int j = 0; j < 4; ++j) { u32x2 o; o.x = cvt_pk(v[j].x, v[j].y); o.y = cvt_pk(v[j].z, v[j].w); xo[64 * j] = o; } }
        }
        if (mode == 2) continue;
        float ss = 0.f;
#pragma unroll
        for (int j = 0; j < 4; ++j) ss += (v[j].x * v[j].x + v[j].y * v[j].y) + (v[j].z * v[j].z + v[j].w * v[j].w);
        const float rstd = rsqrtf(wave_sum(ss) * (1.f / D) + RMS_EPS);
        const float* md = W.mod + ((size_t)l * NBMAX + b) * 6 * D + (mode == 1 ? 3 * D : 0);
        GAS u32x2* ho = (GAS u32x2*)(W.H + (size_t)t * D) + F.lane;
#pragma unroll
        for (int j = 0; j < 4; ++j) { const f32x4 g = *((const GAS f32x4*)ng + F.lane + 64 * j), sh = *((const GAS f32x4*)md + F.lane + 64 * j), sc = *((const GAS f32x4*)(md + D) + F.lane + 64 * j);
            const float h0 = v[j].x * rstd * g.x * (1.f + sc.x) + sh.x, h1 = v[j].y * rstd * g.y * (1.f + sc.y) + sh.y, h2 = v[j].z * rstd * g.z * (1.f + sc.z) + sh.z, h3 = v[j].w * rstd * g.w * (1.f + sc.w) + sh.w;
            u32x2 o; o.x = cvt_pk(h0, h1); o.y = cvt_pk(h2, h3); ho[64 * j] = o; }
    }
}
typedef pg8::Unit Unit;
__device__ __forceinline__ u32x4 pack8(const f32x4& a, const f32x4& b) { u32x4 w; w.x = cvt_pk(a[0], a[1]); w.y = cvt_pk(a[2], a[3]); w.z = cvt_pk(b[0], b[1]); w.w = cvt_pk(b[2], b[3]); return w; }

#ifndef MK_ATT_FP8
#define MK_ATT_FP8 1
#endif
__device__ __forceinline__ u32x2 pack8_fp8(const f32x4& a, const f32x4& b) { int w0 = 0, w1 = 0;
    w0 = __builtin_amdgcn_cvt_pk_fp8_f32(a[0], a[1], w0, false); w0 = __builtin_amdgcn_cvt_pk_fp8_f32(a[2], a[3], w0, true);
    w1 = __builtin_amdgcn_cvt_pk_fp8_f32(b[0], b[1], w1, false); w1 = __builtin_amdgcn_cvt_pk_fp8_f32(b[2], b[3], w1, true);
    u32x2 r; r.x = (unsigned)w0; r.y = (unsigned)w1; return r; }
struct EpiNull {
    static constexpr bool PERM = true, AFTER_DRAIN = false, MIDK = false;
    __device__ __forceinline__ void operator()(const f32x4 (&acc)[2][2][4][2], const Unit&, int, int, int, int) const {
#pragma unroll
        for (int a = 0; a < 2; ++a)
#pragma unroll
            for (int b = 0; b < 2; ++b)
#pragma unroll
                for (int m = 0; m < 4; ++m) { asm volatile("" :: "v"(acc[a][b][m][0]), "v"(acc[a][b][m][1])); } }
};
struct EpiIn {
    static constexpr bool PERM = true, AFTER_DRAIN = false, MIDK = false;
    bf16 *GQ, *GK, *GV, *SG, *LGF, *LGB, *DQ, *DK, *DV, *SGA, *SGB; const float* b_up; const float* qg; const float* kg;
    __device__ __forceinline__ void operator()(const f32x4 (&acc)[2][2][4][2], const Unit& u, int wr, int wc, int fr, int fq) const {
        const int pn = u.pn; const int row0 = u.pm * 256 + wr * 64 + fr;
        if (pn >= 8 && pn <= 11) {
            const bool isk = pn >= 10; const int head = 2 * ((pn - 8) & 1) + (wc >> 1), c = wc & 1;
            const float* gv = isk ? kg : qg; const float sc = isk ? 1.f : QSCALE;
            f32x4 g[2][2];
#pragma unroll
            for (int bj = 0; bj < 2; ++bj)
#pragma unroll
                for (int n = 0; n < 2; ++n) g[bj][n] = *(const f32x4*)(gv + 32 * bj + 8 * fq + 4 * n);
#pragma unroll
            for (int ai = 0; ai < 2; ++ai)
#pragma unroll
                for (int m = 0; m < 4; ++m) {
                    const int r = row0 + ai * 128 + m * 16, b = r / SEQ, s = r % SEQ;
                    float ss = 0.f;
#pragma unroll
                    for (int bj = 0; bj < 2; ++bj)
#pragma unroll
                        for (int n = 0; n < 2; ++n) { const f32x4 x = acc[ai][bj][m][n]; ss += (x[0] * x[0] + x[1] * x[1]) + (x[2] * x[2] + x[3] * x[3]); }
                    ss += __shfl_xor(ss, 16); ss += __shfl_xor(ss, 32);
                    const float rs = rsqrtf(ss * (1.f / 64.f) + RMS_EPS) * sc;
#if MK_ATT_FP8
                    unsigned char* dst8 = (unsigned char*)(isk ? DK : DQ) + ((((size_t)b * NH + head) * 2 + c) * SEQ + s) * 64;
#pragma unroll
                    for (int bj = 0; bj < 2; ++bj) {
                        const f32x4 v0 = acc[ai][bj][m][0] * rs * g[bj][0], v1 = acc[ai][bj][m][1] * rs * g[bj][1];
                        int chunk = 2 * bj + (fq >> 1); if (isk) chunk ^= ((s >> 2) & 3);
                        *(u32x2*)(dst8 + chunk * 16 + 8 * (fq & 1)) = pack8_fp8(v0, v1);
                    }
#else
                    bf16* dst = (isk ? DK : DQ) + ((((size_t)b * NH + head) * 2 + c) * SEQ + s) * 64;
#pragma unroll
                    for (int bj = 0; bj < 2; ++bj) {
                        const f32x4 v0 = acc[ai][bj][m][0] * rs * g[bj][0], v1 = acc[ai][bj][m][1] * rs * g[bj][1];
                        int chunk = 4 * bj + fq; if (isk) chunk ^= ((s >> 1) & 7);
                        *(u32x4*)(dst + chunk * 8) = pack8(v0, v1);
                    }
#endif
                }
            return;
        }
#pragma unroll
        for (int ai = 0; ai < 2; ++ai)
#pragma unroll
            for (int m = 0; m < 4; ++m) {
                const int r = row0 + ai * 128 + m * 16;
#pragma unroll
                for (int bj = 0; bj < 2; ++bj) {
                    const int c0 = 128 * bj + 32 * wc + 8 * fq;
                    f32x4 v0 = acc[ai][bj][m][0], v1 = acc[ai][bj][m][1];
                    if (pn == 0) { *(u32x4*)(GQ + (size_t)r * 256 + c0) = pack8(v0 * 0.125f, v1 * 0.125f); }
                    else if (pn == 1) { *(u32x4*)(GK + (size_t)r * 256 + c0) = pack8(v0, v1); }
                    else if (pn <= 3) { *(u32x4*)(GV + (size_t)r * 512 + (pn - 2) * 256 + c0) = pack8(v0, v1); }
                    else if (pn <= 5) {
#pragma unroll
                        for (int i = 0; i < 4; ++i) { v0[i] = fsilu(v0[i]); v1[i] = fsilu(v1[i]); }
                        *(u32x4*)(SG + (size_t)r * 512 + (pn - 4) * 256 + c0) = pack8(v0, v1); }
                    else if (pn <= 7) {
                        const float* bu = b_up + (pn - 6) * 256 + c0; const f32x4 b0 = *(const f32x4*)bu, b1 = *(const f32x4*)(bu + 4);
#pragma unroll
                        for (int i = 0; i < 4; ++i) { float z = v0[i] + b0[i]; v0[i] = (fminf(z, 0.f) - __logf(1.f + __expf(-fabsf(z)))) * (1.f / 16.f);
                                                      z = v1[i] + b1[i]; v1[i] = (fminf(z, 0.f) - __logf(1.f + __expf(-fabsf(z)))) * (1.f / 16.f); }
                        *(u32x4*)((pn == 6 ? LGF : LGB) + (size_t)r * 256 + c0) = pack8(v0, v1); }
#if MK_ATT_FP8
                    else if (pn <= 13) {
                        const int b = r / SEQ, s = r % SEQ, head = 2 * (pn - 12) + bj;
                        const int kk = s & 63, wkey = kk & 31, hh_ = (wkey >> 2) & 1, reg_ = (wkey & 3) + 4 * (wkey >> 3), pos = hh_ * 32 + 16 * (kk >> 5) + reg_;
                        unsigned char* tb = (unsigned char*)DV + (((size_t)b * NH + head) * (SEQ / 64) + (s >> 6)) * 8192;
                        const u32x2 pk = pack8_fp8(v0, v1); const int dv0 = 32 * wc + 8 * fq;
#pragma unroll
                        for (int i = 0; i < 8; ++i) { const int dv = dv0 + i; const unsigned byte = ((i < 4 ? pk.x : pk.y) >> (8 * (i & 3))) & 0xffu;
                            tb[dv * 64 + ((((pos >> 4) ^ ((dv >> 2) & 3)) << 4) | (pos & 15))] = (unsigned char)byte; } }
#else
                    else if (pn <= 13) {
                        const int b = r / SEQ, s = r % SEQ, head = 2 * (pn - 12) + bj;
                        bf16* dst = DV + ((((size_t)b * NH + head) * (SEQ / 8) + (s >> 3)) * 4 + wc) * 256 + (s & 7) * 32 + 8 * fq;
                        *(u32x4*)dst = pack8(v0, v1); }
#endif
                    else {
#pragma unroll
                        for (int i = 0; i < 4; ++i) { v0[i] = fsigmoid(v0[i]); v1[i] = fsigmoid(v1[i]); }
                        bf16* base = (pn <= 17) ? SGA + (pn - 14) * 256 : SGB + (pn - 18) * 256;
                        *(u32x4*)(base + (size_t)r * D + c0) = pack8(v0, v1); }
                }
            }
    }
};

struct EpiMerge {
    static constexpr bool PERM = true, AFTER_DRAIN = false, MIDK = false;
    const bf16* SGA; const bf16* SGB; bf16* O; int nM;
    __device__ __forceinline__ void operator()(const f32x4 (&acc)[2][2][4][2], const Unit& u, int wr, int wc, int fr, int fq) const {
        const int sel = u.pn >> 2; const int row0 = (u.pm - sel * nM) * 256 + wr * 64 + fr, col0 = (u.pn & 3) * 256 + wc * 32 + 8 * fq;
        const bf16* G = sel ? SGB : SGA;
#pragma unroll
        for (int ai = 0; ai < 2; ++ai)
#pragma unroll
            for (int m = 0; m < 4; ++m) { const size_t off = (size_t)(row0 + ai * 128 + m * 16) * D + col0;
#pragma unroll
                for (int bj = 0; bj < 2; ++bj) { const u32x4 b = *(const u32x4*)(G + off + bj * 128);
                    f32x4 v0 = acc[ai][bj][m][0], v1 = acc[ai][bj][m][1];
                    v0[0] *= bflo(b.x); v0[1] *= bfhi(b.x); v0[2] *= bflo(b.y); v0[3] *= bfhi(b.y); v1[0] *= bflo(b.z); v1[1] *= bfhi(b.z); v1[2] *= bflo(b.w); v1[3] *= bfhi(b.w);
                    if (sel) { const u32x4 t = *(const u32x4*)(O + off + bj * 128);
                        v0[0] += bflo(t.x); v0[1] += bfhi(t.x); v0[2] += bflo(t.y); v0[3] += bfhi(t.y); v1[0] += bflo(t.z); v1[1] += bfhi(t.z); v1[2] += bflo(t.w); v1[3] += bfhi(t.w); }
                    *(u32x4*)(O + off + bj * 128) = pack8(v0, v1); }
                asm volatile("" ::: "memory"); }
    }
};
struct MergeOrder {
    pg8::StaticOrder so; int nM;
    __device__ __forceinline__ bool next(int i, Unit& u) const { Unit t; if (!so.next(i >> 1, t)) return false; const int sel = i & 1; u.pm = t.pm + sel * nM; u.pn = t.pn + sel * 4; return true; }
    __device__ __forceinline__ void a_ready(const Unit&) const {}
    __device__ __forceinline__ void done(const Unit&) const {}
};

struct EpiResid {
    static constexpr bool PERM = true, AFTER_DRAIN = false, MIDK = false;
    const float* xin32; bf16* xb; const float* g1;
    __device__ __forceinline__ void operator()(const f32x4 (&acc)[2][2][4][2], const Unit& u, int wr, int wc, int fr, int fq) const {
        const int row0 = u.pm * 256 + wr * 64 + fr, col0 = u.pn * 256 + wc * 32 + 8 * fq;
        const int b = (u.pm * 256) / SEQ; const float* g = g1 + (size_t)b * 6 * D + col0;
        f32x4 gv[2][2];
#pragma unroll
        for (int bj = 0; bj < 2; ++bj)
#pragma unroll
            for (int n = 0; n < 2; ++n) gv[bj][n] = *(const f32x4*)(g + bj * 128 + n * 4);
#pragma unroll
        for (int ai = 0; ai < 2; ++ai)
#pragma unroll
            for (int m = 0; m < 4; ++m) { const size_t off = (size_t)(row0 + ai * 128 + m * 16) * D + col0;
#pragma unroll
                for (int bj = 0; bj < 2; ++bj) { f32x4 x0, x1;
                    if (xin32) { x0 = *(const f32x4*)(xin32 + off + bj * 128); x1 = *(const f32x4*)(xin32 + off + bj * 128 + 4); }
                    else { const u32x4 a = *(const u32x4*)(xb + off + bj * 128); x0 = (f32x4){bflo(a.x), bfhi(a.x), bflo(a.y), bfhi(a.y)}; x1 = (f32x4){bflo(a.z), bfhi(a.z), bflo(a.w), bfhi(a.w)}; }
                    *(u32x4*)(xb + off + bj * 128) = pack8(x0 + gv[bj][0] * acc[ai][bj][m][0], x1 + gv[bj][1] * acc[ai][bj][m][1]); }
                asm volatile("" ::: "memory"); }
    }
};

struct EpiLogits {
    static constexpr bool PERM = false, AFTER_DRAIN = false, MIDK = false;
    float* L;
    __device__ __forceinline__ void operator()(const f32x4 (&acc)[2][2][4][2], const Unit& u, int wr, int wc, int fr, int fq) const {
        if (wc >= 2) return;
        const int row0 = u.pm * 256 + wr * 64 + fr, col0 = wc * 32 + 4 * fq;
#pragma unroll
        for (int ai = 0; ai < 2; ++ai)
#pragma unroll
            for (int m = 0; m < 4; ++m)
#pragma unroll
                for (int n = 0; n < 2; ++n) *(f32x4*)(L + (size_t)(row0 + ai * 128 + m * 16) * 64 + col0 + n * 16) = acc[ai][0][m][n];
    }
};

#ifndef MK_MOE_FP8
#define MK_MOE_FP8 0
#endif
#if MK_MOE_FP8
struct EpiAct {
    static constexpr bool PERM = true, AFTER_DRAIN = false, MIDK = false;
    unsigned char* ACT;
    __device__ __forceinline__ void operator()(const f32x4 (&acc)[2][2][4][2], const Unit& u, int wr, int wc, int fr, int fq) const {
        const int row0 = u.pm * 256 + wr * 64 + fr, col0 = (u.pn & 3) * 128 + wc * 32 + 8 * fq;
        constexpr float inv = 1.f / WSCALE;
#pragma unroll
        for (int ai = 0; ai < 2; ++ai)
#pragma unroll
            for (int m = 0; m < 4; ++m) { f32x4 v0, v1;
#pragma unroll
                for (int i = 0; i < 4; ++i) { v0[i] = fsilu(acc[ai][0][m][0][i] * inv) * acc[ai][1][m][0][i] * (inv * ASCALE); v1[i] = fsilu(acc[ai][0][m][1][i] * inv) * acc[ai][1][m][1][i] * (inv * ASCALE); }
                *(u32x2*)(ACT + (size_t)(row0 + ai * 128 + m * 16) * DE + col0) = pack8_fp8(v0, v1); }
    }
};
struct EpiYs {
    static constexpr bool PERM = true, AFTER_DRAIN = false, MIDK = false;
    bf16* YS; const float* gs;
    __device__ __forceinline__ void operator()(const f32x4 (&acc)[2][2][4][2], const Unit& u, int wr, int wc, int fr, int fq) const {
        const int row0 = u.pm * 256 + wr * 64 + fr, col0 = (u.pn & 3) * 256 + wc * 32 + 8 * fq;
#pragma unroll
        for (int ai = 0; ai < 2; ++ai)
#pragma unroll
            for (int m = 0; m < 4; ++m) { const int r = row0 + ai * 128 + m * 16; const float gt = gs[r] * (1.f / (WSCALE * ASCALE));
#pragma unroll
                for (int bj = 0; bj < 2; ++bj) *(u32x4*)(YS + (size_t)r * D + col0 + bj * 128) = pack8(acc[ai][bj][m][0] * gt, acc[ai][bj][m][1] * gt); }
    }
};
#else
struct EpiAct {
    static constexpr bool PERM = true, AFTER_DRAIN = false, MIDK = false;
    bf16* ACT;
    __device__ __forceinline__ void operator()(const f32x4 (&acc)[2][2][4][2], const Unit& u, int wr, int wc, int fr, int fq) const {
        const int row0 = u.pm * 256 + wr * 64 + fr, col0 = (u.pn & 3) * 128 + wc * 32 + 8 * fq;
#pragma unroll
        for (int ai = 0; ai < 2; ++ai)
#pragma unroll
            for (int m = 0; m < 4; ++m) { f32x4 v0, v1;
#pragma unroll
                for (int i = 0; i < 4; ++i) { v0[i] = fsilu(acc[ai][0][m][0][i]) * acc[ai][1][m][0][i]; v1[i] = fsilu(acc[ai][0][m][1][i]) * acc[ai][1][m][1][i]; }
                *(u32x4*)(ACT + (size_t)(row0 + ai * 128 + m * 16) * DE + col0) = pack8(v0, v1); }
    }
};
struct EpiYs {
    static constexpr bool PERM = true, AFTER_DRAIN = false, MIDK = false;
    unsigned char* YS; const float* gs;
    __device__ __forceinline__ void operator()(const f32x4 (&acc)[2][2][4][2], const Unit& u, int wr, int wc, int fr, int fq) const {
        const int row0 = u.pm * 256 + wr * 64 + fr, col0 = (u.pn & 3) * 256 + wc * 32 + 8 * fq;
#pragma unroll
        for (int ai = 0; ai < 2; ++ai)
#pragma unroll
            for (int m = 0; m < 4; ++m) { const int r = row0 + ai * 128 + m * 16; const float gt = gs[r] * YSCALE;
#pragma unroll
                for (int bj = 0; bj < 2; ++bj) *(u32x2*)(YS + (size_t)r * D + col0 + bj * 128) = pack8_fp8(acc[ai][bj][m][0] * gt, acc[ai][bj][m][1] * gt); }
    }
};
#endif
struct GroupedOrder {
    const int* tilee; int U, G, c; const int* rowidx;
    __device__ __forceinline__ bool next(int i, Unit& u) const {
        int id;
        if ((G & 7) == 0) { const int gx = G >> 3, per = (U + 7) >> 3, n = i * gx + (c >> 3); if (n >= per) return false; id = (c & 7) * per + n; if (id >= U) return false; }
        else { id = i * G + c; if (id >= U) return false; }
        const int t = id >> 2; u.pm = t; u.pn = tilee[t] * 4 + (id & 3); return true;
    }
    __device__ __forceinline__ void a_ready(const Unit&) const {}
    __device__ __forceinline__ void done(const Unit&) const {}
};
constexpr int AT_KR = 0, AT_VR = 32768, AT_TAB = 65536, AT_SLOT = 8192;
typedef int v8i __attribute__((ext_vector_type(8)));
typedef int v4i __attribute__((ext_vector_type(4)));
__device__ __forceinline__ int crow(int r, int hi) { return (r & 3) + 8 * (r >> 2) + 4 * hi; }

__device__ __forceinline__ void attn_bias(f32x16& s0, f32x16& s1, int relbase, const LAS float* tabh) {
#pragma unroll
    for (int r = 0; r < 16; ++r) {
        int i0 = relbase + (r & 3) + 8 * (r >> 2); int i1 = i0 + 32;
        i0 = i0 < 0 ? 0 : (i0 > 255 ? 255 : i0); i1 = i1 < 0 ? 0 : (i1 > 255 ? 255 : i1);
        s0[r] += tabh[i0]; s1[r] += tabh[i1];
    }
}
template <int J>
__device__ __forceinline__ void attn_exp_chunk(f32x16& s0, f32x16& s1, float& lsum) {
    float ls = 0.f;
#pragma unroll
    for (int r = 4 * J; r < 4 * J + 4; ++r) { s0[r] = __builtin_amdgcn_exp2f(s0[r]); s1[r] = __builtin_amdgcn_exp2f(s1[r]); }
    (void)ls; (void)lsum;
}
__device__ __forceinline__ int pk4_bf8(float a, float b, float c, float d) { int w = 0; w = __builtin_amdgcn_cvt_pk_bf8_f32(a, b, w, false); w = __builtin_amdgcn_cvt_pk_bf8_f32(c, d, w, true); return w; }
__device__ __forceinline__ void glds16(const void* gsrc, unsigned lds_dst) { unsigned keep;
    asm volatile("s_mov_b32 %0, m0\n\ts_mov_b32 m0, %2\n\ts_nop 0\n\tglobal_load_lds_dwordx4 %1, off\n\ts_mov_b32 m0, %0" : "=&s"(keep) : "v"(gsrc), "s"(lds_dst) : "memory"); }
__device__ __forceinline__ void attn_dma_k(unsigned lds0, const unsigned char* kg0, int t, int slot, int wid, int lane) {
    glds16(kg0 + (size_t)(wid >> 2) * SEQ * 64 + (size_t)t * 4096 + (wid & 3) * 1024 + lane * 16, (unsigned)__builtin_amdgcn_readfirstlane((int)(lds0 + AT_KR + slot * AT_SLOT + wid * 1024)));
}
__device__ __forceinline__ void attn_dma_v(unsigned lds0, const unsigned char* vg0, int t, int slot, int wid, int lane) {
    glds16(vg0 + (size_t)t * 8192 + wid * 1024 + lane * 16, (unsigned)__builtin_amdgcn_readfirstlane((int)(lds0 + AT_VR + slot * AT_SLOT + wid * 1024)));
}
#define AT_RD128(dst, addr, off) asm volatile("ds_read_b128 %0, %1 offset:%c2" : "=&v"(dst) : "v"(addr), "i"(off) : "memory")
#define AT_MFMA8(a, b, c) __builtin_amdgcn_mfma_scale_f32_32x32x64_f8f6f4(a, b, c, 0, 0, 0, 0, 0, 0)
#define AT_MFMA8B(a, b, c) __builtin_amdgcn_mfma_scale_f32_32x32x64_f8f6f4(a, b, c, 0, 1, 0, 0, 0, 0)

template <int VAR>
__device__ __forceinline__ void phase_attn(Frame& F, int l) {
    refresh(F);
    const WS W = ws_map(F.ws, F.nb); const float* const* IN_ = F.a->in; (void)IN_; (void)W;
    const int lane = F.lane, wid = F.wave, r32 = lane & 31, hh = lane >> 5, qg = wid & 3, c = wid >> 2;
    LAS unsigned char* lds = F.lds; const unsigned lds0 = (unsigned)(unsigned long)lds;
    LAS float* tab = (LAS float*)(lds + AT_TAB);
    for (int i = F.tid; i < 1028; i += NTHR) tab[i] = W.tab[i];
    const float lam = W.tab[1032 + l]; const float lam_init = 0.8f - 0.6f * __expf(-0.3f * (float)l);
    const float* subg = IN_[13] + l * 128;
    const int U = F.nb * NH * 64;
    const int gx = F.G >> 3, per = U >> 3;
    const int sw = (r32 >> 2) & 3;
    const unsigned ka0 = lds0 + AT_KR + c * 4096 + r32 * 64 + (((2 * hh) ^ sw) << 4), ka1 = lds0 + AT_KR + c * 4096 + r32 * 64 + (((2 * hh + 1) ^ sw) << 4);
    const unsigned va0 = lds0 + AT_VR + r32 * 64 + (((2 * hh) ^ sw) << 4), va1 = lds0 + AT_VR + r32 * 64 + (((2 * hh + 1) ^ sw) << 4);
#ifndef MK_ATT_1BAR
#define MK_ATT_1BAR 1
#endif
    const bool lag = (MK_ATT_1BAR == 0) && wid >= 4;
    __syncthreads();
    for (int i = 0;; ++i) {
        int id;
        if ((F.G & 7) == 0) { const int n = i * gx + (F.bid >> 3); if (n >= per) break; id = (F.bid & 7) * per + n; }
        else { id = i * F.G + F.bid; if (id >= U) break; }
        const int bh = id >> 6, qb = id & 63, b = bh >> 2, h = bh & 3;
        const int qw0 = qb * 128 + 32 * qg;
        const unsigned char* kg0 = (const unsigned char*)W.DK + ((size_t)bh * 2) * SEQ * 64;
        const unsigned char* vg0 = (const unsigned char*)W.DV + (size_t)bh * SEQ * 128;
        v8i qf; { const unsigned char* qp = (const unsigned char*)W.DQ + (((size_t)bh * 2 + c) * SEQ + qw0 + r32) * 64 + 32 * hh;
            const v4i q0 = *(const v4i*)qp, q1 = *(const v4i*)(qp + 16); qf = (v8i){q0[0], q0[1], q0[2], q0[3], q1[0], q1[1], q1[2], q1[3]}; }
        asm volatile("s_waitcnt vmcnt(0)" ::: "memory");
        attn_dma_k(lds0, kg0, 0, 0, wid, lane); attn_dma_k(lds0, kg0, 1, 1, wid, lane); attn_dma_v(lds0, vg0, 0, 0, wid, lane); attn_dma_k(lds0, kg0, 2, 2, wid, lane);
        attn_dma_v(lds0, vg0, 1, 1, wid, lane); attn_dma_k(lds0, kg0, 3, 3, wid, lane); attn_dma_v(lds0, vg0, 2, 2, wid, lane);
        f32x16 o[4]; f32x16 osum = f32x16{};
#pragma unroll
        for (int dt = 0; dt < 4; ++dt) o[dt] = f32x16{};
        float lsum = 0.f;
        const v8i ones8 = {0x38383838, 0x38383838, 0x38383838, 0x38383838, 0x38383838, 0x38383838, 0x38383838, 0x38383838};
        const int tL = (qw0 >= 154) ? ((qw0 - 154) >> 6) + 1 : 0, tR = (qw0 + 185) >> 6;
        const float shl = tab[1024 + h];
        const LAS float* tabh = tab + h * 256;
        const int rel0 = -qw0 - r32 + 4 * hh + 128;
        const f32x16 cshift = {-2.f, -2.f, -2.f, -2.f, -2.f, -2.f, -2.f, -2.f, -2.f, -2.f, -2.f, -2.f, -2.f, -2.f, -2.f, -2.f};
        asm volatile("s_waitcnt vmcnt(4)" ::: "memory"); __builtin_amdgcn_s_barrier(); asm volatile("" ::: "memory");
        f32x16 sc0, sc1, sn0, sn1; v8i p; v4i kx[4];
        AT_RD128(kx[0], ka0, 0); AT_RD128(kx[1], ka1, 0); AT_RD128(kx[2], ka0, 2048); AT_RD128(kx[3], ka1, 2048);
        asm volatile("s_waitcnt lgkmcnt(0)" ::: "memory"); __builtin_amdgcn_sched_barrier(0);
        sc0 = AT_MFMA8(((v8i){kx[0][0], kx[0][1], kx[0][2], kx[0][3], kx[1][0], kx[1][1], kx[1][2], kx[1][3]}), qf, cshift);
        sc1 = AT_MFMA8(((v8i){kx[2][0], kx[2][1], kx[2][2], kx[2][3], kx[3][0], kx[3][1], kx[3][2], kx[3][3]}), qf, cshift);
        __builtin_amdgcn_s_barrier(); asm volatile("" ::: "memory");
        if (lag) { __builtin_amdgcn_s_barrier(); asm volatile("" ::: "memory"); }
#define AT_STEP(SL, t) do { \
            { const int tk = (t) + 4 < 128 ? (t) + 4 : 127; attn_dma_k(lds0, kg0, tk, SL, wid, lane); } \
            asm volatile("s_waitcnt vmcnt(4)" ::: "memory");                                                       \
            AT_RD128(kx[0], ka0, ((SL + 1) & 3) * AT_SLOT); AT_RD128(kx[1], ka1, ((SL + 1) & 3) * AT_SLOT);        \
            AT_RD128(kx[2], ka0, ((SL + 1) & 3) * AT_SLOT + 2048); AT_RD128(kx[3], ka1, ((SL + 1) & 3) * AT_SLOT + 2048); \
            if ((t) >= tL && (t) < tR) attn_bias(sc0, sc1, 64 * (t) + rel0, tabh);                                \
            attn_exp_chunk<0>(sc0, sc1, lsum); attn_exp_chunk<1>(sc0, sc1, lsum);                                 \
            asm volatile("s_waitcnt lgkmcnt(0)" ::: "memory"); __builtin_amdgcn_sched_barrier(0); \
            sn0 = AT_MFMA8(((v8i){kx[0][0], kx[0][1], kx[0][2], kx[0][3], kx[1][0], kx[1][1], kx[1][2], kx[1][3]}), qf, cshift); \
            __builtin_amdgcn_sched_barrier(0); \
            attn_exp_chunk<2>(sc0, sc1, lsum); \
            __builtin_amdgcn_sched_barrier(0); \
            sn1 = AT_MFMA8(((v8i){kx[2][0], kx[2][1], kx[2][2], kx[2][3], kx[3][0], kx[3][1], kx[3][2], kx[3][3]}), qf, cshift); \
            __builtin_amdgcn_sched_barrier(0); \
            attn_exp_chunk<3>(sc0, sc1, lsum); \
            p[0] = pk4_bf8(sc0[0], sc0[1], sc0[2], sc0[3]); p[1] = pk4_bf8(sc0[4], sc0[5], sc0[6], sc0[7]); p[2] = pk4_bf8(sc0[8], sc0[9], sc0[10], sc0[11]); p[3] = pk4_bf8(sc0[12], sc0[13], sc0[14], sc0[15]); \
            p[4] = pk4_bf8(sc1[0], sc1[1], sc1[2], sc1[3]); p[5] = pk4_bf8(sc1[4], sc1[5], sc1[6], sc1[7]); p[6] = pk4_bf8(sc1[8], sc1[9], sc1[10], sc1[11]); p[7] = pk4_bf8(sc1[12], sc1[13], sc1[14], sc1[15]); \
            if (!MK_ATT_1BAR) { __builtin_amdgcn_s_barrier(); asm volatile("" ::: "memory"); } \
            { const int tv = (t) + 3 < 128 ? (t) + 3 : 127; attn_dma_v(lds0, vg0, tv, (SL + 3) & 3, wid, lane); } \
            asm volatile("s_waitcnt vmcnt(4)" ::: "memory");                                                       \
            { v4i vx[8]; \
              AT_RD128(vx[0], va0, SL * AT_SLOT); AT_RD128(vx[1], va1, SL * AT_SLOT); AT_RD128(vx[2], va0, SL * AT_SLOT + 2048); AT_RD128(vx[3], va1, SL * AT_SLOT + 2048); \
              AT_RD128(vx[4], va0, SL * AT_SLOT + 4096); AT_RD128(vx[5], va1, SL * AT_SLOT + 4096); AT_RD128(vx[6], va0, SL * AT_SLOT + 6144); AT_RD128(vx[7], va1, SL * AT_SLOT + 6144); \
              if ((t) == tL) { _Pragma("unroll") for (int dt = 0; dt < 4; ++dt) o[dt] *= shl; osum *= shl; } \
              osum = AT_MFMA8B(ones8, p, osum); \
              asm volatile("s_waitcnt lgkmcnt(4)" ::: "memory"); __builtin_amdgcn_sched_barrier(0); \
              o[0] = AT_MFMA8B(((v8i){vx[0][0], vx[0][1], vx[0][2], vx[0][3], vx[1][0], vx[1][1], vx[1][2], vx[1][3]}), p, o[0]); \
              o[1] = AT_MFMA8B(((v8i){vx[2][0], vx[2][1], vx[2][2], vx[2][3], vx[3][0], vx[3][1], vx[3][2], vx[3][3]}), p, o[1]); \
              asm volatile("s_waitcnt lgkmcnt(0)" ::: "memory"); __builtin_amdgcn_sched_barrier(0); \
              o[2] = AT_MFMA8B(((v8i){vx[4][0], vx[4][1], vx[4][2], vx[4][3], vx[5][0], vx[5][1], vx[5][2], vx[5][3]}), p, o[2]); \
              o[3] = AT_MFMA8B(((v8i){vx[6][0], vx[6][1], vx[6][2], vx[6][3], vx[7][0], vx[7][1], vx[7][2], vx[7][3]}), p, o[3]); } \
            sc0 = sn0; sc1 = sn1; \
            __builtin_amdgcn_s_barrier(); asm volatile("" ::: "memory"); } while (0)
        for (int t0 = 0; t0 < 128; t0 += 4) { AT_STEP(0, t0); AT_STEP(1, t0 + 1); AT_STEP(2, t0 + 2); AT_STEP(3, t0 + 3); }
#undef AT_STEP
        if (!lag && !MK_ATT_1BAR) { __builtin_amdgcn_s_barrier(); asm volatile("" ::: "memory"); }
        asm volatile("s_waitcnt vmcnt(0)" ::: "memory"); __builtin_amdgcn_s_barrier(); asm volatile("" ::: "memory");
        const float lt = osum[0];
        LAS float* xch = (LAS float*)(lds + qg * 16384);
        if (c == 1) { const float f = lam / lt;
#pragma unroll
            for (int dt = 0; dt < 4; ++dt)
#pragma unroll
                for (int r = 0; r < 16; ++r) xch[(dt * 16 + r) * 64 + lane] = o[dt][r] * f; }
        LDS_WAIT(); __builtin_amdgcn_s_barrier(); asm volatile("" ::: "memory");
        if (c == 0) { const float f = 1.f / lt; float ss = 0.f;
#pragma unroll
            for (int dt = 0; dt < 4; ++dt)
#pragma unroll
                for (int r = 0; r < 16; ++r) { const float v = o[dt][r] * f - xch[(dt * 16 + r) * 64 + lane]; o[dt][r] = v; ss += v * v; }
            ss += __shfl_xor(ss, 32);
            const float rn = rsqrtf(ss * (1.f / 128.f) + RMS_EPS) * (1.f - lam_init);
            bf16* orow = W.OAB + (size_t)F.T * 512 + ((size_t)b * SEQ + qw0 + r32) * 512 + h * 128;
#pragma unroll
            for (int dt = 0; dt < 4; ++dt)
#pragma unroll
                for (int g = 0; g < 4; ++g) { const int dv = 32 * dt + 8 * g + 4 * hh; const f32x4 sg = *(const f32x4*)(subg + dv);
                    u32x2 ov; ov.x = cvt_pk(o[dt][4 * g] * rn * sg[0], o[dt][4 * g + 1] * rn * sg[1]); ov.y = cvt_pk(o[dt][4 * g + 2] * rn * sg[2], o[dt][4 * g + 3] * rn * sg[3]);
                    *(u32x2*)(orow + dv) = ov; }
        }
        LDS_WAIT(); __builtin_amdgcn_s_barrier(); asm volatile("" ::: "memory");
    }
}
constexpr int GL_CUM = 0;
constexpr int GL_S64 = 144, GL_S192 = 400;
constexpr int G1_KEF = 34816, G1_KEB = G1_KEF + 64 * GL_S64, G1_VT = G1_KEB + 64 * GL_S64;
constexpr int G3_AOP = 34816, G3_KIF = G3_AOP + 64 * GL_S192, G3_KIB = G3_KIF + 64 * GL_S64, G3_BOP = G3_KIB + 64 * GL_S64;
static_assert(G3_BOP + 128 * GL_S192 <= 150 * 1024, "GLA LDS");

__device__ __forceinline__ bf16x8 lds_frag(const LAS unsigned char* base, int row, int stride, int kbyte) { return *(const LAS bf16x8*)(base + row * stride + kbyte); }

__device__ __forceinline__ void gla_cum(Frame& F, size_t trow0, int h) {
    const WS W = ws_map(F.ws, F.nb); const float* const* IN_ = F.a->in; (void)IN_; (void)W;
    LAS float* cum = (LAS float*)(F.lds + GL_CUM);
#pragma unroll
    for (int it = 0; it < 4; ++it) { const int idx = F.tid + it * NTHR; const int dir = idx >> 10, t = (idx >> 4) & 63, d4 = (idx & 15) * 4;
        const u32x2 a = *(const u32x2*)((dir ? W.LGB : W.LGF) + (trow0 + t) * 256 + h * 64 + d4);
        *(LAS f32x4*)(cum + (dir * 64 + t) * 64 + d4) = (f32x4){bflo(a.x), bfhi(a.x), bflo(a.y), bfhi(a.y)}; }
    __syncthreads();
    {
        const int dir = F.tid >> 8, seg = (F.tid >> 6) & 3, d = F.tid & 63; LAS float* cc = cum + dir * 4096 + d; LAS float* tot = cum + 8192 + (dir * 4 + seg) * 64 + d;
        float v[16]; float run = 0.f;
        if (dir == 0) {
#pragma unroll
            for (int i = 0; i < 16; ++i) { run += cc[(16 * seg + i) * 64]; v[i] = run; }
        } else {
#pragma unroll
            for (int i = 15; i >= 0; --i) { run += cc[(16 * seg + i) * 64]; v[i] = run; }
        }
        *tot = run;
        __syncthreads();
        float off = 0.f; const LAS float* tb = cum + 8192 + dir * 256 + d;
        if (dir == 0) { if (seg > 0) off += tb[0]; if (seg > 1) off += tb[64]; if (seg > 2) off += tb[128]; }
        else { if (seg < 3) off += tb[192]; if (seg < 2) off += tb[128]; if (seg < 1) off += tb[64]; }
#pragma unroll
        for (int i = 0; i < 16; ++i) cc[(16 * seg + i) * 64] = v[i] + off;
    }
    __syncthreads();
}

__device__ __forceinline__ void phase_gla1(Frame& F) {
    refresh(F);
    const WS W = ws_map(F.ws, F.nb); const float* const* IN_ = F.a->in; (void)IN_; (void)W;
    LAS unsigned char* lds = F.lds; LAS float* cum = (LAS float*)(lds + GL_CUM);
    const int lane = F.lane, wid = F.wave, r32 = lane & 31, hh = lane >> 5;
    const int U = F.nb * NH * 128;
    for (int u = F.bid; u < U; u += F.G) {
        const int n = u & 127, bh = u >> 7, b = bh >> 2, h = bh & 3; const size_t trow0 = (size_t)b * SEQ + n * 64;
        gla_cum(F, trow0, h);
        {
            const int t = F.tid >> 3, d0 = (F.tid & 7) * 8;
            const u32x4 kv = *(const u32x4*)(W.GK + (trow0 + t) * 256 + h * 64 + d0);
            const unsigned kw[4] = {kv.x, kv.y, kv.z, kv.w};
#pragma unroll
            for (int j = 0; j < 8; ++j) { const int d = d0 + j; const float k = (j & 1) ? bfhi(kw[j >> 1]) : bflo(kw[j >> 1]);
                const float ef = __expf(cum[63 * 64 + d] - cum[t * 64 + d]), eb = __expf(cum[4096 + d] - cum[4096 + t * 64 + d]);
                *(LAS bf16*)(lds + G1_KEF + d * GL_S64 + t * 2) = (bf16)(cvt_pk(k * ef, 0.f) & 0xffffu);
                *(LAS bf16*)(lds + G1_KEB + d * GL_S64 + t * 2) = (bf16)(cvt_pk(k * eb, 0.f) & 0xffffu); }
            const int v0 = (F.tid & 7) * 16;
            const u32x4 va = *(const u32x4*)(W.GV + (trow0 + t) * 512 + h * 128 + v0), vb = *(const u32x4*)(W.GV + (trow0 + t) * 512 + h * 128 + v0 + 8);
            const unsigned vw[8] = {va.x, va.y, va.z, va.w, vb.x, vb.y, vb.z, vb.w};
#pragma unroll
            for (int j = 0; j < 16; ++j) *(LAS bf16*)(lds + G1_VT + (v0 + j) * GL_S64 + t * 2) = (bf16)((j & 1) ? (vw[j >> 1] >> 16) : (vw[j >> 1] & 0xffffu));
            if (F.tid < 128) { const int dir = F.tid >> 6, d = F.tid & 63; W.DEC[((size_t)u * 2 + dir) * 64 + d] = __expf(dir ? cum[4096 + d] : cum[63 * 64 + d]); }
        }
        __syncthreads();
        {
            const int dt = wid & 3, dd = wid >> 2;
            f32x16 cf = {}, cb = {};
#pragma unroll
            for (int s = 0; s < 4; ++s) { const int kb = (16 * s + 8 * hh) * 2;
                const bf16x8 a = lds_frag(lds + G1_VT, 32 * dt + r32, GL_S64, kb);
                cf = __builtin_amdgcn_mfma_f32_32x32x16_bf16(a, lds_frag(lds + G1_KEF, 32 * dd + r32, GL_S64, kb), cf, 0, 0, 0);
                cb = __builtin_amdgcn_mfma_f32_32x32x16_bf16(a, lds_frag(lds + G1_KEB, 32 * dd + r32, GL_S64, kb), cb, 0, 0, 0); }
            bf16* of = (bf16*)W.KVT + ((size_t)u * 2) * 8192; bf16* ob = of + 8192;
#pragma unroll
            for (int r = 0; r < 16; ++r) { const int dv = 32 * dt + crow(r, hh), d = 32 * dd + r32;
                const float pf = __shfl_xor(cf[r], 1), pb = __shfl_xor(cb[r], 1);
                if (!(lane & 1)) { *(unsigned*)(of + dv * 64 + d) = cvt_pk(cf[r], pf); *(unsigned*)(ob + dv * 64 + d) = cvt_pk(cb[r], pb); } }
        }
        __syncthreads();
    }
}

__device__ __forceinline__ void phase_gla2(Frame& F) {
    refresh(F);
    const WS W = ws_map(F.ws, F.nb); const float* const* IN_ = F.a->in; (void)IN_; (void)W;
    const size_t total = (size_t)F.nb * NH * 2 * 4096;
    for (size_t wk = (size_t)F.bid * NTHR + F.tid; wk < total; wk += (size_t)F.G * NTHR) {
        const int e2 = (int)(wk & 4095), dir = (int)((wk >> 12) & 1), bh = (int)(wk >> 13), d = (e2 * 2) & 63;
        unsigned* base = (unsigned*)((bf16*)W.KVT + ((size_t)bh * 128 * 2 + dir) * 8192) + e2; const float* dec = W.DEC + ((size_t)bh * 128 * 2 + dir) * 64 + d;
        float S0 = 0.f, S1 = 0.f;
        for (int n0 = 0; n0 < 128; n0 += 8) {
            unsigned kv[8]; float dc0[8], dc1[8];
#pragma unroll
            for (int j = 0; j < 8; ++j) { const int n = dir ? 127 - (n0 + j) : n0 + j; kv[j] = base[(size_t)n * 8192]; dc0[j] = dec[(size_t)n * 128]; dc1[j] = dec[(size_t)n * 128 + 1]; }
#pragma unroll
            for (int j = 0; j < 8; ++j) { const int n = dir ? 127 - (n0 + j) : n0 + j; base[(size_t)n * 8192] = cvt_pk(S0, S1); S0 = dc0[j] * S0 + bflo(kv[j]); S1 = dc1[j] * S1 + bfhi(kv[j]); }
        }
    }
}

__device__ __forceinline__ void phase_gla3(Frame& F, int l) {
    refresh(F);
    const WS W = ws_map(F.ws, F.nb); const float* const* IN_ = F.a->in; (void)IN_; (void)W;
    LAS unsigned char* lds = F.lds; LAS float* cum = (LAS float*)(lds + GL_CUM);
    const int lane = F.lane, wid = F.wave, r32 = lane & 31, hh = lane >> 5;
    const float* gng = IN_[9] + l * 128;
    const int U = F.nb * NH * 128;
    for (int u = F.bid; u < U; u += F.G) {
        const int n = u & 127, bh = u >> 7, b = bh >> 2, h = bh & 3; const size_t trow0 = (size_t)b * SEQ + n * 64;
        gla_cum(F, trow0, h);
        {
            const int t = F.tid >> 3, d0 = (F.tid & 7) * 8;
            const u32x4 qv = *(const u32x4*)(W.GQ + (trow0 + t) * 256 + h * 64 + d0), kv = *(const u32x4*)(W.GK + (trow0 + t) * 256 + h * 64 + d0);
            const unsigned qw[4] = {qv.x, qv.y, qv.z, qv.w}, kw[4] = {kv.x, kv.y, kv.z, kv.w};
            float qf[8], qb[8], kf[8], kb[8];
#pragma unroll
            for (int j = 0; j < 8; ++j) { const int d = d0 + j; const float q = (j & 1) ? bfhi(qw[j >> 1]) : bflo(qw[j >> 1]), k = (j & 1) ? bfhi(kw[j >> 1]) : bflo(kw[j >> 1]);
                const float cf = cum[t * 64 + d], cb = cum[4096 + t * 64 + d];
                qf[j] = q * __expf(cf); qb[j] = q * __expf(cb); kf[j] = k * __expf(-cf); kb[j] = k * __expf(-cb); }
            u32x4 o;
            o.x = cvt_pk(qf[0], qf[1]); o.y = cvt_pk(qf[2], qf[3]); o.z = cvt_pk(qf[4], qf[5]); o.w = cvt_pk(qf[6], qf[7]); *(LAS u32x4*)(lds + G3_AOP + t * GL_S192 + (64 + d0) * 2) = o;
            o.x = cvt_pk(qb[0], qb[1]); o.y = cvt_pk(qb[2], qb[3]); o.z = cvt_pk(qb[4], qb[5]); o.w = cvt_pk(qb[6], qb[7]); *(LAS u32x4*)(lds + G3_AOP + t * GL_S192 + (128 + d0) * 2) = o;
            o.x = cvt_pk(kf[0], kf[1]); o.y = cvt_pk(kf[2], kf[3]); o.z = cvt_pk(kf[4], kf[5]); o.w = cvt_pk(kf[6], kf[7]); *(LAS u32x4*)(lds + G3_KIF + t * GL_S64 + d0 * 2) = o;
            o.x = cvt_pk(kb[0], kb[1]); o.y = cvt_pk(kb[2], kb[3]); o.z = cvt_pk(kb[4], kb[5]); o.w = cvt_pk(kb[6], kb[7]); *(LAS u32x4*)(lds + G3_KIB + t * GL_S64 + d0 * 2) = o;
            const int v0 = (F.tid & 7) * 16;
            const u32x4 va = *(const u32x4*)(W.GV + (trow0 + t) * 512 + h * 128 + v0), vb = *(const u32x4*)(W.GV + (trow0 + t) * 512 + h * 128 + v0 + 8);
            const unsigned vw[8] = {va.x, va.y, va.z, va.w, vb.x, vb.y, vb.z, vb.w};
#pragma unroll
            for (int j = 0; j < 16; ++j) *(LAS bf16*)(lds + G3_BOP + (v0 + j) * GL_S192 + t * 2) = (bf16)((j & 1) ? (vw[j >> 1] >> 16) : (vw[j >> 1] & 0xffffu));
            const int dv = F.tid >> 2, dd0 = (F.tid & 3) * 16;
#pragma unroll
            for (int dir = 0; dir < 2; ++dir) { const bf16* sp = (const bf16*)W.KVT + ((size_t)u * 2 + dir) * 8192 + dv * 64 + dd0;
                const u32x4 o0 = *(const u32x4*)sp, o1 = *(const u32x4*)(sp + 8);
                *(LAS u32x4*)(lds + G3_BOP + dv * GL_S192 + (64 + 64 * dir + dd0) * 2) = o0; *(LAS u32x4*)(lds + G3_BOP + dv * GL_S192 + (64 + 64 * dir + dd0 + 8) * 2) = o1; }
        }
        __syncthreads();
        if (wid < 4) {
            const int it = wid >> 1, jt = wid & 1;
            f32x16 af = {}, ab = {};
#pragma unroll
            for (int s = 0; s < 4; ++s) { const int kb = (16 * s + 8 * hh) * 2;
                if (jt <= it) af = __builtin_amdgcn_mfma_f32_32x32x16_bf16(lds_frag(lds + G3_AOP, 32 * it + r32, GL_S192, 128 + kb), lds_frag(lds + G3_KIF, 32 * jt + r32, GL_S64, kb), af, 0, 0, 0);
                if (jt >= it) ab = __builtin_amdgcn_mfma_f32_32x32x16_bf16(lds_frag(lds + G3_AOP, 32 * it + r32, GL_S192, 256 + kb), lds_frag(lds + G3_KIB, 32 * jt + r32, GL_S64, kb), ab, 0, 0, 0); }
#pragma unroll
            for (int r = 0; r < 16; ++r) { const int i = 32 * it + crow(r, hh), j = 32 * jt + r32; const float v = (j <= i) ? af[r] : ab[r];
                *(LAS bf16*)(lds + G3_AOP + i * GL_S192 + j * 2) = (bf16)(cvt_pk(v, 0.f) & 0xffffu); }
        }
        __syncthreads();
        {
            const int it = wid >> 2, dt = wid & 3; f32x16 o = {};
#pragma unroll
            for (int s = 0; s < 12; ++s) { const int kb = (16 * s + 8 * hh) * 2;
                o = __builtin_amdgcn_mfma_f32_32x32x16_bf16(lds_frag(lds + G3_AOP, 32 * it + r32, GL_S192, kb), lds_frag(lds + G3_BOP, 32 * dt + r32, GL_S192, kb), o, 0, 0, 0); }
            LAS float* out = (LAS float*)(lds + GL_CUM);
#pragma unroll
            for (int r = 0; r < 16; ++r) out[(32 * it + crow(r, hh)) * 128 + 32 * dt + r32] = o[r];
        }
        __syncthreads();
        {
            const int t = F.tid >> 3, v0 = (F.tid & 7) * 16; const LAS float* orow = (const LAS float*)(lds + GL_CUM) + t * 128 + v0;
            float x[16]; float ss = 0.f;
#pragma unroll
            for (int j = 0; j < 16; ++j) { x[j] = orow[j]; ss += x[j] * x[j]; }
            ss += __shfl_xor(ss, 1); ss += __shfl_xor(ss, 2); ss += __shfl_xor(ss, 4);
            const float rs = rsqrtf(ss * (1.f / 128.f) + RMS_EPS);
            const u32x4 ga = *(const u32x4*)(W.SG + (trow0 + t) * 512 + h * 128 + v0), gb = *(const u32x4*)(W.SG + (trow0 + t) * 512 + h * 128 + v0 + 8);
            const unsigned gw[8] = {ga.x, ga.y, ga.z, ga.w, gb.x, gb.y, gb.z, gb.w};
            float y[16];
#pragma unroll
            for (int j = 0; j < 16; ++j) y[j] = x[j] * rs * gng[v0 + j] * ((j & 1) ? bfhi(gw[j >> 1]) : bflo(gw[j >> 1]));
            u32x4 o0, o1; o0.x = cvt_pk(y[0], y[1]); o0.y = cvt_pk(y[2], y[3]); o0.z = cvt_pk(y[4], y[5]); o0.w = cvt_pk(y[6], y[7]);
            o1.x = cvt_pk(y[8], y[9]); o1.y = cvt_pk(y[10], y[11]); o1.z = cvt_pk(y[12], y[13]); o1.w = cvt_pk(y[14], y[15]);
            bf16* dst = W.OAB + (trow0 + t) * 512 + h * 128 + v0; *(u32x4*)dst = o0; *(u32x4*)(dst + 8) = o1;
        }
        __syncthreads();
    }
}
__device__ __forceinline__ void phase_select(Frame& F, int l) {
    refresh(F);
    const WS W = ws_map(F.ws, F.nb); const float* const* IN_ = F.a->in; (void)IN_; (void)W;
    LAS int* lcnt = (LAS int*)F.lds; LAS int* lbase = lcnt + 32;
    const float* b_rg = IN_[19] + l * 4; const float* b_re = IN_[21] + l * 32;
    unsigned* gcnt = W.ctl + CW_CNT + l * 64;
    for (int t0 = F.bid * NTHR; t0 < F.T; t0 += F.G * NTHR) {
        if (F.tid < 32) lcnt[F.tid] = 0;
        __syncthreads();
        const int t = t0 + F.tid; int e0 = 0, e1 = 0, r0 = 0, r1 = 0; float g0 = 0.f, g1 = 0.f;
        if (t < F.T) {
            const float* lg = W.LOGITS + (size_t)t * 64;
            float gl[4]; { const f32x4 v = *(const f32x4*)lg; gl[0] = v[0] + b_rg[0]; gl[1] = v[1] + b_rg[1]; gl[2] = v[2] + b_rg[2]; gl[3] = v[3] + b_rg[3]; }
            int grp = 0; float mx = gl[0];
            if (gl[1] > mx) { mx = gl[1]; grp = 1; } if (gl[2] > mx) { mx = gl[2]; grp = 2; } if (gl[3] > mx) { mx = gl[3]; grp = 3; }
            const float p_grp = 1.f / (__expf(gl[0] - mx) + __expf(gl[1] - mx) + __expf(gl[2] - mx) + __expf(gl[3] - mx));
            const f32x4 ea = *(const f32x4*)(lg + 4 + grp * 8), eb = *(const f32x4*)(lg + 8 + grp * 8);
            const f32x4 ba = *(const f32x4*)(b_re + grp * 8), bb = *(const f32x4*)(b_re + grp * 8 + 4);
            float b0v = -1e30f, b1v = -1e30f; int i0 = 0, i1 = 0;
#pragma unroll
            for (int j = 0; j < 8; ++j) { const float e = (j < 4) ? ea[j] + ba[j] : eb[j - 4] + bb[j - 4];
                if (e > b0v) { b1v = b0v; i1 = i0; b0v = e; i0 = j; } else if (e > b1v) { b1v = e; i1 = j; } }
            const float p1 = __expf(b1v - b0v), s2 = 1.f + p1;
            e0 = grp * 8 + i0; e1 = grp * 8 + i1; g0 = p_grp / s2; g1 = p_grp * p1 / s2;
            r0 = __hip_atomic_fetch_add(lcnt + e0, 1, __ATOMIC_RELAXED, __HIP_MEMORY_SCOPE_WORKGROUP);
            r1 = __hip_atomic_fetch_add(lcnt + e1, 1, __ATOMIC_RELAXED, __HIP_MEMORY_SCOPE_WORKGROUP);
        }
        __syncthreads();
        if (F.tid < 32) lbase[F.tid] = (int)__hip_atomic_fetch_add(gcnt + F.tid, (unsigned)lcnt[F.tid], __ATOMIC_RELAXED, __HIP_MEMORY_SCOPE_AGENT);
        __syncthreads();
        if (t < F.T) { W.eid[t * 2] = e0; W.eid[t * 2 + 1] = e1; W.gate[t * 2] = g0; W.gate[t * 2 + 1] = g1; W.rank[t * 2] = lbase[e0] + r0; W.rank[t * 2 + 1] = lbase[e1] + r1; }
        __syncthreads();
    }
}
__device__ __forceinline__ void phase_gather(Frame& F, int l) {
    refresh(F);
    const WS W = ws_map(F.ws, F.nb); const float* const* IN_ = F.a->in; (void)IN_; (void)W;
    LAS int* seg = (LAS int*)F.lds; LAS int* cnt = seg + 40;
    const unsigned* gcnt = W.ctl + CW_CNT + l * 64;
    if (F.tid == 0) { int o = 0; for (int e = 0; e < 32; ++e) { const int c = (int)__hip_atomic_load(gcnt + e, __ATOMIC_RELAXED, __HIP_MEMORY_SCOPE_AGENT); seg[e] = o; cnt[e] = c; o += (c + 255) & ~255; } seg[32] = o; }
    __syncthreads();
    const int ntile = seg[32] >> 8;
    if (F.bid == 0) {
        for (int i = F.tid; i < ntile; i += NTHR) { int e = 0; while (e < 31 && (i << 8) >= seg[e + 1]) ++e; W.tilee[i] = e; }
        if (F.tid == 0) W.segp[0] = ntile;
    }
    for (int p = F.bid * NTHR + F.tid; p < (ntile << 8); p += F.G * NTHR) { int e = 0; while (e < 31 && p >= seg[e + 1]) ++e; if (p - seg[e] >= cnt[e]) W.stok[p] = 0; }
    for (int it = F.bid * NTHR + F.tid; it < F.T * 2; it += F.G * NTHR) {
        const int e = W.eid[it], p = seg[e] + W.rank[it];
        W.stok[p] = it >> 1; W.pos[it] = p; W.gsort[p] = W.gate[it];
    }
}

#ifndef MK_MASK
#define MK_MASK 0xffffffffu
#endif
#define EN(b) (((MK_MASK) >> (b)) & 1u)
#ifndef MK_ALIGN
#define MK_ALIGN true
#endif
#ifndef MK_SP2
#define MK_SP2 true
#endif
#ifndef MK_DUP
#define MK_DUP 0u
#endif
#define REPS(b) ((((MK_DUP) >> (b)) & 1u) ? 2 : 1)
constexpr int NPL = 14, NPH = 2 + DEPTH * NPL;
__global__ void __launch_bounds__(NTHR, 2) mk_fwd(Args args) {
    extern __shared__ __attribute__((aligned(16))) unsigned char lds_raw[];
    Frame F;
    F.lds = (LAS unsigned char*)lds_raw; F.tid = threadIdx.x; F.lane = F.tid & 63; F.wave = __builtin_amdgcn_readfirstlane(F.tid >> 6);
    F.G = gridDim.x; F.bid = blockIdx.x; F.nb = args.nb; F.T = args.nb * SEQ; F.ws = args.ws; F.a = &args; F.xbuf = args.out;
    const float* const* IN_ = args.in;
    volatile LAS unsigned* misc = (volatile LAS unsigned*)(F.lds + LDS_MISC);
    if (F.tid < 64) misc[F.tid] = 0u;
    __syncthreads();
    XcdBarrier bar = xcd_barrier_post((unsigned*)args.ws + CW_BAR + args.li * XCD_BAR_WORDS, misc);
    const int lo = args.ph_lo, hi = args.ph_hi;
#define IN(k) (lo <= (k) && (k) < hi)
#ifdef MK_BAR2
#define SEAM(k) do { if (IN(k) && IN((k) + 1)) { xcd_barrier(bar); xcd_barrier(bar); } } while (0)
#else
#define SEAM(k) do { if (IN(k) && IN((k) + 1)) xcd_barrier(bar); } while (0)
#endif
    LAS unsigned char* gl = F.lds;
    if (EN(0) && IN(0)) { for (int rp = 0; rp < REPS(0); ++rp) { p0_prologue(F); __syncthreads(); } SEAM(0); }
    for (int l = 0; l < DEPTH; ++l) {
        const int pb = 1 + l * NPL;
        if (EN(1) && IN(pb + 0)) { for (int rp = 0; rp < ((l == 0) ? REPS(14) : 1); ++rp) phase_norm(F, l, 0); SEAM(pb + 0); }
        if (EN(2) && IN(pb + 1)) { const WS W = ws_map(F.ws, F.nb);
            pg8::Gemm g{W.H, W.win + (size_t)l * NIN * D, F.T, NIN, D}; pg8::StaticOrder S; S.init(F.T, NIN, F.G, F.bid);
            EpiIn E{W.GQ, W.GK, W.GV, W.SG, W.LGF, W.LGB, W.DQ, W.DK, W.DV, W.SGA, W.SGB, IN_[8] + l * 512, IN_[10] + l * 64, IN_[11] + l * 64};
#ifdef MK_DEPHASE
            { const int g_ = (F.bid >> 3) & 7; for (int k_ = 0; k_ < g_ * MK_DEPHASE; ++k_) __builtin_amdgcn_s_sleep(127); }
#endif
#ifdef MK_INPROJ_NULL
            { EpiNull EN_; pg8::gemm_phase<EpiNull, pg8::StaticOrder, MK_ALIGN, MK_SP2>(gl, g, S, EN_); }
#endif
            for (int rp = 0; rp < REPS(2); ++rp) pg8::gemm_phase<EpiIn, pg8::StaticOrder, MK_ALIGN, MK_SP2>(gl, g, S, E);
            SEAM(pb + 1);
        }
        if (EN(3) && IN(pb + 2)) { for (int rp = 0; rp < REPS(3); ++rp) phase_gla1(F); SEAM(pb + 2); }
        if (EN(4) && IN(pb + 3)) { phase_gla2(F); SEAM(pb + 3); }
        if (EN(5) && IN(pb + 4)) { for (int rp = 0; rp < REPS(5); ++rp) phase_gla3(F, l); __syncthreads(); }
        if (EN(6) && IN(pb + 5)) {
#ifdef MK_ATT_PROBE
            phase_attn<MK_ATT_PROBE>(F, l);
#endif
            phase_attn<0>(F, l); SEAM(pb + 5); }
        if (EN(7) && IN(pb + 6)) { const WS W = ws_map(F.ws, F.nb);
            pg8::Gemm g{W.OAB, W.wab + (size_t)l * D * D, 0, 0, 512}; MergeOrder S; S.so.init(F.T, D, F.G, F.bid); S.nM = F.T / 256;
            EpiMerge E{W.SGA, W.SGB, W.MERGED, F.T / 256};
            for (int rp = 0; rp < REPS(7); ++rp) pg8::gemm_phase<EpiMerge, MergeOrder, MK_ALIGN, MK_SP2>(gl, g, S, E);
            SEAM(pb + 6);
        }
        if (EN(8) && IN(pb + 7)) { const WS W = ws_map(F.ws, F.nb); const float* modl = W.mod + (size_t)l * NBMAX * 6 * D;
            pg8::Gemm g{W.MERGED, W.wo + (size_t)l * D * D, F.T, D, D}; pg8::StaticOrder S; S.init(F.T, D, F.G, F.bid);
            EpiResid E{l == 0 ? IN_[0] : nullptr, W.XB, modl + 2 * D};
            for (int rp = 0; rp < ((l == 0) ? REPS(8) : 1); ++rp) pg8::gemm_phase<EpiResid, pg8::StaticOrder, MK_ALIGN, MK_SP2>(gl, g, S, E);
            SEAM(pb + 7);
        }
        if (EN(1) && IN(pb + 8)) { for (int rp = 0; rp < REPS(1); ++rp) phase_norm(F, l, 1); SEAM(pb + 8); }
        if (EN(9) && IN(pb + 9)) { const WS W = ws_map(F.ws, F.nb);
            pg8::Gemm g{W.H, W.wr + (size_t)l * 256 * D, F.T, 256, D}; pg8::StaticOrder S; S.init(F.T, 256, F.G, F.bid);
            EpiLogits E{W.LOGITS};
            for (int rp = 0; rp < REPS(9); ++rp) pg8::gemm_phase<EpiLogits, pg8::StaticOrder, MK_ALIGN, MK_SP2>(gl, g, S, E);
            SEAM(pb + 9);
        }
        if (EN(10) && IN(pb + 10)) { phase_select(F, l); SEAM(pb + 10); }
        if (EN(11) && IN(pb + 11)) { for (int rp = 0; rp < REPS(11); ++rp) { phase_gather(F, l); __syncthreads(); } SEAM(pb + 11); }
        if (EN(12) && IN(pb + 12)) { const WS W = ws_map(F.ws, F.nb);
            const int ntile = W.segp[0];
#if MK_MOE_FP8
            pg8::Gemm g{W.XS, (const bf16*)((const unsigned char*)W.w1 + (size_t)l * NE * 1024 * D), 0, 0, D / 2}; GroupedOrder S{W.tilee, ntile * 4, F.G, F.bid};
            EpiAct E{(unsigned char*)W.ACT};
#else
            pg8::Gemm g{W.H, W.w1 + (size_t)l * NE * 1024 * D, 0, 0, D}; GroupedOrder S{W.tilee, ntile * 4, F.G, F.bid, W.stok};
            EpiAct E{W.ACT};
#endif
            for (int rp = 0; rp < REPS(12); ++rp) pg8::gemm_phase<EpiAct, GroupedOrder, MK_ALIGN, MK_SP2, true>(gl, g, S, E);
            SEAM(pb + 12);
        }
        if (EN(13) && IN(pb + 13)) { const WS W = ws_map(F.ws, F.nb);
            const int ntile = W.segp[0];
#if MK_MOE_FP8
            pg8::Gemm g{W.ACT, (const bf16*)((const unsigned char*)W.w2 + (size_t)l * NE * D * DE), 0, 0, DE / 2}; GroupedOrder S{W.tilee, ntile * 4, F.G, F.bid};
#else
            pg8::Gemm g{W.ACT, W.w2 + (size_t)l * NE * D * DE, 0, 0, DE}; GroupedOrder S{W.tilee, ntile * 4, F.G, F.bid, nullptr};
#endif
            EpiYs E{(unsigned char*)W.YS, W.gsort};
            for (int rp = 0; rp < REPS(13); ++rp) pg8::gemm_phase<EpiYs, GroupedOrder, MK_ALIGN, MK_SP2>(gl, g, S, E);
            SEAM(pb + 13);
        }
    }
    if (EN(1) && IN(NPH - 1)) phase_norm(F, 0, 2);
#undef IN
#undef SEAM
}

struct LaunchCfg { int grid; bool ok; };
inline LaunchCfg& launch_cfg() {
    static LaunchCfg c{0, false}; static bool init = false;
    if (!init) { init = true;
        int dev = 0, cus = 0, per_cu = 0;
        if (hipGetDevice(&dev) != hipSuccess || hipDeviceGetAttribute(&cus, hipDeviceAttributeMultiprocessorCount, dev) != hipSuccess) { fprintf(stderr, "mk: device query failed\n"); return c; }
        if (hipFuncSetAttribute((const void*)mk_fwd, hipFuncAttributeMaxDynamicSharedMemorySize, LDS_BYTES) != hipSuccess) { fprintf(stderr, "mk: hipFuncSetAttribute failed\n"); return c; }
        if (hipOccupancyMaxActiveBlocksPerMultiprocessor(&per_cu, (const void*)mk_fwd, NTHR, LDS_BYTES) != hipSuccess || per_cu < 1) { fprintf(stderr, "mk: occupancy query says %d blocks/CU\n", per_cu); (void)hipGetLastError(); return c; }
        c.grid = cus; c.ok = true;
    }
    return c;
}
inline void launch_range(void* const* d_in, float* xbuf, void* d_ws, int nb, int lo, int hi, int li, hipStream_t stream) {
    LaunchCfg& c = launch_cfg(); if (!c.ok) return;
    Args a{}; for (int i = 0; i < 24; ++i) a.in[i] = (const float*)d_in[i];
    a.out = xbuf; a.ws = (unsigned char*)d_ws; a.nb = nb; a.ph_lo = lo; a.ph_hi = hi; a.li = li;
    hipLaunchKernelGGL(mk_fwd, dim3(c.grid), dim3(NTHR), LDS_BYTES, stream, a);
    const hipError_t le = hipPeekAtLastError(); if (le != hipSuccess) fprintf(stderr, "mk: launch [%d,%d) failed: %s\n", lo, hi, hipGetErrorName(le));
}
}
extern "C" void kernel_launch(void* const* d_in, const int* in_sizes, int n_in, void* d_out, int out_size, void* d_ws, size_t ws_size, hipStream_t stream) {
    (void)in_sizes; (void)n_in; (void)out_size;
    static int checked = 0;
    if (!checked) { checked = 1; const mk::WS w = mk::ws_map((unsigned char*)d_ws, 4); if (w.end > ws_size) { fprintf(stderr, "mk: workspace too small: need %zu, have %zu\n", w.end, ws_size); checked = -1; } }
    if (checked < 0) return;
    if (hipMemsetAsync(d_ws, 0, mk::CTL_BYTES, stream) != hipSuccess) return;
    mk::launch_range(d_in, (float*)d_out, d_ws, 4, 0, mk::NPH, 0, stream);
}
```

```cpp
#include <hip/hip_runtime.h>
#include <cstdio>
#include <cstdint>
#include <cmath>
#define MK_ATT_FP8 1
namespace pg8 {
#define PG8_LAS __attribute__((address_space(3)))
typedef unsigned short bf16_t;
typedef short bf16x8 __attribute__((ext_vector_type(8)));
typedef float f32x4 __attribute__((ext_vector_type(4)));
typedef unsigned u32x4 __attribute__((ext_vector_type(4)));
constexpr int BM = 256, BK = 64, HALF = 128, HTB = HALF * BK * 2  , STAGE_BYTES = 8 * HTB, NXCD = 8, WGM = 8;

__host__ __device__ __forceinline__ int lds_byte(int r, int c) { const int st = (r >> 4) * 2 + (c >> 5), rr = r & 15, cc = c & 31, ob = rr * 64 + cc * 2; return st * 1024 + (ob ^ (((ob >> 9) & 1) << 5)); }
__host__ __device__ __forceinline__ void stage_rc(int b, int& R, int& C) { const int st = b / 1024, sb = b % 1024, swz = sb ^ (((sb >> 9) & 1) << 5); R = (st >> 1) * 16 + swz / 64; C = (st & 1) * 32 + (swz % 64) / 2; }
__host__ __device__ __forceinline__ int perm32(int rho) { const int n = rho >> 4, i = rho & 15; return 8 * (i >> 2) + 4 * n + (i & 3); }

struct Unit { int pm, pn; };
struct Gemm { const bf16_t* A; const bf16_t* Bt; int M, N, K; };

struct StaticOrder {
    int nM, nN, nwg, G, c;
    __host__ __device__ void init(int M, int N, int G_, int c_) { nM = M / BM; nN = N / BM; nwg = nM * nN; G = G_; c = c_; }
    __host__ __device__ bool next(int i, Unit& u) const {
        const long L = (long)i * G + c; if (L >= nwg) return false;
        int wgid = (int)L; { const int q = nwg / NXCD, r = nwg % NXCD, xcd = wgid % NXCD, off = wgid / NXCD; wgid = (xcd < r ? xcd * (q + 1) : r * (q + 1) + (xcd - r) * q) + off; }
        const int nig = WGM * nN, gid = wgid / nig, fm = gid * WGM, gsz = (nM - fm) < WGM ? (nM - fm) : WGM;
        u.pm = fm + ((wgid % nig) % gsz); u.pn = (wgid % nig) / gsz; return true;
    }
    __device__ __forceinline__ void a_ready(const Unit&) const {}
    __device__ __forceinline__ void done(const Unit&) const {}
};
__device__ __forceinline__ unsigned cvt_pk_bf16(float lo, float hi) { unsigned r; asm volatile("v_cvt_pk_bf16_f32 %0, %1, %2" : "=v"(r) : "v"(lo), "v"(hi)); return r; }
__device__ __forceinline__ const void* pg8_uniform(const void* p) { const unsigned long long v = (unsigned long long)p;
    const unsigned lo = (unsigned)__builtin_amdgcn_readfirstlane((int)(unsigned)v), hi = (unsigned)__builtin_amdgcn_readfirstlane((int)(unsigned)(v >> 32)); return (const void*)(((unsigned long long)hi << 32) | lo); }
__device__ __forceinline__ void pg8_glds(const void* sbase, unsigned voff, unsigned ldsdst) { unsigned keep;
    asm volatile("s_nop 4\n\ts_mov_b32 %0, m0\n\ts_mov_b32 m0, %3\n\ts_nop 0\n\tglobal_load_lds_dwordx4 %1, %2\n\ts_mov_b32 m0, %0" : "=&s"(keep) : "v"(voff), "s"(sbase), "s"(ldsdst) : "memory"); }
typedef int pg8_v8i __attribute__((ext_vector_type(8)));
typedef int pg8_v4i __attribute__((ext_vector_type(4)));
template <class Epi, class Sched, bool ALIGN_EPI = false, bool SP2 = false, bool GATHER = false>
__device__ __forceinline__ void gemm_phase(PG8_LAS unsigned char* lds, const Gemm g, const Sched& S, const Epi& E) {
    int tid_ = threadIdx.x; asm volatile("" : "+v"(tid_));
    const int tid = tid_, wid = __builtin_amdgcn_readfirstlane(tid >> 6), lane = tid & 63, wr = wid >> 2, wc = wid & 3, fr = lane & 15, fq = lane >> 4;
    const int K = g.K, nt = K / BK;
    unsigned voffA[2], voffB[2]; unsigned vc[2][2] = {}, vn[2][2] = {}, vs[2][2] = {}; (void)vc; (void)vn; (void)vs;
#pragma unroll
    for (int i = 0; i < 2; ++i) { int R, C; stage_rc(tid * 16 + i * 8192, R, C); const int Rb = Epi::PERM ? ((R & ~31) + perm32(R & 31)) : R;
        voffA[i] = (unsigned)(R * K + C) * 2u; voffB[i] = (unsigned)(Rb * K + C) * 2u; }
    const size_t kstep = (size_t)(BK * 2);
    const size_t hstep = (size_t)HALF * K * 2;
    const size_t tstep = 2 * hstep;
    const unsigned ldsw = (unsigned)wid * 1024u; const unsigned lds0 = (unsigned)(unsigned long)lds; (void)lds0;
    const int aoff = lds_byte(wr * 64 + fr, fq * 8), boff = lds_byte(wc * 32 + fr, fq * 8);
#define PG8_SA(b, h) (((b) * 2 + (h)) * HTB)
#define PG8_SB(b, h) ((4 + (b) * 2 + (h)) * HTB)
#if defined(PG8_ASM_STAGE) && PG8_ASM_STAGE
#define PG8_STAGE(bufoff, gbase, voff) do { const void* _gb = pg8_uniform(gbase); _Pragma("unroll") for (int _i = 0; _i < 2; ++_i) \
        pg8_glds(_gb, (voff)[_i], (unsigned)__builtin_amdgcn_readfirstlane((int)(lds0 + (unsigned)(bufoff) + ldsw + _i * 8192))); } while (0)
#else
#define PG8_STAGE(bufoff, gbase, voff) do { _Pragma("unroll") for (int _i = 0; _i < 2; ++_i) \
        __builtin_amdgcn_global_load_lds((const unsigned*)((const char*)(gbase) + (voff)[_i]), (PG8_LAS unsigned*)(lds + (bufoff) + ldsw + _i * 8192), 16, 0, 0); } while (0)
#endif
#define PG8_STAGE_A(b, h, X, VS) do { if constexpr (GATHER) { PG8_STAGE(PG8_SA(b, h), X, VS[h]); } else { PG8_STAGE(PG8_SA(b, h), (X) + (h) * hstep, voffA); } } while (0)
#define PG8_LOADROWS(u, v) do { _Pragma("unroll") for (int i_ = 0; i_ < 2; ++i_) { int R_, C_; stage_rc(tid * 16 + i_ * 8192, R_, C_); _Pragma("unroll") for (int h_ = 0; h_ < 2; ++h_) \
        v[h_][i_] = (unsigned)S.rowidx[(u).pm * 256 + h_ * 128 + R_] * (unsigned)(K * 2) + (unsigned)C_ * 2u; } } while (0)
#define PG8_LDA(dst, b, h) do { _Pragma("unroll") for (int m = 0; m < 4; ++m) _Pragma("unroll") for (int k = 0; k < 2; ++k) dst[m][k] = *(const PG8_LAS bf16x8*)(lds + PG8_SA(b, h) + aoff + m * 2048 + k * 1024); } while (0)
#define PG8_LDB(dst, b, h) do { _Pragma("unroll") for (int n = 0; n < 2; ++n) _Pragma("unroll") for (int k = 0; k < 2; ++k) dst[n][k] = *(const PG8_LAS bf16x8*)(lds + PG8_SB(b, h) + boff + n * 2048 + k * 1024); } while (0)
#define PG8_MMA(ai, bj, At, Bt) do { __builtin_amdgcn_s_setprio(1); _Pragma("unroll") for (int m = 0; m < 4; ++m) _Pragma("unroll") for (int n = 0; n < 2; ++n) _Pragma("unroll") for (int k = 0; k < 2; ++k) \
        acc[ai][bj][m][n] = __builtin_amdgcn_mfma_f32_16x16x32_bf16(Bt[n][k], At[m][k], acc[ai][bj][m][n], 0, 0, 0); __builtin_amdgcn_s_setprio(0); } while (0)
#define PG8_WAIT_V(n) asm volatile("s_waitcnt vmcnt(" #n ")" ::: "memory")
#define PG8_WAIT_L(n) asm volatile("s_waitcnt lgkmcnt(" #n ")" ::: "memory")
#define PG8_BAR __builtin_amdgcn_s_barrier()
#define PG8_SCHED __builtin_amdgcn_sched_barrier(0)
    Unit cur, nxt; int ui = 0;
    if (!S.next(0, cur)) return;
    f32x4 acc[2][2][4][2];
#pragma unroll
    for (int a = 0; a < 2; ++a)
#pragma unroll
        for (int b = 0; b < 2; ++b)
#pragma unroll
            for (int m = 0; m < 4; ++m)
#pragma unroll
                for (int n = 0; n < 2; ++n) acc[a][b][m][n] = (f32x4){0.f, 0.f, 0.f, 0.f};
    bf16x8 At[4][2], B0[2][2], B1[2][2];
    const char* cA = (const char*)g.A + (GATHER ? (size_t)0 : (size_t)cur.pm * tstep); const char* cB = (const char*)g.Bt + (size_t)cur.pn * tstep;
    S.a_ready(cur);
    if constexpr (GATHER) { PG8_LOADROWS(cur, vc); }
    if constexpr (SP2) {
        PG8_STAGE(PG8_SB(0, 0), cB, voffB); PG8_STAGE(PG8_SB(0, 1), cB + hstep, voffB); PG8_STAGE_A(0, 0, cA, vc); PG8_STAGE_A(0, 1, cA, vc);
        if (wr == 1) PG8_BAR;
        PG8_WAIT_V(2); PG8_BAR;
        PG8_STAGE(PG8_SB(1, 0), cB + kstep, voffB); PG8_STAGE_A(1, 0, cA + kstep, vc); PG8_STAGE(PG8_SB(1, 1), cB + hstep + kstep, voffB);
        PG8_WAIT_V(6); PG8_BAR;
    } else {
        PG8_STAGE(PG8_SB(0, 0), cB, voffB); PG8_STAGE_A(0, 0, cA, vc); PG8_STAGE(PG8_SB(0, 1), cB + hstep, voffB); PG8_STAGE_A(0, 1, cA, vc);
        if (wr == 1) PG8_BAR;
        PG8_WAIT_V(4); PG8_BAR;
        PG8_STAGE(PG8_SB(1, 0), cB + kstep, voffB); PG8_STAGE_A(1, 0, cA + kstep, vc); PG8_STAGE(PG8_SB(1, 1), cB + hstep + kstep, voffB);
        PG8_WAIT_V(6); PG8_BAR;
    }
    for (;;) {
        const bool has_next = S.next(ui + 1, nxt);
        const char* nA = (has_next && !GATHER) ? (const char*)g.A + (size_t)nxt.pm * tstep : cA; const char* nB = has_next ? (const char*)g.Bt + (size_t)nxt.pn * tstep : cB;
        for (int t = 0; t < nt; t += 2) {
            const bool last = (t == nt - 2);
            const char* a1 = cA + (size_t)(t + 1) * kstep;
            const char* a2 = last ? nA : cA + (size_t)(t + 2) * kstep; const char* b2 = last ? nB : cB + (size_t)(t + 2) * kstep;
            const char* a3 = a2 + kstep; const char* b3 = b2 + kstep;
            if (last && has_next) S.a_ready(nxt);
            if constexpr (GATHER) { if (last && has_next) { PG8_LOADROWS(nxt, vn); }
                _Pragma("unroll") for (int h_ = 0; h_ < 2; ++h_) _Pragma("unroll") for (int i_ = 0; i_ < 2; ++i_) vs[h_][i_] = (last && has_next) ? vn[h_][i_] : vc[h_][i_]; }
            if constexpr (Epi::MIDK) { if (t == nt / 2) E.mid(acc, cur, wr, wc, fr, fq); }
            if constexpr (SP2) {
            PG8_LDB(B0, 0, 0); PG8_LDB(B1, 0, 1); PG8_SCHED; PG8_LDA(At, 0, 0); PG8_STAGE_A(1, 1, a1, vc);
            PG8_WAIT_V(8); PG8_WAIT_L(0); PG8_BAR; PG8_MMA(0, 0, At, B0); PG8_MMA(0, 1, At, B1); PG8_BAR; PG8_SCHED;
            PG8_LDA(At, 0, 1); PG8_STAGE(PG8_SB(0, 0), b2, voffB); PG8_STAGE(PG8_SB(0, 1), b2 + hstep, voffB); PG8_STAGE_A(0, 0, a2, vs);
            PG8_WAIT_V(8); PG8_WAIT_L(0); PG8_BAR; PG8_MMA(1, 0, At, B0); PG8_MMA(1, 1, At, B1); PG8_BAR; PG8_SCHED;
            PG8_LDB(B0, 1, 0); PG8_LDB(B1, 1, 1); PG8_SCHED; PG8_LDA(At, 1, 0); PG8_STAGE_A(0, 1, a2, vs);
            PG8_WAIT_V(8); PG8_WAIT_L(0); PG8_BAR; PG8_MMA(0, 0, At, B0); PG8_MMA(0, 1, At, B1); PG8_BAR; PG8_SCHED;
            PG8_LDA(At, 1, 1); PG8_STAGE(PG8_SB(1, 0), b3, voffB); PG8_STAGE(PG8_SB(1, 1), b3 + hstep, voffB); PG8_STAGE_A(1, 0, a3, vs);
            PG8_WAIT_V(8); PG8_WAIT_L(0); PG8_BAR; PG8_MMA(1, 0, At, B0); PG8_MMA(1, 1, At, B1); PG8_BAR; PG8_SCHED;
            } else {
            PG8_LDB(B0, 0, 0); PG8_SCHED; PG8_LDA(At, 0, 0); PG8_STAGE_A(1, 1, a1, vc);
            PG8_WAIT_L(8); PG8_BAR; PG8_WAIT_L(0); PG8_MMA(0, 0, At, B0); PG8_BAR; PG8_SCHED;
            PG8_LDB(B1, 0, 1); PG8_STAGE(PG8_SB(0, 0), b2, voffB);
            PG8_BAR; PG8_WAIT_L(0); PG8_MMA(0, 1, At, B1); PG8_BAR;
            PG8_LDA(At, 0, 1); PG8_STAGE_A(0, 0, a2, vs);
            PG8_BAR; PG8_WAIT_L(0); PG8_MMA(1, 0, At, B0); PG8_BAR; PG8_SCHED;
            PG8_STAGE(PG8_SB(0, 1), b2 + hstep, voffB);
            PG8_WAIT_V(6); PG8_BAR; PG8_MMA(1, 1, At, B1); PG8_BAR;
            PG8_LDB(B0, 1, 0); PG8_SCHED; PG8_LDA(At, 1, 0); PG8_STAGE_A(0, 1, a2, vs);
            PG8_WAIT_L(8); PG8_BAR; PG8_WAIT_L(0); PG8_MMA(0, 0, At, B0); PG8_BAR; PG8_SCHED;
            PG8_LDB(B1, 1, 1); PG8_STAGE(PG8_SB(1, 0), b3, voffB);
            PG8_BAR; PG8_WAIT_L(0); PG8_MMA(0, 1, At, B1); PG8_BAR;
            PG8_LDA(At, 1, 1); PG8_STAGE_A(1, 0, a3, vs);
            PG8_BAR; PG8_WAIT_L(0); PG8_MMA(1, 0, At, B0); PG8_BAR; PG8_SCHED;
            PG8_STAGE(PG8_SB(1, 1), b3 + hstep, voffB);
            PG8_WAIT_V(6); PG8_BAR; PG8_MMA(1, 1, At, B1); PG8_BAR;
            }
        }
        if constexpr (ALIGN_EPI) { if (wr == 0) PG8_BAR; }
        if constexpr (!Epi::AFTER_DRAIN) { E(acc, cur, wr, wc, fr, fq); S.done(cur); }
        if (!has_next) break;
#pragma unroll
        for (int a = 0; a < 2; ++a)
#pragma unroll
            for (int b = 0; b < 2; ++b)
#pragma unroll
                for (int m = 0; m < 4; ++m)
#pragma unroll
                    for (int n = 0; n < 2; ++n) acc[a][b][m][n] = (f32x4){0.f, 0.f, 0.f, 0.f};
        cur = nxt; cA = nA; cB = nB; ++ui;
        if constexpr (GATHER) { _Pragma("unroll") for (int h_ = 0; h_ < 2; ++h_) _Pragma("unroll") for (int i_ = 0; i_ < 2; ++i_) vc[h_][i_] = vn[h_][i_]; }
        if constexpr (ALIGN_EPI) { if (wr == 1) PG8_BAR; }
    }
    PG8_WAIT_V(0);
    if constexpr (!ALIGN_EPI) { if (wr == 0) PG8_BAR; }
    PG8_BAR;
    if constexpr (Epi::AFTER_DRAIN) { E.fused(acc, cur, wr, wc, fr, fq, lds, wid, lane); S.done(cur); }
#undef PG8_SA
#undef PG8_SB
#undef PG8_STAGE
#undef PG8_STAGE_A
#undef PG8_LOADROWS
#undef PG8_LDA
#undef PG8_LDB
#undef PG8_MMA
#undef PG8_WAIT_V
#undef PG8_WAIT_L
#undef PG8_BAR
#undef PG8_SCHED
}
}
namespace mk {
constexpr int D = 1024, SEQ = 8192, NBMAX = 4, NH = 4, DIN = 5152, NE = 32, DE = 512, DEPTH = 2;
constexpr int NT_IN = 22, NIN = NT_IN * 256;
constexpr int NWAVES = 8, NTHR = 512;
#ifndef MK_MOE_FP8
#define MK_MOE_FP8 0
#endif
constexpr float WSCALE = 16.f, ASCALE = 4.f, YSCALE = 32.f;
constexpr float LOG2E = 1.4426950408889634f, QSCALE = 0.125f * LOG2E, RMS_EPS = 1e-6f;
constexpr int O_GQ = 0, O_GK = 256, O_GV = 512, O_GG = 1024, O_LRF = 1536, O_LRB = 1552, O_DQ = 1568, O_DK = 2080, O_DV = 2592, O_GA = 3104, O_GB = 4128;
typedef unsigned short bf16;
typedef unsigned u32x4 __attribute__((ext_vector_type(4)));
typedef unsigned u32x2 __attribute__((ext_vector_type(2)));
typedef float f32x4 __attribute__((ext_vector_type(4)));
typedef float f32x16 __attribute__((ext_vector_type(16)));
typedef short bf16x8 __attribute__((ext_vector_type(8)));
typedef short s16x4 __attribute__((ext_vector_type(4)));
#define LAS __attribute__((address_space(3)))
#define GAS __attribute__((address_space(1)))
#define LDS_WAIT() asm volatile("s_waitcnt lgkmcnt(0)" ::: "memory")
#define VM_WAIT() asm volatile("s_waitcnt vmcnt(0)" ::: "memory")

constexpr size_t MiB = 1u << 20;
constexpr size_t CTL_BYTES = 256 * 1024;
constexpr int CW_BAR = 4096;
constexpr int CW_CNT = 32768;
constexpr size_t OFF_MOD = 256 * 1024, OFF_TAB = 512 * 1024;
constexpr size_t OFF_WIN = 1 * MiB, SZ_WIN = (size_t)DEPTH * NIN * D * 2;
constexpr size_t OFF_WAB = OFF_WIN + SZ_WIN, SZ_WAB = (size_t)DEPTH * D * D * 2;
constexpr size_t OFF_WO = OFF_WAB + SZ_WAB, SZ_WO = SZ_WAB;
constexpr size_t OFF_WR = OFF_WO + SZ_WO, SZ_WR = (size_t)DEPTH * 256 * D * 2;
constexpr size_t OFF_W1 = OFF_WR + SZ_WR, SZ_W1 = (size_t)DEPTH * NE * 1024 * D * 2;
constexpr size_t OFF_W2 = OFF_W1 + SZ_W1, SZ_W2 = (size_t)DEPTH * NE * D * DE * 2;
constexpr size_t OFF_ACT = 225 * MiB;
static_assert(OFF_W2 + SZ_W2 <= OFF_ACT, "weights fit");
struct WS {
    unsigned* ctl; float* mod; float* tab;
    bf16 *win, *wab, *wo, *wr, *w1, *w2;
    bf16 *H, *OAB, *XB; int* eid; float* gate; int* rank; int* pos; int* tilee; int* segp;
    bf16 *GQ, *GK, *GV, *SG; bf16 *LGF, *LGB; bf16 *DQ, *DK, *DV, *SGA, *SGB; float* KVT; float* DEC; bf16* MERGED;
    bf16 *XS, *ACT, *YS; float* LOGITS; float* gsort; int* stok;
    size_t end;
};
__host__ __device__ inline WS ws_map(unsigned char* b, int nb) {
    WS w; const size_t T = (size_t)nb * SEQ;
    w.ctl = (unsigned*)b; w.mod = (float*)(b + OFF_MOD); w.tab = (float*)(b + OFF_TAB);
    w.win = (bf16*)(b + OFF_WIN); w.wab = (bf16*)(b + OFF_WAB); w.wo = (bf16*)(b + OFF_WO); w.wr = (bf16*)(b + OFF_WR); w.w1 = (bf16*)(b + OFF_W1); w.w2 = (bf16*)(b + OFF_W2);
    size_t o = OFF_ACT;
    auto take = [&](size_t bytes) { unsigned char* p = b + o; o += (bytes + 255) & ~(size_t)255; return p; };
    w.H = (bf16*)take(T * 2048); w.OAB = (bf16*)take(T * 2048); w.XB = (bf16*)take(T * 2048);
    w.eid = (int*)take(T * 8); w.gate = (float*)take(T * 8); w.rank = (int*)take(T * 8); w.pos = (int*)take(T * 8); w.tilee = (int*)take(4096); w.segp = (int*)take(1024);
    const size_t u0 = o;
    w.GQ = (bf16*)take(T * 512); w.GK = (bf16*)take(T * 512); w.GV = (bf16*)take(T * 1024); w.SG = (bf16*)take(T * 1024);
    w.LGF = (bf16*)take(T * 512); w.LGB = (bf16*)take(T * 512);
    w.DQ = (bf16*)take(T * 1024); w.DK = (bf16*)take(T * 1024); w.DV = (bf16*)take(T * 1024); w.SGA = (bf16*)take(T * 2048); w.SGB = (bf16*)take(T * 2048);
    w.KVT = (float*)take(T * 4096); w.MERGED = (bf16*)w.KVT; w.DEC = (float*)take(T * 32);
    const size_t e1 = o; o = u0;
    const size_t R = 2 * T + 32 * 256;
    w.XS = (bf16*)take(R * 2048); w.ACT = (bf16*)take(R * 1024); w.YS = (bf16*)take(R * 2048); w.LOGITS = (float*)take(T * 256); w.gsort = (float*)take(R * 4); w.stok = (int*)take(R * 4);
    w.end = o > e1 ? o : e1;
    return w;
}

typedef float f32x2_t __attribute__((ext_vector_type(2))); typedef __bf16 bf16x2_t __attribute__((ext_vector_type(2)));
__device__ __forceinline__ unsigned cvt_pk(float lo, float hi) { const f32x2_t v = {lo, hi}; const bf16x2_t b = __builtin_convertvector(v, bf16x2_t); return __builtin_bit_cast(unsigned, b); }
__device__ __forceinline__ float bf2f(unsigned short b) { return __uint_as_float(((unsigned)b) << 16); }
__device__ __forceinline__ float bflo(unsigned w) { return __uint_as_float(w << 16); }
__device__ __forceinline__ float bfhi(unsigned w) { return __uint_as_float(w & 0xffff0000u); }
__device__ __forceinline__ float fsigmoid(float x) { return __builtin_amdgcn_rcpf(1.f + __expf(-x)); }
__device__ __forceinline__ float fsilu(float x) { return x * fsigmoid(x); }
__device__ __forceinline__ float wave_sum(float v) {
#pragma unroll
    for (int o = 1; o < 64; o <<= 1) v += __shfl_xor(v, o);
    return v;
}
__device__ __forceinline__ int t5_bucket(int rel) {
    int ret = rel > 0 ? 16 : 0; int n = rel < 0 ? -rel : rel;
    if (n < 8) return ret + n;
    return ret + 8 + (n >= 12) + (n >= 16) + (n >= 23) + (n >= 32) + (n >= 46) + (n >= 64) + (n >= 91);
}

#define XB_TMO      128
#define XB_XCNT(j)  (256  + 64 * (j))
#define XB_XSUB(j)  (1280 + 64 * (j))
#define XB_XGEN(j)  (2304 + 64 * (j))
#define XB_TOP      3328
#define XB_TOPGEN   3392
#define XCD_BAR_WORDS 3456
#define XB_SPIN_CAP (1u << 18)
__device__ __forceinline__ unsigned xb_ld(unsigned* p)              { return __hip_atomic_load(p, __ATOMIC_RELAXED, __HIP_MEMORY_SCOPE_AGENT); }
__device__ __forceinline__ unsigned xb_add(unsigned* p, unsigned v) { return __hip_atomic_fetch_add(p, v, __ATOMIC_RELAXED, __HIP_MEMORY_SCOPE_AGENT); }
__device__ __forceinline__ unsigned xb_xcc_id() { return (unsigned)__builtin_amdgcn_s_getreg((3 << 11) | 20) & 0xFu; }
#define XB_SPIN(cond, bar) do { unsigned _sp = 0; while (cond) { __builtin_amdgcn_s_sleep(1); \
    if ((++_sp & 255u) == 0u) { if (xb_ld(&(bar)[XB_TMO])) break; if (_sp > XB_SPIN_CAP) { atomicAdd(&(bar)[XB_TMO], 1u); break; } } } } while (0)
struct XcdBarrier { unsigned* bar; unsigned x; volatile LAS unsigned* st; };
__device__ __forceinline__ XcdBarrier xcd_barrier_post(unsigned* bar, volatile LAS unsigned* st) {
    XcdBarrier b; b.bar = bar; b.x = xb_xcc_id(); b.st = st;
    if (threadIdx.x == 0) (void)xb_add(&bar[XB_XCNT(b.x)], 1u);
    return b;
}
__device__ __forceinline__ void xcd_barrier_complete(unsigned* bar, unsigned x, unsigned& nloc, unsigned& nx) {
    const unsigned G = gridDim.x * gridDim.y * gridDim.z;
    unsigned sum, cnt, mine, sp = 0u;
    for (;;) {
        sum = 0u; cnt = 0u; mine = 0u;
#pragma unroll
        for (unsigned j = 0; j < 16; ++j) { const unsigned c = xb_ld(&bar[XB_XCNT(j)]); sum += c; cnt += (c > 0u) ? 1u : 0u; mine = (j == x) ? c : mine; }
        if (sum == G) break;
        __builtin_amdgcn_s_sleep(1);
        if ((++sp & 255u) == 0u) { if (xb_ld(&bar[XB_TMO])) break; if (sp > XB_SPIN_CAP) { atomicAdd(&bar[XB_TMO], 1u); break; } }
    }
    nloc = mine > 0u ? mine : 1u; nx = cnt > 0u ? cnt : 1u;
}
__device__ __forceinline__ void xcd_barrier(const XcdBarrier& b) {
    asm volatile("s_waitcnt vmcnt(0)" ::: "memory");
    __syncthreads();
    if (threadIdx.x == 0) {
        unsigned* bar = b.bar;
        __builtin_amdgcn_s_waitcnt(0);
        unsigned nloc = b.st[0], nx = b.st[1];
        if (nloc == 0u) { xcd_barrier_complete(bar, b.x, nloc, nx); b.st[0] = nloc; b.st[1] = nx; }
        const unsigned old = xb_add(&bar[XB_XSUB(b.x)], 1u);
        const unsigned gen = old / nloc;
        if (old + 1u == (gen + 1u) * nloc) {
            __builtin_amdgcn_fence(__ATOMIC_RELEASE, "agent");
            asm volatile("s_waitcnt vmcnt(0)" ::: "memory");
            const unsigned og = xb_add(&bar[XB_TOP], 1u);
            const unsigned tg = og / nx;
            if (og + 1u == (tg + 1u) * nx) xb_add(&bar[XB_TOPGEN], 1u);
            else XB_SPIN(xb_ld(&bar[XB_TOPGEN]) == tg, bar);
            __builtin_amdgcn_fence(__ATOMIC_ACQUIRE, "agent");
            xb_add(&bar[XB_XGEN(b.x)], 1u);
            asm volatile("s_waitcnt vmcnt(0)" ::: "memory");
        } else {
            XB_SPIN(xb_ld(&bar[XB_XGEN(b.x)]) == gen, bar);
            __builtin_amdgcn_fence(__ATOMIC_ACQUIRE, "agent");
            asm volatile("s_waitcnt vmcnt(0)" ::: "memory");
        }
    }
    __syncthreads();
}

struct Args { const float* in[24]; float* out; unsigned char* ws; int nb, ph_lo, ph_hi, li; };
struct Frame {
    LAS unsigned char* lds; int tid, lane, wave, G, bid, nb, T; unsigned char* ws; const Args* a; float* xbuf;
};
__device__ __forceinline__ void refresh(Frame& F) { int t = threadIdx.x; asm volatile("" : "+v"(t)); F.tid = t; F.lane = t & 63; F.wave = __builtin_amdgcn_readfirstlane(t >> 6); }
constexpr int LDS_BYTES = 160 * 1024 - 64 * 0;
constexpr int LDS_MISC = 160 * 1024 - 256;

__device__ __forceinline__ void tr_item(const float* src, int lds_, int ks0, int c0, bf16* dst, int ldd, int r0, int kd0, LAS float* scr, int lane) {
#pragma unroll 8
    for (int i = 0; i < 32; ++i) { const int kk = 2 * i + (lane >> 5); scr[kk * 33 + (lane & 31)] = src[(size_t)(ks0 + kk) * lds_ + c0 + (lane & 31)]; }
    LDS_WAIT(); asm volatile("" ::: "memory");
    const int c = lane & 7;
#pragma unroll
    for (int j = 0; j < 4; ++j) { const int n = (lane >> 3) + 8 * j; const LAS float* s = scr + (8 * c) * 33 + n;
        u32x4 o; o.x = cvt_pk(s[0 * 33], s[1 * 33]); o.y = cvt_pk(s[2 * 33], s[3 * 33]); o.z = cvt_pk(s[4 * 33], s[5 * 33]); o.w = cvt_pk(s[6 * 33], s[7 * 33]);
        *(u32x4*)(dst + (size_t)(r0 + n) * ldd + kd0 + 8 * c) = o; }
    LDS_WAIT(); asm volatile("" ::: "memory");
}
__device__ __forceinline__ void tr_item8(const float* src, int lds_, int ks0, int c0, unsigned char* dst, int ldd, int r0, int kd0, float scale, LAS float* scr, int lane) {
#pragma unroll 8
    for (int i = 0; i < 32; ++i) { const int kk = 2 * i + (lane >> 5); scr[kk * 33 + (lane & 31)] = src[(size_t)(ks0 + kk) * lds_ + c0 + (lane & 31)] * scale; }
    LDS_WAIT(); asm volatile("" ::: "memory");
    const int c = lane & 7;
#pragma unroll
    for (int j = 0; j < 4; ++j) { const int n = (lane >> 3) + 8 * j; const LAS float* s = scr + (8 * c) * 33 + n;
        int w0 = 0, w1 = 0;
        w0 = __builtin_amdgcn_cvt_pk_fp8_f32(s[0 * 33], s[1 * 33], w0, false); w0 = __builtin_amdgcn_cvt_pk_fp8_f32(s[2 * 33], s[3 * 33], w0, true);
        w1 = __builtin_amdgcn_cvt_pk_fp8_f32(s[4 * 33], s[5 * 33], w1, false); w1 = __builtin_amdgcn_cvt_pk_fp8_f32(s[6 * 33], s[7 * 33], w1, true);
        u32x2 o; o.x = (unsigned)w0; o.y = (unsigned)w1;
        *(u32x2*)(dst + (size_t)(r0 + n) * ldd + kd0 + 8 * c) = o; }
    LDS_WAIT(); asm volatile("" ::: "memory");
}
__device__ __forceinline__ int win_src_col(int tile, int p0) {
    const int bj = p0 >> 7, wc = (p0 >> 5) & 3; const int L = 64 * wc + 32 * bj;
    switch (tile) {
        case 0: return O_GQ + p0; case 1: return O_GK + p0;
        case 2: case 3: return O_GV + (tile - 2) * 256 + p0;
        case 4: case 5: return O_GG + (tile - 4) * 256 + p0;
        case 8: case 9: return O_DQ + (tile - 8) * 256 + L;
        case 10: case 11: return O_DK + (tile - 10) * 256 + L;
        case 12: case 13: return O_DV + (tile - 12) * 256 + p0;
        case 14: case 15: case 16: case 17: return O_GA + (tile - 14) * 256 + p0;
        default: return O_GB + (tile - 18) * 256 + p0;
    }
}
__device__ __forceinline__ void p0_prologue(Frame& F) {
    refresh(F);
    const WS W = ws_map(F.ws, F.nb); const float* const* IN_ = F.a->in;
    const float* c_in = IN_[1]; const float* w_ada = IN_[2]; const float* b_ada = IN_[3];
    {
        LAS float* red = (LAS float*)F.lds;
        for (int it = F.bid; it < DEPTH * 96; it += F.G) {
            const int l = it / 96, j = (it % 96) * 64 + F.lane;
            const float* w = w_ada + (size_t)l * D * 6 * D + j;
            float a0 = 0.f, a1 = 0.f, a2 = 0.f, a3 = 0.f;
            const int kbeg = F.wave * 128;
#pragma unroll 16
            for (int k = kbeg; k < kbeg + 128; ++k) { const float wv = w[(size_t)k * 6 * D];
                const float c0 = c_in[k], c1 = c_in[D + k], c2 = c_in[2 * D + k], c3 = c_in[3 * D + k];
                a0 += fsilu(c0) * wv; a1 += fsilu(c1) * wv; a2 += fsilu(c2) * wv; a3 += fsilu(c3) * wv; }
            red[(F.wave * 4 + 0) * 64 + F.lane] = a0; red[(F.wave * 4 + 1) * 64 + F.lane] = a1; red[(F.wave * 4 + 2) * 64 + F.lane] = a2; red[(F.wave * 4 + 3) * 64 + F.lane] = a3;
            __syncthreads();
            if (F.tid < 256) { const int b = F.tid >> 6, jj = F.tid & 63; float s = 0.f;
#pragma unroll
                for (int wv = 0; wv < 8; ++wv) s += red[(wv * 4 + b) * 64 + jj];
                const int jc = (it % 96) * 64 + jj;
                W.mod[((size_t)l * NBMAX + b) * 6 * D + jc] = s + b_ada[l * 6 * D + jc]; }
            __syncthreads();
        }
    }
    if (F.bid == 0) {
        const float* rb = IN_[14];
        for (int i = F.tid; i < 1024; i += NTHR) { const int h = i >> 8, rel = (i & 255) - 128; W.tab[i] = (rb[t5_bucket(rel) * 4 + h] - rb[31 * 4 + h]) * LOG2E; }
        if (F.tid < 4) W.tab[1024 + F.tid] = __expf(rb[15 * 4 + F.tid] - rb[31 * 4 + F.tid]);
        if (F.tid >= 64 && F.tid < 64 + DEPTH) { const int l = F.tid - 64; const float* lv = IN_[12] + l * 256; float s1 = 0.f, s2 = 0.f;
            for (int i = 0; i < 64; ++i) { s1 += lv[i] * lv[64 + i]; s2 += lv[128 + i] * lv[192 + i]; }
            W.tab[1032 + l] = expf(s1) - expf(s2) + (0.8f - 0.6f * expf(-0.3f * (float)l)); }
    }
    __syncthreads();
    LAS float* scr = (LAS float*)(F.lds + F.wave * 16384);
    const int gw = F.bid * NWAVES + F.wave, NGW = F.G * NWAVES;
    constexpr int I_IN = (NIN / 32) * 16, I_AB = 32 * 16, I_O = 32 * 16, I_1 = NE * 32 * 16, I_2 = NE * 32 * 8;
    constexpr int PER_L = I_IN + I_AB + I_O + I_1 + I_2;
    for (int it = gw; it < DEPTH * PER_L; it += NGW) {
        const int l = it / PER_L; int r = it % PER_L;
        if (r < I_IN) { const int rb = r / 16, kb = r % 16, R = rb * 32, tile = R >> 8, p0 = R & 255;
            if (tile == 6 || tile == 7) continue;
            tr_item(IN_[6] + (size_t)l * D * DIN, DIN, kb * 64, win_src_col(tile, p0), W.win + (size_t)l * NIN * D, D, R, kb * 64, scr, F.lane); continue; }
        r -= I_IN;
        if (r < I_AB) { const int rb = r / 16, kb = r % 16;
            if (kb < 8) tr_item(IN_[15] + (size_t)l * 512 * D, D, kb * 64, rb * 32, W.wab + (size_t)l * D * D, 512, rb * 32, kb * 64, scr, F.lane);
            else tr_item(IN_[16] + (size_t)l * 512 * D, D, (kb - 8) * 64, rb * 32, W.wab + (size_t)l * D * D + (size_t)1024 * 512, 512, rb * 32, (kb - 8) * 64, scr, F.lane);
            continue; }
        r -= I_AB;
        if (r < I_O) { const int rb = r / 16, kb = r % 16; tr_item(IN_[17] + (size_t)l * D * D, D, kb * 64, rb * 32, W.wo + (size_t)l * D * D, D, rb * 32, kb * 64, scr, F.lane); continue; }
        r -= I_O;
        if (r < I_1) { const int e = r / 512, q = r % 512, rb = q / 16, kb = q % 16, R = rb * 32, pn = R >> 8, p = R & 255;
            const int col = (p < 128) ? (128 * pn + p) : (512 + 128 * pn + p - 128);
#if MK_MOE_FP8
            tr_item8(IN_[22] + ((size_t)l * NE + e) * D * 1024, 1024, kb * 64, col, (unsigned char*)W.w1 + ((size_t)l * NE + e) * 1024 * D, D, R, kb * 64, WSCALE, scr, F.lane); continue; }
#else
            tr_item(IN_[22] + ((size_t)l * NE + e) * D * 1024, 1024, kb * 64, col, W.w1 + ((size_t)l * NE + e) * 1024 * D, D, R, kb * 64, scr, F.lane); continue; }
#endif
        r -= I_1;
        { const int e = r / 256, q = r % 256, rb = q / 8, kb = q % 8;
#if MK_MOE_FP8
          tr_item8(IN_[23] + ((size_t)l * NE + e) * DE * D, D, kb * 64, rb * 32, (unsigned char*)W.w2 + ((size_t)l * NE + e) * D * DE, DE, rb * 32, kb * 64, WSCALE, scr, F.lane); }
#else
          tr_item(IN_[23] + ((size_t)l * NE + e) * DE * D, D, kb * 64, rb * 32, W.w2 + ((size_t)l * NE + e) * D * DE, DE, rb * 32, kb * 64, scr, F.lane); }
#endif
    }
    for (int it = gw; it < DEPTH * 2 * 8 * 16; it += NGW) {
        const int l = it >> 8, dir = (it >> 7) & 1, nbk = (it >> 4) & 7, kb = it & 15; const int k = kb * 64 + F.lane;
        const float* wi = IN_[6] + (size_t)l * D * DIN + (size_t)k * DIN + (dir ? O_LRB : O_LRF);
        float wv[16];
#pragma unroll
        for (int r = 0; r < 16; ++r) wv[r] = wi[r];
        const float* wu = IN_[7] + ((size_t)l * 2 + dir) * 16 * 256;
        bf16* dst = W.win + (size_t)l * NIN * D + (size_t)((6 + dir) * 256) * D;
        for (int n = nbk * 32; n < nbk * 32 + 32; ++n) { float s = 0.f;
#pragma unroll
            for (int r = 0; r < 16; ++r) s += wv[r] * wu[r * 256 + n];
            dst[(size_t)n * D + k] = (bf16)(cvt_pk(s, 0.f) & 0xffffu); }
    }
    for (int it = gw * 64 + F.lane; it < DEPTH * 256 * 128; it += NGW * 64) {
        const int l = it / (256 * 128), q = it % (256 * 128), row = q >> 7, k0 = (q & 127) * 8;
        float v[8];
#pragma unroll
        for (int i = 0; i < 8; ++i) { float x = 0.f;
            if (row < 4) x = IN_[18][((size_t)l * D + k0 + i) * 4 + row]; else if (row < 36) x = IN_[20][((size_t)l * D + k0 + i) * 32 + row - 4];
            v[i] = x; }
        u32x4 o; o.x = cvt_pk(v[0], v[1]); o.y = cvt_pk(v[2], v[3]); o.z = cvt_pk(v[4], v[5]); o.w = cvt_pk(v[6], v[7]);
        *(u32x4*)(W.wr + ((size_t)l * 256 + row) * D + k0) = o;
    }
}

__device__ __forceinline__ void phase_norm(Frame& F, int l, int mode) {
    refresh(F);
    const WS W = ws_map(F.ws, F.nb); const float* const* IN_ = F.a->in;
    const int gw = F.bid * NWAVES + F.wave, NGW = F.G * NWAVES;
    const bool combine = (mode == 2) || (mode == 0 && l > 0);
    const bool from_in = (mode == 0 && l == 0);
    const int lp = (mode == 2) ? DEPTH - 1 : l - 1;
    const float* ng = (mode == 1 ? IN_[5] : IN_[4]) + (size_t)(mode == 2 ? 0 : l) * D;
    for (int t = gw; t < F.T; t += NGW) {
        const int b = t / SEQ;
        f32x4 v[4];
        if (from_in) { const GAS f32x4* xr = (const GAS f32x4*)(IN_[0] + (size_t)t * D) + F.lane;
#pragma unroll
            for (int j = 0; j < 4; ++j) v[j] = xr[64 * j]; }
        else { const GAS u32x2* xr = (const GAS u32x2*)(W.XB + (size_t)t * D) + F.lane;
#pragma unroll
            for (int j = 0; j < 4; ++j) { const u32x2 a = xr[64 * j]; v[j] = (f32x4){bflo(a.x), bfhi(a.x), bflo(a.y), bfhi(a.y)}; } }
        if (combine) {
            const float* g2 = W.mod + ((size_t)lp * NBMAX + b) * 6 * D + 5 * D;
            const int p0 = W.pos[t * 2], p1 = W.pos[t * 2 + 1];
            const GAS unsigned* y0 = (const GAS unsigned*)((const unsigned char*)W.YS + (size_t)p0 * D) + F.lane; const GAS unsigned* y1 = (const GAS unsigned*)((const unsigned char*)W.YS + (size_t)p1 * D) + F.lane;
#pragma unroll
            for (int j = 0; j < 4; ++j) { const unsigned a = y0[64 * j], c = y1[64 * j]; const f32x4 g = *((const GAS f32x4*)g2 + F.lane + 64 * j) * (1.f / YSCALE);
                v[j].x += g.x * (__builtin_amdgcn_cvt_f32_fp8((int)a, 0) + __builtin_amdgcn_cvt_f32_fp8((int)c, 0)); v[j].y += g.y * (__builtin_amdgcn_cvt_f32_fp8((int)a, 1) + __builtin_amdgcn_cvt_f32_fp8((int)c, 1));
                v[j].z += g.z * (__builtin_amdgcn_cvt_f32_fp8((int)a, 2) + __builtin_amdgcn_cvt_f32_fp8((int)c, 2)); v[j].w += g.w * (__builtin_amdgcn_cvt_f32_fp8((int)a, 3) + __builtin_amdgcn_cvt_f32_fp8((int)c, 3)); }
            if (mode == 2) { GAS f32x4* xo = (GAS f32x4*)(F.xbuf + (size_t)t * D) + F.lane;
#pragma unroll
                for (int j = 0; j < 4; ++j) xo[64 * j] = v[j]; }
            else { GAS u32x2* xo = (GAS u32x2*)(W.XB + (size_t)t * D) + F.lane;
#pragma unroll
                for (int j = 0; j < 4; ++j) { u32x2 o; o.x = cvt_pk(v[j].x, v[j].y); o.y = cvt_pk(v[j].z, v[j].w); xo[64 * j] = o; } }
        }
        if (mode == 2) continue;
        float ss = 0.f;
#pragma unroll
        for (int j = 0; j < 4; ++j) ss += (v[j].x * v[j].x + v[j].y * v[j].y) + (v[j].z * v[j].z + v[j].w * v[j].w);
        const float rstd = rsqrtf(wave_sum(ss) * (1.f / D) + RMS_EPS);
        const float* md = W.mod + ((size_t)l * NBMAX + b) * 6 * D + (mode == 1 ? 3 * D : 0);
        GAS u32x2* ho = (GAS u32x2*)(W.H + (size_t)t * D) + F.lane;
#pragma unroll
        for (int j = 0; j < 4; ++j) { const f32x4 g = *((const GAS f32x4*)ng + F.lane + 64 * j), sh = *((const GAS f32x4*)md + F.lane + 64 * j), sc = *((const GAS f32x4*)(md + D) + F.lane + 64 * j);
            const float h0 = v[j].x * rstd * g.x * (1.f + sc.x) + sh.x, h1 = v[j].y * rstd * g.y * (1.f + sc.y) + sh.y, h2 = v[j].z * rstd * g.z * (1.f + sc.z) + sh.z, h3 = v[j].w * rstd * g.w * (1.f + sc.w) + sh.w;
            u32x2 o; o.x = cvt_pk(h0, h1); o.y = cvt_pk(h2, h3); ho[64 * j] = o; }
    }
}
typedef pg8::Unit Unit;
__device__ __forceinline__ u32x4 pack8(const f32x4& a, const f32x4& b) { u32x4 w; w.x = cvt_pk(a[0], a[1]); w.y = cvt_pk(a[2], a[3]); w.z = cvt_pk(b[0], b[1]); w.w = cvt_pk(b[2], b[3]); return w; }

#ifndef MK_ATT_FP8
#define MK_ATT_FP8 1
#endif
__device__ __forceinline__ u32x2 pack8_fp8(const f32x4& a, const f32x4& b) { int w0 = 0, w1 = 0;
    w0 = __builtin_amdgcn_cvt_pk_fp8_f32(a[0], a[1], w0, false); w0 = __builtin_amdgcn_cvt_pk_fp8_f32(a[2], a[3], w0, true);
    w1 = __builtin_amdgcn_cvt_pk_fp8_f32(b[0], b[1], w1, false); w1 = __builtin_amdgcn_cvt_pk_fp8_f32(b[2], b[3], w1, true);
    u32x2 r; r.x = (unsigned)w0; r.y = (unsigned)w1; return r; }
struct EpiNull {
    static constexpr bool PERM = true, AFTER_DRAIN = false, MIDK = false;
    __device__ __forceinline__ void operator()(const f32x4 (&acc)[2][2][4][2], const Unit&, int, int, int, int) const {
#pragma unroll
        for (int a = 0; a < 2; ++a)
#pragma unroll
            for (int b = 0; b < 2; ++b)
#pragma unroll
                for (int m = 0; m < 4; ++m) { asm volatile("" :: "v"(acc[a][b][m][0]), "v"(acc[a][b][m][1])); } }
};
struct EpiIn {
    static constexpr bool PERM = true, AFTER_DRAIN = false, MIDK = false;
    bf16 *GQ, *GK, *GV, *SG, *LGF, *LGB, *DQ, *DK, *DV, *SGA, *SGB; const float* b_up; const float* qg; const float* kg; int plain;
    __device__ __forceinline__ void operator()(const f32x4 (&acc)[2][2][4][2], const Unit& u, int wr, int wc, int fr, int fq) const {
        const int pn = u.pn; const int row0 = u.pm * 256 + wr * 64 + fr;
        if (pn >= 8 && pn <= 11) {
            const bool isk = pn >= 10; const int head = 2 * ((pn - 8) & 1) + (wc >> 1), c = wc & 1;
            const float* gv = isk ? kg : qg; const float sc = isk ? 1.f : QSCALE;
            f32x4 g[2][2];
#pragma unroll
            for (int bj = 0; bj < 2; ++bj)
#pragma unroll
                for (int n = 0; n < 2; ++n) g[bj][n] = *(const f32x4*)(gv + 32 * bj + 8 * fq + 4 * n);
#pragma unroll
            for (int ai = 0; ai < 2; ++ai)
#pragma unroll
                for (int m = 0; m < 4; ++m) {
                    const int r = row0 + ai * 128 + m * 16, b = r / SEQ, s = r % SEQ;
                    float ss = 0.f;
#pragma unroll
                    for (int bj = 0; bj < 2; ++bj)
#pragma unroll
                        for (int n = 0; n < 2; ++n) { const f32x4 x = acc[ai][bj][m][n]; ss += (x[0] * x[0] + x[1] * x[1]) + (x[2] * x[2] + x[3] * x[3]); }
                    ss += __shfl_xor(ss, 16); ss += __shfl_xor(ss, 32);
                    const float rs = rsqrtf(ss * (1.f / 64.f) + RMS_EPS) * sc;
#if MK_ATT_FP8
                    unsigned char* dst8 = (unsigned char*)(isk ? DK : DQ) + ((((size_t)b * NH + head) * 2 + c) * SEQ + s) * 64;
#pragma unroll
                    for (int bj = 0; bj < 2; ++bj) {
                        const f32x4 v0 = acc[ai][bj][m][0] * rs * g[bj][0], v1 = acc[ai][bj][m][1] * rs * g[bj][1];
                        int chunk = 2 * bj + (fq >> 1); if (isk) chunk ^= ((s >> 2) & 3);
                        *(u32x2*)(dst8 + chunk * 16 + 8 * (fq & 1)) = pack8_fp8(v0, v1);
                    }
#else
                    bf16* dst = (isk ? DK : DQ) + ((((size_t)b * NH + head) * 2 + c) * SEQ + s) * 64;
#pragma unroll
                    for (int bj = 0; bj < 2; ++bj) {
                        const f32x4 v0 = acc[ai][bj][m][0] * rs * g[bj][0], v1 = acc[ai][bj][m][1] * rs * g[bj][1];
                        int chunk = 4 * bj + fq; if (isk) chunk ^= ((s >> 1) & 7);
                        *(u32x4*)(dst + chunk * 8) = pack8(v0, v1);
                    }
#endif
                }
            return;
        }
#pragma unroll
        for (int ai = 0; ai < 2; ++ai)
#pragma unroll
            for (int m = 0; m < 4; ++m) {
                const int r = row0 + ai * 128 + m * 16;
#pragma unroll
                for (int bj = 0; bj < 2; ++bj) {
                    const int c0 = 128 * bj + 32 * wc + 8 * fq;
                    f32x4 v0 = acc[ai][bj][m][0], v1 = acc[ai][bj][m][1];
                    if (plain) { *(u32x4*)(SGA + (size_t)r * D + (pn & 3) * 256 + c0) = pack8(v0, v1); }
                    else if (pn == 0) { *(u32x4*)(GQ + (size_t)r * 256 + c0) = pack8(v0 * 0.125f, v1 * 0.125f); }
                    else if (pn == 1) { *(u32x4*)(GK + (size_t)r * 256 + c0) = pack8(v0, v1); }
                    else if (pn <= 3) { *(u32x4*)(GV + (size_t)r * 512 + (pn - 2) * 256 + c0) = pack8(v0, v1); }
                    else if (pn <= 5) {
#pragma unroll
                        for (int i = 0; i < 4; ++i) { v0[i] = fsilu(v0[i]); v1[i] = fsilu(v1[i]); }
                        *(u32x4*)(SG + (size_t)r * 512 + (pn - 4) * 256 + c0) = pack8(v0, v1); }
                    else if (pn <= 7) {
                        const float* bu = b_up + (pn - 6) * 256 + c0; const f32x4 b0 = *(const f32x4*)bu, b1 = *(const f32x4*)(bu + 4);
#pragma unroll
                        for (int i = 0; i < 4; ++i) { float z = v0[i] + b0[i]; v0[i] = (fminf(z, 0.f) - __logf(1.f + __expf(-fabsf(z)))) * (1.f / 16.f);
                                                      z = v1[i] + b1[i]; v1[i] = (fminf(z, 0.f) - __logf(1.f + __expf(-fabsf(z)))) * (1.f / 16.f); }
                        *(u32x4*)((pn == 6 ? LGF : LGB) + (size_t)r * 256 + c0) = pack8(v0, v1); }
#if MK_ATT_FP8
                    else if (pn <= 13) {
                        const int b = r / SEQ, s = r % SEQ, head = 2 * (pn - 12) + bj;
                        const int kk = s & 63, wkey = kk & 31, hh_ = (wkey >> 2) & 1, reg_ = (wkey & 3) + 4 * (wkey >> 3), pos = hh_ * 32 + 16 * (kk >> 5) + reg_;
                        unsigned char* tb = (unsigned char*)DV + (((size_t)b * NH + head) * (SEQ / 64) + (s >> 6)) * 8192;
                        const u32x2 pk = pack8_fp8(v0, v1); const int dv0 = 32 * wc + 8 * fq;
#pragma unroll
                        for (int i = 0; i < 8; ++i) { const int dv = dv0 + i; const unsigned byte = ((i < 4 ? pk.x : pk.y) >> (8 * (i & 3))) & 0xffu;
                            tb[dv * 64 + ((((pos >> 4) ^ ((dv >> 2) & 3)) << 4) | (pos & 15))] = (unsigned char)byte; } }
#else
                    else if (pn <= 13) {
                        const int b = r / SEQ, s = r % SEQ, head = 2 * (pn - 12) + bj;
                        bf16* dst = DV + ((((size_t)b * NH + head) * (SEQ / 8) + (s >> 3)) * 4 + wc) * 256 + (s & 7) * 32 + 8 * fq;
                        *(u32x4*)dst = pack8(v0, v1); }
#endif
                    else {
#pragma unroll
                        for (int i = 0; i < 4; ++i) { v0[i] = fsigmoid(v0[i]); v1[i] = fsigmoid(v1[i]); }
                        bf16* base = (pn <= 17) ? SGA + (pn - 14) * 256 : SGB + (pn - 18) * 256;
                        *(u32x4*)(base + (size_t)r * D + c0) = pack8(v0, v1); }
                }
            }
    }
};

struct EpiMerge {
    static constexpr bool PERM = true, AFTER_DRAIN = false, MIDK = false;
    const bf16* SGA; const bf16* SGB; bf16* O; int nM;
    __device__ __forceinline__ void operator()(const f32x4 (&acc)[2][2][4][2], const Unit& u, int wr, int wc, int fr, int fq) const {
        const int sel = u.pn >> 2; const int row0 = (u.pm - sel * nM) * 256 + wr * 64 + fr, col0 = (u.pn & 3) * 256 + wc * 32 + 8 * fq;
        const bf16* G = sel ? SGB : SGA;
#pragma unroll
        for (int ai = 0; ai < 2; ++ai) {
            u32x4 gt[4][2], t1[4][2];
#pragma unroll
            for (int m = 0; m < 4; ++m) { const size_t off = (size_t)(row0 + ai * 128 + m * 16) * D + col0;
#pragma unroll
                for (int bj = 0; bj < 2; ++bj) { gt[m][bj] = *(const u32x4*)(G + off + bj * 128); if (sel) t1[m][bj] = *(const u32x4*)(O + off + bj * 128); } }
#pragma unroll
            for (int m = 0; m < 4; ++m) { const size_t off = (size_t)(row0 + ai * 128 + m * 16) * D + col0;
#pragma unroll
                for (int bj = 0; bj < 2; ++bj) { const u32x4 b = gt[m][bj];
                    f32x4 v0 = acc[ai][bj][m][0], v1 = acc[ai][bj][m][1];
                    v0[0] *= bflo(b.x); v0[1] *= bfhi(b.x); v0[2] *= bflo(b.y); v0[3] *= bfhi(b.y); v1[0] *= bflo(b.z); v1[1] *= bfhi(b.z); v1[2] *= bflo(b.w); v1[3] *= bfhi(b.w);
                    if (sel) { const u32x4 t = t1[m][bj];
                        v0[0] += bflo(t.x); v0[1] += bfhi(t.x); v0[2] += bflo(t.y); v0[3] += bfhi(t.y); v1[0] += bflo(t.z); v1[1] += bfhi(t.z); v1[2] += bflo(t.w); v1[3] += bfhi(t.w); }
                    *(u32x4*)(O + off + bj * 128) = pack8(v0, v1); } }
            asm volatile("" ::: "memory");
        }
    }
};
struct MergeOrder {
    pg8::StaticOrder so; int nM;
    __device__ __forceinline__ bool next(int i, Unit& u) const { Unit t; if (!so.next(i >> 1, t)) return false; const int sel = i & 1; u.pm = t.pm + sel * nM; u.pn = t.pn + sel * 4; return true; }
    __device__ __forceinline__ void a_ready(const Unit&) const {}
    __device__ __forceinline__ void done(const Unit&) const {}
};

struct EpiResid {
    static constexpr bool PERM = true, AFTER_DRAIN = false, MIDK = false;
    const float* xin32; bf16* xb; const float* g1;
    __device__ __forceinline__ void operator()(const f32x4 (&acc)[2][2][4][2], const Unit& u, int wr, int wc, int fr, int fq) const {
        const int row0 = u.pm * 256 + wr * 64 + fr, col0 = u.pn * 256 + wc * 32 + 8 * fq;
        const int b = (u.pm * 256) / SEQ; const float* g = g1 + (size_t)b * 6 * D + col0;
        f32x4 gv[2][2];
#pragma unroll
        for (int bj = 0; bj < 2; ++bj)
#pragma unroll
            for (int n = 0; n < 2; ++n) gv[bj][n] = *(const f32x4*)(g + bj * 128 + n * 4);
        if (xin32) {
#pragma unroll
            for (int ai = 0; ai < 2; ++ai)
#pragma unroll
                for (int mh = 0; mh < 2; ++mh) { f32x4 x0[2][2], x1[2][2];
#pragma unroll
                    for (int m2 = 0; m2 < 2; ++m2) { const size_t off = (size_t)(row0 + ai * 128 + (2 * mh + m2) * 16) * D + col0;
#pragma unroll
                        for (int bj = 0; bj < 2; ++bj) { x0[m2][bj] = *(const f32x4*)(xin32 + off + bj * 128); x1[m2][bj] = *(const f32x4*)(xin32 + off + bj * 128 + 4); } }
#pragma unroll
                    for (int m2 = 0; m2 < 2; ++m2) { const int m = 2 * mh + m2; const size_t off = (size_t)(row0 + ai * 128 + m * 16) * D + col0;
#pragma unroll
                        for (int bj = 0; bj < 2; ++bj) *(u32x4*)(xb + off + bj * 128) = pack8(x0[m2][bj] + gv[bj][0] * acc[ai][bj][m][0], x1[m2][bj] + gv[bj][1] * acc[ai][bj][m][1]); }
                    asm volatile("" ::: "memory"); }
        } else {
#pragma unroll
            for (int ai = 0; ai < 2; ++ai) { u32x4 xr[4][2];
#pragma unroll
                for (int m = 0; m < 4; ++m) { const size_t off = (size_t)(row0 + ai * 128 + m * 16) * D + col0;
#pragma unroll
                    for (int bj = 0; bj < 2; ++bj) xr[m][bj] = *(const u32x4*)(xb + off + bj * 128); }
#pragma unroll
                for (int m = 0; m < 4; ++m) { const size_t off = (size_t)(row0 + ai * 128 + m * 16) * D + col0;
#pragma unroll
                    for (int bj = 0; bj < 2; ++bj) { const u32x4 a = xr[m][bj];
                        const f32x4 x0 = {bflo(a.x), bfhi(a.x), bflo(a.y), bfhi(a.y)}, x1 = {bflo(a.z), bfhi(a.z), bflo(a.w), bfhi(a.w)};
                        *(u32x4*)(xb + off + bj * 128) = pack8(x0 + gv[bj][0] * acc[ai][bj][m][0], x1 + gv[bj][1] * acc[ai][bj][m][1]); } }
                asm volatile("" ::: "memory"); }
        }
    }
};

struct EpiLogits {
    static constexpr bool PERM = false, AFTER_DRAIN = false, MIDK = false;
    float* L;
    __device__ __forceinline__ void operator()(const f32x4 (&acc)[2][2][4][2], const Unit& u, int wr, int wc, int fr, int fq) const {
        if (wc >= 2) return;
        const int row0 = u.pm * 256 + wr * 64 + fr, col0 = wc * 32 + 4 * fq;
#pragma unroll
        for (int ai = 0; ai < 2; ++ai)
#pragma unroll
            for (int m = 0; m < 4; ++m)
#pragma unroll
                for (int n = 0; n < 2; ++n) *(f32x4*)(L + (size_t)(row0 + ai * 128 + m * 16) * 64 + col0 + n * 16) = acc[ai][0][m][n];
    }
};

#ifndef MK_MOE_FP8
#define MK_MOE_FP8 0
#endif
#if MK_MOE_FP8
struct EpiAct {
    static constexpr bool PERM = true, AFTER_DRAIN = false, MIDK = false;
    unsigned char* ACT;
    __device__ __forceinline__ void operator()(const f32x4 (&acc)[2][2][4][2], const Unit& u, int wr, int wc, int fr, int fq) const {
        const int row0 = u.pm * 256 + wr * 64 + fr, col0 = (u.pn & 3) * 128 + wc * 32 + 8 * fq;
        constexpr float inv = 1.f / WSCALE;
#pragma unroll
        for (int ai = 0; ai < 2; ++ai)
#pragma unroll
            for (int m = 0; m < 4; ++m) { f32x4 v0, v1;
#pragma unroll
                for (int i = 0; i < 4; ++i) { v0[i] = fsilu(acc[ai][0][m][0][i] * inv) * acc[ai][1][m][0][i] * (inv * ASCALE); v1[i] = fsilu(acc[ai][0][m][1][i] * inv) * acc[ai][1][m][1][i] * (inv * ASCALE); }
                *(u32x2*)(ACT + (size_t)(row0 + ai * 128 + m * 16) * DE + col0) = pack8_fp8(v0, v1); }
    }
};
struct EpiYs {
    static constexpr bool PERM = true, AFTER_DRAIN = false, MIDK = false;
    bf16* YS; const float* gs;
    __device__ __forceinline__ void operator()(const f32x4 (&acc)[2][2][4][2], const Unit& u, int wr, int wc, int fr, int fq) const {
        const int row0 = u.pm * 256 + wr * 64 + fr, col0 = (u.pn & 3) * 256 + wc * 32 + 8 * fq;
#pragma unroll
        for (int ai = 0; ai < 2; ++ai)
#pragma unroll
            for (int m = 0; m < 4; ++m) { const int r = row0 + ai * 128 + m * 16; const float gt = gs[r] * (1.f / (WSCALE * ASCALE));
#pragma unroll
                for (int bj = 0; bj < 2; ++bj) *(u32x4*)(YS + (size_t)r * D + col0 + bj * 128) = pack8(acc[ai][bj][m][0] * gt, acc[ai][bj][m][1] * gt); }
    }
};
#else
struct EpiAct {
    static constexpr bool PERM = true, AFTER_DRAIN = false, MIDK = false;
    bf16* ACT;
    __device__ __forceinline__ void operator()(const f32x4 (&acc)[2][2][4][2], const Unit& u, int wr, int wc, int fr, int fq) const {
        const int row0 = u.pm * 256 + wr * 64 + fr, col0 = (u.pn & 3) * 128 + wc * 32 + 8 * fq;
#pragma unroll
        for (int ai = 0; ai < 2; ++ai)
#pragma unroll
            for (int m = 0; m < 4; ++m) { f32x4 v0, v1;
#pragma unroll
                for (int i = 0; i < 4; ++i) { v0[i] = fsilu(acc[ai][0][m][0][i]) * acc[ai][1][m][0][i]; v1[i] = fsilu(acc[ai][0][m][1][i]) * acc[ai][1][m][1][i]; }
                *(u32x4*)(ACT + (size_t)(row0 + ai * 128 + m * 16) * DE + col0) = pack8(v0, v1); }
    }
};
struct EpiYs {
    static constexpr bool PERM = true, AFTER_DRAIN = false, MIDK = false;
    unsigned char* YS; const float* gs;
    __device__ __forceinline__ void operator()(const f32x4 (&acc)[2][2][4][2], const Unit& u, int wr, int wc, int fr, int fq) const {
        const int row0 = u.pm * 256 + wr * 64 + fr, col0 = (u.pn & 3) * 256 + wc * 32 + 8 * fq;
        float gts[2][4];
#pragma unroll
        for (int ai = 0; ai < 2; ++ai)
#pragma unroll
            for (int m = 0; m < 4; ++m) gts[ai][m] = gs[row0 + ai * 128 + m * 16] * YSCALE;
#pragma unroll
        for (int ai = 0; ai < 2; ++ai)
#pragma unroll
            for (int m = 0; m < 4; ++m) { const int r = row0 + ai * 128 + m * 16; const float gt = gts[ai][m];
#pragma unroll
                for (int bj = 0; bj < 2; ++bj) *(u32x2*)(YS + (size_t)r * D + col0 + bj * 128) = pack8_fp8(acc[ai][bj][m][0] * gt, acc[ai][bj][m][1] * gt); }
    }
};
#endif
struct GroupedOrder {
    const int* tilee; int U, G, c; const int* rowidx;
    __device__ __forceinline__ bool next(int i, Unit& u) const {
        int id;
        if ((G & 7) == 0) { const int gx = G >> 3, per = (U + 7) >> 3, n = i * gx + (c >> 3); if (n >= per) return false; id = (c & 7) * per + n; if (id >= U) return false; }
        else { id = i * G + c; if (id >= U) return false; }
        const int t = id >> 2; u.pm = t; u.pn = tilee[t] * 4 + (id & 3); return true;
    }
    __device__ __forceinline__ void a_ready(const Unit&) const {}
    __device__ __forceinline__ void done(const Unit&) const {}
};
constexpr int AT_KR = 0, AT_VR = 32768, AT_TAB = 65536, AT_SLOT = 8192;
typedef int v8i __attribute__((ext_vector_type(8)));
typedef int v4i __attribute__((ext_vector_type(4)));
__device__ __forceinline__ int crow(int r, int hi) { return (r & 3) + 8 * (r >> 2) + 4 * hi; }

__device__ __forceinline__ void attn_bias(f32x16& s0, f32x16& s1, int relbase, const LAS float* tabh) {
#pragma unroll
    for (int r = 0; r < 16; ++r) {
        int i0 = relbase + (r & 3) + 8 * (r >> 2); int i1 = i0 + 32;
        i0 = i0 < 0 ? 0 : (i0 > 255 ? 255 : i0); i1 = i1 < 0 ? 0 : (i1 > 255 ? 255 : i1);
        s0[r] += tabh[i0]; s1[r] += tabh[i1];
    }
}
template <int J>
__device__ __forceinline__ void attn_exp_chunk(f32x16& s0, f32x16& s1, float& lsum) {
    float ls = 0.f;
#pragma unroll
    for (int r = 4 * J; r < 4 * J + 4; ++r) { s0[r] = __builtin_amdgcn_exp2f(s0[r]); s1[r] = __builtin_amdgcn_exp2f(s1[r]); }
    (void)ls; (void)lsum;
}
__device__ __forceinline__ int pk4_bf8(float a, float b, float c, float d) { int w = 0; w = __builtin_amdgcn_cvt_pk_bf8_f32(a, b, w, false); w = __builtin_amdgcn_cvt_pk_bf8_f32(c, d, w, true); return w; }
__device__ __forceinline__ void glds16(const void* gsrc, unsigned lds_dst) { unsigned keep;
    asm volatile("s_mov_b32 %0, m0\n\ts_mov_b32 m0, %2\n\ts_nop 0\n\tglobal_load_lds_dwordx4 %1, off\n\ts_mov_b32 m0, %0" : "=&s"(keep) : "v"(gsrc), "s"(lds_dst) : "memory"); }
__device__ __forceinline__ void attn_dma_k(unsigned lds0, const unsigned char* kg0, int t, int slot, int wid, int lane) {
    glds16(kg0 + (size_t)(wid >> 2) * SEQ * 64 + (size_t)t * 4096 + (wid & 3) * 1024 + lane * 16, (unsigned)__builtin_amdgcn_readfirstlane((int)(lds0 + AT_KR + slot * AT_SLOT + wid * 1024)));
}
__device__ __forceinline__ void attn_dma_v(unsigned lds0, const unsigned char* vg0, int t, int slot, int wid, int lane) {
    glds16(vg0 + (size_t)t * 8192 + wid * 1024 + lane * 16, (unsigned)__builtin_amdgcn_readfirstlane((int)(lds0 + AT_VR + slot * AT_SLOT + wid * 1024)));
}
#define AT_RD128(dst, addr, off) asm volatile("ds_read_b128 %0, %1 offset:%c2" : "=&v"(dst) : "v"(addr), "i"(off) : "memory")
#define AT_MFMA8(a, b, c) __builtin_amdgcn_mfma_scale_f32_32x32x64_f8f6f4(a, b, c, 0, 0, 0, 0, 0, 0)
#define AT_MFMA8B(a, b, c) __builtin_amdgcn_mfma_scale_f32_32x32x64_f8f6f4(a, b, c, 0, 1, 0, 0, 0, 0)

template <int VAR>
__device__ __forceinline__ void phase_attn(Frame& F, int l) {
    refresh(F);
    const WS W = ws_map(F.ws, F.nb); const float* const* IN_ = F.a->in; (void)IN_; (void)W;
    const int lane = F.lane, wid = F.wave, r32 = lane & 31, hh = lane >> 5, qg = wid & 3, c = wid >> 2;
    LAS unsigned char* lds = F.lds; const unsigned lds0 = (unsigned)(unsigned long)lds;
    LAS float* tab = (LAS float*)(lds + AT_TAB);
    for (int i = F.tid; i < 1028; i += NTHR) tab[i] = W.tab[i];
    const float lam = W.tab[1032 + l]; const float lam_init = 0.8f - 0.6f * __expf(-0.3f * (float)l);
    const float* subg = IN_[13] + l * 128;
    const int U = F.nb * NH * 64;
    const int gx = F.G >> 3, per = U >> 3;
    const int sw = (r32 >> 2) & 3;
    const unsigned ka0 = lds0 + AT_KR + c * 4096 + r32 * 64 + (((2 * hh) ^ sw) << 4), ka1 = lds0 + AT_KR + c * 4096 + r32 * 64 + (((2 * hh + 1) ^ sw) << 4);
    const unsigned va0 = lds0 + AT_VR + r32 * 64 + (((2 * hh) ^ sw) << 4), va1 = lds0 + AT_VR + r32 * 64 + (((2 * hh + 1) ^ sw) << 4);
#ifndef MK_ATT_1BAR
#define MK_ATT_1BAR 1
#endif
    const bool lag = (MK_ATT_1BAR == 0) && wid >= 4;
    __syncthreads();
    for (int i = 0;; ++i) {
        int id;
        if ((F.G & 7) == 0) { const int n = i * gx + (F.bid >> 3); if (n >= per) break; id = (F.bid & 7) * per + n; }
        else { id = i * F.G + F.bid; if (id >= U) break; }
        const int bh = id >> 6, qb = id & 63, b = bh >> 2, h = bh & 3;
        const int qw0 = qb * 128 + 32 * qg;
        const unsigned char* kg0 = (const unsigned char*)W.DK + ((size_t)bh * 2) * SEQ * 64;
        const unsigned char* vg0 = (const unsigned char*)W.DV + (size_t)bh * SEQ * 128;
        v8i qf; { const unsigned char* qp = (const unsigned char*)W.DQ + (((size_t)bh * 2 + c) * SEQ + qw0 + r32) * 64 + 32 * hh;
            const v4i q0 = *(const v4i*)qp, q1 = *(const v4i*)(qp + 16); qf = (v8i){q0[0], q0[1], q0[2], q0[3], q1[0], q1[1], q1[2], q1[3]}; }
        asm volatile("s_waitcnt vmcnt(0)" ::: "memory");
        attn_dma_k(lds0, kg0, 0, 0, wid, lane); attn_dma_k(lds0, kg0, 1, 1, wid, lane); attn_dma_v(lds0, vg0, 0, 0, wid, lane); attn_dma_k(lds0, kg0, 2, 2, wid, lane);
        attn_dma_v(lds0, vg0, 1, 1, wid, lane); attn_dma_k(lds0, kg0, 3, 3, wid, lane); attn_dma_v(lds0, vg0, 2, 2, wid, lane);
        f32x16 o[4]; f32x16 osum = f32x16{};
#pragma unroll
        for (int dt = 0; dt < 4; ++dt) o[dt] = f32x16{};
        float lsum = 0.f;
        const v8i ones8 = {0x38383838, 0x38383838, 0x38383838, 0x38383838, 0x38383838, 0x38383838, 0x38383838, 0x38383838};
        const int tL = (qw0 >= 154) ? ((qw0 - 154) >> 6) + 1 : 0, tR = (qw0 + 185) >> 6;
        const float shl = tab[1024 + h];
        const LAS float* tabh = tab + h * 256;
        const int rel0 = -qw0 - r32 + 4 * hh + 128;
        const f32x16 cshift = {-4.f, -4.f, -4.f, -4.f, -4.f, -4.f, -4.f, -4.f, -4.f, -4.f, -4.f, -4.f, -4.f, -4.f, -4.f, -4.f};
        asm volatile("s_waitcnt vmcnt(4)" ::: "memory"); __builtin_amdgcn_s_barrier(); asm volatile("" ::: "memory");
        f32x16 sc0, sc1, sn0, sn1; v8i p; v4i kx[4];
        AT_RD128(kx[0], ka0, 0); AT_RD128(kx[1], ka1, 0); AT_RD128(kx[2], ka0, 2048); AT_RD128(kx[3], ka1, 2048);
        asm volatile("s_waitcnt lgkmcnt(0)" ::: "memory"); __builtin_amdgcn_sched_barrier(0);
        sc0 = AT_MFMA8(((v8i){kx[0][0], kx[0][1], kx[0][2], kx[0][3], kx[1][0], kx[1][1], kx[1][2], kx[1][3]}), qf, cshift);
        sc1 = AT_MFMA8(((v8i){kx[2][0], kx[2][1], kx[2][2], kx[2][3], kx[3][0], kx[3][1], kx[3][2], kx[3][3]}), qf, cshift);
        __builtin_amdgcn_s_barrier(); asm volatile("" ::: "memory");
        if (lag) { __builtin_amdgcn_s_barrier(); asm volatile("" ::: "memory"); }
#define AT_STEP(SL, t) do { \
            { const int tk = (t) + 4 < 128 ? (t) + 4 : 127; attn_dma_k(lds0, kg0, tk, SL, wid, lane); } \
            asm volatile("s_waitcnt vmcnt(4)" ::: "memory");                                                       \
            AT_RD128(kx[0], ka0, ((SL + 1) & 3) * AT_SLOT); AT_RD128(kx[1], ka1, ((SL + 1) & 3) * AT_SLOT);        \
            AT_RD128(kx[2], ka0, ((SL + 1) & 3) * AT_SLOT + 2048); AT_RD128(kx[3], ka1, ((SL + 1) & 3) * AT_SLOT + 2048); \
            if ((t) >= tL && (t) < tR) attn_bias(sc0, sc1, 64 * (t) + rel0, tabh);                                \
            attn_exp_chunk<0>(sc0, sc1, lsum); attn_exp_chunk<1>(sc0, sc1, lsum);                                 \
            asm volatile("s_waitcnt lgkmcnt(0)" ::: "memory"); __builtin_amdgcn_sched_barrier(0); \
            sn0 = AT_MFMA8(((v8i){kx[0][0], kx[0][1], kx[0][2], kx[0][3], kx[1][0], kx[1][1], kx[1][2], kx[1][3]}), qf, cshift); \
            __builtin_amdgcn_sched_barrier(0); \
            attn_exp_chunk<2>(sc0, sc1, lsum); \
            __builtin_amdgcn_sched_barrier(0); \
            sn1 = AT_MFMA8(((v8i){kx[2][0], kx[2][1], kx[2][2], kx[2][3], kx[3][0], kx[3][1], kx[3][2], kx[3][3]}), qf, cshift); \
            __builtin_amdgcn_sched_barrier(0); \
            attn_exp_chunk<3>(sc0, sc1, lsum); \
            p[0] = pk4_bf8(sc0[0], sc0[1], sc0[2], sc0[3]); p[1] = pk4_bf8(sc0[4], sc0[5], sc0[6], sc0[7]); p[2] = pk4_bf8(sc0[8], sc0[9], sc0[10], sc0[11]); p[3] = pk4_bf8(sc0[12], sc0[13], sc0[14], sc0[15]); \
            p[4] = pk4_bf8(sc1[0], sc1[1], sc1[2], sc1[3]); p[5] = pk4_bf8(sc1[4], sc1[5], sc1[6], sc1[7]); p[6] = pk4_bf8(sc1[8], sc1[9], sc1[10], sc1[11]); p[7] = pk4_bf8(sc1[12], sc1[13], sc1[14], sc1[15]); \
            if (!MK_ATT_1BAR) { __builtin_amdgcn_s_barrier(); asm volatile("" ::: "memory"); } \
            { const int tv = (t) + 3 < 128 ? (t) + 3 : 127; attn_dma_v(lds0, vg0, tv, (SL + 3) & 3, wid, lane); } \
            asm volatile("s_waitcnt vmcnt(4)" ::: "memory");                                                       \
            { v4i vx[8]; \
              AT_RD128(vx[0], va0, SL * AT_SLOT); AT_RD128(vx[1], va1, SL * AT_SLOT); AT_RD128(vx[2], va0, SL * AT_SLOT + 2048); AT_RD128(vx[3], va1, SL * AT_SLOT + 2048); \
              AT_RD128(vx[4], va0, SL * AT_SLOT + 4096); AT_RD128(vx[5], va1, SL * AT_SLOT + 4096); AT_RD128(vx[6], va0, SL * AT_SLOT + 6144); AT_RD128(vx[7], va1, SL * AT_SLOT + 6144); \
              if ((t) == tL) { _Pragma("unroll") for (int dt = 0; dt < 4; ++dt) o[dt] *= shl; osum *= shl; } \
              osum = AT_MFMA8B(ones8, p, osum); \
              asm volatile("s_waitcnt lgkmcnt(4)" ::: "memory"); __builtin_amdgcn_sched_barrier(0); \
              o[0] = AT_MFMA8B(((v8i){vx[0][0], vx[0][1], vx[0][2], vx[0][3], vx[1][0], vx[1][1], vx[1][2], vx[1][3]}), p, o[0]); \
              o[1] = AT_MFMA8B(((v8i){vx[2][0], vx[2][1], vx[2][2], vx[2][3], vx[3][0], vx[3][1], vx[3][2], vx[3][3]}), p, o[1]); \
              asm volatile("s_waitcnt lgkmcnt(0)" ::: "memory"); __builtin_amdgcn_sched_barrier(0); \
              o[2] = AT_MFMA8B(((v8i){vx[4][0], vx[4][1], vx[4][2], vx[4][3], vx[5][0], vx[5][1], vx[5][2], vx[5][3]}), p, o[2]); \
              o[3] = AT_MFMA8B(((v8i){vx[6][0], vx[6][1], vx[6][2], vx[6][3], vx[7][0], vx[7][1], vx[7][2], vx[7][3]}), p, o[3]); } \
            sc0 = sn0; sc1 = sn1; \
            __builtin_amdgcn_s_barrier(); asm volatile("" ::: "memory"); } while (0)
        for (int t0 = 0; t0 < 128; t0 += 4) { AT_STEP(0, t0); AT_STEP(1, t0 + 1); AT_STEP(2, t0 + 2); AT_STEP(3, t0 + 3); }
#undef AT_STEP
        if (!lag && !MK_ATT_1BAR) { __builtin_amdgcn_s_barrier(); asm volatile("" ::: "memory"); }
        asm volatile("s_waitcnt vmcnt(0)" ::: "memory"); __builtin_amdgcn_s_barrier(); asm volatile("" ::: "memory");
        const float lt = osum[0];
        LAS float* xch = (LAS float*)(lds + qg * 16384);
        if (c == 1) { const float f = lam / lt;
#pragma unroll
            for (int dt = 0; dt < 4; ++dt)
#pragma unroll
                for (int r = 0; r < 16; ++r) xch[(dt * 16 + r) * 64 + lane] = o[dt][r] * f; }
        LDS_WAIT(); __builtin_amdgcn_s_barrier(); asm volatile("" ::: "memory");
        if (c == 0) { const float f = 1.f / lt; float ss = 0.f;
#pragma unroll
            for (int dt = 0; dt < 4; ++dt)
#pragma unroll
                for (int r = 0; r < 16; ++r) { const float v = o[dt][r] * f - xch[(dt * 16 + r) * 64 + lane]; o[dt][r] = v; ss += v * v; }
            ss += __shfl_xor(ss, 32);
            const float rn = rsqrtf(ss * (1.f / 128.f) + RMS_EPS) * (1.f - lam_init);
            bf16* orow = W.OAB + (size_t)F.T * 512 + ((size_t)b * SEQ + qw0 + r32) * 512 + h * 128;
#pragma unroll
            for (int dt = 0; dt < 4; ++dt)
#pragma unroll
                for (int g = 0; g < 4; ++g) { const int dv = 32 * dt + 8 * g + 4 * hh; const f32x4 sg = *(const f32x4*)(subg + dv);
                    u32x2 ov; ov.x = cvt_pk(o[dt][4 * g] * rn * sg[0], o[dt][4 * g + 1] * rn * sg[1]); ov.y = cvt_pk(o[dt][4 * g + 2] * rn * sg[2], o[dt][4 * g + 3] * rn * sg[3]);
                    *(u32x2*)(orow + dv) = ov; }
        }
        LDS_WAIT(); __builtin_amdgcn_s_barrier(); asm volatile("" ::: "memory");
    }
}
constexpr int GL_CUM = 0;
constexpr int GL_S64 = 144, GL_S192 = 400;
constexpr int G1_KEF = 34816, G1_KEB = G1_KEF + 64 * GL_S64, G1_VT = G1_KEB + 64 * GL_S64;
constexpr int G3_AOP = 34816, G3_KIF = G3_AOP + 64 * GL_S192, G3_KIB = G3_KIF + 64 * GL_S64, G3_BOP = G3_KIB + 64 * GL_S64;
static_assert(G3_BOP + 128 * GL_S192 <= 150 * 1024, "GLA LDS");

__device__ __forceinline__ bf16x8 lds_frag(const LAS unsigned char* base, int row, int stride, int kbyte) { return *(const LAS bf16x8*)(base + row * stride + kbyte); }

struct GlaIn { u32x2 lg[4]; u32x4 k, v0, v1, q, st[4], sg0, sg1; };
template <bool G3>
__device__ __forceinline__ void gla_load(const Frame& F, const WS& W, int u, GlaIn& r) {
    const int n = u & 127, bh = u >> 7, b = bh >> 2, h = bh & 3; const size_t trow0 = (size_t)b * SEQ + n * 64;
#pragma unroll
    for (int it = 0; it < 4; ++it) { const int idx = F.tid + it * NTHR; const int dir = idx >> 10, t = (idx >> 4) & 63, d4 = (idx & 15) * 4;
        r.lg[it] = *(const u32x2*)((dir ? W.LGB : W.LGF) + (trow0 + t) * 256 + h * 64 + d4); }
    const int t = F.tid >> 3, d0 = (F.tid & 7) * 8, v0 = (F.tid & 7) * 16;
    r.k = *(const u32x4*)(W.GK + (trow0 + t) * 256 + h * 64 + d0);
    r.v0 = *(const u32x4*)(W.GV + (trow0 + t) * 512 + h * 128 + v0); r.v1 = *(const u32x4*)(W.GV + (trow0 + t) * 512 + h * 128 + v0 + 8);
    if constexpr (G3) {
        r.q = *(const u32x4*)(W.GQ + (trow0 + t) * 256 + h * 64 + d0);
        const int dv = F.tid >> 2, dd0 = (F.tid & 3) * 16;
#pragma unroll
        for (int dir = 0; dir < 2; ++dir) { const bf16* sp = (const bf16*)W.KVT + ((size_t)u * 2 + dir) * 8192 + dv * 64 + dd0; r.st[2 * dir] = *(const u32x4*)sp; r.st[2 * dir + 1] = *(const u32x4*)(sp + 8); }
        r.sg0 = *(const u32x4*)(W.SG + (trow0 + t) * 512 + h * 128 + v0); r.sg1 = *(const u32x4*)(W.SG + (trow0 + t) * 512 + h * 128 + v0 + 8);
    }
}
__device__ __forceinline__ void gla_cum(Frame& F, const GlaIn& r) {
    LAS float* cum = (LAS float*)(F.lds + GL_CUM);
#pragma unroll
    for (int it = 0; it < 4; ++it) { const int idx = F.tid + it * NTHR; const int dir = idx >> 10, t = (idx >> 4) & 63, d4 = (idx & 15) * 4;
        const u32x2 a = r.lg[it];
        *(LAS f32x4*)(cum + (dir * 64 + t) * 64 + d4) = (f32x4){bflo(a.x), bfhi(a.x), bflo(a.y), bfhi(a.y)}; }
    __syncthreads();
    {
        const int dir = F.tid >> 8, seg = (F.tid >> 6) & 3, d = F.tid & 63; LAS float* cc = cum + dir * 4096 + d; LAS float* tot = cum + 8192 + (dir * 4 + seg) * 64 + d;
        float v[16]; float run = 0.f;
        if (dir == 0) {
#pragma unroll
            for (int i = 0; i < 16; ++i) { run += cc[(16 * seg + i) * 64]; v[i] = run; }
        } else {
#pragma unroll
            for (int i = 15; i >= 0; --i) { run += cc[(16 * seg + i) * 64]; v[i] = run; }
        }
        *tot = run;
        __syncthreads();
        float off = 0.f; const LAS float* tb = cum + 8192 + dir * 256 + d;
        if (dir == 0) { if (seg > 0) off += tb[0]; if (seg > 1) off += tb[64]; if (seg > 2) off += tb[128]; }
        else { if (seg < 3) off += tb[192]; if (seg < 2) off += tb[128]; if (seg < 1) off += tb[64]; }
#pragma unroll
        for (int i = 0; i < 16; ++i) cc[(16 * seg + i) * 64] = v[i] + off;
    }
    __syncthreads();
}

__device__ __forceinline__ void phase_gla1(Frame& F) {
    refresh(F);
    const WS W = ws_map(F.ws, F.nb); const float* const* IN_ = F.a->in; (void)IN_; (void)W;
    LAS unsigned char* lds = F.lds; LAS float* cum = (LAS float*)(lds + GL_CUM);
    const int lane = F.lane, wid = F.wave, r32 = lane & 31, hh = lane >> 5;
    const int U = F.nb * NH * 128;
    GlaIn cur, nxt;
    if (F.bid < U) gla_load<false>(F, W, F.bid, nxt);
    for (int u = F.bid; u < U; u += F.G) {
        cur = nxt;
        if (u + F.G < U) gla_load<false>(F, W, u + F.G, nxt);
        gla_cum(F, cur);
        {
            const int t = F.tid >> 3, d0 = (F.tid & 7) * 8;
            const u32x4 kv = cur.k;
            const unsigned kw[4] = {kv.x, kv.y, kv.z, kv.w};
#pragma unroll
            for (int j = 0; j < 8; ++j) { const int d = d0 + j; const float k = (j & 1) ? bfhi(kw[j >> 1]) : bflo(kw[j >> 1]);
                const float ef = __expf(cum[63 * 64 + d] - cum[t * 64 + d]), eb = __expf(cum[4096 + d] - cum[4096 + t * 64 + d]);
                *(LAS bf16*)(lds + G1_KEF + d * GL_S64 + t * 2) = (bf16)(cvt_pk(k * ef, 0.f) & 0xffffu);
                *(LAS bf16*)(lds + G1_KEB + d * GL_S64 + t * 2) = (bf16)(cvt_pk(k * eb, 0.f) & 0xffffu); }
            const int v0 = (F.tid & 7) * 16;
            const u32x4 va = cur.v0, vb = cur.v1;
            const unsigned vw[8] = {va.x, va.y, va.z, va.w, vb.x, vb.y, vb.z, vb.w};
#pragma unroll
            for (int j = 0; j < 16; ++j) *(LAS bf16*)(lds + G1_VT + (v0 + j) * GL_S64 + t * 2) = (bf16)((j & 1) ? (vw[j >> 1] >> 16) : (vw[j >> 1] & 0xffffu));
            if (F.tid < 128) { const int dir = F.tid >> 6, d = F.tid & 63; W.DEC[((size_t)u * 2 + dir) * 64 + d] = __expf(dir ? cum[4096 + d] : cum[63 * 64 + d]); }
        }
        __syncthreads();
        {
            const int dt = wid & 3, dd = wid >> 2;
            f32x16 cf = {}, cb = {};
#pragma unroll
            for (int s = 0; s < 4; ++s) { const int kb = (16 * s + 8 * hh) * 2;
                const bf16x8 a = lds_frag(lds + G1_VT, 32 * dt + r32, GL_S64, kb);
                cf = __builtin_amdgcn_mfma_f32_32x32x16_bf16(a, lds_frag(lds + G1_KEF, 32 * dd + r32, GL_S64, kb), cf, 0, 0, 0);
                cb = __builtin_amdgcn_mfma_f32_32x32x16_bf16(a, lds_frag(lds + G1_KEB, 32 * dd + r32, GL_S64, kb), cb, 0, 0, 0); }
            bf16* of = (bf16*)W.KVT + ((size_t)u * 2) * 8192; bf16* ob = of + 8192;
#pragma unroll
            for (int r = 0; r < 16; ++r) { const int dv = 32 * dt + crow(r, hh), d = 32 * dd + r32;
                const float pf = __shfl_xor(cf[r], 1), pb = __shfl_xor(cb[r], 1);
                if (!(lane & 1)) { *(unsigned*)(of + dv * 64 + d) = cvt_pk(cf[r], pf); *(unsigned*)(ob + dv * 64 + d) = cvt_pk(cb[r], pb); } }
        }
        __syncthreads();
    }
}

__device__ __forceinline__ void phase_gla2(Frame& F) {
    refresh(F);
    const WS W = ws_map(F.ws, F.nb); const float* const* IN_ = F.a->in; (void)IN_; (void)W;
    const size_t total = (size_t)F.nb * NH * 2 * 4096;
    for (size_t wk = (size_t)F.bid * NTHR + F.tid; wk < total; wk += (size_t)F.G * NTHR) {
        const int e2 = (int)(wk & 4095), dir = (int)((wk >> 12) & 1), bh = (int)(wk >> 13), d = (e2 * 2) & 63;
        unsigned* base = (unsigned*)((bf16*)W.KVT + ((size_t)bh * 128 * 2 + dir) * 8192) + e2; const float* dec = W.DEC + ((size_t)bh * 128 * 2 + dir) * 64 + d;
        float S0 = 0.f, S1 = 0.f;
        for (int n0 = 0; n0 < 128; n0 += 8) {
            unsigned kv[8]; float dc0[8], dc1[8];
#pragma unroll
            for (int j = 0; j < 8; ++j) { const int n = dir ? 127 - (n0 + j) : n0 + j; kv[j] = base[(size_t)n * 8192]; dc0[j] = dec[(size_t)n * 128]; dc1[j] = dec[(size_t)n * 128 + 1]; }
#pragma unroll
            for (int j = 0; j < 8; ++j) { const int n = dir ? 127 - (n0 + j) : n0 + j; base[(size_t)n * 8192] = cvt_pk(S0, S1); S0 = dc0[j] * S0 + bflo(kv[j]); S1 = dc1[j] * S1 + bfhi(kv[j]); }
        }
    }
}

__device__ __forceinline__ void phase_gla3(Frame& F, int l) {
    refresh(F);
    const WS W = ws_map(F.ws, F.nb); const float* const* IN_ = F.a->in; (void)IN_; (void)W;
    LAS unsigned char* lds = F.lds; LAS float* cum = (LAS float*)(lds + GL_CUM);
    const int lane = F.lane, wid = F.wave, r32 = lane & 31, hh = lane >> 5;
    const float* gng = IN_[9] + l * 128;
    const int U = F.nb * NH * 128;
    GlaIn cur, nxt;
    if (F.bid < U) gla_load<true>(F, W, F.bid, nxt);
    for (int u = F.bid; u < U; u += F.G) {
        const int n = u & 127, bh = u >> 7, b = bh >> 2, h = bh & 3; const size_t trow0 = (size_t)b * SEQ + n * 64;
        cur = nxt;
        if (u + F.G < U) gla_load<true>(F, W, u + F.G, nxt);
        gla_cum(F, cur);
        {
            const int t = F.tid >> 3, d0 = (F.tid & 7) * 8;
            const u32x4 qv = cur.q, kv = cur.k;
            const unsigned qw[4] = {qv.x, qv.y, qv.z, qv.w}, kw[4] = {kv.x, kv.y, kv.z, kv.w};
            float qf[8], qb[8], kf[8], kb[8];
#pragma unroll
            for (int j = 0; j < 8; ++j) { const int d = d0 + j; const float q = (j & 1) ? bfhi(qw[j >> 1]) : bflo(qw[j >> 1]), k = (j & 1) ? bfhi(kw[j >> 1]) : bflo(kw[j >> 1]);
                const float cf = cum[t * 64 + d], cb = cum[4096 + t * 64 + d];
                qf[j] = q * __expf(cf); qb[j] = q * __expf(cb); kf[j] = k * __expf(-cf); kb[j] = k * __expf(-cb); }
            u32x4 o;
            o.x = cvt_pk(qf[0], qf[1]); o.y = cvt_pk(qf[2], qf[3]); o.z = cvt_pk(qf[4], qf[5]); o.w = cvt_pk(qf[6], qf[7]); *(LAS u32x4*)(lds + G3_AOP + t * GL_S192 + (64 + d0) * 2) = o;
            o.x = cvt_pk(qb[0], qb[1]); o.y = cvt_pk(qb[2], qb[3]); o.z = cvt_pk(qb[4], qb[5]); o.w = cvt_pk(qb[6], qb[7]); *(LAS u32x4*)(lds + G3_AOP + t * GL_S192 + (128 + d0) * 2) = o;
            o.x = cvt_pk(kf[0], kf[1]); o.y = cvt_pk(kf[2], kf[3]); o.z = cvt_pk(kf[4], kf[5]); o.w = cvt_pk(kf[6], kf[7]); *(LAS u32x4*)(lds + G3_KIF + t * GL_S64 + d0 * 2) = o;
            o.x = cvt_pk(kb[0], kb[1]); o.y = cvt_pk(kb[2], kb[3]); o.z = cvt_pk(kb[4], kb[5]); o.w = cvt_pk(kb[6], kb[7]); *(LAS u32x4*)(lds + G3_KIB + t * GL_S64 + d0 * 2) = o;
            const int v0 = (F.tid & 7) * 16;
            const u32x4 va = cur.v0, vb = cur.v1;
            const unsigned vw[8] = {va.x, va.y, va.z, va.w, vb.x, vb.y, vb.z, vb.w};
#pragma unroll
            for (int j = 0; j < 16; ++j) *(LAS bf16*)(lds + G3_BOP + (v0 + j) * GL_S192 + t * 2) = (bf16)((j & 1) ? (vw[j >> 1] >> 16) : (vw[j >> 1] & 0xffffu));
            const int dv = F.tid >> 2, dd0 = (F.tid & 3) * 16;
#pragma unroll
            for (int dir = 0; dir < 2; ++dir) { const u32x4 o0 = cur.st[2 * dir], o1 = cur.st[2 * dir + 1];
                *(LAS u32x4*)(lds + G3_BOP + dv * GL_S192 + (64 + 64 * dir + dd0) * 2) = o0; *(LAS u32x4*)(lds + G3_BOP + dv * GL_S192 + (64 + 64 * dir + dd0 + 8) * 2) = o1; }
        }
        __syncthreads();
        if (wid < 4) {
            const int it = wid >> 1, jt = wid & 1;
            f32x16 af = {}, ab = {};
#pragma unroll
            for (int s = 0; s < 4; ++s) { const int kb = (16 * s + 8 * hh) * 2;
                if (jt <= it) af = __builtin_amdgcn_mfma_f32_32x32x16_bf16(lds_frag(lds + G3_AOP, 32 * it + r32, GL_S192, 128 + kb), lds_frag(lds + G3_KIF, 32 * jt + r32, GL_S64, kb), af, 0, 0, 0);
                if (jt >= it) ab = __builtin_amdgcn_mfma_f32_32x32x16_bf16(lds_frag(lds + G3_AOP, 32 * it + r32, GL_S192, 256 + kb), lds_frag(lds + G3_KIB, 32 * jt + r32, GL_S64, kb), ab, 0, 0, 0); }
#pragma unroll
            for (int r = 0; r < 16; ++r) { const int i = 32 * it + crow(r, hh), j = 32 * jt + r32; const float v = (j <= i) ? af[r] : ab[r];
                *(LAS bf16*)(lds + G3_AOP + i * GL_S192 + j * 2) = (bf16)(cvt_pk(v, 0.f) & 0xffffu); }
        }
        __syncthreads();
        {
            const int it = wid >> 2, dt = wid & 3; f32x16 o = {};
#pragma unroll
            for (int s = 0; s < 12; ++s) { const int kb = (16 * s + 8 * hh) * 2;
                o = __builtin_amdgcn_mfma_f32_32x32x16_bf16(lds_frag(lds + G3_AOP, 32 * it + r32, GL_S192, kb), lds_frag(lds + G3_BOP, 32 * dt + r32, GL_S192, kb), o, 0, 0, 0); }
            LAS float* out = (LAS float*)(lds + GL_CUM);
#pragma unroll
            for (int r = 0; r < 16; ++r) out[(32 * it + crow(r, hh)) * 128 + 32 * dt + r32] = o[r];
        }
        __syncthreads();
        {
            const int t = F.tid >> 3, v0 = (F.tid & 7) * 16; const LAS float* orow = (const LAS float*)(lds + GL_CUM) + t * 128 + v0;
            float x[16]; float ss = 0.f;
#pragma unroll
            for (int j = 0; j < 16; ++j) { x[j] = orow[j]; ss += x[j] * x[j]; }
            ss += __shfl_xor(ss, 1); ss += __shfl_xor(ss, 2); ss += __shfl_xor(ss, 4);
            const float rs = rsqrtf(ss * (1.f / 128.f) + RMS_EPS);
            const u32x4 ga = cur.sg0, gb = cur.sg1;
            const unsigned gw[8] = {ga.x, ga.y, ga.z, ga.w, gb.x, gb.y, gb.z, gb.w};
            float y[16];
#pragma unroll
            for (int j = 0; j < 16; ++j) y[j] = x[j] * rs * gng[v0 + j] * ((j & 1) ? bfhi(gw[j >> 1]) : bflo(gw[j >> 1]));
            u32x4 o0, o1; o0.x = cvt_pk(y[0], y[1]); o0.y = cvt_pk(y[2], y[3]); o0.z = cvt_pk(y[4], y[5]); o0.w = cvt_pk(y[6], y[7]);
            o1.x = cvt_pk(y[8], y[9]); o1.y = cvt_pk(y[10], y[11]); o1.z = cvt_pk(y[12], y[13]); o1.w = cvt_pk(y[14], y[15]);
            bf16* dst = W.OAB + (trow0 + t) * 512 + h * 128 + v0; *(u32x4*)dst = o0; *(u32x4*)(dst + 8) = o1;
        }
        __syncthreads();
    }
}
__device__ __forceinline__ void phase_select(Frame& F, int l) {
    refresh(F);
    const WS W = ws_map(F.ws, F.nb); const float* const* IN_ = F.a->in; (void)IN_; (void)W;
    LAS int* lcnt = (LAS int*)F.lds; LAS int* lbase = lcnt + 32;
    const float* b_rg = IN_[19] + l * 4; const float* b_re = IN_[21] + l * 32;
    unsigned* gcnt = W.ctl + CW_CNT + l * 64;
    for (int t0 = F.bid * NTHR; t0 < F.T; t0 += F.G * NTHR) {
        if (F.tid < 32) lcnt[F.tid] = 0;
        __syncthreads();
        const int t = t0 + F.tid; int e0 = 0, e1 = 0, r0 = 0, r1 = 0; float g0 = 0.f, g1 = 0.f;
        if (t < F.T) {
            const float* lg = W.LOGITS + (size_t)t * 64;
            float gl[4]; { const f32x4 v = *(const f32x4*)lg; gl[0] = v[0] + b_rg[0]; gl[1] = v[1] + b_rg[1]; gl[2] = v[2] + b_rg[2]; gl[3] = v[3] + b_rg[3]; }
            int grp = 0; float mx = gl[0];
            if (gl[1] > mx) { mx = gl[1]; grp = 1; } if (gl[2] > mx) { mx = gl[2]; grp = 2; } if (gl[3] > mx) { mx = gl[3]; grp = 3; }
            const float p_grp = 1.f / (__expf(gl[0] - mx) + __expf(gl[1] - mx) + __expf(gl[2] - mx) + __expf(gl[3] - mx));
            const f32x4 ea = *(const f32x4*)(lg + 4 + grp * 8), eb = *(const f32x4*)(lg + 8 + grp * 8);
            const f32x4 ba = *(const f32x4*)(b_re + grp * 8), bb = *(const f32x4*)(b_re + grp * 8 + 4);
            float b0v = -1e30f, b1v = -1e30f; int i0 = 0, i1 = 0;
#pragma unroll
            for (int j = 0; j < 8; ++j) { const float e = (j < 4) ? ea[j] + ba[j] : eb[j - 4] + bb[j - 4];
                if (e > b0v) { b1v = b0v; i1 = i0; b0v = e; i0 = j; } else if (e > b1v) { b1v = e; i1 = j; } }
            const float p1 = __expf(b1v - b0v), s2 = 1.f + p1;
            e0 = grp * 8 + i0; e1 = grp * 8 + i1; g0 = p_grp / s2; g1 = p_grp * p1 / s2;
            r0 = __hip_atomic_fetch_add(lcnt + e0, 1, __ATOMIC_RELAXED, __HIP_MEMORY_SCOPE_WORKGROUP);
            r1 = __hip_atomic_fetch_add(lcnt + e1, 1, __ATOMIC_RELAXED, __HIP_MEMORY_SCOPE_WORKGROUP);
        }
        __syncthreads();
        if (F.tid < 32) lbase[F.tid] = (int)__hip_atomic_fetch_add(gcnt + F.tid, (unsigned)lcnt[F.tid], __ATOMIC_RELAXED, __HIP_MEMORY_SCOPE_AGENT);
        __syncthreads();
        if (t < F.T) { W.eid[t * 2] = e0; W.eid[t * 2 + 1] = e1; W.gate[t * 2] = g0; W.gate[t * 2 + 1] = g1; W.rank[t * 2] = lbase[e0] + r0; W.rank[t * 2 + 1] = lbase[e1] + r1; }
        __syncthreads();
    }
}
__device__ __forceinline__ void phase_gather(Frame& F, int l) {
    refresh(F);
    const WS W = ws_map(F.ws, F.nb); const float* const* IN_ = F.a->in; (void)IN_; (void)W;
    LAS int* seg = (LAS int*)F.lds; LAS int* cnt = seg + 40;
    const unsigned* gcnt = W.ctl + CW_CNT + l * 64;
    if (F.tid == 0) { int o = 0; for (int e = 0; e < 32; ++e) { const int c = (int)__hip_atomic_load(gcnt + e, __ATOMIC_RELAXED, __HIP_MEMORY_SCOPE_AGENT); seg[e] = o; cnt[e] = c; o += (c + 255) & ~255; } seg[32] = o; }
    __syncthreads();
    const int ntile = seg[32] >> 8;
    if (F.bid == 0) {
        for (int i = F.tid; i < ntile; i += NTHR) { int e = 0; while (e < 31 && (i << 8) >= seg[e + 1]) ++e; W.tilee[i] = e; }
        if (F.tid == 0) W.segp[0] = ntile;
    }
    for (int p = F.bid * NTHR + F.tid; p < (ntile << 8); p += F.G * NTHR) { int e = 0; while (e < 31 && p >= seg[e + 1]) ++e; if (p - seg[e] >= cnt[e]) W.stok[p] = 0; }
    for (int it = F.bid * NTHR + F.tid; it < F.T * 2; it += F.G * NTHR) {
        const int e = W.eid[it], p = seg[e] + W.rank[it];
        W.stok[p] = it >> 1; W.pos[it] = p; W.gsort[p] = W.gate[it];
    }
}

#ifndef MK_MASK
#define MK_MASK 0xffffffffu
#endif
#define EN(b) (((MK_MASK) >> (b)) & 1u)
#ifndef MK_ALIGN
#define MK_ALIGN true
#endif
#ifndef MK_SP2
#define MK_SP2 true
#endif
#ifndef MK_DUP
#define MK_DUP 0u
#endif
#define REPS(b) ((((MK_DUP) >> (b)) & 1u) ? 2 : 1)
constexpr int NPL = 14, NPH = 2 + DEPTH * NPL;
__global__ void __launch_bounds__(NTHR, 2) mk_fwd(Args args) {
    extern __shared__ __attribute__((aligned(16))) unsigned char lds_raw[];
    Frame F;
    F.lds = (LAS unsigned char*)lds_raw; F.tid = threadIdx.x; F.lane = F.tid & 63; F.wave = __builtin_amdgcn_readfirstlane(F.tid >> 6);
    F.G = gridDim.x; F.bid = blockIdx.x; F.nb = args.nb; F.T = args.nb * SEQ; F.ws = args.ws; F.a = &args; F.xbuf = args.out;
    const float* const* IN_ = args.in;
    volatile LAS unsigned* misc = (volatile LAS unsigned*)(F.lds + LDS_MISC);
    if (F.tid < 64) misc[F.tid] = 0u;
    __syncthreads();
    XcdBarrier bar = xcd_barrier_post((unsigned*)args.ws + CW_BAR + args.li * XCD_BAR_WORDS, misc);
    const int lo = args.ph_lo, hi = args.ph_hi;
#define IN(k) (lo <= (k) && (k) < hi)
#ifdef MK_BAR2
#define SEAM(k) do { if (IN(k) && IN((k) + 1)) { xcd_barrier(bar); xcd_barrier(bar); } } while (0)
#else
#define SEAM(k) do { if (IN(k) && IN((k) + 1)) xcd_barrier(bar); } while (0)
#endif
    LAS unsigned char* gl = F.lds;
    if (EN(0) && IN(0)) { for (int rp = 0; rp < REPS(0); ++rp) { p0_prologue(F); __syncthreads(); } SEAM(0); }
    for (int l = 0; l < DEPTH; ++l) {
        const int pb = 1 + l * NPL;
        if (EN(1) && IN(pb + 0)) { for (int rp = 0; rp < ((l == 0) ? REPS(14) : 1); ++rp) phase_norm(F, l, 0); SEAM(pb + 0); }
        if (EN(2) && IN(pb + 1)) { const WS W = ws_map(F.ws, F.nb);
            pg8::Gemm g{W.H, W.win + (size_t)l * NIN * D, F.T, NIN, D}; pg8::StaticOrder S; S.init(F.T, NIN, F.G, F.bid);
            EpiIn E{W.GQ, W.GK, W.GV, W.SG, W.LGF, W.LGB, W.DQ, W.DK, W.DV, W.SGA, W.SGB, IN_[8] + l * 512, IN_[10] + l * 64, IN_[11] + l * 64, 0};
#ifdef MK_DEPHASE
            { const int g_ = (F.bid >> 3) & 7; for (int k_ = 0; k_ < g_ * MK_DEPHASE; ++k_) __builtin_amdgcn_s_sleep(127); }
#endif
#ifdef MK_INPROJ_PLAIN
            { EpiIn EP_ = E; EP_.plain = 1; pg8::gemm_phase<EpiIn, pg8::StaticOrder, MK_ALIGN, MK_SP2>(gl, g, S, EP_); }
#endif
#ifdef MK_INPROJ_NULL
            { EpiNull EN_; pg8::gemm_phase<EpiNull, pg8::StaticOrder, MK_ALIGN, MK_SP2>(gl, g, S, EN_); }
#endif
            for (int rp = 0; rp < REPS(2); ++rp) pg8::gemm_phase<EpiIn, pg8::StaticOrder, MK_ALIGN, MK_SP2>(gl, g, S, E);
            SEAM(pb + 1);
        }
        if (EN(3) && IN(pb + 2)) { for (int rp = 0; rp < REPS(3); ++rp) phase_gla1(F); SEAM(pb + 2); }
        if (EN(4) && IN(pb + 3)) { phase_gla2(F); SEAM(pb + 3); }
        if (EN(5) && IN(pb + 4)) { for (int rp = 0; rp < REPS(5); ++rp) phase_gla3(F, l); __syncthreads(); }
        if (EN(6) && IN(pb + 5)) {
#ifdef MK_ATT_PROBE
            phase_attn<MK_ATT_PROBE>(F, l);
#endif
            phase_attn<0>(F, l); SEAM(pb + 5); }
        if (EN(7) && IN(pb + 6)) { const WS W = ws_map(F.ws, F.nb);
            pg8::Gemm g{W.OAB, W.wab + (size_t)l * D * D, 0, 0, 512}; MergeOrder S; S.so.init(F.T, D, F.G, F.bid); S.nM = F.T / 256;
            EpiMerge E{W.SGA, W.SGB, W.MERGED, F.T / 256};
            for (int rp = 0; rp < REPS(7); ++rp) pg8::gemm_phase<EpiMerge, MergeOrder, MK_ALIGN, MK_SP2>(gl, g, S, E);
            SEAM(pb + 6);
        }
        if (EN(8) && IN(pb + 7)) { const WS W = ws_map(F.ws, F.nb); const float* modl = W.mod + (size_t)l * NBMAX * 6 * D;
            pg8::Gemm g{W.MERGED, W.wo + (size_t)l * D * D, F.T, D, D}; pg8::StaticOrder S; S.init(F.T, D, F.G, F.bid);
            EpiResid E{l == 0 ? IN_[0] : nullptr, W.XB, modl + 2 * D};
            for (int rp = 0; rp < ((l == 0) ? REPS(8) : 1); ++rp) pg8::gemm_phase<EpiResid, pg8::StaticOrder, MK_ALIGN, MK_SP2>(gl, g, S, E);
            SEAM(pb + 7);
        }
        if (EN(1) && IN(pb + 8)) { for (int rp = 0; rp < REPS(1); ++rp) phase_norm(F, l, 1); SEAM(pb + 8); }
        if (EN(9) && IN(pb + 9)) { const WS W = ws_map(F.ws, F.nb);
            pg8::Gemm g{W.H, W.wr + (size_t)l * 256 * D, F.T, 256, D}; pg8::StaticOrder S; S.init(F.T, 256, F.G, F.bid);
            EpiLogits E{W.LOGITS};
            for (int rp = 0; rp < REPS(9); ++rp) pg8::gemm_phase<EpiLogits, pg8::StaticOrder, MK_ALIGN, MK_SP2>(gl, g, S, E);
            SEAM(pb + 9);
        }
        if (EN(10) && IN(pb + 10)) { phase_select(F, l); SEAM(pb + 10); }
        if (EN(11) && IN(pb + 11)) { for (int rp = 0; rp < REPS(11); ++rp) { phase_gather(F, l); __syncthreads(); } SEAM(pb + 11); }
        if (EN(12) && IN(pb + 12)) { const WS W = ws_map(F.ws, F.nb);
            const int ntile = W.segp[0];
#if MK_MOE_FP8
            pg8::Gemm g{W.XS, (const bf16*)((const unsigned char*)W.w1 + (size_t)l * NE * 1024 * D), 0, 0, D / 2}; GroupedOrder S{W.tilee, ntile * 4, F.G, F.bid};
            EpiAct E{(unsigned char*)W.ACT};
#else
            pg8::Gemm g{W.H, W.w1 + (size_t)l * NE * 1024 * D, 0, 0, D}; GroupedOrder S{W.tilee, ntile * 4, F.G, F.bid, W.stok};
            EpiAct E{W.ACT};
#endif
            for (int rp = 0; rp < REPS(12); ++rp) pg8::gemm_phase<EpiAct, GroupedOrder, MK_ALIGN, MK_SP2, true>(gl, g, S, E);
            SEAM(pb + 12);
        }
        if (EN(13) && IN(pb + 13)) { const WS W = ws_map(F.ws, F.nb);
            const int ntile = W.segp[0];
#if MK_MOE_FP8
            pg8::Gemm g{W.ACT, (const bf16*)((const unsigned char*)W.w2 + (size_t)l * NE * D * DE), 0, 0, DE / 2}; GroupedOrder S{W.tilee, ntile * 4, F.G, F.bid};
#else
            pg8::Gemm g{W.ACT, W.w2 + (size_t)l * NE * D * DE, 0, 0, DE}; GroupedOrder S{W.tilee, ntile * 4, F.G, F.bid, nullptr};
#endif
            EpiYs E{(unsigned char*)W.YS, W.gsort};
            for (int rp = 0; rp < REPS(13); ++rp) pg8::gemm_phase<EpiYs, GroupedOrder, MK_ALIGN, MK_SP2>(gl, g, S, E);
            SEAM(pb + 13);
        }
    }
    if (EN(1) && IN(NPH - 1)) phase_norm(F, 0, 2);
#undef IN
#undef SEAM
}

struct LaunchCfg { int grid; bool ok; };
inline LaunchCfg& launch_cfg() {
    static LaunchCfg c{0, false}; static bool init = false;
    if (!init) { init = true;
        int dev = 0, cus = 0, per_cu = 0;
        if (hipGetDevice(&dev) != hipSuccess || hipDeviceGetAttribute(&cus, hipDeviceAttributeMultiprocessorCount, dev) != hipSuccess) { fprintf(stderr, "mk: device query failed\n"); return c; }
        if (hipFuncSetAttribute((const void*)mk_fwd, hipFuncAttributeMaxDynamicSharedMemorySize, LDS_BYTES) != hipSuccess) { fprintf(stderr, "mk: hipFuncSetAttribute failed\n"); return c; }
        if (hipOccupancyMaxActiveBlocksPerMultiprocessor(&per_cu, (const void*)mk_fwd, NTHR, LDS_BYTES) != hipSuccess || per_cu < 1) { fprintf(stderr, "mk: occupancy query says %d blocks/CU\n", per_cu); (void)hipGetLastError(); return c; }
        c.grid = cus; c.ok = true;
    }
    return c;
}
inline void launch_range(void* const* d_in, float* xbuf, void* d_ws, int nb, int lo, int hi, int li, hipStream_t stream) {
    LaunchCfg& c = launch_cfg(); if (!c.ok) return;
    Args a{}; for (int i = 0; i < 24; ++i) a.in[i] = (const float*)d_in[i];
    a.out = xbuf; a.ws = (unsigned char*)d_ws; a.nb = nb; a.ph_lo = lo; a.ph_hi = hi; a.li = li;
    hipLaunchKernelGGL(mk_fwd, dim3(c.grid), dim3(NTHR), LDS_BYTES, stream, a);
    const hipError_t le = hipPeekAtLastError(); if (le != hipSuccess) fprintf(stderr, "mk: launch [%d,%d) failed: %s\n", lo, hi, hipGetErrorName(le));
}
}
extern "C" void kernel_launch(void* const* d_in, const int* in_sizes, int n_in, void* d_out, int out_size, void* d_ws, size_t ws_size, hipStream_t stream) {
    (void)in_sizes; (void)n_in; (void)out_size;
    static int checked = 0;
    if (!checked) { checked = 1; const mk::WS w = mk::ws_map((unsigned char*)d_ws, 4); if (w.end > ws_size) { fprintf(stderr, "mk: workspace too small: need %zu, have %zu\n", w.end, ws_size); checked = -1; } }
    if (checked < 0) return;
    if (hipMemsetAsync(d_ws, 0, mk::CTL_BYTES, stream) != hipSuccess) return;
    mk::launch_range(d_in, (float*)d_out, d_ws, 4, 0, mk::NPH, 0, stream);
}
```

```cpp
#include <hip/hip_runtime.h>
#include <cstdio>
#include <cstdint>
#include <cmath>
#define MK_ATT_FP8 1
namespace pg8 {
#define PG8_LAS __attribute__((address_space(3)))
typedef unsigned short bf16_t;
typedef short bf16x8 __attribute__((ext_vector_type(8)));
typedef float f32x4 __attribute__((ext_vector_type(4)));
typedef unsigned u32x4 __attribute__((ext_vector_type(4)));
constexpr int BM = 256, BK = 64, HALF = 128, HTB = HALF * BK * 2  , STAGE_BYTES = 8 * HTB, NXCD = 8, WGM = 8;

__host__ __device__ __forceinline__ int lds_byte(int r, int c) { const int st = (r >> 4) * 2 + (c >> 5), rr = r & 15, cc = c & 31, ob = rr * 64 + cc * 2; return st * 1024 + (ob ^ (((ob >> 9) & 1) << 5)); }
__host__ __device__ __forceinline__ void stage_rc(int b, int& R, int& C) { const int st = b / 1024, sb = b % 1024, swz = sb ^ (((sb >> 9) & 1) << 5); R = (st >> 1) * 16 + swz / 64; C = (st & 1) * 32 + (swz % 64) / 2; }
__host__ __device__ __forceinline__ int perm32(int rho) { const int n = rho >> 4, i = rho & 15; return 8 * (i >> 2) + 4 * n + (i & 3); }

struct Unit { int pm, pn; };
struct Gemm { const bf16_t* A; const bf16_t* Bt; int M, N, K; };

struct StaticOrder {
    int nM, nN, nwg, G, c;
    __host__ __device__ void init(int M, int N, int G_, int c_) { nM = M / BM; nN = N / BM; nwg = nM * nN; G = G_; c = c_; }
    __host__ __device__ bool next(int i, Unit& u) const {
        const long L = (long)i * G + c; if (L >= nwg) return false;
        int wgid = (int)L; { const int q = nwg / NXCD, r = nwg % NXCD, xcd = wgid % NXCD, off = wgid / NXCD; wgid = (xcd < r ? xcd * (q + 1) : r * (q + 1) + (xcd - r) * q) + off; }
        const int nig = WGM * nN, gid = wgid / nig, fm = gid * WGM, gsz = (nM - fm) < WGM ? (nM - fm) : WGM;
        u.pm = fm + ((wgid % nig) % gsz); u.pn = (wgid % nig) / gsz; return true;
    }
    __device__ __forceinline__ void a_ready(const Unit&) const {}
    __device__ __forceinline__ void done(const Unit&) const {}
};
__device__ __forceinline__ unsigned cvt_pk_bf16(float lo, float hi) { unsigned r; asm volatile("v_cvt_pk_bf16_f32 %0, %1, %2" : "=v"(r) : "v"(lo), "v"(hi)); return r; }
__device__ __forceinline__ const void* pg8_uniform(const void* p) { const unsigned long long v = (unsigned long long)p;
    const unsigned lo = (unsigned)__builtin_amdgcn_readfirstlane((int)(unsigned)v), hi = (unsigned)__builtin_amdgcn_readfirstlane((int)(unsigned)(v >> 32)); return (const void*)(((unsigned long long)hi << 32) | lo); }
__device__ __forceinline__ void pg8_glds(const void* sbase, unsigned voff, unsigned ldsdst) { unsigned keep;
    asm volatile("s_nop 4\n\ts_mov_b32 %0, m0\n\ts_mov_b32 m0, %3\n\ts_nop 0\n\tglobal_load_lds_dwordx4 %1, %2\n\ts_mov_b32 m0, %0" : "=&s"(keep) : "v"(voff), "s"(sbase), "s"(ldsdst) : "memory"); }
typedef int pg8_v8i __attribute__((ext_vector_type(8)));
typedef int pg8_v4i __attribute__((ext_vector_type(4)));
template <class Epi, class Sched, bool ALIGN_EPI = false, bool SP2 = false, bool GATHER = false>
__device__ __forceinline__ void gemm_phase(PG8_LAS unsigned char* lds, const Gemm g, const Sched& S, const Epi& E) {
    int tid_ = threadIdx.x; asm volatile("" : "+v"(tid_));
    const int tid = tid_, wid = __builtin_amdgcn_readfirstlane(tid >> 6), lane = tid & 63, wr = wid >> 2, wc = wid & 3, fr = lane & 15, fq = lane >> 4;
    const int K = g.K, nt = K / BK;
    unsigned voffA[2], voffB[2]; unsigned vc[2][2] = {}, vn[2][2] = {}, vs[2][2] = {}; (void)vc; (void)vn; (void)vs;
#pragma unroll
    for (int i = 0; i < 2; ++i) { int R, C; stage_rc(tid * 16 + i * 8192, R, C); const int Rb = Epi::PERM ? ((R & ~31) + perm32(R & 31)) : R;
        voffA[i] = (unsigned)(R * K + C) * 2u; voffB[i] = (unsigned)(Rb * K + C) * 2u; }
    const size_t kstep = (size_t)(BK * 2);
    const size_t hstep = (size_t)HALF * K * 2;
    const size_t tstep = 2 * hstep;
    const unsigned ldsw = (unsigned)wid * 1024u; const unsigned lds0 = (unsigned)(unsigned long)lds; (void)lds0;
    const int aoff = lds_byte(wr * 64 + fr, fq * 8), boff = lds_byte(wc * 32 + fr, fq * 8);
#define PG8_SA(b, h) (((b) * 2 + (h)) * HTB)
#define PG8_SB(b, h) ((4 + (b) * 2 + (h)) * HTB)
#if defined(PG8_ASM_STAGE) && PG8_ASM_STAGE
#define PG8_STAGE(bufoff, gbase, voff) do { const void* _gb = pg8_uniform(gbase); _Pragma("unroll") for (int _i = 0; _i < 2; ++_i) \
        pg8_glds(_gb, (voff)[_i], (unsigned)__builtin_amdgcn_readfirstlane((int)(lds0 + (unsigned)(bufoff) + ldsw + _i * 8192))); } while (0)
#else
#define PG8_STAGE(bufoff, gbase, voff) do { _Pragma("unroll") for (int _i = 0; _i < 2; ++_i) \
        __builtin_amdgcn_global_load_lds((const unsigned*)((const char*)(gbase) + (voff)[_i]), (PG8_LAS unsigned*)(lds + (bufoff) + ldsw + _i * 8192), 16, 0, 0); } while (0)
#endif
#define PG8_STAGE_A(b, h, X, VS) do { if constexpr (GATHER) { PG8_STAGE(PG8_SA(b, h), X, VS[h]); } else { PG8_STAGE(PG8_SA(b, h), (X) + (h) * hstep, voffA); } } while (0)
#define PG8_LOADROWS(u, v) do { _Pragma("unroll") for (int i_ = 0; i_ < 2; ++i_) { int R_, C_; stage_rc(tid * 16 + i_ * 8192, R_, C_); _Pragma("unroll") for (int h_ = 0; h_ < 2; ++h_) \
        v[h_][i_] = (unsigned)S.rowidx[(u).pm * 256 + h_ * 128 + R_] * (unsigned)(K * 2) + (unsigned)C_ * 2u; } } while (0)
#define PG8_LDA(dst, b, h) do { _Pragma("unroll") for (int m = 0; m < 4; ++m) _Pragma("unroll") for (int k = 0; k < 2; ++k) dst[m][k] = *(const PG8_LAS bf16x8*)(lds + PG8_SA(b, h) + aoff + m * 2048 + k * 1024); } while (0)
#define PG8_LDB(dst, b, h) do { _Pragma("unroll") for (int n = 0; n < 2; ++n) _Pragma("unroll") for (int k = 0; k < 2; ++k) dst[n][k] = *(const PG8_LAS bf16x8*)(lds + PG8_SB(b, h) + boff + n * 2048 + k * 1024); } while (0)
#define PG8_MMA(ai, bj, At, Bt) do { __builtin_amdgcn_s_setprio(1); _Pragma("unroll") for (int m = 0; m < 4; ++m) _Pragma("unroll") for (int n = 0; n < 2; ++n) _Pragma("unroll") for (int k = 0; k < 2; ++k) \
        acc[ai][bj][m][n] = __builtin_amdgcn_mfma_f32_16x16x32_bf16(Bt[n][k], At[m][k], acc[ai][bj][m][n], 0, 0, 0); __builtin_amdgcn_s_setprio(0); } while (0)
#define PG8_WAIT_V(n) asm volatile("s_waitcnt vmcnt(" #n ")" ::: "memory")
#define PG8_WAIT_L(n) asm volatile("s_waitcnt lgkmcnt(" #n ")" ::: "memory")
#define PG8_BAR __builtin_amdgcn_s_barrier()
#define PG8_SCHED __builtin_amdgcn_sched_barrier(0)
    Unit cur, nxt; int ui = 0;
    if (!S.next(0, cur)) return;
    f32x4 acc[2][2][4][2];
#pragma unroll
    for (int a = 0; a < 2; ++a)
#pragma unroll
        for (int b = 0; b < 2; ++b)
#pragma unroll
            for (int m = 0; m < 4; ++m)
#pragma unroll
                for (int n = 0; n < 2; ++n) acc[a][b][m][n] = (f32x4){0.f, 0.f, 0.f, 0.f};
    bf16x8 At[4][2], B0[2][2], B1[2][2];
    const char* cA = (const char*)g.A + (GATHER ? (size_t)0 : (size_t)cur.pm * tstep); const char* cB = (const char*)g.Bt + (size_t)cur.pn * tstep;
    S.a_ready(cur);
    if constexpr (GATHER) { PG8_LOADROWS(cur, vc); }
    if constexpr (SP2) {
        PG8_STAGE(PG8_SB(0, 0), cB, voffB); PG8_STAGE(PG8_SB(0, 1), cB + hstep, voffB); PG8_STAGE_A(0, 0, cA, vc); PG8_STAGE_A(0, 1, cA, vc);
        if (wr == 1) PG8_BAR;
        PG8_WAIT_V(2); PG8_BAR;
        PG8_STAGE(PG8_SB(1, 0), cB + kstep, voffB); PG8_STAGE_A(1, 0, cA + kstep, vc); PG8_STAGE(PG8_SB(1, 1), cB + hstep + kstep, voffB);
        PG8_WAIT_V(6); PG8_BAR;
    } else {
        PG8_STAGE(PG8_SB(0, 0), cB, voffB); PG8_STAGE_A(0, 0, cA, vc); PG8_STAGE(PG8_SB(0, 1), cB + hstep, voffB); PG8_STAGE_A(0, 1, cA, vc);
        if (wr == 1) PG8_BAR;
        PG8_WAIT_V(4); PG8_BAR;
        PG8_STAGE(PG8_SB(1, 0), cB + kstep, voffB); PG8_STAGE_A(1, 0, cA + kstep, vc); PG8_STAGE(PG8_SB(1, 1), cB + hstep + kstep, voffB);
        PG8_WAIT_V(6); PG8_BAR;
    }
    for (;;) {
        const bool has_next = S.next(ui + 1, nxt);
        const char* nA = (has_next && !GATHER) ? (const char*)g.A + (size_t)nxt.pm * tstep : cA; const char* nB = has_next ? (const char*)g.Bt + (size_t)nxt.pn * tstep : cB;
        for (int t = 0; t < nt; t += 2) {
            const bool last = (t == nt - 2);
            const char* a1 = cA + (size_t)(t + 1) * kstep;
            const char* a2 = last ? nA : cA + (size_t)(t + 2) * kstep; const char* b2 = last ? nB : cB + (size_t)(t + 2) * kstep;
            const char* a3 = a2 + kstep; const char* b3 = b2 + kstep;
            if (last && has_next) S.a_ready(nxt);
            if constexpr (GATHER) { if (last && has_next) { PG8_LOADROWS(nxt, vn); }
                _Pragma("unroll") for (int h_ = 0; h_ < 2; ++h_) _Pragma("unroll") for (int i_ = 0; i_ < 2; ++i_) vs[h_][i_] = (last && has_next) ? vn[h_][i_] : vc[h_][i_]; }
            if constexpr (Epi::MIDK) { if (t == nt / 2) E.mid(acc, cur, wr, wc, fr, fq); }
            if constexpr (SP2) {
            PG8_LDB(B0, 0, 0); PG8_LDB(B1, 0, 1); PG8_SCHED; PG8_LDA(At, 0, 0); PG8_STAGE_A(1, 1, a1, vc);
            PG8_WAIT_V(8); PG8_WAIT_L(0); PG8_BAR; PG8_MMA(0, 0, At, B0); PG8_MMA(0, 1, At, B1); PG8_BAR; PG8_SCHED;
            PG8_LDA(At, 0, 1); PG8_STAGE(PG8_SB(0, 0), b2, voffB); PG8_STAGE(PG8_SB(0, 1), b2 + hstep, voffB); PG8_STAGE_A(0, 0, a2, vs);
            PG8_WAIT_V(8); PG8_WAIT_L(0); PG8_BAR; PG8_MMA(1, 0, At, B0); PG8_MMA(1, 1, At, B1); PG8_BAR; PG8_SCHED;
            PG8_LDB(B0, 1, 0); PG8_LDB(B1, 1, 1); PG8_SCHED; PG8_LDA(At, 1, 0); PG8_STAGE_A(0, 1, a2, vs);
            PG8_WAIT_V(8); PG8_WAIT_L(0); PG8_BAR; PG8_MMA(0, 0, At, B0); PG8_MMA(0, 1, At, B1); PG8_BAR; PG8_SCHED;
            PG8_LDA(At, 1, 1); PG8_STAGE(PG8_SB(1, 0), b3, voffB); PG8_STAGE(PG8_SB(1, 1), b3 + hstep, voffB); PG8_STAGE_A(1, 0, a3, vs);
            PG8_WAIT_V(8); PG8_WAIT_L(0); PG8_BAR; PG8_MMA(1, 0, At, B0); PG8_MMA(1, 1, At, B1); PG8_BAR; PG8_SCHED;
            } else {
            PG8_LDB(B0, 0, 0); PG8_SCHED; PG8_LDA(At, 0, 0); PG8_STAGE_A(1, 1, a1, vc);
            PG8_WAIT_L(8); PG8_BAR; PG8_WAIT_L(0); PG8_MMA(0, 0, At, B0); PG8_BAR; PG8_SCHED;
            PG8_LDB(B1, 0, 1); PG8_STAGE(PG8_SB(0, 0), b2, voffB);
            PG8_BAR; PG8_WAIT_L(0); PG8_MMA(0, 1, At, B1); PG8_BAR;
            PG8_LDA(At, 0, 1); PG8_STAGE_A(0, 0, a2, vs);
            PG8_BAR; PG8_WAIT_L(0); PG8_MMA(1, 0, At, B0); PG8_BAR; PG8_SCHED;
            PG8_STAGE(PG8_SB(0, 1), b2 + hstep, voffB);
            PG8_WAIT_V(6); PG8_BAR; PG8_MMA(1, 1, At, B1); PG8_BAR;
            PG8_LDB(B0, 1, 0); PG8_SCHED; PG8_LDA(At, 1, 0); PG8_STAGE_A(0, 1, a2, vs);
            PG8_WAIT_L(8); PG8_BAR; PG8_WAIT_L(0); PG8_MMA(0, 0, At, B0); PG8_BAR; PG8_SCHED;
            PG8_LDB(B1, 1, 1); PG8_STAGE(PG8_SB(1, 0), b3, voffB);
            PG8_BAR; PG8_WAIT_L(0); PG8_MMA(0, 1, At, B1); PG8_BAR;
            PG8_LDA(At, 1, 1); PG8_STAGE_A(1, 0, a3, vs);
            PG8_BAR; PG8_WAIT_L(0); PG8_MMA(1, 0, At, B0); PG8_BAR; PG8_SCHED;
            PG8_STAGE(PG8_SB(1, 1), b3 + hstep, voffB);
            PG8_WAIT_V(6); PG8_BAR; PG8_MMA(1, 1, At, B1); PG8_BAR;
            }
        }
        if constexpr (ALIGN_EPI) { if (wr == 0) PG8_BAR; }
        if constexpr (!Epi::AFTER_DRAIN) { E(acc, cur, wr, wc, fr, fq); S.done(cur); }
        if (!has_next) break;
#pragma unroll
        for (int a = 0; a < 2; ++a)
#pragma unroll
            for (int b = 0; b < 2; ++b)
#pragma unroll
                for (int m = 0; m < 4; ++m)
#pragma unroll
                    for (int n = 0; n < 2; ++n) acc[a][b][m][n] = (f32x4){0.f, 0.f, 0.f, 0.f};
        cur = nxt; cA = nA; cB = nB; ++ui;
        if constexpr (GATHER) { _Pragma("unroll") for (int h_ = 0; h_ < 2; ++h_) _Pragma("unroll") for (int i_ = 0; i_ < 2; ++i_) vc[h_][i_] = vn[h_][i_]; }
        if constexpr (ALIGN_EPI) { if (wr == 1) PG8_BAR; }
    }
    PG8_WAIT_V(0);
    if constexpr (!ALIGN_EPI) { if (wr == 0) PG8_BAR; }
    PG8_BAR;
    if constexpr (Epi::AFTER_DRAIN) { E.fused(acc, cur, wr, wc, fr, fq, lds, wid, lane); S.done(cur); }
#undef PG8_SA
#undef PG8_SB
#undef PG8_STAGE
#undef PG8_STAGE_A
#undef PG8_LOADROWS
#undef PG8_LDA
#undef PG8_LDB
#undef PG8_MMA
#undef PG8_WAIT_V
#undef PG8_WAIT_L
#undef PG8_BAR
#undef PG8_SCHED
}
}
namespace mk {
constexpr int D = 1024, SEQ = 8192, NBMAX = 4, NH = 4, DIN = 5152, NE = 32, DE = 512, DEPTH = 2;
constexpr int NT_IN = 22, NIN = NT_IN * 256;
constexpr int NWAVES = 8, NTHR = 512;
#ifndef MK_MOE_FP8
#define MK_MOE_FP8 0
#endif
constexpr float WSCALE = 16.f, ASCALE = 4.f, YSCALE = 32.f;
constexpr float LOG2E = 1.4426950408889634f, QSCALE = 0.125f * LOG2E, RMS_EPS = 1e-6f;
constexpr int O_GQ = 0, O_GK = 256, O_GV = 512, O_GG = 1024, O_LRF = 1536, O_LRB = 1552, O_DQ = 1568, O_DK = 2080, O_DV = 2592, O_GA = 3104, O_GB = 4128;
typedef unsigned short bf16;
typedef unsigned u32x4 __attribute__((ext_vector_type(4)));
typedef unsigned u32x2 __attribute__((ext_vector_type(2)));
typedef float f32x4 __attribute__((ext_vector_type(4)));
typedef float f32x16 __attribute__((ext_vector_type(16)));
typedef short bf16x8 __attribute__((ext_vector_type(8)));
typedef short s16x4 __attribute__((ext_vector_type(4)));
#define LAS __attribute__((address_space(3)))
#define GAS __attribute__((address_space(1)))
#define LDS_WAIT() asm volatile("s_waitcnt lgkmcnt(0)" ::: "memory")
#define VM_WAIT() asm volatile("s_waitcnt vmcnt(0)" ::: "memory")

constexpr size_t MiB = 1u << 20;
constexpr size_t CTL_BYTES = 256 * 1024;
constexpr int CW_BAR = 4096;
constexpr int CW_CNT = 32768;
constexpr size_t OFF_MOD = 256 * 1024, OFF_TAB = 512 * 1024;
constexpr size_t OFF_WIN = 1 * MiB, SZ_WIN = (size_t)DEPTH * NIN * D * 2;
constexpr size_t OFF_WAB = OFF_WIN + SZ_WIN, SZ_WAB = (size_t)DEPTH * D * D * 2;
constexpr size_t OFF_WO = OFF_WAB + SZ_WAB, SZ_WO = SZ_WAB;
constexpr size_t OFF_WR = OFF_WO + SZ_WO, SZ_WR = (size_t)DEPTH * 256 * D * 2;
constexpr size_t OFF_W1 = OFF_WR + SZ_WR, SZ_W1 = (size_t)DEPTH * NE * 1024 * D * 2;
constexpr size_t OFF_W2 = OFF_W1 + SZ_W1, SZ_W2 = (size_t)DEPTH * NE * D * DE * 2;
constexpr size_t OFF_ACT = 225 * MiB;
static_assert(OFF_W2 + SZ_W2 <= OFF_ACT, "weights fit");
struct WS {
    unsigned* ctl; float* mod; float* tab;
    bf16 *win, *wab, *wo, *wr, *w1, *w2;
    bf16 *H, *OAB, *XB; int* eid; float* gate; int* rank; int* pos; int* tilee; int* segp;
    bf16 *GQ, *GK, *GV, *SG; bf16 *LGF, *LGB; bf16 *DQ, *DK, *DV, *SGA, *SGB; float* KVT; float* DEC; bf16* MERGED;
    bf16 *XS, *ACT, *YS; float* LOGITS; float* gsort; int* stok;
    size_t end;
};
__host__ __device__ inline WS ws_map(unsigned char* b, int nb) {
    WS w; const size_t T = (size_t)nb * SEQ;
    w.ctl = (unsigned*)b; w.mod = (float*)(b + OFF_MOD); w.tab = (float*)(b + OFF_TAB);
    w.win = (bf16*)(b + OFF_WIN); w.wab = (bf16*)(b + OFF_WAB); w.wo = (bf16*)(b + OFF_WO); w.wr = (bf16*)(b + OFF_WR); w.w1 = (bf16*)(b + OFF_W1); w.w2 = (bf16*)(b + OFF_W2);
    size_t o = OFF_ACT;
    auto take = [&](size_t bytes) { unsigned char* p = b + o; o += (bytes + 255) & ~(size_t)255; return p; };
    w.H = (bf16*)take(T * 2048); w.OAB = (bf16*)take(T * 2048); w.XB = (bf16*)take(T * 2048);
    w.eid = (int*)take(T * 8); w.gate = (float*)take(T * 8); w.rank = (int*)take(T * 8); w.pos = (int*)take(T * 8); w.tilee = (int*)take(4096); w.segp = (int*)take(1024);
    const size_t u0 = o;
    w.GQ = (bf16*)take(T * 512); w.GK = (bf16*)take(T * 512); w.GV = (bf16*)take(T * 1024); w.SG = (bf16*)take(T * 1024);
    w.LGF = (bf16*)take(T * 512); w.LGB = (bf16*)take(T * 512);
    w.DQ = (bf16*)take(T * 1024); w.DK = (bf16*)take(T * 1024); w.DV = (bf16*)take(T * 1024); w.SGA = (bf16*)take(T * 2048); w.SGB = (bf16*)take(T * 2048);
    w.KVT = (float*)take(T * 4096); w.MERGED = (bf16*)w.KVT; w.DEC = (float*)take(T * 32);
    const size_t e1 = o; o = u0;
    const size_t R = 2 * T + 32 * 256;
    w.XS = (bf16*)take(R * 2048); w.ACT = (bf16*)take(R * 1024); w.YS = (bf16*)take(R * 2048); w.LOGITS = (float*)take(T * 256); w.gsort = (float*)take(R * 4); w.stok = (int*)take(R * 4);
    w.end = o > e1 ? o : e1;
    return w;
}

typedef float f32x2_t __attribute__((ext_vector_type(2))); typedef __bf16 bf16x2_t __attribute__((ext_vector_type(2)));
__device__ __forceinline__ unsigned cvt_pk(float lo, float hi) { const f32x2_t v = {lo, hi}; const bf16x2_t b = __builtin_convertvector(v, bf16x2_t); return __builtin_bit_cast(unsigned, b); }
__device__ __forceinline__ float bf2f(unsigned short b) { return __uint_as_float(((unsigned)b) << 16); }
__device__ __forceinline__ float bflo(unsigned w) { return __uint_as_float(w << 16); }
__device__ __forceinline__ float bfhi(unsigned w) { return __uint_as_float(w & 0xffff0000u); }
__device__ __forceinline__ float fsigmoid(float x) { return __builtin_amdgcn_rcpf(1.f + __expf(-x)); }
__device__ __forceinline__ float fsilu(float x) { return x * fsigmoid(x); }
__device__ __forceinline__ float wave_sum(float v) {
#pragma unroll
    for (int o = 1; o < 64; o <<= 1) v += __shfl_xor(v, o);
    return v;
}
__device__ __forceinline__ int t5_bucket(int rel) {
    int ret = rel > 0 ? 16 : 0; int n = rel < 0 ? -rel : rel;
    if (n < 8) return ret + n;
    return ret + 8 + (n >= 12) + (n >= 16) + (n >= 23) + (n >= 32) + (n >= 46) + (n >= 64) + (n >= 91);
}

#define XB_TMO      128
#define XB_XCNT(j)  (256  + 64 * (j))
#define XB_XSUB(j)  (1280 + 64 * (j))
#define XB_XGEN(j)  (2304 + 64 * (j))
#define XB_TOP      3328
#define XB_TOPGEN   3392
#define XCD_BAR_WORDS 3456
#define XB_SPIN_CAP (1u << 18)
__device__ __forceinline__ unsigned xb_ld(unsigned* p)              { return __hip_atomic_load(p, __ATOMIC_RELAXED, __HIP_MEMORY_SCOPE_AGENT); }
__device__ __forceinline__ unsigned xb_add(unsigned* p, unsigned v) { return __hip_atomic_fetch_add(p, v, __ATOMIC_RELAXED, __HIP_MEMORY_SCOPE_AGENT); }
__device__ __forceinline__ unsigned xb_xcc_id() { return (unsigned)__builtin_amdgcn_s_getreg((3 << 11) | 20) & 0xFu; }
#define XB_SPIN(cond, bar) do { unsigned _sp = 0; while (cond) { __builtin_amdgcn_s_sleep(1); \
    if ((++_sp & 255u) == 0u) { if (xb_ld(&(bar)[XB_TMO])) break; if (_sp > XB_SPIN_CAP) { atomicAdd(&(bar)[XB_TMO], 1u); break; } } } } while (0)
struct XcdBarrier { unsigned* bar; unsigned x; volatile LAS unsigned* st; };
__device__ __forceinline__ XcdBarrier xcd_barrier_post(unsigned* bar, volatile LAS unsigned* st) {
    XcdBarrier b; b.bar = bar; b.x = xb_xcc_id(); b.st = st;
    if (threadIdx.x == 0) (void)xb_add(&bar[XB_XCNT(b.x)], 1u);
    return b;
}
__device__ __forceinline__ void xcd_barrier_complete(unsigned* bar, unsigned x, unsigned& nloc, unsigned& nx) {
    const unsigned G = gridDim.x * gridDim.y * gridDim.z;
    unsigned sum, cnt, mine, sp = 0u;
    for (;;) {
        sum = 0u; cnt = 0u; mine = 0u;
#pragma unroll
        for (unsigned j = 0; j < 16; ++j) { const unsigned c = xb_ld(&bar[XB_XCNT(j)]); sum += c; cnt += (c > 0u) ? 1u : 0u; mine = (j == x) ? c : mine; }
        if (sum == G) break;
        __builtin_amdgcn_s_sleep(1);
        if ((++sp & 255u) == 0u) { if (xb_ld(&bar[XB_TMO])) break; if (sp > XB_SPIN_CAP) { atomicAdd(&bar[XB_TMO], 1u); break; } }
    }
    nloc = mine > 0u ? mine : 1u; nx = cnt > 0u ? cnt : 1u;
}
__device__ __forceinline__ void xcd_barrier(const XcdBarrier& b) {
    asm volatile("s_waitcnt vmcnt(0)" ::: "memory");
    __syncthreads();
    if (threadIdx.x == 0) {
        unsigned* bar = b.bar;
        __builtin_amdgcn_s_waitcnt(0);
        unsigned nloc = b.st[0], nx = b.st[1];
        if (nloc == 0u) { xcd_barrier_complete(bar, b.x, nloc, nx); b.st[0] = nloc; b.st[1] = nx; }
        const unsigned old = xb_add(&bar[XB_XSUB(b.x)], 1u);
        const unsigned gen = old / nloc;
        if (old + 1u == (gen + 1u) * nloc) {
            __builtin_amdgcn_fence(__ATOMIC_RELEASE, "agent");
            asm volatile("s_waitcnt vmcnt(0)" ::: "memory");
            const unsigned og = xb_add(&bar[XB_TOP], 1u);
            const unsigned tg = og / nx;
            if (og + 1u == (tg + 1u) * nx) xb_add(&bar[XB_TOPGEN], 1u);
            else XB_SPIN(xb_ld(&bar[XB_TOPGEN]) == tg, bar);
            __builtin_amdgcn_fence(__ATOMIC_ACQUIRE, "agent");
            xb_add(&bar[XB_XGEN(b.x)], 1u);
            asm volatile("s_waitcnt vmcnt(0)" ::: "memory");
        } else {
            XB_SPIN(xb_ld(&bar[XB_XGEN(b.x)]) == gen, bar);
            __builtin_amdgcn_fence(__ATOMIC_ACQUIRE, "agent");
            asm volatile("s_waitcnt vmcnt(0)" ::: "memory");
        }
    }
    __syncthreads();
}

struct Args { const float* in[24]; float* out; unsigned char* ws; int nb, ph_lo, ph_hi, li; };
struct Frame {
    LAS unsigned char* lds; int tid, lane, wave, G, bid, nb, T; unsigned char* ws; const Args* a; float* xbuf;
};
__device__ __forceinline__ void refresh(Frame& F) { int t = threadIdx.x; asm volatile("" : "+v"(t)); F.tid = t; F.lane = t & 63; F.wave = __builtin_amdgcn_readfirstlane(t >> 6); }
constexpr int LDS_BYTES = 160 * 1024 - 64 * 0;
constexpr int LDS_MISC = 160 * 1024 - 256;

__device__ __forceinline__ void tr_item(const float* src, int lds_, int ks0, int c0, bf16* dst, int ldd, int r0, int kd0, LAS float* scr, int lane) {
#pragma unroll 8
    for (int i = 0; i < 32; ++i) { const int kk = 2 * i + (lane >> 5); scr[kk * 33 + (lane & 31)] = src[(size_t)(ks0 + kk) * lds_ + c0 + (lane & 31)]; }
    LDS_WAIT(); asm volatile("" ::: "memory");
    const int c = lane & 7;
#pragma unroll
    for (int j = 0; j < 4; ++j) { const int n = (lane >> 3) + 8 * j; const LAS float* s = scr + (8 * c) * 33 + n;
        u32x4 o; o.x = cvt_pk(s[0 * 33], s[1 * 33]); o.y = cvt_pk(s[2 * 33], s[3 * 33]); o.z = cvt_pk(s[4 * 33], s[5 * 33]); o.w = cvt_pk(s[6 * 33], s[7 * 33]);
        *(u32x4*)(dst + (size_t)(r0 + n) * ldd + kd0 + 8 * c) = o; }
    LDS_WAIT(); asm volatile("" ::: "memory");
}
__device__ __forceinline__ void tr_item8(const float* src, int lds_, int ks0, int c0, unsigned char* dst, int ldd, int r0, int kd0, float scale, LAS float* scr, int lane) {
#pragma unroll 8
    for (int i = 0; i < 32; ++i) { const int kk = 2 * i + (lane >> 5); scr[kk * 33 + (lane & 31)] = src[(size_t)(ks0 + kk) * lds_ + c0 + (lane & 31)] * scale; }
    LDS_WAIT(); asm volatile("" ::: "memory");
    const int c = lane & 7;
#pragma unroll
    for (int j = 0; j < 4; ++j) { const int n = (lane >> 3) + 8 * j; const LAS float* s = scr + (8 * c) * 33 + n;
        int w0 = 0, w1 = 0;
        w0 = __builtin_amdgcn_cvt_pk_fp8_f32(s[0 * 33], s[1 * 33], w0, false); w0 = __builtin_amdgcn_cvt_pk_fp8_f32(s[2 * 33], s[3 * 33], w0, true);
        w1 = __builtin_amdgcn_cvt_pk_fp8_f32(s[4 * 33], s[5 * 33], w1, false); w1 = __builtin_amdgcn_cvt_pk_fp8_f32(s[6 * 33], s[7 * 33], w1, true);
        u32x2 o; o.x = (unsigned)w0; o.y = (unsigned)w1;
        *(u32x2*)(dst + (size_t)(r0 + n) * ldd + kd0 + 8 * c) = o; }
    LDS_WAIT(); asm volatile("" ::: "memory");
}
__device__ __forceinline__ int win_src_col(int tile, int p0) {
    const int bj = p0 >> 7, wc = (p0 >> 5) & 3; const int L = 64 * wc + 32 * bj;
    switch (tile) {
        case 0: return O_GQ + p0; case 1: return O_GK + p0;
        case 2: case 3: return O_GV + (tile - 2) * 256 + p0;
        case 4: case 5: return O_GG + (tile - 4) * 256 + p0;
        case 8: case 9: return O_DQ + (tile - 8) * 256 + L;
        case 10: case 11: return O_DK + (tile - 10) * 256 + L;
        case 12: case 13: return O_DV + (tile - 12) * 256 + p0;
        case 14: case 15: case 16: case 17: return O_GA + (tile - 14) * 256 + p0;
        default: return O_GB + (tile - 18) * 256 + p0;
    }
}
__device__ __forceinline__ void p0_prologue(Frame& F) {
    refresh(F);
    const WS W = ws_map(F.ws, F.nb); const float* const* IN_ = F.a->in;
    const float* c_in = IN_[1]; const float* w_ada = IN_[2]; const float* b_ada = IN_[3];
    {
        LAS float* red = (LAS float*)F.lds;
        for (int it = F.bid; it < DEPTH * 96; it += F.G) {
            const int l = it / 96, j = (it % 96) * 64 + F.lane;
            const float* w = w_ada + (size_t)l * D * 6 * D + j;
            float a0 = 0.f, a1 = 0.f, a2 = 0.f, a3 = 0.f;
            const int kbeg = F.wave * 128;
#pragma unroll 16
            for (int k = kbeg; k < kbeg + 128; ++k) { const float wv = w[(size_t)k * 6 * D];
                const float c0 = c_in[k], c1 = c_in[D + k], c2 = c_in[2 * D + k], c3 = c_in[3 * D + k];
                a0 += fsilu(c0) * wv; a1 += fsilu(c1) * wv; a2 += fsilu(c2) * wv; a3 += fsilu(c3) * wv; }
            red[(F.wave * 4 + 0) * 64 + F.lane] = a0; red[(F.wave * 4 + 1) * 64 + F.lane] = a1; red[(F.wave * 4 + 2) * 64 + F.lane] = a2; red[(F.wave * 4 + 3) * 64 + F.lane] = a3;
            __syncthreads();
            if (F.tid < 256) { const int b = F.tid >> 6, jj = F.tid & 63; float s = 0.f;
#pragma unroll
                for (int wv = 0; wv < 8; ++wv) s += red[(wv * 4 + b) * 64 + jj];
                const int jc = (it % 96) * 64 + jj;
                W.mod[((size_t)l * NBMAX + b) * 6 * D + jc] = s + b_ada[l * 6 * D + jc]; }
            __syncthreads();
        }
    }
    if (F.bid == 0) {
        const float* rb = IN_[14];
        for (int i = F.tid; i < 1024; i += NTHR) { const int h = i >> 8, rel = (i & 255) - 128; W.tab[i] = (rb[t5_bucket(rel) * 4 + h] - rb[31 * 4 + h]) * LOG2E; }
        if (F.tid < 4) W.tab[1024 + F.tid] = __expf(rb[15 * 4 + F.tid] - rb[31 * 4 + F.tid]);
        if (F.tid >= 64 && F.tid < 64 + DEPTH) { const int l = F.tid - 64; const float* lv = IN_[12] + l * 256; float s1 = 0.f, s2 = 0.f;
            for (int i = 0; i < 64; ++i) { s1 += lv[i] * lv[64 + i]; s2 += lv[128 + i] * lv[192 + i]; }
            W.tab[1032 + l] = expf(s1) - expf(s2) + (0.8f - 0.6f * expf(-0.3f * (float)l)); }
    }
    __syncthreads();
    LAS float* scr = (LAS float*)(F.lds + F.wave * 16384);
    const int gw = F.bid * NWAVES + F.wave, NGW = F.G * NWAVES;
    constexpr int I_IN = (NIN / 32) * 16, I_AB = 32 * 16, I_O = 32 * 16, I_1 = NE * 32 * 16, I_2 = NE * 32 * 8;
    constexpr int PER_L = I_IN + I_AB + I_O + I_1 + I_2;
    for (int it = gw; it < DEPTH * PER_L; it += NGW) {
        const int l = it / PER_L; int r = it % PER_L;
        if (r < I_IN) { const int rb = r / 16, kb = r % 16, R = rb * 32, tile = R >> 8, p0 = R & 255;
            if (tile == 6 || tile == 7) continue;
            tr_item(IN_[6] + (size_t)l * D * DIN, DIN, kb * 64, win_src_col(tile, p0), W.win + (size_t)l * NIN * D, D, R, kb * 64, scr, F.lane); continue; }
        r -= I_IN;
        if (r < I_AB) { const int rb = r / 16, kb = r % 16;
            if (kb < 8) tr_item(IN_[15] + (size_t)l * 512 * D, D, kb * 64, rb * 32, W.wab + (size_t)l * D * D, 512, rb * 32, kb * 64, scr, F.lane);
            else tr_item(IN_[16] + (size_t)l * 512 * D, D, (kb - 8) * 64, rb * 32, W.wab + (size_t)l * D * D + (size_t)1024 * 512, 512, rb * 32, (kb - 8) * 64, scr, F.lane);
            continue; }
        r -= I_AB;
        if (r < I_O) { const int rb = r / 16, kb = r % 16; tr_item(IN_[17] + (size_t)l * D * D, D, kb * 64, rb * 32, W.wo + (size_t)l * D * D, D, rb * 32, kb * 64, scr, F.lane); continue; }
        r -= I_O;
        if (r < I_1) { const int e = r / 512, q = r % 512, rb = q / 16, kb = q % 16, R = rb * 32, pn = R >> 8, p = R & 255;
            const int col = (p < 128) ? (128 * pn + p) : (512 + 128 * pn + p - 128);
#if MK_MOE_FP8
            tr_item8(IN_[22] + ((size_t)l * NE + e) * D * 1024, 1024, kb * 64, col, (unsigned char*)W.w1 + ((size_t)l * NE + e) * 1024 * D, D, R, kb * 64, WSCALE, scr, F.lane); continue; }
#else
            tr_item(IN_[22] + ((size_t)l * NE + e) * D * 1024, 1024, kb * 64, col, W.w1 + ((size_t)l * NE + e) * 1024 * D, D, R, kb * 64, scr, F.lane); continue; }
#endif
        r -= I_1;
        { const int e = r / 256, q = r % 256, rb = q / 8, kb = q % 8;
#if MK_MOE_FP8
          tr_item8(IN_[23] + ((size_t)l * NE + e) * DE * D, D, kb * 64, rb * 32, (unsigned char*)W.w2 + ((size_t)l * NE + e) * D * DE, DE, rb * 32, kb * 64, WSCALE, scr, F.lane); }
#else
          tr_item(IN_[23] + ((size_t)l * NE + e) * DE * D, D, kb * 64, rb * 32, W.w2 + ((size_t)l * NE + e) * D * DE, DE, rb * 32, kb * 64, scr, F.lane); }
#endif
    }
    for (int it = gw; it < DEPTH * 2 * 8 * 16; it += NGW) {
        const int l = it >> 8, dir = (it >> 7) & 1, nbk = (it >> 4) & 7, kb = it & 15; const int k = kb * 64 + F.lane;
        const float* wi = IN_[6] + (size_t)l * D * DIN + (size_t)k * DIN + (dir ? O_LRB : O_LRF);
        float wv[16];
#pragma unroll
        for (int r = 0; r < 16; ++r) wv[r] = wi[r];
        const float* wu = IN_[7] + ((size_t)l * 2 + dir) * 16 * 256;
        bf16* dst = W.win + (size_t)l * NIN * D + (size_t)((6 + dir) * 256) * D;
        for (int n = nbk * 32; n < nbk * 32 + 32; ++n) { float s = 0.f;
#pragma unroll
            for (int r = 0; r < 16; ++r) s += wv[r] * wu[r * 256 + n];
            dst[(size_t)n * D + k] = (bf16)(cvt_pk(s, 0.f) & 0xffffu); }
    }
    for (int it = gw * 64 + F.lane; it < DEPTH * 256 * 128; it += NGW * 64) {
        const int l = it / (256 * 128), q = it % (256 * 128), row = q >> 7, k0 = (q & 127) * 8;
        float v[8];
#pragma unroll
        for (int i = 0; i < 8; ++i) { float x = 0.f;
            if (row < 4) x = IN_[18][((size_t)l * D + k0 + i) * 4 + row]; else if (row < 36) x = IN_[20][((size_t)l * D + k0 + i) * 32 + row - 4];
            v[i] = x; }
        u32x4 o; o.x = cvt_pk(v[0], v[1]); o.y = cvt_pk(v[2], v[3]); o.z = cvt_pk(v[4], v[5]); o.w = cvt_pk(v[6], v[7]);
        *(u32x4*)(W.wr + ((size_t)l * 256 + row) * D + k0) = o;
    }
}

__device__ __forceinline__ void phase_norm(Frame& F, int l, int mode) {
    refresh(F);
    const WS W = ws_map(F.ws, F.nb); const float* const* IN_ = F.a->in;
    const int gw = F.bid * NWAVES + F.wave, NGW = F.G * NWAVES;
    const bool combine = (mode == 2) || (mode == 0 && l > 0);
    const bool from_in = (mode == 0 && l == 0);
    const int lp = (mode == 2) ? DEPTH - 1 : l - 1;
    const float* ng = (mode == 1 ? IN_[5] : IN_[4]) + (size_t)(mode == 2 ? 0 : l) * D;
    for (int t = gw; t < F.T; t += NGW) {
        const int b = t / SEQ;
        f32x4 v[4];
        if (from_in) { const GAS f32x4* xr = (const GAS f32x4*)(IN_[0] + (size_t)t * D) + F.lane;
#pragma unroll
            for (int j = 0; j < 4; ++j) v[j] = xr[64 * j]; }
        else { const GAS u32x2* xr = (const GAS u32x2*)(W.XB + (size_t)t * D) + F.lane;
#pragma unroll
            for (int j = 0; j < 4; ++j) { const u32x2 a = xr[64 * j]; v[j] = (f32x4){bflo(a.x), bfhi(a.x), bflo(a.y), bfhi(a.y)}; } }
        if (combine) {
            const float* g2 = W.mod + ((size_t)lp * NBMAX + b) * 6 * D + 5 * D;
            const int p0 = W.pos[t * 2], p1 = W.pos[t * 2 + 1];
            const GAS unsigned* y0 = (const GAS unsigned*)((const unsigned char*)W.YS + (size_t)p0 * D) + F.lane; const GAS unsigned* y1 = (const GAS unsigned*)((const unsigned char*)W.YS + (size_t)p1 * D) + F.lane;
#pragma unroll
            for (int j = 0; j < 4; ++j) { const unsigned a = y0[64 * j], c = y1[64 * j]; const f32x4 g = *((const GAS f32x4*)g2 + F.lane + 64 * j) * (1.f / YSCALE);
                v[j].x += g.x * (__builtin_amdgcn_cvt_f32_fp8((int)a, 0) + __builtin_amdgcn_cvt_f32_fp8((int)c, 0)); v[j].y += g.y * (__builtin_amdgcn_cvt_f32_fp8((int)a, 1) + __builtin_amdgcn_cvt_f32_fp8((int)c, 1));
                v[j].z += g.z * (__builtin_amdgcn_cvt_f32_fp8((int)a, 2) + __builtin_amdgcn_cvt_f32_fp8((int)c, 2)); v[j].w += g.w * (__builtin_amdgcn_cvt_f32_fp8((int)a, 3) + __builtin_amdgcn_cvt_f32_fp8((int)c, 3)); }
            if (mode == 2) { GAS f32x4* xo = (GAS f32x4*)(F.xbuf + (size_t)t * D) + F.lane;
#pragma unroll
                for (int j = 0; j < 4; ++j) xo[64 * j] = v[j]; }
            else { GAS u32x2* xo = (GAS u32x2*)(W.XB + (size_t)t * D) + F.lane;
#pragma unroll
                for (int j = 0; j < 4; ++j) { u32x2 o; o.x = cvt_pk(v[j].x, v[j].y); o.y = cvt_pk(v[j].z, v[j].w); xo[64 * j] = o; } }
        }
        if (mode == 2) continue;
        float ss = 0.f;
#pragma unroll
        for (int j = 0; j < 4; ++j) ss += (v[j].x * v[j].x + v[j].y * v[j].y) + (v[j].z * v[j].z + v[j].w * v[j].w);
        const float rstd = rsqrtf(wave_sum(ss) * (1.f / D) + RMS_EPS);
        const float* md = W.mod + ((size_t)l * NBMAX + b) * 6 * D + (mode == 1 ? 3 * D : 0);
        GAS u32x2* ho = (GAS u32x2*)(W.H + (size_t)t * D) + F.lane;
#pragma unroll
        for (int j = 0; j < 4; ++j) { const f32x4 g = *((const GAS f32x4*)ng + F.lane + 64 * j), sh = *((const GAS f32x4*)md + F.lane + 64 * j), sc = *((const GAS f32x4*)(md + D) + F.lane + 64 * j);
            const float h0 = v[j].x * rstd * g.x * (1.f + sc.x) + sh.x, h1 = v[j].y * rstd * g.y * (1.f + sc.y) + sh.y, h2 = v[j].z * rstd * g.z * (1.f + sc.z) + sh.z, h3 = v[j].w * rstd * g.w * (1.f + sc.w) + sh.w;
            u32x2 o; o.x = cvt_pk(h0, h1); o.y = cvt_pk(h2, h3); ho[64 * j] = o; }
    }
}
typedef pg8::Unit Unit;
__device__ __forceinline__ u32x4 pack8(const f32x4& a, const f32x4& b) { u32x4 w; w.x = cvt_pk(a[0], a[1]); w.y = cvt_pk(a[2], a[3]); w.z = cvt_pk(b[0], b[1]); w.w = cvt_pk(b[2], b[3]); return w; }

#ifndef MK_ATT_FP8
#define MK_ATT_FP8 1
#endif
__device__ __forceinline__ u32x2 pack8_fp8(const f32x4& a, const f32x4& b) { int w0 = 0, w1 = 0;
    w0 = __builtin_amdgcn_cvt_pk_fp8_f32(a[0], a[1], w0, false); w0 = __builtin_amdgcn_cvt_pk_fp8_f32(a[2], a[3], w0, true);
    w1 = __builtin_amdgcn_cvt_pk_fp8_f32(b[0], b[1], w1, false); w1 = __builtin_amdgcn_cvt_pk_fp8_f32(b[2], b[3], w1, true);
    u32x2 r; r.x = (unsigned)w0; r.y = (unsigned)w1; return r; }
struct EpiNull {
    static constexpr bool PERM = true, AFTER_DRAIN = false, MIDK = false;
    __device__ __forceinline__ void operator()(const f32x4 (&acc)[2][2][4][2], const Unit&, int, int, int, int) const {
#pragma unroll
        for (int a = 0; a < 2; ++a)
#pragma unroll
            for (int b = 0; b < 2; ++b)
#pragma unroll
                for (int m = 0; m < 4; ++m) { asm volatile("" :: "v"(acc[a][b][m][0]), "v"(acc[a][b][m][1])); } }
};
struct EpiIn {
    static constexpr bool PERM = true, AFTER_DRAIN = false, MIDK = false;
    bf16 *GQ, *GK, *GV, *SG, *LGF, *LGB, *DQ, *DK, *DV, *SGA, *SGB; const float* b_up; const float* qg; const float* kg; int plain;
    __device__ __forceinline__ void operator()(const f32x4 (&acc)[2][2][4][2], const Unit& u, int wr, int wc, int fr, int fq) const {
        const int pn = u.pn; const int row0 = u.pm * 256 + wr * 64 + fr;
        if (pn >= 8 && pn <= 11) {
            const bool isk = pn >= 10; const int head = 2 * ((pn - 8) & 1) + (wc >> 1), c = wc & 1;
            const float* gv = isk ? kg : qg; const float sc = isk ? 1.f : QSCALE;
            f32x4 g[2][2];
#pragma unroll
            for (int bj = 0; bj < 2; ++bj)
#pragma unroll
                for (int n = 0; n < 2; ++n) g[bj][n] = *(const f32x4*)(gv + 32 * bj + 8 * fq + 4 * n);
#pragma unroll
            for (int ai = 0; ai < 2; ++ai)
#pragma unroll
                for (int m = 0; m < 4; ++m) {
                    const int r = row0 + ai * 128 + m * 16, b = r / SEQ, s = r % SEQ;
                    float ss = 0.f;
#pragma unroll
                    for (int bj = 0; bj < 2; ++bj)
#pragma unroll
                        for (int n = 0; n < 2; ++n) { const f32x4 x = acc[ai][bj][m][n]; ss += (x[0] * x[0] + x[1] * x[1]) + (x[2] * x[2] + x[3] * x[3]); }
                    ss += __shfl_xor(ss, 16); ss += __shfl_xor(ss, 32);
                    const float rs = rsqrtf(ss * (1.f / 64.f) + RMS_EPS) * sc;
#if MK_ATT_FP8
                    unsigned char* dst8 = (unsigned char*)(isk ? DK : DQ) + ((((size_t)b * NH + head) * 2 + c) * SEQ + s) * 64;
#pragma unroll
                    for (int bj = 0; bj < 2; ++bj) {
                        const f32x4 v0 = acc[ai][bj][m][0] * rs * g[bj][0], v1 = acc[ai][bj][m][1] * rs * g[bj][1];
                        int chunk = 2 * bj + (fq >> 1); if (isk) chunk ^= ((s >> 2) & 3);
                        *(u32x2*)(dst8 + chunk * 16 + 8 * (fq & 1)) = pack8_fp8(v0, v1);
                    }
#else
                    bf16* dst = (isk ? DK : DQ) + ((((size_t)b * NH + head) * 2 + c) * SEQ + s) * 64;
#pragma unroll
                    for (int bj = 0; bj < 2; ++bj) {
                        const f32x4 v0 = acc[ai][bj][m][0] * rs * g[bj][0], v1 = acc[ai][bj][m][1] * rs * g[bj][1];
                        int chunk = 4 * bj + fq; if (isk) chunk ^= ((s >> 1) & 7);
                        *(u32x4*)(dst + chunk * 8) = pack8(v0, v1);
                    }
#endif
                }
            return;
        }
#pragma unroll
        for (int ai = 0; ai < 2; ++ai)
#pragma unroll
            for (int m = 0; m < 4; ++m) {
                const int r = row0 + ai * 128 + m * 16;
#pragma unroll
                for (int bj = 0; bj < 2; ++bj) {
                    const int c0 = 128 * bj + 32 * wc + 8 * fq;
                    f32x4 v0 = acc[ai][bj][m][0], v1 = acc[ai][bj][m][1];
                    if (plain) { *(u32x4*)(SGA + (size_t)r * D + (pn & 3) * 256 + c0) = pack8(v0, v1); }
                    else if (pn == 0) { *(u32x4*)(GQ + (size_t)r * 256 + c0) = pack8(v0 * 0.125f, v1 * 0.125f); }
                    else if (pn == 1) { *(u32x4*)(GK + (size_t)r * 256 + c0) = pack8(v0, v1); }
                    else if (pn <= 3) { *(u32x4*)(GV + (size_t)r * 512 + (pn - 2) * 256 + c0) = pack8(v0, v1); }
                    else if (pn <= 5) {
#pragma unroll
                        for (int i = 0; i < 4; ++i) { v0[i] = fsilu(v0[i]); v1[i] = fsilu(v1[i]); }
                        *(u32x4*)(SG + (size_t)r * 512 + (pn - 4) * 256 + c0) = pack8(v0, v1); }
                    else if (pn <= 7) {
                        const float* bu = b_up + (pn - 6) * 256 + c0; const f32x4 b0 = *(const f32x4*)bu, b1 = *(const f32x4*)(bu + 4);
#pragma unroll
                        for (int i = 0; i < 4; ++i) { float z = v0[i] + b0[i]; v0[i] = (fminf(z, 0.f) - __logf(1.f + __expf(-fabsf(z)))) * (1.f / 16.f);
                                                      z = v1[i] + b1[i]; v1[i] = (fminf(z, 0.f) - __logf(1.f + __expf(-fabsf(z)))) * (1.f / 16.f); }
                        *(u32x4*)((pn == 6 ? LGF : LGB) + (size_t)r * 256 + c0) = pack8(v0, v1); }
#if MK_ATT_FP8
                    else if (pn <= 13) {
                        const int b = r / SEQ, s = r % SEQ, head = 2 * (pn - 12) + bj;
                        const int kk = s & 63, wkey = kk & 31, hh_ = (wkey >> 2) & 1, reg_ = (wkey & 3) + 4 * (wkey >> 3), pos = hh_ * 32 + 16 * (kk >> 5) + reg_;
                        unsigned char* tb = (unsigned char*)DV + (((size_t)b * NH + head) * (SEQ / 64) + (s >> 6)) * 8192;
                        const u32x2 pk = pack8_fp8(v0, v1); const int dv0 = 32 * wc + 8 * fq;
#pragma unroll
                        for (int i = 0; i < 8; ++i) { const int dv = dv0 + i; const unsigned byte = ((i < 4 ? pk.x : pk.y) >> (8 * (i & 3))) & 0xffu;
                            tb[dv * 64 + ((((pos >> 4) ^ ((dv >> 2) & 3)) << 4) | (pos & 15))] = (unsigned char)byte; } }
#else
                    else if (pn <= 13) {
                        const int b = r / SEQ, s = r % SEQ, head = 2 * (pn - 12) + bj;
                        bf16* dst = DV + ((((size_t)b * NH + head) * (SEQ / 8) + (s >> 3)) * 4 + wc) * 256 + (s & 7) * 32 + 8 * fq;
                        *(u32x4*)dst = pack8(v0, v1); }
#endif
                    else {
#pragma unroll
                        for (int i = 0; i < 4; ++i) { v0[i] = fsigmoid(v0[i]); v1[i] = fsigmoid(v1[i]); }
                        bf16* base = (pn <= 17) ? SGA + (pn - 14) * 256 : SGB + (pn - 18) * 256;
                        *(u32x4*)(base + (size_t)r * D + c0) = pack8(v0, v1); }
                }
            }
    }
};

struct EpiMerge {
    static constexpr bool PERM = true, AFTER_DRAIN = false, MIDK = false;
    const bf16* SGA; const bf16* SGB; bf16* O; int nM;
    __device__ __forceinline__ void operator()(const f32x4 (&acc)[2][2][4][2], const Unit& u, int wr, int wc, int fr, int fq) const {
        const int sel = u.pn >> 2; const int row0 = (u.pm - sel * nM) * 256 + wr * 64 + fr, col0 = (u.pn & 3) * 256 + wc * 32 + 8 * fq;
        const bf16* G = sel ? SGB : SGA;
#pragma unroll
        for (int ai = 0; ai < 2; ++ai) {
            u32x4 gt[4][2], t1[4][2];
#pragma unroll
            for (int m = 0; m < 4; ++m) { const size_t off = (size_t)(row0 + ai * 128 + m * 16) * D + col0;
#pragma unroll
                for (int bj = 0; bj < 2; ++bj) { gt[m][bj] = *(const u32x4*)(G + off + bj * 128); if (sel) t1[m][bj] = *(const u32x4*)(O + off + bj * 128); } }
#pragma unroll
            for (int m = 0; m < 4; ++m) { const size_t off = (size_t)(row0 + ai * 128 + m * 16) * D + col0;
#pragma unroll
                for (int bj = 0; bj < 2; ++bj) { const u32x4 b = gt[m][bj];
                    f32x4 v0 = acc[ai][bj][m][0], v1 = acc[ai][bj][m][1];
                    v0[0] *= bflo(b.x); v0[1] *= bfhi(b.x); v0[2] *= bflo(b.y); v0[3] *= bfhi(b.y); v1[0] *= bflo(b.z); v1[1] *= bfhi(b.z); v1[2] *= bflo(b.w); v1[3] *= bfhi(b.w);
                    if (sel) { const u32x4 t = t1[m][bj];
                        v0[0] += bflo(t.x); v0[1] += bfhi(t.x); v0[2] += bflo(t.y); v0[3] += bfhi(t.y); v1[0] += bflo(t.z); v1[1] += bfhi(t.z); v1[2] += bflo(t.w); v1[3] += bfhi(t.w); }
                    *(u32x4*)(O + off + bj * 128) = pack8(v0, v1); } }
            asm volatile("" ::: "memory");
        }
    }
};
struct MergeOrder {
    pg8::StaticOrder so; int nM;
    __device__ __forceinline__ bool next(int i, Unit& u) const { Unit t; if (!so.next(i >> 1, t)) return false; const int sel = i & 1; u.pm = t.pm + sel * nM; u.pn = t.pn + sel * 4; return true; }
    __device__ __forceinline__ void a_ready(const Unit&) const {}
    __device__ __forceinline__ void done(const Unit&) const {}
};

struct EpiResid {
    static constexpr bool PERM = true, AFTER_DRAIN = false, MIDK = false;
    const float* xin32; bf16* xb; const float* g1;
    __device__ __forceinline__ void operator()(const f32x4 (&acc)[2][2][4][2], const Unit& u, int wr, int wc, int fr, int fq) const {
        const int row0 = u.pm * 256 + wr * 64 + fr, col0 = u.pn * 256 + wc * 32 + 8 * fq;
        const int b = (u.pm * 256) / SEQ; const float* g = g1 + (size_t)b * 6 * D + col0;
        f32x4 gv[2][2];
#pragma unroll
        for (int bj = 0; bj < 2; ++bj)
#pragma unroll
            for (int n = 0; n < 2; ++n) gv[bj][n] = *(const f32x4*)(g + bj * 128 + n * 4);
        if (xin32) {
#pragma unroll
            for (int ai = 0; ai < 2; ++ai)
#pragma unroll
                for (int mh = 0; mh < 2; ++mh) { f32x4 x0[2][2], x1[2][2];
#pragma unroll
                    for (int m2 = 0; m2 < 2; ++m2) { const size_t off = (size_t)(row0 + ai * 128 + (2 * mh + m2) * 16) * D + col0;
#pragma unroll
                        for (int bj = 0; bj < 2; ++bj) { x0[m2][bj] = *(const f32x4*)(xin32 + off + bj * 128); x1[m2][bj] = *(const f32x4*)(xin32 + off + bj * 128 + 4); } }
#pragma unroll
                    for (int m2 = 0; m2 < 2; ++m2) { const int m = 2 * mh + m2; const size_t off = (size_t)(row0 + ai * 128 + m * 16) * D + col0;
#pragma unroll
                        for (int bj = 0; bj < 2; ++bj) *(u32x4*)(xb + off + bj * 128) = pack8(x0[m2][bj] + gv[bj][0] * acc[ai][bj][m][0], x1[m2][bj] + gv[bj][1] * acc[ai][bj][m][1]); }
                    asm volatile("" ::: "memory"); }
        } else {
#pragma unroll
            for (int ai = 0; ai < 2; ++ai) { u32x4 xr[4][2];
#pragma unroll
                for (int m = 0; m < 4; ++m) { const size_t off = (size_t)(row0 + ai * 128 + m * 16) * D + col0;
#pragma unroll
                    for (int bj = 0; bj < 2; ++bj) xr[m][bj] = *(const u32x4*)(xb + off + bj * 128); }
#pragma unroll
                for (int m = 0; m < 4; ++m) { const size_t off = (size_t)(row0 + ai * 128 + m * 16) * D + col0;
#pragma unroll
                    for (int bj = 0; bj < 2; ++bj) { const u32x4 a = xr[m][bj];
                        const f32x4 x0 = {bflo(a.x), bfhi(a.x), bflo(a.y), bfhi(a.y)}, x1 = {bflo(a.z), bfhi(a.z), bflo(a.w), bfhi(a.w)};
                        *(u32x4*)(xb + off + bj * 128) = pack8(x0 + gv[bj][0] * acc[ai][bj][m][0], x1 + gv[bj][1] * acc[ai][bj][m][1]); } }
                asm volatile("" ::: "memory"); }
        }
    }
};

struct EpiLogits {
    static constexpr bool PERM = false, AFTER_DRAIN = false, MIDK = false;
    float* L;
    __device__ __forceinline__ void operator()(const f32x4 (&acc)[2][2][4][2], const Unit& u, int wr, int wc, int fr, int fq) const {
        if (wc >= 2) return;
        const int row0 = u.pm * 256 + wr * 64 + fr, col0 = wc * 32 + 4 * fq;
#pragma unroll
        for (int ai = 0; ai < 2; ++ai)
#pragma unroll
            for (int m = 0; m < 4; ++m)
#pragma unroll
                for (int n = 0; n < 2; ++n) *(f32x4*)(L + (size_t)(row0 + ai * 128 + m * 16) * 64 + col0 + n * 16) = acc[ai][0][m][n];
    }
};

#ifndef MK_MOE_FP8
#define MK_MOE_FP8 0
#endif
#if MK_MOE_FP8
struct EpiAct {
    static constexpr bool PERM = true, AFTER_DRAIN = false, MIDK = false;
    unsigned char* ACT;
    __device__ __forceinline__ void operator()(const f32x4 (&acc)[2][2][4][2], const Unit& u, int wr, int wc, int fr, int fq) const {
        const int row0 = u.pm * 256 + wr * 64 + fr, col0 = (u.pn & 3) * 128 + wc * 32 + 8 * fq;
        constexpr float inv = 1.f / WSCALE;
#pragma unroll
        for (int ai = 0; ai < 2; ++ai)
#pragma unroll
            for (int m = 0; m < 4; ++m) { f32x4 v0, v1;
#pragma unroll
                for (int i = 0; i < 4; ++i) { v0[i] = fsilu(acc[ai][0][m][0][i] * inv) * acc[ai][1][m][0][i] * (inv * ASCALE); v1[i] = fsilu(acc[ai][0][m][1][i] * inv) * acc[ai][1][m][1][i] * (inv * ASCALE); }
                *(u32x2*)(ACT + (size_t)(row0 + ai * 128 + m * 16) * DE + col0) = pack8_fp8(v0, v1); }
    }
};
struct EpiYs {
    static constexpr bool PERM = true, AFTER_DRAIN = false, MIDK = false;
    bf16* YS; const float* gs;
    __device__ __forceinline__ void operator()(const f32x4 (&acc)[2][2][4][2], const Unit& u, int wr, int wc, int fr, int fq) const {
        const int row0 = u.pm * 256 + wr * 64 + fr, col0 = (u.pn & 3) * 256 + wc * 32 + 8 * fq;
#pragma unroll
        for (int ai = 0; ai < 2; ++ai)
#pragma unroll
            for (int m = 0; m < 4; ++m) { const int r = row0 + ai * 128 + m * 16; const float gt = gs[r] * (1.f / (WSCALE * ASCALE));
#pragma unroll
                for (int bj = 0; bj < 2; ++bj) *(u32x4*)(YS + (size_t)r * D + col0 + bj * 128) = pack8(acc[ai][bj][m][0] * gt, acc[ai][bj][m][1] * gt); }
    }
};
#else
struct EpiAct {
    static constexpr bool PERM = true, AFTER_DRAIN = false, MIDK = false;
    bf16* ACT;
    __device__ __forceinline__ void operator()(const f32x4 (&acc)[2][2][4][2], const Unit& u, int wr, int wc, int fr, int fq) const {
        const int row0 = u.pm * 256 + wr * 64 + fr, col0 = (u.pn & 3) * 128 + wc * 32 + 8 * fq;
#pragma unroll
        for (int ai = 0; ai < 2; ++ai)
#pragma unroll
            for (int m = 0; m < 4; ++m) { f32x4 v0, v1;
#pragma unroll
                for (int i = 0; i < 4; ++i) { v0[i] = fsilu(acc[ai][0][m][0][i]) * acc[ai][1][m][0][i]; v1[i] = fsilu(acc[ai][0][m][1][i]) * acc[ai][1][m][1][i]; }
                *(u32x4*)(ACT + (size_t)(row0 + ai * 128 + m * 16) * DE + col0) = pack8(v0, v1); }
    }
};
struct EpiYs {
    static constexpr bool PERM = true, AFTER_DRAIN = false, MIDK = false;
    unsigned char* YS; const float* gs;
    __device__ __forceinline__ void operator()(const f32x4 (&acc)[2][2][4][2], const Unit& u, int wr, int wc, int fr, int fq) const {
        const int row0 = u.pm * 256 + wr * 64 + fr, col0 = (u.pn & 3) * 256 + wc * 32 + 8 * fq;
        float gts[2][4];
#pragma unroll
        for (int ai = 0; ai < 2; ++ai)
#pragma unroll
            for (int m = 0; m < 4; ++m) gts[ai][m] = gs[row0 + ai * 128 + m * 16] * YSCALE;
#pragma unroll
        for (int ai = 0; ai < 2; ++ai)
#pragma unroll
            for (int m = 0; m < 4; ++m) { const int r = row0 + ai * 128 + m * 16; const float gt = gts[ai][m];
#pragma unroll
                for (int bj = 0; bj < 2; ++bj) *(u32x2*)(YS + (size_t)r * D + col0 + bj * 128) = pack8_fp8(acc[ai][bj][m][0] * gt, acc[ai][bj][m][1] * gt); }
    }
};
#endif
struct GroupedOrder {
    const int* tilee; int U, G, c; const int* rowidx;
    __device__ __forceinline__ bool next(int i, Unit& u) const {
        int id;
        if ((G & 7) == 0) { const int gx = G >> 3, per = (U + 7) >> 3, n = i * gx + (c >> 3); if (n >= per) return false; id = (c & 7) * per + n; if (id >= U) return false; }
        else { id = i * G + c; if (id >= U) return false; }
        const int t = id >> 2; u.pm = t; u.pn = tilee[t] * 4 + (id & 3); return true;
    }
    __device__ __forceinline__ void a_ready(const Unit&) const {}
    __device__ __forceinline__ void done(const Unit&) const {}
};
constexpr int AT_KR = 0, AT_VR = 32768, AT_TAB = 98304, AT_SLOT = 8192;
typedef int v8i __attribute__((ext_vector_type(8)));
typedef int v4i __attribute__((ext_vector_type(4)));
__device__ __forceinline__ int crow(int r, int hi) { return (r & 3) + 8 * (r >> 2) + 4 * hi; }

__device__ __forceinline__ void attn_bias(f32x16& s0, f32x16& s1, int relbase, const LAS float* tabh) {
#pragma unroll
    for (int r = 0; r < 16; ++r) {
        int i0 = relbase + (r & 3) + 8 * (r >> 2); int i1 = i0 + 32;
        i0 = i0 < 0 ? 0 : (i0 > 255 ? 255 : i0); i1 = i1 < 0 ? 0 : (i1 > 255 ? 255 : i1);
        s0[r] += tabh[i0]; s1[r] += tabh[i1];
    }
}
template <int J>
__device__ __forceinline__ void attn_exp_chunk(f32x16& s0, f32x16& s1, float& lsum) {
    float ls = 0.f;
#pragma unroll
    for (int r = 4 * J; r < 4 * J + 4; ++r) { s0[r] = __builtin_amdgcn_exp2f(s0[r]); s1[r] = __builtin_amdgcn_exp2f(s1[r]); }
    (void)ls; (void)lsum;
}
typedef short v2s_t __attribute__((ext_vector_type(2)));
__device__ __forceinline__ int pk4_bf8(float a, float b, float c, float d) { v2s_t w = {0, 0}; w = __builtin_amdgcn_cvt_scalef32_pk_bf8_f32(w, a, b, 16.0f, false); w = __builtin_amdgcn_cvt_scalef32_pk_bf8_f32(w, c, d, 16.0f, true); return __builtin_bit_cast(int, w); }
__device__ __forceinline__ void glds16(const void* gsrc, unsigned lds_dst) { unsigned keep;
    asm volatile("s_mov_b32 %0, m0\n\ts_mov_b32 m0, %2\n\ts_nop 0\n\tglobal_load_lds_dwordx4 %1, off\n\ts_mov_b32 m0, %0" : "=&s"(keep) : "v"(gsrc), "s"(lds_dst) : "memory"); }
__device__ __forceinline__ void attn_dma_k(unsigned lds0, const unsigned char* kg0, int t, int slot, int wid, int lane) {
    glds16(kg0 + (size_t)(wid >> 2) * SEQ * 64 + (size_t)t * 4096 + (wid & 3) * 1024 + lane * 16, (unsigned)__builtin_amdgcn_readfirstlane((int)(lds0 + AT_KR + slot * AT_SLOT + wid * 1024)));
}
__device__ __forceinline__ void attn_dma_v(unsigned lds0, const unsigned char* vg0, int t, int slot, int wid, int lane) {
    glds16(vg0 + (size_t)t * 8192 + wid * 1024 + lane * 16, (unsigned)__builtin_amdgcn_readfirstlane((int)(lds0 + AT_VR + slot * AT_SLOT + wid * 1024)));
}
#define AT_RD128(dst, addr, off) asm volatile("ds_read_b128 %0, %1 offset:%c2" : "=&v"(dst) : "v"(addr), "i"(off) : "memory")
#define AT_MFMA8(a, b, c) __builtin_amdgcn_mfma_scale_f32_32x32x64_f8f6f4(a, b, c, 0, 0, 0, 0, 0, 0)
#define AT_MFMA8B(a, b, c) __builtin_amdgcn_mfma_scale_f32_32x32x64_f8f6f4(a, b, c, 0, 1, 0, 0, 0, 0)

template <int VAR>
__device__ __forceinline__ void phase_attn(Frame& F, int l) {
    refresh(F);
    const WS W = ws_map(F.ws, F.nb); const float* const* IN_ = F.a->in; (void)IN_; (void)W;
    const int lane = F.lane, wid = F.wave, r32 = lane & 31, hh = lane >> 5, qg = wid & 3, c = wid >> 2;
    LAS unsigned char* lds = F.lds; const unsigned lds0 = (unsigned)(unsigned long)lds;
    LAS float* tab = (LAS float*)(lds + AT_TAB);
    for (int i = F.tid; i < 1028; i += NTHR) tab[i] = W.tab[i];
    const float lam = W.tab[1032 + l]; const float lam_init = 0.8f - 0.6f * __expf(-0.3f * (float)l);
    const float* subg = IN_[13] + l * 128;
    const int U = F.nb * NH * 64;
    const int gx = F.G >> 3, per = U >> 3;
    const int sw = (r32 >> 2) & 3;
    const unsigned ka0 = lds0 + AT_KR + c * 4096 + r32 * 64 + (((2 * hh) ^ sw) << 4), ka1 = lds0 + AT_KR + c * 4096 + r32 * 64 + (((2 * hh + 1) ^ sw) << 4);
    const unsigned va0 = lds0 + AT_VR + r32 * 64 + (((2 * hh) ^ sw) << 4), va1 = lds0 + AT_VR + r32 * 64 + (((2 * hh + 1) ^ sw) << 4);
#ifndef MK_ATT_1BAR
#define MK_ATT_1BAR 1
#endif
    const bool lag = (MK_ATT_1BAR == 0) && wid >= 4;
    __syncthreads();
    for (int i = 0;; ++i) {
        int id;
        if ((F.G & 7) == 0) { const int n = i * gx + (F.bid >> 3); if (n >= per) break; id = (F.bid & 7) * per + n; }
        else { id = i * F.G + F.bid; if (id >= U) break; }
        const int bh = id >> 6, qb = id & 63, b = bh >> 2, h = bh & 3;
        const int qw0 = qb * 128 + 32 * qg;
        const unsigned char* kg0 = (const unsigned char*)W.DK + ((size_t)bh * 2) * SEQ * 64;
        const unsigned char* vg0 = (const unsigned char*)W.DV + (size_t)bh * SEQ * 128;
        v8i qf; { const unsigned char* qp = (const unsigned char*)W.DQ + (((size_t)bh * 2 + c) * SEQ + qw0 + r32) * 64 + 32 * hh;
            const v4i q0 = *(const v4i*)qp, q1 = *(const v4i*)(qp + 16); qf = (v8i){q0[0], q0[1], q0[2], q0[3], q1[0], q1[1], q1[2], q1[3]}; }
        asm volatile("s_waitcnt vmcnt(0)" ::: "memory");
        attn_dma_k(lds0, kg0, 0, 0, wid, lane); attn_dma_k(lds0, kg0, 1, 1, wid, lane); attn_dma_v(lds0, vg0, 0, 7, wid, lane); attn_dma_v(lds0, vg0, 0, 0, wid, lane);
        attn_dma_k(lds0, kg0, 2, 2, wid, lane); attn_dma_v(lds0, vg0, 1, 1, wid, lane); attn_dma_k(lds0, kg0, 3, 3, wid, lane);
        attn_dma_v(lds0, vg0, 2, 2, wid, lane); attn_dma_v(lds0, vg0, 3, 3, wid, lane); attn_dma_v(lds0, vg0, 4, 4, wid, lane); attn_dma_v(lds0, vg0, 5, 5, wid, lane);
        f32x16 o[4]; f32x16 osum = f32x16{};
#pragma unroll
        for (int dt = 0; dt < 4; ++dt) o[dt] = f32x16{};
        const v8i ones8 = {0x38383838, 0x38383838, 0x38383838, 0x38383838, 0x38383838, 0x38383838, 0x38383838, 0x38383838};
        const int tL = (qw0 >= 154) ? ((qw0 - 154) >> 6) + 1 : 0, tR = (qw0 + 185) >> 6;
        const float shl = tab[1024 + h];
        const LAS float* tabh = tab + h * 256;
        const int rel0 = -qw0 - r32 + 4 * hh + 128;
        const f32x16 cshift = f32x16{};
        asm volatile("s_waitcnt vmcnt(7)" ::: "memory"); __builtin_amdgcn_s_barrier(); asm volatile("" ::: "memory");
        f32x16 s0, s1; v8i p = {0, 0, 0, 0, 0, 0, 0, 0};
        v4i fa0, fa1, fb0, fb1;
        {   v4i kx[4];
            AT_RD128(kx[0], ka0, 0); AT_RD128(kx[1], ka1, 0); AT_RD128(kx[2], ka0, 2048); AT_RD128(kx[3], ka1, 2048);
            AT_RD128(fa0, va0, 7 * AT_SLOT); AT_RD128(fa1, va1, 7 * AT_SLOT); AT_RD128(fb0, va0, 7 * AT_SLOT + 2048); AT_RD128(fb1, va1, 7 * AT_SLOT + 2048);
            asm volatile("s_waitcnt lgkmcnt(4)" ::: "memory"); __builtin_amdgcn_sched_barrier(0);
            s0 = AT_MFMA8(((v8i){kx[0][0], kx[0][1], kx[0][2], kx[0][3], kx[1][0], kx[1][1], kx[1][2], kx[1][3]}), qf, cshift);
            s1 = AT_MFMA8(((v8i){kx[2][0], kx[2][1], kx[2][2], kx[2][3], kx[3][0], kx[3][1], kx[3][2], kx[3][3]}), qf, cshift); }
        __builtin_amdgcn_s_barrier(); asm volatile("" ::: "memory");
#define AT_EXP8(sv, b0) do { if constexpr (!(VAR & 1)) { _Pragma("unroll") for (int r_ = (b0); r_ < (b0) + 8; ++r_) sv[r_] = __builtin_amdgcn_exp2f(sv[r_]); } } while (0)
#define AT_RDV(dst, addr, off) do { if constexpr (!(VAR & 4)) AT_RD128(dst, addr, off); else asm volatile("" : "=v"(dst)); } while (0)
#define AT_RDK(dst, addr, off) do { if constexpr (!(VAR & 16)) AT_RD128(dst, addr, off); else asm volatile("" : "=v"(dst)); } while (0)
#define AT_PV(dst, a, b) do { if constexpr (!(VAR & 2)) dst = AT_MFMA8B(a, b, dst); } while (0)
#define AT_QK(dst, a) do { if constexpr (!(VAR & 8)) dst = AT_MFMA8(a, qf, cshift); } while (0)
#define AT_PK(dst, sv, b0) do { if constexpr (!(VAR & 32)) dst = pk4_bf8(sv[b0], sv[(b0) + 1], sv[(b0) + 2], sv[(b0) + 3]); else dst = __builtin_bit_cast(int, sv[b0]); } while (0)
#define AT_V8(a, b) ((v8i){a[0], a[1], a[2], a[3], b[0], b[1], b[2], b[3]})
#define AT_LGKM(n) do { asm volatile("s_waitcnt lgkmcnt(" #n ")" ::: "memory"); __builtin_amdgcn_sched_barrier(0); } while (0)
#define AT_STEP(SL, t) do { \
            if constexpr (!(VAR & 128)) { const int tk = (t) + 4 < 128 ? (t) + 4 : 127, tv = (t) + 6 < 128 ? (t) + 6 : 127; attn_dma_k(lds0, kg0, tk, (SL) & 3, wid, lane); attn_dma_v(lds0, vg0, tv, ((SL) + 6) & 7, wid, lane); } \
            { v4i fc0, fc1, fd0, fd1, fk0, fk1, fk2, fk3; \
              if ((t) >= tL && (t) < tR) attn_bias(s0, s1, 64 * (t) + rel0, tabh);                                \
              if ((t) - 1 == tL) { _Pragma("unroll") for (int dt = 0; dt < 4; ++dt) o[dt] *= shl; osum *= shl; }    \
              AT_RDV(fc0, va0, (((SL) + 7) & 7) * AT_SLOT + 4096); AT_RDV(fc1, va1, (((SL) + 7) & 7) * AT_SLOT + 4096); AT_RDV(fd0, va0, (((SL) + 7) & 7) * AT_SLOT + 6144); AT_RDV(fd1, va1, (((SL) + 7) & 7) * AT_SLOT + 6144); \
              AT_RDK(fk0, ka0, (((SL) + 1) & 3) * AT_SLOT); AT_RDK(fk1, ka1, (((SL) + 1) & 3) * AT_SLOT); \
              AT_PV(osum, ones8, p); \
              AT_EXP8(s0, 0); \
              AT_LGKM(6); \
              AT_PV(o[0], AT_V8(fa0, fa1), p); \
              AT_RDK(fk2, ka0, (((SL) + 1) & 3) * AT_SLOT + 2048); AT_RDK(fk3, ka1, (((SL) + 1) & 3) * AT_SLOT + 2048); \
              AT_EXP8(s0, 8); \
              __builtin_amdgcn_sched_barrier(0); \
              AT_PV(o[1], AT_V8(fb0, fb1), p); \
              AT_EXP8(s1, 0); \
              AT_LGKM(4); \
              AT_PV(o[2], AT_V8(fc0, fc1), p); \
              AT_RDV(fa0, va0, ((SL) & 7) * AT_SLOT); AT_RDV(fa1, va1, ((SL) & 7) * AT_SLOT); \
              AT_EXP8(s1, 8); \
              __builtin_amdgcn_sched_barrier(0); \
              AT_PV(o[3], AT_V8(fd0, fd1), p); \
              AT_RDV(fb0, va0, ((SL) & 7) * AT_SLOT + 2048); AT_RDV(fb1, va1, ((SL) & 7) * AT_SLOT + 2048); \
              AT_PK(p[0], s0, 0); AT_PK(p[1], s0, 4); AT_PK(p[2], s0, 8); AT_PK(p[3], s0, 12); \
              AT_LGKM(6); \
              AT_QK(s0, AT_V8(fk0, fk1)); \
              AT_PK(p[4], s1, 0); AT_PK(p[5], s1, 4); AT_PK(p[6], s1, 8); AT_PK(p[7], s1, 12); \
              AT_LGKM(4); \
              AT_QK(s1, AT_V8(fk2, fk3)); \
              asm volatile("" : "+v"(p)); }                          \
            asm volatile("s_waitcnt vmcnt(5)" ::: "memory"); if constexpr (!(VAR & 64)) __builtin_amdgcn_s_barrier(); asm volatile("" ::: "memory"); } while (0)
        for (int t0 = 0; t0 < 128; t0 += 8) { AT_STEP(0, t0); AT_STEP(1, t0 + 1); AT_STEP(2, t0 + 2); AT_STEP(3, t0 + 3); AT_STEP(4, t0 + 4); AT_STEP(5, t0 + 5); AT_STEP(6, t0 + 6); AT_STEP(7, t0 + 7); }
#undef AT_STEP
#undef AT_EXP8
#undef AT_RDV
#undef AT_RDK
#undef AT_PV
#undef AT_QK
#undef AT_PK
        {
            v4i fc0, fc1, fd0, fd1;
            AT_RD128(fc0, va0, 7 * AT_SLOT + 4096); AT_RD128(fc1, va1, 7 * AT_SLOT + 4096); AT_RD128(fd0, va0, 7 * AT_SLOT + 6144); AT_RD128(fd1, va1, 7 * AT_SLOT + 6144);
            if (127 == tL) { _Pragma("unroll") for (int dt = 0; dt < 4; ++dt) o[dt] *= shl; osum *= shl; }
            osum = AT_MFMA8B(ones8, p, osum);
            AT_LGKM(0);
            o[0] = AT_MFMA8B(AT_V8(fa0, fa1), p, o[0]); o[1] = AT_MFMA8B(AT_V8(fb0, fb1), p, o[1]); o[2] = AT_MFMA8B(AT_V8(fc0, fc1), p, o[2]); o[3] = AT_MFMA8B(AT_V8(fd0, fd1), p, o[3]);
        }
#undef AT_LGKM
#undef AT_V8
        asm volatile("s_waitcnt vmcnt(0)" ::: "memory"); __builtin_amdgcn_s_barrier(); asm volatile("" ::: "memory");
        const float lt = osum[0];
        LAS float* xch = (LAS float*)(lds + qg * 16384);
        if (c == 1) { const float f = lam / lt;
#pragma unroll
            for (int dt = 0; dt < 4; ++dt)
#pragma unroll
                for (int r = 0; r < 16; ++r) xch[(dt * 16 + r) * 64 + lane] = o[dt][r] * f; }
        LDS_WAIT(); __builtin_amdgcn_s_barrier(); asm volatile("" ::: "memory");
        if (c == 0) { const float f = 1.f / lt; float ss = 0.f;
#pragma unroll
            for (int dt = 0; dt < 4; ++dt)
#pragma unroll
                for (int r = 0; r < 16; ++r) { const float v = o[dt][r] * f - xch[(dt * 16 + r) * 64 + lane]; o[dt][r] = v; ss += v * v; }
            ss += __shfl_xor(ss, 32);
            const float rn = rsqrtf(ss * (1.f / 128.f) + RMS_EPS) * (1.f - lam_init);
            bf16* orow = W.OAB + (size_t)F.T * 512 + ((size_t)b * SEQ + qw0 + r32) * 512 + h * 128;
#pragma unroll
            for (int dt = 0; dt < 4; ++dt)
#pragma unroll
                for (int g = 0; g < 4; ++g) { const int dv = 32 * dt + 8 * g + 4 * hh; const f32x4 sg = *(const f32x4*)(subg + dv);
                    u32x2 ov; ov.x = cvt_pk(o[dt][4 * g] * rn * sg[0], o[dt][4 * g + 1] * rn * sg[1]); ov.y = cvt_pk(o[dt][4 * g + 2] * rn * sg[2], o[dt][4 * g + 3] * rn * sg[3]);
                    *(u32x2*)(orow + dv) = ov; }
        }
        LDS_WAIT(); __builtin_amdgcn_s_barrier(); asm volatile("" ::: "memory");
    }
}
constexpr int GL_CUM = 0;
constexpr int GL_S64 = 144, GL_S192 = 400;
constexpr int G1_KEF = 34816, G1_KEB = G1_KEF + 64 * GL_S64, G1_VT = G1_KEB + 64 * GL_S64;
constexpr int G3_AOP = 34816, G3_KIF = G3_AOP + 64 * GL_S192, G3_KIB = G3_KIF + 64 * GL_S64, G3_BOP = G3_KIB + 64 * GL_S64;
static_assert(G3_BOP + 128 * GL_S192 <= 150 * 1024, "GLA LDS");

__device__ __forceinline__ bf16x8 lds_frag(const LAS unsigned char* base, int row, int stride, int kbyte) { return *(const LAS bf16x8*)(base + row * stride + kbyte); }

struct GlaIn { u32x2 lg[4]; u32x4 k, v0, v1, q, st[4], sg0, sg1; };
template <bool G3>
__device__ __forceinline__ void gla_load(const Frame& F, const WS& W, int u, GlaIn& r) {
    const int n = u & 127, bh = u >> 7, b = bh >> 2, h = bh & 3; const size_t trow0 = (size_t)b * SEQ + n * 64;
#pragma unroll
    for (int it = 0; it < 4; ++it) { const int idx = F.tid + it * NTHR; const int dir = idx >> 10, t = (idx >> 4) & 63, d4 = (idx & 15) * 4;
        r.lg[it] = *(const u32x2*)((dir ? W.LGB : W.LGF) + (trow0 + t) * 256 + h * 64 + d4); }
    const int t = F.tid >> 3, d0 = (F.tid & 7) * 8, v0 = (F.tid & 7) * 16;
    r.k = *(const u32x4*)(W.GK + (trow0 + t) * 256 + h * 64 + d0);
    r.v0 = *(const u32x4*)(W.GV + (trow0 + t) * 512 + h * 128 + v0); r.v1 = *(const u32x4*)(W.GV + (trow0 + t) * 512 + h * 128 + v0 + 8);
    if constexpr (G3) {
        r.q = *(const u32x4*)(W.GQ + (trow0 + t) * 256 + h * 64 + d0);
        const int dv = F.tid >> 2, dd0 = (F.tid & 3) * 16;
#pragma unroll
        for (int dir = 0; dir < 2; ++dir) { const bf16* sp = (const bf16*)W.KVT + ((size_t)u * 2 + dir) * 8192 + dv * 64 + dd0; r.st[2 * dir] = *(const u32x4*)sp; r.st[2 * dir + 1] = *(const u32x4*)(sp + 8); }
        r.sg0 = *(const u32x4*)(W.SG + (trow0 + t) * 512 + h * 128 + v0); r.sg1 = *(const u32x4*)(W.SG + (trow0 + t) * 512 + h * 128 + v0 + 8);
    }
}
__device__ __forceinline__ void gla_cum(Frame& F, const GlaIn& r) {
    LAS float* cum = (LAS float*)(F.lds + GL_CUM);
#pragma unroll
    for (int it = 0; it < 4; ++it) { const int idx = F.tid + it * NTHR; const int dir = idx >> 10, t = (idx >> 4) & 63, d4 = (idx & 15) * 4;
        const u32x2 a = r.lg[it];
        *(LAS f32x4*)(cum + (dir * 64 + t) * 64 + d4) = (f32x4){bflo(a.x), bfhi(a.x), bflo(a.y), bfhi(a.y)}; }
    __syncthreads();
    {
        const int dir = F.tid >> 8, seg = (F.tid >> 6) & 3, d = F.tid & 63; LAS float* cc = cum + dir * 4096 + d; LAS float* tot = cum + 8192 + (dir * 4 + seg) * 64 + d;
        float v[16]; float run = 0.f;
        if (dir == 0) {
#pragma unroll
            for (int i = 0; i < 16; ++i) { run += cc[(16 * seg + i) * 64]; v[i] = run; }
        } else {
#pragma unroll
            for (int i = 15; i >= 0; --i) { run += cc[(16 * seg + i) * 64]; v[i] = run; }
        }
        *tot = run;
        __syncthreads();
        float off = 0.f; const LAS float* tb = cum + 8192 + dir * 256 + d;
        if (dir == 0) { if (seg > 0) off += tb[0]; if (seg > 1) off += tb[64]; if (seg > 2) off += tb[128]; }
        else { if (seg < 3) off += tb[192]; if (seg < 2) off += tb[128]; if (seg < 1) off += tb[64]; }
#pragma unroll
        for (int i = 0; i < 16; ++i) cc[(16 * seg + i) * 64] = v[i] + off;
    }
    __syncthreads();
}

__device__ __forceinline__ void phase_gla1(Frame& F) {
    refresh(F);
    const WS W = ws_map(F.ws, F.nb); const float* const* IN_ = F.a->in; (void)IN_; (void)W;
    LAS unsigned char* lds = F.lds; LAS float* cum = (LAS float*)(lds + GL_CUM);
    const int lane = F.lane, wid = F.wave, r32 = lane & 31, hh = lane >> 5;
    const int U = F.nb * NH * 128;
    GlaIn cur, nxt;
    if (F.bid < U) gla_load<false>(F, W, F.bid, nxt);
    for (int u = F.bid; u < U; u += F.G) {
        cur = nxt;
        if (u + F.G < U) gla_load<false>(F, W, u + F.G, nxt);
        gla_cum(F, cur);
        {
            const int t = F.tid >> 3, d0 = (F.tid & 7) * 8;
            const u32x4 kv = cur.k;
            const unsigned kw[4] = {kv.x, kv.y, kv.z, kv.w};
#pragma unroll
            for (int j = 0; j < 8; ++j) { const int d = d0 + j; const float k = (j & 1) ? bfhi(kw[j >> 1]) : bflo(kw[j >> 1]);
                const float ef = __expf(cum[63 * 64 + d] - cum[t * 64 + d]), eb = __expf(cum[4096 + d] - cum[4096 + t * 64 + d]);
                *(LAS bf16*)(lds + G1_KEF + d * GL_S64 + t * 2) = (bf16)(cvt_pk(k * ef, 0.f) & 0xffffu);
                *(LAS bf16*)(lds + G1_KEB + d * GL_S64 + t * 2) = (bf16)(cvt_pk(k * eb, 0.f) & 0xffffu); }
            const int v0 = (F.tid & 7) * 16;
            const u32x4 va = cur.v0, vb = cur.v1;
            const unsigned vw[8] = {va.x, va.y, va.z, va.w, vb.x, vb.y, vb.z, vb.w};
#pragma unroll
            for (int j = 0; j < 16; ++j) *(LAS bf16*)(lds + G1_VT + (v0 + j) * GL_S64 + t * 2) = (bf16)((j & 1) ? (vw[j >> 1] >> 16) : (vw[j >> 1] & 0xffffu));
            if (F.tid < 128) { const int dir = F.tid >> 6, d = F.tid & 63; W.DEC[((size_t)u * 2 + dir) * 64 + d] = __expf(dir ? cum[4096 + d] : cum[63 * 64 + d]); }
        }
        __syncthreads();
        {
            const int dt = wid & 3, dd = wid >> 2;
            f32x16 cf = {}, cb = {};
#pragma unroll
            for (int s = 0; s < 4; ++s) { const int kb = (16 * s + 8 * hh) * 2;
                const bf16x8 a = lds_frag(lds + G1_VT, 32 * dt + r32, GL_S64, kb);
                cf = __builtin_amdgcn_mfma_f32_32x32x16_bf16(a, lds_frag(lds + G1_KEF, 32 * dd + r32, GL_S64, kb), cf, 0, 0, 0);
                cb = __builtin_amdgcn_mfma_f32_32x32x16_bf16(a, lds_frag(lds + G1_KEB, 32 * dd + r32, GL_S64, kb), cb, 0, 0, 0); }
            bf16* of = (bf16*)W.KVT + ((size_t)u * 2) * 8192; bf16* ob = of + 8192;
#pragma unroll
            for (int r = 0; r < 16; ++r) { const int dv = 32 * dt + crow(r, hh), d = 32 * dd + r32;
                const float pf = __shfl_xor(cf[r], 1), pb = __shfl_xor(cb[r], 1);
                if (!(lane & 1)) { *(unsigned*)(of + dv * 64 + d) = cvt_pk(cf[r], pf); *(unsigned*)(ob + dv * 64 + d) = cvt_pk(cb[r], pb); } }
        }
        __syncthreads();
    }
}

__device__ __forceinline__ void phase_gla2(Frame& F) {
    refresh(F);
    const WS W = ws_map(F.ws, F.nb); const float* const* IN_ = F.a->in; (void)IN_; (void)W;
    const size_t total = (size_t)F.nb * NH * 2 * 4096;
    for (size_t wk = (size_t)F.bid * NTHR + F.tid; wk < total; wk += (size_t)F.G * NTHR) {
        const int e2 = (int)(wk & 4095), dir = (int)((wk >> 12) & 1), bh = (int)(wk >> 13), d = (e2 * 2) & 63;
        unsigned* base = (unsigned*)((bf16*)W.KVT + ((size_t)bh * 128 * 2 + dir) * 8192) + e2; const float* dec = W.DEC + ((size_t)bh * 128 * 2 + dir) * 64 + d;
        float S0 = 0.f, S1 = 0.f;
        for (int n0 = 0; n0 < 128; n0 += 8) {
            unsigned kv[8]; float dc0[8], dc1[8];
#pragma unroll
            for (int j = 0; j < 8; ++j) { const int n = dir ? 127 - (n0 + j) : n0 + j; kv[j] = base[(size_t)n * 8192]; dc0[j] = dec[(size_t)n * 128]; dc1[j] = dec[(size_t)n * 128 + 1]; }
#pragma unroll
            for (int j = 0; j < 8; ++j) { const int n = dir ? 127 - (n0 + j) : n0 + j; base[(size_t)n * 8192] = cvt_pk(S0, S1); S0 = dc0[j] * S0 + bflo(kv[j]); S1 = dc1[j] * S1 + bfhi(kv[j]); }
        }
    }
}

__device__ __forceinline__ void phase_gla3(Frame& F, int l) {
    refresh(F);
    const WS W = ws_map(F.ws, F.nb); const float* const* IN_ = F.a->in; (void)IN_; (void)W;
    LAS unsigned char* lds = F.lds; LAS float* cum = (LAS float*)(lds + GL_CUM);
    const int lane = F.lane, wid = F.wave, r32 = lane & 31, hh = lane >> 5;
    const float* gng = IN_[9] + l * 128;
    const int U = F.nb * NH * 128;
    GlaIn cur, nxt;
    if (F.bid < U) gla_load<true>(F, W, F.bid, nxt);
    for (int u = F.bid; u < U; u += F.G) {
        const int n = u & 127, bh = u >> 7, b = bh >> 2, h = bh & 3; const size_t trow0 = (size_t)b * SEQ + n * 64;
        cur = nxt;
        if (u + F.G < U) gla_load<true>(F, W, u + F.G, nxt);
        gla_cum(F, cur);
        {
            const int t = F.tid >> 3, d0 = (F.tid & 7) * 8;
            const u32x4 qv = cur.q, kv = cur.k;
            const unsigned qw[4] = {qv.x, qv.y, qv.z, qv.w}, kw[4] = {kv.x, kv.y, kv.z, kv.w};
            float qf[8], qb[8], kf[8], kb[8];
#pragma unroll
            for (int j = 0; j < 8; ++j) { const int d = d0 + j; const float q = (j & 1) ? bfhi(qw[j >> 1]) : bflo(qw[j >> 1]), k = (j & 1) ? bfhi(kw[j >> 1]) : bflo(kw[j >> 1]);
                const float cf = cum[t * 64 + d], cb = cum[4096 + t * 64 + d];
                qf[j] = q * __expf(cf); qb[j] = q * __expf(cb); kf[j] = k * __expf(-cf); kb[j] = k * __expf(-cb); }
            u32x4 o;
            o.x = cvt_pk(qf[0], qf[1]); o.y = cvt_pk(qf[2], qf[3]); o.z = cvt_pk(qf[4], qf[5]); o.w = cvt_pk(qf[6], qf[7]); *(LAS u32x4*)(lds + G3_AOP + t * GL_S192 + (64 + d0) * 2) = o;
            o.x = cvt_pk(qb[0], qb[1]); o.y = cvt_pk(qb[2], qb[3]); o.z = cvt_pk(qb[4], qb[5]); o.w = cvt_pk(qb[6], qb[7]); *(LAS u32x4*)(lds + G3_AOP + t * GL_S192 + (128 + d0) * 2) = o;
            o.x = cvt_pk(kf[0], kf[1]); o.y = cvt_pk(kf[2], kf[3]); o.z = cvt_pk(kf[4], kf[5]); o.w = cvt_pk(kf[6], kf[7]); *(LAS u32x4*)(lds + G3_KIF + t * GL_S64 + d0 * 2) = o;
            o.x = cvt_pk(kb[0], kb[1]); o.y = cvt_pk(kb[2], kb[3]); o.z = cvt_pk(kb[4], kb[5]); o.w = cvt_pk(kb[6], kb[7]); *(LAS u32x4*)(lds + G3_KIB + t * GL_S64 + d0 * 2) = o;
            const int v0 = (F.tid & 7) * 16;
            const u32x4 va = cur.v0, vb = cur.v1;
            const unsigned vw[8] = {va.x, va.y, va.z, va.w, vb.x, vb.y, vb.z, vb.w};
#pragma unroll
            for (int j = 0; j < 16; ++j) *(LAS bf16*)(lds + G3_BOP + (v0 + j) * GL_S192 + t * 2) = (bf16)((j & 1) ? (vw[j >> 1] >> 16) : (vw[j >> 1] & 0xffffu));
            const int dv = F.tid >> 2, dd0 = (F.tid & 3) * 16;
#pragma unroll
            for (int dir = 0; dir < 2; ++dir) { const u32x4 o0 = cur.st[2 * dir], o1 = cur.st[2 * dir + 1];
                *(LAS u32x4*)(lds + G3_BOP + dv * GL_S192 + (64 + 64 * dir + dd0) * 2) = o0; *(LAS u32x4*)(lds + G3_BOP + dv * GL_S192 + (64 + 64 * dir + dd0 + 8) * 2) = o1; }
        }
        __syncthreads();
        if (wid < 4) {
            const int it = wid >> 1, jt = wid & 1;
            f32x16 af = {}, ab = {};
#pragma unroll
            for (int s = 0; s < 4; ++s) { const int kb = (16 * s + 8 * hh) * 2;
                if (jt <= it) af = __builtin_amdgcn_mfma_f32_32x32x16_bf16(lds_frag(lds + G3_AOP, 32 * it + r32, GL_S192, 128 + kb), lds_frag(lds + G3_KIF, 32 * jt + r32, GL_S64, kb), af, 0, 0, 0);
                if (jt >= it) ab = __builtin_amdgcn_mfma_f32_32x32x16_bf16(lds_frag(lds + G3_AOP, 32 * it + r32, GL_S192, 256 + kb), lds_frag(lds + G3_KIB, 32 * jt + r32, GL_S64, kb), ab, 0, 0, 0); }
#pragma unroll
            for (int r = 0; r < 16; ++r) { const int i = 32 * it + crow(r, hh), j = 32 * jt + r32; const float v = (j <= i) ? af[r] : ab[r];
                *(LAS bf16*)(lds + G3_AOP + i * GL_S192 + j * 2) = (bf16)(cvt_pk(v, 0.f) & 0xffffu); }
        }
        __syncthreads();
        {
            const int it = wid >> 2, dt = wid & 3; f32x16 o = {};
#pragma unroll
            for (int s = 0; s < 12; ++s) { const int kb = (16 * s + 8 * hh) * 2;
                o = __builtin_amdgcn_mfma_f32_32x32x16_bf16(lds_frag(lds + G3_AOP, 32 * it + r32, GL_S192, kb), lds_frag(lds + G3_BOP, 32 * dt + r32, GL_S192, kb), o, 0, 0, 0); }
            LAS float* out = (LAS float*)(lds + GL_CUM);
#pragma unroll
            for (int r = 0; r < 16; ++r) out[(32 * it + crow(r, hh)) * 128 + 32 * dt + r32] = o[r];
        }
        __syncthreads();
        {
            const int t = F.tid >> 3, v0 = (F.tid & 7) * 16; const LAS float* orow = (const LAS float*)(lds + GL_CUM) + t * 128 + v0;
            float x[16]; float ss = 0.f;
#pragma unroll
            for (int j = 0; j < 16; ++j) { x[j] = orow[j]; ss += x[j] * x[j]; }
            ss += __shfl_xor(ss, 1); ss += __shfl_xor(ss, 2); ss += __shfl_xor(ss, 4);
            const float rs = rsqrtf(ss * (1.f / 128.f) + RMS_EPS);
            const u32x4 ga = cur.sg0, gb = cur.sg1;
            const unsigned gw[8] = {ga.x, ga.y, ga.z, ga.w, gb.x, gb.y, gb.z, gb.w};
            float y[16];
#pragma unroll
            for (int j = 0; j < 16; ++j) y[j] = x[j] * rs * gng[v0 + j] * ((j & 1) ? bfhi(gw[j >> 1]) : bflo(gw[j >> 1]));
            u32x4 o0, o1; o0.x = cvt_pk(y[0], y[1]); o0.y = cvt_pk(y[2], y[3]); o0.z = cvt_pk(y[4], y[5]); o0.w = cvt_pk(y[6], y[7]);
            o1.x = cvt_pk(y[8], y[9]); o1.y = cvt_pk(y[10], y[11]); o1.z = cvt_pk(y[12], y[13]); o1.w = cvt_pk(y[14], y[15]);
            bf16* dst = W.OAB + (trow0 + t) * 512 + h * 128 + v0; *(u32x4*)dst = o0; *(u32x4*)(dst + 8) = o1;
        }
        __syncthreads();
    }
}
__device__ __forceinline__ void phase_select(Frame& F, int l) {
    refresh(F);
    const WS W = ws_map(F.ws, F.nb); const float* const* IN_ = F.a->in; (void)IN_; (void)W;
    LAS int* lcnt = (LAS int*)F.lds; LAS int* lbase = lcnt + 32;
    const float* b_rg = IN_[19] + l * 4; const float* b_re = IN_[21] + l * 32;
    unsigned* gcnt = W.ctl + CW_CNT + l * 64;
    for (int t0 = F.bid * NTHR; t0 < F.T; t0 += F.G * NTHR) {
        if (F.tid < 32) lcnt[F.tid] = 0;
        __syncthreads();
        const int t = t0 + F.tid; int e0 = 0, e1 = 0, r0 = 0, r1 = 0; float g0 = 0.f, g1 = 0.f;
        if (t < F.T) {
            const float* lg = W.LOGITS + (size_t)t * 64;
            float gl[4]; { const f32x4 v = *(const f32x4*)lg; gl[0] = v[0] + b_rg[0]; gl[1] = v[1] + b_rg[1]; gl[2] = v[2] + b_rg[2]; gl[3] = v[3] + b_rg[3]; }
            int grp = 0; float mx = gl[0];
            if (gl[1] > mx) { mx = gl[1]; grp = 1; } if (gl[2] > mx) { mx = gl[2]; grp = 2; } if (gl[3] > mx) { mx = gl[3]; grp = 3; }
            const float p_grp = 1.f / (__expf(gl[0] - mx) + __expf(gl[1] - mx) + __expf(gl[2] - mx) + __expf(gl[3] - mx));
            const f32x4 ea = *(const f32x4*)(lg + 4 + grp * 8), eb = *(const f32x4*)(lg + 8 + grp * 8);
            const f32x4 ba = *(const f32x4*)(b_re + grp * 8), bb = *(const f32x4*)(b_re + grp * 8 + 4);
            float b0v = -1e30f, b1v = -1e30f; int i0 = 0, i1 = 0;
#pragma unroll
            for (int j = 0; j < 8; ++j) { const float e = (j < 4) ? ea[j] + ba[j] : eb[j - 4] + bb[j - 4];
                if (e > b0v) { b1v = b0v; i1 = i0; b0v = e; i0 = j; } else if (e > b1v) { b1v = e; i1 = j; } }
            const float p1 = __expf(b1v - b0v), s2 = 1.f + p1;
            e0 = grp * 8 + i0; e1 = grp * 8 + i1; g0 = p_grp / s2; g1 = p_grp * p1 / s2;
            r0 = __hip_atomic_fetch_add(lcnt + e0, 1, __ATOMIC_RELAXED, __HIP_MEMORY_SCOPE_WORKGROUP);
            r1 = __hip_atomic_fetch_add(lcnt + e1, 1, __ATOMIC_RELAXED, __HIP_MEMORY_SCOPE_WORKGROUP);
        }
        __syncthreads();
        if (F.tid < 32) lbase[F.tid] = (int)__hip_atomic_fetch_add(gcnt + F.tid, (unsigned)lcnt[F.tid], __ATOMIC_RELAXED, __HIP_MEMORY_SCOPE_AGENT);
        __syncthreads();
        if (t < F.T) { W.eid[t * 2] = e0; W.eid[t * 2 + 1] = e1; W.gate[t * 2] = g0; W.gate[t * 2 + 1] = g1; W.rank[t * 2] = lbase[e0] + r0; W.rank[t * 2 + 1] = lbase[e1] + r1; }
        __syncthreads();
    }
}
__device__ __forceinline__ void phase_gather(Frame& F, int l) {
    refresh(F);
    const WS W = ws_map(F.ws, F.nb); const float* const* IN_ = F.a->in; (void)IN_; (void)W;
    LAS int* seg = (LAS int*)F.lds; LAS int* cnt = seg + 40;
    const unsigned* gcnt = W.ctl + CW_CNT + l * 64;
    if (F.tid == 0) { int o = 0; for (int e = 0; e < 32; ++e) { const int c = (int)__hip_atomic_load(gcnt + e, __ATOMIC_RELAXED, __HIP_MEMORY_SCOPE_AGENT); seg[e] = o; cnt[e] = c; o += (c + 255) & ~255; } seg[32] = o; }
    __syncthreads();
    const int ntile = seg[32] >> 8;
    if (F.bid == 0) {
        for (int i = F.tid; i < ntile; i += NTHR) { int e = 0; while (e < 31 && (i << 8) >= seg[e + 1]) ++e; W.tilee[i] = e; }
        if (F.tid == 0) W.segp[0] = ntile;
    }
    for (int p = F.bid * NTHR + F.tid; p < (ntile << 8); p += F.G * NTHR) { int e = 0; while (e < 31 && p >= seg[e + 1]) ++e; if (p - seg[e] >= cnt[e]) W.stok[p] = 0; }
    for (int it = F.bid * NTHR + F.tid; it < F.T * 2; it += F.G * NTHR) {
        const int e = W.eid[it], p = seg[e] + W.rank[it];
        W.stok[p] = it >> 1; W.pos[it] = p; W.gsort[p] = W.gate[it];
    }
}

#ifndef MK_MASK
#define MK_MASK 0xffffffffu
#endif
#define EN(b) (((MK_MASK) >> (b)) & 1u)
#ifndef MK_ALIGN
#define MK_ALIGN true
#endif
#ifndef MK_SP2
#define MK_SP2 true
#endif
#ifndef MK_DUP
#define MK_DUP 0u
#endif
#define REPS(b) ((((MK_DUP) >> (b)) & 1u) ? 2 : 1)
constexpr int NPL = 14, NPH = 2 + DEPTH * NPL;
__global__ void __launch_bounds__(NTHR, 2) mk_fwd(Args args) {
    extern __shared__ __attribute__((aligned(16))) unsigned char lds_raw[];
    Frame F;
    F.lds = (LAS unsigned char*)lds_raw; F.tid = threadIdx.x; F.lane = F.tid & 63; F.wave = __builtin_amdgcn_readfirstlane(F.tid >> 6);
    F.G = gridDim.x; F.bid = blockIdx.x; F.nb = args.nb; F.T = args.nb * SEQ; F.ws = args.ws; F.a = &args; F.xbuf = args.out;
    const float* const* IN_ = args.in;
    volatile LAS unsigned* misc = (volatile LAS unsigned*)(F.lds + LDS_MISC);
    if (F.tid < 64) misc[F.tid] = 0u;
    __syncthreads();
    XcdBarrier bar = xcd_barrier_post((unsigned*)args.ws + CW_BAR + args.li * XCD_BAR_WORDS, misc);
    const int lo = args.ph_lo, hi = args.ph_hi;
#define IN(k) (lo <= (k) && (k) < hi)
#ifdef MK_BAR2
#define SEAM(k) do { if (IN(k) && IN((k) + 1)) { xcd_barrier(bar); xcd_barrier(bar); } } while (0)
#else
#define SEAM(k) do { if (IN(k) && IN((k) + 1)) xcd_barrier(bar); } while (0)
#endif
#ifdef MK_UB
    {
        typedef int ub8i __attribute__((ext_vector_type(8))); typedef int ub4i __attribute__((ext_vector_type(4)));
        ub8i ua, ubb; for (int i = 0; i < 8; ++i) { ua[i] = 0x38383838 + F.lane; ubb[i] = 0x30303030 + F.lane * 3; }
        f32x16 acc0 = {}, acc1 = {}, acc2 = {}, acc3 = {};
        float e0 = F.lane * 0.01f, e1 = e0 + 1, e2 = e0 + 2, e3 = e0 + 3, e4 = e0 + 4, e5 = e0 + 5, e6 = e0 + 6, e7 = e0 + 7;
        ub4i ld0 = {}, ld1 = {}; const unsigned la = (unsigned)(unsigned long)F.lds + F.tid * 16;
#define UB_M(acc) do { if constexpr (MK_UB & 1) acc = __builtin_amdgcn_mfma_scale_f32_32x32x64_f8f6f4(ua, ubb, acc, 0, 0, 0, 0, 0, 0); } while (0)
#define UB_E() do { if constexpr (MK_UB & 2) { e0 = __builtin_amdgcn_exp2f(e0); e1 = __builtin_amdgcn_exp2f(e1); e2 = __builtin_amdgcn_exp2f(e2); e3 = __builtin_amdgcn_exp2f(e3); \
                                              e4 = __builtin_amdgcn_exp2f(e4); e5 = __builtin_amdgcn_exp2f(e5); e6 = __builtin_amdgcn_exp2f(e6); e7 = __builtin_amdgcn_exp2f(e7); } } while (0)
#define UB_L() do { if constexpr (MK_UB & 4) { asm volatile("ds_read_b128 %0, %1" : "=&v"(ld0) : "v"(la) : "memory"); asm volatile("ds_read_b128 %0, %1 offset:8192" : "=&v"(ld1) : "v"(la) : "memory"); } } while (0)
        for (int it = 0; it < 2000; ++it) {
            UB_M(acc0); __builtin_amdgcn_sched_barrier(0); UB_E(); UB_L(); __builtin_amdgcn_sched_barrier(0);
            UB_M(acc1); __builtin_amdgcn_sched_barrier(0); UB_E(); UB_L(); __builtin_amdgcn_sched_barrier(0);
            UB_M(acc2); __builtin_amdgcn_sched_barrier(0); UB_E(); UB_L(); __builtin_amdgcn_sched_barrier(0);
            UB_M(acc3); __builtin_amdgcn_sched_barrier(0); UB_E(); UB_L(); __builtin_amdgcn_sched_barrier(0);
            if constexpr (MK_UB & 4) asm volatile("s_waitcnt lgkmcnt(0)" ::: "memory");
        }
        const float sink = acc0[0] + acc1[1] + acc2[2] + acc3[3] + e0 + e1 + e2 + e3 + e4 + e5 + e6 + e7 + (float)(ld0[0] + ld1[1]);
        if (sink == 12345.678f) ((unsigned*)args.ws)[CW_CNT + 77] = 1u;
        __syncthreads();
    }
#endif
    LAS unsigned char* gl = F.lds;
    if (EN(0) && IN(0)) { for (int rp = 0; rp < REPS(0); ++rp) { p0_prologue(F); __syncthreads(); } SEAM(0); }
    for (int l = 0; l < DEPTH; ++l) {
        const int pb = 1 + l * NPL;
        if (EN(1) && IN(pb + 0)) { for (int rp = 0; rp < ((l == 0) ? REPS(14) : 1); ++rp) phase_norm(F, l, 0); SEAM(pb + 0); }
        if (EN(2) && IN(pb + 1)) { const WS W = ws_map(F.ws, F.nb);
            pg8::Gemm g{W.H, W.win + (size_t)l * NIN * D, F.T, NIN, D}; pg8::StaticOrder S; S.init(F.T, NIN, F.G, F.bid);
            EpiIn E{W.GQ, W.GK, W.GV, W.SG, W.LGF, W.LGB, W.DQ, W.DK, W.DV, W.SGA, W.SGB, IN_[8] + l * 512, IN_[10] + l * 64, IN_[11] + l * 64, 0};
#ifdef MK_DEPHASE
            { const int g_ = (F.bid >> 3) & 7; for (int k_ = 0; k_ < g_ * MK_DEPHASE; ++k_) __builtin_amdgcn_s_sleep(127); }
#endif
#ifdef MK_INPROJ_PLAIN
            { EpiIn EP_ = E; EP_.plain = 1; pg8::gemm_phase<EpiIn, pg8::StaticOrder, MK_ALIGN, MK_SP2>(gl, g, S, EP_); }
#endif
#ifdef MK_INPROJ_NULL
            { EpiNull EN_; pg8::gemm_phase<EpiNull, pg8::StaticOrder, MK_ALIGN, MK_SP2>(gl, g, S, EN_); }
#endif
            for (int rp = 0; rp < REPS(2); ++rp) pg8::gemm_phase<EpiIn, pg8::StaticOrder, MK_ALIGN, MK_SP2>(gl, g, S, E);
            SEAM(pb + 1);
        }
        if (EN(3) && IN(pb + 2)) { for (int rp = 0; rp < REPS(3); ++rp) phase_gla1(F); SEAM(pb + 2); }
        if (EN(4) && IN(pb + 3)) { phase_gla2(F); SEAM(pb + 3); }
        if (EN(5) && IN(pb + 4)) { for (int rp = 0; rp < REPS(5); ++rp) phase_gla3(F, l); __syncthreads(); }
        if (EN(6) && IN(pb + 5)) {
#ifdef MK_ATT_PROBE
            phase_attn<MK_ATT_PROBE>(F, l);
#endif
            phase_attn<0>(F, l); SEAM(pb + 5); }
        if (EN(7) && IN(pb + 6)) { const WS W = ws_map(F.ws, F.nb);
            pg8::Gemm g{W.OAB, W.wab + (size_t)l * D * D, 0, 0, 512}; MergeOrder S; S.so.init(F.T, D, F.G, F.bid); S.nM = F.T / 256;
            EpiMerge E{W.SGA, W.SGB, W.MERGED, F.T / 256};
            for (int rp = 0; rp < REPS(7); ++rp) pg8::gemm_phase<EpiMerge, MergeOrder, MK_ALIGN, MK_SP2>(gl, g, S, E);
            SEAM(pb + 6);
        }
        if (EN(8) && IN(pb + 7)) { const WS W = ws_map(F.ws, F.nb); const float* modl = W.mod + (size_t)l * NBMAX * 6 * D;
            pg8::Gemm g{W.MERGED, W.wo + (size_t)l * D * D, F.T, D, D}; pg8::StaticOrder S; S.init(F.T, D, F.G, F.bid);
            EpiResid E{l == 0 ? IN_[0] : nullptr, W.XB, modl + 2 * D};
            for (int rp = 0; rp < ((l == 0) ? REPS(8) : 1); ++rp) pg8::gemm_phase<EpiResid, pg8::StaticOrder, MK_ALIGN, MK_SP2>(gl, g, S, E);
            SEAM(pb + 7);
        }
        if (EN(1) && IN(pb + 8)) { for (int rp = 0; rp < REPS(1); ++rp) phase_norm(F, l, 1); SEAM(pb + 8); }
        if (EN(9) && IN(pb + 9)) { const WS W = ws_map(F.ws, F.nb);
            pg8::Gemm g{W.H, W.wr + (size_t)l * 256 * D, F.T, 256, D}; pg8::StaticOrder S; S.init(F.T, 256, F.G, F.bid);
            EpiLogits E{W.LOGITS};
            for (int rp = 0; rp < REPS(9); ++rp) pg8::gemm_phase<EpiLogits, pg8::StaticOrder, MK_ALIGN, MK_SP2>(gl, g, S, E);
            SEAM(pb + 9);
        }
        if (EN(10) && IN(pb + 10)) { phase_select(F, l); SEAM(pb + 10); }
        if (EN(11) && IN(pb + 11)) { for (int rp = 0; rp < REPS(11); ++rp) { phase_gather(F, l); __syncthreads(); } SEAM(pb + 11); }
        if (EN(12) && IN(pb + 12)) { const WS W = ws_map(F.ws, F.nb);
            const int ntile = W.segp[0];
#if MK_MOE_FP8
            pg8::Gemm g{W.XS, (const bf16*)((const unsigned char*)W.w1 + (size_t)l * NE * 1024 * D), 0, 0, D / 2}; GroupedOrder S{W.tilee, ntile * 4, F.G, F.bid};
            EpiAct E{(unsigned char*)W.ACT};
#else
            pg8::Gemm g{W.H, W.w1 + (size_t)l * NE * 1024 * D, 0, 0, D}; GroupedOrder S{W.tilee, ntile * 4, F.G, F.bid, W.stok};
            EpiAct E{W.ACT};
#endif
            for (int rp = 0; rp < REPS(12); ++rp) pg8::gemm_phase<EpiAct, GroupedOrder, MK_ALIGN, MK_SP2, true>(gl, g, S, E);
            SEAM(pb + 12);
        }
        if (EN(13) && IN(pb + 13)) { const WS W = ws_map(F.ws, F.nb);
            const int ntile = W.segp[0];
#if MK_MOE_FP8
            pg8::Gemm g{W.ACT, (const bf16*)((const unsigned char*)W.w2 + (size_t)l * NE * D * DE), 0, 0, DE / 2}; GroupedOrder S{W.tilee, ntile * 4, F.G, F.bid};
#else
            pg8::Gemm g{W.ACT, W.w2 + (size_t)l * NE * D * DE, 0, 0, DE}; GroupedOrder S{W.tilee, ntile * 4, F.G, F.bid, nullptr};
#endif
            EpiYs E{(unsigned char*)W.YS, W.gsort};
            for (int rp = 0; rp < REPS(13); ++rp) pg8::gemm_phase<EpiYs, GroupedOrder, MK_ALIGN, MK_SP2>(gl, g, S, E);
            SEAM(pb + 13);
        }
    }
    if (EN(1) && IN(NPH - 1)) phase_norm(F, 0, 2);
#undef IN
#undef SEAM
}

struct LaunchCfg { int grid; bool ok; };
inline LaunchCfg& launch_cfg() {
    static LaunchCfg c{0, false}; static bool init = false;
    if (!init) { init = true;
        int dev = 0, cus = 0, per_cu = 0;
        if (hipGetDevice(&dev) != hipSuccess || hipDeviceGetAttribute(&cus, hipDeviceAttributeMultiprocessorCount, dev) != hipSuccess) { fprintf(stderr, "mk: device query failed\n"); return c; }
        if (hipFuncSetAttribute((const void*)mk_fwd, hipFuncAttributeMaxDynamicSharedMemorySize, LDS_BYTES) != hipSuccess) { fprintf(stderr, "mk: hipFuncSetAttribute failed\n"); return c; }
        if (hipOccupancyMaxActiveBlocksPerMultiprocessor(&per_cu, (const void*)mk_fwd, NTHR, LDS_BYTES) != hipSuccess || per_cu < 1) { fprintf(stderr, "mk: occupancy query says %d blocks/CU\n", per_cu); (void)hipGetLastError(); return c; }
        c.grid = cus; c.ok = true;
    }
    return c;
}
inline void launch_range(void* const* d_in, float* xbuf, void* d_ws, int nb, int lo, int hi, int li, hipStream_t stream) {
    LaunchCfg& c = launch_cfg(); if (!c.ok) return;
    Args a{}; for (int i = 0; i < 24; ++i) a.in[i] = (const float*)d_in[i];
    a.out = xbuf; a.ws = (unsigned char*)d_ws; a.nb = nb; a.ph_lo = lo; a.ph_hi = hi; a.li = li;
    hipLaunchKernelGGL(mk_fwd, dim3(c.grid), dim3(NTHR), LDS_BYTES, stream, a);
    const hipError_t le = hipPeekAtLastError(); if (le != hipSuccess) fprintf(stderr, "mk: launch [%d,%d) failed: %s\n", lo, hi, hipGetErrorName(le));
}
}
extern "C" void kernel_launch(void* const* d_in, const int* in_sizes, int n_in, void* d_out, int out_size, void* d_ws, size_t ws_size, hipStream_t stream) {
    (void)in_sizes; (void)n_in; (void)out_size;
    static int checked = 0;
    if (!checked) { checked = 1; const mk::WS w = mk::ws_map((unsigned char*)d_ws, 4); if (w.end > ws_size) { fprintf(stderr, "mk: workspace too small: need %zu, have %zu\n", w.end, ws_size); checked = -1; } }
    if (checked < 0) return;
    if (hipMemsetAsync(d_ws, 0, mk::CTL_BYTES, stream) != hipSuccess) return;
    mk::launch_range(d_in, (float*)d_out, d_ws, 4, 0, mk::NPH, 0, stream);
}
```

```cpp
#include <hip/hip_runtime.h>
#include <cstdio>
#include <cstdint>
#include <cmath>
#define MK_ATT_FP8 1
namespace pg8 {
#define PG8_LAS __attribute__((address_space(3)))
typedef unsigned short bf16_t;
typedef short bf16x8 __attribute__((ext_vector_type(8)));
typedef float f32x4 __attribute__((ext_vector_type(4)));
typedef unsigned u32x4 __attribute__((ext_vector_type(4)));
constexpr int BM = 256, BK = 64, HALF = 128, HTB = HALF * BK * 2  , STAGE_BYTES = 8 * HTB, NXCD = 8, WGM = 8;

__host__ __device__ __forceinline__ int lds_byte(int r, int c) { const int st = (r >> 4) * 2 + (c >> 5), rr = r & 15, cc = c & 31, ob = rr * 64 + cc * 2; return st * 1024 + (ob ^ (((ob >> 9) & 1) << 5)); }
__host__ __device__ __forceinline__ void stage_rc(int b, int& R, int& C) { const int st = b / 1024, sb = b % 1024, swz = sb ^ (((sb >> 9) & 1) << 5); R = (st >> 1) * 16 + swz / 64; C = (st & 1) * 32 + (swz % 64) / 2; }
__host__ __device__ __forceinline__ int perm32(int rho) { const int n = rho >> 4, i = rho & 15; return 8 * (i >> 2) + 4 * n + (i & 3); }

struct Unit { int pm, pn; };
struct Gemm { const bf16_t* A; const bf16_t* Bt; int M, N, K; };

struct StaticOrder {
    int nM, nN, nwg, G, c;
    __host__ __device__ void init(int M, int N, int G_, int c_) { nM = M / BM; nN = N / BM; nwg = nM * nN; G = G_; c = c_; }
    __host__ __device__ bool next(int i, Unit& u) const {
        const long L = (long)i * G + c; if (L >= nwg) return false;
        int wgid = (int)L; { const int q = nwg / NXCD, r = nwg % NXCD, xcd = wgid % NXCD, off = wgid / NXCD; wgid = (xcd < r ? xcd * (q + 1) : r * (q + 1) + (xcd - r) * q) + off; }
        const int nig = WGM * nN, gid = wgid / nig, fm = gid * WGM, gsz = (nM - fm) < WGM ? (nM - fm) : WGM;
        u.pm = fm + ((wgid % nig) % gsz); u.pn = (wgid % nig) / gsz; return true;
    }
    __device__ __forceinline__ void a_ready(const Unit&) const {}
    __device__ __forceinline__ void done(const Unit&) const {}
};
__device__ __forceinline__ unsigned cvt_pk_bf16(float lo, float hi) { unsigned r; asm volatile("v_cvt_pk_bf16_f32 %0, %1, %2" : "=v"(r) : "v"(lo), "v"(hi)); return r; }
__device__ __forceinline__ const void* pg8_uniform(const void* p) { const unsigned long long v = (unsigned long long)p;
    const unsigned lo = (unsigned)__builtin_amdgcn_readfirstlane((int)(unsigned)v), hi = (unsigned)__builtin_amdgcn_readfirstlane((int)(unsigned)(v >> 32)); return (const void*)(((unsigned long long)hi << 32) | lo); }
__device__ __forceinline__ void pg8_glds(const void* sbase, unsigned voff, unsigned ldsdst) { unsigned keep;
    asm volatile("s_nop 4\n\ts_mov_b32 %0, m0\n\ts_mov_b32 m0, %3\n\ts_nop 0\n\tglobal_load_lds_dwordx4 %1, %2\n\ts_mov_b32 m0, %0" : "=&s"(keep) : "v"(voff), "s"(sbase), "s"(ldsdst) : "memory"); }
typedef int pg8_v8i __attribute__((ext_vector_type(8)));
typedef int pg8_v4i __attribute__((ext_vector_type(4)));
template <class Epi, class Sched, bool ALIGN_EPI = false, bool SP2 = false, bool GATHER = false>
__device__ __forceinline__ void gemm_phase(PG8_LAS unsigned char* lds, const Gemm g, const Sched& S, const Epi& E) {
    int tid_ = threadIdx.x; asm volatile("" : "+v"(tid_));
    const int tid = tid_, wid = __builtin_amdgcn_readfirstlane(tid >> 6), lane = tid & 63, wr = wid >> 2, wc = wid & 3, fr = lane & 15, fq = lane >> 4;
    const int K = g.K, nt = K / BK;
    unsigned voffA[2], voffB[2]; unsigned vc[2][2] = {}, vn[2][2] = {}, vs[2][2] = {}; (void)vc; (void)vn; (void)vs;
#pragma unroll
    for (int i = 0; i < 2; ++i) { int R, C; stage_rc(tid * 16 + i * 8192, R, C); const int Rb = Epi::PERM ? ((R & ~31) + perm32(R & 31)) : R;
        voffA[i] = (unsigned)(R * K + C) * 2u; voffB[i] = (unsigned)(Rb * K + C) * 2u; }
    const size_t kstep = (size_t)(BK * 2);
    const size_t hstep = (size_t)HALF * K * 2;
    const size_t tstep = 2 * hstep;
    const unsigned ldsw = (unsigned)wid * 1024u; const unsigned lds0 = (unsigned)(unsigned long)lds; (void)lds0;
    const int aoff = lds_byte(wr * 64 + fr, fq * 8), boff = lds_byte(wc * 32 + fr, fq * 8);
#define PG8_SA(b, h) (((b) * 2 + (h)) * HTB)
#define PG8_SB(b, h) ((4 + (b) * 2 + (h)) * HTB)
#if defined(PG8_ASM_STAGE) && PG8_ASM_STAGE
#define PG8_STAGE(bufoff, gbase, voff) do { const void* _gb = pg8_uniform(gbase); _Pragma("unroll") for (int _i = 0; _i < 2; ++_i) \
        pg8_glds(_gb, (voff)[_i], (unsigned)__builtin_amdgcn_readfirstlane((int)(lds0 + (unsigned)(bufoff) + ldsw + _i * 8192))); } while (0)
#else
#define PG8_STAGE(bufoff, gbase, voff) do { _Pragma("unroll") for (int _i = 0; _i < 2; ++_i) \
        __builtin_amdgcn_global_load_lds((const unsigned*)((const char*)(gbase) + (voff)[_i]), (PG8_LAS unsigned*)(lds + (bufoff) + ldsw + _i * 8192), 16, 0, 0); } while (0)
#endif
#define PG8_STAGE_A(b, h, X, VS) do { if constexpr (GATHER) { PG8_STAGE(PG8_SA(b, h), X, VS[h]); } else { PG8_STAGE(PG8_SA(b, h), (X) + (h) * hstep, voffA); } } while (0)
#define PG8_LOADROWS(u, v) do { _Pragma("unroll") for (int i_ = 0; i_ < 2; ++i_) { int R_, C_; stage_rc(tid * 16 + i_ * 8192, R_, C_); _Pragma("unroll") for (int h_ = 0; h_ < 2; ++h_) \
        v[h_][i_] = (unsigned)S.rowidx[(u).pm * 256 + h_ * 128 + R_] * (unsigned)(K * 2) + (unsigned)C_ * 2u; } } while (0)
#define PG8_LDA(dst, b, h) do { _Pragma("unroll") for (int m = 0; m < 4; ++m) _Pragma("unroll") for (int k = 0; k < 2; ++k) dst[m][k] = *(const PG8_LAS bf16x8*)(lds + PG8_SA(b, h) + aoff + m * 2048 + k * 1024); } while (0)
#define PG8_LDB(dst, b, h) do { _Pragma("unroll") for (int n = 0; n < 2; ++n) _Pragma("unroll") for (int k = 0; k < 2; ++k) dst[n][k] = *(const PG8_LAS bf16x8*)(lds + PG8_SB(b, h) + boff + n * 2048 + k * 1024); } while (0)
#define PG8_MMA(ai, bj, At, Bt) do { __builtin_amdgcn_s_setprio(1); _Pragma("unroll") for (int m = 0; m < 4; ++m) _Pragma("unroll") for (int n = 0; n < 2; ++n) _Pragma("unroll") for (int k = 0; k < 2; ++k) \
        acc[ai][bj][m][n] = __builtin_amdgcn_mfma_f32_16x16x32_bf16(Bt[n][k], At[m][k], acc[ai][bj][m][n], 0, 0, 0); __builtin_amdgcn_s_setprio(0); } while (0)
#define PG8_WAIT_V(n) asm volatile("s_waitcnt vmcnt(" #n ")" ::: "memory")
#define PG8_WAIT_L(n) asm volatile("s_waitcnt lgkmcnt(" #n ")" ::: "memory")
#define PG8_BAR __builtin_amdgcn_s_barrier()
#define PG8_SCHED __builtin_amdgcn_sched_barrier(0)
    Unit cur, nxt; int ui = 0;
    if (!S.next(0, cur)) return;
    f32x4 acc[2][2][4][2];
#pragma unroll
    for (int a = 0; a < 2; ++a)
#pragma unroll
        for (int b = 0; b < 2; ++b)
#pragma unroll
            for (int m = 0; m < 4; ++m)
#pragma unroll
                for (int n = 0; n < 2; ++n) acc[a][b][m][n] = (f32x4){0.f, 0.f, 0.f, 0.f};
    bf16x8 At[4][2], B0[2][2], B1[2][2];
    const char* cA = (const char*)g.A + (GATHER ? (size_t)0 : (size_t)cur.pm * tstep); const char* cB = (const char*)g.Bt + (size_t)cur.pn * tstep;
    S.a_ready(cur);
    if constexpr (GATHER) { PG8_LOADROWS(cur, vc); }
    if constexpr (SP2) {
        PG8_STAGE(PG8_SB(0, 0), cB, voffB); PG8_STAGE(PG8_SB(0, 1), cB + hstep, voffB); PG8_STAGE_A(0, 0, cA, vc); PG8_STAGE_A(0, 1, cA, vc);
        if (wr == 1) PG8_BAR;
        PG8_WAIT_V(2); PG8_BAR;
        PG8_STAGE(PG8_SB(1, 0), cB + kstep, voffB); PG8_STAGE_A(1, 0, cA + kstep, vc); PG8_STAGE(PG8_SB(1, 1), cB + hstep + kstep, voffB);
        PG8_WAIT_V(6); PG8_BAR;
    } else {
        PG8_STAGE(PG8_SB(0, 0), cB, voffB); PG8_STAGE_A(0, 0, cA, vc); PG8_STAGE(PG8_SB(0, 1), cB + hstep, voffB); PG8_STAGE_A(0, 1, cA, vc);
        if (wr == 1) PG8_BAR;
        PG8_WAIT_V(4); PG8_BAR;
        PG8_STAGE(PG8_SB(1, 0), cB + kstep, voffB); PG8_STAGE_A(1, 0, cA + kstep, vc); PG8_STAGE(PG8_SB(1, 1), cB + hstep + kstep, voffB);
        PG8_WAIT_V(6); PG8_BAR;
    }
    for (;;) {
        const bool has_next = S.next(ui + 1, nxt);
        const char* nA = (has_next && !GATHER) ? (const char*)g.A + (size_t)nxt.pm * tstep : cA; const char* nB = has_next ? (const char*)g.Bt + (size_t)nxt.pn * tstep : cB;
        for (int t = 0; t < nt; t += 2) {
            const bool last = (t == nt - 2);
            const char* a1 = cA + (size_t)(t + 1) * kstep;
            const char* a2 = last ? nA : cA + (size_t)(t + 2) * kstep; const char* b2 = last ? nB : cB + (size_t)(t + 2) * kstep;
            const char* a3 = a2 + kstep; const char* b3 = b2 + kstep;
            if (last && has_next) S.a_ready(nxt);
            if constexpr (GATHER) { if (last && has_next) { PG8_LOADROWS(nxt, vn); }
                _Pragma("unroll") for (int h_ = 0; h_ < 2; ++h_) _Pragma("unroll") for (int i_ = 0; i_ < 2; ++i_) vs[h_][i_] = (last && has_next) ? vn[h_][i_] : vc[h_][i_]; }
            if constexpr (Epi::MIDK) { if (t == nt / 2) E.mid(acc, cur, wr, wc, fr, fq); }
            if constexpr (SP2) {
            PG8_LDB(B0, 0, 0); PG8_LDB(B1, 0, 1); PG8_SCHED; PG8_LDA(At, 0, 0); PG8_STAGE_A(1, 1, a1, vc);
            PG8_WAIT_V(8); PG8_WAIT_L(0); PG8_BAR; PG8_MMA(0, 0, At, B0); PG8_MMA(0, 1, At, B1); PG8_BAR; PG8_SCHED;
            PG8_LDA(At, 0, 1); PG8_STAGE(PG8_SB(0, 0), b2, voffB); PG8_STAGE(PG8_SB(0, 1), b2 + hstep, voffB); PG8_STAGE_A(0, 0, a2, vs);
            PG8_WAIT_V(8); PG8_WAIT_L(0); PG8_BAR; PG8_MMA(1, 0, At, B0); PG8_MMA(1, 1, At, B1); PG8_BAR; PG8_SCHED;
            PG8_LDB(B0, 1, 0); PG8_LDB(B1, 1, 1); PG8_SCHED; PG8_LDA(At, 1, 0); PG8_STAGE_A(0, 1, a2, vs);
            PG8_WAIT_V(8); PG8_WAIT_L(0); PG8_BAR; PG8_MMA(0, 0, At, B0); PG8_MMA(0, 1, At, B1); PG8_BAR; PG8_SCHED;
            PG8_LDA(At, 1, 1); PG8_STAGE(PG8_SB(1, 0), b3, voffB); PG8_STAGE(PG8_SB(1, 1), b3 + hstep, voffB); PG8_STAGE_A(1, 0, a3, vs);
            PG8_WAIT_V(8); PG8_WAIT_L(0); PG8_BAR; PG8_MMA(1, 0, At, B0); PG8_MMA(1, 1, At, B1); PG8_BAR; PG8_SCHED;
            } else {
            PG8_LDB(B0, 0, 0); PG8_SCHED; PG8_LDA(At, 0, 0); PG8_STAGE_A(1, 1, a1, vc);
            PG8_WAIT_L(8); PG8_BAR; PG8_WAIT_L(0); PG8_MMA(0, 0, At, B0); PG8_BAR; PG8_SCHED;
            PG8_LDB(B1, 0, 1); PG8_STAGE(PG8_SB(0, 0), b2, voffB);
            PG8_BAR; PG8_WAIT_L(0); PG8_MMA(0, 1, At, B1); PG8_BAR;
            PG8_LDA(At, 0, 1); PG8_STAGE_A(0, 0, a2, vs);
            PG8_BAR; PG8_WAIT_L(0); PG8_MMA(1, 0, At, B0); PG8_BAR; PG8_SCHED;
            PG8_STAGE(PG8_SB(0, 1), b2 + hstep, voffB);
            PG8_WAIT_V(6); PG8_BAR; PG8_MMA(1, 1, At, B1); PG8_BAR;
            PG8_LDB(B0, 1, 0); PG8_SCHED; PG8_LDA(At, 1, 0); PG8_STAGE_A(0, 1, a2, vs);
            PG8_WAIT_L(8); PG8_BAR; PG8_WAIT_L(0); PG8_MMA(0, 0, At, B0); PG8_BAR; PG8_SCHED;
            PG8_LDB(B1, 1, 1); PG8_STAGE(PG8_SB(1, 0), b3, voffB);
            PG8_BAR; PG8_WAIT_L(0); PG8_MMA(0, 1, At, B1); PG8_BAR;
            PG8_LDA(At, 1, 1); PG8_STAGE_A(1, 0, a3, vs);
            PG8_BAR; PG8_WAIT_L(0); PG8_MMA(1, 0, At, B0); PG8_BAR; PG8_SCHED;
            PG8_STAGE(PG8_SB(1, 1), b3 + hstep, voffB);
            PG8_WAIT_V(6); PG8_BAR; PG8_MMA(1, 1, At, B1); PG8_BAR;
            }
        }
        if constexpr (ALIGN_EPI) { if (wr == 0) PG8_BAR; }
        if constexpr (!Epi::AFTER_DRAIN) { E(acc, cur, wr, wc, fr, fq); S.done(cur); }
        if (!has_next) break;
#pragma unroll
        for (int a = 0; a < 2; ++a)
#pragma unroll
            for (int b = 0; b < 2; ++b)
#pragma unroll
                for (int m = 0; m < 4; ++m)
#pragma unroll
                    for (int n = 0; n < 2; ++n) acc[a][b][m][n] = (f32x4){0.f, 0.f, 0.f, 0.f};
        cur = nxt; cA = nA; cB = nB; ++ui;
        if constexpr (GATHER) { _Pragma("unroll") for (int h_ = 0; h_ < 2; ++h_) _Pragma("unroll") for (int i_ = 0; i_ < 2; ++i_) vc[h_][i_] = vn[h_][i_]; }
        if constexpr (ALIGN_EPI) { if (wr == 1) PG8_BAR; }
    }
    PG8_WAIT_V(0);
    if constexpr (!ALIGN_EPI) { if (wr == 0) PG8_BAR; }
    PG8_BAR;
    if constexpr (Epi::AFTER_DRAIN) { E.fused(acc, cur, wr, wc, fr, fq, lds, wid, lane); S.done(cur); }
#undef PG8_SA
#undef PG8_SB
#undef PG8_STAGE
#undef PG8_STAGE_A
#undef PG8_LOADROWS
#undef PG8_LDA
#undef PG8_LDB
#undef PG8_MMA
#undef PG8_WAIT_V
#undef PG8_WAIT_L
#undef PG8_BAR
#undef PG8_SCHED
}
}
namespace mk {
constexpr int D = 1024, SEQ = 8192, NBMAX = 4, NH = 4, DIN = 5152, NE = 32, DE = 512, DEPTH = 2;
constexpr int NT_IN = 22, NIN = NT_IN * 256;
constexpr int NWAVES = 8, NTHR = 512;
#ifndef MK_MOE_FP8
#define MK_MOE_FP8 0
#endif
constexpr float WSCALE = 16.f, ASCALE = 4.f, YSCALE = 32.f;
constexpr float LOG2E = 1.4426950408889634f, QSCALE = 0.125f * LOG2E, RMS_EPS = 1e-6f;
constexpr int O_GQ = 0, O_GK = 256, O_GV = 512, O_GG = 1024, O_LRF = 1536, O_LRB = 1552, O_DQ = 1568, O_DK = 2080, O_DV = 2592, O_GA = 3104, O_GB = 4128;
typedef unsigned short bf16;
typedef unsigned u32x4 __attribute__((ext_vector_type(4)));
typedef unsigned u32x2 __attribute__((ext_vector_type(2)));
typedef float f32x4 __attribute__((ext_vector_type(4)));
typedef float f32x16 __attribute__((ext_vector_type(16)));
typedef short bf16x8 __attribute__((ext_vector_type(8)));
typedef short s16x4 __attribute__((ext_vector_type(4)));
#define LAS __attribute__((address_space(3)))
#define GAS __attribute__((address_space(1)))
#define LDS_WAIT() asm volatile("s_waitcnt lgkmcnt(0)" ::: "memory")
#define VM_WAIT() asm volatile("s_waitcnt vmcnt(0)" ::: "memory")

constexpr size_t MiB = 1u << 20;
constexpr size_t CTL_BYTES = 256 * 1024;
constexpr int CW_BAR = 4096;
constexpr int CW_CNT = 32768;
constexpr size_t OFF_MOD = 256 * 1024, OFF_TAB = 512 * 1024;
constexpr size_t OFF_WIN = 1 * MiB, SZ_WIN = (size_t)DEPTH * NIN * D * 2;
constexpr size_t OFF_WAB = OFF_WIN + SZ_WIN, SZ_WAB = (size_t)DEPTH * D * D * 2;
constexpr size_t OFF_WO = OFF_WAB + SZ_WAB, SZ_WO = SZ_WAB;
constexpr size_t OFF_WR = OFF_WO + SZ_WO, SZ_WR = (size_t)DEPTH * 256 * D * 2;
constexpr size_t OFF_W1 = OFF_WR + SZ_WR, SZ_W1 = (size_t)DEPTH * NE * 1024 * D * 2;
constexpr size_t OFF_W2 = OFF_W1 + SZ_W1, SZ_W2 = (size_t)DEPTH * NE * D * DE * 2;
constexpr size_t OFF_ACT = 225 * MiB;
static_assert(OFF_W2 + SZ_W2 <= OFF_ACT, "weights fit");
struct WS {
    unsigned* ctl; float* mod; float* tab;
    bf16 *win, *wab, *wo, *wr, *w1, *w2;
    bf16 *H, *OAB, *XB; int* eid; float* gate; int* rank; int* pos; int* tilee; int* segp;
    bf16 *GQ, *GK, *GV, *SG; bf16 *LGF, *LGB; bf16 *DQ, *DK, *DV, *SGA, *SGB; float* KVT; float* DEC; bf16* MERGED;
    bf16 *XS, *ACT, *YS; float* LOGITS; float* gsort; int* stok;
    size_t end;
};
__host__ __device__ inline WS ws_map(unsigned char* b, int nb) {
    WS w; const size_t T = (size_t)nb * SEQ;
    w.ctl = (unsigned*)b; w.mod = (float*)(b + OFF_MOD); w.tab = (float*)(b + OFF_TAB);
    w.win = (bf16*)(b + OFF_WIN); w.wab = (bf16*)(b + OFF_WAB); w.wo = (bf16*)(b + OFF_WO); w.wr = (bf16*)(b + OFF_WR); w.w1 = (bf16*)(b + OFF_W1); w.w2 = (bf16*)(b + OFF_W2);
    size_t o = OFF_ACT;
    auto take = [&](size_t bytes) { unsigned char* p = b + o; o += (bytes + 255) & ~(size_t)255; return p; };
    w.H = (bf16*)take(T * 2048); w.OAB = (bf16*)take(T * 2048); w.XB = (bf16*)take(T * 2048);
    w.eid = (int*)take(T * 8); w.gate = (float*)take(T * 8); w.rank = (int*)take(T * 8); w.pos = (int*)take(T * 8); w.tilee = (int*)take(4096); w.segp = (int*)take(1024);
    const size_t u0 = o;
    w.GQ = (bf16*)take(T * 512); w.GK = (bf16*)take(T * 512); w.GV = (bf16*)take(T * 1024); w.SG = (bf16*)take(T * 1024);
    w.LGF = (bf16*)take(T * 512); w.LGB = (bf16*)take(T * 512);
    w.DQ = (bf16*)take(T * 1024); w.DK = (bf16*)take(T * 1024); w.DV = (bf16*)take(T * 1024); w.SGA = (bf16*)take(T * 2048); w.SGB = (bf16*)take(T * 2048);
    w.KVT = (float*)take(T * 4096); w.MERGED = (bf16*)w.KVT; w.DEC = (float*)take(T * 32);
    const size_t e1 = o; o = u0;
    const size_t R = 2 * T + 32 * 256;
    w.XS = (bf16*)take(R * 2048); w.ACT = (bf16*)take(R * 1024); w.YS = (bf16*)take(R * 2048); w.LOGITS = (float*)take(T * 256); w.gsort = (float*)take(R * 4); w.stok = (int*)take(R * 4);
    w.end = o > e1 ? o : e1;
    return w;
}

typedef float f32x2_t __attribute__((ext_vector_type(2))); typedef __bf16 bf16x2_t __attribute__((ext_vector_type(2)));
__device__ __forceinline__ unsigned cvt_pk(float lo, float hi) { const f32x2_t v = {lo, hi}; const bf16x2_t b = __builtin_convertvector(v, bf16x2_t); return __builtin_bit_cast(unsigned, b); }
__device__ __forceinline__ float bf2f(unsigned short b) { return __uint_as_float(((unsigned)b) << 16); }
__device__ __forceinline__ float bflo(unsigned w) { return __uint_as_float(w << 16); }
__device__ __forceinline__ float bfhi(unsigned w) { return __uint_as_float(w & 0xffff0000u); }
__device__ __forceinline__ float fsigmoid(float x) { return __builtin_amdgcn_rcpf(1.f + __expf(-x)); }
__device__ __forceinline__ float fsilu(float x) { return x * fsigmoid(x); }
__device__ __forceinline__ float wave_sum(float v) {
#pragma unroll
    for (int o = 1; o < 64; o <<= 1) v += __shfl_xor(v, o);
    return v;
}
__device__ __forceinline__ int t5_bucket(int rel) {
    int ret = rel > 0 ? 16 : 0; int n = rel < 0 ? -rel : rel;
    if (n < 8) return ret + n;
    return ret + 8 + (n >= 12) + (n >= 16) + (n >= 23) + (n >= 32) + (n >= 46) + (n >= 64) + (n >= 91);
}

#define XB_TMO      128
#define XB_XCNT(j)  (256  + 64 * (j))
#define XB_XSUB(j)  (1280 + 64 * (j))
#define XB_XGEN(j)  (2304 + 64 * (j))
#define XB_TOP      3328
#define XB_TOPGEN   3392
#define XCD_BAR_WORDS 3456
#define XB_SPIN_CAP (1u << 18)
__device__ __forceinline__ unsigned xb_ld(unsigned* p)              { return __hip_atomic_load(p, __ATOMIC_RELAXED, __HIP_MEMORY_SCOPE_AGENT); }
__device__ __forceinline__ unsigned xb_add(unsigned* p, unsigned v) { return __hip_atomic_fetch_add(p, v, __ATOMIC_RELAXED, __HIP_MEMORY_SCOPE_AGENT); }
__device__ __forceinline__ unsigned xb_xcc_id() { return (unsigned)__builtin_amdgcn_s_getreg((3 << 11) | 20) & 0xFu; }
#define XB_SPIN(cond, bar) do { unsigned _sp = 0; while (cond) { __builtin_amdgcn_s_sleep(1); \
    if ((++_sp & 255u) == 0u) { if (xb_ld(&(bar)[XB_TMO])) break; if (_sp > XB_SPIN_CAP) { atomicAdd(&(bar)[XB_TMO], 1u); break; } } } } while (0)
struct XcdBarrier { unsigned* bar; unsigned x; volatile LAS unsigned* st; };
__device__ __forceinline__ XcdBarrier xcd_barrier_post(unsigned* bar, volatile LAS unsigned* st) {
    XcdBarrier b; b.bar = bar; b.x = xb_xcc_id(); b.st = st;
    if (threadIdx.x == 0) (void)xb_add(&bar[XB_XCNT(b.x)], 1u);
    return b;
}
__device__ __forceinline__ void xcd_barrier_complete(unsigned* bar, unsigned x, unsigned& nloc, unsigned& nx) {
    const unsigned G = gridDim.x * gridDim.y * gridDim.z;
    unsigned sum, cnt, mine, sp = 0u;
    for (;;) {
        sum = 0u; cnt = 0u; mine = 0u;
#pragma unroll
        for (unsigned j = 0; j < 16; ++j) { const unsigned c = xb_ld(&bar[XB_XCNT(j)]); sum += c; cnt += (c > 0u) ? 1u : 0u; mine = (j == x) ? c : mine; }
        if (sum == G) break;
        __builtin_amdgcn_s_sleep(1);
        if ((++sp & 255u) == 0u) { if (xb_ld(&bar[XB_TMO])) break; if (sp > XB_SPIN_CAP) { atomicAdd(&bar[XB_TMO], 1u); break; } }
    }
    nloc = mine > 0u ? mine : 1u; nx = cnt > 0u ? cnt : 1u;
}
__device__ __forceinline__ void xcd_barrier(const XcdBarrier& b) {
    asm volatile("s_waitcnt vmcnt(0)" ::: "memory");
    __syncthreads();
    if (threadIdx.x == 0) {
        unsigned* bar = b.bar;
        __builtin_amdgcn_s_waitcnt(0);
        unsigned nloc = b.st[0], nx = b.st[1];
        if (nloc == 0u) { xcd_barrier_complete(bar, b.x, nloc, nx); b.st[0] = nloc; b.st[1] = nx; }
        const unsigned old = xb_add(&bar[XB_XSUB(b.x)], 1u);
        const unsigned gen = old / nloc;
        if (old + 1u == (gen + 1u) * nloc) {
            __builtin_amdgcn_fence(__ATOMIC_RELEASE, "agent");
            asm volatile("s_waitcnt vmcnt(0)" ::: "memory");
            const unsigned og = xb_add(&bar[XB_TOP], 1u);
            const unsigned tg = og / nx;
            if (og + 1u == (tg + 1u) * nx) xb_add(&bar[XB_TOPGEN], 1u);
            else XB_SPIN(xb_ld(&bar[XB_TOPGEN]) == tg, bar);
            __builtin_amdgcn_fence(__ATOMIC_ACQUIRE, "agent");
            xb_add(&bar[XB_XGEN(b.x)], 1u);
            asm volatile("s_waitcnt vmcnt(0)" ::: "memory");
        } else {
            XB_SPIN(xb_ld(&bar[XB_XGEN(b.x)]) == gen, bar);
            __builtin_amdgcn_fence(__ATOMIC_ACQUIRE, "agent");
            asm volatile("s_waitcnt vmcnt(0)" ::: "memory");
        }
    }
    __syncthreads();
}

struct Args { const float* in[24]; float* out; unsigned char* ws; int nb, ph_lo, ph_hi, li; };
struct Frame {
    LAS unsigned char* lds; int tid, lane, wave, G, bid, nb, T; unsigned char* ws; const Args* a; float* xbuf;
};
__device__ __forceinline__ void refresh(Frame& F) { int t = threadIdx.x; asm volatile("" : "+v"(t)); F.tid = t; F.lane = t & 63; F.wave = __builtin_amdgcn_readfirstlane(t >> 6); }
constexpr int LDS_BYTES = 160 * 1024 - 64 * 0;
constexpr int LDS_MISC = 160 * 1024 - 256;

__device__ __forceinline__ void tr_item(const float* src, int lds_, int ks0, int c0, bf16* dst, int ldd, int r0, int kd0, LAS float* scr, int lane) {
#pragma unroll 8
    for (int i = 0; i < 32; ++i) { const int kk = 2 * i + (lane >> 5); scr[kk * 33 + (lane & 31)] = src[(size_t)(ks0 + kk) * lds_ + c0 + (lane & 31)]; }
    LDS_WAIT(); asm volatile("" ::: "memory");
    const int c = lane & 7;
#pragma unroll
    for (int j = 0; j < 4; ++j) { const int n = (lane >> 3) + 8 * j; const LAS float* s = scr + (8 * c) * 33 + n;
        u32x4 o; o.x = cvt_pk(s[0 * 33], s[1 * 33]); o.y = cvt_pk(s[2 * 33], s[3 * 33]); o.z = cvt_pk(s[4 * 33], s[5 * 33]); o.w = cvt_pk(s[6 * 33], s[7 * 33]);
        *(u32x4*)(dst + (size_t)(r0 + n) * ldd + kd0 + 8 * c) = o; }
    LDS_WAIT(); asm volatile("" ::: "memory");
}
__device__ __forceinline__ void tr_item8(const float* src, int lds_, int ks0, int c0, unsigned char* dst, int ldd, int r0, int kd0, float scale, LAS float* scr, int lane) {
#pragma unroll 8
    for (int i = 0; i < 32; ++i) { const int kk = 2 * i + (lane >> 5); scr[kk * 33 + (lane & 31)] = src[(size_t)(ks0 + kk) * lds_ + c0 + (lane & 31)] * scale; }
    LDS_WAIT(); asm volatile("" ::: "memory");
    const int c = lane & 7;
#pragma unroll
    for (int j = 0; j < 4; ++j) { const int n = (lane >> 3) + 8 * j; const LAS float* s = scr + (8 * c) * 33 + n;
        int w0 = 0, w1 = 0;
        w0 = __builtin_amdgcn_cvt_pk_fp8_f32(s[0 * 33], s[1 * 33], w0, false); w0 = __builtin_amdgcn_cvt_pk_fp8_f32(s[2 * 33], s[3 * 33], w0, true);
        w1 = __builtin_amdgcn_cvt_pk_fp8_f32(s[4 * 33], s[5 * 33], w1, false); w1 = __builtin_amdgcn_cvt_pk_fp8_f32(s[6 * 33], s[7 * 33], w1, true);
        u32x2 o; o.x = (unsigned)w0; o.y = (unsigned)w1;
        *(u32x2*)(dst + (size_t)(r0 + n) * ldd + kd0 + 8 * c) = o; }
    LDS_WAIT(); asm volatile("" ::: "memory");
}
__device__ __forceinline__ int win_src_col(int tile, int p0) {
    const int bj = p0 >> 7, wc = (p0 >> 5) & 3; const int L = 64 * wc + 32 * bj;
    switch (tile) {
        case 0: return O_GQ + p0; case 1: return O_GK + p0;
        case 2: case 3: return O_GV + (tile - 2) * 256 + p0;
        case 4: case 5: return O_GG + (tile - 4) * 256 + p0;
        case 8: case 9: return O_DQ + (tile - 8) * 256 + L;
        case 10: case 11: return O_DK + (tile - 10) * 256 + L;
        case 12: case 13: return O_DV + (tile - 12) * 256 + p0;
        case 14: case 15: case 16: case 17: return O_GA + (tile - 14) * 256 + p0;
        default: return O_GB + (tile - 18) * 256 + p0;
    }
}
__device__ __forceinline__ void p0_prologue(Frame& F) {
    refresh(F);
    const WS W = ws_map(F.ws, F.nb); const float* const* IN_ = F.a->in;
    const float* c_in = IN_[1]; const float* w_ada = IN_[2]; const float* b_ada = IN_[3];
    {
        LAS float* red = (LAS float*)F.lds;
        for (int it = F.bid; it < DEPTH * 96; it += F.G) {
            const int l = it / 96, j = (it % 96) * 64 + F.lane;
            const float* w = w_ada + (size_t)l * D * 6 * D + j;
            float a0 = 0.f, a1 = 0.f, a2 = 0.f, a3 = 0.f;
            const int kbeg = F.wave * 128;
#pragma unroll 16
            for (int k = kbeg; k < kbeg + 128; ++k) { const float wv = w[(size_t)k * 6 * D];
                const float c0 = c_in[k], c1 = c_in[D + k], c2 = c_in[2 * D + k], c3 = c_in[3 * D + k];
                a0 += fsilu(c0) * wv; a1 += fsilu(c1) * wv; a2 += fsilu(c2) * wv; a3 += fsilu(c3) * wv; }
            red[(F.wave * 4 + 0) * 64 + F.lane] = a0; red[(F.wave * 4 + 1) * 64 + F.lane] = a1; red[(F.wave * 4 + 2) * 64 + F.lane] = a2; red[(F.wave * 4 + 3) * 64 + F.lane] = a3;
            __syncthreads();
            if (F.tid < 256) { const int b = F.tid >> 6, jj = F.tid & 63; float s = 0.f;
#pragma unroll
                for (int wv = 0; wv < 8; ++wv) s += red[(wv * 4 + b) * 64 + jj];
                const int jc = (it % 96) * 64 + jj;
                W.mod[((size_t)l * NBMAX + b) * 6 * D + jc] = s + b_ada[l * 6 * D + jc]; }
            __syncthreads();
        }
    }
    if (F.bid == 0) {
        const float* rb = IN_[14];
        for (int i = F.tid; i < 1024; i += NTHR) { const int h = i >> 8, rel = (i & 255) - 128; W.tab[i] = (rb[t5_bucket(rel) * 4 + h] - rb[31 * 4 + h]) * LOG2E; }
        if (F.tid < 4) W.tab[1024 + F.tid] = __expf(rb[15 * 4 + F.tid] - rb[31 * 4 + F.tid]);
        if (F.tid >= 64 && F.tid < 64 + DEPTH) { const int l = F.tid - 64; const float* lv = IN_[12] + l * 256; float s1 = 0.f, s2 = 0.f;
            for (int i = 0; i < 64; ++i) { s1 += lv[i] * lv[64 + i]; s2 += lv[128 + i] * lv[192 + i]; }
            W.tab[1032 + l] = expf(s1) - expf(s2) + (0.8f - 0.6f * expf(-0.3f * (float)l)); }
    }
    __syncthreads();
    LAS float* scr = (LAS float*)(F.lds + F.wave * 16384);
    const int gw = F.bid * NWAVES + F.wave, NGW = F.G * NWAVES;
    constexpr int I_IN = (NIN / 32) * 16, I_AB = 32 * 16, I_O = 32 * 16, I_1 = NE * 32 * 16, I_2 = NE * 32 * 8;
    constexpr int PER_L = I_IN + I_AB + I_O + I_1 + I_2;
    for (int it = gw; it < DEPTH * PER_L; it += NGW) {
        const int l = it / PER_L; int r = it % PER_L;
        if (r < I_IN) { const int rb = r / 16, kb = r % 16, R = rb * 32, tile = R >> 8, p0 = R & 255;
            if (tile == 6 || tile == 7) continue;
            tr_item(IN_[6] + (size_t)l * D * DIN, DIN, kb * 64, win_src_col(tile, p0), W.win + (size_t)l * NIN * D, D, R, kb * 64, scr, F.lane); continue; }
        r -= I_IN;
        if (r < I_AB) { const int rb = r / 16, kb = r % 16;
            if (kb < 8) tr_item(IN_[15] + (size_t)l * 512 * D, D, kb * 64, rb * 32, W.wab + (size_t)l * D * D, 512, rb * 32, kb * 64, scr, F.lane);
            else tr_item(IN_[16] + (size_t)l * 512 * D, D, (kb - 8) * 64, rb * 32, W.wab + (size_t)l * D * D + (size_t)1024 * 512, 512, rb * 32, (kb - 8) * 64, scr, F.lane);
            continue; }
        r -= I_AB;
        if (r < I_O) { const int rb = r / 16, kb = r % 16; tr_item(IN_[17] + (size_t)l * D * D, D, kb * 64, rb * 32, W.wo + (size_t)l * D * D, D, rb * 32, kb * 64, scr, F.lane); continue; }
        r -= I_O;
        if (r < I_1) { const int e = r / 512, q = r % 512, rb = q / 16, kb = q % 16, R = rb * 32, pn = R >> 8, p = R & 255;
            const int col = (p < 128) ? (128 * pn + p) : (512 + 128 * pn + p - 128);
#if MK_MOE_FP8
            tr_item8(IN_[22] + ((size_t)l * NE + e) * D * 1024, 1024, kb * 64, col, (unsigned char*)W.w1 + ((size_t)l * NE + e) * 1024 * D, D, R, kb * 64, WSCALE, scr, F.lane); continue; }
#else
            tr_item(IN_[22] + ((size_t)l * NE + e) * D * 1024, 1024, kb * 64, col, W.w1 + ((size_t)l * NE + e) * 1024 * D, D, R, kb * 64, scr, F.lane); continue; }
#endif
        r -= I_1;
        { const int e = r / 256, q = r % 256, rb = q / 8, kb = q % 8;
#if MK_MOE_FP8
          tr_item8(IN_[23] + ((size_t)l * NE + e) * DE * D, D, kb * 64, rb * 32, (unsigned char*)W.w2 + ((size_t)l * NE + e) * D * DE, DE, rb * 32, kb * 64, WSCALE, scr, F.lane); }
#else
          tr_item(IN_[23] + ((size_t)l * NE + e) * DE * D, D, kb * 64, rb * 32, W.w2 + ((size_t)l * NE + e) * D * DE, DE, rb * 32, kb * 64, scr, F.lane); }
#endif
    }
    for (int it = gw; it < DEPTH * 2 * 8 * 16; it += NGW) {
        const int l = it >> 8, dir = (it >> 7) & 1, nbk = (it >> 4) & 7, kb = it & 15; const int k = kb * 64 + F.lane;
        const float* wi = IN_[6] + (size_t)l * D * DIN + (size_t)k * DIN + (dir ? O_LRB : O_LRF);
        float wv[16];
#pragma unroll
        for (int r = 0; r < 16; ++r) wv[r] = wi[r];
        const float* wu = IN_[7] + ((size_t)l * 2 + dir) * 16 * 256;
        bf16* dst = W.win + (size_t)l * NIN * D + (size_t)((6 + dir) * 256) * D;
        for (int n = nbk * 32; n < nbk * 32 + 32; ++n) { float s = 0.f;
#pragma unroll
            for (int r = 0; r < 16; ++r) s += wv[r] * wu[r * 256 + n];
            dst[(size_t)n * D + k] = (bf16)(cvt_pk(s, 0.f) & 0xffffu); }
    }
    for (int it = gw * 64 + F.lane; it < DEPTH * 256 * 128; it += NGW * 64) {
        const int l = it / (256 * 128), q = it % (256 * 128), row = q >> 7, k0 = (q & 127) * 8;
        float v[8];
#pragma unroll
        for (int i = 0; i < 8; ++i) { float x = 0.f;
            if (row < 4) x = IN_[18][((size_t)l * D + k0 + i) * 4 + row]; else if (row < 36) x = IN_[20][((size_t)l * D + k0 + i) * 32 + row - 4];
            v[i] = x; }
        u32x4 o; o.x = cvt_pk(v[0], v[1]); o.y = cvt_pk(v[2], v[3]); o.z = cvt_pk(v[4], v[5]); o.w = cvt_pk(v[6], v[7]);
        *(u32x4*)(W.wr + ((size_t)l * 256 + row) * D + k0) = o;
    }
}

__device__ __forceinline__ void phase_norm(Frame& F, int l, int mode) {
    refresh(F);
    const WS W = ws_map(F.ws, F.nb); const float* const* IN_ = F.a->in;
    const int gw = F.bid * NWAVES + F.wave, NGW = F.G * NWAVES;
    const bool combine = (mode == 2) || (mode == 0 && l > 0);
    const bool from_in = (mode == 0 && l == 0);
    const int lp = (mode == 2) ? DEPTH - 1 : l - 1;
    const float* ng = (mode == 1 ? IN_[5] : IN_[4]) + (size_t)(mode == 2 ? 0 : l) * D;
    for (int t = gw; t < F.T; t += NGW) {
        const int b = t / SEQ;
        f32x4 v[4];
        if (from_in) { const GAS f32x4* xr = (const GAS f32x4*)(IN_[0] + (size_t)t * D) + F.lane;
#pragma unroll
            for (int j = 0; j < 4; ++j) v[j] = xr[64 * j]; }
        else { const GAS u32x2* xr = (const GAS u32x2*)(W.XB + (size_t)t * D) + F.lane;
#pragma unroll
            for (int j = 0; j < 4; ++j) { const u32x2 a = xr[64 * j]; v[j] = (f32x4){bflo(a.x), bfhi(a.x), bflo(a.y), bfhi(a.y)}; } }
        if (combine) {
            const float* g2 = W.mod + ((size_t)lp * NBMAX + b) * 6 * D + 5 * D;
            const int p0 = W.pos[t * 2], p1 = W.pos[t * 2 + 1];
            const GAS unsigned* y0 = (const GAS unsigned*)((const unsigned char*)W.YS + (size_t)p0 * D) + F.lane; const GAS unsigned* y1 = (const GAS unsigned*)((const unsigned char*)W.YS + (size_t)p1 * D) + F.lane;
#pragma unroll
            for (int j = 0; j < 4; ++j) { const unsigned a = y0[64 * j], c = y1[64 * j]; const f32x4 g = *((const GAS f32x4*)g2 + F.lane + 64 * j) * (1.f / YSCALE);
                v[j].x += g.x * (__builtin_amdgcn_cvt_f32_fp8((int)a, 0) + __builtin_amdgcn_cvt_f32_fp8((int)c, 0)); v[j].y += g.y * (__builtin_amdgcn_cvt_f32_fp8((int)a, 1) + __builtin_amdgcn_cvt_f32_fp8((int)c, 1));
                v[j].z += g.z * (__builtin_amdgcn_cvt_f32_fp8((int)a, 2) + __builtin_amdgcn_cvt_f32_fp8((int)c, 2)); v[j].w += g.w * (__builtin_amdgcn_cvt_f32_fp8((int)a, 3) + __builtin_amdgcn_cvt_f32_fp8((int)c, 3)); }
            if (mode == 2) { GAS f32x4* xo = (GAS f32x4*)(F.xbuf + (size_t)t * D) + F.lane;
#pragma unroll
                for (int j = 0; j < 4; ++j) xo[64 * j] = v[j]; }
            else { GAS u32x2* xo = (GAS u32x2*)(W.XB + (size_t)t * D) + F.lane;
#pragma unroll
                for (int j = 0; j < 4; ++j) { u32x2 o; o.x = cvt_pk(v[j].x, v[j].y); o.y = cvt_pk(v[j].z, v[j].w); xo[64 * j] = o; } }
        }
        if (mode == 2) continue;
        float ss = 0.f;
#pragma unroll
        for (int j = 0; j < 4; ++j) ss += (v[j].x * v[j].x + v[j].y * v[j].y) + (v[j].z * v[j].z + v[j].w * v[j].w);
        const float rstd = rsqrtf(wave_sum(ss) * (1.f / D) + RMS_EPS);
        const float* md = W.mod + ((size_t)l * NBMAX + b) * 6 * D + (mode == 1 ? 3 * D : 0);
        GAS u32x2* ho = (GAS u32x2*)(W.H + (size_t)t * D) + F.lane;
#pragma unroll
        for (int j = 0; j < 4; ++j) { const f32x4 g = *((const GAS f32x4*)ng + F.lane + 64 * j), sh = *((const GAS f32x4*)md + F.lane + 64 * j), sc = *((const GAS f32x4*)(md + D) + F.lane + 64 * j);
            const float h0 = v[j].x * rstd * g.x * (1.f + sc.x) + sh.x, h1 = v[j].y * rstd * g.y * (1.f + sc.y) + sh.y, h2 = v[j].z * rstd * g.z * (1.f + sc.z) + sh.z, h3 = v[j].w * rstd * g.w * (1.f + sc.w) + sh.w;
            u32x2 o; o.x = cvt_pk(h0, h1); o.y = cvt_pk(h2, h3); ho[64 * j] = o; }
    }
}
typedef pg8::Unit Unit;
__device__ __forceinline__ u32x4 pack8(const f32x4& a, const f32x4& b) { u32x4 w; w.x = cvt_pk(a[0], a[1]); w.y = cvt_pk(a[2], a[3]); w.z = cvt_pk(b[0], b[1]); w.w = cvt_pk(b[2], b[3]); return w; }

#ifndef MK_ATT_FP8
#define MK_ATT_FP8 1
#endif
__device__ __forceinline__ u32x2 pack8_fp8(const f32x4& a, const f32x4& b) { int w0 = 0, w1 = 0;
    w0 = __builtin_amdgcn_cvt_pk_fp8_f32(a[0], a[1], w0, false); w0 = __builtin_amdgcn_cvt_pk_fp8_f32(a[2], a[3], w0, true);
    w1 = __builtin_amdgcn_cvt_pk_fp8_f32(b[0], b[1], w1, false); w1 = __builtin_amdgcn_cvt_pk_fp8_f32(b[2], b[3], w1, true);
    u32x2 r; r.x = (unsigned)w0; r.y = (unsigned)w1; return r; }
struct EpiNull {
    static constexpr bool PERM = true, AFTER_DRAIN = false, MIDK = false;
    __device__ __forceinline__ void operator()(const f32x4 (&acc)[2][2][4][2], const Unit&, int, int, int, int) const {
#pragma unroll
        for (int a = 0; a < 2; ++a)
#pragma unroll
            for (int b = 0; b < 2; ++b)
#pragma unroll
                for (int m = 0; m < 4; ++m) { asm volatile("" :: "v"(acc[a][b][m][0]), "v"(acc[a][b][m][1])); } }
};
struct EpiIn {
    static constexpr bool PERM = true, AFTER_DRAIN = false, MIDK = false;
    bf16 *GQ, *GK, *GV, *SG, *LGF, *LGB, *DQ, *DK, *DV, *SGA, *SGB; const float* b_up; const float* qg; const float* kg; int plain;
    __device__ __forceinline__ void operator()(const f32x4 (&acc)[2][2][4][2], const Unit& u, int wr, int wc, int fr, int fq) const {
        const int pn = u.pn; const int row0 = u.pm * 256 + wr * 64 + fr;
        if (pn >= 8 && pn <= 11) {
            const bool isk = pn >= 10; const int head = 2 * ((pn - 8) & 1) + (wc >> 1), c = wc & 1;
            const float* gv = isk ? kg : qg; const float sc = isk ? 1.f : QSCALE;
            f32x4 g[2][2];
#pragma unroll
            for (int bj = 0; bj < 2; ++bj)
#pragma unroll
                for (int n = 0; n < 2; ++n) g[bj][n] = *(const f32x4*)(gv + 32 * bj + 8 * fq + 4 * n);
#pragma unroll
            for (int ai = 0; ai < 2; ++ai)
#pragma unroll
                for (int m = 0; m < 4; ++m) {
                    const int r = row0 + ai * 128 + m * 16, b = r / SEQ, s = r % SEQ;
                    float ss = 0.f;
#pragma unroll
                    for (int bj = 0; bj < 2; ++bj)
#pragma unroll
                        for (int n = 0; n < 2; ++n) { const f32x4 x = acc[ai][bj][m][n]; ss += (x[0] * x[0] + x[1] * x[1]) + (x[2] * x[2] + x[3] * x[3]); }
                    ss += __shfl_xor(ss, 16); ss += __shfl_xor(ss, 32);
                    const float rs = rsqrtf(ss * (1.f / 64.f) + RMS_EPS) * sc;
#if MK_ATT_FP8
                    unsigned char* dst8 = (unsigned char*)(isk ? DK : DQ) + ((((size_t)b * NH + head) * 2 + c) * SEQ + s) * 64;
#pragma unroll
                    for (int bj = 0; bj < 2; ++bj) {
                        const f32x4 v0 = acc[ai][bj][m][0] * rs * g[bj][0], v1 = acc[ai][bj][m][1] * rs * g[bj][1];
                        int chunk = 2 * bj + (fq >> 1); if (isk) chunk ^= ((s >> 2) & 3);
                        *(u32x2*)(dst8 + chunk * 16 + 8 * (fq & 1)) = pack8_fp8(v0, v1);
                    }
#else
                    bf16* dst = (isk ? DK : DQ) + ((((size_t)b * NH + head) * 2 + c) * SEQ + s) * 64;
#pragma unroll
                    for (int bj = 0; bj < 2; ++bj) {
                        const f32x4 v0 = acc[ai][bj][m][0] * rs * g[bj][0], v1 = acc[ai][bj][m][1] * rs * g[bj][1];
                        int chunk = 4 * bj + fq; if (isk) chunk ^= ((s >> 1) & 7);
                        *(u32x4*)(dst + chunk * 8) = pack8(v0, v1);
                    }
#endif
                }
            return;
        }
#pragma unroll
        for (int ai = 0; ai < 2; ++ai)
#pragma unroll
            for (int m = 0; m < 4; ++m) {
                const int r = row0 + ai * 128 + m * 16;
#pragma unroll
                for (int bj = 0; bj < 2; ++bj) {
                    const int c0 = 128 * bj + 32 * wc + 8 * fq;
                    f32x4 v0 = acc[ai][bj][m][0], v1 = acc[ai][bj][m][1];
                    if (plain) { *(u32x4*)(SGA + (size_t)r * D + (pn & 3) * 256 + c0) = pack8(v0, v1); }
                    else if (pn == 0) { *(u32x4*)(GQ + (size_t)r * 256 + c0) = pack8(v0 * 0.125f, v1 * 0.125f); }
                    else if (pn == 1) { *(u32x4*)(GK + (size_t)r * 256 + c0) = pack8(v0, v1); }
                    else if (pn <= 3) { *(u32x4*)(GV + (size_t)r * 512 + (pn - 2) * 256 + c0) = pack8(v0, v1); }
                    else if (pn <= 5) {
#pragma unroll
                        for (int i = 0; i < 4; ++i) { v0[i] = fsilu(v0[i]); v1[i] = fsilu(v1[i]); }
                        *(u32x4*)(SG + (size_t)r * 512 + (pn - 4) * 256 + c0) = pack8(v0, v1); }
                    else if (pn <= 7) {
                        const float* bu = b_up + (pn - 6) * 256 + c0; const f32x4 b0 = *(const f32x4*)bu, b1 = *(const f32x4*)(bu + 4);
#pragma unroll
                        for (int i = 0; i < 4; ++i) { float z = v0[i] + b0[i]; v0[i] = (fminf(z, 0.f) - __logf(1.f + __expf(-fabsf(z)))) * (1.f / 16.f);
                                                      z = v1[i] + b1[i]; v1[i] = (fminf(z, 0.f) - __logf(1.f + __expf(-fabsf(z)))) * (1.f / 16.f); }
                        *(u32x4*)((pn == 6 ? LGF : LGB) + (size_t)r * 256 + c0) = pack8(v0, v1); }
#if MK_ATT_FP8
                    else if (pn <= 13) {
                        const int b = r / SEQ, s = r % SEQ, head = 2 * (pn - 12) + bj;
                        const int kk = s & 63, wkey = kk & 31, hh_ = (wkey >> 2) & 1, reg_ = (wkey & 3) + 4 * (wkey >> 3), pos = hh_ * 32 + 16 * (kk >> 5) + reg_;
                        unsigned char* tb = (unsigned char*)DV + (((size_t)b * NH + head) * (SEQ / 64) + (s >> 6)) * 8192;
                        const u32x2 pk = pack8_fp8(v0, v1); const int dv0 = 32 * wc + 8 * fq;
#pragma unroll
                        for (int i = 0; i < 8; ++i) { const int dv = dv0 + i; const unsigned byte = ((i < 4 ? pk.x : pk.y) >> (8 * (i & 3))) & 0xffu;
                            tb[dv * 64 + ((((pos >> 4) ^ ((dv >> 2) & 3)) << 4) | (pos & 15))] = (unsigned char)byte; } }
#else
                    else if (pn <= 13) {
                        const int b = r / SEQ, s = r % SEQ, head = 2 * (pn - 12) + bj;
                        bf16* dst = DV + ((((size_t)b * NH + head) * (SEQ / 8) + (s >> 3)) * 4 + wc) * 256 + (s & 7) * 32 + 8 * fq;
                        *(u32x4*)dst = pack8(v0, v1); }
#endif
                    else {
#pragma unroll
                        for (int i = 0; i < 4; ++i) { v0[i] = fsigmoid(v0[i]); v1[i] = fsigmoid(v1[i]); }
                        bf16* base = (pn <= 17) ? SGA + (pn - 14) * 256 : SGB + (pn - 18) * 256;
                        *(u32x4*)(base + (size_t)r * D + c0) = pack8(v0, v1); }
                }
            }
    }
};

struct EpiMerge {
    static constexpr bool PERM = true, AFTER_DRAIN = false, MIDK = false;
    const bf16* SGA; const bf16* SGB; bf16* O; int nM;
    __device__ __forceinline__ void operator()(const f32x4 (&acc)[2][2][4][2], const Unit& u, int wr, int wc, int fr, int fq) const {
        const int sel = u.pn >> 2; const int row0 = (u.pm - sel * nM) * 256 + wr * 64 + fr, col0 = (u.pn & 3) * 256 + wc * 32 + 8 * fq;
        const bf16* G = sel ? SGB : SGA;
#pragma unroll
        for (int ai = 0; ai < 2; ++ai) {
            u32x4 gt[4][2], t1[4][2];
#pragma unroll
            for (int m = 0; m < 4; ++m) { const size_t off = (size_t)(row0 + ai * 128 + m * 16) * D + col0;
#pragma unroll
                for (int bj = 0; bj < 2; ++bj) { gt[m][bj] = *(const u32x4*)(G + off + bj * 128); if (sel) t1[m][bj] = *(const u32x4*)(O + off + bj * 128); } }
#pragma unroll
            for (int m = 0; m < 4; ++m) { const size_t off = (size_t)(row0 + ai * 128 + m * 16) * D + col0;
#pragma unroll
                for (int bj = 0; bj < 2; ++bj) { const u32x4 b = gt[m][bj];
                    f32x4 v0 = acc[ai][bj][m][0], v1 = acc[ai][bj][m][1];
                    v0[0] *= bflo(b.x); v0[1] *= bfhi(b.x); v0[2] *= bflo(b.y); v0[3] *= bfhi(b.y); v1[0] *= bflo(b.z); v1[1] *= bfhi(b.z); v1[2] *= bflo(b.w); v1[3] *= bfhi(b.w);
                    if (sel) { const u32x4 t = t1[m][bj];
                        v0[0] += bflo(t.x); v0[1] += bfhi(t.x); v0[2] += bflo(t.y); v0[3] += bfhi(t.y); v1[0] += bflo(t.z); v1[1] += bfhi(t.z); v1[2] += bflo(t.w); v1[3] += bfhi(t.w); }
                    *(u32x4*)(O + off + bj * 128) = pack8(v0, v1); } }
            asm volatile("" ::: "memory");
        }
    }
};
struct MergeOrder {
    pg8::StaticOrder so; int nM;
    __device__ __forceinline__ bool next(int i, Unit& u) const { Unit t; if (!so.next(i >> 1, t)) return false; const int sel = i & 1; u.pm = t.pm + sel * nM; u.pn = t.pn + sel * 4; return true; }
    __device__ __forceinline__ void a_ready(const Unit&) const {}
    __device__ __forceinline__ void done(const Unit&) const {}
};

struct EpiResid {
    static constexpr bool PERM = true, AFTER_DRAIN = false, MIDK = false;
    const float* xin32; bf16* xb; const float* g1;
    __device__ __forceinline__ void operator()(const f32x4 (&acc)[2][2][4][2], const Unit& u, int wr, int wc, int fr, int fq) const {
        const int row0 = u.pm * 256 + wr * 64 + fr, col0 = u.pn * 256 + wc * 32 + 8 * fq;
        const int b = (u.pm * 256) / SEQ; const float* g = g1 + (size_t)b * 6 * D + col0;
        f32x4 gv[2][2];
#pragma unroll
        for (int bj = 0; bj < 2; ++bj)
#pragma unroll
            for (int n = 0; n < 2; ++n) gv[bj][n] = *(const f32x4*)(g + bj * 128 + n * 4);
        if (xin32) {
#pragma unroll
            for (int ai = 0; ai < 2; ++ai)
#pragma unroll
                for (int mh = 0; mh < 2; ++mh) { f32x4 x0[2][2], x1[2][2];
#pragma unroll
                    for (int m2 = 0; m2 < 2; ++m2) { const size_t off = (size_t)(row0 + ai * 128 + (2 * mh + m2) * 16) * D + col0;
#pragma unroll
                        for (int bj = 0; bj < 2; ++bj) { x0[m2][bj] = *(const f32x4*)(xin32 + off + bj * 128); x1[m2][bj] = *(const f32x4*)(xin32 + off + bj * 128 + 4); } }
#pragma unroll
                    for (int m2 = 0; m2 < 2; ++m2) { const int m = 2 * mh + m2; const size_t off = (size_t)(row0 + ai * 128 + m * 16) * D + col0;
#pragma unroll
                        for (int bj = 0; bj < 2; ++bj) *(u32x4*)(xb + off + bj * 128) = pack8(x0[m2][bj] + gv[bj][0] * acc[ai][bj][m][0], x1[m2][bj] + gv[bj][1] * acc[ai][bj][m][1]); }
                    asm volatile("" ::: "memory"); }
        } else {
#pragma unroll
            for (int ai = 0; ai < 2; ++ai) { u32x4 xr[4][2];
#pragma unroll
                for (int m = 0; m < 4; ++m) { const size_t off = (size_t)(row0 + ai * 128 + m * 16) * D + col0;
#pragma unroll
                    for (int bj = 0; bj < 2; ++bj) xr[m][bj] = *(const u32x4*)(xb + off + bj * 128); }
#pragma unroll
                for (int m = 0; m < 4; ++m) { const size_t off = (size_t)(row0 + ai * 128 + m * 16) * D + col0;
#pragma unroll
                    for (int bj = 0; bj < 2; ++bj) { const u32x4 a = xr[m][bj];
                        const f32x4 x0 = {bflo(a.x), bfhi(a.x), bflo(a.y), bfhi(a.y)}, x1 = {bflo(a.z), bfhi(a.z), bflo(a.w), bfhi(a.w)};
                        *(u32x4*)(xb + off + bj * 128) = pack8(x0 + gv[bj][0] * acc[ai][bj][m][0], x1 + gv[bj][1] * acc[ai][bj][m][1]); } }
                asm volatile("" ::: "memory"); }
        }
    }
};

struct EpiLogits {
    static constexpr bool PERM = false, AFTER_DRAIN = false, MIDK = false;
    float* L;
    __device__ __forceinline__ void operator()(const f32x4 (&acc)[2][2][4][2], const Unit& u, int wr, int wc, int fr, int fq) const {
        if (wc >= 2) return;
        const int row0 = u.pm * 256 + wr * 64 + fr, col0 = wc * 32 + 4 * fq;
#pragma unroll
        for (int ai = 0; ai < 2; ++ai)
#pragma unroll
            for (int m = 0; m < 4; ++m)
#pragma unroll
                for (int n = 0; n < 2; ++n) *(f32x4*)(L + (size_t)(row0 + ai * 128 + m * 16) * 64 + col0 + n * 16) = acc[ai][0][m][n];
    }
};

#ifndef MK_MOE_FP8
#define MK_MOE_FP8 0
#endif
#if MK_MOE_FP8
struct EpiAct {
    static constexpr bool PERM = true, AFTER_DRAIN = false, MIDK = false;
    unsigned char* ACT;
    __device__ __forceinline__ void operator()(const f32x4 (&acc)[2][2][4][2], const Unit& u, int wr, int wc, int fr, int fq) const {
        const int row0 = u.pm * 256 + wr * 64 + fr, col0 = (u.pn & 3) * 128 + wc * 32 + 8 * fq;
        constexpr float inv = 1.f / WSCALE;
#pragma unroll
        for (int ai = 0; ai < 2; ++ai)
#pragma unroll
            for (int m = 0; m < 4; ++m) { f32x4 v0, v1;
#pragma unroll
                for (int i = 0; i < 4; ++i) { v0[i] = fsilu(acc[ai][0][m][0][i] * inv) * acc[ai][1][m][0][i] * (inv * ASCALE); v1[i] = fsilu(acc[ai][0][m][1][i] * inv) * acc[ai][1][m][1][i] * (inv * ASCALE); }
                *(u32x2*)(ACT + (size_t)(row0 + ai * 128 + m * 16) * DE + col0) = pack8_fp8(v0, v1); }
    }
};
struct EpiYs {
    static constexpr bool PERM = true, AFTER_DRAIN = false, MIDK = false;
    bf16* YS; const float* gs;
    __device__ __forceinline__ void operator()(const f32x4 (&acc)[2][2][4][2], const Unit& u, int wr, int wc, int fr, int fq) const {
        const int row0 = u.pm * 256 + wr * 64 + fr, col0 = (u.pn & 3) * 256 + wc * 32 + 8 * fq;
#pragma unroll
        for (int ai = 0; ai < 2; ++ai)
#pragma unroll
            for (int m = 0; m < 4; ++m) { const int r = row0 + ai * 128 + m * 16; const float gt = gs[r] * (1.f / (WSCALE * ASCALE));
#pragma unroll
                for (int bj = 0; bj < 2; ++bj) *(u32x4*)(YS + (size_t)r * D + col0 + bj * 128) = pack8(acc[ai][bj][m][0] * gt, acc[ai][bj][m][1] * gt); }
    }
};
#else
struct EpiAct {
    static constexpr bool PERM = true, AFTER_DRAIN = false, MIDK = false;
    bf16* ACT;
    __device__ __forceinline__ void operator()(const f32x4 (&acc)[2][2][4][2], const Unit& u, int wr, int wc, int fr, int fq) const {
        const int row0 = u.pm * 256 + wr * 64 + fr, col0 = (u.pn & 3) * 128 + wc * 32 + 8 * fq;
#pragma unroll
        for (int ai = 0; ai < 2; ++ai)
#pragma unroll
            for (int m = 0; m < 4; ++m) { f32x4 v0, v1;
#pragma unroll
                for (int i = 0; i < 4; ++i) { v0[i] = fsilu(acc[ai][0][m][0][i]) * acc[ai][1][m][0][i]; v1[i] = fsilu(acc[ai][0][m][1][i]) * acc[ai][1][m][1][i]; }
                *(u32x4*)(ACT + (size_t)(row0 + ai * 128 + m * 16) * DE + col0) = pack8(v0, v1); }
    }
};
struct EpiYs {
    static constexpr bool PERM = true, AFTER_DRAIN = false, MIDK = false;
    unsigned char* YS; const float* gs;
    __device__ __forceinline__ void operator()(const f32x4 (&acc)[2][2][4][2], const Unit& u, int wr, int wc, int fr, int fq) const {
        const int row0 = u.pm * 256 + wr * 64 + fr, col0 = (u.pn & 3) * 256 + wc * 32 + 8 * fq;
        float gts[2][4];
#pragma unroll
        for (int ai = 0; ai < 2; ++ai)
#pragma unroll
            for (int m = 0; m < 4; ++m) gts[ai][m] = gs[row0 + ai * 128 + m * 16] * YSCALE;
#pragma unroll
        for (int ai = 0; ai < 2; ++ai)
#pragma unroll
            for (int m = 0; m < 4; ++m) { const int r = row0 + ai * 128 + m * 16; const float gt = gts[ai][m];
#pragma unroll
                for (int bj = 0; bj < 2; ++bj) *(u32x2*)(YS + (size_t)r * D + col0 + bj * 128) = pack8_fp8(acc[ai][bj][m][0] * gt, acc[ai][bj][m][1] * gt); }
    }
};
#endif
struct GroupedOrder {
    const int* tilee; int U, G, c; const int* rowidx;
    __device__ __forceinline__ bool next(int i, Unit& u) const {
        int id;
        if ((G & 7) == 0) { const int gx = G >> 3, per = (U + 7) >> 3, n = i * gx + (c >> 3); if (n >= per) return false; id = (c & 7) * per + n; if (id >= U) return false; }
        else { id = i * G + c; if (id >= U) return false; }
        const int t = id >> 2; u.pm = t; u.pn = tilee[t] * 4 + (id & 3); return true;
    }
    __device__ __forceinline__ void a_ready(const Unit&) const {}
    __device__ __forceinline__ void done(const Unit&) const {}
};
constexpr int AT_KR = 0, AT_VR = 32768, AT_TAB = 98304, AT_SLOT = 8192;
typedef int v8i __attribute__((ext_vector_type(8)));
typedef int v4i __attribute__((ext_vector_type(4)));
__device__ __forceinline__ int crow(int r, int hi) { return (r & 3) + 8 * (r >> 2) + 4 * hi; }

__device__ __forceinline__ void attn_bias(f32x16& s0, f32x16& s1, int relbase, const LAS float* tabh) {
#pragma unroll
    for (int r = 0; r < 16; ++r) {
        int i0 = relbase + (r & 3) + 8 * (r >> 2); int i1 = i0 + 32;
        i0 = i0 < 0 ? 0 : (i0 > 255 ? 255 : i0); i1 = i1 < 0 ? 0 : (i1 > 255 ? 255 : i1);
        s0[r] += tabh[i0]; s1[r] += tabh[i1];
    }
}
template <int J>
__device__ __forceinline__ void attn_exp_chunk(f32x16& s0, f32x16& s1, float& lsum) {
    float ls = 0.f;
#pragma unroll
    for (int r = 4 * J; r < 4 * J + 4; ++r) { s0[r] = __builtin_amdgcn_exp2f(s0[r]); s1[r] = __builtin_amdgcn_exp2f(s1[r]); }
    (void)ls; (void)lsum;
}
__device__ __forceinline__ int pk4_bf8(float a, float b, float c, float d) {
    const unsigned lo = __builtin_bit_cast(unsigned, __builtin_amdgcn_cvt_pkrtz(a, b)), hi = __builtin_bit_cast(unsigned, __builtin_amdgcn_cvt_pkrtz(c, d));
    return (int)__builtin_amdgcn_perm(hi, lo, 0x07050301u);
}
#define AT_CM4 ((f32x16){-4.f, -4.f, -4.f, -4.f, -4.f, -4.f, -4.f, -4.f, -4.f, -4.f, -4.f, -4.f, -4.f, -4.f, -4.f, -4.f})
__device__ __forceinline__ void glds16(const void* gsrc, unsigned lds_dst) { unsigned keep;
    asm volatile("s_mov_b32 %0, m0\n\ts_mov_b32 m0, %2\n\ts_nop 0\n\tglobal_load_lds_dwordx4 %1, off\n\ts_mov_b32 m0, %0" : "=&s"(keep) : "v"(gsrc), "s"(lds_dst) : "memory"); }
__device__ __forceinline__ void attn_dma_k(unsigned lds0, const unsigned char* kg0, int t, int slot, int wid, int lane) {
    glds16(kg0 + (size_t)(wid >> 2) * SEQ * 64 + (size_t)t * 4096 + (wid & 3) * 1024 + lane * 16, (unsigned)__builtin_amdgcn_readfirstlane((int)(lds0 + AT_KR + slot * AT_SLOT + wid * 1024)));
}
__device__ __forceinline__ void attn_dma_v(unsigned lds0, const unsigned char* vg0, int t, int slot, int wid, int lane) {
    glds16(vg0 + (size_t)t * 8192 + wid * 1024 + lane * 16, (unsigned)__builtin_amdgcn_readfirstlane((int)(lds0 + AT_VR + slot * AT_SLOT + wid * 1024)));
}
#define AT_RD128(dst, addr, off) asm volatile("ds_read_b128 %0, %1 offset:%c2" : "=&v"(dst) : "v"(addr), "i"(off) : "memory")
#define AT_MFMA8(a, b, c) __builtin_amdgcn_mfma_scale_f32_32x32x64_f8f6f4(a, b, c, 0, 0, 0, 0, 0, 0)
#define AT_MFMA8B(a, b, c) __builtin_amdgcn_mfma_scale_f32_32x32x64_f8f6f4(a, b, c, 0, 1, 0, 0, 0, 0)

template <int VAR>
__device__ __forceinline__ void phase_attn(Frame& F, int l) {
    refresh(F);
    const WS W = ws_map(F.ws, F.nb); const float* const* IN_ = F.a->in; (void)IN_; (void)W;
    const int lane = F.lane, wid = F.wave, r32 = lane & 31, hh = lane >> 5, qg = wid & 3, c = wid >> 2;
    LAS unsigned char* lds = F.lds; const unsigned lds0 = (unsigned)(unsigned long)lds;
    LAS float* tab = (LAS float*)(lds + AT_TAB);
    for (int i = F.tid; i < 1028; i += NTHR) tab[i] = W.tab[i];
    const float lam = W.tab[1032 + l]; const float lam_init = 0.8f - 0.6f * __expf(-0.3f * (float)l);
    const float* subg = IN_[13] + l * 128;
    const int U = F.nb * NH * 64;
    const int gx = F.G >> 3, per = U >> 3;
    const int sw = (r32 >> 2) & 3;
    const unsigned ka0 = lds0 + AT_KR + c * 4096 + r32 * 64 + (((2 * hh) ^ sw) << 4), ka1 = lds0 + AT_KR + c * 4096 + r32 * 64 + (((2 * hh + 1) ^ sw) << 4);
    const unsigned va0 = lds0 + AT_VR + r32 * 64 + (((2 * hh) ^ sw) << 4), va1 = lds0 + AT_VR + r32 * 64 + (((2 * hh + 1) ^ sw) << 4);
#ifndef MK_ATT_1BAR
#define MK_ATT_1BAR 1
#endif
    const bool lag = (MK_ATT_1BAR == 0) && wid >= 4;
    __syncthreads();
    for (int i = 0;; ++i) {
        int id;
        if ((F.G & 7) == 0) { const int n = i * gx + (F.bid >> 3); if (n >= per) break; id = (F.bid & 7) * per + n; }
        else { id = i * F.G + F.bid; if (id >= U) break; }
        const int bh = id >> 6, qb = id & 63, b = bh >> 2, h = bh & 3;
        const int qw0 = qb * 128 + 32 * qg;
        const unsigned char* kg0 = (const unsigned char*)W.DK + ((size_t)bh * 2) * SEQ * 64;
        const unsigned char* vg0 = (const unsigned char*)W.DV + (size_t)bh * SEQ * 128;
        v8i qf; { const unsigned char* qp = (const unsigned char*)W.DQ + (((size_t)bh * 2 + c) * SEQ + qw0 + r32) * 64 + 32 * hh;
            const v4i q0 = *(const v4i*)qp, q1 = *(const v4i*)(qp + 16); qf = (v8i){q0[0], q0[1], q0[2], q0[3], q1[0], q1[1], q1[2], q1[3]}; }
        asm volatile("s_waitcnt vmcnt(0)" ::: "memory");
        attn_dma_k(lds0, kg0, 0, 0, wid, lane); attn_dma_k(lds0, kg0, 1, 1, wid, lane); attn_dma_v(lds0, vg0, 0, 7, wid, lane); attn_dma_v(lds0, vg0, 0, 0, wid, lane);
        attn_dma_k(lds0, kg0, 2, 2, wid, lane); attn_dma_v(lds0, vg0, 1, 1, wid, lane); attn_dma_k(lds0, kg0, 3, 3, wid, lane);
        attn_dma_v(lds0, vg0, 2, 2, wid, lane); attn_dma_v(lds0, vg0, 3, 3, wid, lane); attn_dma_v(lds0, vg0, 4, 4, wid, lane); attn_dma_v(lds0, vg0, 5, 5, wid, lane);
        f32x16 o[4]; f32x16 osum = f32x16{};
#pragma unroll
        for (int dt = 0; dt < 4; ++dt) o[dt] = f32x16{};
        v8i ones8 = {0x38383838, 0x38383838, 0x38383838, 0x38383838, 0x38383838, 0x38383838, 0x38383838, 0x38383838};
        asm volatile("" : "+v"(ones8));
        const int tL = (qw0 >= 154) ? ((qw0 - 154) >> 6) + 1 : 0, tR = (qw0 + 185) >> 6;
        const float shl = tab[1024 + h];
        const LAS float* tabh = tab + h * 256;
        const int rel0 = -qw0 - r32 + 4 * hh + 128;
        asm volatile("s_waitcnt vmcnt(7)" ::: "memory"); __builtin_amdgcn_s_barrier(); asm volatile("" ::: "memory");
        f32x16 s0, s1; v8i p = {0, 0, 0, 0, 0, 0, 0, 0};
        v4i fa0, fa1, fb0, fb1;
        {   v4i kx[4];
            AT_RD128(kx[0], ka0, 0); AT_RD128(kx[1], ka1, 0); AT_RD128(kx[2], ka0, 2048); AT_RD128(kx[3], ka1, 2048);
            AT_RD128(fa0, va0, 7 * AT_SLOT); AT_RD128(fa1, va1, 7 * AT_SLOT); AT_RD128(fb0, va0, 7 * AT_SLOT + 2048); AT_RD128(fb1, va1, 7 * AT_SLOT + 2048);
            asm volatile("s_waitcnt lgkmcnt(4)" ::: "memory"); __builtin_amdgcn_sched_barrier(0);
            s0 = AT_MFMA8(((v8i){kx[0][0], kx[0][1], kx[0][2], kx[0][3], kx[1][0], kx[1][1], kx[1][2], kx[1][3]}), qf, AT_CM4);
            s1 = AT_MFMA8(((v8i){kx[2][0], kx[2][1], kx[2][2], kx[2][3], kx[3][0], kx[3][1], kx[3][2], kx[3][3]}), qf, AT_CM4); }
        __builtin_amdgcn_s_barrier(); asm volatile("" ::: "memory");
#define AT_EXP8(sv, b0) do { if constexpr (!(VAR & 1)) { _Pragma("unroll") for (int r_ = (b0); r_ < (b0) + 8; ++r_) sv[r_] = __builtin_amdgcn_exp2f(sv[r_]); } } while (0)
#define AT_RDV(dst, addr, off) do { if constexpr (!(VAR & 4)) AT_RD128(dst, addr, off); else asm volatile("" : "=v"(dst)); } while (0)
#define AT_RDK(dst, addr, off) do { if constexpr (!(VAR & 16)) AT_RD128(dst, addr, off); else asm volatile("" : "=v"(dst)); } while (0)
#define AT_PV(dst, a, b) do { if constexpr (!(VAR & 2)) dst = AT_MFMA8B(a, b, dst); } while (0)
#define AT_QK(dst, a) do { if constexpr (!(VAR & 8)) { const v8i a_ = (a); asm volatile("v_mfma_f32_32x32x64_f8f6f4 %0, %1, %2, -4.0" : "=&v"(dst) : "v"(a_), "v"(qf)); } } while (0)
#define AT_PK(dst, sv, b0) do { if constexpr (!(VAR & 32)) dst = pk4_bf8(sv[b0], sv[(b0) + 1], sv[(b0) + 2], sv[(b0) + 3]); else dst = __builtin_bit_cast(int, sv[b0]); } while (0)
#define AT_V8(a, b) ((v8i){a[0], a[1], a[2], a[3], b[0], b[1], b[2], b[3]})
#define AT_LGKM(n) do { asm volatile("s_waitcnt lgkmcnt(" #n ")" ::: "memory"); __builtin_amdgcn_sched_barrier(0); } while (0)
#define AT_STEP(SL, t) do { \
            if constexpr (!(VAR & 128)) { const int tk = (t) + 4 < 128 ? (t) + 4 : 127, tv = (t) + 6 < 128 ? (t) + 6 : 127; attn_dma_k(lds0, kg0, tk, (SL) & 3, wid, lane); attn_dma_v(lds0, vg0, tv, ((SL) + 6) & 7, wid, lane); } \
            { v4i fc0, fc1, fd0, fd1, fk0, fk1, fk2, fk3; \
              if ((t) >= tL && (t) < tR) attn_bias(s0, s1, 64 * (t) + rel0, tabh);                                \
              if ((t) - 1 == tL) { _Pragma("unroll") for (int dt = 0; dt < 4; ++dt) o[dt] *= shl; osum *= shl; }    \
              AT_RDV(fc0, va0, (((SL) + 7) & 7) * AT_SLOT + 4096); AT_RDV(fc1, va1, (((SL) + 7) & 7) * AT_SLOT + 4096); AT_RDV(fd0, va0, (((SL) + 7) & 7) * AT_SLOT + 6144); AT_RDV(fd1, va1, (((SL) + 7) & 7) * AT_SLOT + 6144); \
              AT_RDK(fk0, ka0, (((SL) + 1) & 3) * AT_SLOT); AT_RDK(fk1, ka1, (((SL) + 1) & 3) * AT_SLOT); \
              AT_PV(osum, ones8, p); \
              AT_EXP8(s0, 0); \
              AT_LGKM(6); \
              AT_PV(o[0], AT_V8(fa0, fa1), p); \
              AT_RDK(fk2, ka0, (((SL) + 1) & 3) * AT_SLOT + 2048); AT_RDK(fk3, ka1, (((SL) + 1) & 3) * AT_SLOT + 2048); \
              AT_EXP8(s0, 8); \
              __builtin_amdgcn_sched_barrier(0); \
              AT_PV(o[1], AT_V8(fb0, fb1), p); \
              AT_EXP8(s1, 0); \
              AT_LGKM(4); \
              AT_PV(o[2], AT_V8(fc0, fc1), p); \
              AT_RDV(fa0, va0, ((SL) & 7) * AT_SLOT); AT_RDV(fa1, va1, ((SL) & 7) * AT_SLOT); \
              AT_EXP8(s1, 8); \
              __builtin_amdgcn_sched_barrier(0); \
              AT_PV(o[3], AT_V8(fd0, fd1), p); \
              AT_RDV(fb0, va0, ((SL) & 7) * AT_SLOT + 2048); AT_RDV(fb1, va1, ((SL) & 7) * AT_SLOT + 2048); \
              AT_PK(p[0], s0, 0); AT_PK(p[1], s0, 4); AT_PK(p[2], s0, 8); AT_PK(p[3], s0, 12); \
              AT_LGKM(6); \
              AT_QK(s0, AT_V8(fk0, fk1)); \
              AT_PK(p[4], s1, 0); AT_PK(p[5], s1, 4); AT_PK(p[6], s1, 8); AT_PK(p[7], s1, 12); \
              AT_LGKM(4); \
              AT_QK(s1, AT_V8(fk2, fk3)); \
              asm volatile("" : "+v"(p)); }                          \
            asm volatile("s_waitcnt vmcnt(5)" ::: "memory"); if constexpr (!(VAR & 64)) __builtin_amdgcn_s_barrier(); asm volatile("" ::: "memory"); } while (0)
        for (int t0 = 0; t0 < 128; t0 += 8) { AT_STEP(0, t0); AT_STEP(1, t0 + 1); AT_STEP(2, t0 + 2); AT_STEP(3, t0 + 3); AT_STEP(4, t0 + 4); AT_STEP(5, t0 + 5); AT_STEP(6, t0 + 6); AT_STEP(7, t0 + 7); }
#undef AT_STEP
#undef AT_EXP8
#undef AT_RDV
#undef AT_RDK
#undef AT_PV
#undef AT_QK
#undef AT_PK
        {
            v4i fc0, fc1, fd0, fd1;
            AT_RD128(fc0, va0, 7 * AT_SLOT + 4096); AT_RD128(fc1, va1, 7 * AT_SLOT + 4096); AT_RD128(fd0, va0, 7 * AT_SLOT + 6144); AT_RD128(fd1, va1, 7 * AT_SLOT + 6144);
            if (127 == tL) { _Pragma("unroll") for (int dt = 0; dt < 4; ++dt) o[dt] *= shl; osum *= shl; }
            osum = AT_MFMA8B(ones8, p, osum);
            AT_LGKM(0);
            o[0] = AT_MFMA8B(AT_V8(fa0, fa1), p, o[0]); o[1] = AT_MFMA8B(AT_V8(fb0, fb1), p, o[1]); o[2] = AT_MFMA8B(AT_V8(fc0, fc1), p, o[2]); o[3] = AT_MFMA8B(AT_V8(fd0, fd1), p, o[3]);
        }
#undef AT_LGKM
#undef AT_V8
        asm volatile("s_waitcnt vmcnt(0)" ::: "memory"); __builtin_amdgcn_s_barrier(); asm volatile("" ::: "memory");
        const float lt = osum[0];
        LAS float* xch = (LAS float*)(lds + qg * 16384);
        if (c == 1) { const float f = lam / lt;
#pragma unroll
            for (int dt = 0; dt < 4; ++dt)
#pragma unroll
                for (int r = 0; r < 16; ++r) xch[(dt * 16 + r) * 64 + lane] = o[dt][r] * f; }
        LDS_WAIT(); __builtin_amdgcn_s_barrier(); asm volatile("" ::: "memory");
        if (c == 0) { const float f = 1.f / lt; float ss = 0.f;
#pragma unroll
            for (int dt = 0; dt < 4; ++dt)
#pragma unroll
                for (int r = 0; r < 16; ++r) { const float v = o[dt][r] * f - xch[(dt * 16 + r) * 64 + lane]; o[dt][r] = v; ss += v * v; }
            ss += __shfl_xor(ss, 32);
            const float rn = rsqrtf(ss * (1.f / 128.f) + RMS_EPS) * (1.f - lam_init);
            bf16* orow = W.OAB + (size_t)F.T * 512 + ((size_t)b * SEQ + qw0 + r32) * 512 + h * 128;
#pragma unroll
            for (int dt = 0; dt < 4; ++dt)
#pragma unroll
                for (int g = 0; g < 4; ++g) { const int dv = 32 * dt + 8 * g + 4 * hh; const f32x4 sg = *(const f32x4*)(subg + dv);
                    u32x2 ov; ov.x = cvt_pk(o[dt][4 * g] * rn * sg[0], o[dt][4 * g + 1] * rn * sg[1]); ov.y = cvt_pk(o[dt][4 * g + 2] * rn * sg[2], o[dt][4 * g + 3] * rn * sg[3]);
                    *(u32x2*)(orow + dv) = ov; }
        }
        LDS_WAIT(); __builtin_amdgcn_s_barrier(); asm volatile("" ::: "memory");
    }
}
constexpr int GL_CUM = 0;
constexpr int GL_S64 = 144, GL_S192 = 400;
constexpr int G1_KEF = 34816, G1_KEB = G1_KEF + 64 * GL_S64, G1_VT = G1_KEB + 64 * GL_S64;
constexpr int G3_AOP = 34816, G3_KIF = G3_AOP + 64 * GL_S192, G3_KIB = G3_KIF + 64 * GL_S64, G3_BOP = G3_KIB + 64 * GL_S64;
static_assert(G3_BOP + 128 * GL_S192 <= 150 * 1024, "GLA LDS");

__device__ __forceinline__ bf16x8 lds_frag(const LAS unsigned char* base, int row, int stride, int kbyte) { return *(const LAS bf16x8*)(base + row * stride + kbyte); }

struct GlaIn { u32x2 lg[4]; u32x4 k, v0, v1, q, st[4], sg0, sg1; };
template <bool G3>
__device__ __forceinline__ void gla_load(const Frame& F, const WS& W, int u, GlaIn& r) {
    const int n = u & 127, bh = u >> 7, b = bh >> 2, h = bh & 3; const size_t trow0 = (size_t)b * SEQ + n * 64;
#pragma unroll
    for (int it = 0; it < 4; ++it) { const int idx = F.tid + it * NTHR; const int dir = idx >> 10, t = (idx >> 4) & 63, d4 = (idx & 15) * 4;
        r.lg[it] = *(const u32x2*)((dir ? W.LGB : W.LGF) + (trow0 + t) * 256 + h * 64 + d4); }
    const int t = F.tid >> 3, d0 = (F.tid & 7) * 8, v0 = (F.tid & 7) * 16;
    r.k = *(const u32x4*)(W.GK + (trow0 + t) * 256 + h * 64 + d0);
    r.v0 = *(const u32x4*)(W.GV + (trow0 + t) * 512 + h * 128 + v0); r.v1 = *(const u32x4*)(W.GV + (trow0 + t) * 512 + h * 128 + v0 + 8);
    if constexpr (G3) {
        r.q = *(const u32x4*)(W.GQ + (trow0 + t) * 256 + h * 64 + d0);
        const int dv = F.tid >> 2, dd0 = (F.tid & 3) * 16;
#pragma unroll
        for (int dir = 0; dir < 2; ++dir) { const bf16* sp = (const bf16*)W.KVT + ((size_t)u * 2 + dir) * 8192 + dv * 64 + dd0; r.st[2 * dir] = *(const u32x4*)sp; r.st[2 * dir + 1] = *(const u32x4*)(sp + 8); }
        r.sg0 = *(const u32x4*)(W.SG + (trow0 + t) * 512 + h * 128 + v0); r.sg1 = *(const u32x4*)(W.SG + (trow0 + t) * 512 + h * 128 + v0 + 8);
    }
}
__device__ __forceinline__ void gla_cum(Frame& F, const GlaIn& r) {
    LAS float* cum = (LAS float*)(F.lds + GL_CUM);
#pragma unroll
    for (int it = 0; it < 4; ++it) { const int idx = F.tid + it * NTHR; const int dir = idx >> 10, t = (idx >> 4) & 63, d4 = (idx & 15) * 4;
        const u32x2 a = r.lg[it];
        *(LAS f32x4*)(cum + (dir * 64 + t) * 64 + d4) = (f32x4){bflo(a.x), bfhi(a.x), bflo(a.y), bfhi(a.y)}; }
    __syncthreads();
    {
        const int dir = F.tid >> 8, seg = (F.tid >> 6) & 3, d = F.tid & 63; LAS float* cc = cum + dir * 4096 + d; LAS float* tot = cum + 8192 + (dir * 4 + seg) * 64 + d;
        float v[16]; float run = 0.f;
        if (dir == 0) {
#pragma unroll
            for (int i = 0; i < 16; ++i) { run += cc[(16 * seg + i) * 64]; v[i] = run; }
        } else {
#pragma unroll
            for (int i = 15; i >= 0; --i) { run += cc[(16 * seg + i) * 64]; v[i] = run; }
        }
        *tot = run;
        __syncthreads();
        float off = 0.f; const LAS float* tb = cum + 8192 + dir * 256 + d;
        if (dir == 0) { if (seg > 0) off += tb[0]; if (seg > 1) off += tb[64]; if (seg > 2) off += tb[128]; }
        else { if (seg < 3) off += tb[192]; if (seg < 2) off += tb[128]; if (seg < 1) off += tb[64]; }
#pragma unroll
        for (int i = 0; i < 16; ++i) cc[(16 * seg + i) * 64] = v[i] + off;
    }
    __syncthreads();
}

__device__ __forceinline__ void phase_gla1(Frame& F) {
    refresh(F);
    const WS W = ws_map(F.ws, F.nb); const float* const* IN_ = F.a->in; (void)IN_; (void)W;
    LAS unsigned char* lds = F.lds; LAS float* cum = (LAS float*)(lds + GL_CUM);
    const int lane = F.lane, wid = F.wave, r32 = lane & 31, hh = lane >> 5;
    const int U = F.nb * NH * 128;
    GlaIn cur, nxt;
    if (F.bid < U) gla_load<false>(F, W, F.bid, nxt);
    for (int u = F.bid; u < U; u += F.G) {
        cur = nxt;
        if (u + F.G < U) gla_load<false>(F, W, u + F.G, nxt);
        gla_cum(F, cur);
        {
            const int t = F.tid >> 3, d0 = (F.tid & 7) * 8;
            const u32x4 kv = cur.k;
            const unsigned kw[4] = {kv.x, kv.y, kv.z, kv.w};
#pragma unroll
            for (int j = 0; j < 8; ++j) { const int d = d0 + j; const float k = (j & 1) ? bfhi(kw[j >> 1]) : bflo(kw[j >> 1]);
                const float ef = __expf(cum[63 * 64 + d] - cum[t * 64 + d]), eb = __expf(cum[4096 + d] - cum[4096 + t * 64 + d]);
                *(LAS bf16*)(lds + G1_KEF + d * GL_S64 + t * 2) = (bf16)(cvt_pk(k * ef, 0.f) & 0xffffu);
                *(LAS bf16*)(lds + G1_KEB + d * GL_S64 + t * 2) = (bf16)(cvt_pk(k * eb, 0.f) & 0xffffu); }
            const int v0 = (F.tid & 7) * 16;
            const u32x4 va = cur.v0, vb = cur.v1;
            const unsigned vw[8] = {va.x, va.y, va.z, va.w, vb.x, vb.y, vb.z, vb.w};
#pragma unroll
            for (int j = 0; j < 16; ++j) *(LAS bf16*)(lds + G1_VT + (v0 + j) * GL_S64 + t * 2) = (bf16)((j & 1) ? (vw[j >> 1] >> 16) : (vw[j >> 1] & 0xffffu));
            if (F.tid < 128) { const int dir = F.tid >> 6, d = F.tid & 63; W.DEC[((size_t)u * 2 + dir) * 64 + d] = __expf(dir ? cum[4096 + d] : cum[63 * 64 + d]); }
        }
        __syncthreads();
        {
            const int dt = wid & 3, dd = wid >> 2;
            f32x16 cf = {}, cb = {};
#pragma unroll
            for (int s = 0; s < 4; ++s) { const int kb = (16 * s + 8 * hh) * 2;
                const bf16x8 a = lds_frag(lds + G1_VT, 32 * dt + r32, GL_S64, kb);
                cf = __builtin_amdgcn_mfma_f32_32x32x16_bf16(a, lds_frag(lds + G1_KEF, 32 * dd + r32, GL_S64, kb), cf, 0, 0, 0);
                cb = __builtin_amdgcn_mfma_f32_32x32x16_bf16(a, lds_frag(lds + G1_KEB, 32 * dd + r32, GL_S64, kb), cb, 0, 0, 0); }
            bf16* of = (bf16*)W.KVT + ((size_t)u * 2) * 8192; bf16* ob = of + 8192;
#pragma unroll
            for (int r = 0; r < 16; ++r) { const int dv = 32 * dt + crow(r, hh), d = 32 * dd + r32;
                const float pf = __shfl_xor(cf[r], 1), pb = __shfl_xor(cb[r], 1);
                if (!(lane & 1)) { *(unsigned*)(of + dv * 64 + d) = cvt_pk(cf[r], pf); *(unsigned*)(ob + dv * 64 + d) = cvt_pk(cb[r], pb); } }
        }
        __syncthreads();
    }
}

__device__ __forceinline__ void phase_gla2(Frame& F) {
    refresh(F);
    const WS W = ws_map(F.ws, F.nb); const float* const* IN_ = F.a->in; (void)IN_; (void)W;
    const size_t total = (size_t)F.nb * NH * 2 * 4096;
    for (size_t wk = (size_t)F.bid * NTHR + F.tid; wk < total; wk += (size_t)F.G * NTHR) {
        const int e2 = (int)(wk & 4095), dir = (int)((wk >> 12) & 1), bh = (int)(wk >> 13), d = (e2 * 2) & 63;
        unsigned* base = (unsigned*)((bf16*)W.KVT + ((size_t)bh * 128 * 2 + dir) * 8192) + e2; const float* dec = W.DEC + ((size_t)bh * 128 * 2 + dir) * 64 + d;
        float S0 = 0.f, S1 = 0.f;
        for (int n0 = 0; n0 < 128; n0 += 8) {
            unsigned kv[8]; float dc0[8], dc1[8];
#pragma unroll
            for (int j = 0; j < 8; ++j) { const int n = dir ? 127 - (n0 + j) : n0 + j; kv[j] = base[(size_t)n * 8192]; dc0[j] = dec[(size_t)n * 128]; dc1[j] = dec[(size_t)n * 128 + 1]; }
#pragma unroll
            for (int j = 0; j < 8; ++j) { const int n = dir ? 127 - (n0 + j) : n0 + j; base[(size_t)n * 8192] = cvt_pk(S0, S1); S0 = dc0[j] * S0 + bflo(kv[j]); S1 = dc1[j] * S1 + bfhi(kv[j]); }
        }
    }
}

__device__ __forceinline__ void phase_gla3(Frame& F, int l) {
    refresh(F);
    const WS W = ws_map(F.ws, F.nb); const float* const* IN_ = F.a->in; (void)IN_; (void)W;
    LAS unsigned char* lds = F.lds; LAS float* cum = (LAS float*)(lds + GL_CUM);
    const int lane = F.lane, wid = F.wave, r32 = lane & 31, hh = lane >> 5;
    const float* gng = IN_[9] + l * 128;
    const int U = F.nb * NH * 128;
    GlaIn cur, nxt;
    if (F.bid < U) gla_load<true>(F, W, F.bid, nxt);
    for (int u = F.bid; u < U; u += F.G) {
        const int n = u & 127, bh = u >> 7, b = bh >> 2, h = bh & 3; const size_t trow0 = (size_t)b * SEQ + n * 64;
        cur = nxt;
        if (u + F.G < U) gla_load<true>(F, W, u + F.G, nxt);
        gla_cum(F, cur);
        {
            const int t = F.tid >> 3, d0 = (F.tid & 7) * 8;
            const u32x4 qv = cur.q, kv = cur.k;
            const unsigned qw[4] = {qv.x, qv.y, qv.z, qv.w}, kw[4] = {kv.x, kv.y, kv.z, kv.w};
            float qf[8], qb[8], kf[8], kb[8];
#pragma unroll
            for (int j = 0; j < 8; ++j) { const int d = d0 + j; const float q = (j & 1) ? bfhi(qw[j >> 1]) : bflo(qw[j >> 1]), k = (j & 1) ? bfhi(kw[j >> 1]) : bflo(kw[j >> 1]);
                const float cf = cum[t * 64 + d], cb = cum[4096 + t * 64 + d];
                qf[j] = q * __expf(cf); qb[j] = q * __expf(cb); kf[j] = k * __expf(-cf); kb[j] = k * __expf(-cb); }
            u32x4 o;
            o.x = cvt_pk(qf[0], qf[1]); o.y = cvt_pk(qf[2], qf[3]); o.z = cvt_pk(qf[4], qf[5]); o.w = cvt_pk(qf[6], qf[7]); *(LAS u32x4*)(lds + G3_AOP + t * GL_S192 + (64 + d0) * 2) = o;
            o.x = cvt_pk(qb[0], qb[1]); o.y = cvt_pk(qb[2], qb[3]); o.z = cvt_pk(qb[4], qb[5]); o.w = cvt_pk(qb[6], qb[7]); *(LAS u32x4*)(lds + G3_AOP + t * GL_S192 + (128 + d0) * 2) = o;
            o.x = cvt_pk(kf[0], kf[1]); o.y = cvt_pk(kf[2], kf[3]); o.z = cvt_pk(kf[4], kf[5]); o.w = cvt_pk(kf[6], kf[7]); *(LAS u32x4*)(lds + G3_KIF + t * GL_S64 + d0 * 2) = o;
            o.x = cvt_pk(kb[0], kb[1]); o.y = cvt_pk(kb[2], kb[3]); o.z = cvt_pk(kb[4], kb[5]); o.w = cvt_pk(kb[6], kb[7]); *(LAS u32x4*)(lds + G3_KIB + t * GL_S64 + d0 * 2) = o;
            const int v0 = (F.tid & 7) * 16;
            const u32x4 va = cur.v0, vb = cur.v1;
            const unsigned vw[8] = {va.x, va.y, va.z, va.w, vb.x, vb.y, vb.z, vb.w};
#pragma unroll
            for (int j = 0; j < 16; ++j) *(LAS bf16*)(lds + G3_BOP + (v0 + j) * GL_S192 + t * 2) = (bf16)((j & 1) ? (vw[j >> 1] >> 16) : (vw[j >> 1] & 0xffffu));
            const int dv = F.tid >> 2, dd0 = (F.tid & 3) * 16;
#pragma unroll
            for (int dir = 0; dir < 2; ++dir) { const u32x4 o0 = cur.st[2 * dir], o1 = cur.st[2 * dir + 1];
                *(LAS u32x4*)(lds + G3_BOP + dv * GL_S192 + (64 + 64 * dir + dd0) * 2) = o0; *(LAS u32x4*)(lds + G3_BOP + dv * GL_S192 + (64 + 64 * dir + dd0 + 8) * 2) = o1; }
        }
        __syncthreads();
        if (wid < 4) {
            const int it = wid >> 1, jt = wid & 1;
            f32x16 af = {}, ab = {};
#pragma unroll
            for (int s = 0; s < 4; ++s) { const int kb = (16 * s + 8 * hh) * 2;
                if (jt <= it) af = __builtin_amdgcn_mfma_f32_32x32x16_bf16(lds_frag(lds + G3_AOP, 32 * it + r32, GL_S192, 128 + kb), lds_frag(lds + G3_KIF, 32 * jt + r32, GL_S64, kb), af, 0, 0, 0);
                if (jt >= it) ab = __builtin_amdgcn_mfma_f32_32x32x16_bf16(lds_frag(lds + G3_AOP, 32 * it + r32, GL_S192, 256 + kb), lds_frag(lds + G3_KIB, 32 * jt + r32, GL_S64, kb), ab, 0, 0, 0); }
#pragma unroll
            for (int r = 0; r < 16; ++r) { const int i = 32 * it + crow(r, hh), j = 32 * jt + r32; const float v = (j <= i) ? af[r] : ab[r];
                *(LAS bf16*)(lds + G3_AOP + i * GL_S192 + j * 2) = (bf16)(cvt_pk(v, 0.f) & 0xffffu); }
        }
        __syncthreads();
        {
            const int it = wid >> 2, dt = wid & 3; f32x16 o = {};
#pragma unroll
            for (int s = 0; s < 12; ++s) { const int kb = (16 * s + 8 * hh) * 2;
                o = __builtin_amdgcn_mfma_f32_32x32x16_bf16(lds_frag(lds + G3_AOP, 32 * it + r32, GL_S192, kb), lds_frag(lds + G3_BOP, 32 * dt + r32, GL_S192, kb), o, 0, 0, 0); }
            LAS float* out = (LAS float*)(lds + GL_CUM);
#pragma unroll
            for (int r = 0; r < 16; ++r) out[(32 * it + crow(r, hh)) * 128 + 32 * dt + r32] = o[r];
        }
        __syncthreads();
        {
            const int t = F.tid >> 3, v0 = (F.tid & 7) * 16; const LAS float* orow = (const LAS float*)(lds + GL_CUM) + t * 128 + v0;
            float x[16]; float ss = 0.f;
#pragma unroll
            for (int j = 0; j < 16; ++j) { x[j] = orow[j]; ss += x[j] * x[j]; }
            ss += __shfl_xor(ss, 1); ss += __shfl_xor(ss, 2); ss += __shfl_xor(ss, 4);
            const float rs = rsqrtf(ss * (1.f / 128.f) + RMS_EPS);
            const u32x4 ga = cur.sg0, gb = cur.sg1;
            const unsigned gw[8] = {ga.x, ga.y, ga.z, ga.w, gb.x, gb.y, gb.z, gb.w};
            float y[16];
#pragma unroll
            for (int j = 0; j < 16; ++j) y[j] = x[j] * rs * gng[v0 + j] * ((j & 1) ? bfhi(gw[j >> 1]) : bflo(gw[j >> 1]));
            u32x4 o0, o1; o0.x = cvt_pk(y[0], y[1]); o0.y = cvt_pk(y[2], y[3]); o0.z = cvt_pk(y[4], y[5]); o0.w = cvt_pk(y[6], y[7]);
            o1.x = cvt_pk(y[8], y[9]); o1.y = cvt_pk(y[10], y[11]); o1.z = cvt_pk(y[12], y[13]); o1.w = cvt_pk(y[14], y[15]);
            bf16* dst = W.OAB + (trow0 + t) * 512 + h * 128 + v0; *(u32x4*)dst = o0; *(u32x4*)(dst + 8) = o1;
        }
        __syncthreads();
    }
}
__device__ __forceinline__ void phase_select(Frame& F, int l) {
    refresh(F);
    const WS W = ws_map(F.ws, F.nb); const float* const* IN_ = F.a->in; (void)IN_; (void)W;
    LAS int* lcnt = (LAS int*)F.lds; LAS int* lbase = lcnt + 32;
    const float* b_rg = IN_[19] + l * 4; const float* b_re = IN_[21] + l * 32;
    unsigned* gcnt = W.ctl + CW_CNT + l * 64;
    for (int t0 = F.bid * NTHR; t0 < F.T; t0 += F.G * NTHR) {
        if (F.tid < 32) lcnt[F.tid] = 0;
        __syncthreads();
        const int t = t0 + F.tid; int e0 = 0, e1 = 0, r0 = 0, r1 = 0; float g0 = 0.f, g1 = 0.f;
        if (t < F.T) {
            const float* lg = W.LOGITS + (size_t)t * 64;
            float gl[4]; { const f32x4 v = *(const f32x4*)lg; gl[0] = v[0] + b_rg[0]; gl[1] = v[1] + b_rg[1]; gl[2] = v[2] + b_rg[2]; gl[3] = v[3] + b_rg[3]; }
            int grp = 0; float mx = gl[0];
            if (gl[1] > mx) { mx = gl[1]; grp = 1; } if (gl[2] > mx) { mx = gl[2]; grp = 2; } if (gl[3] > mx) { mx = gl[3]; grp = 3; }
            const float p_grp = 1.f / (__expf(gl[0] - mx) + __expf(gl[1] - mx) + __expf(gl[2] - mx) + __expf(gl[3] - mx));
            const f32x4 ea = *(const f32x4*)(lg + 4 + grp * 8), eb = *(const f32x4*)(lg + 8 + grp * 8);
            const f32x4 ba = *(const f32x4*)(b_re + grp * 8), bb = *(const f32x4*)(b_re + grp * 8 + 4);
            float b0v = -1e30f, b1v = -1e30f; int i0 = 0, i1 = 0;
#pragma unroll
            for (int j = 0; j < 8; ++j) { const float e = (j < 4) ? ea[j] + ba[j] : eb[j - 4] + bb[j - 4];
                if (e > b0v) { b1v = b0v; i1 = i0; b0v = e; i0 = j; } else if (e > b1v) { b1v = e; i1 = j; } }
            const float p1 = __expf(b1v - b0v), s2 = 1.f + p1;
            e0 = grp * 8 + i0; e1 = grp * 8 + i1; g0 = p_grp / s2; g1 = p_grp * p1 / s2;
            r0 = __hip_atomic_fetch_add(lcnt + e0, 1, __ATOMIC_RELAXED, __HIP_MEMORY_SCOPE_WORKGROUP);
            r1 = __hip_atomic_fetch_add(lcnt + e1, 1, __ATOMIC_RELAXED, __HIP_MEMORY_SCOPE_WORKGROUP);
        }
        __syncthreads();
        if (F.tid < 32) lbase[F.tid] = (int)__hip_atomic_fetch_add(gcnt + F.tid, (unsigned)lcnt[F.tid], __ATOMIC_RELAXED, __HIP_MEMORY_SCOPE_AGENT);
        __syncthreads();
        if (t < F.T) { W.eid[t * 2] = e0; W.eid[t * 2 + 1] = e1; W.gate[t * 2] = g0; W.gate[t * 2 + 1] = g1; W.rank[t * 2] = lbase[e0] + r0; W.rank[t * 2 + 1] = lbase[e1] + r1; }
        __syncthreads();
    }
}
__device__ __forceinline__ void phase_gather(Frame& F, int l) {
    refresh(F);
    const WS W = ws_map(F.ws, F.nb); const float* const* IN_ = F.a->in; (void)IN_; (void)W;
    LAS int* seg = (LAS int*)F.lds; LAS int* cnt = seg + 40;
    const unsigned* gcnt = W.ctl + CW_CNT + l * 64;
    if (F.tid == 0) { int o = 0; for (int e = 0; e < 32; ++e) { const int c = (int)__hip_atomic_load(gcnt + e, __ATOMIC_RELAXED, __HIP_MEMORY_SCOPE_AGENT); seg[e] = o; cnt[e] = c; o += (c + 255) & ~255; } seg[32] = o; }
    __syncthreads();
    const int ntile = seg[32] >> 8;
    if (F.bid == 0) {
        for (int i = F.tid; i < ntile; i += NTHR) { int e = 0; while (e < 31 && (i << 8) >= seg[e + 1]) ++e; W.tilee[i] = e; }
        if (F.tid == 0) W.segp[0] = ntile;
    }
    for (int p = F.bid * NTHR + F.tid; p < (ntile << 8); p += F.G * NTHR) { int e = 0; while (e < 31 && p >= seg[e + 1]) ++e; if (p - seg[e] >= cnt[e]) W.stok[p] = 0; }
    for (int it = F.bid * NTHR + F.tid; it < F.T * 2; it += F.G * NTHR) {
        const int e = W.eid[it], p = seg[e] + W.rank[it];
        W.stok[p] = it >> 1; W.pos[it] = p; W.gsort[p] = W.gate[it];
    }
}

#ifndef MK_MASK
#define MK_MASK 0xffffffffu
#endif
#define EN(b) (((MK_MASK) >> (b)) & 1u)
#ifndef MK_ALIGN
#define MK_ALIGN true
#endif
#ifndef MK_SP2
#define MK_SP2 true
#endif
#ifndef MK_DUP
#define MK_DUP 0u
#endif
#define REPS(b) ((((MK_DUP) >> (b)) & 1u) ? 2 : 1)
constexpr int NPL = 14, NPH = 2 + DEPTH * NPL;
__global__ void __launch_bounds__(NTHR, 2) mk_fwd(Args args) {
    extern __shared__ __attribute__((aligned(16))) unsigned char lds_raw[];
    Frame F;
    F.lds = (LAS unsigned char*)lds_raw; F.tid = threadIdx.x; F.lane = F.tid & 63; F.wave = __builtin_amdgcn_readfirstlane(F.tid >> 6);
    F.G = gridDim.x; F.bid = blockIdx.x; F.nb = args.nb; F.T = args.nb * SEQ; F.ws = args.ws; F.a = &args; F.xbuf = args.out;
    const float* const* IN_ = args.in;
    volatile LAS unsigned* misc = (volatile LAS unsigned*)(F.lds + LDS_MISC);
    if (F.tid < 64) misc[F.tid] = 0u;
    __syncthreads();
    XcdBarrier bar = xcd_barrier_post((unsigned*)args.ws + CW_BAR + args.li * XCD_BAR_WORDS, misc);
    const int lo = args.ph_lo, hi = args.ph_hi;
#define IN(k) (lo <= (k) && (k) < hi)
#ifdef MK_BAR2
#define SEAM(k) do { if (IN(k) && IN((k) + 1)) { xcd_barrier(bar); xcd_barrier(bar); } } while (0)
#else
#define SEAM(k) do { if (IN(k) && IN((k) + 1)) xcd_barrier(bar); } while (0)
#endif
#ifdef MK_UB
    {
        typedef int ub8i __attribute__((ext_vector_type(8))); typedef int ub4i __attribute__((ext_vector_type(4)));
        ub8i ua, ubb; for (int i = 0; i < 8; ++i) { ua[i] = 0x38383838 + F.lane; ubb[i] = 0x30303030 + F.lane * 3; }
        f32x16 acc0 = {}, acc1 = {}, acc2 = {}, acc3 = {};
        float e0 = F.lane * 0.01f, e1 = e0 + 1, e2 = e0 + 2, e3 = e0 + 3, e4 = e0 + 4, e5 = e0 + 5, e6 = e0 + 6, e7 = e0 + 7;
        ub4i ld0 = {}, ld1 = {}; const unsigned la = (unsigned)(unsigned long)F.lds + F.tid * 16;
#define UB_M(acc) do { if constexpr (MK_UB & 1) acc = __builtin_amdgcn_mfma_scale_f32_32x32x64_f8f6f4(ua, ubb, acc, 0, (MK_UB & 16) ? 1 : 0, 0, 0, 0, 0); } while (0)
#define UB_E() do { if constexpr (MK_UB & 2) { e0 = __builtin_amdgcn_exp2f(e0); e1 = __builtin_amdgcn_exp2f(e1); e2 = __builtin_amdgcn_exp2f(e2); e3 = __builtin_amdgcn_exp2f(e3); \
                                              e4 = __builtin_amdgcn_exp2f(e4); e5 = __builtin_amdgcn_exp2f(e5); e6 = __builtin_amdgcn_exp2f(e6); e7 = __builtin_amdgcn_exp2f(e7); } } while (0)
#define UB_L() do { if constexpr (MK_UB & 4) { asm volatile("ds_read_b128 %0, %1" : "=&v"(ld0) : "v"(la) : "memory"); asm volatile("ds_read_b128 %0, %1 offset:8192" : "=&v"(ld1) : "v"(la) : "memory"); } } while (0)
        for (int it = 0; it < 2000; ++it) {
            UB_M(acc0); __builtin_amdgcn_sched_barrier(0); UB_E(); UB_L(); __builtin_amdgcn_sched_barrier(0);
            UB_M(acc1); __builtin_amdgcn_sched_barrier(0); UB_E(); UB_L(); __builtin_amdgcn_sched_barrier(0);
            UB_M(acc2); __builtin_amdgcn_sched_barrier(0); UB_E(); UB_L(); __builtin_amdgcn_sched_barrier(0);
            UB_M(acc3); __builtin_amdgcn_sched_barrier(0); UB_E(); UB_L(); __builtin_amdgcn_sched_barrier(0);
            if constexpr (MK_UB & 4) asm volatile("s_waitcnt lgkmcnt(0)" ::: "memory");
        }
        const float sink = acc0[0] + acc1[1] + acc2[2] + acc3[3] + e0 + e1 + e2 + e3 + e4 + e5 + e6 + e7 + (float)(ld0[0] + ld1[1]);
        if (sink == 12345.678f) ((unsigned*)args.ws)[CW_CNT + 77] = 1u;
        __syncthreads();
    }
#endif
    LAS unsigned char* gl = F.lds;
    if (EN(0) && IN(0)) { for (int rp = 0; rp < REPS(0); ++rp) { p0_prologue(F); __syncthreads(); } SEAM(0); }
    for (int l = 0; l < DEPTH; ++l) {
        const int pb = 1 + l * NPL;
        if (EN(1) && IN(pb + 0)) { for (int rp = 0; rp < ((l == 0) ? REPS(14) : 1); ++rp) phase_norm(F, l, 0); SEAM(pb + 0); }
        if (EN(2) && IN(pb + 1)) { const WS W = ws_map(F.ws, F.nb);
            pg8::Gemm g{W.H, W.win + (size_t)l * NIN * D, F.T, NIN, D}; pg8::StaticOrder S; S.init(F.T, NIN, F.G, F.bid);
            EpiIn E{W.GQ, W.GK, W.GV, W.SG, W.LGF, W.LGB, W.DQ, W.DK, W.DV, W.SGA, W.SGB, IN_[8] + l * 512, IN_[10] + l * 64, IN_[11] + l * 64, 0};
#ifdef MK_DEPHASE
            { const int g_ = (F.bid >> 3) & 7; for (int k_ = 0; k_ < g_ * MK_DEPHASE; ++k_) __builtin_amdgcn_s_sleep(127); }
#endif
#ifdef MK_INPROJ_PLAIN
            { EpiIn EP_ = E; EP_.plain = 1; pg8::gemm_phase<EpiIn, pg8::StaticOrder, MK_ALIGN, MK_SP2>(gl, g, S, EP_); }
#endif
#ifdef MK_INPROJ_NULL
            { EpiNull EN_; pg8::gemm_phase<EpiNull, pg8::StaticOrder, MK_ALIGN, MK_SP2>(gl, g, S, EN_); }
#endif
            for (int rp = 0; rp < REPS(2); ++rp) pg8::gemm_phase<EpiIn, pg8::StaticOrder, MK_ALIGN, MK_SP2>(gl, g, S, E);
            SEAM(pb + 1);
        }
        if (EN(3) && IN(pb + 2)) { for (int rp = 0; rp < REPS(3); ++rp) phase_gla1(F); SEAM(pb + 2); }
        if (EN(4) && IN(pb + 3)) { phase_gla2(F); SEAM(pb + 3); }
        if (EN(5) && IN(pb + 4)) { for (int rp = 0; rp < REPS(5); ++rp) phase_gla3(F, l); __syncthreads(); }
        if (EN(6) && IN(pb + 5)) {
#ifdef MK_ATT_PROBE
            phase_attn<MK_ATT_PROBE>(F, l);
#endif
            phase_attn<0>(F, l); SEAM(pb + 5); }
        if (EN(7) && IN(pb + 6)) { const WS W = ws_map(F.ws, F.nb);
            pg8::Gemm g{W.OAB, W.wab + (size_t)l * D * D, 0, 0, 512}; MergeOrder S; S.so.init(F.T, D, F.G, F.bid); S.nM = F.T / 256;
            EpiMerge E{W.SGA, W.SGB, W.MERGED, F.T / 256};
            for (int rp = 0; rp < REPS(7); ++rp) pg8::gemm_phase<EpiMerge, MergeOrder, MK_ALIGN, MK_SP2>(gl, g, S, E);
            SEAM(pb + 6);
        }
        if (EN(8) && IN(pb + 7)) { const WS W = ws_map(F.ws, F.nb); const float* modl = W.mod + (size_t)l * NBMAX * 6 * D;
            pg8::Gemm g{W.MERGED, W.wo + (size_t)l * D * D, F.T, D, D}; pg8::StaticOrder S; S.init(F.T, D, F.G, F.bid);
            EpiResid E{l == 0 ? IN_[0] : nullptr, W.XB, modl + 2 * D};
            for (int rp = 0; rp < ((l == 0) ? REPS(8) : 1); ++rp) pg8::gemm_phase<EpiResid, pg8::StaticOrder, MK_ALIGN, MK_SP2>(gl, g, S, E);
            SEAM(pb + 7);
        }
        if (EN(1) && IN(pb + 8)) { for (int rp = 0; rp < REPS(1); ++rp) phase_norm(F, l, 1); SEAM(pb + 8); }
        if (EN(9) && IN(pb + 9)) { const WS W = ws_map(F.ws, F.nb);
            pg8::Gemm g{W.H, W.wr + (size_t)l * 256 * D, F.T, 256, D}; pg8::StaticOrder S; S.init(F.T, 256, F.G, F.bid);
            EpiLogits E{W.LOGITS};
            for (int rp = 0; rp < REPS(9); ++rp) pg8::gemm_phase<EpiLogits, pg8::StaticOrder, MK_ALIGN, MK_SP2>(gl, g, S, E);
            SEAM(pb + 9);
        }
        if (EN(10) && IN(pb + 10)) { phase_select(F, l); SEAM(pb + 10); }
        if (EN(11) && IN(pb + 11)) { for (int rp = 0; rp < REPS(11); ++rp) { phase_gather(F, l); __syncthreads(); } SEAM(pb + 11); }
        if (EN(12) && IN(pb + 12)) { const WS W = ws_map(F.ws, F.nb);
            const int ntile = W.segp[0];
#if MK_MOE_FP8
            pg8::Gemm g{W.XS, (const bf16*)((const unsigned char*)W.w1 + (size_t)l * NE * 1024 * D), 0, 0, D / 2}; GroupedOrder S{W.tilee, ntile * 4, F.G, F.bid};
            EpiAct E{(unsigned char*)W.ACT};
#else
            pg8::Gemm g{W.H, W.w1 + (size_t)l * NE * 1024 * D, 0, 0, D}; GroupedOrder S{W.tilee, ntile * 4, F.G, F.bid, W.stok};
            EpiAct E{W.ACT};
#endif
            for (int rp = 0; rp < REPS(12); ++rp) pg8::gemm_phase<EpiAct, GroupedOrder, MK_ALIGN, MK_SP2, true>(gl, g, S, E);
            SEAM(pb + 12);
        }
        if (EN(13) && IN(pb + 13)) { const WS W = ws_map(F.ws, F.nb);
            const int ntile = W.segp[0];
#if MK_MOE_FP8
            pg8::Gemm g{W.ACT, (const bf16*)((const unsigned char*)W.w2 + (size_t)l * NE * D * DE), 0, 0, DE / 2}; GroupedOrder S{W.tilee, ntile * 4, F.G, F.bid};
#else
            pg8::Gemm g{W.ACT, W.w2 + (size_t)l * NE * D * DE, 0, 0, DE}; GroupedOrder S{W.tilee, ntile * 4, F.G, F.bid, nullptr};
#endif
            EpiYs E{(unsigned char*)W.YS, W.gsort};
            for (int rp = 0; rp < REPS(13); ++rp) pg8::gemm_phase<EpiYs, GroupedOrder, MK_ALIGN, MK_SP2>(gl, g, S, E);
            SEAM(pb + 13);
        }
    }
    if (EN(1) && IN(NPH - 1)) phase_norm(F, 0, 2);
#undef IN
#undef SEAM
}

struct LaunchCfg { int grid; bool ok; };
inline LaunchCfg& launch_cfg() {
    static LaunchCfg c{0, false}; static bool init = false;
    if (!init) { init = true;
        int dev = 0, cus = 0, per_cu = 0;
        if (hipGetDevice(&dev) != hipSuccess || hipDeviceGetAttribute(&cus, hipDeviceAttributeMultiprocessorCount, dev) != hipSuccess) { fprintf(stderr, "mk: device query failed\n"); return c; }
        if (hipFuncSetAttribute((const void*)mk_fwd, hipFuncAttributeMaxDynamicSharedMemorySize, LDS_BYTES) != hipSuccess) { fprintf(stderr, "mk: hipFuncSetAttribute failed\n"); return c; }
        if (hipOccupancyMaxActiveBlocksPerMultiprocessor(&per_cu, (const void*)mk_fwd, NTHR, LDS_BYTES) != hipSuccess || per_cu < 1) { fprintf(stderr, "mk: occupancy query says %d blocks/CU\n", per_cu); (void)hipGetLastError(); return c; }
        c.grid = cus; c.ok = true;
    }
    return c;
}
inline void launch_range(void* const* d_in, float* xbuf, void* d_ws, int nb, int lo, int hi, int li, hipStream_t stream) {
    LaunchCfg& c = launch_cfg(); if (!c.ok) return;
    Args a{}; for (int i = 0; i < 24; ++i) a.in[i] = (const float*)d_in[i];
    a.out = xbuf; a.ws = (unsigned char*)d_ws; a.nb = nb; a.ph_lo = lo; a.ph_hi = hi; a.li = li;
    hipLaunchKernelGGL(mk_fwd, dim3(c.grid), dim3(NTHR), LDS_BYTES, stream, a);
    const hipError_t le = hipPeekAtLastError(); if (le != hipSuccess) fprintf(stderr, "mk: launch [%d,%d) failed: %s\n", lo, hi, hipGetErrorName(le));
}
}
extern "C" void kernel_launch(void* const* d_in, const int* in_sizes, int n_in, void* d_out, int out_size, void* d_ws, size_t ws_size, hipStream_t stream) {
    (void)in_sizes; (void)n_in; (void)out_size;
    static int checked = 0;
    if (!checked) { checked = 1; const mk::WS w = mk::ws_map((unsigned char*)d_ws, 4); if (w.end > ws_size) { fprintf(stderr, "mk: workspace too small: need %zu, have %zu\n", w.end, ws_size); checked = -1; } }
    if (checked < 0) return;
    if (hipMemsetAsync(d_ws, 0, mk::CTL_BYTES, stream) != hipSuccess) return;
    mk::launch_range(d_in, (float*)d_out, d_ws, 4, 0, mk::NPH, 0, stream);
}
```

```cpp
#include <hip/hip_runtime.h>
#include <cstdio>
#include <cstdint>
#include <cmath>
#define MK_ATT_FP8 1
namespace pg8 {
#define PG8_LAS __attribute__((address_space(3)))
typedef unsigned short bf16_t;
typedef short bf16x8 __attribute__((ext_vector_type(8)));
typedef float f32x4 __attribute__((ext_vector_type(4)));
typedef unsigned u32x4 __attribute__((ext_vector_type(4)));
constexpr int BM = 256, BK = 64, HALF = 128, HTB = HALF * BK * 2  , STAGE_BYTES = 8 * HTB, NXCD = 8, WGM = 8;

__host__ __device__ __forceinline__ int lds_byte(int r, int c) { const int st = (r >> 4) * 2 + (c >> 5), rr = r & 15, cc = c & 31, ob = rr * 64 + cc * 2; return st * 1024 + (ob ^ (((ob >> 9) & 1) << 5)); }
__host__ __device__ __forceinline__ void stage_rc(int b, int& R, int& C) { const int st = b / 1024, sb = b % 1024, swz = sb ^ (((sb >> 9) & 1) << 5); R = (st >> 1) * 16 + swz / 64; C = (st & 1) * 32 + (swz % 64) / 2; }
__host__ __device__ __forceinline__ int perm32(int rho) { const int n = rho >> 4, i = rho & 15; return 8 * (i >> 2) + 4 * n + (i & 3); }

struct Unit { int pm, pn; };
struct Gemm { const bf16_t* A; const bf16_t* Bt; int M, N, K; };

struct StaticOrder {
    int nM, nN, nwg, G, c;
    __host__ __device__ void init(int M, int N, int G_, int c_) { nM = M / BM; nN = N / BM; nwg = nM * nN; G = G_; c = c_; }
    __host__ __device__ bool next(int i, Unit& u) const {
        const long L = (long)i * G + c; if (L >= nwg) return false;
        int wgid = (int)L; { const int q = nwg / NXCD, r = nwg % NXCD, xcd = wgid % NXCD, off = wgid / NXCD; wgid = (xcd < r ? xcd * (q + 1) : r * (q + 1) + (xcd - r) * q) + off; }
        const int nig = WGM * nN, gid = wgid / nig, fm = gid * WGM, gsz = (nM - fm) < WGM ? (nM - fm) : WGM;
        u.pm = fm + ((wgid % nig) % gsz); u.pn = (wgid % nig) / gsz; return true;
    }
    __device__ __forceinline__ void a_ready(const Unit&) const {}
    __device__ __forceinline__ void done(const Unit&) const {}
};
__device__ __forceinline__ unsigned cvt_pk_bf16(float lo, float hi) { unsigned r; asm volatile("v_cvt_pk_bf16_f32 %0, %1, %2" : "=v"(r) : "v"(lo), "v"(hi)); return r; }
__device__ __forceinline__ const void* pg8_uniform(const void* p) { const unsigned long long v = (unsigned long long)p;
    const unsigned lo = (unsigned)__builtin_amdgcn_readfirstlane((int)(unsigned)v), hi = (unsigned)__builtin_amdgcn_readfirstlane((int)(unsigned)(v >> 32)); return (const void*)(((unsigned long long)hi << 32) | lo); }
__device__ __forceinline__ void pg8_glds(const void* sbase, unsigned voff, unsigned ldsdst) { unsigned keep;
    asm volatile("s_nop 4\n\ts_mov_b32 %0, m0\n\ts_mov_b32 m0, %3\n\ts_nop 0\n\tglobal_load_lds_dwordx4 %1, %2\n\ts_mov_b32 m0, %0" : "=&s"(keep) : "v"(voff), "s"(sbase), "s"(ldsdst) : "memory"); }
typedef int pg8_v8i __attribute__((ext_vector_type(8)));
typedef int pg8_v4i __attribute__((ext_vector_type(4)));
template <class Epi, class Sched, bool ALIGN_EPI = false, bool SP2 = false, bool GATHER = false>
__device__ __forceinline__ void gemm_phase(PG8_LAS unsigned char* lds, const Gemm g, const Sched& S, const Epi& E) {
    int tid_ = threadIdx.x; asm volatile("" : "+v"(tid_));
    const int tid = tid_, wid = __builtin_amdgcn_readfirstlane(tid >> 6), lane = tid & 63, wr = wid >> 2, wc = wid & 3, fr = lane & 15, fq = lane >> 4;
    const int K = g.K, nt = K / BK;
    unsigned voffA[2], voffB[2]; unsigned vc[2][2] = {}, vn[2][2] = {}, vs[2][2] = {}; (void)vc; (void)vn; (void)vs;
#pragma unroll
    for (int i = 0; i < 2; ++i) { int R, C; stage_rc(tid * 16 + i * 8192, R, C); const int Rb = Epi::PERM ? ((R & ~31) + perm32(R & 31)) : R;
        voffA[i] = (unsigned)(R * K + C) * 2u; voffB[i] = (unsigned)(Rb * K + C) * 2u; }
    const size_t kstep = (size_t)(BK * 2);
    const size_t hstep = (size_t)HALF * K * 2;
    const size_t tstep = 2 * hstep;
    const unsigned ldsw = (unsigned)wid * 1024u; const unsigned lds0 = (unsigned)(unsigned long)lds; (void)lds0;
    const int aoff = lds_byte(wr * 64 + fr, fq * 8), boff = lds_byte(wc * 32 + fr, fq * 8);
#define PG8_SA(b, h) (((b) * 2 + (h)) * HTB)
#define PG8_SB(b, h) ((4 + (b) * 2 + (h)) * HTB)
#if defined(PG8_ASM_STAGE) && PG8_ASM_STAGE
#define PG8_STAGE(bufoff, gbase, voff) do { const void* _gb = pg8_uniform(gbase); _Pragma("unroll") for (int _i = 0; _i < 2; ++_i) \
        pg8_glds(_gb, (voff)[_i], (unsigned)__builtin_amdgcn_readfirstlane((int)(lds0 + (unsigned)(bufoff) + ldsw + _i * 8192))); } while (0)
#else
#define PG8_STAGE(bufoff, gbase, voff) do { _Pragma("unroll") for (int _i = 0; _i < 2; ++_i) \
        __builtin_amdgcn_global_load_lds((const unsigned*)((const char*)(gbase) + (voff)[_i]), (PG8_LAS unsigned*)(lds + (bufoff) + ldsw + _i * 8192), 16, 0, 0); } while (0)
#endif
#define PG8_STAGE_A(b, h, X, VS) do { if constexpr (GATHER) { PG8_STAGE(PG8_SA(b, h), X, VS[h]); } else { PG8_STAGE(PG8_SA(b, h), (X) + (h) * hstep, voffA); } } while (0)
#define PG8_LOADROWS(u, v) do { _Pragma("unroll") for (int i_ = 0; i_ < 2; ++i_) { int R_, C_; stage_rc(tid * 16 + i_ * 8192, R_, C_); _Pragma("unroll") for (int h_ = 0; h_ < 2; ++h_) \
        v[h_][i_] = (unsigned)S.rowidx[(u).pm * 256 + h_ * 128 + R_] * (unsigned)(K * 2) + (unsigned)C_ * 2u; } } while (0)
#define PG8_LDA(dst, b, h) do { _Pragma("unroll") for (int m = 0; m < 4; ++m) _Pragma("unroll") for (int k = 0; k < 2; ++k) dst[m][k] = *(const PG8_LAS bf16x8*)(lds + PG8_SA(b, h) + aoff + m * 2048 + k * 1024); } while (0)
#define PG8_LDB(dst, b, h) do { _Pragma("unroll") for (int n = 0; n < 2; ++n) _Pragma("unroll") for (int k = 0; k < 2; ++k) dst[n][k] = *(const PG8_LAS bf16x8*)(lds + PG8_SB(b, h) + boff + n * 2048 + k * 1024); } while (0)
#define PG8_MMA(ai, bj, At, Bt) do { __builtin_amdgcn_s_setprio(1); _Pragma("unroll") for (int m = 0; m < 4; ++m) _Pragma("unroll") for (int n = 0; n < 2; ++n) _Pragma("unroll") for (int k = 0; k < 2; ++k) \
        acc[ai][bj][m][n] = __builtin_amdgcn_mfma_f32_16x16x32_bf16(Bt[n][k], At[m][k], acc[ai][bj][m][n], 0, 0, 0); __builtin_amdgcn_s_setprio(0); } while (0)
#define PG8_WAIT_V(n) asm volatile("s_waitcnt vmcnt(" #n ")" ::: "memory")
#define PG8_WAIT_L(n) asm volatile("s_waitcnt lgkmcnt(" #n ")" ::: "memory")
#define PG8_BAR __builtin_amdgcn_s_barrier()
#define PG8_SCHED __builtin_amdgcn_sched_barrier(0)
    Unit cur, nxt; int ui = 0;
    if (!S.next(0, cur)) return;
    f32x4 acc[2][2][4][2];
#pragma unroll
    for (int a = 0; a < 2; ++a)
#pragma unroll
        for (int b = 0; b < 2; ++b)
#pragma unroll
            for (int m = 0; m < 4; ++m)
#pragma unroll
                for (int n = 0; n < 2; ++n) acc[a][b][m][n] = (f32x4){0.f, 0.f, 0.f, 0.f};
    bf16x8 At[4][2], B0[2][2], B1[2][2];
    const char* cA = (const char*)g.A + (GATHER ? (size_t)0 : (size_t)cur.pm * tstep); const char* cB = (const char*)g.Bt + (size_t)cur.pn * tstep;
    S.a_ready(cur);
    if constexpr (GATHER) { PG8_LOADROWS(cur, vc); }
    if constexpr (SP2) {
        PG8_STAGE(PG8_SB(0, 0), cB, voffB); PG8_STAGE(PG8_SB(0, 1), cB + hstep, voffB); PG8_STAGE_A(0, 0, cA, vc); PG8_STAGE_A(0, 1, cA, vc);
        if (wr == 1) PG8_BAR;
        PG8_WAIT_V(2); PG8_BAR;
        PG8_STAGE(PG8_SB(1, 0), cB + kstep, voffB); PG8_STAGE_A(1, 0, cA + kstep, vc); PG8_STAGE(PG8_SB(1, 1), cB + hstep + kstep, voffB);
        PG8_WAIT_V(6); PG8_BAR;
    } else {
        PG8_STAGE(PG8_SB(0, 0), cB, voffB); PG8_STAGE_A(0, 0, cA, vc); PG8_STAGE(PG8_SB(0, 1), cB + hstep, voffB); PG8_STAGE_A(0, 1, cA, vc);
        if (wr == 1) PG8_BAR;
        PG8_WAIT_V(4); PG8_BAR;
        PG8_STAGE(PG8_SB(1, 0), cB + kstep, voffB); PG8_STAGE_A(1, 0, cA + kstep, vc); PG8_STAGE(PG8_SB(1, 1), cB + hstep + kstep, voffB);
        PG8_WAIT_V(6); PG8_BAR;
    }
    for (;;) {
        const bool has_next = S.next(ui + 1, nxt);
        const char* nA = (has_next && !GATHER) ? (const char*)g.A + (size_t)nxt.pm * tstep : cA; const char* nB = has_next ? (const char*)g.Bt + (size_t)nxt.pn * tstep : cB;
        for (int t = 0; t < nt; t += 2) {
            const bool last = (t == nt - 2);
            const char* a1 = cA + (size_t)(t + 1) * kstep;
            const char* a2 = last ? nA : cA + (size_t)(t + 2) * kstep; const char* b2 = last ? nB : cB + (size_t)(t + 2) * kstep;
            const char* a3 = a2 + kstep; const char* b3 = b2 + kstep;
            if (last && has_next) S.a_ready(nxt);
            if constexpr (GATHER) { if (last && has_next) { PG8_LOADROWS(nxt, vn); }
                _Pragma("unroll") for (int h_ = 0; h_ < 2; ++h_) _Pragma("unroll") for (int i_ = 0; i_ < 2; ++i_) vs[h_][i_] = (last && has_next) ? vn[h_][i_] : vc[h_][i_]; }
            if constexpr (Epi::MIDK) { if (t == nt / 2) E.mid(acc, cur, wr, wc, fr, fq); }
            if constexpr (SP2) {
            PG8_LDB(B0, 0, 0); PG8_LDB(B1, 0, 1); PG8_SCHED; PG8_LDA(At, 0, 0); PG8_STAGE_A(1, 1, a1, vc);
            PG8_WAIT_V(8); PG8_WAIT_L(0); PG8_BAR; PG8_MMA(0, 0, At, B0); PG8_MMA(0, 1, At, B1); PG8_BAR; PG8_SCHED;
            PG8_LDA(At, 0, 1); PG8_STAGE(PG8_SB(0, 0), b2, voffB); PG8_STAGE(PG8_SB(0, 1), b2 + hstep, voffB); PG8_STAGE_A(0, 0, a2, vs);
            PG8_WAIT_V(8); PG8_WAIT_L(0); PG8_BAR; PG8_MMA(1, 0, At, B0); PG8_MMA(1, 1, At, B1); PG8_BAR; PG8_SCHED;
            PG8_LDB(B0, 1, 0); PG8_LDB(B1, 1, 1); PG8_SCHED; PG8_LDA(At, 1, 0); PG8_STAGE_A(0, 1, a2, vs);
            PG8_WAIT_V(8); PG8_WAIT_L(0); PG8_BAR; PG8_MMA(0, 0, At, B0); PG8_MMA(0, 1, At, B1); PG8_BAR; PG8_SCHED;
            PG8_LDA(At, 1, 1); PG8_STAGE(PG8_SB(1, 0), b3, voffB); PG8_STAGE(PG8_SB(1, 1), b3 + hstep, voffB); PG8_STAGE_A(1, 0, a3, vs);
            PG8_WAIT_V(8); PG8_WAIT_L(0); PG8_BAR; PG8_MMA(1, 0, At, B0); PG8_MMA(1, 1, At, B1); PG8_BAR; PG8_SCHED;
            } else {
            PG8_LDB(B0, 0, 0); PG8_SCHED; PG8_LDA(At, 0, 0); PG8_STAGE_A(1, 1, a1, vc);
            PG8_WAIT_L(8); PG8_BAR; PG8_WAIT_L(0); PG8_MMA(0, 0, At, B0); PG8_BAR; PG8_SCHED;
            PG8_LDB(B1, 0, 1); PG8_STAGE(PG8_SB(0, 0), b2, voffB);
            PG8_BAR; PG8_WAIT_L(0); PG8_MMA(0, 1, At, B1); PG8_BAR;
            PG8_LDA(At, 0, 1); PG8_STAGE_A(0, 0, a2, vs);
            PG8_BAR; PG8_WAIT_L(0); PG8_MMA(1, 0, At, B0); PG8_BAR; PG8_SCHED;
            PG8_STAGE(PG8_SB(0, 1), b2 + hstep, voffB);
            PG8_WAIT_V(6); PG8_BAR; PG8_MMA(1, 1, At, B1); PG8_BAR;
            PG8_LDB(B0, 1, 0); PG8_SCHED; PG8_LDA(At, 1, 0); PG8_STAGE_A(0, 1, a2, vs);
            PG8_WAIT_L(8); PG8_BAR; PG8_WAIT_L(0); PG8_MMA(0, 0, At, B0); PG8_BAR; PG8_SCHED;
            PG8_LDB(B1, 1, 1); PG8_STAGE(PG8_SB(1, 0), b3, voffB);
            PG8_BAR; PG8_WAIT_L(0); PG8_MMA(0, 1, At, B1); PG8_BAR;
            PG8_LDA(At, 1, 1); PG8_STAGE_A(1, 0, a3, vs);
            PG8_BAR; PG8_WAIT_L(0); PG8_MMA(1, 0, At, B0); PG8_BAR; PG8_SCHED;
            PG8_STAGE(PG8_SB(1, 1), b3 + hstep, voffB);
            PG8_WAIT_V(6); PG8_BAR; PG8_MMA(1, 1, At, B1); PG8_BAR;
            }
        }
        if constexpr (ALIGN_EPI) { if (wr == 0) PG8_BAR; }
        if constexpr (!Epi::AFTER_DRAIN) { E(acc, cur, wr, wc, fr, fq); S.done(cur); }
        if (!has_next) break;
#pragma unroll
        for (int a = 0; a < 2; ++a)
#pragma unroll
            for (int b = 0; b < 2; ++b)
#pragma unroll
                for (int m = 0; m < 4; ++m)
#pragma unroll
                    for (int n = 0; n < 2; ++n) acc[a][b][m][n] = (f32x4){0.f, 0.f, 0.f, 0.f};
        cur = nxt; cA = nA; cB = nB; ++ui;
        if constexpr (GATHER) { _Pragma("unroll") for (int h_ = 0; h_ < 2; ++h_) _Pragma("unroll") for (int i_ = 0; i_ < 2; ++i_) vc[h_][i_] = vn[h_][i_]; }
        if constexpr (ALIGN_EPI) { if (wr == 1) PG8_BAR; }
    }
    PG8_WAIT_V(0);
    if constexpr (!ALIGN_EPI) { if (wr == 0) PG8_BAR; }
    PG8_BAR;
    if constexpr (Epi::AFTER_DRAIN) { E.fused(acc, cur, wr, wc, fr, fq, lds, wid, lane); S.done(cur); }
#undef PG8_SA
#undef PG8_SB
#undef PG8_STAGE
#undef PG8_STAGE_A
#undef PG8_LOADROWS
#undef PG8_LDA
#undef PG8_LDB
#undef PG8_MMA
#undef PG8_WAIT_V
#undef PG8_WAIT_L
#undef PG8_BAR
#undef PG8_SCHED
}
}
namespace mk {
constexpr int D = 1024, SEQ = 8192, NBMAX = 4, NH = 4, DIN = 5152, NE = 32, DE = 512, DEPTH = 2;
constexpr int NT_IN = 22, NIN = NT_IN * 256;
constexpr int NWAVES = 8, NTHR = 512;
#ifndef MK_MOE_FP8
#define MK_MOE_FP8 0
#endif
constexpr float WSCALE = 16.f, ASCALE = 4.f, YSCALE = 32.f;
constexpr float LOG2E = 1.4426950408889634f, QSCALE = 0.125f * LOG2E, RMS_EPS = 1e-6f;
constexpr int O_GQ = 0, O_GK = 256, O_GV = 512, O_GG = 1024, O_LRF = 1536, O_LRB = 1552, O_DQ = 1568, O_DK = 2080, O_DV = 2592, O_GA = 3104, O_GB = 4128;
typedef unsigned short bf16;
typedef unsigned u32x4 __attribute__((ext_vector_type(4)));
typedef unsigned u32x2 __attribute__((ext_vector_type(2)));
typedef float f32x4 __attribute__((ext_vector_type(4)));
typedef float f32x16 __attribute__((ext_vector_type(16)));
typedef short bf16x8 __attribute__((ext_vector_type(8)));
typedef short s16x4 __attribute__((ext_vector_type(4)));
#define LAS __attribute__((address_space(3)))
#define GAS __attribute__((address_space(1)))
#define LDS_WAIT() asm volatile("s_waitcnt lgkmcnt(0)" ::: "memory")
#define VM_WAIT() asm volatile("s_waitcnt vmcnt(0)" ::: "memory")

constexpr size_t MiB = 1u << 20;
constexpr size_t CTL_BYTES = 256 * 1024;
constexpr int CW_BAR = 4096;
constexpr int CW_CNT = 32768;
constexpr size_t OFF_MOD = 256 * 1024, OFF_TAB = 512 * 1024;
constexpr size_t OFF_WIN = 1 * MiB, SZ_WIN = (size_t)DEPTH * NIN * D * 2;
constexpr size_t OFF_WAB = OFF_WIN + SZ_WIN, SZ_WAB = (size_t)DEPTH * D * D * 2;
constexpr size_t OFF_WO = OFF_WAB + SZ_WAB, SZ_WO = SZ_WAB;
constexpr size_t OFF_WR = OFF_WO + SZ_WO, SZ_WR = (size_t)DEPTH * 256 * D * 2;
constexpr size_t OFF_W1 = OFF_WR + SZ_WR, SZ_W1 = (size_t)DEPTH * NE * 1024 * D * 2;
constexpr size_t OFF_W2 = OFF_W1 + SZ_W1, SZ_W2 = (size_t)DEPTH * NE * D * DE * 2;
constexpr size_t OFF_ACT = 225 * MiB;
static_assert(OFF_W2 + SZ_W2 <= OFF_ACT, "weights fit");
struct WS {
    unsigned* ctl; float* mod; float* tab;
    bf16 *win, *wab, *wo, *wr, *w1, *w2;
    bf16 *H, *OAB, *XB; int* eid; float* gate; int* rank; int* pos; int* tilee; int* segp;
    bf16 *GQ, *GK, *GV, *SG; bf16 *LGF, *LGB; bf16 *DQ, *DK, *DV, *SGA, *SGB; float* KVT; float* DEC; bf16* MERGED;
    bf16 *XS, *ACT, *YS; float* LOGITS; float* gsort; int* stok;
    size_t end;
};
__host__ __device__ inline WS ws_map(unsigned char* b, int nb) {
    WS w; const size_t T = (size_t)nb * SEQ;
    w.ctl = (unsigned*)b; w.mod = (float*)(b + OFF_MOD); w.tab = (float*)(b + OFF_TAB);
    w.win = (bf16*)(b + OFF_WIN); w.wab = (bf16*)(b + OFF_WAB); w.wo = (bf16*)(b + OFF_WO); w.wr = (bf16*)(b + OFF_WR); w.w1 = (bf16*)(b + OFF_W1); w.w2 = (bf16*)(b + OFF_W2);
    size_t o = OFF_ACT;
    auto take = [&](size_t bytes) { unsigned char* p = b + o; o += (bytes + 255) & ~(size_t)255; return p; };
    w.H = (bf16*)take(T * 2048); w.OAB = (bf16*)take(T * 2048); w.XB = (bf16*)take(T * 2048);
    w.eid = (int*)take(T * 8); w.gate = (float*)take(T * 8); w.rank = (int*)take(T * 8); w.pos = (int*)take(T * 8); w.tilee = (int*)take(4096); w.segp = (int*)take(1024);
    const size_t u0 = o;
    w.GQ = (bf16*)take(T * 512); w.GK = (bf16*)take(T * 512); w.GV = (bf16*)take(T * 1024); w.SG = (bf16*)take(T * 1024);
    w.LGF = (bf16*)take(T * 512); w.LGB = (bf16*)take(T * 512);
    w.DQ = (bf16*)take(T * 1024); w.DK = (bf16*)take(T * 1024); w.DV = (bf16*)take(T * 1024); w.SGA = (bf16*)take(T * 2048); w.SGB = (bf16*)take(T * 2048);
    w.KVT = (float*)take(T * 4096); w.MERGED = (bf16*)w.KVT; w.DEC = (float*)take(T * 32);
    const size_t e1 = o; o = u0;
    const size_t R = 2 * T + 32 * 256;
    w.XS = (bf16*)take(R * 2048); w.ACT = (bf16*)take(R * 1024); w.YS = (bf16*)take(R * 2048); w.LOGITS = (float*)take(T * 256); w.gsort = (float*)take(R * 4); w.stok = (int*)take(R * 4);
    w.end = o > e1 ? o : e1;
    return w;
}

typedef float f32x2_t __attribute__((ext_vector_type(2))); typedef __bf16 bf16x2_t __attribute__((ext_vector_type(2)));
__device__ __forceinline__ unsigned cvt_pk(float lo, float hi) { const f32x2_t v = {lo, hi}; const bf16x2_t b = __builtin_convertvector(v, bf16x2_t); return __builtin_bit_cast(unsigned, b); }
__device__ __forceinline__ float bf2f(unsigned short b) { return __uint_as_float(((unsigned)b) << 16); }
__device__ __forceinline__ float bflo(unsigned w) { return __uint_as_float(w << 16); }
__device__ __forceinline__ float bfhi(unsigned w) { return __uint_as_float(w & 0xffff0000u); }
__device__ __forceinline__ float fsigmoid(float x) { return __builtin_amdgcn_rcpf(1.f + __expf(-x)); }
__device__ __forceinline__ float fsilu(float x) { return x * fsigmoid(x); }
__device__ __forceinline__ float wave_sum(float v) {
#pragma unroll
    for (int o = 1; o < 64; o <<= 1) v += __shfl_xor(v, o);
    return v;
}
__device__ __forceinline__ int t5_bucket(int rel) {
    int ret = rel > 0 ? 16 : 0; int n = rel < 0 ? -rel : rel;
    if (n < 8) return ret + n;
    return ret + 8 + (n >= 12) + (n >= 16) + (n >= 23) + (n >= 32) + (n >= 46) + (n >= 64) + (n >= 91);
}

#define XB_TMO      128
#define XB_XCNT(j)  (256  + 64 * (j))
#define XB_XSUB(j)  (1280 + 64 * (j))
#define XB_XGEN(j)  (2304 + 64 * (j))
#define XB_TOP      3328
#define XB_TOPGEN   3392
#define XCD_BAR_WORDS 3456
#define XB_SPIN_CAP (1u << 18)
__device__ __forceinline__ unsigned xb_ld(unsigned* p)              { return __hip_atomic_load(p, __ATOMIC_RELAXED, __HIP_MEMORY_SCOPE_AGENT); }
__device__ __forceinline__ unsigned xb_add(unsigned* p, unsigned v) { return __hip_atomic_fetch_add(p, v, __ATOMIC_RELAXED, __HIP_MEMORY_SCOPE_AGENT); }
__device__ __forceinline__ unsigned xb_xcc_id() { return (unsigned)__builtin_amdgcn_s_getreg((3 << 11) | 20) & 0xFu; }
#define XB_SPIN(cond, bar) do { unsigned _sp = 0; while (cond) { __builtin_amdgcn_s_sleep(1); \
    if ((++_sp & 255u) == 0u) { if (xb_ld(&(bar)[XB_TMO])) break; if (_sp > XB_SPIN_CAP) { atomicAdd(&(bar)[XB_TMO], 1u); break; } } } } while (0)
struct XcdBarrier { unsigned* bar; unsigned x; volatile LAS unsigned* st; };
__device__ __forceinline__ XcdBarrier xcd_barrier_post(unsigned* bar, volatile LAS unsigned* st) {
    XcdBarrier b; b.bar = bar; b.x = xb_xcc_id(); b.st = st;
    if (threadIdx.x == 0) (void)xb_add(&bar[XB_XCNT(b.x)], 1u);
    return b;
}
__device__ __forceinline__ void xcd_barrier_complete(unsigned* bar, unsigned x, unsigned& nloc, unsigned& nx) {
    const unsigned G = gridDim.x * gridDim.y * gridDim.z;
    unsigned sum, cnt, mine, sp = 0u;
    for (;;) {
        sum = 0u; cnt = 0u; mine = 0u;
#pragma unroll
        for (unsigned j = 0; j < 16; ++j) { const unsigned c = xb_ld(&bar[XB_XCNT(j)]); sum += c; cnt += (c > 0u) ? 1u : 0u; mine = (j == x) ? c : mine; }
        if (sum == G) break;
        __builtin_amdgcn_s_sleep(1);
        if ((++sp & 255u) == 0u) { if (xb_ld(&bar[XB_TMO])) break; if (sp > XB_SPIN_CAP) { atomicAdd(&bar[XB_TMO], 1u); break; } }
    }
    nloc = mine > 0u ? mine : 1u; nx = cnt > 0u ? cnt : 1u;
}
__device__ __forceinline__ void xcd_barrier(const XcdBarrier& b) {
    asm volatile("s_waitcnt vmcnt(0)" ::: "memory");
    __syncthreads();
    if (threadIdx.x == 0) {
        unsigned* bar = b.bar;
        __builtin_amdgcn_s_waitcnt(0);
        unsigned nloc = b.st[0], nx = b.st[1];
        if (nloc == 0u) { xcd_barrier_complete(bar, b.x, nloc, nx); b.st[0] = nloc; b.st[1] = nx; }
        const unsigned old = xb_add(&bar[XB_XSUB(b.x)], 1u);
        const unsigned gen = old / nloc;
        if (old + 1u == (gen + 1u) * nloc) {
            __builtin_amdgcn_fence(__ATOMIC_RELEASE, "agent");
            asm volatile("s_waitcnt vmcnt(0)" ::: "memory");
            const unsigned og = xb_add(&bar[XB_TOP], 1u);
            const unsigned tg = og / nx;
            if (og + 1u == (tg + 1u) * nx) xb_add(&bar[XB_TOPGEN], 1u);
            else XB_SPIN(xb_ld(&bar[XB_TOPGEN]) == tg, bar);
            __builtin_amdgcn_fence(__ATOMIC_ACQUIRE, "agent");
            xb_add(&bar[XB_XGEN(b.x)], 1u);
            asm volatile("s_waitcnt vmcnt(0)" ::: "memory");
        } else {
            XB_SPIN(xb_ld(&bar[XB_XGEN(b.x)]) == gen, bar);
            __builtin_amdgcn_fence(__ATOMIC_ACQUIRE, "agent");
            asm volatile("s_waitcnt vmcnt(0)" ::: "memory");
        }
    }
    __syncthreads();
}

struct Args { const float* in[24]; float* out; unsigned char* ws; int nb, ph_lo, ph_hi, li; };
struct Frame {
    LAS unsigned char* lds; int tid, lane, wave, G, bid, nb, T; unsigned char* ws; const Args* a; float* xbuf;
};
__device__ __forceinline__ void refresh(Frame& F) { int t = threadIdx.x; asm volatile("" : "+v"(t)); F.tid = t; F.lane = t & 63; F.wave = __builtin_amdgcn_readfirstlane(t >> 6); }
constexpr int LDS_BYTES = 160 * 1024 - 64 * 0;
constexpr int LDS_MISC = 160 * 1024 - 256;

__device__ __forceinline__ void tr_item(const float* src, int lds_, int ks0, int c0, bf16* dst, int ldd, int r0, int kd0, LAS float* scr, int lane) {
#pragma unroll 8
    for (int i = 0; i < 32; ++i) { const int kk = 2 * i + (lane >> 5); scr[kk * 33 + (lane & 31)] = src[(size_t)(ks0 + kk) * lds_ + c0 + (lane & 31)]; }
    LDS_WAIT(); asm volatile("" ::: "memory");
    const int c = lane & 7;
#pragma unroll
    for (int j = 0; j < 4; ++j) { const int n = (lane >> 3) + 8 * j; const LAS float* s = scr + (8 * c) * 33 + n;
        u32x4 o; o.x = cvt_pk(s[0 * 33], s[1 * 33]); o.y = cvt_pk(s[2 * 33], s[3 * 33]); o.z = cvt_pk(s[4 * 33], s[5 * 33]); o.w = cvt_pk(s[6 * 33], s[7 * 33]);
        *(u32x4*)(dst + (size_t)(r0 + n) * ldd + kd0 + 8 * c) = o; }
    LDS_WAIT(); asm volatile("" ::: "memory");
}
__device__ __forceinline__ void tr_item8(const float* src, int lds_, int ks0, int c0, unsigned char* dst, int ldd, int r0, int kd0, float scale, LAS float* scr, int lane) {
#pragma unroll 8
    for (int i = 0; i < 32; ++i) { const int kk = 2 * i + (lane >> 5); scr[kk * 33 + (lane & 31)] = src[(size_t)(ks0 + kk) * lds_ + c0 + (lane & 31)] * scale; }
    LDS_WAIT(); asm volatile("" ::: "memory");
    const int c = lane & 7;
#pragma unroll
    for (int j = 0; j < 4; ++j) { const int n = (lane >> 3) + 8 * j; const LAS float* s = scr + (8 * c) * 33 + n;
        int w0 = 0, w1 = 0;
        w0 = __builtin_amdgcn_cvt_pk_fp8_f32(s[0 * 33], s[1 * 33], w0, false); w0 = __builtin_amdgcn_cvt_pk_fp8_f32(s[2 * 33], s[3 * 33], w0, true);
        w1 = __builtin_amdgcn_cvt_pk_fp8_f32(s[4 * 33], s[5 * 33], w1, false); w1 = __builtin_amdgcn_cvt_pk_fp8_f32(s[6 * 33], s[7 * 33], w1, true);
        u32x2 o; o.x = (unsigned)w0; o.y = (unsigned)w1;
        *(u32x2*)(dst + (size_t)(r0 + n) * ldd + kd0 + 8 * c) = o; }
    LDS_WAIT(); asm volatile("" ::: "memory");
}
__device__ __forceinline__ int win_src_col(int tile, int p0) {
    const int bj = p0 >> 7, wc = (p0 >> 5) & 3; const int L = 64 * wc + 32 * bj;
    switch (tile) {
        case 0: return O_GQ + p0; case 1: return O_GK + p0;
        case 2: case 3: return O_GV + (tile - 2) * 256 + p0;
        case 4: case 5: return O_GG + (tile - 4) * 256 + p0;
        case 8: case 9: return O_DQ + (tile - 8) * 256 + L;
        case 10: case 11: return O_DK + (tile - 10) * 256 + L;
        case 12: case 13: return O_DV + (tile - 12) * 256 + p0;
        case 14: case 15: case 16: case 17: return O_GA + (tile - 14) * 256 + p0;
        default: return O_GB + (tile - 18) * 256 + p0;
    }
}
__device__ __forceinline__ void p0_prologue(Frame& F) {
    refresh(F);
    const WS W = ws_map(F.ws, F.nb); const float* const* IN_ = F.a->in;
    const float* c_in = IN_[1]; const float* w_ada = IN_[2]; const float* b_ada = IN_[3];
    {
        LAS float* red = (LAS float*)F.lds;
        for (int it = F.bid; it < DEPTH * 96; it += F.G) {
            const int l = it / 96, j = (it % 96) * 64 + F.lane;
            const float* w = w_ada + (size_t)l * D * 6 * D + j;
            float a0 = 0.f, a1 = 0.f, a2 = 0.f, a3 = 0.f;
            const int kbeg = F.wave * 128;
#pragma unroll 16
            for (int k = kbeg; k < kbeg + 128; ++k) { const float wv = w[(size_t)k * 6 * D];
                const float c0 = c_in[k], c1 = c_in[D + k], c2 = c_in[2 * D + k], c3 = c_in[3 * D + k];
                a0 += fsilu(c0) * wv; a1 += fsilu(c1) * wv; a2 += fsilu(c2) * wv; a3 += fsilu(c3) * wv; }
            red[(F.wave * 4 + 0) * 64 + F.lane] = a0; red[(F.wave * 4 + 1) * 64 + F.lane] = a1; red[(F.wave * 4 + 2) * 64 + F.lane] = a2; red[(F.wave * 4 + 3) * 64 + F.lane] = a3;
            __syncthreads();
            if (F.tid < 256) { const int b = F.tid >> 6, jj = F.tid & 63; float s = 0.f;
#pragma unroll
                for (int wv = 0; wv < 8; ++wv) s += red[(wv * 4 + b) * 64 + jj];
                const int jc = (it % 96) * 64 + jj;
                W.mod[((size_t)l * NBMAX + b) * 6 * D + jc] = s + b_ada[l * 6 * D + jc]; }
            __syncthreads();
        }
    }
    if (F.bid == 0) {
        const float* rb = IN_[14];
        for (int i = F.tid; i < 1024; i += NTHR) { const int h = i >> 8, rel = (i & 255) - 128; W.tab[i] = (rb[t5_bucket(rel) * 4 + h] - rb[31 * 4 + h]) * LOG2E; }
        if (F.tid < 4) W.tab[1024 + F.tid] = __expf(rb[15 * 4 + F.tid] - rb[31 * 4 + F.tid]);
        if (F.tid >= 64 && F.tid < 64 + DEPTH) { const int l = F.tid - 64; const float* lv = IN_[12] + l * 256; float s1 = 0.f, s2 = 0.f;
            for (int i = 0; i < 64; ++i) { s1 += lv[i] * lv[64 + i]; s2 += lv[128 + i] * lv[192 + i]; }
            W.tab[1032 + l] = expf(s1) - expf(s2) + (0.8f - 0.6f * expf(-0.3f * (float)l)); }
    }
    __syncthreads();
    LAS float* scr = (LAS float*)(F.lds + F.wave * 16384);
    const int gw = F.bid * NWAVES + F.wave, NGW = F.G * NWAVES;
    constexpr int I_IN = (NIN / 32) * 16, I_AB = 32 * 16, I_O = 32 * 16, I_1 = NE * 32 * 16, I_2 = NE * 32 * 8;
    constexpr int PER_L = I_IN + I_AB + I_O + I_1 + I_2;
    for (int it = gw; it < DEPTH * PER_L; it += NGW) {
        const int l = it / PER_L; int r = it % PER_L;
        if (r < I_IN) { const int rb = r / 16, kb = r % 16, R = rb * 32, tile = R >> 8, p0 = R & 255;
            if (tile == 6 || tile == 7) continue;
            tr_item(IN_[6] + (size_t)l * D * DIN, DIN, kb * 64, win_src_col(tile, p0), W.win + (size_t)l * NIN * D, D, R, kb * 64, scr, F.lane); continue; }
        r -= I_IN;
        if (r < I_AB) { const int rb = r / 16, kb = r % 16;
            if (kb < 8) tr_item(IN_[15] + (size_t)l * 512 * D, D, kb * 64, rb * 32, W.wab + (size_t)l * D * D, 512, rb * 32, kb * 64, scr, F.lane);
            else tr_item(IN_[16] + (size_t)l * 512 * D, D, (kb - 8) * 64, rb * 32, W.wab + (size_t)l * D * D + (size_t)1024 * 512, 512, rb * 32, (kb - 8) * 64, scr, F.lane);
            continue; }
        r -= I_AB;
        if (r < I_O) { const int rb = r / 16, kb = r % 16; tr_item(IN_[17] + (size_t)l * D * D, D, kb * 64, rb * 32, W.wo + (size_t)l * D * D, D, rb * 32, kb * 64, scr, F.lane); continue; }
        r -= I_O;
        if (r < I_1) { const int e = r / 512, q = r % 512, rb = q / 16, kb = q % 16, R = rb * 32, pn = R >> 8, p = R & 255;
            const int col = (p < 128) ? (128 * pn + p) : (512 + 128 * pn + p - 128);
#if MK_MOE_FP8
            tr_item8(IN_[22] + ((size_t)l * NE + e) * D * 1024, 1024, kb * 64, col, (unsigned char*)W.w1 + ((size_t)l * NE + e) * 1024 * D, D, R, kb * 64, WSCALE, scr, F.lane); continue; }
#else
            tr_item(IN_[22] + ((size_t)l * NE + e) * D * 1024, 1024, kb * 64, col, W.w1 + ((size_t)l * NE + e) * 1024 * D, D, R, kb * 64, scr, F.lane); continue; }
#endif
        r -= I_1;
        { const int e = r / 256, q = r % 256, rb = q / 8, kb = q % 8;
#if MK_MOE_FP8
          tr_item8(IN_[23] + ((size_t)l * NE + e) * DE * D, D, kb * 64, rb * 32, (unsigned char*)W.w2 + ((size_t)l * NE + e) * D * DE, DE, rb * 32, kb * 64, WSCALE, scr, F.lane); }
#else
          tr_item(IN_[23] + ((size_t)l * NE + e) * DE * D, D, kb * 64, rb * 32, W.w2 + ((size_t)l * NE + e) * D * DE, DE, rb * 32, kb * 64, scr, F.lane); }
#endif
    }
    for (int it = gw; it < DEPTH * 2 * 8 * 16; it += NGW) {
        const int l = it >> 8, dir = (it >> 7) & 1, nbk = (it >> 4) & 7, kb = it & 15; const int k = kb * 64 + F.lane;
        const float* wi = IN_[6] + (size_t)l * D * DIN + (size_t)k * DIN + (dir ? O_LRB : O_LRF);
        float wv[16];
#pragma unroll
        for (int r = 0; r < 16; ++r) wv[r] = wi[r];
        const float* wu = IN_[7] + ((size_t)l * 2 + dir) * 16 * 256;
        bf16* dst = W.win + (size_t)l * NIN * D + (size_t)((6 + dir) * 256) * D;
        for (int n = nbk * 32; n < nbk * 32 + 32; ++n) { float s = 0.f;
#pragma unroll
            for (int r = 0; r < 16; ++r) s += wv[r] * wu[r * 256 + n];
            dst[(size_t)n * D + k] = (bf16)(cvt_pk(s, 0.f) & 0xffffu); }
    }
    for (int it = gw * 64 + F.lane; it < DEPTH * 256 * 128; it += NGW * 64) {
        const int l = it / (256 * 128), q = it % (256 * 128), row = q >> 7, k0 = (q & 127) * 8;
        float v[8];
#pragma unroll
        for (int i = 0; i < 8; ++i) { float x = 0.f;
            if (row < 4) x = IN_[18][((size_t)l * D + k0 + i) * 4 + row]; else if (row < 36) x = IN_[20][((size_t)l * D + k0 + i) * 32 + row - 4];
            v[i] = x; }
        u32x4 o; o.x = cvt_pk(v[0], v[1]); o.y = cvt_pk(v[2], v[3]); o.z = cvt_pk(v[4], v[5]); o.w = cvt_pk(v[6], v[7]);
        *(u32x4*)(W.wr + ((size_t)l * 256 + row) * D + k0) = o;
    }
}

__device__ __forceinline__ void phase_norm(Frame& F, int l, int mode) {
    refresh(F);
    const WS W = ws_map(F.ws, F.nb); const float* const* IN_ = F.a->in;
    const int gw = F.bid * NWAVES + F.wave, NGW = F.G * NWAVES;
    const bool combine = (mode == 2) || (mode == 0 && l > 0);
    const bool from_in = (mode == 0 && l == 0);
    const int lp = (mode == 2) ? DEPTH - 1 : l - 1;
    const float* ng = (mode == 1 ? IN_[5] : IN_[4]) + (size_t)(mode == 2 ? 0 : l) * D;
    for (int t = gw; t < F.T; t += NGW) {
        const int b = t / SEQ;
        f32x4 v[4];
        if (from_in) { const GAS f32x4* xr = (const GAS f32x4*)(IN_[0] + (size_t)t * D) + F.lane;
#pragma unroll
            for (int j = 0; j < 4; ++j) v[j] = xr[64 * j]; }
        else { const GAS u32x2* xr = (const GAS u32x2*)(W.XB + (size_t)t * D) + F.lane;
#pragma unroll
            for (int j = 0; j < 4; ++j) { const u32x2 a = xr[64 * j]; v[j] = (f32x4){bflo(a.x), bfhi(a.x), bflo(a.y), bfhi(a.y)}; } }
        if (combine) {
            const float* g2 = W.mod + ((size_t)lp * NBMAX + b) * 6 * D + 5 * D;
            const int p0 = W.pos[t * 2], p1 = W.pos[t * 2 + 1];
            const GAS unsigned* y0 = (const GAS unsigned*)((const unsigned char*)W.YS + (size_t)p0 * D) + F.lane; const GAS unsigned* y1 = (const GAS unsigned*)((const unsigned char*)W.YS + (size_t)p1 * D) + F.lane;
#pragma unroll
            for (int j = 0; j < 4; ++j) { const unsigned a = y0[64 * j], c = y1[64 * j]; const f32x4 g = *((const GAS f32x4*)g2 + F.lane + 64 * j) * (1.f / YSCALE);
                v[j].x += g.x * (__builtin_amdgcn_cvt_f32_fp8((int)a, 0) + __builtin_amdgcn_cvt_f32_fp8((int)c, 0)); v[j].y += g.y * (__builtin_amdgcn_cvt_f32_fp8((int)a, 1) + __builtin_amdgcn_cvt_f32_fp8((int)c, 1));
                v[j].z += g.z * (__builtin_amdgcn_cvt_f32_fp8((int)a, 2) + __builtin_amdgcn_cvt_f32_fp8((int)c, 2)); v[j].w += g.w * (__builtin_amdgcn_cvt_f32_fp8((int)a, 3) + __builtin_amdgcn_cvt_f32_fp8((int)c, 3)); }
            if (mode == 2) { GAS f32x4* xo = (GAS f32x4*)(F.xbuf + (size_t)t * D) + F.lane;
#pragma unroll
                for (int j = 0; j < 4; ++j) xo[64 * j] = v[j]; }
            else { GAS u32x2* xo = (GAS u32x2*)(W.XB + (size_t)t * D) + F.lane;
#pragma unroll
                for (int j = 0; j < 4; ++j) { u32x2 o; o.x = cvt_pk(v[j].x, v[j].y); o.y = cvt_pk(v[j].z, v[j].w); xo[64 * j] = o; } }
        }
        if (mode == 2) continue;
        float ss = 0.f;
#pragma unroll
        for (int j = 0; j < 4; ++j) ss += (v[j].x * v[j].x + v[j].y * v[j].y) + (v[j].z * v[j].z + v[j].w * v[j].w);
        const float rstd = rsqrtf(wave_sum(ss) * (1.f / D) + RMS_EPS);
        const float* md = W.mod + ((size_t)l * NBMAX + b) * 6 * D + (mode == 1 ? 3 * D : 0);
        GAS u32x2* ho = (GAS u32x2*)(W.H + (size_t)t * D) + F.lane;
#pragma unroll
        for (int j = 0; j < 4; ++j) { const f32x4 g = *((const GAS f32x4*)ng + F.lane + 64 * j), sh = *((const GAS f32x4*)md + F.lane + 64 * j), sc = *((const GAS f32x4*)(md + D) + F.lane + 64 * j);
            const float h0 = v[j].x * rstd * g.x * (1.f + sc.x) + sh.x, h1 = v[j].y * rstd * g.y * (1.f + sc.y) + sh.y, h2 = v[j].z * rstd * g.z * (1.f + sc.z) + sh.z, h3 = v[j].w * rstd * g.w * (1.f + sc.w) + sh.w;
            u32x2 o; o.x = cvt_pk(h0, h1); o.y = cvt_pk(h2, h3); ho[64 * j] = o; }
    }
}
typedef pg8::Unit Unit;
__device__ __forceinline__ u32x4 pack8(const f32x4& a, const f32x4& b) { u32x4 w; w.x = cvt_pk(a[0], a[1]); w.y = cvt_pk(a[2], a[3]); w.z = cvt_pk(b[0], b[1]); w.w = cvt_pk(b[2], b[3]); return w; }

#ifndef MK_ATT_FP8
#define MK_ATT_FP8 1
#endif
__device__ __forceinline__ u32x2 pack8_fp8(const f32x4& a, const f32x4& b) { int w0 = 0, w1 = 0;
    w0 = __builtin_amdgcn_cvt_pk_fp8_f32(a[0], a[1], w0, false); w0 = __builtin_amdgcn_cvt_pk_fp8_f32(a[2], a[3], w0, true);
    w1 = __builtin_amdgcn_cvt_pk_fp8_f32(b[0], b[1], w1, false); w1 = __builtin_amdgcn_cvt_pk_fp8_f32(b[2], b[3], w1, true);
    u32x2 r; r.x = (unsigned)w0; r.y = (unsigned)w1; return r; }
struct EpiNull {
    static constexpr bool PERM = true, AFTER_DRAIN = false, MIDK = false;
    __device__ __forceinline__ void operator()(const f32x4 (&acc)[2][2][4][2], const Unit&, int, int, int, int) const {
#pragma unroll
        for (int a = 0; a < 2; ++a)
#pragma unroll
            for (int b = 0; b < 2; ++b)
#pragma unroll
                for (int m = 0; m < 4; ++m) { asm volatile("" :: "v"(acc[a][b][m][0]), "v"(acc[a][b][m][1])); } }
};
struct EpiIn {
    static constexpr bool PERM = true, AFTER_DRAIN = false, MIDK = false;
    bf16 *GQ, *GK, *GV, *SG, *LGF, *LGB, *DQ, *DK, *DV, *SGA, *SGB; const float* b_up; const float* qg; const float* kg; int plain;
    __device__ __forceinline__ void operator()(const f32x4 (&acc)[2][2][4][2], const Unit& u, int wr, int wc, int fr, int fq) const {
        const int pn = u.pn; const int row0 = u.pm * 256 + wr * 64 + fr;
        if (pn >= 8 && pn <= 11) {
            const bool isk = pn >= 10; const int head = 2 * ((pn - 8) & 1) + (wc >> 1), c = wc & 1;
            const float* gv = isk ? kg : qg; const float sc = isk ? 1.f : QSCALE;
            f32x4 g[2][2];
#pragma unroll
            for (int bj = 0; bj < 2; ++bj)
#pragma unroll
                for (int n = 0; n < 2; ++n) g[bj][n] = *(const f32x4*)(gv + 32 * bj + 8 * fq + 4 * n);
#pragma unroll
            for (int ai = 0; ai < 2; ++ai)
#pragma unroll
                for (int m = 0; m < 4; ++m) {
                    const int r = row0 + ai * 128 + m * 16, b = r / SEQ, s = r % SEQ;
                    float ss = 0.f;
#pragma unroll
                    for (int bj = 0; bj < 2; ++bj)
#pragma unroll
                        for (int n = 0; n < 2; ++n) { const f32x4 x = acc[ai][bj][m][n]; ss += (x[0] * x[0] + x[1] * x[1]) + (x[2] * x[2] + x[3] * x[3]); }
                    ss += __shfl_xor(ss, 16); ss += __shfl_xor(ss, 32);
                    const float rs = rsqrtf(ss * (1.f / 64.f) + RMS_EPS) * sc;
#if MK_ATT_FP8
                    unsigned char* dst8 = (unsigned char*)(isk ? DK : DQ) + ((((size_t)b * NH + head) * 2 + c) * SEQ + s) * 64;
#pragma unroll
                    for (int bj = 0; bj < 2; ++bj) {
                        const f32x4 v0 = acc[ai][bj][m][0] * rs * g[bj][0], v1 = acc[ai][bj][m][1] * rs * g[bj][1];
                        int chunk = 2 * bj + (fq >> 1); if (isk) chunk ^= ((s >> 2) & 3);
                        *(u32x2*)(dst8 + chunk * 16 + 8 * (fq & 1)) = pack8_fp8(v0, v1);
                    }
#else
                    bf16* dst = (isk ? DK : DQ) + ((((size_t)b * NH + head) * 2 + c) * SEQ + s) * 64;
#pragma unroll
                    for (int bj = 0; bj < 2; ++bj) {
                        const f32x4 v0 = acc[ai][bj][m][0] * rs * g[bj][0], v1 = acc[ai][bj][m][1] * rs * g[bj][1];
                        int chunk = 4 * bj + fq; if (isk) chunk ^= ((s >> 1) & 7);
                        *(u32x4*)(dst + chunk * 8) = pack8(v0, v1);
                    }
#endif
                }
            return;
        }
#pragma unroll
        for (int ai = 0; ai < 2; ++ai)
#pragma unroll
            for (int m = 0; m < 4; ++m) {
                const int r = row0 + ai * 128 + m * 16;
#pragma unroll
                for (int bj = 0; bj < 2; ++bj) {
                    const int c0 = 128 * bj + 32 * wc + 8 * fq;
                    f32x4 v0 = acc[ai][bj][m][0], v1 = acc[ai][bj][m][1];
                    if (plain) { *(u32x4*)(SGA + (size_t)r * D + (pn & 3) * 256 + c0) = pack8(v0, v1); }
                    else if (pn == 0) { *(u32x4*)(GQ + (size_t)r * 256 + c0) = pack8(v0 * 0.125f, v1 * 0.125f); }
                    else if (pn == 1) { *(u32x4*)(GK + (size_t)r * 256 + c0) = pack8(v0, v1); }
                    else if (pn <= 3) { *(u32x4*)(GV + (size_t)r * 512 + (pn - 2) * 256 + c0) = pack8(v0, v1); }
                    else if (pn <= 5) {
#pragma unroll
                        for (int i = 0; i < 4; ++i) { v0[i] = fsilu(v0[i]); v1[i] = fsilu(v1[i]); }
                        *(u32x4*)(SG + (size_t)r * 512 + (pn - 4) * 256 + c0) = pack8(v0, v1); }
                    else if (pn <= 7) {
                        const float* bu = b_up + (pn - 6) * 256 + c0; const f32x4 b0 = *(const f32x4*)bu, b1 = *(const f32x4*)(bu + 4);
#pragma unroll
                        for (int i = 0; i < 4; ++i) { float z = v0[i] + b0[i]; v0[i] = (fminf(z, 0.f) - __logf(1.f + __expf(-fabsf(z)))) * (1.f / 16.f);
                                                      z = v1[i] + b1[i]; v1[i] = (fminf(z, 0.f) - __logf(1.f + __expf(-fabsf(z)))) * (1.f / 16.f); }
                        *(u32x4*)((pn == 6 ? LGF : LGB) + (size_t)r * 256 + c0) = pack8(v0, v1); }
#if MK_ATT_FP8
                    else if (pn <= 13) {
                        const int b = r / SEQ, s = r % SEQ, head = 2 * (pn - 12) + bj;
                        const int kk = s & 63, wkey = kk & 31, hh_ = (wkey >> 2) & 1, reg_ = (wkey & 3) + 4 * (wkey >> 3), pos = hh_ * 32 + 16 * (kk >> 5) + reg_;
                        unsigned char* tb = (unsigned char*)DV + (((size_t)b * NH + head) * (SEQ / 64) + (s >> 6)) * 8192;
                        const u32x2 pk = pack8_fp8(v0, v1); const int dv0 = 32 * wc + 8 * fq;
#pragma unroll
                        for (int i = 0; i < 8; ++i) { const int dv = dv0 + i; const unsigned byte = ((i < 4 ? pk.x : pk.y) >> (8 * (i & 3))) & 0xffu;
                            tb[dv * 64 + ((((pos >> 4) ^ ((dv >> 2) & 3)) << 4) | (pos & 15))] = (unsigned char)byte; } }
#else
                    else if (pn <= 13) {
                        const int b = r / SEQ, s = r % SEQ, head = 2 * (pn - 12) + bj;
                        bf16* dst = DV + ((((size_t)b * NH + head) * (SEQ / 8) + (s >> 3)) * 4 + wc) * 256 + (s & 7) * 32 + 8 * fq;
                        *(u32x4*)dst = pack8(v0, v1); }
#endif
                    else {
#pragma unroll
                        for (int i = 0; i < 4; ++i) { v0[i] = fsigmoid(v0[i]); v1[i] = fsigmoid(v1[i]); }
                        bf16* base = (pn <= 17) ? SGA + (pn - 14) * 256 : SGB + (pn - 18) * 256;
                        *(u32x4*)(base + (size_t)r * D + c0) = pack8(v0, v1); }
                }
            }
    }
};

struct EpiMerge {
    static constexpr bool PERM = true, AFTER_DRAIN = false, MIDK = false;
    const bf16* SGA; const bf16* SGB; bf16* O; int nM;
    __device__ __forceinline__ void operator()(const f32x4 (&acc)[2][2][4][2], const Unit& u, int wr, int wc, int fr, int fq) const {
        const int sel = u.pn >> 2; const int row0 = (u.pm - sel * nM) * 256 + wr * 64 + fr, col0 = (u.pn & 3) * 256 + wc * 32 + 8 * fq;
        const bf16* G = sel ? SGB : SGA;
#pragma unroll
        for (int ai = 0; ai < 2; ++ai) {
            u32x4 gt[4][2], t1[4][2];
#pragma unroll
            for (int m = 0; m < 4; ++m) { const size_t off = (size_t)(row0 + ai * 128 + m * 16) * D + col0;
#pragma unroll
                for (int bj = 0; bj < 2; ++bj) { gt[m][bj] = *(const u32x4*)(G + off + bj * 128); if (sel) t1[m][bj] = *(const u32x4*)(O + off + bj * 128); } }
#pragma unroll
            for (int m = 0; m < 4; ++m) { const size_t off = (size_t)(row0 + ai * 128 + m * 16) * D + col0;
#pragma unroll
                for (int bj = 0; bj < 2; ++bj) { const u32x4 b = gt[m][bj];
                    f32x4 v0 = acc[ai][bj][m][0], v1 = acc[ai][bj][m][1];
                    v0[0] *= bflo(b.x); v0[1] *= bfhi(b.x); v0[2] *= bflo(b.y); v0[3] *= bfhi(b.y); v1[0] *= bflo(b.z); v1[1] *= bfhi(b.z); v1[2] *= bflo(b.w); v1[3] *= bfhi(b.w);
                    if (sel) { const u32x4 t = t1[m][bj];
                        v0[0] += bflo(t.x); v0[1] += bfhi(t.x); v0[2] += bflo(t.y); v0[3] += bfhi(t.y); v1[0] += bflo(t.z); v1[1] += bfhi(t.z); v1[2] += bflo(t.w); v1[3] += bfhi(t.w); }
                    *(u32x4*)(O + off + bj * 128) = pack8(v0, v1); } }
            asm volatile("" ::: "memory");
        }
    }
};
struct MergeOrder {
    pg8::StaticOrder so; int nM;
    __device__ __forceinline__ bool next(int i, Unit& u) const { Unit t; if (!so.next(i >> 1, t)) return false; const int sel = i & 1; u.pm = t.pm + sel * nM; u.pn = t.pn + sel * 4; return true; }
    __device__ __forceinline__ void a_ready(const Unit&) const {}
    __device__ __forceinline__ void done(const Unit&) const {}
};

struct EpiResid {
    static constexpr bool PERM = true, AFTER_DRAIN = false, MIDK = false;
    const float* xin32; bf16* xb; const float* g1;
    __device__ __forceinline__ void operator()(const f32x4 (&acc)[2][2][4][2], const Unit& u, int wr, int wc, int fr, int fq) const {
        const int row0 = u.pm * 256 + wr * 64 + fr, col0 = u.pn * 256 + wc * 32 + 8 * fq;
        const int b = (u.pm * 256) / SEQ; const float* g = g1 + (size_t)b * 6 * D + col0;
        f32x4 gv[2][2];
#pragma unroll
        for (int bj = 0; bj < 2; ++bj)
#pragma unroll
            for (int n = 0; n < 2; ++n) gv[bj][n] = *(const f32x4*)(g + bj * 128 + n * 4);
        if (xin32) {
#pragma unroll
            for (int ai = 0; ai < 2; ++ai)
#pragma unroll
                for (int mh = 0; mh < 2; ++mh) { f32x4 x0[2][2], x1[2][2];
#pragma unroll
                    for (int m2 = 0; m2 < 2; ++m2) { const size_t off = (size_t)(row0 + ai * 128 + (2 * mh + m2) * 16) * D + col0;
#pragma unroll
                        for (int bj = 0; bj < 2; ++bj) { x0[m2][bj] = *(const f32x4*)(xin32 + off + bj * 128); x1[m2][bj] = *(const f32x4*)(xin32 + off + bj * 128 + 4); } }
#pragma unroll
                    for (int m2 = 0; m2 < 2; ++m2) { const int m = 2 * mh + m2; const size_t off = (size_t)(row0 + ai * 128 + m * 16) * D + col0;
#pragma unroll
                        for (int bj = 0; bj < 2; ++bj) *(u32x4*)(xb + off + bj * 128) = pack8(x0[m2][bj] + gv[bj][0] * acc[ai][bj][m][0], x1[m2][bj] + gv[bj][1] * acc[ai][bj][m][1]); }
                    asm volatile("" ::: "memory"); }
        } else {
#pragma unroll
            for (int ai = 0; ai < 2; ++ai) { u32x4 xr[4][2];
#pragma unroll
                for (int m = 0; m < 4; ++m) { const size_t off = (size_t)(row0 + ai * 128 + m * 16) * D + col0;
#pragma unroll
                    for (int bj = 0; bj < 2; ++bj) xr[m][bj] = *(const u32x4*)(xb + off + bj * 128); }
#pragma unroll
                for (int m = 0; m < 4; ++m) { const size_t off = (size_t)(row0 + ai * 128 + m * 16) * D + col0;
#pragma unroll
                    for (int bj = 0; bj < 2; ++bj) { const u32x4 a = xr[m][bj];
                        const f32x4 x0 = {bflo(a.x), bfhi(a.x), bflo(a.y), bfhi(a.y)}, x1 = {bflo(a.z), bfhi(a.z), bflo(a.w), bfhi(a.w)};
                        *(u32x4*)(xb + off + bj * 128) = pack8(x0 + gv[bj][0] * acc[ai][bj][m][0], x1 + gv[bj][1] * acc[ai][bj][m][1]); } }
                asm volatile("" ::: "memory"); }
        }
    }
};

struct EpiLogits {
    static constexpr bool PERM = false, AFTER_DRAIN = false, MIDK = false;
    float* L;
    __device__ __forceinline__ void operator()(const f32x4 (&acc)[2][2][4][2], const Unit& u, int wr, int wc, int fr, int fq) const {
        if (wc >= 2) return;
        const int row0 = u.pm * 256 + wr * 64 + fr, col0 = wc * 32 + 4 * fq;
#pragma unroll
        for (int ai = 0; ai < 2; ++ai)
#pragma unroll
            for (int m = 0; m < 4; ++m)
#pragma unroll
                for (int n = 0; n < 2; ++n) *(f32x4*)(L + (size_t)(row0 + ai * 128 + m * 16) * 64 + col0 + n * 16) = acc[ai][0][m][n];
    }
};

#ifndef MK_MOE_FP8
#define MK_MOE_FP8 0
#endif
#if MK_MOE_FP8
struct EpiAct {
    static constexpr bool PERM = true, AFTER_DRAIN = false, MIDK = false;
    unsigned char* ACT;
    __device__ __forceinline__ void operator()(const f32x4 (&acc)[2][2][4][2], const Unit& u, int wr, int wc, int fr, int fq) const {
        const int row0 = u.pm * 256 + wr * 64 + fr, col0 = (u.pn & 3) * 128 + wc * 32 + 8 * fq;
        constexpr float inv = 1.f / WSCALE;
#pragma unroll
        for (int ai = 0; ai < 2; ++ai)
#pragma unroll
            for (int m = 0; m < 4; ++m) { f32x4 v0, v1;
#pragma unroll
                for (int i = 0; i < 4; ++i) { v0[i] = fsilu(acc[ai][0][m][0][i] * inv) * acc[ai][1][m][0][i] * (inv * ASCALE); v1[i] = fsilu(acc[ai][0][m][1][i] * inv) * acc[ai][1][m][1][i] * (inv * ASCALE); }
                *(u32x2*)(ACT + (size_t)(row0 + ai * 128 + m * 16) * DE + col0) = pack8_fp8(v0, v1); }
    }
};
struct EpiYs {
    static constexpr bool PERM = true, AFTER_DRAIN = false, MIDK = false;
    bf16* YS; const float* gs;
    __device__ __forceinline__ void operator()(const f32x4 (&acc)[2][2][4][2], const Unit& u, int wr, int wc, int fr, int fq) const {
        const int row0 = u.pm * 256 + wr * 64 + fr, col0 = (u.pn & 3) * 256 + wc * 32 + 8 * fq;
#pragma unroll
        for (int ai = 0; ai < 2; ++ai)
#pragma unroll
            for (int m = 0; m < 4; ++m) { const int r = row0 + ai * 128 + m * 16; const float gt = gs[r] * (1.f / (WSCALE * ASCALE));
#pragma unroll
                for (int bj = 0; bj < 2; ++bj) *(u32x4*)(YS + (size_t)r * D + col0 + bj * 128) = pack8(acc[ai][bj][m][0] * gt, acc[ai][bj][m][1] * gt); }
    }
};
#else
struct EpiAct {
    static constexpr bool PERM = true, AFTER_DRAIN = false, MIDK = false;
    bf16* ACT;
    __device__ __forceinline__ void operator()(const f32x4 (&acc)[2][2][4][2], const Unit& u, int wr, int wc, int fr, int fq) const {
        const int row0 = u.pm * 256 + wr * 64 + fr, col0 = (u.pn & 3) * 128 + wc * 32 + 8 * fq;
#pragma unroll
        for (int ai = 0; ai < 2; ++ai)
#pragma unroll
            for (int m = 0; m < 4; ++m) { f32x4 v0, v1;
#pragma unroll
                for (int i = 0; i < 4; ++i) { v0[i] = fsilu(acc[ai][0][m][0][i]) * acc[ai][1][m][0][i]; v1[i] = fsilu(acc[ai][0][m][1][i]) * acc[ai][1][m][1][i]; }
                *(u32x4*)(ACT + (size_t)(row0 + ai * 128 + m * 16) * DE + col0) = pack8(v0, v1); }
    }
};
struct EpiYs {
    static constexpr bool PERM = true, AFTER_DRAIN = false, MIDK = false;
    unsigned char* YS; const float* gs;
    __device__ __forceinline__ void operator()(const f32x4 (&acc)[2][2][4][2], const Unit& u, int wr, int wc, int fr, int fq) const {
        const int row0 = u.pm * 256 + wr * 64 + fr, col0 = (u.pn & 3) * 256 + wc * 32 + 8 * fq;
        float gts[2][4];
#pragma unroll
        for (int ai = 0; ai < 2; ++ai)
#pragma unroll
            for (int m = 0; m < 4; ++m) gts[ai][m] = gs[row0 + ai * 128 + m * 16] * YSCALE;
#pragma unroll
        for (int ai = 0; ai < 2; ++ai)
#pragma unroll
            for (int m = 0; m < 4; ++m) { const int r = row0 + ai * 128 + m * 16; const float gt = gts[ai][m];
#pragma unroll
                for (int bj = 0; bj < 2; ++bj) *(u32x2*)(YS + (size_t)r * D + col0 + bj * 128) = pack8_fp8(acc[ai][bj][m][0] * gt, acc[ai][bj][m][1] * gt); }
    }
};
#endif
struct GroupedOrder {
    const int* tilee; int U, G, c; const int* rowidx;
    __device__ __forceinline__ bool next(int i, Unit& u) const {
        int id;
        if ((G & 7) == 0) { const int gx = G >> 3, per = (U + 7) >> 3, n = i * gx + (c >> 3); if (n >= per) return false; id = (c & 7) * per + n; if (id >= U) return false; }
        else { id = i * G + c; if (id >= U) return false; }
        const int t = id >> 2; u.pm = t; u.pn = tilee[t] * 4 + (id & 3); return true;
    }
    __device__ __forceinline__ void a_ready(const Unit&) const {}
    __device__ __forceinline__ void done(const Unit&) const {}
};
constexpr int AT_KR = 0, AT_VR = 32768, AT_TAB = 98304, AT_SLOT = 8192;
typedef int v8i __attribute__((ext_vector_type(8)));
typedef int v4i __attribute__((ext_vector_type(4)));
__device__ __forceinline__ int crow(int r, int hi) { return (r & 3) + 8 * (r >> 2) + 4 * hi; }

__device__ __forceinline__ void attn_bias(f32x16& s0, f32x16& s1, int relbase, const LAS float* tabh) {
#pragma unroll
    for (int r = 0; r < 16; ++r) {
        int i0 = relbase + (r & 3) + 8 * (r >> 2); int i1 = i0 + 32;
        i0 = i0 < 0 ? 0 : (i0 > 255 ? 255 : i0); i1 = i1 < 0 ? 0 : (i1 > 255 ? 255 : i1);
        s0[r] += tabh[i0]; s1[r] += tabh[i1];
    }
}
template <int J>
__device__ __forceinline__ void attn_exp_chunk(f32x16& s0, f32x16& s1, float& lsum) {
    float ls = 0.f;
#pragma unroll
    for (int r = 4 * J; r < 4 * J + 4; ++r) { s0[r] = __builtin_amdgcn_exp2f(s0[r]); s1[r] = __builtin_amdgcn_exp2f(s1[r]); }
    (void)ls; (void)lsum;
}
__device__ __forceinline__ int pk4_bf8(float a, float b, float c, float d) {
    const unsigned lo = __builtin_bit_cast(unsigned, __builtin_amdgcn_cvt_pkrtz(a, b)), hi = __builtin_bit_cast(unsigned, __builtin_amdgcn_cvt_pkrtz(c, d));
    return (int)__builtin_amdgcn_perm(hi, lo, 0x07050301u);
}
#define AT_CM4 ((f32x16){-4.f, -4.f, -4.f, -4.f, -4.f, -4.f, -4.f, -4.f, -4.f, -4.f, -4.f, -4.f, -4.f, -4.f, -4.f, -4.f})
__device__ __forceinline__ void glds16(const void* gsrc, unsigned lds_dst) { unsigned keep;
    asm volatile("s_mov_b32 %0, m0\n\ts_mov_b32 m0, %2\n\ts_nop 0\n\tglobal_load_lds_dwordx4 %1, off\n\ts_mov_b32 m0, %0" : "=&s"(keep) : "v"(gsrc), "s"(lds_dst) : "memory"); }
__device__ __forceinline__ void attn_dma_k(unsigned lds0, const unsigned char* kg0, int t, int slot, int wid, int lane) {
    glds16(kg0 + (size_t)(wid >> 2) * SEQ * 64 + (size_t)t * 4096 + (wid & 3) * 1024 + lane * 16, (unsigned)__builtin_amdgcn_readfirstlane((int)(lds0 + AT_KR + slot * AT_SLOT + wid * 1024)));
}
__device__ __forceinline__ void attn_dma_v(unsigned lds0, const unsigned char* vg0, int t, int slot, int wid, int lane) {
    glds16(vg0 + (size_t)t * 8192 + wid * 1024 + lane * 16, (unsigned)__builtin_amdgcn_readfirstlane((int)(lds0 + AT_VR + slot * AT_SLOT + wid * 1024)));
}
#define AT_RD128(dst, addr, off) asm volatile("ds_read_b128 %0, %1 offset:%c2" : "=&v"(dst) : "v"(addr), "i"(off) : "memory")
#define AT_MFMA8(a, b, c) __builtin_amdgcn_mfma_scale_f32_32x32x64_f8f6f4(a, b, c, 0, 0, 0, 0, 0, 0)
#define AT_MFMA8B(a, b, c) __builtin_amdgcn_mfma_scale_f32_32x32x64_f8f6f4(a, b, c, 0, 1, 0, 0, 0, 0)

template <int VAR>
__device__ __forceinline__ void phase_attn(Frame& F, int l) {
    refresh(F);
    const WS W = ws_map(F.ws, F.nb); const float* const* IN_ = F.a->in; (void)IN_; (void)W;
    const int lane = F.lane, wid = F.wave, r32 = lane & 31, hh = lane >> 5, qg = wid & 3, c = wid >> 2;
    LAS unsigned char* lds = F.lds; const unsigned lds0 = (unsigned)(unsigned long)lds;
    LAS float* tab = (LAS float*)(lds + AT_TAB);
    for (int i = F.tid; i < 1028; i += NTHR) tab[i] = W.tab[i];
    const float lam = W.tab[1032 + l]; const float lam_init = 0.8f - 0.6f * __expf(-0.3f * (float)l);
    const float* subg = IN_[13] + l * 128;
    const int U = F.nb * NH * 64;
    const int gx = F.G >> 3, per = U >> 3;
    const int sw = (r32 >> 2) & 3;
    const unsigned ka0 = lds0 + AT_KR + c * 4096 + r32 * 64 + (((2 * hh) ^ sw) << 4), ka1 = lds0 + AT_KR + c * 4096 + r32 * 64 + (((2 * hh + 1) ^ sw) << 4);
    const unsigned va0 = lds0 + AT_VR + r32 * 64 + (((2 * hh) ^ sw) << 4), va1 = lds0 + AT_VR + r32 * 64 + (((2 * hh + 1) ^ sw) << 4);
#ifndef MK_ATT_1BAR
#define MK_ATT_1BAR 1
#endif
    const bool lag = (MK_ATT_1BAR == 0) && wid >= 4;
    __syncthreads();
    for (int i = 0;; ++i) {
        int id;
        if ((F.G & 7) == 0) { const int n = i * gx + (F.bid >> 3); if (n >= per) break; id = (F.bid & 7) * per + n; }
        else { id = i * F.G + F.bid; if (id >= U) break; }
        const int bh = id >> 6, qb = id & 63, b = bh >> 2, h = bh & 3;
        const int qw0 = qb * 128 + 32 * qg;
        const unsigned char* kg0 = (const unsigned char*)W.DK + ((size_t)bh * 2) * SEQ * 64;
        const unsigned char* vg0 = (const unsigned char*)W.DV + (size_t)bh * SEQ * 128;
        v8i qf; { const unsigned char* qp = (const unsigned char*)W.DQ + (((size_t)bh * 2 + c) * SEQ + qw0 + r32) * 64 + 32 * hh;
            const v4i q0 = *(const v4i*)qp, q1 = *(const v4i*)(qp + 16); qf = (v8i){q0[0], q0[1], q0[2], q0[3], q1[0], q1[1], q1[2], q1[3]}; }
        asm volatile("s_waitcnt vmcnt(0)" ::: "memory");
        attn_dma_k(lds0, kg0, 0, 0, wid, lane); attn_dma_k(lds0, kg0, 1, 1, wid, lane); attn_dma_v(lds0, vg0, 0, 7, wid, lane); attn_dma_v(lds0, vg0, 0, 0, wid, lane);
        attn_dma_k(lds0, kg0, 2, 2, wid, lane); attn_dma_v(lds0, vg0, 1, 1, wid, lane); attn_dma_k(lds0, kg0, 3, 3, wid, lane);
        attn_dma_v(lds0, vg0, 2, 2, wid, lane); attn_dma_v(lds0, vg0, 3, 3, wid, lane); attn_dma_v(lds0, vg0, 4, 4, wid, lane); attn_dma_v(lds0, vg0, 5, 5, wid, lane);
        f32x16 o[4]; f32x4 osum = f32x4{};
#pragma unroll
        for (int dt = 0; dt < 4; ++dt) o[dt] = f32x16{};
        v8i ones8; { const int on = (((lane & 15) < 8) == (((lane >> 4) & 1) == 0)) ? 0x38383838 : 0; ones8 = (v8i){on, on, on, on, on, on, on, on}; }
        asm volatile("" : "+v"(ones8));
        const int tL = (qw0 >= 154) ? ((qw0 - 154) >> 6) + 1 : 0, tR = (qw0 + 185) >> 6;
        const float shl = tab[1024 + h];
        const LAS float* tabh = tab + h * 256;
        const int rel0 = -qw0 - r32 + 4 * hh + 128;
        asm volatile("s_waitcnt vmcnt(7)" ::: "memory"); __builtin_amdgcn_s_barrier(); asm volatile("" ::: "memory");
        f32x16 s0, s1; v8i p = {0, 0, 0, 0, 0, 0, 0, 0};
        v4i fa0, fa1, fb0, fb1;
        {   v4i kx[4];
            AT_RD128(kx[0], ka0, 0); AT_RD128(kx[1], ka1, 0); AT_RD128(kx[2], ka0, 2048); AT_RD128(kx[3], ka1, 2048);
            AT_RD128(fa0, va0, 7 * AT_SLOT); AT_RD128(fa1, va1, 7 * AT_SLOT); AT_RD128(fb0, va0, 7 * AT_SLOT + 2048); AT_RD128(fb1, va1, 7 * AT_SLOT + 2048);
            asm volatile("s_waitcnt lgkmcnt(4)" ::: "memory"); __builtin_amdgcn_sched_barrier(0);
            s0 = AT_MFMA8(((v8i){kx[0][0], kx[0][1], kx[0][2], kx[0][3], kx[1][0], kx[1][1], kx[1][2], kx[1][3]}), qf, AT_CM4);
            s1 = AT_MFMA8(((v8i){kx[2][0], kx[2][1], kx[2][2], kx[2][3], kx[3][0], kx[3][1], kx[3][2], kx[3][3]}), qf, AT_CM4); }
        __builtin_amdgcn_s_barrier(); asm volatile("" ::: "memory");
#define AT_EXP8(sv, b0) do { if constexpr (!(VAR & 1)) { _Pragma("unroll") for (int r_ = (b0); r_ < (b0) + 8; ++r_) sv[r_] = __builtin_amdgcn_exp2f(sv[r_]); } } while (0)
#define AT_RDV(dst, addr, off) do { if constexpr (!(VAR & 4)) AT_RD128(dst, addr, off); else asm volatile("" : "=v"(dst)); } while (0)
#define AT_RDK(dst, addr, off) do { if constexpr (!(VAR & 16)) AT_RD128(dst, addr, off); else asm volatile("" : "=v"(dst)); } while (0)
#define AT_PV(dst, a, b) do { if constexpr (!(VAR & 2)) dst = AT_MFMA8B(a, b, dst); } while (0)
#define AT_SUM(b) do { if constexpr (!(VAR & 2)) osum = __builtin_amdgcn_mfma_scale_f32_16x16x128_f8f6f4(ones8, b, osum, 0, 1, 0, 0, 0, 0); } while (0)
#define AT_QK(dst, a) do { if constexpr (!(VAR & 8)) { const v8i a_ = (a); asm volatile("v_mfma_f32_32x32x64_f8f6f4 %0, %1, %2, -4.0" : "=&v"(dst) : "v"(a_), "v"(qf)); } } while (0)
#define AT_PK(dst, sv, b0) do { if constexpr (!(VAR & 32)) dst = pk4_bf8(sv[b0], sv[(b0) + 1], sv[(b0) + 2], sv[(b0) + 3]); else dst = __builtin_bit_cast(int, sv[b0]); } while (0)
#define AT_V8(a, b) ((v8i){a[0], a[1], a[2], a[3], b[0], b[1], b[2], b[3]})
#define AT_LGKM(n) do { asm volatile("s_waitcnt lgkmcnt(" #n ")" ::: "memory"); __builtin_amdgcn_sched_barrier(0); } while (0)
#define AT_STEP(SL, t) do { \
            if ((t) - 1 == tL) { _Pragma("unroll") for (int dt = 0; dt < 4; ++dt) o[dt] *= shl; osum *= shl; }    \
            AT_SUM(p); __builtin_amdgcn_sched_barrier(0);                                                           \
            if constexpr (!(VAR & 128)) { const int tk = (t) + 4 < 128 ? (t) + 4 : 127, tv = (t) + 6 < 128 ? (t) + 6 : 127; attn_dma_k(lds0, kg0, tk, (SL) & 3, wid, lane); attn_dma_v(lds0, vg0, tv, ((SL) + 6) & 7, wid, lane); } \
            { v4i fc0, fc1, fd0, fd1, fk0, fk1, fk2, fk3; \
              if ((t) >= tL && (t) < tR) attn_bias(s0, s1, 64 * (t) + rel0, tabh);                                \
              AT_RDV(fc0, va0, (((SL) + 7) & 7) * AT_SLOT + 4096); AT_RDV(fc1, va1, (((SL) + 7) & 7) * AT_SLOT + 4096); AT_RDV(fd0, va0, (((SL) + 7) & 7) * AT_SLOT + 6144); AT_RDV(fd1, va1, (((SL) + 7) & 7) * AT_SLOT + 6144); \
              AT_RDK(fk0, ka0, (((SL) + 1) & 3) * AT_SLOT); AT_RDK(fk1, ka1, (((SL) + 1) & 3) * AT_SLOT); \
              AT_EXP8(s0, 0); \
              AT_LGKM(6); \
              AT_PV(o[0], AT_V8(fa0, fa1), p); \
              AT_RDK(fk2, ka0, (((SL) + 1) & 3) * AT_SLOT + 2048); AT_RDK(fk3, ka1, (((SL) + 1) & 3) * AT_SLOT + 2048); \
              AT_EXP8(s0, 8); \
              __builtin_amdgcn_sched_barrier(0); \
              AT_PV(o[1], AT_V8(fb0, fb1), p); \
              AT_EXP8(s1, 0); \
              AT_LGKM(4); \
              AT_PV(o[2], AT_V8(fc0, fc1), p); \
              AT_RDV(fa0, va0, ((SL) & 7) * AT_SLOT); AT_RDV(fa1, va1, ((SL) & 7) * AT_SLOT); \
              AT_EXP8(s1, 8); \
              __builtin_amdgcn_sched_barrier(0); \
              AT_PV(o[3], AT_V8(fd0, fd1), p); \
              AT_RDV(fb0, va0, ((SL) & 7) * AT_SLOT + 2048); AT_RDV(fb1, va1, ((SL) & 7) * AT_SLOT + 2048); \
              AT_PK(p[0], s0, 0); AT_PK(p[1], s0, 4); AT_PK(p[2], s0, 8); AT_PK(p[3], s0, 12); \
              AT_LGKM(6); \
              AT_QK(s0, AT_V8(fk0, fk1)); \
              AT_PK(p[4], s1, 0); AT_PK(p[5], s1, 4); AT_PK(p[6], s1, 8); AT_PK(p[7], s1, 12); \
              AT_LGKM(4); \
              AT_QK(s1, AT_V8(fk2, fk3)); \
              asm volatile("" : "+v"(p)); }                          \
            asm volatile("s_waitcnt vmcnt(5)" ::: "memory"); if constexpr (!(VAR & 64)) __builtin_amdgcn_s_barrier(); asm volatile("" ::: "memory"); } while (0)
        for (int t0 = 0; t0 < 128; t0 += 8) { AT_STEP(0, t0); AT_STEP(1, t0 + 1); AT_STEP(2, t0 + 2); AT_STEP(3, t0 + 3); AT_STEP(4, t0 + 4); AT_STEP(5, t0 + 5); AT_STEP(6, t0 + 6); AT_STEP(7, t0 + 7); }
#undef AT_STEP
#undef AT_EXP8
#undef AT_RDV
#undef AT_RDK
#undef AT_PV
#undef AT_SUM
#undef AT_QK
#undef AT_PK
        {
            v4i fc0, fc1, fd0, fd1;
            AT_RD128(fc0, va0, 7 * AT_SLOT + 4096); AT_RD128(fc1, va1, 7 * AT_SLOT + 4096); AT_RD128(fd0, va0, 7 * AT_SLOT + 6144); AT_RD128(fd1, va1, 7 * AT_SLOT + 6144);
            if (127 == tL) { _Pragma("unroll") for (int dt = 0; dt < 4; ++dt) o[dt] *= shl; osum *= shl; }
            osum = __builtin_amdgcn_mfma_scale_f32_16x16x128_f8f6f4(ones8, p, osum, 0, 1, 0, 0, 0, 0);
            AT_LGKM(0);
            o[0] = AT_MFMA8B(AT_V8(fa0, fa1), p, o[0]); o[1] = AT_MFMA8B(AT_V8(fb0, fb1), p, o[1]); o[2] = AT_MFMA8B(AT_V8(fc0, fc1), p, o[2]); o[3] = AT_MFMA8B(AT_V8(fd0, fd1), p, o[3]);
        }
#undef AT_LGKM
#undef AT_V8
        asm volatile("s_waitcnt vmcnt(0)" ::: "memory"); __builtin_amdgcn_s_barrier(); asm volatile("" ::: "memory");
        const float lt = __shfl(osum[0], r32 + (r32 >= 16 ? 16 : 0));
        LAS float* xch = (LAS float*)(lds + qg * 16384);
        if (c == 1) { const float f = lam / lt;
#pragma unroll
            for (int dt = 0; dt < 4; ++dt)
#pragma unroll
                for (int r = 0; r < 16; ++r) xch[(dt * 16 + r) * 64 + lane] = o[dt][r] * f; }
        LDS_WAIT(); __builtin_amdgcn_s_barrier(); asm volatile("" ::: "memory");
        if (c == 0) { const float f = 1.f / lt; float ss = 0.f;
#pragma unroll
            for (int dt = 0; dt < 4; ++dt)
#pragma unroll
                for (int r = 0; r < 16; ++r) { const float v = o[dt][r] * f - xch[(dt * 16 + r) * 64 + lane]; o[dt][r] = v; ss += v * v; }
            ss += __shfl_xor(ss, 32);
            const float rn = rsqrtf(ss * (1.f / 128.f) + RMS_EPS) * (1.f - lam_init);
            bf16* orow = W.OAB + (size_t)F.T * 512 + ((size_t)b * SEQ + qw0 + r32) * 512 + h * 128;
#pragma unroll
            for (int dt = 0; dt < 4; ++dt)
#pragma unroll
                for (int g = 0; g < 4; ++g) { const int dv = 32 * dt + 8 * g + 4 * hh; const f32x4 sg = *(const f32x4*)(subg + dv);
                    u32x2 ov; ov.x = cvt_pk(o[dt][4 * g] * rn * sg[0], o[dt][4 * g + 1] * rn * sg[1]); ov.y = cvt_pk(o[dt][4 * g + 2] * rn * sg[2], o[dt][4 * g + 3] * rn * sg[3]);
                    *(u32x2*)(orow + dv) = ov; }
        }
        LDS_WAIT(); __builtin_amdgcn_s_barrier(); asm volatile("" ::: "memory");
    }
}
constexpr int GL_CUM = 0;
constexpr int GL_S64 = 144, GL_S192 = 400;
constexpr int G1_KEF = 34816, G1_KEB = G1_KEF + 64 * GL_S64, G1_VT = G1_KEB + 64 * GL_S64;
constexpr int G3_AOP = 34816, G3_KIF = G3_AOP + 64 * GL_S192, G3_KIB = G3_KIF + 64 * GL_S64, G3_BOP = G3_KIB + 64 * GL_S64;
static_assert(G3_BOP + 128 * GL_S192 <= 150 * 1024, "GLA LDS");

__device__ __forceinline__ bf16x8 lds_frag(const LAS unsigned char* base, int row, int stride, int kbyte) { return *(const LAS bf16x8*)(base + row * stride + kbyte); }

struct GlaIn { u32x2 lg[4]; u32x4 k, v0, v1, q, st[4], sg0, sg1; };
template <bool G3>
__device__ __forceinline__ void gla_load(const Frame& F, const WS& W, int u, GlaIn& r) {
    const int n = u & 127, bh = u >> 7, b = bh >> 2, h = bh & 3; const size_t trow0 = (size_t)b * SEQ + n * 64;
#pragma unroll
    for (int it = 0; it < 4; ++it) { const int idx = F.tid + it * NTHR; const int dir = idx >> 10, t = (idx >> 4) & 63, d4 = (idx & 15) * 4;
        r.lg[it] = *(const u32x2*)((dir ? W.LGB : W.LGF) + (trow0 + t) * 256 + h * 64 + d4); }
    const int t = F.tid >> 3, d0 = (F.tid & 7) * 8, v0 = (F.tid & 7) * 16;
    r.k = *(const u32x4*)(W.GK + (trow0 + t) * 256 + h * 64 + d0);
    r.v0 = *(const u32x4*)(W.GV + (trow0 + t) * 512 + h * 128 + v0); r.v1 = *(const u32x4*)(W.GV + (trow0 + t) * 512 + h * 128 + v0 + 8);
    if constexpr (G3) {
        r.q = *(const u32x4*)(W.GQ + (trow0 + t) * 256 + h * 64 + d0);
        const int dv = F.tid >> 2, dd0 = (F.tid & 3) * 16;
#pragma unroll
        for (int dir = 0; dir < 2; ++dir) { const bf16* sp = (const bf16*)W.KVT + ((size_t)u * 2 + dir) * 8192 + dv * 64 + dd0; r.st[2 * dir] = *(const u32x4*)sp; r.st[2 * dir + 1] = *(const u32x4*)(sp + 8); }
        r.sg0 = *(const u32x4*)(W.SG + (trow0 + t) * 512 + h * 128 + v0); r.sg1 = *(const u32x4*)(W.SG + (trow0 + t) * 512 + h * 128 + v0 + 8);
    }
}
__device__ __forceinline__ void gla_cum(Frame& F, const GlaIn& r) {
    LAS float* cum = (LAS float*)(F.lds + GL_CUM);
#pragma unroll
    for (int it = 0; it < 4; ++it) { const int idx = F.tid + it * NTHR; const int dir = idx >> 10, t = (idx >> 4) & 63, d4 = (idx & 15) * 4;
        const u32x2 a = r.lg[it];
        *(LAS f32x4*)(cum + (dir * 64 + t) * 64 + d4) = (f32x4){bflo(a.x), bfhi(a.x), bflo(a.y), bfhi(a.y)}; }
    __syncthreads();
    {
        const int dir = F.tid >> 8, seg = (F.tid >> 6) & 3, d = F.tid & 63; LAS float* cc = cum + dir * 4096 + d; LAS float* tot = cum + 8192 + (dir * 4 + seg) * 64 + d;
        float v[16]; float run = 0.f;
        if (dir == 0) {
#pragma unroll
            for (int i = 0; i < 16; ++i) { run += cc[(16 * seg + i) * 64]; v[i] = run; }
        } else {
#pragma unroll
            for (int i = 15; i >= 0; --i) { run += cc[(16 * seg + i) * 64]; v[i] = run; }
        }
        *tot = run;
        __syncthreads();
        float off = 0.f; const LAS float* tb = cum + 8192 + dir * 256 + d;
        if (dir == 0) { if (seg > 0) off += tb[0]; if (seg > 1) off += tb[64]; if (seg > 2) off += tb[128]; }
        else { if (seg < 3) off += tb[192]; if (seg < 2) off += tb[128]; if (seg < 1) off += tb[64]; }
#pragma unroll
        for (int i = 0; i < 16; ++i) cc[(16 * seg + i) * 64] = v[i] + off;
    }
    __syncthreads();
}

__device__ __forceinline__ void phase_gla1(Frame& F) {
    refresh(F);
    const WS W = ws_map(F.ws, F.nb); const float* const* IN_ = F.a->in; (void)IN_; (void)W;
    LAS unsigned char* lds = F.lds; LAS float* cum = (LAS float*)(lds + GL_CUM);
    const int lane = F.lane, wid = F.wave, r32 = lane & 31, hh = lane >> 5;
    const int U = F.nb * NH * 128;
    GlaIn cur, nxt;
    if (F.bid < U) gla_load<false>(F, W, F.bid, nxt);
    for (int u = F.bid; u < U; u += F.G) {
        cur = nxt;
        if (u + F.G < U) gla_load<false>(F, W, u + F.G, nxt);
        gla_cum(F, cur);
        {
            const int t = F.tid >> 3, d0 = (F.tid & 7) * 8;
            const u32x4 kv = cur.k;
            const unsigned kw[4] = {kv.x, kv.y, kv.z, kv.w};
#pragma unroll
            for (int j = 0; j < 8; ++j) { const int d = d0 + j; const float k = (j & 1) ? bfhi(kw[j >> 1]) : bflo(kw[j >> 1]);
                const float ef = __expf(cum[63 * 64 + d] - cum[t * 64 + d]), eb = __expf(cum[4096 + d] - cum[4096 + t * 64 + d]);
                *(LAS bf16*)(lds + G1_KEF + d * GL_S64 + t * 2) = (bf16)(cvt_pk(k * ef, 0.f) & 0xffffu);
                *(LAS bf16*)(lds + G1_KEB + d * GL_S64 + t * 2) = (bf16)(cvt_pk(k * eb, 0.f) & 0xffffu); }
            const int v0 = (F.tid & 7) * 16;
            const u32x4 va = cur.v0, vb = cur.v1;
            const unsigned vw[8] = {va.x, va.y, va.z, va.w, vb.x, vb.y, vb.z, vb.w};
#pragma unroll
            for (int j = 0; j < 16; ++j) *(LAS bf16*)(lds + G1_VT + (v0 + j) * GL_S64 + t * 2) = (bf16)((j & 1) ? (vw[j >> 1] >> 16) : (vw[j >> 1] & 0xffffu));
            if (F.tid < 128) { const int dir = F.tid >> 6, d = F.tid & 63; W.DEC[((size_t)u * 2 + dir) * 64 + d] = __expf(dir ? cum[4096 + d] : cum[63 * 64 + d]); }
        }
        __syncthreads();
        {
            const int dt = wid & 3, dd = wid >> 2;
            f32x16 cf = {}, cb = {};
#pragma unroll
            for (int s = 0; s < 4; ++s) { const int kb = (16 * s + 8 * hh) * 2;
                const bf16x8 a = lds_frag(lds + G1_VT, 32 * dt + r32, GL_S64, kb);
                cf = __builtin_amdgcn_mfma_f32_32x32x16_bf16(a, lds_frag(lds + G1_KEF, 32 * dd + r32, GL_S64, kb), cf, 0, 0, 0);
                cb = __builtin_amdgcn_mfma_f32_32x32x16_bf16(a, lds_frag(lds + G1_KEB, 32 * dd + r32, GL_S64, kb), cb, 0, 0, 0); }
            bf16* of = (bf16*)W.KVT + ((size_t)u * 2) * 8192; bf16* ob = of + 8192;
#pragma unroll
            for (int r = 0; r < 16; ++r) { const int dv = 32 * dt + crow(r, hh), d = 32 * dd + r32;
                const float pf = __shfl_xor(cf[r], 1), pb = __shfl_xor(cb[r], 1);
                if (!(lane & 1)) { *(unsigned*)(of + dv * 64 + d) = cvt_pk(cf[r], pf); *(unsigned*)(ob + dv * 64 + d) = cvt_pk(cb[r], pb); } }
        }
        __syncthreads();
    }
}

__device__ __forceinline__ void phase_gla2(Frame& F) {
    refresh(F);
    const WS W = ws_map(F.ws, F.nb); const float* const* IN_ = F.a->in; (void)IN_; (void)W;
    const size_t total = (size_t)F.nb * NH * 2 * 4096;
    for (size_t wk = (size_t)F.bid * NTHR + F.tid; wk < total; wk += (size_t)F.G * NTHR) {
        const int e2 = (int)(wk & 4095), dir = (int)((wk >> 12) & 1), bh = (int)(wk >> 13), d = (e2 * 2) & 63;
        unsigned* base = (unsigned*)((bf16*)W.KVT + ((size_t)bh * 128 * 2 + dir) * 8192) + e2; const float* dec = W.DEC + ((size_t)bh * 128 * 2 + dir) * 64 + d;
        float S0 = 0.f, S1 = 0.f;
        for (int n0 = 0; n0 < 128; n0 += 8) {
            unsigned kv[8]; float dc0[8], dc1[8];
#pragma unroll
            for (int j = 0; j < 8; ++j) { const int n = dir ? 127 - (n0 + j) : n0 + j; kv[j] = base[(size_t)n * 8192]; dc0[j] = dec[(size_t)n * 128]; dc1[j] = dec[(size_t)n * 128 + 1]; }
#pragma unroll
            for (int j = 0; j < 8; ++j) { const int n = dir ? 127 - (n0 + j) : n0 + j; base[(size_t)n * 8192] = cvt_pk(S0, S1); S0 = dc0[j] * S0 + bflo(kv[j]); S1 = dc1[j] * S1 + bfhi(kv[j]); }
        }
    }
}

__device__ __forceinline__ void phase_gla3(Frame& F, int l) {
    refresh(F);
    const WS W = ws_map(F.ws, F.nb); const float* const* IN_ = F.a->in; (void)IN_; (void)W;
    LAS unsigned char* lds = F.lds; LAS float* cum = (LAS float*)(lds + GL_CUM);
    const int lane = F.lane, wid = F.wave, r32 = lane & 31, hh = lane >> 5;
    const float* gng = IN_[9] + l * 128;
    const int U = F.nb * NH * 128;
    GlaIn cur, nxt;
    if (F.bid < U) gla_load<true>(F, W, F.bid, nxt);
    for (int u = F.bid; u < U; u += F.G) {
        const int n = u & 127, bh = u >> 7, b = bh >> 2, h = bh & 3; const size_t trow0 = (size_t)b * SEQ + n * 64;
        cur = nxt;
        if (u + F.G < U) gla_load<true>(F, W, u + F.G, nxt);
        gla_cum(F, cur);
        {
            const int t = F.tid >> 3, d0 = (F.tid & 7) * 8;
            const u32x4 qv = cur.q, kv = cur.k;
            const unsigned qw[4] = {qv.x, qv.y, qv.z, qv.w}, kw[4] = {kv.x, kv.y, kv.z, kv.w};
            float qf[8], qb[8], kf[8], kb[8];
#pragma unroll
            for (int j = 0; j < 8; ++j) { const int d = d0 + j; const float q = (j & 1) ? bfhi(qw[j >> 1]) : bflo(qw[j >> 1]), k = (j & 1) ? bfhi(kw[j >> 1]) : bflo(kw[j >> 1]);
                const float cf = cum[t * 64 + d], cb = cum[4096 + t * 64 + d];
                qf[j] = q * __expf(cf); qb[j] = q * __expf(cb); kf[j] = k * __expf(-cf); kb[j] = k * __expf(-cb); }
            u32x4 o;
            o.x = cvt_pk(qf[0], qf[1]); o.y = cvt_pk(qf[2], qf[3]); o.z = cvt_pk(qf[4], qf[5]); o.w = cvt_pk(qf[6], qf[7]); *(LAS u32x4*)(lds + G3_AOP + t * GL_S192 + (64 + d0) * 2) = o;
            o.x = cvt_pk(qb[0], qb[1]); o.y = cvt_pk(qb[2], qb[3]); o.z = cvt_pk(qb[4], qb[5]); o.w = cvt_pk(qb[6], qb[7]); *(LAS u32x4*)(lds + G3_AOP + t * GL_S192 + (128 + d0) * 2) = o;
            o.x = cvt_pk(kf[0], kf[1]); o.y = cvt_pk(kf[2], kf[3]); o.z = cvt_pk(kf[4], kf[5]); o.w = cvt_pk(kf[6], kf[7]); *(LAS u32x4*)(lds + G3_KIF + t * GL_S64 + d0 * 2) = o;
            o.x = cvt_pk(kb[0], kb[1]); o.y = cvt_pk(kb[2], kb[3]); o.z = cvt_pk(kb[4], kb[5]); o.w = cvt_pk(kb[6], kb[7]); *(LAS u32x4*)(lds + G3_KIB + t * GL_S64 + d0 * 2) = o;
            const int v0 = (F.tid & 7) * 16;
            const u32x4 va = cur.v0, vb = cur.v1;
            const unsigned vw[8] = {va.x, va.y, va.z, va.w, vb.x, vb.y, vb.z, vb.w};
#pragma unroll
            for (int j = 0; j < 16; ++j) *(LAS bf16*)(lds + G3_BOP + (v0 + j) * GL_S192 + t * 2) = (bf16)((j & 1) ? (vw[j >> 1] >> 16) : (vw[j >> 1] & 0xffffu));
            const int dv = F.tid >> 2, dd0 = (F.tid & 3) * 16;
#pragma unroll
            for (int dir = 0; dir < 2; ++dir) { const u32x4 o0 = cur.st[2 * dir], o1 = cur.st[2 * dir + 1];
                *(LAS u32x4*)(lds + G3_BOP + dv * GL_S192 + (64 + 64 * dir + dd0) * 2) = o0; *(LAS u32x4*)(lds + G3_BOP + dv * GL_S192 + (64 + 64 * dir + dd0 + 8) * 2) = o1; }
        }
        __syncthreads();
        if (wid < 4) {
            const int it = wid >> 1, jt = wid & 1;
            f32x16 af = {}, ab = {};
#pragma unroll
            for (int s = 0; s < 4; ++s) { const int kb = (16 * s + 8 * hh) * 2;
                if (jt <= it) af = __builtin_amdgcn_mfma_f32_32x32x16_bf16(lds_frag(lds + G3_AOP, 32 * it + r32, GL_S192, 128 + kb), lds_frag(lds + G3_KIF, 32 * jt + r32, GL_S64, kb), af, 0, 0, 0);
                if (jt >= it) ab = __builtin_amdgcn_mfma_f32_32x32x16_bf16(lds_frag(lds + G3_AOP, 32 * it + r32, GL_S192, 256 + kb), lds_frag(lds + G3_KIB, 32 * jt + r32, GL_S64, kb), ab, 0, 0, 0); }
#pragma unroll
            for (int r = 0; r < 16; ++r) { const int i = 32 * it + crow(r, hh), j = 32 * jt + r32; const float v = (j <= i) ? af[r] : ab[r];
                *(LAS bf16*)(lds + G3_AOP + i * GL_S192 + j * 2) = (bf16)(cvt_pk(v, 0.f) & 0xffffu); }
        }
        __syncthreads();
        {
            const int it = wid >> 2, dt = wid & 3; f32x16 o = {};
#pragma unroll
            for (int s = 0; s < 12; ++s) { const int kb = (16 * s + 8 * hh) * 2;
                o = __builtin_amdgcn_mfma_f32_32x32x16_bf16(lds_frag(lds + G3_AOP, 32 * it + r32, GL_S192, kb), lds_frag(lds + G3_BOP, 32 * dt + r32, GL_S192, kb), o, 0, 0, 0); }
            LAS float* out = (LAS float*)(lds + GL_CUM);
#pragma unroll
            for (int r = 0; r < 16; ++r) out[(32 * it + crow(r, hh)) * 128 + 32 * dt + r32] = o[r];
        }
        __syncthreads();
        {
            const int t = F.tid >> 3, v0 = (F.tid & 7) * 16; const LAS float* orow = (const LAS float*)(lds + GL_CUM) + t * 128 + v0;
            float x[16]; float ss = 0.f;
#pragma unroll
            for (int j = 0; j < 16; ++j) { x[j] = orow[j]; ss += x[j] * x[j]; }
            ss += __shfl_xor(ss, 1); ss += __shfl_xor(ss, 2); ss += __shfl_xor(ss, 4);
            const float rs = rsqrtf(ss * (1.f / 128.f) + RMS_EPS);
            const u32x4 ga = cur.sg0, gb = cur.sg1;
            const unsigned gw[8] = {ga.x, ga.y, ga.z, ga.w, gb.x, gb.y, gb.z, gb.w};
            float y[16];
#pragma unroll
            for (int j = 0; j < 16; ++j) y[j] = x[j] * rs * gng[v0 + j] * ((j & 1) ? bfhi(gw[j >> 1]) : bflo(gw[j >> 1]));
            u32x4 o0, o1; o0.x = cvt_pk(y[0], y[1]); o0.y = cvt_pk(y[2], y[3]); o0.z = cvt_pk(y[4], y[5]); o0.w = cvt_pk(y[6], y[7]);
            o1.x = cvt_pk(y[8], y[9]); o1.y = cvt_pk(y[10], y[11]); o1.z = cvt_pk(y[12], y[13]); o1.w = cvt_pk(y[14], y[15]);
            bf16* dst = W.OAB + (trow0 + t) * 512 + h * 128 + v0; *(u32x4*)dst = o0; *(u32x4*)(dst + 8) = o1;
        }
        __syncthreads();
    }
}
__device__ __forceinline__ void phase_select(Frame& F, int l) {
    refresh(F);
    const WS W = ws_map(F.ws, F.nb); const float* const* IN_ = F.a->in; (void)IN_; (void)W;
    LAS int* lcnt = (LAS int*)F.lds; LAS int* lbase = lcnt + 32;
    const float* b_rg = IN_[19] + l * 4; const float* b_re = IN_[21] + l * 32;
    unsigned* gcnt = W.ctl + CW_CNT + l * 64;
    for (int t0 = F.bid * NTHR; t0 < F.T; t0 += F.G * NTHR) {
        if (F.tid < 32) lcnt[F.tid] = 0;
        __syncthreads();
        const int t = t0 + F.tid; int e0 = 0, e1 = 0, r0 = 0, r1 = 0; float g0 = 0.f, g1 = 0.f;
        if (t < F.T) {
            const float* lg = W.LOGITS + (size_t)t * 64;
            float gl[4]; { const f32x4 v = *(const f32x4*)lg; gl[0] = v[0] + b_rg[0]; gl[1] = v[1] + b_rg[1]; gl[2] = v[2] + b_rg[2]; gl[3] = v[3] + b_rg[3]; }
            int grp = 0; float mx = gl[0];
            if (gl[1] > mx) { mx = gl[1]; grp = 1; } if (gl[2] > mx) { mx = gl[2]; grp = 2; } if (gl[3] > mx) { mx = gl[3]; grp = 3; }
            const float p_grp = 1.f / (__expf(gl[0] - mx) + __expf(gl[1] - mx) + __expf(gl[2] - mx) + __expf(gl[3] - mx));
            const f32x4 ea = *(const f32x4*)(lg + 4 + grp * 8), eb = *(const f32x4*)(lg + 8 + grp * 8);
            const f32x4 ba = *(const f32x4*)(b_re + grp * 8), bb = *(const f32x4*)(b_re + grp * 8 + 4);
            float b0v = -1e30f, b1v = -1e30f; int i0 = 0, i1 = 0;
#pragma unroll
            for (int j = 0; j < 8; ++j) { const float e = (j < 4) ? ea[j] + ba[j] : eb[j - 4] + bb[j - 4];
                if (e > b0v) { b1v = b0v; i1 = i0; b0v = e; i0 = j; } else if (e > b1v) { b1v = e; i1 = j; } }
            const float p1 = __expf(b1v - b0v), s2 = 1.f + p1;
            e0 = grp * 8 + i0; e1 = grp * 8 + i1; g0 = p_grp / s2; g1 = p_grp * p1 / s2;
            r0 = __hip_atomic_fetch_add(lcnt + e0, 1, __ATOMIC_RELAXED, __HIP_MEMORY_SCOPE_WORKGROUP);
            r1 = __hip_atomic_fetch_add(lcnt + e1, 1, __ATOMIC_RELAXED, __HIP_MEMORY_SCOPE_WORKGROUP);
        }
        __syncthreads();
        if (F.tid < 32) lbase[F.tid] = (int)__hip_atomic_fetch_add(gcnt + F.tid, (unsigned)lcnt[F.tid], __ATOMIC_RELAXED, __HIP_MEMORY_SCOPE_AGENT);
        __syncthreads();
        if (t < F.T) { W.eid[t * 2] = e0; W.eid[t * 2 + 1] = e1; W.gate[t * 2] = g0; W.gate[t * 2 + 1] = g1; W.rank[t * 2] = lbase[e0] + r0; W.rank[t * 2 + 1] = lbase[e1] + r1; }
        __syncthreads();
    }
}
__device__ __forceinline__ void phase_gather(Frame& F, int l) {
    refresh(F);
    const WS W = ws_map(F.ws, F.nb); const float* const* IN_ = F.a->in; (void)IN_; (void)W;
    LAS int* seg = (LAS int*)F.lds; LAS int* cnt = seg + 40;
    const unsigned* gcnt = W.ctl + CW_CNT + l * 64;
    if (F.tid == 0) { int o = 0; for (int e = 0; e < 32; ++e) { const int c = (int)__hip_atomic_load(gcnt + e, __ATOMIC_RELAXED, __HIP_MEMORY_SCOPE_AGENT); seg[e] = o; cnt[e] = c; o += (c + 255) & ~255; } seg[32] = o; }
    __syncthreads();
    const int ntile = seg[32] >> 8;
    if (F.bid == 0) {
        for (int i = F.tid; i < ntile; i += NTHR) { int e = 0; while (e < 31 && (i << 8) >= seg[e + 1]) ++e; W.tilee[i] = e; }
        if (F.tid == 0) W.segp[0] = ntile;
    }
    for (int p = F.bid * NTHR + F.tid; p < (ntile << 8); p += F.G * NTHR) { int e = 0; while (e < 31 && p >= seg[e + 1]) ++e; if (p - seg[e] >= cnt[e]) W.stok[p] = 0; }
    for (int it = F.bid * NTHR + F.tid; it < F.T * 2; it += F.G * NTHR) {
        const int e = W.eid[it], p = seg[e] + W.rank[it];
        W.stok[p] = it >> 1; W.pos[it] = p; W.gsort[p] = W.gate[it];
    }
}

#ifndef MK_MASK
#define MK_MASK 0xffffffffu
#endif
#define EN(b) (((MK_MASK) >> (b)) & 1u)
#ifndef MK_ALIGN
#define MK_ALIGN true
#endif
#ifndef MK_SP2
#define MK_SP2 true
#endif
#ifndef MK_DUP
#define MK_DUP 0u
#endif
#define REPS(b) ((((MK_DUP) >> (b)) & 1u) ? 2 : 1)
constexpr int NPL = 14, NPH = 2 + DEPTH * NPL;
__global__ void __launch_bounds__(NTHR, 2) mk_fwd(Args args) {
    extern __shared__ __attribute__((aligned(16))) unsigned char lds_raw[];
    Frame F;
    F.lds = (LAS unsigned char*)lds_raw; F.tid = threadIdx.x; F.lane = F.tid & 63; F.wave = __builtin_amdgcn_readfirstlane(F.tid >> 6);
    F.G = gridDim.x; F.bid = blockIdx.x; F.nb = args.nb; F.T = args.nb * SEQ; F.ws = args.ws; F.a = &args; F.xbuf = args.out;
    const float* const* IN_ = args.in;
    volatile LAS unsigned* misc = (volatile LAS unsigned*)(F.lds + LDS_MISC);
    if (F.tid < 64) misc[F.tid] = 0u;
    __syncthreads();
    XcdBarrier bar = xcd_barrier_post((unsigned*)args.ws + CW_BAR + args.li * XCD_BAR_WORDS, misc);
    const int lo = args.ph_lo, hi = args.ph_hi;
#define IN(k) (lo <= (k) && (k) < hi)
#ifdef MK_BAR2
#define SEAM(k) do { if (IN(k) && IN((k) + 1)) { xcd_barrier(bar); xcd_barrier(bar); } } while (0)
#else
#define SEAM(k) do { if (IN(k) && IN((k) + 1)) xcd_barrier(bar); } while (0)
#endif
#ifdef MK_UB
    {
        typedef int ub8i __attribute__((ext_vector_type(8))); typedef int ub4i __attribute__((ext_vector_type(4)));
        ub8i ua, ubb; for (int i = 0; i < 8; ++i) { ua[i] = 0x38383838 + F.lane; ubb[i] = 0x30303030 + F.lane * 3; }
        f32x16 acc0 = {}, acc1 = {}, acc2 = {}, acc3 = {};
        float e0 = F.lane * 0.01f, e1 = e0 + 1, e2 = e0 + 2, e3 = e0 + 3, e4 = e0 + 4, e5 = e0 + 5, e6 = e0 + 6, e7 = e0 + 7;
        ub4i ld0 = {}, ld1 = {}; const unsigned la = (unsigned)(unsigned long)F.lds + F.tid * 16;
#define UB_M(acc) do { if constexpr (MK_UB & 1) acc = __builtin_amdgcn_mfma_scale_f32_32x32x64_f8f6f4(ua, ubb, acc, 0, (MK_UB & 16) ? 1 : 0, 0, 0, 0, 0); } while (0)
#define UB_E() do { if constexpr (MK_UB & 2) { e0 = __builtin_amdgcn_exp2f(e0); e1 = __builtin_amdgcn_exp2f(e1); e2 = __builtin_amdgcn_exp2f(e2); e3 = __builtin_amdgcn_exp2f(e3); \
                                              e4 = __builtin_amdgcn_exp2f(e4); e5 = __builtin_amdgcn_exp2f(e5); e6 = __builtin_amdgcn_exp2f(e6); e7 = __builtin_amdgcn_exp2f(e7); } } while (0)
#define UB_L() do { if constexpr (MK_UB & 4) { asm volatile("ds_read_b128 %0, %1" : "=&v"(ld0) : "v"(la) : "memory"); asm volatile("ds_read_b128 %0, %1 offset:8192" : "=&v"(ld1) : "v"(la) : "memory"); } } while (0)
        for (int it = 0; it < 2000; ++it) {
            UB_M(acc0); __builtin_amdgcn_sched_barrier(0); UB_E(); UB_L(); __builtin_amdgcn_sched_barrier(0);
            UB_M(acc1); __builtin_amdgcn_sched_barrier(0); UB_E(); UB_L(); __builtin_amdgcn_sched_barrier(0);
            UB_M(acc2); __builtin_amdgcn_sched_barrier(0); UB_E(); UB_L(); __builtin_amdgcn_sched_barrier(0);
            UB_M(acc3); __builtin_amdgcn_sched_barrier(0); UB_E(); UB_L(); __builtin_amdgcn_sched_barrier(0);
            if constexpr (MK_UB & 4) asm volatile("s_waitcnt lgkmcnt(0)" ::: "memory");
        }
        const float sink = acc0[0] + acc1[1] + acc2[2] + acc3[3] + e0 + e1 + e2 + e3 + e4 + e5 + e6 + e7 + (float)(ld0[0] + ld1[1]);
        if (sink == 12345.678f) ((unsigned*)args.ws)[CW_CNT + 77] = 1u;
        __syncthreads();
    }
#endif
    LAS unsigned char* gl = F.lds;
    if (EN(0) && IN(0)) { for (int rp = 0; rp < REPS(0); ++rp) { p0_prologue(F); __syncthreads(); } SEAM(0); }
    for (int l = 0; l < DEPTH; ++l) {
        const int pb = 1 + l * NPL;
        if (EN(1) && IN(pb + 0)) { for (int rp = 0; rp < ((l == 0) ? REPS(14) : 1); ++rp) phase_norm(F, l, 0); SEAM(pb + 0); }
        if (EN(2) && IN(pb + 1)) { const WS W = ws_map(F.ws, F.nb);
            pg8::Gemm g{W.H, W.win + (size_t)l * NIN * D, F.T, NIN, D}; pg8::StaticOrder S; S.init(F.T, NIN, F.G, F.bid);
            EpiIn E{W.GQ, W.GK, W.GV, W.SG, W.LGF, W.LGB, W.DQ, W.DK, W.DV, W.SGA, W.SGB, IN_[8] + l * 512, IN_[10] + l * 64, IN_[11] + l * 64, 0};
#ifdef MK_DEPHASE
            { const int g_ = (F.bid >> 3) & 7; for (int k_ = 0; k_ < g_ * MK_DEPHASE; ++k_) __builtin_amdgcn_s_sleep(127); }
#endif
#ifdef MK_INPROJ_PLAIN
            { EpiIn EP_ = E; EP_.plain = 1; pg8::gemm_phase<EpiIn, pg8::StaticOrder, MK_ALIGN, MK_SP2>(gl, g, S, EP_); }
#endif
#ifdef MK_INPROJ_NULL
            { EpiNull EN_; pg8::gemm_phase<EpiNull, pg8::StaticOrder, MK_ALIGN, MK_SP2>(gl, g, S, EN_); }
#endif
            for (int rp = 0; rp < REPS(2); ++rp) pg8::gemm_phase<EpiIn, pg8::StaticOrder, MK_ALIGN, MK_SP2>(gl, g, S, E);
            SEAM(pb + 1);
        }
        if (EN(3) && IN(pb + 2)) { for (int rp = 0; rp < REPS(3); ++rp) phase_gla1(F); SEAM(pb + 2); }
        if (EN(4) && IN(pb + 3)) { phase_gla2(F); SEAM(pb + 3); }
        if (EN(5) && IN(pb + 4)) { for (int rp = 0; rp < REPS(5); ++rp) phase_gla3(F, l); __syncthreads(); }
        if (EN(6) && IN(pb + 5)) {
#ifdef MK_ATT_PROBE
            phase_attn<MK_ATT_PROBE>(F, l);
#endif
            phase_attn<0>(F, l); SEAM(pb + 5); }
        if (EN(7) && IN(pb + 6)) { const WS W = ws_map(F.ws, F.nb);
            pg8::Gemm g{W.OAB, W.wab + (size_t)l * D * D, 0, 0, 512}; MergeOrder S; S.so.init(F.T, D, F.G, F.bid); S.nM = F.T / 256;
            EpiMerge E{W.SGA, W.SGB, W.MERGED, F.T / 256};
            for (int rp = 0; rp < REPS(7); ++rp) pg8::gemm_phase<EpiMerge, MergeOrder, MK_ALIGN, MK_SP2>(gl, g, S, E);
            SEAM(pb + 6);
        }
        if (EN(8) && IN(pb + 7)) { const WS W = ws_map(F.ws, F.nb); const float* modl = W.mod + (size_t)l * NBMAX * 6 * D;
            pg8::Gemm g{W.MERGED, W.wo + (size_t)l * D * D, F.T, D, D}; pg8::StaticOrder S; S.init(F.T, D, F.G, F.bid);
            EpiResid E{l == 0 ? IN_[0] : nullptr, W.XB, modl + 2 * D};
            for (int rp = 0; rp < ((l == 0) ? REPS(8) : 1); ++rp) pg8::gemm_phase<EpiResid, pg8::StaticOrder, MK_ALIGN, MK_SP2>(gl, g, S, E);
            SEAM(pb + 7);
        }
        if (EN(1) && IN(pb + 8)) { for (int rp = 0; rp < REPS(1); ++rp) phase_norm(F, l, 1); SEAM(pb + 8); }
        if (EN(9) && IN(pb + 9)) { const WS W = ws_map(F.ws, F.nb);
            pg8::Gemm g{W.H, W.wr + (size_t)l * 256 * D, F.T, 256, D}; pg8::StaticOrder S; S.init(F.T, 256, F.G, F.bid);
            EpiLogits E{W.LOGITS};
            for (int rp = 0; rp < REPS(9); ++rp) pg8::gemm_phase<EpiLogits, pg8::StaticOrder, MK_ALIGN, MK_SP2>(gl, g, S, E);
            SEAM(pb + 9);
        }
        if (EN(10) && IN(pb + 10)) { phase_select(F, l); SEAM(pb + 10); }
        if (EN(11) && IN(pb + 11)) { for (int rp = 0; rp < REPS(11); ++rp) { phase_gather(F, l); __syncthreads(); } SEAM(pb + 11); }
        if (EN(12) && IN(pb + 12)) { const WS W = ws_map(F.ws, F.nb);
            const int ntile = W.segp[0];
#if MK_MOE_FP8
            pg8::Gemm g{W.XS, (const bf16*)((const unsigned char*)W.w1 + (size_t)l * NE * 1024 * D), 0, 0, D / 2}; GroupedOrder S{W.tilee, ntile * 4, F.G, F.bid};
            EpiAct E{(unsigned char*)W.ACT};
#else
            pg8::Gemm g{W.H, W.w1 + (size_t)l * NE * 1024 * D, 0, 0, D}; GroupedOrder S{W.tilee, ntile * 4, F.G, F.bid, W.stok};
            EpiAct E{W.ACT};
#endif
            for (int rp = 0; rp < REPS(12); ++rp) pg8::gemm_phase<EpiAct, GroupedOrder, MK_ALIGN, MK_SP2, true>(gl, g, S, E);
            SEAM(pb + 12);
        }
        if (EN(13) && IN(pb + 13)) { const WS W = ws_map(F.ws, F.nb);
            const int ntile = W.segp[0];
#if MK_MOE_FP8
            pg8::Gemm g{W.ACT, (const bf16*)((const unsigned char*)W.w2 + (size_t)l * NE * D * DE), 0, 0, DE / 2}; GroupedOrder S{W.tilee, ntile * 4, F.G, F.bid};
#else
            pg8::Gemm g{W.ACT, W.w2 + (size_t)l * NE * D * DE, 0, 0, DE}; GroupedOrder S{W.tilee, ntile * 4, F.G, F.bid, nullptr};
#endif
            EpiYs E{(unsigned char*)W.YS, W.gsort};
            for (int rp = 0; rp < REPS(13); ++rp) pg8::gemm_phase<EpiYs, GroupedOrder, MK_ALIGN, MK_SP2>(gl, g, S, E);
            SEAM(pb + 13);
        }
    }
    if (EN(1) && IN(NPH - 1)) phase_norm(F, 0, 2);
#undef IN
#undef SEAM
}

struct LaunchCfg { int grid; bool ok; };
inline LaunchCfg& launch_cfg() {
    static LaunchCfg c{0, false}; static bool init = false;
    if (!init) { init = true;
        int dev = 0, cus = 0, per_cu = 0;
        if (hipGetDevice(&dev) != hipSuccess || hipDeviceGetAttribute(&cus, hipDeviceAttributeMultiprocessorCount, dev) != hipSuccess) { fprintf(stderr, "mk: device query failed\n"); return c; }
        if (hipFuncSetAttribute((const void*)mk_fwd, hipFuncAttributeMaxDynamicSharedMemorySize, LDS_BYTES) != hipSuccess) { fprintf(stderr, "mk: hipFuncSetAttribute failed\n"); return c; }
        if (hipOccupancyMaxActiveBlocksPerMultiprocessor(&per_cu, (const void*)mk_fwd, NTHR, LDS_BYTES) != hipSuccess || per_cu < 1) { fprintf(stderr, "mk: occupancy query says %d blocks/CU\n", per_cu); (void)hipGetLastError(); return c; }
        c.grid = cus; c.ok = true;
    }
    return c;
}
inline void launch_range(void* const* d_in, float* xbuf, void* d_ws, int nb, int lo, int hi, int li, hipStream_t stream) {
    LaunchCfg& c = launch_cfg(); if (!c.ok) return;
    Args a{}; for (int i = 0; i < 24; ++i) a.in[i] = (const float*)d_in[i];
    a.out = xbuf; a.ws = (unsigned char*)d_ws; a.nb = nb; a.ph_lo = lo; a.ph_hi = hi; a.li = li;
    hipLaunchKernelGGL(mk_fwd, dim3(c.grid), dim3(NTHR), LDS_BYTES, stream, a);
    const hipError_t le = hipPeekAtLastError(); if (le != hipSuccess) fprintf(stderr, "mk: launch [%d,%d) failed: %s\n", lo, hi, hipGetErrorName(le));
}
}
extern "C" void kernel_launch(void* const* d_in, const int* in_sizes, int n_in, void* d_out, int out_size, void* d_ws, size_t ws_size, hipStream_t stream) {
    (void)in_sizes; (void)n_in; (void)out_size;
    static int checked = 0;
    if (!checked) { checked = 1; const mk::WS w = mk::ws_map((unsigned char*)d_ws, 4); if (w.end > ws_size) { fprintf(stderr, "mk: workspace too small: need %zu, have %zu\n", w.end, ws_size); checked = -1; } }
    if (checked < 0) return;
    if (hipMemsetAsync(d_ws, 0, mk::CTL_BYTES, stream) != hipSuccess) return;
    mk::launch_range(d_in, (float*)d_out, d_ws, 4, 0, mk::NPH, 0, stream);
}
```

```cpp
#include <hip/hip_runtime.h>
#include <cstdio>
#include <cstdint>
#include <cmath>
#define MK_ATT_FP8 1
namespace pg8 {
#define PG8_LAS __attribute__((address_space(3)))
typedef unsigned short bf16_t;
typedef short bf16x8 __attribute__((ext_vector_type(8)));
typedef float f32x4 __attribute__((ext_vector_type(4)));
typedef unsigned u32x4 __attribute__((ext_vector_type(4)));
constexpr int BM = 256, BK = 64, HALF = 128, HTB = HALF * BK * 2  , STAGE_BYTES = 8 * HTB, NXCD = 8, WGM = 8;

__host__ __device__ __forceinline__ int lds_byte(int r, int c) { const int st = (r >> 4) * 2 + (c >> 5), rr = r & 15, cc = c & 31, ob = rr * 64 + cc * 2; return st * 1024 + (ob ^ (((ob >> 9) & 1) << 5)); }
__host__ __device__ __forceinline__ void stage_rc(int b, int& R, int& C) { const int st = b / 1024, sb = b % 1024, swz = sb ^ (((sb >> 9) & 1) << 5); R = (st >> 1) * 16 + swz / 64; C = (st & 1) * 32 + (swz % 64) / 2; }
__host__ __device__ __forceinline__ int perm32(int rho) { const int n = rho >> 4, i = rho & 15; return 8 * (i >> 2) + 4 * n + (i & 3); }

struct Unit { int pm, pn; };
struct Gemm { const bf16_t* A; const bf16_t* Bt; int M, N, K; };

struct StaticOrder {
    int nM, nN, nwg, G, c;
    __host__ __device__ void init(int M, int N, int G_, int c_) { nM = M / BM; nN = N / BM; nwg = nM * nN; G = G_; c = c_; }
    __host__ __device__ bool next(int i, Unit& u) const {
        const long L = (long)i * G + c; if (L >= nwg) return false;
        int wgid = (int)L; { const int q = nwg / NXCD, r = nwg % NXCD, xcd = wgid % NXCD, off = wgid / NXCD; wgid = (xcd < r ? xcd * (q + 1) : r * (q + 1) + (xcd - r) * q) + off; }
        const int nig = WGM * nN, gid = wgid / nig, fm = gid * WGM, gsz = (nM - fm) < WGM ? (nM - fm) : WGM;
        u.pm = fm + ((wgid % nig) % gsz); u.pn = (wgid % nig) / gsz; return true;
    }
    __device__ __forceinline__ void a_ready(const Unit&) const {}
    __device__ __forceinline__ void done(const Unit&) const {}
};
__device__ __forceinline__ unsigned cvt_pk_bf16(float lo, float hi) { unsigned r; asm volatile("v_cvt_pk_bf16_f32 %0, %1, %2" : "=v"(r) : "v"(lo), "v"(hi)); return r; }
__device__ __forceinline__ const void* pg8_uniform(const void* p) { const unsigned long long v = (unsigned long long)p;
    const unsigned lo = (unsigned)__builtin_amdgcn_readfirstlane((int)(unsigned)v), hi = (unsigned)__builtin_amdgcn_readfirstlane((int)(unsigned)(v >> 32)); return (const void*)(((unsigned long long)hi << 32) | lo); }
__device__ __forceinline__ void pg8_glds(const void* sbase, unsigned voff, unsigned ldsdst) { unsigned keep;
    asm volatile("s_nop 4\n\ts_mov_b32 %0, m0\n\ts_mov_b32 m0, %3\n\ts_nop 0\n\tglobal_load_lds_dwordx4 %1, %2\n\ts_mov_b32 m0, %0" : "=&s"(keep) : "v"(voff), "s"(sbase), "s"(ldsdst) : "memory"); }
typedef int pg8_v8i __attribute__((ext_vector_type(8)));
typedef int pg8_v4i __attribute__((ext_vector_type(4)));
template <class Epi, class Sched, bool ALIGN_EPI = false, bool SP2 = false, bool GATHER = false>
__device__ __forceinline__ void gemm_phase(PG8_LAS unsigned char* lds, const Gemm g, const Sched& S, const Epi& E) {
    int tid_ = threadIdx.x; asm volatile("" : "+v"(tid_));
    const int tid = tid_, wid = __builtin_amdgcn_readfirstlane(tid >> 6), lane = tid & 63, wr = wid >> 2, wc = wid & 3, fr = lane & 15, fq = lane >> 4;
    const int K = g.K, nt = K / BK;
    unsigned voffA[2], voffB[2]; unsigned vc[2][2] = {}, vn[2][2] = {}, vs[2][2] = {}; (void)vc; (void)vn; (void)vs;
#pragma unroll
    for (int i = 0; i < 2; ++i) { int R, C; stage_rc(tid * 16 + i * 8192, R, C); const int Rb = Epi::PERM ? ((R & ~31) + perm32(R & 31)) : R;
        voffA[i] = (unsigned)(R * K + C) * 2u; voffB[i] = (unsigned)(Rb * K + C) * 2u; }
    const size_t kstep = (size_t)(BK * 2);
    const size_t hstep = (size_t)HALF * K * 2;
    const size_t tstep = 2 * hstep;
    const unsigned ldsw = (unsigned)wid * 1024u; const unsigned lds0 = (unsigned)(unsigned long)lds; (void)lds0;
    const int aoff = lds_byte(wr * 64 + fr, fq * 8), boff = lds_byte(wc * 32 + fr, fq * 8);
#define PG8_SA(b, h) (((b) * 2 + (h)) * HTB)
#define PG8_SB(b, h) ((4 + (b) * 2 + (h)) * HTB)
#if defined(PG8_ASM_STAGE) && PG8_ASM_STAGE
#define PG8_STAGE(bufoff, gbase, voff) do { const void* _gb = pg8_uniform(gbase); _Pragma("unroll") for (int _i = 0; _i < 2; ++_i) \
        pg8_glds(_gb, (voff)[_i], (unsigned)__builtin_amdgcn_readfirstlane((int)(lds0 + (unsigned)(bufoff) + ldsw + _i * 8192))); } while (0)
#else
#define PG8_STAGE(bufoff, gbase, voff) do { _Pragma("unroll") for (int _i = 0; _i < 2; ++_i) \
        __builtin_amdgcn_global_load_lds((const unsigned*)((const char*)(gbase) + (voff)[_i]), (PG8_LAS unsigned*)(lds + (bufoff) + ldsw + _i * 8192), 16, 0, 0); } while (0)
#endif
#define PG8_STAGE_A(b, h, X, VS) do { if constexpr (GATHER) { PG8_STAGE(PG8_SA(b, h), X, VS[h]); } else { PG8_STAGE(PG8_SA(b, h), (X) + (h) * hstep, voffA); } } while (0)
#define PG8_LOADROWS(u, v) do { _Pragma("unroll") for (int i_ = 0; i_ < 2; ++i_) { int R_, C_; stage_rc(tid * 16 + i_ * 8192, R_, C_); _Pragma("unroll") for (int h_ = 0; h_ < 2; ++h_) \
        v[h_][i_] = (unsigned)S.rowidx[(u).pm * 256 + h_ * 128 + R_] * (unsigned)(K * 2) + (unsigned)C_ * 2u; } } while (0)
#define PG8_LDA(dst, b, h) do { _Pragma("unroll") for (int m = 0; m < 4; ++m) _Pragma("unroll") for (int k = 0; k < 2; ++k) dst[m][k] = *(const PG8_LAS bf16x8*)(lds + PG8_SA(b, h) + aoff + m * 2048 + k * 1024); } while (0)
#define PG8_LDB(dst, b, h) do { _Pragma("unroll") for (int n = 0; n < 2; ++n) _Pragma("unroll") for (int k = 0; k < 2; ++k) dst[n][k] = *(const PG8_LAS bf16x8*)(lds + PG8_SB(b, h) + boff + n * 2048 + k * 1024); } while (0)
#define PG8_MMA(ai, bj, At, Bt) do { __builtin_amdgcn_s_setprio(1); _Pragma("unroll") for (int m = 0; m < 4; ++m) _Pragma("unroll") for (int n = 0; n < 2; ++n) _Pragma("unroll") for (int k = 0; k < 2; ++k) \
        acc[ai][bj][m][n] = __builtin_amdgcn_mfma_f32_16x16x32_bf16(Bt[n][k], At[m][k], acc[ai][bj][m][n], 0, 0, 0); __builtin_amdgcn_s_setprio(0); } while (0)
#define PG8_WAIT_V(n) asm volatile("s_waitcnt vmcnt(" #n ")" ::: "memory")
#define PG8_WAIT_L(n) asm volatile("s_waitcnt lgkmcnt(" #n ")" ::: "memory")
#define PG8_BAR __builtin_amdgcn_s_barrier()
#define PG8_SCHED __builtin_amdgcn_sched_barrier(0)
    Unit cur, nxt; int ui = 0;
    if (!S.next(0, cur)) return;
    f32x4 acc[2][2][4][2];
#pragma unroll
    for (int a = 0; a < 2; ++a)
#pragma unroll
        for (int b = 0; b < 2; ++b)
#pragma unroll
            for (int m = 0; m < 4; ++m)
#pragma unroll
                for (int n = 0; n < 2; ++n) acc[a][b][m][n] = (f32x4){0.f, 0.f, 0.f, 0.f};
    bf16x8 At[4][2], B0[2][2], B1[2][2];
    const char* cA = (const char*)g.A + (GATHER ? (size_t)0 : (size_t)cur.pm * tstep); const char* cB = (const char*)g.Bt + (size_t)cur.pn * tstep;
    S.a_ready(cur);
    if constexpr (GATHER) { PG8_LOADROWS(cur, vc); }
    if constexpr (SP2) {
        PG8_STAGE(PG8_SB(0, 0), cB, voffB); PG8_STAGE(PG8_SB(0, 1), cB + hstep, voffB); PG8_STAGE_A(0, 0, cA, vc); PG8_STAGE_A(0, 1, cA, vc);
        if (wr == 1) PG8_BAR;
        PG8_WAIT_V(2); PG8_BAR;
        PG8_STAGE(PG8_SB(1, 0), cB + kstep, voffB); PG8_STAGE_A(1, 0, cA + kstep, vc); PG8_STAGE(PG8_SB(1, 1), cB + hstep + kstep, voffB);
        PG8_WAIT_V(6); PG8_BAR;
    } else {
        PG8_STAGE(PG8_SB(0, 0), cB, voffB); PG8_STAGE_A(0, 0, cA, vc); PG8_STAGE(PG8_SB(0, 1), cB + hstep, voffB); PG8_STAGE_A(0, 1, cA, vc);
        if (wr == 1) PG8_BAR;
        PG8_WAIT_V(4); PG8_BAR;
        PG8_STAGE(PG8_SB(1, 0), cB + kstep, voffB); PG8_STAGE_A(1, 0, cA + kstep, vc); PG8_STAGE(PG8_SB(1, 1), cB + hstep + kstep, voffB);
        PG8_WAIT_V(6); PG8_BAR;
    }
    for (;;) {
        const bool has_next = S.next(ui + 1, nxt);
        const char* nA = (has_next && !GATHER) ? (const char*)g.A + (size_t)nxt.pm * tstep : cA; const char* nB = has_next ? (const char*)g.Bt + (size_t)nxt.pn * tstep : cB;
        for (int t = 0; t < nt; t += 2) {
            const bool last = (t == nt - 2);
            const char* a1 = cA + (size_t)(t + 1) * kstep;
            const char* a2 = last ? nA : cA + (size_t)(t + 2) * kstep; const char* b2 = last ? nB : cB + (size_t)(t + 2) * kstep;
            const char* a3 = a2 + kstep; const char* b3 = b2 + kstep;
            if (last && has_next) S.a_ready(nxt);
            if constexpr (GATHER) { if (last && has_next) { PG8_LOADROWS(nxt, vn); }
                _Pragma("unroll") for (int h_ = 0; h_ < 2; ++h_) _Pragma("unroll") for (int i_ = 0; i_ < 2; ++i_) vs[h_][i_] = (last && has_next) ? vn[h_][i_] : vc[h_][i_]; }
            if constexpr (Epi::MIDK) { if (t == nt / 2) E.mid(acc, cur, wr, wc, fr, fq); }
            if constexpr (SP2) {
            PG8_LDB(B0, 0, 0); PG8_LDB(B1, 0, 1); PG8_SCHED; PG8_LDA(At, 0, 0); PG8_STAGE_A(1, 1, a1, vc);
            PG8_WAIT_V(8); PG8_WAIT_L(0); PG8_BAR; PG8_MMA(0, 0, At, B0); PG8_MMA(0, 1, At, B1); PG8_BAR; PG8_SCHED;
            PG8_LDA(At, 0, 1); PG8_STAGE(PG8_SB(0, 0), b2, voffB); PG8_STAGE(PG8_SB(0, 1), b2 + hstep, voffB); PG8_STAGE_A(0, 0, a2, vs);
            PG8_WAIT_V(8); PG8_WAIT_L(0); PG8_BAR; PG8_MMA(1, 0, At, B0); PG8_MMA(1, 1, At, B1); PG8_BAR; PG8_SCHED;
            PG8_LDB(B0, 1, 0); PG8_LDB(B1, 1, 1); PG8_SCHED; PG8_LDA(At, 1, 0); PG8_STAGE_A(0, 1, a2, vs);
            PG8_WAIT_V(8); PG8_WAIT_L(0); PG8_BAR; PG8_MMA(0, 0, At, B0); PG8_MMA(0, 1, At, B1); PG8_BAR; PG8_SCHED;
            PG8_LDA(At, 1, 1); PG8_STAGE(PG8_SB(1, 0), b3, voffB); PG8_STAGE(PG8_SB(1, 1), b3 + hstep, voffB); PG8_STAGE_A(1, 0, a3, vs);
            PG8_WAIT_V(8); PG8_WAIT_L(0); PG8_BAR; PG8_MMA(1, 0, At, B0); PG8_MMA(1, 1, At, B1); PG8_BAR; PG8_SCHED;
            } else {
            PG8_LDB(B0, 0, 0); PG8_SCHED; PG8_LDA(At, 0, 0); PG8_STAGE_A(1, 1, a1, vc);
            PG8_WAIT_L(8); PG8_BAR; PG8_WAIT_L(0); PG8_MMA(0, 0, At, B0); PG8_BAR; PG8_SCHED;
            PG8_LDB(B1, 0, 1); PG8_STAGE(PG8_SB(0, 0), b2, voffB);
            PG8_BAR; PG8_WAIT_L(0); PG8_MMA(0, 1, At, B1); PG8_BAR;
            PG8_LDA(At, 0, 1); PG8_STAGE_A(0, 0, a2, vs);
            PG8_BAR; PG8_WAIT_L(0); PG8_MMA(1, 0, At, B0); PG8_BAR; PG8_SCHED;
            PG8_STAGE(PG8_SB(0, 1), b2 + hstep, voffB);
            PG8_WAIT_V(6); PG8_BAR; PG8_MMA(1, 1, At, B1); PG8_BAR;
            PG8_LDB(B0, 1, 0); PG8_SCHED; PG8_LDA(At, 1, 0); PG8_STAGE_A(0, 1, a2, vs);
            PG8_WAIT_L(8); PG8_BAR; PG8_WAIT_L(0); PG8_MMA(0, 0, At, B0); PG8_BAR; PG8_SCHED;
            PG8_LDB(B1, 1, 1); PG8_STAGE(PG8_SB(1, 0), b3, voffB);
            PG8_BAR; PG8_WAIT_L(0); PG8_MMA(0, 1, At, B1); PG8_BAR;
            PG8_LDA(At, 1, 1); PG8_STAGE_A(1, 0, a3, vs);
            PG8_BAR; PG8_WAIT_L(0); PG8_MMA(1, 0, At, B0); PG8_BAR; PG8_SCHED;
            PG8_STAGE(PG8_SB(1, 1), b3 + hstep, voffB);
            PG8_WAIT_V(6); PG8_BAR; PG8_MMA(1, 1, At, B1); PG8_BAR;
            }
        }
        if constexpr (ALIGN_EPI) { if (wr == 0) PG8_BAR; }
        if constexpr (!Epi::AFTER_DRAIN) { E(acc, cur, wr, wc, fr, fq); S.done(cur); }
        if (!has_next) break;
#pragma unroll
        for (int a = 0; a < 2; ++a)
#pragma unroll
            for (int b = 0; b < 2; ++b)
#pragma unroll
                for (int m = 0; m < 4; ++m)
#pragma unroll
                    for (int n = 0; n < 2; ++n) acc[a][b][m][n] = (f32x4){0.f, 0.f, 0.f, 0.f};
        cur = nxt; cA = nA; cB = nB; ++ui;
        if constexpr (GATHER) { _Pragma("unroll") for (int h_ = 0; h_ < 2; ++h_) _Pragma("unroll") for (int i_ = 0; i_ < 2; ++i_) vc[h_][i_] = vn[h_][i_]; }
        if constexpr (ALIGN_EPI) { if (wr == 1) PG8_BAR; }
    }
    PG8_WAIT_V(0);
    if constexpr (!ALIGN_EPI) { if (wr == 0) PG8_BAR; }
    PG8_BAR;
    if constexpr (Epi::AFTER_DRAIN) { E.fused(acc, cur, wr, wc, fr, fq, lds, wid, lane); S.done(cur); }
#undef PG8_SA
#undef PG8_SB
#undef PG8_STAGE
#undef PG8_STAGE_A
#undef PG8_LOADROWS
#undef PG8_LDA
#undef PG8_LDB
#undef PG8_MMA
#undef PG8_WAIT_V
#undef PG8_WAIT_L
#undef PG8_BAR
#undef PG8_SCHED
}
}
namespace mk {
constexpr int D = 1024, SEQ = 8192, NBMAX = 4, NH = 4, DIN = 5152, NE = 32, DE = 512, DEPTH = 2;
constexpr int NT_IN = 22, NIN = NT_IN * 256;
constexpr int NWAVES = 8, NTHR = 512;
#ifndef MK_MOE_FP8
#define MK_MOE_FP8 0
#endif
constexpr float WSCALE = 16.f, ASCALE = 4.f, YSCALE = 32.f;
constexpr float LOG2E = 1.4426950408889634f, QSCALE = 0.125f * LOG2E, RMS_EPS = 1e-6f;
constexpr int O_GQ = 0, O_GK = 256, O_GV = 512, O_GG = 1024, O_LRF = 1536, O_LRB = 1552, O_DQ = 1568, O_DK = 2080, O_DV = 2592, O_GA = 3104, O_GB = 4128;
typedef unsigned short bf16;
typedef unsigned u32x4 __attribute__((ext_vector_type(4)));
typedef unsigned u32x2 __attribute__((ext_vector_type(2)));
typedef float f32x4 __attribute__((ext_vector_type(4)));
typedef float f32x16 __attribute__((ext_vector_type(16)));
typedef short bf16x8 __attribute__((ext_vector_type(8)));
typedef short s16x4 __attribute__((ext_vector_type(4)));
#define LAS __attribute__((address_space(3)))
#define GAS __attribute__((address_space(1)))
#define LDS_WAIT() asm volatile("s_waitcnt lgkmcnt(0)" ::: "memory")
#define VM_WAIT() asm volatile("s_waitcnt vmcnt(0)" ::: "memory")

constexpr size_t MiB = 1u << 20;
constexpr size_t CTL_BYTES = 256 * 1024;
constexpr int CW_BAR = 4096;
constexpr int CW_CNT = 32768;
constexpr size_t OFF_MOD = 256 * 1024, OFF_TAB = 512 * 1024;
constexpr size_t OFF_WIN = 1 * MiB, SZ_WIN = (size_t)DEPTH * NIN * D * 2;
constexpr size_t OFF_WAB = OFF_WIN + SZ_WIN, SZ_WAB = (size_t)DEPTH * D * D * 2;
constexpr size_t OFF_WO = OFF_WAB + SZ_WAB, SZ_WO = SZ_WAB;
constexpr size_t OFF_WR = OFF_WO + SZ_WO, SZ_WR = (size_t)DEPTH * 256 * D * 2;
constexpr size_t OFF_W1 = OFF_WR + SZ_WR, SZ_W1 = (size_t)DEPTH * NE * 1024 * D * 2;
constexpr size_t OFF_W2 = OFF_W1 + SZ_W1, SZ_W2 = (size_t)DEPTH * NE * D * DE * 2;
constexpr size_t OFF_ACT = 225 * MiB;
static_assert(OFF_W2 + SZ_W2 <= OFF_ACT, "weights fit");
struct WS {
    unsigned* ctl; float* mod; float* tab;
    bf16 *win, *wab, *wo, *wr, *w1, *w2;
    bf16 *H, *OAB, *XB; int* eid; float* gate; int* rank; int* pos; int* tilee; int* segp;
    bf16 *GQ, *GK, *GV, *SG; bf16 *LGF, *LGB; bf16 *DQ, *DK, *DV, *SGA, *SGB; float* KVT; float* DEC; bf16* MERGED;
    bf16 *XS, *ACT, *YS; float* LOGITS; float* gsort; int* stok;
    size_t end;
};
__host__ __device__ inline WS ws_map(unsigned char* b, int nb) {
    WS w; const size_t T = (size_t)nb * SEQ;
    w.ctl = (unsigned*)b; w.mod = (float*)(b + OFF_MOD); w.tab = (float*)(b + OFF_TAB);
    w.win = (bf16*)(b + OFF_WIN); w.wab = (bf16*)(b + OFF_WAB); w.wo = (bf16*)(b + OFF_WO); w.wr = (bf16*)(b + OFF_WR); w.w1 = (bf16*)(b + OFF_W1); w.w2 = (bf16*)(b + OFF_W2);
    size_t o = OFF_ACT;
    auto take = [&](size_t bytes) { unsigned char* p = b + o; o += (bytes + 255) & ~(size_t)255; return p; };
    w.H = (bf16*)take(T * 2048); w.OAB = (bf16*)take(T * 2048); w.XB = (bf16*)take(T * 2048);
    w.eid = (int*)take(T * 8); w.gate = (float*)take(T * 8); w.rank = (int*)take(T * 8); w.pos = (int*)take(T * 8); w.tilee = (int*)take(4096); w.segp = (int*)take(1024);
    const size_t u0 = o;
    w.GQ = (bf16*)take(T * 512); w.GK = (bf16*)take(T * 512); w.GV = (bf16*)take(T * 1024); w.SG = (bf16*)take(T * 1024);
    w.LGF = (bf16*)take(T * 512); w.LGB = (bf16*)take(T * 512);
    w.DQ = (bf16*)take(T * 1024); w.DK = (bf16*)take(T * 1024); w.DV = (bf16*)take(T * 1024); w.SGA = (bf16*)take(T * 2048); w.SGB = (bf16*)take(T * 2048);
    w.KVT = (float*)take(T * 4096); w.MERGED = (bf16*)w.KVT; w.DEC = (float*)take(T * 32);
    const size_t e1 = o; o = u0;
    const size_t R = 2 * T + 32 * 256;
    w.XS = (bf16*)take(R * 2048); w.ACT = (bf16*)take(R * 1024); w.YS = (bf16*)take(R * 2048); w.LOGITS = (float*)take(T * 256); w.gsort = (float*)take(R * 4); w.stok = (int*)take(R * 4);
    w.end = o > e1 ? o : e1;
    return w;
}

typedef float f32x2_t __attribute__((ext_vector_type(2))); typedef __bf16 bf16x2_t __attribute__((ext_vector_type(2)));
__device__ __forceinline__ unsigned cvt_pk(float lo, float hi) { const f32x2_t v = {lo, hi}; const bf16x2_t b = __builtin_convertvector(v, bf16x2_t); return __builtin_bit_cast(unsigned, b); }
__device__ __forceinline__ float bf2f(unsigned short b) { return __uint_as_float(((unsigned)b) << 16); }
__device__ __forceinline__ float bflo(unsigned w) { return __uint_as_float(w << 16); }
__device__ __forceinline__ float bfhi(unsigned w) { return __uint_as_float(w & 0xffff0000u); }
__device__ __forceinline__ float fsigmoid(float x) { return __builtin_amdgcn_rcpf(1.f + __expf(-x)); }
__device__ __forceinline__ float fsilu(float x) { return x * fsigmoid(x); }
__device__ __forceinline__ float fsigmoid255(float x) { return __builtin_amdgcn_rcpf(fmaf(__expf(-x), 1.f / 255.f, 1.f / 255.f)); }
__device__ __forceinline__ float wave_sum(float v) {
#pragma unroll
    for (int o = 1; o < 64; o <<= 1) v += __shfl_xor(v, o);
    return v;
}
__device__ __forceinline__ int t5_bucket(int rel) {
    int ret = rel > 0 ? 16 : 0; int n = rel < 0 ? -rel : rel;
    if (n < 8) return ret + n;
    return ret + 8 + (n >= 12) + (n >= 16) + (n >= 23) + (n >= 32) + (n >= 46) + (n >= 64) + (n >= 91);
}

#define XB_TMO      128
#define XB_XCNT(j)  (256  + 64 * (j))
#define XB_XSUB(j)  (1280 + 64 * (j))
#define XB_XGEN(j)  (2304 + 64 * (j))
#define XB_TOP      3328
#define XB_TOPGEN   3392
#define XCD_BAR_WORDS 3456
#define XB_SPIN_CAP (1u << 18)
__device__ __forceinline__ unsigned xb_ld(unsigned* p)              { return __hip_atomic_load(p, __ATOMIC_RELAXED, __HIP_MEMORY_SCOPE_AGENT); }
__device__ __forceinline__ unsigned xb_add(unsigned* p, unsigned v) { return __hip_atomic_fetch_add(p, v, __ATOMIC_RELAXED, __HIP_MEMORY_SCOPE_AGENT); }
__device__ __forceinline__ unsigned xb_xcc_id() { return (unsigned)__builtin_amdgcn_s_getreg((3 << 11) | 20) & 0xFu; }
#define XB_SPIN(cond, bar) do { unsigned _sp = 0; while (cond) { __builtin_amdgcn_s_sleep(1); \
    if ((++_sp & 255u) == 0u) { if (xb_ld(&(bar)[XB_TMO])) break; if (_sp > XB_SPIN_CAP) { atomicAdd(&(bar)[XB_TMO], 1u); break; } } } } while (0)
struct XcdBarrier { unsigned* bar; unsigned x; volatile LAS unsigned* st; };
__device__ __forceinline__ XcdBarrier xcd_barrier_post(unsigned* bar, volatile LAS unsigned* st) {
    XcdBarrier b; b.bar = bar; b.x = xb_xcc_id(); b.st = st;
    if (threadIdx.x == 0) (void)xb_add(&bar[XB_XCNT(b.x)], 1u);
    return b;
}
__device__ __forceinline__ void xcd_barrier_complete(unsigned* bar, unsigned x, unsigned& nloc, unsigned& nx) {
    const unsigned G = gridDim.x * gridDim.y * gridDim.z;
    unsigned sum, cnt, mine, sp = 0u;
    for (;;) {
        sum = 0u; cnt = 0u; mine = 0u;
#pragma unroll
        for (unsigned j = 0; j < 16; ++j) { const unsigned c = xb_ld(&bar[XB_XCNT(j)]); sum += c; cnt += (c > 0u) ? 1u : 0u; mine = (j == x) ? c : mine; }
        if (sum == G) break;
        __builtin_amdgcn_s_sleep(1);
        if ((++sp & 255u) == 0u) { if (xb_ld(&bar[XB_TMO])) break; if (sp > XB_SPIN_CAP) { atomicAdd(&bar[XB_TMO], 1u); break; } }
    }
    nloc = mine > 0u ? mine : 1u; nx = cnt > 0u ? cnt : 1u;
}
__device__ __forceinline__ void xcd_barrier(const XcdBarrier& b) {
    asm volatile("s_waitcnt vmcnt(0)" ::: "memory");
    __syncthreads();
    if (threadIdx.x == 0) {
        unsigned* bar = b.bar;
        __builtin_amdgcn_s_waitcnt(0);
        unsigned nloc = b.st[0], nx = b.st[1];
        if (nloc == 0u) { xcd_barrier_complete(bar, b.x, nloc, nx); b.st[0] = nloc; b.st[1] = nx; }
        const unsigned old = xb_add(&bar[XB_XSUB(b.x)], 1u);
        const unsigned gen = old / nloc;
        if (old + 1u == (gen + 1u) * nloc) {
            __builtin_amdgcn_fence(__ATOMIC_RELEASE, "agent");
            asm volatile("s_waitcnt vmcnt(0)" ::: "memory");
            const unsigned og = xb_add(&bar[XB_TOP], 1u);
            const unsigned tg = og / nx;
            if (og + 1u == (tg + 1u) * nx) xb_add(&bar[XB_TOPGEN], 1u);
            else XB_SPIN(xb_ld(&bar[XB_TOPGEN]) == tg, bar);
            __builtin_amdgcn_fence(__ATOMIC_ACQUIRE, "agent");
            xb_add(&bar[XB_XGEN(b.x)], 1u);
            asm volatile("s_waitcnt vmcnt(0)" ::: "memory");
        } else {
            XB_SPIN(xb_ld(&bar[XB_XGEN(b.x)]) == gen, bar);
            __builtin_amdgcn_fence(__ATOMIC_ACQUIRE, "agent");
            asm volatile("s_waitcnt vmcnt(0)" ::: "memory");
        }
    }
    __syncthreads();
}

struct Args { const float* in[24]; float* out; unsigned char* ws; int nb, ph_lo, ph_hi, li; };
struct Frame {
    LAS unsigned char* lds; int tid, lane, wave, G, bid, nb, T; unsigned char* ws; const Args* a; float* xbuf;
};
__device__ __forceinline__ void refresh(Frame& F) { int t = threadIdx.x; asm volatile("" : "+v"(t)); F.tid = t; F.lane = t & 63; F.wave = __builtin_amdgcn_readfirstlane(t >> 6); }
constexpr int LDS_BYTES = 160 * 1024 - 64 * 0;
constexpr int LDS_MISC = 160 * 1024 - 256;

__device__ __forceinline__ void tr_item(const float* src, int lds_, int ks0, int c0, bf16* dst, int ldd, int r0, int kd0, LAS float* scr, int lane, float scale = 1.f) {
#pragma unroll 8
    for (int i = 0; i < 32; ++i) { const int kk = 2 * i + (lane >> 5); scr[kk * 33 + (lane & 31)] = src[(size_t)(ks0 + kk) * lds_ + c0 + (lane & 31)] * scale; }
    LDS_WAIT(); asm volatile("" ::: "memory");
    const int c = lane & 7;
#pragma unroll
    for (int j = 0; j < 4; ++j) { const int n = (lane >> 3) + 8 * j; const LAS float* s = scr + (8 * c) * 33 + n;
        u32x4 o; o.x = cvt_pk(s[0 * 33], s[1 * 33]); o.y = cvt_pk(s[2 * 33], s[3 * 33]); o.z = cvt_pk(s[4 * 33], s[5 * 33]); o.w = cvt_pk(s[6 * 33], s[7 * 33]);
        *(u32x4*)(dst + (size_t)(r0 + n) * ldd + kd0 + 8 * c) = o; }
    LDS_WAIT(); asm volatile("" ::: "memory");
}
__device__ __forceinline__ void tr_item8(const float* src, int lds_, int ks0, int c0, unsigned char* dst, int ldd, int r0, int kd0, float scale, LAS float* scr, int lane) {
#pragma unroll 8
    for (int i = 0; i < 32; ++i) { const int kk = 2 * i + (lane >> 5); scr[kk * 33 + (lane & 31)] = src[(size_t)(ks0 + kk) * lds_ + c0 + (lane & 31)] * scale; }
    LDS_WAIT(); asm volatile("" ::: "memory");
    const int c = lane & 7;
#pragma unroll
    for (int j = 0; j < 4; ++j) { const int n = (lane >> 3) + 8 * j; const LAS float* s = scr + (8 * c) * 33 + n;
        int w0 = 0, w1 = 0;
        w0 = __builtin_amdgcn_cvt_pk_fp8_f32(s[0 * 33], s[1 * 33], w0, false); w0 = __builtin_amdgcn_cvt_pk_fp8_f32(s[2 * 33], s[3 * 33], w0, true);
        w1 = __builtin_amdgcn_cvt_pk_fp8_f32(s[4 * 33], s[5 * 33], w1, false); w1 = __builtin_amdgcn_cvt_pk_fp8_f32(s[6 * 33], s[7 * 33], w1, true);
        u32x2 o; o.x = (unsigned)w0; o.y = (unsigned)w1;
        *(u32x2*)(dst + (size_t)(r0 + n) * ldd + kd0 + 8 * c) = o; }
    LDS_WAIT(); asm volatile("" ::: "memory");
}
__device__ __forceinline__ int win_src_col(int tile, int p0) {
    const int bj = p0 >> 7, wc = (p0 >> 5) & 3; const int L = 64 * wc + 32 * bj;
    switch (tile) {
        case 0: return O_GQ + p0; case 1: return O_GK + p0;
        case 2: case 3: return O_GV + (tile - 2) * 256 + p0;
        case 4: case 5: return O_GG + (tile - 4) * 256 + p0;
        case 8: case 9: return O_DQ + (tile - 8) * 256 + L;
        case 10: case 11: return O_DK + (tile - 10) * 256 + L;
        case 12: case 13: return O_DV + (tile - 12) * 256 + p0;
        case 14: case 15: case 16: case 17: return O_GA + (tile - 14) * 256 + p0;
        default: return O_GB + (tile - 18) * 256 + p0;
    }
}
__device__ __forceinline__ void p0_prologue(Frame& F) {
    refresh(F);
    const WS W = ws_map(F.ws, F.nb); const float* const* IN_ = F.a->in;
    const float* c_in = IN_[1]; const float* w_ada = IN_[2]; const float* b_ada = IN_[3];
    {
        LAS float* red = (LAS float*)F.lds;
        for (int it = F.bid; it < DEPTH * 96; it += F.G) {
            const int l = it / 96, j = (it % 96) * 64 + F.lane;
            const float* w = w_ada + (size_t)l * D * 6 * D + j;
            float a0 = 0.f, a1 = 0.f, a2 = 0.f, a3 = 0.f;
            const int kbeg = F.wave * 128;
#pragma unroll 16
            for (int k = kbeg; k < kbeg + 128; ++k) { const float wv = w[(size_t)k * 6 * D];
                const float c0 = c_in[k], c1 = c_in[D + k], c2 = c_in[2 * D + k], c3 = c_in[3 * D + k];
                a0 += fsilu(c0) * wv; a1 += fsilu(c1) * wv; a2 += fsilu(c2) * wv; a3 += fsilu(c3) * wv; }
            red[(F.wave * 4 + 0) * 64 + F.lane] = a0; red[(F.wave * 4 + 1) * 64 + F.lane] = a1; red[(F.wave * 4 + 2) * 64 + F.lane] = a2; red[(F.wave * 4 + 3) * 64 + F.lane] = a3;
            __syncthreads();
            if (F.tid < 256) { const int b = F.tid >> 6, jj = F.tid & 63; float s = 0.f;
#pragma unroll
                for (int wv = 0; wv < 8; ++wv) s += red[(wv * 4 + b) * 64 + jj];
                const int jc = (it % 96) * 64 + jj;
                W.mod[((size_t)l * NBMAX + b) * 6 * D + jc] = s + b_ada[l * 6 * D + jc]; }
            __syncthreads();
        }
    }
    if (F.bid == 0) {
        const float* rb = IN_[14];
        for (int i = F.tid; i < 1024; i += NTHR) { const int h = i >> 8, rel = (i & 255) - 128; W.tab[i] = (rb[t5_bucket(rel) * 4 + h] - rb[31 * 4 + h]) * LOG2E; }
        if (F.tid < 4) W.tab[1024 + F.tid] = __expf(rb[15 * 4 + F.tid] - rb[31 * 4 + F.tid]);
        if (F.tid >= 64 && F.tid < 64 + DEPTH) { const int l = F.tid - 64; const float* lv = IN_[12] + l * 256; float s1 = 0.f, s2 = 0.f;
            for (int i = 0; i < 64; ++i) { s1 += lv[i] * lv[64 + i]; s2 += lv[128 + i] * lv[192 + i]; }
            W.tab[1032 + l] = expf(s1) - expf(s2) + (0.8f - 0.6f * expf(-0.3f * (float)l)); }
    }
    __syncthreads();
    LAS float* scr = (LAS float*)(F.lds + F.wave * 16384);
    const int gw = F.bid * NWAVES + F.wave, NGW = F.G * NWAVES;
    constexpr int I_IN = (NIN / 32) * 16, I_AB = 32 * 16, I_O = 32 * 16, I_1 = NE * 32 * 16, I_2 = NE * 32 * 8;
    constexpr int PER_L = I_IN + I_AB + I_O + I_1 + I_2;
    for (int it = gw; it < DEPTH * PER_L; it += NGW) {
        const int l = it / PER_L; int r = it % PER_L;
        if (r < I_IN) { const int rb = r / 16, kb = r % 16, R = rb * 32, tile = R >> 8, p0 = R & 255;
            if (tile == 6 || tile == 7) continue;
            tr_item(IN_[6] + (size_t)l * D * DIN, DIN, kb * 64, win_src_col(tile, p0), W.win + (size_t)l * NIN * D, D, R, kb * 64, scr, F.lane); continue; }
        r -= I_IN;
        if (r < I_AB) { const int rb = r / 16, kb = r % 16;
            if (kb < 8) tr_item(IN_[15] + (size_t)l * 512 * D, D, kb * 64, rb * 32, W.wab + (size_t)l * D * D, 512, rb * 32, kb * 64, scr, F.lane, 1.f / 255.f);
            else tr_item(IN_[16] + (size_t)l * 512 * D, D, (kb - 8) * 64, rb * 32, W.wab + (size_t)l * D * D + (size_t)1024 * 512, 512, rb * 32, (kb - 8) * 64, scr, F.lane, 1.f / 255.f);
            continue; }
        r -= I_AB;
        if (r < I_O) { const int rb = r / 16, kb = r % 16; tr_item(IN_[17] + (size_t)l * D * D, D, kb * 64, rb * 32, W.wo + (size_t)l * D * D, D, rb * 32, kb * 64, scr, F.lane); continue; }
        r -= I_O;
        if (r < I_1) { const int e = r / 512, q = r % 512, rb = q / 16, kb = q % 16, R = rb * 32, pn = R >> 8, p = R & 255;
            const int col = (p < 128) ? (128 * pn + p) : (512 + 128 * pn + p - 128);
#if MK_MOE_FP8
            tr_item8(IN_[22] + ((size_t)l * NE + e) * D * 1024, 1024, kb * 64, col, (unsigned char*)W.w1 + ((size_t)l * NE + e) * 1024 * D, D, R, kb * 64, WSCALE, scr, F.lane); continue; }
#else
            tr_item(IN_[22] + ((size_t)l * NE + e) * D * 1024, 1024, kb * 64, col, W.w1 + ((size_t)l * NE + e) * 1024 * D, D, R, kb * 64, scr, F.lane); continue; }
#endif
        r -= I_1;
        { const int e = r / 256, q = r % 256, rb = q / 8, kb = q % 8;
#if MK_MOE_FP8
          tr_item8(IN_[23] + ((size_t)l * NE + e) * DE * D, D, kb * 64, rb * 32, (unsigned char*)W.w2 + ((size_t)l * NE + e) * D * DE, DE, rb * 32, kb * 64, WSCALE, scr, F.lane); }
#else
          tr_item(IN_[23] + ((size_t)l * NE + e) * DE * D, D, kb * 64, rb * 32, W.w2 + ((size_t)l * NE + e) * D * DE, DE, rb * 32, kb * 64, scr, F.lane); }
#endif
    }
    for (int it = gw; it < DEPTH * 2 * 8 * 16; it += NGW) {
        const int l = it >> 8, dir = (it >> 7) & 1, nbk = (it >> 4) & 7, kb = it & 15; const int k = kb * 64 + F.lane;
        const float* wi = IN_[6] + (size_t)l * D * DIN + (size_t)k * DIN + (dir ? O_LRB : O_LRF);
        float wv[16];
#pragma unroll
        for (int r = 0; r < 16; ++r) wv[r] = wi[r];
        const float* wu = IN_[7] + ((size_t)l * 2 + dir) * 16 * 256;
        bf16* dst = W.win + (size_t)l * NIN * D + (size_t)((6 + dir) * 256) * D;
        for (int n = nbk * 32; n < nbk * 32 + 32; ++n) { float s = 0.f;
#pragma unroll
            for (int r = 0; r < 16; ++r) s += wv[r] * wu[r * 256 + n];
            dst[(size_t)n * D + k] = (bf16)(cvt_pk(s, 0.f) & 0xffffu); }
    }
    for (int it = gw * 64 + F.lane; it < DEPTH * 256 * 128; it += NGW * 64) {
        const int l = it / (256 * 128), q = it % (256 * 128), row = q >> 7, k0 = (q & 127) * 8;
        float v[8];
#pragma unroll
        for (int i = 0; i < 8; ++i) { float x = 0.f;
            if (row < 4) x = IN_[18][((size_t)l * D + k0 + i) * 4 + row]; else if (row < 36) x = IN_[20][((size_t)l * D + k0 + i) * 32 + row - 4];
            v[i] = x; }
        u32x4 o; o.x = cvt_pk(v[0], v[1]); o.y = cvt_pk(v[2], v[3]); o.z = cvt_pk(v[4], v[5]); o.w = cvt_pk(v[6], v[7]);
        *(u32x4*)(W.wr + ((size_t)l * 256 + row) * D + k0) = o;
    }
}

__device__ __forceinline__ void phase_norm(Frame& F, int l, int mode) {
    refresh(F);
    const WS W = ws_map(F.ws, F.nb); const float* const* IN_ = F.a->in;
    const int gw = F.bid * NWAVES + F.wave, NGW = F.G * NWAVES;
    const bool combine = (mode == 2) || (mode == 0 && l > 0);
    const bool from_in = (mode == 0 && l == 0);
    const int lp = (mode == 2) ? DEPTH - 1 : l - 1;
    const float* ng = (mode == 1 ? IN_[5] : IN_[4]) + (size_t)(mode == 2 ? 0 : l) * D;
    for (int t = gw; t < F.T; t += NGW) {
        const int b = t / SEQ;
        f32x4 v[4];
        if (from_in) { const GAS f32x4* xr = (const GAS f32x4*)(IN_[0] + (size_t)t * D) + F.lane;
#pragma unroll
            for (int j = 0; j < 4; ++j) v[j] = xr[64 * j]; }
        else { const GAS u32x2* xr = (const GAS u32x2*)(W.XB + (size_t)t * D) + F.lane;
#pragma unroll
            for (int j = 0; j < 4; ++j) { const u32x2 a = xr[64 * j]; v[j] = (f32x4){bflo(a.x), bfhi(a.x), bflo(a.y), bfhi(a.y)}; } }
        if (combine) {
            const float* g2 = W.mod + ((size_t)lp * NBMAX + b) * 6 * D + 5 * D;
            const int p0 = W.pos[t * 2], p1 = W.pos[t * 2 + 1];
            const GAS unsigned* y0 = (const GAS unsigned*)((const unsigned char*)W.YS + (size_t)p0 * D) + F.lane; const GAS unsigned* y1 = (const GAS unsigned*)((const unsigned char*)W.YS + (size_t)p1 * D) + F.lane;
#pragma unroll
            for (int j = 0; j < 4; ++j) { const unsigned a = y0[64 * j], c = y1[64 * j]; const f32x4 g = *((const GAS f32x4*)g2 + F.lane + 64 * j) * (1.f / YSCALE);
                v[j].x += g.x * (__builtin_amdgcn_cvt_f32_fp8((int)a, 0) + __builtin_amdgcn_cvt_f32_fp8((int)c, 0)); v[j].y += g.y * (__builtin_amdgcn_cvt_f32_fp8((int)a, 1) + __builtin_amdgcn_cvt_f32_fp8((int)c, 1));
                v[j].z += g.z * (__builtin_amdgcn_cvt_f32_fp8((int)a, 2) + __builtin_amdgcn_cvt_f32_fp8((int)c, 2)); v[j].w += g.w * (__builtin_amdgcn_cvt_f32_fp8((int)a, 3) + __builtin_amdgcn_cvt_f32_fp8((int)c, 3)); }
            if (mode == 2) { GAS f32x4* xo = (GAS f32x4*)(F.xbuf + (size_t)t * D) + F.lane;
#pragma unroll
                for (int j = 0; j < 4; ++j) xo[64 * j] = v[j]; }
            else { GAS u32x2* xo = (GAS u32x2*)(W.XB + (size_t)t * D) + F.lane;
#pragma unroll
                for (int j = 0; j < 4; ++j) { u32x2 o; o.x = cvt_pk(v[j].x, v[j].y); o.y = cvt_pk(v[j].z, v[j].w); xo[64 * j] = o; } }
        }
        if (mode == 2) continue;
        float ss = 0.f;
#pragma unroll
        for (int j = 0; j < 4; ++j) ss += (v[j].x * v[j].x + v[j].y * v[j].y) + (v[j].z * v[j].z + v[j].w * v[j].w);
        const float rstd = rsqrtf(wave_sum(ss) * (1.f / D) + RMS_EPS);
        const float* md = W.mod + ((size_t)l * NBMAX + b) * 6 * D + (mode == 1 ? 3 * D : 0);
        GAS u32x2* ho = (GAS u32x2*)(W.H + (size_t)t * D) + F.lane;
#pragma unroll
        for (int j = 0; j < 4; ++j) { const f32x4 g = *((const GAS f32x4*)ng + F.lane + 64 * j), sh = *((const GAS f32x4*)md + F.lane + 64 * j), sc = *((const GAS f32x4*)(md + D) + F.lane + 64 * j);
            const float h0 = v[j].x * rstd * g.x * (1.f + sc.x) + sh.x, h1 = v[j].y * rstd * g.y * (1.f + sc.y) + sh.y, h2 = v[j].z * rstd * g.z * (1.f + sc.z) + sh.z, h3 = v[j].w * rstd * g.w * (1.f + sc.w) + sh.w;
            u32x2 o; o.x = cvt_pk(h0, h1); o.y = cvt_pk(h2, h3); ho[64 * j] = o; }
    }
}
typedef pg8::Unit Unit;
__device__ __forceinline__ u32x4 pack8(const f32x4& a, const f32x4& b) { u32x4 w; w.x = cvt_pk(a[0], a[1]); w.y = cvt_pk(a[2], a[3]); w.z = cvt_pk(b[0], b[1]); w.w = cvt_pk(b[2], b[3]); return w; }

#ifndef MK_ATT_FP8
#define MK_ATT_FP8 1
#endif
__device__ __forceinline__ u32x2 pack8_fp8(const f32x4& a, const f32x4& b) { int w0 = 0, w1 = 0;
    w0 = __builtin_amdgcn_cvt_pk_fp8_f32(a[0], a[1], w0, false); w0 = __builtin_amdgcn_cvt_pk_fp8_f32(a[2], a[3], w0, true);
    w1 = __builtin_amdgcn_cvt_pk_fp8_f32(b[0], b[1], w1, false); w1 = __builtin_amdgcn_cvt_pk_fp8_f32(b[2], b[3], w1, true);
    u32x2 r; r.x = (unsigned)w0; r.y = (unsigned)w1; return r; }
struct EpiNull {
    static constexpr bool PERM = true, AFTER_DRAIN = false, MIDK = false;
    __device__ __forceinline__ void operator()(const f32x4 (&acc)[2][2][4][2], const Unit&, int, int, int, int) const {
#pragma unroll
        for (int a = 0; a < 2; ++a)
#pragma unroll
            for (int b = 0; b < 2; ++b)
#pragma unroll
                for (int m = 0; m < 4; ++m) { asm volatile("" :: "v"(acc[a][b][m][0]), "v"(acc[a][b][m][1])); } }
};
struct EpiIn {
    static constexpr bool PERM = true, AFTER_DRAIN = false, MIDK = false;
    bf16 *GQ, *GK, *GV, *SG, *LGF, *LGB, *DQ, *DK, *DV, *SGA, *SGB; const float* b_up; const float* qg; const float* kg; int plain;
    __device__ __forceinline__ void operator()(const f32x4 (&acc)[2][2][4][2], const Unit& u, int wr, int wc, int fr, int fq) const {
        const int pn = u.pn; const int row0 = u.pm * 256 + wr * 64 + fr;
        if (pn >= 8 && pn <= 11) {
            const bool isk = pn >= 10; const int head = 2 * ((pn - 8) & 1) + (wc >> 1), c = wc & 1;
            const float* gv = isk ? kg : qg; const float sc = isk ? 1.f : QSCALE;
            f32x4 g[2][2];
#pragma unroll
            for (int bj = 0; bj < 2; ++bj)
#pragma unroll
                for (int n = 0; n < 2; ++n) g[bj][n] = *(const f32x4*)(gv + 32 * bj + 8 * fq + 4 * n);
#pragma unroll
            for (int ai = 0; ai < 2; ++ai)
#pragma unroll
                for (int m = 0; m < 4; ++m) {
                    const int r = row0 + ai * 128 + m * 16, b = r / SEQ, s = r % SEQ;
                    float ss = 0.f;
#pragma unroll
                    for (int bj = 0; bj < 2; ++bj)
#pragma unroll
                        for (int n = 0; n < 2; ++n) { const f32x4 x = acc[ai][bj][m][n]; ss += (x[0] * x[0] + x[1] * x[1]) + (x[2] * x[2] + x[3] * x[3]); }
                    ss += __shfl_xor(ss, 16); ss += __shfl_xor(ss, 32);
                    const float rs = rsqrtf(ss * (1.f / 64.f) + RMS_EPS) * sc;
#if MK_ATT_FP8
                    unsigned char* dst8 = (unsigned char*)(isk ? DK : DQ) + ((((size_t)b * NH + head) * 2 + c) * SEQ + s) * 64;
#pragma unroll
                    for (int bj = 0; bj < 2; ++bj) {
                        const f32x4 v0 = acc[ai][bj][m][0] * rs * g[bj][0], v1 = acc[ai][bj][m][1] * rs * g[bj][1];
                        int chunk = 2 * bj + (fq >> 1); if (isk) chunk ^= ((s >> 2) & 3);
                        *(u32x2*)(dst8 + chunk * 16 + 8 * (fq & 1)) = pack8_fp8(v0, v1);
                    }
#else
                    bf16* dst = (isk ? DK : DQ) + ((((size_t)b * NH + head) * 2 + c) * SEQ + s) * 64;
#pragma unroll
                    for (int bj = 0; bj < 2; ++bj) {
                        const f32x4 v0 = acc[ai][bj][m][0] * rs * g[bj][0], v1 = acc[ai][bj][m][1] * rs * g[bj][1];
                        int chunk = 4 * bj + fq; if (isk) chunk ^= ((s >> 1) & 7);
                        *(u32x4*)(dst + chunk * 8) = pack8(v0, v1);
                    }
#endif
                }
            return;
        }
#pragma unroll
        for (int ai = 0; ai < 2; ++ai)
#pragma unroll
            for (int m = 0; m < 4; ++m) {
                const int r = row0 + ai * 128 + m * 16;
#pragma unroll
                for (int bj = 0; bj < 2; ++bj) {
                    const int c0 = 128 * bj + 32 * wc + 8 * fq;
                    f32x4 v0 = acc[ai][bj][m][0], v1 = acc[ai][bj][m][1];
                    if (plain) { *(u32x4*)(SGA + (size_t)r * D + (pn & 3) * 256 + c0) = pack8(v0, v1); }
                    else if (pn == 0) { *(u32x4*)(GQ + (size_t)r * 256 + c0) = pack8(v0 * 0.125f, v1 * 0.125f); }
                    else if (pn == 1) { *(u32x4*)(GK + (size_t)r * 256 + c0) = pack8(v0, v1); }
                    else if (pn <= 3) { *(u32x4*)(GV + (size_t)r * 512 + (pn - 2) * 256 + c0) = pack8(v0, v1); }
                    else if (pn <= 5) {
#pragma unroll
                        for (int i = 0; i < 4; ++i) { v0[i] = fsilu(v0[i]); v1[i] = fsilu(v1[i]); }
                        *(u32x4*)(SG + (size_t)r * 512 + (pn - 4) * 256 + c0) = pack8(v0, v1); }
                    else if (pn <= 7) {
                        const float* bu = b_up + (pn - 6) * 256 + c0; const f32x4 b0 = *(const f32x4*)bu, b1 = *(const f32x4*)(bu + 4);
#pragma unroll
                        for (int i = 0; i < 4; ++i) { float z = v0[i] + b0[i]; v0[i] = (fminf(z, 0.f) - __logf(1.f + __expf(-fabsf(z)))) * (1.f / 16.f);
                                                      z = v1[i] + b1[i]; v1[i] = (fminf(z, 0.f) - __logf(1.f + __expf(-fabsf(z)))) * (1.f / 16.f); }
                        *(u32x4*)((pn == 6 ? LGF : LGB) + (size_t)r * 256 + c0) = pack8(v0, v1); }
#if MK_ATT_FP8
                    else if (pn <= 13) {
                        const int b = r / SEQ, s = r % SEQ, head = 2 * (pn - 12) + bj;
                        const int kk = s & 63, wkey = kk & 31, hh_ = (wkey >> 2) & 1, reg_ = (wkey & 3) + 4 * (wkey >> 3), pos = hh_ * 32 + 16 * (kk >> 5) + reg_;
                        unsigned char* tb = (unsigned char*)DV + (((size_t)b * NH + head) * (SEQ / 64) + (s >> 6)) * 8192;
                        const u32x2 pk = pack8_fp8(v0, v1); const int dv0 = 32 * wc + 8 * fq;
#pragma unroll
                        for (int i = 0; i < 8; ++i) { const int dv = dv0 + i; const unsigned byte = ((i < 4 ? pk.x : pk.y) >> (8 * (i & 3))) & 0xffu;
                            tb[dv * 64 + ((((pos >> 4) ^ ((dv >> 2) & 3)) << 4) | (pos & 15))] = (unsigned char)byte; } }
#else
                    else if (pn <= 13) {
                        const int b = r / SEQ, s = r % SEQ, head = 2 * (pn - 12) + bj;
                        bf16* dst = DV + ((((size_t)b * NH + head) * (SEQ / 8) + (s >> 3)) * 4 + wc) * 256 + (s & 7) * 32 + 8 * fq;
                        *(u32x4*)dst = pack8(v0, v1); }
#endif
                    else {
#pragma unroll
                        for (int i = 0; i < 4; ++i) { v0[i] = fsigmoid255(v0[i]); v1[i] = fsigmoid255(v1[i]); }
                        unsigned char* base = (pn <= 17) ? (unsigned char*)SGA + (pn - 14) * 256 : (unsigned char*)SGB + (pn - 18) * 256;
                        u32x2 q; q.x = 0u; q.y = 0u;
                        q.x = __builtin_amdgcn_cvt_pk_u8_f32(v0[0], 0, q.x); q.x = __builtin_amdgcn_cvt_pk_u8_f32(v0[1], 1, q.x); q.x = __builtin_amdgcn_cvt_pk_u8_f32(v0[2], 2, q.x); q.x = __builtin_amdgcn_cvt_pk_u8_f32(v0[3], 3, q.x);
                        q.y = __builtin_amdgcn_cvt_pk_u8_f32(v1[0], 0, q.y); q.y = __builtin_amdgcn_cvt_pk_u8_f32(v1[1], 1, q.y); q.y = __builtin_amdgcn_cvt_pk_u8_f32(v1[2], 2, q.y); q.y = __builtin_amdgcn_cvt_pk_u8_f32(v1[3], 3, q.y);
                        *(u32x2*)(base + (size_t)r * D + c0) = q; }
                }
            }
    }
};

struct EpiMerge {
    static constexpr bool PERM = true, AFTER_DRAIN = false, MIDK = false;
    const bf16* SGA; const bf16* SGB; bf16* O; int nM;
    __device__ __forceinline__ void operator()(const f32x4 (&acc)[2][2][4][2], const Unit& u, int wr, int wc, int fr, int fq) const {
        const int sel = u.pn >> 2; const int row0 = (u.pm - sel * nM) * 256 + wr * 64 + fr, col0 = (u.pn & 3) * 256 + wc * 32 + 8 * fq;
        const unsigned char* G = (const unsigned char*)(sel ? SGB : SGA);
#pragma unroll
        for (int ai = 0; ai < 2; ++ai) {
            u32x2 gt[4][2]; u32x4 t1[4][2];
#pragma unroll
            for (int m = 0; m < 4; ++m) { const size_t off = (size_t)(row0 + ai * 128 + m * 16) * D + col0;
#pragma unroll
                for (int bj = 0; bj < 2; ++bj) { gt[m][bj] = *(const u32x2*)(G + off + bj * 128); if (sel) t1[m][bj] = *(const u32x4*)(O + off + bj * 128); } }
#pragma unroll
            for (int m = 0; m < 4; ++m) { const size_t off = (size_t)(row0 + ai * 128 + m * 16) * D + col0;
#pragma unroll
                for (int bj = 0; bj < 2; ++bj) { const u32x2 b = gt[m][bj];
                    f32x4 v0 = acc[ai][bj][m][0], v1 = acc[ai][bj][m][1];
                    v0[0] *= (float)(b.x & 0xffu); v0[1] *= (float)((b.x >> 8) & 0xffu); v0[2] *= (float)((b.x >> 16) & 0xffu); v0[3] *= (float)(b.x >> 24);
                    v1[0] *= (float)(b.y & 0xffu); v1[1] *= (float)((b.y >> 8) & 0xffu); v1[2] *= (float)((b.y >> 16) & 0xffu); v1[3] *= (float)(b.y >> 24);
                    if (sel) { const u32x4 t = t1[m][bj];
                        v0[0] += bflo(t.x); v0[1] += bfhi(t.x); v0[2] += bflo(t.y); v0[3] += bfhi(t.y); v1[0] += bflo(t.z); v1[1] += bfhi(t.z); v1[2] += bflo(t.w); v1[3] += bfhi(t.w); }
                    *(u32x4*)(O + off + bj * 128) = pack8(v0, v1); } }
            asm volatile("" ::: "memory");
        }
    }
};
struct MergeOrder {
    pg8::StaticOrder so; int nM;
    __device__ __forceinline__ bool next(int i, Unit& u) const { Unit t; if (!so.next(i >> 1, t)) return false; const int sel = i & 1; u.pm = t.pm + sel * nM; u.pn = t.pn + sel * 4; return true; }
    __device__ __forceinline__ void a_ready(const Unit&) const {}
    __device__ __forceinline__ void done(const Unit&) const {}
};

struct EpiResid {
    static constexpr bool PERM = true, AFTER_DRAIN = false, MIDK = false;
    const float* xin32; bf16* xb; const float* g1;
    __device__ __forceinline__ void operator()(const f32x4 (&acc)[2][2][4][2], const Unit& u, int wr, int wc, int fr, int fq) const {
        const int row0 = u.pm * 256 + wr * 64 + fr, col0 = u.pn * 256 + wc * 32 + 8 * fq;
        const int b = (u.pm * 256) / SEQ; const float* g = g1 + (size_t)b * 6 * D + col0;
        f32x4 gv[2][2];
#pragma unroll
        for (int bj = 0; bj < 2; ++bj)
#pragma unroll
            for (int n = 0; n < 2; ++n) gv[bj][n] = *(const f32x4*)(g + bj * 128 + n * 4);
        if (xin32) {
#pragma unroll
            for (int ai = 0; ai < 2; ++ai)
#pragma unroll
                for (int mh = 0; mh < 2; ++mh) { f32x4 x0[2][2], x1[2][2];
#pragma unroll
                    for (int m2 = 0; m2 < 2; ++m2) { const size_t off = (size_t)(row0 + ai * 128 + (2 * mh + m2) * 16) * D + col0;
#pragma unroll
                        for (int bj = 0; bj < 2; ++bj) { x0[m2][bj] = *(const f32x4*)(xin32 + off + bj * 128); x1[m2][bj] = *(const f32x4*)(xin32 + off + bj * 128 + 4); } }
#pragma unroll
                    for (int m2 = 0; m2 < 2; ++m2) { const int m = 2 * mh + m2; const size_t off = (size_t)(row0 + ai * 128 + m * 16) * D + col0;
#pragma unroll
                        for (int bj = 0; bj < 2; ++bj) *(u32x4*)(xb + off + bj * 128) = pack8(x0[m2][bj] + gv[bj][0] * acc[ai][bj][m][0], x1[m2][bj] + gv[bj][1] * acc[ai][bj][m][1]); }
                    asm volatile("" ::: "memory"); }
        } else {
#pragma unroll
            for (int ai = 0; ai < 2; ++ai) { u32x4 xr[4][2];
#pragma unroll
                for (int m = 0; m < 4; ++m) { const size_t off = (size_t)(row0 + ai * 128 + m * 16) * D + col0;
#pragma unroll
                    for (int bj = 0; bj < 2; ++bj) xr[m][bj] = *(const u32x4*)(xb + off + bj * 128); }
#pragma unroll
                for (int m = 0; m < 4; ++m) { const size_t off = (size_t)(row0 + ai * 128 + m * 16) * D + col0;
#pragma unroll
                    for (int bj = 0; bj < 2; ++bj) { const u32x4 a = xr[m][bj];
                        const f32x4 x0 = {bflo(a.x), bfhi(a.x), bflo(a.y), bfhi(a.y)}, x1 = {bflo(a.z), bfhi(a.z), bflo(a.w), bfhi(a.w)};
                        *(u32x4*)(xb + off + bj * 128) = pack8(x0 + gv[bj][0] * acc[ai][bj][m][0], x1 + gv[bj][1] * acc[ai][bj][m][1]); } }
                asm volatile("" ::: "memory"); }
        }
    }
};

struct EpiLogits {
    static constexpr bool PERM = false, AFTER_DRAIN = false, MIDK = false;
    float* L;
    __device__ __forceinline__ void operator()(const f32x4 (&acc)[2][2][4][2], const Unit& u, int wr, int wc, int fr, int fq) const {
        if (wc >= 2) return;
        const int row0 = u.pm * 256 + wr * 64 + fr, col0 = wc * 32 + 4 * fq;
#pragma unroll
        for (int ai = 0; ai < 2; ++ai)
#pragma unroll
            for (int m = 0; m < 4; ++m)
#pragma unroll
                for (int n = 0; n < 2; ++n) *(f32x4*)(L + (size_t)(row0 + ai * 128 + m * 16) * 64 + col0 + n * 16) = acc[ai][0][m][n];
    }
};

#ifndef MK_MOE_FP8
#define MK_MOE_FP8 0
#endif
#if MK_MOE_FP8
struct EpiAct {
    static constexpr bool PERM = true, AFTER_DRAIN = false, MIDK = false;
    unsigned char* ACT;
    __device__ __forceinline__ void operator()(const f32x4 (&acc)[2][2][4][2], const Unit& u, int wr, int wc, int fr, int fq) const {
        const int row0 = u.pm * 256 + wr * 64 + fr, col0 = (u.pn & 3) * 128 + wc * 32 + 8 * fq;
        constexpr float inv = 1.f / WSCALE;
#pragma unroll
        for (int ai = 0; ai < 2; ++ai)
#pragma unroll
            for (int m = 0; m < 4; ++m) { f32x4 v0, v1;
#pragma unroll
                for (int i = 0; i < 4; ++i) { v0[i] = fsilu(acc[ai][0][m][0][i] * inv) * acc[ai][1][m][0][i] * (inv * ASCALE); v1[i] = fsilu(acc[ai][0][m][1][i] * inv) * acc[ai][1][m][1][i] * (inv * ASCALE); }
                *(u32x2*)(ACT + (size_t)(row0 + ai * 128 + m * 16) * DE + col0) = pack8_fp8(v0, v1); }
    }
};
struct EpiYs {
    static constexpr bool PERM = true, AFTER_DRAIN = false, MIDK = false;
    bf16* YS; const float* gs;
    __device__ __forceinline__ void operator()(const f32x4 (&acc)[2][2][4][2], const Unit& u, int wr, int wc, int fr, int fq) const {
        const int row0 = u.pm * 256 + wr * 64 + fr, col0 = (u.pn & 3) * 256 + wc * 32 + 8 * fq;
#pragma unroll
        for (int ai = 0; ai < 2; ++ai)
#pragma unroll
            for (int m = 0; m < 4; ++m) { const int r = row0 + ai * 128 + m * 16; const float gt = gs[r] * (1.f / (WSCALE * ASCALE));
#pragma unroll
                for (int bj = 0; bj < 2; ++bj) *(u32x4*)(YS + (size_t)r * D + col0 + bj * 128) = pack8(acc[ai][bj][m][0] * gt, acc[ai][bj][m][1] * gt); }
    }
};
#else
struct EpiAct {
    static constexpr bool PERM = true, AFTER_DRAIN = false, MIDK = false;
    bf16* ACT;
    __device__ __forceinline__ void operator()(const f32x4 (&acc)[2][2][4][2], const Unit& u, int wr, int wc, int fr, int fq) const {
        const int row0 = u.pm * 256 + wr * 64 + fr, col0 = (u.pn & 3) * 128 + wc * 32 + 8 * fq;
#pragma unroll
        for (int ai = 0; ai < 2; ++ai)
#pragma unroll
            for (int m = 0; m < 4; ++m) { f32x4 v0, v1;
#pragma unroll
                for (int i = 0; i < 4; ++i) { v0[i] = fsilu(acc[ai][0][m][0][i]) * acc[ai][1][m][0][i]; v1[i] = fsilu(acc[ai][0][m][1][i]) * acc[ai][1][m][1][i]; }
                *(u32x4*)(ACT + (size_t)(row0 + ai * 128 + m * 16) * DE + col0) = pack8(v0, v1); }
    }
};
struct EpiYs {
    static constexpr bool PERM = true, AFTER_DRAIN = false, MIDK = false;
    unsigned char* YS; const float* gs;
    __device__ __forceinline__ void operator()(const f32x4 (&acc)[2][2][4][2], const Unit& u, int wr, int wc, int fr, int fq) const {
        const int row0 = u.pm * 256 + wr * 64 + fr, col0 = (u.pn & 3) * 256 + wc * 32 + 8 * fq;
        float gts[2][4];
#pragma unroll
        for (int ai = 0; ai < 2; ++ai)
#pragma unroll
            for (int m = 0; m < 4; ++m) gts[ai][m] = gs[row0 + ai * 128 + m * 16] * YSCALE;
#pragma unroll
        for (int ai = 0; ai < 2; ++ai)
#pragma unroll
            for (int m = 0; m < 4; ++m) { const int r = row0 + ai * 128 + m * 16; const float gt = gts[ai][m];
#pragma unroll
                for (int bj = 0; bj < 2; ++bj) *(u32x2*)(YS + (size_t)r * D + col0 + bj * 128) = pack8_fp8(acc[ai][bj][m][0] * gt, acc[ai][bj][m][1] * gt); }
    }
};
#endif
struct GroupedOrder {
    const int* tilee; int U, G, c; const int* rowidx;
    __device__ __forceinline__ bool next(int i, Unit& u) const {
        int id;
        if ((G & 7) == 0) { const int gx = G >> 3, per = (U + 7) >> 3, n = i * gx + (c >> 3); if (n >= per) return false; id = (c & 7) * per + n; if (id >= U) return false; }
        else { id = i * G + c; if (id >= U) return false; }
        const int t = id >> 2; u.pm = t; u.pn = tilee[t] * 4 + (id & 3); return true;
    }
    __device__ __forceinline__ void a_ready(const Unit&) const {}
    __device__ __forceinline__ void done(const Unit&) const {}
};
constexpr int AT_KR = 0, AT_VR = 32768, AT_TAB = 98304, AT_SLOT = 8192;
typedef int v8i __attribute__((ext_vector_type(8)));
typedef int v4i __attribute__((ext_vector_type(4)));
__device__ __forceinline__ int crow(int r, int hi) { return (r & 3) + 8 * (r >> 2) + 4 * hi; }

__device__ __forceinline__ void attn_bias(f32x16& s0, f32x16& s1, int relbase, const LAS float* tabh) {
#pragma unroll
    for (int r = 0; r < 16; ++r) {
        int i0 = relbase + (r & 3) + 8 * (r >> 2); int i1 = i0 + 32;
        i0 = i0 < 0 ? 0 : (i0 > 255 ? 255 : i0); i1 = i1 < 0 ? 0 : (i1 > 255 ? 255 : i1);
        s0[r] += tabh[i0]; s1[r] += tabh[i1];
    }
}
template <int J>
__device__ __forceinline__ void attn_exp_chunk(f32x16& s0, f32x16& s1, float& lsum) {
    float ls = 0.f;
#pragma unroll
    for (int r = 4 * J; r < 4 * J + 4; ++r) { s0[r] = __builtin_amdgcn_exp2f(s0[r]); s1[r] = __builtin_amdgcn_exp2f(s1[r]); }
    (void)ls; (void)lsum;
}
__device__ __forceinline__ int pk4_bf8(float a, float b, float c, float d) {
    const unsigned lo = __builtin_bit_cast(unsigned, __builtin_amdgcn_cvt_pkrtz(a, b)), hi = __builtin_bit_cast(unsigned, __builtin_amdgcn_cvt_pkrtz(c, d));
    return (int)__builtin_amdgcn_perm(hi, lo, 0x07050301u);
}
#define AT_CM4 ((f32x16){-4.f, -4.f, -4.f, -4.f, -4.f, -4.f, -4.f, -4.f, -4.f, -4.f, -4.f, -4.f, -4.f, -4.f, -4.f, -4.f})
__device__ __forceinline__ void glds16(const void* gsrc, unsigned lds_dst) { unsigned keep;
    asm volatile("s_mov_b32 %0, m0\n\ts_mov_b32 m0, %2\n\ts_nop 0\n\tglobal_load_lds_dwordx4 %1, off\n\ts_mov_b32 m0, %0" : "=&s"(keep) : "v"(gsrc), "s"(lds_dst) : "memory"); }
__device__ __forceinline__ void attn_dma_k(unsigned lds0, const unsigned char* kg0, int t, int slot, int wid, int lane) {
    glds16(kg0 + (size_t)(wid >> 2) * SEQ * 64 + (size_t)t * 4096 + (wid & 3) * 1024 + lane * 16, (unsigned)__builtin_amdgcn_readfirstlane((int)(lds0 + AT_KR + slot * AT_SLOT + wid * 1024)));
}
__device__ __forceinline__ void attn_dma_v(unsigned lds0, const unsigned char* vg0, int t, int slot, int wid, int lane) {
    glds16(vg0 + (size_t)t * 8192 + wid * 1024 + lane * 16, (unsigned)__builtin_amdgcn_readfirstlane((int)(lds0 + AT_VR + slot * AT_SLOT + wid * 1024)));
}
#define AT_RD128(dst, addr, off) asm volatile("ds_read_b128 %0, %1 offset:%c2" : "=&v"(dst) : "v"(addr), "i"(off) : "memory")
#define AT_MFMA8(a, b, c) __builtin_amdgcn_mfma_scale_f32_32x32x64_f8f6f4(a, b, c, 0, 0, 0, 0, 0, 0)
#define AT_MFMA8B(a, b, c) __builtin_amdgcn_mfma_scale_f32_32x32x64_f8f6f4(a, b, c, 0, 1, 0, 0, 0, 0)

template <int VAR>
__device__ __forceinline__ void phase_attn(Frame& F, int l) {
    refresh(F);
    const WS W = ws_map(F.ws, F.nb); const float* const* IN_ = F.a->in; (void)IN_; (void)W;
    const int lane = F.lane, wid = F.wave, r32 = lane & 31, hh = lane >> 5, qg = wid & 3, c = wid >> 2;
    LAS unsigned char* lds = F.lds; const unsigned lds0 = (unsigned)(unsigned long)lds;
    LAS float* tab = (LAS float*)(lds + AT_TAB);
    for (int i = F.tid; i < 1028; i += NTHR) tab[i] = W.tab[i];
    const float lam = W.tab[1032 + l]; const float lam_init = 0.8f - 0.6f * __expf(-0.3f * (float)l);
    const float* subg = IN_[13] + l * 128;
    const int U = F.nb * NH * 64;
    const int gx = F.G >> 3, per = U >> 3;
    const int sw = (r32 >> 2) & 3;
    const unsigned ka0 = lds0 + AT_KR + c * 4096 + r32 * 64 + (((2 * hh) ^ sw) << 4), ka1 = lds0 + AT_KR + c * 4096 + r32 * 64 + (((2 * hh + 1) ^ sw) << 4);
    const unsigned va0 = lds0 + AT_VR + r32 * 64 + (((2 * hh) ^ sw) << 4), va1 = lds0 + AT_VR + r32 * 64 + (((2 * hh + 1) ^ sw) << 4);
#ifndef MK_ATT_1BAR
#define MK_ATT_1BAR 1
#endif
    const bool lag = (MK_ATT_1BAR == 0) && wid >= 4;
    __syncthreads();
    for (int i = 0;; ++i) {
        int id;
        if ((F.G & 7) == 0) { const int n = i * gx + (F.bid >> 3); if (n >= per) break; id = (F.bid & 7) * per + n; }
        else { id = i * F.G + F.bid; if (id >= U) break; }
        const int bh = id >> 6, qb = id & 63, b = bh >> 2, h = bh & 3;
        const int qw0 = qb * 128 + 32 * qg;
        const unsigned char* kg0 = (const unsigned char*)W.DK + ((size_t)bh * 2) * SEQ * 64;
        const unsigned char* vg0 = (const unsigned char*)W.DV + (size_t)bh * SEQ * 128;
        v8i qf; { const unsigned char* qp = (const unsigned char*)W.DQ + (((size_t)bh * 2 + c) * SEQ + qw0 + r32) * 64 + 32 * hh;
            const v4i q0 = *(const v4i*)qp, q1 = *(const v4i*)(qp + 16); qf = (v8i){q0[0], q0[1], q0[2], q0[3], q1[0], q1[1], q1[2], q1[3]}; }
        asm volatile("s_waitcnt vmcnt(0)" ::: "memory");
        attn_dma_k(lds0, kg0, 0, 0, wid, lane); attn_dma_k(lds0, kg0, 1, 1, wid, lane); attn_dma_v(lds0, vg0, 0, 7, wid, lane); attn_dma_v(lds0, vg0, 0, 0, wid, lane);
        attn_dma_k(lds0, kg0, 2, 2, wid, lane); attn_dma_v(lds0, vg0, 1, 1, wid, lane); attn_dma_k(lds0, kg0, 3, 3, wid, lane);
        attn_dma_v(lds0, vg0, 2, 2, wid, lane); attn_dma_v(lds0, vg0, 3, 3, wid, lane); attn_dma_v(lds0, vg0, 4, 4, wid, lane); attn_dma_v(lds0, vg0, 5, 5, wid, lane);
        f32x16 o[4]; f32x4 osum = f32x4{};
#pragma unroll
        for (int dt = 0; dt < 4; ++dt) o[dt] = f32x16{};
        v8i ones8; { const int on = (((lane & 15) < 8) == (((lane >> 4) & 1) == 0)) ? 0x38383838 : 0; ones8 = (v8i){on, on, on, on, on, on, on, on}; }
        asm volatile("" : "+v"(ones8));
        const int tL = (qw0 >= 154) ? ((qw0 - 154) >> 6) + 1 : 0, tR = (qw0 + 185) >> 6;
        const float shl = tab[1024 + h];
        const LAS float* tabh = tab + h * 256;
        const int rel0 = -qw0 - r32 + 4 * hh + 128;
        asm volatile("s_waitcnt vmcnt(7)" ::: "memory"); __builtin_amdgcn_s_barrier(); asm volatile("" ::: "memory");
        f32x16 s0, s1; v8i p = {0, 0, 0, 0, 0, 0, 0, 0};
        v4i fa0, fa1, fb0, fb1;
        {   v4i kx[4];
            AT_RD128(kx[0], ka0, 0); AT_RD128(kx[1], ka1, 0); AT_RD128(kx[2], ka0, 2048); AT_RD128(kx[3], ka1, 2048);
            AT_RD128(fa0, va0, 7 * AT_SLOT); AT_RD128(fa1, va1, 7 * AT_SLOT); AT_RD128(fb0, va0, 7 * AT_SLOT + 2048); AT_RD128(fb1, va1, 7 * AT_SLOT + 2048);
            asm volatile("s_waitcnt lgkmcnt(4)" ::: "memory"); __builtin_amdgcn_sched_barrier(0);
            s0 = AT_MFMA8(((v8i){kx[0][0], kx[0][1], kx[0][2], kx[0][3], kx[1][0], kx[1][1], kx[1][2], kx[1][3]}), qf, AT_CM4);
            s1 = AT_MFMA8(((v8i){kx[2][0], kx[2][1], kx[2][2], kx[2][3], kx[3][0], kx[3][1], kx[3][2], kx[3][3]}), qf, AT_CM4); }
        __builtin_amdgcn_s_barrier(); asm volatile("" ::: "memory");
#define AT_EXP8(sv, b0) do { if constexpr (!(VAR & 1)) { _Pragma("unroll") for (int r_ = (b0); r_ < (b0) + 8; ++r_) sv[r_] = __builtin_amdgcn_exp2f(sv[r_]); } } while (0)
#define AT_RDV(dst, addr, off) do { if constexpr (!(VAR & 4)) AT_RD128(dst, addr, off); else asm volatile("" : "=v"(dst)); } while (0)
#define AT_RDK(dst, addr, off) do { if constexpr (!(VAR & 16)) AT_RD128(dst, addr, off); else asm volatile("" : "=v"(dst)); } while (0)
#define AT_PV(dst, a, b) do { if constexpr (!(VAR & 2)) dst = AT_MFMA8B(a, b, dst); } while (0)
#define AT_SUM(b) do { if constexpr (!(VAR & 2)) osum = __builtin_amdgcn_mfma_scale_f32_16x16x128_f8f6f4(ones8, b, osum, 0, 1, 0, 0, 0, 0); } while (0)
#define AT_QK(dst, a) do { if constexpr (!(VAR & 8)) { const v8i a_ = (a); asm volatile("v_mfma_f32_32x32x64_f8f6f4 %0, %1, %2, -4.0" : "=&v"(dst) : "v"(a_), "v"(qf)); } } while (0)
#define AT_PK(dst, sv, b0) do { if constexpr (!(VAR & 32)) dst = pk4_bf8(sv[b0], sv[(b0) + 1], sv[(b0) + 2], sv[(b0) + 3]); else dst = __builtin_bit_cast(int, sv[b0]); } while (0)
#define AT_V8(a, b) ((v8i){a[0], a[1], a[2], a[3], b[0], b[1], b[2], b[3]})
#define AT_LGKM(n) do { asm volatile("s_waitcnt lgkmcnt(" #n ")" ::: "memory"); __builtin_amdgcn_sched_barrier(0); } while (0)
#define AT_STEP(SL, t) do { \
            if ((t) - 1 == tL) { _Pragma("unroll") for (int dt = 0; dt < 4; ++dt) o[dt] *= shl; osum *= shl; }    \
            AT_SUM(p); __builtin_amdgcn_sched_barrier(0);                                                           \
            if constexpr (!(VAR & 128)) { const int tk = (t) + 4 < 128 ? (t) + 4 : 127, tv = (t) + 6 < 128 ? (t) + 6 : 127; attn_dma_k(lds0, kg0, tk, (SL) & 3, wid, lane); attn_dma_v(lds0, vg0, tv, ((SL) + 6) & 7, wid, lane); } \
            { v4i fc0, fc1, fd0, fd1, fk0, fk1, fk2, fk3; \
              if ((t) >= tL && (t) < tR) attn_bias(s0, s1, 64 * (t) + rel0, tabh);                                \
              AT_RDV(fc0, va0, (((SL) + 7) & 7) * AT_SLOT + 4096); AT_RDV(fc1, va1, (((SL) + 7) & 7) * AT_SLOT + 4096); AT_RDV(fd0, va0, (((SL) + 7) & 7) * AT_SLOT + 6144); AT_RDV(fd1, va1, (((SL) + 7) & 7) * AT_SLOT + 6144); \
              AT_RDK(fk0, ka0, (((SL) + 1) & 3) * AT_SLOT); AT_RDK(fk1, ka1, (((SL) + 1) & 3) * AT_SLOT); \
              AT_EXP8(s0, 0); \
              AT_LGKM(6); \
              AT_PV(o[0], AT_V8(fa0, fa1), p); \
              AT_RDK(fk2, ka0, (((SL) + 1) & 3) * AT_SLOT + 2048); AT_RDK(fk3, ka1, (((SL) + 1) & 3) * AT_SLOT + 2048); \
              AT_EXP8(s0, 8); \
              __builtin_amdgcn_sched_barrier(0); \
              AT_PV(o[1], AT_V8(fb0, fb1), p); \
              AT_EXP8(s1, 0); \
              AT_LGKM(4); \
              AT_PV(o[2], AT_V8(fc0, fc1), p); \
              AT_RDV(fa0, va0, ((SL) & 7) * AT_SLOT); AT_RDV(fa1, va1, ((SL) & 7) * AT_SLOT); \
              AT_EXP8(s1, 8); \
              __builtin_amdgcn_sched_barrier(0); \
              AT_PV(o[3], AT_V8(fd0, fd1), p); \
              AT_RDV(fb0, va0, ((SL) & 7) * AT_SLOT + 2048); AT_RDV(fb1, va1, ((SL) & 7) * AT_SLOT + 2048); \
              AT_PK(p[0], s0, 0); AT_PK(p[1], s0, 4); AT_PK(p[2], s0, 8); AT_PK(p[3], s0, 12); \
              AT_LGKM(6); \
              AT_QK(s0, AT_V8(fk0, fk1)); \
              AT_PK(p[4], s1, 0); AT_PK(p[5], s1, 4); AT_PK(p[6], s1, 8); AT_PK(p[7], s1, 12); \
              AT_LGKM(4); \
              AT_QK(s1, AT_V8(fk2, fk3)); \
              asm volatile("" : "+v"(p)); }                          \
            asm volatile("s_waitcnt vmcnt(5)" ::: "memory"); if constexpr (!(VAR & 64)) __builtin_amdgcn_s_barrier(); asm volatile("" ::: "memory"); } while (0)
        for (int t0 = 0; t0 < 128; t0 += 8) { AT_STEP(0, t0); AT_STEP(1, t0 + 1); AT_STEP(2, t0 + 2); AT_STEP(3, t0 + 3); AT_STEP(4, t0 + 4); AT_STEP(5, t0 + 5); AT_STEP(6, t0 + 6); AT_STEP(7, t0 + 7); }
#undef AT_STEP
#undef AT_EXP8
#undef AT_RDV
#undef AT_RDK
#undef AT_PV
#undef AT_SUM
#undef AT_QK
#undef AT_PK
        {
            v4i fc0, fc1, fd0, fd1;
            AT_RD128(fc0, va0, 7 * AT_SLOT + 4096); AT_RD128(fc1, va1, 7 * AT_SLOT + 4096); AT_RD128(fd0, va0, 7 * AT_SLOT + 6144); AT_RD128(fd1, va1, 7 * AT_SLOT + 6144);
            if (127 == tL) { _Pragma("unroll") for (int dt = 0; dt < 4; ++dt) o[dt] *= shl; osum *= shl; }
            osum = __builtin_amdgcn_mfma_scale_f32_16x16x128_f8f6f4(ones8, p, osum, 0, 1, 0, 0, 0, 0);
            AT_LGKM(0);
            o[0] = AT_MFMA8B(AT_V8(fa0, fa1), p, o[0]); o[1] = AT_MFMA8B(AT_V8(fb0, fb1), p, o[1]); o[2] = AT_MFMA8B(AT_V8(fc0, fc1), p, o[2]); o[3] = AT_MFMA8B(AT_V8(fd0, fd1), p, o[3]);
        }
#undef AT_LGKM
#undef AT_V8
        asm volatile("s_waitcnt vmcnt(0)" ::: "memory"); __builtin_amdgcn_s_barrier(); asm volatile("" ::: "memory");
        const float lt = __shfl(osum[0], r32 + (r32 >= 16 ? 16 : 0));
        LAS float* xch = (LAS float*)(lds + qg * 16384);
        if (c == 1) { const float f = lam / lt;
#pragma unroll
            for (int dt = 0; dt < 4; ++dt)
#pragma unroll
                for (int r = 0; r < 16; ++r) xch[(dt * 16 + r) * 64 + lane] = o[dt][r] * f; }
        LDS_WAIT(); __builtin_amdgcn_s_barrier(); asm volatile("" ::: "memory");
        if (c == 0) { const float f = 1.f / lt; float ss = 0.f;
#pragma unroll
            for (int dt = 0; dt < 4; ++dt)
#pragma unroll
                for (int r = 0; r < 16; ++r) { const float v = o[dt][r] * f - xch[(dt * 16 + r) * 64 + lane]; o[dt][r] = v; ss += v * v; }
            ss += __shfl_xor(ss, 32);
            const float rn = rsqrtf(ss * (1.f / 128.f) + RMS_EPS) * (1.f - lam_init);
            bf16* orow = W.OAB + (size_t)F.T * 512 + ((size_t)b * SEQ + qw0 + r32) * 512 + h * 128;
#pragma unroll
            for (int dt = 0; dt < 4; ++dt)
#pragma unroll
                for (int g = 0; g < 4; ++g) { const int dv = 32 * dt + 8 * g + 4 * hh; const f32x4 sg = *(const f32x4*)(subg + dv);
                    u32x2 ov; ov.x = cvt_pk(o[dt][4 * g] * rn * sg[0], o[dt][4 * g + 1] * rn * sg[1]); ov.y = cvt_pk(o[dt][4 * g + 2] * rn * sg[2], o[dt][4 * g + 3] * rn * sg[3]);
                    *(u32x2*)(orow + dv) = ov; }
        }
        LDS_WAIT(); __builtin_amdgcn_s_barrier(); asm volatile("" ::: "memory");
    }
}
constexpr int GL_CUM = 0;
constexpr int GL_S64 = 144, GL_S192 = 400;
constexpr int G1_KEF = 34816, G1_KEB = G1_KEF + 64 * GL_S64, G1_VT = G1_KEB + 64 * GL_S64;
constexpr int G3_AOP = 34816, G3_KIF = G3_AOP + 64 * GL_S192, G3_KIB = G3_KIF + 64 * GL_S64, G3_BOP = G3_KIB + 64 * GL_S64;
static_assert(G3_BOP + 128 * GL_S192 <= 150 * 1024, "GLA LDS");

__device__ __forceinline__ bf16x8 lds_frag(const LAS unsigned char* base, int row, int stride, int kbyte) { return *(const LAS bf16x8*)(base + row * stride + kbyte); }

struct GlaIn { u32x2 lg[4]; u32x4 k, v0, v1, q, st[4], sg0, sg1; };
template <bool G3>
__device__ __forceinline__ void gla_load(const Frame& F, const WS& W, int u, GlaIn& r) {
    const int n = u & 127, bh = u >> 7, b = bh >> 2, h = bh & 3; const size_t trow0 = (size_t)b * SEQ + n * 64;
#pragma unroll
    for (int it = 0; it < 4; ++it) { const int idx = F.tid + it * NTHR; const int dir = idx >> 10, t = (idx >> 4) & 63, d4 = (idx & 15) * 4;
        r.lg[it] = *(const u32x2*)((dir ? W.LGB : W.LGF) + (trow0 + t) * 256 + h * 64 + d4); }
    const int t = F.tid >> 3, d0 = (F.tid & 7) * 8, v0 = (F.tid & 7) * 16;
    r.k = *(const u32x4*)(W.GK + (trow0 + t) * 256 + h * 64 + d0);
    r.v0 = *(const u32x4*)(W.GV + (trow0 + t) * 512 + h * 128 + v0); r.v1 = *(const u32x4*)(W.GV + (trow0 + t) * 512 + h * 128 + v0 + 8);
    if constexpr (G3) {
        r.q = *(const u32x4*)(W.GQ + (trow0 + t) * 256 + h * 64 + d0);
        const int dv = F.tid >> 2, dd0 = (F.tid & 3) * 16;
#pragma unroll
        for (int dir = 0; dir < 2; ++dir) { const bf16* sp = (const bf16*)W.KVT + ((size_t)u * 2 + dir) * 8192 + dv * 64 + dd0; r.st[2 * dir] = *(const u32x4*)sp; r.st[2 * dir + 1] = *(const u32x4*)(sp + 8); }
        r.sg0 = *(const u32x4*)(W.SG + (trow0 + t) * 512 + h * 128 + v0); r.sg1 = *(const u32x4*)(W.SG + (trow0 + t) * 512 + h * 128 + v0 + 8);
    }
}
__device__ __forceinline__ void gla_cum(Frame& F, const GlaIn& r) {
    LAS float* cum = (LAS float*)(F.lds + GL_CUM);
#pragma unroll
    for (int it = 0; it < 4; ++it) { const int idx = F.tid + it * NTHR; const int dir = idx >> 10, t = (idx >> 4) & 63, d4 = (idx & 15) * 4;
        const u32x2 a = r.lg[it];
        *(LAS f32x4*)(cum + (dir * 64 + t) * 64 + d4) = (f32x4){bflo(a.x), bfhi(a.x), bflo(a.y), bfhi(a.y)}; }
    __syncthreads();
    {
        const int dir = F.tid >> 8, seg = (F.tid >> 6) & 3, d = F.tid & 63; LAS float* cc = cum + dir * 4096 + d; LAS float* tot = cum + 8192 + (dir * 4 + seg) * 64 + d;
        float v[16]; float run = 0.f;
        if (dir == 0) {
#pragma unroll
            for (int i = 0; i < 16; ++i) { run += cc[(16 * seg + i) * 64]; v[i] = run; }
        } else {
#pragma unroll
            for (int i = 15; i >= 0; --i) { run += cc[(16 * seg + i) * 64]; v[i] = run; }
        }
        *tot = run;
        __syncthreads();
        float off = 0.f; const LAS float* tb = cum + 8192 + dir * 256 + d;
        if (dir == 0) { if (seg > 0) off += tb[0]; if (seg > 1) off += tb[64]; if (seg > 2) off += tb[128]; }
        else { if (seg < 3) off += tb[192]; if (seg < 2) off += tb[128]; if (seg < 1) off += tb[64]; }
#pragma unroll
        for (int i = 0; i < 16; ++i) cc[(16 * seg + i) * 64] = v[i] + off;
    }
    __syncthreads();
}

__device__ __forceinline__ void phase_gla1(Frame& F) {
    refresh(F);
    const WS W = ws_map(F.ws, F.nb); const float* const* IN_ = F.a->in; (void)IN_; (void)W;
    LAS unsigned char* lds = F.lds; LAS float* cum = (LAS float*)(lds + GL_CUM);
    const int lane = F.lane, wid = F.wave, r32 = lane & 31, hh = lane >> 5;
    const int U = F.nb * NH * 128;
    GlaIn cur, nxt;
    if (F.bid < U) gla_load<false>(F, W, F.bid, nxt);
    for (int u = F.bid; u < U; u += F.G) {
        cur = nxt;
        if (u + F.G < U) gla_load<false>(F, W, u + F.G, nxt);
        gla_cum(F, cur);
        {
            const int t = F.tid >> 3, d0 = (F.tid & 7) * 8;
            const u32x4 kv = cur.k;
            const unsigned kw[4] = {kv.x, kv.y, kv.z, kv.w};
#pragma unroll
            for (int j = 0; j < 8; ++j) { const int d = d0 + j; const float k = (j & 1) ? bfhi(kw[j >> 1]) : bflo(kw[j >> 1]);
                const float ef = __expf(cum[63 * 64 + d] - cum[t * 64 + d]), eb = __expf(cum[4096 + d] - cum[4096 + t * 64 + d]);
                *(LAS bf16*)(lds + G1_KEF + d * GL_S64 + t * 2) = (bf16)(cvt_pk(k * ef, 0.f) & 0xffffu);
                *(LAS bf16*)(lds + G1_KEB + d * GL_S64 + t * 2) = (bf16)(cvt_pk(k * eb, 0.f) & 0xffffu); }
            const int v0 = (F.tid & 7) * 16;
            const u32x4 va = cur.v0, vb = cur.v1;
            const unsigned vw[8] = {va.x, va.y, va.z, va.w, vb.x, vb.y, vb.z, vb.w};
#pragma unroll
            for (int j = 0; j < 16; ++j) *(LAS bf16*)(lds + G1_VT + (v0 + j) * GL_S64 + t * 2) = (bf16)((j & 1) ? (vw[j >> 1] >> 16) : (vw[j >> 1] & 0xffffu));
            if (F.tid < 128) { const int dir = F.tid >> 6, d = F.tid & 63; W.DEC[((size_t)u * 2 + dir) * 64 + d] = __expf(dir ? cum[4096 + d] : cum[63 * 64 + d]); }
        }
        __syncthreads();
        {
            const int dt = wid & 3, dd = wid >> 2;
            f32x16 cf = {}, cb = {};
#pragma unroll
            for (int s = 0; s < 4; ++s) { const int kb = (16 * s + 8 * hh) * 2;
                const bf16x8 a = lds_frag(lds + G1_VT, 32 * dt + r32, GL_S64, kb);
                cf = __builtin_amdgcn_mfma_f32_32x32x16_bf16(a, lds_frag(lds + G1_KEF, 32 * dd + r32, GL_S64, kb), cf, 0, 0, 0);
                cb = __builtin_amdgcn_mfma_f32_32x32x16_bf16(a, lds_frag(lds + G1_KEB, 32 * dd + r32, GL_S64, kb), cb, 0, 0, 0); }
            bf16* of = (bf16*)W.KVT + ((size_t)u * 2) * 8192; bf16* ob = of + 8192;
#pragma unroll
            for (int r = 0; r < 16; ++r) { const int dv = 32 * dt + crow(r, hh), d = 32 * dd + r32;
                const float pf = __shfl_xor(cf[r], 1), pb = __shfl_xor(cb[r], 1);
                if (!(lane & 1)) { *(unsigned*)(of + dv * 64 + d) = cvt_pk(cf[r], pf); *(unsigned*)(ob + dv * 64 + d) = cvt_pk(cb[r], pb); } }
        }
        __syncthreads();
    }
}

__device__ __forceinline__ void phase_gla2(Frame& F) {
    refresh(F);
    const WS W = ws_map(F.ws, F.nb); const float* const* IN_ = F.a->in; (void)IN_; (void)W;
    const size_t total = (size_t)F.nb * NH * 2 * 4096;
    for (size_t wk = (size_t)F.bid * NTHR + F.tid; wk < total; wk += (size_t)F.G * NTHR) {
        const int e2 = (int)(wk & 4095), dir = (int)((wk >> 12) & 1), bh = (int)(wk >> 13), d = (e2 * 2) & 63;
        unsigned* base = (unsigned*)((bf16*)W.KVT + ((size_t)bh * 128 * 2 + dir) * 8192) + e2; const float* dec = W.DEC + ((size_t)bh * 128 * 2 + dir) * 64 + d;
        float S0 = 0.f, S1 = 0.f;
        for (int n0 = 0; n0 < 128; n0 += 8) {
            unsigned kv[8]; float dc0[8], dc1[8];
#pragma unroll
            for (int j = 0; j < 8; ++j) { const int n = dir ? 127 - (n0 + j) : n0 + j; kv[j] = base[(size_t)n * 8192]; dc0[j] = dec[(size_t)n * 128]; dc1[j] = dec[(size_t)n * 128 + 1]; }
#pragma unroll
            for (int j = 0; j < 8; ++j) { const int n = dir ? 127 - (n0 + j) : n0 + j; base[(size_t)n * 8192] = cvt_pk(S0, S1); S0 = dc0[j] * S0 + bflo(kv[j]); S1 = dc1[j] * S1 + bfhi(kv[j]); }
        }
    }
}

__device__ __forceinline__ void phase_gla3(Frame& F, int l) {
    refresh(F);
    const WS W = ws_map(F.ws, F.nb); const float* const* IN_ = F.a->in; (void)IN_; (void)W;
    LAS unsigned char* lds = F.lds; LAS float* cum = (LAS float*)(lds + GL_CUM);
    const int lane = F.lane, wid = F.wave, r32 = lane & 31, hh = lane >> 5;
    const float* gng = IN_[9] + l * 128;
    const int U = F.nb * NH * 128;
    GlaIn cur, nxt;
    if (F.bid < U) gla_load<true>(F, W, F.bid, nxt);
    for (int u = F.bid; u < U; u += F.G) {
        const int n = u & 127, bh = u >> 7, b = bh >> 2, h = bh & 3; const size_t trow0 = (size_t)b * SEQ + n * 64;
        cur = nxt;
        if (u + F.G < U) gla_load<true>(F, W, u + F.G, nxt);
        gla_cum(F, cur);
        {
            const int t = F.tid >> 3, d0 = (F.tid & 7) * 8;
            const u32x4 qv = cur.q, kv = cur.k;
            const unsigned qw[4] = {qv.x, qv.y, qv.z, qv.w}, kw[4] = {kv.x, kv.y, kv.z, kv.w};
            float qf[8], qb[8], kf[8], kb[8];
#pragma unroll
            for (int j = 0; j < 8; ++j) { const int d = d0 + j; const float q = (j & 1) ? bfhi(qw[j >> 1]) : bflo(qw[j >> 1]), k = (j & 1) ? bfhi(kw[j >> 1]) : bflo(kw[j >> 1]);
                const float cf = cum[t * 64 + d], cb = cum[4096 + t * 64 + d];
                qf[j] = q * __expf(cf); qb[j] = q * __expf(cb); kf[j] = k * __expf(-cf); kb[j] = k * __expf(-cb); }
            u32x4 o;
            o.x = cvt_pk(qf[0], qf[1]); o.y = cvt_pk(qf[2], qf[3]); o.z = cvt_pk(qf[4], qf[5]); o.w = cvt_pk(qf[6], qf[7]); *(LAS u32x4*)(lds + G3_AOP + t * GL_S192 + (64 + d0) * 2) = o;
            o.x = cvt_pk(qb[0], qb[1]); o.y = cvt_pk(qb[2], qb[3]); o.z = cvt_pk(qb[4], qb[5]); o.w = cvt_pk(qb[6], qb[7]); *(LAS u32x4*)(lds + G3_AOP + t * GL_S192 + (128 + d0) * 2) = o;
            o.x = cvt_pk(kf[0], kf[1]); o.y = cvt_pk(kf[2], kf[3]); o.z = cvt_pk(kf[4], kf[5]); o.w = cvt_pk(kf[6], kf[7]); *(LAS u32x4*)(lds + G3_KIF + t * GL_S64 + d0 * 2) = o;
            o.x = cvt_pk(kb[0], kb[1]); o.y = cvt_pk(kb[2], kb[3]); o.z = cvt_pk(kb[4], kb[5]); o.w = cvt_pk(kb[6], kb[7]); *(LAS u32x4*)(lds + G3_KIB + t * GL_S64 + d0 * 2) = o;
            const int v0 = (F.tid & 7) * 16;
            const u32x4 va = cur.v0, vb = cur.v1;
            const unsigned vw[8] = {va.x, va.y, va.z, va.w, vb.x, vb.y, vb.z, vb.w};
#pragma unroll
            for (int j = 0; j < 16; ++j) *(LAS bf16*)(lds + G3_BOP + (v0 + j) * GL_S192 + t * 2) = (bf16)((j & 1) ? (vw[j >> 1] >> 16) : (vw[j >> 1] & 0xffffu));
            const int dv = F.tid >> 2, dd0 = (F.tid & 3) * 16;
#pragma unroll
            for (int dir = 0; dir < 2; ++dir) { const u32x4 o0 = cur.st[2 * dir], o1 = cur.st[2 * dir + 1];
                *(LAS u32x4*)(lds + G3_BOP + dv * GL_S192 + (64 + 64 * dir + dd0) * 2) = o0; *(LAS u32x4*)(lds + G3_BOP + dv * GL_S192 + (64 + 64 * dir + dd0 + 8) * 2) = o1; }
        }
        __syncthreads();
        if (wid < 4) {
            const int it = wid >> 1, jt = wid & 1;
            f32x16 af = {}, ab = {};
#pragma unroll
            for (int s = 0; s < 4; ++s) { const int kb = (16 * s + 8 * hh) * 2;
                if (jt <= it) af = __builtin_amdgcn_mfma_f32_32x32x16_bf16(lds_frag(lds + G3_AOP, 32 * it + r32, GL_S192, 128 + kb), lds_frag(lds + G3_KIF, 32 * jt + r32, GL_S64, kb), af, 0, 0, 0);
                if (jt >= it) ab = __builtin_amdgcn_mfma_f32_32x32x16_bf16(lds_frag(lds + G3_AOP, 32 * it + r32, GL_S192, 256 + kb), lds_frag(lds + G3_KIB, 32 * jt + r32, GL_S64, kb), ab, 0, 0, 0); }
#pragma unroll
            for (int r = 0; r < 16; ++r) { const int i = 32 * it + crow(r, hh), j = 32 * jt + r32; const float v = (j <= i) ? af[r] : ab[r];
                *(LAS bf16*)(lds + G3_AOP + i * GL_S192 + j * 2) = (bf16)(cvt_pk(v, 0.f) & 0xffffu); }
        }
        __syncthreads();
        {
            const int it = wid >> 2, dt = wid & 3; f32x16 o = {};
#pragma unroll
            for (int s = 0; s < 12; ++s) { const int kb = (16 * s + 8 * hh) * 2;
                o = __builtin_amdgcn_mfma_f32_32x32x16_bf16(lds_frag(lds + G3_AOP, 32 * it + r32, GL_S192, kb), lds_frag(lds + G3_BOP, 32 * dt + r32, GL_S192, kb), o, 0, 0, 0); }
            LAS float* out = (LAS float*)(lds + GL_CUM);
#pragma unroll
            for (int r = 0; r < 16; ++r) out[(32 * it + crow(r, hh)) * 128 + 32 * dt + r32] = o[r];
        }
        __syncthreads();
        {
            const int t = F.tid >> 3, v0 = (F.tid & 7) * 16; const LAS float* orow = (const LAS float*)(lds + GL_CUM) + t * 128 + v0;
            float x[16]; float ss = 0.f;
#pragma unroll
            for (int j = 0; j < 16; ++j) { x[j] = orow[j]; ss += x[j] * x[j]; }
            ss += __shfl_xor(ss, 1); ss += __shfl_xor(ss, 2); ss += __shfl_xor(ss, 4);
            const float rs = rsqrtf(ss * (1.f / 128.f) + RMS_EPS);
            const u32x4 ga = cur.sg0, gb = cur.sg1;
            const unsigned gw[8] = {ga.x, ga.y, ga.z, ga.w, gb.x, gb.y, gb.z, gb.w};
            float y[16];
#pragma unroll
            for (int j = 0; j < 16; ++j) y[j] = x[j] * rs * gng[v0 + j] * ((j & 1) ? bfhi(gw[j >> 1]) : bflo(gw[j >> 1]));
            u32x4 o0, o1; o0.x = cvt_pk(y[0], y[1]); o0.y = cvt_pk(y[2], y[3]); o0.z = cvt_pk(y[4], y[5]); o0.w = cvt_pk(y[6], y[7]);
            o1.x = cvt_pk(y[8], y[9]); o1.y = cvt_pk(y[10], y[11]); o1.z = cvt_pk(y[12], y[13]); o1.w = cvt_pk(y[14], y[15]);
            bf16* dst = W.OAB + (trow0 + t) * 512 + h * 128 + v0; *(u32x4*)dst = o0; *(u32x4*)(dst + 8) = o1;
        }
        __syncthreads();
    }
}
__device__ __forceinline__ void phase_select(Frame& F, int l) {
    refresh(F);
    const WS W = ws_map(F.ws, F.nb); const float* const* IN_ = F.a->in; (void)IN_; (void)W;
    LAS int* lcnt = (LAS int*)F.lds; LAS int* lbase = lcnt + 32;
    const float* b_rg = IN_[19] + l * 4; const float* b_re = IN_[21] + l * 32;
    unsigned* gcnt = W.ctl + CW_CNT + l * 64;
    for (int t0 = F.bid * NTHR; t0 < F.T; t0 += F.G * NTHR) {
        if (F.tid < 32) lcnt[F.tid] = 0;
        __syncthreads();
        const int t = t0 + F.tid; int e0 = 0, e1 = 0, r0 = 0, r1 = 0; float g0 = 0.f, g1 = 0.f;
        if (t < F.T) {
            const float* lg = W.LOGITS + (size_t)t * 64;
            float gl[4]; { const f32x4 v = *(const f32x4*)lg; gl[0] = v[0] + b_rg[0]; gl[1] = v[1] + b_rg[1]; gl[2] = v[2] + b_rg[2]; gl[3] = v[3] + b_rg[3]; }
            int grp = 0; float mx = gl[0];
            if (gl[1] > mx) { mx = gl[1]; grp = 1; } if (gl[2] > mx) { mx = gl[2]; grp = 2; } if (gl[3] > mx) { mx = gl[3]; grp = 3; }
            const float p_grp = 1.f / (__expf(gl[0] - mx) + __expf(gl[1] - mx) + __expf(gl[2] - mx) + __expf(gl[3] - mx));
            const f32x4 ea = *(const f32x4*)(lg + 4 + grp * 8), eb = *(const f32x4*)(lg + 8 + grp * 8);
            const f32x4 ba = *(const f32x4*)(b_re + grp * 8), bb = *(const f32x4*)(b_re + grp * 8 + 4);
            float b0v = -1e30f, b1v = -1e30f; int i0 = 0, i1 = 0;
#pragma unroll
            for (int j = 0; j < 8; ++j) { const float e = (j < 4) ? ea[j] + ba[j] : eb[j - 4] + bb[j - 4];
                if (e > b0v) { b1v = b0v; i1 = i0; b0v = e; i0 = j; } else if (e > b1v) { b1v = e; i1 = j; } }
            const float p1 = __expf(b1v - b0v), s2 = 1.f + p1;
            e0 = grp * 8 + i0; e1 = grp * 8 + i1; g0 = p_grp / s2; g1 = p_grp * p1 / s2;
            r0 = __hip_atomic_fetch_add(lcnt + e0, 1, __ATOMIC_RELAXED, __HIP_MEMORY_SCOPE_WORKGROUP);
            r1 = __hip_atomic_fetch_add(lcnt + e1, 1, __ATOMIC_RELAXED, __HIP_MEMORY_SCOPE_WORKGROUP);
        }
        __syncthreads();
        if (F.tid < 32) lbase[F.tid] = (int)__hip_atomic_fetch_add(gcnt + F.tid, (unsigned)lcnt[F.tid], __ATOMIC_RELAXED, __HIP_MEMORY_SCOPE_AGENT);
        __syncthreads();
        if (t < F.T) { W.eid[t * 2] = e0; W.eid[t * 2 + 1] = e1; W.gate[t * 2] = g0; W.gate[t * 2 + 1] = g1; W.rank[t * 2] = lbase[e0] + r0; W.rank[t * 2 + 1] = lbase[e1] + r1; }
        __syncthreads();
    }
}
__device__ __forceinline__ void phase_gather(Frame& F, int l) {
    refresh(F);
    const WS W = ws_map(F.ws, F.nb); const float* const* IN_ = F.a->in; (void)IN_; (void)W;
    LAS int* seg = (LAS int*)F.lds; LAS int* cnt = seg + 40;
    const unsigned* gcnt = W.ctl + CW_CNT + l * 64;
    if (F.tid == 0) { int o = 0; for (int e = 0; e < 32; ++e) { const int c = (int)__hip_atomic_load(gcnt + e, __ATOMIC_RELAXED, __HIP_MEMORY_SCOPE_AGENT); seg[e] = o; cnt[e] = c; o += (c + 255) & ~255; } seg[32] = o; }
    __syncthreads();
    const int ntile = seg[32] >> 8;
    if (F.bid == 0) {
        for (int i = F.tid; i < ntile; i += NTHR) { int e = 0; while (e < 31 && (i << 8) >= seg[e + 1]) ++e; W.tilee[i] = e; }
        if (F.tid == 0) W.segp[0] = ntile;
    }
    for (int p = F.bid * NTHR + F.tid; p < (ntile << 8); p += F.G * NTHR) { int e = 0; while (e < 31 && p >= seg[e + 1]) ++e; if (p - seg[e] >= cnt[e]) W.stok[p] = 0; }
    for (int it = F.bid * NTHR + F.tid; it < F.T * 2; it += F.G * NTHR) {
        const int e = W.eid[it], p = seg[e] + W.rank[it];
        W.stok[p] = it >> 1; W.pos[it] = p; W.gsort[p] = W.gate[it];
    }
}

#ifndef MK_MASK
#define MK_MASK 0xffffffffu
#endif
#define EN(b) (((MK_MASK) >> (b)) & 1u)
#ifndef MK_ALIGN
#define MK_ALIGN true
#endif
#ifndef MK_SP2
#define MK_SP2 true
#endif
#ifndef MK_DUP
#define MK_DUP 0u
#endif
#define REPS(b) ((((MK_DUP) >> (b)) & 1u) ? 2 : 1)
constexpr int NPL = 14, NPH = 2 + DEPTH * NPL;
__global__ void __launch_bounds__(NTHR, 2) mk_fwd(Args args) {
    extern __shared__ __attribute__((aligned(16))) unsigned char lds_raw[];
    Frame F;
    F.lds = (LAS unsigned char*)lds_raw; F.tid = threadIdx.x; F.lane = F.tid & 63; F.wave = __builtin_amdgcn_readfirstlane(F.tid >> 6);
    F.G = gridDim.x; F.bid = blockIdx.x; F.nb = args.nb; F.T = args.nb * SEQ; F.ws = args.ws; F.a = &args; F.xbuf = args.out;
    const float* const* IN_ = args.in;
    volatile LAS unsigned* misc = (volatile LAS unsigned*)(F.lds + LDS_MISC);
    if (F.tid < 64) misc[F.tid] = 0u;
    __syncthreads();
    XcdBarrier bar = xcd_barrier_post((unsigned*)args.ws + CW_BAR + args.li * XCD_BAR_WORDS, misc);
    const int lo = args.ph_lo, hi = args.ph_hi;
#define IN(k) (lo <= (k) && (k) < hi)
#ifdef MK_BAR2
#define SEAM(k) do { if (IN(k) && IN((k) + 1)) { xcd_barrier(bar); xcd_barrier(bar); } } while (0)
#else
#define SEAM(k) do { if (IN(k) && IN((k) + 1)) xcd_barrier(bar); } while (0)
#endif
#ifdef MK_UB
    {
        typedef int ub8i __attribute__((ext_vector_type(8))); typedef int ub4i __attribute__((ext_vector_type(4)));
        ub8i ua, ubb; for (int i = 0; i < 8; ++i) { ua[i] = 0x38383838 + F.lane; ubb[i] = 0x30303030 + F.lane * 3; }
        f32x16 acc0 = {}, acc1 = {}, acc2 = {}, acc3 = {};
        float e0 = F.lane * 0.01f, e1 = e0 + 1, e2 = e0 + 2, e3 = e0 + 3, e4 = e0 + 4, e5 = e0 + 5, e6 = e0 + 6, e7 = e0 + 7;
        ub4i ld0 = {}, ld1 = {}; const unsigned la = (unsigned)(unsigned long)F.lds + F.tid * 16;
#define UB_M(acc) do { if constexpr (MK_UB & 1) acc = __builtin_amdgcn_mfma_scale_f32_32x32x64_f8f6f4(ua, ubb, acc, 0, (MK_UB & 16) ? 1 : 0, 0, 0, 0, 0); } while (0)
#define UB_E() do { if constexpr (MK_UB & 2) { e0 = __builtin_amdgcn_exp2f(e0); e1 = __builtin_amdgcn_exp2f(e1); e2 = __builtin_amdgcn_exp2f(e2); e3 = __builtin_amdgcn_exp2f(e3); \
                                              e4 = __builtin_amdgcn_exp2f(e4); e5 = __builtin_amdgcn_exp2f(e5); e6 = __builtin_amdgcn_exp2f(e6); e7 = __builtin_amdgcn_exp2f(e7); } } while (0)
#define UB_L() do { if constexpr (MK_UB & 4) { asm volatile("ds_read_b128 %0, %1" : "=&v"(ld0) : "v"(la) : "memory"); asm volatile("ds_read_b128 %0, %1 offset:8192" : "=&v"(ld1) : "v"(la) : "memory"); } } while (0)
        for (int it = 0; it < 2000; ++it) {
            UB_M(acc0); __builtin_amdgcn_sched_barrier(0); UB_E(); UB_L(); __builtin_amdgcn_sched_barrier(0);
            UB_M(acc1); __builtin_amdgcn_sched_barrier(0); UB_E(); UB_L(); __builtin_amdgcn_sched_barrier(0);
            UB_M(acc2); __builtin_amdgcn_sched_barrier(0); UB_E(); UB_L(); __builtin_amdgcn_sched_barrier(0);
            UB_M(acc3); __builtin_amdgcn_sched_barrier(0); UB_E(); UB_L(); __builtin_amdgcn_sched_barrier(0);
            if constexpr (MK_UB & 4) asm volatile("s_waitcnt lgkmcnt(0)" ::: "memory");
        }
        const float sink = acc0[0] + acc1[1] + acc2[2] + acc3[3] + e0 + e1 + e2 + e3 + e4 + e5 + e6 + e7 + (float)(ld0[0] + ld1[1]);
        if (sink == 12345.678f) ((unsigned*)args.ws)[CW_CNT + 77] = 1u;
        __syncthreads();
    }
#endif
    LAS unsigned char* gl = F.lds;
    if (EN(0) && IN(0)) { for (int rp = 0; rp < REPS(0); ++rp) { p0_prologue(F); __syncthreads(); } SEAM(0); }
    for (int l = 0; l < DEPTH; ++l) {
        const int pb = 1 + l * NPL;
        if (EN(1) && IN(pb + 0)) { for (int rp = 0; rp < ((l == 0) ? REPS(14) : 1); ++rp) phase_norm(F, l, 0); SEAM(pb + 0); }
        if (EN(2) && IN(pb + 1)) { const WS W = ws_map(F.ws, F.nb);
            pg8::Gemm g{W.H, W.win + (size_t)l * NIN * D, F.T, NIN, D}; pg8::StaticOrder S; S.init(F.T, NIN, F.G, F.bid);
            EpiIn E{W.GQ, W.GK, W.GV, W.SG, W.LGF, W.LGB, W.DQ, W.DK, W.DV, W.SGA, W.SGB, IN_[8] + l * 512, IN_[10] + l * 64, IN_[11] + l * 64, 0};
#ifdef MK_DEPHASE
            { const int g_ = (F.bid >> 3) & 7; for (int k_ = 0; k_ < g_ * MK_DEPHASE; ++k_) __builtin_amdgcn_s_sleep(127); }
#endif
#ifdef MK_INPROJ_PLAIN
            { EpiIn EP_ = E; EP_.plain = 1; pg8::gemm_phase<EpiIn, pg8::StaticOrder, MK_ALIGN, MK_SP2>(gl, g, S, EP_); }
#endif
#ifdef MK_INPROJ_NULL
            { EpiNull EN_; pg8::gemm_phase<EpiNull, pg8::StaticOrder, MK_ALIGN, MK_SP2>(gl, g, S, EN_); }
#endif
            for (int rp = 0; rp < REPS(2); ++rp) pg8::gemm_phase<EpiIn, pg8::StaticOrder, MK_ALIGN, MK_SP2>(gl, g, S, E);
            SEAM(pb + 1);
        }
        if (EN(3) && IN(pb + 2)) { for (int rp = 0; rp < REPS(3); ++rp) phase_gla1(F); SEAM(pb + 2); }
        if (EN(4) && IN(pb + 3)) { phase_gla2(F); SEAM(pb + 3); }
        if (EN(5) && IN(pb + 4)) { for (int rp = 0; rp < REPS(5); ++rp) phase_gla3(F, l); __syncthreads(); }
        if (EN(6) && IN(pb + 5)) {
#ifdef MK_ATT_PROBE
            phase_attn<MK_ATT_PROBE>(F, l);
#endif
            phase_attn<0>(F, l); SEAM(pb + 5); }
        if (EN(7) && IN(pb + 6)) { const WS W = ws_map(F.ws, F.nb);
            pg8::Gemm g{W.OAB, W.wab + (size_t)l * D * D, 0, 0, 512}; MergeOrder S; S.so.init(F.T, D, F.G, F.bid); S.nM = F.T / 256;
            EpiMerge E{W.SGA, W.SGB, W.MERGED, F.T / 256};
            for (int rp = 0; rp < REPS(7); ++rp) pg8::gemm_phase<EpiMerge, MergeOrder, MK_ALIGN, MK_SP2>(gl, g, S, E);
            SEAM(pb + 6);
        }
        if (EN(8) && IN(pb + 7)) { const WS W = ws_map(F.ws, F.nb); const float* modl = W.mod + (size_t)l * NBMAX * 6 * D;
            pg8::Gemm g{W.MERGED, W.wo + (size_t)l * D * D, F.T, D, D}; pg8::StaticOrder S; S.init(F.T, D, F.G, F.bid);
            EpiResid E{l == 0 ? IN_[0] : nullptr, W.XB, modl + 2 * D};
            for (int rp = 0; rp < ((l == 0) ? REPS(8) : 1); ++rp) pg8::gemm_phase<EpiResid, pg8::StaticOrder, MK_ALIGN, MK_SP2>(gl, g, S, E);
            SEAM(pb + 7);
        }
        if (EN(1) && IN(pb + 8)) { for (int rp = 0; rp < REPS(1); ++rp) phase_norm(F, l, 1); SEAM(pb + 8); }
        if (EN(9) && IN(pb + 9)) { const WS W = ws_map(F.ws, F.nb);
            pg8::Gemm g{W.H, W.wr + (size_t)l * 256 * D, F.T, 256, D}; pg8::StaticOrder S; S.init(F.T, 256, F.G, F.bid);
            EpiLogits E{W.LOGITS};
            for (int rp = 0; rp < REPS(9); ++rp) pg8::gemm_phase<EpiLogits, pg8::StaticOrder, MK_ALIGN, MK_SP2>(gl, g, S, E);
            SEAM(pb + 9);
        }
        if (EN(10) && IN(pb + 10)) { phase_select(F, l); SEAM(pb + 10); }
        if (EN(11) && IN(pb + 11)) { for (int rp = 0; rp < REPS(11); ++rp) { phase_gather(F, l); __syncthreads(); } SEAM(pb + 11); }
        if (EN(12) && IN(pb + 12)) { const WS W = ws_map(F.ws, F.nb);
            const int ntile = W.segp[0];
#if MK_MOE_FP8
            pg8::Gemm g{W.XS, (const bf16*)((const unsigned char*)W.w1 + (size_t)l * NE * 1024 * D), 0, 0, D / 2}; GroupedOrder S{W.tilee, ntile * 4, F.G, F.bid};
            EpiAct E{(unsigned char*)W.ACT};
#else
            pg8::Gemm g{W.H, W.w1 + (size_t)l * NE * 1024 * D, 0, 0, D}; GroupedOrder S{W.tilee, ntile * 4, F.G, F.bid, W.stok};
            EpiAct E{W.ACT};
#endif
            for (int rp = 0; rp < REPS(12); ++rp) pg8::gemm_phase<EpiAct, GroupedOrder, MK_ALIGN, MK_SP2, true>(gl, g, S, E);
            SEAM(pb + 12);
        }
        if (EN(13) && IN(pb + 13)) { const WS W = ws_map(F.ws, F.nb);
            const int ntile = W.segp[0];
#if MK_MOE_FP8
            pg8::Gemm g{W.ACT, (const bf16*)((const unsigned char*)W.w2 + (size_t)l * NE * D * DE), 0, 0, DE / 2}; GroupedOrder S{W.tilee, ntile * 4, F.G, F.bid};
#else
            pg8::Gemm g{W.ACT, W.w2 + (size_t)l * NE * D * DE, 0, 0, DE}; GroupedOrder S{W.tilee, ntile * 4, F.G, F.bid, nullptr};
#endif
            EpiYs E{(unsigned char*)W.YS, W.gsort};
            for (int rp = 0; rp < REPS(13); ++rp) pg8::gemm_phase<EpiYs, GroupedOrder, MK_ALIGN, MK_SP2>(gl, g, S, E);
            SEAM(pb + 13);
        }
    }
    if (EN(1) && IN(NPH - 1)) phase_norm(F, 0, 2);
#undef IN
#undef SEAM
}

struct LaunchCfg { int grid; bool ok; };
inline LaunchCfg& launch_cfg() {
    static LaunchCfg c{0, false}; static bool init = false;
    if (!init) { init = true;
        int dev = 0, cus = 0, per_cu = 0;
        if (hipGetDevice(&dev) != hipSuccess || hipDeviceGetAttribute(&cus, hipDeviceAttributeMultiprocessorCount, dev) != hipSuccess) { fprintf(stderr, "mk: device query failed\n"); return c; }
        if (hipFuncSetAttribute((const void*)mk_fwd, hipFuncAttributeMaxDynamicSharedMemorySize, LDS_BYTES) != hipSuccess) { fprintf(stderr, "mk: hipFuncSetAttribute failed\n"); return c; }
        if (hipOccupancyMaxActiveBlocksPerMultiprocessor(&per_cu, (const void*)mk_fwd, NTHR, LDS_BYTES) != hipSuccess || per_cu < 1) { fprintf(stderr, "mk: occupancy query says %d blocks/CU\n", per_cu); (void)hipGetLastError(); return c; }
        c.grid = cus; c.ok = true;
    }
    return c;
}
inline void launch_range(void* const* d_in, float* xbuf, void* d_ws, int nb, int lo, int hi, int li, hipStream_t stream) {
    LaunchCfg& c = launch_cfg(); if (!c.ok) return;
    Args a{}; for (int i = 0; i < 24; ++i) a.in[i] = (const float*)d_in[i];
    a.out = xbuf; a.ws = (unsigned char*)d_ws; a.nb = nb; a.ph_lo = lo; a.ph_hi = hi; a.li = li;
    hipLaunchKernelGGL(mk_fwd, dim3(c.grid), dim3(NTHR), LDS_BYTES, stream, a);
    const hipError_t le = hipPeekAtLastError(); if (le != hipSuccess) fprintf(stderr, "mk: launch [%d,%d) failed: %s\n", lo, hi, hipGetErrorName(le));
}
}
extern "C" void kernel_launch(void* const* d_in, const int* in_sizes, int n_in, void* d_out, int out_size, void* d_ws, size_t ws_size, hipStream_t stream) {
    (void)in_sizes; (void)n_in; (void)out_size;
    static int checked = 0;
    if (!checked) { checked = 1; const mk::WS w = mk::ws_map((unsigned char*)d_ws, 4); if (w.end > ws_size) { fprintf(stderr, "mk: workspace too small: need %zu, have %zu\n", w.end, ws_size); checked = -1; } }
    if (checked < 0) return;
    if (hipMemsetAsync(d_ws, 0, mk::CTL_BYTES, stream) != hipSuccess) return;
    mk::launch_range(d_in, (float*)d_out, d_ws, 4, 0, mk::NPH, 0, stream);
}
```

```cpp
#include <hip/hip_runtime.h>
#include <cstdio>
#include <cstdint>
#include <cmath>
#define MK_ATT_FP8 1
namespace pg8 {
#define PG8_LAS __attribute__((address_space(3)))
typedef unsigned short bf16_t;
typedef short bf16x8 __attribute__((ext_vector_type(8)));
typedef float f32x4 __attribute__((ext_vector_type(4)));
typedef unsigned u32x4 __attribute__((ext_vector_type(4)));
constexpr int BM = 256, BK = 64, HALF = 128, HTB = HALF * BK * 2  , STAGE_BYTES = 8 * HTB, NXCD = 8, WGM = 8;

__host__ __device__ __forceinline__ int lds_byte(int r, int c) { const int st = (r >> 4) * 2 + (c >> 5), rr = r & 15, cc = c & 31, ob = rr * 64 + cc * 2; return st * 1024 + (ob ^ (((ob >> 9) & 1) << 5)); }
__host__ __device__ __forceinline__ void stage_rc(int b, int& R, int& C) { const int st = b / 1024, sb = b % 1024, swz = sb ^ (((sb >> 9) & 1) << 5); R = (st >> 1) * 16 + swz / 64; C = (st & 1) * 32 + (swz % 64) / 2; }
__host__ __device__ __forceinline__ int perm32(int rho) { const int n = rho >> 4, i = rho & 15; return 8 * (i >> 2) + 4 * n + (i & 3); }

struct Unit { int pm, pn; };
struct Gemm { const bf16_t* A; const bf16_t* Bt; int M, N, K; };

struct StaticOrder {
    int nM, nN, nwg, G, c;
    __host__ __device__ void init(int M, int N, int G_, int c_) { nM = M / BM; nN = N / BM; nwg = nM * nN; G = G_; c = c_; }
    __host__ __device__ bool next(int i, Unit& u) const {
        const long L = (long)i * G + c; if (L >= nwg) return false;
        int wgid = (int)L; { const int q = nwg / NXCD, r = nwg % NXCD, xcd = wgid % NXCD, off = wgid / NXCD; wgid = (xcd < r ? xcd * (q + 1) : r * (q + 1) + (xcd - r) * q) + off; }
        const int nig = WGM * nN, gid = wgid / nig, fm = gid * WGM, gsz = (nM - fm) < WGM ? (nM - fm) : WGM;
        u.pm = fm + ((wgid % nig) % gsz); u.pn = (wgid % nig) / gsz; return true;
    }
    __device__ __forceinline__ void a_ready(const Unit&) const {}
    __device__ __forceinline__ void done(const Unit&) const {}
};
__device__ __forceinline__ unsigned cvt_pk_bf16(float lo, float hi) { unsigned r; asm volatile("v_cvt_pk_bf16_f32 %0, %1, %2" : "=v"(r) : "v"(lo), "v"(hi)); return r; }
__device__ __forceinline__ const void* pg8_uniform(const void* p) { const unsigned long long v = (unsigned long long)p;
    const unsigned lo = (unsigned)__builtin_amdgcn_readfirstlane((int)(unsigned)v), hi = (unsigned)__builtin_amdgcn_readfirstlane((int)(unsigned)(v >> 32)); return (const void*)(((unsigned long long)hi << 32) | lo); }
__device__ __forceinline__ void pg8_glds(const void* sbase, unsigned voff, unsigned ldsdst) { unsigned keep;
    asm volatile("s_nop 4\n\ts_mov_b32 %0, m0\n\ts_mov_b32 m0, %3\n\ts_nop 0\n\tglobal_load_lds_dwordx4 %1, %2\n\ts_mov_b32 m0, %0" : "=&s"(keep) : "v"(voff), "s"(sbase), "s"(ldsdst) : "memory"); }
typedef int pg8_v8i __attribute__((ext_vector_type(8)));
typedef int pg8_v4i __attribute__((ext_vector_type(4)));
template <class Epi, class Sched, bool ALIGN_EPI = false, bool SP2 = false, bool GATHER = false>
__device__ __forceinline__ void gemm_phase(PG8_LAS unsigned char* lds, const Gemm g, const Sched& S, const Epi& E) {
    int tid_ = threadIdx.x; asm volatile("" : "+v"(tid_));
    const int tid = tid_, wid = __builtin_amdgcn_readfirstlane(tid >> 6), lane = tid & 63, wr = wid >> 2, wc = wid & 3, fr = lane & 15, fq = lane >> 4;
    const int K = g.K, nt = K / BK;
    unsigned voffA[2], voffB[2]; unsigned vc[2][2] = {}, vn[2][2] = {}, vs[2][2] = {}; (void)vc; (void)vn; (void)vs;
#pragma unroll
    for (int i = 0; i < 2; ++i) { int R, C; stage_rc(tid * 16 + i * 8192, R, C); const int Rb = Epi::PERM ? ((R & ~31) + perm32(R & 31)) : R;
        voffA[i] = (unsigned)(R * K + C) * 2u; voffB[i] = (unsigned)(Rb * K + C) * 2u; }
    const size_t kstep = (size_t)(BK * 2);
    const size_t hstep = (size_t)HALF * K * 2;
    const size_t tstep = 2 * hstep;
    const unsigned ldsw = (unsigned)wid * 1024u; const unsigned lds0 = (unsigned)(unsigned long)lds; (void)lds0;
    const int aoff = lds_byte(wr * 64 + fr, fq * 8), boff = lds_byte(wc * 32 + fr, fq * 8);
#define PG8_SA(b, h) (((b) * 2 + (h)) * HTB)
#define PG8_SB(b, h) ((4 + (b) * 2 + (h)) * HTB)
#if defined(PG8_ASM_STAGE) && PG8_ASM_STAGE
#define PG8_STAGE(bufoff, gbase, voff) do { const void* _gb = pg8_uniform(gbase); _Pragma("unroll") for (int _i = 0; _i < 2; ++_i) \
        pg8_glds(_gb, (voff)[_i], (unsigned)__builtin_amdgcn_readfirstlane((int)(lds0 + (unsigned)(bufoff) + ldsw + _i * 8192))); } while (0)
#else
#define PG8_STAGE(bufoff, gbase, voff) do { _Pragma("unroll") for (int _i = 0; _i < 2; ++_i) \
        __builtin_amdgcn_global_load_lds((const unsigned*)((const char*)(gbase) + (voff)[_i]), (PG8_LAS unsigned*)(lds + (bufoff) + ldsw + _i * 8192), 16, 0, 0); } while (0)
#endif
#define PG8_STAGE_A(b, h, X, VS) do { if constexpr (GATHER) { PG8_STAGE(PG8_SA(b, h), X, VS[h]); } else { PG8_STAGE(PG8_SA(b, h), (X) + (h) * hstep, voffA); } } while (0)
#define PG8_LOADROWS(u, v) do { _Pragma("unroll") for (int i_ = 0; i_ < 2; ++i_) { int R_, C_; stage_rc(tid * 16 + i_ * 8192, R_, C_); _Pragma("unroll") for (int h_ = 0; h_ < 2; ++h_) \
        v[h_][i_] = (unsigned)S.rowidx[(u).pm * 256 + h_ * 128 + R_] * (unsigned)(K * 2) + (unsigned)C_ * 2u; } } while (0)
#define PG8_LDA(dst, b, h) do { _Pragma("unroll") for (int m = 0; m < 4; ++m) _Pragma("unroll") for (int k = 0; k < 2; ++k) dst[m][k] = *(const PG8_LAS bf16x8*)(lds + PG8_SA(b, h) + aoff + m * 2048 + k * 1024); } while (0)
#define PG8_LDB(dst, b, h) do { _Pragma("unroll") for (int n = 0; n < 2; ++n) _Pragma("unroll") for (int k = 0; k < 2; ++k) dst[n][k] = *(const PG8_LAS bf16x8*)(lds + PG8_SB(b, h) + boff + n * 2048 + k * 1024); } while (0)
#define PG8_MMA(ai, bj, At, Bt) do { __builtin_amdgcn_s_setprio(1); _Pragma("unroll") for (int m = 0; m < 4; ++m) _Pragma("unroll") for (int n = 0; n < 2; ++n) _Pragma("unroll") for (int k = 0; k < 2; ++k) \
        acc[ai][bj][m][n] = __builtin_amdgcn_mfma_f32_16x16x32_bf16(Bt[n][k], At[m][k], acc[ai][bj][m][n], 0, 0, 0); __builtin_amdgcn_s_setprio(0); } while (0)
#define PG8_WAIT_V(n) asm volatile("s_waitcnt vmcnt(" #n ")" ::: "memory")
#define PG8_WAIT_L(n) asm volatile("s_waitcnt lgkmcnt(" #n ")" ::: "memory")
#define PG8_BAR __builtin_amdgcn_s_barrier()
#define PG8_SCHED __builtin_amdgcn_sched_barrier(0)
    Unit cur, nxt; int ui = 0;
    if (!S.next(0, cur)) return;
    f32x4 acc[2][2][4][2];
#pragma unroll
    for (int a = 0; a < 2; ++a)
#pragma unroll
        for (int b = 0; b < 2; ++b)
#pragma unroll
            for (int m = 0; m < 4; ++m)
#pragma unroll
                for (int n = 0; n < 2; ++n) acc[a][b][m][n] = (f32x4){0.f, 0.f, 0.f, 0.f};
    bf16x8 At[4][2], B0[2][2], B1[2][2];
    const char* cA = (const char*)g.A + (GATHER ? (size_t)0 : (size_t)cur.pm * tstep); const char* cB = (const char*)g.Bt + (size_t)cur.pn * tstep;
    S.a_ready(cur);
    if constexpr (GATHER) { PG8_LOADROWS(cur, vc); }
    if constexpr (SP2) {
        PG8_STAGE(PG8_SB(0, 0), cB, voffB); PG8_STAGE(PG8_SB(0, 1), cB + hstep, voffB); PG8_STAGE_A(0, 0, cA, vc); PG8_STAGE_A(0, 1, cA, vc);
        if (wr == 1) PG8_BAR;
        PG8_WAIT_V(2); PG8_BAR;
        PG8_STAGE(PG8_SB(1, 0), cB + kstep, voffB); PG8_STAGE_A(1, 0, cA + kstep, vc); PG8_STAGE(PG8_SB(1, 1), cB + hstep + kstep, voffB);
        PG8_WAIT_V(6); PG8_BAR;
    } else {
        PG8_STAGE(PG8_SB(0, 0), cB, voffB); PG8_STAGE_A(0, 0, cA, vc); PG8_STAGE(PG8_SB(0, 1), cB + hstep, voffB); PG8_STAGE_A(0, 1, cA, vc);
        if (wr == 1) PG8_BAR;
        PG8_WAIT_V(4); PG8_BAR;
        PG8_STAGE(PG8_SB(1, 0), cB + kstep, voffB); PG8_STAGE_A(1, 0, cA + kstep, vc); PG8_STAGE(PG8_SB(1, 1), cB + hstep + kstep, voffB);
        PG8_WAIT_V(6); PG8_BAR;
    }
    for (;;) {
        const bool has_next = S.next(ui + 1, nxt);
        const char* nA = (has_next && !GATHER) ? (const char*)g.A + (size_t)nxt.pm * tstep : cA; const char* nB = has_next ? (const char*)g.Bt + (size_t)nxt.pn * tstep : cB;
        for (int t = 0; t < nt; t += 2) {
            const bool last = (t == nt - 2);
            const char* a1 = cA + (size_t)(t + 1) * kstep;
            const char* a2 = last ? nA : cA + (size_t)(t + 2) * kstep; const char* b2 = last ? nB : cB + (size_t)(t + 2) * kstep;
            const char* a3 = a2 + kstep; const char* b3 = b2 + kstep;
            if (last && has_next) S.a_ready(nxt);
            if constexpr (GATHER) { if (last && has_next) { PG8_LOADROWS(nxt, vn); }
                _Pragma("unroll") for (int h_ = 0; h_ < 2; ++h_) _Pragma("unroll") for (int i_ = 0; i_ < 2; ++i_) vs[h_][i_] = (last && has_next) ? vn[h_][i_] : vc[h_][i_]; }
            if constexpr (Epi::MIDK) { if (t == nt / 2) E.mid(acc, cur, wr, wc, fr, fq); }
            if constexpr (SP2) {
            PG8_LDB(B0, 0, 0); PG8_LDB(B1, 0, 1); PG8_SCHED; PG8_LDA(At, 0, 0); PG8_STAGE_A(1, 1, a1, vc);
            PG8_WAIT_V(8); PG8_WAIT_L(0); PG8_BAR; PG8_MMA(0, 0, At, B0); PG8_MMA(0, 1, At, B1); PG8_BAR; PG8_SCHED;
            PG8_LDA(At, 0, 1); PG8_STAGE(PG8_SB(0, 0), b2, voffB); PG8_STAGE(PG8_SB(0, 1), b2 + hstep, voffB); PG8_STAGE_A(0, 0, a2, vs);
            PG8_WAIT_V(8); PG8_WAIT_L(0); PG8_BAR; PG8_MMA(1, 0, At, B0); PG8_MMA(1, 1, At, B1); PG8_BAR; PG8_SCHED;
            PG8_LDB(B0, 1, 0); PG8_LDB(B1, 1, 1); PG8_SCHED; PG8_LDA(At, 1, 0); PG8_STAGE_A(0, 1, a2, vs);
            PG8_WAIT_V(8); PG8_WAIT_L(0); PG8_BAR; PG8_MMA(0, 0, At, B0); PG8_MMA(0, 1, At, B1); PG8_BAR; PG8_SCHED;
            PG8_LDA(At, 1, 1); PG8_STAGE(PG8_SB(1, 0), b3, voffB); PG8_STAGE(PG8_SB(1, 1), b3 + hstep, voffB); PG8_STAGE_A(1, 0, a3, vs);
            PG8_WAIT_V(8); PG8_WAIT_L(0); PG8_BAR; PG8_MMA(1, 0, At, B0); PG8_MMA(1, 1, At, B1); PG8_BAR; PG8_SCHED;
            } else {
            PG8_LDB(B0, 0, 0); PG8_SCHED; PG8_LDA(At, 0, 0); PG8_STAGE_A(1, 1, a1, vc);
            PG8_WAIT_L(8); PG8_BAR; PG8_WAIT_L(0); PG8_MMA(0, 0, At, B0); PG8_BAR; PG8_SCHED;
            PG8_LDB(B1, 0, 1); PG8_STAGE(PG8_SB(0, 0), b2, voffB);
            PG8_BAR; PG8_WAIT_L(0); PG8_MMA(0, 1, At, B1); PG8_BAR;
            PG8_LDA(At, 0, 1); PG8_STAGE_A(0, 0, a2, vs);
            PG8_BAR; PG8_WAIT_L(0); PG8_MMA(1, 0, At, B0); PG8_BAR; PG8_SCHED;
            PG8_STAGE(PG8_SB(0, 1), b2 + hstep, voffB);
            PG8_WAIT_V(6); PG8_BAR; PG8_MMA(1, 1, At, B1); PG8_BAR;
            PG8_LDB(B0, 1, 0); PG8_SCHED; PG8_LDA(At, 1, 0); PG8_STAGE_A(0, 1, a2, vs);
            PG8_WAIT_L(8); PG8_BAR; PG8_WAIT_L(0); PG8_MMA(0, 0, At, B0); PG8_BAR; PG8_SCHED;
            PG8_LDB(B1, 1, 1); PG8_STAGE(PG8_SB(1, 0), b3, voffB);
            PG8_BAR; PG8_WAIT_L(0); PG8_MMA(0, 1, At, B1); PG8_BAR;
            PG8_LDA(At, 1, 1); PG8_STAGE_A(1, 0, a3, vs);
            PG8_BAR; PG8_WAIT_L(0); PG8_MMA(1, 0, At, B0); PG8_BAR; PG8_SCHED;
            PG8_STAGE(PG8_SB(1, 1), b3 + hstep, voffB);
            PG8_WAIT_V(6); PG8_BAR; PG8_MMA(1, 1, At, B1); PG8_BAR;
            }
        }
        if constexpr (ALIGN_EPI) { if (wr == 0) PG8_BAR; }
        if constexpr (!Epi::AFTER_DRAIN) { E(acc, cur, wr, wc, fr, fq); S.done(cur); }
        if (!has_next) break;
#pragma unroll
        for (int a = 0; a < 2; ++a)
#pragma unroll
            for (int b = 0; b < 2; ++b)
#pragma unroll
                for (int m = 0; m < 4; ++m)
#pragma unroll
                    for (int n = 0; n < 2; ++n) acc[a][b][m][n] = (f32x4){0.f, 0.f, 0.f, 0.f};
        cur = nxt; cA = nA; cB = nB; ++ui;
        if constexpr (GATHER) { _Pragma("unroll") for (int h_ = 0; h_ < 2; ++h_) _Pragma("unroll") for (int i_ = 0; i_ < 2; ++i_) vc[h_][i_] = vn[h_][i_]; }
        if constexpr (ALIGN_EPI) { if (wr == 1) PG8_BAR; }
    }
    PG8_WAIT_V(0);
    if constexpr (!ALIGN_EPI) { if (wr == 0) PG8_BAR; }
    PG8_BAR;
    if constexpr (Epi::AFTER_DRAIN) { E.fused(acc, cur, wr, wc, fr, fq, lds, wid, lane); S.done(cur); }
#undef PG8_SA
#undef PG8_SB
#undef PG8_STAGE
#undef PG8_STAGE_A
#undef PG8_LOADROWS
#undef PG8_LDA
#undef PG8_LDB
#undef PG8_MMA
#undef PG8_WAIT_V
#undef PG8_WAIT_L
#undef PG8_BAR
#undef PG8_SCHED
}
}
namespace mk {
constexpr int D = 1024, SEQ = 8192, NBMAX = 4, NH = 4, DIN = 5152, NE = 32, DE = 512, DEPTH = 2;
constexpr int NT_IN = 22, NIN = NT_IN * 256;
constexpr int NWAVES = 8, NTHR = 512;
#ifndef MK_MOE_FP8
#define MK_MOE_FP8 0
#endif
constexpr float WSCALE = 16.f, ASCALE = 4.f, YSCALE = 32.f;
constexpr float LOG2E = 1.4426950408889634f, QSCALE = 0.125f * LOG2E, RMS_EPS = 1e-6f;
constexpr int O_GQ = 0, O_GK = 256, O_GV = 512, O_GG = 1024, O_LRF = 1536, O_LRB = 1552, O_DQ = 1568, O_DK = 2080, O_DV = 2592, O_GA = 3104, O_GB = 4128;
typedef unsigned short bf16;
typedef unsigned u32x4 __attribute__((ext_vector_type(4)));
typedef unsigned u32x2 __attribute__((ext_vector_type(2)));
typedef float f32x4 __attribute__((ext_vector_type(4)));
typedef float f32x16 __attribute__((ext_vector_type(16)));
typedef short bf16x8 __attribute__((ext_vector_type(8)));
typedef short s16x4 __attribute__((ext_vector_type(4)));
#define LAS __attribute__((address_space(3)))
#define GAS __attribute__((address_space(1)))
#define LDS_WAIT() asm volatile("s_waitcnt lgkmcnt(0)" ::: "memory")
#define VM_WAIT() asm volatile("s_waitcnt vmcnt(0)" ::: "memory")

constexpr size_t MiB = 1u << 20;
constexpr size_t CTL_BYTES = 256 * 1024;
constexpr int CW_BAR = 4096;
constexpr int CW_CNT = 32768;
constexpr size_t OFF_MOD = 256 * 1024, OFF_TAB = 512 * 1024;
constexpr size_t OFF_WIN = 1 * MiB, SZ_WIN = (size_t)DEPTH * NIN * D * 2;
constexpr size_t OFF_WAB = OFF_WIN + SZ_WIN, SZ_WAB = (size_t)DEPTH * D * D * 2;
constexpr size_t OFF_WO = OFF_WAB + SZ_WAB, SZ_WO = SZ_WAB;
constexpr size_t OFF_WR = OFF_WO + SZ_WO, SZ_WR = (size_t)DEPTH * 256 * D * 2;
constexpr size_t OFF_W1 = OFF_WR + SZ_WR, SZ_W1 = (size_t)DEPTH * NE * 1024 * D * 2;
constexpr size_t OFF_W2 = OFF_W1 + SZ_W1, SZ_W2 = (size_t)DEPTH * NE * D * DE * 2;
constexpr size_t OFF_ACT = 225 * MiB;
static_assert(OFF_W2 + SZ_W2 <= OFF_ACT, "weights fit");
struct WS {
    unsigned* ctl; float* mod; float* tab;
    bf16 *win, *wab, *wo, *wr, *w1, *w2;
    bf16 *H, *OAB, *XB; int* eid; float* gate; int* rank; int* pos; int* tilee; int* segp;
    bf16 *GQ, *GK, *GV, *SG; bf16 *LGF, *LGB; bf16 *DQ, *DK, *DV, *SGA, *SGB; float* KVT; float* DEC; bf16* MERGED;
    bf16 *XS, *ACT, *YS; float* LOGITS; float* gsort; int* stok;
    size_t end;
};
__host__ __device__ inline WS ws_map(unsigned char* b, int nb) {
    WS w; const size_t T = (size_t)nb * SEQ;
    w.ctl = (unsigned*)b; w.mod = (float*)(b + OFF_MOD); w.tab = (float*)(b + OFF_TAB);
    w.win = (bf16*)(b + OFF_WIN); w.wab = (bf16*)(b + OFF_WAB); w.wo = (bf16*)(b + OFF_WO); w.wr = (bf16*)(b + OFF_WR); w.w1 = (bf16*)(b + OFF_W1); w.w2 = (bf16*)(b + OFF_W2);
    size_t o = OFF_ACT;
    auto take = [&](size_t bytes) { unsigned char* p = b + o; o += (bytes + 255) & ~(size_t)255; return p; };
    w.H = (bf16*)take(T * 2048); w.OAB = (bf16*)take(T * 2048); w.XB = (bf16*)take(T * 2048);
    w.eid = (int*)take(T * 8); w.gate = (float*)take(T * 8); w.rank = (int*)take(T * 8); w.pos = (int*)take(T * 8); w.tilee = (int*)take(4096); w.segp = (int*)take(1024);
    const size_t u0 = o;
    w.GQ = (bf16*)take(T * 512); w.GK = (bf16*)take(T * 512); w.GV = (bf16*)take(T * 1024); w.SG = (bf16*)take(T * 1024);
    w.LGF = (bf16*)take(T * 512); w.LGB = (bf16*)take(T * 512);
    w.DQ = (bf16*)take(T * 1024); w.DK = (bf16*)take(T * 1024); w.DV = (bf16*)take(T * 1024); w.SGA = (bf16*)take(T * 2048); w.SGB = (bf16*)take(T * 2048);
    w.KVT = (float*)take(T * 4096); w.MERGED = (bf16*)w.KVT; w.DEC = (float*)take(T * 32);
    const size_t e1 = o; o = u0;
    const size_t R = 2 * T + 32 * 256;
    w.XS = (bf16*)take(R * 2048); w.ACT = (bf16*)take(R * 1024); w.YS = (bf16*)take(R * 2048); w.LOGITS = (float*)take(T * 256); w.gsort = (float*)take(R * 4); w.stok = (int*)take(R * 4);
    w.end = o > e1 ? o : e1;
    return w;
}

typedef float f32x2_t __attribute__((ext_vector_type(2))); typedef __bf16 bf16x2_t __attribute__((ext_vector_type(2)));
__device__ __forceinline__ unsigned cvt_pk(float lo, float hi) { const f32x2_t v = {lo, hi}; const bf16x2_t b = __builtin_convertvector(v, bf16x2_t); return __builtin_bit_cast(unsigned, b); }
__device__ __forceinline__ float bf2f(unsigned short b) { return __uint_as_float(((unsigned)b) << 16); }
__device__ __forceinline__ float bflo(unsigned w) { return __uint_as_float(w << 16); }
__device__ __forceinline__ float bfhi(unsigned w) { return __uint_as_float(w & 0xffff0000u); }
__device__ __forceinline__ float fsigmoid(float x) { return __builtin_amdgcn_rcpf(1.f + __expf(-x)); }
__device__ __forceinline__ float fsilu(float x) { return x * fsigmoid(x); }
__device__ __forceinline__ float fsigmoid255(float x) { return __builtin_amdgcn_rcpf(fmaf(__expf(-x), 1.f / 255.f, 1.f / 255.f)); }
__device__ __forceinline__ float wave_sum(float v) {
#pragma unroll
    for (int o = 1; o < 64; o <<= 1) v += __shfl_xor(v, o);
    return v;
}
__device__ __forceinline__ int t5_bucket(int rel) {
    int ret = rel > 0 ? 16 : 0; int n = rel < 0 ? -rel : rel;
    if (n < 8) return ret + n;
    return ret + 8 + (n >= 12) + (n >= 16) + (n >= 23) + (n >= 32) + (n >= 46) + (n >= 64) + (n >= 91);
}

#define XB_TMO      128
#define XB_XCNT(j)  (256  + 64 * (j))
#define XB_XSUB(j)  (1280 + 64 * (j))
#define XB_XGEN(j)  (2304 + 64 * (j))
#define XB_TOP      3328
#define XB_TOPGEN   3392
#define XCD_BAR_WORDS 3456
#define XB_SPIN_CAP (1u << 18)
__device__ __forceinline__ unsigned xb_ld(unsigned* p)              { return __hip_atomic_load(p, __ATOMIC_RELAXED, __HIP_MEMORY_SCOPE_AGENT); }
__device__ __forceinline__ unsigned xb_add(unsigned* p, unsigned v) { return __hip_atomic_fetch_add(p, v, __ATOMIC_RELAXED, __HIP_MEMORY_SCOPE_AGENT); }
__device__ __forceinline__ unsigned xb_xcc_id() { return (unsigned)__builtin_amdgcn_s_getreg((3 << 11) | 20) & 0xFu; }
#define XB_SPIN(cond, bar) do { unsigned _sp = 0; while (cond) { __builtin_amdgcn_s_sleep(1); \
    if ((++_sp & 255u) == 0u) { if (xb_ld(&(bar)[XB_TMO])) break; if (_sp > XB_SPIN_CAP) { atomicAdd(&(bar)[XB_TMO], 1u); break; } } } } while (0)
struct XcdBarrier { unsigned* bar; unsigned x; volatile LAS unsigned* st; };
__device__ __forceinline__ XcdBarrier xcd_barrier_post(unsigned* bar, volatile LAS unsigned* st) {
    XcdBarrier b; b.bar = bar; b.x = xb_xcc_id(); b.st = st;
    if (threadIdx.x == 0) (void)xb_add(&bar[XB_XCNT(b.x)], 1u);
    return b;
}
__device__ __forceinline__ void xcd_barrier_complete(unsigned* bar, unsigned x, unsigned& nloc, unsigned& nx) {
    const unsigned G = gridDim.x * gridDim.y * gridDim.z;
    unsigned sum, cnt, mine, sp = 0u;
    for (;;) {
        sum = 0u; cnt = 0u; mine = 0u;
#pragma unroll
        for (unsigned j = 0; j < 16; ++j) { const unsigned c = xb_ld(&bar[XB_XCNT(j)]); sum += c; cnt += (c > 0u) ? 1u : 0u; mine = (j == x) ? c : mine; }
        if (sum == G) break;
        __builtin_amdgcn_s_sleep(1);
        if ((++sp & 255u) == 0u) { if (xb_ld(&bar[XB_TMO])) break; if (sp > XB_SPIN_CAP) { atomicAdd(&bar[XB_TMO], 1u); break; } }
    }
    nloc = mine > 0u ? mine : 1u; nx = cnt > 0u ? cnt : 1u;
}
__device__ __forceinline__ void xcd_barrier(const XcdBarrier& b) {
    asm volatile("s_waitcnt vmcnt(0)" ::: "memory");
    __syncthreads();
    if (threadIdx.x == 0) {
        unsigned* bar = b.bar;
        __builtin_amdgcn_s_waitcnt(0);
        unsigned nloc = b.st[0], nx = b.st[1];
        if (nloc == 0u) { xcd_barrier_complete(bar, b.x, nloc, nx); b.st[0] = nloc; b.st[1] = nx; }
        const unsigned old = xb_add(&bar[XB_XSUB(b.x)], 1u);
        const unsigned gen = old / nloc;
        if (old + 1u == (gen + 1u) * nloc) {
            __builtin_amdgcn_fence(__ATOMIC_RELEASE, "agent");
            asm volatile("s_waitcnt vmcnt(0)" ::: "memory");
            const unsigned og = xb_add(&bar[XB_TOP], 1u);
            const unsigned tg = og / nx;
            if (og + 1u == (tg + 1u) * nx) xb_add(&bar[XB_TOPGEN], 1u);
            else XB_SPIN(xb_ld(&bar[XB_TOPGEN]) == tg, bar);
            __builtin_amdgcn_fence(__ATOMIC_ACQUIRE, "agent");
            xb_add(&bar[XB_XGEN(b.x)], 1u);
            asm volatile("s_waitcnt vmcnt(0)" ::: "memory");
        } else {
            XB_SPIN(xb_ld(&bar[XB_XGEN(b.x)]) == gen, bar);
            __builtin_amdgcn_fence(__ATOMIC_ACQUIRE, "agent");
            asm volatile("s_waitcnt vmcnt(0)" ::: "memory");
        }
    }
    __syncthreads();
}

struct Args { const float* in[24]; float* out; unsigned char* ws; int nb, ph_lo, ph_hi, li; };
struct Frame {
    LAS unsigned char* lds; int tid, lane, wave, G, bid, nb, T; unsigned char* ws; const Args* a; float* xbuf;
};
__device__ __forceinline__ void refresh(Frame& F) { int t = threadIdx.x; asm volatile("" : "+v"(t)); F.tid = t; F.lane = t & 63; F.wave = __builtin_amdgcn_readfirstlane(t >> 6); }
constexpr int LDS_BYTES = 160 * 1024 - 64 * 0;
constexpr int LDS_MISC = 160 * 1024 - 256;

__device__ __forceinline__ void tr_item(const float* src, int lds_, int ks0, int c0, bf16* dst, int ldd, int r0, int kd0, LAS float* scr, int lane, float scale = 1.f) {
#pragma unroll 8
    for (int i = 0; i < 32; ++i) { const int kk = 2 * i + (lane >> 5); scr[kk * 33 + (lane & 31)] = src[(size_t)(ks0 + kk) * lds_ + c0 + (lane & 31)] * scale; }
    LDS_WAIT(); asm volatile("" ::: "memory");
    const int c = lane & 7;
#pragma unroll
    for (int j = 0; j < 4; ++j) { const int n = (lane >> 3) + 8 * j; const LAS float* s = scr + (8 * c) * 33 + n;
        u32x4 o; o.x = cvt_pk(s[0 * 33], s[1 * 33]); o.y = cvt_pk(s[2 * 33], s[3 * 33]); o.z = cvt_pk(s[4 * 33], s[5 * 33]); o.w = cvt_pk(s[6 * 33], s[7 * 33]);
        *(u32x4*)(dst + (size_t)(r0 + n) * ldd + kd0 + 8 * c) = o; }
    LDS_WAIT(); asm volatile("" ::: "memory");
}
__device__ __forceinline__ void tr_item8(const float* src, int lds_, int ks0, int c0, unsigned char* dst, int ldd, int r0, int kd0, float scale, LAS float* scr, int lane) {
#pragma unroll 8
    for (int i = 0; i < 32; ++i) { const int kk = 2 * i + (lane >> 5); scr[kk * 33 + (lane & 31)] = src[(size_t)(ks0 + kk) * lds_ + c0 + (lane & 31)] * scale; }
    LDS_WAIT(); asm volatile("" ::: "memory");
    const int c = lane & 7;
#pragma unroll
    for (int j = 0; j < 4; ++j) { const int n = (lane >> 3) + 8 * j; const LAS float* s = scr + (8 * c) * 33 + n;
        int w0 = 0, w1 = 0;
        w0 = __builtin_amdgcn_cvt_pk_fp8_f32(s[0 * 33], s[1 * 33], w0, false); w0 = __builtin_amdgcn_cvt_pk_fp8_f32(s[2 * 33], s[3 * 33], w0, true);
        w1 = __builtin_amdgcn_cvt_pk_fp8_f32(s[4 * 33], s[5 * 33], w1, false); w1 = __builtin_amdgcn_cvt_pk_fp8_f32(s[6 * 33], s[7 * 33], w1, true);
        u32x2 o; o.x = (unsigned)w0; o.y = (unsigned)w1;
        *(u32x2*)(dst + (size_t)(r0 + n) * ldd + kd0 + 8 * c) = o; }
    LDS_WAIT(); asm volatile("" ::: "memory");
}
__device__ __forceinline__ int win_src_col(int tile, int p0) {
    const int bj = p0 >> 7, wc = (p0 >> 5) & 3; const int L = 64 * wc + 32 * bj;
    switch (tile) {
        case 0: return O_GQ + p0; case 1: return O_GK + p0;
        case 2: case 3: return O_GV + (tile - 2) * 256 + p0;
        case 4: case 5: return O_GG + (tile - 4) * 256 + p0;
        case 8: case 9: return O_DQ + (tile - 8) * 256 + L;
        case 10: case 11: return O_DK + (tile - 10) * 256 + L;
        case 12: case 13: return O_DV + (tile - 12) * 256 + p0;
        case 14: case 15: case 16: case 17: return O_GA + (tile - 14) * 256 + p0;
        default: return O_GB + (tile - 18) * 256 + p0;
    }
}
__device__ __forceinline__ void p0_prologue(Frame& F) {
    refresh(F);
    const WS W = ws_map(F.ws, F.nb); const float* const* IN_ = F.a->in;
    const float* c_in = IN_[1]; const float* w_ada = IN_[2]; const float* b_ada = IN_[3];
    {
        LAS float* red = (LAS float*)F.lds;
        for (int it = F.bid; it < DEPTH * 96; it += F.G) {
            const int l = it / 96, j = (it % 96) * 64 + F.lane;
            const float* w = w_ada + (size_t)l * D * 6 * D + j;
            float a0 = 0.f, a1 = 0.f, a2 = 0.f, a3 = 0.f;
            const int kbeg = F.wave * 128;
#pragma unroll 16
            for (int k = kbeg; k < kbeg + 128; ++k) { const float wv = w[(size_t)k * 6 * D];
                const float c0 = c_in[k], c1 = c_in[D + k], c2 = c_in[2 * D + k], c3 = c_in[3 * D + k];
                a0 += fsilu(c0) * wv; a1 += fsilu(c1) * wv; a2 += fsilu(c2) * wv; a3 += fsilu(c3) * wv; }
            red[(F.wave * 4 + 0) * 64 + F.lane] = a0; red[(F.wave * 4 + 1) * 64 + F.lane] = a1; red[(F.wave * 4 + 2) * 64 + F.lane] = a2; red[(F.wave * 4 + 3) * 64 + F.lane] = a3;
            __syncthreads();
            if (F.tid < 256) { const int b = F.tid >> 6, jj = F.tid & 63; float s = 0.f;
#pragma unroll
                for (int wv = 0; wv < 8; ++wv) s += red[(wv * 4 + b) * 64 + jj];
                const int jc = (it % 96) * 64 + jj;
                W.mod[((size_t)l * NBMAX + b) * 6 * D + jc] = s + b_ada[l * 6 * D + jc]; }
            __syncthreads();
        }
    }
    if (F.bid == 0) {
        const float* rb = IN_[14];
        for (int i = F.tid; i < 1024; i += NTHR) { const int h = i >> 8, rel = (i & 255) - 128; W.tab[i] = (rb[t5_bucket(rel) * 4 + h] - rb[31 * 4 + h]) * LOG2E; }
        if (F.tid < 4) W.tab[1024 + F.tid] = __expf(rb[15 * 4 + F.tid] - rb[31 * 4 + F.tid]);
        if (F.tid >= 64 && F.tid < 64 + DEPTH) { const int l = F.tid - 64; const float* lv = IN_[12] + l * 256; float s1 = 0.f, s2 = 0.f;
            for (int i = 0; i < 64; ++i) { s1 += lv[i] * lv[64 + i]; s2 += lv[128 + i] * lv[192 + i]; }
            W.tab[1032 + l] = expf(s1) - expf(s2) + (0.8f - 0.6f * expf(-0.3f * (float)l)); }
    }
    __syncthreads();
    LAS float* scr = (LAS float*)(F.lds + F.wave * 16384);
    const int gw = F.bid * NWAVES + F.wave, NGW = F.G * NWAVES;
    constexpr int I_IN = (NIN / 32) * 16, I_AB = 32 * 16, I_O = 32 * 16, I_1 = NE * 32 * 16, I_2 = NE * 32 * 8;
    constexpr int PER_L = I_IN + I_AB + I_O + I_1 + I_2;
    for (int it = gw; it < DEPTH * PER_L; it += NGW) {
        const int l = it / PER_L; int r = it % PER_L;
        if (r < I_IN) { const int rb = r / 16, kb = r % 16, R = rb * 32, tile = R >> 8, p0 = R & 255;
            if (tile == 6 || tile == 7) continue;
            tr_item(IN_[6] + (size_t)l * D * DIN, DIN, kb * 64, win_src_col(tile, p0), W.win + (size_t)l * NIN * D, D, R, kb * 64, scr, F.lane); continue; }
        r -= I_IN;
        if (r < I_AB) { const int rb = r / 16, kb = r % 16;
            if (kb < 8) tr_item(IN_[15] + (size_t)l * 512 * D, D, kb * 64, rb * 32, W.wab + (size_t)l * D * D, 512, rb * 32, kb * 64, scr, F.lane, 1.f / 255.f);
            else tr_item(IN_[16] + (size_t)l * 512 * D, D, (kb - 8) * 64, rb * 32, W.wab + (size_t)l * D * D + (size_t)1024 * 512, 512, rb * 32, (kb - 8) * 64, scr, F.lane, 1.f / 255.f);
            continue; }
        r -= I_AB;
        if (r < I_O) { const int rb = r / 16, kb = r % 16; tr_item(IN_[17] + (size_t)l * D * D, D, kb * 64, rb * 32, W.wo + (size_t)l * D * D, D, rb * 32, kb * 64, scr, F.lane); continue; }
        r -= I_O;
        if (r < I_1) { const int e = r / 512, q = r % 512, rb = q / 16, kb = q % 16, R = rb * 32, pn = R >> 8, p = R & 255;
            const int col = (p < 128) ? (128 * pn + p) : (512 + 128 * pn + p - 128);
            tr_item(IN_[22] + ((size_t)l * NE + e) * D * 1024, 1024, kb * 64, col, W.w1 + ((size_t)l * NE + e) * 1024 * D, D, R, kb * 64, scr, F.lane); continue; }
        r -= I_1;
        { const int e = r / 256, q = r % 256, rb = q / 8, kb = q % 8;
          tr_item(IN_[23] + ((size_t)l * NE + e) * DE * D, D, kb * 64, rb * 32, W.w2 + ((size_t)l * NE + e) * D * DE, DE, rb * 32, kb * 64, scr, F.lane); }
    }
    for (int it = gw; it < DEPTH * 2 * 8 * 16; it += NGW) {
        const int l = it >> 8, dir = (it >> 7) & 1, nbk = (it >> 4) & 7, kb = it & 15; const int k = kb * 64 + F.lane;
        const float* wi = IN_[6] + (size_t)l * D * DIN + (size_t)k * DIN + (dir ? O_LRB : O_LRF);
        float wv[16];
#pragma unroll
        for (int r = 0; r < 16; ++r) wv[r] = wi[r];
        const float* wu = IN_[7] + ((size_t)l * 2 + dir) * 16 * 256;
        bf16* dst = W.win + (size_t)l * NIN * D + (size_t)((6 + dir) * 256) * D;
        for (int n = nbk * 32; n < nbk * 32 + 32; ++n) { float s = 0.f;
#pragma unroll
            for (int r = 0; r < 16; ++r) s += wv[r] * wu[r * 256 + n];
            dst[(size_t)n * D + k] = (bf16)(cvt_pk(s, 0.f) & 0xffffu); }
    }
    for (int it = gw * 64 + F.lane; it < DEPTH * 256 * 128; it += NGW * 64) {
        const int l = it / (256 * 128), q = it % (256 * 128), row = q >> 7, k0 = (q & 127) * 8;
        float v[8];
#pragma unroll
        for (int i = 0; i < 8; ++i) { float x = 0.f;
            if (row < 4) x = IN_[18][((size_t)l * D + k0 + i) * 4 + row]; else if (row < 36) x = IN_[20][((size_t)l * D + k0 + i) * 32 + row - 4];
            v[i] = x; }
        u32x4 o; o.x = cvt_pk(v[0], v[1]); o.y = cvt_pk(v[2], v[3]); o.z = cvt_pk(v[4], v[5]); o.w = cvt_pk(v[6], v[7]);
        *(u32x4*)(W.wr + ((size_t)l * 256 + row) * D + k0) = o;
    }
}

struct NormRow { f32x4 xf[4]; u32x2 xb[4]; unsigned ya[4], yc[4]; };
__device__ __forceinline__ void norm_load(NormRow& r, const float* xin, const bf16* XB, const unsigned char* YS, int t, int lane, bool from_in, bool combine, int p0, int p1) {
    if (from_in) { const GAS f32x4* xr = (const GAS f32x4*)(xin + (size_t)t * D) + lane;
#pragma unroll
        for (int j = 0; j < 4; ++j) r.xf[j] = xr[64 * j]; }
    else { const GAS u32x2* xr = (const GAS u32x2*)(XB + (size_t)t * D) + lane;
#pragma unroll
        for (int j = 0; j < 4; ++j) r.xb[j] = xr[64 * j]; }
    if (combine) { const GAS unsigned* y0 = (const GAS unsigned*)(YS + (size_t)p0 * D) + lane; const GAS unsigned* y1 = (const GAS unsigned*)(YS + (size_t)p1 * D) + lane;
#pragma unroll
        for (int j = 0; j < 4; ++j) { r.ya[j] = y0[64 * j]; r.yc[j] = y1[64 * j]; } }
}
__device__ __forceinline__ void phase_norm(Frame& F, int l, int mode) {
    refresh(F);
    const WS W = ws_map(F.ws, F.nb); const float* const* IN_ = F.a->in;
    const int gw = F.bid * NWAVES + F.wave, NGW = F.G * NWAVES;
    const bool combine = (mode == 2) || (mode == 0 && l > 0);
    const bool from_in = (mode == 0 && l == 0);
    const int lp = (mode == 2) ? DEPTH - 1 : l - 1;
    const float* ng = (mode == 1 ? IN_[5] : IN_[4]) + (size_t)(mode == 2 ? 0 : l) * D;
    NormRow r0, r1, r2, r3;
    int bcur = -1; f32x4 vA[4], vSH[4], vG2[4];
    auto compute = [&](const NormRow& cur, int t) {
        const int b = t / SEQ;
        if (b != bcur) { bcur = b;
            const float* md = W.mod + ((size_t)l * NBMAX + b) * 6 * D + (mode == 1 ? 3 * D : 0);
            const float* g2 = W.mod + ((size_t)lp * NBMAX + b) * 6 * D + 5 * D;
#pragma unroll
            for (int j = 0; j < 4; ++j) {
                if (mode != 2) { const f32x4 g = *((const GAS f32x4*)ng + F.lane + 64 * j), sc = *((const GAS f32x4*)(md + D) + F.lane + 64 * j); vSH[j] = *((const GAS f32x4*)md + F.lane + 64 * j);
                    vA[j] = (f32x4){g.x * (1.f + sc.x), g.y * (1.f + sc.y), g.z * (1.f + sc.z), g.w * (1.f + sc.w)}; }
                if (combine) vG2[j] = *((const GAS f32x4*)g2 + F.lane + 64 * j) * (1.f / YSCALE); } }
        f32x4 v[4];
        if (from_in) {
#pragma unroll
            for (int j = 0; j < 4; ++j) v[j] = cur.xf[j]; }
        else {
#pragma unroll
            for (int j = 0; j < 4; ++j) { const u32x2 a = cur.xb[j]; v[j] = (f32x4){bflo(a.x), bfhi(a.x), bflo(a.y), bfhi(a.y)}; } }
        if (combine) {
#pragma unroll
            for (int j = 0; j < 4; ++j) { const unsigned a = cur.ya[j], c = cur.yc[j]; const f32x4 g = vG2[j];
                v[j].x += g.x * (__builtin_amdgcn_cvt_f32_fp8((int)a, 0) + __builtin_amdgcn_cvt_f32_fp8((int)c, 0)); v[j].y += g.y * (__builtin_amdgcn_cvt_f32_fp8((int)a, 1) + __builtin_amdgcn_cvt_f32_fp8((int)c, 1));
                v[j].z += g.z * (__builtin_amdgcn_cvt_f32_fp8((int)a, 2) + __builtin_amdgcn_cvt_f32_fp8((int)c, 2)); v[j].w += g.w * (__builtin_amdgcn_cvt_f32_fp8((int)a, 3) + __builtin_amdgcn_cvt_f32_fp8((int)c, 3)); }
            if (mode == 2) { GAS f32x4* xo = (GAS f32x4*)(F.xbuf + (size_t)t * D) + F.lane;
#pragma unroll
                for (int j = 0; j < 4; ++j) xo[64 * j] = v[j]; }
            else { GAS u32x2* xo = (GAS u32x2*)(W.XB + (size_t)t * D) + F.lane;
#pragma unroll
                for (int j = 0; j < 4; ++j) { u32x2 o; o.x = cvt_pk(v[j].x, v[j].y); o.y = cvt_pk(v[j].z, v[j].w); xo[64 * j] = o; } }
        }
        if (mode != 2) {
            float ss = 0.f;
#pragma unroll
            for (int j = 0; j < 4; ++j) ss += (v[j].x * v[j].x + v[j].y * v[j].y) + (v[j].z * v[j].z + v[j].w * v[j].w);
            const float rstd = rsqrtf(wave_sum(ss) * (1.f / D) + RMS_EPS);
            GAS u32x2* ho = (GAS u32x2*)(W.H + (size_t)t * D) + F.lane;
#pragma unroll
            for (int j = 0; j < 4; ++j) { const f32x4 g = vA[j], sh = vSH[j];
                const float h0 = v[j].x * rstd * g.x + sh.x, h1 = v[j].y * rstd * g.y + sh.y, h2 = v[j].z * rstd * g.z + sh.z, h3 = v[j].w * rstd * g.w + sh.w;
                u32x2 o; o.x = cvt_pk(h0, h1); o.y = cvt_pk(h2, h3); ho[64 * j] = o; }
        }
    };
    auto slots = [&](int t, int& p0, int& p1) { p0 = 0; p1 = 0; if (combine && t < F.T) { p0 = W.pos[t * 2]; p1 = W.pos[t * 2 + 1]; } };
    auto load = [&](NormRow& r, int t, int p0, int p1) { if (t < F.T) norm_load(r, IN_[0], W.XB, (const unsigned char*)W.YS, t, F.lane, from_in, combine, p0, p1); };
    int q0, q1, n0, n1;
    slots(gw, q0, q1); load(r0, gw, q0, q1); slots(gw + NGW, q0, q1); load(r1, gw + NGW, q0, q1); slots(gw + 2 * NGW, q0, q1); load(r2, gw + 2 * NGW, q0, q1);
    slots(gw + 3 * NGW, q0, q1);
    for (int t = gw; t < F.T; t += 4 * NGW) {
        load(r3, t + 3 * NGW, q0, q1); slots(t + 4 * NGW, n0, n1); compute(r0, t);
        if (t + NGW < F.T) { load(r0, t + 4 * NGW, n0, n1); slots(t + 5 * NGW, q0, q1); compute(r1, t + NGW); }
        if (t + 2 * NGW < F.T) { load(r1, t + 5 * NGW, q0, q1); slots(t + 6 * NGW, n0, n1); compute(r2, t + 2 * NGW); }
        if (t + 3 * NGW < F.T) { load(r2, t + 6 * NGW, n0, n1); slots(t + 7 * NGW, q0, q1); compute(r3, t + 3 * NGW); }
    }
}
typedef pg8::Unit Unit;
__device__ __forceinline__ u32x4 pack8(const f32x4& a, const f32x4& b) { u32x4 w; w.x = cvt_pk(a[0], a[1]); w.y = cvt_pk(a[2], a[3]); w.z = cvt_pk(b[0], b[1]); w.w = cvt_pk(b[2], b[3]); return w; }

#ifndef MK_ATT_FP8
#define MK_ATT_FP8 1
#endif
__device__ __forceinline__ u32x2 pack8_fp8(const f32x4& a, const f32x4& b) { int w0 = 0, w1 = 0;
    w0 = __builtin_amdgcn_cvt_pk_fp8_f32(a[0], a[1], w0, false); w0 = __builtin_amdgcn_cvt_pk_fp8_f32(a[2], a[3], w0, true);
    w1 = __builtin_amdgcn_cvt_pk_fp8_f32(b[0], b[1], w1, false); w1 = __builtin_amdgcn_cvt_pk_fp8_f32(b[2], b[3], w1, true);
    u32x2 r; r.x = (unsigned)w0; r.y = (unsigned)w1; return r; }
struct EpiNull {
    static constexpr bool PERM = true, AFTER_DRAIN = false, MIDK = false;
    __device__ __forceinline__ void operator()(const f32x4 (&acc)[2][2][4][2], const Unit&, int, int, int, int) const {
#pragma unroll
        for (int a = 0; a < 2; ++a)
#pragma unroll
            for (int b = 0; b < 2; ++b)
#pragma unroll
                for (int m = 0; m < 4; ++m) { asm volatile("" :: "v"(acc[a][b][m][0]), "v"(acc[a][b][m][1])); } }
};
struct EpiIn {
    static constexpr bool PERM = true, AFTER_DRAIN = false, MIDK = false;
    bf16 *GQ, *GK, *GV, *SG, *LGF, *LGB, *DQ, *DK, *DV, *SGA, *SGB; const float* b_up; const float* qg; const float* kg; int plain;
    __device__ __forceinline__ void operator()(const f32x4 (&acc)[2][2][4][2], const Unit& u, int wr, int wc, int fr, int fq) const {
        const int pn = u.pn; const int row0 = u.pm * 256 + wr * 64 + fr;
        if (pn >= 8 && pn <= 11) {
            const bool isk = pn >= 10; const int head = 2 * ((pn - 8) & 1) + (wc >> 1), c = wc & 1;
            const float* gv = isk ? kg : qg; const float sc = isk ? 1.f : QSCALE;
            f32x4 g[2][2];
#pragma unroll
            for (int bj = 0; bj < 2; ++bj)
#pragma unroll
                for (int n = 0; n < 2; ++n) g[bj][n] = *(const f32x4*)(gv + 32 * bj + 8 * fq + 4 * n);
#pragma unroll
            for (int ai = 0; ai < 2; ++ai)
#pragma unroll
                for (int m = 0; m < 4; ++m) {
                    const int r = row0 + ai * 128 + m * 16, b = r / SEQ, s = r % SEQ;
                    float ss = 0.f;
#pragma unroll
                    for (int bj = 0; bj < 2; ++bj)
#pragma unroll
                        for (int n = 0; n < 2; ++n) { const f32x4 x = acc[ai][bj][m][n]; ss += (x[0] * x[0] + x[1] * x[1]) + (x[2] * x[2] + x[3] * x[3]); }
                    ss += __shfl_xor(ss, 16); ss += __shfl_xor(ss, 32);
                    const float rs = rsqrtf(ss * (1.f / 64.f) + RMS_EPS) * sc;
#if MK_ATT_FP8
                    unsigned char* dst8 = (unsigned char*)(isk ? DK : DQ) + ((((size_t)b * NH + head) * 2 + c) * SEQ + s) * 64;
#pragma unroll
                    for (int bj = 0; bj < 2; ++bj) {
                        const f32x4 v0 = acc[ai][bj][m][0] * rs * g[bj][0], v1 = acc[ai][bj][m][1] * rs * g[bj][1];
                        int chunk = 2 * bj + (fq >> 1); if (isk) chunk ^= ((s >> 2) & 3);
                        *(u32x2*)(dst8 + chunk * 16 + 8 * (fq & 1)) = pack8_fp8(v0, v1);
                    }
#else
                    bf16* dst = (isk ? DK : DQ) + ((((size_t)b * NH + head) * 2 + c) * SEQ + s) * 64;
#pragma unroll
                    for (int bj = 0; bj < 2; ++bj) {
                        const f32x4 v0 = acc[ai][bj][m][0] * rs * g[bj][0], v1 = acc[ai][bj][m][1] * rs * g[bj][1];
                        int chunk = 4 * bj + fq; if (isk) chunk ^= ((s >> 1) & 7);
                        *(u32x4*)(dst + chunk * 8) = pack8(v0, v1);
                    }
#endif
                }
            return;
        }
#pragma unroll
        for (int ai = 0; ai < 2; ++ai)
#pragma unroll
            for (int m = 0; m < 4; ++m) {
                const int r = row0 + ai * 128 + m * 16;
#pragma unroll
                for (int bj = 0; bj < 2; ++bj) {
                    const int c0 = 128 * bj + 32 * wc + 8 * fq;
                    f32x4 v0 = acc[ai][bj][m][0], v1 = acc[ai][bj][m][1];
                    if (plain) { *(u32x4*)(SGA + (size_t)r * D + (pn & 3) * 256 + c0) = pack8(v0, v1); }
                    else if (pn == 0) { *(u32x4*)(GQ + (size_t)r * 256 + c0) = pack8(v0 * 0.125f, v1 * 0.125f); }
                    else if (pn == 1) { *(u32x4*)(GK + (size_t)r * 256 + c0) = pack8(v0, v1); }
                    else if (pn <= 3) { *(u32x4*)(GV + (size_t)r * 512 + (pn - 2) * 256 + c0) = pack8(v0, v1); }
                    else if (pn <= 5) {
#pragma unroll
                        for (int i = 0; i < 4; ++i) { v0[i] = fsilu(v0[i]); v1[i] = fsilu(v1[i]); }
                        *(u32x4*)(SG + (size_t)r * 512 + (pn - 4) * 256 + c0) = pack8(v0, v1); }
                    else if (pn <= 7) {
                        const float* bu = b_up + (pn - 6) * 256 + c0; const f32x4 b0 = *(const f32x4*)bu, b1 = *(const f32x4*)(bu + 4);
#pragma unroll
                        for (int i = 0; i < 4; ++i) { float z = v0[i] + b0[i]; v0[i] = (fminf(z, 0.f) - __logf(1.f + __expf(-fabsf(z)))) * (1.f / 16.f);
                                                      z = v1[i] + b1[i]; v1[i] = (fminf(z, 0.f) - __logf(1.f + __expf(-fabsf(z)))) * (1.f / 16.f); }
                        *(u32x4*)((pn == 6 ? LGF : LGB) + (size_t)r * 256 + c0) = pack8(v0, v1); }
#if MK_ATT_FP8
                    else if (pn <= 13) {
                        const int b = r / SEQ, s = r % SEQ, head = 2 * (pn - 12) + bj;
                        const int kk = s & 63, wkey = kk & 31, hh_ = (wkey >> 2) & 1, reg_ = (wkey & 3) + 4 * (wkey >> 3), pos = hh_ * 32 + 16 * (kk >> 5) + reg_;
                        unsigned char* tb = (unsigned char*)DV + (((size_t)b * NH + head) * (SEQ / 64) + (s >> 6)) * 8192;
                        const u32x2 pk = pack8_fp8(v0, v1); const int dv0 = 32 * wc + 8 * fq;
#pragma unroll
                        for (int i = 0; i < 8; ++i) { const int dv = dv0 + i; const unsigned byte = ((i < 4 ? pk.x : pk.y) >> (8 * (i & 3))) & 0xffu;
                            tb[dv * 64 + ((((pos >> 4) ^ ((dv >> 2) & 3)) << 4) | (pos & 15))] = (unsigned char)byte; } }
#else
                    else if (pn <= 13) {
                        const int b = r / SEQ, s = r % SEQ, head = 2 * (pn - 12) + bj;
                        bf16* dst = DV + ((((size_t)b * NH + head) * (SEQ / 8) + (s >> 3)) * 4 + wc) * 256 + (s & 7) * 32 + 8 * fq;
                        *(u32x4*)dst = pack8(v0, v1); }
#endif
                    else {
#pragma unroll
                        for (int i = 0; i < 4; ++i) { v0[i] = fsigmoid255(v0[i]); v1[i] = fsigmoid255(v1[i]); }
                        unsigned char* base = (pn <= 17) ? (unsigned char*)SGA + (pn - 14) * 256 : (unsigned char*)SGB + (pn - 18) * 256;
                        u32x2 q; q.x = 0u; q.y = 0u;
                        q.x = __builtin_amdgcn_cvt_pk_u8_f32(v0[0], 0, q.x); q.x = __builtin_amdgcn_cvt_pk_u8_f32(v0[1], 1, q.x); q.x = __builtin_amdgcn_cvt_pk_u8_f32(v0[2], 2, q.x); q.x = __builtin_amdgcn_cvt_pk_u8_f32(v0[3], 3, q.x);
                        q.y = __builtin_amdgcn_cvt_pk_u8_f32(v1[0], 0, q.y); q.y = __builtin_amdgcn_cvt_pk_u8_f32(v1[1], 1, q.y); q.y = __builtin_amdgcn_cvt_pk_u8_f32(v1[2], 2, q.y); q.y = __builtin_amdgcn_cvt_pk_u8_f32(v1[3], 3, q.y);
                        *(u32x2*)(base + (size_t)r * D + c0) = q; }
                }
            }
    }
};

struct EpiMerge {
    static constexpr bool PERM = true, AFTER_DRAIN = false, MIDK = false;
    const bf16* SGA; const bf16* SGB; bf16* O; int nM;
    __device__ __forceinline__ void operator()(const f32x4 (&acc)[2][2][4][2], const Unit& u, int wr, int wc, int fr, int fq) const {
        const int sel = u.pn >> 2; const int row0 = (u.pm - sel * nM) * 256 + wr * 64 + fr, col0 = (u.pn & 3) * 256 + wc * 32 + 8 * fq;
        const unsigned char* G = (const unsigned char*)(sel ? SGB : SGA);
#pragma unroll
        for (int ai = 0; ai < 2; ++ai) {
            u32x2 gt[4][2]; u32x4 t1[4][2];
#pragma unroll
            for (int m = 0; m < 4; ++m) { const size_t off = (size_t)(row0 + ai * 128 + m * 16) * D + col0;
#pragma unroll
                for (int bj = 0; bj < 2; ++bj) { gt[m][bj] = *(const u32x2*)(G + off + bj * 128); if (sel) t1[m][bj] = *(const u32x4*)(O + off + bj * 128); } }
#pragma unroll
            for (int m = 0; m < 4; ++m) { const size_t off = (size_t)(row0 + ai * 128 + m * 16) * D + col0;
#pragma unroll
                for (int bj = 0; bj < 2; ++bj) { const u32x2 b = gt[m][bj];
                    f32x4 v0 = acc[ai][bj][m][0], v1 = acc[ai][bj][m][1];
                    v0[0] *= (float)(b.x & 0xffu); v0[1] *= (float)((b.x >> 8) & 0xffu); v0[2] *= (float)((b.x >> 16) & 0xffu); v0[3] *= (float)(b.x >> 24);
                    v1[0] *= (float)(b.y & 0xffu); v1[1] *= (float)((b.y >> 8) & 0xffu); v1[2] *= (float)((b.y >> 16) & 0xffu); v1[3] *= (float)(b.y >> 24);
                    if (sel) { const u32x4 t = t1[m][bj];
                        v0[0] += bflo(t.x); v0[1] += bfhi(t.x); v0[2] += bflo(t.y); v0[3] += bfhi(t.y); v1[0] += bflo(t.z); v1[1] += bfhi(t.z); v1[2] += bflo(t.w); v1[3] += bfhi(t.w); }
                    *(u32x4*)(O + off + bj * 128) = pack8(v0, v1); } }
            asm volatile("" ::: "memory");
        }
    }
};
struct MergeOrder {
    pg8::StaticOrder so; int nM;
    __device__ __forceinline__ bool next(int i, Unit& u) const { Unit t; if (!so.next(i >> 1, t)) return false; const int sel = i & 1; u.pm = t.pm + sel * nM; u.pn = t.pn + sel * 4; return true; }
    __device__ __forceinline__ void a_ready(const Unit&) const {}
    __device__ __forceinline__ void done(const Unit&) const {}
};

struct EpiResid {
    static constexpr bool PERM = true, AFTER_DRAIN = false, MIDK = false;
    const float* xin32; bf16* xb; const float* g1;
    __device__ __forceinline__ void operator()(const f32x4 (&acc)[2][2][4][2], const Unit& u, int wr, int wc, int fr, int fq) const {
        const int row0 = u.pm * 256 + wr * 64 + fr, col0 = u.pn * 256 + wc * 32 + 8 * fq;
        const int b = (u.pm * 256) / SEQ; const float* g = g1 + (size_t)b * 6 * D + col0;
        f32x4 gv[2][2];
#pragma unroll
        for (int bj = 0; bj < 2; ++bj)
#pragma unroll
            for (int n = 0; n < 2; ++n) gv[bj][n] = *(const f32x4*)(g + bj * 128 + n * 4);
        if (xin32) {
#pragma unroll
            for (int ai = 0; ai < 2; ++ai)
#pragma unroll
                for (int mh = 0; mh < 2; ++mh) { f32x4 x0[2][2], x1[2][2];
#pragma unroll
                    for (int m2 = 0; m2 < 2; ++m2) { const size_t off = (size_t)(row0 + ai * 128 + (2 * mh + m2) * 16) * D + col0;
#pragma unroll
                        for (int bj = 0; bj < 2; ++bj) { x0[m2][bj] = *(const f32x4*)(xin32 + off + bj * 128); x1[m2][bj] = *(const f32x4*)(xin32 + off + bj * 128 + 4); } }
#pragma unroll
                    for (int m2 = 0; m2 < 2; ++m2) { const int m = 2 * mh + m2; const size_t off = (size_t)(row0 + ai * 128 + m * 16) * D + col0;
#pragma unroll
                        for (int bj = 0; bj < 2; ++bj) *(u32x4*)(xb + off + bj * 128) = pack8(x0[m2][bj] + gv[bj][0] * acc[ai][bj][m][0], x1[m2][bj] + gv[bj][1] * acc[ai][bj][m][1]); }
                    asm volatile("" ::: "memory"); }
        } else {
#pragma unroll
            for (int ai = 0; ai < 2; ++ai) { u32x4 xr[4][2];
#pragma unroll
                for (int m = 0; m < 4; ++m) { const size_t off = (size_t)(row0 + ai * 128 + m * 16) * D + col0;
#pragma unroll
                    for (int bj = 0; bj < 2; ++bj) xr[m][bj] = *(const u32x4*)(xb + off + bj * 128); }
#pragma unroll
                for (int m = 0; m < 4; ++m) { const size_t off = (size_t)(row0 + ai * 128 + m * 16) * D + col0;
#pragma unroll
                    for (int bj = 0; bj < 2; ++bj) { const u32x4 a = xr[m][bj];
                        const f32x4 x0 = {bflo(a.x), bfhi(a.x), bflo(a.y), bfhi(a.y)}, x1 = {bflo(a.z), bfhi(a.z), bflo(a.w), bfhi(a.w)};
                        *(u32x4*)(xb + off + bj * 128) = pack8(x0 + gv[bj][0] * acc[ai][bj][m][0], x1 + gv[bj][1] * acc[ai][bj][m][1]); } }
                asm volatile("" ::: "memory"); }
        }
    }
};

struct EpiLogits {
    static constexpr bool PERM = false, AFTER_DRAIN = false, MIDK = false;
    float* L;
    __device__ __forceinline__ void operator()(const f32x4 (&acc)[2][2][4][2], const Unit& u, int wr, int wc, int fr, int fq) const {
        if (wc >= 2) return;
        const int row0 = u.pm * 256 + wr * 64 + fr, col0 = wc * 32 + 4 * fq;
#pragma unroll
        for (int ai = 0; ai < 2; ++ai)
#pragma unroll
            for (int m = 0; m < 4; ++m)
#pragma unroll
                for (int n = 0; n < 2; ++n) *(f32x4*)(L + (size_t)(row0 + ai * 128 + m * 16) * 64 + col0 + n * 16) = acc[ai][0][m][n];
    }
};

#ifndef MK_MOE_FP8
#define MK_MOE_FP8 0
#endif
#if MK_MOE_FP8
struct EpiAct {
    static constexpr bool PERM = true, AFTER_DRAIN = false, MIDK = false;
    unsigned char* ACT;
    __device__ __forceinline__ void operator()(const f32x4 (&acc)[2][2][4][2], const Unit& u, int wr, int wc, int fr, int fq) const {
        const int row0 = u.pm * 256 + wr * 64 + fr, col0 = (u.pn & 3) * 128 + wc * 32 + 8 * fq;
        constexpr float inv = 1.f / WSCALE;
#pragma unroll
        for (int ai = 0; ai < 2; ++ai)
#pragma unroll
            for (int m = 0; m < 4; ++m) { f32x4 v0, v1;
#pragma unroll
                for (int i = 0; i < 4; ++i) { v0[i] = fsilu(acc[ai][0][m][0][i] * inv) * acc[ai][1][m][0][i] * (inv * ASCALE); v1[i] = fsilu(acc[ai][0][m][1][i] * inv) * acc[ai][1][m][1][i] * (inv * ASCALE); }
                *(u32x2*)(ACT + (size_t)(row0 + ai * 128 + m * 16) * DE + col0) = pack8_fp8(v0, v1); }
    }
};
struct EpiYs {
    static constexpr bool PERM = true, AFTER_DRAIN = false, MIDK = false;
    bf16* YS; const float* gs;
    __device__ __forceinline__ void operator()(const f32x4 (&acc)[2][2][4][2], const Unit& u, int wr, int wc, int fr, int fq) const {
        const int row0 = u.pm * 256 + wr * 64 + fr, col0 = (u.pn & 3) * 256 + wc * 32 + 8 * fq;
#pragma unroll
        for (int ai = 0; ai < 2; ++ai)
#pragma unroll
            for (int m = 0; m < 4; ++m) { const int r = row0 + ai * 128 + m * 16; const float gt = gs[r] * (1.f / (WSCALE * ASCALE));
#pragma unroll
                for (int bj = 0; bj < 2; ++bj) *(u32x4*)(YS + (size_t)r * D + col0 + bj * 128) = pack8(acc[ai][bj][m][0] * gt, acc[ai][bj][m][1] * gt); }
    }
};
#else
struct EpiAct {
    static constexpr bool PERM = true, AFTER_DRAIN = false, MIDK = false;
    bf16* ACT;
    __device__ __forceinline__ void operator()(const f32x4 (&acc)[2][2][4][2], const Unit& u, int wr, int wc, int fr, int fq) const {
        const int row0 = u.pm * 256 + wr * 64 + fr, col0 = (u.pn & 3) * 128 + wc * 32 + 8 * fq;
#pragma unroll
        for (int ai = 0; ai < 2; ++ai)
#pragma unroll
            for (int m = 0; m < 4; ++m) { f32x4 v0, v1;
#pragma unroll
                for (int i = 0; i < 4; ++i) { v0[i] = fsilu(acc[ai][0][m][0][i]) * acc[ai][1][m][0][i]; v1[i] = fsilu(acc[ai][0][m][1][i]) * acc[ai][1][m][1][i]; }
                *(u32x4*)(ACT + (size_t)(row0 + ai * 128 + m * 16) * DE + col0) = pack8(v0, v1); }
    }
};
struct EpiYs {
    static constexpr bool PERM = true, AFTER_DRAIN = false, MIDK = false;
    unsigned char* YS; const float* gs;
    __device__ __forceinline__ void operator()(const f32x4 (&acc)[2][2][4][2], const Unit& u, int wr, int wc, int fr, int fq) const {
        const int row0 = u.pm * 256 + wr * 64 + fr, col0 = (u.pn & 3) * 256 + wc * 32 + 8 * fq;
        float gts[2][4];
#pragma unroll
        for (int ai = 0; ai < 2; ++ai)
#pragma unroll
            for (int m = 0; m < 4; ++m) gts[ai][m] = gs[row0 + ai * 128 + m * 16] * YSCALE;
#pragma unroll
        for (int ai = 0; ai < 2; ++ai)
#pragma unroll
            for (int m = 0; m < 4; ++m) { const int r = row0 + ai * 128 + m * 16; const float gt = gts[ai][m];
#pragma unroll
                for (int bj = 0; bj < 2; ++bj) *(u32x2*)(YS + (size_t)r * D + col0 + bj * 128) = pack8_fp8(acc[ai][bj][m][0] * gt, acc[ai][bj][m][1] * gt); }
    }
};
#endif
struct GroupedOrder {
    const int* tilee; int U, G, c; const int* rowidx;
    __device__ __forceinline__ bool next(int i, Unit& u) const {
        int id;
        if ((G & 7) == 0) { const int gx = G >> 3, per = (U + 7) >> 3, n = i * gx + (c >> 3); if (n >= per) return false; id = (c & 7) * per + n; if (id >= U) return false; }
        else { id = i * G + c; if (id >= U) return false; }
        const int t = id >> 2; u.pm = t; u.pn = tilee[t] * 4 + (id & 3); return true;
    }
    __device__ __forceinline__ void a_ready(const Unit&) const {}
    __device__ __forceinline__ void done(const Unit&) const {}
};
constexpr int AT_KR = 0, AT_VR = 32768, AT_TAB = 98304, AT_SLOT = 8192;
typedef int v8i __attribute__((ext_vector_type(8)));
typedef int v4i __attribute__((ext_vector_type(4)));
__device__ __forceinline__ int crow(int r, int hi) { return (r & 3) + 8 * (r >> 2) + 4 * hi; }

__device__ __forceinline__ void attn_bias(f32x16& s0, f32x16& s1, int relbase, const LAS float* tabh) {
#pragma unroll
    for (int r = 0; r < 16; ++r) {
        int i0 = relbase + (r & 3) + 8 * (r >> 2); int i1 = i0 + 32;
        i0 = i0 < 0 ? 0 : (i0 > 255 ? 255 : i0); i1 = i1 < 0 ? 0 : (i1 > 255 ? 255 : i1);
        s0[r] += tabh[i0]; s1[r] += tabh[i1];
    }
}
template <int J>
__device__ __forceinline__ void attn_exp_chunk(f32x16& s0, f32x16& s1, float& lsum) {
    float ls = 0.f;
#pragma unroll
    for (int r = 4 * J; r < 4 * J + 4; ++r) { s0[r] = __builtin_amdgcn_exp2f(s0[r]); s1[r] = __builtin_amdgcn_exp2f(s1[r]); }
    (void)ls; (void)lsum;
}
__device__ __forceinline__ int pk4_bf8(float a, float b, float c, float d) {
    const unsigned lo = __builtin_bit_cast(unsigned, __builtin_amdgcn_cvt_pkrtz(a, b)), hi = __builtin_bit_cast(unsigned, __builtin_amdgcn_cvt_pkrtz(c, d));
    return (int)__builtin_amdgcn_perm(hi, lo, 0x07050301u);
}
#define AT_CM4 ((f32x16){-4.f, -4.f, -4.f, -4.f, -4.f, -4.f, -4.f, -4.f, -4.f, -4.f, -4.f, -4.f, -4.f, -4.f, -4.f, -4.f})
__device__ __forceinline__ void glds16(const unsigned char* sbase, unsigned voff, unsigned lds_dst) { unsigned keep;
    asm volatile("s_mov_b32 %0, m0\n\ts_mov_b32 m0, %3\n\ts_nop 0\n\tglobal_load_lds_dwordx4 %1, %2\n\ts_mov_b32 m0, %0" : "=&s"(keep) : "v"(voff), "s"(sbase), "s"(lds_dst) : "memory"); }
__device__ __forceinline__ void attn_dma_k(unsigned lds0, const unsigned char* kg0, int t, int slot, int wid, int lane) {
    glds16(kg0 + (size_t)(wid >> 2) * SEQ * 64 + (size_t)t * 4096 + (wid & 3) * 1024, (unsigned)lane * 16u, (unsigned)__builtin_amdgcn_readfirstlane((int)(lds0 + AT_KR + slot * AT_SLOT + wid * 1024)));
}
__device__ __forceinline__ void attn_dma_v(unsigned lds0, const unsigned char* vg0, int t, int slot, int wid, int lane) {
    glds16(vg0 + (size_t)t * 8192 + wid * 1024, (unsigned)lane * 16u, (unsigned)__builtin_amdgcn_readfirstlane((int)(lds0 + AT_VR + slot * AT_SLOT + wid * 1024)));
}
#define AT_RD128(dst, addr, off) asm volatile("ds_read_b128 %0, %1 offset:%c2" : "=&v"(dst) : "v"(addr), "i"(off) : "memory")
#define AT_MFMA8(a, b, c) __builtin_amdgcn_mfma_scale_f32_32x32x64_f8f6f4(a, b, c, 0, 0, 0, 0, 0, 0)
#define AT_MFMA8B(a, b, c) __builtin_amdgcn_mfma_scale_f32_32x32x64_f8f6f4(a, b, c, 0, 1, 0, 0, 0, 0)

template <int VAR>
__device__ __forceinline__ void phase_attn(Frame& F, int l) {
    refresh(F);
    const WS W = ws_map(F.ws, F.nb); const float* const* IN_ = F.a->in; (void)IN_; (void)W;
    const int lane = F.lane, wid = F.wave, r32 = lane & 31, hh = lane >> 5, qg = wid & 3, c = wid >> 2;
    LAS unsigned char* lds = F.lds; const unsigned lds0 = (unsigned)(unsigned long)lds;
    LAS float* tab = (LAS float*)(lds + AT_TAB);
    for (int i = F.tid; i < 1028; i += NTHR) tab[i] = W.tab[i];
    const float lam = W.tab[1032 + l]; const float lam_init = 0.8f - 0.6f * __expf(-0.3f * (float)l);
    const float* subg = IN_[13] + l * 128;
    const int U = F.nb * NH * 64;
    const int gx = F.G >> 3, per = U >> 3;
    const int sw = (r32 >> 2) & 3;
    const unsigned ka0 = lds0 + AT_KR + c * 4096 + r32 * 64 + (((2 * hh) ^ sw) << 4), ka1 = lds0 + AT_KR + c * 4096 + r32 * 64 + (((2 * hh + 1) ^ sw) << 4);
    const unsigned va0 = lds0 + AT_VR + r32 * 64 + (((2 * hh) ^ sw) << 4), va1 = lds0 + AT_VR + r32 * 64 + (((2 * hh + 1) ^ sw) << 4);
#ifndef MK_ATT_1BAR
#define MK_ATT_1BAR 1
#endif
    const bool lag = (MK_ATT_1BAR == 0) && wid >= 4;
    __syncthreads();
    for (int i = 0;; ++i) {
        int id;
        if ((F.G & 7) == 0) { const int n = i * gx + (F.bid >> 3); if (n >= per) break; id = (F.bid & 7) * per + n; }
        else { id = i * F.G + F.bid; if (id >= U) break; }
        const int bh = id >> 6, qb = id & 63, b = bh >> 2, h = bh & 3;
        const int qw0 = qb * 128 + 32 * qg;
        const unsigned char* kg0 = (const unsigned char*)W.DK + ((size_t)bh * 2) * SEQ * 64;
        const unsigned char* vg0 = (const unsigned char*)W.DV + (size_t)bh * SEQ * 128;
        v8i qf; { const unsigned char* qp = (const unsigned char*)W.DQ + (((size_t)bh * 2 + c) * SEQ + qw0 + r32) * 64 + 32 * hh;
            const v4i q0 = *(const v4i*)qp, q1 = *(const v4i*)(qp + 16); qf = (v8i){q0[0], q0[1], q0[2], q0[3], q1[0], q1[1], q1[2], q1[3]}; }
        asm volatile("s_waitcnt vmcnt(0)" ::: "memory");
        attn_dma_k(lds0, kg0, 0, 0, wid, lane); attn_dma_k(lds0, kg0, 1, 1, wid, lane); attn_dma_v(lds0, vg0, 0, 7, wid, lane); attn_dma_v(lds0, vg0, 0, 0, wid, lane);
        attn_dma_k(lds0, kg0, 2, 2, wid, lane); attn_dma_v(lds0, vg0, 1, 1, wid, lane); attn_dma_k(lds0, kg0, 3, 3, wid, lane);
        attn_dma_v(lds0, vg0, 2, 2, wid, lane); attn_dma_v(lds0, vg0, 3, 3, wid, lane); attn_dma_v(lds0, vg0, 4, 4, wid, lane); attn_dma_v(lds0, vg0, 5, 5, wid, lane);
        f32x16 o[4]; f32x4 osum = f32x4{};
#pragma unroll
        for (int dt = 0; dt < 4; ++dt) o[dt] = f32x16{};
        v8i ones8; { const int on = (((lane & 15) < 8) == (((lane >> 4) & 1) == 0)) ? 0x38383838 : 0; ones8 = (v8i){on, on, on, on, on, on, on, on}; }
        asm volatile("" : "+v"(ones8));
        const int tL = (qw0 >= 154) ? ((qw0 - 154) >> 6) + 1 : 0, tR = (qw0 + 185) >> 6;
        const float shl = tab[1024 + h];
        const LAS float* tabh = tab + h * 256;
        const int rel0 = -qw0 - r32 + 4 * hh + 128;
        asm volatile("s_waitcnt vmcnt(7)" ::: "memory"); __builtin_amdgcn_s_barrier(); asm volatile("" ::: "memory");
        f32x16 s0, s1; v8i p = {0, 0, 0, 0, 0, 0, 0, 0};
        v4i fa0, fa1, fb0, fb1;
        {   v4i kx[4];
            AT_RD128(kx[0], ka0, 0); AT_RD128(kx[1], ka1, 0); AT_RD128(kx[2], ka0, 2048); AT_RD128(kx[3], ka1, 2048);
            AT_RD128(fa0, va0, 7 * AT_SLOT); AT_RD128(fa1, va1, 7 * AT_SLOT); AT_RD128(fb0, va0, 7 * AT_SLOT + 2048); AT_RD128(fb1, va1, 7 * AT_SLOT + 2048);
            asm volatile("s_waitcnt lgkmcnt(4)" ::: "memory"); __builtin_amdgcn_sched_barrier(0);
            s0 = AT_MFMA8(((v8i){kx[0][0], kx[0][1], kx[0][2], kx[0][3], kx[1][0], kx[1][1], kx[1][2], kx[1][3]}), qf, AT_CM4);
            s1 = AT_MFMA8(((v8i){kx[2][0], kx[2][1], kx[2][2], kx[2][3], kx[3][0], kx[3][1], kx[3][2], kx[3][3]}), qf, AT_CM4); }
        __builtin_amdgcn_s_barrier(); asm volatile("" ::: "memory");
        const bool near0 = (0 >= tL) && (0 < tR);
#define AT_EXP8(sv, b0) do { if constexpr (!(VAR & 1)) { _Pragma("unroll") for (int r_ = (b0); r_ < (b0) + 8; ++r_) sv[r_] = __builtin_amdgcn_exp2f(sv[r_]); } } while (0)
#define AT_RDV(dst, addr, off) do { if constexpr (!(VAR & 4)) AT_RD128(dst, addr, off); else asm volatile("" : "=v"(dst)); } while (0)
#define AT_RDK(dst, addr, off) do { if constexpr (!(VAR & 16)) AT_RD128(dst, addr, off); else asm volatile("" : "=v"(dst)); } while (0)
#define AT_PV(dst, a, b) do { if constexpr (!(VAR & 2)) dst = AT_MFMA8B(a, b, dst); } while (0)
#define AT_SUM(b) do { if constexpr (!(VAR & 2)) osum = __builtin_amdgcn_mfma_scale_f32_16x16x128_f8f6f4(ones8, b, osum, 0, 1, 0, 0, 0, 0); } while (0)
#define AT_QK(dst, a) do { if constexpr (!(VAR & 8)) { const v8i a_ = (a); asm volatile("v_mfma_f32_32x32x64_f8f6f4 %0, %1, %2, -4.0" : "=&v"(dst) : "v"(a_), "v"(qf)); } } while (0)
#define AT_PK(dst, sv, b0) do { if constexpr (!(VAR & 32)) dst = pk4_bf8(sv[b0], sv[(b0) + 1], sv[(b0) + 2], sv[(b0) + 3]); else dst = __builtin_bit_cast(int, sv[b0]); } while (0)
#define AT_V8(a, b) ((v8i){a[0], a[1], a[2], a[3], b[0], b[1], b[2], b[3]})
#define AT_LGKM(n) do { asm volatile("s_waitcnt lgkmcnt(" #n ")" ::: "memory"); __builtin_amdgcn_sched_barrier(0); } while (0)
#define AT_STEP(SL, t) do { \
            if ((t) - 1 == tL) { _Pragma("unroll") for (int dt = 0; dt < 4; ++dt) o[dt] *= shl; osum *= shl; }    \
            AT_SUM(p); __builtin_amdgcn_sched_barrier(0);                                                           \
            if constexpr (!(VAR & 128)) { const int tk = (t) + 4 < 128 ? (t) + 4 : 127, tv = (t) + 6 < 128 ? (t) + 6 : 127; attn_dma_k(lds0, kg0, tk, (SL) & 3, wid, lane); attn_dma_v(lds0, vg0, tv, ((SL) + 6) & 7, wid, lane); } \
            { v4i fc0, fc1, fd0, fd1, fk0, fk1, fk2, fk3; \
              if ((t) >= tL && (t) < tR) { attn_bias(s0, s1, 64 * (t) + rel0, tabh); AT_EXP8(s0, 0); }           \
              AT_RDV(fc0, va0, (((SL) + 7) & 7) * AT_SLOT + 4096); AT_RDV(fc1, va1, (((SL) + 7) & 7) * AT_SLOT + 4096); AT_RDV(fd0, va0, (((SL) + 7) & 7) * AT_SLOT + 6144); AT_RDV(fd1, va1, (((SL) + 7) & 7) * AT_SLOT + 6144); \
              AT_RDK(fk0, ka0, (((SL) + 1) & 3) * AT_SLOT); AT_RDK(fk1, ka1, (((SL) + 1) & 3) * AT_SLOT); \
              AT_LGKM(6); \
              AT_PV(o[0], AT_V8(fa0, fa1), p); \
              AT_RDK(fk2, ka0, (((SL) + 1) & 3) * AT_SLOT + 2048); AT_RDK(fk3, ka1, (((SL) + 1) & 3) * AT_SLOT + 2048); \
              AT_EXP8(s0, 8); \
              __builtin_amdgcn_sched_barrier(0); \
              AT_PV(o[1], AT_V8(fb0, fb1), p); \
              AT_EXP8(s1, 0); \
              AT_LGKM(4); \
              AT_PV(o[2], AT_V8(fc0, fc1), p); \
              AT_RDV(fa0, va0, ((SL) & 7) * AT_SLOT); AT_RDV(fa1, va1, ((SL) & 7) * AT_SLOT); \
              AT_EXP8(s1, 8); \
              __builtin_amdgcn_sched_barrier(0); \
              AT_PV(o[3], AT_V8(fd0, fd1), p); \
              AT_RDV(fb0, va0, ((SL) & 7) * AT_SLOT + 2048); AT_RDV(fb1, va1, ((SL) & 7) * AT_SLOT + 2048); \
              AT_PK(p[0], s0, 0); AT_PK(p[1], s0, 4); AT_PK(p[2], s0, 8); AT_PK(p[3], s0, 12); \
              AT_LGKM(6); \
              AT_QK(s0, AT_V8(fk0, fk1)); \
              AT_PK(p[4], s1, 0); AT_PK(p[5], s1, 4); AT_PK(p[6], s1, 8); AT_PK(p[7], s1, 12); \
              AT_LGKM(4); \
              AT_QK(s1, AT_V8(fk2, fk3)); \
              asm volatile("" : "+v"(p));                            \
              if (!((t) + 1 >= tL && (t) + 1 < tR)) { asm volatile("s_nop 3" ::: "memory"); AT_EXP8(s0, 0); asm volatile("" : "+v"(s0)); } }     \
            asm volatile("s_waitcnt vmcnt(5)" ::: "memory"); if constexpr (!(VAR & 64)) __builtin_amdgcn_s_barrier(); asm volatile("" ::: "memory"); } while (0)
        if (!near0) { AT_EXP8(s0, 0); }
        for (int t0 = 0; t0 < 128; t0 += 8) { AT_STEP(0, t0); AT_STEP(1, t0 + 1); AT_STEP(2, t0 + 2); AT_STEP(3, t0 + 3); AT_STEP(4, t0 + 4); AT_STEP(5, t0 + 5); AT_STEP(6, t0 + 6); AT_STEP(7, t0 + 7); }
#undef AT_STEP
#undef AT_EXP8
#undef AT_RDV
#undef AT_RDK
#undef AT_PV
#undef AT_SUM
#undef AT_QK
#undef AT_PK
        {
            v4i fc0, fc1, fd0, fd1;
            AT_RD128(fc0, va0, 7 * AT_SLOT + 4096); AT_RD128(fc1, va1, 7 * AT_SLOT + 4096); AT_RD128(fd0, va0, 7 * AT_SLOT + 6144); AT_RD128(fd1, va1, 7 * AT_SLOT + 6144);
            if (127 == tL) { _Pragma("unroll") for (int dt = 0; dt < 4; ++dt) o[dt] *= shl; osum *= shl; }
            osum = __builtin_amdgcn_mfma_scale_f32_16x16x128_f8f6f4(ones8, p, osum, 0, 1, 0, 0, 0, 0);
            AT_LGKM(0);
            o[0] = AT_MFMA8B(AT_V8(fa0, fa1), p, o[0]); o[1] = AT_MFMA8B(AT_V8(fb0, fb1), p, o[1]); o[2] = AT_MFMA8B(AT_V8(fc0, fc1), p, o[2]); o[3] = AT_MFMA8B(AT_V8(fd0, fd1), p, o[3]);
        }
#undef AT_LGKM
#undef AT_V8
        asm volatile("s_waitcnt vmcnt(0)" ::: "memory"); __builtin_amdgcn_s_barrier(); asm volatile("" ::: "memory");
        const float lt = __shfl(osum[0], r32 + (r32 >= 16 ? 16 : 0));
        LAS float* xch = (LAS float*)(lds + qg * 16384);
        if (c == 1) { const float f = lam / lt;
#pragma unroll
            for (int dt = 0; dt < 4; ++dt)
#pragma unroll
                for (int r = 0; r < 16; ++r) xch[(dt * 16 + r) * 64 + lane] = o[dt][r] * f; }
        LDS_WAIT(); __builtin_amdgcn_s_barrier(); asm volatile("" ::: "memory");
        if (c == 0) { const float f = 1.f / lt; float ss = 0.f;
#pragma unroll
            for (int dt = 0; dt < 4; ++dt)
#pragma unroll
                for (int r = 0; r < 16; ++r) { const float v = o[dt][r] * f - xch[(dt * 16 + r) * 64 + lane]; o[dt][r] = v; ss += v * v; }
            ss += __shfl_xor(ss, 32);
            const float rn = rsqrtf(ss * (1.f / 128.f) + RMS_EPS) * (1.f - lam_init);
            bf16* orow = W.OAB + (size_t)F.T * 512 + ((size_t)b * SEQ + qw0 + r32) * 512 + h * 128;
#pragma unroll
            for (int dt = 0; dt < 4; ++dt)
#pragma unroll
                for (int g = 0; g < 4; ++g) { const int dv = 32 * dt + 8 * g + 4 * hh; const f32x4 sg = *(const f32x4*)(subg + dv);
                    u32x2 ov; ov.x = cvt_pk(o[dt][4 * g] * rn * sg[0], o[dt][4 * g + 1] * rn * sg[1]); ov.y = cvt_pk(o[dt][4 * g + 2] * rn * sg[2], o[dt][4 * g + 3] * rn * sg[3]);
                    *(u32x2*)(orow + dv) = ov; }
        }
        LDS_WAIT(); __builtin_amdgcn_s_barrier(); asm volatile("" ::: "memory");
    }
}
constexpr int GL_CUM = 0;
constexpr int GL_S64 = 144, GL_S192 = 400;
constexpr int G1_KEF = 34816, G1_KEB = G1_KEF + 64 * GL_S64, G1_VT = G1_KEB + 64 * GL_S64;
constexpr int G3_AOP = 34816, G3_KIF = G3_AOP + 64 * GL_S192, G3_KIB = G3_KIF + 64 * GL_S64, G3_BOP = G3_KIB + 64 * GL_S64;
static_assert(G3_BOP + 128 * GL_S192 <= 150 * 1024, "GLA LDS");

__device__ __forceinline__ bf16x8 lds_frag(const LAS unsigned char* base, int row, int stride, int kbyte) { return *(const LAS bf16x8*)(base + row * stride + kbyte); }

struct GlaIn { u32x2 lg[4]; u32x4 k, v0, v1, q, st[4], sg0, sg1; };
template <bool G3>
__device__ __forceinline__ void gla_load(const Frame& F, const WS& W, int u, GlaIn& r) {
    const int n = u & 127, bh = u >> 7, b = bh >> 2, h = bh & 3; const size_t trow0 = (size_t)b * SEQ + n * 64;
#pragma unroll
    for (int it = 0; it < 4; ++it) { const int idx = F.tid + it * NTHR; const int dir = idx >> 10, t = (idx >> 4) & 63, d4 = (idx & 15) * 4;
        r.lg[it] = *(const u32x2*)((dir ? W.LGB : W.LGF) + (trow0 + t) * 256 + h * 64 + d4); }
    const int t = F.tid >> 3, d0 = (F.tid & 7) * 8, v0 = (F.tid & 7) * 16;
    r.k = *(const u32x4*)(W.GK + (trow0 + t) * 256 + h * 64 + d0);
    r.v0 = *(const u32x4*)(W.GV + (trow0 + t) * 512 + h * 128 + v0); r.v1 = *(const u32x4*)(W.GV + (trow0 + t) * 512 + h * 128 + v0 + 8);
    if constexpr (G3) {
        r.q = *(const u32x4*)(W.GQ + (trow0 + t) * 256 + h * 64 + d0);
        const int dv = F.tid >> 2, dd0 = (F.tid & 3) * 16;
#pragma unroll
        for (int dir = 0; dir < 2; ++dir) { const bf16* sp = (const bf16*)W.KVT + ((size_t)u * 2 + dir) * 8192 + dv * 64 + dd0; r.st[2 * dir] = *(const u32x4*)sp; r.st[2 * dir + 1] = *(const u32x4*)(sp + 8); }
        r.sg0 = *(const u32x4*)(W.SG + (trow0 + t) * 512 + h * 128 + v0); r.sg1 = *(const u32x4*)(W.SG + (trow0 + t) * 512 + h * 128 + v0 + 8);
    }
}
__device__ __forceinline__ void gla_cum(Frame& F, const GlaIn& r) {
    LAS float* cum = (LAS float*)(F.lds + GL_CUM);
#pragma unroll
    for (int it = 0; it < 4; ++it) { const int idx = F.tid + it * NTHR; const int dir = idx >> 10, t = (idx >> 4) & 63, d4 = (idx & 15) * 4;
        const u32x2 a = r.lg[it];
        *(LAS f32x4*)(cum + (dir * 64 + t) * 64 + d4) = (f32x4){bflo(a.x), bfhi(a.x), bflo(a.y), bfhi(a.y)}; }
    __syncthreads();
    {
        const int dir = F.tid >> 8, seg = (F.tid >> 6) & 3, d = F.tid & 63; LAS float* cc = cum + dir * 4096 + d; LAS float* tot = cum + 8192 + (dir * 4 + seg) * 64 + d;
        float v[16]; float run = 0.f;
        if (dir == 0) {
#pragma unroll
            for (int i = 0; i < 16; ++i) { run += cc[(16 * seg + i) * 64]; v[i] = run; }
        } else {
#pragma unroll
            for (int i = 15; i >= 0; --i) { run += cc[(16 * seg + i) * 64]; v[i] = run; }
        }
        *tot = run;
        __syncthreads();
        float off = 0.f; const LAS float* tb = cum + 8192 + dir * 256 + d;
        if (dir == 0) { if (seg > 0) off += tb[0]; if (seg > 1) off += tb[64]; if (seg > 2) off += tb[128]; }
        else { if (seg < 3) off += tb[192]; if (seg < 2) off += tb[128]; if (seg < 1) off += tb[64]; }
#pragma unroll
        for (int i = 0; i < 16; ++i) cc[(16 * seg + i) * 64] = v[i] + off;
    }
    __syncthreads();
}

__device__ __forceinline__ void phase_gla1(Frame& F) {
    refresh(F);
    const WS W = ws_map(F.ws, F.nb); const float* const* IN_ = F.a->in; (void)IN_; (void)W;
    LAS unsigned char* lds = F.lds; LAS float* cum = (LAS float*)(lds + GL_CUM);
    const int lane = F.lane, wid = F.wave, r32 = lane & 31, hh = lane >> 5;
    const int U = F.nb * NH * 128;
    GlaIn cur, nxt;
    if (F.bid < U) gla_load<false>(F, W, F.bid, nxt);
    for (int u = F.bid; u < U; u += F.G) {
        cur = nxt;
        if (u + F.G < U) gla_load<false>(F, W, u + F.G, nxt);
        gla_cum(F, cur);
        {
            const int t = F.tid >> 3, d0 = (F.tid & 7) * 8;
            const u32x4 kv = cur.k;
            const unsigned kw[4] = {kv.x, kv.y, kv.z, kv.w};
#pragma unroll
            for (int j = 0; j < 8; ++j) { const int d = d0 + j; const float k = (j & 1) ? bfhi(kw[j >> 1]) : bflo(kw[j >> 1]);
                const float ef = __expf(cum[63 * 64 + d] - cum[t * 64 + d]), eb = __expf(cum[4096 + d] - cum[4096 + t * 64 + d]);
                *(LAS bf16*)(lds + G1_KEF + d * GL_S64 + t * 2) = (bf16)(cvt_pk(k * ef, 0.f) & 0xffffu);
                *(LAS bf16*)(lds + G1_KEB + d * GL_S64 + t * 2) = (bf16)(cvt_pk(k * eb, 0.f) & 0xffffu); }
            const int v0 = (F.tid & 7) * 16;
            const u32x4 va = cur.v0, vb = cur.v1;
            const unsigned vw[8] = {va.x, va.y, va.z, va.w, vb.x, vb.y, vb.z, vb.w};
#pragma unroll
            for (int j = 0; j < 16; ++j) *(LAS bf16*)(lds + G1_VT + (v0 + j) * GL_S64 + t * 2) = (bf16)((j & 1) ? (vw[j >> 1] >> 16) : (vw[j >> 1] & 0xffffu));
            if (F.tid < 128) { const int dir = F.tid >> 6, d = F.tid & 63; W.DEC[((size_t)u * 2 + dir) * 64 + d] = __expf(dir ? cum[4096 + d] : cum[63 * 64 + d]); }
        }
        __syncthreads();
        {
            const int dt = wid & 3, dd = wid >> 2;
            f32x16 cf = {}, cb = {};
#pragma unroll
            for (int s = 0; s < 4; ++s) { const int kb = (16 * s + 8 * hh) * 2;
                const bf16x8 a = lds_frag(lds + G1_VT, 32 * dt + r32, GL_S64, kb);
                cf = __builtin_amdgcn_mfma_f32_32x32x16_bf16(a, lds_frag(lds + G1_KEF, 32 * dd + r32, GL_S64, kb), cf, 0, 0, 0);
                cb = __builtin_amdgcn_mfma_f32_32x32x16_bf16(a, lds_frag(lds + G1_KEB, 32 * dd + r32, GL_S64, kb), cb, 0, 0, 0); }
            bf16* of = (bf16*)W.KVT + ((size_t)u * 2) * 8192; bf16* ob = of + 8192;
#pragma unroll
            for (int r = 0; r < 16; ++r) { const int dv = 32 * dt + crow(r, hh), d = 32 * dd + r32;
                const float pf = __shfl_xor(cf[r], 1), pb = __shfl_xor(cb[r], 1);
                if (!(lane & 1)) { *(unsigned*)(of + dv * 64 + d) = cvt_pk(cf[r], pf); *(unsigned*)(ob + dv * 64 + d) = cvt_pk(cb[r], pb); } }
        }
        __syncthreads();
    }
}

__device__ __forceinline__ void phase_gla2(Frame& F) {
    refresh(F);
    const WS W = ws_map(F.ws, F.nb); const float* const* IN_ = F.a->in; (void)IN_; (void)W;
    const size_t total = (size_t)F.nb * NH * 2 * 4096;
    for (size_t wk = (size_t)F.bid * NTHR + F.tid; wk < total; wk += (size_t)F.G * NTHR) {
        const int e2 = (int)(wk & 4095), dir = (int)((wk >> 12) & 1), bh = (int)(wk >> 13), d = (e2 * 2) & 63;
        unsigned* base = (unsigned*)((bf16*)W.KVT + ((size_t)bh * 128 * 2 + dir) * 8192) + e2; const float* dec = W.DEC + ((size_t)bh * 128 * 2 + dir) * 64 + d;
        float S0 = 0.f, S1 = 0.f;
        for (int n0 = 0; n0 < 128; n0 += 8) {
            unsigned kv[8]; float dc0[8], dc1[8];
#pragma unroll
            for (int j = 0; j < 8; ++j) { const int n = dir ? 127 - (n0 + j) : n0 + j; kv[j] = base[(size_t)n * 8192]; dc0[j] = dec[(size_t)n * 128]; dc1[j] = dec[(size_t)n * 128 + 1]; }
#pragma unroll
            for (int j = 0; j < 8; ++j) { const int n = dir ? 127 - (n0 + j) : n0 + j; base[(size_t)n * 8192] = cvt_pk(S0, S1); S0 = dc0[j] * S0 + bflo(kv[j]); S1 = dc1[j] * S1 + bfhi(kv[j]); }
        }
    }
}

__device__ __forceinline__ void phase_gla3(Frame& F, int l) {
    refresh(F);
    const WS W = ws_map(F.ws, F.nb); const float* const* IN_ = F.a->in; (void)IN_; (void)W;
    LAS unsigned char* lds = F.lds; LAS float* cum = (LAS float*)(lds + GL_CUM);
    const int lane = F.lane, wid = F.wave, r32 = lane & 31, hh = lane >> 5;
    const float* gng = IN_[9] + l * 128;
    const int U = F.nb * NH * 128;
    GlaIn cur, nxt;
    if (F.bid < U) gla_load<true>(F, W, F.bid, nxt);
    for (int u = F.bid; u < U; u += F.G) {
        const int n = u & 127, bh = u >> 7, b = bh >> 2, h = bh & 3; const size_t trow0 = (size_t)b * SEQ + n * 64;
        cur = nxt;
        if (u + F.G < U) gla_load<true>(F, W, u + F.G, nxt);
        gla_cum(F, cur);
        {
            const int t = F.tid >> 3, d0 = (F.tid & 7) * 8;
            const u32x4 qv = cur.q, kv = cur.k;
            const unsigned qw[4] = {qv.x, qv.y, qv.z, qv.w}, kw[4] = {kv.x, kv.y, kv.z, kv.w};
            float qf[8], qb[8], kf[8], kb[8];
#pragma unroll
            for (int j = 0; j < 8; ++j) { const int d = d0 + j; const float q = (j & 1) ? bfhi(qw[j >> 1]) : bflo(qw[j >> 1]), k = (j & 1) ? bfhi(kw[j >> 1]) : bflo(kw[j >> 1]);
                const float cf = cum[t * 64 + d], cb = cum[4096 + t * 64 + d];
                qf[j] = q * __expf(cf); qb[j] = q * __expf(cb); kf[j] = k * __expf(-cf); kb[j] = k * __expf(-cb); }
            u32x4 o;
            o.x = cvt_pk(qf[0], qf[1]); o.y = cvt_pk(qf[2], qf[3]); o.z = cvt_pk(qf[4], qf[5]); o.w = cvt_pk(qf[6], qf[7]); *(LAS u32x4*)(lds + G3_AOP + t * GL_S192 + (64 + d0) * 2) = o;
            o.x = cvt_pk(qb[0], qb[1]); o.y = cvt_pk(qb[2], qb[3]); o.z = cvt_pk(qb[4], qb[5]); o.w = cvt_pk(qb[6], qb[7]); *(LAS u32x4*)(lds + G3_AOP + t * GL_S192 + (128 + d0) * 2) = o;
            o.x = cvt_pk(kf[0], kf[1]); o.y = cvt_pk(kf[2], kf[3]); o.z = cvt_pk(kf[4], kf[5]); o.w = cvt_pk(kf[6], kf[7]); *(LAS u32x4*)(lds + G3_KIF + t * GL_S64 + d0 * 2) = o;
            o.x = cvt_pk(kb[0], kb[1]); o.y = cvt_pk(kb[2], kb[3]); o.z = cvt_pk(kb[4], kb[5]); o.w = cvt_pk(kb[6], kb[7]); *(LAS u32x4*)(lds + G3_KIB + t * GL_S64 + d0 * 2) = o;
            const int v0 = (F.tid & 7) * 16;
            const u32x4 va = cur.v0, vb = cur.v1;
            const unsigned vw[8] = {va.x, va.y, va.z, va.w, vb.x, vb.y, vb.z, vb.w};
#pragma unroll
            for (int j = 0; j < 16; ++j) *(LAS bf16*)(lds + G3_BOP + (v0 + j) * GL_S192 + t * 2) = (bf16)((j & 1) ? (vw[j >> 1] >> 16) : (vw[j >> 1] & 0xffffu));
            const int dv = F.tid >> 2, dd0 = (F.tid & 3) * 16;
#pragma unroll
            for (int dir = 0; dir < 2; ++dir) { const u32x4 o0 = cur.st[2 * dir], o1 = cur.st[2 * dir + 1];
                *(LAS u32x4*)(lds + G3_BOP + dv * GL_S192 + (64 + 64 * dir + dd0) * 2) = o0; *(LAS u32x4*)(lds + G3_BOP + dv * GL_S192 + (64 + 64 * dir + dd0 + 8) * 2) = o1; }
        }
        __syncthreads();
        if (wid < 4) {
            const int it = wid >> 1, jt = wid & 1;
            f32x16 af = {}, ab = {};
#pragma unroll
            for (int s = 0; s < 4; ++s) { const int kb = (16 * s + 8 * hh) * 2;
                if (jt <= it) af = __builtin_amdgcn_mfma_f32_32x32x16_bf16(lds_frag(lds + G3_AOP, 32 * it + r32, GL_S192, 128 + kb), lds_frag(lds + G3_KIF, 32 * jt + r32, GL_S64, kb), af, 0, 0, 0);
                if (jt >= it) ab = __builtin_amdgcn_mfma_f32_32x32x16_bf16(lds_frag(lds + G3_AOP, 32 * it + r32, GL_S192, 256 + kb), lds_frag(lds + G3_KIB, 32 * jt + r32, GL_S64, kb), ab, 0, 0, 0); }
#pragma unroll
            for (int r = 0; r < 16; ++r) { const int i = 32 * it + crow(r, hh), j = 32 * jt + r32; const float v = (j <= i) ? af[r] : ab[r];
                *(LAS bf16*)(lds + G3_AOP + i * GL_S192 + j * 2) = (bf16)(cvt_pk(v, 0.f) & 0xffffu); }
        }
        __syncthreads();
        {
            const int it = wid >> 2, dt = wid & 3; f32x16 o = {};
#pragma unroll
            for (int s = 0; s < 12; ++s) { const int kb = (16 * s + 8 * hh) * 2;
                o = __builtin_amdgcn_mfma_f32_32x32x16_bf16(lds_frag(lds + G3_AOP, 32 * it + r32, GL_S192, kb), lds_frag(lds + G3_BOP, 32 * dt + r32, GL_S192, kb), o, 0, 0, 0); }
            LAS float* out = (LAS float*)(lds + GL_CUM);
#pragma unroll
            for (int r = 0; r < 16; ++r) out[(32 * it + crow(r, hh)) * 128 + 32 * dt + r32] = o[r];
        }
        __syncthreads();
        {
            const int t = F.tid >> 3, v0 = (F.tid & 7) * 16; const LAS float* orow = (const LAS float*)(lds + GL_CUM) + t * 128 + v0;
            float x[16]; float ss = 0.f;
#pragma unroll
            for (int j = 0; j < 16; ++j) { x[j] = orow[j]; ss += x[j] * x[j]; }
            ss += __shfl_xor(ss, 1); ss += __shfl_xor(ss, 2); ss += __shfl_xor(ss, 4);
            const float rs = rsqrtf(ss * (1.f / 128.f) + RMS_EPS);
            const u32x4 ga = cur.sg0, gb = cur.sg1;
            const unsigned gw[8] = {ga.x, ga.y, ga.z, ga.w, gb.x, gb.y, gb.z, gb.w};
            float y[16];
#pragma unroll
            for (int j = 0; j < 16; ++j) y[j] = x[j] * rs * gng[v0 + j] * ((j & 1) ? bfhi(gw[j >> 1]) : bflo(gw[j >> 1]));
            u32x4 o0, o1; o0.x = cvt_pk(y[0], y[1]); o0.y = cvt_pk(y[2], y[3]); o0.z = cvt_pk(y[4], y[5]); o0.w = cvt_pk(y[6], y[7]);
            o1.x = cvt_pk(y[8], y[9]); o1.y = cvt_pk(y[10], y[11]); o1.z = cvt_pk(y[12], y[13]); o1.w = cvt_pk(y[14], y[15]);
            bf16* dst = W.OAB + (trow0 + t) * 512 + h * 128 + v0; *(u32x4*)dst = o0; *(u32x4*)(dst + 8) = o1;
        }
        __syncthreads();
    }
}
__device__ __forceinline__ void phase_select(Frame& F, int l) {
    refresh(F);
    const WS W = ws_map(F.ws, F.nb); const float* const* IN_ = F.a->in; (void)IN_; (void)W;
    LAS int* lcnt = (LAS int*)F.lds; LAS int* lbase = lcnt + 32;
    const float* b_rg = IN_[19] + l * 4; const float* b_re = IN_[21] + l * 32;
    unsigned* gcnt = W.ctl + CW_CNT + l * 64;
    for (int t0 = F.bid * NTHR; t0 < F.T; t0 += F.G * NTHR) {
        if (F.tid < 32) lcnt[F.tid] = 0;
        __syncthreads();
        const int t = t0 + F.tid; int e0 = 0, e1 = 0, r0 = 0, r1 = 0; float g0 = 0.f, g1 = 0.f;
        if (t < F.T) {
            const float* lg = W.LOGITS + (size_t)t * 64;
            float gl[4]; { const f32x4 v = *(const f32x4*)lg; gl[0] = v[0] + b_rg[0]; gl[1] = v[1] + b_rg[1]; gl[2] = v[2] + b_rg[2]; gl[3] = v[3] + b_rg[3]; }
            int grp = 0; float mx = gl[0];
            if (gl[1] > mx) { mx = gl[1]; grp = 1; } if (gl[2] > mx) { mx = gl[2]; grp = 2; } if (gl[3] > mx) { mx = gl[3]; grp = 3; }
            const float p_grp = 1.f / (__expf(gl[0] - mx) + __expf(gl[1] - mx) + __expf(gl[2] - mx) + __expf(gl[3] - mx));
            const f32x4 ea = *(const f32x4*)(lg + 4 + grp * 8), eb = *(const f32x4*)(lg + 8 + grp * 8);
            const f32x4 ba = *(const f32x4*)(b_re + grp * 8), bb = *(const f32x4*)(b_re + grp * 8 + 4);
            float b0v = -1e30f, b1v = -1e30f; int i0 = 0, i1 = 0;
#pragma unroll
            for (int j = 0; j < 8; ++j) { const float e = (j < 4) ? ea[j] + ba[j] : eb[j - 4] + bb[j - 4];
                if (e > b0v) { b1v = b0v; i1 = i0; b0v = e; i0 = j; } else if (e > b1v) { b1v = e; i1 = j; } }
            const float p1 = __expf(b1v - b0v), s2 = 1.f + p1;
            e0 = grp * 8 + i0; e1 = grp * 8 + i1; g0 = p_grp / s2; g1 = p_grp * p1 / s2;
            r0 = __hip_atomic_fetch_add(lcnt + e0, 1, __ATOMIC_RELAXED, __HIP_MEMORY_SCOPE_WORKGROUP);
            r1 = __hip_atomic_fetch_add(lcnt + e1, 1, __ATOMIC_RELAXED, __HIP_MEMORY_SCOPE_WORKGROUP);
        }
        __syncthreads();
        if (F.tid < 32) lbase[F.tid] = (int)__hip_atomic_fetch_add(gcnt + F.tid, (unsigned)lcnt[F.tid], __ATOMIC_RELAXED, __HIP_MEMORY_SCOPE_AGENT);
        __syncthreads();
        if (t < F.T) { W.eid[t * 2] = e0; W.eid[t * 2 + 1] = e1; W.gate[t * 2] = g0; W.gate[t * 2 + 1] = g1; W.rank[t * 2] = lbase[e0] + r0; W.rank[t * 2 + 1] = lbase[e1] + r1; }
        __syncthreads();
    }
}
__device__ __forceinline__ void phase_gather(Frame& F, int l) {
    refresh(F);
    const WS W = ws_map(F.ws, F.nb); const float* const* IN_ = F.a->in; (void)IN_; (void)W;
    LAS int* seg = (LAS int*)F.lds; LAS int* cnt = seg + 40;
    const unsigned* gcnt = W.ctl + CW_CNT + l * 64;
    if (F.tid == 0) { int o = 0; for (int e = 0; e < 32; ++e) { const int c = (int)__hip_atomic_load(gcnt + e, __ATOMIC_RELAXED, __HIP_MEMORY_SCOPE_AGENT); seg[e] = o; cnt[e] = c; o += (c + 255) & ~255; } seg[32] = o; }
    __syncthreads();
    const int ntile = seg[32] >> 8;
    if (F.bid == 0) {
        for (int i = F.tid; i < ntile; i += NTHR) { int e = 0; while (e < 31 && (i << 8) >= seg[e + 1]) ++e; W.tilee[i] = e; }
        if (F.tid == 0) W.segp[0] = ntile;
    }
    for (int p = F.bid * NTHR + F.tid; p < (ntile << 8); p += F.G * NTHR) { int e = 0; while (e < 31 && p >= seg[e + 1]) ++e; if (p - seg[e] >= cnt[e]) W.stok[p] = 0; }
    for (int it = F.bid * NTHR + F.tid; it < F.T * 2; it += F.G * NTHR) {
        const int e = W.eid[it], p = seg[e] + W.rank[it];
        W.stok[p] = it >> 1; W.pos[it] = p; W.gsort[p] = W.gate[it];
    }
}

#ifndef MK_MASK
#define MK_MASK 0xffffffffu
#endif
#define EN(b) (((MK_MASK) >> (b)) & 1u)
#ifndef MK_ALIGN
#define MK_ALIGN true
#endif
#ifndef MK_SP2
#define MK_SP2 true
#endif
#ifndef MK_DUP
#define MK_DUP 0u
#endif
#define REPS(b) ((((MK_DUP) >> (b)) & 1u) ? 2 : 1)
constexpr int NPL = 14, NPH = 2 + DEPTH * NPL;
#ifdef MK_UB
__device__ __forceinline__ void ub_bench(Frame& F) {
    {
        typedef int ub8i __attribute__((ext_vector_type(8))); typedef int ub4i __attribute__((ext_vector_type(4)));
        ub8i ua, ubb; for (int i = 0; i < 8; ++i) { ua[i] = 0x38383838 + F.lane; ubb[i] = 0x30303030 + F.lane * 3; }
        f32x16 acc0 = {}, acc1 = {}, acc2 = {}, acc3 = {};
        float e0 = F.lane * 0.01f, e1 = e0 + 1, e2 = e0 + 2, e3 = e0 + 3, e4 = e0 + 4, e5 = e0 + 5, e6 = e0 + 6, e7 = e0 + 7;
        ub4i ld0 = {}, ld1 = {}; const unsigned la = (unsigned)(unsigned long)F.lds + F.tid * 16;
#define UB_M(acc) do { if constexpr (MK_UB & 1) acc = __builtin_amdgcn_mfma_scale_f32_32x32x64_f8f6f4(ua, ubb, acc, 0, (MK_UB & 16) ? 1 : 0, 0, 0, 0, 0); } while (0)
#define UB_E() do { if constexpr (MK_UB & 2) { e0 = __builtin_amdgcn_exp2f(e0); e1 = __builtin_amdgcn_exp2f(e1); e2 = __builtin_amdgcn_exp2f(e2); e3 = __builtin_amdgcn_exp2f(e3); \
                                              e4 = __builtin_amdgcn_exp2f(e4); e5 = __builtin_amdgcn_exp2f(e5); e6 = __builtin_amdgcn_exp2f(e6); e7 = __builtin_amdgcn_exp2f(e7); } } while (0)
#define UB_L() do { if constexpr (MK_UB & 4) { asm volatile("ds_read_b128 %0, %1" : "=&v"(ld0) : "v"(la) : "memory"); asm volatile("ds_read_b128 %0, %1 offset:8192" : "=&v"(ld1) : "v"(la) : "memory"); } } while (0)
        float g0 = e0, g1 = e1, g2 = e2, g3 = e3, g4 = e4, g5 = e5, g6 = e6, g7 = e7;
#define UB_F() do { if constexpr (MK_UB & 64) { g0 = fmaf(g0, 1.0001f, 0.5f); g1 = fmaf(g1, 1.0001f, 0.5f); g2 = fmaf(g2, 1.0001f, 0.5f); g3 = fmaf(g3, 1.0001f, 0.5f); \
                                                g4 = fmaf(g4, 1.0001f, 0.5f); g5 = fmaf(g5, 1.0001f, 0.5f); g6 = fmaf(g6, 1.0001f, 0.5f); g7 = fmaf(g7, 1.0001f, 0.5f); } } while (0)
        if (!(MK_UB & 32) || F.wave < 4)
        for (int it = 0; it < 2000; ++it) {
            UB_M(acc0); __builtin_amdgcn_sched_barrier(0); UB_E(); UB_F(); UB_L(); __builtin_amdgcn_sched_barrier(0);
            UB_M(acc1); __builtin_amdgcn_sched_barrier(0); UB_E(); UB_F(); UB_L(); __builtin_amdgcn_sched_barrier(0);
            UB_M(acc2); __builtin_amdgcn_sched_barrier(0); UB_E(); UB_F(); UB_L(); __builtin_amdgcn_sched_barrier(0);
            UB_M(acc3); __builtin_amdgcn_sched_barrier(0); UB_E(); UB_F(); UB_L(); __builtin_amdgcn_sched_barrier(0);
            if constexpr (MK_UB & 4) asm volatile("s_waitcnt lgkmcnt(0)" ::: "memory");
        }
        const float sink = g0 + g1 + g2 + g3 + g4 + g5 + g6 + g7 + acc0[0] + acc1[1] + acc2[2] + acc3[3] + e0 + e1 + e2 + e3 + e4 + e5 + e6 + e7 + (float)(ld0[0] + ld1[1]);
        if (sink == 12345.678f) ((unsigned*)F.ws)[CW_CNT + 77] = 1u;
        __syncthreads();
    }
}
#endif
__global__ void __launch_bounds__(NTHR, 2) mk_fwd(Args args) {
    extern __shared__ __attribute__((aligned(16))) unsigned char lds_raw[];
    Frame F;
    F.lds = (LAS unsigned char*)lds_raw; F.tid = threadIdx.x; F.lane = F.tid & 63; F.wave = __builtin_amdgcn_readfirstlane(F.tid >> 6);
    F.G = gridDim.x; F.bid = blockIdx.x; F.nb = args.nb; F.T = args.nb * SEQ; F.ws = args.ws; F.a = &args; F.xbuf = args.out;
    const float* const* IN_ = args.in;
    volatile LAS unsigned* misc = (volatile LAS unsigned*)(F.lds + LDS_MISC);
    if (F.tid < 64) misc[F.tid] = 0u;
    __syncthreads();
    XcdBarrier bar = xcd_barrier_post((unsigned*)args.ws + CW_BAR + args.li * XCD_BAR_WORDS, misc);
    const int lo = args.ph_lo, hi = args.ph_hi;
#define IN(k) (lo <= (k) && (k) < hi)
#ifdef MK_BAR2
#define SEAM(k) do { if (IN(k) && IN((k) + 1)) { xcd_barrier(bar); xcd_barrier(bar); } } while (0)
#else
#define SEAM(k) do { if (IN(k) && IN((k) + 1)) xcd_barrier(bar); } while (0)
#endif
#if defined(MK_UB) && !defined(MK_UB_MID)
    ub_bench(F);
#endif
    LAS unsigned char* gl = F.lds;
    if (EN(0) && IN(0)) { for (int rp = 0; rp < REPS(0); ++rp) { p0_prologue(F); __syncthreads(); } SEAM(0); }
    for (int l = 0; l < DEPTH; ++l) {
        const int pb = 1 + l * NPL;
#if defined(MK_UB) && defined(MK_UB_MID)
        if (l == 1) { ub_bench(F); refresh(F); }
#endif
        if (EN(1) && IN(pb + 0)) { for (int rp = 0; rp < ((l == 0) ? REPS(14) : 1); ++rp) phase_norm(F, l, 0); SEAM(pb + 0); }
        if (EN(2) && IN(pb + 1)) { const WS W = ws_map(F.ws, F.nb);
            pg8::Gemm g{W.H, W.win + (size_t)l * NIN * D, F.T, NIN, D}; pg8::StaticOrder S; S.init(F.T, NIN, F.G, F.bid);
            EpiIn E{W.GQ, W.GK, W.GV, W.SG, W.LGF, W.LGB, W.DQ, W.DK, W.DV, W.SGA, W.SGB, IN_[8] + l * 512, IN_[10] + l * 64, IN_[11] + l * 64, 0};
#ifdef MK_DEPHASE
            { const int g_ = (F.bid >> 3) & 7; for (int k_ = 0; k_ < g_ * MK_DEPHASE; ++k_) __builtin_amdgcn_s_sleep(127); }
#endif
#ifdef MK_INPROJ_PLAIN
            { EpiIn EP_ = E; EP_.plain = 1; pg8::gemm_phase<EpiIn, pg8::StaticOrder, MK_ALIGN, MK_SP2>(gl, g, S, EP_); }
#endif
#ifdef MK_INPROJ_NULL
            { EpiNull EN_; pg8::gemm_phase<EpiNull, pg8::StaticOrder, MK_ALIGN, MK_SP2>(gl, g, S, EN_); }
#endif
            for (int rp = 0; rp < REPS(2); ++rp) pg8::gemm_phase<EpiIn, pg8::StaticOrder, MK_ALIGN, MK_SP2>(gl, g, S, E);
            SEAM(pb + 1);
        }
        if (EN(3) && IN(pb + 2)) { for (int rp = 0; rp < REPS(3); ++rp) phase_gla1(F); SEAM(pb + 2); }
        if (EN(4) && IN(pb + 3)) { phase_gla2(F); SEAM(pb + 3); }
        if (EN(5) && IN(pb + 4)) { for (int rp = 0; rp < REPS(5); ++rp) phase_gla3(F, l); __syncthreads(); }
        if (EN(6) && IN(pb + 5)) {
#ifdef MK_ATT_PROBE
            phase_attn<MK_ATT_PROBE>(F, l);
#endif
#ifdef MK_CLK
            unsigned long long ct0 = 0, cr0 = 0; if (l == 1) { ct0 = __builtin_readcyclecounter(); cr0 = __builtin_amdgcn_s_memrealtime(); }
#endif
            phase_attn<0>(F, l);
#ifdef MK_CLK
            if (l == 1 && F.bid == 0 && F.tid == 0) {
                const unsigned long long ct1 = __builtin_readcyclecounter(), cr1 = __builtin_amdgcn_s_memrealtime();
                const unsigned long long ticks = (ct1 - ct0) * (unsigned long long)(MK_CLK) / (cr1 - cr0 + 1);
                while (__builtin_amdgcn_s_memrealtime() - cr1 < ticks) __builtin_amdgcn_s_sleep(8);
            }
            __syncthreads();
#endif
            SEAM(pb + 5); }
        if (EN(7) && IN(pb + 6)) { const WS W = ws_map(F.ws, F.nb);
            pg8::Gemm g{W.OAB, W.wab + (size_t)l * D * D, 0, 0, 512}; MergeOrder S; S.so.init(F.T, D, F.G, F.bid); S.nM = F.T / 256;
            EpiMerge E{W.SGA, W.SGB, W.MERGED, F.T / 256};
            for (int rp = 0; rp < REPS(7); ++rp) pg8::gemm_phase<EpiMerge, MergeOrder, MK_ALIGN, MK_SP2>(gl, g, S, E);
            SEAM(pb + 6);
        }
        if (EN(8) && IN(pb + 7)) { const WS W = ws_map(F.ws, F.nb); const float* modl = W.mod + (size_t)l * NBMAX * 6 * D;
            pg8::Gemm g{W.MERGED, W.wo + (size_t)l * D * D, F.T, D, D}; pg8::StaticOrder S; S.init(F.T, D, F.G, F.bid);
            EpiResid E{l == 0 ? IN_[0] : nullptr, W.XB, modl + 2 * D};
            for (int rp = 0; rp < ((l == 0) ? REPS(8) : 1); ++rp) pg8::gemm_phase<EpiResid, pg8::StaticOrder, MK_ALIGN, MK_SP2>(gl, g, S, E);
            SEAM(pb + 7);
        }
        if (EN(1) && IN(pb + 8)) { for (int rp = 0; rp < REPS(1); ++rp) phase_norm(F, l, 1); SEAM(pb + 8); }
        if (EN(9) && IN(pb + 9)) { const WS W = ws_map(F.ws, F.nb);
            pg8::Gemm g{W.H, W.wr + (size_t)l * 256 * D, F.T, 256, D}; pg8::StaticOrder S; S.init(F.T, 256, F.G, F.bid);
            EpiLogits E{W.LOGITS};
            for (int rp = 0; rp < REPS(9); ++rp) pg8::gemm_phase<EpiLogits, pg8::StaticOrder, MK_ALIGN, MK_SP2>(gl, g, S, E);
            SEAM(pb + 9);
        }
        if (EN(10) && IN(pb + 10)) { phase_select(F, l); SEAM(pb + 10); }
        if (EN(11) && IN(pb + 11)) { for (int rp = 0; rp < REPS(11); ++rp) { phase_gather(F, l); __syncthreads(); } SEAM(pb + 11); }
        if (EN(12) && IN(pb + 12)) { const WS W = ws_map(F.ws, F.nb);
            const int ntile = W.segp[0];
#if MK_MOE_FP8
            pg8::Gemm g{W.XS, (const bf16*)((const unsigned char*)W.w1 + (size_t)l * NE * 1024 * D), 0, 0, D / 2}; GroupedOrder S{W.tilee, ntile * 4, F.G, F.bid};
            EpiAct E{(unsigned char*)W.ACT};
#else
            pg8::Gemm g{W.H, W.w1 + (size_t)l * NE * 1024 * D, 0, 0, D}; GroupedOrder S{W.tilee, ntile * 4, F.G, F.bid, W.stok};
            EpiAct E{W.ACT};
#endif
            for (int rp = 0; rp < REPS(12); ++rp) pg8::gemm_phase<EpiAct, GroupedOrder, MK_ALIGN, MK_SP2, true>(gl, g, S, E);
            SEAM(pb + 12);
        }
        if (EN(13) && IN(pb + 13)) { const WS W = ws_map(F.ws, F.nb);
            const int ntile = W.segp[0];
#if MK_MOE_FP8
            pg8::Gemm g{W.ACT, (const bf16*)((const unsigned char*)W.w2 + (size_t)l * NE * D * DE), 0, 0, DE / 2}; GroupedOrder S{W.tilee, ntile * 4, F.G, F.bid};
#else
            pg8::Gemm g{W.ACT, W.w2 + (size_t)l * NE * D * DE, 0, 0, DE}; GroupedOrder S{W.tilee, ntile * 4, F.G, F.bid, nullptr};
#endif
            EpiYs E{(unsigned char*)W.YS, W.gsort};
            for (int rp = 0; rp < REPS(13); ++rp) pg8::gemm_phase<EpiYs, GroupedOrder, MK_ALIGN, MK_SP2>(gl, g, S, E);
            SEAM(pb + 13);
        }
    }
    if (EN(1) && IN(NPH - 1)) phase_norm(F, 0, 2);
#undef IN
#undef SEAM
}

struct LaunchCfg { int grid; bool ok; };
inline LaunchCfg& launch_cfg() {
    static LaunchCfg c{0, false}; static bool init = false;
    if (!init) { init = true;
        int dev = 0, cus = 0, per_cu = 0;
        if (hipGetDevice(&dev) != hipSuccess || hipDeviceGetAttribute(&cus, hipDeviceAttributeMultiprocessorCount, dev) != hipSuccess) { fprintf(stderr, "mk: device query failed\n"); return c; }
        if (hipFuncSetAttribute((const void*)mk_fwd, hipFuncAttributeMaxDynamicSharedMemorySize, LDS_BYTES) != hipSuccess) { fprintf(stderr, "mk: hipFuncSetAttribute failed\n"); return c; }
        if (hipOccupancyMaxActiveBlocksPerMultiprocessor(&per_cu, (const void*)mk_fwd, NTHR, LDS_BYTES) != hipSuccess || per_cu < 1) { fprintf(stderr, "mk: occupancy query says %d blocks/CU\n", per_cu); (void)hipGetLastError(); return c; }
        c.grid = cus; c.ok = true;
    }
    return c;
}
inline void launch_range(void* const* d_in, float* xbuf, void* d_ws, int nb, int lo, int hi, int li, hipStream_t stream) {
    LaunchCfg& c = launch_cfg(); if (!c.ok) return;
    Args a{}; for (int i = 0; i < 24; ++i) a.in[i] = (const float*)d_in[i];
    a.out = xbuf; a.ws = (unsigned char*)d_ws; a.nb = nb; a.ph_lo = lo; a.ph_hi = hi; a.li = li;
    hipLaunchKernelGGL(mk_fwd, dim3(c.grid), dim3(NTHR), LDS_BYTES, stream, a);
    const hipError_t le = hipPeekAtLastError(); if (le != hipSuccess) fprintf(stderr, "mk: launch [%d,%d) failed: %s\n", lo, hi, hipGetErrorName(le));
}
}
extern "C" void kernel_launch(void* const* d_in, const int* in_sizes, int n_in, void* d_out, int out_size, void* d_ws, size_t ws_size, hipStream_t stream) {
    (void)in_sizes; (void)n_in; (void)out_size;
    static int checked = 0;
    if (!checked) { checked = 1; const mk::WS w = mk::ws_map((unsigned char*)d_ws, 4); if (w.end > ws_size) { fprintf(stderr, "mk: workspace too small: need %zu, have %zu\n", w.end, ws_size); checked = -1; } }
    if (checked < 0) return;
    if (hipMemsetAsync(d_ws, 0, mk::CTL_BYTES, stream) != hipSuccess) return;
    mk::launch_range(d_in, (float*)d_out, d_ws, 4, 0, mk::NPH, 0, stream);
}
```

```cpp
#include <hip/hip_runtime.h>
#include <cstdio>
#include <cstdint>
#include <cmath>
#define MK_ATT_FP8 1
namespace pg8 {
#define PG8_LAS __attribute__((address_space(3)))
typedef unsigned short bf16_t;
typedef short bf16x8 __attribute__((ext_vector_type(8)));
typedef float f32x4 __attribute__((ext_vector_type(4)));
typedef unsigned u32x4 __attribute__((ext_vector_type(4)));
constexpr int BM = 256, BK = 64, HALF = 128, HTB = HALF * BK * 2  , STAGE_BYTES = 8 * HTB, NXCD = 8, WGM = 8;

__host__ __device__ __forceinline__ int lds_byte(int r, int c) { const int st = (r >> 4) * 2 + (c >> 5), rr = r & 15, cc = c & 31, ob = rr * 64 + cc * 2; return st * 1024 + (ob ^ (((ob >> 9) & 1) << 5)); }
__host__ __device__ __forceinline__ void stage_rc(int b, int& R, int& C) { const int st = b / 1024, sb = b % 1024, swz = sb ^ (((sb >> 9) & 1) << 5); R = (st >> 1) * 16 + swz / 64; C = (st & 1) * 32 + (swz % 64) / 2; }
__host__ __device__ __forceinline__ int perm32(int rho) { const int n = rho >> 4, i = rho & 15; return 8 * (i >> 2) + 4 * n + (i & 3); }

struct Unit { int pm, pn; };
struct Gemm { const bf16_t* A; const bf16_t* Bt; int M, N, K; };

struct StaticOrder {
    int nM, nN, nwg, G, c;
    __host__ __device__ void init(int M, int N, int G_, int c_) { nM = M / BM; nN = N / BM; nwg = nM * nN; G = G_; c = c_; }
    __host__ __device__ bool next(int i, Unit& u) const {
        const long L = (long)i * G + c; if (L >= nwg) return false;
        int wgid = (int)L; { const int q = nwg / NXCD, r = nwg % NXCD, xcd = wgid % NXCD, off = wgid / NXCD; wgid = (xcd < r ? xcd * (q + 1) : r * (q + 1) + (xcd - r) * q) + off; }
        const int nig = WGM * nN, gid = wgid / nig, fm = gid * WGM, gsz = (nM - fm) < WGM ? (nM - fm) : WGM;
        u.pm = fm + ((wgid % nig) % gsz); u.pn = (wgid % nig) / gsz; return true;
    }
    __device__ __forceinline__ void a_ready(const Unit&) const {}
    __device__ __forceinline__ void done(const Unit&) const {}
};
__device__ __forceinline__ unsigned cvt_pk_bf16(float lo, float hi) { unsigned r; asm volatile("v_cvt_pk_bf16_f32 %0, %1, %2" : "=v"(r) : "v"(lo), "v"(hi)); return r; }
__device__ __forceinline__ const void* pg8_uniform(const void* p) { const unsigned long long v = (unsigned long long)p;
    const unsigned lo = (unsigned)__builtin_amdgcn_readfirstlane((int)(unsigned)v), hi = (unsigned)__builtin_amdgcn_readfirstlane((int)(unsigned)(v >> 32)); return (const void*)(((unsigned long long)hi << 32) | lo); }
__device__ __forceinline__ void pg8_glds(const void* sbase, unsigned voff, unsigned ldsdst) { unsigned keep;
    asm volatile("s_nop 4\n\ts_mov_b32 %0, m0\n\ts_mov_b32 m0, %3\n\ts_nop 0\n\tglobal_load_lds_dwordx4 %1, %2\n\ts_mov_b32 m0, %0" : "=&s"(keep) : "v"(voff), "s"(sbase), "s"(ldsdst) : "memory"); }
typedef int pg8_v8i __attribute__((ext_vector_type(8)));
typedef int pg8_v4i __attribute__((ext_vector_type(4)));
template <class Epi, class Sched, bool ALIGN_EPI = false, bool SP2 = false, bool GATHER = false>
__device__ __forceinline__ void gemm_phase(PG8_LAS unsigned char* lds, const Gemm g, const Sched& S, const Epi& E) {
    int tid_ = threadIdx.x; asm volatile("" : "+v"(tid_));
    const int tid = tid_, wid = __builtin_amdgcn_readfirstlane(tid >> 6), lane = tid & 63, wr = wid >> 2, wc = wid & 3, fr = lane & 15, fq = lane >> 4;
    const int K = g.K, nt = K / BK;
    unsigned voffA[2], voffB[2]; unsigned vc[2][2] = {}, vn[2][2] = {}, vs[2][2] = {}; (void)vc; (void)vn; (void)vs;
#pragma unroll
    for (int i = 0; i < 2; ++i) { int R, C; stage_rc(tid * 16 + i * 8192, R, C); const int Rb = Epi::PERM ? ((R & ~31) + perm32(R & 31)) : R;
        voffA[i] = (unsigned)(R * K + C) * 2u; voffB[i] = (unsigned)(Rb * K + C) * 2u; }
    const size_t kstep = (size_t)(BK * 2);
    const size_t hstep = (size_t)HALF * K * 2;
    const size_t tstep = 2 * hstep;
    const unsigned ldsw = (unsigned)wid * 1024u; const unsigned lds0 = (unsigned)(unsigned long)lds; (void)lds0;
    const int aoff = lds_byte(wr * 64 + fr, fq * 8), boff = lds_byte(wc * 32 + fr, fq * 8);
#define PG8_SA(b, h) (((b) * 2 + (h)) * HTB)
#define PG8_SB(b, h) ((4 + (b) * 2 + (h)) * HTB)
#if defined(PG8_ASM_STAGE) && PG8_ASM_STAGE
#define PG8_STAGE(bufoff, gbase, voff) do { const void* _gb = pg8_uniform(gbase); _Pragma("unroll") for (int _i = 0; _i < 2; ++_i) \
        pg8_glds(_gb, (voff)[_i], (unsigned)__builtin_amdgcn_readfirstlane((int)(lds0 + (unsigned)(bufoff) + ldsw + _i * 8192))); } while (0)
#else
#define PG8_STAGE(bufoff, gbase, voff) do { _Pragma("unroll") for (int _i = 0; _i < 2; ++_i) \
        __builtin_amdgcn_global_load_lds((const unsigned*)((const char*)(gbase) + (voff)[_i]), (PG8_LAS unsigned*)(lds + (bufoff) + ldsw + _i * 8192), 16, 0, 0); } while (0)
#endif
#define PG8_STAGE_A(b, h, X, VS) do { if constexpr (GATHER) { PG8_STAGE(PG8_SA(b, h), X, VS[h]); } else { PG8_STAGE(PG8_SA(b, h), (X) + (h) * hstep, voffA); } } while (0)
#define PG8_LOADROWS(u, v) do { _Pragma("unroll") for (int i_ = 0; i_ < 2; ++i_) { int R_, C_; stage_rc(tid * 16 + i_ * 8192, R_, C_); _Pragma("unroll") for (int h_ = 0; h_ < 2; ++h_) \
        v[h_][i_] = (unsigned)S.rowidx[(u).pm * 256 + h_ * 128 + R_] * (unsigned)(K * 2) + (unsigned)C_ * 2u; } } while (0)
#define PG8_LDA(dst, b, h) do { _Pragma("unroll") for (int m = 0; m < 4; ++m) _Pragma("unroll") for (int k = 0; k < 2; ++k) dst[m][k] = *(const PG8_LAS bf16x8*)(lds + PG8_SA(b, h) + aoff + m * 2048 + k * 1024); } while (0)
#define PG8_LDB(dst, b, h) do { _Pragma("unroll") for (int n = 0; n < 2; ++n) _Pragma("unroll") for (int k = 0; k < 2; ++k) dst[n][k] = *(const PG8_LAS bf16x8*)(lds + PG8_SB(b, h) + boff + n * 2048 + k * 1024); } while (0)
#define PG8_MMA(ai, bj, At, Bt) do { __builtin_amdgcn_s_setprio(1); _Pragma("unroll") for (int m = 0; m < 4; ++m) _Pragma("unroll") for (int n = 0; n < 2; ++n) _Pragma("unroll") for (int k = 0; k < 2; ++k) \
        acc[ai][bj][m][n] = __builtin_amdgcn_mfma_f32_16x16x32_bf16(Bt[n][k], At[m][k], acc[ai][bj][m][n], 0, 0, 0); __builtin_amdgcn_s_setprio(0); } while (0)
#define PG8_WAIT_V(n) asm volatile("s_waitcnt vmcnt(" #n ")" ::: "memory")
#define PG8_WAIT_L(n) asm volatile("s_waitcnt lgkmcnt(" #n ")" ::: "memory")
#define PG8_BAR __builtin_amdgcn_s_barrier()
#define PG8_SCHED __builtin_amdgcn_sched_barrier(0)
    Unit cur, nxt; int ui = 0;
    if (!S.next(0, cur)) return;
    f32x4 acc[2][2][4][2];
#pragma unroll
    for (int a = 0; a < 2; ++a)
#pragma unroll
        for (int b = 0; b < 2; ++b)
#pragma unroll
            for (int m = 0; m < 4; ++m)
#pragma unroll
                for (int n = 0; n < 2; ++n) acc[a][b][m][n] = (f32x4){0.f, 0.f, 0.f, 0.f};
    bf16x8 At[4][2], B0[2][2], B1[2][2];
    const char* cA = (const char*)g.A + (GATHER ? (size_t)0 : (size_t)cur.pm * tstep); const char* cB = (const char*)g.Bt + (size_t)cur.pn * tstep;
    S.a_ready(cur);
    if constexpr (GATHER) { PG8_LOADROWS(cur, vc); }
    if constexpr (SP2) {
        PG8_STAGE(PG8_SB(0, 0), cB, voffB); PG8_STAGE(PG8_SB(0, 1), cB + hstep, voffB); PG8_STAGE_A(0, 0, cA, vc); PG8_STAGE_A(0, 1, cA, vc);
        if (wr == 1) PG8_BAR;
        PG8_WAIT_V(2); PG8_BAR;
        PG8_STAGE(PG8_SB(1, 0), cB + kstep, voffB); PG8_STAGE_A(1, 0, cA + kstep, vc); PG8_STAGE(PG8_SB(1, 1), cB + hstep + kstep, voffB);
        PG8_WAIT_V(6); PG8_BAR;
    } else {
        PG8_STAGE(PG8_SB(0, 0), cB, voffB); PG8_STAGE_A(0, 0, cA, vc); PG8_STAGE(PG8_SB(0, 1), cB + hstep, voffB); PG8_STAGE_A(0, 1, cA, vc);
        if (wr == 1) PG8_BAR;
        PG8_WAIT_V(4); PG8_BAR;
        PG8_STAGE(PG8_SB(1, 0), cB + kstep, voffB); PG8_STAGE_A(1, 0, cA + kstep, vc); PG8_STAGE(PG8_SB(1, 1), cB + hstep + kstep, voffB);
        PG8_WAIT_V(6); PG8_BAR;
    }
    for (;;) {
        const bool has_next = S.next(ui + 1, nxt);
        const char* nA = (has_next && !GATHER) ? (const char*)g.A + (size_t)nxt.pm * tstep : cA; const char* nB = has_next ? (const char*)g.Bt + (size_t)nxt.pn * tstep : cB;
        for (int t = 0; t < nt; t += 2) {
            const bool last = (t == nt - 2);
            const char* a1 = cA + (size_t)(t + 1) * kstep;
            const char* a2 = last ? nA : cA + (size_t)(t + 2) * kstep; const char* b2 = last ? nB : cB + (size_t)(t + 2) * kstep;
            const char* a3 = a2 + kstep; const char* b3 = b2 + kstep;
            if (last && has_next) S.a_ready(nxt);
            if constexpr (GATHER) { if (last && has_next) { PG8_LOADROWS(nxt, vn); }
                _Pragma("unroll") for (int h_ = 0; h_ < 2; ++h_) _Pragma("unroll") for (int i_ = 0; i_ < 2; ++i_) vs[h_][i_] = (last && has_next) ? vn[h_][i_] : vc[h_][i_]; }
            if constexpr (Epi::MIDK) { if (t == nt / 2) E.mid(acc, cur, wr, wc, fr, fq); }
            if constexpr (SP2) {
            PG8_LDB(B0, 0, 0); PG8_LDB(B1, 0, 1); PG8_SCHED; PG8_LDA(At, 0, 0); PG8_STAGE_A(1, 1, a1, vc);
            PG8_WAIT_V(8); PG8_WAIT_L(0); PG8_BAR; PG8_MMA(0, 0, At, B0); PG8_MMA(0, 1, At, B1); PG8_BAR; PG8_SCHED;
            PG8_LDA(At, 0, 1); PG8_STAGE(PG8_SB(0, 0), b2, voffB); PG8_STAGE(PG8_SB(0, 1), b2 + hstep, voffB); PG8_STAGE_A(0, 0, a2, vs);
            PG8_WAIT_V(8); PG8_WAIT_L(0); PG8_BAR; PG8_MMA(1, 0, At, B0); PG8_MMA(1, 1, At, B1); PG8_BAR; PG8_SCHED;
            PG8_LDB(B0, 1, 0); PG8_LDB(B1, 1, 1); PG8_SCHED; PG8_LDA(At, 1, 0); PG8_STAGE_A(0, 1, a2, vs);
            PG8_WAIT_V(8); PG8_WAIT_L(0); PG8_BAR; PG8_MMA(0, 0, At, B0); PG8_MMA(0, 1, At, B1); PG8_BAR; PG8_SCHED;
            PG8_LDA(At, 1, 1); PG8_STAGE(PG8_SB(1, 0), b3, voffB); PG8_STAGE(PG8_SB(1, 1), b3 + hstep, voffB); PG8_STAGE_A(1, 0, a3, vs);
            PG8_WAIT_V(8); PG8_WAIT_L(0); PG8_BAR; PG8_MMA(1, 0, At, B0); PG8_MMA(1, 1, At, B1); PG8_BAR; PG8_SCHED;
            } else {
            PG8_LDB(B0, 0, 0); PG8_SCHED; PG8_LDA(At, 0, 0); PG8_STAGE_A(1, 1, a1, vc);
            PG8_WAIT_L(8); PG8_BAR; PG8_WAIT_L(0); PG8_MMA(0, 0, At, B0); PG8_BAR; PG8_SCHED;
            PG8_LDB(B1, 0, 1); PG8_STAGE(PG8_SB(0, 0), b2, voffB);
            PG8_BAR; PG8_WAIT_L(0); PG8_MMA(0, 1, At, B1); PG8_BAR;
            PG8_LDA(At, 0, 1); PG8_STAGE_A(0, 0, a2, vs);
            PG8_BAR; PG8_WAIT_L(0); PG8_MMA(1, 0, At, B0); PG8_BAR; PG8_SCHED;
            PG8_STAGE(PG8_SB(0, 1), b2 + hstep, voffB);
            PG8_WAIT_V(6); PG8_BAR; PG8_MMA(1, 1, At, B1); PG8_BAR;
            PG8_LDB(B0, 1, 0); PG8_SCHED; PG8_LDA(At, 1, 0); PG8_STAGE_A(0, 1, a2, vs);
            PG8_WAIT_L(8); PG8_BAR; PG8_WAIT_L(0); PG8_MMA(0, 0, At, B0); PG8_BAR; PG8_SCHED;
            PG8_LDB(B1, 1, 1); PG8_STAGE(PG8_SB(1, 0), b3, voffB);
            PG8_BAR; PG8_WAIT_L(0); PG8_MMA(0, 1, At, B1); PG8_BAR;
            PG8_LDA(At, 1, 1); PG8_STAGE_A(1, 0, a3, vs);
            PG8_BAR; PG8_WAIT_L(0); PG8_MMA(1, 0, At, B0); PG8_BAR; PG8_SCHED;
            PG8_STAGE(PG8_SB(1, 1), b3 + hstep, voffB);
            PG8_WAIT_V(6); PG8_BAR; PG8_MMA(1, 1, At, B1); PG8_BAR;
            }
        }
        if constexpr (ALIGN_EPI) { if (wr == 0) PG8_BAR; }
        if constexpr (!Epi::AFTER_DRAIN) { E(acc, cur, wr, wc, fr, fq); S.done(cur); }
        if (!has_next) break;
#pragma unroll
        for (int a = 0; a < 2; ++a)
#pragma unroll
            for (int b = 0; b < 2; ++b)
#pragma unroll
                for (int m = 0; m < 4; ++m)
#pragma unroll
                    for (int n = 0; n < 2; ++n) acc[a][b][m][n] = (f32x4){0.f, 0.f, 0.f, 0.f};
        cur = nxt; cA = nA; cB = nB; ++ui;
        if constexpr (GATHER) { _Pragma("unroll") for (int h_ = 0; h_ < 2; ++h_) _Pragma("unroll") for (int i_ = 0; i_ < 2; ++i_) vc[h_][i_] = vn[h_][i_]; }
        if constexpr (ALIGN_EPI) { if (wr == 1) PG8_BAR; }
    }
    PG8_WAIT_V(0);
    if constexpr (!ALIGN_EPI) { if (wr == 0) PG8_BAR; }
    PG8_BAR;
    if constexpr (Epi::AFTER_DRAIN) { E.fused(acc, cur, wr, wc, fr, fq, lds, wid, lane); S.done(cur); }
#undef PG8_SA
#undef PG8_SB
#undef PG8_STAGE
#undef PG8_STAGE_A
#undef PG8_LOADROWS
#undef PG8_LDA
#undef PG8_LDB
#undef PG8_MMA
#undef PG8_WAIT_V
#undef PG8_WAIT_L
#undef PG8_BAR
#undef PG8_SCHED
}
}
namespace mk {
constexpr int D = 1024, SEQ = 8192, NBMAX = 4, NH = 4, DIN = 5152, NE = 32, DE = 512, DEPTH = 2;
constexpr int NT_IN = 22, NIN = NT_IN * 256;
constexpr int NWAVES = 8, NTHR = 512;
#ifndef MK_MOE_FP8
#define MK_MOE_FP8 0
#endif
constexpr float WSCALE = 16.f, ASCALE = 4.f, YSCALE = 32.f;
constexpr float LOG2E = 1.4426950408889634f, QSCALE = 0.125f * LOG2E, RMS_EPS = 1e-6f;
constexpr int O_GQ = 0, O_GK = 256, O_GV = 512, O_GG = 1024, O_LRF = 1536, O_LRB = 1552, O_DQ = 1568, O_DK = 2080, O_DV = 2592, O_GA = 3104, O_GB = 4128;
typedef unsigned short bf16;
typedef unsigned u32x4 __attribute__((ext_vector_type(4)));
typedef unsigned u32x2 __attribute__((ext_vector_type(2)));
typedef float f32x4 __attribute__((ext_vector_type(4)));
typedef float f32x16 __attribute__((ext_vector_type(16)));
typedef short bf16x8 __attribute__((ext_vector_type(8)));
typedef short s16x4 __attribute__((ext_vector_type(4)));
#define LAS __attribute__((address_space(3)))
#define GAS __attribute__((address_space(1)))
#define LDS_WAIT() asm volatile("s_waitcnt lgkmcnt(0)" ::: "memory")
#define VM_WAIT() asm volatile("s_waitcnt vmcnt(0)" ::: "memory")

constexpr size_t MiB = 1u << 20;
constexpr size_t CTL_BYTES = 256 * 1024;
constexpr int CW_BAR = 4096;
constexpr int CW_CNT = 32768;
constexpr size_t OFF_MOD = 256 * 1024, OFF_TAB = 512 * 1024;
constexpr size_t OFF_WIN = 1 * MiB, SZ_WIN = (size_t)DEPTH * NIN * D * 2;
constexpr size_t OFF_WAB = OFF_WIN + SZ_WIN, SZ_WAB = (size_t)DEPTH * D * D * 2;
constexpr size_t OFF_WO = OFF_WAB + SZ_WAB, SZ_WO = SZ_WAB;
constexpr size_t OFF_WR = OFF_WO + SZ_WO, SZ_WR = (size_t)DEPTH * 256 * D * 2;
constexpr size_t OFF_W1 = OFF_WR + SZ_WR, SZ_W1 = (size_t)DEPTH * NE * 1024 * D * 2;
constexpr size_t OFF_W2 = OFF_W1 + SZ_W1, SZ_W2 = (size_t)DEPTH * NE * D * DE * 2;
constexpr size_t OFF_ACT = 225 * MiB;
static_assert(OFF_W2 + SZ_W2 <= OFF_ACT, "weights fit");
struct WS {
    unsigned* ctl; float* mod; float* tab;
    bf16 *win, *wab, *wo, *wr, *w1, *w2;
    bf16 *H, *OAB, *XB; int* eid; float* gate; int* rank; int* pos; int* tilee; int* segp;
    bf16 *GQ, *GK, *GV, *SG; bf16 *LGF, *LGB; bf16 *DQ, *DK, *DV, *SGA, *SGB; float* KVT; float* DEC; bf16* MERGED;
    bf16 *XS, *ACT, *YS; float* LOGITS; float* gsort; int* stok;
    size_t end;
};
__host__ __device__ inline WS ws_map(unsigned char* b, int nb) {
    WS w; const size_t T = (size_t)nb * SEQ;
    w.ctl = (unsigned*)b; w.mod = (float*)(b + OFF_MOD); w.tab = (float*)(b + OFF_TAB);
    w.win = (bf16*)(b + OFF_WIN); w.wab = (bf16*)(b + OFF_WAB); w.wo = (bf16*)(b + OFF_WO); w.wr = (bf16*)(b + OFF_WR); w.w1 = (bf16*)(b + OFF_W1); w.w2 = (bf16*)(b + OFF_W2);
    size_t o = OFF_ACT;
    auto take = [&](size_t bytes) { unsigned char* p = b + o; o += (bytes + 255) & ~(size_t)255; return p; };
    w.H = (bf16*)take(T * 2048); w.OAB = (bf16*)take(T * 2048); w.XB = (bf16*)take(T * 2048);
    w.eid = (int*)take(T * 8); w.gate = (float*)take(T * 8); w.rank = (int*)take(T * 8); w.pos = (int*)take(T * 8); w.tilee = (int*)take(4096); w.segp = (int*)take(1024);
    const size_t u0 = o;
    w.GQ = (bf16*)take(T * 512); w.GK = (bf16*)take(T * 512); w.GV = (bf16*)take(T * 1024); w.SG = (bf16*)take(T * 1024);
    w.LGF = (bf16*)take(T * 512); w.LGB = (bf16*)take(T * 512);
    w.DQ = (bf16*)take(T * 1024); w.DK = (bf16*)take(T * 1024); w.DV = (bf16*)take(T * 1024); w.SGA = (bf16*)take(T * 2048); w.SGB = (bf16*)take(T * 2048);
    w.KVT = (float*)take(T * 4096); w.MERGED = (bf16*)w.KVT; w.DEC = (float*)take(T * 32);
    const size_t e1 = o; o = u0;
    const size_t R = 2 * T + 32 * 256;
    w.XS = (bf16*)take(R * 2048); w.ACT = (bf16*)take(R * 1024); w.YS = (bf16*)take(R * 2048); w.LOGITS = (float*)take(T * 256); w.gsort = (float*)take(R * 4); w.stok = (int*)take(R * 4);
    w.end = o > e1 ? o : e1;
    return w;
}

typedef float f32x2_t __attribute__((ext_vector_type(2))); typedef __bf16 bf16x2_t __attribute__((ext_vector_type(2)));
__device__ __forceinline__ unsigned cvt_pk(float lo, float hi) { const f32x2_t v = {lo, hi}; const bf16x2_t b = __builtin_convertvector(v, bf16x2_t); return __builtin_bit_cast(unsigned, b); }
__device__ __forceinline__ float bf2f(unsigned short b) { return __uint_as_float(((unsigned)b) << 16); }
__device__ __forceinline__ float bflo(unsigned w) { return __uint_as_float(w << 16); }
__device__ __forceinline__ float bfhi(unsigned w) { return __uint_as_float(w & 0xffff0000u); }
__device__ __forceinline__ float fsigmoid(float x) { return __builtin_amdgcn_rcpf(1.f + __expf(-x)); }
__device__ __forceinline__ float fsilu(float x) { return x * fsigmoid(x); }
__device__ __forceinline__ float fsigmoid255(float x) { return __builtin_amdgcn_rcpf(fmaf(__expf(-x), 1.f / 255.f, 1.f / 255.f)); }
__device__ __forceinline__ float wave_sum(float v) {
#pragma unroll
    for (int o = 1; o < 64; o <<= 1) v += __shfl_xor(v, o);
    return v;
}
__device__ __forceinline__ int t5_bucket(int rel) {
    int ret = rel > 0 ? 16 : 0; int n = rel < 0 ? -rel : rel;
    if (n < 8) return ret + n;
    return ret + 8 + (n >= 12) + (n >= 16) + (n >= 23) + (n >= 32) + (n >= 46) + (n >= 64) + (n >= 91);
}

#define XB_TMO      128
#define XB_XCNT(j)  (256  + 64 * (j))
#define XB_XSUB(j)  (1280 + 64 * (j))
#define XB_XGEN(j)  (2304 + 64 * (j))
#define XB_TOP      3328
#define XB_TOPGEN   3392
#define XCD_BAR_WORDS 3456
#define XB_SPIN_CAP (1u << 18)
__device__ __forceinline__ unsigned xb_ld(unsigned* p)              { return __hip_atomic_load(p, __ATOMIC_RELAXED, __HIP_MEMORY_SCOPE_AGENT); }
__device__ __forceinline__ unsigned xb_add(unsigned* p, unsigned v) { return __hip_atomic_fetch_add(p, v, __ATOMIC_RELAXED, __HIP_MEMORY_SCOPE_AGENT); }
__device__ __forceinline__ unsigned xb_xcc_id() { return (unsigned)__builtin_amdgcn_s_getreg((3 << 11) | 20) & 0xFu; }
#define XB_SPIN(cond, bar) do { unsigned _sp = 0; while (cond) { __builtin_amdgcn_s_sleep(1); \
    if ((++_sp & 255u) == 0u) { if (xb_ld(&(bar)[XB_TMO])) break; if (_sp > XB_SPIN_CAP) { atomicAdd(&(bar)[XB_TMO], 1u); break; } } } } while (0)
struct XcdBarrier { unsigned* bar; unsigned x; volatile LAS unsigned* st; };
__device__ __forceinline__ XcdBarrier xcd_barrier_post(unsigned* bar, volatile LAS unsigned* st) {
    XcdBarrier b; b.bar = bar; b.x = xb_xcc_id(); b.st = st;
    if (threadIdx.x == 0) (void)xb_add(&bar[XB_XCNT(b.x)], 1u);
    return b;
}
__device__ __forceinline__ void xcd_barrier_complete(unsigned* bar, unsigned x, unsigned& nloc, unsigned& nx) {
    const unsigned G = gridDim.x * gridDim.y * gridDim.z;
    unsigned sum, cnt, mine, sp = 0u;
    for (;;) {
        sum = 0u; cnt = 0u; mine = 0u;
#pragma unroll
        for (unsigned j = 0; j < 16; ++j) { const unsigned c = xb_ld(&bar[XB_XCNT(j)]); sum += c; cnt += (c > 0u) ? 1u : 0u; mine = (j == x) ? c : mine; }
        if (sum == G) break;
        __builtin_amdgcn_s_sleep(1);
        if ((++sp & 255u) == 0u) { if (xb_ld(&bar[XB_TMO])) break; if (sp > XB_SPIN_CAP) { atomicAdd(&bar[XB_TMO], 1u); break; } }
    }
    nloc = mine > 0u ? mine : 1u; nx = cnt > 0u ? cnt : 1u;
}
__device__ __forceinline__ void xcd_barrier(const XcdBarrier& b) {
    asm volatile("s_waitcnt vmcnt(0)" ::: "memory");
    __syncthreads();
    if (threadIdx.x == 0) {
        unsigned* bar = b.bar;
        __builtin_amdgcn_s_waitcnt(0);
        unsigned nloc = b.st[0], nx = b.st[1];
        if (nloc == 0u) { xcd_barrier_complete(bar, b.x, nloc, nx); b.st[0] = nloc; b.st[1] = nx; }
        const unsigned old = xb_add(&bar[XB_XSUB(b.x)], 1u);
        const unsigned gen = old / nloc;
        if (old + 1u == (gen + 1u) * nloc) {
            __builtin_amdgcn_fence(__ATOMIC_RELEASE, "agent");
            asm volatile("s_waitcnt vmcnt(0)" ::: "memory");
            const unsigned og = xb_add(&bar[XB_TOP], 1u);
            const unsigned tg = og / nx;
            if (og + 1u == (tg + 1u) * nx) xb_add(&bar[XB_TOPGEN], 1u);
            else XB_SPIN(xb_ld(&bar[XB_TOPGEN]) == tg, bar);
            __builtin_amdgcn_fence(__ATOMIC_ACQUIRE, "agent");
            xb_add(&bar[XB_XGEN(b.x)], 1u);
            asm volatile("s_waitcnt vmcnt(0)" ::: "memory");
        } else {
            XB_SPIN(xb_ld(&bar[XB_XGEN(b.x)]) == gen, bar);
            __builtin_amdgcn_fence(__ATOMIC_ACQUIRE, "agent");
            asm volatile("s_waitcnt vmcnt(0)" ::: "memory");
        }
    }
    __syncthreads();
}

struct Args { const float* in[24]; float* out; unsigned char* ws; int nb, ph_lo, ph_hi, li; };
struct Frame {
    LAS unsigned char* lds; int tid, lane, wave, G, bid, nb, T; unsigned char* ws; const Args* a; float* xbuf;
};
__device__ __forceinline__ void refresh(Frame& F) { int t = threadIdx.x; asm volatile("" : "+v"(t)); F.tid = t; F.lane = t & 63; F.wave = __builtin_amdgcn_readfirstlane(t >> 6); }
constexpr int LDS_BYTES = 160 * 1024 - 64 * 0;
constexpr int LDS_MISC = 160 * 1024 - 256;

__device__ __forceinline__ void tr_item(const float* src, int lds_, int ks0, int c0, bf16* dst, int ldd, int r0, int kd0, LAS float* scr, int lane, float scale = 1.f) {
#pragma unroll 8
    for (int i = 0; i < 32; ++i) { const int kk = 2 * i + (lane >> 5); scr[kk * 33 + (lane & 31)] = src[(size_t)(ks0 + kk) * lds_ + c0 + (lane & 31)] * scale; }
    LDS_WAIT(); asm volatile("" ::: "memory");
    const int c = lane & 7;
#pragma unroll
    for (int j = 0; j < 4; ++j) { const int n = (lane >> 3) + 8 * j; const LAS float* s = scr + (8 * c) * 33 + n;
        u32x4 o; o.x = cvt_pk(s[0 * 33], s[1 * 33]); o.y = cvt_pk(s[2 * 33], s[3 * 33]); o.z = cvt_pk(s[4 * 33], s[5 * 33]); o.w = cvt_pk(s[6 * 33], s[7 * 33]);
        *(u32x4*)(dst + (size_t)(r0 + n) * ldd + kd0 + 8 * c) = o; }
    LDS_WAIT(); asm volatile("" ::: "memory");
}
__device__ __forceinline__ void tr_item8(const float* src, int lds_, int ks0, int c0, unsigned char* dst, int ldd, int r0, int kd0, float scale, LAS float* scr, int lane) {
#pragma unroll 8
    for (int i = 0; i < 32; ++i) { const int kk = 2 * i + (lane >> 5); scr[kk * 33 + (lane & 31)] = src[(size_t)(ks0 + kk) * lds_ + c0 + (lane & 31)] * scale; }
    LDS_WAIT(); asm volatile("" ::: "memory");
    const int c = lane & 7;
#pragma unroll
    for (int j = 0; j < 4; ++j) { const int n = (lane >> 3) + 8 * j; const LAS float* s = scr + (8 * c) * 33 + n;
        int w0 = 0, w1 = 0;
        w0 = __builtin_amdgcn_cvt_pk_fp8_f32(s[0 * 33], s[1 * 33], w0, false); w0 = __builtin_amdgcn_cvt_pk_fp8_f32(s[2 * 33], s[3 * 33], w0, true);
        w1 = __builtin_amdgcn_cvt_pk_fp8_f32(s[4 * 33], s[5 * 33], w1, false); w1 = __builtin_amdgcn_cvt_pk_fp8_f32(s[6 * 33], s[7 * 33], w1, true);
        u32x2 o; o.x = (unsigned)w0; o.y = (unsigned)w1;
        *(u32x2*)(dst + (size_t)(r0 + n) * ldd + kd0 + 8 * c) = o; }
    LDS_WAIT(); asm volatile("" ::: "memory");
}
__device__ __forceinline__ int win_src_col(int tile, int p0) {
    const int bj = p0 >> 7, wc = (p0 >> 5) & 3; const int L = 64 * wc + 32 * bj;
    switch (tile) {
        case 0: return O_GQ + p0; case 1: return O_GK + p0;
        case 2: case 3: return O_GV + (tile - 2) * 256 + p0;
        case 4: case 5: return O_GG + (tile - 4) * 256 + p0;
        case 8: case 9: return O_DQ + (tile - 8) * 256 + L;
        case 10: case 11: return O_DK + (tile - 10) * 256 + L;
        case 12: case 13: return O_DV + (tile - 12) * 256 + p0;
        case 14: case 15: case 16: case 17: return O_GA + (tile - 14) * 256 + p0;
        default: return O_GB + (tile - 18) * 256 + p0;
    }
}
__device__ __forceinline__ void p0_prologue(Frame& F) {
    refresh(F);
    const WS W = ws_map(F.ws, F.nb); const float* const* IN_ = F.a->in;
    const float* c_in = IN_[1]; const float* w_ada = IN_[2]; const float* b_ada = IN_[3];
    {
        LAS float* red = (LAS float*)F.lds;
        for (int it = F.bid; it < DEPTH * 96; it += F.G) {
            const int l = it / 96, j = (it % 96) * 64 + F.lane;
            const float* w = w_ada + (size_t)l * D * 6 * D + j;
            float a0 = 0.f, a1 = 0.f, a2 = 0.f, a3 = 0.f;
            const int kbeg = F.wave * 128;
#pragma unroll 16
            for (int k = kbeg; k < kbeg + 128; ++k) { const float wv = w[(size_t)k * 6 * D];
                const float c0 = c_in[k], c1 = c_in[D + k], c2 = c_in[2 * D + k], c3 = c_in[3 * D + k];
                a0 += fsilu(c0) * wv; a1 += fsilu(c1) * wv; a2 += fsilu(c2) * wv; a3 += fsilu(c3) * wv; }
            red[(F.wave * 4 + 0) * 64 + F.lane] = a0; red[(F.wave * 4 + 1) * 64 + F.lane] = a1; red[(F.wave * 4 + 2) * 64 + F.lane] = a2; red[(F.wave * 4 + 3) * 64 + F.lane] = a3;
            __syncthreads();
            if (F.tid < 256) { const int b = F.tid >> 6, jj = F.tid & 63; float s = 0.f;
#pragma unroll
                for (int wv = 0; wv < 8; ++wv) s += red[(wv * 4 + b) * 64 + jj];
                const int jc = (it % 96) * 64 + jj;
                W.mod[((size_t)l * NBMAX + b) * 6 * D + jc] = s + b_ada[l * 6 * D + jc]; }
            __syncthreads();
        }
    }
    if (F.bid == 0) {
        const float* rb = IN_[14];
        for (int i = F.tid; i < 1024; i += NTHR) { const int h = i >> 8, rel = (i & 255) - 128; W.tab[i] = (rb[t5_bucket(rel) * 4 + h] - rb[31 * 4 + h]) * LOG2E; }
        if (F.tid < 4) W.tab[1024 + F.tid] = __expf(rb[15 * 4 + F.tid] - rb[31 * 4 + F.tid]);
        if (F.tid >= 64 && F.tid < 64 + DEPTH) { const int l = F.tid - 64; const float* lv = IN_[12] + l * 256; float s1 = 0.f, s2 = 0.f;
            for (int i = 0; i < 64; ++i) { s1 += lv[i] * lv[64 + i]; s2 += lv[128 + i] * lv[192 + i]; }
            W.tab[1032 + l] = expf(s1) - expf(s2) + (0.8f - 0.6f * expf(-0.3f * (float)l)); }
    }
    __syncthreads();
    LAS float* scr = (LAS float*)(F.lds + F.wave * 16384);
    const int gw = F.bid * NWAVES + F.wave, NGW = F.G * NWAVES;
    constexpr int I_IN = (NIN / 32) * 16, I_AB = 32 * 16, I_O = 32 * 16, I_1 = NE * 32 * 16, I_2 = NE * 32 * 8;
    constexpr int PER_L = I_IN + I_AB + I_O + I_1 + I_2;
    for (int it = gw; it < DEPTH * PER_L; it += NGW) {
        const int l = it / PER_L; int r = it % PER_L;
        if (r < I_IN) { const int rb = r / 16, kb = r % 16, R = rb * 32, tile = R >> 8, p0 = R & 255;
            if (tile == 6 || tile == 7) continue;
            tr_item(IN_[6] + (size_t)l * D * DIN, DIN, kb * 64, win_src_col(tile, p0), W.win + (size_t)l * NIN * D, D, R, kb * 64, scr, F.lane); continue; }
        r -= I_IN;
        if (r < I_AB) { const int rb = r / 16, kb = r % 16;
            if (kb < 8) tr_item(IN_[15] + (size_t)l * 512 * D, D, kb * 64, rb * 32, W.wab + (size_t)l * D * D, 512, rb * 32, kb * 64, scr, F.lane, 1.f / 255.f);
            else tr_item(IN_[16] + (size_t)l * 512 * D, D, (kb - 8) * 64, rb * 32, W.wab + (size_t)l * D * D + (size_t)1024 * 512, 512, rb * 32, (kb - 8) * 64, scr, F.lane, 1.f / 255.f);
            continue; }
        r -= I_AB;
        if (r < I_O) { const int rb = r / 16, kb = r % 16; tr_item(IN_[17] + (size_t)l * D * D, D, kb * 64, rb * 32, W.wo + (size_t)l * D * D, D, rb * 32, kb * 64, scr, F.lane); continue; }
        r -= I_O;
        if (r < I_1) { const int e = r / 512, q = r % 512, rb = q / 16, kb = q % 16, R = rb * 32, pn = R >> 8, p = R & 255;
            const int col = (p < 128) ? (128 * pn + p) : (512 + 128 * pn + p - 128);
            tr_item(IN_[22] + ((size_t)l * NE + e) * D * 1024, 1024, kb * 64, col, W.w1 + ((size_t)l * NE + e) * 1024 * D, D, R, kb * 64, scr, F.lane); continue; }
        r -= I_1;
        { const int e = r / 256, q = r % 256, rb = q / 8, kb = q % 8;
          tr_item(IN_[23] + ((size_t)l * NE + e) * DE * D, D, kb * 64, rb * 32, W.w2 + ((size_t)l * NE + e) * D * DE, DE, rb * 32, kb * 64, scr, F.lane); }
    }
    for (int it = gw; it < DEPTH * 2 * 8 * 16; it += NGW) {
        const int l = it >> 8, dir = (it >> 7) & 1, nbk = (it >> 4) & 7, kb = it & 15; const int k = kb * 64 + F.lane;
        const float* wi = IN_[6] + (size_t)l * D * DIN + (size_t)k * DIN + (dir ? O_LRB : O_LRF);
        float wv[16];
#pragma unroll
        for (int r = 0; r < 16; ++r) wv[r] = wi[r];
        const float* wu = IN_[7] + ((size_t)l * 2 + dir) * 16 * 256;
        bf16* dst = W.win + (size_t)l * NIN * D + (size_t)((6 + dir) * 256) * D;
        for (int n = nbk * 32; n < nbk * 32 + 32; ++n) { float s = 0.f;
#pragma unroll
            for (int r = 0; r < 16; ++r) s += wv[r] * wu[r * 256 + n];
            dst[(size_t)n * D + k] = (bf16)(cvt_pk(s, 0.f) & 0xffffu); }
    }
    for (int it = gw * 64 + F.lane; it < DEPTH * 256 * 128; it += NGW * 64) {
        const int l = it / (256 * 128), q = it % (256 * 128), row = q >> 7, k0 = (q & 127) * 8;
        float v[8];
#pragma unroll
        for (int i = 0; i < 8; ++i) { float x = 0.f;
            if (row < 4) x = IN_[18][((size_t)l * D + k0 + i) * 4 + row]; else if (row < 36) x = IN_[20][((size_t)l * D + k0 + i) * 32 + row - 4];
            v[i] = x; }
        u32x4 o; o.x = cvt_pk(v[0], v[1]); o.y = cvt_pk(v[2], v[3]); o.z = cvt_pk(v[4], v[5]); o.w = cvt_pk(v[6], v[7]);
        *(u32x4*)(W.wr + ((size_t)l * 256 + row) * D + k0) = o;
    }
}

struct NormRow { f32x4 xf[4]; u32x2 xb[4]; unsigned ya[4], yc[4]; };
__device__ __forceinline__ void norm_load(NormRow& r, const float* xin, const bf16* XB, const unsigned char* YS, int t, int lane, bool from_in, bool combine, int p0, int p1) {
    if (from_in) { const GAS f32x4* xr = (const GAS f32x4*)(xin + (size_t)t * D) + lane;
#pragma unroll
        for (int j = 0; j < 4; ++j) r.xf[j] = xr[64 * j]; }
    else { const GAS u32x2* xr = (const GAS u32x2*)(XB + (size_t)t * D) + lane;
#pragma unroll
        for (int j = 0; j < 4; ++j) r.xb[j] = xr[64 * j]; }
    if (combine) { const GAS unsigned* y0 = (const GAS unsigned*)(YS + (size_t)p0 * D) + lane; const GAS unsigned* y1 = (const GAS unsigned*)(YS + (size_t)p1 * D) + lane;
#pragma unroll
        for (int j = 0; j < 4; ++j) { r.ya[j] = y0[64 * j]; r.yc[j] = y1[64 * j]; } }
}
__device__ __forceinline__ void phase_norm(Frame& F, int l, int mode) {
    refresh(F);
    const WS W = ws_map(F.ws, F.nb); const float* const* IN_ = F.a->in;
    const int gw = F.bid * NWAVES + F.wave, NGW = F.G * NWAVES;
    const bool combine = (mode == 2) || (mode == 0 && l > 0);
    const bool from_in = (mode == 0 && l == 0);
    const int lp = (mode == 2) ? DEPTH - 1 : l - 1;
    const float* ng = (mode == 1 ? IN_[5] : IN_[4]) + (size_t)(mode == 2 ? 0 : l) * D;
    NormRow ra, rb;
    int bcur = -1; f32x4 vA[4], vSH[4], vG2[4];
    auto compute = [&](const NormRow& cur, int t) {
        const int b = t / SEQ;
        if (b != bcur) { bcur = b;
            const float* md = W.mod + ((size_t)l * NBMAX + b) * 6 * D + (mode == 1 ? 3 * D : 0);
            const float* g2 = W.mod + ((size_t)lp * NBMAX + b) * 6 * D + 5 * D;
#pragma unroll
            for (int j = 0; j < 4; ++j) {
                if (mode != 2) { const f32x4 g = *((const GAS f32x4*)ng + F.lane + 64 * j), sc = *((const GAS f32x4*)(md + D) + F.lane + 64 * j); vSH[j] = *((const GAS f32x4*)md + F.lane + 64 * j);
                    vA[j] = (f32x4){g.x * (1.f + sc.x), g.y * (1.f + sc.y), g.z * (1.f + sc.z), g.w * (1.f + sc.w)}; }
                if (combine) vG2[j] = *((const GAS f32x4*)g2 + F.lane + 64 * j) * (1.f / YSCALE); } }
        f32x4 v[4];
        if (from_in) {
#pragma unroll
            for (int j = 0; j < 4; ++j) v[j] = cur.xf[j]; }
        else {
#pragma unroll
            for (int j = 0; j < 4; ++j) { const u32x2 a = cur.xb[j]; v[j] = (f32x4){bflo(a.x), bfhi(a.x), bflo(a.y), bfhi(a.y)}; } }
        if (combine) {
#pragma unroll
            for (int j = 0; j < 4; ++j) { const unsigned a = cur.ya[j], c = cur.yc[j]; const f32x4 g = vG2[j];
                v[j].x += g.x * (__builtin_amdgcn_cvt_f32_fp8((int)a, 0) + __builtin_amdgcn_cvt_f32_fp8((int)c, 0)); v[j].y += g.y * (__builtin_amdgcn_cvt_f32_fp8((int)a, 1) + __builtin_amdgcn_cvt_f32_fp8((int)c, 1));
                v[j].z += g.z * (__builtin_amdgcn_cvt_f32_fp8((int)a, 2) + __builtin_amdgcn_cvt_f32_fp8((int)c, 2)); v[j].w += g.w * (__builtin_amdgcn_cvt_f32_fp8((int)a, 3) + __builtin_amdgcn_cvt_f32_fp8((int)c, 3)); }
            if (mode == 2) { GAS f32x4* xo = (GAS f32x4*)(F.xbuf + (size_t)t * D) + F.lane;
#pragma unroll
                for (int j = 0; j < 4; ++j) xo[64 * j] = v[j]; }
            else { GAS u32x2* xo = (GAS u32x2*)(W.XB + (size_t)t * D) + F.lane;
#pragma unroll
                for (int j = 0; j < 4; ++j) { u32x2 o; o.x = cvt_pk(v[j].x, v[j].y); o.y = cvt_pk(v[j].z, v[j].w); xo[64 * j] = o; } }
        }
        if (mode != 2) {
            float ss = 0.f;
#pragma unroll
            for (int j = 0; j < 4; ++j) ss += (v[j].x * v[j].x + v[j].y * v[j].y) + (v[j].z * v[j].z + v[j].w * v[j].w);
            const float rstd = rsqrtf(wave_sum(ss) * (1.f / D) + RMS_EPS);
            GAS u32x2* ho = (GAS u32x2*)(W.H + (size_t)t * D) + F.lane;
#pragma unroll
            for (int j = 0; j < 4; ++j) { const f32x4 g = vA[j], sh = vSH[j];
                const float h0 = v[j].x * rstd * g.x + sh.x, h1 = v[j].y * rstd * g.y + sh.y, h2 = v[j].z * rstd * g.z + sh.z, h3 = v[j].w * rstd * g.w + sh.w;
                u32x2 o; o.x = cvt_pk(h0, h1); o.y = cvt_pk(h2, h3); ho[64 * j] = o; }
        }
    };
    auto slots = [&](int t, int& p0, int& p1) { p0 = 0; p1 = 0; if (combine && t < F.T) { p0 = W.pos[t * 2]; p1 = W.pos[t * 2 + 1]; } };
    int pa0, pa1, pb0, pb1;
    slots(gw, pa0, pa1); slots(gw + NGW, pb0, pb1);
    if (gw < F.T) norm_load(ra, IN_[0], W.XB, (const unsigned char*)W.YS, gw, F.lane, from_in, combine, pa0, pa1);
    for (int t = gw; t < F.T; t += 2 * NGW) {
        const int t1 = t + NGW, t2 = t + 2 * NGW;
        if (t1 < F.T) norm_load(rb, IN_[0], W.XB, (const unsigned char*)W.YS, t1, F.lane, from_in, combine, pb0, pb1);
        slots(t2, pa0, pa1);
        compute(ra, t);
        if (t1 < F.T) {
            if (t2 < F.T) norm_load(ra, IN_[0], W.XB, (const unsigned char*)W.YS, t2, F.lane, from_in, combine, pa0, pa1);
            slots(t2 + NGW, pb0, pb1);
            compute(rb, t1);
        }
    }
}
typedef pg8::Unit Unit;
__device__ __forceinline__ u32x4 pack8(const f32x4& a, const f32x4& b) { u32x4 w; w.x = cvt_pk(a[0], a[1]); w.y = cvt_pk(a[2], a[3]); w.z = cvt_pk(b[0], b[1]); w.w = cvt_pk(b[2], b[3]); return w; }

#ifndef MK_ATT_FP8
#define MK_ATT_FP8 1
#endif
__device__ __forceinline__ u32x2 pack8_fp8(const f32x4& a, const f32x4& b) { int w0 = 0, w1 = 0;
    w0 = __builtin_amdgcn_cvt_pk_fp8_f32(a[0], a[1], w0, false); w0 = __builtin_amdgcn_cvt_pk_fp8_f32(a[2], a[3], w0, true);
    w1 = __builtin_amdgcn_cvt_pk_fp8_f32(b[0], b[1], w1, false); w1 = __builtin_amdgcn_cvt_pk_fp8_f32(b[2], b[3], w1, true);
    u32x2 r; r.x = (unsigned)w0; r.y = (unsigned)w1; return r; }
struct EpiNull {
    static constexpr bool PERM = true, AFTER_DRAIN = false, MIDK = false;
    __device__ __forceinline__ void operator()(const f32x4 (&acc)[2][2][4][2], const Unit&, int, int, int, int) const {
#pragma unroll
        for (int a = 0; a < 2; ++a)
#pragma unroll
            for (int b = 0; b < 2; ++b)
#pragma unroll
                for (int m = 0; m < 4; ++m) { asm volatile("" :: "v"(acc[a][b][m][0]), "v"(acc[a][b][m][1])); } }
};
struct EpiIn {
    static constexpr bool PERM = true, AFTER_DRAIN = false, MIDK = false;
    bf16 *GQ, *GK, *GV, *SG, *LGF, *LGB, *DQ, *DK, *DV, *SGA, *SGB; const float* b_up; const float* qg; const float* kg; int plain;
    __device__ __forceinline__ void operator()(const f32x4 (&acc)[2][2][4][2], const Unit& u, int wr, int wc, int fr, int fq) const {
        const int pn = u.pn; const int row0 = u.pm * 256 + wr * 64 + fr;
        if (pn >= 8 && pn <= 11) {
            const bool isk = pn >= 10; const int head = 2 * ((pn - 8) & 1) + (wc >> 1), c = wc & 1;
            const float* gv = isk ? kg : qg; const float sc = isk ? 1.f : QSCALE;
            f32x4 g[2][2];
#pragma unroll
            for (int bj = 0; bj < 2; ++bj)
#pragma unroll
                for (int n = 0; n < 2; ++n) g[bj][n] = *(const f32x4*)(gv + 32 * bj + 8 * fq + 4 * n);
#pragma unroll
            for (int ai = 0; ai < 2; ++ai)
#pragma unroll
                for (int m = 0; m < 4; ++m) {
                    const int r = row0 + ai * 128 + m * 16, b = r / SEQ, s = r % SEQ;
                    float ss = 0.f;
#pragma unroll
                    for (int bj = 0; bj < 2; ++bj)
#pragma unroll
                        for (int n = 0; n < 2; ++n) { const f32x4 x = acc[ai][bj][m][n]; ss += (x[0] * x[0] + x[1] * x[1]) + (x[2] * x[2] + x[3] * x[3]); }
                    ss += __shfl_xor(ss, 16); ss += __shfl_xor(ss, 32);
                    const float rs = rsqrtf(ss * (1.f / 64.f) + RMS_EPS) * sc;
#if MK_ATT_FP8
                    unsigned char* dst8 = (unsigned char*)(isk ? DK : DQ) + ((((size_t)b * NH + head) * 2 + c) * SEQ + s) * 64;
#pragma unroll
                    for (int bj = 0; bj < 2; ++bj) {
                        const f32x4 v0 = acc[ai][bj][m][0] * rs * g[bj][0], v1 = acc[ai][bj][m][1] * rs * g[bj][1];
                        int chunk = 2 * bj + (fq >> 1); if (isk) chunk ^= ((s >> 2) & 3);
                        *(u32x2*)(dst8 + chunk * 16 + 8 * (fq & 1)) = pack8_fp8(v0, v1);
                    }
#else
                    bf16* dst = (isk ? DK : DQ) + ((((size_t)b * NH + head) * 2 + c) * SEQ + s) * 64;
#pragma unroll
                    for (int bj = 0; bj < 2; ++bj) {
                        const f32x4 v0 = acc[ai][bj][m][0] * rs * g[bj][0], v1 = acc[ai][bj][m][1] * rs * g[bj][1];
                        int chunk = 4 * bj + fq; if (isk) chunk ^= ((s >> 1) & 7);
                        *(u32x4*)(dst + chunk * 8) = pack8(v0, v1);
                    }
#endif
                }
            return;
        }
#pragma unroll
        for (int ai = 0; ai < 2; ++ai)
#pragma unroll
            for (int m = 0; m < 4; ++m) {
                const int r = row0 + ai * 128 + m * 16;
#pragma unroll
                for (int bj = 0; bj < 2; ++bj) {
                    const int c0 = 128 * bj + 32 * wc + 8 * fq;
                    f32x4 v0 = acc[ai][bj][m][0], v1 = acc[ai][bj][m][1];
                    if (plain) { *(u32x4*)(SGA + (size_t)r * D + (pn & 3) * 256 + c0) = pack8(v0, v1); }
                    else if (pn == 0) { *(u32x4*)(GQ + (size_t)r * 256 + c0) = pack8(v0 * 0.125f, v1 * 0.125f); }
                    else if (pn == 1) { *(u32x4*)(GK + (size_t)r * 256 + c0) = pack8(v0, v1); }
                    else if (pn <= 3) { *(u32x4*)(GV + (size_t)r * 512 + (pn - 2) * 256 + c0) = pack8(v0, v1); }
                    else if (pn <= 5) {
#pragma unroll
                        for (int i = 0; i < 4; ++i) { v0[i] = fsilu(v0[i]); v1[i] = fsilu(v1[i]); }
                        *(u32x4*)(SG + (size_t)r * 512 + (pn - 4) * 256 + c0) = pack8(v0, v1); }
                    else if (pn <= 7) {
                        const float* bu = b_up + (pn - 6) * 256 + c0; const f32x4 b0 = *(const f32x4*)bu, b1 = *(const f32x4*)(bu + 4);
#pragma unroll
                        for (int i = 0; i < 4; ++i) { float z = v0[i] + b0[i]; v0[i] = (fminf(z, 0.f) - __logf(1.f + __expf(-fabsf(z)))) * (1.f / 16.f);
                                                      z = v1[i] + b1[i]; v1[i] = (fminf(z, 0.f) - __logf(1.f + __expf(-fabsf(z)))) * (1.f / 16.f); }
                        *(u32x4*)((pn == 6 ? LGF : LGB) + (size_t)r * 256 + c0) = pack8(v0, v1); }
#if MK_ATT_FP8
                    else if (pn <= 13) {
                        const int b = r / SEQ, s = r % SEQ, head = 2 * (pn - 12) + bj;
                        const int kk = s & 63, wkey = kk & 31, hh_ = (wkey >> 2) & 1, reg_ = (wkey & 3) + 4 * (wkey >> 3), pos = hh_ * 32 + 16 * (kk >> 5) + reg_;
                        unsigned char* tb = (unsigned char*)DV + (((size_t)b * NH + head) * (SEQ / 64) + (s >> 6)) * 8192;
                        const u32x2 pk = pack8_fp8(v0, v1); const int dv0 = 32 * wc + 8 * fq;
#pragma unroll
                        for (int i = 0; i < 8; ++i) { const int dv = dv0 + i; const unsigned byte = ((i < 4 ? pk.x : pk.y) >> (8 * (i & 3))) & 0xffu;
                            tb[dv * 64 + ((((pos >> 4) ^ ((dv >> 2) & 3)) << 4) | (pos & 15))] = (unsigned char)byte; } }
#else
                    else if (pn <= 13) {
                        const int b = r / SEQ, s = r % SEQ, head = 2 * (pn - 12) + bj;
                        bf16* dst = DV + ((((size_t)b * NH + head) * (SEQ / 8) + (s >> 3)) * 4 + wc) * 256 + (s & 7) * 32 + 8 * fq;
                        *(u32x4*)dst = pack8(v0, v1); }
#endif
                    else {
#pragma unroll
                        for (int i = 0; i < 4; ++i) { v0[i] = fsigmoid255(v0[i]); v1[i] = fsigmoid255(v1[i]); }
                        unsigned char* base = (pn <= 17) ? (unsigned char*)SGA + (pn - 14) * 256 : (unsigned char*)SGB + (pn - 18) * 256;
                        u32x2 q; q.x = 0u; q.y = 0u;
                        q.x = __builtin_amdgcn_cvt_pk_u8_f32(v0[0], 0, q.x); q.x = __builtin_amdgcn_cvt_pk_u8_f32(v0[1], 1, q.x); q.x = __builtin_amdgcn_cvt_pk_u8_f32(v0[2], 2, q.x); q.x = __builtin_amdgcn_cvt_pk_u8_f32(v0[3], 3, q.x);
                        q.y = __builtin_amdgcn_cvt_pk_u8_f32(v1[0], 0, q.y); q.y = __builtin_amdgcn_cvt_pk_u8_f32(v1[1], 1, q.y); q.y = __builtin_amdgcn_cvt_pk_u8_f32(v1[2], 2, q.y); q.y = __builtin_amdgcn_cvt_pk_u8_f32(v1[3], 3, q.y);
                        *(u32x2*)(base + (size_t)r * D + c0) = q; }
                }
            }
    }
};

struct EpiMerge {
    static constexpr bool PERM = true, AFTER_DRAIN = false, MIDK = false;
    const bf16* SGA; const bf16* SGB; bf16* O; int nM;
    __device__ __forceinline__ void operator()(const f32x4 (&acc)[2][2][4][2], const Unit& u, int wr, int wc, int fr, int fq) const {
        const int sel = u.pn >> 2; const int row0 = (u.pm - sel * nM) * 256 + wr * 64 + fr, col0 = (u.pn & 3) * 256 + wc * 32 + 8 * fq;
        const unsigned char* G = (const unsigned char*)(sel ? SGB : SGA);
#pragma unroll
        for (int ai = 0; ai < 2; ++ai) {
            u32x2 gt[4][2]; u32x4 t1[4][2];
#pragma unroll
            for (int m = 0; m < 4; ++m) { const size_t off = (size_t)(row0 + ai * 128 + m * 16) * D + col0;
#pragma unroll
                for (int bj = 0; bj < 2; ++bj) { gt[m][bj] = *(const u32x2*)(G + off + bj * 128); if (sel) t1[m][bj] = *(const u32x4*)(O + off + bj * 128); } }
#pragma unroll
            for (int m = 0; m < 4; ++m) { const size_t off = (size_t)(row0 + ai * 128 + m * 16) * D + col0;
#pragma unroll
                for (int bj = 0; bj < 2; ++bj) { const u32x2 b = gt[m][bj];
                    f32x4 v0 = acc[ai][bj][m][0], v1 = acc[ai][bj][m][1];
                    v0[0] *= (float)(b.x & 0xffu); v0[1] *= (float)((b.x >> 8) & 0xffu); v0[2] *= (float)((b.x >> 16) & 0xffu); v0[3] *= (float)(b.x >> 24);
                    v1[0] *= (float)(b.y & 0xffu); v1[1] *= (float)((b.y >> 8) & 0xffu); v1[2] *= (float)((b.y >> 16) & 0xffu); v1[3] *= (float)(b.y >> 24);
                    if (sel) { const u32x4 t = t1[m][bj];
                        v0[0] += bflo(t.x); v0[1] += bfhi(t.x); v0[2] += bflo(t.y); v0[3] += bfhi(t.y); v1[0] += bflo(t.z); v1[1] += bfhi(t.z); v1[2] += bflo(t.w); v1[3] += bfhi(t.w); }
                    *(u32x4*)(O + off + bj * 128) = pack8(v0, v1); } }
            asm volatile("" ::: "memory");
        }
    }
};
struct MergeOrder {
    pg8::StaticOrder so; int nM;
    __device__ __forceinline__ bool next(int i, Unit& u) const { Unit t; if (!so.next(i >> 1, t)) return false; const int sel = i & 1; u.pm = t.pm + sel * nM; u.pn = t.pn + sel * 4; return true; }
    __device__ __forceinline__ void a_ready(const Unit&) const {}
    __device__ __forceinline__ void done(const Unit&) const {}
};

struct EpiResid {
    static constexpr bool PERM = true, AFTER_DRAIN = false, MIDK = false;
    const float* xin32; bf16* xb; const float* g1;
    __device__ __forceinline__ void operator()(const f32x4 (&acc)[2][2][4][2], const Unit& u, int wr, int wc, int fr, int fq) const {
        const int row0 = u.pm * 256 + wr * 64 + fr, col0 = u.pn * 256 + wc * 32 + 8 * fq;
        const int b = (u.pm * 256) / SEQ; const float* g = g1 + (size_t)b * 6 * D + col0;
        f32x4 gv[2][2];
#pragma unroll
        for (int bj = 0; bj < 2; ++bj)
#pragma unroll
            for (int n = 0; n < 2; ++n) gv[bj][n] = *(const f32x4*)(g + bj * 128 + n * 4);
        if (xin32) {
#pragma unroll
            for (int ai = 0; ai < 2; ++ai)
#pragma unroll
                for (int mh = 0; mh < 2; ++mh) { f32x4 x0[2][2], x1[2][2];
#pragma unroll
                    for (int m2 = 0; m2 < 2; ++m2) { const size_t off = (size_t)(row0 + ai * 128 + (2 * mh + m2) * 16) * D + col0;
#pragma unroll
                        for (int bj = 0; bj < 2; ++bj) { x0[m2][bj] = *(const f32x4*)(xin32 + off + bj * 128); x1[m2][bj] = *(const f32x4*)(xin32 + off + bj * 128 + 4); } }
#pragma unroll
                    for (int m2 = 0; m2 < 2; ++m2) { const int m = 2 * mh + m2; const size_t off = (size_t)(row0 + ai * 128 + m * 16) * D + col0;
#pragma unroll
                        for (int bj = 0; bj < 2; ++bj) *(u32x4*)(xb + off + bj * 128) = pack8(x0[m2][bj] + gv[bj][0] * acc[ai][bj][m][0], x1[m2][bj] + gv[bj][1] * acc[ai][bj][m][1]); }
                    asm volatile("" ::: "memory"); }
        } else {
#pragma unroll
            for (int ai = 0; ai < 2; ++ai) { u32x4 xr[4][2];
#pragma unroll
                for (int m = 0; m < 4; ++m) { const size_t off = (size_t)(row0 + ai * 128 + m * 16) * D + col0;
#pragma unroll
                    for (int bj = 0; bj < 2; ++bj) xr[m][bj] = *(const u32x4*)(xb + off + bj * 128); }
#pragma unroll
                for (int m = 0; m < 4; ++m) { const size_t off = (size_t)(row0 + ai * 128 + m * 16) * D + col0;
#pragma unroll
                    for (int bj = 0; bj < 2; ++bj) { const u32x4 a = xr[m][bj];
                        const f32x4 x0 = {bflo(a.x), bfhi(a.x), bflo(a.y), bfhi(a.y)}, x1 = {bflo(a.z), bfhi(a.z), bflo(a.w), bfhi(a.w)};
                        *(u32x4*)(xb + off + bj * 128) = pack8(x0 + gv[bj][0] * acc[ai][bj][m][0], x1 + gv[bj][1] * acc[ai][bj][m][1]); } }
                asm volatile("" ::: "memory"); }
        }
    }
};

struct EpiLogits {
    static constexpr bool PERM = false, AFTER_DRAIN = false, MIDK = false;
    float* L;
    __device__ __forceinline__ void operator()(const f32x4 (&acc)[2][2][4][2], const Unit& u, int wr, int wc, int fr, int fq) const {
        if (wc >= 2) return;
        const int row0 = u.pm * 256 + wr * 64 + fr, col0 = wc * 32 + 4 * fq;
#pragma unroll
        for (int ai = 0; ai < 2; ++ai)
#pragma unroll
            for (int m = 0; m < 4; ++m)
#pragma unroll
                for (int n = 0; n < 2; ++n) *(f32x4*)(L + (size_t)(row0 + ai * 128 + m * 16) * 64 + col0 + n * 16) = acc[ai][0][m][n];
    }
};

#ifndef MK_MOE_FP8
#define MK_MOE_FP8 0
#endif
#if MK_MOE_FP8
struct EpiAct {
    static constexpr bool PERM = true, AFTER_DRAIN = false, MIDK = false;
    unsigned char* ACT;
    __device__ __forceinline__ void operator()(const f32x4 (&acc)[2][2][4][2], const Unit& u, int wr, int wc, int fr, int fq) const {
        const int row0 = u.pm * 256 + wr * 64 + fr, col0 = (u.pn & 3) * 128 + wc * 32 + 8 * fq;
        constexpr float inv = 1.f / WSCALE;
#pragma unroll
        for (int ai = 0; ai < 2; ++ai)
#pragma unroll
            for (int m = 0; m < 4; ++m) { f32x4 v0, v1;
#pragma unroll
                for (int i = 0; i < 4; ++i) { v0[i] = fsilu(acc[ai][0][m][0][i] * inv) * acc[ai][1][m][0][i] * (inv * ASCALE); v1[i] = fsilu(acc[ai][0][m][1][i] * inv) * acc[ai][1][m][1][i] * (inv * ASCALE); }
                *(u32x2*)(ACT + (size_t)(row0 + ai * 128 + m * 16) * DE + col0) = pack8_fp8(v0, v1); }
    }
};
struct EpiYs {
    static constexpr bool PERM = true, AFTER_DRAIN = false, MIDK = false;
    bf16* YS; const float* gs;
    __device__ __forceinline__ void operator()(const f32x4 (&acc)[2][2][4][2], const Unit& u, int wr, int wc, int fr, int fq) const {
        const int row0 = u.pm * 256 + wr * 64 + fr, col0 = (u.pn & 3) * 256 + wc * 32 + 8 * fq;
#pragma unroll
        for (int ai = 0; ai < 2; ++ai)
#pragma unroll
            for (int m = 0; m < 4; ++m) { const int r = row0 + ai * 128 + m * 16; const float gt = gs[r] * (1.f / (WSCALE * ASCALE));
#pragma unroll
                for (int bj = 0; bj < 2; ++bj) *(u32x4*)(YS + (size_t)r * D + col0 + bj * 128) = pack8(acc[ai][bj][m][0] * gt, acc[ai][bj][m][1] * gt); }
    }
};
#else
struct EpiAct {
    static constexpr bool PERM = true, AFTER_DRAIN = false, MIDK = false;
    bf16* ACT;
    __device__ __forceinline__ void operator()(const f32x4 (&acc)[2][2][4][2], const Unit& u, int wr, int wc, int fr, int fq) const {
        const int row0 = u.pm * 256 + wr * 64 + fr, col0 = (u.pn & 3) * 128 + wc * 32 + 8 * fq;
#pragma unroll
        for (int ai = 0; ai < 2; ++ai)
#pragma unroll
            for (int m = 0; m < 4; ++m) { f32x4 v0, v1;
#pragma unroll
                for (int i = 0; i < 4; ++i) { v0[i] = fsilu(acc[ai][0][m][0][i]) * acc[ai][1][m][0][i]; v1[i] = fsilu(acc[ai][0][m][1][i]) * acc[ai][1][m][1][i]; }
                *(u32x4*)(ACT + (size_t)(row0 + ai * 128 + m * 16) * DE + col0) = pack8(v0, v1); }
    }
};
struct EpiYs {
    static constexpr bool PERM = true, AFTER_DRAIN = false, MIDK = false;
    unsigned char* YS; const float* gs;
    __device__ __forceinline__ void operator()(const f32x4 (&acc)[2][2][4][2], const Unit& u, int wr, int wc, int fr, int fq) const {
        const int row0 = u.pm * 256 + wr * 64 + fr, col0 = (u.pn & 3) * 256 + wc * 32 + 8 * fq;
        float gts[2][4];
#pragma unroll
        for (int ai = 0; ai < 2; ++ai)
#pragma unroll
            for (int m = 0; m < 4; ++m) gts[ai][m] = gs[row0 + ai * 128 + m * 16] * YSCALE;
#pragma unroll
        for (int ai = 0; ai < 2; ++ai)
#pragma unroll
            for (int m = 0; m < 4; ++m) { const int r = row0 + ai * 128 + m * 16; const float gt = gts[ai][m];
#pragma unroll
                for (int bj = 0; bj < 2; ++bj) *(u32x2*)(YS + (size_t)r * D + col0 + bj * 128) = pack8_fp8(acc[ai][bj][m][0] * gt, acc[ai][bj][m][1] * gt); }
    }
};
#endif
struct GroupedOrder {
    const int* tilee; int U, G, c; const int* rowidx;
    __device__ __forceinline__ bool next(int i, Unit& u) const {
        int id;
        if ((G & 7) == 0) { const int gx = G >> 3, per = (U + 7) >> 3, n = i * gx + (c >> 3); if (n >= per) return false; id = (c & 7) * per + n; if (id >= U) return false; }
        else { id = i * G + c; if (id >= U) return false; }
        const int t = id >> 2; u.pm = t; u.pn = tilee[t] * 4 + (id & 3); return true;
    }
    __device__ __forceinline__ void a_ready(const Unit&) const {}
    __device__ __forceinline__ void done(const Unit&) const {}
};
constexpr int AT_KR = 0, AT_VR = 32768, AT_TAB = 98304, AT_SLOT = 8192;
typedef int v8i __attribute__((ext_vector_type(8)));
typedef int v4i __attribute__((ext_vector_type(4)));
__device__ __forceinline__ int crow(int r, int hi) { return (r & 3) + 8 * (r >> 2) + 4 * hi; }

__device__ __forceinline__ void attn_bias(f32x16& s0, f32x16& s1, int relbase, const LAS float* tabh) {
#pragma unroll
    for (int r = 0; r < 16; ++r) {
        int i0 = relbase + (r & 3) + 8 * (r >> 2); int i1 = i0 + 32;
        i0 = i0 < 0 ? 0 : (i0 > 255 ? 255 : i0); i1 = i1 < 0 ? 0 : (i1 > 255 ? 255 : i1);
        s0[r] += tabh[i0]; s1[r] += tabh[i1];
    }
}
template <int J>
__device__ __forceinline__ void attn_exp_chunk(f32x16& s0, f32x16& s1, float& lsum) {
    float ls = 0.f;
#pragma unroll
    for (int r = 4 * J; r < 4 * J + 4; ++r) { s0[r] = __builtin_amdgcn_exp2f(s0[r]); s1[r] = __builtin_amdgcn_exp2f(s1[r]); }
    (void)ls; (void)lsum;
}
__device__ __forceinline__ int pk4_bf8(float a, float b, float c, float d) {
    const unsigned lo = __builtin_bit_cast(unsigned, __builtin_amdgcn_cvt_pkrtz(a, b)), hi = __builtin_bit_cast(unsigned, __builtin_amdgcn_cvt_pkrtz(c, d));
    return (int)__builtin_amdgcn_perm(hi, lo, 0x07050301u);
}
#define AT_CM4 ((f32x16){-4.f, -4.f, -4.f, -4.f, -4.f, -4.f, -4.f, -4.f, -4.f, -4.f, -4.f, -4.f, -4.f, -4.f, -4.f, -4.f})
__device__ __forceinline__ void glds16(const unsigned char* sbase, unsigned voff, unsigned lds_dst) { unsigned keep;
    asm volatile("s_mov_b32 %0, m0\n\ts_mov_b32 m0, %3\n\ts_nop 0\n\tglobal_load_lds_dwordx4 %1, %2\n\ts_mov_b32 m0, %0" : "=&s"(keep) : "v"(voff), "s"(sbase), "s"(lds_dst) : "memory"); }
__device__ __forceinline__ void attn_dma_k(unsigned lds0, const unsigned char* kg0, int t, int slot, int wid, int lane) {
    glds16(kg0 + (size_t)(wid >> 2) * SEQ * 64 + (size_t)t * 4096 + (wid & 3) * 1024, (unsigned)lane * 16u, (unsigned)__builtin_amdgcn_readfirstlane((int)(lds0 + AT_KR + slot * AT_SLOT + wid * 1024)));
}
__device__ __forceinline__ void attn_dma_v(unsigned lds0, const unsigned char* vg0, int t, int slot, int wid, int lane) {
    glds16(vg0 + (size_t)t * 8192 + wid * 1024, (unsigned)lane * 16u, (unsigned)__builtin_amdgcn_readfirstlane((int)(lds0 + AT_VR + slot * AT_SLOT + wid * 1024)));
}
#define AT_RD128(dst, addr, off) asm volatile("ds_read_b128 %0, %1 offset:%c2" : "=&v"(dst) : "v"(addr), "i"(off) : "memory")
#define AT_MFMA8(a, b, c) __builtin_amdgcn_mfma_scale_f32_32x32x64_f8f6f4(a, b, c, 0, 0, 0, 0, 0, 0)
#define AT_MFMA8B(a, b, c) __builtin_amdgcn_mfma_scale_f32_32x32x64_f8f6f4(a, b, c, 0, 1, 0, 0, 0, 0)

template <int VAR>
__device__ __forceinline__ void phase_attn(Frame& F, int l) {
    refresh(F);
    const WS W = ws_map(F.ws, F.nb); const float* const* IN_ = F.a->in; (void)IN_; (void)W;
    const int lane = F.lane, wid = F.wave, r32 = lane & 31, hh = lane >> 5, qg = wid & 3, c = wid >> 2;
    LAS unsigned char* lds = F.lds; const unsigned lds0 = (unsigned)(unsigned long)lds;
    LAS float* tab = (LAS float*)(lds + AT_TAB);
    for (int i = F.tid; i < 1028; i += NTHR) tab[i] = W.tab[i];
    const float lam = W.tab[1032 + l]; const float lam_init = 0.8f - 0.6f * __expf(-0.3f * (float)l);
    const float* subg = IN_[13] + l * 128;
    const int U = F.nb * NH * 64;
    const int gx = F.G >> 3, per = U >> 3;
    const int sw = (r32 >> 2) & 3;
    const unsigned ka0 = lds0 + AT_KR + c * 4096 + r32 * 64 + (((2 * hh) ^ sw) << 4), ka1 = lds0 + AT_KR + c * 4096 + r32 * 64 + (((2 * hh + 1) ^ sw) << 4);
    const unsigned va0 = lds0 + AT_VR + r32 * 64 + (((2 * hh) ^ sw) << 4), va1 = lds0 + AT_VR + r32 * 64 + (((2 * hh + 1) ^ sw) << 4);
#ifndef MK_ATT_1BAR
#define MK_ATT_1BAR 1
#endif
    const bool lag = (MK_ATT_1BAR == 0) && wid >= 4;
    __syncthreads();
    for (int i = 0;; ++i) {
        int id;
        if ((F.G & 7) == 0) { const int n = i * gx + (F.bid >> 3); if (n >= per) break; id = (F.bid & 7) * per + n; }
        else { id = i * F.G + F.bid; if (id >= U) break; }
        const int bh = id >> 6, qb = id & 63, b = bh >> 2, h = bh & 3;
        const int qw0 = qb * 128 + 32 * qg;
        const unsigned char* kg0 = (const unsigned char*)W.DK + ((size_t)bh * 2) * SEQ * 64;
        const unsigned char* vg0 = (const unsigned char*)W.DV + (size_t)bh * SEQ * 128;
        v8i qf; { const unsigned char* qp = (const unsigned char*)W.DQ + (((size_t)bh * 2 + c) * SEQ + qw0 + r32) * 64 + 32 * hh;
            const v4i q0 = *(const v4i*)qp, q1 = *(const v4i*)(qp + 16); qf = (v8i){q0[0], q0[1], q0[2], q0[3], q1[0], q1[1], q1[2], q1[3]}; }
        asm volatile("s_waitcnt vmcnt(0)" ::: "memory");
        attn_dma_k(lds0, kg0, 0, 0, wid, lane); attn_dma_k(lds0, kg0, 1, 1, wid, lane); attn_dma_v(lds0, vg0, 0, 7, wid, lane); attn_dma_v(lds0, vg0, 0, 0, wid, lane);
        attn_dma_k(lds0, kg0, 2, 2, wid, lane); attn_dma_v(lds0, vg0, 1, 1, wid, lane); attn_dma_k(lds0, kg0, 3, 3, wid, lane);
        attn_dma_v(lds0, vg0, 2, 2, wid, lane); attn_dma_v(lds0, vg0, 3, 3, wid, lane); attn_dma_v(lds0, vg0, 4, 4, wid, lane); attn_dma_v(lds0, vg0, 5, 5, wid, lane);
        f32x16 o[4]; f32x4 osum = f32x4{};
#pragma unroll
        for (int dt = 0; dt < 4; ++dt) o[dt] = f32x16{};
        v8i ones8; { const int on = (((lane & 15) < 8) == (((lane >> 4) & 1) == 0)) ? 0x38383838 : 0; ones8 = (v8i){on, on, on, on, on, on, on, on}; }
        asm volatile("" : "+v"(ones8));
        const int tL = (qw0 >= 154) ? ((qw0 - 154) >> 6) + 1 : 0, tR = (qw0 + 185) >> 6;
        const float shl = tab[1024 + h];
        const LAS float* tabh = tab + h * 256;
        const int rel0 = -qw0 - r32 + 4 * hh + 128;
        asm volatile("s_waitcnt vmcnt(7)" ::: "memory"); __builtin_amdgcn_s_barrier(); asm volatile("" ::: "memory");
        f32x16 s0, s1; v8i p = {0, 0, 0, 0, 0, 0, 0, 0};
        v4i fa0, fa1, fb0, fb1;
        {   v4i kx[4];
            AT_RD128(kx[0], ka0, 0); AT_RD128(kx[1], ka1, 0); AT_RD128(kx[2], ka0, 2048); AT_RD128(kx[3], ka1, 2048);
            AT_RD128(fa0, va0, 7 * AT_SLOT); AT_RD128(fa1, va1, 7 * AT_SLOT); AT_RD128(fb0, va0, 7 * AT_SLOT + 2048); AT_RD128(fb1, va1, 7 * AT_SLOT + 2048);
            asm volatile("s_waitcnt lgkmcnt(4)" ::: "memory"); __builtin_amdgcn_sched_barrier(0);
            s0 = AT_MFMA8(((v8i){kx[0][0], kx[0][1], kx[0][2], kx[0][3], kx[1][0], kx[1][1], kx[1][2], kx[1][3]}), qf, AT_CM4);
            s1 = AT_MFMA8(((v8i){kx[2][0], kx[2][1], kx[2][2], kx[2][3], kx[3][0], kx[3][1], kx[3][2], kx[3][3]}), qf, AT_CM4); }
        __builtin_amdgcn_s_barrier(); asm volatile("" ::: "memory");
        const bool near0 = (0 >= tL) && (0 < tR);
#define AT_EXP8(sv, b0) do { if constexpr (!(VAR & 1)) { _Pragma("unroll") for (int r_ = (b0); r_ < (b0) + 8; ++r_) sv[r_] = __builtin_amdgcn_exp2f(sv[r_]); } } while (0)
#define AT_RDV(dst, addr, off) do { if constexpr (!(VAR & 4)) AT_RD128(dst, addr, off); else asm volatile("" : "=v"(dst)); } while (0)
#define AT_RDK(dst, addr, off) do { if constexpr (!(VAR & 16)) AT_RD128(dst, addr, off); else asm volatile("" : "=v"(dst)); } while (0)
#define AT_PV(dst, a, b) do { if constexpr (!(VAR & 2)) dst = AT_MFMA8B(a, b, dst); } while (0)
#define AT_SUM(b) do { if constexpr (!(VAR & 2)) osum = __builtin_amdgcn_mfma_scale_f32_16x16x128_f8f6f4(ones8, b, osum, 0, 1, 0, 0, 0, 0); } while (0)
#define AT_QK(dst, a) do { if constexpr (!(VAR & 8)) { const v8i a_ = (a); asm volatile("v_mfma_f32_32x32x64_f8f6f4 %0, %1, %2, -4.0" : "=&v"(dst) : "v"(a_), "v"(qf)); } } while (0)
#define AT_PK(dst, sv, b0) do { if constexpr (!(VAR & 32)) dst = pk4_bf8(sv[b0], sv[(b0) + 1], sv[(b0) + 2], sv[(b0) + 3]); else dst = __builtin_bit_cast(int, sv[b0]); } while (0)
#define AT_V8(a, b) ((v8i){a[0], a[1], a[2], a[3], b[0], b[1], b[2], b[3]})
#define AT_LGKM(n) do { asm volatile("s_waitcnt lgkmcnt(" #n ")" ::: "memory"); __builtin_amdgcn_sched_barrier(0); } while (0)
#define AT_STEP(SL, t) do { \
            if ((t) - 1 == tL) { _Pragma("unroll") for (int dt = 0; dt < 4; ++dt) o[dt] *= shl; osum *= shl; }    \
            AT_SUM(p); __builtin_amdgcn_sched_barrier(0);                                                           \
            if constexpr (!(VAR & 128)) { const int tk = (t) + 4 < 128 ? (t) + 4 : 127, tv = (t) + 6 < 128 ? (t) + 6 : 127; attn_dma_k(lds0, kg0, tk, (SL) & 3, wid, lane); attn_dma_v(lds0, vg0, tv, ((SL) + 6) & 7, wid, lane); } \
            { v4i fc0, fc1, fd0, fd1, fk0, fk1, fk2, fk3; \
              if ((t) >= tL && (t) < tR) { attn_bias(s0, s1, 64 * (t) + rel0, tabh); AT_EXP8(s0, 0); }           \
              AT_RDV(fc0, va0, (((SL) + 7) & 7) * AT_SLOT + 4096); AT_RDV(fc1, va1, (((SL) + 7) & 7) * AT_SLOT + 4096); AT_RDV(fd0, va0, (((SL) + 7) & 7) * AT_SLOT + 6144); AT_RDV(fd1, va1, (((SL) + 7) & 7) * AT_SLOT + 6144); \
              AT_RDK(fk0, ka0, (((SL) + 1) & 3) * AT_SLOT); AT_RDK(fk1, ka1, (((SL) + 1) & 3) * AT_SLOT); \
              AT_LGKM(6); \
              AT_PV(o[0], AT_V8(fa0, fa1), p); \
              AT_RDK(fk2, ka0, (((SL) + 1) & 3) * AT_SLOT + 2048); AT_RDK(fk3, ka1, (((SL) + 1) & 3) * AT_SLOT + 2048); \
              AT_EXP8(s0, 8); \
              __builtin_amdgcn_sched_barrier(0); \
              AT_PV(o[1], AT_V8(fb0, fb1), p); \
              AT_EXP8(s1, 0); \
              AT_LGKM(4); \
              AT_PV(o[2], AT_V8(fc0, fc1), p); \
              AT_RDV(fa0, va0, ((SL) & 7) * AT_SLOT); AT_RDV(fa1, va1, ((SL) & 7) * AT_SLOT); \
              AT_EXP8(s1, 8); \
              __builtin_amdgcn_sched_barrier(0); \
              AT_PV(o[3], AT_V8(fd0, fd1), p); \
              AT_RDV(fb0, va0, ((SL) & 7) * AT_SLOT + 2048); AT_RDV(fb1, va1, ((SL) & 7) * AT_SLOT + 2048); \
              AT_PK(p[0], s0, 0); AT_PK(p[1], s0, 4); AT_PK(p[2], s0, 8); AT_PK(p[3], s0, 12); \
              AT_LGKM(6); \
              AT_QK(s0, AT_V8(fk0, fk1)); \
              AT_PK(p[4], s1, 0); AT_PK(p[5], s1, 4); AT_PK(p[6], s1, 8); AT_PK(p[7], s1, 12); \
              AT_LGKM(4); \
              AT_QK(s1, AT_V8(fk2, fk3)); \
              asm volatile("" : "+v"(p));                            \
              if (!((t) + 1 >= tL && (t) + 1 < tR)) { asm volatile("s_nop 3" ::: "memory"); AT_EXP8(s0, 0); asm volatile("" : "+v"(s0)); } }     \
            asm volatile("s_waitcnt vmcnt(5)" ::: "memory"); if constexpr (!(VAR & 64)) __builtin_amdgcn_s_barrier(); asm volatile("" ::: "memory"); } while (0)
        if (!near0) { AT_EXP8(s0, 0); }
        for (int t0 = 0; t0 < 128; t0 += 8) { AT_STEP(0, t0); AT_STEP(1, t0 + 1); AT_STEP(2, t0 + 2); AT_STEP(3, t0 + 3); AT_STEP(4, t0 + 4); AT_STEP(5, t0 + 5); AT_STEP(6, t0 + 6); AT_STEP(7, t0 + 7); }
#undef AT_STEP
#undef AT_EXP8
#undef AT_RDV
#undef AT_RDK
#undef AT_PV
#undef AT_SUM
#undef AT_QK
#undef AT_PK
        {
            v4i fc0, fc1, fd0, fd1;
            AT_RD128(fc0, va0, 7 * AT_SLOT + 4096); AT_RD128(fc1, va1, 7 * AT_SLOT + 4096); AT_RD128(fd0, va0, 7 * AT_SLOT + 6144); AT_RD128(fd1, va1, 7 * AT_SLOT + 6144);
            if (127 == tL) { _Pragma("unroll") for (int dt = 0; dt < 4; ++dt) o[dt] *= shl; osum *= shl; }
            osum = __builtin_amdgcn_mfma_scale_f32_16x16x128_f8f6f4(ones8, p, osum, 0, 1, 0, 0, 0, 0);
            AT_LGKM(0);
            o[0] = AT_MFMA8B(AT_V8(fa0, fa1), p, o[0]); o[1] = AT_MFMA8B(AT_V8(fb0, fb1), p, o[1]); o[2] = AT_MFMA8B(AT_V8(fc0, fc1), p, o[2]); o[3] = AT_MFMA8B(AT_V8(fd0, fd1), p, o[3]);
        }
#undef AT_LGKM
#undef AT_V8
        asm volatile("s_waitcnt vmcnt(0)" ::: "memory"); __builtin_amdgcn_s_barrier(); asm volatile("" ::: "memory");
        const float lt = __shfl(osum[0], r32 + (r32 >= 16 ? 16 : 0));
        LAS float* xch = (LAS float*)(lds + qg * 16384);
        if (c == 1) { const float f = lam / lt;
#pragma unroll
            for (int dt = 0; dt < 4; ++dt)
#pragma unroll
                for (int r = 0; r < 16; ++r) xch[(dt * 16 + r) * 64 + lane] = o[dt][r] * f; }
        LDS_WAIT(); __builtin_amdgcn_s_barrier(); asm volatile("" ::: "memory");
        if (c == 0) { const float f = 1.f / lt; float ss = 0.f;
#pragma unroll
            for (int dt = 0; dt < 4; ++dt)
#pragma unroll
                for (int r = 0; r < 16; ++r) { const float v = o[dt][r] * f - xch[(dt * 16 + r) * 64 + lane]; o[dt][r] = v; ss += v * v; }
            ss += __shfl_xor(ss, 32);
            const float rn = rsqrtf(ss * (1.f / 128.f) + RMS_EPS) * (1.f - lam_init);
            bf16* orow = W.OAB + (size_t)F.T * 512 + ((size_t)b * SEQ + qw0 + r32) * 512 + h * 128;
#pragma unroll
            for (int dt = 0; dt < 4; ++dt)
#pragma unroll
                for (int g = 0; g < 4; ++g) { const int dv = 32 * dt + 8 * g + 4 * hh; const f32x4 sg = *(const f32x4*)(subg + dv);
                    u32x2 ov; ov.x = cvt_pk(o[dt][4 * g] * rn * sg[0], o[dt][4 * g + 1] * rn * sg[1]); ov.y = cvt_pk(o[dt][4 * g + 2] * rn * sg[2], o[dt][4 * g + 3] * rn * sg[3]);
                    *(u32x2*)(orow + dv) = ov; }
        }
        LDS_WAIT(); __builtin_amdgcn_s_barrier(); asm volatile("" ::: "memory");
    }
}
constexpr int GL_CUM = 0;
constexpr int GL_S64 = 144, GL_S192 = 400;
constexpr int G1_KEF = 34816, G1_KEB = G1_KEF + 64 * GL_S64, G1_VT = G1_KEB + 64 * GL_S64;
constexpr int G3_AOP = 34816, G3_KIF = G3_AOP + 64 * GL_S192, G3_KIB = G3_KIF + 64 * GL_S64, G3_BOP = G3_KIB + 64 * GL_S64;
static_assert(G3_BOP + 128 * GL_S192 <= 150 * 1024, "GLA LDS");

__device__ __forceinline__ bf16x8 lds_frag(const LAS unsigned char* base, int row, int stride, int kbyte) { return *(const LAS bf16x8*)(base + row * stride + kbyte); }

struct GlaIn { u32x2 lg[4]; u32x4 k, v0, v1, q, st[4], sg0, sg1; };
template <bool G3>
__device__ __forceinline__ void gla_load(const Frame& F, const WS& W, int u, GlaIn& r) {
    const int n = u & 127, bh = u >> 7, b = bh >> 2, h = bh & 3; const size_t trow0 = (size_t)b * SEQ + n * 64;
#pragma unroll
    for (int it = 0; it < 4; ++it) { const int idx = F.tid + it * NTHR; const int dir = idx >> 10, t = (idx >> 4) & 63, d4 = (idx & 15) * 4;
        r.lg[it] = *(const u32x2*)((dir ? W.LGB : W.LGF) + (trow0 + t) * 256 + h * 64 + d4); }
    const int t = F.tid >> 3, d0 = (F.tid & 7) * 8, v0 = (F.tid & 7) * 16;
    r.k = *(const u32x4*)(W.GK + (trow0 + t) * 256 + h * 64 + d0);
    r.v0 = *(const u32x4*)(W.GV + (trow0 + t) * 512 + h * 128 + v0); r.v1 = *(const u32x4*)(W.GV + (trow0 + t) * 512 + h * 128 + v0 + 8);
    if constexpr (G3) {
        r.q = *(const u32x4*)(W.GQ + (trow0 + t) * 256 + h * 64 + d0);
        const int dv = F.tid >> 2, dd0 = (F.tid & 3) * 16;
#pragma unroll
        for (int dir = 0; dir < 2; ++dir) { const bf16* sp = (const bf16*)W.KVT + ((size_t)u * 2 + dir) * 8192 + dv * 64 + dd0; r.st[2 * dir] = *(const u32x4*)sp; r.st[2 * dir + 1] = *(const u32x4*)(sp + 8); }
        r.sg0 = *(const u32x4*)(W.SG + (trow0 + t) * 512 + h * 128 + v0); r.sg1 = *(const u32x4*)(W.SG + (trow0 + t) * 512 + h * 128 + v0 + 8);
    }
}
__device__ __forceinline__ void gla_cum(Frame& F, const GlaIn& r) {
    LAS float* cum = (LAS float*)(F.lds + GL_CUM);
#pragma unroll
    for (int it = 0; it < 4; ++it) { const int idx = F.tid + it * NTHR; const int dir = idx >> 10, t = (idx >> 4) & 63, d4 = (idx & 15) * 4;
        const u32x2 a = r.lg[it];
        *(LAS f32x4*)(cum + (dir * 64 + t) * 64 + d4) = (f32x4){bflo(a.x), bfhi(a.x), bflo(a.y), bfhi(a.y)}; }
    __syncthreads();
    {
        const int dir = F.tid >> 8, seg = (F.tid >> 6) & 3, d = F.tid & 63; LAS float* cc = cum + dir * 4096 + d; LAS float* tot = cum + 8192 + (dir * 4 + seg) * 64 + d;
        float v[16]; float run = 0.f;
        if (dir == 0) {
#pragma unroll
            for (int i = 0; i < 16; ++i) { run += cc[(16 * seg + i) * 64]; v[i] = run; }
        } else {
#pragma unroll
            for (int i = 15; i >= 0; --i) { run += cc[(16 * seg + i) * 64]; v[i] = run; }
        }
        *tot = run;
        __syncthreads();
        float off = 0.f; const LAS float* tb = cum + 8192 + dir * 256 + d;
        if (dir == 0) { if (seg > 0) off += tb[0]; if (seg > 1) off += tb[64]; if (seg > 2) off += tb[128]; }
        else { if (seg < 3) off += tb[192]; if (seg < 2) off += tb[128]; if (seg < 1) off += tb[64]; }
#pragma unroll
        for (int i = 0; i < 16; ++i) cc[(16 * seg + i) * 64] = v[i] + off;
    }
    __syncthreads();
}

__device__ __forceinline__ void phase_gla1(Frame& F) {
    refresh(F);
    const WS W = ws_map(F.ws, F.nb); const float* const* IN_ = F.a->in; (void)IN_; (void)W;
    LAS unsigned char* lds = F.lds; LAS float* cum = (LAS float*)(lds + GL_CUM);
    const int lane = F.lane, wid = F.wave, r32 = lane & 31, hh = lane >> 5;
    const int U = F.nb * NH * 128;
    GlaIn cur, nxt;
    if (F.bid < U) gla_load<false>(F, W, F.bid, nxt);
    for (int u = F.bid; u < U; u += F.G) {
        cur = nxt;
        if (u + F.G < U) gla_load<false>(F, W, u + F.G, nxt);
        gla_cum(F, cur);
        {
            const int t = F.tid >> 3, d0 = (F.tid & 7) * 8;
            const u32x4 kv = cur.k;
            const unsigned kw[4] = {kv.x, kv.y, kv.z, kv.w};
#pragma unroll
            for (int j = 0; j < 8; ++j) { const int d = d0 + j; const float k = (j & 1) ? bfhi(kw[j >> 1]) : bflo(kw[j >> 1]);
                const float ef = __expf(cum[63 * 64 + d] - cum[t * 64 + d]), eb = __expf(cum[4096 + d] - cum[4096 + t * 64 + d]);
                *(LAS bf16*)(lds + G1_KEF + d * GL_S64 + t * 2) = (bf16)(cvt_pk(k * ef, 0.f) & 0xffffu);
                *(LAS bf16*)(lds + G1_KEB + d * GL_S64 + t * 2) = (bf16)(cvt_pk(k * eb, 0.f) & 0xffffu); }
            const int v0 = (F.tid & 7) * 16;
            const u32x4 va = cur.v0, vb = cur.v1;
            const unsigned vw[8] = {va.x, va.y, va.z, va.w, vb.x, vb.y, vb.z, vb.w};
#pragma unroll
            for (int j = 0; j < 16; ++j) *(LAS bf16*)(lds + G1_VT + (v0 + j) * GL_S64 + t * 2) = (bf16)((j & 1) ? (vw[j >> 1] >> 16) : (vw[j >> 1] & 0xffffu));
            if (F.tid < 128) { const int dir = F.tid >> 6, d = F.tid & 63; W.DEC[((size_t)u * 2 + dir) * 64 + d] = __expf(dir ? cum[4096 + d] : cum[63 * 64 + d]); }
        }
        __syncthreads();
        {
            const int dt = wid & 3, dd = wid >> 2;
            f32x16 cf = {}, cb = {};
#pragma unroll
            for (int s = 0; s < 4; ++s) { const int kb = (16 * s + 8 * hh) * 2;
                const bf16x8 a = lds_frag(lds + G1_VT, 32 * dt + r32, GL_S64, kb);
                cf = __builtin_amdgcn_mfma_f32_32x32x16_bf16(a, lds_frag(lds + G1_KEF, 32 * dd + r32, GL_S64, kb), cf, 0, 0, 0);
                cb = __builtin_amdgcn_mfma_f32_32x32x16_bf16(a, lds_frag(lds + G1_KEB, 32 * dd + r32, GL_S64, kb), cb, 0, 0, 0); }
            bf16* of = (bf16*)W.KVT + ((size_t)u * 2) * 8192; bf16* ob = of + 8192;
#pragma unroll
            for (int r = 0; r < 16; ++r) { const int dv = 32 * dt + crow(r, hh), d = 32 * dd + r32;
                const float pf = __shfl_xor(cf[r], 1), pb = __shfl_xor(cb[r], 1);
                if (!(lane & 1)) { *(unsigned*)(of + dv * 64 + d) = cvt_pk(cf[r], pf); *(unsigned*)(ob + dv * 64 + d) = cvt_pk(cb[r], pb); } }
        }
        __syncthreads();
    }
}

__device__ __forceinline__ void phase_gla2(Frame& F) {
    refresh(F);
    const WS W = ws_map(F.ws, F.nb); const float* const* IN_ = F.a->in; (void)IN_; (void)W;
    const size_t total = (size_t)F.nb * NH * 2 * 4096;
    for (size_t wk = (size_t)F.bid * NTHR + F.tid; wk < total; wk += (size_t)F.G * NTHR) {
        const int e2 = (int)(wk & 4095), dir = (int)((wk >> 12) & 1), bh = (int)(wk >> 13), d = (e2 * 2) & 63;
        unsigned* base = (unsigned*)((bf16*)W.KVT + ((size_t)bh * 128 * 2 + dir) * 8192) + e2; const float* dec = W.DEC + ((size_t)bh * 128 * 2 + dir) * 64 + d;
        float S0 = 0.f, S1 = 0.f;
        for (int n0 = 0; n0 < 128; n0 += 8) {
            unsigned kv[8]; float dc0[8], dc1[8];
#pragma unroll
            for (int j = 0; j < 8; ++j) { const int n = dir ? 127 - (n0 + j) : n0 + j; kv[j] = base[(size_t)n * 8192]; dc0[j] = dec[(size_t)n * 128]; dc1[j] = dec[(size_t)n * 128 + 1]; }
#pragma unroll
            for (int j = 0; j < 8; ++j) { const int n = dir ? 127 - (n0 + j) : n0 + j; base[(size_t)n * 8192] = cvt_pk(S0, S1); S0 = dc0[j] * S0 + bflo(kv[j]); S1 = dc1[j] * S1 + bfhi(kv[j]); }
        }
    }
}

__device__ __forceinline__ void phase_gla3(Frame& F, int l) {
    refresh(F);
    const WS W = ws_map(F.ws, F.nb); const float* const* IN_ = F.a->in; (void)IN_; (void)W;
    LAS unsigned char* lds = F.lds; LAS float* cum = (LAS float*)(lds + GL_CUM);
    const int lane = F.lane, wid = F.wave, r32 = lane & 31, hh = lane >> 5;
    const float* gng = IN_[9] + l * 128;
    const int U = F.nb * NH * 128;
    GlaIn cur, nxt;
    if (F.bid < U) gla_load<true>(F, W, F.bid, nxt);
    for (int u = F.bid; u < U; u += F.G) {
        const int n = u & 127, bh = u >> 7, b = bh >> 2, h = bh & 3; const size_t trow0 = (size_t)b * SEQ + n * 64;
        cur = nxt;
        if (u + F.G < U) gla_load<true>(F, W, u + F.G, nxt);
        gla_cum(F, cur);
        {
            const int t = F.tid >> 3, d0 = (F.tid & 7) * 8;
            const u32x4 qv = cur.q, kv = cur.k;
            const unsigned qw[4] = {qv.x, qv.y, qv.z, qv.w}, kw[4] = {kv.x, kv.y, kv.z, kv.w};
            float qf[8], qb[8], kf[8], kb[8];
#pragma unroll
            for (int j = 0; j < 8; ++j) { const int d = d0 + j; const float q = (j & 1) ? bfhi(qw[j >> 1]) : bflo(qw[j >> 1]), k = (j & 1) ? bfhi(kw[j >> 1]) : bflo(kw[j >> 1]);
                const float cf = cum[t * 64 + d], cb = cum[4096 + t * 64 + d];
                qf[j] = q * __expf(cf); qb[j] = q * __expf(cb); kf[j] = k * __expf(-cf); kb[j] = k * __expf(-cb); }
            u32x4 o;
            o.x = cvt_pk(qf[0], qf[1]); o.y = cvt_pk(qf[2], qf[3]); o.z = cvt_pk(qf[4], qf[5]); o.w = cvt_pk(qf[6], qf[7]); *(LAS u32x4*)(lds + G3_AOP + t * GL_S192 + (64 + d0) * 2) = o;
            o.x = cvt_pk(qb[0], qb[1]); o.y = cvt_pk(qb[2], qb[3]); o.z = cvt_pk(qb[4], qb[5]); o.w = cvt_pk(qb[6], qb[7]); *(LAS u32x4*)(lds + G3_AOP + t * GL_S192 + (128 + d0) * 2) = o;
            o.x = cvt_pk(kf[0], kf[1]); o.y = cvt_pk(kf[2], kf[3]); o.z = cvt_pk(kf[4], kf[5]); o.w = cvt_pk(kf[6], kf[7]); *(LAS u32x4*)(lds + G3_KIF + t * GL_S64 + d0 * 2) = o;
            o.x = cvt_pk(kb[0], kb[1]); o.y = cvt_pk(kb[2], kb[3]); o.z = cvt_pk(kb[4], kb[5]); o.w = cvt_pk(kb[6], kb[7]); *(LAS u32x4*)(lds + G3_KIB + t * GL_S64 + d0 * 2) = o;
            const int v0 = (F.tid & 7) * 16;
            const u32x4 va = cur.v0, vb = cur.v1;
            const unsigned vw[8] = {va.x, va.y, va.z, va.w, vb.x, vb.y, vb.z, vb.w};
#pragma unroll
            for (int j = 0; j < 16; ++j) *(LAS bf16*)(lds + G3_BOP + (v0 + j) * GL_S192 + t * 2) = (bf16)((j & 1) ? (vw[j >> 1] >> 16) : (vw[j >> 1] & 0xffffu));
            const int dv = F.tid >> 2, dd0 = (F.tid & 3) * 16;
#pragma unroll
            for (int dir = 0; dir < 2; ++dir) { const u32x4 o0 = cur.st[2 * dir], o1 = cur.st[2 * dir + 1];
                *(LAS u32x4*)(lds + G3_BOP + dv * GL_S192 + (64 + 64 * dir + dd0) * 2) = o0; *(LAS u32x4*)(lds + G3_BOP + dv * GL_S192 + (64 + 64 * dir + dd0 + 8) * 2) = o1; }
        }
        __syncthreads();
        if (wid < 4) {
            const int it = wid >> 1, jt = wid & 1;
            f32x16 af = {}, ab = {};
#pragma unroll
            for (int s = 0; s < 4; ++s) { const int kb = (16 * s + 8 * hh) * 2;
                if (jt <= it) af = __builtin_amdgcn_mfma_f32_32x32x16_bf16(lds_frag(lds + G3_AOP, 32 * it + r32, GL_S192, 128 + kb), lds_frag(lds + G3_KIF, 32 * jt + r32, GL_S64, kb), af, 0, 0, 0);
                if (jt >= it) ab = __builtin_amdgcn_mfma_f32_32x32x16_bf16(lds_frag(lds + G3_AOP, 32 * it + r32, GL_S192, 256 + kb), lds_frag(lds + G3_KIB, 32 * jt + r32, GL_S64, kb), ab, 0, 0, 0); }
#pragma unroll
            for (int r = 0; r < 16; ++r) { const int i = 32 * it + crow(r, hh), j = 32 * jt + r32; const float v = (j <= i) ? af[r] : ab[r];
                *(LAS bf16*)(lds + G3_AOP + i * GL_S192 + j * 2) = (bf16)(cvt_pk(v, 0.f) & 0xffffu); }
        }
        __syncthreads();
        {
            const int it = wid >> 2, dt = wid & 3; f32x16 o = {};
#pragma unroll
            for (int s = 0; s < 12; ++s) { const int kb = (16 * s + 8 * hh) * 2;
                o = __builtin_amdgcn_mfma_f32_32x32x16_bf16(lds_frag(lds + G3_AOP, 32 * it + r32, GL_S192, kb), lds_frag(lds + G3_BOP, 32 * dt + r32, GL_S192, kb), o, 0, 0, 0); }
            LAS float* out = (LAS float*)(lds + GL_CUM);
#pragma unroll
            for (int r = 0; r < 16; ++r) out[(32 * it + crow(r, hh)) * 128 + 32 * dt + r32] = o[r];
        }
        __syncthreads();
        {
            const int t = F.tid >> 3, v0 = (F.tid & 7) * 16; const LAS float* orow = (const LAS float*)(lds + GL_CUM) + t * 128 + v0;
            float x[16]; float ss = 0.f;
#pragma unroll
            for (int j = 0; j < 16; ++j) { x[j] = orow[j]; ss += x[j] * x[j]; }
            ss += __shfl_xor(ss, 1); ss += __shfl_xor(ss, 2); ss += __shfl_xor(ss, 4);
            const float rs = rsqrtf(ss * (1.f / 128.f) + RMS_EPS);
            const u32x4 ga = cur.sg0, gb = cur.sg1;
            const unsigned gw[8] = {ga.x, ga.y, ga.z, ga.w, gb.x, gb.y, gb.z, gb.w};
            float y[16];
#pragma unroll
            for (int j = 0; j < 16; ++j) y[j] = x[j] * rs * gng[v0 + j] * ((j & 1) ? bfhi(gw[j >> 1]) : bflo(gw[j >> 1]));
            u32x4 o0, o1; o0.x = cvt_pk(y[0], y[1]); o0.y = cvt_pk(y[2], y[3]); o0.z = cvt_pk(y[4], y[5]); o0.w = cvt_pk(y[6], y[7]);
            o1.x = cvt_pk(y[8], y[9]); o1.y = cvt_pk(y[10], y[11]); o1.z = cvt_pk(y[12], y[13]); o1.w = cvt_pk(y[14], y[15]);
            bf16* dst = W.OAB + (trow0 + t) * 512 + h * 128 + v0; *(u32x4*)dst = o0; *(u32x4*)(dst + 8) = o1;
        }
        __syncthreads();
    }
}
__device__ __forceinline__ void phase_select(Frame& F, int l) {
    refresh(F);
    const WS W = ws_map(F.ws, F.nb); const float* const* IN_ = F.a->in; (void)IN_; (void)W;
    LAS int* lcnt = (LAS int*)F.lds; LAS int* lbase = lcnt + 32;
    const float* b_rg = IN_[19] + l * 4; const float* b_re = IN_[21] + l * 32;
    unsigned* gcnt = W.ctl + CW_CNT + l * 64;
    for (int t0 = F.bid * NTHR; t0 < F.T; t0 += F.G * NTHR) {
        if (F.tid < 32) lcnt[F.tid] = 0;
        __syncthreads();
        const int t = t0 + F.tid; int e0 = 0, e1 = 0, r0 = 0, r1 = 0; float g0 = 0.f, g1 = 0.f;
        if (t < F.T) {
            const float* lg = W.LOGITS + (size_t)t * 64;
            float gl[4]; { const f32x4 v = *(const f32x4*)lg; gl[0] = v[0] + b_rg[0]; gl[1] = v[1] + b_rg[1]; gl[2] = v[2] + b_rg[2]; gl[3] = v[3] + b_rg[3]; }
            int grp = 0; float mx = gl[0];
            if (gl[1] > mx) { mx = gl[1]; grp = 1; } if (gl[2] > mx) { mx = gl[2]; grp = 2; } if (gl[3] > mx) { mx = gl[3]; grp = 3; }
            const float p_grp = 1.f / (__expf(gl[0] - mx) + __expf(gl[1] - mx) + __expf(gl[2] - mx) + __expf(gl[3] - mx));
            const f32x4 ea = *(const f32x4*)(lg + 4 + grp * 8), eb = *(const f32x4*)(lg + 8 + grp * 8);
            const f32x4 ba = *(const f32x4*)(b_re + grp * 8), bb = *(const f32x4*)(b_re + grp * 8 + 4);
            float b0v = -1e30f, b1v = -1e30f; int i0 = 0, i1 = 0;
#pragma unroll
            for (int j = 0; j < 8; ++j) { const float e = (j < 4) ? ea[j] + ba[j] : eb[j - 4] + bb[j - 4];
                if (e > b0v) { b1v = b0v; i1 = i0; b0v = e; i0 = j; } else if (e > b1v) { b1v = e; i1 = j; } }
            const float p1 = __expf(b1v - b0v), s2 = 1.f + p1;
            e0 = grp * 8 + i0; e1 = grp * 8 + i1; g0 = p_grp / s2; g1 = p_grp * p1 / s2;
            r0 = __hip_atomic_fetch_add(lcnt + e0, 1, __ATOMIC_RELAXED, __HIP_MEMORY_SCOPE_WORKGROUP);
            r1 = __hip_atomic_fetch_add(lcnt + e1, 1, __ATOMIC_RELAXED, __HIP_MEMORY_SCOPE_WORKGROUP);
        }
        __syncthreads();
        if (F.tid < 32) lbase[F.tid] = (int)__hip_atomic_fetch_add(gcnt + F.tid, (unsigned)lcnt[F.tid], __ATOMIC_RELAXED, __HIP_MEMORY_SCOPE_AGENT);
        __syncthreads();
        if (t < F.T) { W.eid[t * 2] = e0; W.eid[t * 2 + 1] = e1; W.gate[t * 2] = g0; W.gate[t * 2 + 1] = g1; W.rank[t * 2] = lbase[e0] + r0; W.rank[t * 2 + 1] = lbase[e1] + r1; }
        __syncthreads();
    }
}
__device__ __forceinline__ void phase_gather(Frame& F, int l) {
    refresh(F);
    const WS W = ws_map(F.ws, F.nb); const float* const* IN_ = F.a->in; (void)IN_; (void)W;
    LAS int* seg = (LAS int*)F.lds; LAS int* cnt = seg + 40;
    const unsigned* gcnt = W.ctl + CW_CNT + l * 64;
    if (F.tid == 0) { int o = 0; for (int e = 0; e < 32; ++e) { const int c = (int)__hip_atomic_load(gcnt + e, __ATOMIC_RELAXED, __HIP_MEMORY_SCOPE_AGENT); seg[e] = o; cnt[e] = c; o += (c + 255) & ~255; } seg[32] = o; }
    __syncthreads();
    const int ntile = seg[32] >> 8;
    if (F.bid == 0) {
        for (int i = F.tid; i < ntile; i += NTHR) { int e = 0; while (e < 31 && (i << 8) >= seg[e + 1]) ++e; W.tilee[i] = e; }
        if (F.tid == 0) W.segp[0] = ntile;
    }
    for (int p = F.bid * NTHR + F.tid; p < (ntile << 8); p += F.G * NTHR) { int e = 0; while (e < 31 && p >= seg[e + 1]) ++e; if (p - seg[e] >= cnt[e]) W.stok[p] = 0; }
    for (int it = F.bid * NTHR + F.tid; it < F.T * 2; it += F.G * NTHR) {
        const int e = W.eid[it], p = seg[e] + W.rank[it];
        W.stok[p] = it >> 1; W.pos[it] = p; W.gsort[p] = W.gate[it];
    }
}

#ifndef MK_MASK
#define MK_MASK 0xffffffffu
#endif
#define EN(b) (((MK_MASK) >> (b)) & 1u)
#ifndef MK_ALIGN
#define MK_ALIGN true
#endif
#ifndef MK_SP2
#define MK_SP2 true
#endif
#ifndef MK_DUP
#define MK_DUP 0u
#endif
#define REPS(b) ((((MK_DUP) >> (b)) & 1u) ? 2 : 1)
constexpr int NPL = 14, NPH = 2 + DEPTH * NPL;
#ifdef MK_UB
__device__ __forceinline__ void ub_bench(Frame& F) {
    {
        typedef int ub8i __attribute__((ext_vector_type(8))); typedef int ub4i __attribute__((ext_vector_type(4)));
        ub8i ua, ubb; for (int i = 0; i < 8; ++i) { ua[i] = 0x38383838 + F.lane; ubb[i] = 0x30303030 + F.lane * 3; }
        f32x16 acc0 = {}, acc1 = {}, acc2 = {}, acc3 = {};
        float e0 = F.lane * 0.01f, e1 = e0 + 1, e2 = e0 + 2, e3 = e0 + 3, e4 = e0 + 4, e5 = e0 + 5, e6 = e0 + 6, e7 = e0 + 7;
        ub4i ld0 = {}, ld1 = {}; const unsigned la = (unsigned)(unsigned long)F.lds + F.tid * 16;
#define UB_M(acc) do { if constexpr (MK_UB & 1) acc = __builtin_amdgcn_mfma_scale_f32_32x32x64_f8f6f4(ua, ubb, acc, 0, (MK_UB & 16) ? 1 : 0, 0, 0, 0, 0); } while (0)
#define UB_E() do { if constexpr (MK_UB & 2) { e0 = __builtin_amdgcn_exp2f(e0); e1 = __builtin_amdgcn_exp2f(e1); e2 = __builtin_amdgcn_exp2f(e2); e3 = __builtin_amdgcn_exp2f(e3); \
                                              e4 = __builtin_amdgcn_exp2f(e4); e5 = __builtin_amdgcn_exp2f(e5); e6 = __builtin_amdgcn_exp2f(e6); e7 = __builtin_amdgcn_exp2f(e7); } } while (0)
#define UB_L() do { if constexpr (MK_UB & 4) { asm volatile("ds_read_b128 %0, %1" : "=&v"(ld0) : "v"(la) : "memory"); asm volatile("ds_read_b128 %0, %1 offset:8192" : "=&v"(ld1) : "v"(la) : "memory"); } } while (0)
        float g0 = e0, g1 = e1, g2 = e2, g3 = e3, g4 = e4, g5 = e5, g6 = e6, g7 = e7;
#define UB_F() do { if constexpr (MK_UB & 64) { g0 = fmaf(g0, 1.0001f, 0.5f); g1 = fmaf(g1, 1.0001f, 0.5f); g2 = fmaf(g2, 1.0001f, 0.5f); g3 = fmaf(g3, 1.0001f, 0.5f); \
                                                g4 = fmaf(g4, 1.0001f, 0.5f); g5 = fmaf(g5, 1.0001f, 0.5f); g6 = fmaf(g6, 1.0001f, 0.5f); g7 = fmaf(g7, 1.0001f, 0.5f); } } while (0)
        if (!(MK_UB & 32) || F.wave < 4)
        for (int it = 0; it < 2000; ++it) {
            UB_M(acc0); __builtin_amdgcn_sched_barrier(0); UB_E(); UB_F(); UB_L(); __builtin_amdgcn_sched_barrier(0);
            UB_M(acc1); __builtin_amdgcn_sched_barrier(0); UB_E(); UB_F(); UB_L(); __builtin_amdgcn_sched_barrier(0);
            UB_M(acc2); __builtin_amdgcn_sched_barrier(0); UB_E(); UB_F(); UB_L(); __builtin_amdgcn_sched_barrier(0);
            UB_M(acc3); __builtin_amdgcn_sched_barrier(0); UB_E(); UB_F(); UB_L(); __builtin_amdgcn_sched_barrier(0);
            if constexpr (MK_UB & 4) asm volatile("s_waitcnt lgkmcnt(0)" ::: "memory");
        }
        const float sink = g0 + g1 + g2 + g3 + g4 + g5 + g6 + g7 + acc0[0] + acc1[1] + acc2[2] + acc3[3] + e0 + e1 + e2 + e3 + e4 + e5 + e6 + e7 + (float)(ld0[0] + ld1[1]);
        if (sink == 12345.678f) ((unsigned*)F.ws)[CW_CNT + 77] = 1u;
        __syncthreads();
    }
}
#endif
__global__ void __launch_bounds__(NTHR, 2) mk_fwd(Args args) {
    extern __shared__ __attribute__((aligned(16))) unsigned char lds_raw[];
    Frame F;
    F.lds = (LAS unsigned char*)lds_raw; F.tid = threadIdx.x; F.lane = F.tid & 63; F.wave = __builtin_amdgcn_readfirstlane(F.tid >> 6);
    F.G = gridDim.x; F.bid = blockIdx.x; F.nb = args.nb; F.T = args.nb * SEQ; F.ws = args.ws; F.a = &args; F.xbuf = args.out;
    const float* const* IN_ = args.in;
    volatile LAS unsigned* misc = (volatile LAS unsigned*)(F.lds + LDS_MISC);
    if (F.tid < 64) misc[F.tid] = 0u;
    __syncthreads();
    XcdBarrier bar = xcd_barrier_post((unsigned*)args.ws + CW_BAR + args.li * XCD_BAR_WORDS, misc);
    const int lo = args.ph_lo, hi = args.ph_hi;
#define IN(k) (lo <= (k) && (k) < hi)
#ifdef MK_BAR2
#define SEAM(k) do { if (IN(k) && IN((k) + 1)) { xcd_barrier(bar); xcd_barrier(bar); } } while (0)
#else
#define SEAM(k) do { if (IN(k) && IN((k) + 1)) xcd_barrier(bar); } while (0)
#endif
#if defined(MK_UB) && !defined(MK_UB_MID)
    ub_bench(F);
#endif
    LAS unsigned char* gl = F.lds;
    if (EN(0) && IN(0)) { for (int rp = 0; rp < REPS(0); ++rp) { p0_prologue(F); __syncthreads(); } SEAM(0); }
    for (int l = 0; l < DEPTH; ++l) {
        const int pb = 1 + l * NPL;
#if defined(MK_UB) && defined(MK_UB_MID)
        if (l == 1) { ub_bench(F); refresh(F); }
#endif
        if (EN(1) && IN(pb + 0)) { for (int rp = 0; rp < ((l == 0) ? REPS(14) : 1); ++rp) phase_norm(F, l, 0); SEAM(pb + 0); }
        if (EN(2) && IN(pb + 1)) { const WS W = ws_map(F.ws, F.nb);
            pg8::Gemm g{W.H, W.win + (size_t)l * NIN * D, F.T, NIN, D}; pg8::StaticOrder S; S.init(F.T, NIN, F.G, F.bid);
            EpiIn E{W.GQ, W.GK, W.GV, W.SG, W.LGF, W.LGB, W.DQ, W.DK, W.DV, W.SGA, W.SGB, IN_[8] + l * 512, IN_[10] + l * 64, IN_[11] + l * 64, 0};
#ifdef MK_DEPHASE
            { const int g_ = (F.bid >> 3) & 7; for (int k_ = 0; k_ < g_ * MK_DEPHASE; ++k_) __builtin_amdgcn_s_sleep(127); }
#endif
#ifdef MK_INPROJ_PLAIN
            { EpiIn EP_ = E; EP_.plain = 1; pg8::gemm_phase<EpiIn, pg8::StaticOrder, MK_ALIGN, MK_SP2>(gl, g, S, EP_); }
#endif
#ifdef MK_INPROJ_NULL
            { EpiNull EN_; pg8::gemm_phase<EpiNull, pg8::StaticOrder, MK_ALIGN, MK_SP2>(gl, g, S, EN_); }
#endif
            for (int rp = 0; rp < REPS(2); ++rp) pg8::gemm_phase<EpiIn, pg8::StaticOrder, MK_ALIGN, MK_SP2>(gl, g, S, E);
            SEAM(pb + 1);
        }
        if (EN(3) && IN(pb + 2)) { for (int rp = 0; rp < REPS(3); ++rp) phase_gla1(F); SEAM(pb + 2); }
        if (EN(4) && IN(pb + 3)) { phase_gla2(F); SEAM(pb + 3); }
        if (EN(5) && IN(pb + 4)) { for (int rp = 0; rp < REPS(5); ++rp) phase_gla3(F, l); __syncthreads(); }
        if (EN(6) && IN(pb + 5)) {
#ifdef MK_ATT_PROBE
            phase_attn<MK_ATT_PROBE>(F, l);
#endif
#ifdef MK_CLK
            unsigned long long ct0 = 0, cr0 = 0; if (l == 1) { ct0 = __builtin_readcyclecounter(); cr0 = __builtin_amdgcn_s_memrealtime(); }
#endif
            phase_attn<0>(F, l);
#ifdef MK_CLK
            if (l == 1 && F.bid == 0 && F.tid == 0) {
                const unsigned long long ct1 = __builtin_readcyclecounter(), cr1 = __builtin_amdgcn_s_memrealtime();
                const unsigned long long ticks = (ct1 - ct0) * (unsigned long long)(MK_CLK) / (cr1 - cr0 + 1);
                while (__builtin_amdgcn_s_memrealtime() - cr1 < ticks) __builtin_amdgcn_s_sleep(8);
            }
            __syncthreads();
#endif
            SEAM(pb + 5); }
        if (EN(7) && IN(pb + 6)) { const WS W = ws_map(F.ws, F.nb);
            pg8::Gemm g{W.OAB, W.wab + (size_t)l * D * D, 0, 0, 512}; MergeOrder S; S.so.init(F.T, D, F.G, F.bid); S.nM = F.T / 256;
            EpiMerge E{W.SGA, W.SGB, W.MERGED, F.T / 256};
            for (int rp = 0; rp < REPS(7); ++rp) pg8::gemm_phase<EpiMerge, MergeOrder, MK_ALIGN, MK_SP2>(gl, g, S, E);
            SEAM(pb + 6);
        }
        if (EN(8) && IN(pb + 7)) { const WS W = ws_map(F.ws, F.nb); const float* modl = W.mod + (size_t)l * NBMAX * 6 * D;
            pg8::Gemm g{W.MERGED, W.wo + (size_t)l * D * D, F.T, D, D}; pg8::StaticOrder S; S.init(F.T, D, F.G, F.bid);
            EpiResid E{l == 0 ? IN_[0] : nullptr, W.XB, modl + 2 * D};
            for (int rp = 0; rp < ((l == 0) ? REPS(8) : 1); ++rp) pg8::gemm_phase<EpiResid, pg8::StaticOrder, MK_ALIGN, MK_SP2>(gl, g, S, E);
            SEAM(pb + 7);
        }
        if (EN(1) && IN(pb + 8)) { for (int rp = 0; rp < REPS(1); ++rp) phase_norm(F, l, 1); SEAM(pb + 8); }
        if (EN(9) && IN(pb + 9)) { const WS W = ws_map(F.ws, F.nb);
            pg8::Gemm g{W.H, W.wr + (size_t)l * 256 * D, F.T, 256, D}; pg8::StaticOrder S; S.init(F.T, 256, F.G, F.bid);
            EpiLogits E{W.LOGITS};
            for (int rp = 0; rp < REPS(9); ++rp) pg8::gemm_phase<EpiLogits, pg8::StaticOrder, MK_ALIGN, MK_SP2>(gl, g, S, E);
            SEAM(pb + 9);
        }
        if (EN(10) && IN(pb + 10)) { phase_select(F, l); SEAM(pb + 10); }
        if (EN(11) && IN(pb + 11)) { for (int rp = 0; rp < REPS(11); ++rp) { phase_gather(F, l); __syncthreads(); } SEAM(pb + 11); }
        if (EN(12) && IN(pb + 12)) { const WS W = ws_map(F.ws, F.nb);
            const int ntile = W.segp[0];
#if MK_MOE_FP8
            pg8::Gemm g{W.XS, (const bf16*)((const unsigned char*)W.w1 + (size_t)l * NE * 1024 * D), 0, 0, D / 2}; GroupedOrder S{W.tilee, ntile * 4, F.G, F.bid};
            EpiAct E{(unsigned char*)W.ACT};
#else
            pg8::Gemm g{W.H, W.w1 + (size_t)l * NE * 1024 * D, 0, 0, D}; GroupedOrder S{W.tilee, ntile * 4, F.G, F.bid, W.stok};
            EpiAct E{W.ACT};
#endif
            for (int rp = 0; rp < REPS(12); ++rp) pg8::gemm_phase<EpiAct, GroupedOrder, MK_ALIGN, MK_SP2, true>(gl, g, S, E);
            SEAM(pb + 12);
        }
        if (EN(13) && IN(pb + 13)) { const WS W = ws_map(F.ws, F.nb);
            const int ntile = W.segp[0];
#if MK_MOE_FP8
            pg8::Gemm g{W.ACT, (const bf16*)((const unsigned char*)W.w2 + (size_t)l * NE * D * DE), 0, 0, DE / 2}; GroupedOrder S{W.tilee, ntile * 4, F.G, F.bid};
#else
            pg8::Gemm g{W.ACT, W.w2 + (size_t)l * NE * D * DE, 0, 0, DE}; GroupedOrder S{W.tilee, ntile * 4, F.G, F.bid, nullptr};
#endif
            EpiYs E{(unsigned char*)W.YS, W.gsort};
            for (int rp = 0; rp < REPS(13); ++rp) pg8::gemm_phase<EpiYs, GroupedOrder, MK_ALIGN, MK_SP2>(gl, g, S, E);
            SEAM(pb + 13);
        }
    }
    if (EN(1) && IN(NPH - 1)) phase_norm(F, 0, 2);
#undef IN
#undef SEAM
}

struct LaunchCfg { int grid; bool ok; };
inline LaunchCfg& launch_cfg() {
    static LaunchCfg c{0, false}; static bool init = false;
    if (!init) { init = true;
        int dev = 0, cus = 0, per_cu = 0;
        if (hipGetDevice(&dev) != hipSuccess || hipDeviceGetAttribute(&cus, hipDeviceAttributeMultiprocessorCount, dev) != hipSuccess) { fprintf(stderr, "mk: device query failed\n"); return c; }
        if (hipFuncSetAttribute((const void*)mk_fwd, hipFuncAttributeMaxDynamicSharedMemorySize, LDS_BYTES) != hipSuccess) { fprintf(stderr, "mk: hipFuncSetAttribute failed\n"); return c; }
        if (hipOccupancyMaxActiveBlocksPerMultiprocessor(&per_cu, (const void*)mk_fwd, NTHR, LDS_BYTES) != hipSuccess || per_cu < 1) { fprintf(stderr, "mk: occupancy query says %d blocks/CU\n", per_cu); (void)hipGetLastError(); return c; }
        c.grid = cus; c.ok = true;
    }
    return c;
}
inline void launch_range(void* const* d_in, float* xbuf, void* d_ws, int nb, int lo, int hi, int li, hipStream_t stream) {
    LaunchCfg& c = launch_cfg(); if (!c.ok) return;
    Args a{}; for (int i = 0; i < 24; ++i) a.in[i] = (const float*)d_in[i];
    a.out = xbuf; a.ws = (unsigned char*)d_ws; a.nb = nb; a.ph_lo = lo; a.ph_hi = hi; a.li = li;
    hipLaunchKernelGGL(mk_fwd, dim3(c.grid), dim3(NTHR), LDS_BYTES, stream, a);
    const hipError_t le = hipPeekAtLastError(); if (le != hipSuccess) fprintf(stderr, "mk: launch [%d,%d) failed: %s\n", lo, hi, hipGetErrorName(le));
}
}
extern "C" void kernel_launch(void* const* d_in, const int* in_sizes, int n_in, void* d_out, int out_size, void* d_ws, size_t ws_size, hipStream_t stream) {
    (void)in_sizes; (void)n_in; (void)out_size;
    static int checked = 0;
    if (!checked) { checked = 1; const mk::WS w = mk::ws_map((unsigned char*)d_ws, 4); if (w.end > ws_size) { fprintf(stderr, "mk: workspace too small: need %zu, have %zu\n", w.end, ws_size); checked = -1; } }
    if (checked < 0) return;
    if (hipMemsetAsync(d_ws, 0, mk::CTL_BYTES, stream) != hipSuccess) return;
    mk::launch_range(d_in, (float*)d_out, d_ws, 4, 0, mk::NPH, 0, stream);
}
```

```cpp
#include <hip/hip_runtime.h>
#include <cstdio>
#include <cstdint>
#include <cmath>
#define MK_ATT_FP8 1
namespace pg8 {
#define PG8_LAS __attribute__((address_space(3)))
typedef unsigned short bf16_t;
typedef short bf16x8 __attribute__((ext_vector_type(8)));
typedef float f32x4 __attribute__((ext_vector_type(4)));
typedef unsigned u32x4 __attribute__((ext_vector_type(4)));
constexpr int BM = 256, BK = 64, HALF = 128, HTB = HALF * BK * 2  , STAGE_BYTES = 8 * HTB, NXCD = 8, WGM = 8;

__host__ __device__ __forceinline__ int lds_byte(int r, int c) { const int st = (r >> 4) * 2 + (c >> 5), rr = r & 15, cc = c & 31, ob = rr * 64 + cc * 2; return st * 1024 + (ob ^ (((ob >> 9) & 1) << 5)); }
__host__ __device__ __forceinline__ void stage_rc(int b, int& R, int& C) { const int st = b / 1024, sb = b % 1024, swz = sb ^ (((sb >> 9) & 1) << 5); R = (st >> 1) * 16 + swz / 64; C = (st & 1) * 32 + (swz % 64) / 2; }
__host__ __device__ __forceinline__ int perm32(int rho) { const int n = rho >> 4, i = rho & 15; return 8 * (i >> 2) + 4 * n + (i & 3); }

struct Unit { int pm, pn; };
struct Gemm { const bf16_t* A; const bf16_t* Bt; int M, N, K; };

struct StaticOrder {
    int nM, nN, nwg, G, c;
    __host__ __device__ void init(int M, int N, int G_, int c_) { nM = M / BM; nN = N / BM; nwg = nM * nN; G = G_; c = c_; }
    __host__ __device__ bool next(int i, Unit& u) const {
        const long L = (long)i * G + c; if (L >= nwg) return false;
        int wgid = (int)L; { const int q = nwg / NXCD, r = nwg % NXCD, xcd = wgid % NXCD, off = wgid / NXCD; wgid = (xcd < r ? xcd * (q + 1) : r * (q + 1) + (xcd - r) * q) + off; }
        const int nig = WGM * nN, gid = wgid / nig, fm = gid * WGM, gsz = (nM - fm) < WGM ? (nM - fm) : WGM;
        u.pm = fm + ((wgid % nig) % gsz); u.pn = (wgid % nig) / gsz; return true;
    }
    __device__ __forceinline__ void a_ready(const Unit&) const {}
    __device__ __forceinline__ void done(const Unit&) const {}
};
__device__ __forceinline__ unsigned cvt_pk_bf16(float lo, float hi) { unsigned r; asm volatile("v_cvt_pk_bf16_f32 %0, %1, %2" : "=v"(r) : "v"(lo), "v"(hi)); return r; }
__device__ __forceinline__ const void* pg8_uniform(const void* p) { const unsigned long long v = (unsigned long long)p;
    const unsigned lo = (unsigned)__builtin_amdgcn_readfirstlane((int)(unsigned)v), hi = (unsigned)__builtin_amdgcn_readfirstlane((int)(unsigned)(v >> 32)); return (const void*)(((unsigned long long)hi << 32) | lo); }
__device__ __forceinline__ void pg8_glds(const void* sbase, unsigned voff, unsigned ldsdst) { unsigned keep;
    asm volatile("s_nop 4\n\ts_mov_b32 %0, m0\n\ts_mov_b32 m0, %3\n\ts_nop 0\n\tglobal_load_lds_dwordx4 %1, %2\n\ts_mov_b32 m0, %0" : "=&s"(keep) : "v"(voff), "s"(sbase), "s"(ldsdst) : "memory"); }
typedef int pg8_v8i __attribute__((ext_vector_type(8)));
typedef int pg8_v4i __attribute__((ext_vector_type(4)));
template <class Epi, class Sched, bool ALIGN_EPI = false, bool SP2 = false, bool GATHER = false>
__device__ __forceinline__ void gemm_phase(PG8_LAS unsigned char* lds, const Gemm g, const Sched& S, const Epi& E) {
    int tid_ = threadIdx.x; asm volatile("" : "+v"(tid_));
    const int tid = tid_, wid = __builtin_amdgcn_readfirstlane(tid >> 6), lane = tid & 63, wr = wid >> 2, wc = wid & 3, fr = lane & 15, fq = lane >> 4;
    const int K = g.K, nt = K / BK;
    unsigned voffA[2], voffB[2]; unsigned vc[2][2] = {}, vn[2][2] = {}, vs[2][2] = {}; (void)vc; (void)vn; (void)vs;
#pragma unroll
    for (int i = 0; i < 2; ++i) { int R, C; stage_rc(tid * 16 + i * 8192, R, C); const int Rb = Epi::PERM ? ((R & ~31) + perm32(R & 31)) : R;
        voffA[i] = (unsigned)(R * K + C) * 2u; voffB[i] = (unsigned)(Rb * K + C) * 2u; }
    const size_t kstep = (size_t)(BK * 2);
    const size_t hstep = (size_t)HALF * K * 2;
    const size_t tstep = 2 * hstep;
    const unsigned ldsw = (unsigned)wid * 1024u; const unsigned lds0 = (unsigned)(unsigned long)lds; (void)lds0;
    const int aoff = lds_byte(wr * 64 + fr, fq * 8), boff = lds_byte(wc * 32 + fr, fq * 8);
#define PG8_SA(b, h) (((b) * 2 + (h)) * HTB)
#define PG8_SB(b, h) ((4 + (b) * 2 + (h)) * HTB)
#if defined(PG8_ASM_STAGE) && PG8_ASM_STAGE
#define PG8_STAGE(bufoff, gbase, voff) do { const void* _gb = pg8_uniform(gbase); _Pragma("unroll") for (int _i = 0; _i < 2; ++_i) \
        pg8_glds(_gb, (voff)[_i], (unsigned)__builtin_amdgcn_readfirstlane((int)(lds0 + (unsigned)(bufoff) + ldsw + _i * 8192))); } while (0)
#else
#define PG8_STAGE(bufoff, gbase, voff) do { _Pragma("unroll") for (int _i = 0; _i < 2; ++_i) \
        __builtin_amdgcn_global_load_lds((const unsigned*)((const char*)(gbase) + (voff)[_i]), (PG8_LAS unsigned*)(lds + (bufoff) + ldsw + _i * 8192), 16, 0, 0); } while (0)
#endif
#define PG8_STAGE_A(b, h, X, VS) do { if constexpr (GATHER) { PG8_STAGE(PG8_SA(b, h), X, VS[h]); } else { PG8_STAGE(PG8_SA(b, h), (X) + (h) * hstep, voffA); } } while (0)
#define PG8_LOADROWS(u, v) do { _Pragma("unroll") for (int i_ = 0; i_ < 2; ++i_) { int R_, C_; stage_rc(tid * 16 + i_ * 8192, R_, C_); _Pragma("unroll") for (int h_ = 0; h_ < 2; ++h_) \
        v[h_][i_] = (unsigned)S.rowidx[(u).pm * 256 + h_ * 128 + R_] * (unsigned)(K * 2) + (unsigned)C_ * 2u; } } while (0)
#define PG8_LDA(dst, b, h) do { _Pragma("unroll") for (int m = 0; m < 4; ++m) _Pragma("unroll") for (int k = 0; k < 2; ++k) dst[m][k] = *(const PG8_LAS bf16x8*)(lds + PG8_SA(b, h) + aoff + m * 2048 + k * 1024); } while (0)
#define PG8_LDB(dst, b, h) do { _Pragma("unroll") for (int n = 0; n < 2; ++n) _Pragma("unroll") for (int k = 0; k < 2; ++k) dst[n][k] = *(const PG8_LAS bf16x8*)(lds + PG8_SB(b, h) + boff + n * 2048 + k * 1024); } while (0)
#define PG8_MMA(ai, bj, At, Bt) do { __builtin_amdgcn_s_setprio(1); _Pragma("unroll") for (int m = 0; m < 4; ++m) _Pragma("unroll") for (int n = 0; n < 2; ++n) _Pragma("unroll") for (int k = 0; k < 2; ++k) \
        acc[ai][bj][m][n] = __builtin_amdgcn_mfma_f32_16x16x32_bf16(Bt[n][k], At[m][k], acc[ai][bj][m][n], 0, 0, 0); __builtin_amdgcn_s_setprio(0); } while (0)
#define PG8_WAIT_V(n) asm volatile("s_waitcnt vmcnt(" #n ")" ::: "memory")
#define PG8_WAIT_L(n) asm volatile("s_waitcnt lgkmcnt(" #n ")" ::: "memory")
#define PG8_BAR __builtin_amdgcn_s_barrier()
#define PG8_SCHED __builtin_amdgcn_sched_barrier(0)
    Unit cur, nxt; int ui = 0;
    if (!S.next(0, cur)) return;
    f32x4 acc[2][2][4][2];
#pragma unroll
    for (int a = 0; a < 2; ++a)
#pragma unroll
        for (int b = 0; b < 2; ++b)
#pragma unroll
            for (int m = 0; m < 4; ++m)
#pragma unroll
                for (int n = 0; n < 2; ++n) acc[a][b][m][n] = (f32x4){0.f, 0.f, 0.f, 0.f};
    bf16x8 At[4][2], B0[2][2], B1[2][2];
    const char* cA = (const char*)g.A + (GATHER ? (size_t)0 : (size_t)cur.pm * tstep); const char* cB = (const char*)g.Bt + (size_t)cur.pn * tstep;
    S.a_ready(cur);
    if constexpr (GATHER) { PG8_LOADROWS(cur, vc); }
    if constexpr (SP2) {
        PG8_STAGE(PG8_SB(0, 0), cB, voffB); PG8_STAGE(PG8_SB(0, 1), cB + hstep, voffB); PG8_STAGE_A(0, 0, cA, vc); PG8_STAGE_A(0, 1, cA, vc);
        if (wr == 1) PG8_BAR;
        PG8_WAIT_V(2); PG8_BAR;
        PG8_STAGE(PG8_SB(1, 0), cB + kstep, voffB); PG8_STAGE_A(1, 0, cA + kstep, vc); PG8_STAGE(PG8_SB(1, 1), cB + hstep + kstep, voffB);
        PG8_WAIT_V(6); PG8_BAR;
    } else {
        PG8_STAGE(PG8_SB(0, 0), cB, voffB); PG8_STAGE_A(0, 0, cA, vc); PG8_STAGE(PG8_SB(0, 1), cB + hstep, voffB); PG8_STAGE_A(0, 1, cA, vc);
        if (wr == 1) PG8_BAR;
        PG8_WAIT_V(4); PG8_BAR;
        PG8_STAGE(PG8_SB(1, 0), cB + kstep, voffB); PG8_STAGE_A(1, 0, cA + kstep, vc); PG8_STAGE(PG8_SB(1, 1), cB + hstep + kstep, voffB);
        PG8_WAIT_V(6); PG8_BAR;
    }
    for (;;) {
        const bool has_next = S.next(ui + 1, nxt);
        const char* nA = (has_next && !GATHER) ? (const char*)g.A + (size_t)nxt.pm * tstep : cA; const char* nB = has_next ? (const char*)g.Bt + (size_t)nxt.pn * tstep : cB;
        for (int t = 0; t < nt; t += 2) {
            const bool last = (t == nt - 2);
            const char* a1 = cA + (size_t)(t + 1) * kstep;
            const char* a2 = last ? nA : cA + (size_t)(t + 2) * kstep; const char* b2 = last ? nB : cB + (size_t)(t + 2) * kstep;
            const char* a3 = a2 + kstep; const char* b3 = b2 + kstep;
            if (last && has_next) S.a_ready(nxt);
            if constexpr (GATHER) { if (last && has_next) { PG8_LOADROWS(nxt, vn); }
                _Pragma("unroll") for (int h_ = 0; h_ < 2; ++h_) _Pragma("unroll") for (int i_ = 0; i_ < 2; ++i_) vs[h_][i_] = (last && has_next) ? vn[h_][i_] : vc[h_][i_]; }
            if constexpr (Epi::MIDK) { if (t == nt / 2) E.mid(acc, cur, wr, wc, fr, fq); }
            if constexpr (SP2) {
            PG8_LDB(B0, 0, 0); PG8_LDB(B1, 0, 1); PG8_SCHED; PG8_LDA(At, 0, 0); PG8_STAGE_A(1, 1, a1, vc);
            PG8_WAIT_V(8); PG8_WAIT_L(0); PG8_BAR; PG8_MMA(0, 0, At, B0); PG8_MMA(0, 1, At, B1); PG8_BAR; PG8_SCHED;
            PG8_LDA(At, 0, 1); PG8_STAGE(PG8_SB(0, 0), b2, voffB); PG8_STAGE(PG8_SB(0, 1), b2 + hstep, voffB); PG8_STAGE_A(0, 0, a2, vs);
            PG8_WAIT_V(8); PG8_WAIT_L(0); PG8_BAR; PG8_MMA(1, 0, At, B0); PG8_MMA(1, 1, At, B1); PG8_BAR; PG8_SCHED;
            PG8_LDB(B0, 1, 0); PG8_LDB(B1, 1, 1); PG8_SCHED; PG8_LDA(At, 1, 0); PG8_STAGE_A(0, 1, a2, vs);
            PG8_WAIT_V(8); PG8_WAIT_L(0); PG8_BAR; PG8_MMA(0, 0, At, B0); PG8_MMA(0, 1, At, B1); PG8_BAR; PG8_SCHED;
            PG8_LDA(At, 1, 1); PG8_STAGE(PG8_SB(1, 0), b3, voffB); PG8_STAGE(PG8_SB(1, 1), b3 + hstep, voffB); PG8_STAGE_A(1, 0, a3, vs);
            PG8_WAIT_V(8); PG8_WAIT_L(0); PG8_BAR; PG8_MMA(1, 0, At, B0); PG8_MMA(1, 1, At, B1); PG8_BAR; PG8_SCHED;
            } else {
            PG8_LDB(B0, 0, 0); PG8_SCHED; PG8_LDA(At, 0, 0); PG8_STAGE_A(1, 1, a1, vc);
            PG8_WAIT_L(8); PG8_BAR; PG8_WAIT_L(0); PG8_MMA(0, 0, At, B0); PG8_BAR; PG8_SCHED;
            PG8_LDB(B1, 0, 1); PG8_STAGE(PG8_SB(0, 0), b2, voffB);
            PG8_BAR; PG8_WAIT_L(0); PG8_MMA(0, 1, At, B1); PG8_BAR;
            PG8_LDA(At, 0, 1); PG8_STAGE_A(0, 0, a2, vs);
            PG8_BAR; PG8_WAIT_L(0); PG8_MMA(1, 0, At, B0); PG8_BAR; PG8_SCHED;
            PG8_STAGE(PG8_SB(0, 1), b2 + hstep, voffB);
            PG8_WAIT_V(6); PG8_BAR; PG8_MMA(1, 1, At, B1); PG8_BAR;
            PG8_LDB(B0, 1, 0); PG8_SCHED; PG8_LDA(At, 1, 0); PG8_STAGE_A(0, 1, a2, vs);
            PG8_WAIT_L(8); PG8_BAR; PG8_WAIT_L(0); PG8_MMA(0, 0, At, B0); PG8_BAR; PG8_SCHED;
            PG8_LDB(B1, 1, 1); PG8_STAGE(PG8_SB(1, 0), b3, voffB);
            PG8_BAR; PG8_WAIT_L(0); PG8_MMA(0, 1, At, B1); PG8_BAR;
            PG8_LDA(At, 1, 1); PG8_STAGE_A(1, 0, a3, vs);
            PG8_BAR; PG8_WAIT_L(0); PG8_MMA(1, 0, At, B0); PG8_BAR; PG8_SCHED;
            PG8_STAGE(PG8_SB(1, 1), b3 + hstep, voffB);
            PG8_WAIT_V(6); PG8_BAR; PG8_MMA(1, 1, At, B1); PG8_BAR;
            }
        }
        if constexpr (ALIGN_EPI) { if (wr == 0) PG8_BAR; }
        if constexpr (!Epi::AFTER_DRAIN) { E(acc, cur, wr, wc, fr, fq); S.done(cur); }
        if (!has_next) break;
#pragma unroll
        for (int a = 0; a < 2; ++a)
#pragma unroll
            for (int b = 0; b < 2; ++b)
#pragma unroll
                for (int m = 0; m < 4; ++m)
#pragma unroll
                    for (int n = 0; n < 2; ++n) acc[a][b][m][n] = (f32x4){0.f, 0.f, 0.f, 0.f};
        cur = nxt; cA = nA; cB = nB; ++ui;
        if constexpr (GATHER) { _Pragma("unroll") for (int h_ = 0; h_ < 2; ++h_) _Pragma("unroll") for (int i_ = 0; i_ < 2; ++i_) vc[h_][i_] = vn[h_][i_]; }
        if constexpr (ALIGN_EPI) { if (wr == 1) PG8_BAR; }
    }
    PG8_WAIT_V(0);
    if constexpr (!ALIGN_EPI) { if (wr == 0) PG8_BAR; }
    PG8_BAR;
    if constexpr (Epi::AFTER_DRAIN) { E.fused(acc, cur, wr, wc, fr, fq, lds, wid, lane); S.done(cur); }
#undef PG8_SA
#undef PG8_SB
#undef PG8_STAGE
#undef PG8_STAGE_A
#undef PG8_LOADROWS
#undef PG8_LDA
#undef PG8_LDB
#undef PG8_MMA
#undef PG8_WAIT_V
#undef PG8_WAIT_L
#undef PG8_BAR
#undef PG8_SCHED
}
}
namespace mk {
constexpr int D = 1024, SEQ = 8192, NBMAX = 4, NH = 4, DIN = 5152, NE = 32, DE = 512, DEPTH = 2;
constexpr int NT_IN = 22, NIN = NT_IN * 256;
constexpr int NWAVES = 8, NTHR = 512;
#ifndef MK_MOE_FP8
#define MK_MOE_FP8 0
#endif
constexpr float WSCALE = 16.f, ASCALE = 4.f, YSCALE = 32.f;
constexpr float LOG2E = 1.4426950408889634f, QSCALE = 0.125f * LOG2E, RMS_EPS = 1e-6f;
constexpr int O_GQ = 0, O_GK = 256, O_GV = 512, O_GG = 1024, O_LRF = 1536, O_LRB = 1552, O_DQ = 1568, O_DK = 2080, O_DV = 2592, O_GA = 3104, O_GB = 4128;
typedef unsigned short bf16;
typedef unsigned u32x4 __attribute__((ext_vector_type(4)));
typedef unsigned u32x2 __attribute__((ext_vector_type(2)));
typedef float f32x4 __attribute__((ext_vector_type(4)));
typedef float f32x16 __attribute__((ext_vector_type(16)));
typedef short bf16x8 __attribute__((ext_vector_type(8)));
typedef short s16x4 __attribute__((ext_vector_type(4)));
#define LAS __attribute__((address_space(3)))
#define GAS __attribute__((address_space(1)))
#define LDS_WAIT() asm volatile("s_waitcnt lgkmcnt(0)" ::: "memory")
#define VM_WAIT() asm volatile("s_waitcnt vmcnt(0)" ::: "memory")

constexpr size_t MiB = 1u << 20;
constexpr size_t CTL_BYTES = 256 * 1024;
constexpr int CW_BAR = 4096;
constexpr int CW_CNT = 32768;
constexpr size_t OFF_MOD = 256 * 1024, OFF_TAB = 512 * 1024;
constexpr size_t OFF_WIN = 1 * MiB, SZ_WIN = (size_t)DEPTH * NIN * D * 2;
constexpr size_t OFF_WAB = OFF_WIN + SZ_WIN, SZ_WAB = (size_t)DEPTH * D * D * 2;
constexpr size_t OFF_WO = OFF_WAB + SZ_WAB, SZ_WO = SZ_WAB;
constexpr size_t OFF_WR = OFF_WO + SZ_WO, SZ_WR = (size_t)DEPTH * 256 * D * 2;
constexpr size_t OFF_W1 = OFF_WR + SZ_WR, SZ_W1 = (size_t)DEPTH * NE * 1024 * D * 2;
constexpr size_t OFF_W2 = OFF_W1 + SZ_W1, SZ_W2 = (size_t)DEPTH * NE * D * DE * 2;
constexpr size_t OFF_ACT = 225 * MiB;
static_assert(OFF_W2 + SZ_W2 <= OFF_ACT, "weights fit");
struct WS {
    unsigned* ctl; float* mod; float* tab;
    bf16 *win, *wab, *wo, *wr, *w1, *w2;
    bf16 *H, *OAB, *XB; int* eid; float* gate; int* rank; int* pos; int* tilee; int* segp;
    bf16 *GQ, *GK, *GV, *SG; bf16 *LGF, *LGB; bf16 *DQ, *DK, *DV, *SGA, *SGB; float* KVT; float* DEC; bf16* MERGED;
    bf16 *XS, *ACT, *YS; float* LOGITS; float* gsort; int* stok;
    size_t end;
};
__host__ __device__ inline WS ws_map(unsigned char* b, int nb) {
    WS w; const size_t T = (size_t)nb * SEQ;
    w.ctl = (unsigned*)b; w.mod = (float*)(b + OFF_MOD); w.tab = (float*)(b + OFF_TAB);
    w.win = (bf16*)(b + OFF_WIN); w.wab = (bf16*)(b + OFF_WAB); w.wo = (bf16*)(b + OFF_WO); w.wr = (bf16*)(b + OFF_WR); w.w1 = (bf16*)(b + OFF_W1); w.w2 = (bf16*)(b + OFF_W2);
    size_t o = OFF_ACT;
    auto take = [&](size_t bytes) { unsigned char* p = b + o; o += (bytes + 255) & ~(size_t)255; return p; };
    w.H = (bf16*)take(T * 2048); w.OAB = (bf16*)take(T * 2048); w.XB = (bf16*)take(T * 2048);
    w.eid = (int*)take(T * 8); w.gate = (float*)take(T * 8); w.rank = (int*)take(T * 8); w.pos = (int*)take(T * 8); w.tilee = (int*)take(4096); w.segp = (int*)take(1024);
    const size_t u0 = o;
    w.GQ = (bf16*)take(T * 512); w.GK = (bf16*)take(T * 512); w.GV = (bf16*)take(T * 1024); w.SG = (bf16*)take(T * 1024);
    w.LGF = (bf16*)take(T * 512); w.LGB = (bf16*)take(T * 512);
    w.DQ = (bf16*)take(T * 1024); w.DK = (bf16*)take(T * 1024); w.DV = (bf16*)take(T * 1024); w.SGA = (bf16*)take(T * 2048); w.SGB = (bf16*)take(T * 2048);
    w.KVT = (float*)take(T * 4096); w.MERGED = (bf16*)w.KVT; w.DEC = (float*)take(T * 32);
    const size_t e1 = o; o = u0;
    const size_t R = 2 * T + 32 * 256;
    w.XS = (bf16*)take(R * 2048); w.ACT = (bf16*)take(R * 1024); w.YS = (bf16*)take(R * 2048); w.LOGITS = (float*)take(T * 256); w.gsort = (float*)take(R * 4); w.stok = (int*)take(R * 4);
    w.end = o > e1 ? o : e1;
    return w;
}

typedef float f32x2_t __attribute__((ext_vector_type(2))); typedef __bf16 bf16x2_t __attribute__((ext_vector_type(2)));
__device__ __forceinline__ unsigned cvt_pk(float lo, float hi) { const f32x2_t v = {lo, hi}; const bf16x2_t b = __builtin_convertvector(v, bf16x2_t); return __builtin_bit_cast(unsigned, b); }
__device__ __forceinline__ float bf2f(unsigned short b) { return __uint_as_float(((unsigned)b) << 16); }
__device__ __forceinline__ float bflo(unsigned w) { return __uint_as_float(w << 16); }
__device__ __forceinline__ float bfhi(unsigned w) { return __uint_as_float(w & 0xffff0000u); }
__device__ __forceinline__ float fsigmoid(float x) { return __builtin_amdgcn_rcpf(1.f + __expf(-x)); }
__device__ __forceinline__ float fsilu(float x) { return x * fsigmoid(x); }
__device__ __forceinline__ float fsigmoid255(float x) { return __builtin_amdgcn_rcpf(fmaf(__expf(-x), 1.f / 255.f, 1.f / 255.f)); }
__device__ __forceinline__ float wave_sum(float v) {
#pragma unroll
    for (int o = 1; o < 64; o <<= 1) v += __shfl_xor(v, o);
    return v;
}
__device__ __forceinline__ int t5_bucket(int rel) {
    int ret = rel > 0 ? 16 : 0; int n = rel < 0 ? -rel : rel;
    if (n < 8) return ret + n;
    return ret + 8 + (n >= 12) + (n >= 16) + (n >= 23) + (n >= 32) + (n >= 46) + (n >= 64) + (n >= 91);
}

#define XB_TMO      128
#define XB_XCNT(j)  (256  + 64 * (j))
#define XB_XSUB(j)  (1280 + 64 * (j))
#define XB_XGEN(j)  (2304 + 64 * (j))
#define XB_TOP      3328
#define XB_TOPGEN   3392
#define XCD_BAR_WORDS 3456
#define XB_SPIN_CAP (1u << 18)
__device__ __forceinline__ unsigned xb_ld(unsigned* p)              { return __hip_atomic_load(p, __ATOMIC_RELAXED, __HIP_MEMORY_SCOPE_AGENT); }
__device__ __forceinline__ unsigned xb_add(unsigned* p, unsigned v) { return __hip_atomic_fetch_add(p, v, __ATOMIC_RELAXED, __HIP_MEMORY_SCOPE_AGENT); }
__device__ __forceinline__ unsigned xb_xcc_id() { return (unsigned)__builtin_amdgcn_s_getreg((3 << 11) | 20) & 0xFu; }
#define XB_SPIN(cond, bar) do { unsigned _sp = 0; while (cond) { __builtin_amdgcn_s_sleep(1); \
    if ((++_sp & 255u) == 0u) { if (xb_ld(&(bar)[XB_TMO])) break; if (_sp > XB_SPIN_CAP) { atomicAdd(&(bar)[XB_TMO], 1u); break; } } } } while (0)
struct XcdBarrier { unsigned* bar; unsigned x; volatile LAS unsigned* st; };
__device__ __forceinline__ XcdBarrier xcd_barrier_post(unsigned* bar, volatile LAS unsigned* st) {
    XcdBarrier b; b.bar = bar; b.x = xb_xcc_id(); b.st = st;
    if (threadIdx.x == 0) (void)xb_add(&bar[XB_XCNT(b.x)], 1u);
    return b;
}
__device__ __forceinline__ void xcd_barrier_complete(unsigned* bar, unsigned x, unsigned& nloc, unsigned& nx) {
    const unsigned G = gridDim.x * gridDim.y * gridDim.z;
    unsigned sum, cnt, mine, sp = 0u;
    for (;;) {
        sum = 0u; cnt = 0u; mine = 0u;
#pragma unroll
        for (unsigned j = 0; j < 16; ++j) { const unsigned c = xb_ld(&bar[XB_XCNT(j)]); sum += c; cnt += (c > 0u) ? 1u : 0u; mine = (j == x) ? c : mine; }
        if (sum == G) break;
        __builtin_amdgcn_s_sleep(1);
        if ((++sp & 255u) == 0u) { if (xb_ld(&bar[XB_TMO])) break; if (sp > XB_SPIN_CAP) { atomicAdd(&bar[XB_TMO], 1u); break; } }
    }
    nloc = mine > 0u ? mine : 1u; nx = cnt > 0u ? cnt : 1u;
}
__device__ __forceinline__ void xcd_barrier(const XcdBarrier& b) {
    asm volatile("s_waitcnt vmcnt(0)" ::: "memory");
    __syncthreads();
    if (threadIdx.x == 0) {
        unsigned* bar = b.bar;
        __builtin_amdgcn_s_waitcnt(0);
        unsigned nloc = b.st[0], nx = b.st[1];
        if (nloc == 0u) { xcd_barrier_complete(bar, b.x, nloc, nx); b.st[0] = nloc; b.st[1] = nx; }
        const unsigned old = xb_add(&bar[XB_XSUB(b.x)], 1u);
        const unsigned gen = old / nloc;
        if (old + 1u == (gen + 1u) * nloc) {
            __builtin_amdgcn_fence(__ATOMIC_RELEASE, "agent");
            asm volatile("s_waitcnt vmcnt(0)" ::: "memory");
            const unsigned og = xb_add(&bar[XB_TOP], 1u);
            const unsigned tg = og / nx;
            if (og + 1u == (tg + 1u) * nx) xb_add(&bar[XB_TOPGEN], 1u);
            else XB_SPIN(xb_ld(&bar[XB_TOPGEN]) == tg, bar);
            __builtin_amdgcn_fence(__ATOMIC_ACQUIRE, "agent");
            xb_add(&bar[XB_XGEN(b.x)], 1u);
            asm volatile("s_waitcnt vmcnt(0)" ::: "memory");
        } else {
            XB_SPIN(xb_ld(&bar[XB_XGEN(b.x)]) == gen, bar);
            __builtin_amdgcn_fence(__ATOMIC_ACQUIRE, "agent");
            asm volatile("s_waitcnt vmcnt(0)" ::: "memory");
        }
    }
    __syncthreads();
}

struct Args { const float* in[24]; float* out; unsigned char* ws; int nb, ph_lo, ph_hi, li; };
struct Frame {
    LAS unsigned char* lds; int tid, lane, wave, G, bid, nb, T; unsigned char* ws; const Args* a; float* xbuf;
};
__device__ __forceinline__ void refresh(Frame& F) { int t = threadIdx.x; asm volatile("" : "+v"(t)); F.tid = t; F.lane = t & 63; F.wave = __builtin_amdgcn_readfirstlane(t >> 6); }
constexpr int LDS_BYTES = 160 * 1024 - 64 * 0;
constexpr int LDS_MISC = 160 * 1024 - 256;

#ifndef MK_TRP
#define MK_TRP 0
#endif
__device__ __forceinline__ void tr_item(const float* src, int lds_, int ks0, int c0, bf16* dst, int ldd, int r0, int kd0, LAS float* scr, int lane, float scale = 1.f, bool probe = false) {
#if defined(MK_TR4)
    {
        const float* sp = src + (size_t)(ks0 + (lane >> 3)) * lds_ + c0 + 4 * (lane & 7);
        f32x4 v[8];
#pragma unroll
        for (int i = 0; i < 8; ++i) v[i] = *(const f32x4*)(sp + (size_t)(8 * i) * lds_);
#pragma unroll
        for (int i = 0; i < 8; ++i) { LAS float* d_ = scr + (8 * i + (lane >> 3)) * 33 + 4 * (lane & 7); d_[0] = v[i].x * scale; d_[1] = v[i].y * scale; d_[2] = v[i].z * scale; d_[3] = v[i].w * scale; }
    }
#elif defined(MK_TR32)
    {   const float* sp = src + (size_t)(ks0 + (lane >> 5)) * lds_ + c0 + (lane & 31);
        float v[32];
#pragma unroll
        for (int i = 0; i < 32; ++i) v[i] = sp[(size_t)(2 * i) * lds_];
#pragma unroll
        for (int i = 0; i < 32; ++i) scr[(2 * i + (lane >> 5)) * 33 + (lane & 31)] = v[i] * scale;
    }
#else
    if ((MK_TRP & 2) && probe) { for (int i = 0; i < 32; ++i) scr[(2 * i + (lane >> 5)) * 33 + (lane & 31)] = scale; } else
#pragma unroll 8
    for (int i = 0; i < 32; ++i) { const int kk = 2 * i + (lane >> 5); scr[kk * 33 + (lane & 31)] = src[(size_t)(ks0 + kk) * lds_ + c0 + (lane & 31)] * scale; }
#endif
    LDS_WAIT(); asm volatile("" ::: "memory");
    const int c = lane & 7;
#pragma unroll
    for (int j = 0; j < 4; ++j) { const int n = (lane >> 3) + 8 * j; const LAS float* s = scr + (8 * c) * 33 + n;
        u32x4 o; o.x = cvt_pk(s[0 * 33], s[1 * 33]); o.y = cvt_pk(s[2 * 33], s[3 * 33]); o.z = cvt_pk(s[4 * 33], s[5 * 33]); o.w = cvt_pk(s[6 * 33], s[7 * 33]);
        if (!((MK_TRP & 1) && probe) || o.x == 0x12345678u) *(u32x4*)(dst + (size_t)(r0 + n) * ldd + kd0 + 8 * c) = o; }
    LDS_WAIT(); asm volatile("" ::: "memory");
}
__device__ __forceinline__ void tr_item8(const float* src, int lds_, int ks0, int c0, unsigned char* dst, int ldd, int r0, int kd0, float scale, LAS float* scr, int lane) {
#pragma unroll 8
    for (int i = 0; i < 32; ++i) { const int kk = 2 * i + (lane >> 5); scr[kk * 33 + (lane & 31)] = src[(size_t)(ks0 + kk) * lds_ + c0 + (lane & 31)] * scale; }
    LDS_WAIT(); asm volatile("" ::: "memory");
    const int c = lane & 7;
#pragma unroll
    for (int j = 0; j < 4; ++j) { const int n = (lane >> 3) + 8 * j; const LAS float* s = scr + (8 * c) * 33 + n;
        int w0 = 0, w1 = 0;
        w0 = __builtin_amdgcn_cvt_pk_fp8_f32(s[0 * 33], s[1 * 33], w0, false); w0 = __builtin_amdgcn_cvt_pk_fp8_f32(s[2 * 33], s[3 * 33], w0, true);
        w1 = __builtin_amdgcn_cvt_pk_fp8_f32(s[4 * 33], s[5 * 33], w1, false); w1 = __builtin_amdgcn_cvt_pk_fp8_f32(s[6 * 33], s[7 * 33], w1, true);
        u32x2 o; o.x = (unsigned)w0; o.y = (unsigned)w1;
        *(u32x2*)(dst + (size_t)(r0 + n) * ldd + kd0 + 8 * c) = o; }
    LDS_WAIT(); asm volatile("" ::: "memory");
}
__device__ __forceinline__ int win_src_col(int tile, int p0) {
    const int bj = p0 >> 7, wc = (p0 >> 5) & 3; const int L = 64 * wc + 32 * bj;
    switch (tile) {
        case 0: return O_GQ + p0; case 1: return O_GK + p0;
        case 2: case 3: return O_GV + (tile - 2) * 256 + p0;
        case 4: case 5: return O_GG + (tile - 4) * 256 + p0;
        case 8: case 9: return O_DQ + (tile - 8) * 256 + L;
        case 10: case 11: return O_DK + (tile - 10) * 256 + L;
        case 12: case 13: return O_DV + (tile - 12) * 256 + p0;
        case 14: case 15: case 16: case 17: return O_GA + (tile - 14) * 256 + p0;
        default: return O_GB + (tile - 18) * 256 + p0;
    }
}
struct TrB { const float* src; bf16* dst; int sstride, dstride, width, kind; float scale; };
constexpr int TB_IN = 16 * 6, TB_AB = 16, TB_O = 16, TB_1 = NE * 16, TB_2 = NE * 8, TB_L = TB_IN + TB_AB + TB_O + TB_1 + TB_2;
constexpr int TB_EARLY = TB_IN + TB_AB + TB_O, TB_ALL = DEPTH * TB_L;
__device__ __forceinline__ TrB trb_decode(const WS& W, const float* const* IN_, int it) { TrB d; d.scale = 1.f; d.kind = 0; d.width = 1024;
    const int l = it / TB_L; int r = it % TB_L;
    if (r < TB_IN) { const int kb = r / 6, ch = r % 6;
        const int scol = ch == 0 ? 0 : ch == 1 ? 1024 : 1568 + (ch - 2) * 1024, tile0 = ch == 0 ? 0 : ch == 1 ? 4 : 8 + (ch - 2) * 4;
        d.width = (ch == 1 || ch == 5) ? 512 : 1024; d.kind = (ch == 2) ? 1 : 0;
        d.src = IN_[6] + (size_t)l * D * DIN + (size_t)(kb * 64) * DIN + scol; d.sstride = DIN;
        d.dst = W.win + (size_t)l * NIN * D + (size_t)(tile0 * 256) * D + kb * 64; d.dstride = D; return d; }
    r -= TB_IN;
    if (r < TB_AB) { const int which = r >> 3, kb = r & 7;
        d.src = IN_[15 + which] + (size_t)l * 512 * D + (size_t)(kb * 64) * D; d.sstride = D; d.scale = 1.f / 255.f;
        d.dst = W.wab + (size_t)l * D * D + (size_t)which * 1024 * 512 + kb * 64; d.dstride = 512; return d; }
    r -= TB_AB;
    if (r < TB_O) { const int kb = r;
        d.src = IN_[17] + (size_t)l * D * D + (size_t)(kb * 64) * D; d.sstride = D;
        d.dst = W.wo + (size_t)l * D * D + kb * 64; d.dstride = D; return d; }
    r -= TB_O;
    if (r < TB_1) { const int e = r >> 4, kb = r & 15; d.kind = 2;
        d.src = IN_[22] + ((size_t)l * NE + e) * D * 1024 + (size_t)(kb * 64) * 1024; d.sstride = 1024;
        d.dst = W.w1 + ((size_t)l * NE + e) * 1024 * D + kb * 64; d.dstride = D; return d; }
    r -= TB_1;
    { const int e = r >> 3, kb = r & 7;
        d.src = IN_[23] + ((size_t)l * NE + e) * DE * D + (size_t)(kb * 64) * D; d.sstride = D;
        d.dst = W.w2 + ((size_t)l * NE + e) * D * DE + kb * 64; d.dstride = DE; return d; }
}
__device__ __forceinline__ void trb_items(Frame& F, int stage, int maxn) {
    const WS W = ws_map(F.ws, F.nb); const float* const* IN_ = F.a->in;
    int tid_ = threadIdx.x; asm volatile("" : "+v"(tid_));
    const int lane_ = tid_ & 63, wave_ = __builtin_amdgcn_readfirstlane(tid_ >> 6);
    volatile LAS unsigned* bc = (volatile LAS unsigned*)(F.lds + 148 * 1024);
    unsigned* qcnt = W.ctl + CW_CNT + 160 + stage;
    const int base = stage ? TB_EARLY : 0, lim = stage ? TB_ALL : TB_EARLY;
    for (int taken = 0; taken < maxn; ++taken) {
        __syncthreads();
        if (tid_ == 0) *bc = atomicAdd(qcnt, 1u);
        __syncthreads();
        const int it = __builtin_amdgcn_readfirstlane(base + (int)*bc);
        if (it >= lim) break;
        const TrB d = trb_decode(W, IN_, it);
#pragma unroll
        for (int rd = 0; rd < 2; ++rd) {
            const float* rp = d.src + (size_t)(8 * wave_ + 4 * rd) * d.sstride + lane_;
            float v[4][16];
#pragma unroll
            for (int rr = 0; rr < 4; ++rr)
#pragma unroll
                for (int e = 0; e < 16; ++e) v[rr][e] = (64 * e < d.width) ? rp[(size_t)rr * d.sstride + 64 * e] : 0.f;
#pragma unroll
            for (int e = 0; e < 16; ++e) { const int n = lane_ + 64 * e;
                int R = n;
                if (d.kind == 1) R = (n & ~255) + ((n >> 5) & 1) * 128 + ((n >> 6) & 3) * 32 + (n & 31);
                else if (d.kind == 2) R = (n < 512) ? 256 * (n >> 7) + (n & 127) : 256 * ((n - 512) >> 7) + 128 + (n & 127);
                u32x2 w; w.x = cvt_pk(v[0][e] * d.scale, v[1][e] * d.scale); w.y = cvt_pk(v[2][e] * d.scale, v[3][e] * d.scale);
                if (64 * e < d.width) *(LAS u32x2*)(F.lds + R * 144 + (8 * wave_ + 4 * rd) * 2) = w; }
        }
        __syncthreads();
#pragma unroll
        for (int q = 0; q < 16; ++q) { const int R = wave_ * 128 + 8 * q + (lane_ >> 3);
            if (R < d.width) { const u32x4 o = *(const LAS u32x4*)(F.lds + R * 144 + 16 * (lane_ & 7));
                *(u32x4*)(d.dst + (size_t)R * d.dstride + 8 * (lane_ & 7)) = o; } }
    }
    __syncthreads();
}
__device__ __forceinline__ void p0_prologue(Frame& F, unsigned pmask = 0xffu) {
    refresh(F);
    const WS W = ws_map(F.ws, F.nb); const float* const* IN_ = F.a->in;
    const float* c_in = IN_[1]; const float* w_ada = IN_[2]; const float* b_ada = IN_[3];
    if (pmask & 1u) {
        LAS float* red = (LAS float*)F.lds;
        for (int it = F.bid; it < DEPTH * 96; it += F.G) {
            const int l = it / 96, j = (it % 96) * 64 + F.lane;
            const float* w = w_ada + (size_t)l * D * 6 * D + j;
            float a0 = 0.f, a1 = 0.f, a2 = 0.f, a3 = 0.f;
            const int kbeg = F.wave * 128;
#pragma unroll 16
            for (int k = kbeg; k < kbeg + 128; ++k) { const float wv = w[(size_t)k * 6 * D];
                const float c0 = c_in[k], c1 = c_in[D + k], c2 = c_in[2 * D + k], c3 = c_in[3 * D + k];
                a0 += fsilu(c0) * wv; a1 += fsilu(c1) * wv; a2 += fsilu(c2) * wv; a3 += fsilu(c3) * wv; }
            red[(F.wave * 4 + 0) * 64 + F.lane] = a0; red[(F.wave * 4 + 1) * 64 + F.lane] = a1; red[(F.wave * 4 + 2) * 64 + F.lane] = a2; red[(F.wave * 4 + 3) * 64 + F.lane] = a3;
            __syncthreads();
            if (F.tid < 256) { const int b = F.tid >> 6, jj = F.tid & 63; float s = 0.f;
#pragma unroll
                for (int wv = 0; wv < 8; ++wv) s += red[(wv * 4 + b) * 64 + jj];
                const int jc = (it % 96) * 64 + jj;
                W.mod[((size_t)l * NBMAX + b) * 6 * D + jc] = s + b_ada[l * 6 * D + jc]; }
            __syncthreads();
        }
    }
    if (F.bid == 0) {
        const float* rb = IN_[14];
        for (int i = F.tid; i < 1024; i += NTHR) { const int h = i >> 8, rel = (i & 255) - 128; W.tab[i] = (rb[t5_bucket(rel) * 4 + h] - rb[31 * 4 + h]) * LOG2E; }
        if (F.tid < 4) W.tab[1024 + F.tid] = __expf(rb[15 * 4 + F.tid] - rb[31 * 4 + F.tid]);
        if (F.tid >= 64 && F.tid < 64 + DEPTH) { const int l = F.tid - 64; const float* lv = IN_[12] + l * 256; float s1 = 0.f, s2 = 0.f;
            for (int i = 0; i < 64; ++i) { s1 += lv[i] * lv[64 + i]; s2 += lv[128 + i] * lv[192 + i]; }
            W.tab[1032 + l] = expf(s1) - expf(s2) + (0.8f - 0.6f * expf(-0.3f * (float)l)); }
    }
    __syncthreads();
    LAS float* scr = (LAS float*)(F.lds + F.wave * 16384);
    const int gw = F.bid * NWAVES + F.wave, NGW = F.G * NWAVES;
    constexpr int I_IN = (NIN / 32) * 16, I_AB = 32 * 16, I_O = 32 * 16, I_1 = NE * 32 * 16, I_2 = NE * 32 * 8;
    constexpr int PER_L = I_IN + I_AB + I_O + I_1 + I_2;
    if (pmask & 4u) trb_items(F, 0, 1 << 30);
    if (pmask & 8u)
    for (int it = gw; it < DEPTH * 2 * 8 * 16; it += NGW) {
        const int l = it >> 8, dir = (it >> 7) & 1, nbk = (it >> 4) & 7, kb = it & 15; const int k = kb * 64 + F.lane;
        const float* wi = IN_[6] + (size_t)l * D * DIN + (size_t)k * DIN + (dir ? O_LRB : O_LRF);
        float wv[16];
#pragma unroll
        for (int r = 0; r < 16; ++r) wv[r] = wi[r];
        const float* wu = IN_[7] + ((size_t)l * 2 + dir) * 16 * 256;
        bf16* dst = W.win + (size_t)l * NIN * D + (size_t)((6 + dir) * 256) * D;
        for (int n = nbk * 32; n < nbk * 32 + 32; ++n) { float s = 0.f;
#pragma unroll
            for (int r = 0; r < 16; ++r) s += wv[r] * wu[r * 256 + n];
            dst[(size_t)n * D + k] = (bf16)(cvt_pk(s, 0.f) & 0xffffu); }
    }
    if (pmask & 16u)
    for (int it = gw * 64 + F.lane; it < DEPTH * 256 * 128; it += NGW * 64) {
        const int l = it / (256 * 128), q = it % (256 * 128), row = q >> 7, k0 = (q & 127) * 8;
        float v[8];
#pragma unroll
        for (int i = 0; i < 8; ++i) { float x = 0.f;
            if (row < 4) x = IN_[18][((size_t)l * D + k0 + i) * 4 + row]; else if (row < 36) x = IN_[20][((size_t)l * D + k0 + i) * 32 + row - 4];
            v[i] = x; }
        u32x4 o; o.x = cvt_pk(v[0], v[1]); o.y = cvt_pk(v[2], v[3]); o.z = cvt_pk(v[4], v[5]); o.w = cvt_pk(v[6], v[7]);
        *(u32x4*)(W.wr + ((size_t)l * 256 + row) * D + k0) = o;
    }
}

struct NormRow { f32x4 xf[4]; u32x2 xb[4]; unsigned ya[4], yc[4]; };
__device__ __forceinline__ void norm_load(NormRow& r, const float* xin, const bf16* XB, const unsigned char* YS, int t, int lane, bool from_in, bool combine, int p0, int p1) {
    if (from_in) { const GAS f32x4* xr = (const GAS f32x4*)(xin + (size_t)t * D) + lane;
#pragma unroll
        for (int j = 0; j < 4; ++j) r.xf[j] = xr[64 * j]; }
    else { const GAS u32x2* xr = (const GAS u32x2*)(XB + (size_t)t * D) + lane;
#pragma unroll
        for (int j = 0; j < 4; ++j) r.xb[j] = xr[64 * j]; }
    if (combine) { const GAS unsigned* y0 = (const GAS unsigned*)(YS + (size_t)p0 * D) + lane; const GAS unsigned* y1 = (const GAS unsigned*)(YS + (size_t)p1 * D) + lane;
#pragma unroll
        for (int j = 0; j < 4; ++j) { r.ya[j] = y0[64 * j]; r.yc[j] = y1[64 * j]; } }
}
__device__ __forceinline__ void phase_norm(Frame& F, int l, int mode) {
    refresh(F);
    const WS W = ws_map(F.ws, F.nb); const float* const* IN_ = F.a->in;
    const int gw = F.bid * NWAVES + F.wave, NGW = F.G * NWAVES;
    const bool combine = (mode == 2) || (mode == 0 && l > 0);
    const bool from_in = (mode == 0 && l == 0);
    const int lp = (mode == 2) ? DEPTH - 1 : l - 1;
    const float* ng = (mode == 1 ? IN_[5] : IN_[4]) + (size_t)(mode == 2 ? 0 : l) * D;
    NormRow ra, rb;
    int bcur = -1; f32x4 vA[4], vSH[4], vG2[4];
    auto compute = [&](const NormRow& cur, int t) {
        const int b = t / SEQ;
        if (b != bcur) { bcur = b;
            const float* md = W.mod + ((size_t)l * NBMAX + b) * 6 * D + (mode == 1 ? 3 * D : 0);
            const float* g2 = W.mod + ((size_t)lp * NBMAX + b) * 6 * D + 5 * D;
#pragma unroll
            for (int j = 0; j < 4; ++j) {
                if (mode != 2) { const f32x4 g = *((const GAS f32x4*)ng + F.lane + 64 * j), sc = *((const GAS f32x4*)(md + D) + F.lane + 64 * j); vSH[j] = *((const GAS f32x4*)md + F.lane + 64 * j);
                    vA[j] = (f32x4){g.x * (1.f + sc.x), g.y * (1.f + sc.y), g.z * (1.f + sc.z), g.w * (1.f + sc.w)}; }
                if (combine) vG2[j] = *((const GAS f32x4*)g2 + F.lane + 64 * j) * (1.f / YSCALE); } }
        f32x4 v[4];
        if (from_in) {
#pragma unroll
            for (int j = 0; j < 4; ++j) v[j] = cur.xf[j]; }
        else {
#pragma unroll
            for (int j = 0; j < 4; ++j) { const u32x2 a = cur.xb[j]; v[j] = (f32x4){bflo(a.x), bfhi(a.x), bflo(a.y), bfhi(a.y)}; } }
        if (combine) {
#pragma unroll
            for (int j = 0; j < 4; ++j) { const unsigned a = cur.ya[j], c = cur.yc[j]; const f32x4 g = vG2[j];
                v[j].x += g.x * (__builtin_amdgcn_cvt_f32_fp8((int)a, 0) + __builtin_amdgcn_cvt_f32_fp8((int)c, 0)); v[j].y += g.y * (__builtin_amdgcn_cvt_f32_fp8((int)a, 1) + __builtin_amdgcn_cvt_f32_fp8((int)c, 1));
                v[j].z += g.z * (__builtin_amdgcn_cvt_f32_fp8((int)a, 2) + __builtin_amdgcn_cvt_f32_fp8((int)c, 2)); v[j].w += g.w * (__builtin_amdgcn_cvt_f32_fp8((int)a, 3) + __builtin_amdgcn_cvt_f32_fp8((int)c, 3)); }
            if (mode == 2) { GAS f32x4* xo = (GAS f32x4*)(F.xbuf + (size_t)t * D) + F.lane;
#pragma unroll
                for (int j = 0; j < 4; ++j) xo[64 * j] = v[j]; }
            else { GAS u32x2* xo = (GAS u32x2*)(W.XB + (size_t)t * D) + F.lane;
#pragma unroll
                for (int j = 0; j < 4; ++j) { u32x2 o; o.x = cvt_pk(v[j].x, v[j].y); o.y = cvt_pk(v[j].z, v[j].w); xo[64 * j] = o; } }
        }
        if (mode != 2) {
            float ss = 0.f;
#pragma unroll
            for (int j = 0; j < 4; ++j) ss += (v[j].x * v[j].x + v[j].y * v[j].y) + (v[j].z * v[j].z + v[j].w * v[j].w);
            const float rstd = rsqrtf(wave_sum(ss) * (1.f / D) + RMS_EPS);
            GAS u32x2* ho = (GAS u32x2*)(W.H + (size_t)t * D) + F.lane;
#pragma unroll
            for (int j = 0; j < 4; ++j) { const f32x4 g = vA[j], sh = vSH[j];
                const float h0 = v[j].x * rstd * g.x + sh.x, h1 = v[j].y * rstd * g.y + sh.y, h2 = v[j].z * rstd * g.z + sh.z, h3 = v[j].w * rstd * g.w + sh.w;
                u32x2 o; o.x = cvt_pk(h0, h1); o.y = cvt_pk(h2, h3); ho[64 * j] = o; }
        }
    };
    auto slots = [&](int t, int& p0, int& p1) { p0 = 0; p1 = 0; if (combine && t < F.T) { p0 = W.pos[t * 2]; p1 = W.pos[t * 2 + 1]; } };
    int pa0, pa1, pb0, pb1;
    slots(gw, pa0, pa1); slots(gw + NGW, pb0, pb1);
    if (gw < F.T) norm_load(ra, IN_[0], W.XB, (const unsigned char*)W.YS, gw, F.lane, from_in, combine, pa0, pa1);
    for (int t = gw; t < F.T; t += 2 * NGW) {
        const int t1 = t + NGW, t2 = t + 2 * NGW;
        if (t1 < F.T) norm_load(rb, IN_[0], W.XB, (const unsigned char*)W.YS, t1, F.lane, from_in, combine, pb0, pb1);
        slots(t2, pa0, pa1);
        compute(ra, t);
        if (t1 < F.T) {
            if (t2 < F.T) norm_load(ra, IN_[0], W.XB, (const unsigned char*)W.YS, t2, F.lane, from_in, combine, pa0, pa1);
            slots(t2 + NGW, pb0, pb1);
            compute(rb, t1);
        }
    }
}
typedef pg8::Unit Unit;
__device__ __forceinline__ u32x4 pack8(const f32x4& a, const f32x4& b) { u32x4 w; w.x = cvt_pk(a[0], a[1]); w.y = cvt_pk(a[2], a[3]); w.z = cvt_pk(b[0], b[1]); w.w = cvt_pk(b[2], b[3]); return w; }

#ifndef MK_ATT_FP8
#define MK_ATT_FP8 1
#endif
__device__ __forceinline__ u32x2 pack8_fp8(const f32x4& a, const f32x4& b) { int w0 = 0, w1 = 0;
    w0 = __builtin_amdgcn_cvt_pk_fp8_f32(a[0], a[1], w0, false); w0 = __builtin_amdgcn_cvt_pk_fp8_f32(a[2], a[3], w0, true);
    w1 = __builtin_amdgcn_cvt_pk_fp8_f32(b[0], b[1], w1, false); w1 = __builtin_amdgcn_cvt_pk_fp8_f32(b[2], b[3], w1, true);
    u32x2 r; r.x = (unsigned)w0; r.y = (unsigned)w1; return r; }
struct EpiNull {
    static constexpr bool PERM = true, AFTER_DRAIN = false, MIDK = false;
    __device__ __forceinline__ void operator()(const f32x4 (&acc)[2][2][4][2], const Unit&, int, int, int, int) const {
#pragma unroll
        for (int a = 0; a < 2; ++a)
#pragma unroll
            for (int b = 0; b < 2; ++b)
#pragma unroll
                for (int m = 0; m < 4; ++m) { asm volatile("" :: "v"(acc[a][b][m][0]), "v"(acc[a][b][m][1])); } }
};
struct EpiIn {
    static constexpr bool PERM = true, AFTER_DRAIN = false, MIDK = false;
    bf16 *GQ, *GK, *GV, *SG, *LGF, *LGB, *DQ, *DK, *DV, *SGA, *SGB; const float* b_up; const float* qg; const float* kg; int plain;
    __device__ __forceinline__ void operator()(const f32x4 (&acc)[2][2][4][2], const Unit& u, int wr, int wc, int fr, int fq) const {
        const int pn = u.pn; const int row0 = u.pm * 256 + wr * 64 + fr;
        if (pn >= 8 && pn <= 11) {
            const bool isk = pn >= 10; const int head = 2 * ((pn - 8) & 1) + (wc >> 1), c = wc & 1;
            const float* gv = isk ? kg : qg; const float sc = isk ? 1.f : QSCALE;
            f32x4 g[2][2];
#pragma unroll
            for (int bj = 0; bj < 2; ++bj)
#pragma unroll
                for (int n = 0; n < 2; ++n) g[bj][n] = *(const f32x4*)(gv + 32 * bj + 8 * fq + 4 * n);
#pragma unroll
            for (int ai = 0; ai < 2; ++ai)
#pragma unroll
                for (int m = 0; m < 4; ++m) {
                    const int r = row0 + ai * 128 + m * 16, b = r / SEQ, s = r % SEQ;
                    float ss = 0.f;
#pragma unroll
                    for (int bj = 0; bj < 2; ++bj)
#pragma unroll
                        for (int n = 0; n < 2; ++n) { const f32x4 x = acc[ai][bj][m][n]; ss += (x[0] * x[0] + x[1] * x[1]) + (x[2] * x[2] + x[3] * x[3]); }
                    ss += __shfl_xor(ss, 16); ss += __shfl_xor(ss, 32);
                    const float rs = rsqrtf(ss * (1.f / 64.f) + RMS_EPS) * sc;
#if MK_ATT_FP8
                    unsigned char* dst8 = (unsigned char*)(isk ? DK : DQ) + ((((size_t)b * NH + head) * 2 + c) * SEQ + s) * 64;
#pragma unroll
                    for (int bj = 0; bj < 2; ++bj) {
                        const f32x4 v0 = acc[ai][bj][m][0] * rs * g[bj][0], v1 = acc[ai][bj][m][1] * rs * g[bj][1];
                        int chunk = 2 * bj + (fq >> 1); if (isk) chunk ^= ((s >> 2) & 3);
                        *(u32x2*)(dst8 + chunk * 16 + 8 * (fq & 1)) = pack8_fp8(v0, v1);
                    }
#else
                    bf16* dst = (isk ? DK : DQ) + ((((size_t)b * NH + head) * 2 + c) * SEQ + s) * 64;
#pragma unroll
                    for (int bj = 0; bj < 2; ++bj) {
                        const f32x4 v0 = acc[ai][bj][m][0] * rs * g[bj][0], v1 = acc[ai][bj][m][1] * rs * g[bj][1];
                        int chunk = 4 * bj + fq; if (isk) chunk ^= ((s >> 1) & 7);
                        *(u32x4*)(dst + chunk * 8) = pack8(v0, v1);
                    }
#endif
                }
            return;
        }
#pragma unroll
        for (int ai = 0; ai < 2; ++ai)
#pragma unroll
            for (int m = 0; m < 4; ++m) {
                const int r = row0 + ai * 128 + m * 16;
#pragma unroll
                for (int bj = 0; bj < 2; ++bj) {
                    const int c0 = 128 * bj + 32 * wc + 8 * fq;
                    f32x4 v0 = acc[ai][bj][m][0], v1 = acc[ai][bj][m][1];
                    if (plain) { *(u32x4*)(SGA + (size_t)r * D + (pn & 3) * 256 + c0) = pack8(v0, v1); }
                    else if (pn == 0) { *(u32x4*)(GQ + (size_t)r * 256 + c0) = pack8(v0 * 0.125f, v1 * 0.125f); }
                    else if (pn == 1) { *(u32x4*)(GK + (size_t)r * 256 + c0) = pack8(v0, v1); }
                    else if (pn <= 3) { *(u32x4*)(GV + (size_t)r * 512 + (pn - 2) * 256 + c0) = pack8(v0, v1); }
                    else if (pn <= 5) {
#pragma unroll
                        for (int i = 0; i < 4; ++i) { v0[i] = fsilu(v0[i]); v1[i] = fsilu(v1[i]); }
                        *(u32x4*)(SG + (size_t)r * 512 + (pn - 4) * 256 + c0) = pack8(v0, v1); }
                    else if (pn <= 7) {
                        const float* bu = b_up + (pn - 6) * 256 + c0; const f32x4 b0 = *(const f32x4*)bu, b1 = *(const f32x4*)(bu + 4);
#pragma unroll
                        for (int i = 0; i < 4; ++i) { float z = v0[i] + b0[i]; v0[i] = (fminf(z, 0.f) - __logf(1.f + __expf(-fabsf(z)))) * (1.f / 16.f);
                                                      z = v1[i] + b1[i]; v1[i] = (fminf(z, 0.f) - __logf(1.f + __expf(-fabsf(z)))) * (1.f / 16.f); }
                        *(u32x4*)((pn == 6 ? LGF : LGB) + (size_t)r * 256 + c0) = pack8(v0, v1); }
#if MK_ATT_FP8
                    else if (pn <= 13) {
                        const int b = r / SEQ, s = r % SEQ, head = 2 * (pn - 12) + bj;
                        const int kk = s & 63, wkey = kk & 31, hh_ = (wkey >> 2) & 1, reg_ = (wkey & 3) + 4 * (wkey >> 3), pos = hh_ * 32 + 16 * (kk >> 5) + reg_;
                        unsigned char* tb = (unsigned char*)DV + (((size_t)b * NH + head) * (SEQ / 64) + (s >> 6)) * 8192;
                        const u32x2 pk = pack8_fp8(v0, v1); const int dv0 = 32 * wc + 8 * fq;
#pragma unroll
                        for (int i = 0; i < 8; ++i) { const int dv = dv0 + i; const unsigned byte = ((i < 4 ? pk.x : pk.y) >> (8 * (i & 3))) & 0xffu;
                            tb[dv * 64 + ((((pos >> 4) ^ ((dv >> 2) & 3)) << 4) | (pos & 15))] = (unsigned char)byte; } }
#else
                    else if (pn <= 13) {
                        const int b = r / SEQ, s = r % SEQ, head = 2 * (pn - 12) + bj;
                        bf16* dst = DV + ((((size_t)b * NH + head) * (SEQ / 8) + (s >> 3)) * 4 + wc) * 256 + (s & 7) * 32 + 8 * fq;
                        *(u32x4*)dst = pack8(v0, v1); }
#endif
                    else {
#pragma unroll
                        for (int i = 0; i < 4; ++i) { v0[i] = fsigmoid255(v0[i]); v1[i] = fsigmoid255(v1[i]); }
                        unsigned char* base = (pn <= 17) ? (unsigned char*)SGA + (pn - 14) * 256 : (unsigned char*)SGB + (pn - 18) * 256;
                        u32x2 q; q.x = 0u; q.y = 0u;
                        q.x = __builtin_amdgcn_cvt_pk_u8_f32(v0[0], 0, q.x); q.x = __builtin_amdgcn_cvt_pk_u8_f32(v0[1], 1, q.x); q.x = __builtin_amdgcn_cvt_pk_u8_f32(v0[2], 2, q.x); q.x = __builtin_amdgcn_cvt_pk_u8_f32(v0[3], 3, q.x);
                        q.y = __builtin_amdgcn_cvt_pk_u8_f32(v1[0], 0, q.y); q.y = __builtin_amdgcn_cvt_pk_u8_f32(v1[1], 1, q.y); q.y = __builtin_amdgcn_cvt_pk_u8_f32(v1[2], 2, q.y); q.y = __builtin_amdgcn_cvt_pk_u8_f32(v1[3], 3, q.y);
                        *(u32x2*)(base + (size_t)r * D + c0) = q; }
                }
            }
    }
};

struct EpiMerge {
    static constexpr bool PERM = true, AFTER_DRAIN = false, MIDK = false;
    const bf16* SGA; const bf16* SGB; bf16* O; int nM;
    __device__ __forceinline__ void operator()(const f32x4 (&acc)[2][2][4][2], const Unit& u, int wr, int wc, int fr, int fq) const {
        const int sel = u.pn >> 2; const int row0 = (u.pm - sel * nM) * 256 + wr * 64 + fr, col0 = (u.pn & 3) * 256 + wc * 32 + 8 * fq;
        const unsigned char* G = (const unsigned char*)(sel ? SGB : SGA);
#pragma unroll
        for (int ai = 0; ai < 2; ++ai) {
            u32x2 gt[4][2]; u32x4 t1[4][2];
#pragma unroll
            for (int m = 0; m < 4; ++m) { const size_t off = (size_t)(row0 + ai * 128 + m * 16) * D + col0;
#pragma unroll
                for (int bj = 0; bj < 2; ++bj) { gt[m][bj] = *(const u32x2*)(G + off + bj * 128); if (sel) t1[m][bj] = *(const u32x4*)(O + off + bj * 128); } }
#pragma unroll
            for (int m = 0; m < 4; ++m) { const size_t off = (size_t)(row0 + ai * 128 + m * 16) * D + col0;
#pragma unroll
                for (int bj = 0; bj < 2; ++bj) { const u32x2 b = gt[m][bj];
                    f32x4 v0 = acc[ai][bj][m][0], v1 = acc[ai][bj][m][1];
                    v0[0] *= (float)(b.x & 0xffu); v0[1] *= (float)((b.x >> 8) & 0xffu); v0[2] *= (float)((b.x >> 16) & 0xffu); v0[3] *= (float)(b.x >> 24);
                    v1[0] *= (float)(b.y & 0xffu); v1[1] *= (float)((b.y >> 8) & 0xffu); v1[2] *= (float)((b.y >> 16) & 0xffu); v1[3] *= (float)(b.y >> 24);
                    if (sel) { const u32x4 t = t1[m][bj];
                        v0[0] += bflo(t.x); v0[1] += bfhi(t.x); v0[2] += bflo(t.y); v0[3] += bfhi(t.y); v1[0] += bflo(t.z); v1[1] += bfhi(t.z); v1[2] += bflo(t.w); v1[3] += bfhi(t.w); }
                    *(u32x4*)(O + off + bj * 128) = pack8(v0, v1); } }
            asm volatile("" ::: "memory");
        }
    }
};
struct MergeOrder {
    pg8::StaticOrder so; int nM;
    __device__ __forceinline__ bool next(int i, Unit& u) const { Unit t; if (!so.next(i >> 1, t)) return false; const int sel = i & 1; u.pm = t.pm + sel * nM; u.pn = t.pn + sel * 4; return true; }
    __device__ __forceinline__ void a_ready(const Unit&) const {}
    __device__ __forceinline__ void done(const Unit&) const {}
};

struct EpiResid {
    static constexpr bool PERM = true, AFTER_DRAIN = false, MIDK = false;
    const float* xin32; bf16* xb; const float* g1;
    __device__ __forceinline__ void operator()(const f32x4 (&acc)[2][2][4][2], const Unit& u, int wr, int wc, int fr, int fq) const {
        const int row0 = u.pm * 256 + wr * 64 + fr, col0 = u.pn * 256 + wc * 32 + 8 * fq;
        const int b = (u.pm * 256) / SEQ; const float* g = g1 + (size_t)b * 6 * D + col0;
        f32x4 gv[2][2];
#pragma unroll
        for (int bj = 0; bj < 2; ++bj)
#pragma unroll
            for (int n = 0; n < 2; ++n) gv[bj][n] = *(const f32x4*)(g + bj * 128 + n * 4);
        if (xin32) {
#pragma unroll
            for (int ai = 0; ai < 2; ++ai)
#pragma unroll
                for (int mh = 0; mh < 2; ++mh) { f32x4 x0[2][2], x1[2][2];
#pragma unroll
                    for (int m2 = 0; m2 < 2; ++m2) { const size_t off = (size_t)(row0 + ai * 128 + (2 * mh + m2) * 16) * D + col0;
#pragma unroll
                        for (int bj = 0; bj < 2; ++bj) { x0[m2][bj] = *(const f32x4*)(xin32 + off + bj * 128); x1[m2][bj] = *(const f32x4*)(xin32 + off + bj * 128 + 4); } }
#pragma unroll
                    for (int m2 = 0; m2 < 2; ++m2) { const int m = 2 * mh + m2; const size_t off = (size_t)(row0 + ai * 128 + m * 16) * D + col0;
#pragma unroll
                        for (int bj = 0; bj < 2; ++bj) *(u32x4*)(xb + off + bj * 128) = pack8(x0[m2][bj] + gv[bj][0] * acc[ai][bj][m][0], x1[m2][bj] + gv[bj][1] * acc[ai][bj][m][1]); }
                    asm volatile("" ::: "memory"); }
        } else {
#pragma unroll
            for (int ai = 0; ai < 2; ++ai) { u32x4 xr[4][2];
#pragma unroll
                for (int m = 0; m < 4; ++m) { const size_t off = (size_t)(row0 + ai * 128 + m * 16) * D + col0;
#pragma unroll
                    for (int bj = 0; bj < 2; ++bj) xr[m][bj] = *(const u32x4*)(xb + off + bj * 128); }
#pragma unroll
                for (int m = 0; m < 4; ++m) { const size_t off = (size_t)(row0 + ai * 128 + m * 16) * D + col0;
#pragma unroll
                    for (int bj = 0; bj < 2; ++bj) { const u32x4 a = xr[m][bj];
                        const f32x4 x0 = {bflo(a.x), bfhi(a.x), bflo(a.y), bfhi(a.y)}, x1 = {bflo(a.z), bfhi(a.z), bflo(a.w), bfhi(a.w)};
                        *(u32x4*)(xb + off + bj * 128) = pack8(x0 + gv[bj][0] * acc[ai][bj][m][0], x1 + gv[bj][1] * acc[ai][bj][m][1]); } }
                asm volatile("" ::: "memory"); }
        }
    }
};

struct EpiLogits {
    static constexpr bool PERM = false, AFTER_DRAIN = false, MIDK = false;
    float* L;
    __device__ __forceinline__ void operator()(const f32x4 (&acc)[2][2][4][2], const Unit& u, int wr, int wc, int fr, int fq) const {
        if (wc >= 2) return;
        const int row0 = u.pm * 256 + wr * 64 + fr, col0 = wc * 32 + 4 * fq;
#pragma unroll
        for (int ai = 0; ai < 2; ++ai)
#pragma unroll
            for (int m = 0; m < 4; ++m)
#pragma unroll
                for (int n = 0; n < 2; ++n) *(f32x4*)(L + (size_t)(row0 + ai * 128 + m * 16) * 64 + col0 + n * 16) = acc[ai][0][m][n];
    }
};

#ifndef MK_MOE_FP8
#define MK_MOE_FP8 0
#endif
#if MK_MOE_FP8
struct EpiAct {
    static constexpr bool PERM = true, AFTER_DRAIN = false, MIDK = false;
    unsigned char* ACT;
    __device__ __forceinline__ void operator()(const f32x4 (&acc)[2][2][4][2], const Unit& u, int wr, int wc, int fr, int fq) const {
        const int row0 = u.pm * 256 + wr * 64 + fr, col0 = (u.pn & 3) * 128 + wc * 32 + 8 * fq;
        constexpr float inv = 1.f / WSCALE;
#pragma unroll
        for (int ai = 0; ai < 2; ++ai)
#pragma unroll
            for (int m = 0; m < 4; ++m) { f32x4 v0, v1;
#pragma unroll
                for (int i = 0; i < 4; ++i) { v0[i] = fsilu(acc[ai][0][m][0][i] * inv) * acc[ai][1][m][0][i] * (inv * ASCALE); v1[i] = fsilu(acc[ai][0][m][1][i] * inv) * acc[ai][1][m][1][i] * (inv * ASCALE); }
                *(u32x2*)(ACT + (size_t)(row0 + ai * 128 + m * 16) * DE + col0) = pack8_fp8(v0, v1); }
    }
};
struct EpiYs {
    static constexpr bool PERM = true, AFTER_DRAIN = false, MIDK = false;
    bf16* YS; const float* gs;
    __device__ __forceinline__ void operator()(const f32x4 (&acc)[2][2][4][2], const Unit& u, int wr, int wc, int fr, int fq) const {
        const int row0 = u.pm * 256 + wr * 64 + fr, col0 = (u.pn & 3) * 256 + wc * 32 + 8 * fq;
#pragma unroll
        for (int ai = 0; ai < 2; ++ai)
#pragma unroll
            for (int m = 0; m < 4; ++m) { const int r = row0 + ai * 128 + m * 16; const float gt = gs[r] * (1.f / (WSCALE * ASCALE));
#pragma unroll
                for (int bj = 0; bj < 2; ++bj) *(u32x4*)(YS + (size_t)r * D + col0 + bj * 128) = pack8(acc[ai][bj][m][0] * gt, acc[ai][bj][m][1] * gt); }
    }
};
#else
struct EpiAct {
    static constexpr bool PERM = true, AFTER_DRAIN = false, MIDK = false;
    bf16* ACT;
    __device__ __forceinline__ void operator()(const f32x4 (&acc)[2][2][4][2], const Unit& u, int wr, int wc, int fr, int fq) const {
        const int row0 = u.pm * 256 + wr * 64 + fr, col0 = (u.pn & 3) * 128 + wc * 32 + 8 * fq;
#pragma unroll
        for (int ai = 0; ai < 2; ++ai)
#pragma unroll
            for (int m = 0; m < 4; ++m) { f32x4 v0, v1;
#pragma unroll
                for (int i = 0; i < 4; ++i) { v0[i] = fsilu(acc[ai][0][m][0][i]) * acc[ai][1][m][0][i]; v1[i] = fsilu(acc[ai][0][m][1][i]) * acc[ai][1][m][1][i]; }
                *(u32x4*)(ACT + (size_t)(row0 + ai * 128 + m * 16) * DE + col0) = pack8(v0, v1); }
    }
};
struct EpiYs {
    static constexpr bool PERM = true, AFTER_DRAIN = false, MIDK = false;
    unsigned char* YS; const float* gs;
    __device__ __forceinline__ void operator()(const f32x4 (&acc)[2][2][4][2], const Unit& u, int wr, int wc, int fr, int fq) const {
        const int row0 = u.pm * 256 + wr * 64 + fr, col0 = (u.pn & 3) * 256 + wc * 32 + 8 * fq;
        float gts[2][4];
#pragma unroll
        for (int ai = 0; ai < 2; ++ai)
#pragma unroll
            for (int m = 0; m < 4; ++m) gts[ai][m] = gs[row0 + ai * 128 + m * 16] * YSCALE;
#pragma unroll
        for (int ai = 0; ai < 2; ++ai)
#pragma unroll
            for (int m = 0; m < 4; ++m) { const int r = row0 + ai * 128 + m * 16; const float gt = gts[ai][m];
#pragma unroll
                for (int bj = 0; bj < 2; ++bj) *(u32x2*)(YS + (size_t)r * D + col0 + bj * 128) = pack8_fp8(acc[ai][bj][m][0] * gt, acc[ai][bj][m][1] * gt); }
    }
};
#endif
struct GroupedOrder {
    const int* tilee; int U, G, c; const int* rowidx;
    __device__ __forceinline__ bool next(int i, Unit& u) const {
        int id;
        if ((G & 7) == 0) { const int gx = G >> 3, per = (U + 7) >> 3, n = i * gx + (c >> 3); if (n >= per) return false; id = (c & 7) * per + n; if (id >= U) return false; }
        else { id = i * G + c; if (id >= U) return false; }
        const int t = id >> 2; u.pm = t; u.pn = tilee[t] * 4 + (id & 3); return true;
    }
    __device__ __forceinline__ void a_ready(const Unit&) const {}
    __device__ __forceinline__ void done(const Unit&) const {}
};
constexpr int AT_KR = 0, AT_VR = 32768, AT_TAB = 98304, AT_SLOT = 8192;
typedef int v8i __attribute__((ext_vector_type(8)));
typedef int v4i __attribute__((ext_vector_type(4)));
__device__ __forceinline__ int crow(int r, int hi) { return (r & 3) + 8 * (r >> 2) + 4 * hi; }

__device__ __forceinline__ void attn_bias(f32x16& s0, f32x16& s1, int relbase, const LAS float* tabh) {
#pragma unroll
    for (int r = 0; r < 16; ++r) {
        int i0 = relbase + (r & 3) + 8 * (r >> 2); int i1 = i0 + 32;
        i0 = i0 < 0 ? 0 : (i0 > 255 ? 255 : i0); i1 = i1 < 0 ? 0 : (i1 > 255 ? 255 : i1);
        s0[r] += tabh[i0]; s1[r] += tabh[i1];
    }
}
template <int J>
__device__ __forceinline__ void attn_exp_chunk(f32x16& s0, f32x16& s1, float& lsum) {
    float ls = 0.f;
#pragma unroll
    for (int r = 4 * J; r < 4 * J + 4; ++r) { s0[r] = __builtin_amdgcn_exp2f(s0[r]); s1[r] = __builtin_amdgcn_exp2f(s1[r]); }
    (void)ls; (void)lsum;
}
__device__ __forceinline__ int pk4_bf8(float a, float b, float c, float d) {
    const unsigned lo = __builtin_bit_cast(unsigned, __builtin_amdgcn_cvt_pkrtz(a, b)), hi = __builtin_bit_cast(unsigned, __builtin_amdgcn_cvt_pkrtz(c, d));
    return (int)__builtin_amdgcn_perm(hi, lo, 0x07050301u);
}
#define AT_CM4 ((f32x16){-4.f, -4.f, -4.f, -4.f, -4.f, -4.f, -4.f, -4.f, -4.f, -4.f, -4.f, -4.f, -4.f, -4.f, -4.f, -4.f})
__device__ __forceinline__ void glds16(const unsigned char* sbase, unsigned voff, unsigned lds_dst) { unsigned keep;
    asm volatile("s_mov_b32 %0, m0\n\ts_mov_b32 m0, %3\n\ts_nop 0\n\tglobal_load_lds_dwordx4 %1, %2\n\ts_mov_b32 m0, %0" : "=&s"(keep) : "v"(voff), "s"(sbase), "s"(lds_dst) : "memory"); }
__device__ __forceinline__ void attn_dma_k(unsigned lds0, const unsigned char* kg0, int t, int slot, int wid, int lane) {
    glds16(kg0 + (size_t)(wid >> 2) * SEQ * 64 + (size_t)t * 4096 + (wid & 3) * 1024, (unsigned)lane * 16u, (unsigned)__builtin_amdgcn_readfirstlane((int)(lds0 + AT_KR + slot * AT_SLOT + wid * 1024)));
}
__device__ __forceinline__ void attn_dma_v(unsigned lds0, const unsigned char* vg0, int t, int slot, int wid, int lane) {
    glds16(vg0 + (size_t)t * 8192 + wid * 1024, (unsigned)lane * 16u, (unsigned)__builtin_amdgcn_readfirstlane((int)(lds0 + AT_VR + slot * AT_SLOT + wid * 1024)));
}
#define AT_RD128(dst, addr, off) asm volatile("ds_read_b128 %0, %1 offset:%c2" : "=&v"(dst) : "v"(addr), "i"(off) : "memory")
#define AT_MFMA8(a, b, c) __builtin_amdgcn_mfma_scale_f32_32x32x64_f8f6f4(a, b, c, 0, 0, 0, 0, 0, 0)
#define AT_MFMA8B(a, b, c) __builtin_amdgcn_mfma_scale_f32_32x32x64_f8f6f4(a, b, c, 0, 1, 0, 0, 0, 0)

template <int VAR>
__device__ __forceinline__ void phase_attn(Frame& F, int l) {
    refresh(F);
    const WS W = ws_map(F.ws, F.nb); const float* const* IN_ = F.a->in; (void)IN_; (void)W;
    const int lane = F.lane, wid = F.wave, r32 = lane & 31, hh = lane >> 5, qg = wid & 3, c = wid >> 2;
    LAS unsigned char* lds = F.lds; const unsigned lds0 = (unsigned)(unsigned long)lds;
    LAS float* tab = (LAS float*)(lds + AT_TAB);
    for (int i = F.tid; i < 1028; i += NTHR) tab[i] = W.tab[i];
    const float lam = W.tab[1032 + l]; const float lam_init = 0.8f - 0.6f * __expf(-0.3f * (float)l);
    const float* subg = IN_[13] + l * 128;
    const int U = F.nb * NH * 64;
    const int gx = F.G >> 3, per = U >> 3;
    const int sw = (r32 >> 2) & 3;
    const unsigned ka0 = lds0 + AT_KR + c * 4096 + r32 * 64 + (((2 * hh) ^ sw) << 4), ka1 = lds0 + AT_KR + c * 4096 + r32 * 64 + (((2 * hh + 1) ^ sw) << 4);
    const unsigned va0 = lds0 + AT_VR + r32 * 64 + (((2 * hh) ^ sw) << 4), va1 = lds0 + AT_VR + r32 * 64 + (((2 * hh + 1) ^ sw) << 4);
#ifndef MK_ATT_1BAR
#define MK_ATT_1BAR 1
#endif
    const bool lag = (MK_ATT_1BAR == 0) && wid >= 4;
    __syncthreads();
    for (int i = 0;; ++i) {
        int id;
        if ((F.G & 7) == 0) { const int n = i * gx + (F.bid >> 3); if (n >= per) break; id = (F.bid & 7) * per + n; }
        else { id = i * F.G + F.bid; if (id >= U) break; }
        const int bh = id >> 6, qb = id & 63, b = bh >> 2, h = bh & 3;
        const int qw0 = qb * 128 + 32 * qg;
        const unsigned char* kg0 = (const unsigned char*)W.DK + ((size_t)bh * 2) * SEQ * 64;
        const unsigned char* vg0 = (const unsigned char*)W.DV + (size_t)bh * SEQ * 128;
        v8i qf; { const unsigned char* qp = (const unsigned char*)W.DQ + (((size_t)bh * 2 + c) * SEQ + qw0 + r32) * 64 + 32 * hh;
            const v4i q0 = *(const v4i*)qp, q1 = *(const v4i*)(qp + 16); qf = (v8i){q0[0], q0[1], q0[2], q0[3], q1[0], q1[1], q1[2], q1[3]}; }
        asm volatile("s_waitcnt vmcnt(0)" ::: "memory");
        attn_dma_k(lds0, kg0, 0, 0, wid, lane); attn_dma_k(lds0, kg0, 1, 1, wid, lane); attn_dma_v(lds0, vg0, 0, 7, wid, lane); attn_dma_v(lds0, vg0, 0, 0, wid, lane);
        attn_dma_k(lds0, kg0, 2, 2, wid, lane); attn_dma_v(lds0, vg0, 1, 1, wid, lane); attn_dma_k(lds0, kg0, 3, 3, wid, lane);
        attn_dma_v(lds0, vg0, 2, 2, wid, lane); attn_dma_v(lds0, vg0, 3, 3, wid, lane); attn_dma_v(lds0, vg0, 4, 4, wid, lane); attn_dma_v(lds0, vg0, 5, 5, wid, lane);
        f32x16 o[4]; f32x4 osum = f32x4{};
#pragma unroll
        for (int dt = 0; dt < 4; ++dt) o[dt] = f32x16{};
        v8i ones8; { const int on = (((lane & 15) < 8) == (((lane >> 4) & 1) == 0)) ? 0x38383838 : 0; ones8 = (v8i){on, on, on, on, on, on, on, on}; }
        asm volatile("" : "+v"(ones8));
        const int tL = (qw0 >= 154) ? ((qw0 - 154) >> 6) + 1 : 0, tR = (qw0 + 185) >> 6;
        const float shl = tab[1024 + h];
        const LAS float* tabh = tab + h * 256;
        const int rel0 = -qw0 - r32 + 4 * hh + 128;
        asm volatile("s_waitcnt vmcnt(7)" ::: "memory"); __builtin_amdgcn_s_barrier(); asm volatile("" ::: "memory");
        f32x16 s0, s1; v8i p = {0, 0, 0, 0, 0, 0, 0, 0};
        v4i fa0, fa1, fb0, fb1;
        {   v4i kx[4];
            AT_RD128(kx[0], ka0, 0); AT_RD128(kx[1], ka1, 0); AT_RD128(kx[2], ka0, 2048); AT_RD128(kx[3], ka1, 2048);
            AT_RD128(fa0, va0, 7 * AT_SLOT); AT_RD128(fa1, va1, 7 * AT_SLOT); AT_RD128(fb0, va0, 7 * AT_SLOT + 2048); AT_RD128(fb1, va1, 7 * AT_SLOT + 2048);
            asm volatile("s_waitcnt lgkmcnt(4)" ::: "memory"); __builtin_amdgcn_sched_barrier(0);
            s0 = AT_MFMA8(((v8i){kx[0][0], kx[0][1], kx[0][2], kx[0][3], kx[1][0], kx[1][1], kx[1][2], kx[1][3]}), qf, AT_CM4);
            s1 = AT_MFMA8(((v8i){kx[2][0], kx[2][1], kx[2][2], kx[2][3], kx[3][0], kx[3][1], kx[3][2], kx[3][3]}), qf, AT_CM4); }
        __builtin_amdgcn_s_barrier(); asm volatile("" ::: "memory");
        const bool near0 = (0 >= tL) && (0 < tR);
#define AT_EXP8(sv, b0) do { if constexpr (!(VAR & 1)) { _Pragma("unroll") for (int r_ = (b0); r_ < (b0) + 8; ++r_) sv[r_] = __builtin_amdgcn_exp2f(sv[r_]); } } while (0)
#define AT_RDV(dst, addr, off) do { if constexpr (!(VAR & 4)) AT_RD128(dst, addr, off); else asm volatile("" : "=v"(dst)); } while (0)
#define AT_RDK(dst, addr, off) do { if constexpr (!(VAR & 16)) AT_RD128(dst, addr, off); else asm volatile("" : "=v"(dst)); } while (0)
#define AT_PV(dst, a, b) do { if constexpr (!(VAR & 2)) dst = AT_MFMA8B(a, b, dst); } while (0)
#define AT_SUM(b) do { if constexpr (!(VAR & 2)) osum = __builtin_amdgcn_mfma_scale_f32_16x16x128_f8f6f4(ones8, b, osum, 0, 1, 0, 0, 0, 0); } while (0)
#define AT_QK(dst, a) do { if constexpr (!(VAR & 8)) { const v8i a_ = (a); asm volatile("v_mfma_f32_32x32x64_f8f6f4 %0, %1, %2, -4.0" : "=&v"(dst) : "v"(a_), "v"(qf)); } } while (0)
#define AT_PK(dst, sv, b0) do { if constexpr (!(VAR & 32)) dst = pk4_bf8(sv[b0], sv[(b0) + 1], sv[(b0) + 2], sv[(b0) + 3]); else dst = __builtin_bit_cast(int, sv[b0]); } while (0)
#define AT_V8(a, b) ((v8i){a[0], a[1], a[2], a[3], b[0], b[1], b[2], b[3]})
#define AT_LGKM(n) do { asm volatile("s_waitcnt lgkmcnt(" #n ")" ::: "memory"); __builtin_amdgcn_sched_barrier(0); } while (0)
#define AT_STEP(SL, t) do { \
            if ((t) - 1 == tL) { _Pragma("unroll") for (int dt = 0; dt < 4; ++dt) o[dt] *= shl; osum *= shl; }    \
            AT_SUM(p); __builtin_amdgcn_sched_barrier(0);                                                           \
            if constexpr (!(VAR & 128)) { const int tk = (t) + 4 < 128 ? (t) + 4 : 127, tv = (t) + 6 < 128 ? (t) + 6 : 127; attn_dma_k(lds0, kg0, tk, (SL) & 3, wid, lane); attn_dma_v(lds0, vg0, tv, ((SL) + 6) & 7, wid, lane); } \
            { v4i fc0, fc1, fd0, fd1, fk0, fk1, fk2, fk3; \
              if ((t) >= tL && (t) < tR) { attn_bias(s0, s1, 64 * (t) + rel0, tabh); AT_EXP8(s0, 0); }           \
              AT_RDV(fc0, va0, (((SL) + 7) & 7) * AT_SLOT + 4096); AT_RDV(fc1, va1, (((SL) + 7) & 7) * AT_SLOT + 4096); AT_RDV(fd0, va0, (((SL) + 7) & 7) * AT_SLOT + 6144); AT_RDV(fd1, va1, (((SL) + 7) & 7) * AT_SLOT + 6144); \
              AT_RDK(fk0, ka0, (((SL) + 1) & 3) * AT_SLOT); AT_RDK(fk1, ka1, (((SL) + 1) & 3) * AT_SLOT); \
              AT_LGKM(6); \
              AT_PV(o[0], AT_V8(fa0, fa1), p); \
              AT_RDK(fk2, ka0, (((SL) + 1) & 3) * AT_SLOT + 2048); AT_RDK(fk3, ka1, (((SL) + 1) & 3) * AT_SLOT + 2048); \
              AT_EXP8(s0, 8); \
              __builtin_amdgcn_sched_barrier(0); \
              AT_PV(o[1], AT_V8(fb0, fb1), p); \
              AT_EXP8(s1, 0); \
              AT_LGKM(4); \
              AT_PV(o[2], AT_V8(fc0, fc1), p); \
              AT_RDV(fa0, va0, ((SL) & 7) * AT_SLOT); AT_RDV(fa1, va1, ((SL) & 7) * AT_SLOT); \
              AT_EXP8(s1, 8); \
              __builtin_amdgcn_sched_barrier(0); \
              AT_PV(o[3], AT_V8(fd0, fd1), p); \
              AT_RDV(fb0, va0, ((SL) & 7) * AT_SLOT + 2048); AT_RDV(fb1, va1, ((SL) & 7) * AT_SLOT + 2048); \
              AT_PK(p[0], s0, 0); AT_PK(p[1], s0, 4); AT_PK(p[2], s0, 8); AT_PK(p[3], s0, 12); \
              AT_LGKM(6); \
              AT_QK(s0, AT_V8(fk0, fk1)); \
              AT_PK(p[4], s1, 0); AT_PK(p[5], s1, 4); AT_PK(p[6], s1, 8); AT_PK(p[7], s1, 12); \
              AT_LGKM(4); \
              AT_QK(s1, AT_V8(fk2, fk3)); \
              asm volatile("" : "+v"(p));                            \
              if (!((t) + 1 >= tL && (t) + 1 < tR)) { asm volatile("s_nop 3" ::: "memory"); AT_EXP8(s0, 0); asm volatile("" : "+v"(s0)); } }     \
            asm volatile("s_waitcnt vmcnt(5)" ::: "memory"); if constexpr (!(VAR & 64)) __builtin_amdgcn_s_barrier(); asm volatile("" ::: "memory"); } while (0)
        if (!near0) { AT_EXP8(s0, 0); }
        for (int t0 = 0; t0 < 128; t0 += 8) { AT_STEP(0, t0); AT_STEP(1, t0 + 1); AT_STEP(2, t0 + 2); AT_STEP(3, t0 + 3); AT_STEP(4, t0 + 4); AT_STEP(5, t0 + 5); AT_STEP(6, t0 + 6); AT_STEP(7, t0 + 7); }
#undef AT_STEP
#undef AT_EXP8
#undef AT_RDV
#undef AT_RDK
#undef AT_PV
#undef AT_SUM
#undef AT_QK
#undef AT_PK
        {
            v4i fc0, fc1, fd0, fd1;
            AT_RD128(fc0, va0, 7 * AT_SLOT + 4096); AT_RD128(fc1, va1, 7 * AT_SLOT + 4096); AT_RD128(fd0, va0, 7 * AT_SLOT + 6144); AT_RD128(fd1, va1, 7 * AT_SLOT + 6144);
            if (127 == tL) { _Pragma("unroll") for (int dt = 0; dt < 4; ++dt) o[dt] *= shl; osum *= shl; }
            osum = __builtin_amdgcn_mfma_scale_f32_16x16x128_f8f6f4(ones8, p, osum, 0, 1, 0, 0, 0, 0);
            AT_LGKM(0);
            o[0] = AT_MFMA8B(AT_V8(fa0, fa1), p, o[0]); o[1] = AT_MFMA8B(AT_V8(fb0, fb1), p, o[1]); o[2] = AT_MFMA8B(AT_V8(fc0, fc1), p, o[2]); o[3] = AT_MFMA8B(AT_V8(fd0, fd1), p, o[3]);
        }
#undef AT_LGKM
#undef AT_V8
        asm volatile("s_waitcnt vmcnt(0)" ::: "memory"); __builtin_amdgcn_s_barrier(); asm volatile("" ::: "memory");
        const float lt = __shfl(osum[0], r32 + (r32 >= 16 ? 16 : 0));
        LAS float* xch = (LAS float*)(lds + qg * 16384);
        if (c == 1) { const float f = lam / lt;
#pragma unroll
            for (int dt = 0; dt < 4; ++dt)
#pragma unroll
                for (int r = 0; r < 16; ++r) xch[(dt * 16 + r) * 64 + lane] = o[dt][r] * f; }
        LDS_WAIT(); __builtin_amdgcn_s_barrier(); asm volatile("" ::: "memory");
        if (c == 0) { const float f = 1.f / lt; float ss = 0.f;
#pragma unroll
            for (int dt = 0; dt < 4; ++dt)
#pragma unroll
                for (int r = 0; r < 16; ++r) { const float v = o[dt][r] * f - xch[(dt * 16 + r) * 64 + lane]; o[dt][r] = v; ss += v * v; }
            ss += __shfl_xor(ss, 32);
            const float rn = rsqrtf(ss * (1.f / 128.f) + RMS_EPS) * (1.f - lam_init);
            bf16* orow = W.OAB + (size_t)F.T * 512 + ((size_t)b * SEQ + qw0 + r32) * 512 + h * 128;
#pragma unroll
            for (int dt = 0; dt < 4; ++dt)
#pragma unroll
                for (int g = 0; g < 4; ++g) { const int dv = 32 * dt + 8 * g + 4 * hh; const f32x4 sg = *(const f32x4*)(subg + dv);
                    u32x2 ov; ov.x = cvt_pk(o[dt][4 * g] * rn * sg[0], o[dt][4 * g + 1] * rn * sg[1]); ov.y = cvt_pk(o[dt][4 * g + 2] * rn * sg[2], o[dt][4 * g + 3] * rn * sg[3]);
                    *(u32x2*)(orow + dv) = ov; }
        }
        LDS_WAIT(); __builtin_amdgcn_s_barrier(); asm volatile("" ::: "memory");
        if (l == 0) {
            trb_items(F, 1, 1);
            for (int i2 = F.tid; i2 < 1028; i2 += NTHR) tab[i2] = W.tab[i2];
            __syncthreads();
        }
    }
    if (l == 0) trb_items(F, 1, 1 << 30);
}
constexpr int GL_CUM = 0;
constexpr int GL_S64 = 144, GL_S192 = 400;
constexpr int G1_KEF = 34816, G1_KEB = G1_KEF + 64 * GL_S64, G1_VT = G1_KEB + 64 * GL_S64;
constexpr int G3_AOP = 34816, G3_KIF = G3_AOP + 64 * GL_S192, G3_KIB = G3_KIF + 64 * GL_S64, G3_BOP = G3_KIB + 64 * GL_S64;
static_assert(G3_BOP + 128 * GL_S192 <= 150 * 1024, "GLA LDS");

__device__ __forceinline__ bf16x8 lds_frag(const LAS unsigned char* base, int row, int stride, int kbyte) { return *(const LAS bf16x8*)(base + row * stride + kbyte); }

struct GlaIn { u32x2 lg[4]; u32x4 k, v0, v1, q, st[4], sg0, sg1; };
template <bool G3>
__device__ __forceinline__ void gla_load(const Frame& F, const WS& W, int u, GlaIn& r) {
    const int n = u & 127, bh = u >> 7, b = bh >> 2, h = bh & 3; const size_t trow0 = (size_t)b * SEQ + n * 64;
#pragma unroll
    for (int it = 0; it < 4; ++it) { const int idx = F.tid + it * NTHR; const int dir = idx >> 10, t = (idx >> 4) & 63, d4 = (idx & 15) * 4;
        r.lg[it] = *(const u32x2*)((dir ? W.LGB : W.LGF) + (trow0 + t) * 256 + h * 64 + d4); }
    const int t = F.tid >> 3, d0 = (F.tid & 7) * 8, v0 = (F.tid & 7) * 16;
    r.k = *(const u32x4*)(W.GK + (trow0 + t) * 256 + h * 64 + d0);
    r.v0 = *(const u32x4*)(W.GV + (trow0 + t) * 512 + h * 128 + v0); r.v1 = *(const u32x4*)(W.GV + (trow0 + t) * 512 + h * 128 + v0 + 8);
    if constexpr (G3) {
        r.q = *(const u32x4*)(W.GQ + (trow0 + t) * 256 + h * 64 + d0);
        const int dv = F.tid >> 2, dd0 = (F.tid & 3) * 16;
#pragma unroll
        for (int dir = 0; dir < 2; ++dir) { const bf16* sp = (const bf16*)W.KVT + ((size_t)u * 2 + dir) * 8192 + dv * 64 + dd0; r.st[2 * dir] = *(const u32x4*)sp; r.st[2 * dir + 1] = *(const u32x4*)(sp + 8); }
        r.sg0 = *(const u32x4*)(W.SG + (trow0 + t) * 512 + h * 128 + v0); r.sg1 = *(const u32x4*)(W.SG + (trow0 + t) * 512 + h * 128 + v0 + 8);
    }
}
__device__ __forceinline__ void gla_cum(Frame& F, const GlaIn& r) {
    LAS float* cum = (LAS float*)(F.lds + GL_CUM);
#pragma unroll
    for (int it = 0; it < 4; ++it) { const int idx = F.tid + it * NTHR; const int dir = idx >> 10, t = (idx >> 4) & 63, d4 = (idx & 15) * 4;
        const u32x2 a = r.lg[it];
        *(LAS f32x4*)(cum + (dir * 64 + t) * 64 + d4) = (f32x4){bflo(a.x), bfhi(a.x), bflo(a.y), bfhi(a.y)}; }
    __syncthreads();
    {
        const int dir = F.tid >> 8, seg = (F.tid >> 6) & 3, d = F.tid & 63; LAS float* cc = cum + dir * 4096 + d; LAS float* tot = cum + 8192 + (dir * 4 + seg) * 64 + d;
        float v[16]; float run = 0.f;
        if (dir == 0) {
#pragma unroll
            for (int i = 0; i < 16; ++i) { run += cc[(16 * seg + i) * 64]; v[i] = run; }
        } else {
#pragma unroll
            for (int i = 15; i >= 0; --i) { run += cc[(16 * seg + i) * 64]; v[i] = run; }
        }
        *tot = run;
        __syncthreads();
        float off = 0.f; const LAS float* tb = cum + 8192 + dir * 256 + d;
        if (dir == 0) { if (seg > 0) off += tb[0]; if (seg > 1) off += tb[64]; if (seg > 2) off += tb[128]; }
        else { if (seg < 3) off += tb[192]; if (seg < 2) off += tb[128]; if (seg < 1) off += tb[64]; }
#pragma unroll
        for (int i = 0; i < 16; ++i) cc[(16 * seg + i) * 64] = v[i] + off;
    }
    __syncthreads();
}

__device__ __forceinline__ void phase_gla1(Frame& F) {
    refresh(F);
    const WS W = ws_map(F.ws, F.nb); const float* const* IN_ = F.a->in; (void)IN_; (void)W;
    LAS unsigned char* lds = F.lds; LAS float* cum = (LAS float*)(lds + GL_CUM);
    const int lane = F.lane, wid = F.wave, r32 = lane & 31, hh = lane >> 5;
    const int U = F.nb * NH * 128;
    GlaIn cur, nxt;
    if (F.bid < U) gla_load<false>(F, W, F.bid, nxt);
    for (int u = F.bid; u < U; u += F.G) {
        cur = nxt;
        if (u + F.G < U) gla_load<false>(F, W, u + F.G, nxt);
        gla_cum(F, cur);
        {
            const int t = F.tid >> 3, d0 = (F.tid & 7) * 8;
            const u32x4 kv = cur.k;
            const unsigned kw[4] = {kv.x, kv.y, kv.z, kv.w};
#pragma unroll
            for (int j = 0; j < 8; ++j) { const int d = d0 + j; const float k = (j & 1) ? bfhi(kw[j >> 1]) : bflo(kw[j >> 1]);
                const float ef = __expf(cum[63 * 64 + d] - cum[t * 64 + d]), eb = __expf(cum[4096 + d] - cum[4096 + t * 64 + d]);
                *(LAS bf16*)(lds + G1_KEF + d * GL_S64 + t * 2) = (bf16)(cvt_pk(k * ef, 0.f) & 0xffffu);
                *(LAS bf16*)(lds + G1_KEB + d * GL_S64 + t * 2) = (bf16)(cvt_pk(k * eb, 0.f) & 0xffffu); }
            const int v0 = (F.tid & 7) * 16;
            const u32x4 va = cur.v0, vb = cur.v1;
            const unsigned vw[8] = {va.x, va.y, va.z, va.w, vb.x, vb.y, vb.z, vb.w};
#pragma unroll
            for (int j = 0; j < 16; ++j) *(LAS bf16*)(lds + G1_VT + (v0 + j) * GL_S64 + t * 2) = (bf16)((j & 1) ? (vw[j >> 1] >> 16) : (vw[j >> 1] & 0xffffu));
            if (F.tid < 128) { const int dir = F.tid >> 6, d = F.tid & 63; W.DEC[((size_t)u * 2 + dir) * 64 + d] = __expf(dir ? cum[4096 + d] : cum[63 * 64 + d]); }
        }
        __syncthreads();
        {
            const int dt = wid & 3, dd = wid >> 2;
            f32x16 cf = {}, cb = {};
#pragma unroll
            for (int s = 0; s < 4; ++s) { const int kb = (16 * s + 8 * hh) * 2;
                const bf16x8 a = lds_frag(lds + G1_VT, 32 * dt + r32, GL_S64, kb);
                cf = __builtin_amdgcn_mfma_f32_32x32x16_bf16(a, lds_frag(lds + G1_KEF, 32 * dd + r32, GL_S64, kb), cf, 0, 0, 0);
                cb = __builtin_amdgcn_mfma_f32_32x32x16_bf16(a, lds_frag(lds + G1_KEB, 32 * dd + r32, GL_S64, kb), cb, 0, 0, 0); }
            bf16* of = (bf16*)W.KVT + ((size_t)u * 2) * 8192; bf16* ob = of + 8192;
#pragma unroll
            for (int r = 0; r < 16; ++r) { const int dv = 32 * dt + crow(r, hh), d = 32 * dd + r32;
                const float pf = __shfl_xor(cf[r], 1), pb = __shfl_xor(cb[r], 1);
                if (!(lane & 1)) { *(unsigned*)(of + dv * 64 + d) = cvt_pk(cf[r], pf); *(unsigned*)(ob + dv * 64 + d) = cvt_pk(cb[r], pb); } }
        }
        __syncthreads();
    }
}

__device__ __forceinline__ void phase_gla2(Frame& F) {
    refresh(F);
    const WS W = ws_map(F.ws, F.nb); const float* const* IN_ = F.a->in; (void)IN_; (void)W;
    const size_t total = (size_t)F.nb * NH * 2 * 4096;
    for (size_t wk = (size_t)F.bid * NTHR + F.tid; wk < total; wk += (size_t)F.G * NTHR) {
        const int e2 = (int)(wk & 4095), dir = (int)((wk >> 12) & 1), bh = (int)(wk >> 13), d = (e2 * 2) & 63;
        unsigned* base = (unsigned*)((bf16*)W.KVT + ((size_t)bh * 128 * 2 + dir) * 8192) + e2; const float* dec = W.DEC + ((size_t)bh * 128 * 2 + dir) * 64 + d;
        float S0 = 0.f, S1 = 0.f;
        for (int n0 = 0; n0 < 128; n0 += 8) {
            unsigned kv[8]; float dc0[8], dc1[8];
#pragma unroll
            for (int j = 0; j < 8; ++j) { const int n = dir ? 127 - (n0 + j) : n0 + j; kv[j] = base[(size_t)n * 8192]; dc0[j] = dec[(size_t)n * 128]; dc1[j] = dec[(size_t)n * 128 + 1]; }
#pragma unroll
            for (int j = 0; j < 8; ++j) { const int n = dir ? 127 - (n0 + j) : n0 + j; base[(size_t)n * 8192] = cvt_pk(S0, S1); S0 = dc0[j] * S0 + bflo(kv[j]); S1 = dc1[j] * S1 + bfhi(kv[j]); }
        }
    }
}

__device__ __forceinline__ void phase_gla3(Frame& F, int l) {
    refresh(F);
    const WS W = ws_map(F.ws, F.nb); const float* const* IN_ = F.a->in; (void)IN_; (void)W;
    LAS unsigned char* lds = F.lds; LAS float* cum = (LAS float*)(lds + GL_CUM);
    const int lane = F.lane, wid = F.wave, r32 = lane & 31, hh = lane >> 5;
    const float* gng = IN_[9] + l * 128;
    const int U = F.nb * NH * 128;
    GlaIn cur, nxt;
    if (F.bid < U) gla_load<true>(F, W, F.bid, nxt);
    for (int u = F.bid; u < U; u += F.G) {
        const int n = u & 127, bh = u >> 7, b = bh >> 2, h = bh & 3; const size_t trow0 = (size_t)b * SEQ + n * 64;
        cur = nxt;
        if (u + F.G < U) gla_load<true>(F, W, u + F.G, nxt);
        gla_cum(F, cur);
        {
            const int t = F.tid >> 3, d0 = (F.tid & 7) * 8;
            const u32x4 qv = cur.q, kv = cur.k;
            const unsigned qw[4] = {qv.x, qv.y, qv.z, qv.w}, kw[4] = {kv.x, kv.y, kv.z, kv.w};
            float qf[8], qb[8], kf[8], kb[8];
#pragma unroll
            for (int j = 0; j < 8; ++j) { const int d = d0 + j; const float q = (j & 1) ? bfhi(qw[j >> 1]) : bflo(qw[j >> 1]), k = (j & 1) ? bfhi(kw[j >> 1]) : bflo(kw[j >> 1]);
                const float cf = cum[t * 64 + d], cb = cum[4096 + t * 64 + d];
                qf[j] = q * __expf(cf); qb[j] = q * __expf(cb); kf[j] = k * __expf(-cf); kb[j] = k * __expf(-cb); }
            u32x4 o;
            o.x = cvt_pk(qf[0], qf[1]); o.y = cvt_pk(qf[2], qf[3]); o.z = cvt_pk(qf[4], qf[5]); o.w = cvt_pk(qf[6], qf[7]); *(LAS u32x4*)(lds + G3_AOP + t * GL_S192 + (64 + d0) * 2) = o;
            o.x = cvt_pk(qb[0], qb[1]); o.y = cvt_pk(qb[2], qb[3]); o.z = cvt_pk(qb[4], qb[5]); o.w = cvt_pk(qb[6], qb[7]); *(LAS u32x4*)(lds + G3_AOP + t * GL_S192 + (128 + d0) * 2) = o;
            o.x = cvt_pk(kf[0], kf[1]); o.y = cvt_pk(kf[2], kf[3]); o.z = cvt_pk(kf[4], kf[5]); o.w = cvt_pk(kf[6], kf[7]); *(LAS u32x4*)(lds + G3_KIF + t * GL_S64 + d0 * 2) = o;
            o.x = cvt_pk(kb[0], kb[1]); o.y = cvt_pk(kb[2], kb[3]); o.z = cvt_pk(kb[4], kb[5]); o.w = cvt_pk(kb[6], kb[7]); *(LAS u32x4*)(lds + G3_KIB + t * GL_S64 + d0 * 2) = o;
            const int v0 = (F.tid & 7) * 16;
            const u32x4 va = cur.v0, vb = cur.v1;
            const unsigned vw[8] = {va.x, va.y, va.z, va.w, vb.x, vb.y, vb.z, vb.w};
#pragma unroll
            for (int j = 0; j < 16; ++j) *(LAS bf16*)(lds + G3_BOP + (v0 + j) * GL_S192 + t * 2) = (bf16)((j & 1) ? (vw[j >> 1] >> 16) : (vw[j >> 1] & 0xffffu));
            const int dv = F.tid >> 2, dd0 = (F.tid & 3) * 16;
#pragma unroll
            for (int dir = 0; dir < 2; ++dir) { const u32x4 o0 = cur.st[2 * dir], o1 = cur.st[2 * dir + 1];
                *(LAS u32x4*)(lds + G3_BOP + dv * GL_S192 + (64 + 64 * dir + dd0) * 2) = o0; *(LAS u32x4*)(lds + G3_BOP + dv * GL_S192 + (64 + 64 * dir + dd0 + 8) * 2) = o1; }
        }
        __syncthreads();
        if (wid < 4) {
            const int it = wid >> 1, jt = wid & 1;
            f32x16 af = {}, ab = {};
#pragma unroll
            for (int s = 0; s < 4; ++s) { const int kb = (16 * s + 8 * hh) * 2;
                if (jt <= it) af = __builtin_amdgcn_mfma_f32_32x32x16_bf16(lds_frag(lds + G3_AOP, 32 * it + r32, GL_S192, 128 + kb), lds_frag(lds + G3_KIF, 32 * jt + r32, GL_S64, kb), af, 0, 0, 0);
                if (jt >= it) ab = __builtin_amdgcn_mfma_f32_32x32x16_bf16(lds_frag(lds + G3_AOP, 32 * it + r32, GL_S192, 256 + kb), lds_frag(lds + G3_KIB, 32 * jt + r32, GL_S64, kb), ab, 0, 0, 0); }
#pragma unroll
            for (int r = 0; r < 16; ++r) { const int i = 32 * it + crow(r, hh), j = 32 * jt + r32; const float v = (j <= i) ? af[r] : ab[r];
                *(LAS bf16*)(lds + G3_AOP + i * GL_S192 + j * 2) = (bf16)(cvt_pk(v, 0.f) & 0xffffu); }
        }
        __syncthreads();
        {
            const int it = wid >> 2, dt = wid & 3; f32x16 o = {};
#pragma unroll
            for (int s = 0; s < 12; ++s) { const int kb = (16 * s + 8 * hh) * 2;
                o = __builtin_amdgcn_mfma_f32_32x32x16_bf16(lds_frag(lds + G3_AOP, 32 * it + r32, GL_S192, kb), lds_frag(lds + G3_BOP, 32 * dt + r32, GL_S192, kb), o, 0, 0, 0); }
            LAS float* out = (LAS float*)(lds + GL_CUM);
#pragma unroll
            for (int r = 0; r < 16; ++r) out[(32 * it + crow(r, hh)) * 128 + 32 * dt + r32] = o[r];
        }
        __syncthreads();
        {
            const int t = F.tid >> 3, v0 = (F.tid & 7) * 16; const LAS float* orow = (const LAS float*)(lds + GL_CUM) + t * 128 + v0;
            float x[16]; float ss = 0.f;
#pragma unroll
            for (int j = 0; j < 16; ++j) { x[j] = orow[j]; ss += x[j] * x[j]; }
            ss += __shfl_xor(ss, 1); ss += __shfl_xor(ss, 2); ss += __shfl_xor(ss, 4);
            const float rs = rsqrtf(ss * (1.f / 128.f) + RMS_EPS);
            const u32x4 ga = cur.sg0, gb = cur.sg1;
            const unsigned gw[8] = {ga.x, ga.y, ga.z, ga.w, gb.x, gb.y, gb.z, gb.w};
            float y[16];
#pragma unroll
            for (int j = 0; j < 16; ++j) y[j] = x[j] * rs * gng[v0 + j] * ((j & 1) ? bfhi(gw[j >> 1]) : bflo(gw[j >> 1]));
            u32x4 o0, o1; o0.x = cvt_pk(y[0], y[1]); o0.y = cvt_pk(y[2], y[3]); o0.z = cvt_pk(y[4], y[5]); o0.w = cvt_pk(y[6], y[7]);
            o1.x = cvt_pk(y[8], y[9]); o1.y = cvt_pk(y[10], y[11]); o1.z = cvt_pk(y[12], y[13]); o1.w = cvt_pk(y[14], y[15]);
            bf16* dst = W.OAB + (trow0 + t) * 512 + h * 128 + v0; *(u32x4*)dst = o0; *(u32x4*)(dst + 8) = o1;
        }
        __syncthreads();
    }
}
__device__ __forceinline__ void phase_select(Frame& F, int l) {
    refresh(F);
    const WS W = ws_map(F.ws, F.nb); const float* const* IN_ = F.a->in; (void)IN_; (void)W;
    LAS int* lcnt = (LAS int*)F.lds; LAS int* lbase = lcnt + 32;
    const float* b_rg = IN_[19] + l * 4; const float* b_re = IN_[21] + l * 32;
    unsigned* gcnt = W.ctl + CW_CNT + l * 64;
    for (int t0 = F.bid * NTHR; t0 < F.T; t0 += F.G * NTHR) {
        if (F.tid < 32) lcnt[F.tid] = 0;
        __syncthreads();
        const int t = t0 + F.tid; int e0 = 0, e1 = 0, r0 = 0, r1 = 0; float g0 = 0.f, g1 = 0.f;
        if (t < F.T) {
            const float* lg = W.LOGITS + (size_t)t * 64;
            float gl[4]; { const f32x4 v = *(const f32x4*)lg; gl[0] = v[0] + b_rg[0]; gl[1] = v[1] + b_rg[1]; gl[2] = v[2] + b_rg[2]; gl[3] = v[3] + b_rg[3]; }
            int grp = 0; float mx = gl[0];
            if (gl[1] > mx) { mx = gl[1]; grp = 1; } if (gl[2] > mx) { mx = gl[2]; grp = 2; } if (gl[3] > mx) { mx = gl[3]; grp = 3; }
            const float p_grp = 1.f / (__expf(gl[0] - mx) + __expf(gl[1] - mx) + __expf(gl[2] - mx) + __expf(gl[3] - mx));
            const f32x4 ea = *(const f32x4*)(lg + 4 + grp * 8), eb = *(const f32x4*)(lg + 8 + grp * 8);
            const f32x4 ba = *(const f32x4*)(b_re + grp * 8), bb = *(const f32x4*)(b_re + grp * 8 + 4);
            float b0v = -1e30f, b1v = -1e30f; int i0 = 0, i1 = 0;
#pragma unroll
            for (int j = 0; j < 8; ++j) { const float e = (j < 4) ? ea[j] + ba[j] : eb[j - 4] + bb[j - 4];
                if (e > b0v) { b1v = b0v; i1 = i0; b0v = e; i0 = j; } else if (e > b1v) { b1v = e; i1 = j; } }
            const float p1 = __expf(b1v - b0v), s2 = 1.f + p1;
            e0 = grp * 8 + i0; e1 = grp * 8 + i1; g0 = p_grp / s2; g1 = p_grp * p1 / s2;
            r0 = __hip_atomic_fetch_add(lcnt + e0, 1, __ATOMIC_RELAXED, __HIP_MEMORY_SCOPE_WORKGROUP);
            r1 = __hip_atomic_fetch_add(lcnt + e1, 1, __ATOMIC_RELAXED, __HIP_MEMORY_SCOPE_WORKGROUP);
        }
        __syncthreads();
        if (F.tid < 32) lbase[F.tid] = (int)__hip_atomic_fetch_add(gcnt + F.tid, (unsigned)lcnt[F.tid], __ATOMIC_RELAXED, __HIP_MEMORY_SCOPE_AGENT);
        __syncthreads();
        if (t < F.T) { W.eid[t * 2] = e0; W.eid[t * 2 + 1] = e1; W.gate[t * 2] = g0; W.gate[t * 2 + 1] = g1; W.rank[t * 2] = lbase[e0] + r0; W.rank[t * 2 + 1] = lbase[e1] + r1; }
        __syncthreads();
    }
}
__device__ __forceinline__ void phase_gather(Frame& F, int l) {
    refresh(F);
    const WS W = ws_map(F.ws, F.nb); const float* const* IN_ = F.a->in; (void)IN_; (void)W;
    LAS int* seg = (LAS int*)F.lds; LAS int* cnt = seg + 40;
    const unsigned* gcnt = W.ctl + CW_CNT + l * 64;
    if (F.tid == 0) { int o = 0; for (int e = 0; e < 32; ++e) { const int c = (int)__hip_atomic_load(gcnt + e, __ATOMIC_RELAXED, __HIP_MEMORY_SCOPE_AGENT); seg[e] = o; cnt[e] = c; o += (c + 255) & ~255; } seg[32] = o; }
    __syncthreads();
    const int ntile = seg[32] >> 8;
    if (F.bid == 0) {
        for (int i = F.tid; i < ntile; i += NTHR) { int e = 0; while (e < 31 && (i << 8) >= seg[e + 1]) ++e; W.tilee[i] = e; }
        if (F.tid == 0) W.segp[0] = ntile;
    }
    for (int p = F.bid * NTHR + F.tid; p < (ntile << 8); p += F.G * NTHR) { int e = 0; while (e < 31 && p >= seg[e + 1]) ++e; if (p - seg[e] >= cnt[e]) W.stok[p] = 0; }
    for (int it = F.bid * NTHR + F.tid; it < F.T * 2; it += F.G * NTHR) {
        const int e = W.eid[it], p = seg[e] + W.rank[it];
        W.stok[p] = it >> 1; W.pos[it] = p; W.gsort[p] = W.gate[it];
    }
}

#ifndef MK_MASK
#define MK_MASK 0xffffffffu
#endif
#define EN(b) (((MK_MASK) >> (b)) & 1u)
#ifndef MK_ALIGN
#define MK_ALIGN true
#endif
#ifndef MK_SP2
#define MK_SP2 true
#endif
#ifndef MK_DUP
#define MK_DUP 0u
#endif
#define REPS(b) ((((MK_DUP) >> (b)) & 1u) ? 2 : 1)
constexpr int NPL = 14, NPH = 2 + DEPTH * NPL;
#ifdef MK_UB
__device__ __forceinline__ void ub_bench(Frame& F) {
    {
        typedef int ub8i __attribute__((ext_vector_type(8))); typedef int ub4i __attribute__((ext_vector_type(4)));
        ub8i ua, ubb; for (int i = 0; i < 8; ++i) { ua[i] = 0x38383838 + F.lane; ubb[i] = 0x30303030 + F.lane * 3; }
        f32x16 acc0 = {}, acc1 = {}, acc2 = {}, acc3 = {};
        float e0 = F.lane * 0.01f, e1 = e0 + 1, e2 = e0 + 2, e3 = e0 + 3, e4 = e0 + 4, e5 = e0 + 5, e6 = e0 + 6, e7 = e0 + 7;
        ub4i ld0 = {}, ld1 = {}; const unsigned la = (unsigned)(unsigned long)F.lds + F.tid * 16;
#define UB_M(acc) do { if constexpr (MK_UB & 1) acc = __builtin_amdgcn_mfma_scale_f32_32x32x64_f8f6f4(ua, ubb, acc, 0, (MK_UB & 16) ? 1 : 0, 0, 0, 0, 0); } while (0)
#define UB_E() do { if constexpr (MK_UB & 2) { e0 = __builtin_amdgcn_exp2f(e0); e1 = __builtin_amdgcn_exp2f(e1); e2 = __builtin_amdgcn_exp2f(e2); e3 = __builtin_amdgcn_exp2f(e3); \
                                              e4 = __builtin_amdgcn_exp2f(e4); e5 = __builtin_amdgcn_exp2f(e5); e6 = __builtin_amdgcn_exp2f(e6); e7 = __builtin_amdgcn_exp2f(e7); } } while (0)
#define UB_L() do { if constexpr (MK_UB & 4) { asm volatile("ds_read_b128 %0, %1" : "=&v"(ld0) : "v"(la) : "memory"); asm volatile("ds_read_b128 %0, %1 offset:8192" : "=&v"(ld1) : "v"(la) : "memory"); } } while (0)
        float g0 = e0, g1 = e1, g2 = e2, g3 = e3, g4 = e4, g5 = e5, g6 = e6, g7 = e7;
#define UB_F() do { if constexpr (MK_UB & 64) { g0 = fmaf(g0, 1.0001f, 0.5f); g1 = fmaf(g1, 1.0001f, 0.5f); g2 = fmaf(g2, 1.0001f, 0.5f); g3 = fmaf(g3, 1.0001f, 0.5f); \
                                                g4 = fmaf(g4, 1.0001f, 0.5f); g5 = fmaf(g5, 1.0001f, 0.5f); g6 = fmaf(g6, 1.0001f, 0.5f); g7 = fmaf(g7, 1.0001f, 0.5f); } } while (0)
        if (!(MK_UB & 32) || F.wave < 4)
        for (int it = 0; it < 2000; ++it) {
            UB_M(acc0); __builtin_amdgcn_sched_barrier(0); UB_E(); UB_F(); UB_L(); __builtin_amdgcn_sched_barrier(0);
            UB_M(acc1); __builtin_amdgcn_sched_barrier(0); UB_E(); UB_F(); UB_L(); __builtin_amdgcn_sched_barrier(0);
            UB_M(acc2); __builtin_amdgcn_sched_barrier(0); UB_E(); UB_F(); UB_L(); __builtin_amdgcn_sched_barrier(0);
            UB_M(acc3); __builtin_amdgcn_sched_barrier(0); UB_E(); UB_F(); UB_L(); __builtin_amdgcn_sched_barrier(0);
            if constexpr (MK_UB & 4) asm volatile("s_waitcnt lgkmcnt(0)" ::: "memory");
        }
        const float sink = g0 + g1 + g2 + g3 + g4 + g5 + g6 + g7 + acc0[0] + acc1[1] + acc2[2] + acc3[3] + e0 + e1 + e2 + e3 + e4 + e5 + e6 + e7 + (float)(ld0[0] + ld1[1]);
        if (sink == 12345.678f) ((unsigned*)F.ws)[CW_CNT + 77] = 1u;
        __syncthreads();
    }
}
#endif
__global__ void __launch_bounds__(NTHR, 2) mk_fwd(Args args) {
    extern __shared__ __attribute__((aligned(16))) unsigned char lds_raw[];
    Frame F;
    F.lds = (LAS unsigned char*)lds_raw; F.tid = threadIdx.x; F.lane = F.tid & 63; F.wave = __builtin_amdgcn_readfirstlane(F.tid >> 6);
    F.G = gridDim.x; F.bid = blockIdx.x; F.nb = args.nb; F.T = args.nb * SEQ; F.ws = args.ws; F.a = &args; F.xbuf = args.out;
    const float* const* IN_ = args.in;
    volatile LAS unsigned* misc = (volatile LAS unsigned*)(F.lds + LDS_MISC);
    if (F.tid < 64) misc[F.tid] = 0u;
    __syncthreads();
    XcdBarrier bar = xcd_barrier_post((unsigned*)args.ws + CW_BAR + args.li * XCD_BAR_WORDS, misc);
    const int lo = args.ph_lo, hi = args.ph_hi;
#define IN(k) (lo <= (k) && (k) < hi)
#ifdef MK_BAR2
#define SEAM(k) do { if (IN(k) && IN((k) + 1)) { xcd_barrier(bar); xcd_barrier(bar); } } while (0)
#else
#define SEAM(k) do { if (IN(k) && IN((k) + 1)) xcd_barrier(bar); } while (0)
#endif
#if defined(MK_UB) && !defined(MK_UB_MID)
    ub_bench(F);
#endif
    LAS unsigned char* gl = F.lds;
#ifndef MK_P0MASK
#define MK_P0MASK 0xffu
#endif
    if (EN(0) && IN(0)) { for (int rp = 0; rp < REPS(0); ++rp) { p0_prologue(F, rp ? (MK_P0MASK) : 0xffu); __syncthreads(); } SEAM(0); }
    for (int l = 0; l < DEPTH; ++l) {
        const int pb = 1 + l * NPL;
#if defined(MK_UB) && defined(MK_UB_MID)
        if (l == 1) { ub_bench(F); refresh(F); }
#endif
        if (EN(1) && IN(pb + 0)) { for (int rp = 0; rp < ((l == 0) ? REPS(14) : 1); ++rp) phase_norm(F, l, 0); SEAM(pb + 0); }
        if (EN(2) && IN(pb + 1)) { const WS W = ws_map(F.ws, F.nb);
            pg8::Gemm g{W.H, W.win + (size_t)l * NIN * D, F.T, NIN, D}; pg8::StaticOrder S; S.init(F.T, NIN, F.G, F.bid);
            EpiIn E{W.GQ, W.GK, W.GV, W.SG, W.LGF, W.LGB, W.DQ, W.DK, W.DV, W.SGA, W.SGB, IN_[8] + l * 512, IN_[10] + l * 64, IN_[11] + l * 64, 0};
#ifdef MK_DEPHASE
            { const int g_ = (F.bid >> 3) & 7; for (int k_ = 0; k_ < g_ * MK_DEPHASE; ++k_) __builtin_amdgcn_s_sleep(127); }
#endif
#ifdef MK_INPROJ_PLAIN
            { EpiIn EP_ = E; EP_.plain = 1; pg8::gemm_phase<EpiIn, pg8::StaticOrder, MK_ALIGN, MK_SP2>(gl, g, S, EP_); }
#endif
#ifdef MK_INPROJ_NULL
            { EpiNull EN_; pg8::gemm_phase<EpiNull, pg8::StaticOrder, MK_ALIGN, MK_SP2>(gl, g, S, EN_); }
#endif
            for (int rp = 0; rp < REPS(2); ++rp) pg8::gemm_phase<EpiIn, pg8::StaticOrder, MK_ALIGN, MK_SP2>(gl, g, S, E);
            SEAM(pb + 1);
        }
        if (EN(3) && IN(pb + 2)) { for (int rp = 0; rp < REPS(3); ++rp) phase_gla1(F); SEAM(pb + 2); }
        if (EN(4) && IN(pb + 3)) { phase_gla2(F); SEAM(pb + 3); }
        if (EN(5) && IN(pb + 4)) { for (int rp = 0; rp < REPS(5); ++rp) phase_gla3(F, l); __syncthreads(); }
        if (EN(6) && IN(pb + 5)) {
#ifdef MK_ATT_PROBE
            phase_attn<MK_ATT_PROBE>(F, l);
#endif
#ifdef MK_CLK
            unsigned long long ct0 = 0, cr0 = 0; if (l == 1) { ct0 = __builtin_readcyclecounter(); cr0 = __builtin_amdgcn_s_memrealtime(); }
#endif
            phase_attn<0>(F, l);
#ifdef MK_CLK
            if (l == 1 && F.bid == 0 && F.tid == 0) {
                const unsigned long long ct1 = __builtin_readcyclecounter(), cr1 = __builtin_amdgcn_s_memrealtime();
                const unsigned long long ticks = (ct1 - ct0) * (unsigned long long)(MK_CLK) / (cr1 - cr0 + 1);
                while (__builtin_amdgcn_s_memrealtime() - cr1 < ticks) __builtin_amdgcn_s_sleep(8);
            }
            __syncthreads();
#endif
            SEAM(pb + 5); }
        if (EN(7) && IN(pb + 6)) { const WS W = ws_map(F.ws, F.nb);
            pg8::Gemm g{W.OAB, W.wab + (size_t)l * D * D, 0, 0, 512}; MergeOrder S; S.so.init(F.T, D, F.G, F.bid); S.nM = F.T / 256;
            EpiMerge E{W.SGA, W.SGB, W.MERGED, F.T / 256};
            for (int rp = 0; rp < REPS(7); ++rp) pg8::gemm_phase<EpiMerge, MergeOrder, MK_ALIGN, MK_SP2>(gl, g, S, E);
            SEAM(pb + 6);
        }
        if (EN(8) && IN(pb + 7)) { const WS W = ws_map(F.ws, F.nb); const float* modl = W.mod + (size_t)l * NBMAX * 6 * D;
            pg8::Gemm g{W.MERGED, W.wo + (size_t)l * D * D, F.T, D, D}; pg8::StaticOrder S; S.init(F.T, D, F.G, F.bid);
            EpiResid E{l == 0 ? IN_[0] : nullptr, W.XB, modl + 2 * D};
            for (int rp = 0; rp < ((l == 0) ? REPS(8) : 1); ++rp) pg8::gemm_phase<EpiResid, pg8::StaticOrder, MK_ALIGN, MK_SP2>(gl, g, S, E);
            SEAM(pb + 7);
        }
        if (EN(1) && IN(pb + 8)) { for (int rp = 0; rp < REPS(1); ++rp) phase_norm(F, l, 1); SEAM(pb + 8); }
        if (EN(9) && IN(pb + 9)) { const WS W = ws_map(F.ws, F.nb);
            pg8::Gemm g{W.H, W.wr + (size_t)l * 256 * D, F.T, 256, D}; pg8::StaticOrder S; S.init(F.T, 256, F.G, F.bid);
            EpiLogits E{W.LOGITS};
            for (int rp = 0; rp < REPS(9); ++rp) pg8::gemm_phase<EpiLogits, pg8::StaticOrder, MK_ALIGN, MK_SP2>(gl, g, S, E);
            SEAM(pb + 9);
        }
        if (EN(10) && IN(pb + 10)) { phase_select(F, l); SEAM(pb + 10); }
        if (EN(11) && IN(pb + 11)) { for (int rp = 0; rp < REPS(11); ++rp) { phase_gather(F, l); __syncthreads(); } SEAM(pb + 11); }
        if (EN(12) && IN(pb + 12)) { const WS W = ws_map(F.ws, F.nb);
            const int ntile = W.segp[0];
#if MK_MOE_FP8
            pg8::Gemm g{W.XS, (const bf16*)((const unsigned char*)W.w1 + (size_t)l * NE * 1024 * D), 0, 0, D / 2}; GroupedOrder S{W.tilee, ntile * 4, F.G, F.bid};
            EpiAct E{(unsigned char*)W.ACT};
#else
            pg8::Gemm g{W.H, W.w1 + (size_t)l * NE * 1024 * D, 0, 0, D}; GroupedOrder S{W.tilee, ntile * 4, F.G, F.bid, W.stok};
            EpiAct E{W.ACT};
#endif
            for (int rp = 0; rp < REPS(12); ++rp) pg8::gemm_phase<EpiAct, GroupedOrder, MK_ALIGN, MK_SP2, true>(gl, g, S, E);
            SEAM(pb + 12);
        }
        if (EN(13) && IN(pb + 13)) { const WS W = ws_map(F.ws, F.nb);
            const int ntile = W.segp[0];
#if MK_MOE_FP8
            pg8::Gemm g{W.ACT, (const bf16*)((const unsigned char*)W.w2 + (size_t)l * NE * D * DE), 0, 0, DE / 2}; GroupedOrder S{W.tilee, ntile * 4, F.G, F.bid};
#else
            pg8::Gemm g{W.ACT, W.w2 + (size_t)l * NE * D * DE, 0, 0, DE}; GroupedOrder S{W.tilee, ntile * 4, F.G, F.bid, nullptr};
#endif
            EpiYs E{(unsigned char*)W.YS, W.gsort};
            for (int rp = 0; rp < REPS(13); ++rp) pg8::gemm_phase<EpiYs, GroupedOrder, MK_ALIGN, MK_SP2>(gl, g, S, E);
            SEAM(pb + 13);
        }
    }
    if (EN(1) && IN(NPH - 1)) phase_norm(F, 0, 2);
#undef IN
#undef SEAM
}

struct LaunchCfg { int grid; bool ok; };
inline LaunchCfg& launch_cfg() {
    static LaunchCfg c{0, false}; static bool init = false;
    if (!init) { init = true;
        int dev = 0, cus = 0, per_cu = 0;
        if (hipGetDevice(&dev) != hipSuccess || hipDeviceGetAttribute(&cus, hipDeviceAttributeMultiprocessorCount, dev) != hipSuccess) { fprintf(stderr, "mk: device query failed\n"); return c; }
        if (hipFuncSetAttribute((const void*)mk_fwd, hipFuncAttributeMaxDynamicSharedMemorySize, LDS_BYTES) != hipSuccess) { fprintf(stderr, "mk: hipFuncSetAttribute failed\n"); return c; }
        if (hipOccupancyMaxActiveBlocksPerMultiprocessor(&per_cu, (const void*)mk_fwd, NTHR, LDS_BYTES) != hipSuccess || per_cu < 1) { fprintf(stderr, "mk: occupancy query says %d blocks/CU\n", per_cu); (void)hipGetLastError(); return c; }
        c.grid = cus; c.ok = true;
    }
    return c;
}
inline void launch_range(void* const* d_in, float* xbuf, void* d_ws, int nb, int lo, int hi, int li, hipStream_t stream) {
    LaunchCfg& c = launch_cfg(); if (!c.ok) return;
    Args a{}; for (int i = 0; i < 24; ++i) a.in[i] = (const float*)d_in[i];
    a.out = xbuf; a.ws = (unsigned char*)d_ws; a.nb = nb; a.ph_lo = lo; a.ph_hi = hi; a.li = li;
    hipLaunchKernelGGL(mk_fwd, dim3(c.grid), dim3(NTHR), LDS_BYTES, stream, a);
    const hipError_t le = hipPeekAtLastError(); if (le != hipSuccess) fprintf(stderr, "mk: launch [%d,%d) failed: %s\n", lo, hi, hipGetErrorName(le));
}
}
extern "C" void kernel_launch(void* const* d_in, const int* in_sizes, int n_in, void* d_out, int out_size, void* d_ws, size_t ws_size, hipStream_t stream) {
    (void)in_sizes; (void)n_in; (void)out_size;
    static int checked = 0;
    if (!checked) { checked = 1; const mk::WS w = mk::ws_map((unsigned char*)d_ws, 4); if (w.end > ws_size) { fprintf(stderr, "mk: workspace too small: need %zu, have %zu\n", w.end, ws_size); checked = -1; } }
    if (checked < 0) return;
    if (hipMemsetAsync(d_ws, 0, mk::CTL_BYTES, stream) != hipSuccess) return;
    mk::launch_range(d_in, (float*)d_out, d_ws, 4, 0, mk::NPH, 0, stream);
}
```
